# Optimizing an MI355X kernel written in HIP

```python
import math
import jax
import jax.numpy as jnp
from jax import lax
import numpy as np

D_MODEL = 1024
BATCH = 4
SEQ = 8192
DEPTH = 2

CHUNK = 64
Q_BLOCK = 128
PLE_DIM = 256
RMS_EPS = 1e-6

SSM_GROUP_CH = 16
SSM_GROUPS = 16
SSM_WIDTH = SSM_GROUPS * SSM_GROUP_CH
SSM_STATE = 64

FOX_HEADS = 4
FOX_HEAD_DIM = 64

MLA_HEADS = 4
MLA_NOPE_DIM = 64
MLA_ROPE_DIM = 32
MLA_V_DIM = 64
MLA_Q_LORA = 192
MLA_KV_LORA = 128
ROPE_BASE = 10000.0

CHK_HEADS = 4
CHK_HEAD_DIM = 64
LEFT_CHUNKS = 8
REL_CLIP = 256

N_BRANCHES = 4
BRANCH_WIDTH = 256

IN_SIZES = (SSM_WIDTH,
            FOX_HEADS * FOX_HEAD_DIM, FOX_HEADS * FOX_HEAD_DIM, FOX_HEADS * FOX_HEAD_DIM, FOX_HEADS,
            MLA_Q_LORA, MLA_KV_LORA, MLA_ROPE_DIM,
            CHK_HEADS * CHK_HEAD_DIM, CHK_HEADS * CHK_HEAD_DIM, CHK_HEADS * CHK_HEAD_DIM)
D_IN = sum(IN_SIZES)

D_FF = 2816
N_EXPERTS = 8
TOP_K = 2
D_FF_EXPERT = 1408
MOE_BLOCK = 256
N_DENSE = (DEPTH + 1) // 2
N_MOE = DEPTH // 2

kernel_name = "hybrid_streaming_encoder_block"


def rms_norm(x, g):
    xf = x.astype(jnp.float32)
    y = xf * lax.rsqrt(jnp.mean(xf * xf, axis=-1, keepdims=True) + RMS_EPS)
    return (y * g.astype(jnp.float32)).astype(x.dtype)


def rope_tables(positions):
    inv_freq = ROPE_BASE ** (-jnp.arange(0, MLA_ROPE_DIM, 2, dtype=jnp.float32) / MLA_ROPE_DIM)
    ang = positions.astype(jnp.float32)[..., None] * inv_freq
    return jnp.cos(ang)[:, :, None, :], jnp.sin(ang)[:, :, None, :]


def apply_rope(t, cos, sin):
    tf = t.astype(jnp.float32)
    t1, t2 = jnp.split(tf, 2, axis=-1)
    return jnp.concatenate([t1 * cos - t2 * sin, t2 * cos + t1 * sin], axis=-1).astype(t.dtype)


def s5_mixer(u, a_re, a_im, log_dt, b_re, b_im, c_re, c_im, d_skip, w_glu):
    bsz, seq, _ = u.shape
    f32 = jnp.float32
    uf = u.astype(f32).reshape(bsz, seq, SSM_GROUPS, SSM_GROUP_CH)
    ar, ai = a_re.astype(f32), a_im.astype(f32)
    dt = jnp.exp(log_dt.astype(f32))[:, None]
    mag = jnp.exp(ar * dt)
    abar_r, abar_i = mag * jnp.cos(ai * dt), mag * jnp.sin(ai * dt)
    den = ar * ar + ai * ai
    nr, ni = abar_r - 1.0, abar_i
    coef_r = (nr * ar + ni * ai) / den
    coef_i = (ni * ar - nr * ai) / den
    br, bi = b_re.astype(f32), b_im.astype(f32)
    bbar_r = coef_r[..., None] * br - coef_i[..., None] * bi
    bbar_i = coef_r[..., None] * bi + coef_i[..., None] * br
    bu_r = jnp.einsum("blgh,gph->blgp", uf, bbar_r)
    bu_i = jnp.einsum("blgh,gph->blgp", uf, bbar_i)
    a_r = jnp.broadcast_to(abar_r, bu_r.shape)
    a_i = jnp.broadcast_to(abar_i, bu_i.shape)

    def combine(left, right):
        lar, lai, lbr, lbi = left
        rar, rai, rbr, rbi = right
        return (rar * lar - rai * lai, rar * lai + rai * lar,
                rar * lbr - rai * lbi + rbr, rar * lbi + rai * lbr + rbi)

    _, _, xr, xi = lax.associative_scan(combine, (a_r, a_i, bu_r, bu_i), axis=1)
    y = (jnp.einsum("blgp,ghp->blgh", xr, c_re.astype(f32))
         - jnp.einsum("blgp,ghp->blgh", xi, c_im.astype(f32))
         + d_skip.astype(f32) * uf)
    y = jax.nn.gelu(y.reshape(bsz, seq, SSM_WIDTH)).astype(u.dtype)
    return y * jax.nn.sigmoid(y @ w_glu)


def blocked_attention(q, k, v, frame_causal, decay_cum=None):
    bsz, seq, nh, dq = q.shape
    dv = v.shape[-1]
    nb = seq // Q_BLOCK
    q_blocks = (q * (dq ** -0.5)).reshape(bsz, nb, Q_BLOCK, nh, dq).transpose(1, 0, 2, 3, 4)
    kpos = jnp.arange(seq)
    xs = (q_blocks, jnp.arange(nb))
    if decay_cum is not None:
        xs = xs + (decay_cum.reshape(bsz, nb, Q_BLOCK, nh).transpose(1, 0, 3, 2),)
        decay_k = decay_cum.transpose(0, 2, 1)

    def one_block(args):
        q_blk, blk = args[0], args[1]
        qpos = blk * Q_BLOCK + jnp.arange(Q_BLOCK)
        if frame_causal:
            mask = kpos[None, :] <= qpos[:, None]
        else:
            mask = (kpos[None, :] // CHUNK) <= (qpos[:, None] // CHUNK)
        s = jnp.einsum("bqhd,bkhd->bhqk", q_blk, k, preferred_element_type=jnp.float32)
        if decay_cum is not None:
            s = s + (args[2][..., None] - decay_k[:, :, None, :])
        s = jnp.where(mask, s, -jnp.inf)
        prob = jax.nn.softmax(s, axis=-1).astype(v.dtype)
        return jnp.einsum("bhqk,bkhd->bqhd", prob, v)

    out = lax.map(one_block, xs)
    return out.transpose(1, 0, 2, 3, 4).reshape(bsz, seq, nh * dv)


def fox_mixer(q, k, v, f_logit, b_f):
    bsz, seq, _ = q.shape
    split = lambda t: t.reshape(bsz, seq, FOX_HEADS, FOX_HEAD_DIM)
    log_f = jax.nn.log_sigmoid(f_logit.astype(jnp.float32) + b_f.astype(jnp.float32))
    decay_cum = jnp.cumsum(log_f, axis=1)
    return blocked_attention(split(q), split(k), split(v), True, decay_cum)


def mla_mixer(c_q, c_kv, k_pe, cos, sin, g_q, w_uq, g_kv, w_ukv):
    bsz, seq, _ = c_q.shape
    q = (rms_norm(c_q, g_q) @ w_uq).reshape(bsz, seq, MLA_HEADS, MLA_NOPE_DIM + MLA_ROPE_DIM)
    q_nope, q_pe = q[..., :MLA_NOPE_DIM], q[..., MLA_NOPE_DIM:]
    kv = (rms_norm(c_kv, g_kv) @ w_ukv).reshape(bsz, seq, MLA_HEADS, MLA_NOPE_DIM + MLA_V_DIM)
    k_nope, v = kv[..., :MLA_NOPE_DIM], kv[..., MLA_NOPE_DIM:]
    q_pe = apply_rope(q_pe, cos, sin)
    k_pe = jnp.broadcast_to(apply_rope(k_pe[:, :, None, :], cos, sin), (bsz, seq, MLA_HEADS, MLA_ROPE_DIM))
    q = jnp.concatenate([q_nope, q_pe], axis=-1)
    k = jnp.concatenate([k_nope, k_pe], axis=-1)
    return blocked_attention(q, k, v, False)


def chunk_band_attention(q, k, v, rel_bias):
    bsz, seq, nh, dh = q.shape
    nc = seq // CHUNK
    band = (LEFT_CHUNKS + 1) * CHUNK
    qc = (q * (dh ** -0.5)).reshape(bsz, nc, CHUNK, nh, dh)

    def gather_band(t):
        tc = t.reshape(bsz, nc, CHUNK, nh, dh)
        tp = jnp.pad(tc, ((0, 0), (LEFT_CHUNKS, 0), (0, 0), (0, 0), (0, 0)))
        return jnp.concatenate([tp[:, j:j + nc] for j in range(LEFT_CHUNKS + 1)], axis=2)

    kb, vb = gather_band(k), gather_band(v)
    s = jnp.einsum("bnqhd,bnkhd->bnhqk", qc, kb, preferred_element_type=jnp.float32)
    qi = jnp.arange(CHUNK)
    kj = jnp.arange(band)
    rel = qi[:, None] + LEFT_CHUNKS * CHUNK - kj[None, :]
    idx = jnp.clip(rel, -REL_CLIP, REL_CLIP) + REL_CLIP
    bias = rel_bias.astype(jnp.float32)[:, idx]
    valid = (jnp.arange(nc)[:, None] - LEFT_CHUNKS + kj[None, :] // CHUNK) >= 0
    s = jnp.where(valid[None, :, None, None, :], s + bias[None, None], -jnp.inf)
    prob = jax.nn.softmax(s, axis=-1).astype(v.dtype)
    out = jnp.einsum("bnhqk,bnkhd->bnqhd", prob, vb)
    return out.reshape(bsz, seq, nh * dh)


def hybrid_mixer(h, cos, sin, w_in, ssm_a_re, ssm_a_im, ssm_log_dt, ssm_b_re, ssm_b_im, ssm_c_re,
                 ssm_c_im, ssm_d, ssm_w_glu, fox_b_f, mla_g_q, mla_w_uq, mla_g_kv, mla_w_ukv,
                 chk_rel_bias, w_branch, w_gate, b_gate, w_o):
    bsz, seq, _ = h.shape
    splits = np.cumsum(IN_SIZES)[:-1].tolist()
    (u, fq, fk, fv, ff, cq, ckv, kpe, dq, dk, dv) = jnp.split(h @ w_in, splits, axis=-1)
    y_a = s5_mixer(u, ssm_a_re, ssm_a_im, ssm_log_dt, ssm_b_re, ssm_b_im, ssm_c_re, ssm_c_im, ssm_d, ssm_w_glu)
    y_b = fox_mixer(fq, fk, fv, ff, fox_b_f)
    y_c = mla_mixer(cq, ckv, kpe, cos, sin, mla_g_q, mla_w_uq, mla_g_kv, mla_w_ukv)
    heads = lambda t: t.reshape(bsz, seq, CHK_HEADS, CHK_HEAD_DIM)
    y_d = chunk_band_attention(heads(dq), heads(dk), heads(dv), chk_rel_bias)
    merged = None
    for bi, y in enumerate((y_a, y_b, y_c, y_d)):
        term = jax.nn.sigmoid(h @ w_gate[bi] + b_gate[bi]) * (y @ w_branch[bi])
        merged = term if merged is None else merged + term
    return merged @ w_o


def swiglu(h, w1, w3, w2):
    return (jax.nn.silu(h @ w1) * (h @ w3)) @ w2


def moe_swiglu(h, w_router, b_router, w1, w3, w2):
    bsz, seq, d = h.shape
    n = bsz * seq
    hf = h.reshape(n, d)
    logits = jnp.dot(hf.astype(jnp.float32), w_router.astype(jnp.float32)) + b_router.astype(jnp.float32)
    top_logit, top_idx = lax.top_k(logits, TOP_K)
    gate = jax.nn.softmax(top_logit, axis=-1)
    nk = n * TOP_K
    e_flat = top_idx.reshape(nk)
    tok_flat = jnp.repeat(jnp.arange(n, dtype=jnp.int32), TOP_K)
    gate_flat = gate.reshape(nk)
    order = jnp.argsort(e_flat)
    e_s, tok_s, gate_s = e_flat[order], tok_flat[order], gate_flat[order]
    counts = jnp.bincount(e_flat, length=N_EXPERTS)
    padded = (counts + MOE_BLOCK - 1) // MOE_BLOCK * MOE_BLOCK
    pad_end = jnp.cumsum(padded)
    pad_start = pad_end - padded
    start = jnp.cumsum(counts) - counts
    dest = pad_start[e_s] + jnp.arange(nk) - start[e_s]
    n_blocks = -(-nk // MOE_BLOCK) + N_EXPERTS
    m = n_blocks * MOE_BLOCK
    slot_tok = jnp.full((m,), n, jnp.int32).at[dest].set(tok_s)
    h_pad = jnp.concatenate([hf, jnp.zeros((1, d), hf.dtype)], axis=0)
    xb = h_pad[slot_tok].reshape(n_blocks, MOE_BLOCK, d)
    block_expert = jnp.minimum(
        jnp.searchsorted(pad_end, jnp.arange(n_blocks) * MOE_BLOCK, side="right"), N_EXPERTS - 1)

    def expert_block(args):
        x_blk, e = args
        return (jax.nn.silu(x_blk @ w1[e]) * (x_blk @ w3[e])) @ w2[e]

    yb = lax.map(expert_block, (xb, block_expert)).reshape(m, d)
    y_s = yb[dest] * gate_s[:, None].astype(h.dtype)
    out = jnp.zeros((n, d), h.dtype).at[tok_s].add(y_s)
    return out.reshape(bsz, seq, d)


def setup_inputs(seed: int = 0) -> dict:
    key = jax.random.key(seed)
    ks = iter(jax.random.split(key, 48))
    f32 = jnp.float32

    def nrm(shape, scale):
        return jax.random.normal(next(ks), shape, f32) * scale

    def gain(shape):
        return 1.0 + nrm(shape, 0.02)

    L, G, P, Hg = DEPTH, SSM_GROUPS, SSM_STATE, SSM_GROUP_CH
    x = nrm((BATCH, SEQ, D_MODEL), 1.0)
    p = nrm((DEPTH, BATCH, SEQ, PLE_DIM), 1.0)
    offset = jax.random.randint(next(ks), (BATCH, 1), 0, 256, dtype=jnp.int32) * CHUNK
    positions = (offset + jnp.arange(SEQ, dtype=jnp.int32)[None, :]).astype(jnp.int32)
    w_in = nrm((L, D_MODEL, D_IN), D_MODEL ** -0.5)
    ssm_a_re = -0.5 + nrm((L, G, P), 0.01)
    ssm_a_im = math.pi * jnp.arange(P, dtype=f32)[None, None, :] + nrm((L, G, P), 0.01)
    ssm_log_dt = jax.random.uniform(next(ks), (L, G), f32, math.log(1e-3), math.log(1e-1))
    ssm_b_re = nrm((L, G, P, Hg), (2 * Hg) ** -0.5)
    ssm_b_im = nrm((L, G, P, Hg), (2 * Hg) ** -0.5)
    ssm_c_re = nrm((L, G, Hg, P), (2 * P) ** -0.5)
    ssm_c_im = nrm((L, G, Hg, P), (2 * P) ** -0.5)
    ssm_d = nrm((L, G, Hg), 0.5)
    ssm_w_glu = nrm((L, SSM_WIDTH, SSM_WIDTH), SSM_WIDTH ** -0.5)
    fox_b_f = nrm((L, FOX_HEADS), 0.1)
    mla_g_q = gain((L, MLA_Q_LORA))
    mla_w_uq = nrm((L, MLA_Q_LORA, MLA_HEADS * (MLA_NOPE_DIM + MLA_ROPE_DIM)), MLA_Q_LORA ** -0.5)
    mla_g_kv = gain((L, MLA_KV_LORA))
    mla_w_ukv = nrm((L, MLA_KV_LORA, MLA_HEADS * (MLA_NOPE_DIM + MLA_V_DIM)), MLA_KV_LORA ** -0.5)
    chk_rel_bias = nrm((L, CHK_HEADS, 2 * REL_CLIP + 1), 0.2)
    w_branch = nrm((L, N_BRANCHES, BRANCH_WIDTH, D_MODEL), BRANCH_WIDTH ** -0.5)
    w_gate = nrm((L, N_BRANCHES, D_MODEL, D_MODEL), D_MODEL ** -0.5)
    b_gate = nrm((L, N_BRANCHES, D_MODEL), 0.01)
    w_o = nrm((L, D_MODEL, D_MODEL), D_MODEL ** -0.5)
    g_mix = gain((L, D_MODEL))
    g_ffn = gain((L, D_MODEL))
    ffn_w1 = nrm((N_DENSE, D_MODEL, D_FF), D_MODEL ** -0.5)
    ffn_w3 = nrm((N_DENSE, D_MODEL, D_FF), D_MODEL ** -0.5)
    ffn_w2 = nrm((N_DENSE, D_FF, D_MODEL), D_FF ** -0.5)
    moe_w_router = nrm((N_MOE, D_MODEL, N_EXPERTS), D_MODEL ** -0.5)
    moe_b_router = nrm((N_MOE, N_EXPERTS), 0.01)
    moe_w1 = nrm((N_MOE, N_EXPERTS, D_MODEL, D_FF_EXPERT), D_MODEL ** -0.5)
    moe_w3 = nrm((N_MOE, N_EXPERTS, D_MODEL, D_FF_EXPERT), D_MODEL ** -0.5)
    moe_w2 = nrm((N_MOE, N_EXPERTS, D_FF_EXPERT, D_MODEL), D_FF_EXPERT ** -0.5)
    g_ple = gain((L, D_MODEL))
    ple_w_gate = nrm((L, D_MODEL, D_MODEL), D_MODEL ** -0.5)
    ple_w_up = nrm((L, PLE_DIM, D_MODEL), PLE_DIM ** -0.5)
    g_final = gain((D_MODEL,))
    return {"x": x, "p": p, "positions": positions, "w_in": w_in,
            "ssm_a_re": ssm_a_re, "ssm_a_im": ssm_a_im, "ssm_log_dt": ssm_log_dt,
            "ssm_b_re": ssm_b_re, "ssm_b_im": ssm_b_im, "ssm_c_re": ssm_c_re, "ssm_c_im": ssm_c_im,
            "ssm_d": ssm_d, "ssm_w_glu": ssm_w_glu, "fox_b_f": fox_b_f,
            "mla_g_q": mla_g_q, "mla_w_uq": mla_w_uq, "mla_g_kv": mla_g_kv, "mla_w_ukv": mla_w_ukv,
            "chk_rel_bias": chk_rel_bias, "w_branch": w_branch, "w_gate": w_gate, "b_gate": b_gate,
            "w_o": w_o, "g_mix": g_mix, "g_ffn": g_ffn,
            "ffn_w1": ffn_w1, "ffn_w3": ffn_w3, "ffn_w2": ffn_w2,
            "moe_w_router": moe_w_router, "moe_b_router": moe_b_router,
            "moe_w1": moe_w1, "moe_w3": moe_w3, "moe_w2": moe_w2,
            "g_ple": g_ple, "ple_w_gate": ple_w_gate, "ple_w_up": ple_w_up, "g_final": g_final}


def reference(x, p, positions, w_in, ssm_a_re, ssm_a_im, ssm_log_dt, ssm_b_re, ssm_b_im, ssm_c_re,
              ssm_c_im, ssm_d, ssm_w_glu, fox_b_f, mla_g_q, mla_w_uq, mla_g_kv, mla_w_ukv,
              chk_rel_bias, w_branch, w_gate, b_gate, w_o, g_mix, g_ffn, ffn_w1, ffn_w3, ffn_w2,
              moe_w_router, moe_b_router, moe_w1, moe_w3, moe_w2, g_ple, ple_w_gate, ple_w_up, g_final):
    cos, sin = rope_tables(positions)
    for i in range(DEPTH):
        h = rms_norm(x, g_mix[i])
        x = x + hybrid_mixer(h, cos, sin, w_in[i], ssm_a_re[i], ssm_a_im[i], ssm_log_dt[i], ssm_b_re[i],
                             ssm_b_im[i], ssm_c_re[i], ssm_c_im[i], ssm_d[i], ssm_w_glu[i], fox_b_f[i],
                             mla_g_q[i], mla_w_uq[i], mla_g_kv[i], mla_w_ukv[i], chk_rel_bias[i],
                             w_branch[i], w_gate[i], b_gate[i], w_o[i])
        h = rms_norm(x, g_ffn[i])
        if i % 2 == 0:
            x = x + swiglu(h, ffn_w1[i // 2], ffn_w3[i // 2], ffn_w2[i // 2])
        else:
            j = i // 2
            x = x + moe_swiglu(h, moe_w_router[j], moe_b_router[j], moe_w1[j], moe_w3[j], moe_w2[j])
        ple_gate = jax.nn.sigmoid(rms_norm(x, g_ple[i]) @ ple_w_gate[i])
        x = x + (p[i] @ ple_w_up[i]) * ple_gate
    return rms_norm(x, g_final)
```

```cpp
#define N_LAUNCH_MODE 0
#include <hip/hip_runtime.h>
#include <cstdio>
#include <cstdint>

#define GAS __attribute__((address_space(1)))
#define LAS __attribute__((address_space(3)))
typedef unsigned short bf16;
typedef short bf16x8 __attribute__((ext_vector_type(8)));
typedef short s16x4 __attribute__((ext_vector_type(4)));
typedef float f32x2 __attribute__((ext_vector_type(2)));
typedef float f32x4 __attribute__((ext_vector_type(4)));
typedef float f32x16 __attribute__((ext_vector_type(16)));
typedef unsigned u32x2 __attribute__((ext_vector_type(2)));
typedef unsigned u32x4 __attribute__((ext_vector_type(4)));
typedef __bf16 bf16x2_t __attribute__((ext_vector_type(2)));

constexpr int NB = 4, SEQ = 8192, NTOK = NB * SEQ, D = 1024;
constexpr int ZP = 2304;
constexpr int ZC_U = 0, ZC_FQ = 256, ZC_FK = 512, ZC_FV = 768, ZC_DQ = 1024, ZC_DK = 1280, ZC_DV = 1536, ZC_CQ = 1792, ZC_CKV = 2048, ZC_KPE = 2176;
constexpr int DIN = 2148, DFF = 2816, DFFE = 1408, NE = 8;
constexpr int MOE_ROWS = 2 * NTOK + NE * 256;
constexpr float RMS_EPS = 1e-6f;
constexpr int NWAVES = 8, NTHREADS = 512;

constexpr size_t MiB = 1u << 20;
constexpr size_t WS_CTL = 0, CTL_ZERO_BYTES = 1 * MiB;
constexpr size_t WS_COS = 1 * MiB, WS_SIN = 3 * MiB;
constexpr size_t WS_LOGF = 5 * MiB;
constexpr size_t WS_CDEC = 5 * MiB + 512 * 1024;
constexpr size_t WS_WSUM = 6 * MiB;
constexpr size_t WS_RSTDQ = 6 * MiB + 256 * 1024, WS_RSTDKV = 6 * MiB + 512 * 1024;
constexpr size_t WS_SC = 7 * MiB;
constexpr size_t WS_TOKINFO = 11 * MiB;
constexpr size_t WS_SLOTTOK = 12 * MiB, WS_SLOTGATE = 12 * MiB + 512 * 1024;
constexpr size_t WS_PBF = 17 * MiB;
constexpr size_t WS_WMIX = 49 * MiB, WMIX_STRIDE = 20 * MiB;
constexpr size_t WM_IN = 0, WM_G = 4 * MiB + 512 * 1024, WM_B = 12 * MiB + 512 * 1024, WM_O = 14 * MiB + 512 * 1024, WM_PG = 16 * MiB + 512 * 1024,
                 WM_UP = 18 * MiB + 512 * 1024, WM_UQ = 19 * MiB, WM_UKV = 19 * MiB + 256 * 1024, WM_GLU = 19 * MiB + 384 * 1024;
constexpr size_t WS_W13 = 89 * MiB, WS_W2 = 100 * MiB;
constexpr size_t WS_H = 106 * MiB;
constexpr size_t WS_MLAQ = 170 * MiB, WS_MLAKV = 202 * MiB, WS_KPER = 234 * MiB;
constexpr size_t WS_M = 170 * MiB;
constexpr size_t WS_ZIN = 236 * MiB;
constexpr size_t WS_G = 380 * MiB;
constexpr size_t WS_HMID = 236 * MiB;
constexpr size_t WS_U = 236 * MiB;
constexpr size_t WS_WM13 = 418 * MiB, WS_WM2 = 462 * MiB;
constexpr size_t WS_END = 484 * MiB;
constexpr int CW_BAR = 4096;
constexpr int CW_MOECNT = 16384;

#define LDS_WAIT() asm volatile("s_waitcnt lgkmcnt(0)" ::: "memory")
#define VM_WAIT() asm volatile("s_waitcnt vmcnt(0)" ::: "memory")
__device__ __forceinline__ unsigned f2bf(float f) { unsigned u = __builtin_bit_cast(unsigned, f); return (u + 0x7fffu + ((u >> 16) & 1u)) >> 16; }
__device__ __forceinline__ unsigned pk2(float lo, float hi) { f32x2 v = {lo, hi}; bf16x2_t b = __builtin_convertvector(v, bf16x2_t); return __builtin_bit_cast(unsigned, b); }
__device__ __forceinline__ float bf2f(unsigned short b) { return __uint_as_float((unsigned)b << 16); }
__device__ __forceinline__ float bflo(unsigned w) { return __uint_as_float(w << 16); }
__device__ __forceinline__ float bfhi(unsigned w) { return __uint_as_float(w & 0xffff0000u); }
__device__ __forceinline__ float wave_sum(float v) {
#pragma unroll
    for (int o = 1; o < 64; o <<= 1) v += __shfl_xor(v, o);
    return v;
}
__device__ __forceinline__ float sigmoidf_(float x) { return 1.0f / (1.0f + __expf(-x)); }

#define BODY_IDS() int tid = threadIdx.x; asm volatile("" : "+v"(tid)); const int lane = tid & 63; const int wave = __builtin_amdgcn_readfirstlane(tid >> 6); \
    int grid_ = gridDim.x; asm volatile("" : "+s"(grid_)); \
    const int gw = blockIdx.x * NWAVES + wave, ngw = grid_ * NWAVES, gtid = blockIdx.x * NTHREADS + tid, gthreads = grid_ * NTHREADS; (void)lane; (void)wave; (void)gw; (void)ngw; (void)gtid; (void)gthreads
#define XB_TMO      128
#define XB_XCNT(j)  (256  + 64 * (j))
#define XB_XSUB(j)  (1280 + 64 * (j))
#define XB_XGEN(j)  (2304 + 64 * (j))
#define XB_TOP      3328
#define XB_TOPGEN   3392
#define XCD_BAR_WORDS 3456
#define XB_SPIN_CAP (1u << 22)

__device__ __forceinline__ unsigned xb_ld(unsigned* p)              { return __hip_atomic_load(p, __ATOMIC_RELAXED, __HIP_MEMORY_SCOPE_AGENT); }
__device__ __forceinline__ unsigned xb_add(unsigned* p, unsigned v) { return __hip_atomic_fetch_add(p, v, __ATOMIC_RELAXED, __HIP_MEMORY_SCOPE_AGENT); }
__device__ __forceinline__ unsigned xb_xcc_id() { return (unsigned)__builtin_amdgcn_s_getreg((3 << 11) | 20) & 0xFu; }
#define XB_SPIN(cond, bar) do { unsigned _sp = 0; while (cond) { __builtin_amdgcn_s_sleep(1); \
    if ((++_sp & 255u) == 0u) { if (xb_ld(&(bar)[XB_TMO])) break; if (_sp > XB_SPIN_CAP) { atomicAdd(&(bar)[XB_TMO], 1u); break; } } } } while (0)

struct XcdBarrier { unsigned* bar; unsigned x; volatile LAS unsigned* st; };

__device__ __forceinline__ XcdBarrier xcd_barrier_post(unsigned* bar, volatile LAS unsigned* st) {
    XcdBarrier b; b.bar = bar; b.x = xb_xcc_id(); b.st = st;
    if (threadIdx.x == 0) (void)xb_add(&bar[XB_XCNT(b.x)], 1u);
    return b;
}
__device__ __forceinline__ void xcd_barrier_complete(unsigned* bar, unsigned x, unsigned& nloc, unsigned& nx) {
    const unsigned G = gridDim.x * gridDim.y * gridDim.z;
    unsigned sum, cnt, mine, sp = 0u;
    for (;;) {
        sum = 0u; cnt = 0u; mine = 0u;
#pragma unroll
        for (unsigned j = 0; j < 16; ++j) { const unsigned c = xb_ld(&bar[XB_XCNT(j)]); sum += c; cnt += (c > 0u) ? 1u : 0u; mine = (j == x) ? c : mine; }
        if (sum == G) break;
        __builtin_amdgcn_s_sleep(1);
        if ((++sp & 255u) == 0u) { if (xb_ld(&bar[XB_TMO])) break; if (sp > XB_SPIN_CAP) { atomicAdd(&bar[XB_TMO], 1u); break; } }
    }
    nloc = mine > 0u ? mine : 1u; nx = cnt > 0u ? cnt : 1u;
}
__device__ __forceinline__ void xcd_barrier(const XcdBarrier& b) {
    asm volatile("s_waitcnt vmcnt(0)" ::: "memory");
    __syncthreads();
    if (threadIdx.x == 0) {
        unsigned* bar = b.bar;
        __builtin_amdgcn_s_waitcnt(0);
        unsigned nloc = b.st[0], nx = b.st[1];
        if (nloc == 0u) { xcd_barrier_complete(bar, b.x, nloc, nx); b.st[0] = nloc; b.st[1] = nx; }
        const unsigned old = xb_add(&bar[XB_XSUB(b.x)], 1u);
        const unsigned gen = old / nloc;
        if (old + 1u == (gen + 1u) * nloc) {
            __builtin_amdgcn_fence(__ATOMIC_RELEASE, "agent");
            asm volatile("s_waitcnt vmcnt(0)" ::: "memory");
            const unsigned og = xb_add(&bar[XB_TOP], 1u);
            const unsigned tg = og / nx;
            if (og + 1u == (tg + 1u) * nx) xb_add(&bar[XB_TOPGEN], 1u);
            else XB_SPIN(xb_ld(&bar[XB_TOPGEN]) == tg, bar);
            __builtin_amdgcn_fence(__ATOMIC_ACQUIRE, "agent");
            xb_add(&bar[XB_XGEN(b.x)], 1u);
            asm volatile("s_waitcnt vmcnt(0)" ::: "memory");
        } else {
            XB_SPIN(xb_ld(&bar[XB_XGEN(b.x)]) == gen, bar);
            __builtin_amdgcn_fence(__ATOMIC_ACQUIRE, "agent");
            asm volatile("s_waitcnt vmcnt(0)" ::: "memory");
        }
    }
    __syncthreads();
}
namespace pg8 {
constexpr int BM = 256, BK = 64, HALF = 128, HTB = HALF * BK * 2, STAGE_BYTES = 8 * HTB, NXCD = 8, WGM = 8;
__host__ __device__ __forceinline__ int lds_byte(int r, int c) { const int st = (r >> 4) * 2 + (c >> 5), rr = r & 15, cc = c & 31, ob = rr * 64 + cc * 2; return st * 1024 + (ob ^ (((ob >> 9) & 1) << 5)); }
__host__ __device__ __forceinline__ void stage_rc(int b, int& R, int& C) { const int st = b / 1024, sb = b % 1024, swz = sb ^ (((sb >> 9) & 1) << 5); R = (st >> 1) * 16 + swz / 64; C = (st & 1) * 32 + (swz % 64) / 2; }
__host__ __device__ __forceinline__ int perm32(int rho) { const int n = rho >> 4, i = rho & 15; return 8 * (i >> 2) + 4 * n + (i & 3); }

struct Unit { int pm, pn; };
struct Gemm { const bf16* A; const bf16* Bt; int lda, ldb, K; const int* gidx; };

struct StaticOrder {
    int nM, nN, nwg, G, c;
    __host__ __device__ void init(int M, int N, int G_, int c_) { nM = M / BM; nN = N / BM; nwg = nM * nN; G = G_; c = c_; }
    __host__ __device__ bool next(int i, Unit& u) const {
        const long L = (long)i * G + c; if (L >= nwg) return false;
        int wgid = (int)L; { const int q = nwg / NXCD, r = nwg % NXCD, xcd = wgid % NXCD, off = wgid / NXCD; wgid = (xcd < r ? xcd * (q + 1) : r * (q + 1) + (xcd - r) * q) + off; }
        const int nig = WGM * nN, gid = wgid / nig, fm = gid * WGM, gsz = (nM - fm) < WGM ? (nM - fm) : WGM;
        u.pm = fm + ((wgid % nig) % gsz); u.pn = (wgid % nig) / gsz; return true;
    }
};

template <class Epi, class Sched, bool ALIGN_EPI, bool GATHER>
__device__ __forceinline__ void gemm_phase(LAS unsigned char* lds, const Gemm g, const Sched& S, const Epi& E) {
    int tid = threadIdx.x; asm volatile("" : "+v"(tid));
    const int wid = __builtin_amdgcn_readfirstlane(tid >> 6), lane = tid & 63, wr = wid >> 2, wc = wid & 3, fr = lane & 15, fq = lane >> 4;
    int Kq = g.K; asm volatile("" : "+s"(Kq));
    const int K = Kq, nt = K / BK;
    int RA[2], CA[2];
    unsigned voffA[2], voffB[2];
#pragma unroll
    for (int i = 0; i < 2; ++i) { int R, C; stage_rc(tid * 16 + i * 8192, R, C); const int Rb = Epi::PERM ? ((R & ~31) + perm32(R & 31)) : R;
        RA[i] = R; CA[i] = C; voffA[i] = (unsigned)(R * g.lda + C) * 2u; voffB[i] = (unsigned)(Rb * g.ldb + C) * 2u; }
    const size_t kstep = (size_t)(BK * 2);
    const size_t hstepB = (size_t)HALF * g.ldb * 2, tstepB = 2 * hstepB;
    const size_t hstepA = (size_t)HALF * g.lda * 2, tstepA = 2 * hstepA;
    const unsigned ldsw = (unsigned)wid * 1024u;
    const int aoff = lds_byte(wr * 64 + fr, fq * 8), boff = lds_byte(wc * 32 + fr, fq * 8);
#define PG8_SA(b, h) (((b) * 2 + (h)) * HTB)
#define PG8_SB(b, h) ((4 + (b) * 2 + (h)) * HTB)
#define PG8_STAGEB(bufoff, gbase) do { _Pragma("unroll") for (int _i = 0; _i < 2; ++_i) \
        __builtin_amdgcn_global_load_lds((const unsigned*)((const char*)(gbase) + voffB[_i]), (LAS unsigned*)(lds + (bufoff) + ldsw + _i * 8192), 16, 0, 0); } while (0)
#define PG8_STAGEA(bufoff, kptr, isnext, h) do { _Pragma("unroll") for (int _i = 0; _i < 2; ++_i) { const char* _p; \
        if constexpr (GATHER) _p = (const char*)(kptr) + ((isnext) ? nvo[h][_i] : cvo[h][_i]); else _p = (const char*)(kptr) + (size_t)(h) * hstepA + voffA[_i]; \
        __builtin_amdgcn_global_load_lds((const unsigned*)_p, (LAS unsigned*)(lds + (bufoff) + ldsw + _i * 8192), 16, 0, 0); } } while (0)
#define PG8_LDA(dst, b, h) do { _Pragma("unroll") for (int m = 0; m < 4; ++m) _Pragma("unroll") for (int k = 0; k < 2; ++k) dst[m][k] = *(const LAS bf16x8*)(lds + PG8_SA(b, h) + aoff + m * 2048 + k * 1024); } while (0)
#define PG8_LDB(dst, b, h) do { _Pragma("unroll") for (int n = 0; n < 2; ++n) _Pragma("unroll") for (int k = 0; k < 2; ++k) dst[n][k] = *(const LAS bf16x8*)(lds + PG8_SB(b, h) + boff + n * 2048 + k * 1024); } while (0)
#define PG8_MMA(ai, bj, At, Bt) do { __builtin_amdgcn_s_setprio(1); _Pragma("unroll") for (int m = 0; m < 4; ++m) _Pragma("unroll") for (int n = 0; n < 2; ++n) _Pragma("unroll") for (int k = 0; k < 2; ++k) \
        acc[ai][bj][m][n] = __builtin_amdgcn_mfma_f32_16x16x32_bf16(Bt[n][k], At[m][k], acc[ai][bj][m][n], 0, 0, 0); __builtin_amdgcn_s_setprio(0); } while (0)
#define PG8_WAIT_V(n) asm volatile("s_waitcnt vmcnt(" #n ")" ::: "memory")
#define PG8_WAIT_L(n) asm volatile("s_waitcnt lgkmcnt(" #n ")" ::: "memory")
#define PG8_BAR __builtin_amdgcn_s_barrier()
#define PG8_SCHED __builtin_amdgcn_sched_barrier(0)
#define PG8_VOA(vo, u) do { _Pragma("unroll") for (int _h = 0; _h < 2; ++_h) _Pragma("unroll") for (int _i = 0; _i < 2; ++_i) { \
        int _row = (u).pm * BM + _h * HALF + RA[_i]; if (GATHER) { _row = g.gidx[_row]; _row = _row < 0 ? 0 : _row; } \
        (vo)[_h][_i] = (unsigned)_row * (unsigned)(g.lda * 2) + (unsigned)(CA[_i] * 2); } } while (0)
    Unit cur, nxt; int ui = 0;
    if (!S.next(0, cur)) return;
    f32x4 acc[2][2][4][2];
#pragma unroll
    for (int a = 0; a < 2; ++a)
#pragma unroll
        for (int b = 0; b < 2; ++b)
#pragma unroll
            for (int m = 0; m < 4; ++m)
#pragma unroll
                for (int n = 0; n < 2; ++n) acc[a][b][m][n] = (f32x4){0.f, 0.f, 0.f, 0.f};
    bf16x8 At[4][2], B0[2][2], B1[2][2];
    unsigned cvo[2][2], nvo[2][2];
    if constexpr (GATHER) { PG8_VOA(cvo, cur); PG8_VOA(nvo, cur); }
    const char* cA = (const char*)g.A + (GATHER ? (size_t)0 : (size_t)cur.pm * tstepA); const char* cB = (const char*)g.Bt + (size_t)cur.pn * tstepB;
    PG8_STAGEB(PG8_SB(0, 0), cB); PG8_STAGEB(PG8_SB(0, 1), cB + hstepB); PG8_STAGEA(PG8_SA(0, 0), cA, false, 0); PG8_STAGEA(PG8_SA(0, 1), cA, false, 1);
    if (wr == 1) PG8_BAR;
    PG8_WAIT_V(2); PG8_BAR;
    PG8_STAGEB(PG8_SB(1, 0), cB + kstep); PG8_STAGEA(PG8_SA(1, 0), cA + kstep, false, 0); PG8_STAGEB(PG8_SB(1, 1), cB + hstepB + kstep);
    PG8_WAIT_V(6); PG8_BAR;
    for (;;) {
        const bool has_next = S.next(ui + 1, nxt);
        if constexpr (GATHER) { if (has_next) { PG8_VOA(nvo, nxt); } }
        const char* nA = (GATHER || !has_next) ? cA : (const char*)g.A + (size_t)nxt.pm * tstepA;
        const char* nB = has_next ? (const char*)g.Bt + (size_t)nxt.pn * tstepB : cB;
#pragma nounroll
        for (int t = 0; t < nt; t += 2) {
            const bool last = (t == nt - 2);
            const char* a1 = cA + (size_t)(t + 1) * kstep;
            const char* a2 = last ? nA : cA + (size_t)(t + 2) * kstep; const char* b2 = last ? nB : cB + (size_t)(t + 2) * kstep;
            const char* a3 = a2 + kstep; const char* b3 = b2 + kstep;
            PG8_LDB(B0, 0, 0); PG8_LDB(B1, 0, 1); PG8_SCHED; PG8_LDA(At, 0, 0); PG8_STAGEA(PG8_SA(1, 1), a1, false, 1);
            PG8_WAIT_V(8); PG8_WAIT_L(0); PG8_BAR; PG8_MMA(0, 0, At, B0); PG8_MMA(0, 1, At, B1); PG8_BAR; PG8_SCHED;
            PG8_LDA(At, 0, 1); PG8_STAGEB(PG8_SB(0, 0), b2); PG8_STAGEB(PG8_SB(0, 1), b2 + hstepB); PG8_STAGEA(PG8_SA(0, 0), a2, last, 0);
            PG8_WAIT_V(8); PG8_WAIT_L(0); PG8_BAR; PG8_MMA(1, 0, At, B0); PG8_MMA(1, 1, At, B1); PG8_BAR; PG8_SCHED;
            PG8_LDB(B0, 1, 0); PG8_LDB(B1, 1, 1); PG8_SCHED; PG8_LDA(At, 1, 0); PG8_STAGEA(PG8_SA(0, 1), a2, last, 1);
            PG8_WAIT_V(8); PG8_WAIT_L(0); PG8_BAR; PG8_MMA(0, 0, At, B0); PG8_MMA(0, 1, At, B1); PG8_BAR; PG8_SCHED;
            PG8_LDA(At, 1, 1); PG8_STAGEB(PG8_SB(1, 0), b3); PG8_STAGEB(PG8_SB(1, 1), b3 + hstepB); PG8_STAGEA(PG8_SA(1, 0), a3, last, 0);
            PG8_WAIT_V(8); PG8_WAIT_L(0); PG8_BAR; PG8_MMA(1, 0, At, B0); PG8_MMA(1, 1, At, B1); PG8_BAR; PG8_SCHED;
        }
        if constexpr (ALIGN_EPI) { if (wr == 0) PG8_BAR; }
        E(acc, cur, wr, wc, fr, fq);
        if (!has_next) break;
#pragma unroll
        for (int a = 0; a < 2; ++a)
#pragma unroll
            for (int b = 0; b < 2; ++b)
#pragma unroll
                for (int m = 0; m < 4; ++m)
#pragma unroll
                    for (int n = 0; n < 2; ++n) acc[a][b][m][n] = (f32x4){0.f, 0.f, 0.f, 0.f};
        cur = nxt; cA = nA; cB = nB; ++ui;
        if constexpr (GATHER) {
#pragma unroll
            for (int _h = 0; _h < 2; ++_h)
#pragma unroll
                for (int _i = 0; _i < 2; ++_i) cvo[_h][_i] = nvo[_h][_i]; }
        if constexpr (ALIGN_EPI) { if (wr == 1) PG8_BAR; }
    }
    PG8_WAIT_V(0);
    if constexpr (!ALIGN_EPI) { if (wr == 0) PG8_BAR; }
    PG8_BAR;
#undef PG8_SA
#undef PG8_SB
#undef PG8_STAGEA
#undef PG8_STAGEB
#undef PG8_LDA
#undef PG8_LDB
#undef PG8_MMA
#undef PG8_WAIT_V
#undef PG8_WAIT_L
#undef PG8_BAR
#undef PG8_SCHED
#undef PG8_VOA
}

template <class Epi, class Sched, bool GATHER>
__device__ __forceinline__ void gemm_phase_naive(const Gemm g, const Sched& S, const Epi& E) {
    const int tid = threadIdx.x, wid = tid >> 6, lane = tid & 63, wr = wid >> 2, wc = wid & 3, fr = lane & 15, fq = lane >> 4;
    Unit u;
    for (int ui = 0; S.next(ui, u); ++ui) {
        f32x4 acc[2][2][4][2];
#pragma unroll
        for (int a = 0; a < 2; ++a)
#pragma unroll
            for (int b = 0; b < 2; ++b)
#pragma unroll
                for (int m = 0; m < 4; ++m)
#pragma unroll
                    for (int n = 0; n < 2; ++n) acc[a][b][m][n] = (f32x4){0.f, 0.f, 0.f, 0.f};
        const bf16* arow[2][4];
#pragma unroll
        for (int ai = 0; ai < 2; ++ai)
#pragma unroll
            for (int m = 0; m < 4; ++m) { int r = u.pm * BM + ai * HALF + wr * 64 + m * 16 + fr; if (GATHER) { r = g.gidx[r]; r = r < 0 ? 0 : r; } arow[ai][m] = g.A + (size_t)r * g.lda; }
        for (int k = 0; k < g.K; k += 4) {
            float av[2][4][4];
#pragma unroll
            for (int ai = 0; ai < 2; ++ai)
#pragma unroll
                for (int m = 0; m < 4; ++m) { const u32x2 w = *(const u32x2*)(arow[ai][m] + k); av[ai][m][0] = bflo(w.x); av[ai][m][1] = bfhi(w.x); av[ai][m][2] = bflo(w.y); av[ai][m][3] = bfhi(w.y); }
#pragma unroll
            for (int bj = 0; bj < 2; ++bj)
#pragma unroll
                for (int n = 0; n < 2; ++n)
#pragma unroll
                    for (int e = 0; e < 4; ++e) {
                        const int col = u.pn * BM + bj * HALF + wc * 32 + (Epi::PERM ? (8 * fq + 4 * n) : (16 * n + 4 * fq)) + e;
                        const u32x2 w = *(const u32x2*)(g.Bt + (size_t)col * g.ldb + k);
                        const float b0 = bflo(w.x), b1 = bfhi(w.x), b2 = bflo(w.y), b3 = bfhi(w.y);
#pragma unroll
                        for (int ai = 0; ai < 2; ++ai)
#pragma unroll
                            for (int m = 0; m < 4; ++m) acc[ai][bj][m][n][e] += av[ai][m][0] * b0 + av[ai][m][1] * b1 + av[ai][m][2] * b2 + av[ai][m][3] * b3;
                    }
        }
        E(acc, u, wr, wc, fr, fq);
    }
    VM_WAIT(); __syncthreads();
}
}
namespace epi {
using pg8::Unit; using pg8::BM; using pg8::HALF;
__device__ __forceinline__ void epi_fence() { asm volatile("" ::: "memory"); }
#define EPI_FENCE epi_fence()
#define EPI_LOOP_ROWS for (int ai = 0; ai < 2; ++ai) _Pragma("unroll") for (int m = 0; m < 4; ++m, EPI_FENCE)
#define EPI_LOOP_COLS for (int bj = 0; bj < 2; ++bj) _Pragma("unroll") for (int n = 0; n < 2; ++n)
#define EPI_ROW (u.pm * BM + ai * HALF + wr * 64 + m * 16 + fr)
#define EPI_COLT (bj * HALF + wc * 32 + n * 16 + 4 * fq)
typedef f32x4 acc_t[2][2][4][2];
__device__ __forceinline__ u32x2 pack4(f32x4 v) { u32x2 w; w.x = pk2(v[0], v[1]); w.y = pk2(v[2], v[3]); return w; }
__device__ __forceinline__ f32x4 unpack4(u32x2 w) { return (f32x4){bflo(w.x), bfhi(w.x), bflo(w.y), bfhi(w.y)}; }

struct EpiStore {
    static constexpr bool PERM = false;
    bf16* O; int ldc; int pn0;
    __device__ __forceinline__ void operator()(const acc_t& acc, const Unit& u, int wr, int wc, int fr, int fq) const {
#pragma unroll
        EPI_LOOP_ROWS { bf16* rp = O + (size_t)EPI_ROW * ldc + (u.pn - pn0) * BM;
#pragma unroll
            EPI_LOOP_COLS { *(u32x2*)(rp + EPI_COLT) = pack4(acc[ai][bj][m][n]); } }
    }
};
struct EpiRowScale {
    static constexpr bool PERM = false;
    bf16* O; int ldc; const float* rs;
    __device__ __forceinline__ void operator()(const acc_t& acc, const Unit& u, int wr, int wc, int fr, int fq) const {
#pragma unroll
        EPI_LOOP_ROWS { const int row = EPI_ROW; const float s = rs[row]; bf16* rp = O + (size_t)row * ldc + u.pn * BM;
#pragma unroll
            EPI_LOOP_COLS { *(u32x2*)(rp + EPI_COLT) = pack4(acc[ai][bj][m][n] * s); } }
    }
};
struct EpiMlaQ {
    static constexpr bool PERM = false;
    bf16* O; const float* rs; const float* cosT; const float* sinT;
    __device__ __forceinline__ void operator()(const acc_t& acc, const Unit& u, int wr, int wc, int fr, int fq) const {
#pragma unroll
        EPI_LOOP_ROWS { const int row = EPI_ROW; const float s = rs[row]; bf16* rp = O + (size_t)row * 512 + u.pn * BM;
            const f32x4 cs = *(const f32x4*)(cosT + (size_t)row * 16 + 4 * fq), sn = *(const f32x4*)(sinT + (size_t)row * 16 + 4 * fq);
#pragma unroll
            for (int bj = 0; bj < 2; ++bj) { const int grp = u.pn * 8 + bj * 4 + wc;
                f32x4 t1 = acc[ai][bj][m][0] * s, t2 = acc[ai][bj][m][1] * s;
                if (grp % 3 == 2) { const f32x4 a = t1 * cs - t2 * sn, b = t2 * cs + t1 * sn; t1 = a; t2 = b; }
                *(u32x2*)(rp + bj * HALF + wc * 32 + 4 * fq) = pack4(t1); *(u32x2*)(rp + bj * HALF + wc * 32 + 16 + 4 * fq) = pack4(t2); } }
    }
};
struct EpiGate {
    static constexpr bool PERM = false;
    bf16* G; const float* bias;
    __device__ __forceinline__ void operator()(const acc_t& acc, const Unit& u, int wr, int wc, int fr, int fq) const {
        f32x4 bv[2][2];
#pragma unroll
        EPI_LOOP_COLS bv[bj][n] = *(const f32x4*)(bias + u.pn * BM + EPI_COLT);
#pragma unroll
        EPI_LOOP_ROWS { bf16* rp = G + (size_t)EPI_ROW * D + u.pn * BM;
#pragma unroll
            EPI_LOOP_COLS { f32x4 v = acc[ai][bj][m][n] + bv[bj][n];
                v[0] = sigmoidf_(v[0]); v[1] = sigmoidf_(v[1]); v[2] = sigmoidf_(v[2]); v[3] = sigmoidf_(v[3]);
                *(u32x2*)(rp + EPI_COLT) = pack4(v); } }
    }
};
struct EpiMerge {
    static constexpr bool PERM = false;
    const bf16* G; bf16* M; int first;
    __device__ __forceinline__ void operator()(const acc_t& acc, const Unit& u, int wr, int wc, int fr, int fq) const {
#pragma unroll
        EPI_LOOP_ROWS { const size_t ro = (size_t)EPI_ROW * D + u.pn * BM;
#pragma unroll
            EPI_LOOP_COLS { const f32x4 g = unpack4(*(const u32x2*)(G + ro + EPI_COLT)); f32x4 v = g * acc[ai][bj][m][n];
                if (!first) v += unpack4(*(const u32x2*)(M + ro + EPI_COLT));
                *(u32x2*)(M + ro + EPI_COLT) = pack4(v); } }
    }
};
struct EpiRes {
    static constexpr bool PERM = false;
    const float* xin; float* xout;
    __device__ __forceinline__ void operator()(const acc_t& acc, const Unit& u, int wr, int wc, int fr, int fq) const {
#pragma unroll
        EPI_LOOP_ROWS { const size_t ro = (size_t)EPI_ROW * D + u.pn * BM;
#pragma unroll
            EPI_LOOP_COLS { *(f32x4*)(xout + ro + EPI_COLT) = *(const f32x4*)(xin + ro + EPI_COLT) + acc[ai][bj][m][n]; } }
    }
};
struct EpiPle {
    static constexpr bool PERM = false;
    const bf16* U; float* x;
    __device__ __forceinline__ void operator()(const acc_t& acc, const Unit& u, int wr, int wc, int fr, int fq) const {
#pragma unroll
        EPI_LOOP_ROWS { const size_t ro = (size_t)EPI_ROW * D + u.pn * BM;
#pragma unroll
            EPI_LOOP_COLS { const f32x4 uu = unpack4(*(const u32x2*)(U + ro + EPI_COLT)); f32x4 v = acc[ai][bj][m][n];
                v[0] = sigmoidf_(v[0]); v[1] = sigmoidf_(v[1]); v[2] = sigmoidf_(v[2]); v[3] = sigmoidf_(v[3]);
                *(f32x4*)(x + ro + EPI_COLT) = *(const f32x4*)(x + ro + EPI_COLT) + uu * v; } }
    }
};
struct EpiSwiglu {
    static constexpr bool PERM = false;
    bf16* O; int ldc; int npt;
    __device__ __forceinline__ void operator()(const acc_t& acc, const Unit& u, int wr, int wc, int fr, int fq) const {
        const int ct = (u.pn % npt) * HALF;
#pragma unroll
        EPI_LOOP_ROWS { bf16* rp = O + (size_t)EPI_ROW * ldc + ct + wc * 32 + 4 * fq;
#pragma unroll
            for (int n = 0; n < 2; ++n) { const f32x4 a = acc[ai][0][m][n], b = acc[ai][1][m][n]; f32x4 v;
#pragma unroll
                for (int e = 0; e < 4; ++e) v[e] = a[e] * sigmoidf_(a[e]) * b[e];
                *(u32x2*)(rp + n * 16) = pack4(v); } }
    }
};
struct EpiGlu {
    static constexpr bool PERM = false;
    bf16* Y; int ldc;
    __device__ __forceinline__ void operator()(const acc_t& acc, const Unit& u, int wr, int wc, int fr, int fq) const {
#pragma unroll
        EPI_LOOP_ROWS { bf16* rp = Y + (size_t)EPI_ROW * ldc + u.pn * BM;
#pragma unroll
            EPI_LOOP_COLS { const f32x4 y = unpack4(*(const u32x2*)(rp + EPI_COLT)); f32x4 v = acc[ai][bj][m][n];
#pragma unroll
                for (int e = 0; e < 4; ++e) v[e] = y[e] * sigmoidf_(v[e]);
                *(u32x2*)(rp + EPI_COLT) = pack4(v); } }
    }
};
struct EpiMoeDown {
    static constexpr bool PERM = false;
    float* x; const int* slot_tok; const float* slot_gate;
    __device__ __forceinline__ void operator()(const acc_t& acc, const Unit& u, int wr, int wc, int fr, int fq) const {
        const int ct = (u.pn & 3) * BM;
#pragma unroll
        EPI_LOOP_ROWS { const int row = EPI_ROW; const int tok = slot_tok[row];
            if (tok >= 0) { const float gt = slot_gate[row]; float* rp = x + (size_t)tok * D + ct;
#pragma unroll
                EPI_LOOP_COLS { const f32x4 v = acc[ai][bj][m][n] * gt; float* p = rp + EPI_COLT;
#pragma unroll
                    for (int e = 0; e < 4; ++e) __hip_atomic_fetch_add(p + e, v[e], __ATOMIC_RELAXED, __HIP_MEMORY_SCOPE_AGENT); } } }
    }
};
}
namespace att {
constexpr int MODE_FOX = 0, MODE_MLA = 1, MODE_BAND = 2;
constexpr float LOG2E = 1.4426950408889634f;
struct Tensors {
    const bf16* Q; int ldq;
    const bf16* K; int ldk;
    const bf16* K2;
    const bf16* V; int ldv;
    bf16* O; int ldo;
    const float* cdec;
    const float* relb;
    int qhs, khs, vhs, ohs;
};
template <int DQK> struct Lay { static constexpr int KS = DQK * 2 + 16, KB = 64 * KS, VB = 64 * 128, CB = 256, BUF = KB + VB + CB; };
constexpr int ATT_LDS_TAB = 2 * Lay<96>::BUF;
constexpr int ATT_LDS_BYTES = ATT_LDS_TAB + 520 * 4;
__device__ __forceinline__ int crow(int r, int hi) { return (r & 3) + 8 * (r >> 2) + 4 * hi; }
typedef short v4i16_t __attribute__((ext_vector_type(4)));
__device__ __forceinline__ s16x4 vtr(const LAS unsigned char* p) { return __builtin_bit_cast(s16x4, __builtin_amdgcn_ds_read_tr16_b64_v4i16((LAS v4i16_t*)p)); }

template <int MODE>
__device__ __forceinline__ void attn_unit(const Tensors& T, int b, int h, int qb, LAS unsigned char* lds) {
    constexpr int DQK = (MODE == MODE_MLA) ? 96 : 64, NKS = DQK / 16;
    typedef Lay<DQK> LY;
    int tid = threadIdx.x; asm volatile("" : "+v"(tid));
    const int lane = tid & 63, r32 = lane & 31, hi = lane >> 5; const int wid = __builtin_amdgcn_readfirstlane(tid >> 6);
    const int rowb = b * SEQ, q0 = qb * 256;
    const float sc2 = ((MODE == MODE_MLA) ? 0.10206207261596575f : 0.125f) * LOG2E;
    const int cw = 4 * qb + (wid >> 1);
    const int t_lo = (MODE == MODE_BAND) ? ((4 * qb - 8) > 0 ? (4 * qb - 8) : 0) : 0, t_hi = 4 * qb + 4;
    const int qrow = rowb + q0 + wid * 32 + r32;
    bf16x8 qf[NKS];
    { const bf16* qp = T.Q + (size_t)qrow * T.ldq + h * T.qhs + hi * 8;
#pragma unroll
      for (int ks = 0; ks < NKS; ++ks) qf[ks] = *(const bf16x8*)(qp + ks * 16); }
    float cq = 0.f; if (MODE == MODE_FOX) cq = T.cdec[(size_t)qrow * 4 + h];
    LAS float* tab = (LAS float*)(lds + ATT_LDS_TAB);
    if (MODE == MODE_BAND) { for (int i = tid; i < 513; i += NTHREADS) tab[i] = T.relb[h * 513 + i] * LOG2E; }
    u32x4 kreg0 = {}, kreg1 = {}, vreg = {}; float creg = 0.f;
    const int srow = tid >> 3, sch = tid & 7;
#define ATT_KADDR(c_) (((c_) % 12 < 8) ? (const u32x4*)(T.K + (kr_ + (c_) / 12) * T.ldk + h * T.khs + ((c_) % 12) * 8) : (const u32x4*)(T.K2 + (kr_ + (c_) / 12) * 32 + ((c_) % 12 - 8) * 8))
#define ATT_LOAD_TILE(t_) do { const size_t kr_ = (size_t)(rowb + (t_) * 64); \
        if (MODE == MODE_MLA) { kreg0 = *ATT_KADDR(tid); if (tid < 256) kreg1 = *ATT_KADDR(tid + 512); } \
        else { kreg0 = *(const u32x4*)(T.K + (kr_ + srow) * T.ldk + h * T.khs + sch * 8); } \
        vreg = *(const u32x4*)(T.V + (kr_ + srow) * T.ldv + h * T.vhs + sch * 8); \
        if (MODE == MODE_FOX) { if (tid < 64) creg = T.cdec[(kr_ + tid) * 4 + h]; } } while (0)
#define ATT_STORE_TILE(buf_) do { LAS unsigned char* base_ = lds + (buf_) * LY::BUF; \
        if (MODE == MODE_MLA) { *(LAS u32x4*)(base_ + (tid / 12) * LY::KS + (tid % 12) * 16) = kreg0; \
            if (tid < 256) *(LAS u32x4*)(base_ + ((tid + 512) / 12) * LY::KS + ((tid + 512) % 12) * 16) = kreg1; } \
        else { *(LAS u32x4*)(base_ + srow * LY::KS + sch * 16) = kreg0; } \
        *(LAS u32x4*)(base_ + LY::KB + srow * 128 + ((sch * 16) ^ (((srow >> 1) & 1) << 6))) = vreg; \
        if (MODE == MODE_FOX) { if (tid < 64) *(LAS float*)(base_ + LY::KB + LY::VB + tid * 4) = creg; } } while (0)
    float mrun = -INFINITY, lrun = 0.f;
    f32x16 o0 = {}, o1 = {};
    const int G = lane >> 4, qi = (lane & 15) >> 2, pi = lane & 3;
    const int vb0 = (4 * hi + qi) * 128 + 64 * (0 ^ (qi >> 1)) + 32 * (G & 1) + 8 * pi;
    const int vb1 = (4 * hi + qi) * 128 + 64 * (1 ^ (qi >> 1)) + 32 * (G & 1) + 8 * pi;
    ATT_LOAD_TILE(t_lo); ATT_STORE_TILE(0); __syncthreads();
    for (int t = t_lo; t < t_hi; ++t) {
        const int buf = (t - t_lo) & 1;
        if (t + 1 < t_hi) ATT_LOAD_TILE(t + 1);
        const bool active = (MODE == MODE_BAND) ? (t <= cw && t >= cw - 8) : (t <= cw);
        if (active) {
            const LAS unsigned char* kb = lds + buf * LY::BUF;
            const LAS unsigned char* vbuf = kb + LY::KB;
            f32x16 p0 = {}, p1 = {};
#pragma unroll
            for (int ks = 0; ks < NKS; ++ks) {
                const bf16x8 a0 = *(const LAS bf16x8*)(kb + r32 * LY::KS + (ks * 16 + hi * 8) * 2);
                const bf16x8 a1 = *(const LAS bf16x8*)(kb + (32 + r32) * LY::KS + (ks * 16 + hi * 8) * 2);
                p0 = __builtin_amdgcn_mfma_f32_32x32x16_bf16(a0, qf[ks], p0, 0, 0, 0);
                p1 = __builtin_amdgcn_mfma_f32_32x32x16_bf16(a1, qf[ks], p1, 0, 0, 0);
            }
            if (MODE == MODE_FOX) {
                const LAS float* cb = (const LAS float*)(vbuf + LY::VB);
                const float cq2 = cq * LOG2E;
#pragma unroll
                for (int a = 0; a < 4; ++a) {
                    const f32x4 c0 = *(const LAS f32x4*)(cb + 8 * a + 4 * hi), c1 = *(const LAS f32x4*)(cb + 32 + 8 * a + 4 * hi);
#pragma unroll
                    for (int e = 0; e < 4; ++e) { p0[4 * a + e] = p0[4 * a + e] * sc2 + (cq2 - c0[e] * LOG2E); p1[4 * a + e] = p1[4 * a + e] * sc2 + (cq2 - c1[e] * LOG2E); }
                }
                if (t == cw) { const int ql = 32 * (wid & 1) + r32;
#pragma unroll
                    for (int r = 0; r < 16; ++r) { const int kv = crow(r, hi); if (kv > ql) p0[r] = -INFINITY; if (kv + 32 > ql) p1[r] = -INFINITY; } }
            } else if (MODE == MODE_BAND) {
                const int dq = (q0 + wid * 32 + r32) - t * 64;
#pragma unroll
                for (int r = 0; r < 16; ++r) { const int kv = crow(r, hi);
                    int i0 = dq - kv, i1 = dq - kv - 32; i0 = i0 < -256 ? -256 : (i0 > 256 ? 256 : i0); i1 = i1 < -256 ? -256 : (i1 > 256 ? 256 : i1);
                    p0[r] = p0[r] * sc2 + tab[i0 + 256]; p1[r] = p1[r] * sc2 + tab[i1 + 256]; }
            } else {
#pragma unroll
                for (int r = 0; r < 16; ++r) { p0[r] *= sc2; p1[r] *= sc2; }
            }
            float mx = fmaxf(p0[0], p1[0]);
#pragma unroll
            for (int r = 1; r < 16; ++r) mx = fmaxf(mx, fmaxf(p0[r], p1[r]));
            { auto rr = __builtin_amdgcn_permlane32_swap(__float_as_uint(mx), __float_as_uint(mx), false, false); mx = fmaxf(__uint_as_float(rr[0]), __uint_as_float(rr[1])); }
            const float mnew = fmaxf(mrun, mx);
            if (__any(mnew > mrun)) {
                const float alpha = __builtin_amdgcn_exp2f(mrun - mnew);
                lrun *= alpha;
#pragma unroll
                for (int r = 0; r < 16; ++r) { o0[r] *= alpha; o1[r] *= alpha; }
                mrun = mnew;
            }
            float rs = 0.f;
#pragma unroll
            for (int r = 0; r < 16; ++r) { p0[r] = __builtin_amdgcn_exp2f(p0[r] - mrun); p1[r] = __builtin_amdgcn_exp2f(p1[r] - mrun); rs += p0[r] + p1[r]; }
            lrun += rs;
#pragma unroll
            for (int s4 = 0; s4 < 4; ++s4) {
                u32x4 pw;
                if (s4 < 2) { const int o = 8 * (s4 & 1); pw.x = pk2(p0[o], p0[o + 1]); pw.y = pk2(p0[o + 2], p0[o + 3]); pw.z = pk2(p0[o + 4], p0[o + 5]); pw.w = pk2(p0[o + 6], p0[o + 7]); }
                else        { const int o = 8 * (s4 & 1); pw.x = pk2(p1[o], p1[o + 1]); pw.y = pk2(p1[o + 2], p1[o + 3]); pw.z = pk2(p1[o + 4], p1[o + 5]); pw.w = pk2(p1[o + 6], p1[o + 7]); }
                const bf16x8 pf = __builtin_bit_cast(bf16x8, pw);
                const s16x4 l0 = vtr(vbuf + vb0 + s4 * 2048), h0 = vtr(vbuf + vb0 + s4 * 2048 + 1024);
                const s16x4 l1 = vtr(vbuf + vb1 + s4 * 2048), h1 = vtr(vbuf + vb1 + s4 * 2048 + 1024);
                const bf16x8 vf0 = (bf16x8){l0[0], l0[1], l0[2], l0[3], h0[0], h0[1], h0[2], h0[3]};
                const bf16x8 vf1 = (bf16x8){l1[0], l1[1], l1[2], l1[3], h1[0], h1[1], h1[2], h1[3]};
                o0 = __builtin_amdgcn_mfma_f32_32x32x16_bf16(vf0, pf, o0, 0, 0, 0);
                o1 = __builtin_amdgcn_mfma_f32_32x32x16_bf16(vf1, pf, o1, 0, 0, 0);
            }
        }
        if (t + 1 < t_hi) ATT_STORE_TILE(buf ^ 1);
        __syncthreads();
    }
    { auto rr = __builtin_amdgcn_permlane32_swap(__float_as_uint(lrun), __float_as_uint(lrun), false, false); lrun = __uint_as_float(rr[0]) + __uint_as_float(rr[1]); }
    const float inv = 1.0f / lrun;
    bf16* op = T.O + (size_t)qrow * T.ldo + h * T.ohs;
#pragma unroll
    for (int a = 0; a < 4; ++a) {
        u32x2 w0, w1;
        w0.x = pk2(o0[4 * a] * inv, o0[4 * a + 1] * inv); w0.y = pk2(o0[4 * a + 2] * inv, o0[4 * a + 3] * inv);
        w1.x = pk2(o1[4 * a] * inv, o1[4 * a + 1] * inv); w1.y = pk2(o1[4 * a + 2] * inv, o1[4 * a + 3] * inv);
        *(u32x2*)(op + 8 * a + 4 * hi) = w0; *(u32x2*)(op + 32 + 8 * a + 4 * hi) = w1;
    }
}

template <int MODE>
__device__ __forceinline__ void attn_phase(const Tensors& T, LAS unsigned char* lds) {
    const int G = gridDim.x, bx = blockIdx.x, vcu = (G % 8 == 0) ? (bx % 8) * (G / 8) + bx / 8 : bx;
    for (int pr = vcu; pr < 256; pr += G) {
        const int bh = pr >> 4, s = pr & 15;
        attn_unit<MODE>(T, bh >> 2, bh & 3, s, lds);
        attn_unit<MODE>(T, bh >> 2, bh & 3, 31 - s, lds);
    }
}

template <int MODE>
__device__ __forceinline__ void attn_naive(const Tensors& T) {
    BODY_IDS();
    constexpr int DQK = (MODE == MODE_MLA) ? 96 : 64;
    const float sc = (MODE == MODE_MLA) ? 0.10206207261596575f : 0.125f;
    for (int idx = gtid; idx < NTOK * 4; idx += gthreads) {
        const int h = idx / NTOK, row = idx % NTOK, b = row / SEQ, tpos = row % SEQ, rowb = b * SEQ;
        float q[DQK], o[64];
#pragma unroll
        for (int d = 0; d < DQK; ++d) q[d] = bf2f(T.Q[(size_t)row * T.ldq + h * T.qhs + d]) * sc;
#pragma unroll
        for (int d = 0; d < 64; ++d) o[d] = 0.f;
        float m = -INFINITY, l = 0.f;
        const int ck = tpos / 64;
        const int k_lo = (MODE == MODE_BAND) ? ((ck - 8) > 0 ? (ck - 8) * 64 : 0) : 0;
        const int k_hi = (MODE == MODE_FOX) ? tpos : (ck * 64 + 63);
        const float cq = (MODE == MODE_FOX) ? T.cdec[(size_t)row * 4 + h] : 0.f;
        for (int kv = k_lo; kv <= k_hi; ++kv) {
            const size_t kr = (size_t)(rowb + kv);
            float s = 0.f;
#pragma unroll
            for (int d8 = 0; d8 < 8; ++d8) { const u32x4 w = *(const u32x4*)(T.K + kr * T.ldk + h * T.khs + d8 * 8);
                s += q[d8 * 8 + 0] * bflo(w.x) + q[d8 * 8 + 1] * bfhi(w.x) + q[d8 * 8 + 2] * bflo(w.y) + q[d8 * 8 + 3] * bfhi(w.y)
                   + q[d8 * 8 + 4] * bflo(w.z) + q[d8 * 8 + 5] * bfhi(w.z) + q[d8 * 8 + 6] * bflo(w.w) + q[d8 * 8 + 7] * bfhi(w.w); }
            if (MODE == MODE_MLA) {
#pragma unroll
                for (int d8 = 0; d8 < 4; ++d8) { const u32x4 w = *(const u32x4*)(T.K2 + kr * 32 + d8 * 8);
                    s += q[64 + d8 * 8 + 0] * bflo(w.x) + q[64 + d8 * 8 + 1] * bfhi(w.x) + q[64 + d8 * 8 + 2] * bflo(w.y) + q[64 + d8 * 8 + 3] * bfhi(w.y)
                       + q[64 + d8 * 8 + 4] * bflo(w.z) + q[64 + d8 * 8 + 5] * bfhi(w.z) + q[64 + d8 * 8 + 6] * bflo(w.w) + q[64 + d8 * 8 + 7] * bfhi(w.w); }
            }
            if (MODE == MODE_FOX) s += cq - T.cdec[kr * 4 + h];
            if (MODE == MODE_BAND) { int rel = tpos - kv; rel = rel < -256 ? -256 : (rel > 256 ? 256 : rel); s += T.relb[h * 513 + rel + 256]; }
            const float mn = fmaxf(m, s), al = __expf(m - mn), pp = __expf(s - mn);
            l = l * al + pp; m = mn;
#pragma unroll
            for (int d8 = 0; d8 < 8; ++d8) { const u32x4 w = *(const u32x4*)(T.V + kr * T.ldv + h * T.vhs + d8 * 8);
                o[d8 * 8 + 0] = o[d8 * 8 + 0] * al + pp * bflo(w.x); o[d8 * 8 + 1] = o[d8 * 8 + 1] * al + pp * bfhi(w.x);
                o[d8 * 8 + 2] = o[d8 * 8 + 2] * al + pp * bflo(w.y); o[d8 * 8 + 3] = o[d8 * 8 + 3] * al + pp * bfhi(w.y);
                o[d8 * 8 + 4] = o[d8 * 8 + 4] * al + pp * bflo(w.z); o[d8 * 8 + 5] = o[d8 * 8 + 5] * al + pp * bfhi(w.z);
                o[d8 * 8 + 6] = o[d8 * 8 + 6] * al + pp * bflo(w.w); o[d8 * 8 + 7] = o[d8 * 8 + 7] * al + pp * bfhi(w.w); }
        }
        const float inv = 1.0f / l;
#pragma unroll
        for (int d = 0; d < 64; d += 2) *(unsigned*)(T.O + (size_t)row * T.ldo + h * T.ohs + d) = pk2(o[d] * inv, o[d + 1] * inv);
    }
}
}
struct Params {
    const float* in[37];
    float* out;
    unsigned char* ws;
    int ph_lo, ph_hi;
};
enum { I_X = 0, I_P, I_POS, I_WIN, I_SAR, I_SAI, I_SLDT, I_SBR, I_SBI, I_SCR, I_SCI, I_SD, I_SGLU, I_FBF, I_GQ, I_WUQ, I_GKV, I_WUKV, I_RELB, I_WB, I_WG, I_BG, I_WO,
       I_GMIX, I_GFFN, I_FW1, I_FW3, I_FW2, I_MWR, I_MBR, I_MW1, I_MW3, I_MW2, I_GPLE, I_PWG, I_PWU, I_GFIN };

__device__ __forceinline__ void sincos_rad(double a, float& s, float& c) {
    double r = a * 0.15915494309189535; r = r - __builtin_rint(r); const float f = (float)r;
    s = __builtin_amdgcn_sinf(f); c = __builtin_amdgcn_cosf(f);
}
__device__ __forceinline__ float gelu_tanh(float x) {
    const float z = 0.7978845608028654f * (x + 0.044715f * x * x * x);
    const float e = __expf(2.0f * z); const float th = 1.0f - 2.0f / (1.0f + e);
    return 0.5f * x * (1.0f + th);
}
__device__ __forceinline__ float log_sigmoid(float z) { return fminf(z, 0.f) - log1pf(__expf(-fabsf(z))); }

struct CvtJob { const float* src; const float* ks; bf16* dst; int K, ldsrc, col0, ncols, row0, ldk, ilv; };
__device__ __forceinline__ void cvt_item(const CvtJob& J, LAS float* scr, int item, int lane) {
    const int nblk = J.ncols / 32, kb = item / nblk, nb = item % nblk, k0 = 64 * kb, n0 = 32 * nb;
#pragma unroll 8
    for (int i = 0; i < 32; ++i) { const int kk = 2 * i + (lane >> 5); float v = J.src[(size_t)(k0 + kk) * J.ldsrc + J.col0 + n0 + (lane & 31)]; if (J.ks) v *= J.ks[k0 + kk]; scr[kk * 33 + (lane & 31)] = v; }
    LDS_WAIT(); asm volatile("" ::: "memory");
    const int c = lane & 7;
#pragma unroll
    for (int j = 0; j < 4; ++j) { const int n = (lane >> 3) + 8 * j; const LAS float* s = scr + (8 * c) * 33 + n;
        u32x4 o; o.x = pk2(s[0 * 33], s[1 * 33]); o.y = pk2(s[2 * 33], s[3 * 33]); o.z = pk2(s[4 * 33], s[5 * 33]); o.w = pk2(s[6 * 33], s[7 * 33]);
        const int nn = n0 + n; const int row = J.row0 + (J.ilv ? ((nn >> 7) * 256 + (nn & 127)) : nn);
        *(u32x4*)(J.dst + (size_t)row * J.ldk + k0 + 8 * c) = o; }
    LDS_WAIT(); asm volatile("" ::: "memory");
}
__device__ __forceinline__ bf16* wmix(const Params& P, int L, size_t off) { return (bf16*)(P.ws + WS_WMIX + (size_t)L * WMIX_STRIDE + off); }
__device__ __forceinline__ CvtJob get_job(const Params& P, int j) {
    CvtJob J; J.ks = nullptr; J.ilv = 0; J.col0 = 0; J.row0 = 0;
    if (j < 40) {
        const int L = j / 20, q = j % 20;
        if (q < 5) {
            J.src = P.in[I_WIN] + (size_t)L * D * DIN; J.K = D; J.ldsrc = DIN; J.dst = wmix(P, L, WM_IN); J.ldk = D;
            J.col0 = q == 0 ? 0 : q == 1 ? 1380 : q == 2 ? 1028 : q == 3 ? 1220 : 1348;
            J.ncols = q == 0 ? 1024 : q == 1 ? 768 : q == 2 ? 192 : q == 3 ? 128 : 32;
            J.row0 = q == 0 ? 0 : q == 1 ? 1024 : q == 2 ? 1792 : q == 3 ? 2048 : 2176;
        } else if (q < 9) { const int k = q - 5; J.src = P.in[I_WG] + ((size_t)L * 4 + k) * D * D; J.K = D; J.ldsrc = D; J.ncols = D; J.row0 = k * D; J.dst = wmix(P, L, WM_G); J.ldk = D;
        } else if (q < 13) { const int k = q - 9; J.src = P.in[I_WB] + ((size_t)L * 4 + k) * 256 * D; J.K = 256; J.ldsrc = D; J.ncols = D; J.row0 = k * D; J.dst = wmix(P, L, WM_B); J.ldk = 256;
        } else if (q == 13) { J.src = P.in[I_WO] + (size_t)L * D * D; J.K = D; J.ldsrc = D; J.ncols = D; J.dst = wmix(P, L, WM_O); J.ldk = D;
        } else if (q == 14) { J.src = P.in[I_PWG] + (size_t)L * D * D; J.K = D; J.ldsrc = D; J.ncols = D; J.dst = wmix(P, L, WM_PG); J.ldk = D;
        } else if (q == 15) { J.src = P.in[I_PWU] + (size_t)L * 256 * D; J.K = 256; J.ldsrc = D; J.ncols = D; J.dst = wmix(P, L, WM_UP); J.ldk = 256;
        } else if (q == 16) { J.src = P.in[I_WUQ] + (size_t)L * 192 * 384; J.ks = P.in[I_GQ] + L * 192; J.K = 192; J.ldsrc = 384; J.ncols = 384; J.dst = wmix(P, L, WM_UQ); J.ldk = 256;
        } else if (q == 17) { J.src = P.in[I_WUKV] + (size_t)L * 128 * 512; J.ks = P.in[I_GKV] + L * 128; J.K = 128; J.ldsrc = 512; J.ncols = 512; J.dst = wmix(P, L, WM_UKV); J.ldk = 128;
        } else if (q == 18) { J.src = P.in[I_SGLU] + (size_t)L * 256 * 256; J.K = 256; J.ldsrc = 256; J.ncols = 256; J.dst = wmix(P, L, WM_GLU); J.ldk = 256;
        } else { J.src = nullptr; J.K = 0; J.ldsrc = 0; J.ncols = 32; J.dst = nullptr; J.ldk = 0; }
    } else if (j < 43) {
        const int q = j - 40;
        if (q == 0) { J.src = P.in[I_FW1]; J.K = D; J.ldsrc = DFF; J.ncols = DFF; J.dst = (bf16*)(P.ws + WS_W13); J.ldk = D; J.ilv = 1; }
        else if (q == 1) { J.src = P.in[I_FW3]; J.K = D; J.ldsrc = DFF; J.ncols = DFF; J.row0 = 128; J.dst = (bf16*)(P.ws + WS_W13); J.ldk = D; J.ilv = 1; }
        else { J.src = P.in[I_FW2]; J.K = DFF; J.ldsrc = D; J.ncols = D; J.dst = (bf16*)(P.ws + WS_W2); J.ldk = DFF; }
    } else {
        const int e = (j - 43) / 3, q = (j - 43) % 3;
        if (q == 0) { J.src = P.in[I_MW1] + (size_t)e * D * DFFE; J.K = D; J.ldsrc = DFFE; J.ncols = DFFE; J.row0 = e * 2816; J.dst = (bf16*)(P.ws + WS_WM13); J.ldk = D; J.ilv = 1; }
        else if (q == 1) { J.src = P.in[I_MW3] + (size_t)e * D * DFFE; J.K = D; J.ldsrc = DFFE; J.ncols = DFFE; J.row0 = e * 2816 + 128; J.dst = (bf16*)(P.ws + WS_WM13); J.ldk = D; J.ilv = 1; }
        else { J.src = P.in[I_MW2] + (size_t)e * DFFE * D; J.K = DFFE; J.ldsrc = D; J.ncols = D; J.row0 = e * D; J.dst = (bf16*)(P.ws + WS_WM2); J.ldk = DFFE; }
    }
    return J;
}
__device__ __forceinline__ void cvt_jobs(const Params& P, int j_lo, int j_hi, LAS unsigned char* lds) {
    BODY_IDS();
    LAS float* scr = (LAS float*)(lds + wave * 8704);
    int acc = 0;
    for (int j = j_lo; j < j_hi; ++j) {
        const CvtJob J = get_job(P, j);
        const int items = (J.K / 64) * (J.ncols / 32);
        int first = (gw - (acc % ngw) + ngw) % ngw;
        for (int it = first; it < items; it += ngw) cvt_item(J, scr, it, lane);
        acc += items;
    }
}

__device__ __forceinline__ void p0_misc(const Params& P) {
    BODY_IDS();
    { const f32x4* src = (const f32x4*)P.in[I_P]; u32x2* dst = (u32x2*)(P.ws + WS_PBF);
      for (int i = gtid; i < 2 * NTOK * 256 / 4; i += gthreads) { const f32x4 v = src[i]; u32x2 w; w.x = pk2(v[0], v[1]); w.y = pk2(v[2], v[3]); dst[i] = w; } }
    { const int* pos = (const int*)P.in[I_POS]; float* ct = (float*)(P.ws + WS_COS); float* st = (float*)(P.ws + WS_SIN);
      const double invf[16] = {1.0, 0.5623413251903491, 0.31622776601683794, 0.1778279410038923, 0.1, 0.05623413251903491, 0.03162277660168379, 0.01778279410038923,
                               0.01, 0.005623413251903491, 0.0031622776601683794, 0.0017782794100389228, 0.001, 0.0005623413251903491, 0.00031622776601683794, 0.00017782794100389227};
      for (int i = gtid; i < NTOK * 16; i += gthreads) { const int row = i >> 4, f = i & 15; double iv = invf[0];
#pragma unroll
          for (int q = 1; q < 16; ++q) iv = (f == q) ? invf[q] : iv;
          const float ang = (float)pos[row] * (float)iv; float s, c; sincos_rad((double)ang, s, c); ct[i] = c; st[i] = s; } }
    for (int L = 0; L < 2; ++L) {
        bf16* win = wmix(P, L, WM_IN);
        for (int i = gtid; i < (64 + 96) * D / 8; i += gthreads) { const int e = i * 8, r = e / D, k = e % D; const int row = r < 64 ? 1984 + r : 2208 + (r - 64); *(u32x4*)(win + (size_t)row * D + k) = (u32x4){0u, 0u, 0u, 0u}; }
        bf16* wuq = wmix(P, L, WM_UQ);
        for (int i = gtid; i < 512 * 256 / 8; i += gthreads) { const int e = i * 8, r = e / 256, k = e % 256; if (r >= 384 || k >= 192) *(u32x4*)(wuq + e) = (u32x4){0u, 0u, 0u, 0u}; }
    }
}

__device__ __forceinline__ void rms_row(const float* xrow, const float* gain, bf16* orow, int lane, f32x4 (&v)[4]) {
    const f32x4* xr = (const f32x4*)xrow + lane; float s = 0.f;
#pragma unroll
    for (int j = 0; j < 4; ++j) { v[j] = xr[64 * j]; s += (v[j][0] * v[j][0] + v[j][1] * v[j][1]) + (v[j][2] * v[j][2] + v[j][3] * v[j][3]); }
    const float rstd = 1.0f / sqrtf(wave_sum(s) * (1.0f / D) + RMS_EPS);
    const f32x4* gr = (const f32x4*)gain + lane;
    u32x2* o8 = (u32x2*)orow + lane;
#pragma unroll
    for (int j = 0; j < 4; ++j) { v[j] = v[j] * rstd * gr[64 * j]; u32x2 w; w.x = pk2(v[j][0], v[j][1]); w.y = pk2(v[j][2], v[j][3]); o8[64 * j] = w; }
}
__device__ __forceinline__ void norm_plain(const float* x, const float* gain, bf16* H) {
    BODY_IDS();
    for (int row = gw; row < NTOK; row += ngw) { f32x4 v[4]; rms_row(x + (size_t)row * D, gain, H + (size_t)row * D, lane, v); }
}
__device__ __forceinline__ void norm1_phase(const Params& P, int L, const float* x, LAS unsigned char* lds) {
    BODY_IDS();
    LAS f32x4* wff = (LAS f32x4*)lds;
    const float* win = P.in[I_WIN] + (size_t)L * D * DIN;
    for (int k = tid; k < D; k += NTHREADS) wff[k] = *(const f32x4*)(win + (size_t)k * DIN + 1024);
    __syncthreads();
    const float* gain = P.in[I_GMIX] + L * D; bf16* H = (bf16*)(P.ws + WS_H);
    float* logf = (float*)(P.ws + WS_LOGF); float* wsum = (float*)(P.ws + WS_WSUM);
    const f32x4 bf = *(const f32x4*)(P.in[I_FBF] + L * 4);
    for (int g0 = gw; g0 < NTOK / 16; g0 += ngw) {
        f32x4 run = {0.f, 0.f, 0.f, 0.f};
        for (int i = 0; i < 16; ++i) { const int row = g0 * 16 + i; f32x4 v[4]; rms_row(x + (size_t)row * D, gain, H + (size_t)row * D, lane, v);
            f32x4 d = {0.f, 0.f, 0.f, 0.f};
#pragma unroll
            for (int j = 0; j < 4; ++j)
#pragma unroll
                for (int e = 0; e < 4; ++e) d += wff[4 * lane + 256 * j + e] * v[j][e];
#pragma unroll
            for (int e = 0; e < 4; ++e) { d[e] = wave_sum(d[e]); run[e] += log_sigmoid(d[e] + bf[e]); }
            if (lane == 0) *(f32x4*)(logf + (size_t)row * 4) = run; }
        if (lane == 0) *(f32x4*)(wsum + (size_t)g0 * 4) = run;
    }
    __syncthreads();
}
__device__ __forceinline__ void prep_phase(const Params& P) {
    BODY_IDS();
    const float* logf = (const float*)(P.ws + WS_LOGF); const float* wsum = (const float*)(P.ws + WS_WSUM); float* cdec = (float*)(P.ws + WS_CDEC);
    float* rq = (float*)(P.ws + WS_RSTDQ); float* rkv = (float*)(P.ws + WS_RSTDKV); const bf16* zin = (const bf16*)(P.ws + WS_ZIN); bf16* kper = (bf16*)(P.ws + WS_KPER);
    const float* ct = (const float*)(P.ws + WS_COS); const float* st = (const float*)(P.ws + WS_SIN);
    for (int g0 = gw; g0 < NTOK / 16; g0 += ngw) {
        const int first = (g0 / 512) * 512;
        f32x4 pre = {0.f, 0.f, 0.f, 0.f};
        for (int i = first + lane; i < g0; i += 64) pre += *(const f32x4*)(wsum + (size_t)i * 4);
#pragma unroll
        for (int e = 0; e < 4; ++e) pre[e] = wave_sum(pre[e]);
        if (lane < 16) { const int row = g0 * 16 + lane; *(f32x4*)(cdec + (size_t)row * 4) = *(const f32x4*)(logf + (size_t)row * 4) + pre; }
        for (int i = 0; i < 16; ++i) { const int row = g0 * 16 + i; const bf16* zr = zin + (size_t)row * ZP;
            const float a0 = bf2f(zr[ZC_CQ + lane]), a1 = bf2f(zr[ZC_CQ + 64 + lane]), a2 = bf2f(zr[ZC_CQ + 128 + lane]);
            const float b0 = bf2f(zr[ZC_CKV + lane]), b1 = bf2f(zr[ZC_CKV + 64 + lane]);
            const float sq = wave_sum(a0 * a0 + a1 * a1 + a2 * a2), skv = wave_sum(b0 * b0 + b1 * b1);
            if (lane == 0) { rq[row] = 1.0f / sqrtf(sq * (1.0f / 192.0f) + RMS_EPS); rkv[row] = 1.0f / sqrtf(skv * (1.0f / 128.0f) + RMS_EPS); }
            if (lane < 16) { const float t1 = bf2f(zr[ZC_KPE + lane]), t2 = bf2f(zr[ZC_KPE + 16 + lane]); const float c = ct[(size_t)row * 16 + lane], s = st[(size_t)row * 16 + lane];
                kper[(size_t)row * 32 + lane] = (bf16)f2bf(t1 * c - t2 * s); kper[(size_t)row * 32 + 16 + lane] = (bf16)f2bf(t2 * c + t1 * s); } }
    }
}
__device__ __forceinline__ void final_norm(const Params& P) {
    BODY_IDS();
    const f32x4* gr = (const f32x4*)P.in[I_GFIN] + lane;
    for (int row = gw; row < NTOK; row += ngw) {
        f32x4* xr = (f32x4*)(P.out + (size_t)row * D) + lane; f32x4 v[4]; float s = 0.f;
#pragma unroll
        for (int j = 0; j < 4; ++j) { v[j] = xr[64 * j]; s += (v[j][0] * v[j][0] + v[j][1] * v[j][1]) + (v[j][2] * v[j][2] + v[j][3] * v[j][3]); }
        const float rstd = 1.0f / sqrtf(wave_sum(s) * (1.0f / D) + RMS_EPS);
#pragma unroll
        for (int j = 0; j < 4; ++j) xr[64 * j] = v[j] * rstd * gr[64 * j];
    }
}

namespace s5 {
struct Coef { float abr, abi; float Br[16], Bi[16]; float a64r, a64i; };
__device__ __forceinline__ void coef(const Params& P, int L, int g, int p, Coef& C) {
    const float dt = __expf(P.in[I_SLDT][L * 16 + g]); const float ar = P.in[I_SAR][(L * 16 + g) * 64 + p], ai = P.in[I_SAI][(L * 16 + g) * 64 + p];
    const float mag = __expf(ar * dt); float sn, cs; sincos_rad((double)(ai * dt), sn, cs);
    C.abr = mag * cs; C.abi = mag * sn;
    const float den = ar * ar + ai * ai, nr = C.abr - 1.0f, ni = C.abi;
    const float cr = (nr * ar + ni * ai) / den, ci = (ni * ar - nr * ai) / den;
    const float* br = P.in[I_SBR] + ((size_t)(L * 16 + g) * 64 + p) * 16; const float* bi = P.in[I_SBI] + ((size_t)(L * 16 + g) * 64 + p) * 16;
#pragma unroll
    for (int h = 0; h < 16; ++h) { const float r = br[h], i = bi[h]; C.Br[h] = cr * r - ci * i; C.Bi[h] = cr * i + ci * r; }
    const float m64 = __expf(64.0f * ar * dt); float s64, c64; sincos_rad(64.0 * (double)(ai * dt), s64, c64);
    C.a64r = m64 * c64; C.a64i = m64 * s64;
}
constexpr int WAVE_LDS = 8448;
template <bool EMIT>
__device__ __forceinline__ void chunk(const Params& P, int L, int g, int row0, const Coef& C, float& xr, float& xi, LAS unsigned char* wl, int lane, const bf16x8 (&cf)[4], float dsk) {
    bf16* zin = (bf16*)(P.ws + WS_ZIN);
    LAS float* ut = (LAS float*)wl; LAS unsigned* xt = (LAS unsigned*)(wl + 4096);
    { const u32x4* up = (const u32x4*)(zin + (size_t)(row0 + lane) * ZP + ZC_U + g * 16); const u32x4 w0 = up[0], w1 = up[1];
      LAS f32x4* d = (LAS f32x4*)(ut + lane * 16);
      d[0] = (f32x4){bflo(w0.x), bfhi(w0.x), bflo(w0.y), bfhi(w0.y)}; d[1] = (f32x4){bflo(w0.z), bfhi(w0.z), bflo(w0.w), bfhi(w0.w)};
      d[2] = (f32x4){bflo(w1.x), bfhi(w1.x), bflo(w1.y), bfhi(w1.y)}; d[3] = (f32x4){bflo(w1.z), bfhi(w1.z), bflo(w1.w), bfhi(w1.w)}; }
    for (int tb = 0; tb < 4; ++tb) {
#pragma unroll 4
        for (int ti = 0; ti < 16; ++ti) {
            const LAS f32x4* up = (const LAS f32x4*)(ut + (tb * 16 + ti) * 16);
            float br = 0.f, bi = 0.f;
#pragma unroll
            for (int q = 0; q < 4; ++q) { const f32x4 u4 = up[q];
#pragma unroll
                for (int e = 0; e < 4; ++e) { br += C.Br[4 * q + e] * u4[e]; bi += C.Bi[4 * q + e] * u4[e]; } }
            const float nr = C.abr * xr - C.abi * xi + br, ni = C.abr * xi + C.abi * xr + bi; xr = nr; xi = ni;
            if (EMIT) xt[ti * 68 + lane] = pk2(xr, xi);
        }
        if (EMIT) {
            f32x4 dacc = {0.f, 0.f, 0.f, 0.f};
#pragma unroll
            for (int ks = 0; ks < 4; ++ks) { const bf16x8 a = *(const LAS bf16x8*)((const LAS unsigned char*)xt + (lane & 15) * 272 + (ks * 32 + (lane >> 4) * 8) * 2);
                dacc = __builtin_amdgcn_mfma_f32_16x16x32_bf16(a, cf[ks], dacc, 0, 0, 0); }
            const int hp = lane & 15;
#pragma unroll
            for (int i = 0; i < 4; ++i) { const int tok = tb * 16 + 4 * (lane >> 4) + i; const float y = dacc[i] + dsk * ut[tok * 16 + hp];
                zin[(size_t)(row0 + tok) * ZP + ZC_U + g * 16 + hp] = (bf16)f2bf(gelu_tanh(y)); }
        }
    }
}
template <int PASS>
__device__ __forceinline__ void phase(const Params& P, int L, LAS unsigned char* lds) {
    BODY_IDS();
    LAS unsigned char* wl = lds + wave * WAVE_LDS;
    f32x2* SC = (f32x2*)(P.ws + WS_SC);
    for (int w = gw; w < 2048; w += ngw) {
        const int bg = w >> 5, cg = w & 31, b = bg >> 4, g = bg & 15;
        Coef C; coef(P, L, g, lane, C);
        bf16x8 cf[4]; float dsk = 0.f;
        if (PASS == 1) {
            const int hp = lane & 15, kg = lane >> 4;
            const float* cre = P.in[I_SCR] + ((size_t)(L * 16 + g) * 16 + hp) * 64; const float* cim = P.in[I_SCI] + ((size_t)(L * 16 + g) * 16 + hp) * 64;
#pragma unroll
            for (int ks = 0; ks < 4; ++ks) { const int p0 = 16 * ks + 4 * kg; u32x4 wv;
                wv.x = pk2(cre[p0], -cim[p0]); wv.y = pk2(cre[p0 + 1], -cim[p0 + 1]); wv.z = pk2(cre[p0 + 2], -cim[p0 + 2]); wv.w = pk2(cre[p0 + 3], -cim[p0 + 3]);
                cf[ks] = __builtin_bit_cast(bf16x8, wv); }
            dsk = P.in[I_SD][(L * 16 + g) * 16 + hp];
        } else {
#pragma unroll
            for (int ks = 0; ks < 4; ++ks) cf[ks] = (bf16x8){0, 0, 0, 0, 0, 0, 0, 0};
        }
        float xr = 0.f, xi = 0.f;
        if (PASS == 1) {
            const f32x2* sp = SC + ((size_t)bg * 128) * 64 + lane;
            for (int c = 0; c < 4 * cg; ++c) { const f32x2 s = sp[(size_t)c * 64]; const float nr = C.a64r * xr - C.a64i * xi + s[0], ni = C.a64r * xi + C.a64i * xr + s[1]; xr = nr; xi = ni; }
        }
        for (int cc = 0; cc < 4; ++cc) {
            const int c = 4 * cg + cc, row0 = b * SEQ + c * 64;
            if (PASS == 0) { xr = 0.f; xi = 0.f; }
            chunk<PASS == 1>(P, L, g, row0, C, xr, xi, wl, lane, cf, dsk);
            if (PASS == 0) SC[((size_t)bg * 128 + c) * 64 + lane] = (f32x2){xr, xi};
        }
    }
}
__device__ __forceinline__ void naive(const Params& P, int L) {
    BODY_IDS();
    bf16* zin = (bf16*)(P.ws + WS_ZIN);
    for (int bg = gw; bg < 64; bg += ngw) {
        const int b = bg >> 4, g = bg & 15;
        Coef C; coef(P, L, g, lane, C);
        float cr[16], ci[16];
#pragma unroll
        for (int h = 0; h < 16; ++h) { cr[h] = P.in[I_SCR][((size_t)(L * 16 + g) * 16 + h) * 64 + lane]; ci[h] = P.in[I_SCI][((size_t)(L * 16 + g) * 16 + h) * 64 + lane]; }
        const float dsk = P.in[I_SD][(L * 16 + g) * 16 + (lane & 15)];
        float xr = 0.f, xi = 0.f;
        for (int t = 0; t < SEQ; ++t) {
            bf16* up = zin + (size_t)(b * SEQ + t) * ZP + ZC_U + g * 16;
            const u32x4 w0 = *(const u32x4*)up, w1 = *(const u32x4*)(up + 8);
            const float u[16] = {bflo(w0.x), bfhi(w0.x), bflo(w0.y), bfhi(w0.y), bflo(w0.z), bfhi(w0.z), bflo(w0.w), bfhi(w0.w),
                                 bflo(w1.x), bfhi(w1.x), bflo(w1.y), bfhi(w1.y), bflo(w1.z), bfhi(w1.z), bflo(w1.w), bfhi(w1.w)};
            float br = 0.f, bi = 0.f;
#pragma unroll
            for (int h = 0; h < 16; ++h) { br += C.Br[h] * u[h]; bi += C.Bi[h] * u[h]; }
            const float nr = C.abr * xr - C.abi * xi + br, ni = C.abr * xi + C.abi * xr + bi; xr = nr; xi = ni;
            float ymine = 0.f, umine = 0.f;
#pragma unroll
            for (int h = 0; h < 16; ++h) { const float s = wave_sum(xr * cr[h] - xi * ci[h]); if ((lane & 15) == h) { ymine = s; umine = u[h]; } }
            __builtin_amdgcn_s_waitcnt(0);
            if (lane < 16) up[lane] = (bf16)f2bf(gelu_tanh(ymine + dsk * umine));
        }
    }
}
}

__device__ __forceinline__ void norm2_moe_phase(const Params& P, const float* x, LAS unsigned char* lds) {
    BODY_IDS();
    LAS float* wr = (LAS float*)lds;
    LAS unsigned* lcnt = (LAS unsigned*)(lds + 32768); LAS unsigned* lbase = lcnt + 8;
    for (int i = tid; i < D * 8 / 4; i += NTHREADS) ((LAS f32x4*)wr)[i] = ((const f32x4*)P.in[I_MWR])[i];
    if (tid < 8) lcnt[tid] = 0u;
    __syncthreads();
    const float* gain = P.in[I_GFFN] + 1 * D; bf16* H = (bf16*)(P.ws + WS_H);
    unsigned* tokinfo = (unsigned*)(P.ws + WS_TOKINFO); unsigned* gcnt = (unsigned*)(P.ws + WS_CTL) + CW_MOECNT;
    const float* brt = P.in[I_MBR];
    for (int g0 = gw; g0 < NTOK / 16; g0 += ngw) {
        for (int i = 0; i < 16; ++i) { const int row = g0 * 16 + i; f32x4 v[4]; rms_row(x + (size_t)row * D, gain, H + (size_t)row * D, lane, v);
            float lg[8];
#pragma unroll
            for (int e = 0; e < 8; ++e) lg[e] = 0.f;
#pragma unroll
            for (int j = 0; j < 4; ++j)
#pragma unroll
                for (int q = 0; q < 4; ++q) { const int k = 4 * lane + 256 * j + q; const f32x4 w0 = *(const LAS f32x4*)(wr + k * 8), w1 = *(const LAS f32x4*)(wr + k * 8 + 4); const float hv = v[j][q];
                    lg[0] += hv * w0[0]; lg[1] += hv * w0[1]; lg[2] += hv * w0[2]; lg[3] += hv * w0[3]; lg[4] += hv * w1[0]; lg[5] += hv * w1[1]; lg[6] += hv * w1[2]; lg[7] += hv * w1[3]; }
#pragma unroll
            for (int e = 0; e < 8; ++e) lg[e] = wave_sum(lg[e]) + brt[e];
            int e0 = 0; float l0 = lg[0];
#pragma unroll
            for (int e = 1; e < 8; ++e) if (lg[e] > l0) { l0 = lg[e]; e0 = e; }
            int e1 = 0; float l1 = -INFINITY;
#pragma unroll
            for (int e = 0; e < 8; ++e) if (e != e0 && lg[e] > l1) { l1 = lg[e]; e1 = e; }
            const float ex = __expf(l1 - l0); const float ga = 1.0f / (1.0f + ex), gb = ex / (1.0f + ex);
            if (lane == 0) { const unsigned r0 = __hip_atomic_fetch_add(&lcnt[e0], 1u, __ATOMIC_RELAXED, __HIP_MEMORY_SCOPE_WORKGROUP), r1 = __hip_atomic_fetch_add(&lcnt[e1], 1u, __ATOMIC_RELAXED, __HIP_MEMORY_SCOPE_WORKGROUP);
                u32x4 a; a.x = (unsigned)e0; a.y = (unsigned)e1; a.z = r0; a.w = r1; u32x4 bq; bq.x = __float_as_uint(ga); bq.y = __float_as_uint(gb); bq.z = 0u; bq.w = 0u;
                *(u32x4*)(tokinfo + (size_t)row * 8) = a; *(u32x4*)(tokinfo + (size_t)row * 8 + 4) = bq; } }
    }
    __syncthreads();
    if (tid < 8) lbase[tid] = __hip_atomic_fetch_add(gcnt + tid, lcnt[tid], __ATOMIC_RELAXED, __HIP_MEMORY_SCOPE_AGENT);
    __syncthreads();
    for (int g0 = gw; g0 < NTOK / 16; g0 += ngw) {
        if (lane == 0) { for (int i = 0; i < 16; ++i) { const int row = g0 * 16 + i; u32x4 a = *(u32x4*)(tokinfo + (size_t)row * 8);
            unsigned b0 = 0, b1 = 0;
#pragma unroll
            for (int e = 0; e < 8; ++e) { const unsigned lb = lbase[e]; b0 = (a.x == (unsigned)e) ? lb : b0; b1 = (a.y == (unsigned)e) ? lb : b1; }
            a.z += b0; a.w += b1; *(u32x4*)(tokinfo + (size_t)row * 8) = a; } }
    }
    int* slot_tok = (int*)(P.ws + WS_SLOTTOK);
    for (int i = gtid; i < MOE_ROWS; i += gthreads) slot_tok[i] = -1;
    __syncthreads();
}
struct MoeLayout { int pstart[9]; };
__device__ __forceinline__ MoeLayout moe_layout(const Params& P) {
    const unsigned* gcnt = (const unsigned*)(P.ws + WS_CTL) + CW_MOECNT; MoeLayout Lo; int acc = 0;
#pragma unroll
    for (int e = 0; e < 8; ++e) { Lo.pstart[e] = acc; const int c = (int)__hip_atomic_load(gcnt + e, __ATOMIC_RELAXED, __HIP_MEMORY_SCOPE_AGENT); acc += (c + 255) / 256 * 256; }
    Lo.pstart[8] = acc; return Lo;
}
__device__ __forceinline__ void moe_assign_phase(const Params& P) {
    BODY_IDS();
    const MoeLayout Lo = moe_layout(P);
    const unsigned* tokinfo = (const unsigned*)(P.ws + WS_TOKINFO); int* slot_tok = (int*)(P.ws + WS_SLOTTOK); float* slot_gate = (float*)(P.ws + WS_SLOTGATE);
    for (int t = gtid; t < NTOK; t += gthreads) { const u32x4 a = *(const u32x4*)(tokinfo + (size_t)t * 8); const u32x2 g = *(const u32x2*)(tokinfo + (size_t)t * 8 + 4);
        int p0 = 0, p1 = 0;
#pragma unroll
        for (int e = 0; e < 8; ++e) { p0 = ((int)a.x == e) ? Lo.pstart[e] : p0; p1 = ((int)a.y == e) ? Lo.pstart[e] : p1; }
        const int s0 = p0 + (int)a.z, s1 = p1 + (int)a.w;
        slot_tok[s0] = t; slot_gate[s0] = __uint_as_float(g.x); slot_tok[s1] = t; slot_gate[s1] = __uint_as_float(g.y); }
}
struct MoeOrder {
    int pstart[9]; int ntile, ncol, G, c;
    __device__ __forceinline__ bool next(int i, pg8::Unit& u) const {
        const long Lf = (long)i * G + c; if (Lf >= (long)ntile * ncol) return false;
        const int rt = (int)(Lf / ncol), j = (int)(Lf % ncol); int e = 0;
#pragma unroll
        for (int q = 1; q < 8; ++q) e = (rt * 256 >= pstart[q]) ? q : e;
        u.pm = rt; u.pn = e * ncol + j; return true;
    }
};
__device__ __forceinline__ MoeOrder moe_order(const Params& P, int ncol, int G, int c) {
    const MoeLayout Lo = moe_layout(P); MoeOrder S;
#pragma unroll
    for (int e = 0; e < 9; ++e) S.pstart[e] = Lo.pstart[e];
    S.ntile = Lo.pstart[8] / 256; S.ncol = ncol; S.G = G; S.c = c; return S;
}
#ifndef REF_MASK
#define REF_MASK 0
#endif
#ifndef N_LAUNCH_MODE
#define N_LAUNCH_MODE 1
#endif
constexpr int LDS_BYTES = 147456;
constexpr int MISC_OFF = LDS_BYTES - 64;
constexpr int N_PHASES = 27;
#ifndef PHASE_SEL
#define PHASE_SEL 0xFFFFFFFu
#endif
#define PH_ON(b) (((PHASE_SEL) >> (b)) & 1u)
#ifndef SUB_SEL
#define SUB_SEL 0xFFu
#endif
#define SUB_ON(b) (((SUB_SEL) >> (b)) & 1u)

#define RUN_GEMM(EPI_T, SCHED_T, GATH, gm, sc, ep) do { if (REF_MASK & 1) pg8::gemm_phase_naive<EPI_T, SCHED_T, GATH>(gm, sc, ep); \
    else pg8::gemm_phase<EPI_T, SCHED_T, true, GATH>(lds, gm, sc, ep); } while (0)

__global__ void __launch_bounds__(NTHREADS, 2) mega_fwd(Params P) {
    extern __shared__ __attribute__((aligned(16))) unsigned char lds_raw[];
    LAS unsigned char* lds = (LAS unsigned char*)lds_raw;
    const int tid = threadIdx.x;
    const int G = gridDim.x, bx = blockIdx.x;
    unsigned* ctl = (unsigned*)(P.ws + WS_CTL);
    volatile LAS unsigned* misc = (volatile LAS unsigned*)(lds + MISC_OFF);
    if (tid < 16) misc[tid] = 0u;
    __syncthreads();
    const int lo = P.ph_lo, hi = P.ph_hi;
    XcdBarrier bar; bar.bar = ctl + CW_BAR; bar.x = 0; bar.st = misc;
    if (hi - lo > 1) bar = xcd_barrier_post(ctl + CW_BAR, misc);
#define IN(k) (lo <= (k) && (k) < hi)
#define SEAM(k) do { if (IN(k) && IN((k) + 1)) xcd_barrier(bar); } while (0)

#define H ((bf16*)(P.ws + WS_H))
#define ZIN ((bf16*)(P.ws + WS_ZIN))
#define GB ((bf16*)(P.ws + WS_G))
#define MB ((bf16*)(P.ws + WS_M))
#define MLAQ ((bf16*)(P.ws + WS_MLAQ))
#define MLAKV ((bf16*)(P.ws + WS_MLAKV))
#define KPER ((bf16*)(P.ws + WS_KPER))
#define cosT ((float*)(P.ws + WS_COS))
#define sinT ((float*)(P.ws + WS_SIN))
#define slot_tok ((int*)(P.ws + WS_SLOTTOK))
#define slot_gate ((float*)(P.ws + WS_SLOTGATE))

    if (PH_ON(0) && IN(0)) { cvt_jobs(P, 0, 43, lds); p0_misc(P); }
    SEAM(0);

    for (int L = 0; L < 2; ++L) {
        const int pb = 1 + 12 * L;
        const int pc = (L == 0) ? 9 : 22;
        const float* xsrc = (L == 0) ? P.in[I_X] : P.out;
        if (PH_ON(1) && IN(pb)) norm1_phase(P, L, xsrc, lds);
        SEAM(pb);
        if (PH_ON(2) && IN(pb + 1)) {
            pg8::Gemm g{H, wmix(P, L, WM_IN), D, D, D, nullptr}; pg8::StaticOrder S; S.init(NTOK, ZP, G, bx);
            epi::EpiStore E{ZIN, ZP, 0};
            RUN_GEMM(epi::EpiStore, pg8::StaticOrder, false, g, S, E);
        }
        SEAM(pb + 1);
        if (PH_ON(3) && IN(pb + 2)) {
            prep_phase(P);
            if (!(REF_MASK & 4)) s5::phase<0>(P, L, lds);
            __syncthreads();
        }
        SEAM(pb + 2);
        if (PH_ON(4) && IN(pb + 3)) {
            if (SUB_ON(0)) { pg8::Gemm g{ZIN + ZC_CQ, wmix(P, L, WM_UQ), ZP, 256, 256, nullptr}; pg8::StaticOrder S; S.init(NTOK, 512, G, bx);
              epi::EpiMlaQ E{MLAQ, (const float*)(P.ws + WS_RSTDQ), cosT, sinT};
              RUN_GEMM(epi::EpiMlaQ, pg8::StaticOrder, false, g, S, E); }
            if (SUB_ON(1)) { pg8::Gemm g{ZIN + ZC_CKV, wmix(P, L, WM_UKV), ZP, 128, 128, nullptr}; pg8::StaticOrder S; S.init(NTOK, 512, G, bx);
              epi::EpiRowScale E{MLAKV, 512, (const float*)(P.ws + WS_RSTDKV)};
              RUN_GEMM(epi::EpiRowScale, pg8::StaticOrder, false, g, S, E); }
            if (SUB_ON(2)) { if (REF_MASK & 4) s5::naive(P, L); else s5::phase<1>(P, L, lds); }
            __syncthreads();
            if (SUB_ON(3)) { att::Tensors T; T.Q = ZIN + ZC_FQ; T.ldq = ZP; T.K = ZIN + ZC_FK; T.ldk = ZP; T.K2 = nullptr; T.V = ZIN + ZC_FV; T.ldv = ZP; T.O = ZIN + ZC_FQ; T.ldo = ZP;
              T.cdec = (const float*)(P.ws + WS_CDEC); T.relb = nullptr; T.qhs = 64; T.khs = 64; T.vhs = 64; T.ohs = 64;
              if (REF_MASK & 2) att::attn_naive<att::MODE_FOX>(T); else att::attn_phase<att::MODE_FOX>(T, lds); }
            __syncthreads();
            if (SUB_ON(4)) { att::Tensors T; T.Q = ZIN + ZC_DQ; T.ldq = ZP; T.K = ZIN + ZC_DK; T.ldk = ZP; T.K2 = nullptr; T.V = ZIN + ZC_DV; T.ldv = ZP; T.O = ZIN + ZC_DQ; T.ldo = ZP;
              T.cdec = nullptr; T.relb = P.in[I_RELB] + (size_t)L * 4 * 513; T.qhs = 64; T.khs = 64; T.vhs = 64; T.ohs = 64;
              if (REF_MASK & 2) att::attn_naive<att::MODE_BAND>(T); else att::attn_phase<att::MODE_BAND>(T, lds); }
            __syncthreads();
        }
        SEAM(pb + 3);
        if (PH_ON(5) && IN(pb + 4)) {
            if (SUB_ON(0)) { att::Tensors T; T.Q = MLAQ; T.ldq = 512; T.K = MLAKV; T.ldk = 512; T.K2 = KPER; T.V = MLAKV + 64; T.ldv = 512; T.O = ZIN + ZC_CQ; T.ldo = ZP;
              T.cdec = nullptr; T.relb = nullptr; T.qhs = 96; T.khs = 128; T.vhs = 128; T.ohs = 64;
              if (REF_MASK & 2) att::attn_naive<att::MODE_MLA>(T); else att::attn_phase<att::MODE_MLA>(T, lds); }
            __syncthreads();
            if (SUB_ON(1)) { pg8::Gemm g{ZIN + ZC_U, wmix(P, L, WM_GLU), ZP, 256, 256, nullptr}; pg8::StaticOrder S; S.init(NTOK, 256, G, bx);
              epi::EpiGlu E{ZIN + ZC_U, ZP};
              RUN_GEMM(epi::EpiGlu, pg8::StaticOrder, false, g, S, E); }
        }
        SEAM(pb + 4);
        if (PH_ON(6) && IN(pb + 5)) {
            for (int k = 0; k < 4; ++k) {
                const int ycol = (k == 0) ? ZC_U : (k == 1) ? ZC_FQ : (k == 2) ? ZC_CQ : ZC_DQ;
                { pg8::Gemm g{H, wmix(P, L, WM_G) + (size_t)k * D * D, D, D, D, nullptr}; pg8::StaticOrder S; S.init(NTOK, D, G, bx);
                  epi::EpiGate E{GB, P.in[I_BG] + ((size_t)L * 4 + k) * D};
                  RUN_GEMM(epi::EpiGate, pg8::StaticOrder, false, g, S, E); }
                { pg8::Gemm g{ZIN + ycol, wmix(P, L, WM_B) + (size_t)k * D * 256, ZP, 256, 256, nullptr}; pg8::StaticOrder S; S.init(NTOK, D, G, bx);
                  epi::EpiMerge E{GB, MB, k == 0 ? 1 : 0};
                  RUN_GEMM(epi::EpiMerge, pg8::StaticOrder, false, g, S, E); }
            }
        }
        SEAM(pb + 5);
        if (PH_ON(7) && IN(pb + 6)) {
            pg8::Gemm g{MB, wmix(P, L, WM_O), D, D, D, nullptr}; pg8::StaticOrder S; S.init(NTOK, D, G, bx);
            epi::EpiRes E{xsrc, P.out};
            RUN_GEMM(epi::EpiRes, pg8::StaticOrder, false, g, S, E);
        }
        SEAM(pb + 6);
        if (PH_ON(8) && IN(pb + 7)) {
            if (L == 0) norm_plain(P.out, P.in[I_GFFN], H);
            else { norm2_moe_phase(P, P.out, lds); cvt_jobs(P, 43, 67, lds); __syncthreads(); }
        }
        SEAM(pb + 7);
        if (L == 0) {
            if (PH_ON(9) && IN(9)) {
                pg8::Gemm g{H, (const bf16*)(P.ws + WS_W13), D, D, D, nullptr}; pg8::StaticOrder S; S.init(NTOK, 2 * DFF, G, bx);
                epi::EpiSwiglu E{(bf16*)(P.ws + WS_HMID), DFF, 22};
                RUN_GEMM(epi::EpiSwiglu, pg8::StaticOrder, false, g, S, E);
            }
            SEAM(9);
            if (PH_ON(10) && IN(10)) {
                pg8::Gemm g{(const bf16*)(P.ws + WS_HMID), (const bf16*)(P.ws + WS_W2), DFF, DFF, DFF, nullptr}; pg8::StaticOrder S; S.init(NTOK, D, G, bx);
                epi::EpiRes E{P.out, P.out};
                RUN_GEMM(epi::EpiRes, pg8::StaticOrder, false, g, S, E);
            }
            SEAM(10);
        } else {
            if (PH_ON(21) && IN(21)) moe_assign_phase(P);
            SEAM(21);
            if (PH_ON(22) && IN(22)) {
                pg8::Gemm g{H, (const bf16*)(P.ws + WS_WM13), D, D, D, slot_tok}; const MoeOrder S = moe_order(P, 11, G, bx);
                epi::EpiSwiglu E{(bf16*)(P.ws + WS_HMID), DFFE, 11};
                RUN_GEMM(epi::EpiSwiglu, MoeOrder, true, g, S, E);
            }
            SEAM(22);
            if (PH_ON(23) && IN(23)) {
                pg8::Gemm g{(const bf16*)(P.ws + WS_HMID), (const bf16*)(P.ws + WS_WM2), DFFE, DFFE, DFFE, nullptr}; const MoeOrder S = moe_order(P, 4, G, bx);
                epi::EpiMoeDown E{P.out, slot_tok, slot_gate};
                RUN_GEMM(epi::EpiMoeDown, MoeOrder, false, g, S, E);
            }
            SEAM(23);
        }
        if (PH_ON(11) && IN(pc + 2)) norm_plain(P.out, P.in[I_GPLE] + L * D, H);
        SEAM(pc + 2);
        if (PH_ON(12) && IN(pc + 3)) {
            { pg8::Gemm g{(const bf16*)(P.ws + WS_PBF) + (size_t)L * NTOK * 256, wmix(P, L, WM_UP), 256, 256, 256, nullptr}; pg8::StaticOrder S; S.init(NTOK, D, G, bx);
              epi::EpiStore E{(bf16*)(P.ws + WS_U), D, 0};
              RUN_GEMM(epi::EpiStore, pg8::StaticOrder, false, g, S, E); }
            { pg8::Gemm g{H, wmix(P, L, WM_PG), D, D, D, nullptr}; pg8::StaticOrder S; S.init(NTOK, D, G, bx);
              epi::EpiPle E{(const bf16*)(P.ws + WS_U), P.out};
              RUN_GEMM(epi::EpiPle, pg8::StaticOrder, false, g, S, E); }
        }
        SEAM(pc + 3);
    }
    if (PH_ON(26) && IN(26)) final_norm(P);
#undef IN
#undef SEAM
#undef H
#undef ZIN
#undef GB
#undef MB
#undef MLAQ
#undef MLAKV
#undef KPER
#undef cosT
#undef sinT
#undef slot_tok
#undef slot_gate
}

extern "C" void kernel_launch(void* const* d_in, const int* in_sizes, int n_in, void* d_out, int out_size, void* d_ws, size_t ws_size, hipStream_t stream) {
    static int grid = 0;
    if (grid == 0) {
        if (n_in != 37 || out_size != NTOK * D || ws_size < WS_END) { fprintf(stderr, "kernel_launch: unexpected shapes: n_in %d out %d ws %zu\n", n_in, out_size, ws_size); grid = -1; return; }
        int dev = 0, cus = 0, per_cu = 0;
        if (hipGetDevice(&dev) != hipSuccess || hipDeviceGetAttribute(&cus, hipDeviceAttributeMultiprocessorCount, dev) != hipSuccess) { grid = -1; return; }
        if (hipFuncSetAttribute((const void*)mega_fwd, hipFuncAttributeMaxDynamicSharedMemorySize, LDS_BYTES) != hipSuccess) { fprintf(stderr, "kernel_launch: hipFuncSetAttribute failed\n"); grid = -1; return; }
        if (hipOccupancyMaxActiveBlocksPerMultiprocessor(&per_cu, (const void*)mega_fwd, NTHREADS, LDS_BYTES) != hipSuccess || per_cu < 1)
            fprintf(stderr, "kernel_launch: note: occupancy query reports %d workgroups per CU\n", per_cu);
        (void)hipGetLastError();
        grid = cus;
        if (grid != 256) fprintf(stderr, "kernel_launch: note: %d CUs (built for 256)\n", grid);
    }
    if (grid < 0) return;
    if (hipMemsetAsync((char*)d_ws + WS_CTL, 0, CTL_ZERO_BYTES, stream) != hipSuccess) return;
    Params p{};
    for (int i = 0; i < 37; ++i) p.in[i] = (const float*)d_in[i];
    p.out = (float*)d_out; p.ws = (unsigned char*)d_ws;
#if N_LAUNCH_MODE == 1
    p.ph_lo = 0; p.ph_hi = N_PHASES;
    hipLaunchKernelGGL(mega_fwd, dim3(grid), dim3(NTHREADS), LDS_BYTES, stream, p);
#else
    for (int ph = 0; ph < N_PHASES; ++ph) { p.ph_lo = ph; p.ph_hi = ph + 1; hipLaunchKernelGGL(mega_fwd, dim3(grid), dim3(NTHREADS), LDS_BYTES, stream, p); }
#endif
    const hipError_t le = hipPeekAtLastError();
    if (le != hipSuccess) fprintf(stderr, "kernel_launch: launch failed: %s\n", hipGetErrorName(le));
}
```

```cpp
#include <hip/hip_runtime.h>
#include <cstdio>
#include <cstdint>

#define GAS __attribute__((address_space(1)))
#define LAS __attribute__((address_space(3)))
typedef unsigned short bf16;
typedef short bf16x8 __attribute__((ext_vector_type(8)));
typedef short s16x4 __attribute__((ext_vector_type(4)));
typedef float f32x2 __attribute__((ext_vector_type(2)));
typedef float f32x4 __attribute__((ext_vector_type(4)));
typedef float f32x16 __attribute__((ext_vector_type(16)));
typedef unsigned u32x2 __attribute__((ext_vector_type(2)));
typedef unsigned u32x4 __attribute__((ext_vector_type(4)));
typedef __bf16 bf16x2_t __attribute__((ext_vector_type(2)));

constexpr int NB = 4, SEQ = 8192, NTOK = NB * SEQ, D = 1024;
constexpr int ZP = 2304;
constexpr int ZC_U = 0, ZC_FQ = 256, ZC_FK = 512, ZC_FV = 768, ZC_DQ = 1024, ZC_DK = 1280, ZC_DV = 1536, ZC_CQ = 1792, ZC_CKV = 2048, ZC_KPE = 2176;
constexpr int DIN = 2148, DFF = 2816, DFFE = 1408, NE = 8;
constexpr int MOE_ROWS = 2 * NTOK + NE * 256;
constexpr float RMS_EPS = 1e-6f;
constexpr int NWAVES = 8, NTHREADS = 512;

constexpr size_t MiB = 1u << 20;
constexpr size_t WS_CTL = 0, CTL_ZERO_BYTES = 1 * MiB;
constexpr size_t WS_COS = 1 * MiB, WS_SIN = 3 * MiB;
constexpr size_t WS_LOGF = 5 * MiB;
constexpr size_t WS_CDEC = 5 * MiB + 512 * 1024;
constexpr size_t WS_WSUM = 6 * MiB;
constexpr size_t WS_RSTDQ = 6 * MiB + 256 * 1024, WS_RSTDKV = 6 * MiB + 512 * 1024;
constexpr size_t WS_SC = 7 * MiB;
constexpr size_t WS_TOKINFO = 11 * MiB;
constexpr size_t WS_SLOTTOK = 12 * MiB, WS_SLOTGATE = 12 * MiB + 512 * 1024;
constexpr size_t WS_PBF = 17 * MiB;
constexpr size_t WS_WMIX = 49 * MiB, WMIX_STRIDE = 20 * MiB;
constexpr size_t WM_IN = 0, WM_G = 4 * MiB + 512 * 1024, WM_B = 12 * MiB + 512 * 1024, WM_O = 14 * MiB + 512 * 1024, WM_PG = 16 * MiB + 512 * 1024,
                 WM_UP = 18 * MiB + 512 * 1024, WM_UQ = 19 * MiB, WM_UKV = 19 * MiB + 256 * 1024, WM_GLU = 19 * MiB + 384 * 1024;
constexpr size_t WS_W13 = 89 * MiB, WS_W2 = 100 * MiB;
constexpr size_t WS_H = 106 * MiB;
constexpr size_t WS_MLAQ = 170 * MiB, WS_MLAKV = 202 * MiB, WS_KPER = 234 * MiB;
constexpr size_t WS_M = 170 * MiB;
constexpr size_t WS_ZIN = 236 * MiB;
constexpr size_t WS_G = 380 * MiB;
constexpr size_t WS_HMID = 236 * MiB;
constexpr size_t WS_U = 236 * MiB;
constexpr size_t WS_WM13 = 418 * MiB, WS_WM2 = 462 * MiB;
constexpr size_t WS_END = 484 * MiB;
constexpr int CW_BAR = 4096;
constexpr int CW_MOECNT = 16384;

#define LDS_WAIT() asm volatile("s_waitcnt lgkmcnt(0)" ::: "memory")
#define VM_WAIT() asm volatile("s_waitcnt vmcnt(0)" ::: "memory")
__device__ __forceinline__ unsigned f2bf(float f) { unsigned u = __builtin_bit_cast(unsigned, f); return (u + 0x7fffu + ((u >> 16) & 1u)) >> 16; }
__device__ __forceinline__ unsigned pk2(float lo, float hi) { f32x2 v = {lo, hi}; bf16x2_t b = __builtin_convertvector(v, bf16x2_t); return __builtin_bit_cast(unsigned, b); }
__device__ __forceinline__ float bf2f(unsigned short b) { return __uint_as_float((unsigned)b << 16); }
__device__ __forceinline__ float bflo(unsigned w) { return __uint_as_float(w << 16); }
__device__ __forceinline__ float bfhi(unsigned w) { return __uint_as_float(w & 0xffff0000u); }
__device__ __forceinline__ float wave_sum(float v) {
#pragma unroll
    for (int o = 1; o < 64; o <<= 1) v += __shfl_xor(v, o);
    return v;
}
__device__ __forceinline__ float sigmoidf_(float x) { return 1.0f / (1.0f + __expf(-x)); }

#define BODY_IDS() int tid = threadIdx.x; asm volatile("" : "+v"(tid)); const int lane = tid & 63; const int wave = __builtin_amdgcn_readfirstlane(tid >> 6); \
    int grid_ = gridDim.x; asm volatile("" : "+s"(grid_)); \
    const int gw = blockIdx.x * NWAVES + wave, ngw = grid_ * NWAVES, gtid = blockIdx.x * NTHREADS + tid, gthreads = grid_ * NTHREADS; (void)lane; (void)wave; (void)gw; (void)ngw; (void)gtid; (void)gthreads
#define XB_TMO      128
#define XB_XCNT(j)  (256  + 64 * (j))
#define XB_XSUB(j)  (1280 + 64 * (j))
#define XB_XGEN(j)  (2304 + 64 * (j))
#define XB_TOP      3328
#define XB_TOPGEN   3392
#define XCD_BAR_WORDS 3456
#define XB_SPIN_CAP (1u << 22)

__device__ __forceinline__ unsigned xb_ld(unsigned* p)              { return __hip_atomic_load(p, __ATOMIC_RELAXED, __HIP_MEMORY_SCOPE_AGENT); }
__device__ __forceinline__ unsigned xb_add(unsigned* p, unsigned v) { return __hip_atomic_fetch_add(p, v, __ATOMIC_RELAXED, __HIP_MEMORY_SCOPE_AGENT); }
__device__ __forceinline__ unsigned xb_xcc_id() { return (unsigned)__builtin_amdgcn_s_getreg((3 << 11) | 20) & 0xFu; }
#define XB_SPIN(cond, bar) do { unsigned _sp = 0; while (cond) { __builtin_amdgcn_s_sleep(1); \
    if ((++_sp & 255u) == 0u) { if (xb_ld(&(bar)[XB_TMO])) break; if (_sp > XB_SPIN_CAP) { atomicAdd(&(bar)[XB_TMO], 1u); break; } } } } while (0)

struct XcdBarrier { unsigned* bar; unsigned x; volatile LAS unsigned* st; };

__device__ __forceinline__ XcdBarrier xcd_barrier_post(unsigned* bar, volatile LAS unsigned* st) {
    XcdBarrier b; b.bar = bar; b.x = xb_xcc_id(); b.st = st;
    if (threadIdx.x == 0) (void)xb_add(&bar[XB_XCNT(b.x)], 1u);
    return b;
}
__device__ __forceinline__ void xcd_barrier_complete(unsigned* bar, unsigned x, unsigned& nloc, unsigned& nx) {
    const unsigned G = gridDim.x * gridDim.y * gridDim.z;
    unsigned sum, cnt, mine, sp = 0u;
    for (;;) {
        sum = 0u; cnt = 0u; mine = 0u;
#pragma unroll
        for (unsigned j = 0; j < 16; ++j) { const unsigned c = xb_ld(&bar[XB_XCNT(j)]); sum += c; cnt += (c > 0u) ? 1u : 0u; mine = (j == x) ? c : mine; }
        if (sum == G) break;
        __builtin_amdgcn_s_sleep(1);
        if ((++sp & 255u) == 0u) { if (xb_ld(&bar[XB_TMO])) break; if (sp > XB_SPIN_CAP) { atomicAdd(&bar[XB_TMO], 1u); break; } }
    }
    nloc = mine > 0u ? mine : 1u; nx = cnt > 0u ? cnt : 1u;
}
__device__ __forceinline__ void xcd_barrier(const XcdBarrier& b) {
    asm volatile("s_waitcnt vmcnt(0)" ::: "memory");
    __syncthreads();
    if (threadIdx.x == 0) {
        unsigned* bar = b.bar;
        __builtin_amdgcn_s_waitcnt(0);
        unsigned nloc = b.st[0], nx = b.st[1];
        if (nloc == 0u) { xcd_barrier_complete(bar, b.x, nloc, nx); b.st[0] = nloc; b.st[1] = nx; }
        const unsigned old = xb_add(&bar[XB_XSUB(b.x)], 1u);
        const unsigned gen = old / nloc;
        if (old + 1u == (gen + 1u) * nloc) {
            __builtin_amdgcn_fence(__ATOMIC_RELEASE, "agent");
            asm volatile("s_waitcnt vmcnt(0)" ::: "memory");
            const unsigned og = xb_add(&bar[XB_TOP], 1u);
            const unsigned tg = og / nx;
            if (og + 1u == (tg + 1u) * nx) xb_add(&bar[XB_TOPGEN], 1u);
            else XB_SPIN(xb_ld(&bar[XB_TOPGEN]) == tg, bar);
            __builtin_amdgcn_fence(__ATOMIC_ACQUIRE, "agent");
            xb_add(&bar[XB_XGEN(b.x)], 1u);
            asm volatile("s_waitcnt vmcnt(0)" ::: "memory");
        } else {
            XB_SPIN(xb_ld(&bar[XB_XGEN(b.x)]) == gen, bar);
            __builtin_amdgcn_fence(__ATOMIC_ACQUIRE, "agent");
            asm volatile("s_waitcnt vmcnt(0)" ::: "memory");
        }
    }
    __syncthreads();
}
namespace pg8 {
constexpr int BM = 256, BK = 64, HALF = 128, HTB = HALF * BK * 2, STAGE_BYTES = 8 * HTB, NXCD = 8, WGM = 8;
__host__ __device__ __forceinline__ int lds_byte(int r, int c) { const int st = (r >> 4) * 2 + (c >> 5), rr = r & 15, cc = c & 31, ob = rr * 64 + cc * 2; return st * 1024 + (ob ^ (((ob >> 9) & 1) << 5)); }
__host__ __device__ __forceinline__ void stage_rc(int b, int& R, int& C) { const int st = b / 1024, sb = b % 1024, swz = sb ^ (((sb >> 9) & 1) << 5); R = (st >> 1) * 16 + swz / 64; C = (st & 1) * 32 + (swz % 64) / 2; }
__host__ __device__ __forceinline__ int perm32(int rho) { const int n = rho >> 4, i = rho & 15; return 8 * (i >> 2) + 4 * n + (i & 3); }

struct Unit { int pm, pn; };
struct Gemm { const bf16* A; const bf16* Bt; int lda, ldb, K; const int* gidx; };

struct StaticOrder {
    int nM, nN, nwg, G, c;
    __host__ __device__ void init(int M, int N, int G_, int c_) { nM = M / BM; nN = N / BM; nwg = nM * nN; G = G_; c = c_; }
    __host__ __device__ bool next(int i, Unit& u) const {
        const long L = (long)i * G + c; if (L >= nwg) return false;
        int wgid = (int)L; { const int q = nwg / NXCD, r = nwg % NXCD, xcd = wgid % NXCD, off = wgid / NXCD; wgid = (xcd < r ? xcd * (q + 1) : r * (q + 1) + (xcd - r) * q) + off; }
        const int nig = WGM * nN, gid = wgid / nig, fm = gid * WGM, gsz = (nM - fm) < WGM ? (nM - fm) : WGM;
        u.pm = fm + ((wgid % nig) % gsz); u.pn = (wgid % nig) / gsz; return true;
    }
};

template <class Epi, class Sched, bool ALIGN_EPI, bool GATHER>
__device__ __forceinline__ void gemm_phase(LAS unsigned char* lds, const Gemm g, const Sched& S, const Epi& E) {
    int tid = threadIdx.x; asm volatile("" : "+v"(tid));
    const int wid = __builtin_amdgcn_readfirstlane(tid >> 6), lane = tid & 63, wr = wid >> 2, wc = wid & 3, fr = lane & 15, fq = lane >> 4;
    int Kq = g.K; asm volatile("" : "+s"(Kq));
    const int K = Kq, nt = K / BK;
    int RA[2], CA[2];
    unsigned voffA[2], voffB[2];
#pragma unroll
    for (int i = 0; i < 2; ++i) { int R, C; stage_rc(tid * 16 + i * 8192, R, C); const int Rb = Epi::PERM ? ((R & ~31) + perm32(R & 31)) : R;
        RA[i] = R; CA[i] = C; voffA[i] = (unsigned)(R * g.lda + C) * 2u; voffB[i] = (unsigned)(Rb * g.ldb + C) * 2u; }
    const size_t kstep = (size_t)(BK * 2);
    const size_t hstepB = (size_t)HALF * g.ldb * 2, tstepB = 2 * hstepB;
    const size_t hstepA = (size_t)HALF * g.lda * 2, tstepA = 2 * hstepA;
    const unsigned ldsw = (unsigned)wid * 1024u;
    const int aoff = lds_byte(wr * 64 + fr, fq * 8), boff = lds_byte(wc * 32 + fr, fq * 8);
#define PG8_SA(b, h) (((b) * 2 + (h)) * HTB)
#define PG8_SB(b, h) ((4 + (b) * 2 + (h)) * HTB)
#define PG8_STAGEB(bufoff, gbase) do { _Pragma("unroll") for (int _i = 0; _i < 2; ++_i) \
        __builtin_amdgcn_global_load_lds((const unsigned*)((const char*)(gbase) + voffB[_i]), (LAS unsigned*)(lds + (bufoff) + ldsw + _i * 8192), 16, 0, 0); } while (0)
#define PG8_STAGEA(bufoff, kptr, isnext, h) do { _Pragma("unroll") for (int _i = 0; _i < 2; ++_i) { const char* _p; \
        if constexpr (GATHER) _p = (const char*)(kptr) + ((isnext) ? nvo[h][_i] : cvo[h][_i]); else _p = (const char*)(kptr) + (size_t)(h) * hstepA + voffA[_i]; \
        __builtin_amdgcn_global_load_lds((const unsigned*)_p, (LAS unsigned*)(lds + (bufoff) + ldsw + _i * 8192), 16, 0, 0); } } while (0)
#define PG8_LDA(dst, b, h) do { _Pragma("unroll") for (int m = 0; m < 4; ++m) _Pragma("unroll") for (int k = 0; k < 2; ++k) dst[m][k] = *(const LAS bf16x8*)(lds + PG8_SA(b, h) + aoff + m * 2048 + k * 1024); } while (0)
#define PG8_LDB(dst, b, h) do { _Pragma("unroll") for (int n = 0; n < 2; ++n) _Pragma("unroll") for (int k = 0; k < 2; ++k) dst[n][k] = *(const LAS bf16x8*)(lds + PG8_SB(b, h) + boff + n * 2048 + k * 1024); } while (0)
#define PG8_MMA(ai, bj, At, Bt) do { __builtin_amdgcn_s_setprio(1); _Pragma("unroll") for (int m = 0; m < 4; ++m) _Pragma("unroll") for (int n = 0; n < 2; ++n) _Pragma("unroll") for (int k = 0; k < 2; ++k) \
        acc[ai][bj][m][n] = __builtin_amdgcn_mfma_f32_16x16x32_bf16(Bt[n][k], At[m][k], acc[ai][bj][m][n], 0, 0, 0); __builtin_amdgcn_s_setprio(0); } while (0)
#define PG8_WAIT_V(n) asm volatile("s_waitcnt vmcnt(" #n ")" ::: "memory")
#define PG8_WAIT_L(n) asm volatile("s_waitcnt lgkmcnt(" #n ")" ::: "memory")
#define PG8_BAR __builtin_amdgcn_s_barrier()
#define PG8_SCHED __builtin_amdgcn_sched_barrier(0)
#define PG8_VOA(vo, u) do { _Pragma("unroll") for (int _h = 0; _h < 2; ++_h) _Pragma("unroll") for (int _i = 0; _i < 2; ++_i) { \
        int _row = (u).pm * BM + _h * HALF + RA[_i]; if (GATHER) { _row = g.gidx[_row]; _row = _row < 0 ? 0 : _row; } \
        (vo)[_h][_i] = (unsigned)_row * (unsigned)(g.lda * 2) + (unsigned)(CA[_i] * 2); } } while (0)
    Unit cur, nxt; int ui = 0;
    if (!S.next(0, cur)) return;
    f32x4 acc[2][2][4][2];
#pragma unroll
    for (int a = 0; a < 2; ++a)
#pragma unroll
        for (int b = 0; b < 2; ++b)
#pragma unroll
            for (int m = 0; m < 4; ++m)
#pragma unroll
                for (int n = 0; n < 2; ++n) acc[a][b][m][n] = (f32x4){0.f, 0.f, 0.f, 0.f};
    bf16x8 At[4][2], B0[2][2], B1[2][2];
    unsigned cvo[2][2], nvo[2][2];
    if constexpr (GATHER) { PG8_VOA(cvo, cur); PG8_VOA(nvo, cur); }
    const char* cA = (const char*)g.A + (GATHER ? (size_t)0 : (size_t)cur.pm * tstepA); const char* cB = (const char*)g.Bt + (size_t)cur.pn * tstepB;
    PG8_STAGEB(PG8_SB(0, 0), cB); PG8_STAGEB(PG8_SB(0, 1), cB + hstepB); PG8_STAGEA(PG8_SA(0, 0), cA, false, 0); PG8_STAGEA(PG8_SA(0, 1), cA, false, 1);
    if (wr == 1) PG8_BAR;
    PG8_WAIT_V(2); PG8_BAR;
    PG8_STAGEB(PG8_SB(1, 0), cB + kstep); PG8_STAGEA(PG8_SA(1, 0), cA + kstep, false, 0); PG8_STAGEB(PG8_SB(1, 1), cB + hstepB + kstep);
    PG8_WAIT_V(6); PG8_BAR;
    for (;;) {
        const bool has_next = S.next(ui + 1, nxt);
        if constexpr (GATHER) { if (has_next) { PG8_VOA(nvo, nxt); } }
        const char* nA = (GATHER || !has_next) ? cA : (const char*)g.A + (size_t)nxt.pm * tstepA;
        const char* nB = has_next ? (const char*)g.Bt + (size_t)nxt.pn * tstepB : cB;
#pragma nounroll
        for (int t = 0; t < nt; t += 2) {
            const bool last = (t == nt - 2);
            const char* a1 = cA + (size_t)(t + 1) * kstep;
            const char* a2 = last ? nA : cA + (size_t)(t + 2) * kstep; const char* b2 = last ? nB : cB + (size_t)(t + 2) * kstep;
            const char* a3 = a2 + kstep; const char* b3 = b2 + kstep;
            PG8_LDB(B0, 0, 0); PG8_LDB(B1, 0, 1); PG8_SCHED; PG8_LDA(At, 0, 0); PG8_STAGEA(PG8_SA(1, 1), a1, false, 1);
            PG8_WAIT_V(8); PG8_WAIT_L(0); PG8_BAR; PG8_MMA(0, 0, At, B0); PG8_MMA(0, 1, At, B1); PG8_BAR; PG8_SCHED;
            PG8_LDA(At, 0, 1); PG8_STAGEB(PG8_SB(0, 0), b2); PG8_STAGEB(PG8_SB(0, 1), b2 + hstepB); PG8_STAGEA(PG8_SA(0, 0), a2, last, 0);
            PG8_WAIT_V(8); PG8_WAIT_L(0); PG8_BAR; PG8_MMA(1, 0, At, B0); PG8_MMA(1, 1, At, B1); PG8_BAR; PG8_SCHED;
            PG8_LDB(B0, 1, 0); PG8_LDB(B1, 1, 1); PG8_SCHED; PG8_LDA(At, 1, 0); PG8_STAGEA(PG8_SA(0, 1), a2, last, 1);
            PG8_WAIT_V(8); PG8_WAIT_L(0); PG8_BAR; PG8_MMA(0, 0, At, B0); PG8_MMA(0, 1, At, B1); PG8_BAR; PG8_SCHED;
            PG8_LDA(At, 1, 1); PG8_STAGEB(PG8_SB(1, 0), b3); PG8_STAGEB(PG8_SB(1, 1), b3 + hstepB); PG8_STAGEA(PG8_SA(1, 0), a3, last, 0);
            PG8_WAIT_V(8); PG8_WAIT_L(0); PG8_BAR; PG8_MMA(1, 0, At, B0); PG8_MMA(1, 1, At, B1); PG8_BAR; PG8_SCHED;
        }
        if constexpr (ALIGN_EPI) { if (wr == 0) PG8_BAR; }
        E(acc, cur, wr, wc, fr, fq);
        if (!has_next) break;
#pragma unroll
        for (int a = 0; a < 2; ++a)
#pragma unroll
            for (int b = 0; b < 2; ++b)
#pragma unroll
                for (int m = 0; m < 4; ++m)
#pragma unroll
                    for (int n = 0; n < 2; ++n) acc[a][b][m][n] = (f32x4){0.f, 0.f, 0.f, 0.f};
        cur = nxt; cA = nA; cB = nB; ++ui;
        if constexpr (GATHER) {
#pragma unroll
            for (int _h = 0; _h < 2; ++_h)
#pragma unroll
                for (int _i = 0; _i < 2; ++_i) cvo[_h][_i] = nvo[_h][_i]; }
        if constexpr (ALIGN_EPI) { if (wr == 1) PG8_BAR; }
    }
    PG8_WAIT_V(0);
    if constexpr (!ALIGN_EPI) { if (wr == 0) PG8_BAR; }
    PG8_BAR;
#undef PG8_SA
#undef PG8_SB
#undef PG8_STAGEA
#undef PG8_STAGEB
#undef PG8_LDA
#undef PG8_LDB
#undef PG8_MMA
#undef PG8_WAIT_V
#undef PG8_WAIT_L
#undef PG8_BAR
#undef PG8_SCHED
#undef PG8_VOA
}

template <class Epi, class Sched, bool GATHER>
__device__ __forceinline__ void gemm_phase_naive(const Gemm g, const Sched& S, const Epi& E) {
    const int tid = threadIdx.x, wid = tid >> 6, lane = tid & 63, wr = wid >> 2, wc = wid & 3, fr = lane & 15, fq = lane >> 4;
    Unit u;
    for (int ui = 0; S.next(ui, u); ++ui) {
        f32x4 acc[2][2][4][2];
#pragma unroll
        for (int a = 0; a < 2; ++a)
#pragma unroll
            for (int b = 0; b < 2; ++b)
#pragma unroll
                for (int m = 0; m < 4; ++m)
#pragma unroll
                    for (int n = 0; n < 2; ++n) acc[a][b][m][n] = (f32x4){0.f, 0.f, 0.f, 0.f};
        const bf16* arow[2][4];
#pragma unroll
        for (int ai = 0; ai < 2; ++ai)
#pragma unroll
            for (int m = 0; m < 4; ++m) { int r = u.pm * BM + ai * HALF + wr * 64 + m * 16 + fr; if (GATHER) { r = g.gidx[r]; r = r < 0 ? 0 : r; } arow[ai][m] = g.A + (size_t)r * g.lda; }
        for (int k = 0; k < g.K; k += 4) {
            float av[2][4][4];
#pragma unroll
            for (int ai = 0; ai < 2; ++ai)
#pragma unroll
                for (int m = 0; m < 4; ++m) { const u32x2 w = *(const u32x2*)(arow[ai][m] + k); av[ai][m][0] = bflo(w.x); av[ai][m][1] = bfhi(w.x); av[ai][m][2] = bflo(w.y); av[ai][m][3] = bfhi(w.y); }
#pragma unroll
            for (int bj = 0; bj < 2; ++bj)
#pragma unroll
                for (int n = 0; n < 2; ++n)
#pragma unroll
                    for (int e = 0; e < 4; ++e) {
                        const int col = u.pn * BM + bj * HALF + wc * 32 + (Epi::PERM ? (8 * fq + 4 * n) : (16 * n + 4 * fq)) + e;
                        const u32x2 w = *(const u32x2*)(g.Bt + (size_t)col * g.ldb + k);
                        const float b0 = bflo(w.x), b1 = bfhi(w.x), b2 = bflo(w.y), b3 = bfhi(w.y);
#pragma unroll
                        for (int ai = 0; ai < 2; ++ai)
#pragma unroll
                            for (int m = 0; m < 4; ++m) acc[ai][bj][m][n][e] += av[ai][m][0] * b0 + av[ai][m][1] * b1 + av[ai][m][2] * b2 + av[ai][m][3] * b3;
                    }
        }
        E(acc, u, wr, wc, fr, fq);
    }
    VM_WAIT(); __syncthreads();
}
}
namespace epi {
using pg8::Unit; using pg8::BM; using pg8::HALF;
__device__ __forceinline__ void epi_fence() { asm volatile("" ::: "memory"); }
#define EPI_FENCE epi_fence()
#define EPI_LOOP_ROWS for (int ai = 0; ai < 2; ++ai) _Pragma("unroll") for (int m = 0; m < 4; ++m, EPI_FENCE)
#define EPI_LOOP_COLS for (int bj = 0; bj < 2; ++bj) _Pragma("unroll") for (int n = 0; n < 2; ++n)
#define EPI_ROW (u.pm * BM + ai * HALF + wr * 64 + m * 16 + fr)
#define EPI_COLT (bj * HALF + wc * 32 + n * 16 + 4 * fq)
typedef f32x4 acc_t[2][2][4][2];
__device__ __forceinline__ u32x2 pack4(f32x4 v) { u32x2 w; w.x = pk2(v[0], v[1]); w.y = pk2(v[2], v[3]); return w; }
__device__ __forceinline__ f32x4 unpack4(u32x2 w) { return (f32x4){bflo(w.x), bfhi(w.x), bflo(w.y), bfhi(w.y)}; }

struct EpiStore {
    static constexpr bool PERM = false;
    bf16* O; int ldc; int pn0;
    __device__ __forceinline__ void operator()(const acc_t& acc, const Unit& u, int wr, int wc, int fr, int fq) const {
#pragma unroll
        EPI_LOOP_ROWS { bf16* rp = O + (size_t)EPI_ROW * ldc + (u.pn - pn0) * BM;
#pragma unroll
            EPI_LOOP_COLS { *(u32x2*)(rp + EPI_COLT) = pack4(acc[ai][bj][m][n]); } }
    }
};
struct EpiRowScale {
    static constexpr bool PERM = false;
    bf16* O; int ldc; const float* rs;
    __device__ __forceinline__ void operator()(const acc_t& acc, const Unit& u, int wr, int wc, int fr, int fq) const {
#pragma unroll
        EPI_LOOP_ROWS { const int row = EPI_ROW; const float s = rs[row]; bf16* rp = O + (size_t)row * ldc + u.pn * BM;
#pragma unroll
            EPI_LOOP_COLS { *(u32x2*)(rp + EPI_COLT) = pack4(acc[ai][bj][m][n] * s); } }
    }
};
struct EpiMlaQ {
    static constexpr bool PERM = false;
    bf16* O; const float* rs; const float* cosT; const float* sinT;
    __device__ __forceinline__ void operator()(const acc_t& acc, const Unit& u, int wr, int wc, int fr, int fq) const {
#pragma unroll
        EPI_LOOP_ROWS { const int row = EPI_ROW; const float s = rs[row]; bf16* rp = O + (size_t)row * 512 + u.pn * BM;
            const f32x4 cs = *(const f32x4*)(cosT + (size_t)row * 16 + 4 * fq), sn = *(const f32x4*)(sinT + (size_t)row * 16 + 4 * fq);
#pragma unroll
            for (int bj = 0; bj < 2; ++bj) { const int grp = u.pn * 8 + bj * 4 + wc;
                f32x4 t1 = acc[ai][bj][m][0] * s, t2 = acc[ai][bj][m][1] * s;
                if (grp % 3 == 2) { const f32x4 a = t1 * cs - t2 * sn, b = t2 * cs + t1 * sn; t1 = a; t2 = b; }
                *(u32x2*)(rp + bj * HALF + wc * 32 + 4 * fq) = pack4(t1); *(u32x2*)(rp + bj * HALF + wc * 32 + 16 + 4 * fq) = pack4(t2); } }
    }
};
struct EpiGate {
    static constexpr bool PERM = false;
    bf16* G; const float* bias;
    __device__ __forceinline__ void operator()(const acc_t& acc, const Unit& u, int wr, int wc, int fr, int fq) const {
        f32x4 bv[2][2];
#pragma unroll
        EPI_LOOP_COLS bv[bj][n] = *(const f32x4*)(bias + u.pn * BM + EPI_COLT);
#pragma unroll
        EPI_LOOP_ROWS { bf16* rp = G + (size_t)EPI_ROW * D + u.pn * BM;
#pragma unroll
            EPI_LOOP_COLS { f32x4 v = acc[ai][bj][m][n] + bv[bj][n];
                v[0] = sigmoidf_(v[0]); v[1] = sigmoidf_(v[1]); v[2] = sigmoidf_(v[2]); v[3] = sigmoidf_(v[3]);
                *(u32x2*)(rp + EPI_COLT) = pack4(v); } }
    }
};
struct EpiMerge {
    static constexpr bool PERM = false;
    const bf16* G; bf16* M; int first;
    __device__ __forceinline__ void operator()(const acc_t& acc, const Unit& u, int wr, int wc, int fr, int fq) const {
#pragma unroll
        EPI_LOOP_ROWS { const size_t ro = (size_t)EPI_ROW * D + u.pn * BM;
#pragma unroll
            EPI_LOOP_COLS { const f32x4 g = unpack4(*(const u32x2*)(G + ro + EPI_COLT)); f32x4 v = g * acc[ai][bj][m][n];
                if (!first) v += unpack4(*(const u32x2*)(M + ro + EPI_COLT));
                *(u32x2*)(M + ro + EPI_COLT) = pack4(v); } }
    }
};
struct EpiRes {
    static constexpr bool PERM = false;
    const float* xin; float* xout;
    __device__ __forceinline__ void operator()(const acc_t& acc, const Unit& u, int wr, int wc, int fr, int fq) const {
#pragma unroll
        EPI_LOOP_ROWS { const size_t ro = (size_t)EPI_ROW * D + u.pn * BM;
#pragma unroll
            EPI_LOOP_COLS { *(f32x4*)(xout + ro + EPI_COLT) = *(const f32x4*)(xin + ro + EPI_COLT) + acc[ai][bj][m][n]; } }
    }
};
struct EpiPle {
    static constexpr bool PERM = false;
    const bf16* U; float* x;
    __device__ __forceinline__ void operator()(const acc_t& acc, const Unit& u, int wr, int wc, int fr, int fq) const {
#pragma unroll
        EPI_LOOP_ROWS { const size_t ro = (size_t)EPI_ROW * D + u.pn * BM;
#pragma unroll
            EPI_LOOP_COLS { const f32x4 uu = unpack4(*(const u32x2*)(U + ro + EPI_COLT)); f32x4 v = acc[ai][bj][m][n];
                v[0] = sigmoidf_(v[0]); v[1] = sigmoidf_(v[1]); v[2] = sigmoidf_(v[2]); v[3] = sigmoidf_(v[3]);
                *(f32x4*)(x + ro + EPI_COLT) = *(const f32x4*)(x + ro + EPI_COLT) + uu * v; } }
    }
};
struct EpiSwiglu {
    static constexpr bool PERM = false;
    bf16* O; int ldc; int npt;
    __device__ __forceinline__ void operator()(const acc_t& acc, const Unit& u, int wr, int wc, int fr, int fq) const {
        const int ct = (u.pn % npt) * HALF;
#pragma unroll
        EPI_LOOP_ROWS { bf16* rp = O + (size_t)EPI_ROW * ldc + ct + wc * 32 + 4 * fq;
#pragma unroll
            for (int n = 0; n < 2; ++n) { const f32x4 a = acc[ai][0][m][n], b = acc[ai][1][m][n]; f32x4 v;
#pragma unroll
                for (int e = 0; e < 4; ++e) v[e] = a[e] * sigmoidf_(a[e]) * b[e];
                *(u32x2*)(rp + n * 16) = pack4(v); } }
    }
};
struct EpiGlu {
    static constexpr bool PERM = false;
    bf16* Y; int ldc;
    __device__ __forceinline__ void operator()(const acc_t& acc, const Unit& u, int wr, int wc, int fr, int fq) const {
#pragma unroll
        EPI_LOOP_ROWS { bf16* rp = Y + (size_t)EPI_ROW * ldc + u.pn * BM;
#pragma unroll
            EPI_LOOP_COLS { const f32x4 y = unpack4(*(const u32x2*)(rp + EPI_COLT)); f32x4 v = acc[ai][bj][m][n];
#pragma unroll
                for (int e = 0; e < 4; ++e) v[e] = y[e] * sigmoidf_(v[e]);
                *(u32x2*)(rp + EPI_COLT) = pack4(v); } }
    }
};
struct EpiMoeDown {
    static constexpr bool PERM = false;
    float* x; const int* slot_tok; const float* slot_gate;
    __device__ __forceinline__ void operator()(const acc_t& acc, const Unit& u, int wr, int wc, int fr, int fq) const {
        const int ct = (u.pn & 3) * BM;
#pragma unroll
        EPI_LOOP_ROWS { const int row = EPI_ROW; const int tok = slot_tok[row];
            if (tok >= 0) { const float gt = slot_gate[row]; float* rp = x + (size_t)tok * D + ct;
#pragma unroll
                EPI_LOOP_COLS { const f32x4 v = acc[ai][bj][m][n] * gt; float* p = rp + EPI_COLT;
#pragma unroll
                    for (int e = 0; e < 4; ++e) __hip_atomic_fetch_add(p + e, v[e], __ATOMIC_RELAXED, __HIP_MEMORY_SCOPE_AGENT); } } }
    }
};
}
namespace att {
constexpr int MODE_FOX = 0, MODE_MLA = 1, MODE_BAND = 2;
constexpr float LOG2E = 1.4426950408889634f;
struct Tensors {
    const bf16* Q; int ldq;
    const bf16* K; int ldk;
    const bf16* K2;
    const bf16* V; int ldv;
    bf16* O; int ldo;
    const float* cdec;
    const float* relb;
    int qhs, khs, vhs, ohs;
};
template <int DQK> struct Lay { static constexpr int KS = DQK * 2 + 16, KB = 64 * KS, VB = 64 * 128, CB = 256, BUF = KB + VB + CB; };
constexpr int ATT_LDS_TAB = 2 * Lay<96>::BUF;
constexpr int ATT_LDS_BYTES = ATT_LDS_TAB + 520 * 4;
__device__ __forceinline__ int crow(int r, int hi) { return (r & 3) + 8 * (r >> 2) + 4 * hi; }
typedef short v4i16_t __attribute__((ext_vector_type(4)));
__device__ __forceinline__ s16x4 vtr(const LAS unsigned char* p) { return __builtin_bit_cast(s16x4, __builtin_amdgcn_ds_read_tr16_b64_v4i16((LAS v4i16_t*)p)); }

template <int MODE>
__device__ __forceinline__ void attn_unit(const Tensors& T, int b, int h, int qb, LAS unsigned char* lds) {
    constexpr int DQK = (MODE == MODE_MLA) ? 96 : 64, NKS = DQK / 16;
    typedef Lay<DQK> LY;
    int tid = threadIdx.x; asm volatile("" : "+v"(tid));
    const int lane = tid & 63, r32 = lane & 31, hi = lane >> 5; const int wid = __builtin_amdgcn_readfirstlane(tid >> 6);
    const int rowb = b * SEQ, q0 = qb * 256;
    const float sc2 = ((MODE == MODE_MLA) ? 0.10206207261596575f : 0.125f) * LOG2E;
    const int cw = 4 * qb + (wid >> 1);
    const int t_lo = (MODE == MODE_BAND) ? ((4 * qb - 8) > 0 ? (4 * qb - 8) : 0) : 0, t_hi = 4 * qb + 4;
    const int qrow = rowb + q0 + wid * 32 + r32;
    bf16x8 qf[NKS];
    { const bf16* qp = T.Q + (size_t)qrow * T.ldq + h * T.qhs + hi * 8;
#pragma unroll
      for (int ks = 0; ks < NKS; ++ks) qf[ks] = *(const bf16x8*)(qp + ks * 16); }
    float cq = 0.f; if (MODE == MODE_FOX) cq = T.cdec[(size_t)qrow * 4 + h];
    LAS float* tab = (LAS float*)(lds + ATT_LDS_TAB);
    if (MODE == MODE_BAND) { for (int i = tid; i < 513; i += NTHREADS) tab[i] = T.relb[h * 513 + i] * LOG2E; }
    u32x4 kreg0 = {}, kreg1 = {}, vreg = {}; float creg = 0.f;
    const int srow = tid >> 3, sch = tid & 7;
#define ATT_KADDR(c_) (((c_) % 12 < 8) ? (const u32x4*)(T.K + (kr_ + (c_) / 12) * T.ldk + h * T.khs + ((c_) % 12) * 8) : (const u32x4*)(T.K2 + (kr_ + (c_) / 12) * 32 + ((c_) % 12 - 8) * 8))
#define ATT_LOAD_TILE(t_) do { const size_t kr_ = (size_t)(rowb + (t_) * 64); \
        if (MODE == MODE_MLA) { kreg0 = *ATT_KADDR(tid); if (tid < 256) kreg1 = *ATT_KADDR(tid + 512); } \
        else { kreg0 = *(const u32x4*)(T.K + (kr_ + srow) * T.ldk + h * T.khs + sch * 8); } \
        vreg = *(const u32x4*)(T.V + (kr_ + srow) * T.ldv + h * T.vhs + sch * 8); \
        if (MODE == MODE_FOX) { if (tid < 64) creg = T.cdec[(kr_ + tid) * 4 + h]; } } while (0)
#define ATT_STORE_TILE(buf_) do { LAS unsigned char* base_ = lds + (buf_) * LY::BUF; \
        if (MODE == MODE_MLA) { *(LAS u32x4*)(base_ + (tid / 12) * LY::KS + (tid % 12) * 16) = kreg0; \
            if (tid < 256) *(LAS u32x4*)(base_ + ((tid + 512) / 12) * LY::KS + ((tid + 512) % 12) * 16) = kreg1; } \
        else { *(LAS u32x4*)(base_ + srow * LY::KS + sch * 16) = kreg0; } \
        *(LAS u32x4*)(base_ + LY::KB + srow * 128 + ((sch * 16) ^ (((srow >> 1) & 1) << 6))) = vreg; \
        if (MODE == MODE_FOX) { if (tid < 64) *(LAS float*)(base_ + LY::KB + LY::VB + tid * 4) = creg; } } while (0)
    float mrun = -INFINITY, lrun = 0.f;
    f32x16 o0 = {}, o1 = {};
    const int G = lane >> 4, qi = (lane & 15) >> 2, pi = lane & 3;
    const int vb0 = (4 * hi + qi) * 128 + 64 * (0 ^ (qi >> 1)) + 32 * (G & 1) + 8 * pi;
    const int vb1 = (4 * hi + qi) * 128 + 64 * (1 ^ (qi >> 1)) + 32 * (G & 1) + 8 * pi;
    ATT_LOAD_TILE(t_lo); ATT_STORE_TILE(0); __syncthreads();
    for (int t = t_lo; t < t_hi; ++t) {
        const int buf = (t - t_lo) & 1;
        if (t + 1 < t_hi) ATT_LOAD_TILE(t + 1);
        const bool active = (MODE == MODE_BAND) ? (t <= cw && t >= cw - 8) : (t <= cw);
        if (active) {
            const LAS unsigned char* kb = lds + buf * LY::BUF;
            const LAS unsigned char* vbuf = kb + LY::KB;
            f32x16 p0 = {}, p1 = {};
#pragma unroll
            for (int ks = 0; ks < NKS; ++ks) {
                const bf16x8 a0 = *(const LAS bf16x8*)(kb + r32 * LY::KS + (ks * 16 + hi * 8) * 2);
                const bf16x8 a1 = *(const LAS bf16x8*)(kb + (32 + r32) * LY::KS + (ks * 16 + hi * 8) * 2);
                p0 = __builtin_amdgcn_mfma_f32_32x32x16_bf16(a0, qf[ks], p0, 0, 0, 0);
                p1 = __builtin_amdgcn_mfma_f32_32x32x16_bf16(a1, qf[ks], p1, 0, 0, 0);
            }
            if (MODE == MODE_FOX) {
                const LAS float* cb = (const LAS float*)(vbuf + LY::VB);
                const float cq2 = cq * LOG2E;
#pragma unroll
                for (int a = 0; a < 4; ++a) {
                    const f32x4 c0 = *(const LAS f32x4*)(cb + 8 * a + 4 * hi), c1 = *(const LAS f32x4*)(cb + 32 + 8 * a + 4 * hi);
#pragma unroll
                    for (int e = 0; e < 4; ++e) { p0[4 * a + e] = p0[4 * a + e] * sc2 + (cq2 - c0[e] * LOG2E); p1[4 * a + e] = p1[4 * a + e] * sc2 + (cq2 - c1[e] * LOG2E); }
                }
                if (t == cw) { const int ql = 32 * (wid & 1) + r32;
#pragma unroll
                    for (int r = 0; r < 16; ++r) { const int kv = crow(r, hi); if (kv > ql) p0[r] = -INFINITY; if (kv + 32 > ql) p1[r] = -INFINITY; } }
            } else if (MODE == MODE_BAND) {
                const int dq = (q0 + wid * 32 + r32) - t * 64;
#pragma unroll
                for (int r = 0; r < 16; ++r) { const int kv = crow(r, hi);
                    int i0 = dq - kv, i1 = dq - kv - 32; i0 = i0 < -256 ? -256 : (i0 > 256 ? 256 : i0); i1 = i1 < -256 ? -256 : (i1 > 256 ? 256 : i1);
                    p0[r] = p0[r] * sc2 + tab[i0 + 256]; p1[r] = p1[r] * sc2 + tab[i1 + 256]; }
            } else {
#pragma unroll
                for (int r = 0; r < 16; ++r) { p0[r] *= sc2; p1[r] *= sc2; }
            }
            float mx = fmaxf(p0[0], p1[0]);
#pragma unroll
            for (int r = 1; r < 16; ++r) mx = fmaxf(mx, fmaxf(p0[r], p1[r]));
            { auto rr = __builtin_amdgcn_permlane32_swap(__float_as_uint(mx), __float_as_uint(mx), false, false); mx = fmaxf(__uint_as_float(rr[0]), __uint_as_float(rr[1])); }
            const float mnew = fmaxf(mrun, mx);
            if (__any(mnew > mrun)) {
                const float alpha = __builtin_amdgcn_exp2f(mrun - mnew);
                lrun *= alpha;
#pragma unroll
                for (int r = 0; r < 16; ++r) { o0[r] *= alpha; o1[r] *= alpha; }
                mrun = mnew;
            }
            float rs = 0.f;
#pragma unroll
            for (int r = 0; r < 16; ++r) { p0[r] = __builtin_amdgcn_exp2f(p0[r] - mrun); p1[r] = __builtin_amdgcn_exp2f(p1[r] - mrun); rs += p0[r] + p1[r]; }
            lrun += rs;
#pragma unroll
            for (int s4 = 0; s4 < 4; ++s4) {
                u32x4 pw;
                if (s4 < 2) { const int o = 8 * (s4 & 1); pw.x = pk2(p0[o], p0[o + 1]); pw.y = pk2(p0[o + 2], p0[o + 3]); pw.z = pk2(p0[o + 4], p0[o + 5]); pw.w = pk2(p0[o + 6], p0[o + 7]); }
                else        { const int o = 8 * (s4 & 1); pw.x = pk2(p1[o], p1[o + 1]); pw.y = pk2(p1[o + 2], p1[o + 3]); pw.z = pk2(p1[o + 4], p1[o + 5]); pw.w = pk2(p1[o + 6], p1[o + 7]); }
                const bf16x8 pf = __builtin_bit_cast(bf16x8, pw);
                const s16x4 l0 = vtr(vbuf + vb0 + s4 * 2048), h0 = vtr(vbuf + vb0 + s4 * 2048 + 1024);
                const s16x4 l1 = vtr(vbuf + vb1 + s4 * 2048), h1 = vtr(vbuf + vb1 + s4 * 2048 + 1024);
                const bf16x8 vf0 = (bf16x8){l0[0], l0[1], l0[2], l0[3], h0[0], h0[1], h0[2], h0[3]};
                const bf16x8 vf1 = (bf16x8){l1[0], l1[1], l1[2], l1[3], h1[0], h1[1], h1[2], h1[3]};
                o0 = __builtin_amdgcn_mfma_f32_32x32x16_bf16(vf0, pf, o0, 0, 0, 0);
                o1 = __builtin_amdgcn_mfma_f32_32x32x16_bf16(vf1, pf, o1, 0, 0, 0);
            }
        }
        if (t + 1 < t_hi) ATT_STORE_TILE(buf ^ 1);
        __syncthreads();
    }
    { auto rr = __builtin_amdgcn_permlane32_swap(__float_as_uint(lrun), __float_as_uint(lrun), false, false); lrun = __uint_as_float(rr[0]) + __uint_as_float(rr[1]); }
    const float inv = 1.0f / lrun;
    bf16* op = T.O + (size_t)qrow * T.ldo + h * T.ohs;
#pragma unroll
    for (int a = 0; a < 4; ++a) {
        u32x2 w0, w1;
        w0.x = pk2(o0[4 * a] * inv, o0[4 * a + 1] * inv); w0.y = pk2(o0[4 * a + 2] * inv, o0[4 * a + 3] * inv);
        w1.x = pk2(o1[4 * a] * inv, o1[4 * a + 1] * inv); w1.y = pk2(o1[4 * a + 2] * inv, o1[4 * a + 3] * inv);
        *(u32x2*)(op + 8 * a + 4 * hi) = w0; *(u32x2*)(op + 32 + 8 * a + 4 * hi) = w1;
    }
}

template <int MODE>
__device__ __forceinline__ void attn_phase(const Tensors& T, LAS unsigned char* lds) {
    const int G = gridDim.x, bx = blockIdx.x, vcu = (G % 8 == 0) ? (bx % 8) * (G / 8) + bx / 8 : bx;
    for (int pr = vcu; pr < 256; pr += G) {
        const int bh = pr >> 4, s = pr & 15;
        attn_unit<MODE>(T, bh >> 2, bh & 3, s, lds);
        attn_unit<MODE>(T, bh >> 2, bh & 3, 31 - s, lds);
    }
}

template <int MODE>
__device__ __forceinline__ void attn_naive(const Tensors& T) {
    BODY_IDS();
    constexpr int DQK = (MODE == MODE_MLA) ? 96 : 64;
    const float sc = (MODE == MODE_MLA) ? 0.10206207261596575f : 0.125f;
    for (int idx = gtid; idx < NTOK * 4; idx += gthreads) {
        const int h = idx / NTOK, row = idx % NTOK, b = row / SEQ, tpos = row % SEQ, rowb = b * SEQ;
        float q[DQK], o[64];
#pragma unroll
        for (int d = 0; d < DQK; ++d) q[d] = bf2f(T.Q[(size_t)row * T.ldq + h * T.qhs + d]) * sc;
#pragma unroll
        for (int d = 0; d < 64; ++d) o[d] = 0.f;
        float m = -INFINITY, l = 0.f;
        const int ck = tpos / 64;
        const int k_lo = (MODE == MODE_BAND) ? ((ck - 8) > 0 ? (ck - 8) * 64 : 0) : 0;
        const int k_hi = (MODE == MODE_FOX) ? tpos : (ck * 64 + 63);
        const float cq = (MODE == MODE_FOX) ? T.cdec[(size_t)row * 4 + h] : 0.f;
        for (int kv = k_lo; kv <= k_hi; ++kv) {
            const size_t kr = (size_t)(rowb + kv);
            float s = 0.f;
#pragma unroll
            for (int d8 = 0; d8 < 8; ++d8) { const u32x4 w = *(const u32x4*)(T.K + kr * T.ldk + h * T.khs + d8 * 8);
                s += q[d8 * 8 + 0] * bflo(w.x) + q[d8 * 8 + 1] * bfhi(w.x) + q[d8 * 8 + 2] * bflo(w.y) + q[d8 * 8 + 3] * bfhi(w.y)
                   + q[d8 * 8 + 4] * bflo(w.z) + q[d8 * 8 + 5] * bfhi(w.z) + q[d8 * 8 + 6] * bflo(w.w) + q[d8 * 8 + 7] * bfhi(w.w); }
            if (MODE == MODE_MLA) {
#pragma unroll
                for (int d8 = 0; d8 < 4; ++d8) { const u32x4 w = *(const u32x4*)(T.K2 + kr * 32 + d8 * 8);
                    s += q[64 + d8 * 8 + 0] * bflo(w.x) + q[64 + d8 * 8 + 1] * bfhi(w.x) + q[64 + d8 * 8 + 2] * bflo(w.y) + q[64 + d8 * 8 + 3] * bfhi(w.y)
                       + q[64 + d8 * 8 + 4] * bflo(w.z) + q[64 + d8 * 8 + 5] * bfhi(w.z) + q[64 + d8 * 8 + 6] * bflo(w.w) + q[64 + d8 * 8 + 7] * bfhi(w.w); }
            }
            if (MODE == MODE_FOX) s += cq - T.cdec[kr * 4 + h];
            if (MODE == MODE_BAND) { int rel = tpos - kv; rel = rel < -256 ? -256 : (rel > 256 ? 256 : rel); s += T.relb[h * 513 + rel + 256]; }
            const float mn = fmaxf(m, s), al = __expf(m - mn), pp = __expf(s - mn);
            l = l * al + pp; m = mn;
#pragma unroll
            for (int d8 = 0; d8 < 8; ++d8) { const u32x4 w = *(const u32x4*)(T.V + kr * T.ldv + h * T.vhs + d8 * 8);
                o[d8 * 8 + 0] = o[d8 * 8 + 0] * al + pp * bflo(w.x); o[d8 * 8 + 1] = o[d8 * 8 + 1] * al + pp * bfhi(w.x);
                o[d8 * 8 + 2] = o[d8 * 8 + 2] * al + pp * bflo(w.y); o[d8 * 8 + 3] = o[d8 * 8 + 3] * al + pp * bfhi(w.y);
                o[d8 * 8 + 4] = o[d8 * 8 + 4] * al + pp * bflo(w.z); o[d8 * 8 + 5] = o[d8 * 8 + 5] * al + pp * bfhi(w.z);
                o[d8 * 8 + 6] = o[d8 * 8 + 6] * al + pp * bflo(w.w); o[d8 * 8 + 7] = o[d8 * 8 + 7] * al + pp * bfhi(w.w); }
        }
        const float inv = 1.0f / l;
#pragma unroll
        for (int d = 0; d < 64; d += 2) *(unsigned*)(T.O + (size_t)row * T.ldo + h * T.ohs + d) = pk2(o[d] * inv, o[d + 1] * inv);
    }
}
}
struct Params {
    const float* in[37];
    float* out;
    unsigned char* ws;
    int ph_lo, ph_hi;
};
enum { I_X = 0, I_P, I_POS, I_WIN, I_SAR, I_SAI, I_SLDT, I_SBR, I_SBI, I_SCR, I_SCI, I_SD, I_SGLU, I_FBF, I_GQ, I_WUQ, I_GKV, I_WUKV, I_RELB, I_WB, I_WG, I_BG, I_WO,
       I_GMIX, I_GFFN, I_FW1, I_FW3, I_FW2, I_MWR, I_MBR, I_MW1, I_MW3, I_MW2, I_GPLE, I_PWG, I_PWU, I_GFIN };

__device__ __forceinline__ void sincos_rad(double a, float& s, float& c) {
    double r = a * 0.15915494309189535; r = r - __builtin_rint(r); const float f = (float)r;
    s = __builtin_amdgcn_sinf(f); c = __builtin_amdgcn_cosf(f);
}
__device__ __forceinline__ float gelu_tanh(float x) {
    const float z = 0.7978845608028654f * (x + 0.044715f * x * x * x);
    const float e = __expf(2.0f * z); const float th = 1.0f - 2.0f / (1.0f + e);
    return 0.5f * x * (1.0f + th);
}
__device__ __forceinline__ float log_sigmoid(float z) { return fminf(z, 0.f) - log1pf(__expf(-fabsf(z))); }

struct CvtJob { const float* src; const float* ks; bf16* dst; int K, ldsrc, col0, ncols, row0, ldk, ilv; };
__device__ __forceinline__ void cvt_item(const CvtJob& J, LAS float* scr, int item, int lane) {
    const int nblk = J.ncols / 32, kb = item / nblk, nb = item % nblk, k0 = 64 * kb, n0 = 32 * nb;
#pragma unroll 8
    for (int i = 0; i < 32; ++i) { const int kk = 2 * i + (lane >> 5); float v = J.src[(size_t)(k0 + kk) * J.ldsrc + J.col0 + n0 + (lane & 31)]; if (J.ks) v *= J.ks[k0 + kk]; scr[kk * 33 + (lane & 31)] = v; }
    LDS_WAIT(); asm volatile("" ::: "memory");
    const int c = lane & 7;
#pragma unroll
    for (int j = 0; j < 4; ++j) { const int n = (lane >> 3) + 8 * j; const LAS float* s = scr + (8 * c) * 33 + n;
        u32x4 o; o.x = pk2(s[0 * 33], s[1 * 33]); o.y = pk2(s[2 * 33], s[3 * 33]); o.z = pk2(s[4 * 33], s[5 * 33]); o.w = pk2(s[6 * 33], s[7 * 33]);
        const int nn = n0 + n; const int row = J.row0 + (J.ilv ? ((nn >> 7) * 256 + (nn & 127)) : nn);
        *(u32x4*)(J.dst + (size_t)row * J.ldk + k0 + 8 * c) = o; }
    LDS_WAIT(); asm volatile("" ::: "memory");
}
__device__ __forceinline__ bf16* wmix(const Params& P, int L, size_t off) { return (bf16*)(P.ws + WS_WMIX + (size_t)L * WMIX_STRIDE + off); }
__device__ __forceinline__ CvtJob get_job(const Params& P, int j) {
    CvtJob J; J.ks = nullptr; J.ilv = 0; J.col0 = 0; J.row0 = 0;
    if (j < 40) {
        const int L = j / 20, q = j % 20;
        if (q < 5) {
            J.src = P.in[I_WIN] + (size_t)L * D * DIN; J.K = D; J.ldsrc = DIN; J.dst = wmix(P, L, WM_IN); J.ldk = D;
            J.col0 = q == 0 ? 0 : q == 1 ? 1380 : q == 2 ? 1028 : q == 3 ? 1220 : 1348;
            J.ncols = q == 0 ? 1024 : q == 1 ? 768 : q == 2 ? 192 : q == 3 ? 128 : 32;
            J.row0 = q == 0 ? 0 : q == 1 ? 1024 : q == 2 ? 1792 : q == 3 ? 2048 : 2176;
        } else if (q < 9) { const int k = q - 5; J.src = P.in[I_WG] + ((size_t)L * 4 + k) * D * D; J.K = D; J.ldsrc = D; J.ncols = D; J.row0 = k * D; J.dst = wmix(P, L, WM_G); J.ldk = D;
        } else if (q < 13) { const int k = q - 9; J.src = P.in[I_WB] + ((size_t)L * 4 + k) * 256 * D; J.K = 256; J.ldsrc = D; J.ncols = D; J.row0 = k * D; J.dst = wmix(P, L, WM_B); J.ldk = 256;
        } else if (q == 13) { J.src = P.in[I_WO] + (size_t)L * D * D; J.K = D; J.ldsrc = D; J.ncols = D; J.dst = wmix(P, L, WM_O); J.ldk = D;
        } else if (q == 14) { J.src = P.in[I_PWG] + (size_t)L * D * D; J.K = D; J.ldsrc = D; J.ncols = D; J.dst = wmix(P, L, WM_PG); J.ldk = D;
        } else if (q == 15) { J.src = P.in[I_PWU] + (size_t)L * 256 * D; J.K = 256; J.ldsrc = D; J.ncols = D; J.dst = wmix(P, L, WM_UP); J.ldk = 256;
        } else if (q == 16) { J.src = P.in[I_WUQ] + (size_t)L * 192 * 384; J.ks = P.in[I_GQ] + L * 192; J.K = 192; J.ldsrc = 384; J.ncols = 384; J.dst = wmix(P, L, WM_UQ); J.ldk = 256;
        } else if (q == 17) { J.src = P.in[I_WUKV] + (size_t)L * 128 * 512; J.ks = P.in[I_GKV] + L * 128; J.K = 128; J.ldsrc = 512; J.ncols = 512; J.dst = wmix(P, L, WM_UKV); J.ldk = 128;
        } else if (q == 18) { J.src = P.in[I_SGLU] + (size_t)L * 256 * 256; J.K = 256; J.ldsrc = 256; J.ncols = 256; J.dst = wmix(P, L, WM_GLU); J.ldk = 256;
        } else { J.src = nullptr; J.K = 0; J.ldsrc = 0; J.ncols = 32; J.dst = nullptr; J.ldk = 0; }
    } else if (j < 43) {
        const int q = j - 40;
        if (q == 0) { J.src = P.in[I_FW1]; J.K = D; J.ldsrc = DFF; J.ncols = DFF; J.dst = (bf16*)(P.ws + WS_W13); J.ldk = D; J.ilv = 1; }
        else if (q == 1) { J.src = P.in[I_FW3]; J.K = D; J.ldsrc = DFF; J.ncols = DFF; J.row0 = 128; J.dst = (bf16*)(P.ws + WS_W13); J.ldk = D; J.ilv = 1; }
        else { J.src = P.in[I_FW2]; J.K = DFF; J.ldsrc = D; J.ncols = D; J.dst = (bf16*)(P.ws + WS_W2); J.ldk = DFF; }
    } else {
        const int e = (j - 43) / 3, q = (j - 43) % 3;
        if (q == 0) { J.src = P.in[I_MW1] + (size_t)e * D * DFFE; J.K = D; J.ldsrc = DFFE; J.ncols = DFFE; J.row0 = e * 2816; J.dst = (bf16*)(P.ws + WS_WM13); J.ldk = D; J.ilv = 1; }
        else if (q == 1) { J.src = P.in[I_MW3] + (size_t)e * D * DFFE; J.K = D; J.ldsrc = DFFE; J.ncols = DFFE; J.row0 = e * 2816 + 128; J.dst = (bf16*)(P.ws + WS_WM13); J.ldk = D; J.ilv = 1; }
        else { J.src = P.in[I_MW2] + (size_t)e * DFFE * D; J.K = DFFE; J.ldsrc = D; J.ncols = D; J.row0 = e * D; J.dst = (bf16*)(P.ws + WS_WM2); J.ldk = DFFE; }
    }
    return J;
}
__device__ __forceinline__ void cvt_jobs(const Params& P, int j_lo, int j_hi, LAS unsigned char* lds) {
    BODY_IDS();
    LAS float* scr = (LAS float*)(lds + wave * 8704);
    int acc = 0;
    for (int j = j_lo; j < j_hi; ++j) {
        const CvtJob J = get_job(P, j);
        const int items = (J.K / 64) * (J.ncols / 32);
        int first = (gw - (acc % ngw) + ngw) % ngw;
        for (int it = first; it < items; it += ngw) cvt_item(J, scr, it, lane);
        acc += items;
    }
}

__device__ __forceinline__ void p0_misc(const Params& P) {
    BODY_IDS();
    { const f32x4* src = (const f32x4*)P.in[I_P]; u32x2* dst = (u32x2*)(P.ws + WS_PBF);
      for (int i = gtid; i < 2 * NTOK * 256 / 4; i += gthreads) { const f32x4 v = src[i]; u32x2 w; w.x = pk2(v[0], v[1]); w.y = pk2(v[2], v[3]); dst[i] = w; } }
    { const int* pos = (const int*)P.in[I_POS]; float* ct = (float*)(P.ws + WS_COS); float* st = (float*)(P.ws + WS_SIN);
      const double invf[16] = {1.0, 0.5623413251903491, 0.31622776601683794, 0.1778279410038923, 0.1, 0.05623413251903491, 0.03162277660168379, 0.01778279410038923,
                               0.01, 0.005623413251903491, 0.0031622776601683794, 0.0017782794100389228, 0.001, 0.0005623413251903491, 0.00031622776601683794, 0.00017782794100389227};
      for (int i = gtid; i < NTOK * 16; i += gthreads) { const int row = i >> 4, f = i & 15; double iv = invf[0];
#pragma unroll
          for (int q = 1; q < 16; ++q) iv = (f == q) ? invf[q] : iv;
          const float ang = (float)pos[row] * (float)iv; float s, c; sincos_rad((double)ang, s, c); ct[i] = c; st[i] = s; } }
    for (int L = 0; L < 2; ++L) {
        bf16* win = wmix(P, L, WM_IN);
        for (int i = gtid; i < (64 + 96) * D / 8; i += gthreads) { const int e = i * 8, r = e / D, k = e % D; const int row = r < 64 ? 1984 + r : 2208 + (r - 64); *(u32x4*)(win + (size_t)row * D + k) = (u32x4){0u, 0u, 0u, 0u}; }
        bf16* wuq = wmix(P, L, WM_UQ);
        for (int i = gtid; i < 512 * 256 / 8; i += gthreads) { const int e = i * 8, r = e / 256, k = e % 256; if (r >= 384 || k >= 192) *(u32x4*)(wuq + e) = (u32x4){0u, 0u, 0u, 0u}; }
    }
}

__device__ __forceinline__ void rms_row(const float* xrow, const float* gain, bf16* orow, int lane, f32x4 (&v)[4]) {
    const f32x4* xr = (const f32x4*)xrow + lane; float s = 0.f;
#pragma unroll
    for (int j = 0; j < 4; ++j) { v[j] = xr[64 * j]; s += (v[j][0] * v[j][0] + v[j][1] * v[j][1]) + (v[j][2] * v[j][2] + v[j][3] * v[j][3]); }
    const float rstd = 1.0f / sqrtf(wave_sum(s) * (1.0f / D) + RMS_EPS);
    const f32x4* gr = (const f32x4*)gain + lane;
    u32x2* o8 = (u32x2*)orow + lane;
#pragma unroll
    for (int j = 0; j < 4; ++j) { v[j] = v[j] * rstd * gr[64 * j]; u32x2 w; w.x = pk2(v[j][0], v[j][1]); w.y = pk2(v[j][2], v[j][3]); o8[64 * j] = w; }
}
__device__ __forceinline__ void norm_plain(const float* x, const float* gain, bf16* H) {
    BODY_IDS();
    for (int row = gw; row < NTOK; row += ngw) { f32x4 v[4]; rms_row(x + (size_t)row * D, gain, H + (size_t)row * D, lane, v); }
}
__device__ __forceinline__ void norm1_phase(const Params& P, int L, const float* x, LAS unsigned char* lds) {
    BODY_IDS();
    LAS f32x4* wff = (LAS f32x4*)lds;
    const float* win = P.in[I_WIN] + (size_t)L * D * DIN;
    for (int k = tid; k < D; k += NTHREADS) wff[k] = *(const f32x4*)(win + (size_t)k * DIN + 1024);
    __syncthreads();
    const float* gain = P.in[I_GMIX] + L * D; bf16* H = (bf16*)(P.ws + WS_H);
    float* logf = (float*)(P.ws + WS_LOGF); float* wsum = (float*)(P.ws + WS_WSUM);
    const f32x4 bf = *(const f32x4*)(P.in[I_FBF] + L * 4);
    for (int g0 = gw; g0 < NTOK / 16; g0 += ngw) {
        f32x4 run = {0.f, 0.f, 0.f, 0.f};
        for (int i = 0; i < 16; ++i) { const int row = g0 * 16 + i; f32x4 v[4]; rms_row(x + (size_t)row * D, gain, H + (size_t)row * D, lane, v);
            f32x4 d = {0.f, 0.f, 0.f, 0.f};
#pragma unroll
            for (int j = 0; j < 4; ++j)
#pragma unroll
                for (int e = 0; e < 4; ++e) d += wff[4 * lane + 256 * j + e] * v[j][e];
#pragma unroll
            for (int e = 0; e < 4; ++e) { d[e] = wave_sum(d[e]); run[e] += log_sigmoid(d[e] + bf[e]); }
            if (lane == 0) *(f32x4*)(logf + (size_t)row * 4) = run; }
        if (lane == 0) *(f32x4*)(wsum + (size_t)g0 * 4) = run;
    }
    __syncthreads();
}
__device__ __forceinline__ void prep_phase(const Params& P) {
    BODY_IDS();
    const float* logf = (const float*)(P.ws + WS_LOGF); const float* wsum = (const float*)(P.ws + WS_WSUM); float* cdec = (float*)(P.ws + WS_CDEC);
    float* rq = (float*)(P.ws + WS_RSTDQ); float* rkv = (float*)(P.ws + WS_RSTDKV); const bf16* zin = (const bf16*)(P.ws + WS_ZIN); bf16* kper = (bf16*)(P.ws + WS_KPER);
    const float* ct = (const float*)(P.ws + WS_COS); const float* st = (const float*)(P.ws + WS_SIN);
    for (int g0 = gw; g0 < NTOK / 16; g0 += ngw) {
        const int first = (g0 / 512) * 512;
        f32x4 pre = {0.f, 0.f, 0.f, 0.f};
        for (int i = first + lane; i < g0; i += 64) pre += *(const f32x4*)(wsum + (size_t)i * 4);
#pragma unroll
        for (int e = 0; e < 4; ++e) pre[e] = wave_sum(pre[e]);
        if (lane < 16) { const int row = g0 * 16 + lane; *(f32x4*)(cdec + (size_t)row * 4) = *(const f32x4*)(logf + (size_t)row * 4) + pre; }
        for (int i = 0; i < 16; ++i) { const int row = g0 * 16 + i; const bf16* zr = zin + (size_t)row * ZP;
            const float a0 = bf2f(zr[ZC_CQ + lane]), a1 = bf2f(zr[ZC_CQ + 64 + lane]), a2 = bf2f(zr[ZC_CQ + 128 + lane]);
            const float b0 = bf2f(zr[ZC_CKV + lane]), b1 = bf2f(zr[ZC_CKV + 64 + lane]);
            const float sq = wave_sum(a0 * a0 + a1 * a1 + a2 * a2), skv = wave_sum(b0 * b0 + b1 * b1);
            if (lane == 0) { rq[row] = 1.0f / sqrtf(sq * (1.0f / 192.0f) + RMS_EPS); rkv[row] = 1.0f / sqrtf(skv * (1.0f / 128.0f) + RMS_EPS); }
            if (lane < 16) { const float t1 = bf2f(zr[ZC_KPE + lane]), t2 = bf2f(zr[ZC_KPE + 16 + lane]); const float c = ct[(size_t)row * 16 + lane], s = st[(size_t)row * 16 + lane];
                kper[(size_t)row * 32 + lane] = (bf16)f2bf(t1 * c - t2 * s); kper[(size_t)row * 32 + 16 + lane] = (bf16)f2bf(t2 * c + t1 * s); } }
    }
}
__device__ __forceinline__ void final_norm(const Params& P) {
    BODY_IDS();
    const f32x4* gr = (const f32x4*)P.in[I_GFIN] + lane;
    for (int row = gw; row < NTOK; row += ngw) {
        f32x4* xr = (f32x4*)(P.out + (size_t)row * D) + lane; f32x4 v[4]; float s = 0.f;
#pragma unroll
        for (int j = 0; j < 4; ++j) { v[j] = xr[64 * j]; s += (v[j][0] * v[j][0] + v[j][1] * v[j][1]) + (v[j][2] * v[j][2] + v[j][3] * v[j][3]); }
        const float rstd = 1.0f / sqrtf(wave_sum(s) * (1.0f / D) + RMS_EPS);
#pragma unroll
        for (int j = 0; j < 4; ++j) xr[64 * j] = v[j] * rstd * gr[64 * j];
    }
}

namespace s5 {
struct Coef { float abr, abi; float Br[16], Bi[16]; float a64r, a64i; };
__device__ __forceinline__ void coef(const Params& P, int L, int g, int p, Coef& C) {
    const float dt = __expf(P.in[I_SLDT][L * 16 + g]); const float ar = P.in[I_SAR][(L * 16 + g) * 64 + p], ai = P.in[I_SAI][(L * 16 + g) * 64 + p];
    const float mag = __expf(ar * dt); float sn, cs; sincos_rad((double)(ai * dt), sn, cs);
    C.abr = mag * cs; C.abi = mag * sn;
    const float den = ar * ar + ai * ai, nr = C.abr - 1.0f, ni = C.abi;
    const float cr = (nr * ar + ni * ai) / den, ci = (ni * ar - nr * ai) / den;
    const float* br = P.in[I_SBR] + ((size_t)(L * 16 + g) * 64 + p) * 16; const float* bi = P.in[I_SBI] + ((size_t)(L * 16 + g) * 64 + p) * 16;
#pragma unroll
    for (int h = 0; h < 16; ++h) { const float r = br[h], i = bi[h]; C.Br[h] = cr * r - ci * i; C.Bi[h] = cr * i + ci * r; }
    const float m64 = __expf(64.0f * ar * dt); float s64, c64; sincos_rad(64.0 * (double)(ai * dt), s64, c64);
    C.a64r = m64 * c64; C.a64i = m64 * s64;
}
constexpr int WAVE_LDS = 8448;
template <bool EMIT>
__device__ __forceinline__ void chunk(const Params& P, int L, int g, int row0, const Coef& C, float& xr, float& xi, LAS unsigned char* wl, int lane, const bf16x8 (&cf)[4], float dsk) {
    bf16* zin = (bf16*)(P.ws + WS_ZIN);
    LAS float* ut = (LAS float*)wl; LAS unsigned* xt = (LAS unsigned*)(wl + 4096);
    { const u32x4* up = (const u32x4*)(zin + (size_t)(row0 + lane) * ZP + ZC_U + g * 16); const u32x4 w0 = up[0], w1 = up[1];
      LAS f32x4* d = (LAS f32x4*)(ut + lane * 16);
      d[0] = (f32x4){bflo(w0.x), bfhi(w0.x), bflo(w0.y), bfhi(w0.y)}; d[1] = (f32x4){bflo(w0.z), bfhi(w0.z), bflo(w0.w), bfhi(w0.w)};
      d[2] = (f32x4){bflo(w1.x), bfhi(w1.x), bflo(w1.y), bfhi(w1.y)}; d[3] = (f32x4){bflo(w1.z), bfhi(w1.z), bflo(w1.w), bfhi(w1.w)}; }
    for (int tb = 0; tb < 4; ++tb) {
#pragma unroll 4
        for (int ti = 0; ti < 16; ++ti) {
            const LAS f32x4* up = (const LAS f32x4*)(ut + (tb * 16 + ti) * 16);
            float br = 0.f, bi = 0.f;
#pragma unroll
            for (int q = 0; q < 4; ++q) { const f32x4 u4 = up[q];
#pragma unroll
                for (int e = 0; e < 4; ++e) { br += C.Br[4 * q + e] * u4[e]; bi += C.Bi[4 * q + e] * u4[e]; } }
            const float nr = C.abr * xr - C.abi * xi + br, ni = C.abr * xi + C.abi * xr + bi; xr = nr; xi = ni;
            if (EMIT) xt[ti * 68 + lane] = pk2(xr, xi);
        }
        if (EMIT) {
            f32x4 dacc = {0.f, 0.f, 0.f, 0.f};
#pragma unroll
            for (int ks = 0; ks < 4; ++ks) { const bf16x8 a = *(const LAS bf16x8*)((const LAS unsigned char*)xt + (lane & 15) * 272 + (ks * 32 + (lane >> 4) * 8) * 2);
                dacc = __builtin_amdgcn_mfma_f32_16x16x32_bf16(a, cf[ks], dacc, 0, 0, 0); }
            const int hp = lane & 15;
#pragma unroll
            for (int i = 0; i < 4; ++i) { const int tok = tb * 16 + 4 * (lane >> 4) + i; const float y = dacc[i] + dsk * ut[tok * 16 + hp];
                zin[(size_t)(row0 + tok) * ZP + ZC_U + g * 16 + hp] = (bf16)f2bf(gelu_tanh(y)); }
        }
    }
}
template <int PASS>
__device__ __forceinline__ void phase(const Params& P, int L, LAS unsigned char* lds) {
    BODY_IDS();
    LAS unsigned char* wl = lds + wave * WAVE_LDS;
    f32x2* SC = (f32x2*)(P.ws + WS_SC);
    for (int w = gw; w < 2048; w += ngw) {
        const int bg = w >> 5, cg = w & 31, b = bg >> 4, g = bg & 15;
        Coef C; coef(P, L, g, lane, C);
        bf16x8 cf[4]; float dsk = 0.f;
        if (PASS == 1) {
            const int hp = lane & 15, kg = lane >> 4;
            const float* cre = P.in[I_SCR] + ((size_t)(L * 16 + g) * 16 + hp) * 64; const float* cim = P.in[I_SCI] + ((size_t)(L * 16 + g) * 16 + hp) * 64;
#pragma unroll
            for (int ks = 0; ks < 4; ++ks) { const int p0 = 16 * ks + 4 * kg; u32x4 wv;
                wv.x = pk2(cre[p0], -cim[p0]); wv.y = pk2(cre[p0 + 1], -cim[p0 + 1]); wv.z = pk2(cre[p0 + 2], -cim[p0 + 2]); wv.w = pk2(cre[p0 + 3], -cim[p0 + 3]);
                cf[ks] = __builtin_bit_cast(bf16x8, wv); }
            dsk = P.in[I_SD][(L * 16 + g) * 16 + hp];
        } else {
#pragma unroll
            for (int ks = 0; ks < 4; ++ks) cf[ks] = (bf16x8){0, 0, 0, 0, 0, 0, 0, 0};
        }
        float xr = 0.f, xi = 0.f;
        if (PASS == 1) {
            const f32x2* sp = SC + ((size_t)bg * 128) * 64 + lane;
            for (int c = 0; c < 4 * cg; ++c) { const f32x2 s = sp[(size_t)c * 64]; const float nr = C.a64r * xr - C.a64i * xi + s[0], ni = C.a64r * xi + C.a64i * xr + s[1]; xr = nr; xi = ni; }
        }
        for (int cc = 0; cc < 4; ++cc) {
            const int c = 4 * cg + cc, row0 = b * SEQ + c * 64;
            if (PASS == 0) { xr = 0.f; xi = 0.f; }
            chunk<PASS == 1>(P, L, g, row0, C, xr, xi, wl, lane, cf, dsk);
            if (PASS == 0) SC[((size_t)bg * 128 + c) * 64 + lane] = (f32x2){xr, xi};
        }
    }
}
__device__ __forceinline__ void naive(const Params& P, int L) {
    BODY_IDS();
    bf16* zin = (bf16*)(P.ws + WS_ZIN);
    for (int bg = gw; bg < 64; bg += ngw) {
        const int b = bg >> 4, g = bg & 15;
        Coef C; coef(P, L, g, lane, C);
        float cr[16], ci[16];
#pragma unroll
        for (int h = 0; h < 16; ++h) { cr[h] = P.in[I_SCR][((size_t)(L * 16 + g) * 16 + h) * 64 + lane]; ci[h] = P.in[I_SCI][((size_t)(L * 16 + g) * 16 + h) * 64 + lane]; }
        const float dsk = P.in[I_SD][(L * 16 + g) * 16 + (lane & 15)];
        float xr = 0.f, xi = 0.f;
        for (int t = 0; t < SEQ; ++t) {
            bf16* up = zin + (size_t)(b * SEQ + t) * ZP + ZC_U + g * 16;
            const u32x4 w0 = *(const u32x4*)up, w1 = *(const u32x4*)(up + 8);
            const float u[16] = {bflo(w0.x), bfhi(w0.x), bflo(w0.y), bfhi(w0.y), bflo(w0.z), bfhi(w0.z), bflo(w0.w), bfhi(w0.w),
                                 bflo(w1.x), bfhi(w1.x), bflo(w1.y), bfhi(w1.y), bflo(w1.z), bfhi(w1.z), bflo(w1.w), bfhi(w1.w)};
            float br = 0.f, bi = 0.f;
#pragma unroll
            for (int h = 0; h < 16; ++h) { br += C.Br[h] * u[h]; bi += C.Bi[h] * u[h]; }
            const float nr = C.abr * xr - C.abi * xi + br, ni = C.abr * xi + C.abi * xr + bi; xr = nr; xi = ni;
            float ymine = 0.f, umine = 0.f;
#pragma unroll
            for (int h = 0; h < 16; ++h) { const float s = wave_sum(xr * cr[h] - xi * ci[h]); if ((lane & 15) == h) { ymine = s; umine = u[h]; } }
            __builtin_amdgcn_s_waitcnt(0);
            if (lane < 16) up[lane] = (bf16)f2bf(gelu_tanh(ymine + dsk * umine));
        }
    }
}
}

__device__ __forceinline__ void norm2_moe_phase(const Params& P, const float* x, LAS unsigned char* lds) {
    BODY_IDS();
    LAS float* wr = (LAS float*)lds;
    LAS unsigned* lcnt = (LAS unsigned*)(lds + 32768); LAS unsigned* lbase = lcnt + 8;
    for (int i = tid; i < D * 8 / 4; i += NTHREADS) ((LAS f32x4*)wr)[i] = ((const f32x4*)P.in[I_MWR])[i];
    if (tid < 8) lcnt[tid] = 0u;
    __syncthreads();
    const float* gain = P.in[I_GFFN] + 1 * D; bf16* H = (bf16*)(P.ws + WS_H);
    unsigned* tokinfo = (unsigned*)(P.ws + WS_TOKINFO); unsigned* gcnt = (unsigned*)(P.ws + WS_CTL) + CW_MOECNT;
    const float* brt = P.in[I_MBR];
    for (int g0 = gw; g0 < NTOK / 16; g0 += ngw) {
        for (int i = 0; i < 16; ++i) { const int row = g0 * 16 + i; f32x4 v[4]; rms_row(x + (size_t)row * D, gain, H + (size_t)row * D, lane, v);
            float lg[8];
#pragma unroll
            for (int e = 0; e < 8; ++e) lg[e] = 0.f;
#pragma unroll
            for (int j = 0; j < 4; ++j)
#pragma unroll
                for (int q = 0; q < 4; ++q) { const int k = 4 * lane + 256 * j + q; const f32x4 w0 = *(const LAS f32x4*)(wr + k * 8), w1 = *(const LAS f32x4*)(wr + k * 8 + 4); const float hv = v[j][q];
                    lg[0] += hv * w0[0]; lg[1] += hv * w0[1]; lg[2] += hv * w0[2]; lg[3] += hv * w0[3]; lg[4] += hv * w1[0]; lg[5] += hv * w1[1]; lg[6] += hv * w1[2]; lg[7] += hv * w1[3]; }
#pragma unroll
            for (int e = 0; e < 8; ++e) lg[e] = wave_sum(lg[e]) + brt[e];
            int e0 = 0; float l0 = lg[0];
#pragma unroll
            for (int e = 1; e < 8; ++e) if (lg[e] > l0) { l0 = lg[e]; e0 = e; }
            int e1 = 0; float l1 = -INFINITY;
#pragma unroll
            for (int e = 0; e < 8; ++e) if (e != e0 && lg[e] > l1) { l1 = lg[e]; e1 = e; }
            const float ex = __expf(l1 - l0); const float ga = 1.0f / (1.0f + ex), gb = ex / (1.0f + ex);
            if (lane == 0) { const unsigned r0 = __hip_atomic_fetch_add(&lcnt[e0], 1u, __ATOMIC_RELAXED, __HIP_MEMORY_SCOPE_WORKGROUP), r1 = __hip_atomic_fetch_add(&lcnt[e1], 1u, __ATOMIC_RELAXED, __HIP_MEMORY_SCOPE_WORKGROUP);
                u32x4 a; a.x = (unsigned)e0; a.y = (unsigned)e1; a.z = r0; a.w = r1; u32x4 bq; bq.x = __float_as_uint(ga); bq.y = __float_as_uint(gb); bq.z = 0u; bq.w = 0u;
                *(u32x4*)(tokinfo + (size_t)row * 8) = a; *(u32x4*)(tokinfo + (size_t)row * 8 + 4) = bq; } }
    }
    __syncthreads();
    if (tid < 8) lbase[tid] = __hip_atomic_fetch_add(gcnt + tid, lcnt[tid], __ATOMIC_RELAXED, __HIP_MEMORY_SCOPE_AGENT);
    __syncthreads();
    for (int g0 = gw; g0 < NTOK / 16; g0 += ngw) {
        if (lane == 0) { for (int i = 0; i < 16; ++i) { const int row = g0 * 16 + i; u32x4 a = *(u32x4*)(tokinfo + (size_t)row * 8);
            unsigned b0 = 0, b1 = 0;
#pragma unroll
            for (int e = 0; e < 8; ++e) { const unsigned lb = lbase[e]; b0 = (a.x == (unsigned)e) ? lb : b0; b1 = (a.y == (unsigned)e) ? lb : b1; }
            a.z += b0; a.w += b1; *(u32x4*)(tokinfo + (size_t)row * 8) = a; } }
    }
    int* slot_tok = (int*)(P.ws + WS_SLOTTOK);
    for (int i = gtid; i < MOE_ROWS; i += gthreads) slot_tok[i] = -1;
    __syncthreads();
}
struct MoeLayout { int pstart[9]; };
__device__ __forceinline__ MoeLayout moe_layout(const Params& P) {
    const unsigned* gcnt = (const unsigned*)(P.ws + WS_CTL) + CW_MOECNT; MoeLayout Lo; int acc = 0;
#pragma unroll
    for (int e = 0; e < 8; ++e) { Lo.pstart[e] = acc; const int c = (int)__hip_atomic_load(gcnt + e, __ATOMIC_RELAXED, __HIP_MEMORY_SCOPE_AGENT); acc += (c + 255) / 256 * 256; }
    Lo.pstart[8] = acc; return Lo;
}
__device__ __forceinline__ void moe_assign_phase(const Params& P) {
    BODY_IDS();
    const MoeLayout Lo = moe_layout(P);
    const unsigned* tokinfo = (const unsigned*)(P.ws + WS_TOKINFO); int* slot_tok = (int*)(P.ws + WS_SLOTTOK); float* slot_gate = (float*)(P.ws + WS_SLOTGATE);
    for (int t = gtid; t < NTOK; t += gthreads) { const u32x4 a = *(const u32x4*)(tokinfo + (size_t)t * 8); const u32x2 g = *(const u32x2*)(tokinfo + (size_t)t * 8 + 4);
        int p0 = 0, p1 = 0;
#pragma unroll
        for (int e = 0; e < 8; ++e) { p0 = ((int)a.x == e) ? Lo.pstart[e] : p0; p1 = ((int)a.y == e) ? Lo.pstart[e] : p1; }
        const int s0 = p0 + (int)a.z, s1 = p1 + (int)a.w;
        slot_tok[s0] = t; slot_gate[s0] = __uint_as_float(g.x); slot_tok[s1] = t; slot_gate[s1] = __uint_as_float(g.y); }
}
struct MoeOrder {
    int pstart[9]; int ntile, ncol, G, c;
    __device__ __forceinline__ bool next(int i, pg8::Unit& u) const {
        const long Lf = (long)i * G + c; if (Lf >= (long)ntile * ncol) return false;
        const int rt = (int)(Lf / ncol), j = (int)(Lf % ncol); int e = 0;
#pragma unroll
        for (int q = 1; q < 8; ++q) e = (rt * 256 >= pstart[q]) ? q : e;
        u.pm = rt; u.pn = e * ncol + j; return true;
    }
};
__device__ __forceinline__ MoeOrder moe_order(const Params& P, int ncol, int G, int c) {
    const MoeLayout Lo = moe_layout(P); MoeOrder S;
#pragma unroll
    for (int e = 0; e < 9; ++e) S.pstart[e] = Lo.pstart[e];
    S.ntile = Lo.pstart[8] / 256; S.ncol = ncol; S.G = G; S.c = c; return S;
}
#ifndef REF_MASK
#define REF_MASK 0
#endif
#ifndef N_LAUNCH_MODE
#define N_LAUNCH_MODE 1
#endif
constexpr int LDS_BYTES = 147456;
constexpr int MISC_OFF = LDS_BYTES - 64;
constexpr int N_PHASES = 27;
#ifndef PHASE_SEL
#define PHASE_SEL 0xFFFFFFFu
#endif
#define PH_ON(b) (((PHASE_SEL) >> (b)) & 1u)
#ifndef SUB_SEL
#define SUB_SEL 0xFFu
#endif
#define SUB_ON(b) (((SUB_SEL) >> (b)) & 1u)

#define RUN_GEMM(EPI_T, SCHED_T, GATH, gm, sc, ep) do { if (REF_MASK & 1) pg8::gemm_phase_naive<EPI_T, SCHED_T, GATH>(gm, sc, ep); \
    else pg8::gemm_phase<EPI_T, SCHED_T, true, GATH>(lds, gm, sc, ep); } while (0)

__global__ void __launch_bounds__(NTHREADS, 2) mega_fwd(Params P) {
    extern __shared__ __attribute__((aligned(16))) unsigned char lds_raw[];
    LAS unsigned char* lds = (LAS unsigned char*)lds_raw;
    const int tid = threadIdx.x;
    const int G = gridDim.x, bx = blockIdx.x;
    unsigned* ctl = (unsigned*)(P.ws + WS_CTL);
    volatile LAS unsigned* misc = (volatile LAS unsigned*)(lds + MISC_OFF);
    if (tid < 16) misc[tid] = 0u;
    __syncthreads();
    const int lo = P.ph_lo, hi = P.ph_hi;
    XcdBarrier bar; bar.bar = ctl + CW_BAR; bar.x = 0; bar.st = misc;
    if (hi - lo > 1) bar = xcd_barrier_post(ctl + CW_BAR, misc);
#define IN(k) (lo <= (k) && (k) < hi)
#define SEAM(k) do { if (IN(k) && IN((k) + 1)) xcd_barrier(bar); } while (0)

#define H ((bf16*)(P.ws + WS_H))
#define ZIN ((bf16*)(P.ws + WS_ZIN))
#define GB ((bf16*)(P.ws + WS_G))
#define MB ((bf16*)(P.ws + WS_M))
#define MLAQ ((bf16*)(P.ws + WS_MLAQ))
#define MLAKV ((bf16*)(P.ws + WS_MLAKV))
#define KPER ((bf16*)(P.ws + WS_KPER))
#define cosT ((float*)(P.ws + WS_COS))
#define sinT ((float*)(P.ws + WS_SIN))
#define slot_tok ((int*)(P.ws + WS_SLOTTOK))
#define slot_gate ((float*)(P.ws + WS_SLOTGATE))

    if (PH_ON(0) && IN(0)) { cvt_jobs(P, 0, 43, lds); p0_misc(P); }
    SEAM(0);

    for (int L = 0; L < 2; ++L) {
        const int pb = 1 + 12 * L;
        const int pc = (L == 0) ? 9 : 22;
        const float* xsrc = (L == 0) ? P.in[I_X] : P.out;
        if (PH_ON(1) && IN(pb)) norm1_phase(P, L, xsrc, lds);
        SEAM(pb);
        if (PH_ON(2) && IN(pb + 1)) {
            pg8::Gemm g{H, wmix(P, L, WM_IN), D, D, D, nullptr}; pg8::StaticOrder S; S.init(NTOK, ZP, G, bx);
            epi::EpiStore E{ZIN, ZP, 0};
            RUN_GEMM(epi::EpiStore, pg8::StaticOrder, false, g, S, E);
        }
        SEAM(pb + 1);
        if (PH_ON(3) && IN(pb + 2)) {
            prep_phase(P);
            if (!(REF_MASK & 4)) s5::phase<0>(P, L, lds);
            __syncthreads();
        }
        SEAM(pb + 2);
        if (PH_ON(4) && IN(pb + 3)) {
            if (SUB_ON(0)) { pg8::Gemm g{ZIN + ZC_CQ, wmix(P, L, WM_UQ), ZP, 256, 256, nullptr}; pg8::StaticOrder S; S.init(NTOK, 512, G, bx);
              epi::EpiMlaQ E{MLAQ, (const float*)(P.ws + WS_RSTDQ), cosT, sinT};
              RUN_GEMM(epi::EpiMlaQ, pg8::StaticOrder, false, g, S, E); }
            if (SUB_ON(1)) { pg8::Gemm g{ZIN + ZC_CKV, wmix(P, L, WM_UKV), ZP, 128, 128, nullptr}; pg8::StaticOrder S; S.init(NTOK, 512, G, bx);
              epi::EpiRowScale E{MLAKV, 512, (const float*)(P.ws + WS_RSTDKV)};
              RUN_GEMM(epi::EpiRowScale, pg8::StaticOrder, false, g, S, E); }
            if (SUB_ON(2)) { if (REF_MASK & 4) s5::naive(P, L); else s5::phase<1>(P, L, lds); }
            __syncthreads();
            if (SUB_ON(3)) { att::Tensors T; T.Q = ZIN + ZC_FQ; T.ldq = ZP; T.K = ZIN + ZC_FK; T.ldk = ZP; T.K2 = nullptr; T.V = ZIN + ZC_FV; T.ldv = ZP; T.O = ZIN + ZC_FQ; T.ldo = ZP;
              T.cdec = (const float*)(P.ws + WS_CDEC); T.relb = nullptr; T.qhs = 64; T.khs = 64; T.vhs = 64; T.ohs = 64;
              if (REF_MASK & 2) att::attn_naive<att::MODE_FOX>(T); else att::attn_phase<att::MODE_FOX>(T, lds); }
            __syncthreads();
            if (SUB_ON(4)) { att::Tensors T; T.Q = ZIN + ZC_DQ; T.ldq = ZP; T.K = ZIN + ZC_DK; T.ldk = ZP; T.K2 = nullptr; T.V = ZIN + ZC_DV; T.ldv = ZP; T.O = ZIN + ZC_DQ; T.ldo = ZP;
              T.cdec = nullptr; T.relb = P.in[I_RELB] + (size_t)L * 4 * 513; T.qhs = 64; T.khs = 64; T.vhs = 64; T.ohs = 64;
              if (REF_MASK & 2) att::attn_naive<att::MODE_BAND>(T); else att::attn_phase<att::MODE_BAND>(T, lds); }
            __syncthreads();
        }
        SEAM(pb + 3);
        if (PH_ON(5) && IN(pb + 4)) {
            if (SUB_ON(0)) { att::Tensors T; T.Q = MLAQ; T.ldq = 512; T.K = MLAKV; T.ldk = 512; T.K2 = KPER; T.V = MLAKV + 64; T.ldv = 512; T.O = ZIN + ZC_CQ; T.ldo = ZP;
              T.cdec = nullptr; T.relb = nullptr; T.qhs = 96; T.khs = 128; T.vhs = 128; T.ohs = 64;
              if (REF_MASK & 2) att::attn_naive<att::MODE_MLA>(T); else att::attn_phase<att::MODE_MLA>(T, lds); }
            __syncthreads();
            if (SUB_ON(1)) { pg8::Gemm g{ZIN + ZC_U, wmix(P, L, WM_GLU), ZP, 256, 256, nullptr}; pg8::StaticOrder S; S.init(NTOK, 256, G, bx);
              epi::EpiGlu E{ZIN + ZC_U, ZP};
              RUN_GEMM(epi::EpiGlu, pg8::StaticOrder, false, g, S, E); }
        }
        SEAM(pb + 4);
        if (PH_ON(6) && IN(pb + 5)) {
            for (int k = 0; k < 4; ++k) {
                const int ycol = (k == 0) ? ZC_U : (k == 1) ? ZC_FQ : (k == 2) ? ZC_CQ : ZC_DQ;
                { pg8::Gemm g{H, wmix(P, L, WM_G) + (size_t)k * D * D, D, D, D, nullptr}; pg8::StaticOrder S; S.init(NTOK, D, G, bx);
                  epi::EpiGate E{GB, P.in[I_BG] + ((size_t)L * 4 + k) * D};
                  RUN_GEMM(epi::EpiGate, pg8::StaticOrder, false, g, S, E); }
                { pg8::Gemm g{ZIN + ycol, wmix(P, L, WM_B) + (size_t)k * D * 256, ZP, 256, 256, nullptr}; pg8::StaticOrder S; S.init(NTOK, D, G, bx);
                  epi::EpiMerge E{GB, MB, k == 0 ? 1 : 0};
                  RUN_GEMM(epi::EpiMerge, pg8::StaticOrder, false, g, S, E); }
            }
        }
        SEAM(pb + 5);
        if (PH_ON(7) && IN(pb + 6)) {
            pg8::Gemm g{MB, wmix(P, L, WM_O), D, D, D, nullptr}; pg8::StaticOrder S; S.init(NTOK, D, G, bx);
            epi::EpiRes E{xsrc, P.out};
            RUN_GEMM(epi::EpiRes, pg8::StaticOrder, false, g, S, E);
        }
        SEAM(pb + 6);
        if (PH_ON(8) && IN(pb + 7)) {
            if (L == 0) norm_plain(P.out, P.in[I_GFFN], H);
            else { norm2_moe_phase(P, P.out, lds); cvt_jobs(P, 43, 67, lds); __syncthreads(); }
        }
        SEAM(pb + 7);
        if (L == 0) {
            if (PH_ON(9) && IN(9)) {
                pg8::Gemm g{H, (const bf16*)(P.ws + WS_W13), D, D, D, nullptr}; pg8::StaticOrder S; S.init(NTOK, 2 * DFF, G, bx);
                epi::EpiSwiglu E{(bf16*)(P.ws + WS_HMID), DFF, 22};
                RUN_GEMM(epi::EpiSwiglu, pg8::StaticOrder, false, g, S, E);
            }
            SEAM(9);
            if (PH_ON(10) && IN(10)) {
                pg8::Gemm g{(const bf16*)(P.ws + WS_HMID), (const bf16*)(P.ws + WS_W2), DFF, DFF, DFF, nullptr}; pg8::StaticOrder S; S.init(NTOK, D, G, bx);
                epi::EpiRes E{P.out, P.out};
                RUN_GEMM(epi::EpiRes, pg8::StaticOrder, false, g, S, E);
            }
            SEAM(10);
        } else {
            if (PH_ON(21) && IN(21)) moe_assign_phase(P);
            SEAM(21);
            if (PH_ON(22) && IN(22)) {
                pg8::Gemm g{H, (const bf16*)(P.ws + WS_WM13), D, D, D, slot_tok}; const MoeOrder S = moe_order(P, 11, G, bx);
                epi::EpiSwiglu E{(bf16*)(P.ws + WS_HMID), DFFE, 11};
                RUN_GEMM(epi::EpiSwiglu, MoeOrder, true, g, S, E);
            }
            SEAM(22);
            if (PH_ON(23) && IN(23)) {
                pg8::Gemm g{(const bf16*)(P.ws + WS_HMID), (const bf16*)(P.ws + WS_WM2), DFFE, DFFE, DFFE, nullptr}; const MoeOrder S = moe_order(P, 4, G, bx);
                epi::EpiMoeDown E{P.out, slot_tok, slot_gate};
                RUN_GEMM(epi::EpiMoeDown, MoeOrder, false, g, S, E);
            }
            SEAM(23);
        }
        if (PH_ON(11) && IN(pc + 2)) norm_plain(P.out, P.in[I_GPLE] + L * D, H);
        SEAM(pc + 2);
        if (PH_ON(12) && IN(pc + 3)) {
            { pg8::Gemm g{(const bf16*)(P.ws + WS_PBF) + (size_t)L * NTOK * 256, wmix(P, L, WM_UP), 256, 256, 256, nullptr}; pg8::StaticOrder S; S.init(NTOK, D, G, bx);
              epi::EpiStore E{(bf16*)(P.ws + WS_U), D, 0};
              RUN_GEMM(epi::EpiStore, pg8::StaticOrder, false, g, S, E); }
            { pg8::Gemm g{H, wmix(P, L, WM_PG), D, D, D, nullptr}; pg8::StaticOrder S; S.init(NTOK, D, G, bx);
              epi::EpiPle E{(const bf16*)(P.ws + WS_U), P.out};
              RUN_GEMM(epi::EpiPle, pg8::StaticOrder, false, g, S, E); }
        }
        SEAM(pc + 3);
    }
    if (PH_ON(26) && IN(26)) final_norm(P);
#undef IN
#undef SEAM
#undef H
#undef ZIN
#undef GB
#undef MB
#undef MLAQ
#undef MLAKV
#undef KPER
#undef cosT
#undef sinT
#undef slot_tok
#undef slot_gate
}

extern "C" void kernel_launch(void* const* d_in, const int* in_sizes, int n_in, void* d_out, int out_size, void* d_ws, size_t ws_size, hipStream_t stream) {
    static int grid = 0;
    if (grid == 0) {
        if (n_in != 37 || out_size != NTOK * D || ws_size < WS_END) { fprintf(stderr, "kernel_launch: unexpected shapes: n_in %d out %d ws %zu\n", n_in, out_size, ws_size); grid = -1; return; }
        int dev = 0, cus = 0, per_cu = 0;
        if (hipGetDevice(&dev) != hipSuccess || hipDeviceGetAttribute(&cus, hipDeviceAttributeMultiprocessorCount, dev) != hipSuccess) { grid = -1; return; }
        if (hipFuncSetAttribute((const void*)mega_fwd, hipFuncAttributeMaxDynamicSharedMemorySize, LDS_BYTES) != hipSuccess) { fprintf(stderr, "kernel_launch: hipFuncSetAttribute failed\n"); grid = -1; return; }
        if (hipOccupancyMaxActiveBlocksPerMultiprocessor(&per_cu, (const void*)mega_fwd, NTHREADS, LDS_BYTES) != hipSuccess || per_cu < 1)
            fprintf(stderr, "kernel_launch: note: occupancy query reports %d workgroups per CU\n", per_cu);
        (void)hipGetLastError();
        grid = cus;
        if (grid != 256) fprintf(stderr, "kernel_launch: note: %d CUs (built for 256)\n", grid);
    }
    if (grid < 0) return;
    if (hipMemsetAsync((char*)d_ws + WS_CTL, 0, CTL_ZERO_BYTES, stream) != hipSuccess) return;
    Params p{};
    for (int i = 0; i < 37; ++i) p.in[i] = (const float*)d_in[i];
    p.out = (float*)d_out; p.ws = (unsigned char*)d_ws;
#if N_LAUNCH_MODE == 1
    p.ph_lo = 0; p.ph_hi = N_PHASES;
    hipLaunchKernelGGL(mega_fwd, dim3(grid), dim3(NTHREADS), LDS_BYTES, stream, p);
#else
    for (int ph = 0; ph < N_PHASES; ++ph) { p.ph_lo = ph; p.ph_hi = ph + 1; hipLaunchKernelGGL(mega_fwd, dim3(grid), dim3(NTHREADS), LDS_BYTES, stream, p); }
#endif
    const hipError_t le = hipPeekAtLastError();
    if (le != hipSuccess) fprintf(stderr, "kernel_launch: launch failed: %s\n", hipGetErrorName(le));
}
```

```cpp
#include <hip/hip_runtime.h>
#include <cstdio>
#include <cstdint>

#define GAS __attribute__((address_space(1)))
#define LAS __attribute__((address_space(3)))
typedef unsigned short bf16;
typedef short bf16x8 __attribute__((ext_vector_type(8)));
typedef short s16x4 __attribute__((ext_vector_type(4)));
typedef float f32x2 __attribute__((ext_vector_type(2)));
typedef float f32x4 __attribute__((ext_vector_type(4)));
typedef float f32x16 __attribute__((ext_vector_type(16)));
typedef unsigned u32x2 __attribute__((ext_vector_type(2)));
typedef unsigned u32x4 __attribute__((ext_vector_type(4)));
typedef __bf16 bf16x2_t __attribute__((ext_vector_type(2)));

constexpr int NB = 4, SEQ = 8192, NTOK = NB * SEQ, D = 1024;
constexpr int ZP = 2304;
constexpr int ZC_U = 0, ZC_FQ = 256, ZC_FK = 512, ZC_FV = 768, ZC_DQ = 1024, ZC_DK = 1280, ZC_DV = 1536, ZC_CQ = 1792, ZC_CKV = 2048, ZC_KPE = 2176;
constexpr int DIN = 2148, DFF = 2816, DFFE = 1408, NE = 8;
constexpr int MOE_ROWS = 2 * NTOK + NE * 256;
constexpr float RMS_EPS = 1e-6f;
constexpr int NWAVES = 8, NTHREADS = 512;

constexpr size_t MiB = 1u << 20;
constexpr size_t WS_CTL = 0, CTL_ZERO_BYTES = 1 * MiB;
constexpr size_t WS_COS = 1 * MiB, WS_SIN = 3 * MiB;
constexpr size_t WS_LOGF = 5 * MiB;
constexpr size_t WS_CDEC = 5 * MiB + 512 * 1024;
constexpr size_t WS_WSUM = 6 * MiB;
constexpr size_t WS_RSTDQ = 6 * MiB + 256 * 1024, WS_RSTDKV = 6 * MiB + 512 * 1024;
constexpr size_t WS_SC = 7 * MiB;
constexpr size_t WS_TOKINFO = 11 * MiB;
constexpr size_t WS_SLOTTOK = 12 * MiB, WS_SLOTGATE = 12 * MiB + 512 * 1024;
constexpr size_t WS_PBF = 17 * MiB;
constexpr size_t WS_WMIX = 49 * MiB, WMIX_STRIDE = 20 * MiB;
constexpr size_t WM_IN = 0, WM_G = 4 * MiB + 512 * 1024, WM_B = 12 * MiB + 512 * 1024, WM_O = 14 * MiB + 512 * 1024, WM_PG = 16 * MiB + 512 * 1024,
                 WM_UP = 18 * MiB + 512 * 1024, WM_UQ = 19 * MiB, WM_UKV = 19 * MiB + 256 * 1024, WM_GLU = 19 * MiB + 384 * 1024;
constexpr size_t WS_W13 = 89 * MiB, WS_W2 = 100 * MiB;
constexpr size_t WS_H = 106 * MiB;
constexpr size_t WS_MLAQ = 170 * MiB, WS_MLAKV = 202 * MiB, WS_KPER = 234 * MiB;
constexpr size_t WS_M = 170 * MiB;
constexpr size_t WS_ZIN = 236 * MiB;
constexpr size_t WS_G = 380 * MiB;
constexpr size_t WS_HMID = 236 * MiB;
constexpr size_t WS_U = 236 * MiB;
constexpr size_t WS_WM13 = 418 * MiB, WS_WM2 = 462 * MiB;
constexpr size_t WS_MOEY = 89 * MiB;
constexpr size_t WS_H2 = 300 * MiB;
constexpr size_t WS_END = 484 * MiB;
constexpr int CW_BAR = 4096;
constexpr int CW_MOECNT = 16384;
constexpr int CW_QMAX = 20480;
constexpr int CW_KMAX = 22528;

#define LDS_WAIT() asm volatile("s_waitcnt lgkmcnt(0)" ::: "memory")
#define VM_WAIT() asm volatile("s_waitcnt vmcnt(0)" ::: "memory")
__device__ __forceinline__ unsigned f2bf(float f) { unsigned u = __builtin_bit_cast(unsigned, f); return (u + 0x7fffu + ((u >> 16) & 1u)) >> 16; }
__device__ __forceinline__ unsigned pk2(float lo, float hi) { f32x2 v = {lo, hi}; bf16x2_t b = __builtin_convertvector(v, bf16x2_t); return __builtin_bit_cast(unsigned, b); }
__device__ __forceinline__ float bf2f(unsigned short b) { return __uint_as_float((unsigned)b << 16); }
__device__ __forceinline__ float bflo(unsigned w) { return __uint_as_float(w << 16); }
__device__ __forceinline__ float bfhi(unsigned w) { return __uint_as_float(w & 0xffff0000u); }
constexpr int TID_TAB_OFF = 147456 - 512;
__device__ __forceinline__ unsigned hw_wave_key() { return (unsigned)__builtin_amdgcn_s_getreg((5 << 11) | 4) & 0x3Fu; }
__device__ __forceinline__ int my_tid() {
    unsigned addr = (unsigned)TID_TAB_OFF + 4u * hw_wave_key(); asm volatile("" : "+s"(addr));
    const int wave = __builtin_amdgcn_readfirstlane(*(const LAS int*)(uintptr_t)addr);
    int lane = (int)__builtin_amdgcn_mbcnt_hi(~0u, __builtin_amdgcn_mbcnt_lo(~0u, 0u)); asm volatile("" : "+v"(lane));
    return wave * 64 + lane;
}
__device__ __forceinline__ float shflx(float v, int o, int lane) { return __int_as_float(__builtin_amdgcn_ds_bpermute((lane ^ o) << 2, __float_as_int(v))); }
__device__ __forceinline__ float wave_sum(float v) {
    int lane = (int)__builtin_amdgcn_mbcnt_hi(~0u, __builtin_amdgcn_mbcnt_lo(~0u, 0u)); asm volatile("" : "+v"(lane));
#pragma unroll
    for (int o = 1; o < 64; o <<= 1) v += shflx(v, o, lane);
    return v;
}
__device__ __forceinline__ float sigmoidf_(float x) { return __builtin_amdgcn_rcpf(1.0f + __expf(-x)); }

struct XSrc { const float* f; const bf16* b; };
__device__ __forceinline__ f32x4 ldx4(const XSrc& x, size_t idx) {
    if (x.f) return *(const f32x4*)(x.f + idx);
    const u32x2 w = *(const u32x2*)(x.b + idx); return (f32x4){bflo(w.x), bfhi(w.x), bflo(w.y), bfhi(w.y)};
}
__device__ __forceinline__ bf16* xr_of(float* out) { return (bf16*)((unsigned char*)out + (size_t)NTOK * D * 2); }
#define BODY_IDS() int tid = my_tid(); asm volatile("" : "+v"(tid)); const int lane = tid & 63; const int wave = __builtin_amdgcn_readfirstlane(tid >> 6); \
    int grid_ = gridDim.x; asm volatile("" : "+s"(grid_)); \
    const int gw = blockIdx.x * NWAVES + wave, ngw = grid_ * NWAVES, gtid = blockIdx.x * NTHREADS + tid, gthreads = grid_ * NTHREADS; (void)lane; (void)wave; (void)gw; (void)ngw; (void)gtid; (void)gthreads
#define XB_TMO      128
#define XB_XCNT(j)  (256  + 64 * (j))
#define XB_XSUB(j)  (1280 + 64 * (j))
#define XB_XGEN(j)  (2304 + 64 * (j))
#define XB_TOP      3328
#define XB_TOPGEN   3392
#define XCD_BAR_WORDS 3456
#define XB_SPIN_CAP (1u << 22)

__device__ __forceinline__ unsigned xb_ld(unsigned* p)              { return __hip_atomic_load(p, __ATOMIC_RELAXED, __HIP_MEMORY_SCOPE_AGENT); }
__device__ __forceinline__ unsigned xb_add(unsigned* p, unsigned v) { return __hip_atomic_fetch_add(p, v, __ATOMIC_RELAXED, __HIP_MEMORY_SCOPE_AGENT); }
__device__ __forceinline__ unsigned xb_xcc_id() { return (unsigned)__builtin_amdgcn_s_getreg((3 << 11) | 20) & 0xFu; }
#define XB_SPIN(cond, bar) do { unsigned _sp = 0; while (cond) { __builtin_amdgcn_s_sleep(1); \
    if ((++_sp & 255u) == 0u) { if (xb_ld(&(bar)[XB_TMO])) break; if (_sp > XB_SPIN_CAP) { atomicAdd(&(bar)[XB_TMO], 1u); break; } } } } while (0)

struct XcdBarrier { unsigned* bar; unsigned x; volatile LAS unsigned* st; };

__device__ __forceinline__ XcdBarrier xcd_barrier_post(unsigned* bar, volatile LAS unsigned* st) {
    XcdBarrier b; b.bar = bar; b.x = xb_xcc_id(); b.st = st;
    if (my_tid() == 0) (void)xb_add(&bar[XB_XCNT(b.x)], 1u);
    return b;
}
__device__ __forceinline__ void xcd_barrier_complete(unsigned* bar, unsigned x, unsigned& nloc, unsigned& nx) {
    const unsigned G = gridDim.x * gridDim.y * gridDim.z;
    unsigned sum, cnt, mine, sp = 0u;
    for (;;) {
        sum = 0u; cnt = 0u; mine = 0u;
#pragma unroll
        for (unsigned j = 0; j < 16; ++j) { const unsigned c = xb_ld(&bar[XB_XCNT(j)]); sum += c; cnt += (c > 0u) ? 1u : 0u; mine = (j == x) ? c : mine; }
        if (sum == G) break;
        __builtin_amdgcn_s_sleep(1);
        if ((++sp & 255u) == 0u) { if (xb_ld(&bar[XB_TMO])) break; if (sp > XB_SPIN_CAP) { atomicAdd(&bar[XB_TMO], 1u); break; } }
    }
    nloc = mine > 0u ? mine : 1u; nx = cnt > 0u ? cnt : 1u;
}
__device__ __forceinline__ void xcd_barrier(const XcdBarrier& b) {
    asm volatile("s_waitcnt vmcnt(0)" ::: "memory");
    __syncthreads();
    if (my_tid() == 0) {
        unsigned* bar = b.bar;
        __builtin_amdgcn_s_waitcnt(0);
        unsigned nloc = b.st[0], nx = b.st[1];
        if (nloc == 0u) { xcd_barrier_complete(bar, b.x, nloc, nx); b.st[0] = nloc; b.st[1] = nx; }
        const unsigned old = xb_add(&bar[XB_XSUB(b.x)], 1u);
        const unsigned gen = old / nloc;
        if (old + 1u == (gen + 1u) * nloc) {
            __builtin_amdgcn_fence(__ATOMIC_RELEASE, "agent");
            asm volatile("s_waitcnt vmcnt(0)" ::: "memory");
            const unsigned og = xb_add(&bar[XB_TOP], 1u);
            const unsigned tg = og / nx;
            if (og + 1u == (tg + 1u) * nx) xb_add(&bar[XB_TOPGEN], 1u);
            else XB_SPIN(xb_ld(&bar[XB_TOPGEN]) == tg, bar);
            __builtin_amdgcn_fence(__ATOMIC_ACQUIRE, "agent");
            xb_add(&bar[XB_XGEN(b.x)], 1u);
            asm volatile("s_waitcnt vmcnt(0)" ::: "memory");
        } else {
            XB_SPIN(xb_ld(&bar[XB_XGEN(b.x)]) == gen, bar);
            __builtin_amdgcn_fence(__ATOMIC_ACQUIRE, "agent");
            asm volatile("s_waitcnt vmcnt(0)" ::: "memory");
        }
    }
    __syncthreads();
}
namespace pg8 {
constexpr int BM = 256, BK = 64, HALF = 128, HTB = HALF * BK * 2, STAGE_BYTES = 8 * HTB, NXCD = 8, WGM = 8;
__host__ __device__ __forceinline__ int lds_byte(int r, int c) { const int st = (r >> 4) * 2 + (c >> 5), rr = r & 15, cc = c & 31, ob = rr * 64 + cc * 2; return st * 1024 + (ob ^ (((ob >> 9) & 1) << 5)); }
__host__ __device__ __forceinline__ void stage_rc(int b, int& R, int& C) { const int st = b / 1024, sb = b % 1024, swz = sb ^ (((sb >> 9) & 1) << 5); R = (st >> 1) * 16 + swz / 64; C = (st & 1) * 32 + (swz % 64) / 2; }
__host__ __device__ __forceinline__ int perm32(int rho) { const int n = rho >> 4, i = rho & 15; return 8 * (i >> 2) + 4 * n + (i & 3); }

struct Unit { int pm, pn; };
struct Gemm { const bf16* A; const bf16* Bt; int lda, ldb, K; const int* gidx; };

struct StaticOrder {
    int nM, nN, nwg, G, c;
    __host__ __device__ void init(int M, int N, int G_, int c_) { nM = M / BM; nN = N / BM; nwg = nM * nN; G = G_; c = c_; }
    __host__ __device__ bool next(int i, Unit& u) const {
        const long L = (long)i * G + c; if (L >= nwg) return false;
        int wgid = (int)L; { const int q = nwg / NXCD, r = nwg % NXCD, xcd = wgid % NXCD, off = wgid / NXCD; wgid = (xcd < r ? xcd * (q + 1) : r * (q + 1) + (xcd - r) * q) + off; }
        const int nig = WGM * nN, gid = wgid / nig, fm = gid * WGM, gsz = (nM - fm) < WGM ? (nM - fm) : WGM;
        u.pm = fm + ((wgid % nig) % gsz); u.pn = (wgid % nig) / gsz; return true;
    }
};

template <class Epi, class Sched, bool ALIGN_EPI, bool GATHER>
__device__ __forceinline__ void gemm_phase(LAS unsigned char* lds, const Gemm g, const Sched& S, const Epi& E) {
    int tid = my_tid(); asm volatile("" : "+v"(tid));
    const int wid = __builtin_amdgcn_readfirstlane(tid >> 6), lane = tid & 63, wr = wid >> 2, wc = wid & 3, fr = lane & 15, fq = lane >> 4;
    int Kq = g.K; asm volatile("" : "+s"(Kq));
    const int K = Kq, nt = K / BK;
    int RA[2], CA[2];
    unsigned voffA[2], voffB[2];
#pragma unroll
    for (int i = 0; i < 2; ++i) { int R, C; stage_rc(tid * 16 + i * 8192, R, C); const int Rb = Epi::PERM ? ((R & ~31) + perm32(R & 31)) : R;
        RA[i] = R; CA[i] = C; voffA[i] = (unsigned)(R * g.lda + C) * 2u; voffB[i] = (unsigned)(Rb * g.ldb + C) * 2u; }
    const size_t kstep = (size_t)(BK * 2);
    const size_t hstepB = (size_t)HALF * g.ldb * 2, tstepB = 2 * hstepB;
    const size_t hstepA = (size_t)HALF * g.lda * 2, tstepA = 2 * hstepA;
    const unsigned ldsw = (unsigned)wid * 1024u;
    const int aoff = lds_byte(wr * 64 + fr, fq * 8), boff = lds_byte(wc * 32 + fr, fq * 8);
#define PG8_SA(b, h) (((b) * 2 + (h)) * HTB)
#define PG8_SB(b, h) ((4 + (b) * 2 + (h)) * HTB)
#define PG8_STAGEB(bufoff, gbase) do { _Pragma("unroll") for (int _i = 0; _i < 2; ++_i) \
        __builtin_amdgcn_global_load_lds((const unsigned*)((const char*)(gbase) + voffB[_i]), (LAS unsigned*)(lds + (bufoff) + ldsw + _i * 8192), 16, 0, 0); } while (0)
#define PG8_STAGEA(bufoff, kptr, isnext, h) do { _Pragma("unroll") for (int _i = 0; _i < 2; ++_i) { const char* _p; \
        if constexpr (GATHER) _p = (const char*)(kptr) + ((isnext) ? nvo[h][_i] : cvo[h][_i]); else _p = (const char*)(kptr) + (size_t)(h) * hstepA + voffA[_i]; \
        __builtin_amdgcn_global_load_lds((const unsigned*)_p, (LAS unsigned*)(lds + (bufoff) + ldsw + _i * 8192), 16, 0, 0); } } while (0)
#define PG8_LDA(dst, b, h) do { _Pragma("unroll") for (int m = 0; m < 4; ++m) _Pragma("unroll") for (int k = 0; k < 2; ++k) dst[m][k] = *(const LAS bf16x8*)(lds + PG8_SA(b, h) + aoff + m * 2048 + k * 1024); } while (0)
#define PG8_LDB(dst, b, h) do { _Pragma("unroll") for (int n = 0; n < 2; ++n) _Pragma("unroll") for (int k = 0; k < 2; ++k) dst[n][k] = *(const LAS bf16x8*)(lds + PG8_SB(b, h) + boff + n * 2048 + k * 1024); } while (0)
#define PG8_MMA(ai, bj, At, Bt) do { __builtin_amdgcn_s_setprio(1); _Pragma("unroll") for (int m = 0; m < 4; ++m) _Pragma("unroll") for (int n = 0; n < 2; ++n) _Pragma("unroll") for (int k = 0; k < 2; ++k) \
        acc[ai][bj][m][n] = __builtin_amdgcn_mfma_f32_16x16x32_bf16(Bt[n][k], At[m][k], acc[ai][bj][m][n], 0, 0, 0); __builtin_amdgcn_s_setprio(0); } while (0)
#define PG8_WAIT_V(n) asm volatile("s_waitcnt vmcnt(" #n ")" ::: "memory")
#define PG8_WAIT_L(n) asm volatile("s_waitcnt lgkmcnt(" #n ")" ::: "memory")
#define PG8_BAR __builtin_amdgcn_s_barrier()
#define PG8_SCHED __builtin_amdgcn_sched_barrier(0)
#define PG8_VOA(vo, u) do { _Pragma("unroll") for (int _h = 0; _h < 2; ++_h) _Pragma("unroll") for (int _i = 0; _i < 2; ++_i) { \
        int _row = (u).pm * BM + _h * HALF + RA[_i]; if (GATHER) { _row = g.gidx[_row]; _row = _row < 0 ? 0 : _row; } \
        (vo)[_h][_i] = (unsigned)_row * (unsigned)(g.lda * 2) + (unsigned)(CA[_i] * 2); } } while (0)
    Unit cur, nxt; int ui = 0;
    if (!S.next(0, cur)) return;
    f32x4 acc[2][2][4][2];
#pragma unroll
    for (int a = 0; a < 2; ++a)
#pragma unroll
        for (int b = 0; b < 2; ++b)
#pragma unroll
            for (int m = 0; m < 4; ++m)
#pragma unroll
                for (int n = 0; n < 2; ++n) acc[a][b][m][n] = (f32x4){0.f, 0.f, 0.f, 0.f};
    bf16x8 At[4][2], B0[2][2], B1[2][2];
    unsigned cvo[2][2], nvo[2][2];
    if constexpr (GATHER) { PG8_VOA(cvo, cur); PG8_VOA(nvo, cur); }
    const char* cA = (const char*)g.A + (GATHER ? (size_t)0 : (size_t)cur.pm * tstepA); const char* cB = (const char*)g.Bt + (size_t)cur.pn * tstepB;
    PG8_STAGEB(PG8_SB(0, 0), cB); PG8_STAGEB(PG8_SB(0, 1), cB + hstepB); PG8_STAGEA(PG8_SA(0, 0), cA, false, 0); PG8_STAGEA(PG8_SA(0, 1), cA, false, 1);
    if (wr == 1) PG8_BAR;
    PG8_WAIT_V(2); PG8_BAR;
    PG8_STAGEB(PG8_SB(1, 0), cB + kstep); PG8_STAGEA(PG8_SA(1, 0), cA + kstep, false, 0); PG8_STAGEB(PG8_SB(1, 1), cB + hstepB + kstep);
    PG8_WAIT_V(6); PG8_BAR;
    for (;;) {
        const bool has_next = S.next(ui + 1, nxt);
        if constexpr (GATHER) { if (has_next) { PG8_VOA(nvo, nxt); } }
        const char* nA = (GATHER || !has_next) ? cA : (const char*)g.A + (size_t)nxt.pm * tstepA;
        const char* nB = has_next ? (const char*)g.Bt + (size_t)nxt.pn * tstepB : cB;
#pragma nounroll
        for (int t = 0; t < nt; t += 2) {
            const bool last = (t == nt - 2);
            const char* a1 = cA + (size_t)(t + 1) * kstep;
            const char* a2 = last ? nA : cA + (size_t)(t + 2) * kstep; const char* b2 = last ? nB : cB + (size_t)(t + 2) * kstep;
            const char* a3 = a2 + kstep; const char* b3 = b2 + kstep;
            PG8_LDB(B0, 0, 0); PG8_LDB(B1, 0, 1); PG8_SCHED; PG8_LDA(At, 0, 0); PG8_STAGEA(PG8_SA(1, 1), a1, false, 1);
            PG8_WAIT_V(8); PG8_WAIT_L(0); PG8_BAR; PG8_MMA(0, 0, At, B0); PG8_MMA(0, 1, At, B1); PG8_BAR; PG8_SCHED;
            PG8_LDA(At, 0, 1); PG8_STAGEB(PG8_SB(0, 0), b2); PG8_STAGEB(PG8_SB(0, 1), b2 + hstepB); PG8_STAGEA(PG8_SA(0, 0), a2, last, 0);
            PG8_WAIT_V(8); PG8_WAIT_L(0); PG8_BAR; PG8_MMA(1, 0, At, B0); PG8_MMA(1, 1, At, B1); PG8_BAR; PG8_SCHED;
            PG8_LDB(B0, 1, 0); PG8_LDB(B1, 1, 1); PG8_SCHED; PG8_LDA(At, 1, 0); PG8_STAGEA(PG8_SA(0, 1), a2, last, 1);
            PG8_WAIT_V(8); PG8_WAIT_L(0); PG8_BAR; PG8_MMA(0, 0, At, B0); PG8_MMA(0, 1, At, B1); PG8_BAR; PG8_SCHED;
            PG8_LDA(At, 1, 1); PG8_STAGEB(PG8_SB(1, 0), b3); PG8_STAGEB(PG8_SB(1, 1), b3 + hstepB); PG8_STAGEA(PG8_SA(1, 0), a3, last, 0);
            PG8_WAIT_V(8); PG8_WAIT_L(0); PG8_BAR; PG8_MMA(1, 0, At, B0); PG8_MMA(1, 1, At, B1); PG8_BAR; PG8_SCHED;
        }
        if constexpr (ALIGN_EPI) { if (wr == 0) PG8_BAR; }
        E(acc, cur, wr, wc, fr, fq);
        if (!has_next) break;
#pragma unroll
        for (int a = 0; a < 2; ++a)
#pragma unroll
            for (int b = 0; b < 2; ++b)
#pragma unroll
                for (int m = 0; m < 4; ++m)
#pragma unroll
                    for (int n = 0; n < 2; ++n) acc[a][b][m][n] = (f32x4){0.f, 0.f, 0.f, 0.f};
        cur = nxt; cA = nA; cB = nB; ++ui;
        if constexpr (GATHER) {
#pragma unroll
            for (int _h = 0; _h < 2; ++_h)
#pragma unroll
                for (int _i = 0; _i < 2; ++_i) cvo[_h][_i] = nvo[_h][_i]; }
        if constexpr (ALIGN_EPI) { if (wr == 1) PG8_BAR; }
    }
    PG8_WAIT_V(0);
    if constexpr (!ALIGN_EPI) { if (wr == 0) PG8_BAR; }
    PG8_BAR;
#undef PG8_SA
#undef PG8_SB
#undef PG8_STAGEA
#undef PG8_STAGEB
#undef PG8_LDA
#undef PG8_LDB
#undef PG8_MMA
#undef PG8_WAIT_V
#undef PG8_WAIT_L
#undef PG8_BAR
#undef PG8_SCHED
#undef PG8_VOA
}

template <class Epi, class Sched, bool GATHER>
__device__ __forceinline__ void gemm_phase_naive(const Gemm g, const Sched& S, const Epi& E) {
    const int tid = threadIdx.x, wid = tid >> 6, lane = tid & 63, wr = wid >> 2, wc = wid & 3, fr = lane & 15, fq = lane >> 4;
    Unit u;
    for (int ui = 0; S.next(ui, u); ++ui) {
        f32x4 acc[2][2][4][2];
#pragma unroll
        for (int a = 0; a < 2; ++a)
#pragma unroll
            for (int b = 0; b < 2; ++b)
#pragma unroll
                for (int m = 0; m < 4; ++m)
#pragma unroll
                    for (int n = 0; n < 2; ++n) acc[a][b][m][n] = (f32x4){0.f, 0.f, 0.f, 0.f};
        const bf16* arow[2][4];
#pragma unroll
        for (int ai = 0; ai < 2; ++ai)
#pragma unroll
            for (int m = 0; m < 4; ++m) { int r = u.pm * BM + ai * HALF + wr * 64 + m * 16 + fr; if (GATHER) { r = g.gidx[r]; r = r < 0 ? 0 : r; } arow[ai][m] = g.A + (size_t)r * g.lda; }
        for (int k = 0; k < g.K; k += 4) {
            float av[2][4][4];
#pragma unroll
            for (int ai = 0; ai < 2; ++ai)
#pragma unroll
                for (int m = 0; m < 4; ++m) { const u32x2 w = *(const u32x2*)(arow[ai][m] + k); av[ai][m][0] = bflo(w.x); av[ai][m][1] = bfhi(w.x); av[ai][m][2] = bflo(w.y); av[ai][m][3] = bfhi(w.y); }
#pragma unroll
            for (int bj = 0; bj < 2; ++bj)
#pragma unroll
                for (int n = 0; n < 2; ++n)
#pragma unroll
                    for (int e = 0; e < 4; ++e) {
                        const int col = u.pn * BM + bj * HALF + wc * 32 + (Epi::PERM ? (8 * fq + 4 * n) : (16 * n + 4 * fq)) + e;
                        const u32x2 w = *(const u32x2*)(g.Bt + (size_t)col * g.ldb + k);
                        const float b0 = bflo(w.x), b1 = bfhi(w.x), b2 = bflo(w.y), b3 = bfhi(w.y);
#pragma unroll
                        for (int ai = 0; ai < 2; ++ai)
#pragma unroll
                            for (int m = 0; m < 4; ++m) acc[ai][bj][m][n][e] += av[ai][m][0] * b0 + av[ai][m][1] * b1 + av[ai][m][2] * b2 + av[ai][m][3] * b3;
                    }
        }
        E(acc, u, wr, wc, fr, fq);
    }
    VM_WAIT(); __syncthreads();
}
}
namespace g128 {
using pg8::lds_byte; using pg8::stage_rc; using pg8::HTB; using pg8::BK;
struct Seg { const bf16* A; const bf16* B; int lda, ldb, nt; };
typedef f32x4 acc_t[2][4][2];

template <class Prog>
__device__ __forceinline__ void stream(LAS unsigned char* lds, Prog& P, int nunits, int first, int stride) {
    int tid = my_tid(); asm volatile("" : "+v"(tid));
    const int wid = __builtin_amdgcn_readfirstlane(tid >> 6), lane = tid & 63, wr = wid >> 2, wc = wid & 3, fr = lane & 15, fq = lane >> 4;
    int RA[2], CA[2];
#pragma unroll
    for (int i = 0; i < 2; ++i) stage_rc(tid * 16 + i * 8192, RA[i], CA[i]);
    const unsigned ldsw = (unsigned)wid * 1024u;
    const int aoff = lds_byte(wr * 64 + fr, fq * 8), boff = lds_byte(wc * 32 + fr, fq * 8);
#define G_SA(b) ((b) * HTB)
#define G_SB(b, h) ((2 + (b) * 2 + (h)) * HTB)
#define G_STAGE(bufoff, base, ld, kbyte) do { _Pragma("unroll") for (int _i = 0; _i < 2; ++_i) \
        __builtin_amdgcn_global_load_lds((const unsigned*)((const char*)(base) + (size_t)(kbyte) + (unsigned)(RA[_i] * (ld) + CA[_i]) * 2u), (LAS unsigned*)(lds + (bufoff) + ldsw + _i * 8192), 16, 0, 0); } while (0)
#define G_STAGE_A(b, S, j) G_STAGE(G_SA(b), (S).A, (S).lda, (j) * 128)
#define G_STAGE_B(b, h, S, j) G_STAGE(G_SB(b, h), (const char*)(S).B + (size_t)(h) * 128 * (S).ldb * 2, (S).ldb, (j) * 128)
#define G_LDA(dst, b) do { _Pragma("unroll") for (int m = 0; m < 4; ++m) _Pragma("unroll") for (int k = 0; k < 2; ++k) dst[m][k] = *(const LAS bf16x8*)(lds + G_SA(b) + aoff + m * 2048 + k * 1024); } while (0)
#define G_LDB(dst, b, h) do { _Pragma("unroll") for (int n = 0; n < 2; ++n) _Pragma("unroll") for (int k = 0; k < 2; ++k) dst[n][k] = *(const LAS bf16x8*)(lds + G_SB(b, h) + boff + n * 2048 + k * 1024); } while (0)
#define G_MMA(bj, At, Bt) do { __builtin_amdgcn_s_setprio(1); _Pragma("unroll") for (int m = 0; m < 4; ++m) _Pragma("unroll") for (int n = 0; n < 2; ++n) _Pragma("unroll") for (int k = 0; k < 2; ++k) \
        acc[bj][m][n] = __builtin_amdgcn_mfma_f32_16x16x32_bf16(Bt[n][k], At[m][k], acc[bj][m][n], 0, 0, 0); __builtin_amdgcn_s_setprio(0); } while (0)
#define G_WAIT_V(n) asm volatile("s_waitcnt vmcnt(" #n ")" ::: "memory")
#define G_WAIT_L(n) asm volatile("s_waitcnt lgkmcnt(" #n ")" ::: "memory")
#define G_BAR __builtin_amdgcn_s_barrier()
#define G_SCHED __builtin_amdgcn_sched_barrier(0)
    if (first >= nunits) return;
    P.reset();
    int ucur = first, scur = 0;
    Seg cur, nxt;
    P.seg(ucur, scur, cur);
    acc_t acc;
    P.init(ucur, scur, acc, wr, wc, fr, fq);
    bf16x8 At[4][2], B0[2][2], B1[2][2];
    G_STAGE_B(0, 0, cur, 0); G_STAGE_A(0, cur, 0); G_STAGE_B(0, 1, cur, 0);
    if (wr == 1) G_BAR;
    G_WAIT_V(2); G_BAR;
    G_STAGE_A(1, cur, 1); G_STAGE_B(1, 0, cur, 1);
    G_WAIT_V(4); G_BAR;
#define G_TILE(t_, b_) do { const bool n1_ = ((t_) + 1 >= nt), n2_ = ((t_) + 2 >= nt); const int j1_ = n1_ ? ((t_) + 1 - nt) : ((t_) + 1), j2_ = n2_ ? ((t_) + 2 - nt) : ((t_) + 2); \
        G_LDB(B0, b_, 0); G_SCHED; G_LDA(At, b_); \
        if (n1_) G_STAGE_B((b_) ^ 1, 1, nxt, j1_); else G_STAGE_B((b_) ^ 1, 1, cur, j1_); \
        G_WAIT_V(6); G_WAIT_L(0); G_BAR; G_MMA(0, At, B0); G_BAR; G_SCHED; \
        G_LDB(B1, b_, 1); \
        if (n2_) { G_STAGE_A(b_, nxt, j2_); G_STAGE_B(b_, 0, nxt, j2_); } else { G_STAGE_A(b_, cur, j2_); G_STAGE_B(b_, 0, cur, j2_); } \
        G_WAIT_V(6); G_WAIT_L(0); G_BAR; G_MMA(1, At, B1); G_BAR; G_SCHED; } while (0)
    for (;;) {
        int unxt = ucur, snxt = scur + 1; bool more = true;
        if (snxt == Prog::NSEG) { snxt = 0; unxt = ucur + stride; if (unxt >= nunits) { more = false; unxt = ucur; snxt = scur; } }
        P.seg(unxt, snxt, nxt);
        int ntq = cur.nt; asm volatile("" : "+s"(ntq)); const int nt = ntq;
#pragma nounroll
        for (int t = 0; t < nt; t += 2) { G_TILE(t, 0); G_TILE(t + 1, 1); }
        P.done(ucur, scur, acc, wr, wc, fr, fq);
        if (!more) break;
        P.init(unxt, snxt, acc, wr, wc, fr, fq);
        ucur = unxt; scur = snxt; cur = nxt;
    }
    G_WAIT_V(0);
    if (wr == 0) G_BAR;
    G_BAR;
#undef G_SA
#undef G_SB
#undef G_STAGE
#undef G_STAGE_A
#undef G_STAGE_B
#undef G_LDA
#undef G_LDB
#undef G_MMA
#undef G_WAIT_V
#undef G_WAIT_L
#undef G_BAR
#undef G_SCHED
#undef G_TILE
}

struct MergeProg {
    static constexpr int NSEG = 8;
    const bf16* Hn; const bf16* zin; const bf16* wg; const bf16* wb; const float* bg; bf16* M;
    __device__ __forceinline__ void reset() {
#pragma unroll
        for (int a = 0; a < 2; ++a)
#pragma unroll
            for (int b = 0; b < 4; ++b)
#pragma unroll
                for (int c = 0; c < 2; ++c) { g[a][b][c] = (u32x2){0u, 0u}; macc[a][b][c] = (u32x2){0u, 0u}; } }
    u32x2 g[2][4][2]; u32x2 macc[2][4][2];
    __device__ __forceinline__ void seg(int u, int s, Seg& S) const {
        const int pm = u >> 2, pn = u & 3, k = s >> 1;
        if ((s & 1) == 0) { S.A = Hn + (size_t)pm * 128 * D; S.lda = D; S.B = wg + ((size_t)k * D + pn * 256) * D; S.ldb = D; S.nt = D / 64; }
        else { const int ycol = (k == 0) ? ZC_U : (k == 1) ? ZC_FQ : (k == 2) ? ZC_CQ : ZC_DQ;
               S.A = zin + (size_t)pm * 128 * ZP + ycol; S.lda = ZP; S.B = wb + ((size_t)k * D + pn * 256) * 256; S.ldb = 256; S.nt = 4; }
    }
    __device__ __forceinline__ void init(int u, int s, acc_t& acc, int wr, int wc, int fr, int fq) {
        const int pn = u & 3, k = s >> 1;
        if ((s & 1) == 0) {
#pragma unroll
            for (int bj = 0; bj < 2; ++bj)
#pragma unroll
                for (int n = 0; n < 2; ++n) { const f32x4 bv = *(const f32x4*)(bg + (size_t)k * D + pn * 256 + bj * 128 + wc * 32 + n * 16 + 4 * fq);
#pragma unroll
                    for (int m = 0; m < 4; ++m) acc[bj][m][n] = bv; }
            if (s == 0) {
#pragma unroll
                for (int bj = 0; bj < 2; ++bj)
#pragma unroll
                    for (int m = 0; m < 4; ++m)
#pragma unroll
                        for (int n = 0; n < 2; ++n) macc[bj][m][n] = (u32x2){0u, 0u}; }
        } else {
#pragma unroll
            for (int bj = 0; bj < 2; ++bj)
#pragma unroll
                for (int m = 0; m < 4; ++m)
#pragma unroll
                    for (int n = 0; n < 2; ++n) acc[bj][m][n] = (f32x4){0.f, 0.f, 0.f, 0.f};
        }
    }
    __device__ __forceinline__ void done(int u, int s, const acc_t& acc, int wr, int wc, int fr, int fq) {
        if ((s & 1) == 0) {
#pragma unroll
            for (int bj = 0; bj < 2; ++bj)
#pragma unroll
                for (int m = 0; m < 4; ++m)
#pragma unroll
                    for (int n = 0; n < 2; ++n) { const f32x4 a = acc[bj][m][n]; u32x2 w; w.x = pk2(sigmoidf_(a[0]), sigmoidf_(a[1])); w.y = pk2(sigmoidf_(a[2]), sigmoidf_(a[3])); g[bj][m][n] = w; }
        } else {
#pragma unroll
            for (int bj = 0; bj < 2; ++bj)
#pragma unroll
                for (int m = 0; m < 4; ++m)
#pragma unroll
                    for (int n = 0; n < 2; ++n) { const u32x2 w = g[bj][m][n], q = macc[bj][m][n]; const f32x4 v = (f32x4){bflo(q.x), bfhi(q.x), bflo(q.y), bfhi(q.y)} + (f32x4){bflo(w.x), bfhi(w.x), bflo(w.y), bfhi(w.y)} * acc[bj][m][n];
                        u32x2 r; r.x = pk2(v[0], v[1]); r.y = pk2(v[2], v[3]); macc[bj][m][n] = r; }
            if (s == NSEG - 1) { const int pm = u >> 2, pn = u & 3;
#pragma unroll
                for (int m = 0; m < 4; ++m) { bf16* rp = M + (size_t)(pm * 128 + wr * 64 + m * 16 + fr) * D + pn * 256 + wc * 32 + 4 * fq;
#pragma unroll
                    for (int bj = 0; bj < 2; ++bj)
#pragma unroll
                        for (int n = 0; n < 2; ++n) *(u32x2*)(rp + bj * 128 + n * 16) = macc[bj][m][n]; } }
        }
    }
};

struct InProg {
    static constexpr int NSEG = 9;
    const bf16* Hn; const bf16* win; bf16* zin;
    __device__ __forceinline__ void reset() {}
    __device__ __forceinline__ void seg(int u, int s, Seg& S) const { S.A = Hn + (size_t)u * 128 * D; S.lda = D; S.B = win + (size_t)s * 256 * D; S.ldb = D; S.nt = D / 64; }
    __device__ __forceinline__ void init(int u, int s, acc_t& acc, int wr, int wc, int fr, int fq) {
#pragma unroll
        for (int bj = 0; bj < 2; ++bj)
#pragma unroll
            for (int m = 0; m < 4; ++m)
#pragma unroll
                for (int n = 0; n < 2; ++n) acc[bj][m][n] = (f32x4){0.f, 0.f, 0.f, 0.f};
    }
    __device__ __forceinline__ void done(int u, int s, const acc_t& acc, int wr, int wc, int fr, int fq) {
#pragma unroll
        for (int m = 0; m < 4; ++m) { bf16* rp = zin + (size_t)(u * 128 + wr * 64 + m * 16 + fr) * ZP + s * 256 + wc * 32 + 4 * fq;
#pragma unroll
            for (int bj = 0; bj < 2; ++bj)
#pragma unroll
                for (int n = 0; n < 2; ++n) { const f32x4 v = acc[bj][m][n]; u32x2 w; w.x = pk2(v[0], v[1]); w.y = pk2(v[2], v[3]); *(u32x2*)(rp + bj * 128 + n * 16) = w; } }
    }
};
struct PleProg {
    static constexpr int NSEG = 8;
    const bf16* pbf; const bf16* hp; const bf16* wup; const bf16* wpg; bf16* x;
    u32x2 uu[2][4][2];
    __device__ __forceinline__ void reset() {
#pragma unroll
        for (int a = 0; a < 2; ++a)
#pragma unroll
            for (int b = 0; b < 4; ++b)
#pragma unroll
                for (int c = 0; c < 2; ++c) uu[a][b][c] = (u32x2){0u, 0u}; }
    __device__ __forceinline__ void seg(int u, int s, Seg& S) const {
        const int pn = s >> 1;
        if ((s & 1) == 0) { S.A = pbf + (size_t)u * 128 * 256; S.lda = 256; S.B = wup + (size_t)pn * 256 * 256; S.ldb = 256; S.nt = 4; }
        else { S.A = hp + (size_t)u * 128 * D; S.lda = D; S.B = wpg + (size_t)pn * 256 * D; S.ldb = D; S.nt = D / 64; }
    }
    __device__ __forceinline__ void init(int u, int s, acc_t& acc, int wr, int wc, int fr, int fq) {
#pragma unroll
        for (int bj = 0; bj < 2; ++bj)
#pragma unroll
            for (int m = 0; m < 4; ++m)
#pragma unroll
                for (int n = 0; n < 2; ++n) acc[bj][m][n] = (f32x4){0.f, 0.f, 0.f, 0.f};
    }
    __device__ __forceinline__ void done(int u, int s, const acc_t& acc, int wr, int wc, int fr, int fq) {
        if ((s & 1) == 0) {
#pragma unroll
            for (int bj = 0; bj < 2; ++bj)
#pragma unroll
                for (int m = 0; m < 4; ++m)
#pragma unroll
                    for (int n = 0; n < 2; ++n) { const f32x4 a = acc[bj][m][n]; u32x2 w; w.x = pk2(a[0], a[1]); w.y = pk2(a[2], a[3]); uu[bj][m][n] = w; }
        } else { const int pn = s >> 1;
#pragma unroll
            for (int m = 0; m < 4; ++m) { bf16* rp = x + (size_t)(u * 128 + wr * 64 + m * 16 + fr) * D + pn * 256 + wc * 32 + 4 * fq; u32x2 xv[2][2];
#pragma unroll
                for (int bj = 0; bj < 2; ++bj)
#pragma unroll
                    for (int n = 0; n < 2; ++n) xv[bj][n] = *(const u32x2*)(rp + bj * 128 + n * 16);
#pragma unroll
                for (int bj = 0; bj < 2; ++bj)
#pragma unroll
                    for (int n = 0; n < 2; ++n) { const u32x2 w = uu[bj][m][n]; f32x4 v = acc[bj][m][n];
                        v[0] = sigmoidf_(v[0]); v[1] = sigmoidf_(v[1]); v[2] = sigmoidf_(v[2]); v[3] = sigmoidf_(v[3]);
                        const u32x2 xw = xv[bj][n]; v = (f32x4){bflo(xw.x), bfhi(xw.x), bflo(xw.y), bfhi(xw.y)} + (f32x4){bflo(w.x), bfhi(w.x), bflo(w.y), bfhi(w.y)} * v;
                        u32x2 ow; ow.x = pk2(v[0], v[1]); ow.y = pk2(v[2], v[3]); *(u32x2*)(rp + bj * 128 + n * 16) = ow; } } }
    }
};
struct WoProg {
    static constexpr int NSEG = 4;
    const bf16* Mn; const bf16* wo; const float* xin; float* xout;
    __device__ __forceinline__ void reset() {}
    __device__ __forceinline__ void seg(int u, int s, Seg& S) const { S.A = Mn + (size_t)u * 128 * D; S.lda = D; S.B = wo + (size_t)s * 256 * D; S.ldb = D; S.nt = D / 64; }
    __device__ __forceinline__ void init(int u, int s, acc_t& acc, int wr, int wc, int fr, int fq) {
#pragma unroll
        for (int bj = 0; bj < 2; ++bj)
#pragma unroll
            for (int m = 0; m < 4; ++m)
#pragma unroll
                for (int n = 0; n < 2; ++n) acc[bj][m][n] = (f32x4){0.f, 0.f, 0.f, 0.f};
    }
    __device__ __forceinline__ void done(int u, int s, const acc_t& acc, int wr, int wc, int fr, int fq) {
#pragma unroll
        for (int m = 0; m < 4; ++m) { const size_t ro = (size_t)(u * 128 + wr * 64 + m * 16 + fr) * D + s * 256 + wc * 32 + 4 * fq; f32x4 xv[2][2];
#pragma unroll
            for (int bj = 0; bj < 2; ++bj)
#pragma unroll
                for (int n = 0; n < 2; ++n) xv[bj][n] = *(const f32x4*)(xin + ro + bj * 128 + n * 16);
#pragma unroll
            for (int bj = 0; bj < 2; ++bj)
#pragma unroll
                for (int n = 0; n < 2; ++n) *(f32x4*)(xout + ro + bj * 128 + n * 16) = xv[bj][n] + acc[bj][m][n]; }
    }
};
}
namespace epi {
using pg8::Unit; using pg8::BM; using pg8::HALF;
__device__ __forceinline__ void epi_fence() { asm volatile("" ::: "memory"); }
#define EPI_FENCE epi_fence()
#define EPI_LOOP_ROWS for (int ai = 0; ai < 2; ++ai) _Pragma("unroll") for (int m = 0; m < 4; ++m)
#define EPI_LOOP_COLS for (int bj = 0; bj < 2; ++bj) _Pragma("unroll") for (int n = 0; n < 2; ++n)
#define EPI_ROW (u.pm * BM + ai * HALF + wr * 64 + m * 16 + fr)
#define EPI_COLT (bj * HALF + wc * 32 + n * 16 + 4 * fq)
typedef f32x4 acc_t[2][2][4][2];
__device__ __forceinline__ u32x2 pack4(f32x4 v) { u32x2 w; w.x = pk2(v[0], v[1]); w.y = pk2(v[2], v[3]); return w; }
__device__ __forceinline__ f32x4 unpack4(u32x2 w) { return (f32x4){bflo(w.x), bfhi(w.x), bflo(w.y), bfhi(w.y)}; }

struct EpiStore {
    static constexpr bool PERM = false;
    bf16* O; int ldc; int pn0;
    __device__ __forceinline__ void operator()(const acc_t& acc, const Unit& u, int wr, int wc, int fr, int fq) const {
#pragma unroll
        EPI_LOOP_ROWS { bf16* rp = O + (size_t)EPI_ROW * ldc + (u.pn - pn0) * BM;
#pragma unroll
            EPI_LOOP_COLS { *(u32x2*)(rp + EPI_COLT) = pack4(acc[ai][bj][m][n]); } }
    }
};
struct EpiRowScale {
    static constexpr bool PERM = false;
    bf16* O; int ldc; const float* rs;
    __device__ __forceinline__ void operator()(const acc_t& acc, const Unit& u, int wr, int wc, int fr, int fq) const {
        float sv[2][4];
#pragma unroll
        EPI_LOOP_ROWS sv[ai][m] = rs[EPI_ROW];
#pragma unroll
        EPI_LOOP_ROWS { const int row = EPI_ROW; const float s = sv[ai][m]; bf16* rp = O + (size_t)row * ldc + u.pn * BM;
#pragma unroll
            EPI_LOOP_COLS { *(u32x2*)(rp + EPI_COLT) = pack4(acc[ai][bj][m][n] * s); } }
    }
};
struct EpiMlaQ {
    static constexpr bool PERM = false;
    bf16* O; const float* rs; const float* cosT; const float* sinT;
    __device__ __forceinline__ void operator()(const acc_t& acc, const Unit& u, int wr, int wc, int fr, int fq) const {
        float sv[2][4]; f32x4 csv[2], snv[2];
#pragma unroll
        EPI_LOOP_ROWS sv[ai][m] = rs[EPI_ROW];
        { const int row = u.pm * BM + wr * 64 + fr; csv[0] = *(const f32x4*)(cosT + (size_t)row * 16 + 4 * fq); snv[0] = *(const f32x4*)(sinT + (size_t)row * 16 + 4 * fq); }
#pragma unroll
        for (int it = 0; it < 8; ++it) { const int ai = it >> 2, m = it & 3;
            if (it + 1 < 8) { const int row = u.pm * BM + ((it + 1) >> 2) * HALF + wr * 64 + ((it + 1) & 3) * 16 + fr;
                csv[(it + 1) & 1] = *(const f32x4*)(cosT + (size_t)row * 16 + 4 * fq); snv[(it + 1) & 1] = *(const f32x4*)(sinT + (size_t)row * 16 + 4 * fq); }
            const int row = EPI_ROW; const float s = sv[ai][m]; bf16* rp = O + (size_t)row * 512 + u.pn * BM;
            const f32x4 cs = csv[it & 1], sn = snv[it & 1];
#pragma unroll
            for (int bj = 0; bj < 2; ++bj) { const int grp = u.pn * 8 + bj * 4 + wc;
                f32x4 t1 = acc[ai][bj][m][0] * s, t2 = acc[ai][bj][m][1] * s;
                if (grp % 3 == 2) { const f32x4 a = t1 * cs - t2 * sn, b = t2 * cs + t1 * sn; t1 = a; t2 = b; }
                *(u32x2*)(rp + bj * HALF + wc * 32 + 4 * fq) = pack4(t1); *(u32x2*)(rp + bj * HALF + wc * 32 + 16 + 4 * fq) = pack4(t2); } }
    }
};
struct EpiGate {
    static constexpr bool PERM = false;
    bf16* G; const float* bias;
    __device__ __forceinline__ void operator()(const acc_t& acc, const Unit& u, int wr, int wc, int fr, int fq) const {
        f32x4 bv[2][2];
#pragma unroll
        EPI_LOOP_COLS bv[bj][n] = *(const f32x4*)(bias + u.pn * BM + EPI_COLT);
#pragma unroll
        EPI_LOOP_ROWS { bf16* rp = G + (size_t)EPI_ROW * D + u.pn * BM;
#pragma unroll
            EPI_LOOP_COLS { f32x4 v = acc[ai][bj][m][n] + bv[bj][n];
                v[0] = sigmoidf_(v[0]); v[1] = sigmoidf_(v[1]); v[2] = sigmoidf_(v[2]); v[3] = sigmoidf_(v[3]);
                *(u32x2*)(rp + EPI_COLT) = pack4(v); } }
    }
};
#define EPI_IT_ROW(it_) (u.pm * BM + ((it_) >> 2) * HALF + wr * 64 + ((it_) & 3) * 16 + fr)
#define EPI_C4(c_) (((c_) >> 1) * HALF + wc * 32 + ((c_) & 1) * 16 + 4 * fq)
struct EpiMerge {
    static constexpr bool PERM = false;
    const bf16* G; bf16* M; int first;
    __device__ __forceinline__ void operator()(const acc_t& acc, const Unit& u, int wr, int wc, int fr, int fq) const {
        u32x2 gv[2][4], mv[2][4];
#define EPI_LD(it_) do { const size_t ro_ = (size_t)EPI_IT_ROW(it_) * D + u.pn * BM; _Pragma("unroll") for (int c = 0; c < 4; ++c) { gv[(it_) & 1][c] = *(const u32x2*)(G + ro_ + EPI_C4(c)); \
            mv[(it_) & 1][c] = first ? (u32x2){0u, 0u} : *(const u32x2*)(M + ro_ + EPI_C4(c)); } } while (0)
        EPI_LD(0);
#pragma unroll
        for (int it = 0; it < 8; ++it) { if (it + 1 < 8) EPI_LD(it + 1);
            const size_t ro = (size_t)EPI_IT_ROW(it) * D + u.pn * BM;
#pragma unroll
            for (int c = 0; c < 4; ++c) { const f32x4 v = unpack4(gv[it & 1][c]) * acc[it >> 2][c >> 1][it & 3][c & 1] + unpack4(mv[it & 1][c]); *(u32x2*)(M + ro + EPI_C4(c)) = pack4(v); } }
#undef EPI_LD
    }
};
struct EpiRes {
    static constexpr bool PERM = false;
    XSrc xin; bf16* xout;
    __device__ __forceinline__ void operator()(const acc_t& acc, const Unit& u, int wr, int wc, int fr, int fq) const {
        f32x4 xv[2][4];
#define EPI_LD(it_) do { const size_t ro_ = (size_t)EPI_IT_ROW(it_) * D + u.pn * BM; _Pragma("unroll") for (int c = 0; c < 4; ++c) xv[(it_) & 1][c] = ldx4(xin, ro_ + EPI_C4(c)); } while (0)
        EPI_LD(0);
#pragma unroll
        for (int it = 0; it < 8; ++it) { if (it + 1 < 8) EPI_LD(it + 1);
            const size_t ro = (size_t)EPI_IT_ROW(it) * D + u.pn * BM;
#pragma unroll
            for (int c = 0; c < 4; ++c) *(u32x2*)(xout + ro + EPI_C4(c)) = pack4(xv[it & 1][c] + acc[it >> 2][c >> 1][it & 3][c & 1]); }
#undef EPI_LD
    }
};
struct EpiPle {
    static constexpr bool PERM = false;
    const bf16* U; float* x;
    __device__ __forceinline__ void operator()(const acc_t& acc, const Unit& u, int wr, int wc, int fr, int fq) const {
        f32x4 xv[2][4]; u32x2 uv[2][4];
#define EPI_LD(it_) do { const size_t ro_ = (size_t)EPI_IT_ROW(it_) * D + u.pn * BM; _Pragma("unroll") for (int c = 0; c < 4; ++c) { xv[(it_) & 1][c] = *(const f32x4*)(x + ro_ + EPI_C4(c)); uv[(it_) & 1][c] = *(const u32x2*)(U + ro_ + EPI_C4(c)); } } while (0)
        EPI_LD(0);
#pragma unroll
        for (int it = 0; it < 8; ++it) { if (it + 1 < 8) EPI_LD(it + 1);
            const size_t ro = (size_t)EPI_IT_ROW(it) * D + u.pn * BM;
#pragma unroll
            for (int c = 0; c < 4; ++c) { f32x4 v = acc[it >> 2][c >> 1][it & 3][c & 1];
                v[0] = sigmoidf_(v[0]); v[1] = sigmoidf_(v[1]); v[2] = sigmoidf_(v[2]); v[3] = sigmoidf_(v[3]);
                *(f32x4*)(x + ro + EPI_C4(c)) = xv[it & 1][c] + unpack4(uv[it & 1][c]) * v; } }
#undef EPI_LD
    }
};
struct EpiSwiglu {
    static constexpr bool PERM = false;
    bf16* O; int ldc; int npt;
    __device__ __forceinline__ void operator()(const acc_t& acc, const Unit& u, int wr, int wc, int fr, int fq) const {
        const int ct = (u.pn % npt) * HALF;
#pragma unroll
        EPI_LOOP_ROWS { bf16* rp = O + (size_t)EPI_ROW * ldc + ct + wc * 32 + 4 * fq;
#pragma unroll
            for (int n = 0; n < 2; ++n) { const f32x4 a = acc[ai][0][m][n], b = acc[ai][1][m][n]; f32x4 v;
#pragma unroll
                for (int e = 0; e < 4; ++e) v[e] = a[e] * sigmoidf_(a[e]) * b[e];
                *(u32x2*)(rp + n * 16) = pack4(v); } }
    }
};
struct EpiGlu {
    static constexpr bool PERM = false;
    bf16* Y; int ldc;
    __device__ __forceinline__ void operator()(const acc_t& acc, const Unit& u, int wr, int wc, int fr, int fq) const {
        u32x2 yv[2][4];
#define EPI_LD(it_) do { const bf16* rp_ = Y + (size_t)EPI_IT_ROW(it_) * ldc + u.pn * BM; _Pragma("unroll") for (int c = 0; c < 4; ++c) yv[(it_) & 1][c] = *(const u32x2*)(rp_ + EPI_C4(c)); } while (0)
        EPI_LD(0);
#pragma unroll
        for (int it = 0; it < 8; ++it) { if (it + 1 < 8) EPI_LD(it + 1);
            bf16* rp = Y + (size_t)EPI_IT_ROW(it) * ldc + u.pn * BM;
#pragma unroll
            for (int c = 0; c < 4; ++c) { const f32x4 y = unpack4(yv[it & 1][c]); f32x4 v = acc[it >> 2][c >> 1][it & 3][c & 1];
#pragma unroll
                for (int e = 0; e < 4; ++e) v[e] = y[e] * sigmoidf_(v[e]);
                *(u32x2*)(rp + EPI_C4(c)) = pack4(v); } }
#undef EPI_LD
    }
};
struct EpiMoeDown {
    static constexpr bool PERM = false;
    bf16* Y; const float* slot_gate;
    __device__ __forceinline__ void operator()(const acc_t& acc, const Unit& u, int wr, int wc, int fr, int fq) const {
        const int ct = (u.pn & 3) * BM;
        float gv[2][4];
#pragma unroll
        EPI_LOOP_ROWS gv[ai][m] = slot_gate[EPI_ROW];
#pragma unroll
        EPI_LOOP_ROWS { const int row = EPI_ROW; const float gt = gv[ai][m]; bf16* rp = Y + (size_t)row * D + ct;
#pragma unroll
            EPI_LOOP_COLS { *(u32x2*)(rp + EPI_COLT) = pack4(acc[ai][bj][m][n] * gt); } }
    }
};
}
namespace att {
constexpr int MODE_FOX = 0, MODE_MLA = 1, MODE_BAND = 2;
constexpr float LOG2E = 1.4426950408889634f;
struct Tensors {
    const bf16* Q; int ldq;
    const bf16* K; int ldk;
    const bf16* K2;
    const bf16* V; int ldv;
    bf16* O; int ldo;
    const float* cdec;
    const float* relb;
    int qhs, khs, vhs, ohs;
    const unsigned* qmax; const unsigned* kmax;
};
template <int DQK> struct Lay { static constexpr int KS = DQK * 2 + 16, KB = 64 * KS, VB = 64 * 128, CB = 256, BUF = KB + VB + CB; };
constexpr int ATT_LDS_TAB = 2 * Lay<96>::BUF;
constexpr int ATT_LDS_BYTES = ATT_LDS_TAB + 520 * 4;
__device__ __forceinline__ int crow(int r, int hi) { return (r & 3) + 8 * (r >> 2) + 4 * hi; }
typedef short v4i16_t __attribute__((ext_vector_type(4)));
__device__ __forceinline__ s16x4 vtr(const LAS unsigned char* p) { return __builtin_bit_cast(s16x4, __builtin_amdgcn_ds_read_tr16_b64_v4i16((LAS v4i16_t*)p)); }

template <int MODE>
__device__ __forceinline__ void attn_unit(const Tensors& T, int b, int h, int qb, LAS unsigned char* lds) {
    constexpr int DQK = (MODE == MODE_MLA) ? 96 : 64, NKS = DQK / 16;
    typedef Lay<DQK> LY;
    int tid = my_tid(); asm volatile("" : "+v"(tid));
    const int lane = tid & 63, r32 = lane & 31, hi = lane >> 5; const int wid = __builtin_amdgcn_readfirstlane(tid >> 6);
    const int rowb = b * SEQ, q0 = qb * 256;
    const float sc2 = ((MODE == MODE_MLA) ? 0.10206207261596575f : 0.125f) * LOG2E;
    const int cw = 4 * qb + (wid >> 1);
    const int t_lo = (MODE == MODE_BAND) ? ((4 * qb - 8) > 0 ? (4 * qb - 8) : 0) : 0, t_hi = 4 * qb + 4;
    const int qrow = rowb + q0 + wid * 32 + r32;
    bf16x8 qf[NKS];
    { const bf16* qp = T.Q + (size_t)qrow * T.ldq + h * T.qhs + hi * 8;
#pragma unroll
      for (int ks = 0; ks < NKS; ++ks) qf[ks] = *(const bf16x8*)(qp + ks * 16); }
    float cq = 0.f; if (MODE == MODE_FOX) cq = T.cdec[(size_t)qrow * 4 + h];
    LAS float* tab = (LAS float*)(lds + ATT_LDS_TAB);
    if (MODE == MODE_BAND) { for (int i = tid; i < 513; i += NTHREADS) tab[i] = T.relb[h * 513 + i] * LOG2E; }
    u32x4 kreg0[2] = {}, kreg1[2] = {}, vreg[2] = {}; float creg[2] = {0.f, 0.f};
    const int srow = tid >> 3, sch = tid & 7;
#define ATT_KADDR(c_) (((c_) % 12 < 8) ? (const u32x4*)(T.K + (kr_ + (c_) / 12) * T.ldk + h * T.khs + ((c_) % 12) * 8) : (const u32x4*)(T.K2 + (kr_ + (c_) / 12) * 32 + ((c_) % 12 - 8) * 8))
#define ATT_LOAD_TILE(t_, r_) do { const size_t kr_ = (size_t)(rowb + (t_) * 64); \
        if (MODE == MODE_MLA) { kreg0[r_] = *ATT_KADDR(tid); if (tid < 256) kreg1[r_] = *ATT_KADDR(tid + 512); } \
        else { kreg0[r_] = *(const u32x4*)(T.K + (kr_ + srow) * T.ldk + h * T.khs + sch * 8); } \
        vreg[r_] = *(const u32x4*)(T.V + (kr_ + srow) * T.ldv + h * T.vhs + sch * 8); \
        if (MODE == MODE_FOX) { if (tid < 64) creg[r_] = T.cdec[(kr_ + tid) * 4 + h]; } } while (0)
#define ATT_STORE_TILE(buf_, r_) do { LAS unsigned char* base_ = lds + (buf_) * LY::BUF; \
        if (MODE == MODE_MLA) { *(LAS u32x4*)(base_ + (tid / 12) * LY::KS + (tid % 12) * 16) = kreg0[r_]; \
            if (tid < 256) *(LAS u32x4*)(base_ + ((tid + 512) / 12) * LY::KS + ((tid + 512) % 12) * 16) = kreg1[r_]; } \
        else { *(LAS u32x4*)(base_ + srow * LY::KS + sch * 16) = kreg0[r_]; } \
        *(LAS u32x4*)(base_ + LY::KB + srow * 128 + ((sch * 16) ^ (((srow >> 1) & 1) << 6))) = vreg[r_]; \
        if (MODE == MODE_FOX) { if (tid < 64) *(LAS float*)(base_ + LY::KB + LY::VB + tid * 4) = creg[r_]; } } while (0)
    float mrun = -INFINITY, lrun = 0.f;
    f32x16 o0 = {}, o1 = {};
    const int G = lane >> 4, qi = (lane & 15) >> 2, pi = lane & 3;
    const int vb0 = (4 * hi + qi) * 128 + 64 * (0 ^ (qi >> 1)) + 32 * (G & 1) + 8 * pi;
    const int vb1 = (4 * hi + qi) * 128 + 64 * (1 ^ (qi >> 1)) + 32 * (G & 1) + 8 * pi;
    int t_min = t_lo;
    if (MODE == MODE_FOX) {
        LAS int* tm = (LAS int*)(lds + ATT_LDS_TAB);
        if (tid == 0) tm[0] = t_hi - 1;
        __syncthreads();
        if (tid < t_hi) {
            const float q2 = __uint_as_float(T.qmax[(b * 4 + h) * 32 + qb]), k2 = __uint_as_float(T.kmax[b * 4 + h]);
            const float thr = 0.125f * sqrtf(q2) * 2.0f * sqrtf(k2) * 1.02f + 112.0f;
            const float cfirst = T.cdec[(size_t)(rowb + q0) * 4 + h], clast = T.cdec[(size_t)(rowb + tid * 64 + 63) * 4 + h];
            if (!(clast - cfirst > thr)) __hip_atomic_fetch_min(tm, tid, __ATOMIC_RELAXED, __HIP_MEMORY_SCOPE_WORKGROUP);
        }
        __syncthreads();
        t_min = tm[0];
    }
    const int n_t = t_hi - t_min;
#define ATT_TILE(i_) ((MODE == MODE_FOX) ? (t_hi - 1 - (i_)) : (t_min + (i_)))
    ATT_LOAD_TILE(ATT_TILE(0), 0); ATT_STORE_TILE(0, 0);
    if (n_t > 1) ATT_LOAD_TILE(ATT_TILE(1), 1);
    if (n_t > 2) ATT_LOAD_TILE(ATT_TILE(2), 0);
    __syncthreads();
    for (int it0 = 0; it0 < n_t; it0 += 2) {
#pragma unroll
      for (int half = 0; half < 2; ++half) { const int it = it0 + half; if (it < n_t) {
        const int t = ATT_TILE(it);
        const int buf = half;
        const bool active = (MODE == MODE_BAND) ? (t <= cw && t >= cw - 8) : (t <= cw);
        if (active) {
            const LAS unsigned char* kb = lds + buf * LY::BUF;
            const LAS unsigned char* vbuf = kb + LY::KB;
            f32x16 p0 = {}, p1 = {};
            bf16x8 ka[NKS], kc[NKS];
#pragma unroll
            for (int ks = 0; ks < NKS; ++ks) { ka[ks] = *(const LAS bf16x8*)(kb + r32 * LY::KS + (ks * 16 + hi * 8) * 2); kc[ks] = *(const LAS bf16x8*)(kb + (32 + r32) * LY::KS + (ks * 16 + hi * 8) * 2); }
            __builtin_amdgcn_sched_barrier(0);
#pragma unroll
            for (int ks = 0; ks < NKS; ++ks) { p0 = __builtin_amdgcn_mfma_f32_32x32x16_bf16(ka[ks], qf[ks], p0, 0, 0, 0); p1 = __builtin_amdgcn_mfma_f32_32x32x16_bf16(kc[ks], qf[ks], p1, 0, 0, 0); }
            s16x4 vl0[4], vh0[4], vl1[4], vh1[4];
#pragma unroll
            for (int s4 = 0; s4 < 4; ++s4) { vl0[s4] = vtr(vbuf + vb0 + s4 * 2048); vh0[s4] = vtr(vbuf + vb0 + s4 * 2048 + 1024); vl1[s4] = vtr(vbuf + vb1 + s4 * 2048); vh1[s4] = vtr(vbuf + vb1 + s4 * 2048 + 1024); }
            __builtin_amdgcn_sched_barrier(0);
            if (MODE == MODE_FOX) {
                const LAS float* cb = (const LAS float*)(vbuf + LY::VB);
                const float cq2 = cq * LOG2E;
#pragma unroll
                for (int a = 0; a < 4; ++a) {
                    const f32x4 c0 = *(const LAS f32x4*)(cb + 8 * a + 4 * hi), c1 = *(const LAS f32x4*)(cb + 32 + 8 * a + 4 * hi);
#pragma unroll
                    for (int e = 0; e < 4; ++e) { p0[4 * a + e] = p0[4 * a + e] * sc2 + (cq2 - c0[e] * LOG2E); p1[4 * a + e] = p1[4 * a + e] * sc2 + (cq2 - c1[e] * LOG2E); }
                }
                if (t == cw) { const int ql = 32 * (wid & 1) + r32;
#pragma unroll
                    for (int r = 0; r < 16; ++r) { const int kv = crow(r, hi); if (kv > ql) p0[r] = -INFINITY; if (kv + 32 > ql) p1[r] = -INFINITY; } }
            } else if (MODE == MODE_BAND) {
                const int dq = (q0 + wid * 32 + r32) - t * 64;
#pragma unroll
                for (int r = 0; r < 16; ++r) { const int kv = crow(r, hi);
                    int i0 = dq - kv, i1 = dq - kv - 32; i0 = i0 < -256 ? -256 : (i0 > 256 ? 256 : i0); i1 = i1 < -256 ? -256 : (i1 > 256 ? 256 : i1);
                    p0[r] = p0[r] * sc2 + tab[i0 + 256]; p1[r] = p1[r] * sc2 + tab[i1 + 256]; }
            }
            float mx = fmaxf(p0[0], p1[0]);
#pragma unroll
            for (int r = 1; r < 16; ++r) mx = fmaxf(mx, fmaxf(p0[r], p1[r]));
            { auto rr = __builtin_amdgcn_permlane32_swap(__float_as_uint(mx), __float_as_uint(mx), false, false); mx = fmaxf(__uint_as_float(rr[0]), __uint_as_float(rr[1])); }
            if (MODE == MODE_MLA) mx *= sc2;
            const float mnew = fmaxf(mrun, mx);
            if (__any(mnew > mrun)) {
                const float alpha = __builtin_amdgcn_exp2f(mrun - mnew);
                lrun *= alpha;
#pragma unroll
                for (int r = 0; r < 16; ++r) { o0[r] *= alpha; o1[r] *= alpha; }
                mrun = mnew;
            }
            float rs = 0.f;
#pragma unroll
            for (int r = 0; r < 16; ++r) {
                if (MODE == MODE_MLA) { p0[r] = __builtin_amdgcn_exp2f(__builtin_fmaf(p0[r], sc2, -mrun)); p1[r] = __builtin_amdgcn_exp2f(__builtin_fmaf(p1[r], sc2, -mrun)); }
                else { p0[r] = __builtin_amdgcn_exp2f(p0[r] - mrun); p1[r] = __builtin_amdgcn_exp2f(p1[r] - mrun); }
                rs += p0[r] + p1[r]; }
            lrun += rs;
#pragma unroll
            for (int s4 = 0; s4 < 4; ++s4) {
                u32x4 pw;
                if (s4 < 2) { const int o = 8 * (s4 & 1); pw.x = pk2(p0[o], p0[o + 1]); pw.y = pk2(p0[o + 2], p0[o + 3]); pw.z = pk2(p0[o + 4], p0[o + 5]); pw.w = pk2(p0[o + 6], p0[o + 7]); }
                else        { const int o = 8 * (s4 & 1); pw.x = pk2(p1[o], p1[o + 1]); pw.y = pk2(p1[o + 2], p1[o + 3]); pw.z = pk2(p1[o + 4], p1[o + 5]); pw.w = pk2(p1[o + 6], p1[o + 7]); }
                const bf16x8 pf = __builtin_bit_cast(bf16x8, pw);
                const s16x4 l0 = vl0[s4], h0 = vh0[s4], l1 = vl1[s4], h1 = vh1[s4];
                const bf16x8 vf0 = (bf16x8){l0[0], l0[1], l0[2], l0[3], h0[0], h0[1], h0[2], h0[3]};
                const bf16x8 vf1 = (bf16x8){l1[0], l1[1], l1[2], l1[3], h1[0], h1[1], h1[2], h1[3]};
                o0 = __builtin_amdgcn_mfma_f32_32x32x16_bf16(vf0, pf, o0, 0, 0, 0);
                o1 = __builtin_amdgcn_mfma_f32_32x32x16_bf16(vf1, pf, o1, 0, 0, 0);
            }
        }
        if (it + 1 < n_t) ATT_STORE_TILE(half ^ 1, half ^ 1);
        if (it + 3 < n_t) ATT_LOAD_TILE(ATT_TILE(it + 3), half ^ 1);
        __syncthreads();
      } }
    }
    { auto rr = __builtin_amdgcn_permlane32_swap(__float_as_uint(lrun), __float_as_uint(lrun), false, false); lrun = __uint_as_float(rr[0]) + __uint_as_float(rr[1]); }
    const float inv = 1.0f / lrun;
    bf16* op = T.O + (size_t)qrow * T.ldo + h * T.ohs;
#pragma unroll
    for (int a = 0; a < 4; ++a) {
        u32x2 w0, w1;
        w0.x = pk2(o0[4 * a] * inv, o0[4 * a + 1] * inv); w0.y = pk2(o0[4 * a + 2] * inv, o0[4 * a + 3] * inv);
        w1.x = pk2(o1[4 * a] * inv, o1[4 * a + 1] * inv); w1.y = pk2(o1[4 * a + 2] * inv, o1[4 * a + 3] * inv);
        *(u32x2*)(op + 8 * a + 4 * hi) = w0; *(u32x2*)(op + 32 + 8 * a + 4 * hi) = w1;
    }
}

template <int MODE>
__device__ __forceinline__ void attn_phase(const Tensors& T, LAS unsigned char* lds) {
    const int G = gridDim.x, bx = blockIdx.x, vcu = (G % 8 == 0) ? (bx % 8) * (G / 8) + bx / 8 : bx;
    for (int pr = vcu; pr < 256; pr += G) {
        const int bh = pr >> 4, s = pr & 15;
        attn_unit<MODE>(T, bh >> 2, bh & 3, s, lds);
        attn_unit<MODE>(T, bh >> 2, bh & 3, 31 - s, lds);
    }
}

template <int MODE>
__device__ __forceinline__ void attn_naive(const Tensors& T) {
    BODY_IDS();
    constexpr int DQK = (MODE == MODE_MLA) ? 96 : 64;
    const float sc = (MODE == MODE_MLA) ? 0.10206207261596575f : 0.125f;
    for (int idx = gtid; idx < NTOK * 4; idx += gthreads) {
        const int h = idx / NTOK, row = idx % NTOK, b = row / SEQ, tpos = row % SEQ, rowb = b * SEQ;
        float q[DQK], o[64];
#pragma unroll
        for (int d = 0; d < DQK; ++d) q[d] = bf2f(T.Q[(size_t)row * T.ldq + h * T.qhs + d]) * sc;
#pragma unroll
        for (int d = 0; d < 64; ++d) o[d] = 0.f;
        float m = -INFINITY, l = 0.f;
        const int ck = tpos / 64;
        const int k_lo = (MODE == MODE_BAND) ? ((ck - 8) > 0 ? (ck - 8) * 64 : 0) : 0;
        const int k_hi = (MODE == MODE_FOX) ? tpos : (ck * 64 + 63);
        const float cq = (MODE == MODE_FOX) ? T.cdec[(size_t)row * 4 + h] : 0.f;
        for (int kv = k_lo; kv <= k_hi; ++kv) {
            const size_t kr = (size_t)(rowb + kv);
            float s = 0.f;
#pragma unroll
            for (int d8 = 0; d8 < 8; ++d8) { const u32x4 w = *(const u32x4*)(T.K + kr * T.ldk + h * T.khs + d8 * 8);
                s += q[d8 * 8 + 0] * bflo(w.x) + q[d8 * 8 + 1] * bfhi(w.x) + q[d8 * 8 + 2] * bflo(w.y) + q[d8 * 8 + 3] * bfhi(w.y)
                   + q[d8 * 8 + 4] * bflo(w.z) + q[d8 * 8 + 5] * bfhi(w.z) + q[d8 * 8 + 6] * bflo(w.w) + q[d8 * 8 + 7] * bfhi(w.w); }
            if (MODE == MODE_MLA) {
#pragma unroll
                for (int d8 = 0; d8 < 4; ++d8) { const u32x4 w = *(const u32x4*)(T.K2 + kr * 32 + d8 * 8);
                    s += q[64 + d8 * 8 + 0] * bflo(w.x) + q[64 + d8 * 8 + 1] * bfhi(w.x) + q[64 + d8 * 8 + 2] * bflo(w.y) + q[64 + d8 * 8 + 3] * bfhi(w.y)
                       + q[64 + d8 * 8 + 4] * bflo(w.z) + q[64 + d8 * 8 + 5] * bfhi(w.z) + q[64 + d8 * 8 + 6] * bflo(w.w) + q[64 + d8 * 8 + 7] * bfhi(w.w); }
            }
            if (MODE == MODE_FOX) s += cq - T.cdec[kr * 4 + h];
            if (MODE == MODE_BAND) { int rel = tpos - kv; rel = rel < -256 ? -256 : (rel > 256 ? 256 : rel); s += T.relb[h * 513 + rel + 256]; }
            const float mn = fmaxf(m, s), al = __expf(m - mn), pp = __expf(s - mn);
            l = l * al + pp; m = mn;
#pragma unroll
            for (int d8 = 0; d8 < 8; ++d8) { const u32x4 w = *(const u32x4*)(T.V + kr * T.ldv + h * T.vhs + d8 * 8);
                o[d8 * 8 + 0] = o[d8 * 8 + 0] * al + pp * bflo(w.x); o[d8 * 8 + 1] = o[d8 * 8 + 1] * al + pp * bfhi(w.x);
                o[d8 * 8 + 2] = o[d8 * 8 + 2] * al + pp * bflo(w.y); o[d8 * 8 + 3] = o[d8 * 8 + 3] * al + pp * bfhi(w.y);
                o[d8 * 8 + 4] = o[d8 * 8 + 4] * al + pp * bflo(w.z); o[d8 * 8 + 5] = o[d8 * 8 + 5] * al + pp * bfhi(w.z);
                o[d8 * 8 + 6] = o[d8 * 8 + 6] * al + pp * bflo(w.w); o[d8 * 8 + 7] = o[d8 * 8 + 7] * al + pp * bfhi(w.w); }
        }
        const float inv = 1.0f / l;
#pragma unroll
        for (int d = 0; d < 64; d += 2) *(unsigned*)(T.O + (size_t)row * T.ldo + h * T.ohs + d) = pk2(o[d] * inv, o[d + 1] * inv);
    }
}
}
struct Params {
    const float* in[37];
    float* out;
    unsigned char* ws;
    int ph_lo, ph_hi;
};
enum { I_X = 0, I_P, I_POS, I_WIN, I_SAR, I_SAI, I_SLDT, I_SBR, I_SBI, I_SCR, I_SCI, I_SD, I_SGLU, I_FBF, I_GQ, I_WUQ, I_GKV, I_WUKV, I_RELB, I_WB, I_WG, I_BG, I_WO,
       I_GMIX, I_GFFN, I_FW1, I_FW3, I_FW2, I_MWR, I_MBR, I_MW1, I_MW3, I_MW2, I_GPLE, I_PWG, I_PWU, I_GFIN };

__device__ __forceinline__ void sincos_rad(double a, float& s, float& c) {
    double r = a * 0.15915494309189535; r = r - __builtin_rint(r); const float f = (float)r;
    s = __builtin_amdgcn_sinf(f); c = __builtin_amdgcn_cosf(f);
}
__device__ __forceinline__ float gelu_tanh(float x) {
    const float z = 0.7978845608028654f * (x + 0.044715f * x * x * x);
    const float e = __expf(2.0f * z); const float th = 1.0f - 2.0f / (1.0f + e);
    return 0.5f * x * (1.0f + th);
}
__device__ __forceinline__ float log_sigmoid(float z) { return fminf(z, 0.f) - log1pf(__expf(-fabsf(z))); }

struct CvtJob { const float* src; const float* ks; bf16* dst; int K, ldsrc, col0, ncols, row0, ldk, ilv; };
__device__ __forceinline__ void cvt_item(const CvtJob& J, LAS float* scr, int item, int lane) {
    const int nblk = (J.ncols + 63) >> 6, kb = item / nblk, nb = item % nblk, k0 = 64 * kb, n0 = 64 * nb;
    const int n4 = (lane & 15) * 4; const bool inb = (n0 + n4) < J.ncols;
#pragma unroll 8
    for (int i = 0; i < 16; ++i) { const int kk = 4 * i + (lane >> 4); f32x4 v = {0.f, 0.f, 0.f, 0.f};
        if (inb) v = *(const f32x4*)(J.src + (size_t)(k0 + kk) * J.ldsrc + J.col0 + n0 + n4);
        if (J.ks) v = v * J.ks[k0 + kk];
        *(LAS f32x4*)(scr + kk * 68 + n4) = v; }
    LDS_WAIT(); asm volatile("" ::: "memory");
    const int c = lane & 7;
#pragma unroll
    for (int j = 0; j < 8; ++j) { const int n = (lane >> 3) + 8 * j; const LAS float* s = scr + (8 * c) * 68 + n;
        u32x4 o; o.x = pk2(s[0 * 68], s[1 * 68]); o.y = pk2(s[2 * 68], s[3 * 68]); o.z = pk2(s[4 * 68], s[5 * 68]); o.w = pk2(s[6 * 68], s[7 * 68]);
        const int nn = n0 + n; const int row = J.row0 + (J.ilv ? ((nn >> 7) * 256 + (nn & 127)) : nn);
        if (nn < J.ncols) *(u32x4*)(J.dst + (size_t)row * J.ldk + k0 + 8 * c) = o; }
    LDS_WAIT(); asm volatile("" ::: "memory");
}
__device__ __forceinline__ bf16* wmix(const Params& P, int L, size_t off) { return (bf16*)(P.ws + WS_WMIX + (size_t)L * WMIX_STRIDE + off); }
__device__ __forceinline__ CvtJob get_job(const Params& P, int j) {
    CvtJob J; J.ks = nullptr; J.ilv = 0; J.col0 = 0; J.row0 = 0;
    if (j < 40) {
        const int L = j / 20, q = j % 20;
        if (q < 5) {
            J.src = P.in[I_WIN] + (size_t)L * D * DIN; J.K = D; J.ldsrc = DIN; J.dst = wmix(P, L, WM_IN); J.ldk = D;
            J.col0 = q == 0 ? 0 : q == 1 ? 1380 : q == 2 ? 1028 : q == 3 ? 1220 : 1348;
            J.ncols = q == 0 ? 1024 : q == 1 ? 768 : q == 2 ? 192 : q == 3 ? 128 : 32;
            J.row0 = q == 0 ? 0 : q == 1 ? 1024 : q == 2 ? 1792 : q == 3 ? 2048 : 2176;
        } else if (q < 9) { const int k = q - 5; J.src = P.in[I_WG] + ((size_t)L * 4 + k) * D * D; J.K = D; J.ldsrc = D; J.ncols = D; J.row0 = k * D; J.dst = wmix(P, L, WM_G); J.ldk = D;
        } else if (q < 13) { const int k = q - 9; J.src = P.in[I_WB] + ((size_t)L * 4 + k) * 256 * D; J.K = 256; J.ldsrc = D; J.ncols = D; J.row0 = k * D; J.dst = wmix(P, L, WM_B); J.ldk = 256;
        } else if (q == 13) { J.src = P.in[I_WO] + (size_t)L * D * D; J.K = D; J.ldsrc = D; J.ncols = D; J.dst = wmix(P, L, WM_O); J.ldk = D;
        } else if (q == 14) { J.src = P.in[I_PWG] + (size_t)L * D * D; J.K = D; J.ldsrc = D; J.ncols = D; J.dst = wmix(P, L, WM_PG); J.ldk = D;
        } else if (q == 15) { J.src = P.in[I_PWU] + (size_t)L * 256 * D; J.K = 256; J.ldsrc = D; J.ncols = D; J.dst = wmix(P, L, WM_UP); J.ldk = 256;
        } else if (q == 16) { J.src = P.in[I_WUQ] + (size_t)L * 192 * 384; J.ks = P.in[I_GQ] + L * 192; J.K = 192; J.ldsrc = 384; J.ncols = 384; J.dst = wmix(P, L, WM_UQ); J.ldk = 256;
        } else if (q == 17) { J.src = P.in[I_WUKV] + (size_t)L * 128 * 512; J.ks = P.in[I_GKV] + L * 128; J.K = 128; J.ldsrc = 512; J.ncols = 512; J.dst = wmix(P, L, WM_UKV); J.ldk = 128;
        } else if (q == 18) { J.src = P.in[I_SGLU] + (size_t)L * 256 * 256; J.K = 256; J.ldsrc = 256; J.ncols = 256; J.dst = wmix(P, L, WM_GLU); J.ldk = 256;
        } else { J.src = nullptr; J.K = 0; J.ldsrc = 0; J.ncols = 32; J.dst = nullptr; J.ldk = 0; }
    } else if (j < 43) {
        const int q = j - 40;
        if (q == 0) { J.src = P.in[I_FW1]; J.K = D; J.ldsrc = DFF; J.ncols = DFF; J.dst = (bf16*)(P.ws + WS_W13); J.ldk = D; J.ilv = 1; }
        else if (q == 1) { J.src = P.in[I_FW3]; J.K = D; J.ldsrc = DFF; J.ncols = DFF; J.row0 = 128; J.dst = (bf16*)(P.ws + WS_W13); J.ldk = D; J.ilv = 1; }
        else { J.src = P.in[I_FW2]; J.K = DFF; J.ldsrc = D; J.ncols = D; J.dst = (bf16*)(P.ws + WS_W2); J.ldk = DFF; }
    } else {
        const int e = (j - 43) / 3, q = (j - 43) % 3;
        if (q == 0) { J.src = P.in[I_MW1] + (size_t)e * D * DFFE; J.K = D; J.ldsrc = DFFE; J.ncols = DFFE; J.row0 = e * 2816; J.dst = (bf16*)(P.ws + WS_WM13); J.ldk = D; J.ilv = 1; }
        else if (q == 1) { J.src = P.in[I_MW3] + (size_t)e * D * DFFE; J.K = D; J.ldsrc = DFFE; J.ncols = DFFE; J.row0 = e * 2816 + 128; J.dst = (bf16*)(P.ws + WS_WM13); J.ldk = D; J.ilv = 1; }
        else { J.src = P.in[I_MW2] + (size_t)e * DFFE * D; J.K = DFFE; J.ldsrc = D; J.ncols = D; J.row0 = e * D; J.dst = (bf16*)(P.ws + WS_WM2); J.ldk = DFFE; }
    }
    return J;
}
__device__ __forceinline__ void cvt_jobs(const Params& P, int j_lo, int j_hi, LAS unsigned char* lds) {
    BODY_IDS();
    LAS float* scr = (LAS float*)(lds + wave * 17408);
    int acc = 0;
    for (int j = j_lo; j < j_hi; ++j) {
        const CvtJob J = get_job(P, j);
        const int items = (J.K / 64) * ((J.ncols + 63) >> 6);
        int first = (gw - (acc % ngw) + ngw) % ngw;
        for (int it = first; it < items; it += ngw) cvt_item(J, scr, it, lane);
        acc += items;
    }
}

__device__ __forceinline__ void p0_misc(const Params& P) {
    BODY_IDS();
    { const f32x4* src = (const f32x4*)P.in[I_P]; u32x2* dst = (u32x2*)(P.ws + WS_PBF);
      for (int i = gtid; i < 2 * NTOK * 256 / 4; i += gthreads) { const f32x4 v = src[i]; u32x2 w; w.x = pk2(v[0], v[1]); w.y = pk2(v[2], v[3]); dst[i] = w; } }
    { const int* pos = (const int*)P.in[I_POS]; float* ct = (float*)(P.ws + WS_COS); float* st = (float*)(P.ws + WS_SIN);
      const double invf[16] = {1.0, 0.5623413251903491, 0.31622776601683794, 0.1778279410038923, 0.1, 0.05623413251903491, 0.03162277660168379, 0.01778279410038923,
                               0.01, 0.005623413251903491, 0.0031622776601683794, 0.0017782794100389228, 0.001, 0.0005623413251903491, 0.00031622776601683794, 0.00017782794100389227};
      for (int i = gtid; i < NTOK * 16; i += gthreads) { const int row = i >> 4, f = i & 15; double iv = invf[0];
#pragma unroll
          for (int q = 1; q < 16; ++q) iv = (f == q) ? invf[q] : iv;
          const float ang = (float)pos[row] * (float)iv; float s, c; sincos_rad((double)ang, s, c); ct[i] = c; st[i] = s; } }
    for (int L = 0; L < 2; ++L) {
        bf16* win = wmix(P, L, WM_IN);
        for (int i = gtid; i < (64 + 96) * D / 8; i += gthreads) { const int e = i * 8, r = e / D, k = e % D; const int row = r < 64 ? 1984 + r : 2208 + (r - 64); *(u32x4*)(win + (size_t)row * D + k) = (u32x4){0u, 0u, 0u, 0u}; }
        bf16* wuq = wmix(P, L, WM_UQ);
        for (int i = gtid; i < 512 * 256 / 8; i += gthreads) { const int e = i * 8, r = e / 256, k = e % 256; if (r >= 384 || k >= 192) *(u32x4*)(wuq + e) = (u32x4){0u, 0u, 0u, 0u}; }
    }
}

__device__ __forceinline__ void rms_load(const XSrc& x, int row, int lane, f32x4 (&v)[4]) {
#pragma unroll
    for (int j = 0; j < 4; ++j) v[j] = ldx4(x, (size_t)row * D + 4 * lane + 256 * j);
}
__device__ __forceinline__ void rms_finish(const float* gain, bf16* orow, int lane, f32x4 (&v)[4]) {
    float s = 0.f;
#pragma unroll
    for (int j = 0; j < 4; ++j) s += (v[j][0] * v[j][0] + v[j][1] * v[j][1]) + (v[j][2] * v[j][2] + v[j][3] * v[j][3]);
    const float rstd = 1.0f / sqrtf(wave_sum(s) * (1.0f / D) + RMS_EPS);
    const f32x4* gr = (const f32x4*)gain + lane;
    u32x2* o8 = (u32x2*)orow + lane;
#pragma unroll
    for (int j = 0; j < 4; ++j) { v[j] = v[j] * rstd * gr[64 * j]; if (orow) { u32x2 w; w.x = pk2(v[j][0], v[j][1]); w.y = pk2(v[j][2], v[j][3]); o8[64 * j] = w; } }
}
#define RMS_ROWS_BEGIN(x_, rowexpr_) f32x4 v[4], vn_[4]; { const int i = 0; rms_load(x_, (rowexpr_), lane, v); } for (int i = 0; i < 16; ++i) { if (i + 1 < 16) { const int i_ = i; { const int i = i_ + 1; rms_load(x_, (rowexpr_), lane, vn_); } }
#define RMS_ROWS_END() _Pragma("unroll") for (int j_ = 0; j_ < 4; ++j_) v[j_] = vn_[j_]; }
__device__ __forceinline__ void norm_plain(const XSrc x, const float* gain, bf16* H, int first, int stride) {
    BODY_IDS();
    for (int u = first; u < NTOK / 128; u += stride)
    { RMS_ROWS_BEGIN(x, u * 128 + wave * 16 + i) const int row = u * 128 + wave * 16 + i; rms_finish(gain, H + (size_t)row * D, lane, v); RMS_ROWS_END() }
}
__device__ __forceinline__ void norm1_phase(const Params& P, int L, const XSrc x, int first, int stride) {
    BODY_IDS();
    const float* win = P.in[I_WIN] + (size_t)L * D * DIN;
    f32x4 wff[4][4];
#pragma unroll
    for (int j = 0; j < 4; ++j)
#pragma unroll
        for (int e = 0; e < 4; ++e) wff[j][e] = *(const f32x4*)(win + (size_t)(4 * lane + 256 * j + e) * DIN + 1024);
    const float* gain = P.in[I_GMIX] + L * D; bf16* H = (bf16*)(P.ws + WS_H);
    float* logf = (float*)(P.ws + WS_LOGF); float* wsum = (float*)(P.ws + WS_WSUM);
    const f32x4 bf = *(const f32x4*)(P.in[I_FBF] + L * 4);
    for (int u = first; u < NTOK / 128; u += stride) { const int g0 = u * 8 + wave;
        f32x4 run = {0.f, 0.f, 0.f, 0.f};
        RMS_ROWS_BEGIN(x, g0 * 16 + i) const int row = g0 * 16 + i; rms_finish(gain, H + (size_t)row * D, lane, v);
            f32x4 d = {0.f, 0.f, 0.f, 0.f};
#pragma unroll
            for (int j = 0; j < 4; ++j)
#pragma unroll
                for (int e = 0; e < 4; ++e) d += wff[j][e] * v[j][e];
#pragma unroll
            for (int e = 0; e < 4; ++e) { d[e] = wave_sum(d[e]); run[e] += log_sigmoid(d[e] + bf[e]); }
            if (lane == 0) *(f32x4*)(logf + (size_t)row * 4) = run; RMS_ROWS_END()
        if (lane == 0) *(f32x4*)(wsum + (size_t)g0 * 4) = run;
    }
    __syncthreads();
}
__device__ __forceinline__ void prep_phase(const Params& P, int L) {
    BODY_IDS();
    unsigned* qmaxw = (unsigned*)(P.ws + WS_CTL) + CW_QMAX + L * 512; unsigned* kmaxw = (unsigned*)(P.ws + WS_CTL) + CW_KMAX + L * 16;
    const float* logf = (const float*)(P.ws + WS_LOGF); const float* wsum = (const float*)(P.ws + WS_WSUM); float* cdec = (float*)(P.ws + WS_CDEC);
    float* rq = (float*)(P.ws + WS_RSTDQ); float* rkv = (float*)(P.ws + WS_RSTDKV); const bf16* zin = (const bf16*)(P.ws + WS_ZIN); bf16* kper = (bf16*)(P.ws + WS_KPER);
    const float* ct = (const float*)(P.ws + WS_COS); const float* st = (const float*)(P.ws + WS_SIN);
    for (int g0 = gw; g0 < NTOK / 16; g0 += ngw) {
        const int first = (g0 / 512) * 512;
        f32x4 pre = {0.f, 0.f, 0.f, 0.f};
        for (int i = first + lane; i < g0; i += 64) pre += *(const f32x4*)(wsum + (size_t)i * 4);
#pragma unroll
        for (int e = 0; e < 4; ++e) pre[e] = wave_sum(pre[e]);
        if (lane < 16) { const int row = g0 * 16 + lane; *(f32x4*)(cdec + (size_t)row * 4) = *(const f32x4*)(logf + (size_t)row * 4) + pre; }
        float q2m = 0.f, k2m = 0.f;
        for (int i = 0; i < 16; ++i) { const int row = g0 * 16 + i; const bf16* zr = zin + (size_t)row * ZP;
            { const u32x2 wq = *(const u32x2*)(zr + ZC_FQ + 4 * lane), wk = *(const u32x2*)(zr + ZC_FK + 4 * lane);
              float sq_ = bflo(wq.x) * bflo(wq.x) + bfhi(wq.x) * bfhi(wq.x) + bflo(wq.y) * bflo(wq.y) + bfhi(wq.y) * bfhi(wq.y);
              float sk_ = bflo(wk.x) * bflo(wk.x) + bfhi(wk.x) * bfhi(wk.x) + bflo(wk.y) * bflo(wk.y) + bfhi(wk.y) * bfhi(wk.y);
#pragma unroll
              for (int o = 1; o < 16; o <<= 1) { sq_ += shflx(sq_, o, lane); sk_ += shflx(sk_, o, lane); }
              q2m = fmaxf(q2m, sq_); k2m = fmaxf(k2m, sk_); }
            const float a0 = bf2f(zr[ZC_CQ + lane]), a1 = bf2f(zr[ZC_CQ + 64 + lane]), a2 = bf2f(zr[ZC_CQ + 128 + lane]);
            const float b0 = bf2f(zr[ZC_CKV + lane]), b1 = bf2f(zr[ZC_CKV + 64 + lane]);
            const float sq = wave_sum(a0 * a0 + a1 * a1 + a2 * a2), skv = wave_sum(b0 * b0 + b1 * b1);
            if (lane == 0) { rq[row] = 1.0f / sqrtf(sq * (1.0f / 192.0f) + RMS_EPS); rkv[row] = 1.0f / sqrtf(skv * (1.0f / 128.0f) + RMS_EPS); }
            if (lane < 16) { const float t1 = bf2f(zr[ZC_KPE + lane]), t2 = bf2f(zr[ZC_KPE + 16 + lane]); const float c = ct[(size_t)row * 16 + lane], s = st[(size_t)row * 16 + lane];
                kper[(size_t)row * 32 + lane] = (bf16)f2bf(t1 * c - t2 * s); kper[(size_t)row * 32 + 16 + lane] = (bf16)f2bf(t2 * c + t1 * s); } }
        if ((lane & 15) == 0) { const int row0 = g0 * 16, b = row0 / SEQ, qb = (row0 % SEQ) / 256, h = lane >> 4;
            atomicMax(qmaxw + (b * 4 + h) * 32 + qb, __float_as_uint(q2m)); atomicMax(kmaxw + b * 4 + h, __float_as_uint(k2m)); }
    }
}
struct FinalRows { u32x2 w[16][4]; };
__device__ __forceinline__ void final_norm_load(const Params& P, int u, FinalRows& R) {
    BODY_IDS();
    const bf16* xb = xr_of(P.out);
#pragma unroll
    for (int i = 0; i < 16; ++i) { const u32x2* xr = (const u32x2*)(xb + (size_t)(u * 128 + wave * 16 + i) * D) + lane;
#pragma unroll
        for (int j = 0; j < 4; ++j) R.w[i][j] = xr[64 * j]; }
}
__device__ __forceinline__ void final_norm_store(const Params& P, int u, const FinalRows& R) {
    BODY_IDS();
    const f32x4* gr = (const f32x4*)P.in[I_GFIN] + lane;
#pragma unroll
    for (int i = 0; i < 16; ++i) { f32x4 v[4]; float s = 0.f;
#pragma unroll
        for (int j = 0; j < 4; ++j) { const u32x2 w = R.w[i][j]; v[j] = (f32x4){bflo(w.x), bfhi(w.x), bflo(w.y), bfhi(w.y)}; s += (v[j][0] * v[j][0] + v[j][1] * v[j][1]) + (v[j][2] * v[j][2] + v[j][3] * v[j][3]); }
        const float rstd = 1.0f / sqrtf(wave_sum(s) * (1.0f / D) + RMS_EPS);
        f32x4* xo = (f32x4*)(P.out + (size_t)(u * 128 + wave * 16 + i) * D) + lane;
#pragma unroll
        for (int j = 0; j < 4; ++j) xo[64 * j] = v[j] * rstd * gr[64 * j]; }
}
namespace s5 {
struct Coef { float abr, abi; f32x2 B2[16]; float a64r, a64i; };
__device__ __forceinline__ void coef(const Params& P, int L, int g, int p, Coef& C) {
    const float dt = __expf(P.in[I_SLDT][L * 16 + g]); const float ar = P.in[I_SAR][(L * 16 + g) * 64 + p], ai = P.in[I_SAI][(L * 16 + g) * 64 + p];
    const float mag = __expf(ar * dt); float sn, cs; sincos_rad((double)(ai * dt), sn, cs);
    C.abr = mag * cs; C.abi = mag * sn;
    const float den = ar * ar + ai * ai, nr = C.abr - 1.0f, ni = C.abi;
    const float cr = (nr * ar + ni * ai) / den, ci = (ni * ar - nr * ai) / den;
    const float* br = P.in[I_SBR] + ((size_t)(L * 16 + g) * 64 + p) * 16; const float* bi = P.in[I_SBI] + ((size_t)(L * 16 + g) * 64 + p) * 16;
#pragma unroll
    for (int h = 0; h < 16; ++h) { const float r = br[h], i = bi[h]; C.B2[h] = (f32x2){cr * r - ci * i, cr * i + ci * r}; }
    const float m64 = __expf(64.0f * ar * dt); float s64, c64; sincos_rad(64.0 * (double)(ai * dt), s64, c64);
    C.a64r = m64 * c64; C.a64i = m64 * s64;
}
constexpr int WAVE_LDS = 8448;
template <bool EMIT>
__device__ __forceinline__ void chunk(const Params& P, int L, int g, int row0, const Coef& C, float& xr, float& xi, LAS unsigned char* wl, int lane, const bf16x8 (&cf)[4], float dsk) {
    bf16* zin = (bf16*)(P.ws + WS_ZIN);
    LAS float* ut = (LAS float*)wl; LAS unsigned* xt = (LAS unsigned*)(wl + 4096);
    { const u32x4* up = (const u32x4*)(zin + (size_t)(row0 + lane) * ZP + ZC_U + g * 16); const u32x4 w0 = up[0], w1 = up[1];
      LAS f32x4* d = (LAS f32x4*)(ut + lane * 16);
      d[0] = (f32x4){bflo(w0.x), bfhi(w0.x), bflo(w0.y), bfhi(w0.y)}; d[1] = (f32x4){bflo(w0.z), bfhi(w0.z), bflo(w0.w), bfhi(w0.w)};
      d[2] = (f32x4){bflo(w1.x), bfhi(w1.x), bflo(w1.y), bfhi(w1.y)}; d[3] = (f32x4){bflo(w1.z), bfhi(w1.z), bflo(w1.w), bfhi(w1.w)}; }
    for (int tb = 0; tb < 4; ++tb) {
#pragma unroll 4
        for (int ti = 0; ti < 16; ++ti) {
            const LAS f32x4* up = (const LAS f32x4*)(ut + (tb * 16 + ti) * 16);
            f32x2 b2a = {0.f, 0.f}, b2b = {0.f, 0.f};
#pragma unroll
            for (int q = 0; q < 4; ++q) { const f32x4 u4 = up[q];
                b2a += C.B2[4 * q + 0] * (f32x2){u4[0], u4[0]}; b2b += C.B2[4 * q + 1] * (f32x2){u4[1], u4[1]};
                b2a += C.B2[4 * q + 2] * (f32x2){u4[2], u4[2]}; b2b += C.B2[4 * q + 3] * (f32x2){u4[3], u4[3]}; }
            const float br = b2a[0] + b2b[0], bi = b2a[1] + b2b[1];
            const float nr = C.abr * xr - C.abi * xi + br, ni = C.abr * xi + C.abi * xr + bi; xr = nr; xi = ni;
            if (EMIT) xt[ti * 68 + lane] = pk2(xr, xi);
        }
        if (EMIT) {
            f32x4 dacc = {0.f, 0.f, 0.f, 0.f};
#pragma unroll
            for (int ks = 0; ks < 4; ++ks) { const bf16x8 a = *(const LAS bf16x8*)((const LAS unsigned char*)xt + (lane & 15) * 272 + (ks * 32 + (lane >> 4) * 8) * 2);
                dacc = __builtin_amdgcn_mfma_f32_16x16x32_bf16(a, cf[ks], dacc, 0, 0, 0); }
            const int hp = lane & 15;
#pragma unroll
            for (int i = 0; i < 4; ++i) { const int tok = tb * 16 + 4 * (lane >> 4) + i; const float y = dacc[i] + dsk * ut[tok * 16 + hp];
                zin[(size_t)(row0 + tok) * ZP + ZC_U + g * 16 + hp] = (bf16)f2bf(gelu_tanh(y)); }
        }
    }
}
template <int PASS>
__device__ __forceinline__ void phase(const Params& P, int L, LAS unsigned char* lds) {
    BODY_IDS();
    LAS unsigned char* wl = lds + wave * WAVE_LDS;
    f32x2* SC = (f32x2*)(P.ws + WS_SC);
    for (int w = gw; w < 2048; w += ngw) {
        const int bg = w >> 5, cg = w & 31, b = bg >> 4, g = bg & 15;
        Coef C; coef(P, L, g, lane, C);
        bf16x8 cf[4]; float dsk = 0.f;
        if (PASS == 1) {
            const int hp = lane & 15, kg = lane >> 4;
            const float* cre = P.in[I_SCR] + ((size_t)(L * 16 + g) * 16 + hp) * 64; const float* cim = P.in[I_SCI] + ((size_t)(L * 16 + g) * 16 + hp) * 64;
#pragma unroll
            for (int ks = 0; ks < 4; ++ks) { const int p0 = 16 * ks + 4 * kg; u32x4 wv;
                wv.x = pk2(cre[p0], -cim[p0]); wv.y = pk2(cre[p0 + 1], -cim[p0 + 1]); wv.z = pk2(cre[p0 + 2], -cim[p0 + 2]); wv.w = pk2(cre[p0 + 3], -cim[p0 + 3]);
                cf[ks] = __builtin_bit_cast(bf16x8, wv); }
            dsk = P.in[I_SD][(L * 16 + g) * 16 + hp];
        } else {
#pragma unroll
            for (int ks = 0; ks < 4; ++ks) cf[ks] = (bf16x8){0, 0, 0, 0, 0, 0, 0, 0};
        }
        float xr = 0.f, xi = 0.f;
        if (PASS == 1) {
            const f32x2* sp = SC + ((size_t)bg * 128) * 64 + lane;
            for (int c = 0; c < 4 * cg; c += 4) { f32x2 sv[4];
#pragma unroll
                for (int q = 0; q < 4; ++q) sv[q] = sp[(size_t)(c + q) * 64];
#pragma unroll
                for (int q = 0; q < 4; ++q) { const float nr = C.a64r * xr - C.a64i * xi + sv[q][0], ni = C.a64r * xi + C.a64i * xr + sv[q][1]; xr = nr; xi = ni; } }
        }
        for (int cc = 0; cc < 4; ++cc) {
            const int c = 4 * cg + cc, row0 = b * SEQ + c * 64;
            if (PASS == 0) { xr = 0.f; xi = 0.f; }
            chunk<PASS == 1>(P, L, g, row0, C, xr, xi, wl, lane, cf, dsk);
            if (PASS == 0) SC[((size_t)bg * 128 + c) * 64 + lane] = (f32x2){xr, xi};
        }
    }
}
__device__ __forceinline__ void naive(const Params& P, int L) {
    BODY_IDS();
    bf16* zin = (bf16*)(P.ws + WS_ZIN);
    for (int bg = gw; bg < 64; bg += ngw) {
        const int b = bg >> 4, g = bg & 15;
        Coef C; coef(P, L, g, lane, C);
        float cr[16], ci[16];
#pragma unroll
        for (int h = 0; h < 16; ++h) { cr[h] = P.in[I_SCR][((size_t)(L * 16 + g) * 16 + h) * 64 + lane]; ci[h] = P.in[I_SCI][((size_t)(L * 16 + g) * 16 + h) * 64 + lane]; }
        const float dsk = P.in[I_SD][(L * 16 + g) * 16 + (lane & 15)];
        float xr = 0.f, xi = 0.f;
        for (int t = 0; t < SEQ; ++t) {
            bf16* up = zin + (size_t)(b * SEQ + t) * ZP + ZC_U + g * 16;
            const u32x4 w0 = *(const u32x4*)up, w1 = *(const u32x4*)(up + 8);
            const float u[16] = {bflo(w0.x), bfhi(w0.x), bflo(w0.y), bfhi(w0.y), bflo(w0.z), bfhi(w0.z), bflo(w0.w), bfhi(w0.w),
                                 bflo(w1.x), bfhi(w1.x), bflo(w1.y), bfhi(w1.y), bflo(w1.z), bfhi(w1.z), bflo(w1.w), bfhi(w1.w)};
            float br = 0.f, bi = 0.f;
#pragma unroll
            for (int h = 0; h < 16; ++h) { br += C.B2[h][0] * u[h]; bi += C.B2[h][1] * u[h]; }
            const float nr = C.abr * xr - C.abi * xi + br, ni = C.abr * xi + C.abi * xr + bi; xr = nr; xi = ni;
            float ymine = 0.f, umine = 0.f;
#pragma unroll
            for (int h = 0; h < 16; ++h) { const float s = wave_sum(xr * cr[h] - xi * ci[h]); if ((lane & 15) == h) { ymine = s; umine = u[h]; } }
            __builtin_amdgcn_s_waitcnt(0);
            if (lane < 16) up[lane] = (bf16)f2bf(gelu_tanh(ymine + dsk * umine));
        }
    }
}
}

__device__ __forceinline__ void norm2_moe_phase(const Params& P, const XSrc x, LAS unsigned char* lds, int first, int stride) {
    BODY_IDS();
    LAS unsigned* lcnt = (LAS unsigned*)(lds + 32768); LAS unsigned* lbase = lcnt + 8;
    f32x4 wr0[4][4], wr1[4][4];
#pragma unroll
    for (int j = 0; j < 4; ++j)
#pragma unroll
        for (int q = 0; q < 4; ++q) { const float* wp = P.in[I_MWR] + (size_t)(4 * lane + 256 * j + q) * 8; wr0[j][q] = *(const f32x4*)wp; wr1[j][q] = *(const f32x4*)(wp + 4); }
    if (tid < 8) lcnt[tid] = 0u;
    __syncthreads();
    const float* gain = P.in[I_GFFN] + 1 * D; bf16* H = (bf16*)(P.ws + WS_H);
    unsigned* tokinfo = (unsigned*)(P.ws + WS_TOKINFO); unsigned* gcnt = (unsigned*)(P.ws + WS_CTL) + CW_MOECNT;
    const float* brt = P.in[I_MBR];
    for (int u = first; u < NTOK / 128; u += stride) { const int g0 = u * 8 + wave;
        RMS_ROWS_BEGIN(x, g0 * 16 + i) const int row = g0 * 16 + i; rms_finish(gain, H + (size_t)row * D, lane, v);
            float lg[8];
#pragma unroll
            for (int e = 0; e < 8; ++e) lg[e] = 0.f;
#pragma unroll
            for (int j = 0; j < 4; ++j)
#pragma unroll
                for (int q = 0; q < 4; ++q) { const f32x4 w0 = wr0[j][q], w1 = wr1[j][q]; const float hv = v[j][q];
                    lg[0] += hv * w0[0]; lg[1] += hv * w0[1]; lg[2] += hv * w0[2]; lg[3] += hv * w0[3]; lg[4] += hv * w1[0]; lg[5] += hv * w1[1]; lg[6] += hv * w1[2]; lg[7] += hv * w1[3]; }
#pragma unroll
            for (int e = 0; e < 8; ++e) lg[e] = wave_sum(lg[e]) + brt[e];
            int e0 = 0; float l0 = lg[0];
#pragma unroll
            for (int e = 1; e < 8; ++e) if (lg[e] > l0) { l0 = lg[e]; e0 = e; }
            int e1 = 0; float l1 = -INFINITY;
#pragma unroll
            for (int e = 0; e < 8; ++e) if (e != e0 && lg[e] > l1) { l1 = lg[e]; e1 = e; }
            const float ex = __expf(l1 - l0); const float ga = 1.0f / (1.0f + ex), gb = ex / (1.0f + ex);
            if (lane == 0) { const unsigned r0 = __hip_atomic_fetch_add(&lcnt[e0], 1u, __ATOMIC_RELAXED, __HIP_MEMORY_SCOPE_WORKGROUP), r1 = __hip_atomic_fetch_add(&lcnt[e1], 1u, __ATOMIC_RELAXED, __HIP_MEMORY_SCOPE_WORKGROUP);
                u32x4 a; a.x = (unsigned)e0; a.y = (unsigned)e1; a.z = r0; a.w = r1; u32x4 bq; bq.x = __float_as_uint(ga); bq.y = __float_as_uint(gb); bq.z = 0u; bq.w = 0u;
                *(u32x4*)(tokinfo + (size_t)row * 8) = a; *(u32x4*)(tokinfo + (size_t)row * 8 + 4) = bq; } RMS_ROWS_END()
    }
    __syncthreads();
    if (tid < 8) lbase[tid] = __hip_atomic_fetch_add(gcnt + tid, lcnt[tid], __ATOMIC_RELAXED, __HIP_MEMORY_SCOPE_AGENT);
    __syncthreads();
    for (int u = first; u < NTOK / 128; u += stride) { const int g0 = u * 8 + wave;
        if (lane == 0) { for (int i = 0; i < 16; ++i) { const int row = g0 * 16 + i; u32x4 a = *(u32x4*)(tokinfo + (size_t)row * 8);
            unsigned b0 = 0, b1 = 0;
#pragma unroll
            for (int e = 0; e < 8; ++e) { const unsigned lb = lbase[e]; b0 = (a.x == (unsigned)e) ? lb : b0; b1 = (a.y == (unsigned)e) ? lb : b1; }
            a.z += b0; a.w += b1; *(u32x4*)(tokinfo + (size_t)row * 8) = a; } }
    }
    int* slot_tok = (int*)(P.ws + WS_SLOTTOK);
    for (int i = gtid; i < MOE_ROWS; i += gthreads) slot_tok[i] = -1;
    __syncthreads();
}
struct MoeLayout { int pstart[9]; };
__device__ __forceinline__ MoeLayout moe_layout(const Params& P) {
    const unsigned* gcnt = (const unsigned*)(P.ws + WS_CTL) + CW_MOECNT; MoeLayout Lo; int acc = 0;
#pragma unroll
    for (int e = 0; e < 8; ++e) { Lo.pstart[e] = acc; const int c = (int)__hip_atomic_load(gcnt + e, __ATOMIC_RELAXED, __HIP_MEMORY_SCOPE_AGENT); acc += (c + 255) / 256 * 256; }
    Lo.pstart[8] = acc; return Lo;
}
__device__ __forceinline__ void moe_assign_phase(const Params& P) {
    BODY_IDS();
    const MoeLayout Lo = moe_layout(P);
    const unsigned* tokinfo = (const unsigned*)(P.ws + WS_TOKINFO); int* slot_tok = (int*)(P.ws + WS_SLOTTOK); float* slot_gate = (float*)(P.ws + WS_SLOTGATE);
    for (int t = gtid; t < NTOK; t += gthreads) { const u32x4 a = *(const u32x4*)(tokinfo + (size_t)t * 8); const u32x2 g = *(const u32x2*)(tokinfo + (size_t)t * 8 + 4);
        int p0 = 0, p1 = 0;
#pragma unroll
        for (int e = 0; e < 8; ++e) { p0 = ((int)a.x == e) ? Lo.pstart[e] : p0; p1 = ((int)a.y == e) ? Lo.pstart[e] : p1; }
        const int s0 = p0 + (int)a.z, s1 = p1 + (int)a.w;
        slot_tok[s0] = t; slot_gate[s0] = __uint_as_float(g.x); slot_tok[s1] = t; slot_gate[s1] = __uint_as_float(g.y); }
}
struct MoeOrder {
    int pstart[9]; int ntile, ncol, G, c;
    __device__ __forceinline__ bool next(int i, pg8::Unit& u) const {
        const long Lf = (long)i * G + c; if (Lf >= (long)ntile * ncol) return false;
        const int rt = (int)(Lf / ncol), j = (int)(Lf % ncol); int e = 0;
#pragma unroll
        for (int q = 1; q < 8; ++q) e = (rt * 256 >= pstart[q]) ? q : e;
        u.pm = rt; u.pn = e * ncol + j; return true;
    }
};
__device__ __forceinline__ MoeOrder moe_order(const Params& P, int ncol, int G, int c) {
    const MoeLayout Lo = moe_layout(P); MoeOrder S;
#pragma unroll
    for (int e = 0; e < 9; ++e) S.pstart[e] = Lo.pstart[e];
    S.ntile = Lo.pstart[8] / 256; S.ncol = ncol; S.G = G; S.c = c; return S;
}

__device__ __forceinline__ void norm_moe_combine(const Params& P, const float* gain, int first, int stride) {
    BODY_IDS();
    const MoeLayout Lo = moe_layout(P);
    const unsigned* tokinfo = (const unsigned*)(P.ws + WS_TOKINFO); const bf16* Y = (const bf16*)(P.ws + WS_MOEY); bf16* H = (bf16*)(P.ws + WS_H2);
    for (int u = first; u < NTOK / 128; u += stride) for (int i = 0; i < 16; ++i) { const int row = u * 128 + wave * 16 + i;
        const u32x4 a = *(const u32x4*)(tokinfo + (size_t)row * 8);
        int p0 = 0, p1 = 0;
#pragma unroll
        for (int e = 0; e < 8; ++e) { p0 = ((int)a.x == e) ? Lo.pstart[e] : p0; p1 = ((int)a.y == e) ? Lo.pstart[e] : p1; }
        const u32x2* y0 = (const u32x2*)(Y + (size_t)(p0 + (int)a.z) * D) + lane; const u32x2* y1 = (const u32x2*)(Y + (size_t)(p1 + (int)a.w) * D) + lane;
        u32x2* xr = (u32x2*)(xr_of(P.out) + (size_t)row * D) + lane; f32x4 v[4]; float s = 0.f;
#pragma unroll
        for (int j = 0; j < 4; ++j) { const u32x2 w0 = y0[64 * j], w1 = y1[64 * j]; const u32x2 wx = xr[64 * j];
            v[j] = (f32x4){bflo(wx.x), bfhi(wx.x), bflo(wx.y), bfhi(wx.y)} + (f32x4){bflo(w0.x), bfhi(w0.x), bflo(w0.y), bfhi(w0.y)} + (f32x4){bflo(w1.x), bfhi(w1.x), bflo(w1.y), bfhi(w1.y)};
            { u32x2 wo; wo.x = pk2(v[j][0], v[j][1]); wo.y = pk2(v[j][2], v[j][3]); xr[64 * j] = wo; } s += (v[j][0] * v[j][0] + v[j][1] * v[j][1]) + (v[j][2] * v[j][2] + v[j][3] * v[j][3]); }
        const float rstd = 1.0f / sqrtf(wave_sum(s) * (1.0f / D) + RMS_EPS);
        const f32x4* gr = (const f32x4*)gain + lane; u32x2* o8 = (u32x2*)(H + (size_t)row * D) + lane;
#pragma unroll
        for (int j = 0; j < 4; ++j) { const f32x4 h = v[j] * rstd * gr[64 * j]; u32x2 w; w.x = pk2(h[0], h[1]); w.y = pk2(h[2], h[3]); o8[64 * j] = w; }
    }
}
#ifndef REF_MASK
#define REF_MASK 0
#endif
#ifndef N_LAUNCH_MODE
#define N_LAUNCH_MODE 1
#endif
constexpr int LDS_BYTES = 147456;
constexpr int MISC_OFF = LDS_BYTES - 64;
constexpr int N_PHASES = 27;
#ifndef PHASE_SEL
#define PHASE_SEL 0xFFFFFFFu
#endif
#define PH_ON(b) (((PHASE_SEL) >> (b)) & 1u)
#ifndef SUB_SEL
#define SUB_SEL 0xFFu
#endif
#define SUB_ON(b) (((SUB_SEL) >> (b)) & 1u)

#ifndef PROBE_MASK
#define PROBE_MASK 0u
#endif
#ifndef PROBE_MULT
#define PROBE_MULT 4
#endif
#define TIMED(bit, ...) do { unsigned long long t0_ = 0; if (((PROBE_MASK) >> (bit)) & 1u) t0_ = __builtin_amdgcn_s_memrealtime(); __VA_ARGS__; \
    if (((PROBE_MASK) >> (bit)) & 1u) pacc += __builtin_amdgcn_s_memrealtime() - t0_; } while (0)
#define RUN_GEMM(EPI_T, SCHED_T, GATH, gm, sc, ep) do { if (REF_MASK & 1) pg8::gemm_phase_naive<EPI_T, SCHED_T, GATH>(gm, sc, ep); \
    else pg8::gemm_phase<EPI_T, SCHED_T, true, GATH>(lds, gm, sc, ep); } while (0)

__device__ __forceinline__ int vcu_of() { int G = gridDim.x, bx = blockIdx.x; asm volatile("" : "+s"(G), "+s"(bx)); return (G % 8 == 0) ? (bx % 8) * (G / 8) + bx / 8 : bx; }
__device__ __forceinline__ bool in_range(int lo, int hi, int k) { asm volatile("" : "+s"(lo), "+s"(hi)); return lo <= k && k < hi; }
__global__ void __launch_bounds__(NTHREADS, 2) mega_fwd(Params P) {
    extern __shared__ __attribute__((aligned(16))) unsigned char lds_raw[];
    LAS unsigned char* lds = (LAS unsigned char*)lds_raw;
    const int tid = threadIdx.x;
    const int G = gridDim.x, bx = blockIdx.x;
    unsigned* ctl = (unsigned*)(P.ws + WS_CTL);
    volatile LAS unsigned* misc = (volatile LAS unsigned*)(lds + MISC_OFF);
    if (tid < 16) misc[tid] = 0u;
    if ((tid & 63) == 0) *(LAS int*)(uintptr_t)((unsigned)TID_TAB_OFF + 4u * hw_wave_key()) = tid >> 6;
    __syncthreads();
    const int lo = P.ph_lo, hi = P.ph_hi;
    XcdBarrier bar; bar.bar = ctl + CW_BAR; bar.x = 0; bar.st = misc;
    if (hi - lo > 1) bar = xcd_barrier_post(ctl + CW_BAR, misc);
#define IN(k) in_range(lo, hi, (k))
#ifndef PROBE_SEAMS
#define PROBE_SEAMS 0u
#endif
#define SEAM(k) do { if (IN(k) && IN((k) + 1)) { unsigned long long t0_ = 0; const bool tm_ = (((PROBE_MASK) >> 24) & 1u) || (((PROBE_SEAMS) >> (k)) & 1u); if (tm_) t0_ = __builtin_amdgcn_s_memrealtime(); \
    xcd_barrier(bar); if (tm_) pacc += __builtin_amdgcn_s_memrealtime() - t0_; } } while (0)
    unsigned long long pacc = 0;

#define H ((bf16*)(P.ws + WS_H))
#define ZIN ((bf16*)(P.ws + WS_ZIN))
#define GB ((bf16*)(P.ws + WS_G))
#define MB ((bf16*)(P.ws + WS_M))
#define MLAQ ((bf16*)(P.ws + WS_MLAQ))
#define MLAKV ((bf16*)(P.ws + WS_MLAKV))
#define KPER ((bf16*)(P.ws + WS_KPER))
#define cosT ((float*)(P.ws + WS_COS))
#define sinT ((float*)(P.ws + WS_SIN))
#define slot_tok ((int*)(P.ws + WS_SLOTTOK))
#define slot_gate ((float*)(P.ws + WS_SLOTGATE))

    if (PH_ON(0) && IN(0)) { TIMED(0, cvt_jobs(P, 0, 43, lds); p0_misc(P)); TIMED(1, norm1_phase(P, 0, XSrc{P.in[I_X], nullptr}, vcu_of(), gridDim.x)); }
    SEAM(0);

    for (int L = 0; L < 2; ++L) {
        const int pb = 1 + 12 * L;
        const int pc = (L == 0) ? 9 : 22;
        bf16* const XR = xr_of(P.out);
        const XSrc xsrc = (L == 0) ? XSrc{P.in[I_X], nullptr} : XSrc{nullptr, XR};
        if (PH_ON(2) && IN(pb + 1)) {
            pg8::Gemm g{H, wmix(P, L, WM_IN), D, D, D, nullptr}; pg8::StaticOrder S; S.init(NTOK, ZP, G, bx);
            epi::EpiStore E{ZIN, ZP, 0};
            TIMED(2, RUN_GEMM(epi::EpiStore, pg8::StaticOrder, false, g, S, E));
        }
        SEAM(pb + 1);
        if (PH_ON(3) && IN(pb + 2)) {
            TIMED(3, prep_phase(P, L));
            if (!(REF_MASK & 4)) TIMED(4, s5::phase<0>(P, L, lds));
            __syncthreads();
        }
        SEAM(pb + 2);
        if (PH_ON(4) && IN(pb + 3)) {
            if (SUB_ON(0)) { pg8::Gemm g{ZIN + ZC_CQ, wmix(P, L, WM_UQ), ZP, 256, 256, nullptr}; pg8::StaticOrder S; S.init(NTOK, 512, G, bx);
              epi::EpiMlaQ E{MLAQ, (const float*)(P.ws + WS_RSTDQ), cosT, sinT};
              TIMED(5, RUN_GEMM(epi::EpiMlaQ, pg8::StaticOrder, false, g, S, E)); }
            if (SUB_ON(1)) { pg8::Gemm g{ZIN + ZC_CKV, wmix(P, L, WM_UKV), ZP, 128, 128, nullptr}; pg8::StaticOrder S; S.init(NTOK, 512, G, bx);
              epi::EpiRowScale E{MLAKV, 512, (const float*)(P.ws + WS_RSTDKV)};
              TIMED(5, RUN_GEMM(epi::EpiRowScale, pg8::StaticOrder, false, g, S, E)); }
            if (SUB_ON(2)) { TIMED(6, if (REF_MASK & 4) s5::naive(P, L); else s5::phase<1>(P, L, lds)); }
            __syncthreads();
            if (SUB_ON(3)) { att::Tensors T; T.Q = ZIN + ZC_FQ; T.ldq = ZP; T.K = ZIN + ZC_FK; T.ldk = ZP; T.K2 = nullptr; T.V = ZIN + ZC_FV; T.ldv = ZP; T.O = ZIN + ZC_FQ; T.ldo = ZP;
              T.cdec = (const float*)(P.ws + WS_CDEC); T.relb = nullptr; T.qhs = 64; T.khs = 64; T.vhs = 64; T.ohs = 64;
              T.qmax = (const unsigned*)(P.ws + WS_CTL) + CW_QMAX + L * 512; T.kmax = (const unsigned*)(P.ws + WS_CTL) + CW_KMAX + L * 16;
              TIMED(7, if (REF_MASK & 2) att::attn_naive<att::MODE_FOX>(T); else att::attn_phase<att::MODE_FOX>(T, lds)); }
            __syncthreads();
            if (SUB_ON(4)) { att::Tensors T; T.Q = ZIN + ZC_DQ; T.ldq = ZP; T.K = ZIN + ZC_DK; T.ldk = ZP; T.K2 = nullptr; T.V = ZIN + ZC_DV; T.ldv = ZP; T.O = ZIN + ZC_DQ; T.ldo = ZP;
              T.cdec = nullptr; T.relb = P.in[I_RELB] + (size_t)L * 4 * 513; T.qhs = 64; T.khs = 64; T.vhs = 64; T.ohs = 64;
              TIMED(8, if (REF_MASK & 2) att::attn_naive<att::MODE_BAND>(T); else att::attn_phase<att::MODE_BAND>(T, lds)); }
            __syncthreads();
        }
        SEAM(pb + 3);
        if (PH_ON(5) && IN(pb + 4)) {
            if (SUB_ON(0)) { att::Tensors T; T.Q = MLAQ; T.ldq = 512; T.K = MLAKV; T.ldk = 512; T.K2 = KPER; T.V = MLAKV + 64; T.ldv = 512; T.O = ZIN + ZC_CQ; T.ldo = ZP;
              T.cdec = nullptr; T.relb = nullptr; T.qhs = 96; T.khs = 128; T.vhs = 128; T.ohs = 64;
              TIMED(9, if (REF_MASK & 2) att::attn_naive<att::MODE_MLA>(T); else att::attn_phase<att::MODE_MLA>(T, lds)); }
            __syncthreads();
            if (SUB_ON(1)) { pg8::Gemm g{ZIN + ZC_U, wmix(P, L, WM_GLU), ZP, 256, 256, nullptr}; pg8::StaticOrder S; S.init(NTOK, 256, G, bx);
              epi::EpiGlu E{ZIN + ZC_U, ZP};
              TIMED(10, RUN_GEMM(epi::EpiGlu, pg8::StaticOrder, false, g, S, E)); }
        }
        SEAM(pb + 4);
        if (PH_ON(6) && IN(pb + 5)) {
            g128::MergeProg MP; MP.Hn = H; MP.zin = ZIN; MP.wg = wmix(P, L, WM_G); MP.wb = wmix(P, L, WM_B); MP.bg = P.in[I_BG] + (size_t)L * 4 * D; MP.M = MB;
            const int vcu_ = vcu_of();
            TIMED(11, g128::stream<g128::MergeProg>(lds, MP, 1024, vcu_, G));
        }
        SEAM(pb + 5);
#define PANEL_FENCE() do { asm volatile("s_waitcnt vmcnt(0)" ::: "memory"); __builtin_amdgcn_fence(__ATOMIC_ACQUIRE, "agent"); asm volatile("s_waitcnt vmcnt(0)" ::: "memory"); __syncthreads(); } while (0)
        if (PH_ON(7) && IN(pb + 6)) {
            pg8::Gemm g{MB, wmix(P, L, WM_O), D, D, D, nullptr}; pg8::StaticOrder S; S.init(NTOK, D, G, bx);
            epi::EpiRes E{xsrc, XR};
            TIMED(13, RUN_GEMM(epi::EpiRes, pg8::StaticOrder, false, g, S, E));
        }
        SEAM(pb + 6);
        if (PH_ON(8) && IN(pb + 7)) {
            const int vcu_ = vcu_of();
            if (L == 0) TIMED(14, norm_plain(XSrc{nullptr, XR}, P.in[I_GFFN], H, vcu_, G));
            else { TIMED(14, norm2_moe_phase(P, XSrc{nullptr, XR}, lds, vcu_, G)); TIMED(25, cvt_jobs(P, 43, 67, lds)); __syncthreads(); }
        }
        SEAM(pb + 7);
        if (L == 0) {
            if (PH_ON(9) && IN(9)) {
                pg8::Gemm g{H, (const bf16*)(P.ws + WS_W13), D, D, D, nullptr}; pg8::StaticOrder S; S.init(NTOK, 2 * DFF, G, bx);
                epi::EpiSwiglu E{(bf16*)(P.ws + WS_HMID), DFF, 22};
                TIMED(15, RUN_GEMM(epi::EpiSwiglu, pg8::StaticOrder, false, g, S, E));
            }
            SEAM(9);
            if (PH_ON(10) && IN(10)) {
                pg8::Gemm g{(const bf16*)(P.ws + WS_HMID), (const bf16*)(P.ws + WS_W2), DFF, DFF, DFF, nullptr}; pg8::StaticOrder S; S.init(NTOK, D, G, bx);
                epi::EpiRes E{XSrc{nullptr, XR}, XR};
                TIMED(16, RUN_GEMM(epi::EpiRes, pg8::StaticOrder, false, g, S, E));
            }
            SEAM(10);
        } else {
            if (PH_ON(21) && IN(21)) TIMED(17, moe_assign_phase(P));
            SEAM(21);
            if (PH_ON(22) && IN(22)) {
                pg8::Gemm g{H, (const bf16*)(P.ws + WS_WM13), D, D, D, slot_tok}; const MoeOrder S = moe_order(P, 11, G, bx);
                epi::EpiSwiglu E{(bf16*)(P.ws + WS_HMID), DFFE, 11};
                TIMED(18, RUN_GEMM(epi::EpiSwiglu, MoeOrder, true, g, S, E));
            }
            SEAM(22);
            if (PH_ON(23) && IN(23)) {
                pg8::Gemm g{(const bf16*)(P.ws + WS_HMID), (const bf16*)(P.ws + WS_WM2), DFFE, DFFE, DFFE, nullptr}; const MoeOrder S = moe_order(P, 4, G, bx);
                epi::EpiMoeDown E{(bf16*)(P.ws + WS_MOEY), slot_gate};
                TIMED(19, RUN_GEMM(epi::EpiMoeDown, MoeOrder, false, g, S, E));
            }
            SEAM(23);
        }
        if (PH_ON(12) && IN(pc + 3)) {
            const int vcu_ = vcu_of();
            if (L == 0) TIMED(20, norm_plain(XSrc{nullptr, XR}, P.in[I_GPLE] + L * D, H, vcu_, G)); else TIMED(20, norm_moe_combine(P, P.in[I_GPLE] + L * D, vcu_, G));
            PANEL_FENCE();
            g128::PleProg PP; PP.pbf = (const bf16*)(P.ws + WS_PBF) + (size_t)L * NTOK * 256; PP.hp = (L == 0) ? H : (const bf16*)(P.ws + WS_H2); PP.wup = wmix(P, L, WM_UP); PP.wpg = wmix(P, L, WM_PG); PP.x = XR;
            TIMED(22, g128::stream<g128::PleProg>(lds, PP, NTOK / 128, vcu_, G));
            PANEL_FENCE();
            if (L == 0) TIMED(1, norm1_phase(P, 1, XSrc{nullptr, XR}, vcu_, G));
        }
        if (L == 0) SEAM(pc + 3);
    }
    if (PH_ON(26) && IN(25)) {
        const int vcu_ = vcu_of(); const int G_ = gridDim.x;
        for (int r = 0; r < (NTOK / 128 + G_ - 1) / G_; ++r) {
            const int u = vcu_ + r * G_; FinalRows FR;
            if (u < NTOK / 128) final_norm_load(P, u, FR);
            xcd_barrier(bar);
            if (u < NTOK / 128) final_norm_store(P, u, FR);
        }
    }
    if (PROBE_MASK || PROBE_SEAMS) { const unsigned long long t0_ = __builtin_amdgcn_s_memrealtime(); while (__builtin_amdgcn_s_memrealtime() - t0_ < (unsigned long long)PROBE_MULT * pacc) __builtin_amdgcn_s_sleep(8); }
#undef IN
#undef SEAM
#undef H
#undef ZIN
#undef GB
#undef MB
#undef MLAQ
#undef MLAKV
#undef KPER
#undef cosT
#undef sinT
#undef slot_tok
#undef slot_gate
}

extern "C" void kernel_launch(void* const* d_in, const int* in_sizes, int n_in, void* d_out, int out_size, void* d_ws, size_t ws_size, hipStream_t stream) {
    static int grid = 0;
    if (grid == 0) {
        if (n_in != 37 || out_size != NTOK * D || ws_size < WS_END) { fprintf(stderr, "kernel_launch: unexpected shapes: n_in %d out %d ws %zu\n", n_in, out_size, ws_size); grid = -1; return; }
        int dev = 0, cus = 0, per_cu = 0;
        if (hipGetDevice(&dev) != hipSuccess || hipDeviceGetAttribute(&cus, hipDeviceAttributeMultiprocessorCount, dev) != hipSuccess) { grid = -1; return; }
        if (hipFuncSetAttribute((const void*)mega_fwd, hipFuncAttributeMaxDynamicSharedMemorySize, LDS_BYTES) != hipSuccess) { fprintf(stderr, "kernel_launch: hipFuncSetAttribute failed\n"); grid = -1; return; }
        if (hipOccupancyMaxActiveBlocksPerMultiprocessor(&per_cu, (const void*)mega_fwd, NTHREADS, LDS_BYTES) != hipSuccess || per_cu < 1)
            fprintf(stderr, "kernel_launch: note: occupancy query reports %d workgroups per CU\n", per_cu);
        (void)hipGetLastError();
        grid = cus;
        if (grid != 256) fprintf(stderr, "kernel_launch: note: %d CUs (built for 256)\n", grid);
    }
    if (grid < 0) return;
    if (hipMemsetAsync((char*)d_ws + WS_CTL, 0, CTL_ZERO_BYTES, stream) != hipSuccess) return;
    Params p{};
    for (int i = 0; i < 37; ++i) p.in[i] = (const float*)d_in[i];
    p.out = (float*)d_out; p.ws = (unsigned char*)d_ws;
#if N_LAUNCH_MODE == 1
    p.ph_lo = 0; p.ph_hi = N_PHASES;
    hipLaunchKernelGGL(mega_fwd, dim3(grid), dim3(NTHREADS), LDS_BYTES, stream, p);
#else
    for (int ph = 0; ph < N_PHASES; ++ph) { p.ph_lo = ph; p.ph_hi = ph + 1; hipLaunchKernelGGL(mega_fwd, dim3(grid), dim3(NTHREADS), LDS_BYTES, stream, p); }
#endif
    const hipError_t le = hipPeekAtLastError();
    if (le != hipSuccess) fprintf(stderr, "kernel_launch: launch failed: %s\n", hipGetErrorName(le));
}
```

```cpp
#include <hip/hip_runtime.h>
#include <cstdio>
#include <cstdint>

#define GAS __attribute__((address_space(1)))
#define LAS __attribute__((address_space(3)))
typedef unsigned short bf16;
typedef short bf16x8 __attribute__((ext_vector_type(8)));
typedef short s16x4 __attribute__((ext_vector_type(4)));
typedef float f32x2 __attribute__((ext_vector_type(2)));
typedef float f32x4 __attribute__((ext_vector_type(4)));
typedef float f32x16 __attribute__((ext_vector_type(16)));
typedef unsigned u32x2 __attribute__((ext_vector_type(2)));
typedef unsigned u32x4 __attribute__((ext_vector_type(4)));
typedef __bf16 bf16x2_t __attribute__((ext_vector_type(2)));

constexpr int NB = 4, SEQ = 8192, NTOK = NB * SEQ, D = 1024;
constexpr int ZP = 2304;
constexpr int ZC_U = 0, ZC_FQ = 256, ZC_FK = 512, ZC_FV = 768, ZC_DQ = 1024, ZC_DK = 1280, ZC_DV = 1536, ZC_CQ = 1792, ZC_CKV = 2048, ZC_KPE = 2176;
constexpr int DIN = 2148, DFF = 2816, DFFE = 1408, NE = 8;
constexpr int MOE_ROWS = 2 * NTOK + NE * 256;
constexpr float RMS_EPS = 1e-6f;
constexpr int NWAVES = 8, NTHREADS = 512;

constexpr size_t MiB = 1u << 20;
constexpr size_t WS_CTL = 0, CTL_ZERO_BYTES = 1 * MiB;
constexpr size_t WS_COS = 1 * MiB, WS_SIN = 3 * MiB;
constexpr size_t WS_LOGF = 5 * MiB;
constexpr size_t WS_CDEC = 5 * MiB + 512 * 1024;
constexpr size_t WS_WSUM = 6 * MiB;
constexpr size_t WS_RSTDQ = 6 * MiB + 256 * 1024, WS_RSTDKV = 6 * MiB + 512 * 1024;
constexpr size_t WS_SC = 7 * MiB;
constexpr size_t WS_TOKINFO = 11 * MiB;
constexpr size_t WS_SLOTTOK = 12 * MiB, WS_SLOTGATE = 12 * MiB + 512 * 1024;
constexpr size_t WS_PBF = 17 * MiB;
constexpr size_t WS_WMIX = 49 * MiB, WMIX_STRIDE = 20 * MiB;
constexpr size_t WM_IN = 0, WM_G = 4 * MiB + 512 * 1024, WM_B = 12 * MiB + 512 * 1024, WM_O = 14 * MiB + 512 * 1024, WM_PG = 16 * MiB + 512 * 1024,
                 WM_UP = 18 * MiB + 512 * 1024, WM_UQ = 19 * MiB, WM_UKV = 19 * MiB + 256 * 1024, WM_GLU = 19 * MiB + 384 * 1024;
constexpr size_t WS_W13 = 89 * MiB, WS_W2 = 100 * MiB;
constexpr size_t WS_H = 106 * MiB;
constexpr size_t WS_MLAQ = 170 * MiB, WS_MLAKV = 202 * MiB, WS_KPER = 234 * MiB;
constexpr size_t WS_M = 170 * MiB;
constexpr size_t WS_ZIN = 236 * MiB;
constexpr size_t WS_G = 380 * MiB;
constexpr size_t WS_HMID = 236 * MiB;
constexpr size_t WS_U = 236 * MiB;
constexpr size_t WS_WM13 = 418 * MiB, WS_WM2 = 462 * MiB;
constexpr size_t WS_MOEY = 89 * MiB;
constexpr size_t WS_H2 = 300 * MiB;
constexpr size_t WS_END = 484 * MiB;
constexpr int CW_BAR = 4096;
constexpr int CW_MOECNT = 16384;
constexpr int CW_QMAX = 20480;
constexpr int CW_KMAX = 22528;

#define LDS_WAIT() asm volatile("s_waitcnt lgkmcnt(0)" ::: "memory")
#define VM_WAIT() asm volatile("s_waitcnt vmcnt(0)" ::: "memory")
__device__ __forceinline__ unsigned f2bf(float f) { unsigned u = __builtin_bit_cast(unsigned, f); return (u + 0x7fffu + ((u >> 16) & 1u)) >> 16; }
__device__ __forceinline__ unsigned pk2(float lo, float hi) { f32x2 v = {lo, hi}; bf16x2_t b = __builtin_convertvector(v, bf16x2_t); return __builtin_bit_cast(unsigned, b); }
__device__ __forceinline__ float bf2f(unsigned short b) { return __uint_as_float((unsigned)b << 16); }
__device__ __forceinline__ float bflo(unsigned w) { return __uint_as_float(w << 16); }
__device__ __forceinline__ float bfhi(unsigned w) { return __uint_as_float(w & 0xffff0000u); }
constexpr int TID_TAB_OFF = 147456 - 512;
__device__ __forceinline__ unsigned hw_wave_key() { return (unsigned)__builtin_amdgcn_s_getreg((5 << 11) | 4) & 0x3Fu; }
__device__ __forceinline__ int my_tid() {
    unsigned addr = (unsigned)TID_TAB_OFF + 4u * hw_wave_key(); asm volatile("" : "+s"(addr));
    const int wave = __builtin_amdgcn_readfirstlane(*(const LAS int*)(uintptr_t)addr);
    int lane = (int)__builtin_amdgcn_mbcnt_hi(~0u, __builtin_amdgcn_mbcnt_lo(~0u, 0u)); asm volatile("" : "+v"(lane));
    return wave * 64 + lane;
}
__device__ __forceinline__ float shflx(float v, int o, int lane) { return __int_as_float(__builtin_amdgcn_ds_bpermute((lane ^ o) << 2, __float_as_int(v))); }
__device__ __forceinline__ float wave_sum(float v) {
    int lane = (int)__builtin_amdgcn_mbcnt_hi(~0u, __builtin_amdgcn_mbcnt_lo(~0u, 0u)); asm volatile("" : "+v"(lane));
#pragma unroll
    for (int o = 1; o < 64; o <<= 1) v += shflx(v, o, lane);
    return v;
}
__device__ __forceinline__ float sigmoidf_(float x) { return __builtin_amdgcn_rcpf(1.0f + __expf(-x)); }

struct XSrc { const float* f; const bf16* b; };
__device__ __forceinline__ f32x4 ldx4(const XSrc& x, size_t idx) {
    if (x.f) return *(const f32x4*)(x.f + idx);
    const u32x2 w = *(const u32x2*)(x.b + idx); return (f32x4){bflo(w.x), bfhi(w.x), bflo(w.y), bfhi(w.y)};
}
__device__ __forceinline__ bf16* xr_of(float* out) { return (bf16*)((unsigned char*)out + (size_t)NTOK * D * 2); }
#define BODY_IDS() int tid = my_tid(); asm volatile("" : "+v"(tid)); const int lane = tid & 63; const int wave = __builtin_amdgcn_readfirstlane(tid >> 6); \
    int grid_ = gridDim.x; asm volatile("" : "+s"(grid_)); \
    const int gw = blockIdx.x * NWAVES + wave, ngw = grid_ * NWAVES, gtid = blockIdx.x * NTHREADS + tid, gthreads = grid_ * NTHREADS; (void)lane; (void)wave; (void)gw; (void)ngw; (void)gtid; (void)gthreads
#define XB_TMO      128
#define XB_XCNT(j)  (256  + 64 * (j))
#define XB_XSUB(j)  (1280 + 64 * (j))
#define XB_XGEN(j)  (2304 + 64 * (j))
#define XB_TOP      3328
#define XB_TOPGEN   3392
#define XCD_BAR_WORDS 3456
#define XB_SPIN_CAP (1u << 22)

__device__ __forceinline__ unsigned xb_ld(unsigned* p)              { return __hip_atomic_load(p, __ATOMIC_RELAXED, __HIP_MEMORY_SCOPE_AGENT); }
__device__ __forceinline__ unsigned xb_add(unsigned* p, unsigned v) { return __hip_atomic_fetch_add(p, v, __ATOMIC_RELAXED, __HIP_MEMORY_SCOPE_AGENT); }
__device__ __forceinline__ unsigned xb_xcc_id() { return (unsigned)__builtin_amdgcn_s_getreg((3 << 11) | 20) & 0xFu; }
#define XB_SPIN(cond, bar) do { unsigned _sp = 0; while (cond) { __builtin_amdgcn_s_sleep(1); \
    if ((++_sp & 255u) == 0u) { if (xb_ld(&(bar)[XB_TMO])) break; if (_sp > XB_SPIN_CAP) { atomicAdd(&(bar)[XB_TMO], 1u); break; } } } } while (0)

struct XcdBarrier { unsigned* bar; unsigned x; volatile LAS unsigned* st; };

__device__ __forceinline__ XcdBarrier xcd_barrier_post(unsigned* bar, volatile LAS unsigned* st) {
    XcdBarrier b; b.bar = bar; b.x = xb_xcc_id(); b.st = st;
    if (my_tid() == 0) (void)xb_add(&bar[XB_XCNT(b.x)], 1u);
    return b;
}
__device__ __forceinline__ void xcd_barrier_complete(unsigned* bar, unsigned x, unsigned& nloc, unsigned& nx) {
    const unsigned G = gridDim.x * gridDim.y * gridDim.z;
    unsigned sum, cnt, mine, sp = 0u;
    for (;;) {
        sum = 0u; cnt = 0u; mine = 0u;
#pragma unroll
        for (unsigned j = 0; j < 16; ++j) { const unsigned c = xb_ld(&bar[XB_XCNT(j)]); sum += c; cnt += (c > 0u) ? 1u : 0u; mine = (j == x) ? c : mine; }
        if (sum == G) break;
        __builtin_amdgcn_s_sleep(1);
        if ((++sp & 255u) == 0u) { if (xb_ld(&bar[XB_TMO])) break; if (sp > XB_SPIN_CAP) { atomicAdd(&bar[XB_TMO], 1u); break; } }
    }
    nloc = mine > 0u ? mine : 1u; nx = cnt > 0u ? cnt : 1u;
}
__device__ __forceinline__ void xcd_barrier(const XcdBarrier& b) {
    asm volatile("s_waitcnt vmcnt(0)" ::: "memory");
    __syncthreads();
    if (my_tid() == 0) {
        unsigned* bar = b.bar;
        __builtin_amdgcn_s_waitcnt(0);
        unsigned nloc = b.st[0], nx = b.st[1];
        if (nloc == 0u) { xcd_barrier_complete(bar, b.x, nloc, nx); b.st[0] = nloc; b.st[1] = nx; }
        const unsigned old = xb_add(&bar[XB_XSUB(b.x)], 1u);
        const unsigned gen = old / nloc;
        if (old + 1u == (gen + 1u) * nloc) {
            __builtin_amdgcn_fence(__ATOMIC_RELEASE, "agent");
            asm volatile("s_waitcnt vmcnt(0)" ::: "memory");
            const unsigned og = xb_add(&bar[XB_TOP], 1u);
            const unsigned tg = og / nx;
            if (og + 1u == (tg + 1u) * nx) xb_add(&bar[XB_TOPGEN], 1u);
            else XB_SPIN(xb_ld(&bar[XB_TOPGEN]) == tg, bar);
            __builtin_amdgcn_fence(__ATOMIC_ACQUIRE, "agent");
            xb_add(&bar[XB_XGEN(b.x)], 1u);
            asm volatile("s_waitcnt vmcnt(0)" ::: "memory");
        } else {
            XB_SPIN(xb_ld(&bar[XB_XGEN(b.x)]) == gen, bar);
            __builtin_amdgcn_fence(__ATOMIC_ACQUIRE, "agent");
            asm volatile("s_waitcnt vmcnt(0)" ::: "memory");
        }
    }
    __syncthreads();
}
namespace pg8 {
constexpr int BM = 256, BK = 64, HALF = 128, HTB = HALF * BK * 2, STAGE_BYTES = 8 * HTB, NXCD = 8, WGM = 8;
__host__ __device__ __forceinline__ int lds_byte(int r, int c) { const int st = (r >> 4) * 2 + (c >> 5), rr = r & 15, cc = c & 31, ob = rr * 64 + cc * 2; return st * 1024 + (ob ^ (((ob >> 9) & 1) << 5)); }
__host__ __device__ __forceinline__ void stage_rc(int b, int& R, int& C) { const int st = b / 1024, sb = b % 1024, swz = sb ^ (((sb >> 9) & 1) << 5); R = (st >> 1) * 16 + swz / 64; C = (st & 1) * 32 + (swz % 64) / 2; }
__host__ __device__ __forceinline__ int perm32(int rho) { const int n = rho >> 4, i = rho & 15; return 8 * (i >> 2) + 4 * n + (i & 3); }

struct Unit { int pm, pn; };
struct Gemm { const bf16* A; const bf16* Bt; int lda, ldb, K; const int* gidx; };

struct StaticOrder {
    int nM, nN, nwg, G, c;
    __host__ __device__ void init(int M, int N, int G_, int c_) { nM = M / BM; nN = N / BM; nwg = nM * nN; G = G_; c = c_; }
    __host__ __device__ bool next(int i, Unit& u) const {
        const long L = (long)i * G + c; if (L >= nwg) return false;
        int wgid = (int)L; { const int q = nwg / NXCD, r = nwg % NXCD, xcd = wgid % NXCD, off = wgid / NXCD; wgid = (xcd < r ? xcd * (q + 1) : r * (q + 1) + (xcd - r) * q) + off; }
        const int nig = WGM * nN, gid = wgid / nig, fm = gid * WGM, gsz = (nM - fm) < WGM ? (nM - fm) : WGM;
        u.pm = fm + ((wgid % nig) % gsz); u.pn = (wgid % nig) / gsz; return true;
    }
};

template <class Epi, class Sched, bool ALIGN_EPI, bool GATHER>
__device__ __forceinline__ void gemm_phase(LAS unsigned char* lds, const Gemm g, const Sched& S, const Epi& E) {
    int tid = my_tid(); asm volatile("" : "+v"(tid));
    const int wid = __builtin_amdgcn_readfirstlane(tid >> 6), lane = tid & 63, wr = wid >> 2, wc = wid & 3, fr = lane & 15, fq = lane >> 4;
    int Kq = g.K; asm volatile("" : "+s"(Kq));
    const int K = Kq, nt = K / BK;
    int RA[2], CA[2];
    unsigned voffA[2], voffB[2];
#pragma unroll
    for (int i = 0; i < 2; ++i) { int R, C; stage_rc(tid * 16 + i * 8192, R, C); const int Rb = Epi::PERM ? ((R & ~31) + perm32(R & 31)) : R;
        RA[i] = R; CA[i] = C; voffA[i] = (unsigned)(R * g.lda + C) * 2u; voffB[i] = (unsigned)(Rb * g.ldb + C) * 2u; }
    const size_t kstep = (size_t)(BK * 2);
    const size_t hstepB = (size_t)HALF * g.ldb * 2, tstepB = 2 * hstepB;
    const size_t hstepA = (size_t)HALF * g.lda * 2, tstepA = 2 * hstepA;
    const unsigned ldsw = (unsigned)wid * 1024u;
    const int aoff = lds_byte(wr * 64 + fr, fq * 8), boff = lds_byte(wc * 32 + fr, fq * 8);
#define PG8_SA(b, h) (((b) * 2 + (h)) * HTB)
#define PG8_SB(b, h) ((4 + (b) * 2 + (h)) * HTB)
#define PG8_STAGEB(bufoff, gbase) do { _Pragma("unroll") for (int _i = 0; _i < 2; ++_i) \
        __builtin_amdgcn_global_load_lds((const unsigned*)((const char*)(gbase) + voffB[_i]), (LAS unsigned*)(lds + (bufoff) + ldsw + _i * 8192), 16, 0, 0); } while (0)
#define PG8_STAGEA(bufoff, kptr, isnext, h) do { _Pragma("unroll") for (int _i = 0; _i < 2; ++_i) { const char* _p; \
        if constexpr (GATHER) _p = (const char*)(kptr) + ((isnext) ? nvo[h][_i] : cvo[h][_i]); else _p = (const char*)(kptr) + (size_t)(h) * hstepA + voffA[_i]; \
        __builtin_amdgcn_global_load_lds((const unsigned*)_p, (LAS unsigned*)(lds + (bufoff) + ldsw + _i * 8192), 16, 0, 0); } } while (0)
#define PG8_LDA(dst, b, h) do { _Pragma("unroll") for (int m = 0; m < 4; ++m) _Pragma("unroll") for (int k = 0; k < 2; ++k) dst[m][k] = *(const LAS bf16x8*)(lds + PG8_SA(b, h) + aoff + m * 2048 + k * 1024); } while (0)
#define PG8_LDB(dst, b, h) do { _Pragma("unroll") for (int n = 0; n < 2; ++n) _Pragma("unroll") for (int k = 0; k < 2; ++k) dst[n][k] = *(const LAS bf16x8*)(lds + PG8_SB(b, h) + boff + n * 2048 + k * 1024); } while (0)
#define PG8_MMA(ai, bj, At, Bt) do { __builtin_amdgcn_s_setprio(1); _Pragma("unroll") for (int m = 0; m < 4; ++m) _Pragma("unroll") for (int n = 0; n < 2; ++n) _Pragma("unroll") for (int k = 0; k < 2; ++k) \
        acc[ai][bj][m][n] = __builtin_amdgcn_mfma_f32_16x16x32_bf16(Bt[n][k], At[m][k], acc[ai][bj][m][n], 0, 0, 0); __builtin_amdgcn_s_setprio(0); } while (0)
#define PG8_WAIT_V(n) asm volatile("s_waitcnt vmcnt(" #n ")" ::: "memory")
#define PG8_WAIT_L(n) asm volatile("s_waitcnt lgkmcnt(" #n ")" ::: "memory")
#define PG8_BAR __builtin_amdgcn_s_barrier()
#define PG8_SCHED __builtin_amdgcn_sched_barrier(0)
#define PG8_VOA(vo, u) do { _Pragma("unroll") for (int _h = 0; _h < 2; ++_h) _Pragma("unroll") for (int _i = 0; _i < 2; ++_i) { \
        int _row = (u).pm * BM + _h * HALF + RA[_i]; if (GATHER) { _row = g.gidx[_row]; _row = _row < 0 ? 0 : _row; } \
        (vo)[_h][_i] = (unsigned)_row * (unsigned)(g.lda * 2) + (unsigned)(CA[_i] * 2); } } while (0)
    Unit cur, nxt; int ui = 0;
    if (!S.next(0, cur)) return;
    f32x4 acc[2][2][4][2];
#pragma unroll
    for (int a = 0; a < 2; ++a)
#pragma unroll
        for (int b = 0; b < 2; ++b)
#pragma unroll
            for (int m = 0; m < 4; ++m)
#pragma unroll
                for (int n = 0; n < 2; ++n) acc[a][b][m][n] = (f32x4){0.f, 0.f, 0.f, 0.f};
    bf16x8 At[4][2], B0[2][2], B1[2][2];
    unsigned cvo[2][2], nvo[2][2];
    if constexpr (GATHER) { PG8_VOA(cvo, cur); PG8_VOA(nvo, cur); }
    const char* cA = (const char*)g.A + (GATHER ? (size_t)0 : (size_t)cur.pm * tstepA); const char* cB = (const char*)g.Bt + (size_t)cur.pn * tstepB;
    PG8_STAGEB(PG8_SB(0, 0), cB); PG8_STAGEB(PG8_SB(0, 1), cB + hstepB); PG8_STAGEA(PG8_SA(0, 0), cA, false, 0); PG8_STAGEA(PG8_SA(0, 1), cA, false, 1);
    if (wr == 1) PG8_BAR;
    PG8_WAIT_V(2); PG8_BAR;
    PG8_STAGEB(PG8_SB(1, 0), cB + kstep); PG8_STAGEA(PG8_SA(1, 0), cA + kstep, false, 0); PG8_STAGEB(PG8_SB(1, 1), cB + hstepB + kstep);
    PG8_WAIT_V(6); PG8_BAR;
    for (;;) {
        const bool has_next = S.next(ui + 1, nxt);
        if constexpr (GATHER) { if (has_next) { PG8_VOA(nvo, nxt); } }
        const char* nA = (GATHER || !has_next) ? cA : (const char*)g.A + (size_t)nxt.pm * tstepA;
        const char* nB = has_next ? (const char*)g.Bt + (size_t)nxt.pn * tstepB : cB;
#pragma nounroll
        for (int t = 0; t < nt; t += 2) {
            const bool last = (t == nt - 2);
            const char* a1 = cA + (size_t)(t + 1) * kstep;
            const char* a2 = last ? nA : cA + (size_t)(t + 2) * kstep; const char* b2 = last ? nB : cB + (size_t)(t + 2) * kstep;
            const char* a3 = a2 + kstep; const char* b3 = b2 + kstep;
            PG8_LDB(B0, 0, 0); PG8_LDB(B1, 0, 1); PG8_SCHED; PG8_LDA(At, 0, 0); PG8_STAGEA(PG8_SA(1, 1), a1, false, 1);
            PG8_WAIT_V(8); PG8_WAIT_L(0); PG8_BAR; PG8_MMA(0, 0, At, B0); PG8_MMA(0, 1, At, B1); PG8_BAR; PG8_SCHED;
            PG8_LDA(At, 0, 1); PG8_STAGEB(PG8_SB(0, 0), b2); PG8_STAGEB(PG8_SB(0, 1), b2 + hstepB); PG8_STAGEA(PG8_SA(0, 0), a2, last, 0);
            PG8_WAIT_V(8); PG8_WAIT_L(0); PG8_BAR; PG8_MMA(1, 0, At, B0); PG8_MMA(1, 1, At, B1); PG8_BAR; PG8_SCHED;
            PG8_LDB(B0, 1, 0); PG8_LDB(B1, 1, 1); PG8_SCHED; PG8_LDA(At, 1, 0); PG8_STAGEA(PG8_SA(0, 1), a2, last, 1);
            PG8_WAIT_V(8); PG8_WAIT_L(0); PG8_BAR; PG8_MMA(0, 0, At, B0); PG8_MMA(0, 1, At, B1); PG8_BAR; PG8_SCHED;
            PG8_LDA(At, 1, 1); PG8_STAGEB(PG8_SB(1, 0), b3); PG8_STAGEB(PG8_SB(1, 1), b3 + hstepB); PG8_STAGEA(PG8_SA(1, 0), a3, last, 0);
            PG8_WAIT_V(8); PG8_WAIT_L(0); PG8_BAR; PG8_MMA(1, 0, At, B0); PG8_MMA(1, 1, At, B1); PG8_BAR; PG8_SCHED;
        }
        if constexpr (ALIGN_EPI) { if (wr == 0) PG8_BAR; }
        E(acc, cur, wr, wc, fr, fq);
        if (!has_next) break;
#pragma unroll
        for (int a = 0; a < 2; ++a)
#pragma unroll
            for (int b = 0; b < 2; ++b)
#pragma unroll
                for (int m = 0; m < 4; ++m)
#pragma unroll
                    for (int n = 0; n < 2; ++n) acc[a][b][m][n] = (f32x4){0.f, 0.f, 0.f, 0.f};
        cur = nxt; cA = nA; cB = nB; ++ui;
        if constexpr (GATHER) {
#pragma unroll
            for (int _h = 0; _h < 2; ++_h)
#pragma unroll
                for (int _i = 0; _i < 2; ++_i) cvo[_h][_i] = nvo[_h][_i]; }
        if constexpr (ALIGN_EPI) { if (wr == 1) PG8_BAR; }
    }
    PG8_WAIT_V(0);
    if constexpr (!ALIGN_EPI) { if (wr == 0) PG8_BAR; }
    PG8_BAR;
#undef PG8_SA
#undef PG8_SB
#undef PG8_STAGEA
#undef PG8_STAGEB
#undef PG8_LDA
#undef PG8_LDB
#undef PG8_MMA
#undef PG8_WAIT_V
#undef PG8_WAIT_L
#undef PG8_BAR
#undef PG8_SCHED
#undef PG8_VOA
}

template <class Epi, class Sched, bool GATHER>
__device__ __forceinline__ void gemm_phase_naive(const Gemm g, const Sched& S, const Epi& E) {
    const int tid = threadIdx.x, wid = tid >> 6, lane = tid & 63, wr = wid >> 2, wc = wid & 3, fr = lane & 15, fq = lane >> 4;
    Unit u;
    for (int ui = 0; S.next(ui, u); ++ui) {
        f32x4 acc[2][2][4][2];
#pragma unroll
        for (int a = 0; a < 2; ++a)
#pragma unroll
            for (int b = 0; b < 2; ++b)
#pragma unroll
                for (int m = 0; m < 4; ++m)
#pragma unroll
                    for (int n = 0; n < 2; ++n) acc[a][b][m][n] = (f32x4){0.f, 0.f, 0.f, 0.f};
        const bf16* arow[2][4];
#pragma unroll
        for (int ai = 0; ai < 2; ++ai)
#pragma unroll
            for (int m = 0; m < 4; ++m) { int r = u.pm * BM + ai * HALF + wr * 64 + m * 16 + fr; if (GATHER) { r = g.gidx[r]; r = r < 0 ? 0 : r; } arow[ai][m] = g.A + (size_t)r * g.lda; }
        for (int k = 0; k < g.K; k += 4) {
            float av[2][4][4];
#pragma unroll
            for (int ai = 0; ai < 2; ++ai)
#pragma unroll
                for (int m = 0; m < 4; ++m) { const u32x2 w = *(const u32x2*)(arow[ai][m] + k); av[ai][m][0] = bflo(w.x); av[ai][m][1] = bfhi(w.x); av[ai][m][2] = bflo(w.y); av[ai][m][3] = bfhi(w.y); }
#pragma unroll
            for (int bj = 0; bj < 2; ++bj)
#pragma unroll
                for (int n = 0; n < 2; ++n)
#pragma unroll
                    for (int e = 0; e < 4; ++e) {
                        const int col = u.pn * BM + bj * HALF + wc * 32 + (Epi::PERM ? (8 * fq + 4 * n) : (16 * n + 4 * fq)) + e;
                        const u32x2 w = *(const u32x2*)(g.Bt + (size_t)col * g.ldb + k);
                        const float b0 = bflo(w.x), b1 = bfhi(w.x), b2 = bflo(w.y), b3 = bfhi(w.y);
#pragma unroll
                        for (int ai = 0; ai < 2; ++ai)
#pragma unroll
                            for (int m = 0; m < 4; ++m) acc[ai][bj][m][n][e] += av[ai][m][0] * b0 + av[ai][m][1] * b1 + av[ai][m][2] * b2 + av[ai][m][3] * b3;
                    }
        }
        E(acc, u, wr, wc, fr, fq);
    }
    VM_WAIT(); __syncthreads();
}
}
namespace g128 {
using pg8::lds_byte; using pg8::stage_rc; using pg8::HTB; using pg8::BK;
struct Seg { const bf16* A; const bf16* B; int lda, ldb, nt; };
typedef f32x4 acc_t[2][4][2];

template <class Prog>
__device__ __forceinline__ void stream(LAS unsigned char* lds, Prog& P, int nunits, int first, int stride) {
    int tid = my_tid(); asm volatile("" : "+v"(tid));
    const int wid = __builtin_amdgcn_readfirstlane(tid >> 6), lane = tid & 63, wr = wid >> 2, wc = wid & 3, fr = lane & 15, fq = lane >> 4;
    int RA[2], CA[2];
#pragma unroll
    for (int i = 0; i < 2; ++i) stage_rc(tid * 16 + i * 8192, RA[i], CA[i]);
    const unsigned ldsw = (unsigned)wid * 1024u;
    const int aoff = lds_byte(wr * 64 + fr, fq * 8), boff = lds_byte(wc * 32 + fr, fq * 8);
#define G_SA(b) ((b) * HTB)
#define G_SB(b, h) ((2 + (b) * 2 + (h)) * HTB)
#define G_STAGE(bufoff, base, ld, kbyte) do { _Pragma("unroll") for (int _i = 0; _i < 2; ++_i) \
        __builtin_amdgcn_global_load_lds((const unsigned*)((const char*)(base) + (size_t)(kbyte) + (unsigned)(RA[_i] * (ld) + CA[_i]) * 2u), (LAS unsigned*)(lds + (bufoff) + ldsw + _i * 8192), 16, 0, 0); } while (0)
#define G_STAGE_A(b, S, j) G_STAGE(G_SA(b), (S).A, (S).lda, (j) * 128)
#define G_STAGE_B(b, h, S, j) G_STAGE(G_SB(b, h), (const char*)(S).B + (size_t)(h) * 128 * (S).ldb * 2, (S).ldb, (j) * 128)
#define G_LDA(dst, b) do { _Pragma("unroll") for (int m = 0; m < 4; ++m) _Pragma("unroll") for (int k = 0; k < 2; ++k) dst[m][k] = *(const LAS bf16x8*)(lds + G_SA(b) + aoff + m * 2048 + k * 1024); } while (0)
#define G_LDB(dst, b, h) do { _Pragma("unroll") for (int n = 0; n < 2; ++n) _Pragma("unroll") for (int k = 0; k < 2; ++k) dst[n][k] = *(const LAS bf16x8*)(lds + G_SB(b, h) + boff + n * 2048 + k * 1024); } while (0)
#define G_MMA(bj, At, Bt) do { __builtin_amdgcn_s_setprio(1); _Pragma("unroll") for (int m = 0; m < 4; ++m) _Pragma("unroll") for (int n = 0; n < 2; ++n) _Pragma("unroll") for (int k = 0; k < 2; ++k) \
        acc[bj][m][n] = __builtin_amdgcn_mfma_f32_16x16x32_bf16(Bt[n][k], At[m][k], acc[bj][m][n], 0, 0, 0); __builtin_amdgcn_s_setprio(0); } while (0)
#define G_WAIT_V(n) asm volatile("s_waitcnt vmcnt(" #n ")" ::: "memory")
#define G_WAIT_L(n) asm volatile("s_waitcnt lgkmcnt(" #n ")" ::: "memory")
#define G_BAR __builtin_amdgcn_s_barrier()
#define G_SCHED __builtin_amdgcn_sched_barrier(0)
    if (first >= nunits) return;
    P.reset();
    int ucur = first, scur = 0;
    Seg cur, nxt;
    P.seg(ucur, scur, cur);
    acc_t acc;
    P.init(ucur, scur, acc, wr, wc, fr, fq);
    bf16x8 At[4][2], B0[2][2], B1[2][2];
    G_STAGE_B(0, 0, cur, 0); G_STAGE_A(0, cur, 0); G_STAGE_B(0, 1, cur, 0);
    if (wr == 1) G_BAR;
    G_WAIT_V(2); G_BAR;
    G_STAGE_A(1, cur, 1); G_STAGE_B(1, 0, cur, 1);
    G_WAIT_V(4); G_BAR;
#define G_TILE(t_, b_) do { const bool n1_ = ((t_) + 1 >= nt), n2_ = ((t_) + 2 >= nt); const int j1_ = n1_ ? ((t_) + 1 - nt) : ((t_) + 1), j2_ = n2_ ? ((t_) + 2 - nt) : ((t_) + 2); \
        G_LDB(B0, b_, 0); G_SCHED; G_LDA(At, b_); \
        if (n1_) G_STAGE_B((b_) ^ 1, 1, nxt, j1_); else G_STAGE_B((b_) ^ 1, 1, cur, j1_); \
        G_WAIT_V(6); G_WAIT_L(0); G_BAR; G_MMA(0, At, B0); G_BAR; G_SCHED; \
        G_LDB(B1, b_, 1); \
        if (n2_) { G_STAGE_A(b_, nxt, j2_); G_STAGE_B(b_, 0, nxt, j2_); } else { G_STAGE_A(b_, cur, j2_); G_STAGE_B(b_, 0, cur, j2_); } \
        G_WAIT_V(6); G_WAIT_L(0); G_BAR; G_MMA(1, At, B1); G_BAR; G_SCHED; } while (0)
    for (;;) {
        int unxt = ucur, snxt = scur + 1; bool more = true;
        if (snxt == Prog::NSEG) { snxt = 0; unxt = ucur + stride; if (unxt >= nunits) { more = false; unxt = ucur; snxt = scur; } }
        P.seg(unxt, snxt, nxt);
        int ntq = cur.nt; asm volatile("" : "+s"(ntq)); const int nt = ntq;
#pragma nounroll
        for (int t = 0; t < nt; t += 2) { G_TILE(t, 0); G_TILE(t + 1, 1); }
        P.done(ucur, scur, acc, wr, wc, fr, fq);
        if (!more) break;
        P.init(unxt, snxt, acc, wr, wc, fr, fq);
        ucur = unxt; scur = snxt; cur = nxt;
    }
    G_WAIT_V(0);
    if (wr == 0) G_BAR;
    G_BAR;
#undef G_SA
#undef G_SB
#undef G_STAGE
#undef G_STAGE_A
#undef G_STAGE_B
#undef G_LDA
#undef G_LDB
#undef G_MMA
#undef G_WAIT_V
#undef G_WAIT_L
#undef G_BAR
#undef G_SCHED
#undef G_TILE
}

struct MergeProg {
    static constexpr int NSEG = 8;
    const bf16* Hn; const bf16* zin; const bf16* wg; const bf16* wb; const float* bg; bf16* M;
    __device__ __forceinline__ void reset() {
#pragma unroll
        for (int a = 0; a < 2; ++a)
#pragma unroll
            for (int b = 0; b < 4; ++b)
#pragma unroll
                for (int c = 0; c < 2; ++c) { g[a][b][c] = (u32x2){0u, 0u}; macc[a][b][c] = (u32x2){0u, 0u}; } }
    u32x2 g[2][4][2]; u32x2 macc[2][4][2];
    __device__ __forceinline__ void seg(int u, int s, Seg& S) const {
        const int pm = u >> 2, pn = u & 3, k = s >> 1;
        if ((s & 1) == 0) { S.A = Hn + (size_t)pm * 128 * D; S.lda = D; S.B = wg + ((size_t)k * D + pn * 256) * D; S.ldb = D; S.nt = D / 64; }
        else { const int ycol = (k == 0) ? ZC_U : (k == 1) ? ZC_FQ : (k == 2) ? ZC_CQ : ZC_DQ;
               S.A = zin + (size_t)pm * 128 * ZP + ycol; S.lda = ZP; S.B = wb + ((size_t)k * D + pn * 256) * 256; S.ldb = 256; S.nt = 4; }
    }
    __device__ __forceinline__ void init(int u, int s, acc_t& acc, int wr, int wc, int fr, int fq) {
        const int pn = u & 3, k = s >> 1;
        if ((s & 1) == 0) {
#pragma unroll
            for (int bj = 0; bj < 2; ++bj)
#pragma unroll
                for (int n = 0; n < 2; ++n) { const f32x4 bv = *(const f32x4*)(bg + (size_t)k * D + pn * 256 + bj * 128 + wc * 32 + n * 16 + 4 * fq);
#pragma unroll
                    for (int m = 0; m < 4; ++m) acc[bj][m][n] = bv; }
            if (s == 0) {
#pragma unroll
                for (int bj = 0; bj < 2; ++bj)
#pragma unroll
                    for (int m = 0; m < 4; ++m)
#pragma unroll
                        for (int n = 0; n < 2; ++n) macc[bj][m][n] = (u32x2){0u, 0u}; }
        } else {
#pragma unroll
            for (int bj = 0; bj < 2; ++bj)
#pragma unroll
                for (int m = 0; m < 4; ++m)
#pragma unroll
                    for (int n = 0; n < 2; ++n) acc[bj][m][n] = (f32x4){0.f, 0.f, 0.f, 0.f};
        }
    }
    __device__ __forceinline__ void done(int u, int s, const acc_t& acc, int wr, int wc, int fr, int fq) {
        if ((s & 1) == 0) {
#pragma unroll
            for (int bj = 0; bj < 2; ++bj)
#pragma unroll
                for (int m = 0; m < 4; ++m)
#pragma unroll
                    for (int n = 0; n < 2; ++n) { const f32x4 a = acc[bj][m][n]; u32x2 w; w.x = pk2(sigmoidf_(a[0]), sigmoidf_(a[1])); w.y = pk2(sigmoidf_(a[2]), sigmoidf_(a[3])); g[bj][m][n] = w; }
        } else {
#pragma unroll
            for (int bj = 0; bj < 2; ++bj)
#pragma unroll
                for (int m = 0; m < 4; ++m)
#pragma unroll
                    for (int n = 0; n < 2; ++n) { const u32x2 w = g[bj][m][n], q = macc[bj][m][n]; const f32x4 v = (f32x4){bflo(q.x), bfhi(q.x), bflo(q.y), bfhi(q.y)} + (f32x4){bflo(w.x), bfhi(w.x), bflo(w.y), bfhi(w.y)} * acc[bj][m][n];
                        u32x2 r; r.x = pk2(v[0], v[1]); r.y = pk2(v[2], v[3]); macc[bj][m][n] = r; }
            if (s == NSEG - 1) { const int pm = u >> 2, pn = u & 3;
#pragma unroll
                for (int m = 0; m < 4; ++m) { bf16* rp = M + (size_t)(pm * 128 + wr * 64 + m * 16 + fr) * D + pn * 256 + wc * 32 + 4 * fq;
#pragma unroll
                    for (int bj = 0; bj < 2; ++bj)
#pragma unroll
                        for (int n = 0; n < 2; ++n) *(u32x2*)(rp + bj * 128 + n * 16) = macc[bj][m][n]; } }
        }
    }
};

struct InProg {
    static constexpr int NSEG = 9;
    const bf16* Hn; const bf16* win; bf16* zin;
    __device__ __forceinline__ void reset() {}
    __device__ __forceinline__ void seg(int u, int s, Seg& S) const { S.A = Hn + (size_t)u * 128 * D; S.lda = D; S.B = win + (size_t)s * 256 * D; S.ldb = D; S.nt = D / 64; }
    __device__ __forceinline__ void init(int u, int s, acc_t& acc, int wr, int wc, int fr, int fq) {
#pragma unroll
        for (int bj = 0; bj < 2; ++bj)
#pragma unroll
            for (int m = 0; m < 4; ++m)
#pragma unroll
                for (int n = 0; n < 2; ++n) acc[bj][m][n] = (f32x4){0.f, 0.f, 0.f, 0.f};
    }
    __device__ __forceinline__ void done(int u, int s, const acc_t& acc, int wr, int wc, int fr, int fq) {
#pragma unroll
        for (int m = 0; m < 4; ++m) { bf16* rp = zin + (size_t)(u * 128 + wr * 64 + m * 16 + fr) * ZP + s * 256 + wc * 32 + 4 * fq;
#pragma unroll
            for (int bj = 0; bj < 2; ++bj)
#pragma unroll
                for (int n = 0; n < 2; ++n) { const f32x4 v = acc[bj][m][n]; u32x2 w; w.x = pk2(v[0], v[1]); w.y = pk2(v[2], v[3]); *(u32x2*)(rp + bj * 128 + n * 16) = w; } }
    }
};
struct PleProg {
    static constexpr int NSEG = 8;
    const bf16* pbf; const bf16* hp; const bf16* wup; const bf16* wpg; bf16* x;
    u32x2 uu[2][4][2];
    __device__ __forceinline__ void reset() {
#pragma unroll
        for (int a = 0; a < 2; ++a)
#pragma unroll
            for (int b = 0; b < 4; ++b)
#pragma unroll
                for (int c = 0; c < 2; ++c) uu[a][b][c] = (u32x2){0u, 0u}; }
    __device__ __forceinline__ void seg(int u, int s, Seg& S) const {
        const int pn = s >> 1;
        if ((s & 1) == 0) { S.A = pbf + (size_t)u * 128 * 256; S.lda = 256; S.B = wup + (size_t)pn * 256 * 256; S.ldb = 256; S.nt = 4; }
        else { S.A = hp + (size_t)u * 128 * D; S.lda = D; S.B = wpg + (size_t)pn * 256 * D; S.ldb = D; S.nt = D / 64; }
    }
    __device__ __forceinline__ void init(int u, int s, acc_t& acc, int wr, int wc, int fr, int fq) {
#pragma unroll
        for (int bj = 0; bj < 2; ++bj)
#pragma unroll
            for (int m = 0; m < 4; ++m)
#pragma unroll
                for (int n = 0; n < 2; ++n) acc[bj][m][n] = (f32x4){0.f, 0.f, 0.f, 0.f};
    }
    __device__ __forceinline__ void done(int u, int s, const acc_t& acc, int wr, int wc, int fr, int fq) {
        if ((s & 1) == 0) {
#pragma unroll
            for (int bj = 0; bj < 2; ++bj)
#pragma unroll
                for (int m = 0; m < 4; ++m)
#pragma unroll
                    for (int n = 0; n < 2; ++n) { const f32x4 a = acc[bj][m][n]; u32x2 w; w.x = pk2(a[0], a[1]); w.y = pk2(a[2], a[3]); uu[bj][m][n] = w; }
        } else { const int pn = s >> 1;
#pragma unroll
            for (int m = 0; m < 4; ++m) { bf16* rp = x + (size_t)(u * 128 + wr * 64 + m * 16 + fr) * D + pn * 256 + wc * 32 + 4 * fq; u32x2 xv[2][2];
#pragma unroll
                for (int bj = 0; bj < 2; ++bj)
#pragma unroll
                    for (int n = 0; n < 2; ++n) xv[bj][n] = *(const u32x2*)(rp + bj * 128 + n * 16);
#pragma unroll
                for (int bj = 0; bj < 2; ++bj)
#pragma unroll
                    for (int n = 0; n < 2; ++n) { const u32x2 w = uu[bj][m][n]; f32x4 v = acc[bj][m][n];
                        v[0] = sigmoidf_(v[0]); v[1] = sigmoidf_(v[1]); v[2] = sigmoidf_(v[2]); v[3] = sigmoidf_(v[3]);
                        const u32x2 xw = xv[bj][n]; v = (f32x4){bflo(xw.x), bfhi(xw.x), bflo(xw.y), bfhi(xw.y)} + (f32x4){bflo(w.x), bfhi(w.x), bflo(w.y), bfhi(w.y)} * v;
                        u32x2 ow; ow.x = pk2(v[0], v[1]); ow.y = pk2(v[2], v[3]); *(u32x2*)(rp + bj * 128 + n * 16) = ow; } } }
    }
};
struct WoProg {
    static constexpr int NSEG = 4;
    const bf16* Mn; const bf16* wo; const float* xin; float* xout;
    __device__ __forceinline__ void reset() {}
    __device__ __forceinline__ void seg(int u, int s, Seg& S) const { S.A = Mn + (size_t)u * 128 * D; S.lda = D; S.B = wo + (size_t)s * 256 * D; S.ldb = D; S.nt = D / 64; }
    __device__ __forceinline__ void init(int u, int s, acc_t& acc, int wr, int wc, int fr, int fq) {
#pragma unroll
        for (int bj = 0; bj < 2; ++bj)
#pragma unroll
            for (int m = 0; m < 4; ++m)
#pragma unroll
                for (int n = 0; n < 2; ++n) acc[bj][m][n] = (f32x4){0.f, 0.f, 0.f, 0.f};
    }
    __device__ __forceinline__ void done(int u, int s, const acc_t& acc, int wr, int wc, int fr, int fq) {
#pragma unroll
        for (int m = 0; m < 4; ++m) { const size_t ro = (size_t)(u * 128 + wr * 64 + m * 16 + fr) * D + s * 256 + wc * 32 + 4 * fq; f32x4 xv[2][2];
#pragma unroll
            for (int bj = 0; bj < 2; ++bj)
#pragma unroll
                for (int n = 0; n < 2; ++n) xv[bj][n] = *(const f32x4*)(xin + ro + bj * 128 + n * 16);
#pragma unroll
            for (int bj = 0; bj < 2; ++bj)
#pragma unroll
                for (int n = 0; n < 2; ++n) *(f32x4*)(xout + ro + bj * 128 + n * 16) = xv[bj][n] + acc[bj][m][n]; }
    }
};
}
namespace epi {
using pg8::Unit; using pg8::BM; using pg8::HALF;
__device__ __forceinline__ void epi_fence() { asm volatile("" ::: "memory"); }
#define EPI_FENCE epi_fence()
#define EPI_LOOP_ROWS for (int ai = 0; ai < 2; ++ai) _Pragma("unroll") for (int m = 0; m < 4; ++m)
#define EPI_LOOP_COLS for (int bj = 0; bj < 2; ++bj) _Pragma("unroll") for (int n = 0; n < 2; ++n)
#define EPI_ROW (u.pm * BM + ai * HALF + wr * 64 + m * 16 + fr)
#define EPI_COLT (bj * HALF + wc * 32 + n * 16 + 4 * fq)
typedef f32x4 acc_t[2][2][4][2];
__device__ __forceinline__ u32x2 pack4(f32x4 v) { u32x2 w; w.x = pk2(v[0], v[1]); w.y = pk2(v[2], v[3]); return w; }
__device__ __forceinline__ f32x4 unpack4(u32x2 w) { return (f32x4){bflo(w.x), bfhi(w.x), bflo(w.y), bfhi(w.y)}; }

struct EpiStore {
    static constexpr bool PERM = true;
    bf16* O; int ldc; int pn0;
    __device__ __forceinline__ void operator()(const acc_t& acc, const Unit& u, int wr, int wc, int fr, int fq) const {
#pragma unroll
        EPI_LOOP_ROWS { bf16* rp = O + (size_t)EPI_ROW * ldc + (u.pn - pn0) * BM + wc * 32 + 8 * fq;
#pragma unroll
            for (int bj = 0; bj < 2; ++bj) { const u32x2 lo = pack4(acc[ai][bj][m][0]), hi = pack4(acc[ai][bj][m][1]); *(u32x4*)(rp + bj * HALF) = (u32x4){lo.x, lo.y, hi.x, hi.y}; } }
    }
};
struct EpiRowScale {
    static constexpr bool PERM = false;
    bf16* O; int ldc; const float* rs;
    __device__ __forceinline__ void operator()(const acc_t& acc, const Unit& u, int wr, int wc, int fr, int fq) const {
        float sv[2][4];
#pragma unroll
        EPI_LOOP_ROWS sv[ai][m] = rs[EPI_ROW];
#pragma unroll
        EPI_LOOP_ROWS { const int row = EPI_ROW; const float s = sv[ai][m]; bf16* rp = O + (size_t)row * ldc + u.pn * BM;
#pragma unroll
            EPI_LOOP_COLS { *(u32x2*)(rp + EPI_COLT) = pack4(acc[ai][bj][m][n] * s); } }
    }
};
struct EpiMlaQ {
    static constexpr bool PERM = false;
    bf16* O; const float* rs; const float* cosT; const float* sinT;
    __device__ __forceinline__ void operator()(const acc_t& acc, const Unit& u, int wr, int wc, int fr, int fq) const {
        float sv[2][4]; f32x4 csv[2], snv[2];
#pragma unroll
        EPI_LOOP_ROWS sv[ai][m] = rs[EPI_ROW];
        { const int row = u.pm * BM + wr * 64 + fr; csv[0] = *(const f32x4*)(cosT + (size_t)row * 16 + 4 * fq); snv[0] = *(const f32x4*)(sinT + (size_t)row * 16 + 4 * fq); }
#pragma unroll
        for (int it = 0; it < 8; ++it) { const int ai = it >> 2, m = it & 3;
            if (it + 1 < 8) { const int row = u.pm * BM + ((it + 1) >> 2) * HALF + wr * 64 + ((it + 1) & 3) * 16 + fr;
                csv[(it + 1) & 1] = *(const f32x4*)(cosT + (size_t)row * 16 + 4 * fq); snv[(it + 1) & 1] = *(const f32x4*)(sinT + (size_t)row * 16 + 4 * fq); }
            const int row = EPI_ROW; const float s = sv[ai][m]; bf16* rp = O + (size_t)row * 512 + u.pn * BM;
            const f32x4 cs = csv[it & 1], sn = snv[it & 1];
#pragma unroll
            for (int bj = 0; bj < 2; ++bj) { const int grp = u.pn * 8 + bj * 4 + wc;
                f32x4 t1 = acc[ai][bj][m][0] * s, t2 = acc[ai][bj][m][1] * s;
                if (grp % 3 == 2) { const f32x4 a = t1 * cs - t2 * sn, b = t2 * cs + t1 * sn; t1 = a; t2 = b; }
                *(u32x2*)(rp + bj * HALF + wc * 32 + 4 * fq) = pack4(t1); *(u32x2*)(rp + bj * HALF + wc * 32 + 16 + 4 * fq) = pack4(t2); } }
    }
};
struct EpiGate {
    static constexpr bool PERM = false;
    bf16* G; const float* bias;
    __device__ __forceinline__ void operator()(const acc_t& acc, const Unit& u, int wr, int wc, int fr, int fq) const {
        f32x4 bv[2][2];
#pragma unroll
        EPI_LOOP_COLS bv[bj][n] = *(const f32x4*)(bias + u.pn * BM + EPI_COLT);
#pragma unroll
        EPI_LOOP_ROWS { bf16* rp = G + (size_t)EPI_ROW * D + u.pn * BM;
#pragma unroll
            EPI_LOOP_COLS { f32x4 v = acc[ai][bj][m][n] + bv[bj][n];
                v[0] = sigmoidf_(v[0]); v[1] = sigmoidf_(v[1]); v[2] = sigmoidf_(v[2]); v[3] = sigmoidf_(v[3]);
                *(u32x2*)(rp + EPI_COLT) = pack4(v); } }
    }
};
#define EPI_IT_ROW(it_) (u.pm * BM + ((it_) >> 2) * HALF + wr * 64 + ((it_) & 3) * 16 + fr)
#define EPI_C4(c_) (((c_) >> 1) * HALF + wc * 32 + ((c_) & 1) * 16 + 4 * fq)
struct EpiMerge {
    static constexpr bool PERM = false;
    const bf16* G; bf16* M; int first;
    __device__ __forceinline__ void operator()(const acc_t& acc, const Unit& u, int wr, int wc, int fr, int fq) const {
        u32x2 gv[2][4], mv[2][4];
#define EPI_LD(it_) do { const size_t ro_ = (size_t)EPI_IT_ROW(it_) * D + u.pn * BM; _Pragma("unroll") for (int c = 0; c < 4; ++c) { gv[(it_) & 1][c] = *(const u32x2*)(G + ro_ + EPI_C4(c)); \
            mv[(it_) & 1][c] = first ? (u32x2){0u, 0u} : *(const u32x2*)(M + ro_ + EPI_C4(c)); } } while (0)
        EPI_LD(0);
#pragma unroll
        for (int it = 0; it < 8; ++it) { if (it + 1 < 8) EPI_LD(it + 1);
            const size_t ro = (size_t)EPI_IT_ROW(it) * D + u.pn * BM;
#pragma unroll
            for (int c = 0; c < 4; ++c) { const f32x4 v = unpack4(gv[it & 1][c]) * acc[it >> 2][c >> 1][it & 3][c & 1] + unpack4(mv[it & 1][c]); *(u32x2*)(M + ro + EPI_C4(c)) = pack4(v); } }
#undef EPI_LD
    }
};
struct EpiRes {
    static constexpr bool PERM = false;
    XSrc xin; bf16* xout;
    __device__ __forceinline__ void operator()(const acc_t& acc, const Unit& u, int wr, int wc, int fr, int fq) const {
        f32x4 xv[2][4];
#define EPI_LD(it_) do { const size_t ro_ = (size_t)EPI_IT_ROW(it_) * D + u.pn * BM; _Pragma("unroll") for (int c = 0; c < 4; ++c) xv[(it_) & 1][c] = ldx4(xin, ro_ + EPI_C4(c)); } while (0)
        EPI_LD(0);
#pragma unroll
        for (int it = 0; it < 8; ++it) { if (it + 1 < 8) EPI_LD(it + 1);
            const size_t ro = (size_t)EPI_IT_ROW(it) * D + u.pn * BM;
#pragma unroll
            for (int c = 0; c < 4; ++c) *(u32x2*)(xout + ro + EPI_C4(c)) = pack4(xv[it & 1][c] + acc[it >> 2][c >> 1][it & 3][c & 1]); }
#undef EPI_LD
    }
};
struct EpiPle {
    static constexpr bool PERM = false;
    const bf16* U; float* x;
    __device__ __forceinline__ void operator()(const acc_t& acc, const Unit& u, int wr, int wc, int fr, int fq) const {
        f32x4 xv[2][4]; u32x2 uv[2][4];
#define EPI_LD(it_) do { const size_t ro_ = (size_t)EPI_IT_ROW(it_) * D + u.pn * BM; _Pragma("unroll") for (int c = 0; c < 4; ++c) { xv[(it_) & 1][c] = *(const f32x4*)(x + ro_ + EPI_C4(c)); uv[(it_) & 1][c] = *(const u32x2*)(U + ro_ + EPI_C4(c)); } } while (0)
        EPI_LD(0);
#pragma unroll
        for (int it = 0; it < 8; ++it) { if (it + 1 < 8) EPI_LD(it + 1);
            const size_t ro = (size_t)EPI_IT_ROW(it) * D + u.pn * BM;
#pragma unroll
            for (int c = 0; c < 4; ++c) { f32x4 v = acc[it >> 2][c >> 1][it & 3][c & 1];
                v[0] = sigmoidf_(v[0]); v[1] = sigmoidf_(v[1]); v[2] = sigmoidf_(v[2]); v[3] = sigmoidf_(v[3]);
                *(f32x4*)(x + ro + EPI_C4(c)) = xv[it & 1][c] + unpack4(uv[it & 1][c]) * v; } }
#undef EPI_LD
    }
};
struct EpiSwiglu {
    static constexpr bool PERM = true;
    bf16* O; int ldc; int npt;
    __device__ __forceinline__ void operator()(const acc_t& acc, const Unit& u, int wr, int wc, int fr, int fq) const {
        const int ct = (u.pn % npt) * HALF;
#pragma unroll
        EPI_LOOP_ROWS { bf16* rp = O + (size_t)EPI_ROW * ldc + ct + wc * 32 + 8 * fq; u32x2 w[2];
#pragma unroll
            for (int n = 0; n < 2; ++n) { const f32x4 a = acc[ai][0][m][n], b = acc[ai][1][m][n]; f32x4 v;
#pragma unroll
                for (int e = 0; e < 4; ++e) v[e] = a[e] * sigmoidf_(a[e]) * b[e];
                w[n] = pack4(v); }
            *(u32x4*)rp = (u32x4){w[0].x, w[0].y, w[1].x, w[1].y}; }
    }
};
struct EpiGlu {
    static constexpr bool PERM = false;
    bf16* Y; int ldc;
    __device__ __forceinline__ void operator()(const acc_t& acc, const Unit& u, int wr, int wc, int fr, int fq) const {
        u32x2 yv[2][4];
#define EPI_LD(it_) do { const bf16* rp_ = Y + (size_t)EPI_IT_ROW(it_) * ldc + u.pn * BM; _Pragma("unroll") for (int c = 0; c < 4; ++c) yv[(it_) & 1][c] = *(const u32x2*)(rp_ + EPI_C4(c)); } while (0)
        EPI_LD(0);
#pragma unroll
        for (int it = 0; it < 8; ++it) { if (it + 1 < 8) EPI_LD(it + 1);
            bf16* rp = Y + (size_t)EPI_IT_ROW(it) * ldc + u.pn * BM;
#pragma unroll
            for (int c = 0; c < 4; ++c) { const f32x4 y = unpack4(yv[it & 1][c]); f32x4 v = acc[it >> 2][c >> 1][it & 3][c & 1];
#pragma unroll
                for (int e = 0; e < 4; ++e) v[e] = y[e] * sigmoidf_(v[e]);
                *(u32x2*)(rp + EPI_C4(c)) = pack4(v); } }
#undef EPI_LD
    }
};
struct EpiMoeDown {
    static constexpr bool PERM = false;
    bf16* Y; const float* slot_gate;
    __device__ __forceinline__ void operator()(const acc_t& acc, const Unit& u, int wr, int wc, int fr, int fq) const {
        const int ct = (u.pn & 3) * BM;
        float gv[2][4];
#pragma unroll
        EPI_LOOP_ROWS gv[ai][m] = slot_gate[EPI_ROW];
#pragma unroll
        EPI_LOOP_ROWS { const int row = EPI_ROW; const float gt = gv[ai][m]; bf16* rp = Y + (size_t)row * D + ct;
#pragma unroll
            EPI_LOOP_COLS { *(u32x2*)(rp + EPI_COLT) = pack4(acc[ai][bj][m][n] * gt); } }
    }
};
}
namespace att {
constexpr int MODE_FOX = 0, MODE_MLA = 1, MODE_BAND = 2;
constexpr float LOG2E = 1.4426950408889634f;
struct Tensors {
    const bf16* Q; int ldq;
    const bf16* K; int ldk;
    const bf16* K2;
    const bf16* V; int ldv;
    bf16* O; int ldo;
    const float* cdec;
    const float* relb;
    int qhs, khs, vhs, ohs;
    const unsigned* qmax; const unsigned* kmax;
};
template <int DQK> struct Lay { static constexpr int KS = DQK * 2 + 16, KB = 64 * KS, VB = 64 * 128, CB = 256, BUF = KB + VB + CB; };
constexpr int ATT_LDS_TAB = 2 * Lay<96>::BUF;
constexpr int ATT_LDS_BYTES = ATT_LDS_TAB + 520 * 4;
__device__ __forceinline__ int crow(int r, int hi) { return (r & 3) + 8 * (r >> 2) + 4 * hi; }
typedef short v4i16_t __attribute__((ext_vector_type(4)));
__device__ __forceinline__ s16x4 vtr(const LAS unsigned char* p) { return __builtin_bit_cast(s16x4, __builtin_amdgcn_ds_read_tr16_b64_v4i16((LAS v4i16_t*)p)); }

template <int MODE>
__device__ __forceinline__ void attn_unit(const Tensors& T, int b, int h, int qb, LAS unsigned char* lds) {
    constexpr int DQK = (MODE == MODE_MLA) ? 96 : 64, NKS = DQK / 16;
    typedef Lay<DQK> LY;
    int tid = my_tid(); asm volatile("" : "+v"(tid));
    const int lane = tid & 63, r32 = lane & 31, hi = lane >> 5; const int wid = __builtin_amdgcn_readfirstlane(tid >> 6);
    const int rowb = b * SEQ, q0 = qb * 256;
    const float sc2 = ((MODE == MODE_MLA) ? 0.10206207261596575f : 0.125f) * LOG2E;
    const int cw = 4 * qb + (wid >> 1);
    const int t_lo = (MODE == MODE_BAND) ? ((4 * qb - 8) > 0 ? (4 * qb - 8) : 0) : 0, t_hi = 4 * qb + 4;
    const int qrow = rowb + q0 + wid * 32 + r32;
    bf16x8 qf[NKS];
    { const bf16* qp = T.Q + (size_t)qrow * T.ldq + h * T.qhs + hi * 8;
#pragma unroll
      for (int ks = 0; ks < NKS; ++ks) qf[ks] = *(const bf16x8*)(qp + ks * 16); }
    float cq = 0.f; if (MODE == MODE_FOX) cq = T.cdec[(size_t)qrow * 4 + h];
    LAS float* tab = (LAS float*)(lds + ATT_LDS_TAB);
    if (MODE == MODE_BAND) { for (int i = tid; i < 513; i += NTHREADS) tab[i] = T.relb[h * 513 + i] * LOG2E; }
    u32x4 kreg0[2] = {}, kreg1[2] = {}, vreg[2] = {}; float creg[2] = {0.f, 0.f};
    const int srow = tid >> 3, sch = tid & 7;
#define ATT_KADDR(c_) (((c_) % 12 < 8) ? (const u32x4*)(T.K + (kr_ + (c_) / 12) * T.ldk + h * T.khs + ((c_) % 12) * 8) : (const u32x4*)(T.K2 + (kr_ + (c_) / 12) * 32 + ((c_) % 12 - 8) * 8))
#define ATT_LOAD_TILE(t_, r_) do { const size_t kr_ = (size_t)(rowb + (t_) * 64); \
        if (MODE == MODE_MLA) { kreg0[r_] = *ATT_KADDR(tid); if (tid < 256) kreg1[r_] = *ATT_KADDR(tid + 512); } \
        else { kreg0[r_] = *(const u32x4*)(T.K + (kr_ + srow) * T.ldk + h * T.khs + sch * 8); } \
        vreg[r_] = *(const u32x4*)(T.V + (kr_ + srow) * T.ldv + h * T.vhs + sch * 8); \
        if (MODE == MODE_FOX) { if (tid < 64) creg[r_] = T.cdec[(kr_ + tid) * 4 + h]; } } while (0)
#define ATT_STORE_TILE(buf_, r_) do { LAS unsigned char* base_ = lds + (buf_) * LY::BUF; \
        if (MODE == MODE_MLA) { *(LAS u32x4*)(base_ + (tid / 12) * LY::KS + (tid % 12) * 16) = kreg0[r_]; \
            if (tid < 256) *(LAS u32x4*)(base_ + ((tid + 512) / 12) * LY::KS + ((tid + 512) % 12) * 16) = kreg1[r_]; } \
        else { *(LAS u32x4*)(base_ + srow * LY::KS + sch * 16) = kreg0[r_]; } \
        *(LAS u32x4*)(base_ + LY::KB + srow * 128 + ((sch * 16) ^ (((srow >> 1) & 1) << 6))) = vreg[r_]; \
        if (MODE == MODE_FOX) { if (tid < 64) *(LAS float*)(base_ + LY::KB + LY::VB + tid * 4) = creg[r_]; } } while (0)
    float mrun = -INFINITY, lrun = 0.f;
    f32x16 o0 = {}, o1 = {};
    const int G = lane >> 4, qi = (lane & 15) >> 2, pi = lane & 3;
    const int vb0 = (4 * hi + qi) * 128 + 64 * (0 ^ (qi >> 1)) + 32 * (G & 1) + 8 * pi;
    const int vb1 = (4 * hi + qi) * 128 + 64 * (1 ^ (qi >> 1)) + 32 * (G & 1) + 8 * pi;
    int t_min = t_lo;
    if (MODE == MODE_FOX) {
        LAS int* tm = (LAS int*)(lds + ATT_LDS_TAB);
        if (tid == 0) tm[0] = t_hi - 1;
        __syncthreads();
        if (tid < t_hi) {
            const float q2 = __uint_as_float(T.qmax[(b * 4 + h) * 32 + qb]), k2 = __uint_as_float(T.kmax[b * 4 + h]);
            const float thr = 0.125f * sqrtf(q2) * 2.0f * sqrtf(k2) * 1.02f + 112.0f;
            const float cfirst = T.cdec[(size_t)(rowb + q0) * 4 + h], clast = T.cdec[(size_t)(rowb + tid * 64 + 63) * 4 + h];
            if (!(clast - cfirst > thr)) __hip_atomic_fetch_min(tm, tid, __ATOMIC_RELAXED, __HIP_MEMORY_SCOPE_WORKGROUP);
        }
        __syncthreads();
        t_min = tm[0];
    }
    const int n_t = t_hi - t_min;
#define ATT_TILE(i_) ((MODE == MODE_FOX) ? (t_hi - 1 - (i_)) : (t_min + (i_)))
    ATT_LOAD_TILE(ATT_TILE(0), 0); ATT_STORE_TILE(0, 0);
    if (n_t > 1) ATT_LOAD_TILE(ATT_TILE(1), 1);
    if (n_t > 2) ATT_LOAD_TILE(ATT_TILE(2), 0);
    __syncthreads();
    for (int it0 = 0; it0 < n_t; it0 += 2) {
#pragma unroll
      for (int half = 0; half < 2; ++half) { const int it = it0 + half; if (it < n_t) {
        const int t = ATT_TILE(it);
        const int buf = half;
        const bool active = (MODE == MODE_BAND) ? (t <= cw && t >= cw - 8) : (t <= cw);
        if (active) {
            const LAS unsigned char* kb = lds + buf * LY::BUF;
            const LAS unsigned char* vbuf = kb + LY::KB;
            f32x16 p0 = {}, p1 = {};
            bf16x8 ka[NKS], kc[NKS];
#pragma unroll
            for (int ks = 0; ks < NKS; ++ks) { ka[ks] = *(const LAS bf16x8*)(kb + r32 * LY::KS + (ks * 16 + hi * 8) * 2); kc[ks] = *(const LAS bf16x8*)(kb + (32 + r32) * LY::KS + (ks * 16 + hi * 8) * 2); }
            __builtin_amdgcn_sched_barrier(0);
#pragma unroll
            for (int ks = 0; ks < NKS; ++ks) { p0 = __builtin_amdgcn_mfma_f32_32x32x16_bf16(ka[ks], qf[ks], p0, 0, 0, 0); p1 = __builtin_amdgcn_mfma_f32_32x32x16_bf16(kc[ks], qf[ks], p1, 0, 0, 0); }
            s16x4 vl0[4], vh0[4], vl1[4], vh1[4];
#pragma unroll
            for (int s4 = 0; s4 < 4; ++s4) { vl0[s4] = vtr(vbuf + vb0 + s4 * 2048); vh0[s4] = vtr(vbuf + vb0 + s4 * 2048 + 1024); vl1[s4] = vtr(vbuf + vb1 + s4 * 2048); vh1[s4] = vtr(vbuf + vb1 + s4 * 2048 + 1024); }
            __builtin_amdgcn_sched_barrier(0);
            if (MODE == MODE_FOX) {
                const LAS float* cb = (const LAS float*)(vbuf + LY::VB);
                const float cq2 = cq * LOG2E;
#pragma unroll
                for (int a = 0; a < 4; ++a) {
                    const f32x4 c0 = *(const LAS f32x4*)(cb + 8 * a + 4 * hi), c1 = *(const LAS f32x4*)(cb + 32 + 8 * a + 4 * hi);
#pragma unroll
                    for (int e = 0; e < 4; ++e) { p0[4 * a + e] = p0[4 * a + e] * sc2 + (cq2 - c0[e] * LOG2E); p1[4 * a + e] = p1[4 * a + e] * sc2 + (cq2 - c1[e] * LOG2E); }
                }
                if (t == cw) { const int ql = 32 * (wid & 1) + r32;
#pragma unroll
                    for (int r = 0; r < 16; ++r) { const int kv = crow(r, hi); if (kv > ql) p0[r] = -INFINITY; if (kv + 32 > ql) p1[r] = -INFINITY; } }
            } else if (MODE == MODE_BAND) {
                const int dq = (q0 + wid * 32 + r32) - t * 64;
#pragma unroll
                for (int r = 0; r < 16; ++r) { const int kv = crow(r, hi);
                    int i0 = dq - kv, i1 = dq - kv - 32; i0 = i0 < -256 ? -256 : (i0 > 256 ? 256 : i0); i1 = i1 < -256 ? -256 : (i1 > 256 ? 256 : i1);
                    p0[r] = p0[r] * sc2 + tab[i0 + 256]; p1[r] = p1[r] * sc2 + tab[i1 + 256]; }
            }
            float mx = fmaxf(p0[0], p1[0]);
#pragma unroll
            for (int r = 1; r < 16; ++r) mx = fmaxf(mx, fmaxf(p0[r], p1[r]));
            { auto rr = __builtin_amdgcn_permlane32_swap(__float_as_uint(mx), __float_as_uint(mx), false, false); mx = fmaxf(__uint_as_float(rr[0]), __uint_as_float(rr[1])); }
            if (MODE == MODE_MLA) mx *= sc2;
            const float mnew = fmaxf(mrun, mx);
            if (__any(mnew > mrun)) {
                const float alpha = __builtin_amdgcn_exp2f(mrun - mnew);
                lrun *= alpha;
#pragma unroll
                for (int r = 0; r < 16; ++r) { o0[r] *= alpha; o1[r] *= alpha; }
                mrun = mnew;
            }
            float rs = 0.f;
#pragma unroll
            for (int r = 0; r < 16; ++r) {
                if (MODE == MODE_MLA) { p0[r] = __builtin_amdgcn_exp2f(__builtin_fmaf(p0[r], sc2, -mrun)); p1[r] = __builtin_amdgcn_exp2f(__builtin_fmaf(p1[r], sc2, -mrun)); }
                else { p0[r] = __builtin_amdgcn_exp2f(p0[r] - mrun); p1[r] = __builtin_amdgcn_exp2f(p1[r] - mrun); }
                rs += p0[r] + p1[r]; }
            lrun += rs;
#pragma unroll
            for (int s4 = 0; s4 < 4; ++s4) {
                u32x4 pw;
                if (s4 < 2) { const int o = 8 * (s4 & 1); pw.x = pk2(p0[o], p0[o + 1]); pw.y = pk2(p0[o + 2], p0[o + 3]); pw.z = pk2(p0[o + 4], p0[o + 5]); pw.w = pk2(p0[o + 6], p0[o + 7]); }
                else        { const int o = 8 * (s4 & 1); pw.x = pk2(p1[o], p1[o + 1]); pw.y = pk2(p1[o + 2], p1[o + 3]); pw.z = pk2(p1[o + 4], p1[o + 5]); pw.w = pk2(p1[o + 6], p1[o + 7]); }
                const bf16x8 pf = __builtin_bit_cast(bf16x8, pw);
                const s16x4 l0 = vl0[s4], h0 = vh0[s4], l1 = vl1[s4], h1 = vh1[s4];
                const bf16x8 vf0 = (bf16x8){l0[0], l0[1], l0[2], l0[3], h0[0], h0[1], h0[2], h0[3]};
                const bf16x8 vf1 = (bf16x8){l1[0], l1[1], l1[2], l1[3], h1[0], h1[1], h1[2], h1[3]};
                o0 = __builtin_amdgcn_mfma_f32_32x32x16_bf16(vf0, pf, o0, 0, 0, 0);
                o1 = __builtin_amdgcn_mfma_f32_32x32x16_bf16(vf1, pf, o1, 0, 0, 0);
            }
        }
        if (it + 1 < n_t) ATT_STORE_TILE(half ^ 1, half ^ 1);
        if (it + 3 < n_t) ATT_LOAD_TILE(ATT_TILE(it + 3), half ^ 1);
        __syncthreads();
      } }
    }
    { auto rr = __builtin_amdgcn_permlane32_swap(__float_as_uint(lrun), __float_as_uint(lrun), false, false); lrun = __uint_as_float(rr[0]) + __uint_as_float(rr[1]); }
    const float inv = 1.0f / lrun;
    bf16* op = T.O + (size_t)qrow * T.ldo + h * T.ohs;
#pragma unroll
    for (int a = 0; a < 4; ++a) {
        u32x2 w0, w1;
        w0.x = pk2(o0[4 * a] * inv, o0[4 * a + 1] * inv); w0.y = pk2(o0[4 * a + 2] * inv, o0[4 * a + 3] * inv);
        w1.x = pk2(o1[4 * a] * inv, o1[4 * a + 1] * inv); w1.y = pk2(o1[4 * a + 2] * inv, o1[4 * a + 3] * inv);
        *(u32x2*)(op + 8 * a + 4 * hi) = w0; *(u32x2*)(op + 32 + 8 * a + 4 * hi) = w1;
    }
}

template <int MODE>
__device__ __forceinline__ void attn_phase(const Tensors& T, LAS unsigned char* lds) {
    const int G = gridDim.x, bx = blockIdx.x, vcu = (G % 8 == 0) ? (bx % 8) * (G / 8) + bx / 8 : bx;
    for (int pr = vcu; pr < 256; pr += G) {
        const int bh = pr >> 4, s = pr & 15;
        attn_unit<MODE>(T, bh >> 2, bh & 3, s, lds);
        attn_unit<MODE>(T, bh >> 2, bh & 3, 31 - s, lds);
    }
}

template <int MODE>
__device__ __forceinline__ void attn_naive(const Tensors& T) {
    BODY_IDS();
    constexpr int DQK = (MODE == MODE_MLA) ? 96 : 64;
    const float sc = (MODE == MODE_MLA) ? 0.10206207261596575f : 0.125f;
    for (int idx = gtid; idx < NTOK * 4; idx += gthreads) {
        const int h = idx / NTOK, row = idx % NTOK, b = row / SEQ, tpos = row % SEQ, rowb = b * SEQ;
        float q[DQK], o[64];
#pragma unroll
        for (int d = 0; d < DQK; ++d) q[d] = bf2f(T.Q[(size_t)row * T.ldq + h * T.qhs + d]) * sc;
#pragma unroll
        for (int d = 0; d < 64; ++d) o[d] = 0.f;
        float m = -INFINITY, l = 0.f;
        const int ck = tpos / 64;
        const int k_lo = (MODE == MODE_BAND) ? ((ck - 8) > 0 ? (ck - 8) * 64 : 0) : 0;
        const int k_hi = (MODE == MODE_FOX) ? tpos : (ck * 64 + 63);
        const float cq = (MODE == MODE_FOX) ? T.cdec[(size_t)row * 4 + h] : 0.f;
        for (int kv = k_lo; kv <= k_hi; ++kv) {
            const size_t kr = (size_t)(rowb + kv);
            float s = 0.f;
#pragma unroll
            for (int d8 = 0; d8 < 8; ++d8) { const u32x4 w = *(const u32x4*)(T.K + kr * T.ldk + h * T.khs + d8 * 8);
                s += q[d8 * 8 + 0] * bflo(w.x) + q[d8 * 8 + 1] * bfhi(w.x) + q[d8 * 8 + 2] * bflo(w.y) + q[d8 * 8 + 3] * bfhi(w.y)
                   + q[d8 * 8 + 4] * bflo(w.z) + q[d8 * 8 + 5] * bfhi(w.z) + q[d8 * 8 + 6] * bflo(w.w) + q[d8 * 8 + 7] * bfhi(w.w); }
            if (MODE == MODE_MLA) {
#pragma unroll
                for (int d8 = 0; d8 < 4; ++d8) { const u32x4 w = *(const u32x4*)(T.K2 + kr * 32 + d8 * 8);
                    s += q[64 + d8 * 8 + 0] * bflo(w.x) + q[64 + d8 * 8 + 1] * bfhi(w.x) + q[64 + d8 * 8 + 2] * bflo(w.y) + q[64 + d8 * 8 + 3] * bfhi(w.y)
                       + q[64 + d8 * 8 + 4] * bflo(w.z) + q[64 + d8 * 8 + 5] * bfhi(w.z) + q[64 + d8 * 8 + 6] * bflo(w.w) + q[64 + d8 * 8 + 7] * bfhi(w.w); }
            }
            if (MODE == MODE_FOX) s += cq - T.cdec[kr * 4 + h];
            if (MODE == MODE_BAND) { int rel = tpos - kv; rel = rel < -256 ? -256 : (rel > 256 ? 256 : rel); s += T.relb[h * 513 + rel + 256]; }
            const float mn = fmaxf(m, s), al = __expf(m - mn), pp = __expf(s - mn);
            l = l * al + pp; m = mn;
#pragma unroll
            for (int d8 = 0; d8 < 8; ++d8) { const u32x4 w = *(const u32x4*)(T.V + kr * T.ldv + h * T.vhs + d8 * 8);
                o[d8 * 8 + 0] = o[d8 * 8 + 0] * al + pp * bflo(w.x); o[d8 * 8 + 1] = o[d8 * 8 + 1] * al + pp * bfhi(w.x);
                o[d8 * 8 + 2] = o[d8 * 8 + 2] * al + pp * bflo(w.y); o[d8 * 8 + 3] = o[d8 * 8 + 3] * al + pp * bfhi(w.y);
                o[d8 * 8 + 4] = o[d8 * 8 + 4] * al + pp * bflo(w.z); o[d8 * 8 + 5] = o[d8 * 8 + 5] * al + pp * bfhi(w.z);
                o[d8 * 8 + 6] = o[d8 * 8 + 6] * al + pp * bflo(w.w); o[d8 * 8 + 7] = o[d8 * 8 + 7] * al + pp * bfhi(w.w); }
        }
        const float inv = 1.0f / l;
#pragma unroll
        for (int d = 0; d < 64; d += 2) *(unsigned*)(T.O + (size_t)row * T.ldo + h * T.ohs + d) = pk2(o[d] * inv, o[d + 1] * inv);
    }
}
}
struct Params {
    const float* in[37];
    float* out;
    unsigned char* ws;
    int ph_lo, ph_hi;
};
enum { I_X = 0, I_P, I_POS, I_WIN, I_SAR, I_SAI, I_SLDT, I_SBR, I_SBI, I_SCR, I_SCI, I_SD, I_SGLU, I_FBF, I_GQ, I_WUQ, I_GKV, I_WUKV, I_RELB, I_WB, I_WG, I_BG, I_WO,
       I_GMIX, I_GFFN, I_FW1, I_FW3, I_FW2, I_MWR, I_MBR, I_MW1, I_MW3, I_MW2, I_GPLE, I_PWG, I_PWU, I_GFIN };

__device__ __forceinline__ void sincos_rad(double a, float& s, float& c) {
    double r = a * 0.15915494309189535; r = r - __builtin_rint(r); const float f = (float)r;
    s = __builtin_amdgcn_sinf(f); c = __builtin_amdgcn_cosf(f);
}
__device__ __forceinline__ float gelu_tanh(float x) {
    const float z = 0.7978845608028654f * (x + 0.044715f * x * x * x);
    const float e = __expf(2.0f * z); const float th = 1.0f - 2.0f / (1.0f + e);
    return 0.5f * x * (1.0f + th);
}
__device__ __forceinline__ float log_sigmoid(float z) { return fminf(z, 0.f) - log1pf(__expf(-fabsf(z))); }

struct CvtJob { const float* src; const float* ks; bf16* dst; int K, ldsrc, col0, ncols, row0, ldk, ilv; };
__device__ __forceinline__ void cvt_item(const CvtJob& J, LAS float* scr, int item, int lane) {
    const int nblk = (J.ncols + 63) >> 6, kb = item / nblk, nb = item % nblk, k0 = 64 * kb, n0 = 64 * nb;
    const int n4 = (lane & 15) * 4; const bool inb = (n0 + n4) < J.ncols;
#pragma unroll 8
    for (int i = 0; i < 16; ++i) { const int kk = 4 * i + (lane >> 4); f32x4 v = {0.f, 0.f, 0.f, 0.f};
        if (inb) v = *(const f32x4*)(J.src + (size_t)(k0 + kk) * J.ldsrc + J.col0 + n0 + n4);
        if (J.ks) v = v * J.ks[k0 + kk];
        *(LAS f32x4*)(scr + kk * 68 + n4) = v; }
    LDS_WAIT(); asm volatile("" ::: "memory");
    const int c = lane & 7;
#pragma unroll
    for (int j = 0; j < 8; ++j) { const int n = (lane >> 3) + 8 * j; const LAS float* s = scr + (8 * c) * 68 + n;
        u32x4 o; o.x = pk2(s[0 * 68], s[1 * 68]); o.y = pk2(s[2 * 68], s[3 * 68]); o.z = pk2(s[4 * 68], s[5 * 68]); o.w = pk2(s[6 * 68], s[7 * 68]);
        const int nn = n0 + n; const int row = J.row0 + (J.ilv ? ((nn >> 7) * 256 + (nn & 127)) : nn);
        if (nn < J.ncols) *(u32x4*)(J.dst + (size_t)row * J.ldk + k0 + 8 * c) = o; }
    LDS_WAIT(); asm volatile("" ::: "memory");
}
__device__ __forceinline__ bf16* wmix(const Params& P, int L, size_t off) { return (bf16*)(P.ws + WS_WMIX + (size_t)L * WMIX_STRIDE + off); }
__device__ __forceinline__ CvtJob get_job(const Params& P, int j) {
    CvtJob J; J.ks = nullptr; J.ilv = 0; J.col0 = 0; J.row0 = 0;
    if (j < 40) {
        const int L = j / 20, q = j % 20;
        if (q < 5) {
            J.src = P.in[I_WIN] + (size_t)L * D * DIN; J.K = D; J.ldsrc = DIN; J.dst = wmix(P, L, WM_IN); J.ldk = D;
            J.col0 = q == 0 ? 0 : q == 1 ? 1380 : q == 2 ? 1028 : q == 3 ? 1220 : 1348;
            J.ncols = q == 0 ? 1024 : q == 1 ? 768 : q == 2 ? 192 : q == 3 ? 128 : 32;
            J.row0 = q == 0 ? 0 : q == 1 ? 1024 : q == 2 ? 1792 : q == 3 ? 2048 : 2176;
        } else if (q < 9) { const int k = q - 5; J.src = P.in[I_WG] + ((size_t)L * 4 + k) * D * D; J.K = D; J.ldsrc = D; J.ncols = D; J.row0 = k * D; J.dst = wmix(P, L, WM_G); J.ldk = D;
        } else if (q < 13) { const int k = q - 9; J.src = P.in[I_WB] + ((size_t)L * 4 + k) * 256 * D; J.K = 256; J.ldsrc = D; J.ncols = D; J.row0 = k * D; J.dst = wmix(P, L, WM_B); J.ldk = 256;
        } else if (q == 13) { J.src = P.in[I_WO] + (size_t)L * D * D; J.K = D; J.ldsrc = D; J.ncols = D; J.dst = wmix(P, L, WM_O); J.ldk = D;
        } else if (q == 14) { J.src = P.in[I_PWG] + (size_t)L * D * D; J.K = D; J.ldsrc = D; J.ncols = D; J.dst = wmix(P, L, WM_PG); J.ldk = D;
        } else if (q == 15) { J.src = P.in[I_PWU] + (size_t)L * 256 * D; J.K = 256; J.ldsrc = D; J.ncols = D; J.dst = wmix(P, L, WM_UP); J.ldk = 256;
        } else if (q == 16) { J.src = P.in[I_WUQ] + (size_t)L * 192 * 384; J.ks = P.in[I_GQ] + L * 192; J.K = 192; J.ldsrc = 384; J.ncols = 384; J.dst = wmix(P, L, WM_UQ); J.ldk = 256;
        } else if (q == 17) { J.src = P.in[I_WUKV] + (size_t)L * 128 * 512; J.ks = P.in[I_GKV] + L * 128; J.K = 128; J.ldsrc = 512; J.ncols = 512; J.dst = wmix(P, L, WM_UKV); J.ldk = 128;
        } else if (q == 18) { J.src = P.in[I_SGLU] + (size_t)L * 256 * 256; J.K = 256; J.ldsrc = 256; J.ncols = 256; J.dst = wmix(P, L, WM_GLU); J.ldk = 256;
        } else { J.src = nullptr; J.K = 0; J.ldsrc = 0; J.ncols = 32; J.dst = nullptr; J.ldk = 0; }
    } else if (j < 43) {
        const int q = j - 40;
        if (q == 0) { J.src = P.in[I_FW1]; J.K = D; J.ldsrc = DFF; J.ncols = DFF; J.dst = (bf16*)(P.ws + WS_W13); J.ldk = D; J.ilv = 1; }
        else if (q == 1) { J.src = P.in[I_FW3]; J.K = D; J.ldsrc = DFF; J.ncols = DFF; J.row0 = 128; J.dst = (bf16*)(P.ws + WS_W13); J.ldk = D; J.ilv = 1; }
        else { J.src = P.in[I_FW2]; J.K = DFF; J.ldsrc = D; J.ncols = D; J.dst = (bf16*)(P.ws + WS_W2); J.ldk = DFF; }
    } else {
        const int e = (j - 43) / 3, q = (j - 43) % 3;
        if (q == 0) { J.src = P.in[I_MW1] + (size_t)e * D * DFFE; J.K = D; J.ldsrc = DFFE; J.ncols = DFFE; J.row0 = e * 2816; J.dst = (bf16*)(P.ws + WS_WM13); J.ldk = D; J.ilv = 1; }
        else if (q == 1) { J.src = P.in[I_MW3] + (size_t)e * D * DFFE; J.K = D; J.ldsrc = DFFE; J.ncols = DFFE; J.row0 = e * 2816 + 128; J.dst = (bf16*)(P.ws + WS_WM13); J.ldk = D; J.ilv = 1; }
        else { J.src = P.in[I_MW2] + (size_t)e * DFFE * D; J.K = DFFE; J.ldsrc = D; J.ncols = D; J.row0 = e * D; J.dst = (bf16*)(P.ws + WS_WM2); J.ldk = DFFE; }
    }
    return J;
}
__device__ __forceinline__ void cvt_jobs(const Params& P, int j_lo, int j_hi, LAS unsigned char* lds) {
    BODY_IDS();
    LAS float* scr = (LAS float*)(lds + wave * 17408);
    int acc = 0;
    for (int j = j_lo; j < j_hi; ++j) {
        const CvtJob J = get_job(P, j);
        const int items = (J.K / 64) * ((J.ncols + 63) >> 6);
        int first = (gw - (acc % ngw) + ngw) % ngw;
        for (int it = first; it < items; it += ngw) cvt_item(J, scr, it, lane);
        acc += items;
    }
}

__device__ __forceinline__ void p0_misc(const Params& P) {
    BODY_IDS();
    { const f32x4* src = (const f32x4*)P.in[I_P]; u32x2* dst = (u32x2*)(P.ws + WS_PBF);
      for (int i = gtid; i < 2 * NTOK * 256 / 4; i += gthreads) { const f32x4 v = src[i]; u32x2 w; w.x = pk2(v[0], v[1]); w.y = pk2(v[2], v[3]); dst[i] = w; } }
    { const int* pos = (const int*)P.in[I_POS]; float* ct = (float*)(P.ws + WS_COS); float* st = (float*)(P.ws + WS_SIN);
      const double invf[16] = {1.0, 0.5623413251903491, 0.31622776601683794, 0.1778279410038923, 0.1, 0.05623413251903491, 0.03162277660168379, 0.01778279410038923,
                               0.01, 0.005623413251903491, 0.0031622776601683794, 0.0017782794100389228, 0.001, 0.0005623413251903491, 0.00031622776601683794, 0.00017782794100389227};
      for (int i = gtid; i < NTOK * 16; i += gthreads) { const int row = i >> 4, f = i & 15; double iv = invf[0];
#pragma unroll
          for (int q = 1; q < 16; ++q) iv = (f == q) ? invf[q] : iv;
          const float ang = (float)pos[row] * (float)iv; float s, c; sincos_rad((double)ang, s, c); ct[i] = c; st[i] = s; } }
    for (int L = 0; L < 2; ++L) {
        bf16* win = wmix(P, L, WM_IN);
        for (int i = gtid; i < (64 + 96) * D / 8; i += gthreads) { const int e = i * 8, r = e / D, k = e % D; const int row = r < 64 ? 1984 + r : 2208 + (r - 64); *(u32x4*)(win + (size_t)row * D + k) = (u32x4){0u, 0u, 0u, 0u}; }
        bf16* wuq = wmix(P, L, WM_UQ);
        for (int i = gtid; i < 512 * 256 / 8; i += gthreads) { const int e = i * 8, r = e / 256, k = e % 256; if (r >= 384 || k >= 192) *(u32x4*)(wuq + e) = (u32x4){0u, 0u, 0u, 0u}; }
    }
}

__device__ __forceinline__ void rms_load(const XSrc& x, int row, int lane, f32x4 (&v)[4]) {
#pragma unroll
    for (int j = 0; j < 4; ++j) v[j] = ldx4(x, (size_t)row * D + 4 * lane + 256 * j);
}
__device__ __forceinline__ void rms_finish(const float* gain, bf16* orow, int lane, f32x4 (&v)[4]) {
    float s = 0.f;
#pragma unroll
    for (int j = 0; j < 4; ++j) s += (v[j][0] * v[j][0] + v[j][1] * v[j][1]) + (v[j][2] * v[j][2] + v[j][3] * v[j][3]);
    const float rstd = 1.0f / sqrtf(wave_sum(s) * (1.0f / D) + RMS_EPS);
    const f32x4* gr = (const f32x4*)gain + lane;
    u32x2* o8 = (u32x2*)orow + lane;
#pragma unroll
    for (int j = 0; j < 4; ++j) { v[j] = v[j] * rstd * gr[64 * j]; if (orow) { u32x2 w; w.x = pk2(v[j][0], v[j][1]); w.y = pk2(v[j][2], v[j][3]); o8[64 * j] = w; } }
}
#define RMS_ROWS_BEGIN(x_, rowexpr_) f32x4 v[4], vn_[4]; { const int i = 0; rms_load(x_, (rowexpr_), lane, v); } for (int i = 0; i < 16; ++i) { if (i + 1 < 16) { const int i_ = i; { const int i = i_ + 1; rms_load(x_, (rowexpr_), lane, vn_); } }
#define RMS_ROWS_END() _Pragma("unroll") for (int j_ = 0; j_ < 4; ++j_) v[j_] = vn_[j_]; }
__device__ __forceinline__ void norm_plain(const XSrc x, const float* gain, bf16* H, int first, int stride) {
    BODY_IDS();
    for (int u = first; u < NTOK / 128; u += stride)
    { RMS_ROWS_BEGIN(x, u * 128 + wave * 16 + i) const int row = u * 128 + wave * 16 + i; rms_finish(gain, H + (size_t)row * D, lane, v); RMS_ROWS_END() }
}
__device__ __forceinline__ void norm1_phase(const Params& P, int L, const XSrc x, int first, int stride) {
    BODY_IDS();
    const float* win = P.in[I_WIN] + (size_t)L * D * DIN;
    f32x4 wff[4][4];
#pragma unroll
    for (int j = 0; j < 4; ++j)
#pragma unroll
        for (int e = 0; e < 4; ++e) wff[j][e] = *(const f32x4*)(win + (size_t)(4 * lane + 256 * j + e) * DIN + 1024);
    const float* gain = P.in[I_GMIX] + L * D; bf16* H = (bf16*)(P.ws + WS_H);
    float* logf = (float*)(P.ws + WS_LOGF); float* wsum = (float*)(P.ws + WS_WSUM);
    const f32x4 bf = *(const f32x4*)(P.in[I_FBF] + L * 4);
    for (int u = first; u < NTOK / 128; u += stride) { const int g0 = u * 8 + wave;
        f32x4 run = {0.f, 0.f, 0.f, 0.f};
        RMS_ROWS_BEGIN(x, g0 * 16 + i) const int row = g0 * 16 + i; rms_finish(gain, H + (size_t)row * D, lane, v);
            f32x4 d = {0.f, 0.f, 0.f, 0.f};
#pragma unroll
            for (int j = 0; j < 4; ++j)
#pragma unroll
                for (int e = 0; e < 4; ++e) d += wff[j][e] * v[j][e];
#pragma unroll
            for (int e = 0; e < 4; ++e) { d[e] = wave_sum(d[e]); run[e] += log_sigmoid(d[e] + bf[e]); }
            if (lane == 0) *(f32x4*)(logf + (size_t)row * 4) = run; RMS_ROWS_END()
        if (lane == 0) *(f32x4*)(wsum + (size_t)g0 * 4) = run;
    }
    __syncthreads();
}
__device__ __forceinline__ void prep_phase(const Params& P, int L) {
    BODY_IDS();
    unsigned* qmaxw = (unsigned*)(P.ws + WS_CTL) + CW_QMAX + L * 512; unsigned* kmaxw = (unsigned*)(P.ws + WS_CTL) + CW_KMAX + L * 16;
    const float* logf = (const float*)(P.ws + WS_LOGF); const float* wsum = (const float*)(P.ws + WS_WSUM); float* cdec = (float*)(P.ws + WS_CDEC);
    float* rq = (float*)(P.ws + WS_RSTDQ); float* rkv = (float*)(P.ws + WS_RSTDKV); const bf16* zin = (const bf16*)(P.ws + WS_ZIN); bf16* kper = (bf16*)(P.ws + WS_KPER);
    const float* ct = (const float*)(P.ws + WS_COS); const float* st = (const float*)(P.ws + WS_SIN);
    for (int g0 = gw; g0 < NTOK / 16; g0 += ngw) {
        const int first = (g0 / 512) * 512;
        f32x4 pre = {0.f, 0.f, 0.f, 0.f};
        for (int i = first + lane; i < g0; i += 64) pre += *(const f32x4*)(wsum + (size_t)i * 4);
#pragma unroll
        for (int e = 0; e < 4; ++e) pre[e] = wave_sum(pre[e]);
        if (lane < 16) { const int row = g0 * 16 + lane; *(f32x4*)(cdec + (size_t)row * 4) = *(const f32x4*)(logf + (size_t)row * 4) + pre; }
        float q2m = 0.f, k2m = 0.f;
        for (int i = 0; i < 16; ++i) { const int row = g0 * 16 + i; const bf16* zr = zin + (size_t)row * ZP;
            { const u32x2 wq = *(const u32x2*)(zr + ZC_FQ + 4 * lane), wk = *(const u32x2*)(zr + ZC_FK + 4 * lane);
              float sq_ = bflo(wq.x) * bflo(wq.x) + bfhi(wq.x) * bfhi(wq.x) + bflo(wq.y) * bflo(wq.y) + bfhi(wq.y) * bfhi(wq.y);
              float sk_ = bflo(wk.x) * bflo(wk.x) + bfhi(wk.x) * bfhi(wk.x) + bflo(wk.y) * bflo(wk.y) + bfhi(wk.y) * bfhi(wk.y);
#pragma unroll
              for (int o = 1; o < 16; o <<= 1) { sq_ += shflx(sq_, o, lane); sk_ += shflx(sk_, o, lane); }
              q2m = fmaxf(q2m, sq_); k2m = fmaxf(k2m, sk_); }
            const float a0 = bf2f(zr[ZC_CQ + lane]), a1 = bf2f(zr[ZC_CQ + 64 + lane]), a2 = bf2f(zr[ZC_CQ + 128 + lane]);
            const float b0 = bf2f(zr[ZC_CKV + lane]), b1 = bf2f(zr[ZC_CKV + 64 + lane]);
            const float sq = wave_sum(a0 * a0 + a1 * a1 + a2 * a2), skv = wave_sum(b0 * b0 + b1 * b1);
            if (lane == 0) { rq[row] = 1.0f / sqrtf(sq * (1.0f / 192.0f) + RMS_EPS); rkv[row] = 1.0f / sqrtf(skv * (1.0f / 128.0f) + RMS_EPS); }
            if (lane < 16) { const float t1 = bf2f(zr[ZC_KPE + lane]), t2 = bf2f(zr[ZC_KPE + 16 + lane]); const float c = ct[(size_t)row * 16 + lane], s = st[(size_t)row * 16 + lane];
                kper[(size_t)row * 32 + lane] = (bf16)f2bf(t1 * c - t2 * s); kper[(size_t)row * 32 + 16 + lane] = (bf16)f2bf(t2 * c + t1 * s); } }
        if ((lane & 15) == 0) { const int row0 = g0 * 16, b = row0 / SEQ, qb = (row0 % SEQ) / 256, h = lane >> 4;
            atomicMax(qmaxw + (b * 4 + h) * 32 + qb, __float_as_uint(q2m)); atomicMax(kmaxw + b * 4 + h, __float_as_uint(k2m)); }
    }
}
struct FinalRows { u32x2 w[16][4]; };
__device__ __forceinline__ void final_norm_load(const Params& P, int u, FinalRows& R) {
    BODY_IDS();
    const bf16* xb = xr_of(P.out);
#pragma unroll
    for (int i = 0; i < 16; ++i) { const u32x2* xr = (const u32x2*)(xb + (size_t)(u * 128 + wave * 16 + i) * D) + lane;
#pragma unroll
        for (int j = 0; j < 4; ++j) R.w[i][j] = xr[64 * j]; }
}
__device__ __forceinline__ void final_norm_store(const Params& P, int u, const FinalRows& R) {
    BODY_IDS();
    const f32x4* gr = (const f32x4*)P.in[I_GFIN] + lane;
#pragma unroll
    for (int i = 0; i < 16; ++i) { f32x4 v[4]; float s = 0.f;
#pragma unroll
        for (int j = 0; j < 4; ++j) { const u32x2 w = R.w[i][j]; v[j] = (f32x4){bflo(w.x), bfhi(w.x), bflo(w.y), bfhi(w.y)}; s += (v[j][0] * v[j][0] + v[j][1] * v[j][1]) + (v[j][2] * v[j][2] + v[j][3] * v[j][3]); }
        const float rstd = 1.0f / sqrtf(wave_sum(s) * (1.0f / D) + RMS_EPS);
        f32x4* xo = (f32x4*)(P.out + (size_t)(u * 128 + wave * 16 + i) * D) + lane;
#pragma unroll
        for (int j = 0; j < 4; ++j) xo[64 * j] = v[j] * rstd * gr[64 * j]; }
}
namespace s5 {
struct Coef { float abr, abi; f32x2 B2[16]; float a64r, a64i; };
__device__ __forceinline__ void coef(const Params& P, int L, int g, int p, Coef& C) {
    const float dt = __expf(P.in[I_SLDT][L * 16 + g]); const float ar = P.in[I_SAR][(L * 16 + g) * 64 + p], ai = P.in[I_SAI][(L * 16 + g) * 64 + p];
    const float mag = __expf(ar * dt); float sn, cs; sincos_rad((double)(ai * dt), sn, cs);
    C.abr = mag * cs; C.abi = mag * sn;
    const float den = ar * ar + ai * ai, nr = C.abr - 1.0f, ni = C.abi;
    const float cr = (nr * ar + ni * ai) / den, ci = (ni * ar - nr * ai) / den;
    const float* br = P.in[I_SBR] + ((size_t)(L * 16 + g) * 64 + p) * 16; const float* bi = P.in[I_SBI] + ((size_t)(L * 16 + g) * 64 + p) * 16;
#pragma unroll
    for (int h = 0; h < 16; ++h) { const float r = br[h], i = bi[h]; C.B2[h] = (f32x2){cr * r - ci * i, cr * i + ci * r}; }
    const float m64 = __expf(64.0f * ar * dt); float s64, c64; sincos_rad(64.0 * (double)(ai * dt), s64, c64);
    C.a64r = m64 * c64; C.a64i = m64 * s64;
}
constexpr int WAVE_LDS = 8448;
template <bool EMIT>
__device__ __forceinline__ void chunk(const Params& P, int L, int g, int row0, const Coef& C, float& xr, float& xi, LAS unsigned char* wl, int lane, const bf16x8 (&cf)[4], float dsk) {
    bf16* zin = (bf16*)(P.ws + WS_ZIN);
    LAS float* ut = (LAS float*)wl; LAS unsigned* xt = (LAS unsigned*)(wl + 4096);
    { const u32x4* up = (const u32x4*)(zin + (size_t)(row0 + lane) * ZP + ZC_U + g * 16); const u32x4 w0 = up[0], w1 = up[1];
      LAS f32x4* d = (LAS f32x4*)(ut + lane * 16);
      d[0] = (f32x4){bflo(w0.x), bfhi(w0.x), bflo(w0.y), bfhi(w0.y)}; d[1] = (f32x4){bflo(w0.z), bfhi(w0.z), bflo(w0.w), bfhi(w0.w)};
      d[2] = (f32x4){bflo(w1.x), bfhi(w1.x), bflo(w1.y), bfhi(w1.y)}; d[3] = (f32x4){bflo(w1.z), bfhi(w1.z), bflo(w1.w), bfhi(w1.w)}; }
    for (int tb = 0; tb < 4; ++tb) {
#pragma unroll 4
        for (int ti = 0; ti < 16; ++ti) {
            const LAS f32x4* up = (const LAS f32x4*)(ut + (tb * 16 + ti) * 16);
            f32x2 b2a = {0.f, 0.f}, b2b = {0.f, 0.f};
#pragma unroll
            for (int q = 0; q < 4; ++q) { const f32x4 u4 = up[q];
                b2a += C.B2[4 * q + 0] * (f32x2){u4[0], u4[0]}; b2b += C.B2[4 * q + 1] * (f32x2){u4[1], u4[1]};
                b2a += C.B2[4 * q + 2] * (f32x2){u4[2], u4[2]}; b2b += C.B2[4 * q + 3] * (f32x2){u4[3], u4[3]}; }
            const float br = b2a[0] + b2b[0], bi = b2a[1] + b2b[1];
            const float nr = C.abr * xr - C.abi * xi + br, ni = C.abr * xi + C.abi * xr + bi; xr = nr; xi = ni;
            if (EMIT) xt[ti * 68 + lane] = pk2(xr, xi);
        }
        if (EMIT) {
            f32x4 dacc = {0.f, 0.f, 0.f, 0.f};
#pragma unroll
            for (int ks = 0; ks < 4; ++ks) { const bf16x8 a = *(const LAS bf16x8*)((const LAS unsigned char*)xt + (lane & 15) * 272 + (ks * 32 + (lane >> 4) * 8) * 2);
                dacc = __builtin_amdgcn_mfma_f32_16x16x32_bf16(a, cf[ks], dacc, 0, 0, 0); }
            const int hp = lane & 15;
#pragma unroll
            for (int i = 0; i < 4; ++i) { const int tok = tb * 16 + 4 * (lane >> 4) + i; const float y = dacc[i] + dsk * ut[tok * 16 + hp];
                zin[(size_t)(row0 + tok) * ZP + ZC_U + g * 16 + hp] = (bf16)f2bf(gelu_tanh(y)); }
        }
    }
}
template <int PASS>
__device__ __forceinline__ void phase(const Params& P, int L, LAS unsigned char* lds) {
    BODY_IDS();
    LAS unsigned char* wl = lds + wave * WAVE_LDS;
    f32x2* SC = (f32x2*)(P.ws + WS_SC);
    for (int w = gw; w < 2048; w += ngw) {
        const int bg = w >> 5, cg = w & 31, b = bg >> 4, g = bg & 15;
        Coef C; coef(P, L, g, lane, C);
        bf16x8 cf[4]; float dsk = 0.f;
        if (PASS == 1) {
            const int hp = lane & 15, kg = lane >> 4;
            const float* cre = P.in[I_SCR] + ((size_t)(L * 16 + g) * 16 + hp) * 64; const float* cim = P.in[I_SCI] + ((size_t)(L * 16 + g) * 16 + hp) * 64;
#pragma unroll
            for (int ks = 0; ks < 4; ++ks) { const int p0 = 16 * ks + 4 * kg; u32x4 wv;
                wv.x = pk2(cre[p0], -cim[p0]); wv.y = pk2(cre[p0 + 1], -cim[p0 + 1]); wv.z = pk2(cre[p0 + 2], -cim[p0 + 2]); wv.w = pk2(cre[p0 + 3], -cim[p0 + 3]);
                cf[ks] = __builtin_bit_cast(bf16x8, wv); }
            dsk = P.in[I_SD][(L * 16 + g) * 16 + hp];
        } else {
#pragma unroll
            for (int ks = 0; ks < 4; ++ks) cf[ks] = (bf16x8){0, 0, 0, 0, 0, 0, 0, 0};
        }
        float xr = 0.f, xi = 0.f;
        if (PASS == 1) {
            const f32x2* sp = SC + ((size_t)bg * 128) * 64 + lane;
            for (int c = 0; c < 4 * cg; c += 4) { f32x2 sv[4];
#pragma unroll
                for (int q = 0; q < 4; ++q) sv[q] = sp[(size_t)(c + q) * 64];
#pragma unroll
                for (int q = 0; q < 4; ++q) { const float nr = C.a64r * xr - C.a64i * xi + sv[q][0], ni = C.a64r * xi + C.a64i * xr + sv[q][1]; xr = nr; xi = ni; } }
        }
        for (int cc = 0; cc < 4; ++cc) {
            const int c = 4 * cg + cc, row0 = b * SEQ + c * 64;
            if (PASS == 0) { xr = 0.f; xi = 0.f; }
            chunk<PASS == 1>(P, L, g, row0, C, xr, xi, wl, lane, cf, dsk);
            if (PASS == 0) SC[((size_t)bg * 128 + c) * 64 + lane] = (f32x2){xr, xi};
        }
    }
}
__device__ __forceinline__ void naive(const Params& P, int L) {
    BODY_IDS();
    bf16* zin = (bf16*)(P.ws + WS_ZIN);
    for (int bg = gw; bg < 64; bg += ngw) {
        const int b = bg >> 4, g = bg & 15;
        Coef C; coef(P, L, g, lane, C);
        float cr[16], ci[16];
#pragma unroll
        for (int h = 0; h < 16; ++h) { cr[h] = P.in[I_SCR][((size_t)(L * 16 + g) * 16 + h) * 64 + lane]; ci[h] = P.in[I_SCI][((size_t)(L * 16 + g) * 16 + h) * 64 + lane]; }
        const float dsk = P.in[I_SD][(L * 16 + g) * 16 + (lane & 15)];
        float xr = 0.f, xi = 0.f;
        for (int t = 0; t < SEQ; ++t) {
            bf16* up = zin + (size_t)(b * SEQ + t) * ZP + ZC_U + g * 16;
            const u32x4 w0 = *(const u32x4*)up, w1 = *(const u32x4*)(up + 8);
            const float u[16] = {bflo(w0.x), bfhi(w0.x), bflo(w0.y), bfhi(w0.y), bflo(w0.z), bfhi(w0.z), bflo(w0.w), bfhi(w0.w),
                                 bflo(w1.x), bfhi(w1.x), bflo(w1.y), bfhi(w1.y), bflo(w1.z), bfhi(w1.z), bflo(w1.w), bfhi(w1.w)};
            float br = 0.f, bi = 0.f;
#pragma unroll
            for (int h = 0; h < 16; ++h) { br += C.B2[h][0] * u[h]; bi += C.B2[h][1] * u[h]; }
            const float nr = C.abr * xr - C.abi * xi + br, ni = C.abr * xi + C.abi * xr + bi; xr = nr; xi = ni;
            float ymine = 0.f, umine = 0.f;
#pragma unroll
            for (int h = 0; h < 16; ++h) { const float s = wave_sum(xr * cr[h] - xi * ci[h]); if ((lane & 15) == h) { ymine = s; umine = u[h]; } }
            __builtin_amdgcn_s_waitcnt(0);
            if (lane < 16) up[lane] = (bf16)f2bf(gelu_tanh(ymine + dsk * umine));
        }
    }
}
}

__device__ __forceinline__ void norm2_moe_phase(const Params& P, const XSrc x, LAS unsigned char* lds, int first, int stride) {
    BODY_IDS();
    LAS unsigned* lcnt = (LAS unsigned*)(lds + 32768); LAS unsigned* lbase = lcnt + 8;
    f32x4 wr0[4][4], wr1[4][4];
#pragma unroll
    for (int j = 0; j < 4; ++j)
#pragma unroll
        for (int q = 0; q < 4; ++q) { const float* wp = P.in[I_MWR] + (size_t)(4 * lane + 256 * j + q) * 8; wr0[j][q] = *(const f32x4*)wp; wr1[j][q] = *(const f32x4*)(wp + 4); }
    if (tid < 8) lcnt[tid] = 0u;
    __syncthreads();
    const float* gain = P.in[I_GFFN] + 1 * D; bf16* H = (bf16*)(P.ws + WS_H);
    unsigned* tokinfo = (unsigned*)(P.ws + WS_TOKINFO); unsigned* gcnt = (unsigned*)(P.ws + WS_CTL) + CW_MOECNT;
    const float* brt = P.in[I_MBR];
    for (int u = first; u < NTOK / 128; u += stride) { const int g0 = u * 8 + wave;
        RMS_ROWS_BEGIN(x, g0 * 16 + i) const int row = g0 * 16 + i; rms_finish(gain, H + (size_t)row * D, lane, v);
            float lg[8];
#pragma unroll
            for (int e = 0; e < 8; ++e) lg[e] = 0.f;
#pragma unroll
            for (int j = 0; j < 4; ++j)
#pragma unroll
                for (int q = 0; q < 4; ++q) { const f32x4 w0 = wr0[j][q], w1 = wr1[j][q]; const float hv = v[j][q];
                    lg[0] += hv * w0[0]; lg[1] += hv * w0[1]; lg[2] += hv * w0[2]; lg[3] += hv * w0[3]; lg[4] += hv * w1[0]; lg[5] += hv * w1[1]; lg[6] += hv * w1[2]; lg[7] += hv * w1[3]; }
#pragma unroll
            for (int e = 0; e < 8; ++e) lg[e] = wave_sum(lg[e]) + brt[e];
            int e0 = 0; float l0 = lg[0];
#pragma unroll
            for (int e = 1; e < 8; ++e) if (lg[e] > l0) { l0 = lg[e]; e0 = e; }
            int e1 = 0; float l1 = -INFINITY;
#pragma unroll
            for (int e = 0; e < 8; ++e) if (e != e0 && lg[e] > l1) { l1 = lg[e]; e1 = e; }
            const float ex = __expf(l1 - l0); const float ga = 1.0f / (1.0f + ex), gb = ex / (1.0f + ex);
            if (lane == 0) { const unsigned r0 = __hip_atomic_fetch_add(&lcnt[e0], 1u, __ATOMIC_RELAXED, __HIP_MEMORY_SCOPE_WORKGROUP), r1 = __hip_atomic_fetch_add(&lcnt[e1], 1u, __ATOMIC_RELAXED, __HIP_MEMORY_SCOPE_WORKGROUP);
                u32x4 a; a.x = (unsigned)e0; a.y = (unsigned)e1; a.z = r0; a.w = r1; u32x4 bq; bq.x = __float_as_uint(ga); bq.y = __float_as_uint(gb); bq.z = 0u; bq.w = 0u;
                *(u32x4*)(tokinfo + (size_t)row * 8) = a; *(u32x4*)(tokinfo + (size_t)row * 8 + 4) = bq; } RMS_ROWS_END()
    }
    __syncthreads();
    if (tid < 8) lbase[tid] = __hip_atomic_fetch_add(gcnt + tid, lcnt[tid], __ATOMIC_RELAXED, __HIP_MEMORY_SCOPE_AGENT);
    __syncthreads();
    for (int u = first; u < NTOK / 128; u += stride) { const int g0 = u * 8 + wave;
        if (lane == 0) { for (int i = 0; i < 16; ++i) { const int row = g0 * 16 + i; u32x4 a = *(u32x4*)(tokinfo + (size_t)row * 8);
            unsigned b0 = 0, b1 = 0;
#pragma unroll
            for (int e = 0; e < 8; ++e) { const unsigned lb = lbase[e]; b0 = (a.x == (unsigned)e) ? lb : b0; b1 = (a.y == (unsigned)e) ? lb : b1; }
            a.z += b0; a.w += b1; *(u32x4*)(tokinfo + (size_t)row * 8) = a; } }
    }
    int* slot_tok = (int*)(P.ws + WS_SLOTTOK);
    for (int i = gtid; i < MOE_ROWS; i += gthreads) slot_tok[i] = -1;
    __syncthreads();
}
struct MoeLayout { int pstart[9]; };
__device__ __forceinline__ MoeLayout moe_layout(const Params& P) {
    const unsigned* gcnt = (const unsigned*)(P.ws + WS_CTL) + CW_MOECNT; MoeLayout Lo; int acc = 0;
#pragma unroll
    for (int e = 0; e < 8; ++e) { Lo.pstart[e] = acc; const int c = (int)__hip_atomic_load(gcnt + e, __ATOMIC_RELAXED, __HIP_MEMORY_SCOPE_AGENT); acc += (c + 255) / 256 * 256; }
    Lo.pstart[8] = acc; return Lo;
}
__device__ __forceinline__ void moe_assign_phase(const Params& P) {
    BODY_IDS();
    const MoeLayout Lo = moe_layout(P);
    const unsigned* tokinfo = (const unsigned*)(P.ws + WS_TOKINFO); int* slot_tok = (int*)(P.ws + WS_SLOTTOK); float* slot_gate = (float*)(P.ws + WS_SLOTGATE);
    for (int t = gtid; t < NTOK; t += gthreads) { const u32x4 a = *(const u32x4*)(tokinfo + (size_t)t * 8); const u32x2 g = *(const u32x2*)(tokinfo + (size_t)t * 8 + 4);
        int p0 = 0, p1 = 0;
#pragma unroll
        for (int e = 0; e < 8; ++e) { p0 = ((int)a.x == e) ? Lo.pstart[e] : p0; p1 = ((int)a.y == e) ? Lo.pstart[e] : p1; }
        const int s0 = p0 + (int)a.z, s1 = p1 + (int)a.w;
        slot_tok[s0] = t; slot_gate[s0] = __uint_as_float(g.x); slot_tok[s1] = t; slot_gate[s1] = __uint_as_float(g.y); }
}
struct MoeOrder {
    int pstart[9]; int ntile, ncol, G, c;
    __device__ __forceinline__ bool next(int i, pg8::Unit& u) const {
        const long Lf = (long)i * G + c; if (Lf >= (long)ntile * ncol) return false;
        const int rt = (int)(Lf / ncol), j = (int)(Lf % ncol); int e = 0;
#pragma unroll
        for (int q = 1; q < 8; ++q) e = (rt * 256 >= pstart[q]) ? q : e;
        u.pm = rt; u.pn = e * ncol + j; return true;
    }
};
__device__ __forceinline__ MoeOrder moe_order(const Params& P, int ncol, int G, int c) {
    const MoeLayout Lo = moe_layout(P); MoeOrder S;
#pragma unroll
    for (int e = 0; e < 9; ++e) S.pstart[e] = Lo.pstart[e];
    S.ntile = Lo.pstart[8] / 256; S.ncol = ncol; S.G = G; S.c = c; return S;
}

__device__ __forceinline__ void norm_moe_combine(const Params& P, const float* gain, int first, int stride) {
    BODY_IDS();
    const MoeLayout Lo = moe_layout(P);
    const unsigned* tokinfo = (const unsigned*)(P.ws + WS_TOKINFO); const bf16* Y = (const bf16*)(P.ws + WS_MOEY); bf16* H = (bf16*)(P.ws + WS_H2);
    for (int u = first; u < NTOK / 128; u += stride) for (int i = 0; i < 16; ++i) { const int row = u * 128 + wave * 16 + i;
        const u32x4 a = *(const u32x4*)(tokinfo + (size_t)row * 8);
        int p0 = 0, p1 = 0;
#pragma unroll
        for (int e = 0; e < 8; ++e) { p0 = ((int)a.x == e) ? Lo.pstart[e] : p0; p1 = ((int)a.y == e) ? Lo.pstart[e] : p1; }
        const u32x2* y0 = (const u32x2*)(Y + (size_t)(p0 + (int)a.z) * D) + lane; const u32x2* y1 = (const u32x2*)(Y + (size_t)(p1 + (int)a.w) * D) + lane;
        u32x2* xr = (u32x2*)(xr_of(P.out) + (size_t)row * D) + lane; f32x4 v[4]; float s = 0.f;
#pragma unroll
        for (int j = 0; j < 4; ++j) { const u32x2 w0 = y0[64 * j], w1 = y1[64 * j]; const u32x2 wx = xr[64 * j];
            v[j] = (f32x4){bflo(wx.x), bfhi(wx.x), bflo(wx.y), bfhi(wx.y)} + (f32x4){bflo(w0.x), bfhi(w0.x), bflo(w0.y), bfhi(w0.y)} + (f32x4){bflo(w1.x), bfhi(w1.x), bflo(w1.y), bfhi(w1.y)};
            { u32x2 wo; wo.x = pk2(v[j][0], v[j][1]); wo.y = pk2(v[j][2], v[j][3]); xr[64 * j] = wo; } s += (v[j][0] * v[j][0] + v[j][1] * v[j][1]) + (v[j][2] * v[j][2] + v[j][3] * v[j][3]); }
        const float rstd = 1.0f / sqrtf(wave_sum(s) * (1.0f / D) + RMS_EPS);
        const f32x4* gr = (const f32x4*)gain + lane; u32x2* o8 = (u32x2*)(H + (size_t)row * D) + lane;
#pragma unroll
        for (int j = 0; j < 4; ++j) { const f32x4 h = v[j] * rstd * gr[64 * j]; u32x2 w; w.x = pk2(h[0], h[1]); w.y = pk2(h[2], h[3]); o8[64 * j] = w; }
    }
}
#ifndef REF_MASK
#define REF_MASK 0
#endif
#ifndef N_LAUNCH_MODE
#define N_LAUNCH_MODE 1
#endif
constexpr int LDS_BYTES = 147456;
constexpr int MISC_OFF = LDS_BYTES - 64;
constexpr int N_PHASES = 27;
#ifndef PHASE_SEL
#define PHASE_SEL 0xFFFFFFFu
#endif
#define PH_ON(b) (((PHASE_SEL) >> (b)) & 1u)
#ifndef SUB_SEL
#define SUB_SEL 0xFFu
#endif
#define SUB_ON(b) (((SUB_SEL) >> (b)) & 1u)

#ifndef PROBE_MASK
#define PROBE_MASK 0u
#endif
#ifndef PROBE_MULT
#define PROBE_MULT 4
#endif
#define TIMED(bit, ...) do { unsigned long long t0_ = 0; if (((PROBE_MASK) >> (bit)) & 1u) t0_ = __builtin_amdgcn_s_memrealtime(); __VA_ARGS__; \
    if (((PROBE_MASK) >> (bit)) & 1u) pacc += __builtin_amdgcn_s_memrealtime() - t0_; } while (0)
#define RUN_GEMM(EPI_T, SCHED_T, GATH, gm, sc, ep) do { if (REF_MASK & 1) pg8::gemm_phase_naive<EPI_T, SCHED_T, GATH>(gm, sc, ep); \
    else pg8::gemm_phase<EPI_T, SCHED_T, true, GATH>(lds, gm, sc, ep); } while (0)

__device__ __forceinline__ int vcu_of() { int G = gridDim.x, bx = blockIdx.x; asm volatile("" : "+s"(G), "+s"(bx)); return (G % 8 == 0) ? (bx % 8) * (G / 8) + bx / 8 : bx; }
__device__ __forceinline__ bool in_range(int lo, int hi, int k) { asm volatile("" : "+s"(lo), "+s"(hi)); return lo <= k && k < hi; }
__global__ void __launch_bounds__(NTHREADS, 2) mega_fwd(Params P) {
    extern __shared__ __attribute__((aligned(16))) unsigned char lds_raw[];
    LAS unsigned char* lds = (LAS unsigned char*)lds_raw;
    const int tid = threadIdx.x;
    const int G = gridDim.x, bx = blockIdx.x;
    unsigned* ctl = (unsigned*)(P.ws + WS_CTL);
    volatile LAS unsigned* misc = (volatile LAS unsigned*)(lds + MISC_OFF);
    if (tid < 16) misc[tid] = 0u;
    if ((tid & 63) == 0) *(LAS int*)(uintptr_t)((unsigned)TID_TAB_OFF + 4u * hw_wave_key()) = tid >> 6;
    __syncthreads();
    const int lo = P.ph_lo, hi = P.ph_hi;
    XcdBarrier bar; bar.bar = ctl + CW_BAR; bar.x = 0; bar.st = misc;
    if (hi - lo > 1) bar = xcd_barrier_post(ctl + CW_BAR, misc);
#define IN(k) in_range(lo, hi, (k))
#ifndef PROBE_SEAMS
#define PROBE_SEAMS 0u
#endif
#define SEAM(k) do { if (IN(k) && IN((k) + 1)) { unsigned long long t0_ = 0; const bool tm_ = (((PROBE_MASK) >> 24) & 1u) || (((PROBE_SEAMS) >> (k)) & 1u); if (tm_) t0_ = __builtin_amdgcn_s_memrealtime(); \
    xcd_barrier(bar); if (tm_) pacc += __builtin_amdgcn_s_memrealtime() - t0_; } } while (0)
    unsigned long long pacc = 0;

#define H ((bf16*)(P.ws + WS_H))
#define ZIN ((bf16*)(P.ws + WS_ZIN))
#define GB ((bf16*)(P.ws + WS_G))
#define MB ((bf16*)(P.ws + WS_M))
#define MLAQ ((bf16*)(P.ws + WS_MLAQ))
#define MLAKV ((bf16*)(P.ws + WS_MLAKV))
#define KPER ((bf16*)(P.ws + WS_KPER))
#define cosT ((float*)(P.ws + WS_COS))
#define sinT ((float*)(P.ws + WS_SIN))
#define slot_tok ((int*)(P.ws + WS_SLOTTOK))
#define slot_gate ((float*)(P.ws + WS_SLOTGATE))

    if (PH_ON(0) && IN(0)) { TIMED(0, cvt_jobs(P, 0, 43, lds); p0_misc(P)); TIMED(1, norm1_phase(P, 0, XSrc{P.in[I_X], nullptr}, vcu_of(), gridDim.x)); }
    SEAM(0);

    for (int L = 0; L < 2; ++L) {
        const int pb = 1 + 12 * L;
        const int pc = (L == 0) ? 9 : 22;
        bf16* const XR = xr_of(P.out);
        const XSrc xsrc = (L == 0) ? XSrc{P.in[I_X], nullptr} : XSrc{nullptr, XR};
        if (PH_ON(2) && IN(pb + 1)) {
            pg8::Gemm g{H, wmix(P, L, WM_IN), D, D, D, nullptr}; pg8::StaticOrder S; S.init(NTOK, ZP, G, bx);
            epi::EpiStore E{ZIN, ZP, 0};
            TIMED(2, RUN_GEMM(epi::EpiStore, pg8::StaticOrder, false, g, S, E));
        }
        SEAM(pb + 1);
        if (PH_ON(3) && IN(pb + 2)) {
            TIMED(3, prep_phase(P, L));
            if (!(REF_MASK & 4)) TIMED(4, s5::phase<0>(P, L, lds));
            __syncthreads();
        }
        SEAM(pb + 2);
        if (PH_ON(4) && IN(pb + 3)) {
            if (SUB_ON(0)) { pg8::Gemm g{ZIN + ZC_CQ, wmix(P, L, WM_UQ), ZP, 256, 256, nullptr}; pg8::StaticOrder S; S.init(NTOK, 512, G, bx);
              epi::EpiMlaQ E{MLAQ, (const float*)(P.ws + WS_RSTDQ), cosT, sinT};
              TIMED(5, RUN_GEMM(epi::EpiMlaQ, pg8::StaticOrder, false, g, S, E)); }
            if (SUB_ON(1)) { pg8::Gemm g{ZIN + ZC_CKV, wmix(P, L, WM_UKV), ZP, 128, 128, nullptr}; pg8::StaticOrder S; S.init(NTOK, 512, G, bx);
              epi::EpiRowScale E{MLAKV, 512, (const float*)(P.ws + WS_RSTDKV)};
              TIMED(5, RUN_GEMM(epi::EpiRowScale, pg8::StaticOrder, false, g, S, E)); }
            if (SUB_ON(2)) { TIMED(6, if (REF_MASK & 4) s5::naive(P, L); else s5::phase<1>(P, L, lds)); }
            __syncthreads();
            if (SUB_ON(3)) { att::Tensors T; T.Q = ZIN + ZC_FQ; T.ldq = ZP; T.K = ZIN + ZC_FK; T.ldk = ZP; T.K2 = nullptr; T.V = ZIN + ZC_FV; T.ldv = ZP; T.O = ZIN + ZC_FQ; T.ldo = ZP;
              T.cdec = (const float*)(P.ws + WS_CDEC); T.relb = nullptr; T.qhs = 64; T.khs = 64; T.vhs = 64; T.ohs = 64;
              T.qmax = (const unsigned*)(P.ws + WS_CTL) + CW_QMAX + L * 512; T.kmax = (const unsigned*)(P.ws + WS_CTL) + CW_KMAX + L * 16;
              TIMED(7, if (REF_MASK & 2) att::attn_naive<att::MODE_FOX>(T); else att::attn_phase<att::MODE_FOX>(T, lds)); }
            __syncthreads();
            if (SUB_ON(4)) { att::Tensors T; T.Q = ZIN + ZC_DQ; T.ldq = ZP; T.K = ZIN + ZC_DK; T.ldk = ZP; T.K2 = nullptr; T.V = ZIN + ZC_DV; T.ldv = ZP; T.O = ZIN + ZC_DQ; T.ldo = ZP;
              T.cdec = nullptr; T.relb = P.in[I_RELB] + (size_t)L * 4 * 513; T.qhs = 64; T.khs = 64; T.vhs = 64; T.ohs = 64;
              TIMED(8, if (REF_MASK & 2) att::attn_naive<att::MODE_BAND>(T); else att::attn_phase<att::MODE_BAND>(T, lds)); }
            __syncthreads();
        }
        SEAM(pb + 3);
        if (PH_ON(5) && IN(pb + 4)) {
            if (SUB_ON(0)) { att::Tensors T; T.Q = MLAQ; T.ldq = 512; T.K = MLAKV; T.ldk = 512; T.K2 = KPER; T.V = MLAKV + 64; T.ldv = 512; T.O = ZIN + ZC_CQ; T.ldo = ZP;
              T.cdec = nullptr; T.relb = nullptr; T.qhs = 96; T.khs = 128; T.vhs = 128; T.ohs = 64;
              TIMED(9, if (REF_MASK & 2) att::attn_naive<att::MODE_MLA>(T); else att::attn_phase<att::MODE_MLA>(T, lds)); }
            __syncthreads();
            if (SUB_ON(1)) { pg8::Gemm g{ZIN + ZC_U, wmix(P, L, WM_GLU), ZP, 256, 256, nullptr}; pg8::StaticOrder S; S.init(NTOK, 256, G, bx);
              epi::EpiGlu E{ZIN + ZC_U, ZP};
              TIMED(10, RUN_GEMM(epi::EpiGlu, pg8::StaticOrder, false, g, S, E)); }
        }
        SEAM(pb + 4);
        if (PH_ON(6) && IN(pb + 5)) {
            g128::MergeProg MP; MP.Hn = H; MP.zin = ZIN; MP.wg = wmix(P, L, WM_G); MP.wb = wmix(P, L, WM_B); MP.bg = P.in[I_BG] + (size_t)L * 4 * D; MP.M = MB;
            const int vcu_ = vcu_of();
            TIMED(11, g128::stream<g128::MergeProg>(lds, MP, 1024, vcu_, G));
        }
        SEAM(pb + 5);
#define PANEL_FENCE() do { asm volatile("s_waitcnt vmcnt(0)" ::: "memory"); __builtin_amdgcn_fence(__ATOMIC_ACQUIRE, "agent"); asm volatile("s_waitcnt vmcnt(0)" ::: "memory"); __syncthreads(); } while (0)
        if (PH_ON(7) && IN(pb + 6)) {
            pg8::Gemm g{MB, wmix(P, L, WM_O), D, D, D, nullptr}; pg8::StaticOrder S; S.init(NTOK, D, G, bx);
            epi::EpiRes E{xsrc, XR};
            TIMED(13, RUN_GEMM(epi::EpiRes, pg8::StaticOrder, false, g, S, E));
        }
        SEAM(pb + 6);
        if (PH_ON(8) && IN(pb + 7)) {
            const int vcu_ = vcu_of();
            if (L == 0) TIMED(14, norm_plain(XSrc{nullptr, XR}, P.in[I_GFFN], H, vcu_, G));
            else { TIMED(14, norm2_moe_phase(P, XSrc{nullptr, XR}, lds, vcu_, G)); TIMED(25, cvt_jobs(P, 43, 67, lds)); __syncthreads(); }
        }
        SEAM(pb + 7);
        if (L == 0) {
            if (PH_ON(9) && IN(9)) {
                pg8::Gemm g{H, (const bf16*)(P.ws + WS_W13), D, D, D, nullptr}; pg8::StaticOrder S; S.init(NTOK, 2 * DFF, G, bx);
                epi::EpiSwiglu E{(bf16*)(P.ws + WS_HMID), DFF, 22};
                TIMED(15, RUN_GEMM(epi::EpiSwiglu, pg8::StaticOrder, false, g, S, E));
            }
            SEAM(9);
            if (PH_ON(10) && IN(10)) {
                pg8::Gemm g{(const bf16*)(P.ws + WS_HMID), (const bf16*)(P.ws + WS_W2), DFF, DFF, DFF, nullptr}; pg8::StaticOrder S; S.init(NTOK, D, G, bx);
                epi::EpiRes E{XSrc{nullptr, XR}, XR};
                TIMED(16, RUN_GEMM(epi::EpiRes, pg8::StaticOrder, false, g, S, E));
            }
            SEAM(10);
        } else {
            if (PH_ON(21) && IN(21)) TIMED(17, moe_assign_phase(P));
            SEAM(21);
            if (PH_ON(22) && IN(22)) {
                pg8::Gemm g{H, (const bf16*)(P.ws + WS_WM13), D, D, D, slot_tok}; const MoeOrder S = moe_order(P, 11, G, bx);
                epi::EpiSwiglu E{(bf16*)(P.ws + WS_HMID), DFFE, 11};
                TIMED(18, RUN_GEMM(epi::EpiSwiglu, MoeOrder, true, g, S, E));
            }
            SEAM(22);
            if (PH_ON(23) && IN(23)) {
                pg8::Gemm g{(const bf16*)(P.ws + WS_HMID), (const bf16*)(P.ws + WS_WM2), DFFE, DFFE, DFFE, nullptr}; const MoeOrder S = moe_order(P, 4, G, bx);
                epi::EpiMoeDown E{(bf16*)(P.ws + WS_MOEY), slot_gate};
                TIMED(19, RUN_GEMM(epi::EpiMoeDown, MoeOrder, false, g, S, E));
            }
            SEAM(23);
        }
        if (PH_ON(12) && IN(pc + 3)) {
            const int vcu_ = vcu_of();
            if (L == 0) TIMED(20, norm_plain(XSrc{nullptr, XR}, P.in[I_GPLE] + L * D, H, vcu_, G)); else TIMED(20, norm_moe_combine(P, P.in[I_GPLE] + L * D, vcu_, G));
            PANEL_FENCE();
            g128::PleProg PP; PP.pbf = (const bf16*)(P.ws + WS_PBF) + (size_t)L * NTOK * 256; PP.hp = (L == 0) ? H : (const bf16*)(P.ws + WS_H2); PP.wup = wmix(P, L, WM_UP); PP.wpg = wmix(P, L, WM_PG); PP.x = XR;
            TIMED(22, g128::stream<g128::PleProg>(lds, PP, NTOK / 128, vcu_, G));
            PANEL_FENCE();
            if (L == 0) TIMED(1, norm1_phase(P, 1, XSrc{nullptr, XR}, vcu_, G));
        }
        if (L == 0) SEAM(pc + 3);
    }
    if (PH_ON(26) && IN(25)) {
        const int vcu_ = vcu_of(); const int G_ = gridDim.x;
        for (int r = 0; r < (NTOK / 128 + G_ - 1) / G_; ++r) {
            const int u = vcu_ + r * G_; FinalRows FR;
            if (u < NTOK / 128) final_norm_load(P, u, FR);
            xcd_barrier(bar);
            if (u < NTOK / 128) final_norm_store(P, u, FR);
        }
    }
    if (PROBE_MASK || PROBE_SEAMS) { const unsigned long long t0_ = __builtin_amdgcn_s_memrealtime(); while (__builtin_amdgcn_s_memrealtime() - t0_ < (unsigned long long)PROBE_MULT * pacc) __builtin_amdgcn_s_sleep(8); }
#undef IN
#undef SEAM
#undef H
#undef ZIN
#undef GB
#undef MB
#undef MLAQ
#undef MLAKV
#undef KPER
#undef cosT
#undef sinT
#undef slot_tok
#undef slot_gate
}

extern "C" void kernel_launch(void* const* d_in, const int* in_sizes, int n_in, void* d_out, int out_size, void* d_ws, size_t ws_size, hipStream_t stream) {
    static int grid = 0;
    if (grid == 0) {
        if (n_in != 37 || out_size != NTOK * D || ws_size < WS_END) { fprintf(stderr, "kernel_launch: unexpected shapes: n_in %d out %d ws %zu\n", n_in, out_size, ws_size); grid = -1; return; }
        int dev = 0, cus = 0, per_cu = 0;
        if (hipGetDevice(&dev) != hipSuccess || hipDeviceGetAttribute(&cus, hipDeviceAttributeMultiprocessorCount, dev) != hipSuccess) { grid = -1; return; }
        if (hipFuncSetAttribute((const void*)mega_fwd, hipFuncAttributeMaxDynamicSharedMemorySize, LDS_BYTES) != hipSuccess) { fprintf(stderr, "kernel_launch: hipFuncSetAttribute failed\n"); grid = -1; return; }
        if (hipOccupancyMaxActiveBlocksPerMultiprocessor(&per_cu, (const void*)mega_fwd, NTHREADS, LDS_BYTES) != hipSuccess || per_cu < 1)
            fprintf(stderr, "kernel_launch: note: occupancy query reports %d workgroups per CU\n", per_cu);
        (void)hipGetLastError();
        grid = cus;
        if (grid != 256) fprintf(stderr, "kernel_launch: note: %d CUs (built for 256)\n", grid);
    }
    if (grid < 0) return;
    if (hipMemsetAsync((char*)d_ws + WS_CTL, 0, CTL_ZERO_BYTES, stream) != hipSuccess) return;
    Params p{};
    for (int i = 0; i < 37; ++i) p.in[i] = (const float*)d_in[i];
    p.out = (float*)d_out; p.ws = (unsigned char*)d_ws;
#if N_LAUNCH_MODE == 1
    p.ph_lo = 0; p.ph_hi = N_PHASES;
    hipLaunchKernelGGL(mega_fwd, dim3(grid), dim3(NTHREADS), LDS_BYTES, stream, p);
#else
    for (int ph = 0; ph < N_PHASES; ++ph) { p.ph_lo = ph; p.ph_hi = ph + 1; hipLaunchKernelGGL(mega_fwd, dim3(grid), dim3(NTHREADS), LDS_BYTES, stream, p); }
#endif
    const hipError_t le = hipPeekAtLastError();
    if (le != hipSuccess) fprintf(stderr, "kernel_launch: launch failed: %s\n", hipGetErrorName(le));
}
```

```cpp
#include <hip/hip_runtime.h>
#include <cstdio>
#include <cstdint>

#define GAS __attribute__((address_space(1)))
#define LAS __attribute__((address_space(3)))
typedef unsigned short bf16;
typedef short bf16x8 __attribute__((ext_vector_type(8)));
typedef short s16x4 __attribute__((ext_vector_type(4)));
typedef float f32x2 __attribute__((ext_vector_type(2)));
typedef float f32x4 __attribute__((ext_vector_type(4)));
typedef float f32x16 __attribute__((ext_vector_type(16)));
typedef unsigned u32x2 __attribute__((ext_vector_type(2)));
typedef unsigned u32x4 __attribute__((ext_vector_type(4)));
typedef __bf16 bf16x2_t __attribute__((ext_vector_type(2)));

constexpr int NB = 4, SEQ = 8192, NTOK = NB * SEQ, D = 1024;
constexpr int ZP = 2304;
constexpr int ZC_U = 0, ZC_FQ = 256, ZC_FK = 512, ZC_FV = 768, ZC_DQ = 1024, ZC_DK = 1280, ZC_DV = 1536, ZC_CQ = 1792, ZC_CKV = 2048, ZC_KPE = 2176;
constexpr int DIN = 2148, DFF = 2816, DFFE = 1408, NE = 8;
constexpr int MOE_ROWS = 2 * NTOK + NE * 256;
constexpr float RMS_EPS = 1e-6f;
constexpr int NWAVES = 8, NTHREADS = 512;

constexpr size_t MiB = 1u << 20;
constexpr size_t WS_CTL = 0, CTL_ZERO_BYTES = 1 * MiB;
constexpr size_t WS_COS = 1 * MiB, WS_SIN = 3 * MiB;
constexpr size_t WS_LOGF = 5 * MiB;
constexpr size_t WS_CDEC = 5 * MiB + 512 * 1024;
constexpr size_t WS_WSUM = 6 * MiB;
constexpr size_t WS_RSTDQ = 6 * MiB + 256 * 1024, WS_RSTDKV = 6 * MiB + 512 * 1024;
constexpr size_t WS_SC = 7 * MiB;
constexpr size_t WS_TOKINFO = 11 * MiB;
constexpr size_t WS_SLOTTOK = 12 * MiB, WS_SLOTGATE = 12 * MiB + 512 * 1024;
constexpr size_t WS_PBF = 17 * MiB;
constexpr size_t WS_WMIX = 49 * MiB, WMIX_STRIDE = 20 * MiB;
constexpr size_t WM_IN = 0, WM_G = 4 * MiB + 512 * 1024, WM_B = 12 * MiB + 512 * 1024, WM_O = 14 * MiB + 512 * 1024, WM_PG = 16 * MiB + 512 * 1024,
                 WM_UP = 18 * MiB + 512 * 1024, WM_UQ = 19 * MiB, WM_UKV = 19 * MiB + 256 * 1024, WM_GLU = 19 * MiB + 384 * 1024;
constexpr size_t WS_W13 = 89 * MiB, WS_W2 = 100 * MiB;
constexpr size_t WS_H = 106 * MiB;
constexpr size_t WS_MLAQ = 170 * MiB, WS_MLAKV = 202 * MiB, WS_KPER = 234 * MiB;
constexpr size_t WS_M = 170 * MiB;
constexpr size_t WS_ZIN = 236 * MiB;
constexpr size_t WS_G = 380 * MiB;
constexpr size_t WS_HMID = 236 * MiB;
constexpr size_t WS_U = 236 * MiB;
constexpr size_t WS_WM13 = 418 * MiB, WS_WM2 = 462 * MiB;
constexpr size_t WS_MOEY = 89 * MiB;
constexpr size_t WS_H2 = 300 * MiB;
constexpr size_t WS_END = 484 * MiB;
constexpr int CW_BAR = 4096;
constexpr int CW_MOECNT = 16384;
constexpr int CW_QMAX = 20480;
constexpr int CW_KMAX = 22528;

#define LDS_WAIT() asm volatile("s_waitcnt lgkmcnt(0)" ::: "memory")
#define VM_WAIT() asm volatile("s_waitcnt vmcnt(0)" ::: "memory")
__device__ __forceinline__ unsigned f2bf(float f) { unsigned u = __builtin_bit_cast(unsigned, f); return (u + 0x7fffu + ((u >> 16) & 1u)) >> 16; }
__device__ __forceinline__ unsigned pk2(float lo, float hi) { f32x2 v = {lo, hi}; bf16x2_t b = __builtin_convertvector(v, bf16x2_t); return __builtin_bit_cast(unsigned, b); }
__device__ __forceinline__ float bf2f(unsigned short b) { return __uint_as_float((unsigned)b << 16); }
__device__ __forceinline__ float bflo(unsigned w) { return __uint_as_float(w << 16); }
__device__ __forceinline__ float bfhi(unsigned w) { return __uint_as_float(w & 0xffff0000u); }
constexpr int TID_TAB_OFF = 147456 - 512;
__device__ __forceinline__ unsigned hw_wave_key() { return (unsigned)__builtin_amdgcn_s_getreg((5 << 11) | 4) & 0x3Fu; }
__device__ __forceinline__ int my_tid() {
    unsigned addr = (unsigned)TID_TAB_OFF + 4u * hw_wave_key(); asm volatile("" : "+s"(addr));
    const int wave = __builtin_amdgcn_readfirstlane(*(const LAS int*)(uintptr_t)addr);
    int lane = (int)__builtin_amdgcn_mbcnt_hi(~0u, __builtin_amdgcn_mbcnt_lo(~0u, 0u)); asm volatile("" : "+v"(lane));
    return wave * 64 + lane;
}
__device__ __forceinline__ float shflx(float v, int o, int lane) { return __int_as_float(__builtin_amdgcn_ds_bpermute((lane ^ o) << 2, __float_as_int(v))); }
__device__ __forceinline__ float wave_sum(float v) {
    int lane = (int)__builtin_amdgcn_mbcnt_hi(~0u, __builtin_amdgcn_mbcnt_lo(~0u, 0u)); asm volatile("" : "+v"(lane));
#pragma unroll
    for (int o = 1; o < 64; o <<= 1) v += shflx(v, o, lane);
    return v;
}
__device__ __forceinline__ float sigmoidf_(float x) { return __builtin_amdgcn_rcpf(1.0f + __expf(-x)); }

struct XSrc { const float* f; const bf16* b; };
__device__ __forceinline__ f32x4 ldx4(const XSrc& x, size_t idx) {
    if (x.f) return *(const f32x4*)(x.f + idx);
    const u32x2 w = *(const u32x2*)(x.b + idx); return (f32x4){bflo(w.x), bfhi(w.x), bflo(w.y), bfhi(w.y)};
}
__device__ __forceinline__ bf16* xr_of(float* out) { return (bf16*)((unsigned char*)out + (size_t)NTOK * D * 2); }
#define BODY_IDS() int tid = my_tid(); asm volatile("" : "+v"(tid)); const int lane = tid & 63; const int wave = __builtin_amdgcn_readfirstlane(tid >> 6); \
    int grid_ = gridDim.x; asm volatile("" : "+s"(grid_)); \
    const int gw = blockIdx.x * NWAVES + wave, ngw = grid_ * NWAVES, gtid = blockIdx.x * NTHREADS + tid, gthreads = grid_ * NTHREADS; (void)lane; (void)wave; (void)gw; (void)ngw; (void)gtid; (void)gthreads
#define XB_TMO      128
#define XB_XCNT(j)  (256  + 64 * (j))
#define XB_XSUB(j)  (1280 + 64 * (j))
#define XB_XGEN(j)  (2304 + 64 * (j))
#define XB_TOP      3328
#define XB_TOPGEN   3392
#define XCD_BAR_WORDS 3456
#define XB_SPIN_CAP (1u << 22)

__device__ __forceinline__ unsigned xb_ld(unsigned* p)              { return __hip_atomic_load(p, __ATOMIC_RELAXED, __HIP_MEMORY_SCOPE_AGENT); }
__device__ __forceinline__ unsigned xb_add(unsigned* p, unsigned v) { return __hip_atomic_fetch_add(p, v, __ATOMIC_RELAXED, __HIP_MEMORY_SCOPE_AGENT); }
__device__ __forceinline__ unsigned xb_xcc_id() { return (unsigned)__builtin_amdgcn_s_getreg((3 << 11) | 20) & 0xFu; }
#define XB_SPIN(cond, bar) do { unsigned _sp = 0; while (cond) { __builtin_amdgcn_s_sleep(1); \
    if ((++_sp & 255u) == 0u) { if (xb_ld(&(bar)[XB_TMO])) break; if (_sp > XB_SPIN_CAP) { atomicAdd(&(bar)[XB_TMO], 1u); break; } } } } while (0)

struct XcdBarrier { unsigned* bar; unsigned x; volatile LAS unsigned* st; };

__device__ __forceinline__ XcdBarrier xcd_barrier_post(unsigned* bar, volatile LAS unsigned* st) {
    XcdBarrier b; b.bar = bar; b.x = xb_xcc_id(); b.st = st;
    if (my_tid() == 0) (void)xb_add(&bar[XB_XCNT(b.x)], 1u);
    return b;
}
__device__ __forceinline__ void xcd_barrier_complete(unsigned* bar, unsigned x, unsigned& nloc, unsigned& nx) {
    const unsigned G = gridDim.x * gridDim.y * gridDim.z;
    unsigned sum, cnt, mine, sp = 0u;
    for (;;) {
        sum = 0u; cnt = 0u; mine = 0u;
#pragma unroll
        for (unsigned j = 0; j < 16; ++j) { const unsigned c = xb_ld(&bar[XB_XCNT(j)]); sum += c; cnt += (c > 0u) ? 1u : 0u; mine = (j == x) ? c : mine; }
        if (sum == G) break;
        __builtin_amdgcn_s_sleep(1);
        if ((++sp & 255u) == 0u) { if (xb_ld(&bar[XB_TMO])) break; if (sp > XB_SPIN_CAP) { atomicAdd(&bar[XB_TMO], 1u); break; } }
    }
    nloc = mine > 0u ? mine : 1u; nx = cnt > 0u ? cnt : 1u;
}
__device__ __forceinline__ void xcd_barrier(const XcdBarrier& b) {
    asm volatile("s_waitcnt vmcnt(0)" ::: "memory");
    __syncthreads();
    if (my_tid() == 0) {
        unsigned* bar = b.bar;
        __builtin_amdgcn_s_waitcnt(0);
        unsigned nloc = b.st[0], nx = b.st[1];
        if (nloc == 0u) { xcd_barrier_complete(bar, b.x, nloc, nx); b.st[0] = nloc; b.st[1] = nx; }
        const unsigned old = xb_add(&bar[XB_XSUB(b.x)], 1u);
        const unsigned gen = old / nloc;
        if (old + 1u == (gen + 1u) * nloc) {
            __builtin_amdgcn_fence(__ATOMIC_RELEASE, "agent");
            asm volatile("s_waitcnt vmcnt(0)" ::: "memory");
            const unsigned og = xb_add(&bar[XB_TOP], 1u);
            const unsigned tg = og / nx;
            if (og + 1u == (tg + 1u) * nx) xb_add(&bar[XB_TOPGEN], 1u);
            else XB_SPIN(xb_ld(&bar[XB_TOPGEN]) == tg, bar);
            __builtin_amdgcn_fence(__ATOMIC_ACQUIRE, "agent");
            xb_add(&bar[XB_XGEN(b.x)], 1u);
            asm volatile("s_waitcnt vmcnt(0)" ::: "memory");
        } else {
            XB_SPIN(xb_ld(&bar[XB_XGEN(b.x)]) == gen, bar);
            __builtin_amdgcn_fence(__ATOMIC_ACQUIRE, "agent");
            asm volatile("s_waitcnt vmcnt(0)" ::: "memory");
        }
    }
    __syncthreads();
}
namespace pg8 {
constexpr int BM = 256, BK = 64, HALF = 128, HTB = HALF * BK * 2, STAGE_BYTES = 8 * HTB, NXCD = 8, WGM = 8;
__host__ __device__ __forceinline__ int lds_byte(int r, int c) { const int st = (r >> 4) * 2 + (c >> 5), rr = r & 15, cc = c & 31, ob = rr * 64 + cc * 2; return st * 1024 + (ob ^ (((ob >> 9) & 1) << 5)); }
__host__ __device__ __forceinline__ void stage_rc(int b, int& R, int& C) { const int st = b / 1024, sb = b % 1024, swz = sb ^ (((sb >> 9) & 1) << 5); R = (st >> 1) * 16 + swz / 64; C = (st & 1) * 32 + (swz % 64) / 2; }
__host__ __device__ __forceinline__ int perm32(int rho) { const int n = rho >> 4, i = rho & 15; return 8 * (i >> 2) + 4 * n + (i & 3); }

struct Unit { int pm, pn; };
struct Gemm { const bf16* A; const bf16* Bt; int lda, ldb, K; const int* gidx; };

struct StaticOrder {
    int nM, nN, nwg, G, c;
    __host__ __device__ void init(int M, int N, int G_, int c_) { nM = M / BM; nN = N / BM; nwg = nM * nN; G = G_; c = c_; }
    __host__ __device__ bool next(int i, Unit& u) const {
        const long L = (long)i * G + c; if (L >= nwg) return false;
        int wgid = (int)L; { const int q = nwg / NXCD, r = nwg % NXCD, xcd = wgid % NXCD, off = wgid / NXCD; wgid = (xcd < r ? xcd * (q + 1) : r * (q + 1) + (xcd - r) * q) + off; }
        const int nig = WGM * nN, gid = wgid / nig, fm = gid * WGM, gsz = (nM - fm) < WGM ? (nM - fm) : WGM;
        u.pm = fm + ((wgid % nig) % gsz); u.pn = (wgid % nig) / gsz; return true;
    }
};

template <class Epi, class Sched, bool ALIGN_EPI, bool GATHER>
__device__ __forceinline__ void gemm_phase(LAS unsigned char* lds, const Gemm g, const Sched& S, const Epi& E) {
    int tid = my_tid(); asm volatile("" : "+v"(tid));
    const int wid = __builtin_amdgcn_readfirstlane(tid >> 6), lane = tid & 63, wr = wid >> 2, wc = wid & 3, fr = lane & 15, fq = lane >> 4;
    int Kq = g.K; asm volatile("" : "+s"(Kq));
    const int K = Kq, nt = K / BK;
    int RA[2], CA[2];
    unsigned voffA[2], voffB[2];
#pragma unroll
    for (int i = 0; i < 2; ++i) { int R, C; stage_rc(tid * 16 + i * 8192, R, C); const int Rb = Epi::PERM ? ((R & ~31) + perm32(R & 31)) : R;
        RA[i] = R; CA[i] = C; voffA[i] = (unsigned)(R * g.lda + C) * 2u; voffB[i] = (unsigned)(Rb * g.ldb + C) * 2u; }
    const size_t kstep = (size_t)(BK * 2);
    const size_t hstepB = (size_t)HALF * g.ldb * 2, tstepB = 2 * hstepB;
    const size_t hstepA = (size_t)HALF * g.lda * 2, tstepA = 2 * hstepA;
    const unsigned ldsw = (unsigned)wid * 1024u;
    const int aoff = lds_byte(wr * 64 + fr, fq * 8), boff = lds_byte(wc * 32 + fr, fq * 8);
#define PG8_SA(b, h) (((b) * 2 + (h)) * HTB)
#define PG8_SB(b, h) ((4 + (b) * 2 + (h)) * HTB)
#define PG8_STAGEB(bufoff, gbase) do { _Pragma("unroll") for (int _i = 0; _i < 2; ++_i) \
        __builtin_amdgcn_global_load_lds((const unsigned*)((const char*)(gbase) + voffB[_i]), (LAS unsigned*)(lds + (bufoff) + ldsw + _i * 8192), 16, 0, 0); } while (0)
#define PG8_STAGEA(bufoff, kptr, isnext, h) do { _Pragma("unroll") for (int _i = 0; _i < 2; ++_i) { const char* _p; \
        if constexpr (GATHER) _p = (const char*)(kptr) + ((isnext) ? nvo[h][_i] : cvo[h][_i]); else _p = (const char*)(kptr) + (size_t)(h) * hstepA + voffA[_i]; \
        __builtin_amdgcn_global_load_lds((const unsigned*)_p, (LAS unsigned*)(lds + (bufoff) + ldsw + _i * 8192), 16, 0, 0); } } while (0)
#define PG8_LDA(dst, b, h) do { _Pragma("unroll") for (int m = 0; m < 4; ++m) _Pragma("unroll") for (int k = 0; k < 2; ++k) dst[m][k] = *(const LAS bf16x8*)(lds + PG8_SA(b, h) + aoff + m * 2048 + k * 1024); } while (0)
#define PG8_LDB(dst, b, h) do { _Pragma("unroll") for (int n = 0; n < 2; ++n) _Pragma("unroll") for (int k = 0; k < 2; ++k) dst[n][k] = *(const LAS bf16x8*)(lds + PG8_SB(b, h) + boff + n * 2048 + k * 1024); } while (0)
#define PG8_MMA(ai, bj, At, Bt) do { __builtin_amdgcn_s_setprio(1); _Pragma("unroll") for (int m = 0; m < 4; ++m) _Pragma("unroll") for (int n = 0; n < 2; ++n) _Pragma("unroll") for (int k = 0; k < 2; ++k) \
        acc[ai][bj][m][n] = __builtin_amdgcn_mfma_f32_16x16x32_bf16(Bt[n][k], At[m][k], acc[ai][bj][m][n], 0, 0, 0); __builtin_amdgcn_s_setprio(0); } while (0)
#define PG8_WAIT_V(n) asm volatile("s_waitcnt vmcnt(" #n ")" ::: "memory")
#define PG8_WAIT_L(n) asm volatile("s_waitcnt lgkmcnt(" #n ")" ::: "memory")
#define PG8_BAR __builtin_amdgcn_s_barrier()
#define PG8_SCHED __builtin_amdgcn_sched_barrier(0)
#define PG8_VOA(vo, u) do { _Pragma("unroll") for (int _h = 0; _h < 2; ++_h) _Pragma("unroll") for (int _i = 0; _i < 2; ++_i) { \
        int _row = (u).pm * BM + _h * HALF + RA[_i]; if (GATHER) { _row = g.gidx[_row]; _row = _row < 0 ? 0 : _row; } \
        (vo)[_h][_i] = (unsigned)_row * (unsigned)(g.lda * 2) + (unsigned)(CA[_i] * 2); } } while (0)
    Unit cur, nxt; int ui = 0;
    if (!S.next(0, cur)) return;
    f32x4 acc[2][2][4][2];
#pragma unroll
    for (int a = 0; a < 2; ++a)
#pragma unroll
        for (int b = 0; b < 2; ++b)
#pragma unroll
            for (int m = 0; m < 4; ++m)
#pragma unroll
                for (int n = 0; n < 2; ++n) acc[a][b][m][n] = (f32x4){0.f, 0.f, 0.f, 0.f};
    bf16x8 At[4][2], B0[2][2], B1[2][2];
    unsigned cvo[2][2], nvo[2][2];
    if constexpr (GATHER) { PG8_VOA(cvo, cur); PG8_VOA(nvo, cur); }
    const char* cA = (const char*)g.A + (GATHER ? (size_t)0 : (size_t)cur.pm * tstepA); const char* cB = (const char*)g.Bt + (size_t)cur.pn * tstepB;
    PG8_STAGEB(PG8_SB(0, 0), cB); PG8_STAGEB(PG8_SB(0, 1), cB + hstepB); PG8_STAGEA(PG8_SA(0, 0), cA, false, 0); PG8_STAGEA(PG8_SA(0, 1), cA, false, 1);
    if (wr == 1) PG8_BAR;
    PG8_WAIT_V(2); PG8_BAR;
    PG8_STAGEB(PG8_SB(1, 0), cB + kstep); PG8_STAGEA(PG8_SA(1, 0), cA + kstep, false, 0); PG8_STAGEB(PG8_SB(1, 1), cB + hstepB + kstep);
    PG8_WAIT_V(6); PG8_BAR;
    for (;;) {
        const bool has_next = S.next(ui + 1, nxt);
        if constexpr (GATHER) { if (has_next) { PG8_VOA(nvo, nxt); } }
        const char* nA = (GATHER || !has_next) ? cA : (const char*)g.A + (size_t)nxt.pm * tstepA;
        const char* nB = has_next ? (const char*)g.Bt + (size_t)nxt.pn * tstepB : cB;
#pragma nounroll
        for (int t = 0; t < nt; t += 2) {
            const bool last = (t == nt - 2);
            const char* a1 = cA + (size_t)(t + 1) * kstep;
            const char* a2 = last ? nA : cA + (size_t)(t + 2) * kstep; const char* b2 = last ? nB : cB + (size_t)(t + 2) * kstep;
            const char* a3 = a2 + kstep; const char* b3 = b2 + kstep;
            PG8_LDB(B0, 0, 0); PG8_LDB(B1, 0, 1); PG8_SCHED; PG8_LDA(At, 0, 0); PG8_STAGEA(PG8_SA(1, 1), a1, false, 1);
            PG8_WAIT_V(8); PG8_WAIT_L(0); PG8_BAR; PG8_MMA(0, 0, At, B0); PG8_MMA(0, 1, At, B1); PG8_BAR; PG8_SCHED;
            PG8_LDA(At, 0, 1); PG8_STAGEB(PG8_SB(0, 0), b2); PG8_STAGEB(PG8_SB(0, 1), b2 + hstepB); PG8_STAGEA(PG8_SA(0, 0), a2, last, 0);
            PG8_WAIT_V(8); PG8_WAIT_L(0); PG8_BAR; PG8_MMA(1, 0, At, B0); PG8_MMA(1, 1, At, B1); PG8_BAR; PG8_SCHED;
            PG8_LDB(B0, 1, 0); PG8_LDB(B1, 1, 1); PG8_SCHED; PG8_LDA(At, 1, 0); PG8_STAGEA(PG8_SA(0, 1), a2, last, 1);
            PG8_WAIT_V(8); PG8_WAIT_L(0); PG8_BAR; PG8_MMA(0, 0, At, B0); PG8_MMA(0, 1, At, B1); PG8_BAR; PG8_SCHED;
            PG8_LDA(At, 1, 1); PG8_STAGEB(PG8_SB(1, 0), b3); PG8_STAGEB(PG8_SB(1, 1), b3 + hstepB); PG8_STAGEA(PG8_SA(1, 0), a3, last, 0);
            PG8_WAIT_V(8); PG8_WAIT_L(0); PG8_BAR; PG8_MMA(1, 0, At, B0); PG8_MMA(1, 1, At, B1); PG8_BAR; PG8_SCHED;
        }
        if constexpr (ALIGN_EPI) { if (wr == 0) PG8_BAR; }
        E(acc, cur, wr, wc, fr, fq);
        if (!has_next) break;
#pragma unroll
        for (int a = 0; a < 2; ++a)
#pragma unroll
            for (int b = 0; b < 2; ++b)
#pragma unroll
                for (int m = 0; m < 4; ++m)
#pragma unroll
                    for (int n = 0; n < 2; ++n) acc[a][b][m][n] = (f32x4){0.f, 0.f, 0.f, 0.f};
        cur = nxt; cA = nA; cB = nB; ++ui;
        if constexpr (GATHER) {
#pragma unroll
            for (int _h = 0; _h < 2; ++_h)
#pragma unroll
                for (int _i = 0; _i < 2; ++_i) cvo[_h][_i] = nvo[_h][_i]; }
        if constexpr (ALIGN_EPI) { if (wr == 1) PG8_BAR; }
    }
    PG8_WAIT_V(0);
    if constexpr (!ALIGN_EPI) { if (wr == 0) PG8_BAR; }
    PG8_BAR;
#undef PG8_SA
#undef PG8_SB
#undef PG8_STAGEA
#undef PG8_STAGEB
#undef PG8_LDA
#undef PG8_LDB
#undef PG8_MMA
#undef PG8_WAIT_V
#undef PG8_WAIT_L
#undef PG8_BAR
#undef PG8_SCHED
#undef PG8_VOA
}

template <class Epi, class Sched, bool GATHER>
__device__ __forceinline__ void gemm_phase_naive(const Gemm g, const Sched& S, const Epi& E) {
    const int tid = threadIdx.x, wid = tid >> 6, lane = tid & 63, wr = wid >> 2, wc = wid & 3, fr = lane & 15, fq = lane >> 4;
    Unit u;
    for (int ui = 0; S.next(ui, u); ++ui) {
        f32x4 acc[2][2][4][2];
#pragma unroll
        for (int a = 0; a < 2; ++a)
#pragma unroll
            for (int b = 0; b < 2; ++b)
#pragma unroll
                for (int m = 0; m < 4; ++m)
#pragma unroll
                    for (int n = 0; n < 2; ++n) acc[a][b][m][n] = (f32x4){0.f, 0.f, 0.f, 0.f};
        const bf16* arow[2][4];
#pragma unroll
        for (int ai = 0; ai < 2; ++ai)
#pragma unroll
            for (int m = 0; m < 4; ++m) { int r = u.pm * BM + ai * HALF + wr * 64 + m * 16 + fr; if (GATHER) { r = g.gidx[r]; r = r < 0 ? 0 : r; } arow[ai][m] = g.A + (size_t)r * g.lda; }
        for (int k = 0; k < g.K; k += 4) {
            float av[2][4][4];
#pragma unroll
            for (int ai = 0; ai < 2; ++ai)
#pragma unroll
                for (int m = 0; m < 4; ++m) { const u32x2 w = *(const u32x2*)(arow[ai][m] + k); av[ai][m][0] = bflo(w.x); av[ai][m][1] = bfhi(w.x); av[ai][m][2] = bflo(w.y); av[ai][m][3] = bfhi(w.y); }
#pragma unroll
            for (int bj = 0; bj < 2; ++bj)
#pragma unroll
                for (int n = 0; n < 2; ++n)
#pragma unroll
                    for (int e = 0; e < 4; ++e) {
                        const int col = u.pn * BM + bj * HALF + wc * 32 + (Epi::PERM ? (8 * fq + 4 * n) : (16 * n + 4 * fq)) + e;
                        const u32x2 w = *(const u32x2*)(g.Bt + (size_t)col * g.ldb + k);
                        const float b0 = bflo(w.x), b1 = bfhi(w.x), b2 = bflo(w.y), b3 = bfhi(w.y);
#pragma unroll
                        for (int ai = 0; ai < 2; ++ai)
#pragma unroll
                            for (int m = 0; m < 4; ++m) acc[ai][bj][m][n][e] += av[ai][m][0] * b0 + av[ai][m][1] * b1 + av[ai][m][2] * b2 + av[ai][m][3] * b3;
                    }
        }
        E(acc, u, wr, wc, fr, fq);
    }
    VM_WAIT(); __syncthreads();
}
}
namespace g128 {
using pg8::lds_byte; using pg8::stage_rc; using pg8::HTB; using pg8::BK;
struct Seg { const bf16* A; const bf16* B; int lda, ldb, nt; };
typedef f32x4 acc_t[2][4][2];

template <class Prog>
__device__ __forceinline__ void stream(LAS unsigned char* lds, Prog& P, int nunits, int first, int stride) {
    int tid = my_tid(); asm volatile("" : "+v"(tid));
    const int wid = __builtin_amdgcn_readfirstlane(tid >> 6), lane = tid & 63, wr = wid >> 2, wc = wid & 3, fr = lane & 15, fq = lane >> 4;
    int RA[2], CA[2], RB[2];
#pragma unroll
    for (int i = 0; i < 2; ++i) { stage_rc(tid * 16 + i * 8192, RA[i], CA[i]); RB[i] = (RA[i] & ~31) + pg8::perm32(RA[i] & 31); }
    const unsigned ldsw = (unsigned)wid * 1024u;
    const int aoff = lds_byte(wr * 64 + fr, fq * 8), boff = lds_byte(wc * 32 + fr, fq * 8);
#define G_SA(b) ((b) * HTB)
#define G_SB(b, h) ((2 + (b) * 2 + (h)) * HTB)
#define G_STAGE(bufoff, base, ld, kbyte, RR) do { _Pragma("unroll") for (int _i = 0; _i < 2; ++_i) \
        __builtin_amdgcn_global_load_lds((const unsigned*)((const char*)(base) + (size_t)(kbyte) + (unsigned)(RR[_i] * (ld) + CA[_i]) * 2u), (LAS unsigned*)(lds + (bufoff) + ldsw + _i * 8192), 16, 0, 0); } while (0)
#define G_STAGE_A(b, S, j) G_STAGE(G_SA(b), (S).A, (S).lda, (j) * 128, RA)
#define G_STAGE_B(b, h, S, j) G_STAGE(G_SB(b, h), (const char*)(S).B + (size_t)(h) * 128 * (S).ldb * 2, (S).ldb, (j) * 128, RB)
#define G_LDA(dst, b) do { _Pragma("unroll") for (int m = 0; m < 4; ++m) _Pragma("unroll") for (int k = 0; k < 2; ++k) dst[m][k] = *(const LAS bf16x8*)(lds + G_SA(b) + aoff + m * 2048 + k * 1024); } while (0)
#define G_LDB(dst, b, h) do { _Pragma("unroll") for (int n = 0; n < 2; ++n) _Pragma("unroll") for (int k = 0; k < 2; ++k) dst[n][k] = *(const LAS bf16x8*)(lds + G_SB(b, h) + boff + n * 2048 + k * 1024); } while (0)
#define G_MMA(bj, At, Bt) do { __builtin_amdgcn_s_setprio(1); _Pragma("unroll") for (int m = 0; m < 4; ++m) _Pragma("unroll") for (int n = 0; n < 2; ++n) _Pragma("unroll") for (int k = 0; k < 2; ++k) \
        acc[bj][m][n] = __builtin_amdgcn_mfma_f32_16x16x32_bf16(Bt[n][k], At[m][k], acc[bj][m][n], 0, 0, 0); __builtin_amdgcn_s_setprio(0); } while (0)
#define G_WAIT_V(n) asm volatile("s_waitcnt vmcnt(" #n ")" ::: "memory")
#define G_WAIT_L(n) asm volatile("s_waitcnt lgkmcnt(" #n ")" ::: "memory")
#define G_BAR __builtin_amdgcn_s_barrier()
#define G_SCHED __builtin_amdgcn_sched_barrier(0)
    if (first >= nunits) return;
    P.reset();
    int ucur = first, scur = 0;
    Seg cur, nxt;
    P.seg(ucur, scur, cur);
    acc_t acc;
    P.init(ucur, scur, acc, wr, wc, fr, fq);
    bf16x8 At[4][2], B0[2][2], B1[2][2];
    G_STAGE_B(0, 0, cur, 0); G_STAGE_A(0, cur, 0); G_STAGE_B(0, 1, cur, 0);
    if (wr == 1) G_BAR;
    G_WAIT_V(2); G_BAR;
    G_STAGE_A(1, cur, 1); G_STAGE_B(1, 0, cur, 1);
    G_WAIT_V(4); G_BAR;
#define G_TILE(t_, b_) do { const bool n1_ = ((t_) + 1 >= nt), n2_ = ((t_) + 2 >= nt); const int j1_ = n1_ ? ((t_) + 1 - nt) : ((t_) + 1), j2_ = n2_ ? ((t_) + 2 - nt) : ((t_) + 2); \
        G_LDB(B0, b_, 0); G_SCHED; G_LDA(At, b_); \
        if (n1_) G_STAGE_B((b_) ^ 1, 1, nxt, j1_); else G_STAGE_B((b_) ^ 1, 1, cur, j1_); \
        G_WAIT_V(6); G_WAIT_L(0); G_BAR; G_MMA(0, At, B0); G_BAR; G_SCHED; \
        G_LDB(B1, b_, 1); \
        if (n2_) { G_STAGE_A(b_, nxt, j2_); G_STAGE_B(b_, 0, nxt, j2_); } else { G_STAGE_A(b_, cur, j2_); G_STAGE_B(b_, 0, cur, j2_); } \
        G_WAIT_V(6); G_WAIT_L(0); G_BAR; G_MMA(1, At, B1); G_BAR; G_SCHED; } while (0)
    for (;;) {
        int unxt = ucur, snxt = scur + 1; bool more = true;
        if (snxt == Prog::NSEG) { snxt = 0; unxt = ucur + stride; if (unxt >= nunits) { more = false; unxt = ucur; snxt = scur; } }
        P.seg(unxt, snxt, nxt);
        int ntq = cur.nt; asm volatile("" : "+s"(ntq)); const int nt = ntq;
#pragma nounroll
        for (int t = 0; t < nt; t += 2) { G_TILE(t, 0); G_TILE(t + 1, 1); }
        P.done(ucur, scur, acc, wr, wc, fr, fq);
        if (!more) break;
        P.init(unxt, snxt, acc, wr, wc, fr, fq);
        ucur = unxt; scur = snxt; cur = nxt;
    }
    G_WAIT_V(0);
    if (wr == 0) G_BAR;
    G_BAR;
#undef G_SA
#undef G_SB
#undef G_STAGE
#undef G_STAGE_A
#undef G_STAGE_B
#undef G_LDA
#undef G_LDB
#undef G_MMA
#undef G_WAIT_V
#undef G_WAIT_L
#undef G_BAR
#undef G_SCHED
#undef G_TILE
}

struct MergeProg {
    static constexpr int NSEG = 8;
    const bf16* Hn; const bf16* zin; const bf16* wg; const bf16* wb; const float* bg; bf16* M;
    __device__ __forceinline__ void reset() {
#pragma unroll
        for (int a = 0; a < 2; ++a)
#pragma unroll
            for (int b = 0; b < 4; ++b)
#pragma unroll
                for (int c = 0; c < 2; ++c) { g[a][b][c] = (u32x2){0u, 0u}; macc[a][b][c] = (u32x2){0u, 0u}; } }
    u32x2 g[2][4][2]; u32x2 macc[2][4][2];
    __device__ __forceinline__ void seg(int u, int s, Seg& S) const {
        const int pm = u >> 2, pn = u & 3, k = s >> 1;
        if ((s & 1) == 0) { S.A = Hn + (size_t)pm * 128 * D; S.lda = D; S.B = wg + ((size_t)k * D + pn * 256) * D; S.ldb = D; S.nt = D / 64; }
        else { const int ycol = (k == 0) ? ZC_U : (k == 1) ? ZC_FQ : (k == 2) ? ZC_CQ : ZC_DQ;
               S.A = zin + (size_t)pm * 128 * ZP + ycol; S.lda = ZP; S.B = wb + ((size_t)k * D + pn * 256) * 256; S.ldb = 256; S.nt = 4; }
    }
    __device__ __forceinline__ void init(int u, int s, acc_t& acc, int wr, int wc, int fr, int fq) {
        const int pn = u & 3, k = s >> 1;
        if ((s & 1) == 0) {
#pragma unroll
            for (int bj = 0; bj < 2; ++bj)
#pragma unroll
                for (int n = 0; n < 2; ++n) { const f32x4 bv = *(const f32x4*)(bg + (size_t)k * D + pn * 256 + bj * 128 + wc * 32 + 8 * fq + 4 * n);
#pragma unroll
                    for (int m = 0; m < 4; ++m) acc[bj][m][n] = bv; }
            if (s == 0) {
#pragma unroll
                for (int bj = 0; bj < 2; ++bj)
#pragma unroll
                    for (int m = 0; m < 4; ++m)
#pragma unroll
                        for (int n = 0; n < 2; ++n) macc[bj][m][n] = (u32x2){0u, 0u}; }
        } else {
#pragma unroll
            for (int bj = 0; bj < 2; ++bj)
#pragma unroll
                for (int m = 0; m < 4; ++m)
#pragma unroll
                    for (int n = 0; n < 2; ++n) acc[bj][m][n] = (f32x4){0.f, 0.f, 0.f, 0.f};
        }
    }
    __device__ __forceinline__ void done(int u, int s, const acc_t& acc, int wr, int wc, int fr, int fq) {
        if ((s & 1) == 0) {
#pragma unroll
            for (int bj = 0; bj < 2; ++bj)
#pragma unroll
                for (int m = 0; m < 4; ++m)
#pragma unroll
                    for (int n = 0; n < 2; ++n) { const f32x4 a = acc[bj][m][n]; u32x2 w; w.x = pk2(sigmoidf_(a[0]), sigmoidf_(a[1])); w.y = pk2(sigmoidf_(a[2]), sigmoidf_(a[3])); g[bj][m][n] = w; }
        } else {
#pragma unroll
            for (int bj = 0; bj < 2; ++bj)
#pragma unroll
                for (int m = 0; m < 4; ++m)
#pragma unroll
                    for (int n = 0; n < 2; ++n) { const u32x2 w = g[bj][m][n], q = macc[bj][m][n]; const f32x4 v = (f32x4){bflo(q.x), bfhi(q.x), bflo(q.y), bfhi(q.y)} + (f32x4){bflo(w.x), bfhi(w.x), bflo(w.y), bfhi(w.y)} * acc[bj][m][n];
                        u32x2 r; r.x = pk2(v[0], v[1]); r.y = pk2(v[2], v[3]); macc[bj][m][n] = r; }
            if (s == NSEG - 1) { const int pm = u >> 2, pn = u & 3;
#pragma unroll
                for (int m = 0; m < 4; ++m) { bf16* rp = M + (size_t)(pm * 128 + wr * 64 + m * 16 + fr) * D + pn * 256 + wc * 32 + 8 * fq;
#pragma unroll
                    for (int bj = 0; bj < 2; ++bj) *(u32x4*)(rp + bj * 128) = (u32x4){macc[bj][m][0].x, macc[bj][m][0].y, macc[bj][m][1].x, macc[bj][m][1].y}; } }
        }
    }
};

struct PleProg {
    static constexpr int NSEG = 8;
    const bf16* pbf; const bf16* hp; const bf16* wup; const bf16* wpg; bf16* x;
    u32x2 uu[2][4][2];
    __device__ __forceinline__ void reset() {
#pragma unroll
        for (int a = 0; a < 2; ++a)
#pragma unroll
            for (int b = 0; b < 4; ++b)
#pragma unroll
                for (int c = 0; c < 2; ++c) uu[a][b][c] = (u32x2){0u, 0u}; }
    __device__ __forceinline__ void seg(int u, int s, Seg& S) const {
        const int pn = s >> 1;
        if ((s & 1) == 0) { S.A = pbf + (size_t)u * 128 * 256; S.lda = 256; S.B = wup + (size_t)pn * 256 * 256; S.ldb = 256; S.nt = 4; }
        else { S.A = hp + (size_t)u * 128 * D; S.lda = D; S.B = wpg + (size_t)pn * 256 * D; S.ldb = D; S.nt = D / 64; }
    }
    __device__ __forceinline__ void init(int u, int s, acc_t& acc, int wr, int wc, int fr, int fq) {
#pragma unroll
        for (int bj = 0; bj < 2; ++bj)
#pragma unroll
            for (int m = 0; m < 4; ++m)
#pragma unroll
                for (int n = 0; n < 2; ++n) acc[bj][m][n] = (f32x4){0.f, 0.f, 0.f, 0.f};
    }
    __device__ __forceinline__ void done(int u, int s, const acc_t& acc, int wr, int wc, int fr, int fq) {
        if ((s & 1) == 0) {
#pragma unroll
            for (int bj = 0; bj < 2; ++bj)
#pragma unroll
                for (int m = 0; m < 4; ++m)
#pragma unroll
                    for (int n = 0; n < 2; ++n) { const f32x4 a = acc[bj][m][n]; u32x2 w; w.x = pk2(a[0], a[1]); w.y = pk2(a[2], a[3]); uu[bj][m][n] = w; }
        } else { const int pn = s >> 1;
#pragma unroll
            for (int m = 0; m < 4; ++m) { bf16* rp = x + (size_t)(u * 128 + wr * 64 + m * 16 + fr) * D + pn * 256 + wc * 32 + 8 * fq; u32x4 xv[2];
#pragma unroll
                for (int bj = 0; bj < 2; ++bj) xv[bj] = *(const u32x4*)(rp + bj * 128);
#pragma unroll
                for (int bj = 0; bj < 2; ++bj) { const u32x4 xw = xv[bj]; f32x4 r[2];
#pragma unroll
                    for (int n = 0; n < 2; ++n) { const u32x2 w = uu[bj][m][n]; f32x4 v = acc[bj][m][n];
                        v[0] = sigmoidf_(v[0]); v[1] = sigmoidf_(v[1]); v[2] = sigmoidf_(v[2]); v[3] = sigmoidf_(v[3]);
                        const f32x4 xo = n == 0 ? (f32x4){bflo(xw.x), bfhi(xw.x), bflo(xw.y), bfhi(xw.y)} : (f32x4){bflo(xw.z), bfhi(xw.z), bflo(xw.w), bfhi(xw.w)};
                        r[n] = xo + (f32x4){bflo(w.x), bfhi(w.x), bflo(w.y), bfhi(w.y)} * v; }
                    *(u32x4*)(rp + bj * 128) = (u32x4){pk2(r[0][0], r[0][1]), pk2(r[0][2], r[0][3]), pk2(r[1][0], r[1][1]), pk2(r[1][2], r[1][3])}; } } }
    }
};
}
namespace epi {
using pg8::Unit; using pg8::BM; using pg8::HALF;
__device__ __forceinline__ void epi_fence() { asm volatile("" ::: "memory"); }
#define EPI_FENCE epi_fence()
#define EPI_LOOP_ROWS for (int ai = 0; ai < 2; ++ai) _Pragma("unroll") for (int m = 0; m < 4; ++m)
#define EPI_LOOP_COLS for (int bj = 0; bj < 2; ++bj) _Pragma("unroll") for (int n = 0; n < 2; ++n)
#define EPI_ROW (u.pm * BM + ai * HALF + wr * 64 + m * 16 + fr)
#define EPI_COLT (bj * HALF + wc * 32 + n * 16 + 4 * fq)
typedef f32x4 acc_t[2][2][4][2];
#define EPI_C8(bj_) ((bj_) * HALF + wc * 32 + 8 * fq)
__device__ __forceinline__ u32x4 pack8(f32x4 a, f32x4 b) { return (u32x4){pk2(a[0], a[1]), pk2(a[2], a[3]), pk2(b[0], b[1]), pk2(b[2], b[3])}; }
__device__ __forceinline__ u32x2 pack4(f32x4 v) { u32x2 w; w.x = pk2(v[0], v[1]); w.y = pk2(v[2], v[3]); return w; }
__device__ __forceinline__ f32x4 unpack4(u32x2 w) { return (f32x4){bflo(w.x), bfhi(w.x), bflo(w.y), bfhi(w.y)}; }

struct EpiStore {
    static constexpr bool PERM = true;
    bf16* O; int ldc; int pn0;
    __device__ __forceinline__ void operator()(const acc_t& acc, const Unit& u, int wr, int wc, int fr, int fq) const {
#pragma unroll
        EPI_LOOP_ROWS { bf16* rp = O + (size_t)EPI_ROW * ldc + (u.pn - pn0) * BM + wc * 32 + 8 * fq;
#pragma unroll
            for (int bj = 0; bj < 2; ++bj) { const u32x2 lo = pack4(acc[ai][bj][m][0]), hi = pack4(acc[ai][bj][m][1]); *(u32x4*)(rp + bj * HALF) = (u32x4){lo.x, lo.y, hi.x, hi.y}; } }
    }
};
struct EpiRowScale {
    static constexpr bool PERM = true;
    bf16* O; int ldc; const float* rs;
    __device__ __forceinline__ void operator()(const acc_t& acc, const Unit& u, int wr, int wc, int fr, int fq) const {
        float sv[2][4];
#pragma unroll
        EPI_LOOP_ROWS sv[ai][m] = rs[EPI_ROW];
#pragma unroll
        EPI_LOOP_ROWS { const int row = EPI_ROW; const float s = sv[ai][m]; bf16* rp = O + (size_t)row * ldc + u.pn * BM;
#pragma unroll
            for (int bj = 0; bj < 2; ++bj) *(u32x4*)(rp + EPI_C8(bj)) = pack8(acc[ai][bj][m][0] * s, acc[ai][bj][m][1] * s); }
    }
};
struct EpiMlaQ {
    static constexpr bool PERM = false;
    bf16* O; const float* rs; const float* cosT; const float* sinT;
    __device__ __forceinline__ void operator()(const acc_t& acc, const Unit& u, int wr, int wc, int fr, int fq) const {
        float sv[2][4]; f32x4 csv[2], snv[2];
#pragma unroll
        EPI_LOOP_ROWS sv[ai][m] = rs[EPI_ROW];
        { const int row = u.pm * BM + wr * 64 + fr; csv[0] = *(const f32x4*)(cosT + (size_t)row * 16 + 4 * fq); snv[0] = *(const f32x4*)(sinT + (size_t)row * 16 + 4 * fq); }
#pragma unroll
        for (int it = 0; it < 8; ++it) { const int ai = it >> 2, m = it & 3;
            if (it + 1 < 8) { const int row = u.pm * BM + ((it + 1) >> 2) * HALF + wr * 64 + ((it + 1) & 3) * 16 + fr;
                csv[(it + 1) & 1] = *(const f32x4*)(cosT + (size_t)row * 16 + 4 * fq); snv[(it + 1) & 1] = *(const f32x4*)(sinT + (size_t)row * 16 + 4 * fq); }
            const int row = EPI_ROW; const float s = sv[ai][m]; bf16* rp = O + (size_t)row * 512 + u.pn * BM;
            const f32x4 cs = csv[it & 1], sn = snv[it & 1];
#pragma unroll
            for (int bj = 0; bj < 2; ++bj) { const int grp = u.pn * 8 + bj * 4 + wc;
                f32x4 t1 = acc[ai][bj][m][0] * s, t2 = acc[ai][bj][m][1] * s;
                if (grp % 3 == 2) { const f32x4 a = t1 * cs - t2 * sn, b = t2 * cs + t1 * sn; t1 = a; t2 = b; }
                *(u32x2*)(rp + bj * HALF + wc * 32 + 4 * fq) = pack4(t1); *(u32x2*)(rp + bj * HALF + wc * 32 + 16 + 4 * fq) = pack4(t2); } }
    }
};
struct EpiGate {
    static constexpr bool PERM = false;
    bf16* G; const float* bias;
    __device__ __forceinline__ void operator()(const acc_t& acc, const Unit& u, int wr, int wc, int fr, int fq) const {
        f32x4 bv[2][2];
#pragma unroll
        EPI_LOOP_COLS bv[bj][n] = *(const f32x4*)(bias + u.pn * BM + EPI_COLT);
#pragma unroll
        EPI_LOOP_ROWS { bf16* rp = G + (size_t)EPI_ROW * D + u.pn * BM;
#pragma unroll
            EPI_LOOP_COLS { f32x4 v = acc[ai][bj][m][n] + bv[bj][n];
                v[0] = sigmoidf_(v[0]); v[1] = sigmoidf_(v[1]); v[2] = sigmoidf_(v[2]); v[3] = sigmoidf_(v[3]);
                *(u32x2*)(rp + EPI_COLT) = pack4(v); } }
    }
};
#define EPI_IT_ROW(it_) (u.pm * BM + ((it_) >> 2) * HALF + wr * 64 + ((it_) & 3) * 16 + fr)
#define EPI_C4(c_) (((c_) >> 1) * HALF + wc * 32 + ((c_) & 1) * 16 + 4 * fq)
struct EpiMerge {
    static constexpr bool PERM = false;
    const bf16* G; bf16* M; int first;
    __device__ __forceinline__ void operator()(const acc_t& acc, const Unit& u, int wr, int wc, int fr, int fq) const {
        u32x2 gv[2][4], mv[2][4];
#define EPI_LD(it_) do { const size_t ro_ = (size_t)EPI_IT_ROW(it_) * D + u.pn * BM; _Pragma("unroll") for (int c = 0; c < 4; ++c) { gv[(it_) & 1][c] = *(const u32x2*)(G + ro_ + EPI_C4(c)); \
            mv[(it_) & 1][c] = first ? (u32x2){0u, 0u} : *(const u32x2*)(M + ro_ + EPI_C4(c)); } } while (0)
        EPI_LD(0);
#pragma unroll
        for (int it = 0; it < 8; ++it) { if (it + 1 < 8) EPI_LD(it + 1);
            const size_t ro = (size_t)EPI_IT_ROW(it) * D + u.pn * BM;
#pragma unroll
            for (int c = 0; c < 4; ++c) { const f32x4 v = unpack4(gv[it & 1][c]) * acc[it >> 2][c >> 1][it & 3][c & 1] + unpack4(mv[it & 1][c]); *(u32x2*)(M + ro + EPI_C4(c)) = pack4(v); } }
#undef EPI_LD
    }
};
struct EpiRes {
    static constexpr bool PERM = true;
    XSrc xin; bf16* xout;
    __device__ __forceinline__ void operator()(const acc_t& acc, const Unit& u, int wr, int wc, int fr, int fq) const {
        f32x4 xv[2][2][2];
#define EPI_LD(it_) do { const size_t ro_ = (size_t)EPI_IT_ROW(it_) * D + u.pn * BM; _Pragma("unroll") for (int bj = 0; bj < 2; ++bj) { \
            if (xin.f) { xv[(it_) & 1][bj][0] = *(const f32x4*)(xin.f + ro_ + EPI_C8(bj)); xv[(it_) & 1][bj][1] = *(const f32x4*)(xin.f + ro_ + EPI_C8(bj) + 4); } \
            else { const u32x4 w_ = *(const u32x4*)(xin.b + ro_ + EPI_C8(bj)); xv[(it_) & 1][bj][0] = (f32x4){bflo(w_.x), bfhi(w_.x), bflo(w_.y), bfhi(w_.y)}; xv[(it_) & 1][bj][1] = (f32x4){bflo(w_.z), bfhi(w_.z), bflo(w_.w), bfhi(w_.w)}; } } } while (0)
        EPI_LD(0);
#pragma unroll
        for (int it = 0; it < 8; ++it) { if (it + 1 < 8) EPI_LD(it + 1);
            const size_t ro = (size_t)EPI_IT_ROW(it) * D + u.pn * BM;
#pragma unroll
            for (int bj = 0; bj < 2; ++bj) *(u32x4*)(xout + ro + EPI_C8(bj)) = pack8(xv[it & 1][bj][0] + acc[it >> 2][bj][it & 3][0], xv[it & 1][bj][1] + acc[it >> 2][bj][it & 3][1]); }
#undef EPI_LD
    }
};
struct EpiPle {
    static constexpr bool PERM = false;
    const bf16* U; float* x;
    __device__ __forceinline__ void operator()(const acc_t& acc, const Unit& u, int wr, int wc, int fr, int fq) const {
        f32x4 xv[2][4]; u32x2 uv[2][4];
#define EPI_LD(it_) do { const size_t ro_ = (size_t)EPI_IT_ROW(it_) * D + u.pn * BM; _Pragma("unroll") for (int c = 0; c < 4; ++c) { xv[(it_) & 1][c] = *(const f32x4*)(x + ro_ + EPI_C4(c)); uv[(it_) & 1][c] = *(const u32x2*)(U + ro_ + EPI_C4(c)); } } while (0)
        EPI_LD(0);
#pragma unroll
        for (int it = 0; it < 8; ++it) { if (it + 1 < 8) EPI_LD(it + 1);
            const size_t ro = (size_t)EPI_IT_ROW(it) * D + u.pn * BM;
#pragma unroll
            for (int c = 0; c < 4; ++c) { f32x4 v = acc[it >> 2][c >> 1][it & 3][c & 1];
                v[0] = sigmoidf_(v[0]); v[1] = sigmoidf_(v[1]); v[2] = sigmoidf_(v[2]); v[3] = sigmoidf_(v[3]);
                *(f32x4*)(x + ro + EPI_C4(c)) = xv[it & 1][c] + unpack4(uv[it & 1][c]) * v; } }
#undef EPI_LD
    }
};
struct EpiSwiglu {
    static constexpr bool PERM = true;
    bf16* O; int ldc; int npt;
    __device__ __forceinline__ void operator()(const acc_t& acc, const Unit& u, int wr, int wc, int fr, int fq) const {
        const int ct = (u.pn % npt) * HALF;
#pragma unroll
        EPI_LOOP_ROWS { bf16* rp = O + (size_t)EPI_ROW * ldc + ct + wc * 32 + 8 * fq; u32x2 w[2];
#pragma unroll
            for (int n = 0; n < 2; ++n) { const f32x4 a = acc[ai][0][m][n], b = acc[ai][1][m][n]; f32x4 v;
#pragma unroll
                for (int e = 0; e < 4; ++e) v[e] = a[e] * sigmoidf_(a[e]) * b[e];
                w[n] = pack4(v); }
            *(u32x4*)rp = (u32x4){w[0].x, w[0].y, w[1].x, w[1].y}; }
    }
};
struct EpiGlu {
    static constexpr bool PERM = true;
    bf16* Y; int ldc;
    __device__ __forceinline__ void operator()(const acc_t& acc, const Unit& u, int wr, int wc, int fr, int fq) const {
        u32x4 yv[2][2];
#define EPI_LD(it_) do { const bf16* rp_ = Y + (size_t)EPI_IT_ROW(it_) * ldc + u.pn * BM; _Pragma("unroll") for (int bj = 0; bj < 2; ++bj) yv[(it_) & 1][bj] = *(const u32x4*)(rp_ + EPI_C8(bj)); } while (0)
        EPI_LD(0);
#pragma unroll
        for (int it = 0; it < 8; ++it) { if (it + 1 < 8) EPI_LD(it + 1);
            bf16* rp = Y + (size_t)EPI_IT_ROW(it) * ldc + u.pn * BM;
#pragma unroll
            for (int bj = 0; bj < 2; ++bj) { const u32x4 w = yv[it & 1][bj]; f32x4 a = acc[it >> 2][bj][it & 3][0], b = acc[it >> 2][bj][it & 3][1];
                a[0] = bflo(w.x) * sigmoidf_(a[0]); a[1] = bfhi(w.x) * sigmoidf_(a[1]); a[2] = bflo(w.y) * sigmoidf_(a[2]); a[3] = bfhi(w.y) * sigmoidf_(a[3]);
                b[0] = bflo(w.z) * sigmoidf_(b[0]); b[1] = bfhi(w.z) * sigmoidf_(b[1]); b[2] = bflo(w.w) * sigmoidf_(b[2]); b[3] = bfhi(w.w) * sigmoidf_(b[3]);
                *(u32x4*)(rp + EPI_C8(bj)) = pack8(a, b); } }
#undef EPI_LD
    }
};
struct EpiMoeDown {
    static constexpr bool PERM = true;
    bf16* Y; const float* slot_gate;
    __device__ __forceinline__ void operator()(const acc_t& acc, const Unit& u, int wr, int wc, int fr, int fq) const {
        const int ct = (u.pn & 3) * BM;
        float gv[2][4];
#pragma unroll
        EPI_LOOP_ROWS gv[ai][m] = slot_gate[EPI_ROW];
#pragma unroll
        EPI_LOOP_ROWS { const int row = EPI_ROW; const float gt = gv[ai][m]; bf16* rp = Y + (size_t)row * D + ct;
#pragma unroll
            for (int bj = 0; bj < 2; ++bj) *(u32x4*)(rp + EPI_C8(bj)) = pack8(acc[ai][bj][m][0] * gt, acc[ai][bj][m][1] * gt); }
    }
};
}
namespace att {
constexpr int MODE_FOX = 0, MODE_MLA = 1, MODE_BAND = 2;
constexpr float LOG2E = 1.4426950408889634f;
struct Tensors {
    const bf16* Q; int ldq;
    const bf16* K; int ldk;
    const bf16* K2;
    const bf16* V; int ldv;
    bf16* O; int ldo;
    const float* cdec;
    const float* relb;
    int qhs, khs, vhs, ohs;
    const unsigned* qmax; const unsigned* kmax;
};
template <int DQK> struct Lay { static constexpr int KS = DQK * 2 + 16, KB = 64 * KS, VB = 64 * 128, CB = 256, BUF = KB + VB + CB; };
constexpr int ATT_LDS_TAB = 2 * Lay<96>::BUF;
constexpr int ATT_LDS_BYTES = ATT_LDS_TAB + 520 * 4;
__device__ __forceinline__ int crow(int r, int hi) { return (r & 3) + 8 * (r >> 2) + 4 * hi; }
typedef short v4i16_t __attribute__((ext_vector_type(4)));
__device__ __forceinline__ s16x4 vtr(const LAS unsigned char* p) { return __builtin_bit_cast(s16x4, __builtin_amdgcn_ds_read_tr16_b64_v4i16((LAS v4i16_t*)p)); }

template <int MODE>
__device__ __forceinline__ void attn_unit(const Tensors& T, int b, int h, int qb, LAS unsigned char* lds) {
    constexpr int DQK = (MODE == MODE_MLA) ? 96 : 64, NKS = DQK / 16;
    typedef Lay<DQK> LY;
    int tid = my_tid(); asm volatile("" : "+v"(tid));
    const int lane = tid & 63, r32 = lane & 31, hi = lane >> 5; const int wid = __builtin_amdgcn_readfirstlane(tid >> 6);
    const int rowb = b * SEQ, q0 = qb * 256;
    const float sc2 = ((MODE == MODE_MLA) ? 0.10206207261596575f : 0.125f) * LOG2E;
    const int cw = 4 * qb + (wid >> 1);
    const int t_lo = (MODE == MODE_BAND) ? ((4 * qb - 8) > 0 ? (4 * qb - 8) : 0) : 0, t_hi = 4 * qb + 4;
    const int qrow = rowb + q0 + wid * 32 + r32;
    bf16x8 qf[NKS];
    { const bf16* qp = T.Q + (size_t)qrow * T.ldq + h * T.qhs + hi * 8;
#pragma unroll
      for (int ks = 0; ks < NKS; ++ks) qf[ks] = *(const bf16x8*)(qp + ks * 16); }
    float cq = 0.f; if (MODE == MODE_FOX) cq = T.cdec[(size_t)qrow * 4 + h];
    LAS float* tab = (LAS float*)(lds + ATT_LDS_TAB);
    if (MODE == MODE_BAND) { for (int i = tid; i < 513; i += NTHREADS) tab[i] = T.relb[h * 513 + i] * LOG2E; }
    u32x4 kreg0[2] = {}, kreg1[2] = {}, vreg[2] = {}; float creg[2] = {0.f, 0.f};
    const int srow = tid >> 3, sch = tid & 7;
#define ATT_KADDR(c_) (((c_) % 12 < 8) ? (const u32x4*)(T.K + (kr_ + (c_) / 12) * T.ldk + h * T.khs + ((c_) % 12) * 8) : (const u32x4*)(T.K2 + (kr_ + (c_) / 12) * 32 + ((c_) % 12 - 8) * 8))
#define ATT_LOAD_TILE(t_, r_) do { const size_t kr_ = (size_t)(rowb + (t_) * 64); \
        if (MODE == MODE_MLA) { kreg0[r_] = *ATT_KADDR(tid); if (tid < 256) kreg1[r_] = *ATT_KADDR(tid + 512); } \
        else { kreg0[r_] = *(const u32x4*)(T.K + (kr_ + srow) * T.ldk + h * T.khs + sch * 8); } \
        vreg[r_] = *(const u32x4*)(T.V + (kr_ + srow) * T.ldv + h * T.vhs + sch * 8); \
        if (MODE == MODE_FOX) { if (tid < 64) creg[r_] = T.cdec[(kr_ + tid) * 4 + h]; } } while (0)
#define ATT_STORE_TILE(buf_, r_) do { LAS unsigned char* base_ = lds + (buf_) * LY::BUF; \
        if (MODE == MODE_MLA) { *(LAS u32x4*)(base_ + (tid / 12) * LY::KS + (tid % 12) * 16) = kreg0[r_]; \
            if (tid < 256) *(LAS u32x4*)(base_ + ((tid + 512) / 12) * LY::KS + ((tid + 512) % 12) * 16) = kreg1[r_]; } \
        else { *(LAS u32x4*)(base_ + srow * LY::KS + sch * 16) = kreg0[r_]; } \
        *(LAS u32x4*)(base_ + LY::KB + srow * 128 + ((sch * 16) ^ (((srow >> 1) & 1) << 6))) = vreg[r_]; \
        if (MODE == MODE_FOX) { if (tid < 64) *(LAS float*)(base_ + LY::KB + LY::VB + tid * 4) = creg[r_]; } } while (0)
    float mrun = -INFINITY, lrun = 0.f;
    f32x16 o0 = {}, o1 = {};
    const int G = lane >> 4, qi = (lane & 15) >> 2, pi = lane & 3;
    const int vb0 = (4 * hi + qi) * 128 + 64 * (0 ^ (qi >> 1)) + 32 * (G & 1) + 8 * pi;
    const int vb1 = (4 * hi + qi) * 128 + 64 * (1 ^ (qi >> 1)) + 32 * (G & 1) + 8 * pi;
    int t_min = t_lo;
    if (MODE == MODE_FOX) {
        LAS int* tm = (LAS int*)(lds + ATT_LDS_TAB);
        if (tid == 0) tm[0] = t_hi - 1;
        __syncthreads();
        if (tid < t_hi) {
            const float q2 = __uint_as_float(T.qmax[(b * 4 + h) * 32 + qb]), k2 = __uint_as_float(T.kmax[b * 4 + h]);
            const float thr = 0.125f * sqrtf(q2) * 2.0f * sqrtf(k2) * 1.02f + 112.0f;
            const float cfirst = T.cdec[(size_t)(rowb + q0) * 4 + h], clast = T.cdec[(size_t)(rowb + tid * 64 + 63) * 4 + h];
            if (!(clast - cfirst > thr)) __hip_atomic_fetch_min(tm, tid, __ATOMIC_RELAXED, __HIP_MEMORY_SCOPE_WORKGROUP);
        }
        __syncthreads();
        t_min = tm[0];
    }
    const int n_t = t_hi - t_min;
#define ATT_TILE(i_) ((MODE == MODE_FOX) ? (t_hi - 1 - (i_)) : (t_min + (i_)))
    ATT_LOAD_TILE(ATT_TILE(0), 0); ATT_STORE_TILE(0, 0);
    if (n_t > 1) ATT_LOAD_TILE(ATT_TILE(1), 1);
    if (n_t > 2) ATT_LOAD_TILE(ATT_TILE(2), 0);
    __syncthreads();
    for (int it0 = 0; it0 < n_t; it0 += 2) {
#pragma unroll
      for (int half = 0; half < 2; ++half) { const int it = it0 + half; if (it < n_t) {
        const int t = ATT_TILE(it);
        const int buf = half;
        const bool active = (MODE == MODE_BAND) ? (t <= cw && t >= cw - 8) : (t <= cw);
        if (active) {
            const LAS unsigned char* kb = lds + buf * LY::BUF;
            const LAS unsigned char* vbuf = kb + LY::KB;
            f32x16 p0 = {}, p1 = {};
            bf16x8 ka[NKS], kc[NKS];
#pragma unroll
            for (int ks = 0; ks < NKS; ++ks) { ka[ks] = *(const LAS bf16x8*)(kb + r32 * LY::KS + (ks * 16 + hi * 8) * 2); kc[ks] = *(const LAS bf16x8*)(kb + (32 + r32) * LY::KS + (ks * 16 + hi * 8) * 2); }
            __builtin_amdgcn_sched_barrier(0);
#pragma unroll
            for (int ks = 0; ks < NKS; ++ks) { p0 = __builtin_amdgcn_mfma_f32_32x32x16_bf16(ka[ks], qf[ks], p0, 0, 0, 0); p1 = __builtin_amdgcn_mfma_f32_32x32x16_bf16(kc[ks], qf[ks], p1, 0, 0, 0); }
            s16x4 vl0[4], vh0[4], vl1[4], vh1[4];
#pragma unroll
            for (int s4 = 0; s4 < 4; ++s4) { vl0[s4] = vtr(vbuf + vb0 + s4 * 2048); vh0[s4] = vtr(vbuf + vb0 + s4 * 2048 + 1024); vl1[s4] = vtr(vbuf + vb1 + s4 * 2048); vh1[s4] = vtr(vbuf + vb1 + s4 * 2048 + 1024); }
            __builtin_amdgcn_sched_barrier(0);
            if (MODE == MODE_FOX) {
                const LAS float* cb = (const LAS float*)(vbuf + LY::VB);
                const float cq2 = cq * LOG2E;
#pragma unroll
                for (int a = 0; a < 4; ++a) {
                    const f32x4 c0 = *(const LAS f32x4*)(cb + 8 * a + 4 * hi), c1 = *(const LAS f32x4*)(cb + 32 + 8 * a + 4 * hi);
#pragma unroll
                    for (int e = 0; e < 4; ++e) { p0[4 * a + e] = p0[4 * a + e] * sc2 + (cq2 - c0[e] * LOG2E); p1[4 * a + e] = p1[4 * a + e] * sc2 + (cq2 - c1[e] * LOG2E); }
                }
                if (t == cw) { const int ql = 32 * (wid & 1) + r32;
#pragma unroll
                    for (int r = 0; r < 16; ++r) { const int kv = crow(r, hi); if (kv > ql) p0[r] = -INFINITY; if (kv + 32 > ql) p1[r] = -INFINITY; } }
            } else if (MODE == MODE_BAND) {
                const int dq = (q0 + wid * 32 + r32) - t * 64;
#pragma unroll
                for (int r = 0; r < 16; ++r) { const int kv = crow(r, hi);
                    int i0 = dq - kv, i1 = dq - kv - 32; i0 = i0 < -256 ? -256 : (i0 > 256 ? 256 : i0); i1 = i1 < -256 ? -256 : (i1 > 256 ? 256 : i1);
                    p0[r] = p0[r] * sc2 + tab[i0 + 256]; p1[r] = p1[r] * sc2 + tab[i1 + 256]; }
            }
            float mx = fmaxf(p0[0], p1[0]);
#pragma unroll
            for (int r = 1; r < 16; ++r) mx = fmaxf(mx, fmaxf(p0[r], p1[r]));
            { auto rr = __builtin_amdgcn_permlane32_swap(__float_as_uint(mx), __float_as_uint(mx), false, false); mx = fmaxf(__uint_as_float(rr[0]), __uint_as_float(rr[1])); }
            if (MODE == MODE_MLA) mx *= sc2;
            const float mnew = fmaxf(mrun, mx);
            if (__any(mnew > mrun)) {
                const float alpha = __builtin_amdgcn_exp2f(mrun - mnew);
                lrun *= alpha;
#pragma unroll
                for (int r = 0; r < 16; ++r) { o0[r] *= alpha; o1[r] *= alpha; }
                mrun = mnew;
            }
            float rs = 0.f;
#pragma unroll
            for (int r = 0; r < 16; ++r) {
                if (MODE == MODE_MLA) { p0[r] = __builtin_amdgcn_exp2f(__builtin_fmaf(p0[r], sc2, -mrun)); p1[r] = __builtin_amdgcn_exp2f(__builtin_fmaf(p1[r], sc2, -mrun)); }
                else { p0[r] = __builtin_amdgcn_exp2f(p0[r] - mrun); p1[r] = __builtin_amdgcn_exp2f(p1[r] - mrun); }
                rs += p0[r] + p1[r]; }
            lrun += rs;
#pragma unroll
            for (int s4 = 0; s4 < 4; ++s4) {
                u32x4 pw;
                if (s4 < 2) { const int o = 8 * (s4 & 1); pw.x = pk2(p0[o], p0[o + 1]); pw.y = pk2(p0[o + 2], p0[o + 3]); pw.z = pk2(p0[o + 4], p0[o + 5]); pw.w = pk2(p0[o + 6], p0[o + 7]); }
                else        { const int o = 8 * (s4 & 1); pw.x = pk2(p1[o], p1[o + 1]); pw.y = pk2(p1[o + 2], p1[o + 3]); pw.z = pk2(p1[o + 4], p1[o + 5]); pw.w = pk2(p1[o + 6], p1[o + 7]); }
                const bf16x8 pf = __builtin_bit_cast(bf16x8, pw);
                const s16x4 l0 = vl0[s4], h0 = vh0[s4], l1 = vl1[s4], h1 = vh1[s4];
                const bf16x8 vf0 = (bf16x8){l0[0], l0[1], l0[2], l0[3], h0[0], h0[1], h0[2], h0[3]};
                const bf16x8 vf1 = (bf16x8){l1[0], l1[1], l1[2], l1[3], h1[0], h1[1], h1[2], h1[3]};
                o0 = __builtin_amdgcn_mfma_f32_32x32x16_bf16(vf0, pf, o0, 0, 0, 0);
                o1 = __builtin_amdgcn_mfma_f32_32x32x16_bf16(vf1, pf, o1, 0, 0, 0);
            }
        }
        if (it + 1 < n_t) ATT_STORE_TILE(half ^ 1, half ^ 1);
        if (it + 3 < n_t) ATT_LOAD_TILE(ATT_TILE(it + 3), half ^ 1);
        __syncthreads();
      } }
    }
    { auto rr = __builtin_amdgcn_permlane32_swap(__float_as_uint(lrun), __float_as_uint(lrun), false, false); lrun = __uint_as_float(rr[0]) + __uint_as_float(rr[1]); }
    const float inv = 1.0f / lrun;
    bf16* op = T.O + (size_t)qrow * T.ldo + h * T.ohs;
#pragma unroll
    for (int a = 0; a < 4; ++a) {
        u32x2 w0, w1;
        w0.x = pk2(o0[4 * a] * inv, o0[4 * a + 1] * inv); w0.y = pk2(o0[4 * a + 2] * inv, o0[4 * a + 3] * inv);
        w1.x = pk2(o1[4 * a] * inv, o1[4 * a + 1] * inv); w1.y = pk2(o1[4 * a + 2] * inv, o1[4 * a + 3] * inv);
        *(u32x2*)(op + 8 * a + 4 * hi) = w0; *(u32x2*)(op + 32 + 8 * a + 4 * hi) = w1;
    }
}

template <int MODE>
__device__ __forceinline__ void attn_phase(const Tensors& T, LAS unsigned char* lds) {
    const int G = gridDim.x, bx = blockIdx.x, vcu = (G % 8 == 0) ? (bx % 8) * (G / 8) + bx / 8 : bx;
    for (int pr = vcu; pr < 256; pr += G) {
        const int bh = pr >> 4, s = pr & 15;
        attn_unit<MODE>(T, bh >> 2, bh & 3, s, lds);
        attn_unit<MODE>(T, bh >> 2, bh & 3, 31 - s, lds);
    }
}

template <int MODE>
__device__ __forceinline__ void attn_naive(const Tensors& T) {
    BODY_IDS();
    constexpr int DQK = (MODE == MODE_MLA) ? 96 : 64;
    const float sc = (MODE == MODE_MLA) ? 0.10206207261596575f : 0.125f;
    for (int idx = gtid; idx < NTOK * 4; idx += gthreads) {
        const int h = idx / NTOK, row = idx % NTOK, b = row / SEQ, tpos = row % SEQ, rowb = b * SEQ;
        float q[DQK], o[64];
#pragma unroll
        for (int d = 0; d < DQK; ++d) q[d] = bf2f(T.Q[(size_t)row * T.ldq + h * T.qhs + d]) * sc;
#pragma unroll
        for (int d = 0; d < 64; ++d) o[d] = 0.f;
        float m = -INFINITY, l = 0.f;
        const int ck = tpos / 64;
        const int k_lo = (MODE == MODE_BAND) ? ((ck - 8) > 0 ? (ck - 8) * 64 : 0) : 0;
        const int k_hi = (MODE == MODE_FOX) ? tpos : (ck * 64 + 63);
        const float cq = (MODE == MODE_FOX) ? T.cdec[(size_t)row * 4 + h] : 0.f;
        for (int kv = k_lo; kv <= k_hi; ++kv) {
            const size_t kr = (size_t)(rowb + kv);
            float s = 0.f;
#pragma unroll
            for (int d8 = 0; d8 < 8; ++d8) { const u32x4 w = *(const u32x4*)(T.K + kr * T.ldk + h * T.khs + d8 * 8);
                s += q[d8 * 8 + 0] * bflo(w.x) + q[d8 * 8 + 1] * bfhi(w.x) + q[d8 * 8 + 2] * bflo(w.y) + q[d8 * 8 + 3] * bfhi(w.y)
                   + q[d8 * 8 + 4] * bflo(w.z) + q[d8 * 8 + 5] * bfhi(w.z) + q[d8 * 8 + 6] * bflo(w.w) + q[d8 * 8 + 7] * bfhi(w.w); }
            if (MODE == MODE_MLA) {
#pragma unroll
                for (int d8 = 0; d8 < 4; ++d8) { const u32x4 w = *(const u32x4*)(T.K2 + kr * 32 + d8 * 8);
                    s += q[64 + d8 * 8 + 0] * bflo(w.x) + q[64 + d8 * 8 + 1] * bfhi(w.x) + q[64 + d8 * 8 + 2] * bflo(w.y) + q[64 + d8 * 8 + 3] * bfhi(w.y)
                       + q[64 + d8 * 8 + 4] * bflo(w.z) + q[64 + d8 * 8 + 5] * bfhi(w.z) + q[64 + d8 * 8 + 6] * bflo(w.w) + q[64 + d8 * 8 + 7] * bfhi(w.w); }
            }
            if (MODE == MODE_FOX) s += cq - T.cdec[kr * 4 + h];
            if (MODE == MODE_BAND) { int rel = tpos - kv; rel = rel < -256 ? -256 : (rel > 256 ? 256 : rel); s += T.relb[h * 513 + rel + 256]; }
            const float mn = fmaxf(m, s), al = __expf(m - mn), pp = __expf(s - mn);
            l = l * al + pp; m = mn;
#pragma unroll
            for (int d8 = 0; d8 < 8; ++d8) { const u32x4 w = *(const u32x4*)(T.V + kr * T.ldv + h * T.vhs + d8 * 8);
                o[d8 * 8 + 0] = o[d8 * 8 + 0] * al + pp * bflo(w.x); o[d8 * 8 + 1] = o[d8 * 8 + 1] * al + pp * bfhi(w.x);
                o[d8 * 8 + 2] = o[d8 * 8 + 2] * al + pp * bflo(w.y); o[d8 * 8 + 3] = o[d8 * 8 + 3] * al + pp * bfhi(w.y);
                o[d8 * 8 + 4] = o[d8 * 8 + 4] * al + pp * bflo(w.z); o[d8 * 8 + 5] = o[d8 * 8 + 5] * al + pp * bfhi(w.z);
                o[d8 * 8 + 6] = o[d8 * 8 + 6] * al + pp * bflo(w.w); o[d8 * 8 + 7] = o[d8 * 8 + 7] * al + pp * bfhi(w.w); }
        }
        const float inv = 1.0f / l;
#pragma unroll
        for (int d = 0; d < 64; d += 2) *(unsigned*)(T.O + (size_t)row * T.ldo + h * T.ohs + d) = pk2(o[d] * inv, o[d + 1] * inv);
    }
}
}
struct Params {
    const float* in[37];
    float* out;
    unsigned char* ws;
    int ph_lo, ph_hi;
};
enum { I_X = 0, I_P, I_POS, I_WIN, I_SAR, I_SAI, I_SLDT, I_SBR, I_SBI, I_SCR, I_SCI, I_SD, I_SGLU, I_FBF, I_GQ, I_WUQ, I_GKV, I_WUKV, I_RELB, I_WB, I_WG, I_BG, I_WO,
       I_GMIX, I_GFFN, I_FW1, I_FW3, I_FW2, I_MWR, I_MBR, I_MW1, I_MW3, I_MW2, I_GPLE, I_PWG, I_PWU, I_GFIN };

__device__ __forceinline__ void sincos_rad(double a, float& s, float& c) {
    double r = a * 0.15915494309189535; r = r - __builtin_rint(r); const float f = (float)r;
    s = __builtin_amdgcn_sinf(f); c = __builtin_amdgcn_cosf(f);
}
__device__ __forceinline__ float gelu_tanh(float x) {
    const float z = 0.7978845608028654f * (x + 0.044715f * x * x * x);
    const float e = __expf(2.0f * z); const float th = 1.0f - 2.0f / (1.0f + e);
    return 0.5f * x * (1.0f + th);
}
__device__ __forceinline__ float log_sigmoid(float z) { return fminf(z, 0.f) - log1pf(__expf(-fabsf(z))); }

struct CvtJob { const float* src; const float* ks; bf16* dst; int K, ldsrc, col0, ncols, row0, ldk, ilv; };
__device__ __forceinline__ void cvt_item(const CvtJob& J, LAS float* scr, int item, int lane) {
    const int nblk = (J.ncols + 63) >> 6, kb = item / nblk, nb = item % nblk, k0 = 64 * kb, n0 = 64 * nb;
    const int n4 = (lane & 15) * 4; const bool inb = (n0 + n4) < J.ncols;
#pragma unroll 8
    for (int i = 0; i < 16; ++i) { const int kk = 4 * i + (lane >> 4); f32x4 v = {0.f, 0.f, 0.f, 0.f};
        if (inb) v = *(const f32x4*)(J.src + (size_t)(k0 + kk) * J.ldsrc + J.col0 + n0 + n4);
        if (J.ks) v = v * J.ks[k0 + kk];
        *(LAS f32x4*)(scr + kk * 68 + n4) = v; }
    LDS_WAIT(); asm volatile("" ::: "memory");
    const int c = lane & 7;
#pragma unroll
    for (int j = 0; j < 8; ++j) { const int n = (lane >> 3) + 8 * j; const LAS float* s = scr + (8 * c) * 68 + n;
        u32x4 o; o.x = pk2(s[0 * 68], s[1 * 68]); o.y = pk2(s[2 * 68], s[3 * 68]); o.z = pk2(s[4 * 68], s[5 * 68]); o.w = pk2(s[6 * 68], s[7 * 68]);
        const int nn = n0 + n; const int row = J.row0 + (J.ilv ? ((nn >> 7) * 256 + (nn & 127)) : nn);
        if (nn < J.ncols) *(u32x4*)(J.dst + (size_t)row * J.ldk + k0 + 8 * c) = o; }
    LDS_WAIT(); asm volatile("" ::: "memory");
}
__device__ __forceinline__ bf16* wmix(const Params& P, int L, size_t off) { return (bf16*)(P.ws + WS_WMIX + (size_t)L * WMIX_STRIDE + off); }
__device__ __forceinline__ CvtJob get_job(const Params& P, int j) {
    CvtJob J; J.ks = nullptr; J.ilv = 0; J.col0 = 0; J.row0 = 0;
    if (j < 40) {
        const int L = j / 20, q = j % 20;
        if (q < 5) {
            J.src = P.in[I_WIN] + (size_t)L * D * DIN; J.K = D; J.ldsrc = DIN; J.dst = wmix(P, L, WM_IN); J.ldk = D;
            J.col0 = q == 0 ? 0 : q == 1 ? 1380 : q == 2 ? 1028 : q == 3 ? 1220 : 1348;
            J.ncols = q == 0 ? 1024 : q == 1 ? 768 : q == 2 ? 192 : q == 3 ? 128 : 32;
            J.row0 = q == 0 ? 0 : q == 1 ? 1024 : q == 2 ? 1792 : q == 3 ? 2048 : 2176;
        } else if (q < 9) { const int k = q - 5; J.src = P.in[I_WG] + ((size_t)L * 4 + k) * D * D; J.K = D; J.ldsrc = D; J.ncols = D; J.row0 = k * D; J.dst = wmix(P, L, WM_G); J.ldk = D;
        } else if (q < 13) { const int k = q - 9; J.src = P.in[I_WB] + ((size_t)L * 4 + k) * 256 * D; J.K = 256; J.ldsrc = D; J.ncols = D; J.row0 = k * D; J.dst = wmix(P, L, WM_B); J.ldk = 256;
        } else if (q == 13) { J.src = P.in[I_WO] + (size_t)L * D * D; J.K = D; J.ldsrc = D; J.ncols = D; J.dst = wmix(P, L, WM_O); J.ldk = D;
        } else if (q == 14) { J.src = P.in[I_PWG] + (size_t)L * D * D; J.K = D; J.ldsrc = D; J.ncols = D; J.dst = wmix(P, L, WM_PG); J.ldk = D;
        } else if (q == 15) { J.src = P.in[I_PWU] + (size_t)L * 256 * D; J.K = 256; J.ldsrc = D; J.ncols = D; J.dst = wmix(P, L, WM_UP); J.ldk = 256;
        } else if (q == 16) { J.src = P.in[I_WUQ] + (size_t)L * 192 * 384; J.ks = P.in[I_GQ] + L * 192; J.K = 192; J.ldsrc = 384; J.ncols = 384; J.dst = wmix(P, L, WM_UQ); J.ldk = 256;
        } else if (q == 17) { J.src = P.in[I_WUKV] + (size_t)L * 128 * 512; J.ks = P.in[I_GKV] + L * 128; J.K = 128; J.ldsrc = 512; J.ncols = 512; J.dst = wmix(P, L, WM_UKV); J.ldk = 128;
        } else if (q == 18) { J.src = P.in[I_SGLU] + (size_t)L * 256 * 256; J.K = 256; J.ldsrc = 256; J.ncols = 256; J.dst = wmix(P, L, WM_GLU); J.ldk = 256;
        } else { J.src = nullptr; J.K = 0; J.ldsrc = 0; J.ncols = 32; J.dst = nullptr; J.ldk = 0; }
    } else if (j < 43) {
        const int q = j - 40;
        if (q == 0) { J.src = P.in[I_FW1]; J.K = D; J.ldsrc = DFF; J.ncols = DFF; J.dst = (bf16*)(P.ws + WS_W13); J.ldk = D; J.ilv = 1; }
        else if (q == 1) { J.src = P.in[I_FW3]; J.K = D; J.ldsrc = DFF; J.ncols = DFF; J.row0 = 128; J.dst = (bf16*)(P.ws + WS_W13); J.ldk = D; J.ilv = 1; }
        else { J.src = P.in[I_FW2]; J.K = DFF; J.ldsrc = D; J.ncols = D; J.dst = (bf16*)(P.ws + WS_W2); J.ldk = DFF; }
    } else {
        const int e = (j - 43) / 3, q = (j - 43) % 3;
        if (q == 0) { J.src = P.in[I_MW1] + (size_t)e * D * DFFE; J.K = D; J.ldsrc = DFFE; J.ncols = DFFE; J.row0 = e * 2816; J.dst = (bf16*)(P.ws + WS_WM13); J.ldk = D; J.ilv = 1; }
        else if (q == 1) { J.src = P.in[I_MW3] + (size_t)e * D * DFFE; J.K = D; J.ldsrc = DFFE; J.ncols = DFFE; J.row0 = e * 2816 + 128; J.dst = (bf16*)(P.ws + WS_WM13); J.ldk = D; J.ilv = 1; }
        else { J.src = P.in[I_MW2] + (size_t)e * DFFE * D; J.K = DFFE; J.ldsrc = D; J.ncols = D; J.row0 = e * D; J.dst = (bf16*)(P.ws + WS_WM2); J.ldk = DFFE; }
    }
    return J;
}
__device__ __forceinline__ void cvt_jobs(const Params& P, int j_lo, int j_hi, LAS unsigned char* lds) {
    BODY_IDS();
    LAS float* scr = (LAS float*)(lds + wave * 17408);
    int acc = 0;
    for (int j = j_lo; j < j_hi; ++j) {
        const CvtJob J = get_job(P, j);
        const int items = (J.K / 64) * ((J.ncols + 63) >> 6);
        int first = (gw - (acc % ngw) + ngw) % ngw;
        for (int it = first; it < items; it += ngw) cvt_item(J, scr, it, lane);
        acc += items;
    }
}

__device__ __forceinline__ void p0_misc(const Params& P) {
    BODY_IDS();
    { const f32x4* src = (const f32x4*)P.in[I_P]; u32x2* dst = (u32x2*)(P.ws + WS_PBF);
      for (int i = gtid; i < 2 * NTOK * 256 / 4; i += gthreads) { const f32x4 v = src[i]; u32x2 w; w.x = pk2(v[0], v[1]); w.y = pk2(v[2], v[3]); dst[i] = w; } }
    { const int* pos = (const int*)P.in[I_POS]; float* ct = (float*)(P.ws + WS_COS); float* st = (float*)(P.ws + WS_SIN);
      const double invf[16] = {1.0, 0.5623413251903491, 0.31622776601683794, 0.1778279410038923, 0.1, 0.05623413251903491, 0.03162277660168379, 0.01778279410038923,
                               0.01, 0.005623413251903491, 0.0031622776601683794, 0.0017782794100389228, 0.001, 0.0005623413251903491, 0.00031622776601683794, 0.00017782794100389227};
      for (int i = gtid; i < NTOK * 16; i += gthreads) { const int row = i >> 4, f = i & 15; double iv = invf[0];
#pragma unroll
          for (int q = 1; q < 16; ++q) iv = (f == q) ? invf[q] : iv;
          const float ang = (float)pos[row] * (float)iv; float s, c; sincos_rad((double)ang, s, c); ct[i] = c; st[i] = s; } }
    for (int L = 0; L < 2; ++L) {
        bf16* win = wmix(P, L, WM_IN);
        for (int i = gtid; i < (64 + 96) * D / 8; i += gthreads) { const int e = i * 8, r = e / D, k = e % D; const int row = r < 64 ? 1984 + r : 2208 + (r - 64); *(u32x4*)(win + (size_t)row * D + k) = (u32x4){0u, 0u, 0u, 0u}; }
        bf16* wuq = wmix(P, L, WM_UQ);
        for (int i = gtid; i < 512 * 256 / 8; i += gthreads) { const int e = i * 8, r = e / 256, k = e % 256; if (r >= 384 || k >= 192) *(u32x4*)(wuq + e) = (u32x4){0u, 0u, 0u, 0u}; }
    }
}

__device__ __forceinline__ void rms_load(const XSrc& x, int row, int lane, f32x4 (&v)[4]) {
#pragma unroll
    for (int j = 0; j < 4; ++j) v[j] = ldx4(x, (size_t)row * D + 4 * lane + 256 * j);
}
__device__ __forceinline__ void rms_finish(const float* gain, bf16* orow, int lane, f32x4 (&v)[4]) {
    float s = 0.f;
#pragma unroll
    for (int j = 0; j < 4; ++j) s += (v[j][0] * v[j][0] + v[j][1] * v[j][1]) + (v[j][2] * v[j][2] + v[j][3] * v[j][3]);
    const float rstd = 1.0f / sqrtf(wave_sum(s) * (1.0f / D) + RMS_EPS);
    const f32x4* gr = (const f32x4*)gain + lane;
    u32x2* o8 = (u32x2*)orow + lane;
#pragma unroll
    for (int j = 0; j < 4; ++j) { v[j] = v[j] * rstd * gr[64 * j]; if (orow) { u32x2 w; w.x = pk2(v[j][0], v[j][1]); w.y = pk2(v[j][2], v[j][3]); o8[64 * j] = w; } }
}
#define RMS_ROWS_BEGIN(x_, rowexpr_) f32x4 v[4], vn_[4]; { const int i = 0; rms_load(x_, (rowexpr_), lane, v); } for (int i = 0; i < 16; ++i) { if (i + 1 < 16) { const int i_ = i; { const int i = i_ + 1; rms_load(x_, (rowexpr_), lane, vn_); } }
#define RMS_ROWS_END() _Pragma("unroll") for (int j_ = 0; j_ < 4; ++j_) v[j_] = vn_[j_]; }
__device__ __forceinline__ void norm_plain(const XSrc x, const float* gain, bf16* H, int first, int stride) {
    BODY_IDS();
    for (int u = first; u < NTOK / 128; u += stride)
    { RMS_ROWS_BEGIN(x, u * 128 + wave * 16 + i) const int row = u * 128 + wave * 16 + i; rms_finish(gain, H + (size_t)row * D, lane, v); RMS_ROWS_END() }
}
__device__ __forceinline__ void norm1_phase(const Params& P, int L, const XSrc x, int first, int stride) {
    BODY_IDS();
    const float* win = P.in[I_WIN] + (size_t)L * D * DIN;
    f32x4 wff[4][4];
#pragma unroll
    for (int j = 0; j < 4; ++j)
#pragma unroll
        for (int e = 0; e < 4; ++e) wff[j][e] = *(const f32x4*)(win + (size_t)(4 * lane + 256 * j + e) * DIN + 1024);
    const float* gain = P.in[I_GMIX] + L * D; bf16* H = (bf16*)(P.ws + WS_H);
    float* logf = (float*)(P.ws + WS_LOGF); float* wsum = (float*)(P.ws + WS_WSUM);
    const f32x4 bf = *(const f32x4*)(P.in[I_FBF] + L * 4);
    for (int u = first; u < NTOK / 128; u += stride) { const int g0 = u * 8 + wave;
        f32x4 run = {0.f, 0.f, 0.f, 0.f};
        RMS_ROWS_BEGIN(x, g0 * 16 + i) const int row = g0 * 16 + i; rms_finish(gain, H + (size_t)row * D, lane, v);
            f32x4 d = {0.f, 0.f, 0.f, 0.f};
#pragma unroll
            for (int j = 0; j < 4; ++j)
#pragma unroll
                for (int e = 0; e < 4; ++e) d += wff[j][e] * v[j][e];
#pragma unroll
            for (int e = 0; e < 4; ++e) { d[e] = wave_sum(d[e]); run[e] += log_sigmoid(d[e] + bf[e]); }
            if (lane == 0) *(f32x4*)(logf + (size_t)row * 4) = run; RMS_ROWS_END()
        if (lane == 0) *(f32x4*)(wsum + (size_t)g0 * 4) = run;
    }
    __syncthreads();
}
__device__ __forceinline__ void prep_phase(const Params& P, int L) {
    BODY_IDS();
    unsigned* qmaxw = (unsigned*)(P.ws + WS_CTL) + CW_QMAX + L * 512; unsigned* kmaxw = (unsigned*)(P.ws + WS_CTL) + CW_KMAX + L * 16;
    const float* logf = (const float*)(P.ws + WS_LOGF); const float* wsum = (const float*)(P.ws + WS_WSUM); float* cdec = (float*)(P.ws + WS_CDEC);
    float* rq = (float*)(P.ws + WS_RSTDQ); float* rkv = (float*)(P.ws + WS_RSTDKV); const bf16* zin = (const bf16*)(P.ws + WS_ZIN); bf16* kper = (bf16*)(P.ws + WS_KPER);
    const float* ct = (const float*)(P.ws + WS_COS); const float* st = (const float*)(P.ws + WS_SIN);
    for (int g0 = gw; g0 < NTOK / 16; g0 += ngw) {
        const int first = (g0 / 512) * 512;
        f32x4 pre = {0.f, 0.f, 0.f, 0.f};
        for (int i = first + lane; i < g0; i += 64) pre += *(const f32x4*)(wsum + (size_t)i * 4);
#pragma unroll
        for (int e = 0; e < 4; ++e) pre[e] = wave_sum(pre[e]);
        if (lane < 16) { const int row = g0 * 16 + lane; *(f32x4*)(cdec + (size_t)row * 4) = *(const f32x4*)(logf + (size_t)row * 4) + pre; }
        float q2m = 0.f, k2m = 0.f;
        for (int i = 0; i < 16; ++i) { const int row = g0 * 16 + i; const bf16* zr = zin + (size_t)row * ZP;
            { const u32x2 wq = *(const u32x2*)(zr + ZC_FQ + 4 * lane), wk = *(const u32x2*)(zr + ZC_FK + 4 * lane);
              float sq_ = bflo(wq.x) * bflo(wq.x) + bfhi(wq.x) * bfhi(wq.x) + bflo(wq.y) * bflo(wq.y) + bfhi(wq.y) * bfhi(wq.y);
              float sk_ = bflo(wk.x) * bflo(wk.x) + bfhi(wk.x) * bfhi(wk.x) + bflo(wk.y) * bflo(wk.y) + bfhi(wk.y) * bfhi(wk.y);
#pragma unroll
              for (int o = 1; o < 16; o <<= 1) { sq_ += shflx(sq_, o, lane); sk_ += shflx(sk_, o, lane); }
              q2m = fmaxf(q2m, sq_); k2m = fmaxf(k2m, sk_); }
            const float a0 = bf2f(zr[ZC_CQ + lane]), a1 = bf2f(zr[ZC_CQ + 64 + lane]), a2 = bf2f(zr[ZC_CQ + 128 + lane]);
            const float b0 = bf2f(zr[ZC_CKV + lane]), b1 = bf2f(zr[ZC_CKV + 64 + lane]);
            const float sq = wave_sum(a0 * a0 + a1 * a1 + a2 * a2), skv = wave_sum(b0 * b0 + b1 * b1);
            if (lane == 0) { rq[row] = 1.0f / sqrtf(sq * (1.0f / 192.0f) + RMS_EPS); rkv[row] = 1.0f / sqrtf(skv * (1.0f / 128.0f) + RMS_EPS); }
            if (lane < 16) { const float t1 = bf2f(zr[ZC_KPE + lane]), t2 = bf2f(zr[ZC_KPE + 16 + lane]); const float c = ct[(size_t)row * 16 + lane], s = st[(size_t)row * 16 + lane];
                kper[(size_t)row * 32 + lane] = (bf16)f2bf(t1 * c - t2 * s); kper[(size_t)row * 32 + 16 + lane] = (bf16)f2bf(t2 * c + t1 * s); } }
        if ((lane & 15) == 0) { const int row0 = g0 * 16, b = row0 / SEQ, qb = (row0 % SEQ) / 256, h = lane >> 4;
            atomicMax(qmaxw + (b * 4 + h) * 32 + qb, __float_as_uint(q2m)); atomicMax(kmaxw + b * 4 + h, __float_as_uint(k2m)); }
    }
}
struct FinalRows { u32x2 w[16][4]; };
__device__ __forceinline__ void final_norm_load(const Params& P, int u, FinalRows& R) {
    BODY_IDS();
    const bf16* xb = xr_of(P.out);
#pragma unroll
    for (int i = 0; i < 16; ++i) { const u32x2* xr = (const u32x2*)(xb + (size_t)(u * 128 + wave * 16 + i) * D) + lane;
#pragma unroll
        for (int j = 0; j < 4; ++j) R.w[i][j] = xr[64 * j]; }
}
__device__ __forceinline__ void final_norm_store(const Params& P, int u, const FinalRows& R) {
    BODY_IDS();
    const f32x4* gr = (const f32x4*)P.in[I_GFIN] + lane;
#pragma unroll
    for (int i = 0; i < 16; ++i) { f32x4 v[4]; float s = 0.f;
#pragma unroll
        for (int j = 0; j < 4; ++j) { const u32x2 w = R.w[i][j]; v[j] = (f32x4){bflo(w.x), bfhi(w.x), bflo(w.y), bfhi(w.y)}; s += (v[j][0] * v[j][0] + v[j][1] * v[j][1]) + (v[j][2] * v[j][2] + v[j][3] * v[j][3]); }
        const float rstd = 1.0f / sqrtf(wave_sum(s) * (1.0f / D) + RMS_EPS);
        f32x4* xo = (f32x4*)(P.out + (size_t)(u * 128 + wave * 16 + i) * D) + lane;
#pragma unroll
        for (int j = 0; j < 4; ++j) xo[64 * j] = v[j] * rstd * gr[64 * j]; }
}
namespace s5 {
struct Coef { float abr, abi; f32x2 B2[16]; float a64r, a64i; };
__device__ __forceinline__ void coef(const Params& P, int L, int g, int p, Coef& C) {
    const float dt = __expf(P.in[I_SLDT][L * 16 + g]); const float ar = P.in[I_SAR][(L * 16 + g) * 64 + p], ai = P.in[I_SAI][(L * 16 + g) * 64 + p];
    const float mag = __expf(ar * dt); float sn, cs; sincos_rad((double)(ai * dt), sn, cs);
    C.abr = mag * cs; C.abi = mag * sn;
    const float den = ar * ar + ai * ai, nr = C.abr - 1.0f, ni = C.abi;
    const float cr = (nr * ar + ni * ai) / den, ci = (ni * ar - nr * ai) / den;
    const float* br = P.in[I_SBR] + ((size_t)(L * 16 + g) * 64 + p) * 16; const float* bi = P.in[I_SBI] + ((size_t)(L * 16 + g) * 64 + p) * 16;
#pragma unroll
    for (int h = 0; h < 16; ++h) { const float r = br[h], i = bi[h]; C.B2[h] = (f32x2){cr * r - ci * i, cr * i + ci * r}; }
    const float m64 = __expf(64.0f * ar * dt); float s64, c64; sincos_rad(64.0 * (double)(ai * dt), s64, c64);
    C.a64r = m64 * c64; C.a64i = m64 * s64;
}
constexpr int WAVE_LDS = 8448;
template <bool EMIT>
__device__ __forceinline__ void chunk(const Params& P, int L, int g, int row0, const Coef& C, float& xr, float& xi, LAS unsigned char* wl, int lane, const bf16x8 (&cf)[4], float dsk) {
    bf16* zin = (bf16*)(P.ws + WS_ZIN);
    LAS float* ut = (LAS float*)wl; LAS unsigned* xt = (LAS unsigned*)(wl + 4096);
    { const u32x4* up = (const u32x4*)(zin + (size_t)(row0 + lane) * ZP + ZC_U + g * 16); const u32x4 w0 = up[0], w1 = up[1];
      LAS f32x4* d = (LAS f32x4*)(ut + lane * 16);
      d[0] = (f32x4){bflo(w0.x), bfhi(w0.x), bflo(w0.y), bfhi(w0.y)}; d[1] = (f32x4){bflo(w0.z), bfhi(w0.z), bflo(w0.w), bfhi(w0.w)};
      d[2] = (f32x4){bflo(w1.x), bfhi(w1.x), bflo(w1.y), bfhi(w1.y)}; d[3] = (f32x4){bflo(w1.z), bfhi(w1.z), bflo(w1.w), bfhi(w1.w)}; }
    for (int tb = 0; tb < 4; ++tb) {
#pragma unroll 4
        for (int ti = 0; ti < 16; ++ti) {
            const LAS f32x4* up = (const LAS f32x4*)(ut + (tb * 16 + ti) * 16);
            f32x2 b2a = {0.f, 0.f}, b2b = {0.f, 0.f};
#pragma unroll
            for (int q = 0; q < 4; ++q) { const f32x4 u4 = up[q];
                b2a += C.B2[4 * q + 0] * (f32x2){u4[0], u4[0]}; b2b += C.B2[4 * q + 1] * (f32x2){u4[1], u4[1]};
                b2a += C.B2[4 * q + 2] * (f32x2){u4[2], u4[2]}; b2b += C.B2[4 * q + 3] * (f32x2){u4[3], u4[3]}; }
            const float br = b2a[0] + b2b[0], bi = b2a[1] + b2b[1];
            const float nr = C.abr * xr - C.abi * xi + br, ni = C.abr * xi + C.abi * xr + bi; xr = nr; xi = ni;
            if (EMIT) xt[ti * 68 + lane] = pk2(xr, xi);
        }
        if (EMIT) {
            f32x4 dacc = {0.f, 0.f, 0.f, 0.f};
#pragma unroll
            for (int ks = 0; ks < 4; ++ks) { const bf16x8 a = *(const LAS bf16x8*)((const LAS unsigned char*)xt + (lane & 15) * 272 + (ks * 32 + (lane >> 4) * 8) * 2);
                dacc = __builtin_amdgcn_mfma_f32_16x16x32_bf16(a, cf[ks], dacc, 0, 0, 0); }
            const int hp = lane & 15;
#pragma unroll
            for (int i = 0; i < 4; ++i) { const int tok = tb * 16 + 4 * (lane >> 4) + i; const float y = dacc[i] + dsk * ut[tok * 16 + hp];
                zin[(size_t)(row0 + tok) * ZP + ZC_U + g * 16 + hp] = (bf16)f2bf(gelu_tanh(y)); }
        }
    }
}
template <int PASS>
__device__ __forceinline__ void phase(const Params& P, int L, LAS unsigned char* lds) {
    BODY_IDS();
    LAS unsigned char* wl = lds + wave * WAVE_LDS;
    f32x2* SC = (f32x2*)(P.ws + WS_SC);
    for (int w = gw; w < 2048; w += ngw) {
        const int bg = w >> 5, cg = w & 31, b = bg >> 4, g = bg & 15;
        Coef C; coef(P, L, g, lane, C);
        bf16x8 cf[4]; float dsk = 0.f;
        if (PASS == 1) {
            const int hp = lane & 15, kg = lane >> 4;
            const float* cre = P.in[I_SCR] + ((size_t)(L * 16 + g) * 16 + hp) * 64; const float* cim = P.in[I_SCI] + ((size_t)(L * 16 + g) * 16 + hp) * 64;
#pragma unroll
            for (int ks = 0; ks < 4; ++ks) { const int p0 = 16 * ks + 4 * kg; u32x4 wv;
                wv.x = pk2(cre[p0], -cim[p0]); wv.y = pk2(cre[p0 + 1], -cim[p0 + 1]); wv.z = pk2(cre[p0 + 2], -cim[p0 + 2]); wv.w = pk2(cre[p0 + 3], -cim[p0 + 3]);
                cf[ks] = __builtin_bit_cast(bf16x8, wv); }
            dsk = P.in[I_SD][(L * 16 + g) * 16 + hp];
        } else {
#pragma unroll
            for (int ks = 0; ks < 4; ++ks) cf[ks] = (bf16x8){0, 0, 0, 0, 0, 0, 0, 0};
        }
        float xr = 0.f, xi = 0.f;
        if (PASS == 1) {
            const f32x2* sp = SC + ((size_t)bg * 128) * 64 + lane;
            for (int c = 0; c < 4 * cg; c += 4) { f32x2 sv[4];
#pragma unroll
                for (int q = 0; q < 4; ++q) sv[q] = sp[(size_t)(c + q) * 64];
#pragma unroll
                for (int q = 0; q < 4; ++q) { const float nr = C.a64r * xr - C.a64i * xi + sv[q][0], ni = C.a64r * xi + C.a64i * xr + sv[q][1]; xr = nr; xi = ni; } }
        }
        for (int cc = 0; cc < 4; ++cc) {
            const int c = 4 * cg + cc, row0 = b * SEQ + c * 64;
            if (PASS == 0) { xr = 0.f; xi = 0.f; }
            chunk<PASS == 1>(P, L, g, row0, C, xr, xi, wl, lane, cf, dsk);
            if (PASS == 0) SC[((size_t)bg * 128 + c) * 64 + lane] = (f32x2){xr, xi};
        }
    }
}
__device__ __forceinline__ void naive(const Params& P, int L) {
    BODY_IDS();
    bf16* zin = (bf16*)(P.ws + WS_ZIN);
    for (int bg = gw; bg < 64; bg += ngw) {
        const int b = bg >> 4, g = bg & 15;
        Coef C; coef(P, L, g, lane, C);
        float cr[16], ci[16];
#pragma unroll
        for (int h = 0; h < 16; ++h) { cr[h] = P.in[I_SCR][((size_t)(L * 16 + g) * 16 + h) * 64 + lane]; ci[h] = P.in[I_SCI][((size_t)(L * 16 + g) * 16 + h) * 64 + lane]; }
        const float dsk = P.in[I_SD][(L * 16 + g) * 16 + (lane & 15)];
        float xr = 0.f, xi = 0.f;
        for (int t = 0; t < SEQ; ++t) {
            bf16* up = zin + (size_t)(b * SEQ + t) * ZP + ZC_U + g * 16;
            const u32x4 w0 = *(const u32x4*)up, w1 = *(const u32x4*)(up + 8);
            const float u[16] = {bflo(w0.x), bfhi(w0.x), bflo(w0.y), bfhi(w0.y), bflo(w0.z), bfhi(w0.z), bflo(w0.w), bfhi(w0.w),
                                 bflo(w1.x), bfhi(w1.x), bflo(w1.y), bfhi(w1.y), bflo(w1.z), bfhi(w1.z), bflo(w1.w), bfhi(w1.w)};
            float br = 0.f, bi = 0.f;
#pragma unroll
            for (int h = 0; h < 16; ++h) { br += C.B2[h][0] * u[h]; bi += C.B2[h][1] * u[h]; }
            const float nr = C.abr * xr - C.abi * xi + br, ni = C.abr * xi + C.abi * xr + bi; xr = nr; xi = ni;
            float ymine = 0.f, umine = 0.f;
#pragma unroll
            for (int h = 0; h < 16; ++h) { const float s = wave_sum(xr * cr[h] - xi * ci[h]); if ((lane & 15) == h) { ymine = s; umine = u[h]; } }
            __builtin_amdgcn_s_waitcnt(0);
            if (lane < 16) up[lane] = (bf16)f2bf(gelu_tanh(ymine + dsk * umine));
        }
    }
}
}

__device__ __forceinline__ void norm2_moe_phase(const Params& P, const XSrc x, LAS unsigned char* lds, int first, int stride) {
    BODY_IDS();
    LAS unsigned* lcnt = (LAS unsigned*)(lds + 32768); LAS unsigned* lbase = lcnt + 8;
    f32x4 wr0[4][4], wr1[4][4];
#pragma unroll
    for (int j = 0; j < 4; ++j)
#pragma unroll
        for (int q = 0; q < 4; ++q) { const float* wp = P.in[I_MWR] + (size_t)(4 * lane + 256 * j + q) * 8; wr0[j][q] = *(const f32x4*)wp; wr1[j][q] = *(const f32x4*)(wp + 4); }
    if (tid < 8) lcnt[tid] = 0u;
    __syncthreads();
    const float* gain = P.in[I_GFFN] + 1 * D; bf16* H = (bf16*)(P.ws + WS_H);
    unsigned* tokinfo = (unsigned*)(P.ws + WS_TOKINFO); unsigned* gcnt = (unsigned*)(P.ws + WS_CTL) + CW_MOECNT;
    const float* brt = P.in[I_MBR];
    for (int u = first; u < NTOK / 128; u += stride) { const int g0 = u * 8 + wave;
        RMS_ROWS_BEGIN(x, g0 * 16 + i) const int row = g0 * 16 + i; rms_finish(gain, H + (size_t)row * D, lane, v);
            float lg[8];
#pragma unroll
            for (int e = 0; e < 8; ++e) lg[e] = 0.f;
#pragma unroll
            for (int j = 0; j < 4; ++j)
#pragma unroll
                for (int q = 0; q < 4; ++q) { const f32x4 w0 = wr0[j][q], w1 = wr1[j][q]; const float hv = v[j][q];
                    lg[0] += hv * w0[0]; lg[1] += hv * w0[1]; lg[2] += hv * w0[2]; lg[3] += hv * w0[3]; lg[4] += hv * w1[0]; lg[5] += hv * w1[1]; lg[6] += hv * w1[2]; lg[7] += hv * w1[3]; }
#pragma unroll
            for (int e = 0; e < 8; ++e) lg[e] = wave_sum(lg[e]) + brt[e];
            int e0 = 0; float l0 = lg[0];
#pragma unroll
            for (int e = 1; e < 8; ++e) if (lg[e] > l0) { l0 = lg[e]; e0 = e; }
            int e1 = 0; float l1 = -INFINITY;
#pragma unroll
            for (int e = 0; e < 8; ++e) if (e != e0 && lg[e] > l1) { l1 = lg[e]; e1 = e; }
            const float ex = __expf(l1 - l0); const float ga = 1.0f / (1.0f + ex), gb = ex / (1.0f + ex);
            if (lane == 0) { const unsigned r0 = __hip_atomic_fetch_add(&lcnt[e0], 1u, __ATOMIC_RELAXED, __HIP_MEMORY_SCOPE_WORKGROUP), r1 = __hip_atomic_fetch_add(&lcnt[e1], 1u, __ATOMIC_RELAXED, __HIP_MEMORY_SCOPE_WORKGROUP);
                u32x4 a; a.x = (unsigned)e0; a.y = (unsigned)e1; a.z = r0; a.w = r1; u32x4 bq; bq.x = __float_as_uint(ga); bq.y = __float_as_uint(gb); bq.z = 0u; bq.w = 0u;
                *(u32x4*)(tokinfo + (size_t)row * 8) = a; *(u32x4*)(tokinfo + (size_t)row * 8 + 4) = bq; } RMS_ROWS_END()
    }
    __syncthreads();
    if (tid < 8) lbase[tid] = __hip_atomic_fetch_add(gcnt + tid, lcnt[tid], __ATOMIC_RELAXED, __HIP_MEMORY_SCOPE_AGENT);
    __syncthreads();
    for (int u = first; u < NTOK / 128; u += stride) { const int g0 = u * 8 + wave;
        if (lane == 0) { for (int i = 0; i < 16; ++i) { const int row = g0 * 16 + i; u32x4 a = *(u32x4*)(tokinfo + (size_t)row * 8);
            unsigned b0 = 0, b1 = 0;
#pragma unroll
            for (int e = 0; e < 8; ++e) { const unsigned lb = lbase[e]; b0 = (a.x == (unsigned)e) ? lb : b0; b1 = (a.y == (unsigned)e) ? lb : b1; }
            a.z += b0; a.w += b1; *(u32x4*)(tokinfo + (size_t)row * 8) = a; } }
    }
    int* slot_tok = (int*)(P.ws + WS_SLOTTOK);
    for (int i = gtid; i < MOE_ROWS; i += gthreads) slot_tok[i] = -1;
    __syncthreads();
}
struct MoeLayout { int pstart[9]; };
__device__ __forceinline__ MoeLayout moe_layout(const Params& P) {
    const unsigned* gcnt = (const unsigned*)(P.ws + WS_CTL) + CW_MOECNT; MoeLayout Lo; int acc = 0;
#pragma unroll
    for (int e = 0; e < 8; ++e) { Lo.pstart[e] = acc; const int c = (int)__hip_atomic_load(gcnt + e, __ATOMIC_RELAXED, __HIP_MEMORY_SCOPE_AGENT); acc += (c + 255) / 256 * 256; }
    Lo.pstart[8] = acc; return Lo;
}
__device__ __forceinline__ void moe_assign_phase(const Params& P) {
    BODY_IDS();
    const MoeLayout Lo = moe_layout(P);
    const unsigned* tokinfo = (const unsigned*)(P.ws + WS_TOKINFO); int* slot_tok = (int*)(P.ws + WS_SLOTTOK); float* slot_gate = (float*)(P.ws + WS_SLOTGATE);
    for (int t = gtid; t < NTOK; t += gthreads) { const u32x4 a = *(const u32x4*)(tokinfo + (size_t)t * 8); const u32x2 g = *(const u32x2*)(tokinfo + (size_t)t * 8 + 4);
        int p0 = 0, p1 = 0;
#pragma unroll
        for (int e = 0; e < 8; ++e) { p0 = ((int)a.x == e) ? Lo.pstart[e] : p0; p1 = ((int)a.y == e) ? Lo.pstart[e] : p1; }
        const int s0 = p0 + (int)a.z, s1 = p1 + (int)a.w;
        slot_tok[s0] = t; slot_gate[s0] = __uint_as_float(g.x); slot_tok[s1] = t; slot_gate[s1] = __uint_as_float(g.y); }
}
struct MoeOrder {
    int pstart[9]; int ntile, ncol, G, c;
    __device__ __forceinline__ bool next(int i, pg8::Unit& u) const {
        const long Lf = (long)i * G + c; if (Lf >= (long)ntile * ncol) return false;
        const int rt = (int)(Lf / ncol), j = (int)(Lf % ncol); int e = 0;
#pragma unroll
        for (int q = 1; q < 8; ++q) e = (rt * 256 >= pstart[q]) ? q : e;
        u.pm = rt; u.pn = e * ncol + j; return true;
    }
};
__device__ __forceinline__ MoeOrder moe_order(const Params& P, int ncol, int G, int c) {
    const MoeLayout Lo = moe_layout(P); MoeOrder S;
#pragma unroll
    for (int e = 0; e < 9; ++e) S.pstart[e] = Lo.pstart[e];
    S.ntile = Lo.pstart[8] / 256; S.ncol = ncol; S.G = G; S.c = c; return S;
}

__device__ __forceinline__ void norm_moe_combine(const Params& P, const float* gain, int first, int stride) {
    BODY_IDS();
    const MoeLayout Lo = moe_layout(P);
    const unsigned* tokinfo = (const unsigned*)(P.ws + WS_TOKINFO); const bf16* Y = (const bf16*)(P.ws + WS_MOEY); bf16* H = (bf16*)(P.ws + WS_H2);
    for (int u = first; u < NTOK / 128; u += stride) for (int i = 0; i < 16; ++i) { const int row = u * 128 + wave * 16 + i;
        const u32x4 a = *(const u32x4*)(tokinfo + (size_t)row * 8);
        int p0 = 0, p1 = 0;
#pragma unroll
        for (int e = 0; e < 8; ++e) { p0 = ((int)a.x == e) ? Lo.pstart[e] : p0; p1 = ((int)a.y == e) ? Lo.pstart[e] : p1; }
        const u32x2* y0 = (const u32x2*)(Y + (size_t)(p0 + (int)a.z) * D) + lane; const u32x2* y1 = (const u32x2*)(Y + (size_t)(p1 + (int)a.w) * D) + lane;
        u32x2* xr = (u32x2*)(xr_of(P.out) + (size_t)row * D) + lane; f32x4 v[4]; float s = 0.f;
#pragma unroll
        for (int j = 0; j < 4; ++j) { const u32x2 w0 = y0[64 * j], w1 = y1[64 * j]; const u32x2 wx = xr[64 * j];
            v[j] = (f32x4){bflo(wx.x), bfhi(wx.x), bflo(wx.y), bfhi(wx.y)} + (f32x4){bflo(w0.x), bfhi(w0.x), bflo(w0.y), bfhi(w0.y)} + (f32x4){bflo(w1.x), bfhi(w1.x), bflo(w1.y), bfhi(w1.y)};
            { u32x2 wo; wo.x = pk2(v[j][0], v[j][1]); wo.y = pk2(v[j][2], v[j][3]); xr[64 * j] = wo; } s += (v[j][0] * v[j][0] + v[j][1] * v[j][1]) + (v[j][2] * v[j][2] + v[j][3] * v[j][3]); }
        const float rstd = 1.0f / sqrtf(wave_sum(s) * (1.0f / D) + RMS_EPS);
        const f32x4* gr = (const f32x4*)gain + lane; u32x2* o8 = (u32x2*)(H + (size_t)row * D) + lane;
#pragma unroll
        for (int j = 0; j < 4; ++j) { const f32x4 h = v[j] * rstd * gr[64 * j]; u32x2 w; w.x = pk2(h[0], h[1]); w.y = pk2(h[2], h[3]); o8[64 * j] = w; }
    }
}
#ifndef REF_MASK
#define REF_MASK 0
#endif
#ifndef N_LAUNCH_MODE
#define N_LAUNCH_MODE 1
#endif
constexpr int LDS_BYTES = 147456;
constexpr int MISC_OFF = LDS_BYTES - 64;
constexpr int N_PHASES = 27;
#ifndef PHASE_SEL
#define PHASE_SEL 0xFFFFFFFu
#endif
#define PH_ON(b) (((PHASE_SEL) >> (b)) & 1u)
#ifndef SUB_SEL
#define SUB_SEL 0xFFu
#endif
#define SUB_ON(b) (((SUB_SEL) >> (b)) & 1u)

#ifndef PROBE_MASK
#define PROBE_MASK 0u
#endif
#ifndef PROBE_MULT
#define PROBE_MULT 4
#endif
#define TIMED(bit, ...) do { unsigned long long t0_ = 0; if (((PROBE_MASK) >> (bit)) & 1u) t0_ = __builtin_amdgcn_s_memrealtime(); __VA_ARGS__; \
    if (((PROBE_MASK) >> (bit)) & 1u) pacc += __builtin_amdgcn_s_memrealtime() - t0_; } while (0)
#define RUN_GEMM(EPI_T, SCHED_T, GATH, gm, sc, ep) do { if (REF_MASK & 1) pg8::gemm_phase_naive<EPI_T, SCHED_T, GATH>(gm, sc, ep); \
    else pg8::gemm_phase<EPI_T, SCHED_T, true, GATH>(lds, gm, sc, ep); } while (0)

__device__ __forceinline__ int vcu_of() { int G = gridDim.x, bx = blockIdx.x; asm volatile("" : "+s"(G), "+s"(bx)); return (G % 8 == 0) ? (bx % 8) * (G / 8) + bx / 8 : bx; }
__device__ __forceinline__ bool in_range(int lo, int hi, int k) { asm volatile("" : "+s"(lo), "+s"(hi)); return lo <= k && k < hi; }
__global__ void __launch_bounds__(NTHREADS, 2) mega_fwd(Params P) {
    extern __shared__ __attribute__((aligned(16))) unsigned char lds_raw[];
    LAS unsigned char* lds = (LAS unsigned char*)lds_raw;
    const int tid = threadIdx.x;
    const int G = gridDim.x, bx = blockIdx.x;
    unsigned* ctl = (unsigned*)(P.ws + WS_CTL);
    volatile LAS unsigned* misc = (volatile LAS unsigned*)(lds + MISC_OFF);
    if (tid < 16) misc[tid] = 0u;
    if ((tid & 63) == 0) *(LAS int*)(uintptr_t)((unsigned)TID_TAB_OFF + 4u * hw_wave_key()) = tid >> 6;
    __syncthreads();
    const int lo = P.ph_lo, hi = P.ph_hi;
    XcdBarrier bar; bar.bar = ctl + CW_BAR; bar.x = 0; bar.st = misc;
    if (hi - lo > 1) bar = xcd_barrier_post(ctl + CW_BAR, misc);
#define IN(k) in_range(lo, hi, (k))
#ifndef PROBE_SEAMS
#define PROBE_SEAMS 0u
#endif
#define SEAM(k) do { if (IN(k) && IN((k) + 1)) { unsigned long long t0_ = 0; const bool tm_ = (((PROBE_MASK) >> 24) & 1u) || (((PROBE_SEAMS) >> (k)) & 1u); if (tm_) t0_ = __builtin_amdgcn_s_memrealtime(); \
    xcd_barrier(bar); if (tm_) pacc += __builtin_amdgcn_s_memrealtime() - t0_; } } while (0)
    unsigned long long pacc = 0;

#define H ((bf16*)(P.ws + WS_H))
#define ZIN ((bf16*)(P.ws + WS_ZIN))
#define GB ((bf16*)(P.ws + WS_G))
#define MB ((bf16*)(P.ws + WS_M))
#define MLAQ ((bf16*)(P.ws + WS_MLAQ))
#define MLAKV ((bf16*)(P.ws + WS_MLAKV))
#define KPER ((bf16*)(P.ws + WS_KPER))
#define cosT ((float*)(P.ws + WS_COS))
#define sinT ((float*)(P.ws + WS_SIN))
#define slot_tok ((int*)(P.ws + WS_SLOTTOK))
#define slot_gate ((float*)(P.ws + WS_SLOTGATE))

    if (PH_ON(0) && IN(0)) { TIMED(0, cvt_jobs(P, 0, 43, lds); p0_misc(P)); TIMED(1, norm1_phase(P, 0, XSrc{P.in[I_X], nullptr}, vcu_of(), gridDim.x)); }
    SEAM(0);

    for (int L = 0; L < 2; ++L) {
        const int pb = 1 + 12 * L;
        const int pc = (L == 0) ? 9 : 22;
        bf16* const XR = xr_of(P.out);
        const XSrc xsrc = (L == 0) ? XSrc{P.in[I_X], nullptr} : XSrc{nullptr, XR};
        if (PH_ON(2) && IN(pb + 1)) {
            pg8::Gemm g{H, wmix(P, L, WM_IN), D, D, D, nullptr}; pg8::StaticOrder S; S.init(NTOK, ZP, G, bx);
            epi::EpiStore E{ZIN, ZP, 0};
            TIMED(2, RUN_GEMM(epi::EpiStore, pg8::StaticOrder, false, g, S, E));
        }
        SEAM(pb + 1);
        if (PH_ON(3) && IN(pb + 2)) {
            TIMED(3, prep_phase(P, L));
            if (!(REF_MASK & 4)) TIMED(4, s5::phase<0>(P, L, lds));
            __syncthreads();
        }
        SEAM(pb + 2);
        if (PH_ON(4) && IN(pb + 3)) {
            if (SUB_ON(0)) { pg8::Gemm g{ZIN + ZC_CQ, wmix(P, L, WM_UQ), ZP, 256, 256, nullptr}; pg8::StaticOrder S; S.init(NTOK, 512, G, bx);
              epi::EpiMlaQ E{MLAQ, (const float*)(P.ws + WS_RSTDQ), cosT, sinT};
              TIMED(5, RUN_GEMM(epi::EpiMlaQ, pg8::StaticOrder, false, g, S, E)); }
            if (SUB_ON(1)) { pg8::Gemm g{ZIN + ZC_CKV, wmix(P, L, WM_UKV), ZP, 128, 128, nullptr}; pg8::StaticOrder S; S.init(NTOK, 512, G, bx);
              epi::EpiRowScale E{MLAKV, 512, (const float*)(P.ws + WS_RSTDKV)};
              TIMED(5, RUN_GEMM(epi::EpiRowScale, pg8::StaticOrder, false, g, S, E)); }
            if (SUB_ON(2)) { TIMED(6, if (REF_MASK & 4) s5::naive(P, L); else s5::phase<1>(P, L, lds)); }
            __syncthreads();
            if (SUB_ON(3)) { att::Tensors T; T.Q = ZIN + ZC_FQ; T.ldq = ZP; T.K = ZIN + ZC_FK; T.ldk = ZP; T.K2 = nullptr; T.V = ZIN + ZC_FV; T.ldv = ZP; T.O = ZIN + ZC_FQ; T.ldo = ZP;
              T.cdec = (const float*)(P.ws + WS_CDEC); T.relb = nullptr; T.qhs = 64; T.khs = 64; T.vhs = 64; T.ohs = 64;
              T.qmax = (const unsigned*)(P.ws + WS_CTL) + CW_QMAX + L * 512; T.kmax = (const unsigned*)(P.ws + WS_CTL) + CW_KMAX + L * 16;
              TIMED(7, if (REF_MASK & 2) att::attn_naive<att::MODE_FOX>(T); else att::attn_phase<att::MODE_FOX>(T, lds)); }
            __syncthreads();
            if (SUB_ON(4)) { att::Tensors T; T.Q = ZIN + ZC_DQ; T.ldq = ZP; T.K = ZIN + ZC_DK; T.ldk = ZP; T.K2 = nullptr; T.V = ZIN + ZC_DV; T.ldv = ZP; T.O = ZIN + ZC_DQ; T.ldo = ZP;
              T.cdec = nullptr; T.relb = P.in[I_RELB] + (size_t)L * 4 * 513; T.qhs = 64; T.khs = 64; T.vhs = 64; T.ohs = 64;
              TIMED(8, if (REF_MASK & 2) att::attn_naive<att::MODE_BAND>(T); else att::attn_phase<att::MODE_BAND>(T, lds)); }
            __syncthreads();
        }
        SEAM(pb + 3);
        if (PH_ON(5) && IN(pb + 4)) {
            if (SUB_ON(0)) { att::Tensors T; T.Q = MLAQ; T.ldq = 512; T.K = MLAKV; T.ldk = 512; T.K2 = KPER; T.V = MLAKV + 64; T.ldv = 512; T.O = ZIN + ZC_CQ; T.ldo = ZP;
              T.cdec = nullptr; T.relb = nullptr; T.qhs = 96; T.khs = 128; T.vhs = 128; T.ohs = 64;
              TIMED(9, if (REF_MASK & 2) att::attn_naive<att::MODE_MLA>(T); else att::attn_phase<att::MODE_MLA>(T, lds)); }
            __syncthreads();
            if (SUB_ON(1)) { pg8::Gemm g{ZIN + ZC_U, wmix(P, L, WM_GLU), ZP, 256, 256, nullptr}; pg8::StaticOrder S; S.init(NTOK, 256, G, bx);
              epi::EpiGlu E{ZIN + ZC_U, ZP};
              TIMED(10, RUN_GEMM(epi::EpiGlu, pg8::StaticOrder, false, g, S, E)); }
        }
        SEAM(pb + 4);
        if (PH_ON(6) && IN(pb + 5)) {
            g128::MergeProg MP; MP.Hn = H; MP.zin = ZIN; MP.wg = wmix(P, L, WM_G); MP.wb = wmix(P, L, WM_B); MP.bg = P.in[I_BG] + (size_t)L * 4 * D; MP.M = MB;
            const int vcu_ = vcu_of();
            TIMED(11, g128::stream<g128::MergeProg>(lds, MP, 1024, vcu_, G));
        }
        SEAM(pb + 5);
#define PANEL_FENCE() do { asm volatile("s_waitcnt vmcnt(0)" ::: "memory"); __builtin_amdgcn_fence(__ATOMIC_ACQUIRE, "agent"); asm volatile("s_waitcnt vmcnt(0)" ::: "memory"); __syncthreads(); } while (0)
        if (PH_ON(7) && IN(pb + 6)) {
            pg8::Gemm g{MB, wmix(P, L, WM_O), D, D, D, nullptr}; pg8::StaticOrder S; S.init(NTOK, D, G, bx);
            epi::EpiRes E{xsrc, XR};
            TIMED(13, RUN_GEMM(epi::EpiRes, pg8::StaticOrder, false, g, S, E));
        }
        SEAM(pb + 6);
        if (PH_ON(8) && IN(pb + 7)) {
            const int vcu_ = vcu_of();
            if (L == 0) TIMED(14, norm_plain(XSrc{nullptr, XR}, P.in[I_GFFN], H, vcu_, G));
            else { TIMED(14, norm2_moe_phase(P, XSrc{nullptr, XR}, lds, vcu_, G)); TIMED(25, cvt_jobs(P, 43, 67, lds)); __syncthreads(); }
        }
        SEAM(pb + 7);
        if (L == 0) {
            if (PH_ON(9) && IN(9)) {
                pg8::Gemm g{H, (const bf16*)(P.ws + WS_W13), D, D, D, nullptr}; pg8::StaticOrder S; S.init(NTOK, 2 * DFF, G, bx);
                epi::EpiSwiglu E{(bf16*)(P.ws + WS_HMID), DFF, 22};
                TIMED(15, RUN_GEMM(epi::EpiSwiglu, pg8::StaticOrder, false, g, S, E));
            }
            SEAM(9);
            if (PH_ON(10) && IN(10)) {
                pg8::Gemm g{(const bf16*)(P.ws + WS_HMID), (const bf16*)(P.ws + WS_W2), DFF, DFF, DFF, nullptr}; pg8::StaticOrder S; S.init(NTOK, D, G, bx);
                epi::EpiRes E{XSrc{nullptr, XR}, XR};
                TIMED(16, RUN_GEMM(epi::EpiRes, pg8::StaticOrder, false, g, S, E));
            }
            SEAM(10);
        } else {
            if (PH_ON(21) && IN(21)) TIMED(17, moe_assign_phase(P));
            SEAM(21);
            if (PH_ON(22) && IN(22)) {
                pg8::Gemm g{H, (const bf16*)(P.ws + WS_WM13), D, D, D, slot_tok}; const MoeOrder S = moe_order(P, 11, G, bx);
                epi::EpiSwiglu E{(bf16*)(P.ws + WS_HMID), DFFE, 11};
                TIMED(18, RUN_GEMM(epi::EpiSwiglu, MoeOrder, true, g, S, E));
            }
            SEAM(22);
            if (PH_ON(23) && IN(23)) {
                pg8::Gemm g{(const bf16*)(P.ws + WS_HMID), (const bf16*)(P.ws + WS_WM2), DFFE, DFFE, DFFE, nullptr}; const MoeOrder S = moe_order(P, 4, G, bx);
                epi::EpiMoeDown E{(bf16*)(P.ws + WS_MOEY), slot_gate};
                TIMED(19, RUN_GEMM(epi::EpiMoeDown, MoeOrder, false, g, S, E));
            }
            SEAM(23);
        }
        if (PH_ON(12) && IN(pc + 3)) {
            const int vcu_ = vcu_of();
            if (L == 0) TIMED(20, norm_plain(XSrc{nullptr, XR}, P.in[I_GPLE] + L * D, H, vcu_, G)); else TIMED(20, norm_moe_combine(P, P.in[I_GPLE] + L * D, vcu_, G));
            PANEL_FENCE();
            g128::PleProg PP; PP.pbf = (const bf16*)(P.ws + WS_PBF) + (size_t)L * NTOK * 256; PP.hp = (L == 0) ? H : (const bf16*)(P.ws + WS_H2); PP.wup = wmix(P, L, WM_UP); PP.wpg = wmix(P, L, WM_PG); PP.x = XR;
            TIMED(22, g128::stream<g128::PleProg>(lds, PP, NTOK / 128, vcu_, G));
            PANEL_FENCE();
            if (L == 0) TIMED(1, norm1_phase(P, 1, XSrc{nullptr, XR}, vcu_, G));
        }
        if (L == 0) SEAM(pc + 3);
    }
    if (PH_ON(26) && IN(25)) {
        const int vcu_ = vcu_of(); const int G_ = gridDim.x;
        for (int r = 0; r < (NTOK / 128 + G_ - 1) / G_; ++r) {
            const int u = vcu_ + r * G_; FinalRows FR;
            if (u < NTOK / 128) final_norm_load(P, u, FR);
            xcd_barrier(bar);
            if (u < NTOK / 128) final_norm_store(P, u, FR);
        }
    }
    if (PROBE_MASK || PROBE_SEAMS) { const unsigned long long t0_ = __builtin_amdgcn_s_memrealtime(); while (__builtin_amdgcn_s_memrealtime() - t0_ < (unsigned long long)PROBE_MULT * pacc) __builtin_amdgcn_s_sleep(8); }
#undef IN
#undef SEAM
#undef H
#undef ZIN
#undef GB
#undef MB
#undef MLAQ
#undef MLAKV
#undef KPER
#undef cosT
#undef sinT
#undef slot_tok
#undef slot_gate
}

extern "C" void kernel_launch(void* const* d_in, const int* in_sizes, int n_in, void* d_out, int out_size, void* d_ws, size_t ws_size, hipStream_t stream) {
    static int grid = 0;
    if (grid == 0) {
        if (n_in != 37 || out_size != NTOK * D || ws_size < WS_END) { fprintf(stderr, "kernel_launch: unexpected shapes: n_in %d out %d ws %zu\n", n_in, out_size, ws_size); grid = -1; return; }
        int dev = 0, cus = 0, per_cu = 0;
        if (hipGetDevice(&dev) != hipSuccess || hipDeviceGetAttribute(&cus, hipDeviceAttributeMultiprocessorCount, dev) != hipSuccess) { grid = -1; return; }
        if (hipFuncSetAttribute((const void*)mega_fwd, hipFuncAttributeMaxDynamicSharedMemorySize, LDS_BYTES) != hipSuccess) { fprintf(stderr, "kernel_launch: hipFuncSetAttribute failed\n"); grid = -1; return; }
        if (hipOccupancyMaxActiveBlocksPerMultiprocessor(&per_cu, (const void*)mega_fwd, NTHREADS, LDS_BYTES) != hipSuccess || per_cu < 1)
            fprintf(stderr, "kernel_launch: note: occupancy query reports %d workgroups per CU\n", per_cu);
        (void)hipGetLastError();
        grid = cus;
        if (grid != 256) fprintf(stderr, "kernel_launch: note: %d CUs (built for 256)\n", grid);
    }
    if (grid < 0) return;
    if (hipMemsetAsync((char*)d_ws + WS_CTL, 0, CTL_ZERO_BYTES, stream) != hipSuccess) return;
    Params p{};
    for (int i = 0; i < 37; ++i) p.in[i] = (const float*)d_in[i];
    p.out = (float*)d_out; p.ws = (unsigned char*)d_ws;
#if N_LAUNCH_MODE == 1
    p.ph_lo = 0; p.ph_hi = N_PHASES;
    hipLaunchKernelGGL(mega_fwd, dim3(grid), dim3(NTHREADS), LDS_BYTES, stream, p);
#else
    for (int ph = 0; ph < N_PHASES; ++ph) { p.ph_lo = ph; p.ph_hi = ph + 1; hipLaunchKernelGGL(mega_fwd, dim3(grid), dim3(NTHREADS), LDS_BYTES, stream, p); }
#endif
    const hipError_t le = hipPeekAtLastError();
    if (le != hipSuccess) fprintf(stderr, "kernel_launch: launch failed: %s\n", hipGetErrorName(le));
}
```

```cpp
#include <hip/hip_runtime.h>
#include <cstdio>
#include <cstdint>

#define GAS __attribute__((address_space(1)))
#define LAS __attribute__((address_space(3)))
typedef unsigned short bf16;
typedef short bf16x8 __attribute__((ext_vector_type(8)));
typedef short s16x4 __attribute__((ext_vector_type(4)));
typedef float f32x2 __attribute__((ext_vector_type(2)));
typedef float f32x4 __attribute__((ext_vector_type(4)));
typedef float f32x16 __attribute__((ext_vector_type(16)));
typedef unsigned u32x2 __attribute__((ext_vector_type(2)));
typedef unsigned u32x4 __attribute__((ext_vector_type(4)));
typedef __bf16 bf16x2_t __attribute__((ext_vector_type(2)));

constexpr int NB = 4, SEQ = 8192, NTOK = NB * SEQ, D = 1024;
constexpr int ZP = 2304;
constexpr int ZC_U = 0, ZC_FQ = 256, ZC_FK = 512, ZC_FV = 768, ZC_DQ = 1024, ZC_DK = 1280, ZC_DV = 1536, ZC_CQ = 1792, ZC_CKV = 2048, ZC_KPE = 2176;
constexpr int DIN = 2148, DFF = 2816, DFFE = 1408, NE = 8;
constexpr int MOE_ROWS = 2 * NTOK + NE * 256;
constexpr float RMS_EPS = 1e-6f;
constexpr int NWAVES = 8, NTHREADS = 512;

constexpr size_t MiB = 1u << 20;
constexpr size_t WS_CTL = 0, CTL_ZERO_BYTES = 1 * MiB;
constexpr size_t WS_COS = 1 * MiB, WS_SIN = 3 * MiB;
constexpr size_t WS_LOGF = 5 * MiB;
constexpr size_t WS_CDEC = 5 * MiB + 512 * 1024;
constexpr size_t WS_WSUM = 6 * MiB;
constexpr size_t WS_RSTDQ = 6 * MiB + 256 * 1024, WS_RSTDKV = 6 * MiB + 512 * 1024;
constexpr size_t WS_SC = 7 * MiB;
constexpr size_t WS_TOKINFO = 11 * MiB;
constexpr size_t WS_SLOTTOK = 12 * MiB, WS_SLOTGATE = 12 * MiB + 512 * 1024;
constexpr size_t WS_PBF = 17 * MiB;
constexpr size_t WS_WMIX = 49 * MiB, WMIX_STRIDE = 20 * MiB;
constexpr size_t WM_IN = 0, WM_G = 4 * MiB + 512 * 1024, WM_B = 12 * MiB + 512 * 1024, WM_O = 14 * MiB + 512 * 1024, WM_PG = 16 * MiB + 512 * 1024,
                 WM_UP = 18 * MiB + 512 * 1024, WM_UQ = 19 * MiB, WM_UKV = 19 * MiB + 256 * 1024, WM_GLU = 19 * MiB + 384 * 1024;
constexpr size_t WS_W13 = 89 * MiB, WS_W2 = 100 * MiB;
constexpr size_t WS_H = 106 * MiB;
constexpr size_t WS_MLAQ = 170 * MiB, WS_MLAKV = 202 * MiB, WS_KPER = 234 * MiB;
constexpr size_t WS_M = 170 * MiB;
constexpr size_t WS_ZIN = 236 * MiB;
constexpr size_t WS_G = 380 * MiB;
constexpr size_t WS_HMID = 236 * MiB;
constexpr size_t WS_U = 236 * MiB;
constexpr size_t WS_WM13 = 418 * MiB, WS_WM2 = 462 * MiB;
constexpr size_t WS_MOEY = 89 * MiB;
constexpr size_t WS_H2 = 300 * MiB;
constexpr size_t WS_END = 484 * MiB;
constexpr int CW_BAR = 4096;
constexpr int CW_MOECNT = 16384;
constexpr int CW_QMAX = 20480;
constexpr int CW_KMAX = 22528;

#define LDS_WAIT() asm volatile("s_waitcnt lgkmcnt(0)" ::: "memory")
#define VM_WAIT() asm volatile("s_waitcnt vmcnt(0)" ::: "memory")
__device__ __forceinline__ unsigned f2bf(float f) { unsigned u = __builtin_bit_cast(unsigned, f); return (u + 0x7fffu + ((u >> 16) & 1u)) >> 16; }
__device__ __forceinline__ unsigned pk2(float lo, float hi) { f32x2 v = {lo, hi}; bf16x2_t b = __builtin_convertvector(v, bf16x2_t); return __builtin_bit_cast(unsigned, b); }
__device__ __forceinline__ float bf2f(unsigned short b) { return __uint_as_float((unsigned)b << 16); }
__device__ __forceinline__ float bflo(unsigned w) { return __uint_as_float(w << 16); }
__device__ __forceinline__ float bfhi(unsigned w) { return __uint_as_float(w & 0xffff0000u); }
constexpr int TID_TAB_OFF = 147456 - 512;
__device__ __forceinline__ unsigned hw_wave_key() { return (unsigned)__builtin_amdgcn_s_getreg((5 << 11) | 4) & 0x3Fu; }
__device__ __forceinline__ int my_tid() {
    unsigned addr = (unsigned)TID_TAB_OFF + 4u * hw_wave_key(); asm volatile("" : "+s"(addr));
    const int wave = __builtin_amdgcn_readfirstlane(*(const LAS int*)(uintptr_t)addr);
    int lane = (int)__builtin_amdgcn_mbcnt_hi(~0u, __builtin_amdgcn_mbcnt_lo(~0u, 0u)); asm volatile("" : "+v"(lane));
    return wave * 64 + lane;
}
__device__ __forceinline__ float shflx(float v, int o, int lane) { return __int_as_float(__builtin_amdgcn_ds_bpermute((lane ^ o) << 2, __float_as_int(v))); }
__device__ __forceinline__ float wave_sum(float v) {
    int lane = (int)__builtin_amdgcn_mbcnt_hi(~0u, __builtin_amdgcn_mbcnt_lo(~0u, 0u)); asm volatile("" : "+v"(lane));
#pragma unroll
    for (int o = 1; o < 64; o <<= 1) v += shflx(v, o, lane);
    return v;
}
__device__ __forceinline__ float sigmoidf_(float x) { return __builtin_amdgcn_rcpf(1.0f + __expf(-x)); }

struct XSrc { const float* f; const bf16* b; };
__device__ __forceinline__ f32x4 ldx4(const XSrc& x, size_t idx) {
    if (x.f) return *(const f32x4*)(x.f + idx);
    const u32x2 w = *(const u32x2*)(x.b + idx); return (f32x4){bflo(w.x), bfhi(w.x), bflo(w.y), bfhi(w.y)};
}
__device__ __forceinline__ bf16* xr_of(float* out) { return (bf16*)((unsigned char*)out + (size_t)NTOK * D * 2); }
#define BODY_IDS() int tid = my_tid(); asm volatile("" : "+v"(tid)); const int lane = tid & 63; const int wave = __builtin_amdgcn_readfirstlane(tid >> 6); \
    int grid_ = gridDim.x; asm volatile("" : "+s"(grid_)); \
    const int gw = blockIdx.x * NWAVES + wave, ngw = grid_ * NWAVES, gtid = blockIdx.x * NTHREADS + tid, gthreads = grid_ * NTHREADS; (void)lane; (void)wave; (void)gw; (void)ngw; (void)gtid; (void)gthreads
#define XB_TMO      128
#define XB_XCNT(j)  (256  + 64 * (j))
#define XB_XSUB(j)  (1280 + 64 * (j))
#define XB_XGEN(j)  (2304 + 64 * (j))
#define XB_TOP      3328
#define XB_TOPGEN   3392
#define XCD_BAR_WORDS 3456
#define XB_SPIN_CAP (1u << 22)

__device__ __forceinline__ unsigned xb_ld(unsigned* p)              { return __hip_atomic_load(p, __ATOMIC_RELAXED, __HIP_MEMORY_SCOPE_AGENT); }
__device__ __forceinline__ unsigned xb_add(unsigned* p, unsigned v) { return __hip_atomic_fetch_add(p, v, __ATOMIC_RELAXED, __HIP_MEMORY_SCOPE_AGENT); }
__device__ __forceinline__ unsigned xb_xcc_id() { return (unsigned)__builtin_amdgcn_s_getreg((3 << 11) | 20) & 0xFu; }
#define XB_SPIN(cond, bar) do { unsigned _sp = 0; while (cond) { __builtin_amdgcn_s_sleep(1); \
    if ((++_sp & 255u) == 0u) { if (xb_ld(&(bar)[XB_TMO])) break; if (_sp > XB_SPIN_CAP) { atomicAdd(&(bar)[XB_TMO], 1u); break; } } } } while (0)

struct XcdBarrier { unsigned* bar; unsigned x; volatile LAS unsigned* st; };

__device__ __forceinline__ XcdBarrier xcd_barrier_post(unsigned* bar, volatile LAS unsigned* st) {
    XcdBarrier b; b.bar = bar; b.x = xb_xcc_id(); b.st = st;
    if (my_tid() == 0) (void)xb_add(&bar[XB_XCNT(b.x)], 1u);
    return b;
}
__device__ __forceinline__ void xcd_barrier_complete(unsigned* bar, unsigned x, unsigned& nloc, unsigned& nx) {
    const unsigned G = gridDim.x * gridDim.y * gridDim.z;
    unsigned sum, cnt, mine, sp = 0u;
    for (;;) {
        sum = 0u; cnt = 0u; mine = 0u;
#pragma unroll
        for (unsigned j = 0; j < 16; ++j) { const unsigned c = xb_ld(&bar[XB_XCNT(j)]); sum += c; cnt += (c > 0u) ? 1u : 0u; mine = (j == x) ? c : mine; }
        if (sum == G) break;
        __builtin_amdgcn_s_sleep(1);
        if ((++sp & 255u) == 0u) { if (xb_ld(&bar[XB_TMO])) break; if (sp > XB_SPIN_CAP) { atomicAdd(&bar[XB_TMO], 1u); break; } }
    }
    nloc = mine > 0u ? mine : 1u; nx = cnt > 0u ? cnt : 1u;
}
__device__ __forceinline__ void xcd_barrier(const XcdBarrier& b) {
    asm volatile("s_waitcnt vmcnt(0)" ::: "memory");
    __syncthreads();
    if (my_tid() == 0) {
        unsigned* bar = b.bar;
        __builtin_amdgcn_s_waitcnt(0);
        unsigned nloc = b.st[0], nx = b.st[1];
        if (nloc == 0u) { xcd_barrier_complete(bar, b.x, nloc, nx); b.st[0] = nloc; b.st[1] = nx; }
        const unsigned old = xb_add(&bar[XB_XSUB(b.x)], 1u);
        const unsigned gen = old / nloc;
        if (old + 1u == (gen + 1u) * nloc) {
            __builtin_amdgcn_fence(__ATOMIC_RELEASE, "agent");
            asm volatile("s_waitcnt vmcnt(0)" ::: "memory");
            const unsigned og = xb_add(&bar[XB_TOP], 1u);
            const unsigned tg = og / nx;
            if (og + 1u == (tg + 1u) * nx) xb_add(&bar[XB_TOPGEN], 1u);
            else XB_SPIN(xb_ld(&bar[XB_TOPGEN]) == tg, bar);
            __builtin_amdgcn_fence(__ATOMIC_ACQUIRE, "agent");
            xb_add(&bar[XB_XGEN(b.x)], 1u);
            asm volatile("s_waitcnt vmcnt(0)" ::: "memory");
        } else {
            XB_SPIN(xb_ld(&bar[XB_XGEN(b.x)]) == gen, bar);
            __builtin_amdgcn_fence(__ATOMIC_ACQUIRE, "agent");
            asm volatile("s_waitcnt vmcnt(0)" ::: "memory");
        }
    }
    __syncthreads();
}
namespace pg8 {
constexpr int BM = 256, BK = 64, HALF = 128, HTB = HALF * BK * 2, STAGE_BYTES = 8 * HTB, NXCD = 8, WGM = 8;
__host__ __device__ __forceinline__ int lds_byte(int r, int c) { const int st = (r >> 4) * 2 + (c >> 5), rr = r & 15, cc = c & 31, ob = rr * 64 + cc * 2; return st * 1024 + (ob ^ (((ob >> 9) & 1) << 5)); }
__host__ __device__ __forceinline__ void stage_rc(int b, int& R, int& C) { const int st = b / 1024, sb = b % 1024, swz = sb ^ (((sb >> 9) & 1) << 5); R = (st >> 1) * 16 + swz / 64; C = (st & 1) * 32 + (swz % 64) / 2; }
__host__ __device__ __forceinline__ int perm32(int rho) { const int n = rho >> 4, i = rho & 15; return 8 * (i >> 2) + 4 * n + (i & 3); }

struct Unit { int pm, pn; };
struct Gemm { const bf16* A; const bf16* Bt; int lda, ldb, K; const int* gidx; };

struct StaticOrder {
    int nM, nN, nwg, G, c;
    __host__ __device__ void init(int M, int N, int G_, int c_) { nM = M / BM; nN = N / BM; nwg = nM * nN; G = G_; c = c_; }
    __host__ __device__ bool next(int i, Unit& u) const {
        const long L = (long)i * G + c; if (L >= nwg) return false;
        int wgid = (int)L; { const int q = nwg / NXCD, r = nwg % NXCD, xcd = wgid % NXCD, off = wgid / NXCD; wgid = (xcd < r ? xcd * (q + 1) : r * (q + 1) + (xcd - r) * q) + off; }
        const int nig = WGM * nN, gid = wgid / nig, fm = gid * WGM, gsz = (nM - fm) < WGM ? (nM - fm) : WGM;
        u.pm = fm + ((wgid % nig) % gsz); u.pn = (wgid % nig) / gsz; return true;
    }
};

template <class Epi, class Sched, bool ALIGN_EPI, bool GATHER>
__device__ __forceinline__ void gemm_phase(LAS unsigned char* lds, const Gemm g, const Sched& S, const Epi& E) {
    int tid = my_tid(); asm volatile("" : "+v"(tid));
    const int wid = __builtin_amdgcn_readfirstlane(tid >> 6), lane = tid & 63, wr = wid >> 2, wc = wid & 3, fr = lane & 15, fq = lane >> 4;
    int Kq = g.K; asm volatile("" : "+s"(Kq));
    const int K = Kq, nt = K / BK;
    int RA[2], CA[2];
    unsigned voffA[2], voffB[2];
#pragma unroll
    for (int i = 0; i < 2; ++i) { int R, C; stage_rc(tid * 16 + i * 8192, R, C); const int Rb = Epi::PERM ? ((R & ~31) + perm32(R & 31)) : R;
        RA[i] = R; CA[i] = C; voffA[i] = (unsigned)(R * g.lda + C) * 2u; voffB[i] = (unsigned)(Rb * g.ldb + C) * 2u; }
    const size_t kstep = (size_t)(BK * 2);
    const size_t hstepB = (size_t)HALF * g.ldb * 2, tstepB = 2 * hstepB;
    const size_t hstepA = (size_t)HALF * g.lda * 2, tstepA = 2 * hstepA;
    const unsigned ldsw = (unsigned)wid * 1024u;
    const int aoff = lds_byte(wr * 64 + fr, fq * 8), boff = lds_byte(wc * 32 + fr, fq * 8);
#define PG8_SA(b, h) (((b) * 2 + (h)) * HTB)
#define PG8_SB(b, h) ((4 + (b) * 2 + (h)) * HTB)
#define PG8_STAGEB(bufoff, gbase) do { _Pragma("unroll") for (int _i = 0; _i < 2; ++_i) \
        __builtin_amdgcn_global_load_lds((const unsigned*)((const char*)(gbase) + voffB[_i]), (LAS unsigned*)(lds + (bufoff) + ldsw + _i * 8192), 16, 0, 0); } while (0)
#define PG8_STAGEA(bufoff, kptr, isnext, h) do { _Pragma("unroll") for (int _i = 0; _i < 2; ++_i) { const char* _p; \
        if constexpr (GATHER) _p = (const char*)(kptr) + ((isnext) ? nvo[h][_i] : cvo[h][_i]); else _p = (const char*)(kptr) + (size_t)(h) * hstepA + voffA[_i]; \
        __builtin_amdgcn_global_load_lds((const unsigned*)_p, (LAS unsigned*)(lds + (bufoff) + ldsw + _i * 8192), 16, 0, 0); } } while (0)
#define PG8_LDA(dst, b, h) do { _Pragma("unroll") for (int m = 0; m < 4; ++m) _Pragma("unroll") for (int k = 0; k < 2; ++k) dst[m][k] = *(const LAS bf16x8*)(lds + PG8_SA(b, h) + aoff + m * 2048 + k * 1024); } while (0)
#define PG8_LDB(dst, b, h) do { _Pragma("unroll") for (int n = 0; n < 2; ++n) _Pragma("unroll") for (int k = 0; k < 2; ++k) dst[n][k] = *(const LAS bf16x8*)(lds + PG8_SB(b, h) + boff + n * 2048 + k * 1024); } while (0)
#define PG8_MMA(ai, bj, At, Bt) do { __builtin_amdgcn_s_setprio(1); _Pragma("unroll") for (int m = 0; m < 4; ++m) _Pragma("unroll") for (int n = 0; n < 2; ++n) _Pragma("unroll") for (int k = 0; k < 2; ++k) \
        acc[ai][bj][m][n] = __builtin_amdgcn_mfma_f32_16x16x32_bf16(Bt[n][k], At[m][k], acc[ai][bj][m][n], 0, 0, 0); __builtin_amdgcn_s_setprio(0); } while (0)
#define PG8_WAIT_V(n) asm volatile("s_waitcnt vmcnt(" #n ")" ::: "memory")
#define PG8_WAIT_L(n) asm volatile("s_waitcnt lgkmcnt(" #n ")" ::: "memory")
#define PG8_BAR __builtin_amdgcn_s_barrier()
#define PG8_SCHED __builtin_amdgcn_sched_barrier(0)
#define PG8_VOA(vo, u) do { _Pragma("unroll") for (int _h = 0; _h < 2; ++_h) _Pragma("unroll") for (int _i = 0; _i < 2; ++_i) { \
        int _row = (u).pm * BM + _h * HALF + RA[_i]; if (GATHER) { _row = g.gidx[_row]; _row = _row < 0 ? 0 : _row; } \
        (vo)[_h][_i] = (unsigned)_row * (unsigned)(g.lda * 2) + (unsigned)(CA[_i] * 2); } } while (0)
    Unit cur, nxt; int ui = 0;
    if (!S.next(0, cur)) return;
    f32x4 acc[2][2][4][2];
#pragma unroll
    for (int a = 0; a < 2; ++a)
#pragma unroll
        for (int b = 0; b < 2; ++b)
#pragma unroll
            for (int m = 0; m < 4; ++m)
#pragma unroll
                for (int n = 0; n < 2; ++n) acc[a][b][m][n] = (f32x4){0.f, 0.f, 0.f, 0.f};
    bf16x8 At[4][2], B0[2][2], B1[2][2];
    unsigned cvo[2][2], nvo[2][2];
    if constexpr (GATHER) { PG8_VOA(cvo, cur); PG8_VOA(nvo, cur); }
    const char* cA = (const char*)g.A + (GATHER ? (size_t)0 : (size_t)cur.pm * tstepA); const char* cB = (const char*)g.Bt + (size_t)cur.pn * tstepB;
    PG8_STAGEB(PG8_SB(0, 0), cB); PG8_STAGEB(PG8_SB(0, 1), cB + hstepB); PG8_STAGEA(PG8_SA(0, 0), cA, false, 0); PG8_STAGEA(PG8_SA(0, 1), cA, false, 1);
    if (wr == 1) PG8_BAR;
    PG8_WAIT_V(2); PG8_BAR;
    PG8_STAGEB(PG8_SB(1, 0), cB + kstep); PG8_STAGEA(PG8_SA(1, 0), cA + kstep, false, 0); PG8_STAGEB(PG8_SB(1, 1), cB + hstepB + kstep);
    PG8_WAIT_V(6); PG8_BAR;
    for (;;) {
        const bool has_next = S.next(ui + 1, nxt);
        if constexpr (GATHER) { if (has_next) { PG8_VOA(nvo, nxt); } }
        const char* nA = (GATHER || !has_next) ? cA : (const char*)g.A + (size_t)nxt.pm * tstepA;
        const char* nB = has_next ? (const char*)g.Bt + (size_t)nxt.pn * tstepB : cB;
#pragma nounroll
        for (int t = 0; t < nt; t += 2) {
            const bool last = (t == nt - 2);
            const char* a1 = cA + (size_t)(t + 1) * kstep;
            const char* a2 = last ? nA : cA + (size_t)(t + 2) * kstep; const char* b2 = last ? nB : cB + (size_t)(t + 2) * kstep;
            const char* a3 = a2 + kstep; const char* b3 = b2 + kstep;
            PG8_LDB(B0, 0, 0); PG8_LDB(B1, 0, 1); PG8_SCHED; PG8_LDA(At, 0, 0); PG8_STAGEA(PG8_SA(1, 1), a1, false, 1);
            PG8_WAIT_V(8); PG8_WAIT_L(0); PG8_BAR; PG8_MMA(0, 0, At, B0); PG8_MMA(0, 1, At, B1); PG8_BAR; PG8_SCHED;
            PG8_LDA(At, 0, 1); PG8_STAGEB(PG8_SB(0, 0), b2); PG8_STAGEB(PG8_SB(0, 1), b2 + hstepB); PG8_STAGEA(PG8_SA(0, 0), a2, last, 0);
            PG8_WAIT_V(8); PG8_WAIT_L(0); PG8_BAR; PG8_MMA(1, 0, At, B0); PG8_MMA(1, 1, At, B1); PG8_BAR; PG8_SCHED;
            PG8_LDB(B0, 1, 0); PG8_LDB(B1, 1, 1); PG8_SCHED; PG8_LDA(At, 1, 0); PG8_STAGEA(PG8_SA(0, 1), a2, last, 1);
            PG8_WAIT_V(8); PG8_WAIT_L(0); PG8_BAR; PG8_MMA(0, 0, At, B0); PG8_MMA(0, 1, At, B1); PG8_BAR; PG8_SCHED;
            PG8_LDA(At, 1, 1); PG8_STAGEB(PG8_SB(1, 0), b3); PG8_STAGEB(PG8_SB(1, 1), b3 + hstepB); PG8_STAGEA(PG8_SA(1, 0), a3, last, 0);
            PG8_WAIT_V(8); PG8_WAIT_L(0); PG8_BAR; PG8_MMA(1, 0, At, B0); PG8_MMA(1, 1, At, B1); PG8_BAR; PG8_SCHED;
        }
        if constexpr (ALIGN_EPI) { if (wr == 0) PG8_BAR; }
        E(acc, cur, wr, wc, fr, fq);
        if (!has_next) break;
#pragma unroll
        for (int a = 0; a < 2; ++a)
#pragma unroll
            for (int b = 0; b < 2; ++b)
#pragma unroll
                for (int m = 0; m < 4; ++m)
#pragma unroll
                    for (int n = 0; n < 2; ++n) acc[a][b][m][n] = (f32x4){0.f, 0.f, 0.f, 0.f};
        cur = nxt; cA = nA; cB = nB; ++ui;
        if constexpr (GATHER) {
#pragma unroll
            for (int _h = 0; _h < 2; ++_h)
#pragma unroll
                for (int _i = 0; _i < 2; ++_i) cvo[_h][_i] = nvo[_h][_i]; }
        if constexpr (ALIGN_EPI) { if (wr == 1) PG8_BAR; }
    }
    PG8_WAIT_V(0);
    if constexpr (!ALIGN_EPI) { if (wr == 0) PG8_BAR; }
    PG8_BAR;
#undef PG8_SA
#undef PG8_SB
#undef PG8_STAGEA
#undef PG8_STAGEB
#undef PG8_LDA
#undef PG8_LDB
#undef PG8_MMA
#undef PG8_WAIT_V
#undef PG8_WAIT_L
#undef PG8_BAR
#undef PG8_SCHED
#undef PG8_VOA
}

template <class Epi, class Sched, bool GATHER>
__device__ __forceinline__ void gemm_phase_naive(const Gemm g, const Sched& S, const Epi& E) {
    const int tid = threadIdx.x, wid = tid >> 6, lane = tid & 63, wr = wid >> 2, wc = wid & 3, fr = lane & 15, fq = lane >> 4;
    Unit u;
    for (int ui = 0; S.next(ui, u); ++ui) {
        f32x4 acc[2][2][4][2];
#pragma unroll
        for (int a = 0; a < 2; ++a)
#pragma unroll
            for (int b = 0; b < 2; ++b)
#pragma unroll
                for (int m = 0; m < 4; ++m)
#pragma unroll
                    for (int n = 0; n < 2; ++n) acc[a][b][m][n] = (f32x4){0.f, 0.f, 0.f, 0.f};
        const bf16* arow[2][4];
#pragma unroll
        for (int ai = 0; ai < 2; ++ai)
#pragma unroll
            for (int m = 0; m < 4; ++m) { int r = u.pm * BM + ai * HALF + wr * 64 + m * 16 + fr; if (GATHER) { r = g.gidx[r]; r = r < 0 ? 0 : r; } arow[ai][m] = g.A + (size_t)r * g.lda; }
        for (int k = 0; k < g.K; k += 4) {
            float av[2][4][4];
#pragma unroll
            for (int ai = 0; ai < 2; ++ai)
#pragma unroll
                for (int m = 0; m < 4; ++m) { const u32x2 w = *(const u32x2*)(arow[ai][m] + k); av[ai][m][0] = bflo(w.x); av[ai][m][1] = bfhi(w.x); av[ai][m][2] = bflo(w.y); av[ai][m][3] = bfhi(w.y); }
#pragma unroll
            for (int bj = 0; bj < 2; ++bj)
#pragma unroll
                for (int n = 0; n < 2; ++n)
#pragma unroll
                    for (int e = 0; e < 4; ++e) {
                        const int col = u.pn * BM + bj * HALF + wc * 32 + (Epi::PERM ? (8 * fq + 4 * n) : (16 * n + 4 * fq)) + e;
                        const u32x2 w = *(const u32x2*)(g.Bt + (size_t)col * g.ldb + k);
                        const float b0 = bflo(w.x), b1 = bfhi(w.x), b2 = bflo(w.y), b3 = bfhi(w.y);
#pragma unroll
                        for (int ai = 0; ai < 2; ++ai)
#pragma unroll
                            for (int m = 0; m < 4; ++m) acc[ai][bj][m][n][e] += av[ai][m][0] * b0 + av[ai][m][1] * b1 + av[ai][m][2] * b2 + av[ai][m][3] * b3;
                    }
        }
        E(acc, u, wr, wc, fr, fq);
    }
    VM_WAIT(); __syncthreads();
}
}
namespace g128 {
using pg8::lds_byte; using pg8::stage_rc; using pg8::HTB; using pg8::BK;
struct Seg { const bf16* A; const bf16* B; int lda, ldb, nt; };
typedef f32x4 acc_t[2][4][2];

template <class Prog>
__device__ __forceinline__ void stream(LAS unsigned char* lds, Prog& P, int nunits, int first, int stride) {
    int tid = my_tid(); asm volatile("" : "+v"(tid));
    const int wid = __builtin_amdgcn_readfirstlane(tid >> 6), lane = tid & 63, wr = wid >> 2, wc = wid & 3, fr = lane & 15, fq = lane >> 4;
    int RA[2], CA[2], RB[2];
#pragma unroll
    for (int i = 0; i < 2; ++i) { stage_rc(tid * 16 + i * 8192, RA[i], CA[i]); RB[i] = (RA[i] & ~31) + pg8::perm32(RA[i] & 31); }
    const unsigned ldsw = (unsigned)wid * 1024u;
    const int aoff = lds_byte(wr * 64 + fr, fq * 8), boff = lds_byte(wc * 32 + fr, fq * 8);
#define G_SA(b) ((b) * HTB)
#define G_SB(b, h) ((2 + (b) * 2 + (h)) * HTB)
#define G_STAGE(bufoff, base, ld, kbyte, RR) do { _Pragma("unroll") for (int _i = 0; _i < 2; ++_i) \
        __builtin_amdgcn_global_load_lds((const unsigned*)((const char*)(base) + (size_t)(kbyte) + (unsigned)(RR[_i] * (ld) + CA[_i]) * 2u), (LAS unsigned*)(lds + (bufoff) + ldsw + _i * 8192), 16, 0, 0); } while (0)
#define G_STAGE_A(b, S, j) G_STAGE(G_SA(b), (S).A, (S).lda, (j) * 128, RA)
#define G_STAGE_B(b, h, S, j) G_STAGE(G_SB(b, h), (const char*)(S).B + (size_t)(h) * 128 * (S).ldb * 2, (S).ldb, (j) * 128, RB)
#define G_LDA(dst, b) do { _Pragma("unroll") for (int m = 0; m < 4; ++m) _Pragma("unroll") for (int k = 0; k < 2; ++k) dst[m][k] = *(const LAS bf16x8*)(lds + G_SA(b) + aoff + m * 2048 + k * 1024); } while (0)
#define G_LDB(dst, b, h) do { _Pragma("unroll") for (int n = 0; n < 2; ++n) _Pragma("unroll") for (int k = 0; k < 2; ++k) dst[n][k] = *(const LAS bf16x8*)(lds + G_SB(b, h) + boff + n * 2048 + k * 1024); } while (0)
#define G_MMA(bj, At, Bt) do { __builtin_amdgcn_s_setprio(1); _Pragma("unroll") for (int m = 0; m < 4; ++m) _Pragma("unroll") for (int n = 0; n < 2; ++n) _Pragma("unroll") for (int k = 0; k < 2; ++k) \
        acc[bj][m][n] = __builtin_amdgcn_mfma_f32_16x16x32_bf16(Bt[n][k], At[m][k], acc[bj][m][n], 0, 0, 0); __builtin_amdgcn_s_setprio(0); } while (0)
#define G_WAIT_V(n) asm volatile("s_waitcnt vmcnt(" #n ")" ::: "memory")
#define G_WAIT_L(n) asm volatile("s_waitcnt lgkmcnt(" #n ")" ::: "memory")
#define G_BAR __builtin_amdgcn_s_barrier()
#define G_SCHED __builtin_amdgcn_sched_barrier(0)
    if (first >= nunits) return;
    P.reset();
    int ucur = first, scur = 0;
    Seg cur, nxt;
    P.seg(ucur, scur, cur);
    acc_t acc;
    P.init(ucur, scur, acc, wr, wc, fr, fq);
    bf16x8 At[4][2], B0[2][2], B1[2][2];
    G_STAGE_B(0, 0, cur, 0); G_STAGE_A(0, cur, 0); G_STAGE_B(0, 1, cur, 0);
    if (wr == 1) G_BAR;
    G_WAIT_V(2); G_BAR;
    G_STAGE_A(1, cur, 1); G_STAGE_B(1, 0, cur, 1);
    G_WAIT_V(4); G_BAR;
#define G_TILE(t_, b_) do { const bool n1_ = ((t_) + 1 >= nt), n2_ = ((t_) + 2 >= nt); const int j1_ = n1_ ? ((t_) + 1 - nt) : ((t_) + 1), j2_ = n2_ ? ((t_) + 2 - nt) : ((t_) + 2); \
        G_LDB(B0, b_, 0); G_SCHED; G_LDA(At, b_); \
        if (n1_) G_STAGE_B((b_) ^ 1, 1, nxt, j1_); else G_STAGE_B((b_) ^ 1, 1, cur, j1_); \
        G_WAIT_V(6); G_WAIT_L(0); G_BAR; G_MMA(0, At, B0); G_BAR; G_SCHED; \
        G_LDB(B1, b_, 1); \
        if (n2_) { G_STAGE_A(b_, nxt, j2_); G_STAGE_B(b_, 0, nxt, j2_); } else { G_STAGE_A(b_, cur, j2_); G_STAGE_B(b_, 0, cur, j2_); } \
        G_WAIT_V(6); G_WAIT_L(0); G_BAR; G_MMA(1, At, B1); G_BAR; G_SCHED; } while (0)
    for (;;) {
        int unxt = ucur, snxt = scur + 1; bool more = true;
        if (snxt == Prog::NSEG) { snxt = 0; unxt = ucur + stride; if (unxt >= nunits) { more = false; unxt = ucur; snxt = scur; } }
        P.seg(unxt, snxt, nxt);
        int ntq = cur.nt; asm volatile("" : "+s"(ntq)); const int nt = ntq;
#pragma nounroll
        for (int t = 0; t < nt; t += 2) { G_TILE(t, 0); G_TILE(t + 1, 1); }
        P.done(ucur, scur, acc, wr, wc, fr, fq);
        if (!more) break;
        P.init(unxt, snxt, acc, wr, wc, fr, fq);
        ucur = unxt; scur = snxt; cur = nxt;
    }
    G_WAIT_V(0);
    if (wr == 0) G_BAR;
    G_BAR;
#undef G_SA
#undef G_SB
#undef G_STAGE
#undef G_STAGE_A
#undef G_STAGE_B
#undef G_LDA
#undef G_LDB
#undef G_MMA
#undef G_WAIT_V
#undef G_WAIT_L
#undef G_BAR
#undef G_SCHED
#undef G_TILE
}

struct MergeProg {
    static constexpr int NSEG = 8;
    const bf16* Hn; const bf16* zin; const bf16* wg; const bf16* wb; const float* bg; bf16* M;
    __device__ __forceinline__ void reset() {
#pragma unroll
        for (int a = 0; a < 2; ++a)
#pragma unroll
            for (int b = 0; b < 4; ++b)
#pragma unroll
                for (int c = 0; c < 2; ++c) { g[a][b][c] = (u32x2){0u, 0u}; macc[a][b][c] = (u32x2){0u, 0u}; } }
    u32x2 g[2][4][2]; u32x2 macc[2][4][2];
    __device__ __forceinline__ void seg(int u, int s, Seg& S) const {
        const int pm = u >> 2, pn = u & 3, k = s >> 1;
        if ((s & 1) == 0) { S.A = Hn + (size_t)pm * 128 * D; S.lda = D; S.B = wg + ((size_t)k * D + pn * 256) * D; S.ldb = D; S.nt = D / 64; }
        else { const int ycol = (k == 0) ? ZC_U : (k == 1) ? ZC_FQ : (k == 2) ? ZC_CQ : ZC_DQ;
               S.A = zin + (size_t)pm * 128 * ZP + ycol; S.lda = ZP; S.B = wb + ((size_t)k * D + pn * 256) * 256; S.ldb = 256; S.nt = 4; }
    }
    __device__ __forceinline__ void init(int u, int s, acc_t& acc, int wr, int wc, int fr, int fq) {
        const int pn = u & 3, k = s >> 1;
        if ((s & 1) == 0) {
#pragma unroll
            for (int bj = 0; bj < 2; ++bj)
#pragma unroll
                for (int n = 0; n < 2; ++n) { const f32x4 bv = *(const f32x4*)(bg + (size_t)k * D + pn * 256 + bj * 128 + wc * 32 + 8 * fq + 4 * n);
#pragma unroll
                    for (int m = 0; m < 4; ++m) acc[bj][m][n] = bv; }
            if (s == 0) {
#pragma unroll
                for (int bj = 0; bj < 2; ++bj)
#pragma unroll
                    for (int m = 0; m < 4; ++m)
#pragma unroll
                        for (int n = 0; n < 2; ++n) macc[bj][m][n] = (u32x2){0u, 0u}; }
        } else {
#pragma unroll
            for (int bj = 0; bj < 2; ++bj)
#pragma unroll
                for (int m = 0; m < 4; ++m)
#pragma unroll
                    for (int n = 0; n < 2; ++n) acc[bj][m][n] = (f32x4){0.f, 0.f, 0.f, 0.f};
        }
    }
    __device__ __forceinline__ void done(int u, int s, const acc_t& acc, int wr, int wc, int fr, int fq) {
        if ((s & 1) == 0) {
#pragma unroll
            for (int bj = 0; bj < 2; ++bj)
#pragma unroll
                for (int m = 0; m < 4; ++m)
#pragma unroll
                    for (int n = 0; n < 2; ++n) { const f32x4 a = acc[bj][m][n]; u32x2 w; w.x = pk2(sigmoidf_(a[0]), sigmoidf_(a[1])); w.y = pk2(sigmoidf_(a[2]), sigmoidf_(a[3])); g[bj][m][n] = w; }
        } else {
#pragma unroll
            for (int bj = 0; bj < 2; ++bj)
#pragma unroll
                for (int m = 0; m < 4; ++m)
#pragma unroll
                    for (int n = 0; n < 2; ++n) { const u32x2 w = g[bj][m][n], q = macc[bj][m][n]; const f32x4 v = (f32x4){bflo(q.x), bfhi(q.x), bflo(q.y), bfhi(q.y)} + (f32x4){bflo(w.x), bfhi(w.x), bflo(w.y), bfhi(w.y)} * acc[bj][m][n];
                        u32x2 r; r.x = pk2(v[0], v[1]); r.y = pk2(v[2], v[3]); macc[bj][m][n] = r; }
            if (s == NSEG - 1) { const int pm = u >> 2, pn = u & 3;
#pragma unroll
                for (int m = 0; m < 4; ++m) { bf16* rp = M + (size_t)(pm * 128 + wr * 64 + m * 16 + fr) * D + pn * 256 + wc * 32 + 8 * fq;
#pragma unroll
                    for (int bj = 0; bj < 2; ++bj) *(u32x4*)(rp + bj * 128) = (u32x4){macc[bj][m][0].x, macc[bj][m][0].y, macc[bj][m][1].x, macc[bj][m][1].y}; } }
        }
    }
};

struct PleProg {
    static constexpr int NSEG = 8;
    const bf16* pbf; const bf16* hp; const bf16* wup; const bf16* wpg; bf16* x;
    u32x2 uu[2][4][2];
    __device__ __forceinline__ void reset() {
#pragma unroll
        for (int a = 0; a < 2; ++a)
#pragma unroll
            for (int b = 0; b < 4; ++b)
#pragma unroll
                for (int c = 0; c < 2; ++c) uu[a][b][c] = (u32x2){0u, 0u}; }
    __device__ __forceinline__ void seg(int u, int s, Seg& S) const {
        const int pn = s >> 1;
        if ((s & 1) == 0) { S.A = pbf + (size_t)u * 128 * 256; S.lda = 256; S.B = wup + (size_t)pn * 256 * 256; S.ldb = 256; S.nt = 4; }
        else { S.A = hp + (size_t)u * 128 * D; S.lda = D; S.B = wpg + (size_t)pn * 256 * D; S.ldb = D; S.nt = D / 64; }
    }
    __device__ __forceinline__ void init(int u, int s, acc_t& acc, int wr, int wc, int fr, int fq) {
#pragma unroll
        for (int bj = 0; bj < 2; ++bj)
#pragma unroll
            for (int m = 0; m < 4; ++m)
#pragma unroll
                for (int n = 0; n < 2; ++n) acc[bj][m][n] = (f32x4){0.f, 0.f, 0.f, 0.f};
    }
    __device__ __forceinline__ void done(int u, int s, const acc_t& acc, int wr, int wc, int fr, int fq) {
        if ((s & 1) == 0) {
#pragma unroll
            for (int bj = 0; bj < 2; ++bj)
#pragma unroll
                for (int m = 0; m < 4; ++m)
#pragma unroll
                    for (int n = 0; n < 2; ++n) { const f32x4 a = acc[bj][m][n]; u32x2 w; w.x = pk2(a[0], a[1]); w.y = pk2(a[2], a[3]); uu[bj][m][n] = w; }
        } else { const int pn = s >> 1;
#pragma unroll
            for (int m = 0; m < 4; ++m) { bf16* rp = x + (size_t)(u * 128 + wr * 64 + m * 16 + fr) * D + pn * 256 + wc * 32 + 8 * fq; u32x4 xv[2];
#pragma unroll
                for (int bj = 0; bj < 2; ++bj) xv[bj] = *(const u32x4*)(rp + bj * 128);
#pragma unroll
                for (int bj = 0; bj < 2; ++bj) { const u32x4 xw = xv[bj]; f32x4 r[2];
#pragma unroll
                    for (int n = 0; n < 2; ++n) { const u32x2 w = uu[bj][m][n]; f32x4 v = acc[bj][m][n];
                        v[0] = sigmoidf_(v[0]); v[1] = sigmoidf_(v[1]); v[2] = sigmoidf_(v[2]); v[3] = sigmoidf_(v[3]);
                        const f32x4 xo = n == 0 ? (f32x4){bflo(xw.x), bfhi(xw.x), bflo(xw.y), bfhi(xw.y)} : (f32x4){bflo(xw.z), bfhi(xw.z), bflo(xw.w), bfhi(xw.w)};
                        r[n] = xo + (f32x4){bflo(w.x), bfhi(w.x), bflo(w.y), bfhi(w.y)} * v; }
                    *(u32x4*)(rp + bj * 128) = (u32x4){pk2(r[0][0], r[0][1]), pk2(r[0][2], r[0][3]), pk2(r[1][0], r[1][1]), pk2(r[1][2], r[1][3])}; } } }
    }
};
}
namespace epi {
using pg8::Unit; using pg8::BM; using pg8::HALF;
__device__ __forceinline__ void epi_fence() { asm volatile("" ::: "memory"); }
#define EPI_FENCE epi_fence()
#define EPI_LOOP_ROWS for (int ai = 0; ai < 2; ++ai) _Pragma("unroll") for (int m = 0; m < 4; ++m)
#define EPI_LOOP_COLS for (int bj = 0; bj < 2; ++bj) _Pragma("unroll") for (int n = 0; n < 2; ++n)
#define EPI_ROW (u.pm * BM + ai * HALF + wr * 64 + m * 16 + fr)
#define EPI_COLT (bj * HALF + wc * 32 + n * 16 + 4 * fq)
typedef f32x4 acc_t[2][2][4][2];
#define EPI_C8(bj_) ((bj_) * HALF + wc * 32 + 8 * fq)
__device__ __forceinline__ u32x4 pack8(f32x4 a, f32x4 b) { return (u32x4){pk2(a[0], a[1]), pk2(a[2], a[3]), pk2(b[0], b[1]), pk2(b[2], b[3])}; }
__device__ __forceinline__ u32x2 pack4(f32x4 v) { u32x2 w; w.x = pk2(v[0], v[1]); w.y = pk2(v[2], v[3]); return w; }
__device__ __forceinline__ f32x4 unpack4(u32x2 w) { return (f32x4){bflo(w.x), bfhi(w.x), bflo(w.y), bfhi(w.y)}; }

struct EpiStore {
    static constexpr bool PERM = true;
    bf16* O; int ldc; int pn0;
    __device__ __forceinline__ void operator()(const acc_t& acc, const Unit& u, int wr, int wc, int fr, int fq) const {
#pragma unroll
        EPI_LOOP_ROWS { bf16* rp = O + (size_t)EPI_ROW * ldc + (u.pn - pn0) * BM + wc * 32 + 8 * fq;
#pragma unroll
            for (int bj = 0; bj < 2; ++bj) { const u32x2 lo = pack4(acc[ai][bj][m][0]), hi = pack4(acc[ai][bj][m][1]); *(u32x4*)(rp + bj * HALF) = (u32x4){lo.x, lo.y, hi.x, hi.y}; } }
    }
};
struct EpiRowScale {
    static constexpr bool PERM = true;
    bf16* O; int ldc; const float* rs;
    __device__ __forceinline__ void operator()(const acc_t& acc, const Unit& u, int wr, int wc, int fr, int fq) const {
        float sv[2][4];
#pragma unroll
        EPI_LOOP_ROWS sv[ai][m] = rs[EPI_ROW];
#pragma unroll
        EPI_LOOP_ROWS { const int row = EPI_ROW; const float s = sv[ai][m]; bf16* rp = O + (size_t)row * ldc + u.pn * BM;
#pragma unroll
            for (int bj = 0; bj < 2; ++bj) *(u32x4*)(rp + EPI_C8(bj)) = pack8(acc[ai][bj][m][0] * s, acc[ai][bj][m][1] * s); }
    }
};
struct EpiMlaQ {
    static constexpr bool PERM = false;
    bf16* O; const float* rs; const float* cosT; const float* sinT;
    __device__ __forceinline__ void operator()(const acc_t& acc, const Unit& u, int wr, int wc, int fr, int fq) const {
        float sv[2][4]; f32x4 csv[2], snv[2];
#pragma unroll
        EPI_LOOP_ROWS sv[ai][m] = rs[EPI_ROW];
        { const int row = u.pm * BM + wr * 64 + fr; csv[0] = *(const f32x4*)(cosT + (size_t)row * 16 + 4 * fq); snv[0] = *(const f32x4*)(sinT + (size_t)row * 16 + 4 * fq); }
#pragma unroll
        for (int it = 0; it < 8; ++it) { const int ai = it >> 2, m = it & 3;
            if (it + 1 < 8) { const int row = u.pm * BM + ((it + 1) >> 2) * HALF + wr * 64 + ((it + 1) & 3) * 16 + fr;
                csv[(it + 1) & 1] = *(const f32x4*)(cosT + (size_t)row * 16 + 4 * fq); snv[(it + 1) & 1] = *(const f32x4*)(sinT + (size_t)row * 16 + 4 * fq); }
            const int row = EPI_ROW; const float s = sv[ai][m]; bf16* rp = O + (size_t)row * 512 + u.pn * BM;
            const f32x4 cs = csv[it & 1], sn = snv[it & 1];
#pragma unroll
            for (int bj = 0; bj < 2; ++bj) { const int grp = u.pn * 8 + bj * 4 + wc;
                f32x4 t1 = acc[ai][bj][m][0] * s, t2 = acc[ai][bj][m][1] * s;
                if (grp % 3 == 2) { const f32x4 a = t1 * cs - t2 * sn, b = t2 * cs + t1 * sn; t1 = a; t2 = b; }
                *(u32x2*)(rp + bj * HALF + wc * 32 + 4 * fq) = pack4(t1); *(u32x2*)(rp + bj * HALF + wc * 32 + 16 + 4 * fq) = pack4(t2); } }
    }
};
struct EpiGate {
    static constexpr bool PERM = false;
    bf16* G; const float* bias;
    __device__ __forceinline__ void operator()(const acc_t& acc, const Unit& u, int wr, int wc, int fr, int fq) const {
        f32x4 bv[2][2];
#pragma unroll
        EPI_LOOP_COLS bv[bj][n] = *(const f32x4*)(bias + u.pn * BM + EPI_COLT);
#pragma unroll
        EPI_LOOP_ROWS { bf16* rp = G + (size_t)EPI_ROW * D + u.pn * BM;
#pragma unroll
            EPI_LOOP_COLS { f32x4 v = acc[ai][bj][m][n] + bv[bj][n];
                v[0] = sigmoidf_(v[0]); v[1] = sigmoidf_(v[1]); v[2] = sigmoidf_(v[2]); v[3] = sigmoidf_(v[3]);
                *(u32x2*)(rp + EPI_COLT) = pack4(v); } }
    }
};
#define EPI_IT_ROW(it_) (u.pm * BM + ((it_) >> 2) * HALF + wr * 64 + ((it_) & 3) * 16 + fr)
#define EPI_C4(c_) (((c_) >> 1) * HALF + wc * 32 + ((c_) & 1) * 16 + 4 * fq)
struct EpiMerge {
    static constexpr bool PERM = false;
    const bf16* G; bf16* M; int first;
    __device__ __forceinline__ void operator()(const acc_t& acc, const Unit& u, int wr, int wc, int fr, int fq) const {
        u32x2 gv[2][4], mv[2][4];
#define EPI_LD(it_) do { const size_t ro_ = (size_t)EPI_IT_ROW(it_) * D + u.pn * BM; _Pragma("unroll") for (int c = 0; c < 4; ++c) { gv[(it_) & 1][c] = *(const u32x2*)(G + ro_ + EPI_C4(c)); \
            mv[(it_) & 1][c] = first ? (u32x2){0u, 0u} : *(const u32x2*)(M + ro_ + EPI_C4(c)); } } while (0)
        EPI_LD(0);
#pragma unroll
        for (int it = 0; it < 8; ++it) { if (it + 1 < 8) EPI_LD(it + 1);
            const size_t ro = (size_t)EPI_IT_ROW(it) * D + u.pn * BM;
#pragma unroll
            for (int c = 0; c < 4; ++c) { const f32x4 v = unpack4(gv[it & 1][c]) * acc[it >> 2][c >> 1][it & 3][c & 1] + unpack4(mv[it & 1][c]); *(u32x2*)(M + ro + EPI_C4(c)) = pack4(v); } }
#undef EPI_LD
    }
};
struct EpiRes {
    static constexpr bool PERM = true;
    XSrc xin; bf16* xout;
    __device__ __forceinline__ void operator()(const acc_t& acc, const Unit& u, int wr, int wc, int fr, int fq) const {
        f32x4 xv[2][2][2];
#define EPI_LD(it_) do { const size_t ro_ = (size_t)EPI_IT_ROW(it_) * D + u.pn * BM; _Pragma("unroll") for (int bj = 0; bj < 2; ++bj) { \
            if (xin.f) { xv[(it_) & 1][bj][0] = *(const f32x4*)(xin.f + ro_ + EPI_C8(bj)); xv[(it_) & 1][bj][1] = *(const f32x4*)(xin.f + ro_ + EPI_C8(bj) + 4); } \
            else { const u32x4 w_ = *(const u32x4*)(xin.b + ro_ + EPI_C8(bj)); xv[(it_) & 1][bj][0] = (f32x4){bflo(w_.x), bfhi(w_.x), bflo(w_.y), bfhi(w_.y)}; xv[(it_) & 1][bj][1] = (f32x4){bflo(w_.z), bfhi(w_.z), bflo(w_.w), bfhi(w_.w)}; } } } while (0)
        EPI_LD(0);
#pragma unroll
        for (int it = 0; it < 8; ++it) { if (it + 1 < 8) EPI_LD(it + 1);
            const size_t ro = (size_t)EPI_IT_ROW(it) * D + u.pn * BM;
#pragma unroll
            for (int bj = 0; bj < 2; ++bj) *(u32x4*)(xout + ro + EPI_C8(bj)) = pack8(xv[it & 1][bj][0] + acc[it >> 2][bj][it & 3][0], xv[it & 1][bj][1] + acc[it >> 2][bj][it & 3][1]); }
#undef EPI_LD
    }
};
struct EpiPle {
    static constexpr bool PERM = false;
    const bf16* U; float* x;
    __device__ __forceinline__ void operator()(const acc_t& acc, const Unit& u, int wr, int wc, int fr, int fq) const {
        f32x4 xv[2][4]; u32x2 uv[2][4];
#define EPI_LD(it_) do { const size_t ro_ = (size_t)EPI_IT_ROW(it_) * D + u.pn * BM; _Pragma("unroll") for (int c = 0; c < 4; ++c) { xv[(it_) & 1][c] = *(const f32x4*)(x + ro_ + EPI_C4(c)); uv[(it_) & 1][c] = *(const u32x2*)(U + ro_ + EPI_C4(c)); } } while (0)
        EPI_LD(0);
#pragma unroll
        for (int it = 0; it < 8; ++it) { if (it + 1 < 8) EPI_LD(it + 1);
            const size_t ro = (size_t)EPI_IT_ROW(it) * D + u.pn * BM;
#pragma unroll
            for (int c = 0; c < 4; ++c) { f32x4 v = acc[it >> 2][c >> 1][it & 3][c & 1];
                v[0] = sigmoidf_(v[0]); v[1] = sigmoidf_(v[1]); v[2] = sigmoidf_(v[2]); v[3] = sigmoidf_(v[3]);
                *(f32x4*)(x + ro + EPI_C4(c)) = xv[it & 1][c] + unpack4(uv[it & 1][c]) * v; } }
#undef EPI_LD
    }
};
struct EpiSwiglu {
    static constexpr bool PERM = true;
    bf16* O; int ldc; int npt;
    __device__ __forceinline__ void operator()(const acc_t& acc, const Unit& u, int wr, int wc, int fr, int fq) const {
        const int ct = (u.pn % npt) * HALF;
#pragma unroll
        EPI_LOOP_ROWS { bf16* rp = O + (size_t)EPI_ROW * ldc + ct + wc * 32 + 8 * fq; u32x2 w[2];
#pragma unroll
            for (int n = 0; n < 2; ++n) { const f32x4 a = acc[ai][0][m][n], b = acc[ai][1][m][n]; f32x4 v;
#pragma unroll
                for (int e = 0; e < 4; ++e) v[e] = a[e] * sigmoidf_(a[e]) * b[e];
                w[n] = pack4(v); }
            *(u32x4*)rp = (u32x4){w[0].x, w[0].y, w[1].x, w[1].y}; }
    }
};
struct EpiGlu {
    static constexpr bool PERM = true;
    bf16* Y; int ldc;
    __device__ __forceinline__ void operator()(const acc_t& acc, const Unit& u, int wr, int wc, int fr, int fq) const {
        u32x4 yv[2][2];
#define EPI_LD(it_) do { const bf16* rp_ = Y + (size_t)EPI_IT_ROW(it_) * ldc + u.pn * BM; _Pragma("unroll") for (int bj = 0; bj < 2; ++bj) yv[(it_) & 1][bj] = *(const u32x4*)(rp_ + EPI_C8(bj)); } while (0)
        EPI_LD(0);
#pragma unroll
        for (int it = 0; it < 8; ++it) { if (it + 1 < 8) EPI_LD(it + 1);
            bf16* rp = Y + (size_t)EPI_IT_ROW(it) * ldc + u.pn * BM;
#pragma unroll
            for (int bj = 0; bj < 2; ++bj) { const u32x4 w = yv[it & 1][bj]; f32x4 a = acc[it >> 2][bj][it & 3][0], b = acc[it >> 2][bj][it & 3][1];
                a[0] = bflo(w.x) * sigmoidf_(a[0]); a[1] = bfhi(w.x) * sigmoidf_(a[1]); a[2] = bflo(w.y) * sigmoidf_(a[2]); a[3] = bfhi(w.y) * sigmoidf_(a[3]);
                b[0] = bflo(w.z) * sigmoidf_(b[0]); b[1] = bfhi(w.z) * sigmoidf_(b[1]); b[2] = bflo(w.w) * sigmoidf_(b[2]); b[3] = bfhi(w.w) * sigmoidf_(b[3]);
                *(u32x4*)(rp + EPI_C8(bj)) = pack8(a, b); } }
#undef EPI_LD
    }
};
struct EpiMoeDown {
    static constexpr bool PERM = true;
    bf16* Y; const float* slot_gate;
    __device__ __forceinline__ void operator()(const acc_t& acc, const Unit& u, int wr, int wc, int fr, int fq) const {
        const int ct = (u.pn & 3) * BM;
        float gv[2][4];
#pragma unroll
        EPI_LOOP_ROWS gv[ai][m] = slot_gate[EPI_ROW];
#pragma unroll
        EPI_LOOP_ROWS { const int row = EPI_ROW; const float gt = gv[ai][m]; bf16* rp = Y + (size_t)row * D + ct;
#pragma unroll
            for (int bj = 0; bj < 2; ++bj) *(u32x4*)(rp + EPI_C8(bj)) = pack8(acc[ai][bj][m][0] * gt, acc[ai][bj][m][1] * gt); }
    }
};
}
namespace att {
constexpr int MODE_FOX = 0, MODE_MLA = 1, MODE_BAND = 2;
constexpr float LOG2E = 1.4426950408889634f;
struct Tensors {
    const bf16* Q; int ldq;
    const bf16* K; int ldk;
    const bf16* K2;
    const bf16* V; int ldv;
    bf16* O; int ldo;
    const float* cdec;
    const float* relb;
    int qhs, khs, vhs, ohs;
    const unsigned* qmax; const unsigned* kmax;
};
template <int DQK> struct Lay { static constexpr int KS = DQK * 2 + 16, KB = 64 * KS, VB = 64 * 128, CB = 256, BUF = KB + VB + CB; };
constexpr int ATT_LDS_TAB = 2 * Lay<96>::BUF;
constexpr int ATT_LDS_BYTES = ATT_LDS_TAB + 520 * 4;
__device__ __forceinline__ int crow(int r, int hi) { return (r & 3) + 8 * (r >> 2) + 4 * hi; }
typedef short v4i16_t __attribute__((ext_vector_type(4)));
__device__ __forceinline__ s16x4 vtr(const LAS unsigned char* p) { return __builtin_bit_cast(s16x4, __builtin_amdgcn_ds_read_tr16_b64_v4i16((LAS v4i16_t*)p)); }

template <int MODE>
__device__ __forceinline__ void attn_unit(const Tensors& T, int b, int h, int qb, LAS unsigned char* lds) {
    constexpr int DQK = (MODE == MODE_MLA) ? 96 : 64, NKS = DQK / 16;
    typedef Lay<DQK> LY;
    int tid = my_tid(); asm volatile("" : "+v"(tid));
    const int lane = tid & 63, r32 = lane & 31, hi = lane >> 5; const int wid = __builtin_amdgcn_readfirstlane(tid >> 6);
    const int rowb = b * SEQ, q0 = qb * 256;
    const float sc2 = ((MODE == MODE_MLA) ? 0.10206207261596575f : 0.125f) * LOG2E;
    const int cw = 4 * qb + (wid >> 1);
    const int t_lo = (MODE == MODE_BAND) ? ((4 * qb - 8) > 0 ? (4 * qb - 8) : 0) : 0, t_hi = 4 * qb + 4;
    const int qrow = rowb + q0 + wid * 32 + r32;
    bf16x8 qf[NKS];
    { const bf16* qp = T.Q + (size_t)qrow * T.ldq + h * T.qhs + hi * 8;
#pragma unroll
      for (int ks = 0; ks < NKS; ++ks) qf[ks] = *(const bf16x8*)(qp + ks * 16); }
    float cq = 0.f; if (MODE == MODE_FOX) cq = T.cdec[(size_t)qrow * 4 + h];
    LAS float* tab = (LAS float*)(lds + ATT_LDS_TAB);
    if (MODE == MODE_BAND) { for (int i = tid; i < 513; i += NTHREADS) tab[i] = T.relb[h * 513 + i] * LOG2E; }
    u32x4 kreg0[2] = {}, kreg1[2] = {}, vreg[2] = {}; float creg[2] = {0.f, 0.f};
    const int srow = tid >> 3, sch = tid & 7;
#define ATT_KADDR(c_) (((c_) % 12 < 8) ? (const u32x4*)(T.K + (kr_ + (c_) / 12) * T.ldk + h * T.khs + ((c_) % 12) * 8) : (const u32x4*)(T.K2 + (kr_ + (c_) / 12) * 32 + ((c_) % 12 - 8) * 8))
#define ATT_LOAD_TILE(t_, r_) do { const size_t kr_ = (size_t)(rowb + (t_) * 64); \
        if (MODE == MODE_MLA) { kreg0[r_] = *ATT_KADDR(tid); if (tid < 256) kreg1[r_] = *ATT_KADDR(tid + 512); } \
        else { kreg0[r_] = *(const u32x4*)(T.K + (kr_ + srow) * T.ldk + h * T.khs + sch * 8); } \
        vreg[r_] = *(const u32x4*)(T.V + (kr_ + srow) * T.ldv + h * T.vhs + sch * 8); \
        if (MODE == MODE_FOX) { if (tid < 64) creg[r_] = T.cdec[(kr_ + tid) * 4 + h]; } } while (0)
#define ATT_STORE_TILE(buf_, r_) do { LAS unsigned char* base_ = lds + (buf_) * LY::BUF; \
        if (MODE == MODE_MLA) { *(LAS u32x4*)(base_ + (tid / 12) * LY::KS + (tid % 12) * 16) = kreg0[r_]; \
            if (tid < 256) *(LAS u32x4*)(base_ + ((tid + 512) / 12) * LY::KS + ((tid + 512) % 12) * 16) = kreg1[r_]; } \
        else { *(LAS u32x4*)(base_ + srow * LY::KS + sch * 16) = kreg0[r_]; } \
        *(LAS u32x4*)(base_ + LY::KB + srow * 128 + ((sch * 16) ^ (((srow >> 1) & 1) << 6))) = vreg[r_]; \
        if (MODE == MODE_FOX) { if (tid < 64) *(LAS float*)(base_ + LY::KB + LY::VB + tid * 4) = creg[r_]; } } while (0)
    float mrun = -INFINITY, lrun = 0.f;
    f32x16 o0 = {}, o1 = {};
    const int G = lane >> 4, qi = (lane & 15) >> 2, pi = lane & 3;
    const int vb0 = (4 * hi + qi) * 128 + 64 * (0 ^ (qi >> 1)) + 32 * (G & 1) + 8 * pi;
    const int vb1 = (4 * hi + qi) * 128 + 64 * (1 ^ (qi >> 1)) + 32 * (G & 1) + 8 * pi;
    int t_min = t_lo;
    if (MODE == MODE_FOX) {
        LAS int* tm = (LAS int*)(lds + ATT_LDS_TAB);
        if (tid == 0) tm[0] = t_hi - 1;
        __syncthreads();
        if (tid < t_hi) {
            const float q2 = __uint_as_float(T.qmax[(b * 4 + h) * 32 + qb]), k2 = __uint_as_float(T.kmax[b * 4 + h]);
            const float thr = 0.125f * sqrtf(q2) * 2.0f * sqrtf(k2) * 1.02f + 112.0f;
            const float cfirst = T.cdec[(size_t)(rowb + q0) * 4 + h], clast = T.cdec[(size_t)(rowb + tid * 64 + 63) * 4 + h];
            if (!(clast - cfirst > thr)) __hip_atomic_fetch_min(tm, tid, __ATOMIC_RELAXED, __HIP_MEMORY_SCOPE_WORKGROUP);
        }
        __syncthreads();
        t_min = tm[0];
    }
    const int n_t = t_hi - t_min;
#define ATT_TILE(i_) ((MODE == MODE_FOX) ? (t_hi - 1 - (i_)) : (t_min + (i_)))
    ATT_LOAD_TILE(ATT_TILE(0), 0); ATT_STORE_TILE(0, 0);
    if (n_t > 1) ATT_LOAD_TILE(ATT_TILE(1), 1);
    if (n_t > 2) ATT_LOAD_TILE(ATT_TILE(2), 0);
    __syncthreads();
    for (int it0 = 0; it0 < n_t; it0 += 2) {
#pragma unroll
      for (int half = 0; half < 2; ++half) { const int it = it0 + half; if (it < n_t) {
        const int t = ATT_TILE(it);
        const int buf = half;
        const bool active = (MODE == MODE_BAND) ? (t <= cw && t >= cw - 8) : (t <= cw);
        if (active) {
            const LAS unsigned char* kb = lds + buf * LY::BUF;
            const LAS unsigned char* vbuf = kb + LY::KB;
            f32x16 p0 = {}, p1 = {};
            bf16x8 ka[NKS], kc[NKS];
#pragma unroll
            for (int ks = 0; ks < NKS; ++ks) { ka[ks] = *(const LAS bf16x8*)(kb + r32 * LY::KS + (ks * 16 + hi * 8) * 2); kc[ks] = *(const LAS bf16x8*)(kb + (32 + r32) * LY::KS + (ks * 16 + hi * 8) * 2); }
            __builtin_amdgcn_sched_barrier(0);
#pragma unroll
            for (int ks = 0; ks < NKS; ++ks) { p0 = __builtin_amdgcn_mfma_f32_32x32x16_bf16(ka[ks], qf[ks], p0, 0, 0, 0); p1 = __builtin_amdgcn_mfma_f32_32x32x16_bf16(kc[ks], qf[ks], p1, 0, 0, 0); }
            s16x4 vl0[4], vh0[4], vl1[4], vh1[4];
#pragma unroll
            for (int s4 = 0; s4 < 4; ++s4) { vl0[s4] = vtr(vbuf + vb0 + s4 * 2048); vh0[s4] = vtr(vbuf + vb0 + s4 * 2048 + 1024); vl1[s4] = vtr(vbuf + vb1 + s4 * 2048); vh1[s4] = vtr(vbuf + vb1 + s4 * 2048 + 1024); }
            __builtin_amdgcn_sched_barrier(0);
            if (MODE == MODE_FOX) {
                const LAS float* cb = (const LAS float*)(vbuf + LY::VB);
                const float cq2 = cq * LOG2E;
#pragma unroll
                for (int a = 0; a < 4; ++a) {
                    const f32x4 c0 = *(const LAS f32x4*)(cb + 8 * a + 4 * hi), c1 = *(const LAS f32x4*)(cb + 32 + 8 * a + 4 * hi);
#pragma unroll
                    for (int e = 0; e < 4; ++e) { p0[4 * a + e] = p0[4 * a + e] * sc2 + (cq2 - c0[e] * LOG2E); p1[4 * a + e] = p1[4 * a + e] * sc2 + (cq2 - c1[e] * LOG2E); }
                }
                if (t == cw) { const int ql = 32 * (wid & 1) + r32;
#pragma unroll
                    for (int r = 0; r < 16; ++r) { const int kv = crow(r, hi); if (kv > ql) p0[r] = -INFINITY; if (kv + 32 > ql) p1[r] = -INFINITY; } }
            } else if (MODE == MODE_BAND) {
                const int dq = (q0 + wid * 32 + r32) - t * 64;
#pragma unroll
                for (int r = 0; r < 16; ++r) { const int kv = crow(r, hi);
                    int i0 = dq - kv, i1 = dq - kv - 32; i0 = i0 < -256 ? -256 : (i0 > 256 ? 256 : i0); i1 = i1 < -256 ? -256 : (i1 > 256 ? 256 : i1);
                    p0[r] = p0[r] * sc2 + tab[i0 + 256]; p1[r] = p1[r] * sc2 + tab[i1 + 256]; }
            }
            float mx = fmaxf(p0[0], p1[0]);
#pragma unroll
            for (int r = 1; r < 16; ++r) mx = fmaxf(mx, fmaxf(p0[r], p1[r]));
            { auto rr = __builtin_amdgcn_permlane32_swap(__float_as_uint(mx), __float_as_uint(mx), false, false); mx = fmaxf(__uint_as_float(rr[0]), __uint_as_float(rr[1])); }
            if (MODE == MODE_MLA) mx *= sc2;
            const float mnew = fmaxf(mrun, mx);
            if (__any(mnew > mrun)) {
                const float alpha = __builtin_amdgcn_exp2f(mrun - mnew);
                lrun *= alpha;
#pragma unroll
                for (int r = 0; r < 16; ++r) { o0[r] *= alpha; o1[r] *= alpha; }
                mrun = mnew;
            }
            float rs = 0.f;
#pragma unroll
            for (int r = 0; r < 16; ++r) {
                if (MODE == MODE_MLA) { p0[r] = __builtin_amdgcn_exp2f(__builtin_fmaf(p0[r], sc2, -mrun)); p1[r] = __builtin_amdgcn_exp2f(__builtin_fmaf(p1[r], sc2, -mrun)); }
                else { p0[r] = __builtin_amdgcn_exp2f(p0[r] - mrun); p1[r] = __builtin_amdgcn_exp2f(p1[r] - mrun); }
                rs += p0[r] + p1[r]; }
            lrun += rs;
#pragma unroll
            for (int s4 = 0; s4 < 4; ++s4) {
                u32x4 pw;
                if (s4 < 2) { const int o = 8 * (s4 & 1); pw.x = pk2(p0[o], p0[o + 1]); pw.y = pk2(p0[o + 2], p0[o + 3]); pw.z = pk2(p0[o + 4], p0[o + 5]); pw.w = pk2(p0[o + 6], p0[o + 7]); }
                else        { const int o = 8 * (s4 & 1); pw.x = pk2(p1[o], p1[o + 1]); pw.y = pk2(p1[o + 2], p1[o + 3]); pw.z = pk2(p1[o + 4], p1[o + 5]); pw.w = pk2(p1[o + 6], p1[o + 7]); }
                const bf16x8 pf = __builtin_bit_cast(bf16x8, pw);
                const s16x4 l0 = vl0[s4], h0 = vh0[s4], l1 = vl1[s4], h1 = vh1[s4];
                const bf16x8 vf0 = (bf16x8){l0[0], l0[1], l0[2], l0[3], h0[0], h0[1], h0[2], h0[3]};
                const bf16x8 vf1 = (bf16x8){l1[0], l1[1], l1[2], l1[3], h1[0], h1[1], h1[2], h1[3]};
                o0 = __builtin_amdgcn_mfma_f32_32x32x16_bf16(vf0, pf, o0, 0, 0, 0);
                o1 = __builtin_amdgcn_mfma_f32_32x32x16_bf16(vf1, pf, o1, 0, 0, 0);
            }
        }
        if (it + 1 < n_t) ATT_STORE_TILE(half ^ 1, half ^ 1);
        if (it + 3 < n_t) ATT_LOAD_TILE(ATT_TILE(it + 3), half ^ 1);
        __syncthreads();
      } }
    }
    { auto rr = __builtin_amdgcn_permlane32_swap(__float_as_uint(lrun), __float_as_uint(lrun), false, false); lrun = __uint_as_float(rr[0]) + __uint_as_float(rr[1]); }
    const float inv = 1.0f / lrun;
    bf16* op = T.O + (size_t)qrow * T.ldo + h * T.ohs;
#pragma unroll
    for (int a = 0; a < 4; ++a) {
        u32x2 w0, w1;
        w0.x = pk2(o0[4 * a] * inv, o0[4 * a + 1] * inv); w0.y = pk2(o0[4 * a + 2] * inv, o0[4 * a + 3] * inv);
        w1.x = pk2(o1[4 * a] * inv, o1[4 * a + 1] * inv); w1.y = pk2(o1[4 * a + 2] * inv, o1[4 * a + 3] * inv);
        *(u32x2*)(op + 8 * a + 4 * hi) = w0; *(u32x2*)(op + 32 + 8 * a + 4 * hi) = w1;
    }
}

template <int MODE>
__device__ __forceinline__ void attn_phase(const Tensors& T, LAS unsigned char* lds) {
    const int G = gridDim.x, bx = blockIdx.x, vcu = (G % 8 == 0) ? (bx % 8) * (G / 8) + bx / 8 : bx;
    for (int pr = vcu; pr < 256; pr += G) {
        const int bh = pr >> 4, s = pr & 15;
        attn_unit<MODE>(T, bh >> 2, bh & 3, s, lds);
        attn_unit<MODE>(T, bh >> 2, bh & 3, 31 - s, lds);
    }
}

template <int MODE>
__device__ __forceinline__ void attn_naive(const Tensors& T) {
    BODY_IDS();
    constexpr int DQK = (MODE == MODE_MLA) ? 96 : 64;
    const float sc = (MODE == MODE_MLA) ? 0.10206207261596575f : 0.125f;
    for (int idx = gtid; idx < NTOK * 4; idx += gthreads) {
        const int h = idx / NTOK, row = idx % NTOK, b = row / SEQ, tpos = row % SEQ, rowb = b * SEQ;
        float q[DQK], o[64];
#pragma unroll
        for (int d = 0; d < DQK; ++d) q[d] = bf2f(T.Q[(size_t)row * T.ldq + h * T.qhs + d]) * sc;
#pragma unroll
        for (int d = 0; d < 64; ++d) o[d] = 0.f;
        float m = -INFINITY, l = 0.f;
        const int ck = tpos / 64;
        const int k_lo = (MODE == MODE_BAND) ? ((ck - 8) > 0 ? (ck - 8) * 64 : 0) : 0;
        const int k_hi = (MODE == MODE_FOX) ? tpos : (ck * 64 + 63);
        const float cq = (MODE == MODE_FOX) ? T.cdec[(size_t)row * 4 + h] : 0.f;
        for (int kv = k_lo; kv <= k_hi; ++kv) {
            const size_t kr = (size_t)(rowb + kv);
            float s = 0.f;
#pragma unroll
            for (int d8 = 0; d8 < 8; ++d8) { const u32x4 w = *(const u32x4*)(T.K + kr * T.ldk + h * T.khs + d8 * 8);
                s += q[d8 * 8 + 0] * bflo(w.x) + q[d8 * 8 + 1] * bfhi(w.x) + q[d8 * 8 + 2] * bflo(w.y) + q[d8 * 8 + 3] * bfhi(w.y)
                   + q[d8 * 8 + 4] * bflo(w.z) + q[d8 * 8 + 5] * bfhi(w.z) + q[d8 * 8 + 6] * bflo(w.w) + q[d8 * 8 + 7] * bfhi(w.w); }
            if (MODE == MODE_MLA) {
#pragma unroll
                for (int d8 = 0; d8 < 4; ++d8) { const u32x4 w = *(const u32x4*)(T.K2 + kr * 32 + d8 * 8);
                    s += q[64 + d8 * 8 + 0] * bflo(w.x) + q[64 + d8 * 8 + 1] * bfhi(w.x) + q[64 + d8 * 8 + 2] * bflo(w.y) + q[64 + d8 * 8 + 3] * bfhi(w.y)
                       + q[64 + d8 * 8 + 4] * bflo(w.z) + q[64 + d8 * 8 + 5] * bfhi(w.z) + q[64 + d8 * 8 + 6] * bflo(w.w) + q[64 + d8 * 8 + 7] * bfhi(w.w); }
            }
            if (MODE == MODE_FOX) s += cq - T.cdec[kr * 4 + h];
            if (MODE == MODE_BAND) { int rel = tpos - kv; rel = rel < -256 ? -256 : (rel > 256 ? 256 : rel); s += T.relb[h * 513 + rel + 256]; }
            const float mn = fmaxf(m, s), al = __expf(m - mn), pp = __expf(s - mn);
            l = l * al + pp; m = mn;
#pragma unroll
            for (int d8 = 0; d8 < 8; ++d8) { const u32x4 w = *(const u32x4*)(T.V + kr * T.ldv + h * T.vhs + d8 * 8);
                o[d8 * 8 + 0] = o[d8 * 8 + 0] * al + pp * bflo(w.x); o[d8 * 8 + 1] = o[d8 * 8 + 1] * al + pp * bfhi(w.x);
                o[d8 * 8 + 2] = o[d8 * 8 + 2] * al + pp * bflo(w.y); o[d8 * 8 + 3] = o[d8 * 8 + 3] * al + pp * bfhi(w.y);
                o[d8 * 8 + 4] = o[d8 * 8 + 4] * al + pp * bflo(w.z); o[d8 * 8 + 5] = o[d8 * 8 + 5] * al + pp * bfhi(w.z);
                o[d8 * 8 + 6] = o[d8 * 8 + 6] * al + pp * bflo(w.w); o[d8 * 8 + 7] = o[d8 * 8 + 7] * al + pp * bfhi(w.w); }
        }
        const float inv = 1.0f / l;
#pragma unroll
        for (int d = 0; d < 64; d += 2) *(unsigned*)(T.O + (size_t)row * T.ldo + h * T.ohs + d) = pk2(o[d] * inv, o[d + 1] * inv);
    }
}
}
struct Params {
    const float* in[37];
    float* out;
    unsigned char* ws;
    int ph_lo, ph_hi;
};
enum { I_X = 0, I_P, I_POS, I_WIN, I_SAR, I_SAI, I_SLDT, I_SBR, I_SBI, I_SCR, I_SCI, I_SD, I_SGLU, I_FBF, I_GQ, I_WUQ, I_GKV, I_WUKV, I_RELB, I_WB, I_WG, I_BG, I_WO,
       I_GMIX, I_GFFN, I_FW1, I_FW3, I_FW2, I_MWR, I_MBR, I_MW1, I_MW3, I_MW2, I_GPLE, I_PWG, I_PWU, I_GFIN };

__device__ __forceinline__ void sincos_rad(double a, float& s, float& c) {
    double r = a * 0.15915494309189535; r = r - __builtin_rint(r); const float f = (float)r;
    s = __builtin_amdgcn_sinf(f); c = __builtin_amdgcn_cosf(f);
}
__device__ __forceinline__ float gelu_tanh(float x) {
    const float z = 0.7978845608028654f * (x + 0.044715f * x * x * x);
    const float e = __expf(2.0f * z); const float th = 1.0f - 2.0f / (1.0f + e);
    return 0.5f * x * (1.0f + th);
}
__device__ __forceinline__ float log_sigmoid(float z) { return fminf(z, 0.f) - log1pf(__expf(-fabsf(z))); }

struct CvtJob { const float* src; const float* ks; bf16* dst; int K, ldsrc, col0, ncols, row0, ldk, ilv; };
__device__ __forceinline__ void cvt_item(const CvtJob& J, LAS float* scr, int item, int lane) {
    const int nblk = (J.ncols + 63) >> 6, kb = item / nblk, nb = item % nblk, k0 = 64 * kb, n0 = 64 * nb;
    const int n4 = (lane & 15) * 4; const bool inb = (n0 + n4) < J.ncols;
#pragma unroll 8
    for (int i = 0; i < 16; ++i) { const int kk = 4 * i + (lane >> 4); f32x4 v = {0.f, 0.f, 0.f, 0.f};
        if (inb) v = *(const f32x4*)(J.src + (size_t)(k0 + kk) * J.ldsrc + J.col0 + n0 + n4);
        if (J.ks) v = v * J.ks[k0 + kk];
        *(LAS f32x4*)(scr + kk * 68 + n4) = v; }
    LDS_WAIT(); asm volatile("" ::: "memory");
    const int c = lane & 7;
#pragma unroll
    for (int j = 0; j < 8; ++j) { const int n = (lane >> 3) + 8 * j; const LAS float* s = scr + (8 * c) * 68 + n;
        u32x4 o; o.x = pk2(s[0 * 68], s[1 * 68]); o.y = pk2(s[2 * 68], s[3 * 68]); o.z = pk2(s[4 * 68], s[5 * 68]); o.w = pk2(s[6 * 68], s[7 * 68]);
        const int nn = n0 + n; const int row = J.row0 + (J.ilv ? ((nn >> 7) * 256 + (nn & 127)) : nn);
        if (nn < J.ncols) *(u32x4*)(J.dst + (size_t)row * J.ldk + k0 + 8 * c) = o; }
    LDS_WAIT(); asm volatile("" ::: "memory");
}
__device__ __forceinline__ bf16* wmix(const Params& P, int L, size_t off) { return (bf16*)(P.ws + WS_WMIX + (size_t)L * WMIX_STRIDE + off); }
__device__ __forceinline__ CvtJob get_job(const Params& P, int j) {
    CvtJob J; J.ks = nullptr; J.ilv = 0; J.col0 = 0; J.row0 = 0;
    if (j < 40) {
        const int L = j / 20, q = j % 20;
        if (q < 5) {
            J.src = P.in[I_WIN] + (size_t)L * D * DIN; J.K = D; J.ldsrc = DIN; J.dst = wmix(P, L, WM_IN); J.ldk = D;
            J.col0 = q == 0 ? 0 : q == 1 ? 1380 : q == 2 ? 1028 : q == 3 ? 1220 : 1348;
            J.ncols = q == 0 ? 1024 : q == 1 ? 768 : q == 2 ? 192 : q == 3 ? 128 : 32;
            J.row0 = q == 0 ? 0 : q == 1 ? 1024 : q == 2 ? 1792 : q == 3 ? 2048 : 2176;
        } else if (q < 9) { const int k = q - 5; J.src = P.in[I_WG] + ((size_t)L * 4 + k) * D * D; J.K = D; J.ldsrc = D; J.ncols = D; J.row0 = k * D; J.dst = wmix(P, L, WM_G); J.ldk = D;
        } else if (q < 13) { const int k = q - 9; J.src = P.in[I_WB] + ((size_t)L * 4 + k) * 256 * D; J.K = 256; J.ldsrc = D; J.ncols = D; J.row0 = k * D; J.dst = wmix(P, L, WM_B); J.ldk = 256;
        } else if (q == 13) { J.src = P.in[I_WO] + (size_t)L * D * D; J.K = D; J.ldsrc = D; J.ncols = D; J.dst = wmix(P, L, WM_O); J.ldk = D;
        } else if (q == 14) { J.src = P.in[I_PWG] + (size_t)L * D * D; J.K = D; J.ldsrc = D; J.ncols = D; J.dst = wmix(P, L, WM_PG); J.ldk = D;
        } else if (q == 15) { J.src = P.in[I_PWU] + (size_t)L * 256 * D; J.K = 256; J.ldsrc = D; J.ncols = D; J.dst = wmix(P, L, WM_UP); J.ldk = 256;
        } else if (q == 16) { J.src = P.in[I_WUQ] + (size_t)L * 192 * 384; J.ks = P.in[I_GQ] + L * 192; J.K = 192; J.ldsrc = 384; J.ncols = 384; J.dst = wmix(P, L, WM_UQ); J.ldk = 256;
        } else if (q == 17) { J.src = P.in[I_WUKV] + (size_t)L * 128 * 512; J.ks = P.in[I_GKV] + L * 128; J.K = 128; J.ldsrc = 512; J.ncols = 512; J.dst = wmix(P, L, WM_UKV); J.ldk = 128;
        } else if (q == 18) { J.src = P.in[I_SGLU] + (size_t)L * 256 * 256; J.K = 256; J.ldsrc = 256; J.ncols = 256; J.dst = wmix(P, L, WM_GLU); J.ldk = 256;
        } else { J.src = nullptr; J.K = 0; J.ldsrc = 0; J.ncols = 32; J.dst = nullptr; J.ldk = 0; }
    } else if (j < 43) {
        const int q = j - 40;
        if (q == 0) { J.src = P.in[I_FW1]; J.K = D; J.ldsrc = DFF; J.ncols = DFF; J.dst = (bf16*)(P.ws + WS_W13); J.ldk = D; J.ilv = 1; }
        else if (q == 1) { J.src = P.in[I_FW3]; J.K = D; J.ldsrc = DFF; J.ncols = DFF; J.row0 = 128; J.dst = (bf16*)(P.ws + WS_W13); J.ldk = D; J.ilv = 1; }
        else { J.src = P.in[I_FW2]; J.K = DFF; J.ldsrc = D; J.ncols = D; J.dst = (bf16*)(P.ws + WS_W2); J.ldk = DFF; }
    } else {
        const int e = (j - 43) / 3, q = (j - 43) % 3;
        if (q == 0) { J.src = P.in[I_MW1] + (size_t)e * D * DFFE; J.K = D; J.ldsrc = DFFE; J.ncols = DFFE; J.row0 = e * 2816; J.dst = (bf16*)(P.ws + WS_WM13); J.ldk = D; J.ilv = 1; }
        else if (q == 1) { J.src = P.in[I_MW3] + (size_t)e * D * DFFE; J.K = D; J.ldsrc = DFFE; J.ncols = DFFE; J.row0 = e * 2816 + 128; J.dst = (bf16*)(P.ws + WS_WM13); J.ldk = D; J.ilv = 1; }
        else { J.src = P.in[I_MW2] + (size_t)e * DFFE * D; J.K = DFFE; J.ldsrc = D; J.ncols = D; J.row0 = e * D; J.dst = (bf16*)(P.ws + WS_WM2); J.ldk = DFFE; }
    }
    return J;
}
__device__ __forceinline__ void cvt_jobs(const Params& P, int j_lo, int j_hi, LAS unsigned char* lds) {
    BODY_IDS();
    LAS float* scr = (LAS float*)(lds + wave * 17408);
    int acc = 0;
    for (int j = j_lo; j < j_hi; ++j) {
        const CvtJob J = get_job(P, j);
        const int items = (J.K / 64) * ((J.ncols + 63) >> 6);
        int first = (gw - (acc % ngw) + ngw) % ngw;
        for (int it = first; it < items; it += ngw) cvt_item(J, scr, it, lane);
        acc += items;
    }
}

__device__ __forceinline__ void p0_misc(const Params& P) {
    BODY_IDS();
    { const f32x4* src = (const f32x4*)P.in[I_P]; u32x2* dst = (u32x2*)(P.ws + WS_PBF);
      for (int i = gtid; i < 2 * NTOK * 256 / 4; i += gthreads) { const f32x4 v = src[i]; u32x2 w; w.x = pk2(v[0], v[1]); w.y = pk2(v[2], v[3]); dst[i] = w; } }
    { const int* pos = (const int*)P.in[I_POS]; float* ct = (float*)(P.ws + WS_COS); float* st = (float*)(P.ws + WS_SIN);
      const double invf[16] = {1.0, 0.5623413251903491, 0.31622776601683794, 0.1778279410038923, 0.1, 0.05623413251903491, 0.03162277660168379, 0.01778279410038923,
                               0.01, 0.005623413251903491, 0.0031622776601683794, 0.0017782794100389228, 0.001, 0.0005623413251903491, 0.00031622776601683794, 0.00017782794100389227};
      for (int i = gtid; i < NTOK * 16; i += gthreads) { const int row = i >> 4, f = i & 15; double iv = invf[0];
#pragma unroll
          for (int q = 1; q < 16; ++q) iv = (f == q) ? invf[q] : iv;
          const float ang = (float)pos[row] * (float)iv; float s, c; sincos_rad((double)ang, s, c); ct[i] = c; st[i] = s; } }
    for (int L = 0; L < 2; ++L) {
        bf16* win = wmix(P, L, WM_IN);
        for (int i = gtid; i < (64 + 96) * D / 8; i += gthreads) { const int e = i * 8, r = e / D, k = e % D; const int row = r < 64 ? 1984 + r : 2208 + (r - 64); *(u32x4*)(win + (size_t)row * D + k) = (u32x4){0u, 0u, 0u, 0u}; }
        bf16* wuq = wmix(P, L, WM_UQ);
        for (int i = gtid; i < 512 * 256 / 8; i += gthreads) { const int e = i * 8, r = e / 256, k = e % 256; if (r >= 384 || k >= 192) *(u32x4*)(wuq + e) = (u32x4){0u, 0u, 0u, 0u}; }
    }
}

__device__ __forceinline__ void rms_load(const XSrc& x, int row, int lane, f32x4 (&v)[4]) {
#pragma unroll
    for (int j = 0; j < 4; ++j) v[j] = ldx4(x, (size_t)row * D + 4 * lane + 256 * j);
}
struct GainRegs { f32x4 g[4]; };
__device__ __forceinline__ GainRegs load_gain(const float* gain, int lane) { GainRegs G; const f32x4* gr = (const f32x4*)gain + lane;
#pragma unroll
    for (int j = 0; j < 4; ++j) G.g[j] = gr[64 * j];
    return G; }
__device__ __forceinline__ void rms_finish(const GainRegs& G, bf16* orow, int lane, f32x4 (&v)[4]) {
    float s = 0.f;
#pragma unroll
    for (int j = 0; j < 4; ++j) s += (v[j][0] * v[j][0] + v[j][1] * v[j][1]) + (v[j][2] * v[j][2] + v[j][3] * v[j][3]);
    const float rstd = 1.0f / sqrtf(wave_sum(s) * (1.0f / D) + RMS_EPS);
    u32x2* o8 = (u32x2*)orow + lane;
#pragma unroll
    for (int j = 0; j < 4; ++j) { v[j] = v[j] * rstd * G.g[j]; if (orow) { u32x2 w; w.x = pk2(v[j][0], v[j][1]); w.y = pk2(v[j][2], v[j][3]); o8[64 * j] = w; } }
}
#define RMS_ROWS_BEGIN(x_, rowexpr_) f32x4 v[4], vn_[4]; { const int i = 0; rms_load(x_, (rowexpr_), lane, v); } for (int i = 0; i < 16; ++i) { if (i + 1 < 16) { const int i_ = i; { const int i = i_ + 1; rms_load(x_, (rowexpr_), lane, vn_); } }
#define RMS_ROWS_END() _Pragma("unroll") for (int j_ = 0; j_ < 4; ++j_) v[j_] = vn_[j_]; }
__device__ __forceinline__ void norm_plain(const XSrc x, const float* gain, bf16* H, int first, int stride) {
    BODY_IDS();
    const GainRegs GR = load_gain(gain, lane);
    for (int u = first; u < NTOK / 128; u += stride)
    { RMS_ROWS_BEGIN(x, u * 128 + wave * 16 + i) const int row = u * 128 + wave * 16 + i; rms_finish(GR, H + (size_t)row * D, lane, v); RMS_ROWS_END() }
}
__device__ __forceinline__ void norm1_phase(const Params& P, int L, const XSrc x, int first, int stride) {
    BODY_IDS();
    const float* win = P.in[I_WIN] + (size_t)L * D * DIN;
    f32x4 wff[4][4];
#pragma unroll
    for (int j = 0; j < 4; ++j)
#pragma unroll
        for (int e = 0; e < 4; ++e) wff[j][e] = *(const f32x4*)(win + (size_t)(4 * lane + 256 * j + e) * DIN + 1024);
    const float* gain = P.in[I_GMIX] + L * D; bf16* H = (bf16*)(P.ws + WS_H); const GainRegs GR = load_gain(gain, lane);
    float* logf = (float*)(P.ws + WS_LOGF); float* wsum = (float*)(P.ws + WS_WSUM);
    const f32x4 bf = *(const f32x4*)(P.in[I_FBF] + L * 4);
    for (int u = first; u < NTOK / 128; u += stride) { const int g0 = u * 8 + wave;
        f32x4 run = {0.f, 0.f, 0.f, 0.f};
        RMS_ROWS_BEGIN(x, g0 * 16 + i) const int row = g0 * 16 + i; rms_finish(GR, H + (size_t)row * D, lane, v);
            f32x4 d = {0.f, 0.f, 0.f, 0.f};
#pragma unroll
            for (int j = 0; j < 4; ++j)
#pragma unroll
                for (int e = 0; e < 4; ++e) d += wff[j][e] * v[j][e];
#pragma unroll
            for (int e = 0; e < 4; ++e) { d[e] = wave_sum(d[e]); run[e] += log_sigmoid(d[e] + bf[e]); }
            if (lane == 0) *(f32x4*)(logf + (size_t)row * 4) = run; RMS_ROWS_END()
        if (lane == 0) *(f32x4*)(wsum + (size_t)g0 * 4) = run;
    }
    __syncthreads();
}
__device__ __forceinline__ void prep_phase(const Params& P, int L) {
    BODY_IDS();
    unsigned* qmaxw = (unsigned*)(P.ws + WS_CTL) + CW_QMAX + L * 512; unsigned* kmaxw = (unsigned*)(P.ws + WS_CTL) + CW_KMAX + L * 16;
    const float* logf = (const float*)(P.ws + WS_LOGF); const float* wsum = (const float*)(P.ws + WS_WSUM); float* cdec = (float*)(P.ws + WS_CDEC);
    float* rq = (float*)(P.ws + WS_RSTDQ); float* rkv = (float*)(P.ws + WS_RSTDKV); const bf16* zin = (const bf16*)(P.ws + WS_ZIN); bf16* kper = (bf16*)(P.ws + WS_KPER);
    const float* ct = (const float*)(P.ws + WS_COS); const float* st = (const float*)(P.ws + WS_SIN);
    for (int g0 = gw; g0 < NTOK / 16; g0 += ngw) {
        const int first = (g0 / 512) * 512;
        f32x4 pre = {0.f, 0.f, 0.f, 0.f};
        for (int i = first + lane; i < g0; i += 64) pre += *(const f32x4*)(wsum + (size_t)i * 4);
#pragma unroll
        for (int e = 0; e < 4; ++e) pre[e] = wave_sum(pre[e]);
        if (lane < 16) { const int row = g0 * 16 + lane; *(f32x4*)(cdec + (size_t)row * 4) = *(const f32x4*)(logf + (size_t)row * 4) + pre; }
        float qk2m = 0.f;
        const int colA = (lane < 32 ? ZC_FQ : ZC_FK) + 8 * (lane & 31), colB = ZC_CQ + 8 * (lane < 52 ? lane : 51);
        u32x4 wa = *(const u32x4*)(zin + (size_t)(g0 * 16) * ZP + colA), wb = *(const u32x4*)(zin + (size_t)(g0 * 16) * ZP + colB);
        for (int i = 0; i < 16; ++i) { const int row = g0 * 16 + i;
            const u32x4 ca = wa, cb = wb;
            if (i + 1 < 16) { wa = *(const u32x4*)(zin + (size_t)(row + 1) * ZP + colA); wb = *(const u32x4*)(zin + (size_t)(row + 1) * ZP + colB); }
            const f32x4 cs = *(const f32x4*)(ct + (size_t)row * 16 + 8 * (lane & 1)), cs2 = *(const f32x4*)(ct + (size_t)row * 16 + 8 * (lane & 1) + 4);
            const f32x4 sn = *(const f32x4*)(st + (size_t)row * 16 + 8 * (lane & 1)), sn2 = *(const f32x4*)(st + (size_t)row * 16 + 8 * (lane & 1) + 4);
            { float sa = (bflo(ca.x) * bflo(ca.x) + bfhi(ca.x) * bfhi(ca.x)) + (bflo(ca.y) * bflo(ca.y) + bfhi(ca.y) * bfhi(ca.y)) + (bflo(ca.z) * bflo(ca.z) + bfhi(ca.z) * bfhi(ca.z)) + (bflo(ca.w) * bflo(ca.w) + bfhi(ca.w) * bfhi(ca.w));
#pragma unroll
              for (int o = 1; o < 8; o <<= 1) sa += shflx(sa, o, lane);
              qk2m = fmaxf(qk2m, sa); }
            const float own[8] = {bflo(cb.x), bfhi(cb.x), bflo(cb.y), bfhi(cb.y), bflo(cb.z), bfhi(cb.z), bflo(cb.w), bfhi(cb.w)};
            float ssb = 0.f;
#pragma unroll
            for (int e = 0; e < 8; ++e) ssb += own[e] * own[e];
            const float sq = wave_sum(lane < 24 ? ssb : 0.f), skv = wave_sum((lane >= 32 && lane < 48) ? ssb : 0.f);
            if (lane == 0) { rq[row] = 1.0f / sqrtf(sq * (1.0f / 192.0f) + RMS_EPS); rkv[row] = 1.0f / sqrtf(skv * (1.0f / 128.0f) + RMS_EPS); }
            float oth[8];
#pragma unroll
            for (int e = 0; e < 8; ++e) oth[e] = shflx(own[e], 2, lane);
            if (lane >= 48 && lane < 52) { const bool lo = lane < 50; float o8[8];
#pragma unroll
                for (int e = 0; e < 8; ++e) { const float c = e < 4 ? cs[e] : cs2[e - 4], sv = e < 4 ? sn[e] : sn2[e - 4];
                    o8[e] = lo ? (own[e] * c - oth[e] * sv) : (own[e] * c + oth[e] * sv); }
                *(u32x4*)(kper + (size_t)row * 32 + (lo ? 0 : 16) + 8 * (lane & 1)) = (u32x4){pk2(o8[0], o8[1]), pk2(o8[2], o8[3]), pk2(o8[4], o8[5]), pk2(o8[6], o8[7])}; } }
        if ((lane & 7) == 0) { const int row0 = g0 * 16, b = row0 / SEQ, qb = (row0 % SEQ) / 256, h = (lane & 31) >> 3;
            if (lane < 32) atomicMax(qmaxw + (b * 4 + h) * 32 + qb, __float_as_uint(qk2m)); else atomicMax(kmaxw + b * 4 + h, __float_as_uint(qk2m)); }
    }
}
struct FinalRows { u32x2 w[16][4]; };
__device__ __forceinline__ void final_norm_load(const Params& P, int u, FinalRows& R) {
    BODY_IDS();
    const bf16* xb = xr_of(P.out);
#pragma unroll
    for (int i = 0; i < 16; ++i) { const u32x2* xr = (const u32x2*)(xb + (size_t)(u * 128 + wave * 16 + i) * D) + lane;
#pragma unroll
        for (int j = 0; j < 4; ++j) R.w[i][j] = xr[64 * j]; }
}
__device__ __forceinline__ void final_norm_store(const Params& P, int u, const FinalRows& R) {
    BODY_IDS();
    const GainRegs GR = load_gain(P.in[I_GFIN], lane);
#pragma unroll
    for (int i = 0; i < 16; ++i) { f32x4 v[4]; float s = 0.f;
#pragma unroll
        for (int j = 0; j < 4; ++j) { const u32x2 w = R.w[i][j]; v[j] = (f32x4){bflo(w.x), bfhi(w.x), bflo(w.y), bfhi(w.y)}; s += (v[j][0] * v[j][0] + v[j][1] * v[j][1]) + (v[j][2] * v[j][2] + v[j][3] * v[j][3]); }
        const float rstd = 1.0f / sqrtf(wave_sum(s) * (1.0f / D) + RMS_EPS);
        f32x4* xo = (f32x4*)(P.out + (size_t)(u * 128 + wave * 16 + i) * D) + lane;
#pragma unroll
        for (int j = 0; j < 4; ++j) xo[64 * j] = v[j] * rstd * GR.g[j]; }
}
namespace s5 {
struct Coef { float abr, abi; f32x2 B2[16]; float a64r, a64i; };
__device__ __forceinline__ void coef(const Params& P, int L, int g, int p, Coef& C) {
    const float dt = __expf(P.in[I_SLDT][L * 16 + g]); const float ar = P.in[I_SAR][(L * 16 + g) * 64 + p], ai = P.in[I_SAI][(L * 16 + g) * 64 + p];
    const float mag = __expf(ar * dt); float sn, cs; sincos_rad((double)(ai * dt), sn, cs);
    C.abr = mag * cs; C.abi = mag * sn;
    const float den = ar * ar + ai * ai, nr = C.abr - 1.0f, ni = C.abi;
    const float cr = (nr * ar + ni * ai) / den, ci = (ni * ar - nr * ai) / den;
    const float* br = P.in[I_SBR] + ((size_t)(L * 16 + g) * 64 + p) * 16; const float* bi = P.in[I_SBI] + ((size_t)(L * 16 + g) * 64 + p) * 16;
#pragma unroll
    for (int h = 0; h < 16; ++h) { const float r = br[h], i = bi[h]; C.B2[h] = (f32x2){cr * r - ci * i, cr * i + ci * r}; }
    const float m64 = __expf(64.0f * ar * dt); float s64, c64; sincos_rad(64.0 * (double)(ai * dt), s64, c64);
    C.a64r = m64 * c64; C.a64i = m64 * s64;
}
constexpr int WAVE_LDS = 8448;
template <bool EMIT>
__device__ __forceinline__ void chunk(const Params& P, int L, int g, int row0, const Coef& C, float& xr, float& xi, LAS unsigned char* wl, int lane, const bf16x8 (&cf)[4], float dsk) {
    bf16* zin = (bf16*)(P.ws + WS_ZIN);
    LAS float* ut = (LAS float*)wl; LAS unsigned* xt = (LAS unsigned*)(wl + 4096);
    { const u32x4* up = (const u32x4*)(zin + (size_t)(row0 + lane) * ZP + ZC_U + g * 16); const u32x4 w0 = up[0], w1 = up[1];
      LAS f32x4* d = (LAS f32x4*)(ut + lane * 16);
      d[0] = (f32x4){bflo(w0.x), bfhi(w0.x), bflo(w0.y), bfhi(w0.y)}; d[1] = (f32x4){bflo(w0.z), bfhi(w0.z), bflo(w0.w), bfhi(w0.w)};
      d[2] = (f32x4){bflo(w1.x), bfhi(w1.x), bflo(w1.y), bfhi(w1.y)}; d[3] = (f32x4){bflo(w1.z), bfhi(w1.z), bflo(w1.w), bfhi(w1.w)}; }
    for (int tb = 0; tb < 4; ++tb) {
#pragma unroll 4
        for (int ti = 0; ti < 16; ++ti) {
            const LAS f32x4* up = (const LAS f32x4*)(ut + (tb * 16 + ti) * 16);
            f32x2 b2a = {0.f, 0.f}, b2b = {0.f, 0.f};
#pragma unroll
            for (int q = 0; q < 4; ++q) { const f32x4 u4 = up[q];
                b2a += C.B2[4 * q + 0] * (f32x2){u4[0], u4[0]}; b2b += C.B2[4 * q + 1] * (f32x2){u4[1], u4[1]};
                b2a += C.B2[4 * q + 2] * (f32x2){u4[2], u4[2]}; b2b += C.B2[4 * q + 3] * (f32x2){u4[3], u4[3]}; }
            const float br = b2a[0] + b2b[0], bi = b2a[1] + b2b[1];
            const float nr = C.abr * xr - C.abi * xi + br, ni = C.abr * xi + C.abi * xr + bi; xr = nr; xi = ni;
            if (EMIT) xt[ti * 68 + lane] = pk2(xr, xi);
        }
        if (EMIT) {
            f32x4 dacc = {0.f, 0.f, 0.f, 0.f};
#pragma unroll
            for (int ks = 0; ks < 4; ++ks) { const bf16x8 a = *(const LAS bf16x8*)((const LAS unsigned char*)xt + (lane & 15) * 272 + (ks * 32 + (lane >> 4) * 8) * 2);
                dacc = __builtin_amdgcn_mfma_f32_16x16x32_bf16(a, cf[ks], dacc, 0, 0, 0); }
            const int hp = lane & 15;
#pragma unroll
            for (int i = 0; i < 4; ++i) { const int tok = tb * 16 + 4 * (lane >> 4) + i; const float y = dacc[i] + dsk * ut[tok * 16 + hp];
                zin[(size_t)(row0 + tok) * ZP + ZC_U + g * 16 + hp] = (bf16)f2bf(gelu_tanh(y)); }
        }
    }
}
template <int PASS>
__device__ __forceinline__ void phase(const Params& P, int L, LAS unsigned char* lds) {
    BODY_IDS();
    LAS unsigned char* wl = lds + wave * WAVE_LDS;
    f32x2* SC = (f32x2*)(P.ws + WS_SC);
    for (int w = gw; w < 2048; w += ngw) {
        const int bg = w >> 5, cg = w & 31, b = bg >> 4, g = bg & 15;
        Coef C; coef(P, L, g, lane, C);
        bf16x8 cf[4]; float dsk = 0.f;
        if (PASS == 1) {
            const int hp = lane & 15, kg = lane >> 4;
            const float* cre = P.in[I_SCR] + ((size_t)(L * 16 + g) * 16 + hp) * 64; const float* cim = P.in[I_SCI] + ((size_t)(L * 16 + g) * 16 + hp) * 64;
#pragma unroll
            for (int ks = 0; ks < 4; ++ks) { const int p0 = 16 * ks + 4 * kg; u32x4 wv;
                wv.x = pk2(cre[p0], -cim[p0]); wv.y = pk2(cre[p0 + 1], -cim[p0 + 1]); wv.z = pk2(cre[p0 + 2], -cim[p0 + 2]); wv.w = pk2(cre[p0 + 3], -cim[p0 + 3]);
                cf[ks] = __builtin_bit_cast(bf16x8, wv); }
            dsk = P.in[I_SD][(L * 16 + g) * 16 + hp];
        } else {
#pragma unroll
            for (int ks = 0; ks < 4; ++ks) cf[ks] = (bf16x8){0, 0, 0, 0, 0, 0, 0, 0};
        }
        float xr = 0.f, xi = 0.f;
        if (PASS == 1) {
            const f32x2* sp = SC + ((size_t)bg * 128) * 64 + lane;
            for (int c = 0; c < 4 * cg; c += 4) { f32x2 sv[4];
#pragma unroll
                for (int q = 0; q < 4; ++q) sv[q] = sp[(size_t)(c + q) * 64];
#pragma unroll
                for (int q = 0; q < 4; ++q) { const float nr = C.a64r * xr - C.a64i * xi + sv[q][0], ni = C.a64r * xi + C.a64i * xr + sv[q][1]; xr = nr; xi = ni; } }
        }
        for (int cc = 0; cc < 4; ++cc) {
            const int c = 4 * cg + cc, row0 = b * SEQ + c * 64;
            if (PASS == 0) { xr = 0.f; xi = 0.f; }
            chunk<PASS == 1>(P, L, g, row0, C, xr, xi, wl, lane, cf, dsk);
            if (PASS == 0) SC[((size_t)bg * 128 + c) * 64 + lane] = (f32x2){xr, xi};
        }
    }
}
__device__ __forceinline__ void naive(const Params& P, int L) {
    BODY_IDS();
    bf16* zin = (bf16*)(P.ws + WS_ZIN);
    for (int bg = gw; bg < 64; bg += ngw) {
        const int b = bg >> 4, g = bg & 15;
        Coef C; coef(P, L, g, lane, C);
        float cr[16], ci[16];
#pragma unroll
        for (int h = 0; h < 16; ++h) { cr[h] = P.in[I_SCR][((size_t)(L * 16 + g) * 16 + h) * 64 + lane]; ci[h] = P.in[I_SCI][((size_t)(L * 16 + g) * 16 + h) * 64 + lane]; }
        const float dsk = P.in[I_SD][(L * 16 + g) * 16 + (lane & 15)];
        float xr = 0.f, xi = 0.f;
        for (int t = 0; t < SEQ; ++t) {
            bf16* up = zin + (size_t)(b * SEQ + t) * ZP + ZC_U + g * 16;
            const u32x4 w0 = *(const u32x4*)up, w1 = *(const u32x4*)(up + 8);
            const float u[16] = {bflo(w0.x), bfhi(w0.x), bflo(w0.y), bfhi(w0.y), bflo(w0.z), bfhi(w0.z), bflo(w0.w), bfhi(w0.w),
                                 bflo(w1.x), bfhi(w1.x), bflo(w1.y), bfhi(w1.y), bflo(w1.z), bfhi(w1.z), bflo(w1.w), bfhi(w1.w)};
            float br = 0.f, bi = 0.f;
#pragma unroll
            for (int h = 0; h < 16; ++h) { br += C.B2[h][0] * u[h]; bi += C.B2[h][1] * u[h]; }
            const float nr = C.abr * xr - C.abi * xi + br, ni = C.abr * xi + C.abi * xr + bi; xr = nr; xi = ni;
            float ymine = 0.f, umine = 0.f;
#pragma unroll
            for (int h = 0; h < 16; ++h) { const float s = wave_sum(xr * cr[h] - xi * ci[h]); if ((lane & 15) == h) { ymine = s; umine = u[h]; } }
            __builtin_amdgcn_s_waitcnt(0);
            if (lane < 16) up[lane] = (bf16)f2bf(gelu_tanh(ymine + dsk * umine));
        }
    }
}
}

__device__ __forceinline__ void norm2_moe_phase(const Params& P, const XSrc x, LAS unsigned char* lds, int first, int stride) {
    BODY_IDS();
    LAS unsigned* lcnt = (LAS unsigned*)(lds + 32768); LAS unsigned* lbase = lcnt + 8;
    f32x4 wr0[4][4], wr1[4][4];
#pragma unroll
    for (int j = 0; j < 4; ++j)
#pragma unroll
        for (int q = 0; q < 4; ++q) { const float* wp = P.in[I_MWR] + (size_t)(4 * lane + 256 * j + q) * 8; wr0[j][q] = *(const f32x4*)wp; wr1[j][q] = *(const f32x4*)(wp + 4); }
    if (tid < 8) lcnt[tid] = 0u;
    __syncthreads();
    const float* gain = P.in[I_GFFN] + 1 * D; bf16* H = (bf16*)(P.ws + WS_H); const GainRegs GR = load_gain(gain, lane);
    unsigned* tokinfo = (unsigned*)(P.ws + WS_TOKINFO); unsigned* gcnt = (unsigned*)(P.ws + WS_CTL) + CW_MOECNT;
    const float* brt = P.in[I_MBR];
    for (int u = first; u < NTOK / 128; u += stride) { const int g0 = u * 8 + wave;
        RMS_ROWS_BEGIN(x, g0 * 16 + i) const int row = g0 * 16 + i; rms_finish(GR, H + (size_t)row * D, lane, v);
            float lg[8];
#pragma unroll
            for (int e = 0; e < 8; ++e) lg[e] = 0.f;
#pragma unroll
            for (int j = 0; j < 4; ++j)
#pragma unroll
                for (int q = 0; q < 4; ++q) { const f32x4 w0 = wr0[j][q], w1 = wr1[j][q]; const float hv = v[j][q];
                    lg[0] += hv * w0[0]; lg[1] += hv * w0[1]; lg[2] += hv * w0[2]; lg[3] += hv * w0[3]; lg[4] += hv * w1[0]; lg[5] += hv * w1[1]; lg[6] += hv * w1[2]; lg[7] += hv * w1[3]; }
#pragma unroll
            for (int e = 0; e < 8; ++e) lg[e] = wave_sum(lg[e]) + brt[e];
            int e0 = 0; float l0 = lg[0];
#pragma unroll
            for (int e = 1; e < 8; ++e) if (lg[e] > l0) { l0 = lg[e]; e0 = e; }
            int e1 = 0; float l1 = -INFINITY;
#pragma unroll
            for (int e = 0; e < 8; ++e) if (e != e0 && lg[e] > l1) { l1 = lg[e]; e1 = e; }
            const float ex = __expf(l1 - l0); const float ga = 1.0f / (1.0f + ex), gb = ex / (1.0f + ex);
            if (lane == 0) { const unsigned r0 = __hip_atomic_fetch_add(&lcnt[e0], 1u, __ATOMIC_RELAXED, __HIP_MEMORY_SCOPE_WORKGROUP), r1 = __hip_atomic_fetch_add(&lcnt[e1], 1u, __ATOMIC_RELAXED, __HIP_MEMORY_SCOPE_WORKGROUP);
                u32x4 a; a.x = (unsigned)e0; a.y = (unsigned)e1; a.z = r0; a.w = r1; u32x4 bq; bq.x = __float_as_uint(ga); bq.y = __float_as_uint(gb); bq.z = 0u; bq.w = 0u;
                *(u32x4*)(tokinfo + (size_t)row * 8) = a; *(u32x4*)(tokinfo + (size_t)row * 8 + 4) = bq; } RMS_ROWS_END()
    }
    __syncthreads();
    if (tid < 8) lbase[tid] = __hip_atomic_fetch_add(gcnt + tid, lcnt[tid], __ATOMIC_RELAXED, __HIP_MEMORY_SCOPE_AGENT);
    __syncthreads();
    for (int u = first; u < NTOK / 128; u += stride) { const int g0 = u * 8 + wave;
        if (lane == 0) { for (int i = 0; i < 16; ++i) { const int row = g0 * 16 + i; u32x4 a = *(u32x4*)(tokinfo + (size_t)row * 8);
            unsigned b0 = 0, b1 = 0;
#pragma unroll
            for (int e = 0; e < 8; ++e) { const unsigned lb = lbase[e]; b0 = (a.x == (unsigned)e) ? lb : b0; b1 = (a.y == (unsigned)e) ? lb : b1; }
            a.z += b0; a.w += b1; *(u32x4*)(tokinfo + (size_t)row * 8) = a; } }
    }
    int* slot_tok = (int*)(P.ws + WS_SLOTTOK);
    for (int i = gtid; i < MOE_ROWS; i += gthreads) slot_tok[i] = -1;
    __syncthreads();
}
struct MoeLayout { int pstart[9]; };
__device__ __forceinline__ MoeLayout moe_layout(const Params& P) {
    const unsigned* gcnt = (const unsigned*)(P.ws + WS_CTL) + CW_MOECNT; MoeLayout Lo; int acc = 0;
#pragma unroll
    for (int e = 0; e < 8; ++e) { Lo.pstart[e] = acc; const int c = (int)__hip_atomic_load(gcnt + e, __ATOMIC_RELAXED, __HIP_MEMORY_SCOPE_AGENT); acc += (c + 255) / 256 * 256; }
    Lo.pstart[8] = acc; return Lo;
}
__device__ __forceinline__ void moe_assign_phase(const Params& P) {
    BODY_IDS();
    const MoeLayout Lo = moe_layout(P);
    const unsigned* tokinfo = (const unsigned*)(P.ws + WS_TOKINFO); int* slot_tok = (int*)(P.ws + WS_SLOTTOK); float* slot_gate = (float*)(P.ws + WS_SLOTGATE);
    for (int t = gtid; t < NTOK; t += gthreads) { const u32x4 a = *(const u32x4*)(tokinfo + (size_t)t * 8); const u32x2 g = *(const u32x2*)(tokinfo + (size_t)t * 8 + 4);
        int p0 = 0, p1 = 0;
#pragma unroll
        for (int e = 0; e < 8; ++e) { p0 = ((int)a.x == e) ? Lo.pstart[e] : p0; p1 = ((int)a.y == e) ? Lo.pstart[e] : p1; }
        const int s0 = p0 + (int)a.z, s1 = p1 + (int)a.w;
        slot_tok[s0] = t; slot_gate[s0] = __uint_as_float(g.x); slot_tok[s1] = t; slot_gate[s1] = __uint_as_float(g.y); }
}
struct MoeOrder {
    int pstart[9]; int ntile, ncol, G, c;
    __device__ __forceinline__ bool next(int i, pg8::Unit& u) const {
        const long Lf = (long)i * G + c; if (Lf >= (long)ntile * ncol) return false;
        const int rt = (int)(Lf / ncol), j = (int)(Lf % ncol); int e = 0;
#pragma unroll
        for (int q = 1; q < 8; ++q) e = (rt * 256 >= pstart[q]) ? q : e;
        u.pm = rt; u.pn = e * ncol + j; return true;
    }
};
__device__ __forceinline__ MoeOrder moe_order(const Params& P, int ncol, int G, int c) {
    const MoeLayout Lo = moe_layout(P); MoeOrder S;
#pragma unroll
    for (int e = 0; e < 9; ++e) S.pstart[e] = Lo.pstart[e];
    S.ntile = Lo.pstart[8] / 256; S.ncol = ncol; S.G = G; S.c = c; return S;
}

__device__ __forceinline__ void norm_moe_combine(const Params& P, const float* gain, int first, int stride) {
    BODY_IDS();
    const MoeLayout Lo = moe_layout(P); const GainRegs GR = load_gain(gain, lane);
    const unsigned* tokinfo = (const unsigned*)(P.ws + WS_TOKINFO); const bf16* Y = (const bf16*)(P.ws + WS_MOEY); bf16* H = (bf16*)(P.ws + WS_H2);
    for (int u = first; u < NTOK / 128; u += stride) for (int i = 0; i < 16; ++i) { const int row = u * 128 + wave * 16 + i;
        const u32x4 a = *(const u32x4*)(tokinfo + (size_t)row * 8);
        int p0 = 0, p1 = 0;
#pragma unroll
        for (int e = 0; e < 8; ++e) { p0 = ((int)a.x == e) ? Lo.pstart[e] : p0; p1 = ((int)a.y == e) ? Lo.pstart[e] : p1; }
        const u32x2* y0 = (const u32x2*)(Y + (size_t)(p0 + (int)a.z) * D) + lane; const u32x2* y1 = (const u32x2*)(Y + (size_t)(p1 + (int)a.w) * D) + lane;
        u32x2* xr = (u32x2*)(xr_of(P.out) + (size_t)row * D) + lane; f32x4 v[4]; float s = 0.f;
#pragma unroll
        for (int j = 0; j < 4; ++j) { const u32x2 w0 = y0[64 * j], w1 = y1[64 * j]; const u32x2 wx = xr[64 * j];
            v[j] = (f32x4){bflo(wx.x), bfhi(wx.x), bflo(wx.y), bfhi(wx.y)} + (f32x4){bflo(w0.x), bfhi(w0.x), bflo(w0.y), bfhi(w0.y)} + (f32x4){bflo(w1.x), bfhi(w1.x), bflo(w1.y), bfhi(w1.y)};
            { u32x2 wo; wo.x = pk2(v[j][0], v[j][1]); wo.y = pk2(v[j][2], v[j][3]); xr[64 * j] = wo; } s += (v[j][0] * v[j][0] + v[j][1] * v[j][1]) + (v[j][2] * v[j][2] + v[j][3] * v[j][3]); }
        const float rstd = 1.0f / sqrtf(wave_sum(s) * (1.0f / D) + RMS_EPS);
        u32x2* o8 = (u32x2*)(H + (size_t)row * D) + lane;
#pragma unroll
        for (int j = 0; j < 4; ++j) { const f32x4 h = v[j] * rstd * GR.g[j]; u32x2 w; w.x = pk2(h[0], h[1]); w.y = pk2(h[2], h[3]); o8[64 * j] = w; }
    }
}
#ifndef REF_MASK
#define REF_MASK 0
#endif
#ifndef N_LAUNCH_MODE
#define N_LAUNCH_MODE 1
#endif
constexpr int LDS_BYTES = 147456;
constexpr int MISC_OFF = LDS_BYTES - 64;
constexpr int N_PHASES = 27;
#ifndef PHASE_SEL
#define PHASE_SEL 0xFFFFFFFu
#endif
#define PH_ON(b) (((PHASE_SEL) >> (b)) & 1u)
#ifndef SUB_SEL
#define SUB_SEL 0xFFu
#endif
#define SUB_ON(b) (((SUB_SEL) >> (b)) & 1u)

#ifndef PROBE_MASK
#define PROBE_MASK 0u
#endif
#ifndef PROBE_MULT
#define PROBE_MULT 4
#endif
#define TIMED(bit, ...) do { unsigned long long t0_ = 0; if (((PROBE_MASK) >> (bit)) & 1u) t0_ = __builtin_amdgcn_s_memrealtime(); __VA_ARGS__; \
    if (((PROBE_MASK) >> (bit)) & 1u) pacc += __builtin_amdgcn_s_memrealtime() - t0_; } while (0)
#define RUN_GEMM(EPI_T, SCHED_T, GATH, gm, sc, ep) do { if (REF_MASK & 1) pg8::gemm_phase_naive<EPI_T, SCHED_T, GATH>(gm, sc, ep); \
    else pg8::gemm_phase<EPI_T, SCHED_T, true, GATH>(lds, gm, sc, ep); } while (0)

__device__ __forceinline__ int vcu_of() { int G = gridDim.x, bx = blockIdx.x; asm volatile("" : "+s"(G), "+s"(bx)); return (G % 8 == 0) ? (bx % 8) * (G / 8) + bx / 8 : bx; }
__device__ __forceinline__ bool in_range(int lo, int hi, int k) { asm volatile("" : "+s"(lo), "+s"(hi)); return lo <= k && k < hi; }
__global__ void __launch_bounds__(NTHREADS, 2) mega_fwd(Params P) {
    extern __shared__ __attribute__((aligned(16))) unsigned char lds_raw[];
    LAS unsigned char* lds = (LAS unsigned char*)lds_raw;
    const int tid = threadIdx.x;
    const int G = gridDim.x, bx = blockIdx.x;
    unsigned* ctl = (unsigned*)(P.ws + WS_CTL);
    volatile LAS unsigned* misc = (volatile LAS unsigned*)(lds + MISC_OFF);
    if (tid < 16) misc[tid] = 0u;
    if ((tid & 63) == 0) *(LAS int*)(uintptr_t)((unsigned)TID_TAB_OFF + 4u * hw_wave_key()) = tid >> 6;
    __syncthreads();
    const int lo = P.ph_lo, hi = P.ph_hi;
    XcdBarrier bar; bar.bar = ctl + CW_BAR; bar.x = 0; bar.st = misc;
    if (hi - lo > 1) bar = xcd_barrier_post(ctl + CW_BAR, misc);
#define IN(k) in_range(lo, hi, (k))
#ifndef PROBE_SEAMS
#define PROBE_SEAMS 0u
#endif
#define SEAM(k) do { if (IN(k) && IN((k) + 1)) { unsigned long long t0_ = 0; const bool tm_ = (((PROBE_MASK) >> 24) & 1u) || (((PROBE_SEAMS) >> (k)) & 1u); if (tm_) t0_ = __builtin_amdgcn_s_memrealtime(); \
    xcd_barrier(bar); if (tm_) pacc += __builtin_amdgcn_s_memrealtime() - t0_; } } while (0)
    unsigned long long pacc = 0;

#define H ((bf16*)(P.ws + WS_H))
#define ZIN ((bf16*)(P.ws + WS_ZIN))
#define GB ((bf16*)(P.ws + WS_G))
#define MB ((bf16*)(P.ws + WS_M))
#define MLAQ ((bf16*)(P.ws + WS_MLAQ))
#define MLAKV ((bf16*)(P.ws + WS_MLAKV))
#define KPER ((bf16*)(P.ws + WS_KPER))
#define cosT ((float*)(P.ws + WS_COS))
#define sinT ((float*)(P.ws + WS_SIN))
#define slot_tok ((int*)(P.ws + WS_SLOTTOK))
#define slot_gate ((float*)(P.ws + WS_SLOTGATE))

    if (PH_ON(0) && IN(0)) { TIMED(0, cvt_jobs(P, 0, 43, lds); p0_misc(P)); TIMED(1, norm1_phase(P, 0, XSrc{P.in[I_X], nullptr}, vcu_of(), gridDim.x)); }
    SEAM(0);

    for (int L = 0; L < 2; ++L) {
        const int pb = 1 + 12 * L;
        const int pc = (L == 0) ? 9 : 22;
        bf16* const XR = xr_of(P.out);
        const XSrc xsrc = (L == 0) ? XSrc{P.in[I_X], nullptr} : XSrc{nullptr, XR};
        if (PH_ON(2) && IN(pb + 1)) {
            pg8::Gemm g{H, wmix(P, L, WM_IN), D, D, D, nullptr}; pg8::StaticOrder S; S.init(NTOK, ZP, G, bx);
            epi::EpiStore E{ZIN, ZP, 0};
            TIMED(2, RUN_GEMM(epi::EpiStore, pg8::StaticOrder, false, g, S, E));
        }
        SEAM(pb + 1);
        if (PH_ON(3) && IN(pb + 2)) {
            TIMED(3, prep_phase(P, L));
            if (!(REF_MASK & 4)) TIMED(4, s5::phase<0>(P, L, lds));
            __syncthreads();
        }
        SEAM(pb + 2);
        if (PH_ON(4) && IN(pb + 3)) {
            if (SUB_ON(0)) { pg8::Gemm g{ZIN + ZC_CQ, wmix(P, L, WM_UQ), ZP, 256, 256, nullptr}; pg8::StaticOrder S; S.init(NTOK, 512, G, bx);
              epi::EpiMlaQ E{MLAQ, (const float*)(P.ws + WS_RSTDQ), cosT, sinT};
              TIMED(5, RUN_GEMM(epi::EpiMlaQ, pg8::StaticOrder, false, g, S, E)); }
            if (SUB_ON(1)) { pg8::Gemm g{ZIN + ZC_CKV, wmix(P, L, WM_UKV), ZP, 128, 128, nullptr}; pg8::StaticOrder S; S.init(NTOK, 512, G, bx);
              epi::EpiRowScale E{MLAKV, 512, (const float*)(P.ws + WS_RSTDKV)};
              TIMED(5, RUN_GEMM(epi::EpiRowScale, pg8::StaticOrder, false, g, S, E)); }
            if (SUB_ON(2)) { TIMED(6, if (REF_MASK & 4) s5::naive(P, L); else s5::phase<1>(P, L, lds)); }
            __syncthreads();
            if (SUB_ON(3)) { att::Tensors T; T.Q = ZIN + ZC_FQ; T.ldq = ZP; T.K = ZIN + ZC_FK; T.ldk = ZP; T.K2 = nullptr; T.V = ZIN + ZC_FV; T.ldv = ZP; T.O = ZIN + ZC_FQ; T.ldo = ZP;
              T.cdec = (const float*)(P.ws + WS_CDEC); T.relb = nullptr; T.qhs = 64; T.khs = 64; T.vhs = 64; T.ohs = 64;
              T.qmax = (const unsigned*)(P.ws + WS_CTL) + CW_QMAX + L * 512; T.kmax = (const unsigned*)(P.ws + WS_CTL) + CW_KMAX + L * 16;
              TIMED(7, if (REF_MASK & 2) att::attn_naive<att::MODE_FOX>(T); else att::attn_phase<att::MODE_FOX>(T, lds)); }
            __syncthreads();
            if (SUB_ON(4)) { att::Tensors T; T.Q = ZIN + ZC_DQ; T.ldq = ZP; T.K = ZIN + ZC_DK; T.ldk = ZP; T.K2 = nullptr; T.V = ZIN + ZC_DV; T.ldv = ZP; T.O = ZIN + ZC_DQ; T.ldo = ZP;
              T.cdec = nullptr; T.relb = P.in[I_RELB] + (size_t)L * 4 * 513; T.qhs = 64; T.khs = 64; T.vhs = 64; T.ohs = 64;
              TIMED(8, if (REF_MASK & 2) att::attn_naive<att::MODE_BAND>(T); else att::attn_phase<att::MODE_BAND>(T, lds)); }
            __syncthreads();
        }
        SEAM(pb + 3);
        if (PH_ON(5) && IN(pb + 4)) {
            if (SUB_ON(0)) { att::Tensors T; T.Q = MLAQ; T.ldq = 512; T.K = MLAKV; T.ldk = 512; T.K2 = KPER; T.V = MLAKV + 64; T.ldv = 512; T.O = ZIN + ZC_CQ; T.ldo = ZP;
              T.cdec = nullptr; T.relb = nullptr; T.qhs = 96; T.khs = 128; T.vhs = 128; T.ohs = 64;
              TIMED(9, if (REF_MASK & 2) att::attn_naive<att::MODE_MLA>(T); else att::attn_phase<att::MODE_MLA>(T, lds)); }
            __syncthreads();
            if (SUB_ON(1)) { pg8::Gemm g{ZIN + ZC_U, wmix(P, L, WM_GLU), ZP, 256, 256, nullptr}; pg8::StaticOrder S; S.init(NTOK, 256, G, bx);
              epi::EpiGlu E{ZIN + ZC_U, ZP};
              TIMED(10, RUN_GEMM(epi::EpiGlu, pg8::StaticOrder, false, g, S, E)); }
        }
        SEAM(pb + 4);
        if (PH_ON(6) && IN(pb + 5)) {
            g128::MergeProg MP; MP.Hn = H; MP.zin = ZIN; MP.wg = wmix(P, L, WM_G); MP.wb = wmix(P, L, WM_B); MP.bg = P.in[I_BG] + (size_t)L * 4 * D; MP.M = MB;
            const int vcu_ = vcu_of();
            TIMED(11, g128::stream<g128::MergeProg>(lds, MP, 1024, vcu_, G));
        }
        SEAM(pb + 5);
#define PANEL_FENCE() do { asm volatile("s_waitcnt vmcnt(0)" ::: "memory"); __builtin_amdgcn_fence(__ATOMIC_ACQUIRE, "agent"); asm volatile("s_waitcnt vmcnt(0)" ::: "memory"); __syncthreads(); } while (0)
        if (PH_ON(7) && IN(pb + 6)) {
            pg8::Gemm g{MB, wmix(P, L, WM_O), D, D, D, nullptr}; pg8::StaticOrder S; S.init(NTOK, D, G, bx);
            epi::EpiRes E{xsrc, XR};
            TIMED(13, RUN_GEMM(epi::EpiRes, pg8::StaticOrder, false, g, S, E));
        }
        SEAM(pb + 6);
        if (PH_ON(8) && IN(pb + 7)) {
            const int vcu_ = vcu_of();
            if (L == 0) TIMED(14, norm_plain(XSrc{nullptr, XR}, P.in[I_GFFN], H, vcu_, G));
            else { TIMED(14, norm2_moe_phase(P, XSrc{nullptr, XR}, lds, vcu_, G)); TIMED(25, cvt_jobs(P, 43, 67, lds)); __syncthreads(); }
        }
        SEAM(pb + 7);
        if (L == 0) {
            if (PH_ON(9) && IN(9)) {
                pg8::Gemm g{H, (const bf16*)(P.ws + WS_W13), D, D, D, nullptr}; pg8::StaticOrder S; S.init(NTOK, 2 * DFF, G, bx);
                epi::EpiSwiglu E{(bf16*)(P.ws + WS_HMID), DFF, 22};
                TIMED(15, RUN_GEMM(epi::EpiSwiglu, pg8::StaticOrder, false, g, S, E));
            }
            SEAM(9);
            if (PH_ON(10) && IN(10)) {
                pg8::Gemm g{(const bf16*)(P.ws + WS_HMID), (const bf16*)(P.ws + WS_W2), DFF, DFF, DFF, nullptr}; pg8::StaticOrder S; S.init(NTOK, D, G, bx);
                epi::EpiRes E{XSrc{nullptr, XR}, XR};
                TIMED(16, RUN_GEMM(epi::EpiRes, pg8::StaticOrder, false, g, S, E));
            }
            SEAM(10);
        } else {
            if (PH_ON(21) && IN(21)) TIMED(17, moe_assign_phase(P));
            SEAM(21);
            if (PH_ON(22) && IN(22)) {
                pg8::Gemm g{H, (const bf16*)(P.ws + WS_WM13), D, D, D, slot_tok}; const MoeOrder S = moe_order(P, 11, G, bx);
                epi::EpiSwiglu E{(bf16*)(P.ws + WS_HMID), DFFE, 11};
                TIMED(18, RUN_GEMM(epi::EpiSwiglu, MoeOrder, true, g, S, E));
            }
            SEAM(22);
            if (PH_ON(23) && IN(23)) {
                pg8::Gemm g{(const bf16*)(P.ws + WS_HMID), (const bf16*)(P.ws + WS_WM2), DFFE, DFFE, DFFE, nullptr}; const MoeOrder S = moe_order(P, 4, G, bx);
                epi::EpiMoeDown E{(bf16*)(P.ws + WS_MOEY), slot_gate};
                TIMED(19, RUN_GEMM(epi::EpiMoeDown, MoeOrder, false, g, S, E));
            }
            SEAM(23);
        }
        if (PH_ON(12) && IN(pc + 3)) {
            const int vcu_ = vcu_of();
            if (L == 0) TIMED(20, norm_plain(XSrc{nullptr, XR}, P.in[I_GPLE] + L * D, H, vcu_, G)); else TIMED(20, norm_moe_combine(P, P.in[I_GPLE] + L * D, vcu_, G));
            PANEL_FENCE();
            g128::PleProg PP; PP.pbf = (const bf16*)(P.ws + WS_PBF) + (size_t)L * NTOK * 256; PP.hp = (L == 0) ? H : (const bf16*)(P.ws + WS_H2); PP.wup = wmix(P, L, WM_UP); PP.wpg = wmix(P, L, WM_PG); PP.x = XR;
            TIMED(22, g128::stream<g128::PleProg>(lds, PP, NTOK / 128, vcu_, G));
            PANEL_FENCE();
            if (L == 0) TIMED(1, norm1_phase(P, 1, XSrc{nullptr, XR}, vcu_, G));
        }
        if (L == 0) SEAM(pc + 3);
    }
    if (PH_ON(26) && IN(25)) {
        const int vcu_ = vcu_of(); const int G_ = gridDim.x;
        for (int r = 0; r < (NTOK / 128 + G_ - 1) / G_; ++r) {
            const int u = vcu_ + r * G_; FinalRows FR;
            if (u < NTOK / 128) final_norm_load(P, u, FR);
            xcd_barrier(bar);
            if (u < NTOK / 128) final_norm_store(P, u, FR);
        }
    }
    if (PROBE_MASK || PROBE_SEAMS) { const unsigned long long t0_ = __builtin_amdgcn_s_memrealtime(); while (__builtin_amdgcn_s_memrealtime() - t0_ < (unsigned long long)PROBE_MULT * pacc) __builtin_amdgcn_s_sleep(8); }
#undef IN
#undef SEAM
#undef H
#undef ZIN
#undef GB
#undef MB
#undef MLAQ
#undef MLAKV
#undef KPER
#undef cosT
#undef sinT
#undef slot_tok
#undef slot_gate
}

extern "C" void kernel_launch(void* const* d_in, const int* in_sizes, int n_in, void* d_out, int out_size, void* d_ws, size_t ws_size, hipStream_t stream) {
    static int grid = 0;
    if (grid == 0) {
        if (n_in != 37 || out_size != NTOK * D || ws_size < WS_END) { fprintf(stderr, "kernel_launch: unexpected shapes: n_in %d out %d ws %zu\n", n_in, out_size, ws_size); grid = -1; return; }
        int dev = 0, cus = 0, per_cu = 0;
        if (hipGetDevice(&dev) != hipSuccess || hipDeviceGetAttribute(&cus, hipDeviceAttributeMultiprocessorCount, dev) != hipSuccess) { grid = -1; return; }
        if (hipFuncSetAttribute((const void*)mega_fwd, hipFuncAttributeMaxDynamicSharedMemorySize, LDS_BYTES) != hipSuccess) { fprintf(stderr, "kernel_launch: hipFuncSetAttribute failed\n"); grid = -1; return; }
        if (hipOccupancyMaxActiveBlocksPerMultiprocessor(&per_cu, (const void*)mega_fwd, NTHREADS, LDS_BYTES) != hipSuccess || per_cu < 1)
            fprintf(stderr, "kernel_launch: note: occupancy query reports %d workgroups per CU\n", per_cu);
        (void)hipGetLastError();
        grid = cus;
        if (grid != 256) fprintf(stderr, "kernel_launch: note: %d CUs (built for 256)\n", grid);
    }
    if (grid < 0) return;
    if (hipMemsetAsync((char*)d_ws + WS_CTL, 0, CTL_ZERO_BYTES, stream) != hipSuccess) return;
    Params p{};
    for (int i = 0; i < 37; ++i) p.in[i] = (const float*)d_in[i];
    p.out = (float*)d_out; p.ws = (unsigned char*)d_ws;
#if N_LAUNCH_MODE == 1
    p.ph_lo = 0; p.ph_hi = N_PHASES;
    hipLaunchKernelGGL(mega_fwd, dim3(grid), dim3(NTHREADS), LDS_BYTES, stream, p);
#else
    for (int ph = 0; ph < N_PHASES; ++ph) { p.ph_lo = ph; p.ph_hi = ph + 1; hipLaunchKernelGGL(mega_fwd, dim3(grid), dim3(NTHREADS), LDS_BYTES, stream, p); }
#endif
    const hipError_t le = hipPeekAtLastError();
    if (le != hipSuccess) fprintf(stderr, "kernel_launch: launch failed: %s\n", hipGetErrorName(le));
}
```

```cpp
#include <hip/hip_runtime.h>
#include <cstdio>
#include <cstdint>

#define GAS __attribute__((address_space(1)))
#define LAS __attribute__((address_space(3)))
typedef unsigned short bf16;
typedef short bf16x8 __attribute__((ext_vector_type(8)));
typedef short s16x4 __attribute__((ext_vector_type(4)));
typedef float f32x2 __attribute__((ext_vector_type(2)));
typedef float f32x4 __attribute__((ext_vector_type(4)));
typedef float f32x16 __attribute__((ext_vector_type(16)));
typedef unsigned u32x2 __attribute__((ext_vector_type(2)));
typedef unsigned u32x4 __attribute__((ext_vector_type(4)));
typedef __bf16 bf16x2_t __attribute__((ext_vector_type(2)));

constexpr int NB = 4, SEQ = 8192, NTOK = NB * SEQ, D = 1024;
constexpr int ZP = 2304;
constexpr int ZC_U = 0, ZC_FQ = 256, ZC_FK = 512, ZC_FV = 768, ZC_DQ = 1024, ZC_DK = 1280, ZC_DV = 1536, ZC_CQ = 1792, ZC_CKV = 2048, ZC_KPE = 2176;
constexpr int DIN = 2148, DFF = 2816, DFFE = 1408, NE = 8;
constexpr int MOE_ROWS = 2 * NTOK + NE * 256;
constexpr float RMS_EPS = 1e-6f;
constexpr int NWAVES = 8, NTHREADS = 512;

constexpr size_t MiB = 1u << 20;
constexpr size_t WS_CTL = 0, CTL_ZERO_BYTES = 1 * MiB;
constexpr size_t WS_COS = 1 * MiB, WS_SIN = 3 * MiB;
constexpr size_t WS_LOGF = 5 * MiB;
constexpr size_t WS_CDEC = 5 * MiB + 512 * 1024;
constexpr size_t WS_WSUM = 6 * MiB;
constexpr size_t WS_RSTDQ = 6 * MiB + 256 * 1024, WS_RSTDKV = 6 * MiB + 512 * 1024;
constexpr size_t WS_SC = 7 * MiB;
constexpr size_t WS_TOKINFO = 11 * MiB;
constexpr size_t WS_SLOTTOK = 12 * MiB, WS_SLOTGATE = 12 * MiB + 512 * 1024;
constexpr size_t WS_PBF = 17 * MiB;
constexpr size_t WS_WMIX = 49 * MiB, WMIX_STRIDE = 20 * MiB;
constexpr size_t WM_IN = 0, WM_G = 4 * MiB + 512 * 1024, WM_B = 12 * MiB + 512 * 1024, WM_O = 14 * MiB + 512 * 1024, WM_PG = 16 * MiB + 512 * 1024,
                 WM_UP = 18 * MiB + 512 * 1024, WM_UQ = 19 * MiB, WM_UKV = 19 * MiB + 256 * 1024, WM_GLU = 19 * MiB + 384 * 1024;
constexpr size_t WS_W13 = 89 * MiB, WS_W2 = 100 * MiB;
constexpr size_t WS_H = 106 * MiB;
constexpr size_t WS_MLAQ = 170 * MiB, WS_MLAKV = 202 * MiB, WS_KPER = 234 * MiB;
constexpr size_t WS_M = 170 * MiB;
constexpr size_t WS_ZIN = 236 * MiB;
constexpr size_t WS_G = 380 * MiB;
constexpr size_t WS_HMID = 236 * MiB;
constexpr size_t WS_U = 236 * MiB;
constexpr size_t WS_WM13 = 418 * MiB, WS_WM2 = 462 * MiB;
constexpr size_t WS_MOEY = 89 * MiB;
constexpr size_t WS_H2 = 300 * MiB;
constexpr size_t WS_END = 484 * MiB;
constexpr int CW_BAR = 4096;
constexpr int CW_MOECNT = 16384;
constexpr int CW_QMAX = 20480;
constexpr int CW_KMAX = 22528;

#define LDS_WAIT() asm volatile("s_waitcnt lgkmcnt(0)" ::: "memory")
#define VM_WAIT() asm volatile("s_waitcnt vmcnt(0)" ::: "memory")
__device__ __forceinline__ unsigned f2bf(float f) { unsigned u = __builtin_bit_cast(unsigned, f); return (u + 0x7fffu + ((u >> 16) & 1u)) >> 16; }
__device__ __forceinline__ unsigned pk2(float lo, float hi) { f32x2 v = {lo, hi}; bf16x2_t b = __builtin_convertvector(v, bf16x2_t); return __builtin_bit_cast(unsigned, b); }
__device__ __forceinline__ float bf2f(unsigned short b) { return __uint_as_float((unsigned)b << 16); }
__device__ __forceinline__ float bflo(unsigned w) { return __uint_as_float(w << 16); }
__device__ __forceinline__ float bfhi(unsigned w) { return __uint_as_float(w & 0xffff0000u); }
constexpr int TID_TAB_OFF = 147456 - 512;
__device__ __forceinline__ unsigned hw_wave_key() { return (unsigned)__builtin_amdgcn_s_getreg((5 << 11) | 4) & 0x3Fu; }
__device__ __forceinline__ int my_tid() {
    unsigned addr = (unsigned)TID_TAB_OFF + 4u * hw_wave_key(); asm volatile("" : "+s"(addr));
    const int wave = __builtin_amdgcn_readfirstlane(*(const LAS int*)(uintptr_t)addr);
    int lane = (int)__builtin_amdgcn_mbcnt_hi(~0u, __builtin_amdgcn_mbcnt_lo(~0u, 0u)); asm volatile("" : "+v"(lane));
    return wave * 64 + lane;
}
__device__ __forceinline__ float shflx(float v, int o, int lane) { return __int_as_float(__builtin_amdgcn_ds_bpermute((lane ^ o) << 2, __float_as_int(v))); }
#define DPP_F(x_, ctrl_, rm_) __int_as_float(__builtin_amdgcn_update_dpp(0, __float_as_int(x_), (ctrl_), (rm_), 0xF, true))
__device__ __forceinline__ float wave_sum(float v) {
    v += DPP_F(v, 0xB1, 0xF); v += DPP_F(v, 0x4E, 0xF); v += DPP_F(v, 0x114, 0xF); v += DPP_F(v, 0x118, 0xF);
    v += DPP_F(v, 0x142, 0xA); v += DPP_F(v, 0x143, 0xC);
    return __int_as_float(__builtin_amdgcn_readlane(__float_as_int(v), 63));
}
__device__ __forceinline__ float sigmoidf_(float x) { return __builtin_amdgcn_rcpf(1.0f + __expf(-x)); }

struct XSrc { const float* f; const bf16* b; };
__device__ __forceinline__ f32x4 ldx4(const XSrc& x, size_t idx) {
    if (x.f) return *(const f32x4*)(x.f + idx);
    const u32x2 w = *(const u32x2*)(x.b + idx); return (f32x4){bflo(w.x), bfhi(w.x), bflo(w.y), bfhi(w.y)};
}
__device__ __forceinline__ bf16* xr_of(float* out) { return (bf16*)((unsigned char*)out + (size_t)NTOK * D * 2); }
#define BODY_IDS() int tid = my_tid(); asm volatile("" : "+v"(tid)); const int lane = tid & 63; const int wave = __builtin_amdgcn_readfirstlane(tid >> 6); \
    int grid_ = gridDim.x; asm volatile("" : "+s"(grid_)); \
    const int gw = blockIdx.x * NWAVES + wave, ngw = grid_ * NWAVES, gtid = blockIdx.x * NTHREADS + tid, gthreads = grid_ * NTHREADS; (void)lane; (void)wave; (void)gw; (void)ngw; (void)gtid; (void)gthreads
#define XB_TMO      128
#define XB_XCNT(j)  (256  + 64 * (j))
#define XB_XSUB(j)  (1280 + 64 * (j))
#define XB_XGEN(j)  (2304 + 64 * (j))
#define XB_TOP      3328
#define XB_TOPGEN   3392
#define XCD_BAR_WORDS 3456
#define XB_SPIN_CAP (1u << 22)

__device__ __forceinline__ unsigned xb_ld(unsigned* p)              { return __hip_atomic_load(p, __ATOMIC_RELAXED, __HIP_MEMORY_SCOPE_AGENT); }
__device__ __forceinline__ unsigned xb_add(unsigned* p, unsigned v) { return __hip_atomic_fetch_add(p, v, __ATOMIC_RELAXED, __HIP_MEMORY_SCOPE_AGENT); }
__device__ __forceinline__ unsigned xb_xcc_id() { return (unsigned)__builtin_amdgcn_s_getreg((3 << 11) | 20) & 0xFu; }
#define XB_SPIN(cond, bar) do { unsigned _sp = 0; while (cond) { __builtin_amdgcn_s_sleep(1); \
    if ((++_sp & 255u) == 0u) { if (xb_ld(&(bar)[XB_TMO])) break; if (_sp > XB_SPIN_CAP) { atomicAdd(&(bar)[XB_TMO], 1u); break; } } } } while (0)

struct XcdBarrier { unsigned* bar; unsigned x; volatile LAS unsigned* st; };

__device__ __forceinline__ XcdBarrier xcd_barrier_post(unsigned* bar, volatile LAS unsigned* st) {
    XcdBarrier b; b.bar = bar; b.x = xb_xcc_id(); b.st = st;
    if (my_tid() == 0) (void)xb_add(&bar[XB_XCNT(b.x)], 1u);
    return b;
}
__device__ __forceinline__ void xcd_barrier_complete(unsigned* bar, unsigned x, unsigned& nloc, unsigned& nx) {
    const unsigned G = gridDim.x * gridDim.y * gridDim.z;
    unsigned sum, cnt, mine, sp = 0u;
    for (;;) {
        sum = 0u; cnt = 0u; mine = 0u;
#pragma unroll
        for (unsigned j = 0; j < 16; ++j) { const unsigned c = xb_ld(&bar[XB_XCNT(j)]); sum += c; cnt += (c > 0u) ? 1u : 0u; mine = (j == x) ? c : mine; }
        if (sum == G) break;
        __builtin_amdgcn_s_sleep(1);
        if ((++sp & 255u) == 0u) { if (xb_ld(&bar[XB_TMO])) break; if (sp > XB_SPIN_CAP) { atomicAdd(&bar[XB_TMO], 1u); break; } }
    }
    nloc = mine > 0u ? mine : 1u; nx = cnt > 0u ? cnt : 1u;
}
__device__ __forceinline__ void xcd_barrier(const XcdBarrier& b) {
    asm volatile("s_waitcnt vmcnt(0)" ::: "memory");
    __syncthreads();
    if (my_tid() == 0) {
        unsigned* bar = b.bar;
        __builtin_amdgcn_s_waitcnt(0);
        unsigned nloc = b.st[0], nx = b.st[1];
        if (nloc == 0u) { xcd_barrier_complete(bar, b.x, nloc, nx); b.st[0] = nloc; b.st[1] = nx; }
        const unsigned old = xb_add(&bar[XB_XSUB(b.x)], 1u);
        const unsigned gen = old / nloc;
        if (old + 1u == (gen + 1u) * nloc) {
            __builtin_amdgcn_fence(__ATOMIC_RELEASE, "agent");
            asm volatile("s_waitcnt vmcnt(0)" ::: "memory");
            const unsigned og = xb_add(&bar[XB_TOP], 1u);
            const unsigned tg = og / nx;
            if (og + 1u == (tg + 1u) * nx) xb_add(&bar[XB_TOPGEN], 1u);
            else XB_SPIN(xb_ld(&bar[XB_TOPGEN]) == tg, bar);
            __builtin_amdgcn_fence(__ATOMIC_ACQUIRE, "agent");
            xb_add(&bar[XB_XGEN(b.x)], 1u);
            asm volatile("s_waitcnt vmcnt(0)" ::: "memory");
        } else {
            XB_SPIN(xb_ld(&bar[XB_XGEN(b.x)]) == gen, bar);
            __builtin_amdgcn_fence(__ATOMIC_ACQUIRE, "agent");
            asm volatile("s_waitcnt vmcnt(0)" ::: "memory");
        }
    }
    __syncthreads();
}
namespace pg8 {
constexpr int BM = 256, BK = 64, HALF = 128, HTB = HALF * BK * 2, STAGE_BYTES = 8 * HTB, NXCD = 8, WGM = 8;
__host__ __device__ __forceinline__ int lds_byte(int r, int c) { const int st = (r >> 4) * 2 + (c >> 5), rr = r & 15, cc = c & 31, ob = rr * 64 + cc * 2; return st * 1024 + (ob ^ (((ob >> 9) & 1) << 5)); }
__host__ __device__ __forceinline__ void stage_rc(int b, int& R, int& C) { const int st = b / 1024, sb = b % 1024, swz = sb ^ (((sb >> 9) & 1) << 5); R = (st >> 1) * 16 + swz / 64; C = (st & 1) * 32 + (swz % 64) / 2; }
__host__ __device__ __forceinline__ int perm32(int rho) { const int n = rho >> 4, i = rho & 15; return 8 * (i >> 2) + 4 * n + (i & 3); }

struct Unit { int pm, pn; };
struct Gemm { const bf16* A; const bf16* Bt; int lda, ldb, K; const int* gidx; };

struct StaticOrder {
    int nM, nN, nwg, G, c;
    __host__ __device__ void init(int M, int N, int G_, int c_) { nM = M / BM; nN = N / BM; nwg = nM * nN; G = G_; c = c_; }
    __host__ __device__ bool next(int i, Unit& u) const {
        const long L = (long)i * G + c; if (L >= nwg) return false;
        int wgid = (int)L; { const int q = nwg / NXCD, r = nwg % NXCD, xcd = wgid % NXCD, off = wgid / NXCD; wgid = (xcd < r ? xcd * (q + 1) : r * (q + 1) + (xcd - r) * q) + off; }
        const int nig = WGM * nN, gid = wgid / nig, fm = gid * WGM, gsz = (nM - fm) < WGM ? (nM - fm) : WGM;
        u.pm = fm + ((wgid % nig) % gsz); u.pn = (wgid % nig) / gsz; return true;
    }
};

template <class Epi, class Sched, bool ALIGN_EPI, bool GATHER>
__device__ __forceinline__ void gemm_phase(LAS unsigned char* lds, const Gemm g, const Sched& S, const Epi& E) {
    int tid = my_tid(); asm volatile("" : "+v"(tid));
    const int wid = __builtin_amdgcn_readfirstlane(tid >> 6), lane = tid & 63, wr = wid >> 2, wc = wid & 3, fr = lane & 15, fq = lane >> 4;
    int Kq = g.K; asm volatile("" : "+s"(Kq));
    const int K = Kq, nt = K / BK;
    int RA[2], CA[2];
    unsigned voffA[2], voffB[2];
#pragma unroll
    for (int i = 0; i < 2; ++i) { int R, C; stage_rc(tid * 16 + i * 8192, R, C); const int Rb = Epi::PERM ? ((R & ~31) + perm32(R & 31)) : R;
        RA[i] = R; CA[i] = C; voffA[i] = (unsigned)(R * g.lda + C) * 2u; voffB[i] = (unsigned)(Rb * g.ldb + C) * 2u; }
    const size_t kstep = (size_t)(BK * 2);
    const size_t hstepB = (size_t)HALF * g.ldb * 2, tstepB = 2 * hstepB;
    const size_t hstepA = (size_t)HALF * g.lda * 2, tstepA = 2 * hstepA;
    const unsigned ldsw = (unsigned)wid * 1024u;
    const int aoff = lds_byte(wr * 64 + fr, fq * 8), boff = lds_byte(wc * 32 + fr, fq * 8);
#define PG8_SA(b, h) (((b) * 2 + (h)) * HTB)
#define PG8_SB(b, h) ((4 + (b) * 2 + (h)) * HTB)
#define PG8_STAGEB(bufoff, gbase) do { _Pragma("unroll") for (int _i = 0; _i < 2; ++_i) \
        __builtin_amdgcn_global_load_lds((const unsigned*)((const char*)(gbase) + voffB[_i]), (LAS unsigned*)(lds + (bufoff) + ldsw + _i * 8192), 16, 0, 0); } while (0)
#define PG8_STAGEA(bufoff, kptr, isnext, h) do { _Pragma("unroll") for (int _i = 0; _i < 2; ++_i) { const char* _p; \
        if constexpr (GATHER) _p = (const char*)(kptr) + ((isnext) ? nvo[h][_i] : cvo[h][_i]); else _p = (const char*)(kptr) + (size_t)(h) * hstepA + voffA[_i]; \
        __builtin_amdgcn_global_load_lds((const unsigned*)_p, (LAS unsigned*)(lds + (bufoff) + ldsw + _i * 8192), 16, 0, 0); } } while (0)
#define PG8_LDA(dst, b, h) do { _Pragma("unroll") for (int m = 0; m < 4; ++m) _Pragma("unroll") for (int k = 0; k < 2; ++k) dst[m][k] = *(const LAS bf16x8*)(lds + PG8_SA(b, h) + aoff + m * 2048 + k * 1024); } while (0)
#define PG8_LDB(dst, b, h) do { _Pragma("unroll") for (int n = 0; n < 2; ++n) _Pragma("unroll") for (int k = 0; k < 2; ++k) dst[n][k] = *(const LAS bf16x8*)(lds + PG8_SB(b, h) + boff + n * 2048 + k * 1024); } while (0)
#define PG8_MMA(ai, bj, At, Bt) do { __builtin_amdgcn_s_setprio(1); _Pragma("unroll") for (int m = 0; m < 4; ++m) _Pragma("unroll") for (int n = 0; n < 2; ++n) _Pragma("unroll") for (int k = 0; k < 2; ++k) \
        acc[ai][bj][m][n] = __builtin_amdgcn_mfma_f32_16x16x32_bf16(Bt[n][k], At[m][k], acc[ai][bj][m][n], 0, 0, 0); __builtin_amdgcn_s_setprio(0); } while (0)
#define PG8_WAIT_V(n) asm volatile("s_waitcnt vmcnt(" #n ")" ::: "memory")
#define PG8_WAIT_L(n) asm volatile("s_waitcnt lgkmcnt(" #n ")" ::: "memory")
#define PG8_BAR __builtin_amdgcn_s_barrier()
#define PG8_SCHED __builtin_amdgcn_sched_barrier(0)
#define PG8_VOA(vo, u) do { _Pragma("unroll") for (int _h = 0; _h < 2; ++_h) _Pragma("unroll") for (int _i = 0; _i < 2; ++_i) { \
        int _row = (u).pm * BM + _h * HALF + RA[_i]; if (GATHER) { _row = g.gidx[_row]; _row = _row < 0 ? 0 : _row; } \
        (vo)[_h][_i] = (unsigned)_row * (unsigned)(g.lda * 2) + (unsigned)(CA[_i] * 2); } } while (0)
    Unit cur, nxt; int ui = 0;
    if (!S.next(0, cur)) return;
    f32x4 acc[2][2][4][2];
#pragma unroll
    for (int a = 0; a < 2; ++a)
#pragma unroll
        for (int b = 0; b < 2; ++b)
#pragma unroll
            for (int m = 0; m < 4; ++m)
#pragma unroll
                for (int n = 0; n < 2; ++n) acc[a][b][m][n] = (f32x4){0.f, 0.f, 0.f, 0.f};
    bf16x8 At[4][2], B0[2][2], B1[2][2];
    unsigned cvo[2][2], nvo[2][2];
    if constexpr (GATHER) { PG8_VOA(cvo, cur); PG8_VOA(nvo, cur); }
    const char* cA = (const char*)g.A + (GATHER ? (size_t)0 : (size_t)cur.pm * tstepA); const char* cB = (const char*)g.Bt + (size_t)cur.pn * tstepB;
    PG8_STAGEB(PG8_SB(0, 0), cB); PG8_STAGEB(PG8_SB(0, 1), cB + hstepB); PG8_STAGEA(PG8_SA(0, 0), cA, false, 0); PG8_STAGEA(PG8_SA(0, 1), cA, false, 1);
    if (wr == 1) PG8_BAR;
    PG8_WAIT_V(2); PG8_BAR;
    PG8_STAGEB(PG8_SB(1, 0), cB + kstep); PG8_STAGEA(PG8_SA(1, 0), cA + kstep, false, 0); PG8_STAGEB(PG8_SB(1, 1), cB + hstepB + kstep);
    PG8_WAIT_V(6); PG8_BAR;
    for (;;) {
        const bool has_next = S.next(ui + 1, nxt);
        if constexpr (GATHER) { if (has_next) { PG8_VOA(nvo, nxt); } }
        const char* nA = (GATHER || !has_next) ? cA : (const char*)g.A + (size_t)nxt.pm * tstepA;
        const char* nB = has_next ? (const char*)g.Bt + (size_t)nxt.pn * tstepB : cB;
#pragma nounroll
        for (int t = 0; t < nt; t += 2) {
            const bool last = (t == nt - 2);
            const char* a1 = cA + (size_t)(t + 1) * kstep;
            const char* a2 = last ? nA : cA + (size_t)(t + 2) * kstep; const char* b2 = last ? nB : cB + (size_t)(t + 2) * kstep;
            const char* a3 = a2 + kstep; const char* b3 = b2 + kstep;
            PG8_LDB(B0, 0, 0); PG8_LDB(B1, 0, 1); PG8_SCHED; PG8_LDA(At, 0, 0); PG8_STAGEA(PG8_SA(1, 1), a1, false, 1);
            PG8_WAIT_V(8); PG8_WAIT_L(0); PG8_BAR; PG8_MMA(0, 0, At, B0); PG8_MMA(0, 1, At, B1); PG8_BAR; PG8_SCHED;
            PG8_LDA(At, 0, 1); PG8_STAGEB(PG8_SB(0, 0), b2); PG8_STAGEB(PG8_SB(0, 1), b2 + hstepB); PG8_STAGEA(PG8_SA(0, 0), a2, last, 0);
            PG8_WAIT_V(8); PG8_WAIT_L(0); PG8_BAR; PG8_MMA(1, 0, At, B0); PG8_MMA(1, 1, At, B1); PG8_BAR; PG8_SCHED;
            PG8_LDB(B0, 1, 0); PG8_LDB(B1, 1, 1); PG8_SCHED; PG8_LDA(At, 1, 0); PG8_STAGEA(PG8_SA(0, 1), a2, last, 1);
            PG8_WAIT_V(8); PG8_WAIT_L(0); PG8_BAR; PG8_MMA(0, 0, At, B0); PG8_MMA(0, 1, At, B1); PG8_BAR; PG8_SCHED;
            PG8_LDA(At, 1, 1); PG8_STAGEB(PG8_SB(1, 0), b3); PG8_STAGEB(PG8_SB(1, 1), b3 + hstepB); PG8_STAGEA(PG8_SA(1, 0), a3, last, 0);
            PG8_WAIT_V(8); PG8_WAIT_L(0); PG8_BAR; PG8_MMA(1, 0, At, B0); PG8_MMA(1, 1, At, B1); PG8_BAR; PG8_SCHED;
        }
        if constexpr (ALIGN_EPI) { if (wr == 0) PG8_BAR; }
        E(acc, cur, wr, wc, fr, fq);
        if (!has_next) break;
#pragma unroll
        for (int a = 0; a < 2; ++a)
#pragma unroll
            for (int b = 0; b < 2; ++b)
#pragma unroll
                for (int m = 0; m < 4; ++m)
#pragma unroll
                    for (int n = 0; n < 2; ++n) acc[a][b][m][n] = (f32x4){0.f, 0.f, 0.f, 0.f};
        cur = nxt; cA = nA; cB = nB; ++ui;
        if constexpr (GATHER) {
#pragma unroll
            for (int _h = 0; _h < 2; ++_h)
#pragma unroll
                for (int _i = 0; _i < 2; ++_i) cvo[_h][_i] = nvo[_h][_i]; }
        if constexpr (ALIGN_EPI) { if (wr == 1) PG8_BAR; }
    }
    PG8_WAIT_V(0);
    if constexpr (!ALIGN_EPI) { if (wr == 0) PG8_BAR; }
    PG8_BAR;
#undef PG8_SA
#undef PG8_SB
#undef PG8_STAGEA
#undef PG8_STAGEB
#undef PG8_LDA
#undef PG8_LDB
#undef PG8_MMA
#undef PG8_WAIT_V
#undef PG8_WAIT_L
#undef PG8_BAR
#undef PG8_SCHED
#undef PG8_VOA
}

template <class Epi, class Sched, bool GATHER>
__device__ __forceinline__ void gemm_phase_naive(const Gemm g, const Sched& S, const Epi& E) {
    const int tid = threadIdx.x, wid = tid >> 6, lane = tid & 63, wr = wid >> 2, wc = wid & 3, fr = lane & 15, fq = lane >> 4;
    Unit u;
    for (int ui = 0; S.next(ui, u); ++ui) {
        f32x4 acc[2][2][4][2];
#pragma unroll
        for (int a = 0; a < 2; ++a)
#pragma unroll
            for (int b = 0; b < 2; ++b)
#pragma unroll
                for (int m = 0; m < 4; ++m)
#pragma unroll
                    for (int n = 0; n < 2; ++n) acc[a][b][m][n] = (f32x4){0.f, 0.f, 0.f, 0.f};
        const bf16* arow[2][4];
#pragma unroll
        for (int ai = 0; ai < 2; ++ai)
#pragma unroll
            for (int m = 0; m < 4; ++m) { int r = u.pm * BM + ai * HALF + wr * 64 + m * 16 + fr; if (GATHER) { r = g.gidx[r]; r = r < 0 ? 0 : r; } arow[ai][m] = g.A + (size_t)r * g.lda; }
        for (int k = 0; k < g.K; k += 4) {
            float av[2][4][4];
#pragma unroll
            for (int ai = 0; ai < 2; ++ai)
#pragma unroll
                for (int m = 0; m < 4; ++m) { const u32x2 w = *(const u32x2*)(arow[ai][m] + k); av[ai][m][0] = bflo(w.x); av[ai][m][1] = bfhi(w.x); av[ai][m][2] = bflo(w.y); av[ai][m][3] = bfhi(w.y); }
#pragma unroll
            for (int bj = 0; bj < 2; ++bj)
#pragma unroll
                for (int n = 0; n < 2; ++n)
#pragma unroll
                    for (int e = 0; e < 4; ++e) {
                        const int col = u.pn * BM + bj * HALF + wc * 32 + (Epi::PERM ? (8 * fq + 4 * n) : (16 * n + 4 * fq)) + e;
                        const u32x2 w = *(const u32x2*)(g.Bt + (size_t)col * g.ldb + k);
                        const float b0 = bflo(w.x), b1 = bfhi(w.x), b2 = bflo(w.y), b3 = bfhi(w.y);
#pragma unroll
                        for (int ai = 0; ai < 2; ++ai)
#pragma unroll
                            for (int m = 0; m < 4; ++m) acc[ai][bj][m][n][e] += av[ai][m][0] * b0 + av[ai][m][1] * b1 + av[ai][m][2] * b2 + av[ai][m][3] * b3;
                    }
        }
        E(acc, u, wr, wc, fr, fq);
    }
    VM_WAIT(); __syncthreads();
}
}
namespace g128 {
using pg8::lds_byte; using pg8::stage_rc; using pg8::HTB; using pg8::BK;
struct Seg { const bf16* A; const bf16* B; int lda, ldb, nt; };
typedef f32x4 acc_t[2][4][2];

template <class Prog>
__device__ __forceinline__ void stream(LAS unsigned char* lds, Prog& P, int nunits, int first, int stride) {
    int tid = my_tid(); asm volatile("" : "+v"(tid));
    const int wid = __builtin_amdgcn_readfirstlane(tid >> 6), lane = tid & 63, wr = wid >> 2, wc = wid & 3, fr = lane & 15, fq = lane >> 4;
    int RA[2], CA[2], RB[2];
#pragma unroll
    for (int i = 0; i < 2; ++i) { stage_rc(tid * 16 + i * 8192, RA[i], CA[i]); RB[i] = (RA[i] & ~31) + pg8::perm32(RA[i] & 31); }
    const unsigned ldsw = (unsigned)wid * 1024u;
    const int aoff = lds_byte(wr * 64 + fr, fq * 8), boff = lds_byte(wc * 32 + fr, fq * 8);
#define G_SA(b) ((b) * HTB)
#define G_SB(b, h) ((2 + (b) * 2 + (h)) * HTB)
#define G_STAGE(bufoff, base, ld, kbyte, RR) do { _Pragma("unroll") for (int _i = 0; _i < 2; ++_i) \
        __builtin_amdgcn_global_load_lds((const unsigned*)((const char*)(base) + (size_t)(kbyte) + (unsigned)(RR[_i] * (ld) + CA[_i]) * 2u), (LAS unsigned*)(lds + (bufoff) + ldsw + _i * 8192), 16, 0, 0); } while (0)
#define G_STAGE_A(b, S, j) G_STAGE(G_SA(b), (S).A, (S).lda, (j) * 128, RA)
#define G_STAGE_B(b, h, S, j) G_STAGE(G_SB(b, h), (const char*)(S).B + (size_t)(h) * 128 * (S).ldb * 2, (S).ldb, (j) * 128, RB)
#define G_LDA(dst, b) do { _Pragma("unroll") for (int m = 0; m < 4; ++m) _Pragma("unroll") for (int k = 0; k < 2; ++k) dst[m][k] = *(const LAS bf16x8*)(lds + G_SA(b) + aoff + m * 2048 + k * 1024); } while (0)
#define G_LDB(dst, b, h) do { _Pragma("unroll") for (int n = 0; n < 2; ++n) _Pragma("unroll") for (int k = 0; k < 2; ++k) dst[n][k] = *(const LAS bf16x8*)(lds + G_SB(b, h) + boff + n * 2048 + k * 1024); } while (0)
#define G_MMA(bj, At, Bt) do { __builtin_amdgcn_s_setprio(1); _Pragma("unroll") for (int m = 0; m < 4; ++m) _Pragma("unroll") for (int n = 0; n < 2; ++n) _Pragma("unroll") for (int k = 0; k < 2; ++k) \
        acc[bj][m][n] = __builtin_amdgcn_mfma_f32_16x16x32_bf16(Bt[n][k], At[m][k], acc[bj][m][n], 0, 0, 0); __builtin_amdgcn_s_setprio(0); } while (0)
#define G_WAIT_V(n) asm volatile("s_waitcnt vmcnt(" #n ")" ::: "memory")
#define G_WAIT_L(n) asm volatile("s_waitcnt lgkmcnt(" #n ")" ::: "memory")
#define G_BAR __builtin_amdgcn_s_barrier()
#define G_SCHED __builtin_amdgcn_sched_barrier(0)
    if (first >= nunits) return;
    P.reset();
    int ucur = first, scur = 0;
    Seg cur, nxt;
    P.seg(ucur, scur, cur);
    acc_t acc;
    P.init(ucur, scur, acc, wr, wc, fr, fq);
    bf16x8 At[4][2], B0[2][2], B1[2][2];
    G_STAGE_B(0, 0, cur, 0); G_STAGE_A(0, cur, 0); G_STAGE_B(0, 1, cur, 0);
    if (wr == 1) G_BAR;
    G_WAIT_V(2); G_BAR;
    G_STAGE_A(1, cur, 1); G_STAGE_B(1, 0, cur, 1);
    G_WAIT_V(4); G_BAR;
#define G_TILE(t_, b_) do { const bool n1_ = ((t_) + 1 >= nt), n2_ = ((t_) + 2 >= nt); const int j1_ = n1_ ? ((t_) + 1 - nt) : ((t_) + 1), j2_ = n2_ ? ((t_) + 2 - nt) : ((t_) + 2); \
        G_LDB(B0, b_, 0); G_SCHED; G_LDA(At, b_); \
        if (n1_) G_STAGE_B((b_) ^ 1, 1, nxt, j1_); else G_STAGE_B((b_) ^ 1, 1, cur, j1_); \
        G_WAIT_V(6); G_WAIT_L(0); G_BAR; G_MMA(0, At, B0); G_BAR; G_SCHED; \
        G_LDB(B1, b_, 1); \
        if (n2_) { G_STAGE_A(b_, nxt, j2_); G_STAGE_B(b_, 0, nxt, j2_); } else { G_STAGE_A(b_, cur, j2_); G_STAGE_B(b_, 0, cur, j2_); } \
        G_WAIT_V(6); G_WAIT_L(0); G_BAR; G_MMA(1, At, B1); G_BAR; G_SCHED; } while (0)
    for (;;) {
        int unxt = ucur, snxt = scur + 1; bool more = true;
        if (snxt == Prog::NSEG) { snxt = 0; unxt = ucur + stride; if (unxt >= nunits) { more = false; unxt = ucur; snxt = scur; } }
        P.seg(unxt, snxt, nxt);
        int ntq = cur.nt; asm volatile("" : "+s"(ntq)); const int nt = ntq;
#pragma nounroll
        for (int t = 0; t < nt; t += 2) { G_TILE(t, 0); G_TILE(t + 1, 1); }
        P.done(ucur, scur, acc, wr, wc, fr, fq);
        if (!more) break;
        P.init(unxt, snxt, acc, wr, wc, fr, fq);
        ucur = unxt; scur = snxt; cur = nxt;
    }
    G_WAIT_V(0);
    if (wr == 0) G_BAR;
    G_BAR;
#undef G_SA
#undef G_SB
#undef G_STAGE
#undef G_STAGE_A
#undef G_STAGE_B
#undef G_LDA
#undef G_LDB
#undef G_MMA
#undef G_WAIT_V
#undef G_WAIT_L
#undef G_BAR
#undef G_SCHED
#undef G_TILE
}

struct MergeProg {
    static constexpr int NSEG = 8;
    const bf16* Hn; const bf16* zin; const bf16* wg; const bf16* wb; const float* bg; bf16* M;
    __device__ __forceinline__ void reset() {
#pragma unroll
        for (int a = 0; a < 2; ++a)
#pragma unroll
            for (int b = 0; b < 4; ++b)
#pragma unroll
                for (int c = 0; c < 2; ++c) { g[a][b][c] = (u32x2){0u, 0u}; macc[a][b][c] = (u32x2){0u, 0u}; } }
    u32x2 g[2][4][2]; u32x2 macc[2][4][2];
    __device__ __forceinline__ void seg(int u, int s, Seg& S) const {
        const int pm = u >> 2, pn = u & 3, k = s >> 1;
        if ((s & 1) == 0) { S.A = Hn + (size_t)pm * 128 * D; S.lda = D; S.B = wg + ((size_t)k * D + pn * 256) * D; S.ldb = D; S.nt = D / 64; }
        else { const int ycol = (k == 0) ? ZC_U : (k == 1) ? ZC_FQ : (k == 2) ? ZC_CQ : ZC_DQ;
               S.A = zin + (size_t)pm * 128 * ZP + ycol; S.lda = ZP; S.B = wb + ((size_t)k * D + pn * 256) * 256; S.ldb = 256; S.nt = 4; }
    }
    __device__ __forceinline__ void init(int u, int s, acc_t& acc, int wr, int wc, int fr, int fq) {
        const int pn = u & 3, k = s >> 1;
        if ((s & 1) == 0) {
#pragma unroll
            for (int bj = 0; bj < 2; ++bj)
#pragma unroll
                for (int n = 0; n < 2; ++n) { const f32x4 bv = *(const f32x4*)(bg + (size_t)k * D + pn * 256 + bj * 128 + wc * 32 + 8 * fq + 4 * n);
#pragma unroll
                    for (int m = 0; m < 4; ++m) acc[bj][m][n] = bv; }
            if (s == 0) {
#pragma unroll
                for (int bj = 0; bj < 2; ++bj)
#pragma unroll
                    for (int m = 0; m < 4; ++m)
#pragma unroll
                        for (int n = 0; n < 2; ++n) macc[bj][m][n] = (u32x2){0u, 0u}; }
        } else {
#pragma unroll
            for (int bj = 0; bj < 2; ++bj)
#pragma unroll
                for (int m = 0; m < 4; ++m)
#pragma unroll
                    for (int n = 0; n < 2; ++n) acc[bj][m][n] = (f32x4){0.f, 0.f, 0.f, 0.f};
        }
    }
    __device__ __forceinline__ void done(int u, int s, const acc_t& acc, int wr, int wc, int fr, int fq) {
        if ((s & 1) == 0) {
#pragma unroll
            for (int bj = 0; bj < 2; ++bj)
#pragma unroll
                for (int m = 0; m < 4; ++m)
#pragma unroll
                    for (int n = 0; n < 2; ++n) { const f32x4 a = acc[bj][m][n]; u32x2 w; w.x = pk2(sigmoidf_(a[0]), sigmoidf_(a[1])); w.y = pk2(sigmoidf_(a[2]), sigmoidf_(a[3])); g[bj][m][n] = w; }
        } else {
#pragma unroll
            for (int bj = 0; bj < 2; ++bj)
#pragma unroll
                for (int m = 0; m < 4; ++m)
#pragma unroll
                    for (int n = 0; n < 2; ++n) { const u32x2 w = g[bj][m][n], q = macc[bj][m][n]; const f32x4 v = (f32x4){bflo(q.x), bfhi(q.x), bflo(q.y), bfhi(q.y)} + (f32x4){bflo(w.x), bfhi(w.x), bflo(w.y), bfhi(w.y)} * acc[bj][m][n];
                        u32x2 r; r.x = pk2(v[0], v[1]); r.y = pk2(v[2], v[3]); macc[bj][m][n] = r; }
            if (s == NSEG - 1) { const int pm = u >> 2, pn = u & 3;
#pragma unroll
                for (int m = 0; m < 4; ++m) { bf16* rp = M + (size_t)(pm * 128 + wr * 64 + m * 16 + fr) * D + pn * 256 + wc * 32 + 8 * fq;
#pragma unroll
                    for (int bj = 0; bj < 2; ++bj) *(u32x4*)(rp + bj * 128) = (u32x4){macc[bj][m][0].x, macc[bj][m][0].y, macc[bj][m][1].x, macc[bj][m][1].y}; } }
        }
    }
};

struct PleProg {
    static constexpr int NSEG = 8;
    const bf16* pbf; const bf16* hp; const bf16* wup; const bf16* wpg; bf16* x;
    u32x2 uu[2][4][2];
    __device__ __forceinline__ void reset() {
#pragma unroll
        for (int a = 0; a < 2; ++a)
#pragma unroll
            for (int b = 0; b < 4; ++b)
#pragma unroll
                for (int c = 0; c < 2; ++c) uu[a][b][c] = (u32x2){0u, 0u}; }
    __device__ __forceinline__ void seg(int u, int s, Seg& S) const {
        const int pn = s >> 1;
        if ((s & 1) == 0) { S.A = pbf + (size_t)u * 128 * 256; S.lda = 256; S.B = wup + (size_t)pn * 256 * 256; S.ldb = 256; S.nt = 4; }
        else { S.A = hp + (size_t)u * 128 * D; S.lda = D; S.B = wpg + (size_t)pn * 256 * D; S.ldb = D; S.nt = D / 64; }
    }
    __device__ __forceinline__ void init(int u, int s, acc_t& acc, int wr, int wc, int fr, int fq) {
#pragma unroll
        for (int bj = 0; bj < 2; ++bj)
#pragma unroll
            for (int m = 0; m < 4; ++m)
#pragma unroll
                for (int n = 0; n < 2; ++n) acc[bj][m][n] = (f32x4){0.f, 0.f, 0.f, 0.f};
    }
    __device__ __forceinline__ void done(int u, int s, const acc_t& acc, int wr, int wc, int fr, int fq) {
        if ((s & 1) == 0) {
#pragma unroll
            for (int bj = 0; bj < 2; ++bj)
#pragma unroll
                for (int m = 0; m < 4; ++m)
#pragma unroll
                    for (int n = 0; n < 2; ++n) { const f32x4 a = acc[bj][m][n]; u32x2 w; w.x = pk2(a[0], a[1]); w.y = pk2(a[2], a[3]); uu[bj][m][n] = w; }
        } else { const int pn = s >> 1;
#pragma unroll
            for (int m = 0; m < 4; ++m) { bf16* rp = x + (size_t)(u * 128 + wr * 64 + m * 16 + fr) * D + pn * 256 + wc * 32 + 8 * fq; u32x4 xv[2];
#pragma unroll
                for (int bj = 0; bj < 2; ++bj) xv[bj] = *(const u32x4*)(rp + bj * 128);
#pragma unroll
                for (int bj = 0; bj < 2; ++bj) { const u32x4 xw = xv[bj]; f32x4 r[2];
#pragma unroll
                    for (int n = 0; n < 2; ++n) { const u32x2 w = uu[bj][m][n]; f32x4 v = acc[bj][m][n];
                        v[0] = sigmoidf_(v[0]); v[1] = sigmoidf_(v[1]); v[2] = sigmoidf_(v[2]); v[3] = sigmoidf_(v[3]);
                        const f32x4 xo = n == 0 ? (f32x4){bflo(xw.x), bfhi(xw.x), bflo(xw.y), bfhi(xw.y)} : (f32x4){bflo(xw.z), bfhi(xw.z), bflo(xw.w), bfhi(xw.w)};
                        r[n] = xo + (f32x4){bflo(w.x), bfhi(w.x), bflo(w.y), bfhi(w.y)} * v; }
                    *(u32x4*)(rp + bj * 128) = (u32x4){pk2(r[0][0], r[0][1]), pk2(r[0][2], r[0][3]), pk2(r[1][0], r[1][1]), pk2(r[1][2], r[1][3])}; } } }
    }
};
}
namespace epi {
using pg8::Unit; using pg8::BM; using pg8::HALF;
__device__ __forceinline__ void epi_fence() { asm volatile("" ::: "memory"); }
#define EPI_FENCE epi_fence()
#define EPI_LOOP_ROWS for (int ai = 0; ai < 2; ++ai) _Pragma("unroll") for (int m = 0; m < 4; ++m)
#define EPI_LOOP_COLS for (int bj = 0; bj < 2; ++bj) _Pragma("unroll") for (int n = 0; n < 2; ++n)
#define EPI_ROW (u.pm * BM + ai * HALF + wr * 64 + m * 16 + fr)
#define EPI_COLT (bj * HALF + wc * 32 + n * 16 + 4 * fq)
typedef f32x4 acc_t[2][2][4][2];
#define EPI_C8(bj_) ((bj_) * HALF + wc * 32 + 8 * fq)
__device__ __forceinline__ u32x4 pack8(f32x4 a, f32x4 b) { return (u32x4){pk2(a[0], a[1]), pk2(a[2], a[3]), pk2(b[0], b[1]), pk2(b[2], b[3])}; }
__device__ __forceinline__ u32x2 pack4(f32x4 v) { u32x2 w; w.x = pk2(v[0], v[1]); w.y = pk2(v[2], v[3]); return w; }
__device__ __forceinline__ f32x4 unpack4(u32x2 w) { return (f32x4){bflo(w.x), bfhi(w.x), bflo(w.y), bfhi(w.y)}; }

struct EpiStore {
    static constexpr bool PERM = true;
    bf16* O; int ldc; int pn0;
    __device__ __forceinline__ void operator()(const acc_t& acc, const Unit& u, int wr, int wc, int fr, int fq) const {
#pragma unroll
        EPI_LOOP_ROWS { bf16* rp = O + (size_t)EPI_ROW * ldc + (u.pn - pn0) * BM + wc * 32 + 8 * fq;
#pragma unroll
            for (int bj = 0; bj < 2; ++bj) { const u32x2 lo = pack4(acc[ai][bj][m][0]), hi = pack4(acc[ai][bj][m][1]); *(u32x4*)(rp + bj * HALF) = (u32x4){lo.x, lo.y, hi.x, hi.y}; } }
    }
};
struct EpiRowScale {
    static constexpr bool PERM = true;
    bf16* O; int ldc; const float* rs;
    __device__ __forceinline__ void operator()(const acc_t& acc, const Unit& u, int wr, int wc, int fr, int fq) const {
        float sv[2][4];
#pragma unroll
        EPI_LOOP_ROWS sv[ai][m] = rs[EPI_ROW];
#pragma unroll
        EPI_LOOP_ROWS { const int row = EPI_ROW; const float s = sv[ai][m]; bf16* rp = O + (size_t)row * ldc + u.pn * BM;
#pragma unroll
            for (int bj = 0; bj < 2; ++bj) *(u32x4*)(rp + EPI_C8(bj)) = pack8(acc[ai][bj][m][0] * s, acc[ai][bj][m][1] * s); }
    }
};
struct EpiMlaQ {
    static constexpr bool PERM = false;
    bf16* O; const float* rs; const float* cosT; const float* sinT;
    __device__ __forceinline__ void operator()(const acc_t& acc, const Unit& u, int wr, int wc, int fr, int fq) const {
        float sv[2][4]; f32x4 csv[2], snv[2];
#pragma unroll
        EPI_LOOP_ROWS sv[ai][m] = rs[EPI_ROW];
        { const int row = u.pm * BM + wr * 64 + fr; csv[0] = *(const f32x4*)(cosT + (size_t)row * 16 + 4 * fq); snv[0] = *(const f32x4*)(sinT + (size_t)row * 16 + 4 * fq); }
#pragma unroll
        for (int it = 0; it < 8; ++it) { const int ai = it >> 2, m = it & 3;
            if (it + 1 < 8) { const int row = u.pm * BM + ((it + 1) >> 2) * HALF + wr * 64 + ((it + 1) & 3) * 16 + fr;
                csv[(it + 1) & 1] = *(const f32x4*)(cosT + (size_t)row * 16 + 4 * fq); snv[(it + 1) & 1] = *(const f32x4*)(sinT + (size_t)row * 16 + 4 * fq); }
            const int row = EPI_ROW; const float s = sv[ai][m]; bf16* rp = O + (size_t)row * 512 + u.pn * BM;
            const f32x4 cs = csv[it & 1], sn = snv[it & 1];
#pragma unroll
            for (int bj = 0; bj < 2; ++bj) { const int grp = u.pn * 8 + bj * 4 + wc;
                f32x4 t1 = acc[ai][bj][m][0] * s, t2 = acc[ai][bj][m][1] * s;
                if (grp % 3 == 2) { const f32x4 a = t1 * cs - t2 * sn, b = t2 * cs + t1 * sn; t1 = a; t2 = b; }
                *(u32x2*)(rp + bj * HALF + wc * 32 + 4 * fq) = pack4(t1); *(u32x2*)(rp + bj * HALF + wc * 32 + 16 + 4 * fq) = pack4(t2); } }
    }
};
struct EpiGate {
    static constexpr bool PERM = false;
    bf16* G; const float* bias;
    __device__ __forceinline__ void operator()(const acc_t& acc, const Unit& u, int wr, int wc, int fr, int fq) const {
        f32x4 bv[2][2];
#pragma unroll
        EPI_LOOP_COLS bv[bj][n] = *(const f32x4*)(bias + u.pn * BM + EPI_COLT);
#pragma unroll
        EPI_LOOP_ROWS { bf16* rp = G + (size_t)EPI_ROW * D + u.pn * BM;
#pragma unroll
            EPI_LOOP_COLS { f32x4 v = acc[ai][bj][m][n] + bv[bj][n];
                v[0] = sigmoidf_(v[0]); v[1] = sigmoidf_(v[1]); v[2] = sigmoidf_(v[2]); v[3] = sigmoidf_(v[3]);
                *(u32x2*)(rp + EPI_COLT) = pack4(v); } }
    }
};
#define EPI_IT_ROW(it_) (u.pm * BM + ((it_) >> 2) * HALF + wr * 64 + ((it_) & 3) * 16 + fr)
#define EPI_C4(c_) (((c_) >> 1) * HALF + wc * 32 + ((c_) & 1) * 16 + 4 * fq)
struct EpiMerge {
    static constexpr bool PERM = false;
    const bf16* G; bf16* M; int first;
    __device__ __forceinline__ void operator()(const acc_t& acc, const Unit& u, int wr, int wc, int fr, int fq) const {
        u32x2 gv[2][4], mv[2][4];
#define EPI_LD(it_) do { const size_t ro_ = (size_t)EPI_IT_ROW(it_) * D + u.pn * BM; _Pragma("unroll") for (int c = 0; c < 4; ++c) { gv[(it_) & 1][c] = *(const u32x2*)(G + ro_ + EPI_C4(c)); \
            mv[(it_) & 1][c] = first ? (u32x2){0u, 0u} : *(const u32x2*)(M + ro_ + EPI_C4(c)); } } while (0)
        EPI_LD(0);
#pragma unroll
        for (int it = 0; it < 8; ++it) { if (it + 1 < 8) EPI_LD(it + 1);
            const size_t ro = (size_t)EPI_IT_ROW(it) * D + u.pn * BM;
#pragma unroll
            for (int c = 0; c < 4; ++c) { const f32x4 v = unpack4(gv[it & 1][c]) * acc[it >> 2][c >> 1][it & 3][c & 1] + unpack4(mv[it & 1][c]); *(u32x2*)(M + ro + EPI_C4(c)) = pack4(v); } }
#undef EPI_LD
    }
};
struct EpiRes {
    static constexpr bool PERM = true;
    XSrc xin; bf16* xout;
    __device__ __forceinline__ void operator()(const acc_t& acc, const Unit& u, int wr, int wc, int fr, int fq) const {
        f32x4 xv[2][2][2];
#define EPI_LD(it_) do { const size_t ro_ = (size_t)EPI_IT_ROW(it_) * D + u.pn * BM; _Pragma("unroll") for (int bj = 0; bj < 2; ++bj) { \
            if (xin.f) { xv[(it_) & 1][bj][0] = *(const f32x4*)(xin.f + ro_ + EPI_C8(bj)); xv[(it_) & 1][bj][1] = *(const f32x4*)(xin.f + ro_ + EPI_C8(bj) + 4); } \
            else { const u32x4 w_ = *(const u32x4*)(xin.b + ro_ + EPI_C8(bj)); xv[(it_) & 1][bj][0] = (f32x4){bflo(w_.x), bfhi(w_.x), bflo(w_.y), bfhi(w_.y)}; xv[(it_) & 1][bj][1] = (f32x4){bflo(w_.z), bfhi(w_.z), bflo(w_.w), bfhi(w_.w)}; } } } while (0)
        EPI_LD(0);
#pragma unroll
        for (int it = 0; it < 8; ++it) { if (it + 1 < 8) EPI_LD(it + 1);
            const size_t ro = (size_t)EPI_IT_ROW(it) * D + u.pn * BM;
#pragma unroll
            for (int bj = 0; bj < 2; ++bj) *(u32x4*)(xout + ro + EPI_C8(bj)) = pack8(xv[it & 1][bj][0] + acc[it >> 2][bj][it & 3][0], xv[it & 1][bj][1] + acc[it >> 2][bj][it & 3][1]); }
#undef EPI_LD
    }
};
struct EpiPle {
    static constexpr bool PERM = false;
    const bf16* U; float* x;
    __device__ __forceinline__ void operator()(const acc_t& acc, const Unit& u, int wr, int wc, int fr, int fq) const {
        f32x4 xv[2][4]; u32x2 uv[2][4];
#define EPI_LD(it_) do { const size_t ro_ = (size_t)EPI_IT_ROW(it_) * D + u.pn * BM; _Pragma("unroll") for (int c = 0; c < 4; ++c) { xv[(it_) & 1][c] = *(const f32x4*)(x + ro_ + EPI_C4(c)); uv[(it_) & 1][c] = *(const u32x2*)(U + ro_ + EPI_C4(c)); } } while (0)
        EPI_LD(0);
#pragma unroll
        for (int it = 0; it < 8; ++it) { if (it + 1 < 8) EPI_LD(it + 1);
            const size_t ro = (size_t)EPI_IT_ROW(it) * D + u.pn * BM;
#pragma unroll
            for (int c = 0; c < 4; ++c) { f32x4 v = acc[it >> 2][c >> 1][it & 3][c & 1];
                v[0] = sigmoidf_(v[0]); v[1] = sigmoidf_(v[1]); v[2] = sigmoidf_(v[2]); v[3] = sigmoidf_(v[3]);
                *(f32x4*)(x + ro + EPI_C4(c)) = xv[it & 1][c] + unpack4(uv[it & 1][c]) * v; } }
#undef EPI_LD
    }
};
struct EpiSwiglu {
    static constexpr bool PERM = true;
    bf16* O; int ldc; int npt;
    __device__ __forceinline__ void operator()(const acc_t& acc, const Unit& u, int wr, int wc, int fr, int fq) const {
        const int ct = (u.pn % npt) * HALF;
#pragma unroll
        EPI_LOOP_ROWS { bf16* rp = O + (size_t)EPI_ROW * ldc + ct + wc * 32 + 8 * fq; u32x2 w[2];
#pragma unroll
            for (int n = 0; n < 2; ++n) { const f32x4 a = acc[ai][0][m][n], b = acc[ai][1][m][n]; f32x4 v;
#pragma unroll
                for (int e = 0; e < 4; ++e) v[e] = a[e] * sigmoidf_(a[e]) * b[e];
                w[n] = pack4(v); }
            *(u32x4*)rp = (u32x4){w[0].x, w[0].y, w[1].x, w[1].y}; }
    }
};
struct EpiGlu {
    static constexpr bool PERM = true;
    bf16* Y; int ldc;
    __device__ __forceinline__ void operator()(const acc_t& acc, const Unit& u, int wr, int wc, int fr, int fq) const {
        u32x4 yv[2][2];
#define EPI_LD(it_) do { const bf16* rp_ = Y + (size_t)EPI_IT_ROW(it_) * ldc + u.pn * BM; _Pragma("unroll") for (int bj = 0; bj < 2; ++bj) yv[(it_) & 1][bj] = *(const u32x4*)(rp_ + EPI_C8(bj)); } while (0)
        EPI_LD(0);
#pragma unroll
        for (int it = 0; it < 8; ++it) { if (it + 1 < 8) EPI_LD(it + 1);
            bf16* rp = Y + (size_t)EPI_IT_ROW(it) * ldc + u.pn * BM;
#pragma unroll
            for (int bj = 0; bj < 2; ++bj) { const u32x4 w = yv[it & 1][bj]; f32x4 a = acc[it >> 2][bj][it & 3][0], b = acc[it >> 2][bj][it & 3][1];
                a[0] = bflo(w.x) * sigmoidf_(a[0]); a[1] = bfhi(w.x) * sigmoidf_(a[1]); a[2] = bflo(w.y) * sigmoidf_(a[2]); a[3] = bfhi(w.y) * sigmoidf_(a[3]);
                b[0] = bflo(w.z) * sigmoidf_(b[0]); b[1] = bfhi(w.z) * sigmoidf_(b[1]); b[2] = bflo(w.w) * sigmoidf_(b[2]); b[3] = bfhi(w.w) * sigmoidf_(b[3]);
                *(u32x4*)(rp + EPI_C8(bj)) = pack8(a, b); } }
#undef EPI_LD
    }
};
struct EpiMoeDown {
    static constexpr bool PERM = true;
    bf16* Y; const float* slot_gate;
    __device__ __forceinline__ void operator()(const acc_t& acc, const Unit& u, int wr, int wc, int fr, int fq) const {
        const int ct = (u.pn & 3) * BM;
        float gv[2][4];
#pragma unroll
        EPI_LOOP_ROWS gv[ai][m] = slot_gate[EPI_ROW];
#pragma unroll
        EPI_LOOP_ROWS { const int row = EPI_ROW; const float gt = gv[ai][m]; bf16* rp = Y + (size_t)row * D + ct;
#pragma unroll
            for (int bj = 0; bj < 2; ++bj) *(u32x4*)(rp + EPI_C8(bj)) = pack8(acc[ai][bj][m][0] * gt, acc[ai][bj][m][1] * gt); }
    }
};
}
namespace att {
constexpr int MODE_FOX = 0, MODE_MLA = 1, MODE_BAND = 2;
constexpr float LOG2E = 1.4426950408889634f;
struct Tensors {
    const bf16* Q; int ldq;
    const bf16* K; int ldk;
    const bf16* K2;
    const bf16* V; int ldv;
    bf16* O; int ldo;
    const float* cdec;
    const float* relb;
    int qhs, khs, vhs, ohs;
    const unsigned* qmax; const unsigned* kmax;
};
template <int DQK> struct Lay { static constexpr int KS = DQK * 2 + 16, KB = 64 * KS, VB = 64 * 128, CB = 256, BUF = KB + VB + CB; };
constexpr int ATT_LDS_TAB = 2 * Lay<96>::BUF;
constexpr int ATT_LDS_BYTES = ATT_LDS_TAB + 520 * 4;
__device__ __forceinline__ int crow(int r, int hi) { return (r & 3) + 8 * (r >> 2) + 4 * hi; }
typedef short v4i16_t __attribute__((ext_vector_type(4)));
__device__ __forceinline__ s16x4 vtr(const LAS unsigned char* p) { return __builtin_bit_cast(s16x4, __builtin_amdgcn_ds_read_tr16_b64_v4i16((LAS v4i16_t*)p)); }

template <int MODE>
__device__ __forceinline__ void attn_unit(const Tensors& T, int b, int h, int qb, LAS unsigned char* lds) {
    constexpr int DQK = (MODE == MODE_MLA) ? 96 : 64, NKS = DQK / 16;
    typedef Lay<DQK> LY;
    int tid = my_tid(); asm volatile("" : "+v"(tid));
    const int lane = tid & 63, r32 = lane & 31, hi = lane >> 5; const int wid = __builtin_amdgcn_readfirstlane(tid >> 6);
    const int rowb = b * SEQ, q0 = qb * 256;
    const float sc2 = ((MODE == MODE_MLA) ? 0.10206207261596575f : 0.125f) * LOG2E;
    const int cw = 4 * qb + (wid >> 1);
    const int t_lo = (MODE == MODE_BAND) ? ((4 * qb - 8) > 0 ? (4 * qb - 8) : 0) : 0, t_hi = 4 * qb + 4;
    const int qrow = rowb + q0 + wid * 32 + r32;
    bf16x8 qf[NKS];
    { const bf16* qp = T.Q + (size_t)qrow * T.ldq + h * T.qhs + hi * 8;
#pragma unroll
      for (int ks = 0; ks < NKS; ++ks) qf[ks] = *(const bf16x8*)(qp + ks * 16); }
    float cq = 0.f; if (MODE == MODE_FOX) cq = T.cdec[(size_t)qrow * 4 + h];
    LAS float* tab = (LAS float*)(lds + ATT_LDS_TAB);
    if (MODE == MODE_BAND) { for (int i = tid; i < 513; i += NTHREADS) tab[i] = T.relb[h * 513 + i] * LOG2E; }
    u32x4 kreg0[2] = {}, kreg1[2] = {}, vreg[2] = {}; float creg[2] = {0.f, 0.f};
    const int srow = tid >> 3, sch = tid & 7;
#define ATT_KADDR(c_) (((c_) % 12 < 8) ? (const u32x4*)(T.K + (kr_ + (c_) / 12) * T.ldk + h * T.khs + ((c_) % 12) * 8) : (const u32x4*)(T.K2 + (kr_ + (c_) / 12) * 32 + ((c_) % 12 - 8) * 8))
#define ATT_LOAD_TILE(t_, r_) do { const size_t kr_ = (size_t)(rowb + (t_) * 64); \
        if (MODE == MODE_MLA) { kreg0[r_] = *ATT_KADDR(tid); if (tid < 256) kreg1[r_] = *ATT_KADDR(tid + 512); } \
        else { kreg0[r_] = *(const u32x4*)(T.K + (kr_ + srow) * T.ldk + h * T.khs + sch * 8); } \
        vreg[r_] = *(const u32x4*)(T.V + (kr_ + srow) * T.ldv + h * T.vhs + sch * 8); \
        if (MODE == MODE_FOX) { if (tid < 64) creg[r_] = T.cdec[(kr_ + tid) * 4 + h]; } } while (0)
#define ATT_STORE_TILE(buf_, r_) do { LAS unsigned char* base_ = lds + (buf_) * LY::BUF; \
        if (MODE == MODE_MLA) { *(LAS u32x4*)(base_ + (tid / 12) * LY::KS + (tid % 12) * 16) = kreg0[r_]; \
            if (tid < 256) *(LAS u32x4*)(base_ + ((tid + 512) / 12) * LY::KS + ((tid + 512) % 12) * 16) = kreg1[r_]; } \
        else { *(LAS u32x4*)(base_ + srow * LY::KS + sch * 16) = kreg0[r_]; } \
        *(LAS u32x4*)(base_ + LY::KB + srow * 128 + ((sch * 16) ^ (((srow >> 1) & 1) << 6))) = vreg[r_]; \
        if (MODE == MODE_FOX) { if (tid < 64) *(LAS float*)(base_ + LY::KB + LY::VB + tid * 4) = creg[r_]; } } while (0)
    float mrun = -INFINITY, lrun = 0.f;
    f32x16 o0 = {}, o1 = {};
    const int G = lane >> 4, qi = (lane & 15) >> 2, pi = lane & 3;
    const int vb0 = (4 * hi + qi) * 128 + 64 * (0 ^ (qi >> 1)) + 32 * (G & 1) + 8 * pi;
    const int vb1 = (4 * hi + qi) * 128 + 64 * (1 ^ (qi >> 1)) + 32 * (G & 1) + 8 * pi;
    int t_min = t_lo;
    if (MODE == MODE_FOX) {
        LAS int* tm = (LAS int*)(lds + ATT_LDS_TAB);
        if (tid == 0) tm[0] = t_hi - 1;
        __syncthreads();
        if (tid < t_hi) {
            const float q2 = __uint_as_float(T.qmax[(b * 4 + h) * 32 + qb]), k2 = __uint_as_float(T.kmax[b * 4 + h]);
            const float thr = 0.125f * sqrtf(q2) * 2.0f * sqrtf(k2) * 1.02f + 112.0f;
            const float cfirst = T.cdec[(size_t)(rowb + q0) * 4 + h], clast = T.cdec[(size_t)(rowb + tid * 64 + 63) * 4 + h];
            if (!(clast - cfirst > thr)) __hip_atomic_fetch_min(tm, tid, __ATOMIC_RELAXED, __HIP_MEMORY_SCOPE_WORKGROUP);
        }
        __syncthreads();
        t_min = tm[0];
    }
    const int n_t = t_hi - t_min;
#define ATT_TILE(i_) ((MODE == MODE_FOX) ? (t_hi - 1 - (i_)) : (t_min + (i_)))
    ATT_LOAD_TILE(ATT_TILE(0), 0); ATT_STORE_TILE(0, 0);
    if (n_t > 1) ATT_LOAD_TILE(ATT_TILE(1), 1);
    if (n_t > 2) ATT_LOAD_TILE(ATT_TILE(2), 0);
    __syncthreads();
    for (int it0 = 0; it0 < n_t; it0 += 2) {
#pragma unroll
      for (int half = 0; half < 2; ++half) { const int it = it0 + half; if (it < n_t) {
        const int t = ATT_TILE(it);
        const int buf = half;
        const bool active = (MODE == MODE_BAND) ? (t <= cw && t >= cw - 8) : (t <= cw);
        if (active) {
            const LAS unsigned char* kb = lds + buf * LY::BUF;
            const LAS unsigned char* vbuf = kb + LY::KB;
            f32x16 p0 = {}, p1 = {};
            bf16x8 ka[NKS], kc[NKS];
#pragma unroll
            for (int ks = 0; ks < NKS; ++ks) { ka[ks] = *(const LAS bf16x8*)(kb + r32 * LY::KS + (ks * 16 + hi * 8) * 2); kc[ks] = *(const LAS bf16x8*)(kb + (32 + r32) * LY::KS + (ks * 16 + hi * 8) * 2); }
            __builtin_amdgcn_sched_barrier(0);
#pragma unroll
            for (int ks = 0; ks < NKS; ++ks) { p0 = __builtin_amdgcn_mfma_f32_32x32x16_bf16(ka[ks], qf[ks], p0, 0, 0, 0); p1 = __builtin_amdgcn_mfma_f32_32x32x16_bf16(kc[ks], qf[ks], p1, 0, 0, 0); }
            s16x4 vl0[4], vh0[4], vl1[4], vh1[4];
#pragma unroll
            for (int s4 = 0; s4 < 4; ++s4) { vl0[s4] = vtr(vbuf + vb0 + s4 * 2048); vh0[s4] = vtr(vbuf + vb0 + s4 * 2048 + 1024); vl1[s4] = vtr(vbuf + vb1 + s4 * 2048); vh1[s4] = vtr(vbuf + vb1 + s4 * 2048 + 1024); }
            __builtin_amdgcn_sched_barrier(0);
            if (MODE == MODE_FOX) {
                const LAS float* cb = (const LAS float*)(vbuf + LY::VB);
                const float cq2 = cq * LOG2E;
#pragma unroll
                for (int a = 0; a < 4; ++a) {
                    const f32x4 c0 = *(const LAS f32x4*)(cb + 8 * a + 4 * hi), c1 = *(const LAS f32x4*)(cb + 32 + 8 * a + 4 * hi);
#pragma unroll
                    for (int e = 0; e < 4; ++e) { p0[4 * a + e] = p0[4 * a + e] * sc2 + (cq2 - c0[e] * LOG2E); p1[4 * a + e] = p1[4 * a + e] * sc2 + (cq2 - c1[e] * LOG2E); }
                }
                if (t == cw) { const int ql = 32 * (wid & 1) + r32;
#pragma unroll
                    for (int r = 0; r < 16; ++r) { const int kv = crow(r, hi); if (kv > ql) p0[r] = -INFINITY; if (kv + 32 > ql) p1[r] = -INFINITY; } }
            } else if (MODE == MODE_BAND) {
                const int dq = (q0 + wid * 32 + r32) - t * 64;
#pragma unroll
                for (int r = 0; r < 16; ++r) { const int kv = crow(r, hi);
                    int i0 = dq - kv, i1 = dq - kv - 32; i0 = i0 < -256 ? -256 : (i0 > 256 ? 256 : i0); i1 = i1 < -256 ? -256 : (i1 > 256 ? 256 : i1);
                    p0[r] = p0[r] * sc2 + tab[i0 + 256]; p1[r] = p1[r] * sc2 + tab[i1 + 256]; }
            }
            float mx = fmaxf(p0[0], p1[0]);
#pragma unroll
            for (int r = 1; r < 16; ++r) mx = fmaxf(mx, fmaxf(p0[r], p1[r]));
            { auto rr = __builtin_amdgcn_permlane32_swap(__float_as_uint(mx), __float_as_uint(mx), false, false); mx = fmaxf(__uint_as_float(rr[0]), __uint_as_float(rr[1])); }
            if (MODE == MODE_MLA) mx *= sc2;
            const float mnew = fmaxf(mrun, mx);
            if (__any(mnew > mrun)) {
                const float alpha = __builtin_amdgcn_exp2f(mrun - mnew);
                lrun *= alpha;
#pragma unroll
                for (int r = 0; r < 16; ++r) { o0[r] *= alpha; o1[r] *= alpha; }
                mrun = mnew;
            }
            float rs = 0.f;
#pragma unroll
            for (int r = 0; r < 16; ++r) {
                if (MODE == MODE_MLA) { p0[r] = __builtin_amdgcn_exp2f(__builtin_fmaf(p0[r], sc2, -mrun)); p1[r] = __builtin_amdgcn_exp2f(__builtin_fmaf(p1[r], sc2, -mrun)); }
                else { p0[r] = __builtin_amdgcn_exp2f(p0[r] - mrun); p1[r] = __builtin_amdgcn_exp2f(p1[r] - mrun); }
                rs += p0[r] + p1[r]; }
            lrun += rs;
#pragma unroll
            for (int s4 = 0; s4 < 4; ++s4) {
                u32x4 pw;
                if (s4 < 2) { const int o = 8 * (s4 & 1); pw.x = pk2(p0[o], p0[o + 1]); pw.y = pk2(p0[o + 2], p0[o + 3]); pw.z = pk2(p0[o + 4], p0[o + 5]); pw.w = pk2(p0[o + 6], p0[o + 7]); }
                else        { const int o = 8 * (s4 & 1); pw.x = pk2(p1[o], p1[o + 1]); pw.y = pk2(p1[o + 2], p1[o + 3]); pw.z = pk2(p1[o + 4], p1[o + 5]); pw.w = pk2(p1[o + 6], p1[o + 7]); }
                const bf16x8 pf = __builtin_bit_cast(bf16x8, pw);
                const s16x4 l0 = vl0[s4], h0 = vh0[s4], l1 = vl1[s4], h1 = vh1[s4];
                const bf16x8 vf0 = (bf16x8){l0[0], l0[1], l0[2], l0[3], h0[0], h0[1], h0[2], h0[3]};
                const bf16x8 vf1 = (bf16x8){l1[0], l1[1], l1[2], l1[3], h1[0], h1[1], h1[2], h1[3]};
                o0 = __builtin_amdgcn_mfma_f32_32x32x16_bf16(vf0, pf, o0, 0, 0, 0);
                o1 = __builtin_amdgcn_mfma_f32_32x32x16_bf16(vf1, pf, o1, 0, 0, 0);
            }
        }
        if (it + 1 < n_t) ATT_STORE_TILE(half ^ 1, half ^ 1);
        if (it + 3 < n_t) ATT_LOAD_TILE(ATT_TILE(it + 3), half ^ 1);
        __syncthreads();
      } }
    }
    { auto rr = __builtin_amdgcn_permlane32_swap(__float_as_uint(lrun), __float_as_uint(lrun), false, false); lrun = __uint_as_float(rr[0]) + __uint_as_float(rr[1]); }
    const float inv = 1.0f / lrun;
    bf16* op = T.O + (size_t)qrow * T.ldo + h * T.ohs;
#pragma unroll
    for (int a = 0; a < 4; ++a) {
        u32x2 w0, w1;
        w0.x = pk2(o0[4 * a] * inv, o0[4 * a + 1] * inv); w0.y = pk2(o0[4 * a + 2] * inv, o0[4 * a + 3] * inv);
        w1.x = pk2(o1[4 * a] * inv, o1[4 * a + 1] * inv); w1.y = pk2(o1[4 * a + 2] * inv, o1[4 * a + 3] * inv);
        *(u32x2*)(op + 8 * a + 4 * hi) = w0; *(u32x2*)(op + 32 + 8 * a + 4 * hi) = w1;
    }
}

template <int MODE>
__device__ __forceinline__ void attn_phase(const Tensors& T, LAS unsigned char* lds) {
    const int G = gridDim.x, bx = blockIdx.x, vcu = (G % 8 == 0) ? (bx % 8) * (G / 8) + bx / 8 : bx;
    for (int pr = vcu; pr < 256; pr += G) {
        const int bh = pr >> 4, s = pr & 15;
        attn_unit<MODE>(T, bh >> 2, bh & 3, s, lds);
        attn_unit<MODE>(T, bh >> 2, bh & 3, 31 - s, lds);
    }
}

template <int MODE>
__device__ __forceinline__ void attn_naive(const Tensors& T) {
    BODY_IDS();
    constexpr int DQK = (MODE == MODE_MLA) ? 96 : 64;
    const float sc = (MODE == MODE_MLA) ? 0.10206207261596575f : 0.125f;
    for (int idx = gtid; idx < NTOK * 4; idx += gthreads) {
        const int h = idx / NTOK, row = idx % NTOK, b = row / SEQ, tpos = row % SEQ, rowb = b * SEQ;
        float q[DQK], o[64];
#pragma unroll
        for (int d = 0; d < DQK; ++d) q[d] = bf2f(T.Q[(size_t)row * T.ldq + h * T.qhs + d]) * sc;
#pragma unroll
        for (int d = 0; d < 64; ++d) o[d] = 0.f;
        float m = -INFINITY, l = 0.f;
        const int ck = tpos / 64;
        const int k_lo = (MODE == MODE_BAND) ? ((ck - 8) > 0 ? (ck - 8) * 64 : 0) : 0;
        const int k_hi = (MODE == MODE_FOX) ? tpos : (ck * 64 + 63);
        const float cq = (MODE == MODE_FOX) ? T.cdec[(size_t)row * 4 + h] : 0.f;
        for (int kv = k_lo; kv <= k_hi; ++kv) {
            const size_t kr = (size_t)(rowb + kv);
            float s = 0.f;
#pragma unroll
            for (int d8 = 0; d8 < 8; ++d8) { const u32x4 w = *(const u32x4*)(T.K + kr * T.ldk + h * T.khs + d8 * 8);
                s += q[d8 * 8 + 0] * bflo(w.x) + q[d8 * 8 + 1] * bfhi(w.x) + q[d8 * 8 + 2] * bflo(w.y) + q[d8 * 8 + 3] * bfhi(w.y)
                   + q[d8 * 8 + 4] * bflo(w.z) + q[d8 * 8 + 5] * bfhi(w.z) + q[d8 * 8 + 6] * bflo(w.w) + q[d8 * 8 + 7] * bfhi(w.w); }
            if (MODE == MODE_MLA) {
#pragma unroll
                for (int d8 = 0; d8 < 4; ++d8) { const u32x4 w = *(const u32x4*)(T.K2 + kr * 32 + d8 * 8);
                    s += q[64 + d8 * 8 + 0] * bflo(w.x) + q[64 + d8 * 8 + 1] * bfhi(w.x) + q[64 + d8 * 8 + 2] * bflo(w.y) + q[64 + d8 * 8 + 3] * bfhi(w.y)
                       + q[64 + d8 * 8 + 4] * bflo(w.z) + q[64 + d8 * 8 + 5] * bfhi(w.z) + q[64 + d8 * 8 + 6] * bflo(w.w) + q[64 + d8 * 8 + 7] * bfhi(w.w); }
            }
            if (MODE == MODE_FOX) s += cq - T.cdec[kr * 4 + h];
            if (MODE == MODE_BAND) { int rel = tpos - kv; rel = rel < -256 ? -256 : (rel > 256 ? 256 : rel); s += T.relb[h * 513 + rel + 256]; }
            const float mn = fmaxf(m, s), al = __expf(m - mn), pp = __expf(s - mn);
            l = l * al + pp; m = mn;
#pragma unroll
            for (int d8 = 0; d8 < 8; ++d8) { const u32x4 w = *(const u32x4*)(T.V + kr * T.ldv + h * T.vhs + d8 * 8);
                o[d8 * 8 + 0] = o[d8 * 8 + 0] * al + pp * bflo(w.x); o[d8 * 8 + 1] = o[d8 * 8 + 1] * al + pp * bfhi(w.x);
                o[d8 * 8 + 2] = o[d8 * 8 + 2] * al + pp * bflo(w.y); o[d8 * 8 + 3] = o[d8 * 8 + 3] * al + pp * bfhi(w.y);
                o[d8 * 8 + 4] = o[d8 * 8 + 4] * al + pp * bflo(w.z); o[d8 * 8 + 5] = o[d8 * 8 + 5] * al + pp * bfhi(w.z);
                o[d8 * 8 + 6] = o[d8 * 8 + 6] * al + pp * bflo(w.w); o[d8 * 8 + 7] = o[d8 * 8 + 7] * al + pp * bfhi(w.w); }
        }
        const float inv = 1.0f / l;
#pragma unroll
        for (int d = 0; d < 64; d += 2) *(unsigned*)(T.O + (size_t)row * T.ldo + h * T.ohs + d) = pk2(o[d] * inv, o[d + 1] * inv);
    }
}
}
struct Params {
    const float* in[37];
    float* out;
    unsigned char* ws;
    int ph_lo, ph_hi;
};
enum { I_X = 0, I_P, I_POS, I_WIN, I_SAR, I_SAI, I_SLDT, I_SBR, I_SBI, I_SCR, I_SCI, I_SD, I_SGLU, I_FBF, I_GQ, I_WUQ, I_GKV, I_WUKV, I_RELB, I_WB, I_WG, I_BG, I_WO,
       I_GMIX, I_GFFN, I_FW1, I_FW3, I_FW2, I_MWR, I_MBR, I_MW1, I_MW3, I_MW2, I_GPLE, I_PWG, I_PWU, I_GFIN };

__device__ __forceinline__ void sincos_rad(double a, float& s, float& c) {
    double r = a * 0.15915494309189535; r = r - __builtin_rint(r); const float f = (float)r;
    s = __builtin_amdgcn_sinf(f); c = __builtin_amdgcn_cosf(f);
}
__device__ __forceinline__ float gelu_tanh(float x) {
    const float z = 0.7978845608028654f * (x + 0.044715f * x * x * x);
    const float e = __expf(2.0f * z); const float th = 1.0f - 2.0f / (1.0f + e);
    return 0.5f * x * (1.0f + th);
}
__device__ __forceinline__ float log_sigmoid(float z) { return fminf(z, 0.f) - log1pf(__expf(-fabsf(z))); }

struct CvtJob { const float* src; const float* ks; bf16* dst; int K, ldsrc, col0, ncols, row0, ldk, ilv; };
struct CvtRegs { f32x4 v[16]; };
__device__ __forceinline__ void cvt_load(const CvtJob& J, int item, int lane, CvtRegs& R) {
    const int nblk = (J.ncols + 63) >> 6, kb = item / nblk, nb = item % nblk, k0 = 64 * kb, n0 = 64 * nb;
    const int n4 = (lane & 15) * 4; const bool inb = (n0 + n4) < J.ncols;
#pragma unroll
    for (int i = 0; i < 16; ++i) { const int kk = 4 * i + (lane >> 4); f32x4 v = {0.f, 0.f, 0.f, 0.f};
        if (inb) v = *(const f32x4*)(J.src + (size_t)(k0 + kk) * J.ldsrc + J.col0 + n0 + n4);
        if (J.ks) v = v * J.ks[k0 + kk];
        R.v[i] = v; }
}
__device__ __forceinline__ void cvt_finish(const CvtJob& J, LAS float* scr, int item, int lane, const CvtRegs& R) {
    const int nblk = (J.ncols + 63) >> 6, kb = item / nblk, nb = item % nblk, k0 = 64 * kb, n0 = 64 * nb;
    const int n4 = (lane & 15) * 4;
#pragma unroll
    for (int i = 0; i < 16; ++i) { const int kk = 4 * i + (lane >> 4); *(LAS f32x4*)(scr + kk * 68 + n4) = R.v[i]; }
    LDS_WAIT(); asm volatile("" ::: "memory");
    const int c = lane & 7;
#pragma unroll
    for (int j = 0; j < 8; ++j) { const int n = (lane >> 3) + 8 * j; const LAS float* s = scr + (8 * c) * 68 + n;
        u32x4 o; o.x = pk2(s[0 * 68], s[1 * 68]); o.y = pk2(s[2 * 68], s[3 * 68]); o.z = pk2(s[4 * 68], s[5 * 68]); o.w = pk2(s[6 * 68], s[7 * 68]);
        const int nn = n0 + n; const int row = J.row0 + (J.ilv ? ((nn >> 7) * 256 + (nn & 127)) : nn);
        if (nn < J.ncols) *(u32x4*)(J.dst + (size_t)row * J.ldk + k0 + 8 * c) = o; }
    LDS_WAIT(); asm volatile("" ::: "memory");
}
__device__ __forceinline__ bf16* wmix(const Params& P, int L, size_t off) { return (bf16*)(P.ws + WS_WMIX + (size_t)L * WMIX_STRIDE + off); }
__device__ __forceinline__ CvtJob get_job(const Params& P, int j) {
    CvtJob J; J.ks = nullptr; J.ilv = 0; J.col0 = 0; J.row0 = 0;
    if (j < 40) {
        const int L = j / 20, q = j % 20;
        if (q < 5) {
            J.src = P.in[I_WIN] + (size_t)L * D * DIN; J.K = D; J.ldsrc = DIN; J.dst = wmix(P, L, WM_IN); J.ldk = D;
            J.col0 = q == 0 ? 0 : q == 1 ? 1380 : q == 2 ? 1028 : q == 3 ? 1220 : 1348;
            J.ncols = q == 0 ? 1024 : q == 1 ? 768 : q == 2 ? 192 : q == 3 ? 128 : 32;
            J.row0 = q == 0 ? 0 : q == 1 ? 1024 : q == 2 ? 1792 : q == 3 ? 2048 : 2176;
        } else if (q < 9) { const int k = q - 5; J.src = P.in[I_WG] + ((size_t)L * 4 + k) * D * D; J.K = D; J.ldsrc = D; J.ncols = D; J.row0 = k * D; J.dst = wmix(P, L, WM_G); J.ldk = D;
        } else if (q < 13) { const int k = q - 9; J.src = P.in[I_WB] + ((size_t)L * 4 + k) * 256 * D; J.K = 256; J.ldsrc = D; J.ncols = D; J.row0 = k * D; J.dst = wmix(P, L, WM_B); J.ldk = 256;
        } else if (q == 13) { J.src = P.in[I_WO] + (size_t)L * D * D; J.K = D; J.ldsrc = D; J.ncols = D; J.dst = wmix(P, L, WM_O); J.ldk = D;
        } else if (q == 14) { J.src = P.in[I_PWG] + (size_t)L * D * D; J.K = D; J.ldsrc = D; J.ncols = D; J.dst = wmix(P, L, WM_PG); J.ldk = D;
        } else if (q == 15) { J.src = P.in[I_PWU] + (size_t)L * 256 * D; J.K = 256; J.ldsrc = D; J.ncols = D; J.dst = wmix(P, L, WM_UP); J.ldk = 256;
        } else if (q == 16) { J.src = P.in[I_WUQ] + (size_t)L * 192 * 384; J.ks = P.in[I_GQ] + L * 192; J.K = 192; J.ldsrc = 384; J.ncols = 384; J.dst = wmix(P, L, WM_UQ); J.ldk = 256;
        } else if (q == 17) { J.src = P.in[I_WUKV] + (size_t)L * 128 * 512; J.ks = P.in[I_GKV] + L * 128; J.K = 128; J.ldsrc = 512; J.ncols = 512; J.dst = wmix(P, L, WM_UKV); J.ldk = 128;
        } else if (q == 18) { J.src = P.in[I_SGLU] + (size_t)L * 256 * 256; J.K = 256; J.ldsrc = 256; J.ncols = 256; J.dst = wmix(P, L, WM_GLU); J.ldk = 256;
        } else { J.src = nullptr; J.K = 0; J.ldsrc = 0; J.ncols = 32; J.dst = nullptr; J.ldk = 0; }
    } else if (j < 43) {
        const int q = j - 40;
        if (q == 0) { J.src = P.in[I_FW1]; J.K = D; J.ldsrc = DFF; J.ncols = DFF; J.dst = (bf16*)(P.ws + WS_W13); J.ldk = D; J.ilv = 1; }
        else if (q == 1) { J.src = P.in[I_FW3]; J.K = D; J.ldsrc = DFF; J.ncols = DFF; J.row0 = 128; J.dst = (bf16*)(P.ws + WS_W13); J.ldk = D; J.ilv = 1; }
        else { J.src = P.in[I_FW2]; J.K = DFF; J.ldsrc = D; J.ncols = D; J.dst = (bf16*)(P.ws + WS_W2); J.ldk = DFF; }
    } else {
        const int e = (j - 43) / 3, q = (j - 43) % 3;
        if (q == 0) { J.src = P.in[I_MW1] + (size_t)e * D * DFFE; J.K = D; J.ldsrc = DFFE; J.ncols = DFFE; J.row0 = e * 2816; J.dst = (bf16*)(P.ws + WS_WM13); J.ldk = D; J.ilv = 1; }
        else if (q == 1) { J.src = P.in[I_MW3] + (size_t)e * D * DFFE; J.K = D; J.ldsrc = DFFE; J.ncols = DFFE; J.row0 = e * 2816 + 128; J.dst = (bf16*)(P.ws + WS_WM13); J.ldk = D; J.ilv = 1; }
        else { J.src = P.in[I_MW2] + (size_t)e * DFFE * D; J.K = DFFE; J.ldsrc = D; J.ncols = D; J.row0 = e * D; J.dst = (bf16*)(P.ws + WS_WM2); J.ldk = DFFE; }
    }
    return J;
}
__device__ __forceinline__ void cvt_jobs(const Params& P, int j_lo, int j_hi, LAS unsigned char* lds) {
    BODY_IDS();
    LAS float* scr = (LAS float*)(lds + wave * 17408);
    int acc = 0; bool have = false; CvtJob Jp; int itp = 0; CvtRegs Rp;
    for (int j = j_lo; j < j_hi; ++j) {
        const CvtJob J = get_job(P, j);
        const int items = (J.K / 64) * ((J.ncols + 63) >> 6);
        const int first = (gw - (acc % ngw) + ngw) % ngw;
        for (int it = first; it < items; it += ngw) {
            CvtRegs Rn; cvt_load(J, it, lane, Rn);
            if (have) cvt_finish(Jp, scr, itp, lane, Rp);
            Jp = J; itp = it; have = true;
#pragma unroll
            for (int i = 0; i < 16; ++i) Rp.v[i] = Rn.v[i];
        }
        acc += items;
    }
    if (have) cvt_finish(Jp, scr, itp, lane, Rp);
}

__device__ __forceinline__ void p0_misc(const Params& P) {
    BODY_IDS();
    { const f32x4* src = (const f32x4*)P.in[I_P]; u32x2* dst = (u32x2*)(P.ws + WS_PBF);
      for (int i = gtid; i < 2 * NTOK * 256 / 4; i += gthreads) { const f32x4 v = src[i]; u32x2 w; w.x = pk2(v[0], v[1]); w.y = pk2(v[2], v[3]); dst[i] = w; } }
    { const int* pos = (const int*)P.in[I_POS]; float* ct = (float*)(P.ws + WS_COS); float* st = (float*)(P.ws + WS_SIN);
      const double invf[16] = {1.0, 0.5623413251903491, 0.31622776601683794, 0.1778279410038923, 0.1, 0.05623413251903491, 0.03162277660168379, 0.01778279410038923,
                               0.01, 0.005623413251903491, 0.0031622776601683794, 0.0017782794100389228, 0.001, 0.0005623413251903491, 0.00031622776601683794, 0.00017782794100389227};
      for (int i = gtid; i < NTOK * 16; i += gthreads) { const int row = i >> 4, f = i & 15; double iv = invf[0];
#pragma unroll
          for (int q = 1; q < 16; ++q) iv = (f == q) ? invf[q] : iv;
          const float ang = (float)pos[row] * (float)iv; float s, c; sincos_rad((double)ang, s, c); ct[i] = c; st[i] = s; } }
    for (int L = 0; L < 2; ++L) {
        bf16* win = wmix(P, L, WM_IN);
        for (int i = gtid; i < (64 + 96) * D / 8; i += gthreads) { const int e = i * 8, r = e / D, k = e % D; const int row = r < 64 ? 1984 + r : 2208 + (r - 64); *(u32x4*)(win + (size_t)row * D + k) = (u32x4){0u, 0u, 0u, 0u}; }
        bf16* wuq = wmix(P, L, WM_UQ);
        for (int i = gtid; i < 512 * 256 / 8; i += gthreads) { const int e = i * 8, r = e / 256, k = e % 256; if (r >= 384 || k >= 192) *(u32x4*)(wuq + e) = (u32x4){0u, 0u, 0u, 0u}; }
    }
}

__device__ __forceinline__ void rms_load(const XSrc& x, int row, int lane, f32x4 (&v)[4]) {
#pragma unroll
    for (int j = 0; j < 4; ++j) v[j] = ldx4(x, (size_t)row * D + 4 * lane + 256 * j);
}
struct GainRegs { f32x4 g[4]; };
__device__ __forceinline__ GainRegs load_gain(const float* gain, int lane) { GainRegs G; const f32x4* gr = (const f32x4*)gain + lane;
#pragma unroll
    for (int j = 0; j < 4; ++j) G.g[j] = gr[64 * j];
    return G; }
__device__ __forceinline__ void rms_finish(const GainRegs& G, bf16* orow, int lane, f32x4 (&v)[4]) {
    float s = 0.f;
#pragma unroll
    for (int j = 0; j < 4; ++j) s += (v[j][0] * v[j][0] + v[j][1] * v[j][1]) + (v[j][2] * v[j][2] + v[j][3] * v[j][3]);
    const float rstd = __builtin_amdgcn_rsqf(wave_sum(s) * (1.0f / D) + RMS_EPS);
    u32x2* o8 = (u32x2*)orow + lane;
#pragma unroll
    for (int j = 0; j < 4; ++j) { v[j] = v[j] * rstd * G.g[j]; if (orow) { u32x2 w; w.x = pk2(v[j][0], v[j][1]); w.y = pk2(v[j][2], v[j][3]); o8[64 * j] = w; } }
}
#define RMS_ROWS_BEGIN(x_, rowexpr_) f32x4 v[4], vn_[4]; { const int i = 0; rms_load(x_, (rowexpr_), lane, v); } for (int i = 0; i < 16; ++i) { if (i + 1 < 16) { const int i_ = i; { const int i = i_ + 1; rms_load(x_, (rowexpr_), lane, vn_); } }
#define RMS_ROWS_END() _Pragma("unroll") for (int j_ = 0; j_ < 4; ++j_) v[j_] = vn_[j_]; }
__device__ __forceinline__ void norm_plain(const XSrc x, const float* gain, bf16* H, int first, int stride) {
    BODY_IDS();
    const GainRegs GR = load_gain(gain, lane);
    for (int u = first; u < NTOK / 128; u += stride)
    { RMS_ROWS_BEGIN(x, u * 128 + wave * 16 + i) const int row = u * 128 + wave * 16 + i; rms_finish(GR, H + (size_t)row * D, lane, v); RMS_ROWS_END() }
}
__device__ __forceinline__ void norm1_phase(const Params& P, int L, const XSrc x, int first, int stride) {
    BODY_IDS();
    const float* win = P.in[I_WIN] + (size_t)L * D * DIN;
    f32x4 wff[4][4];
#pragma unroll
    for (int j = 0; j < 4; ++j)
#pragma unroll
        for (int e = 0; e < 4; ++e) wff[j][e] = *(const f32x4*)(win + (size_t)(4 * lane + 256 * j + e) * DIN + 1024);
    const float* gain = P.in[I_GMIX] + L * D; bf16* H = (bf16*)(P.ws + WS_H); const GainRegs GR = load_gain(gain, lane);
    float* logf = (float*)(P.ws + WS_LOGF); float* wsum = (float*)(P.ws + WS_WSUM);
    const f32x4 bf = *(const f32x4*)(P.in[I_FBF] + L * 4);
    for (int u = first; u < NTOK / 128; u += stride) { const int g0 = u * 8 + wave;
        f32x4 run = {0.f, 0.f, 0.f, 0.f};
        RMS_ROWS_BEGIN(x, g0 * 16 + i) const int row = g0 * 16 + i; rms_finish(GR, H + (size_t)row * D, lane, v);
            f32x4 d = {0.f, 0.f, 0.f, 0.f};
#pragma unroll
            for (int j = 0; j < 4; ++j)
#pragma unroll
                for (int e = 0; e < 4; ++e) d += wff[j][e] * v[j][e];
#pragma unroll
            for (int e = 0; e < 4; ++e) { d[e] = wave_sum(d[e]); run[e] += log_sigmoid(d[e] + bf[e]); }
            if (lane == 0) *(f32x4*)(logf + (size_t)row * 4) = run; RMS_ROWS_END()
        if (lane == 0) *(f32x4*)(wsum + (size_t)g0 * 4) = run;
    }
    __syncthreads();
}
__device__ __forceinline__ void prep_phase(const Params& P, int L) {
    BODY_IDS();
    unsigned* qmaxw = (unsigned*)(P.ws + WS_CTL) + CW_QMAX + L * 512; unsigned* kmaxw = (unsigned*)(P.ws + WS_CTL) + CW_KMAX + L * 16;
    const float* logf = (const float*)(P.ws + WS_LOGF); const float* wsum = (const float*)(P.ws + WS_WSUM); float* cdec = (float*)(P.ws + WS_CDEC);
    float* rq = (float*)(P.ws + WS_RSTDQ); float* rkv = (float*)(P.ws + WS_RSTDKV); const bf16* zin = (const bf16*)(P.ws + WS_ZIN); bf16* kper = (bf16*)(P.ws + WS_KPER);
    const float* ct = (const float*)(P.ws + WS_COS); const float* st = (const float*)(P.ws + WS_SIN);
    for (int g0 = gw; g0 < NTOK / 16; g0 += ngw) {
        const int first = (g0 / 512) * 512;
        f32x4 pre = {0.f, 0.f, 0.f, 0.f};
        for (int i = first + lane; i < g0; i += 64) pre += *(const f32x4*)(wsum + (size_t)i * 4);
#pragma unroll
        for (int e = 0; e < 4; ++e) pre[e] = wave_sum(pre[e]);
        if (lane < 16) { const int row = g0 * 16 + lane; *(f32x4*)(cdec + (size_t)row * 4) = *(const f32x4*)(logf + (size_t)row * 4) + pre; }
        float qk2m = 0.f;
        const int colA = (lane < 32 ? ZC_FQ : ZC_FK) + 8 * (lane & 31), colB = ZC_CQ + 8 * (lane < 52 ? lane : 51);
        u32x4 wa = *(const u32x4*)(zin + (size_t)(g0 * 16) * ZP + colA), wb = *(const u32x4*)(zin + (size_t)(g0 * 16) * ZP + colB);
        for (int i = 0; i < 16; ++i) { const int row = g0 * 16 + i;
            const u32x4 ca = wa, cb = wb;
            if (i + 1 < 16) { wa = *(const u32x4*)(zin + (size_t)(row + 1) * ZP + colA); wb = *(const u32x4*)(zin + (size_t)(row + 1) * ZP + colB); }
            const f32x4 cs = *(const f32x4*)(ct + (size_t)row * 16 + 8 * (lane & 1)), cs2 = *(const f32x4*)(ct + (size_t)row * 16 + 8 * (lane & 1) + 4);
            const f32x4 sn = *(const f32x4*)(st + (size_t)row * 16 + 8 * (lane & 1)), sn2 = *(const f32x4*)(st + (size_t)row * 16 + 8 * (lane & 1) + 4);
            { float sa = (bflo(ca.x) * bflo(ca.x) + bfhi(ca.x) * bfhi(ca.x)) + (bflo(ca.y) * bflo(ca.y) + bfhi(ca.y) * bfhi(ca.y)) + (bflo(ca.z) * bflo(ca.z) + bfhi(ca.z) * bfhi(ca.z)) + (bflo(ca.w) * bflo(ca.w) + bfhi(ca.w) * bfhi(ca.w));
              sa += DPP_F(sa, 0xB1, 0xF); sa += DPP_F(sa, 0x4E, 0xF); sa += DPP_F(sa, 0x141, 0xF);
              qk2m = fmaxf(qk2m, sa); }
            const float own[8] = {bflo(cb.x), bfhi(cb.x), bflo(cb.y), bfhi(cb.y), bflo(cb.z), bfhi(cb.z), bflo(cb.w), bfhi(cb.w)};
            float ssb = 0.f;
#pragma unroll
            for (int e = 0; e < 8; ++e) ssb += own[e] * own[e];
            const float sq = wave_sum(lane < 24 ? ssb : 0.f), skv = wave_sum((lane >= 32 && lane < 48) ? ssb : 0.f);
            if (lane == 0) { rq[row] = __builtin_amdgcn_rsqf(sq * (1.0f / 192.0f) + RMS_EPS); rkv[row] = __builtin_amdgcn_rsqf(skv * (1.0f / 128.0f) + RMS_EPS); }
            float oth[8];
#pragma unroll
            for (int e = 0; e < 8; ++e) oth[e] = DPP_F(own[e], 0x4E, 0xF);
            if (lane >= 48 && lane < 52) { const bool lo = lane < 50; float o8[8];
#pragma unroll
                for (int e = 0; e < 8; ++e) { const float c = e < 4 ? cs[e] : cs2[e - 4], sv = e < 4 ? sn[e] : sn2[e - 4];
                    o8[e] = lo ? (own[e] * c - oth[e] * sv) : (own[e] * c + oth[e] * sv); }
                *(u32x4*)(kper + (size_t)row * 32 + (lo ? 0 : 16) + 8 * (lane & 1)) = (u32x4){pk2(o8[0], o8[1]), pk2(o8[2], o8[3]), pk2(o8[4], o8[5]), pk2(o8[6], o8[7])}; } }
        if ((lane & 7) == 0) { const int row0 = g0 * 16, b = row0 / SEQ, qb = (row0 % SEQ) / 256, h = (lane & 31) >> 3;
            if (lane < 32) atomicMax(qmaxw + (b * 4 + h) * 32 + qb, __float_as_uint(qk2m)); else atomicMax(kmaxw + b * 4 + h, __float_as_uint(qk2m)); }
    }
}
struct FinalRows { u32x2 w[16][4]; };
__device__ __forceinline__ void final_norm_load(const Params& P, int u, FinalRows& R) {
    BODY_IDS();
    const bf16* xb = xr_of(P.out);
#pragma unroll
    for (int i = 0; i < 16; ++i) { const u32x2* xr = (const u32x2*)(xb + (size_t)(u * 128 + wave * 16 + i) * D) + lane;
#pragma unroll
        for (int j = 0; j < 4; ++j) R.w[i][j] = xr[64 * j]; }
}
__device__ __forceinline__ void final_norm_store(const Params& P, int u, const FinalRows& R) {
    BODY_IDS();
    const GainRegs GR = load_gain(P.in[I_GFIN], lane);
#pragma unroll
    for (int i = 0; i < 16; ++i) { f32x4 v[4]; float s = 0.f;
#pragma unroll
        for (int j = 0; j < 4; ++j) { const u32x2 w = R.w[i][j]; v[j] = (f32x4){bflo(w.x), bfhi(w.x), bflo(w.y), bfhi(w.y)}; s += (v[j][0] * v[j][0] + v[j][1] * v[j][1]) + (v[j][2] * v[j][2] + v[j][3] * v[j][3]); }
        const float rstd = __builtin_amdgcn_rsqf(wave_sum(s) * (1.0f / D) + RMS_EPS);
        f32x4* xo = (f32x4*)(P.out + (size_t)(u * 128 + wave * 16 + i) * D) + lane;
#pragma unroll
        for (int j = 0; j < 4; ++j) xo[64 * j] = v[j] * rstd * GR.g[j]; }
}
namespace s5 {
struct Coef { float abr, abi; f32x2 B2[16]; float a64r, a64i; };
__device__ __forceinline__ void coef(const Params& P, int L, int g, int p, Coef& C) {
    const float dt = __expf(P.in[I_SLDT][L * 16 + g]); const float ar = P.in[I_SAR][(L * 16 + g) * 64 + p], ai = P.in[I_SAI][(L * 16 + g) * 64 + p];
    const float mag = __expf(ar * dt); float sn, cs; sincos_rad((double)(ai * dt), sn, cs);
    C.abr = mag * cs; C.abi = mag * sn;
    const float den = ar * ar + ai * ai, nr = C.abr - 1.0f, ni = C.abi;
    const float cr = (nr * ar + ni * ai) / den, ci = (ni * ar - nr * ai) / den;
    const float* br = P.in[I_SBR] + ((size_t)(L * 16 + g) * 64 + p) * 16; const float* bi = P.in[I_SBI] + ((size_t)(L * 16 + g) * 64 + p) * 16;
#pragma unroll
    for (int h = 0; h < 16; ++h) { const float r = br[h], i = bi[h]; C.B2[h] = (f32x2){cr * r - ci * i, cr * i + ci * r}; }
    const float m64 = __expf(64.0f * ar * dt); float s64, c64; sincos_rad(64.0 * (double)(ai * dt), s64, c64);
    C.a64r = m64 * c64; C.a64i = m64 * s64;
}
constexpr int WAVE_LDS = 8448;
template <bool EMIT>
__device__ __forceinline__ void chunk(const Params& P, int L, int g, int row0, const Coef& C, float& xr, float& xi, LAS unsigned char* wl, int lane, const bf16x8 (&cf)[4], float dsk) {
    bf16* zin = (bf16*)(P.ws + WS_ZIN);
    LAS float* ut = (LAS float*)wl; LAS unsigned* xt = (LAS unsigned*)(wl + 4096);
    { const u32x4* up = (const u32x4*)(zin + (size_t)(row0 + lane) * ZP + ZC_U + g * 16); const u32x4 w0 = up[0], w1 = up[1];
      LAS f32x4* d = (LAS f32x4*)(ut + lane * 16);
      d[0] = (f32x4){bflo(w0.x), bfhi(w0.x), bflo(w0.y), bfhi(w0.y)}; d[1] = (f32x4){bflo(w0.z), bfhi(w0.z), bflo(w0.w), bfhi(w0.w)};
      d[2] = (f32x4){bflo(w1.x), bfhi(w1.x), bflo(w1.y), bfhi(w1.y)}; d[3] = (f32x4){bflo(w1.z), bfhi(w1.z), bflo(w1.w), bfhi(w1.w)}; }
    for (int tb = 0; tb < 4; ++tb) {
#pragma unroll 4
        for (int ti = 0; ti < 16; ++ti) {
            const LAS f32x4* up = (const LAS f32x4*)(ut + (tb * 16 + ti) * 16);
            f32x2 b2a = {0.f, 0.f}, b2b = {0.f, 0.f};
#pragma unroll
            for (int q = 0; q < 4; ++q) { const f32x4 u4 = up[q];
                b2a += C.B2[4 * q + 0] * (f32x2){u4[0], u4[0]}; b2b += C.B2[4 * q + 1] * (f32x2){u4[1], u4[1]};
                b2a += C.B2[4 * q + 2] * (f32x2){u4[2], u4[2]}; b2b += C.B2[4 * q + 3] * (f32x2){u4[3], u4[3]}; }
            const float br = b2a[0] + b2b[0], bi = b2a[1] + b2b[1];
            const float nr = C.abr * xr - C.abi * xi + br, ni = C.abr * xi + C.abi * xr + bi; xr = nr; xi = ni;
            if (EMIT) xt[ti * 68 + lane] = pk2(xr, xi);
        }
        if (EMIT) {
            f32x4 dacc = {0.f, 0.f, 0.f, 0.f};
#pragma unroll
            for (int ks = 0; ks < 4; ++ks) { const bf16x8 a = *(const LAS bf16x8*)((const LAS unsigned char*)xt + (lane & 15) * 272 + (ks * 32 + (lane >> 4) * 8) * 2);
                dacc = __builtin_amdgcn_mfma_f32_16x16x32_bf16(a, cf[ks], dacc, 0, 0, 0); }
            const int hp = lane & 15;
#pragma unroll
            for (int i = 0; i < 4; ++i) { const int tok = tb * 16 + 4 * (lane >> 4) + i; const float y = dacc[i] + dsk * ut[tok * 16 + hp];
                zin[(size_t)(row0 + tok) * ZP + ZC_U + g * 16 + hp] = (bf16)f2bf(gelu_tanh(y)); }
        }
    }
}
template <int PASS>
__device__ __forceinline__ void phase(const Params& P, int L, LAS unsigned char* lds) {
    BODY_IDS();
    LAS unsigned char* wl = lds + wave * WAVE_LDS;
    f32x2* SC = (f32x2*)(P.ws + WS_SC);
    for (int w = gw; w < 2048; w += ngw) {
        const int bg = w >> 5, cg = w & 31, b = bg >> 4, g = bg & 15;
        Coef C; coef(P, L, g, lane, C);
        bf16x8 cf[4]; float dsk = 0.f;
        if (PASS == 1) {
            const int hp = lane & 15, kg = lane >> 4;
            const float* cre = P.in[I_SCR] + ((size_t)(L * 16 + g) * 16 + hp) * 64; const float* cim = P.in[I_SCI] + ((size_t)(L * 16 + g) * 16 + hp) * 64;
#pragma unroll
            for (int ks = 0; ks < 4; ++ks) { const int p0 = 16 * ks + 4 * kg; u32x4 wv;
                wv.x = pk2(cre[p0], -cim[p0]); wv.y = pk2(cre[p0 + 1], -cim[p0 + 1]); wv.z = pk2(cre[p0 + 2], -cim[p0 + 2]); wv.w = pk2(cre[p0 + 3], -cim[p0 + 3]);
                cf[ks] = __builtin_bit_cast(bf16x8, wv); }
            dsk = P.in[I_SD][(L * 16 + g) * 16 + hp];
        } else {
#pragma unroll
            for (int ks = 0; ks < 4; ++ks) cf[ks] = (bf16x8){0, 0, 0, 0, 0, 0, 0, 0};
        }
        float xr = 0.f, xi = 0.f;
        if (PASS == 1) {
            const f32x2* sp = SC + ((size_t)bg * 128) * 64 + lane;
            for (int c = 0; c < 4 * cg; c += 4) { f32x2 sv[4];
#pragma unroll
                for (int q = 0; q < 4; ++q) sv[q] = sp[(size_t)(c + q) * 64];
#pragma unroll
                for (int q = 0; q < 4; ++q) { const float nr = C.a64r * xr - C.a64i * xi + sv[q][0], ni = C.a64r * xi + C.a64i * xr + sv[q][1]; xr = nr; xi = ni; } }
        }
        for (int cc = 0; cc < 4; ++cc) {
            const int c = 4 * cg + cc, row0 = b * SEQ + c * 64;
            if (PASS == 0) { xr = 0.f; xi = 0.f; }
            chunk<PASS == 1>(P, L, g, row0, C, xr, xi, wl, lane, cf, dsk);
            if (PASS == 0) SC[((size_t)bg * 128 + c) * 64 + lane] = (f32x2){xr, xi};
        }
    }
}
__device__ __forceinline__ void naive(const Params& P, int L) {
    BODY_IDS();
    bf16* zin = (bf16*)(P.ws + WS_ZIN);
    for (int bg = gw; bg < 64; bg += ngw) {
        const int b = bg >> 4, g = bg & 15;
        Coef C; coef(P, L, g, lane, C);
        float cr[16], ci[16];
#pragma unroll
        for (int h = 0; h < 16; ++h) { cr[h] = P.in[I_SCR][((size_t)(L * 16 + g) * 16 + h) * 64 + lane]; ci[h] = P.in[I_SCI][((size_t)(L * 16 + g) * 16 + h) * 64 + lane]; }
        const float dsk = P.in[I_SD][(L * 16 + g) * 16 + (lane & 15)];
        float xr = 0.f, xi = 0.f;
        for (int t = 0; t < SEQ; ++t) {
            bf16* up = zin + (size_t)(b * SEQ + t) * ZP + ZC_U + g * 16;
            const u32x4 w0 = *(const u32x4*)up, w1 = *(const u32x4*)(up + 8);
            const float u[16] = {bflo(w0.x), bfhi(w0.x), bflo(w0.y), bfhi(w0.y), bflo(w0.z), bfhi(w0.z), bflo(w0.w), bfhi(w0.w),
                                 bflo(w1.x), bfhi(w1.x), bflo(w1.y), bfhi(w1.y), bflo(w1.z), bfhi(w1.z), bflo(w1.w), bfhi(w1.w)};
            float br = 0.f, bi = 0.f;
#pragma unroll
            for (int h = 0; h < 16; ++h) { br += C.B2[h][0] * u[h]; bi += C.B2[h][1] * u[h]; }
            const float nr = C.abr * xr - C.abi * xi + br, ni = C.abr * xi + C.abi * xr + bi; xr = nr; xi = ni;
            float ymine = 0.f, umine = 0.f;
#pragma unroll
            for (int h = 0; h < 16; ++h) { const float s = wave_sum(xr * cr[h] - xi * ci[h]); if ((lane & 15) == h) { ymine = s; umine = u[h]; } }
            __builtin_amdgcn_s_waitcnt(0);
            if (lane < 16) up[lane] = (bf16)f2bf(gelu_tanh(ymine + dsk * umine));
        }
    }
}
}

__device__ __forceinline__ void norm2_moe_phase(const Params& P, const XSrc x, LAS unsigned char* lds, int first, int stride) {
    BODY_IDS();
    LAS unsigned* lcnt = (LAS unsigned*)(lds + 32768); LAS unsigned* lbase = lcnt + 8;
    f32x4 wr0[4][4], wr1[4][4];
#pragma unroll
    for (int j = 0; j < 4; ++j)
#pragma unroll
        for (int q = 0; q < 4; ++q) { const float* wp = P.in[I_MWR] + (size_t)(4 * lane + 256 * j + q) * 8; wr0[j][q] = *(const f32x4*)wp; wr1[j][q] = *(const f32x4*)(wp + 4); }
    if (tid < 8) lcnt[tid] = 0u;
    __syncthreads();
    const float* gain = P.in[I_GFFN] + 1 * D; bf16* H = (bf16*)(P.ws + WS_H); const GainRegs GR = load_gain(gain, lane);
    unsigned* tokinfo = (unsigned*)(P.ws + WS_TOKINFO); unsigned* gcnt = (unsigned*)(P.ws + WS_CTL) + CW_MOECNT;
    const float* brt = P.in[I_MBR];
    for (int u = first; u < NTOK / 128; u += stride) { const int g0 = u * 8 + wave;
        RMS_ROWS_BEGIN(x, g0 * 16 + i) const int row = g0 * 16 + i; rms_finish(GR, H + (size_t)row * D, lane, v);
            float lg[8];
#pragma unroll
            for (int e = 0; e < 8; ++e) lg[e] = 0.f;
#pragma unroll
            for (int j = 0; j < 4; ++j)
#pragma unroll
                for (int q = 0; q < 4; ++q) { const f32x4 w0 = wr0[j][q], w1 = wr1[j][q]; const float hv = v[j][q];
                    lg[0] += hv * w0[0]; lg[1] += hv * w0[1]; lg[2] += hv * w0[2]; lg[3] += hv * w0[3]; lg[4] += hv * w1[0]; lg[5] += hv * w1[1]; lg[6] += hv * w1[2]; lg[7] += hv * w1[3]; }
#pragma unroll
            for (int e = 0; e < 8; ++e) lg[e] = wave_sum(lg[e]) + brt[e];
            int e0 = 0; float l0 = lg[0];
#pragma unroll
            for (int e = 1; e < 8; ++e) if (lg[e] > l0) { l0 = lg[e]; e0 = e; }
            int e1 = 0; float l1 = -INFINITY;
#pragma unroll
            for (int e = 0; e < 8; ++e) if (e != e0 && lg[e] > l1) { l1 = lg[e]; e1 = e; }
            const float ex = __expf(l1 - l0); const float ga = __builtin_amdgcn_rcpf(1.0f + ex), gb = ex * ga;
            if (lane == 0) { const unsigned r0 = __hip_atomic_fetch_add(&lcnt[e0], 1u, __ATOMIC_RELAXED, __HIP_MEMORY_SCOPE_WORKGROUP), r1 = __hip_atomic_fetch_add(&lcnt[e1], 1u, __ATOMIC_RELAXED, __HIP_MEMORY_SCOPE_WORKGROUP);
                u32x4 a; a.x = (unsigned)e0; a.y = (unsigned)e1; a.z = r0; a.w = r1; u32x4 bq; bq.x = __float_as_uint(ga); bq.y = __float_as_uint(gb); bq.z = 0u; bq.w = 0u;
                *(u32x4*)(tokinfo + (size_t)row * 8) = a; *(u32x4*)(tokinfo + (size_t)row * 8 + 4) = bq; } RMS_ROWS_END()
    }
    __syncthreads();
    if (tid < 8) lbase[tid] = __hip_atomic_fetch_add(gcnt + tid, lcnt[tid], __ATOMIC_RELAXED, __HIP_MEMORY_SCOPE_AGENT);
    __syncthreads();
    for (int u = first; u < NTOK / 128; u += stride) { const int g0 = u * 8 + wave;
        if (lane == 0) { for (int i = 0; i < 16; ++i) { const int row = g0 * 16 + i; u32x4 a = *(u32x4*)(tokinfo + (size_t)row * 8);
            unsigned b0 = 0, b1 = 0;
#pragma unroll
            for (int e = 0; e < 8; ++e) { const unsigned lb = lbase[e]; b0 = (a.x == (unsigned)e) ? lb : b0; b1 = (a.y == (unsigned)e) ? lb : b1; }
            a.z += b0; a.w += b1; *(u32x4*)(tokinfo + (size_t)row * 8) = a; } }
    }
    int* slot_tok = (int*)(P.ws + WS_SLOTTOK);
    for (int i = gtid; i < MOE_ROWS; i += gthreads) slot_tok[i] = -1;
    __syncthreads();
}
struct MoeLayout { int pstart[9]; };
__device__ __forceinline__ MoeLayout moe_layout(const Params& P) {
    const unsigned* gcnt = (const unsigned*)(P.ws + WS_CTL) + CW_MOECNT; MoeLayout Lo; int acc = 0;
#pragma unroll
    for (int e = 0; e < 8; ++e) { Lo.pstart[e] = acc; const int c = (int)__hip_atomic_load(gcnt + e, __ATOMIC_RELAXED, __HIP_MEMORY_SCOPE_AGENT); acc += (c + 255) / 256 * 256; }
    Lo.pstart[8] = acc; return Lo;
}
__device__ __forceinline__ void moe_assign_phase(const Params& P) {
    BODY_IDS();
    const MoeLayout Lo = moe_layout(P);
    const unsigned* tokinfo = (const unsigned*)(P.ws + WS_TOKINFO); int* slot_tok = (int*)(P.ws + WS_SLOTTOK); float* slot_gate = (float*)(P.ws + WS_SLOTGATE);
    for (int t = gtid; t < NTOK; t += gthreads) { const u32x4 a = *(const u32x4*)(tokinfo + (size_t)t * 8); const u32x2 g = *(const u32x2*)(tokinfo + (size_t)t * 8 + 4);
        int p0 = 0, p1 = 0;
#pragma unroll
        for (int e = 0; e < 8; ++e) { p0 = ((int)a.x == e) ? Lo.pstart[e] : p0; p1 = ((int)a.y == e) ? Lo.pstart[e] : p1; }
        const int s0 = p0 + (int)a.z, s1 = p1 + (int)a.w;
        slot_tok[s0] = t; slot_gate[s0] = __uint_as_float(g.x); slot_tok[s1] = t; slot_gate[s1] = __uint_as_float(g.y); }
}
struct MoeOrder {
    int pstart[9]; int ntile, ncol, G, c;
    __device__ __forceinline__ bool next(int i, pg8::Unit& u) const {
        const long Lf = (long)i * G + c; if (Lf >= (long)ntile * ncol) return false;
        const int rt = (int)(Lf / ncol), j = (int)(Lf % ncol); int e = 0;
#pragma unroll
        for (int q = 1; q < 8; ++q) e = (rt * 256 >= pstart[q]) ? q : e;
        u.pm = rt; u.pn = e * ncol + j; return true;
    }
};
__device__ __forceinline__ MoeOrder moe_order(const Params& P, int ncol, int G, int c) {
    const MoeLayout Lo = moe_layout(P); MoeOrder S;
#pragma unroll
    for (int e = 0; e < 9; ++e) S.pstart[e] = Lo.pstart[e];
    S.ntile = Lo.pstart[8] / 256; S.ncol = ncol; S.G = G; S.c = c; return S;
}

__device__ __forceinline__ void norm_moe_combine(const Params& P, const float* gain, int first, int stride) {
    BODY_IDS();
    const MoeLayout Lo = moe_layout(P); const GainRegs GR = load_gain(gain, lane);
    const unsigned* tokinfo = (const unsigned*)(P.ws + WS_TOKINFO); const bf16* Y = (const bf16*)(P.ws + WS_MOEY); bf16* H = (bf16*)(P.ws + WS_H2);
    for (int u = first; u < NTOK / 128; u += stride) for (int i = 0; i < 16; ++i) { const int row = u * 128 + wave * 16 + i;
        const u32x4 a = *(const u32x4*)(tokinfo + (size_t)row * 8);
        int p0 = 0, p1 = 0;
#pragma unroll
        for (int e = 0; e < 8; ++e) { p0 = ((int)a.x == e) ? Lo.pstart[e] : p0; p1 = ((int)a.y == e) ? Lo.pstart[e] : p1; }
        const u32x2* y0 = (const u32x2*)(Y + (size_t)(p0 + (int)a.z) * D) + lane; const u32x2* y1 = (const u32x2*)(Y + (size_t)(p1 + (int)a.w) * D) + lane;
        u32x2* xr = (u32x2*)(xr_of(P.out) + (size_t)row * D) + lane; f32x4 v[4]; float s = 0.f;
#pragma unroll
        for (int j = 0; j < 4; ++j) { const u32x2 w0 = y0[64 * j], w1 = y1[64 * j]; const u32x2 wx = xr[64 * j];
            v[j] = (f32x4){bflo(wx.x), bfhi(wx.x), bflo(wx.y), bfhi(wx.y)} + (f32x4){bflo(w0.x), bfhi(w0.x), bflo(w0.y), bfhi(w0.y)} + (f32x4){bflo(w1.x), bfhi(w1.x), bflo(w1.y), bfhi(w1.y)};
            { u32x2 wo; wo.x = pk2(v[j][0], v[j][1]); wo.y = pk2(v[j][2], v[j][3]); xr[64 * j] = wo; } s += (v[j][0] * v[j][0] + v[j][1] * v[j][1]) + (v[j][2] * v[j][2] + v[j][3] * v[j][3]); }
        const float rstd = __builtin_amdgcn_rsqf(wave_sum(s) * (1.0f / D) + RMS_EPS);
        u32x2* o8 = (u32x2*)(H + (size_t)row * D) + lane;
#pragma unroll
        for (int j = 0; j < 4; ++j) { const f32x4 h = v[j] * rstd * GR.g[j]; u32x2 w; w.x = pk2(h[0], h[1]); w.y = pk2(h[2], h[3]); o8[64 * j] = w; }
    }
}
#ifndef REF_MASK
#define REF_MASK 0
#endif
#ifndef N_LAUNCH_MODE
#define N_LAUNCH_MODE 1
#endif
constexpr int LDS_BYTES = 147456;
constexpr int MISC_OFF = LDS_BYTES - 64;
constexpr int N_PHASES = 27;
#ifndef PHASE_SEL
#define PHASE_SEL 0xFFFFFFFu
#endif
#define PH_ON(b) (((PHASE_SEL) >> (b)) & 1u)
#ifndef SUB_SEL
#define SUB_SEL 0xFFu
#endif
#define SUB_ON(b) (((SUB_SEL) >> (b)) & 1u)

#ifndef PROBE_MASK
#define PROBE_MASK 0u
#endif
#ifndef PROBE_MULT
#define PROBE_MULT 4
#endif
#define TIMED(bit, ...) do { unsigned long long t0_ = 0; if (((PROBE_MASK) >> (bit)) & 1u) t0_ = __builtin_amdgcn_s_memrealtime(); __VA_ARGS__; \
    if (((PROBE_MASK) >> (bit)) & 1u) pacc += __builtin_amdgcn_s_memrealtime() - t0_; } while (0)
#define RUN_GEMM(EPI_T, SCHED_T, GATH, gm, sc, ep) do { if (REF_MASK & 1) pg8::gemm_phase_naive<EPI_T, SCHED_T, GATH>(gm, sc, ep); \
    else pg8::gemm_phase<EPI_T, SCHED_T, true, GATH>(lds, gm, sc, ep); } while (0)

__device__ __forceinline__ int vcu_of() { int G = gridDim.x, bx = blockIdx.x; asm volatile("" : "+s"(G), "+s"(bx)); return (G % 8 == 0) ? (bx % 8) * (G / 8) + bx / 8 : bx; }
__device__ __forceinline__ bool in_range(int lo, int hi, int k) { asm volatile("" : "+s"(lo), "+s"(hi)); return lo <= k && k < hi; }
__global__ void __launch_bounds__(NTHREADS, 2) mega_fwd(Params P) {
    extern __shared__ __attribute__((aligned(16))) unsigned char lds_raw[];
    LAS unsigned char* lds = (LAS unsigned char*)lds_raw;
    const int tid = threadIdx.x;
    const int G = gridDim.x, bx = blockIdx.x;
    unsigned* ctl = (unsigned*)(P.ws + WS_CTL);
    volatile LAS unsigned* misc = (volatile LAS unsigned*)(lds + MISC_OFF);
    if (tid < 16) misc[tid] = 0u;
    if ((tid & 63) == 0) *(LAS int*)(uintptr_t)((unsigned)TID_TAB_OFF + 4u * hw_wave_key()) = tid >> 6;
    __syncthreads();
    const int lo = P.ph_lo, hi = P.ph_hi;
    XcdBarrier bar; bar.bar = ctl + CW_BAR; bar.x = 0; bar.st = misc;
    if (hi - lo > 1) bar = xcd_barrier_post(ctl + CW_BAR, misc);
#define IN(k) in_range(lo, hi, (k))
#ifndef PROBE_SEAMS
#define PROBE_SEAMS 0u
#endif
#define SEAM(k) do { if (IN(k) && IN((k) + 1)) { unsigned long long t0_ = 0; const bool tm_ = (((PROBE_MASK) >> 24) & 1u) || (((PROBE_SEAMS) >> (k)) & 1u); if (tm_) t0_ = __builtin_amdgcn_s_memrealtime(); \
    xcd_barrier(bar); if (tm_) pacc += __builtin_amdgcn_s_memrealtime() - t0_; } } while (0)
    unsigned long long pacc = 0;

#define H ((bf16*)(P.ws + WS_H))
#define ZIN ((bf16*)(P.ws + WS_ZIN))
#define GB ((bf16*)(P.ws + WS_G))
#define MB ((bf16*)(P.ws + WS_M))
#define MLAQ ((bf16*)(P.ws + WS_MLAQ))
#define MLAKV ((bf16*)(P.ws + WS_MLAKV))
#define KPER ((bf16*)(P.ws + WS_KPER))
#define cosT ((float*)(P.ws + WS_COS))
#define sinT ((float*)(P.ws + WS_SIN))
#define slot_tok ((int*)(P.ws + WS_SLOTTOK))
#define slot_gate ((float*)(P.ws + WS_SLOTGATE))

    if (PH_ON(0) && IN(0)) { TIMED(0, cvt_jobs(P, 0, 43, lds); p0_misc(P)); TIMED(1, norm1_phase(P, 0, XSrc{P.in[I_X], nullptr}, vcu_of(), gridDim.x)); }
    SEAM(0);

    for (int L = 0; L < 2; ++L) {
        const int pb = 1 + 12 * L;
        const int pc = (L == 0) ? 9 : 22;
        bf16* const XR = xr_of(P.out);
        const XSrc xsrc = (L == 0) ? XSrc{P.in[I_X], nullptr} : XSrc{nullptr, XR};
        if (PH_ON(2) && IN(pb + 1)) {
            pg8::Gemm g{H, wmix(P, L, WM_IN), D, D, D, nullptr}; pg8::StaticOrder S; S.init(NTOK, ZP, G, bx);
            epi::EpiStore E{ZIN, ZP, 0};
            TIMED(2, RUN_GEMM(epi::EpiStore, pg8::StaticOrder, false, g, S, E));
        }
        SEAM(pb + 1);
        if (PH_ON(3) && IN(pb + 2)) {
            TIMED(3, prep_phase(P, L));
            if (!(REF_MASK & 4)) TIMED(4, s5::phase<0>(P, L, lds));
            __syncthreads();
        }
        SEAM(pb + 2);
        if (PH_ON(4) && IN(pb + 3)) {
            if (SUB_ON(0)) { pg8::Gemm g{ZIN + ZC_CQ, wmix(P, L, WM_UQ), ZP, 256, 256, nullptr}; pg8::StaticOrder S; S.init(NTOK, 512, G, bx);
              epi::EpiMlaQ E{MLAQ, (const float*)(P.ws + WS_RSTDQ), cosT, sinT};
              TIMED(5, RUN_GEMM(epi::EpiMlaQ, pg8::StaticOrder, false, g, S, E)); }
            if (SUB_ON(1)) { pg8::Gemm g{ZIN + ZC_CKV, wmix(P, L, WM_UKV), ZP, 128, 128, nullptr}; pg8::StaticOrder S; S.init(NTOK, 512, G, bx);
              epi::EpiRowScale E{MLAKV, 512, (const float*)(P.ws + WS_RSTDKV)};
              TIMED(5, RUN_GEMM(epi::EpiRowScale, pg8::StaticOrder, false, g, S, E)); }
            if (SUB_ON(2)) { TIMED(6, if (REF_MASK & 4) s5::naive(P, L); else s5::phase<1>(P, L, lds)); }
            __syncthreads();
            if (SUB_ON(3)) { att::Tensors T; T.Q = ZIN + ZC_FQ; T.ldq = ZP; T.K = ZIN + ZC_FK; T.ldk = ZP; T.K2 = nullptr; T.V = ZIN + ZC_FV; T.ldv = ZP; T.O = ZIN + ZC_FQ; T.ldo = ZP;
              T.cdec = (const float*)(P.ws + WS_CDEC); T.relb = nullptr; T.qhs = 64; T.khs = 64; T.vhs = 64; T.ohs = 64;
              T.qmax = (const unsigned*)(P.ws + WS_CTL) + CW_QMAX + L * 512; T.kmax = (const unsigned*)(P.ws + WS_CTL) + CW_KMAX + L * 16;
              TIMED(7, if (REF_MASK & 2) att::attn_naive<att::MODE_FOX>(T); else att::attn_phase<att::MODE_FOX>(T, lds)); }
            __syncthreads();
            if (SUB_ON(4)) { att::Tensors T; T.Q = ZIN + ZC_DQ; T.ldq = ZP; T.K = ZIN + ZC_DK; T.ldk = ZP; T.K2 = nullptr; T.V = ZIN + ZC_DV; T.ldv = ZP; T.O = ZIN + ZC_DQ; T.ldo = ZP;
              T.cdec = nullptr; T.relb = P.in[I_RELB] + (size_t)L * 4 * 513; T.qhs = 64; T.khs = 64; T.vhs = 64; T.ohs = 64;
              TIMED(8, if (REF_MASK & 2) att::attn_naive<att::MODE_BAND>(T); else att::attn_phase<att::MODE_BAND>(T, lds)); }
            __syncthreads();
        }
        SEAM(pb + 3);
        if (PH_ON(5) && IN(pb + 4)) {
            if (SUB_ON(0)) { att::Tensors T; T.Q = MLAQ; T.ldq = 512; T.K = MLAKV; T.ldk = 512; T.K2 = KPER; T.V = MLAKV + 64; T.ldv = 512; T.O = ZIN + ZC_CQ; T.ldo = ZP;
              T.cdec = nullptr; T.relb = nullptr; T.qhs = 96; T.khs = 128; T.vhs = 128; T.ohs = 64;
              TIMED(9, if (REF_MASK & 2) att::attn_naive<att::MODE_MLA>(T); else att::attn_phase<att::MODE_MLA>(T, lds)); }
            __syncthreads();
            if (SUB_ON(1)) { pg8::Gemm g{ZIN + ZC_U, wmix(P, L, WM_GLU), ZP, 256, 256, nullptr}; pg8::StaticOrder S; S.init(NTOK, 256, G, bx);
              epi::EpiGlu E{ZIN + ZC_U, ZP};
              TIMED(10, RUN_GEMM(epi::EpiGlu, pg8::StaticOrder, false, g, S, E)); }
        }
        SEAM(pb + 4);
        if (PH_ON(6) && IN(pb + 5)) {
            g128::MergeProg MP; MP.Hn = H; MP.zin = ZIN; MP.wg = wmix(P, L, WM_G); MP.wb = wmix(P, L, WM_B); MP.bg = P.in[I_BG] + (size_t)L * 4 * D; MP.M = MB;
            const int vcu_ = vcu_of();
            TIMED(11, g128::stream<g128::MergeProg>(lds, MP, 1024, vcu_, G));
        }
        SEAM(pb + 5);
#define PANEL_FENCE() do { asm volatile("s_waitcnt vmcnt(0)" ::: "memory"); __builtin_amdgcn_fence(__ATOMIC_ACQUIRE, "agent"); asm volatile("s_waitcnt vmcnt(0)" ::: "memory"); __syncthreads(); } while (0)
        if (PH_ON(7) && IN(pb + 6)) {
            pg8::Gemm g{MB, wmix(P, L, WM_O), D, D, D, nullptr}; pg8::StaticOrder S; S.init(NTOK, D, G, bx);
            epi::EpiRes E{xsrc, XR};
            TIMED(13, RUN_GEMM(epi::EpiRes, pg8::StaticOrder, false, g, S, E));
        }
        SEAM(pb + 6);
        if (PH_ON(8) && IN(pb + 7)) {
            const int vcu_ = vcu_of();
            if (L == 0) TIMED(14, norm_plain(XSrc{nullptr, XR}, P.in[I_GFFN], H, vcu_, G));
            else { TIMED(14, norm2_moe_phase(P, XSrc{nullptr, XR}, lds, vcu_, G)); TIMED(25, cvt_jobs(P, 43, 67, lds)); __syncthreads(); }
        }
        SEAM(pb + 7);
        if (L == 0) {
            if (PH_ON(9) && IN(9)) {
                pg8::Gemm g{H, (const bf16*)(P.ws + WS_W13), D, D, D, nullptr}; pg8::StaticOrder S; S.init(NTOK, 2 * DFF, G, bx);
                epi::EpiSwiglu E{(bf16*)(P.ws + WS_HMID), DFF, 22};
                TIMED(15, RUN_GEMM(epi::EpiSwiglu, pg8::StaticOrder, false, g, S, E));
            }
            SEAM(9);
            if (PH_ON(10) && IN(10)) {
                pg8::Gemm g{(const bf16*)(P.ws + WS_HMID), (const bf16*)(P.ws + WS_W2), DFF, DFF, DFF, nullptr}; pg8::StaticOrder S; S.init(NTOK, D, G, bx);
                epi::EpiRes E{XSrc{nullptr, XR}, XR};
                TIMED(16, RUN_GEMM(epi::EpiRes, pg8::StaticOrder, false, g, S, E));
            }
            SEAM(10);
        } else {
            if (PH_ON(21) && IN(21)) TIMED(17, moe_assign_phase(P));
            SEAM(21);
            if (PH_ON(22) && IN(22)) {
                pg8::Gemm g{H, (const bf16*)(P.ws + WS_WM13), D, D, D, slot_tok}; const MoeOrder S = moe_order(P, 11, G, bx);
                epi::EpiSwiglu E{(bf16*)(P.ws + WS_HMID), DFFE, 11};
                TIMED(18, RUN_GEMM(epi::EpiSwiglu, MoeOrder, true, g, S, E));
            }
            SEAM(22);
            if (PH_ON(23) && IN(23)) {
                pg8::Gemm g{(const bf16*)(P.ws + WS_HMID), (const bf16*)(P.ws + WS_WM2), DFFE, DFFE, DFFE, nullptr}; const MoeOrder S = moe_order(P, 4, G, bx);
                epi::EpiMoeDown E{(bf16*)(P.ws + WS_MOEY), slot_gate};
                TIMED(19, RUN_GEMM(epi::EpiMoeDown, MoeOrder, false, g, S, E));
            }
            SEAM(23);
        }
        if (PH_ON(12) && IN(pc + 3)) {
            const int vcu_ = vcu_of();
            if (L == 0) TIMED(20, norm_plain(XSrc{nullptr, XR}, P.in[I_GPLE] + L * D, H, vcu_, G)); else TIMED(20, norm_moe_combine(P, P.in[I_GPLE] + L * D, vcu_, G));
            PANEL_FENCE();
            g128::PleProg PP; PP.pbf = (const bf16*)(P.ws + WS_PBF) + (size_t)L * NTOK * 256; PP.hp = (L == 0) ? H : (const bf16*)(P.ws + WS_H2); PP.wup = wmix(P, L, WM_UP); PP.wpg = wmix(P, L, WM_PG); PP.x = XR;
            TIMED(22, g128::stream<g128::PleProg>(lds, PP, NTOK / 128, vcu_, G));
            PANEL_FENCE();
            if (L == 0) TIMED(1, norm1_phase(P, 1, XSrc{nullptr, XR}, vcu_, G));
        }
        if (L == 0) SEAM(pc + 3);
    }
    if (PH_ON(26) && IN(25)) {
        const int vcu_ = vcu_of(); const int G_ = gridDim.x;
        for (int r = 0; r < (NTOK / 128 + G_ - 1) / G_; ++r) {
            const int u = vcu_ + r * G_; FinalRows FR;
            if (u < NTOK / 128) final_norm_load(P, u, FR);
            xcd_barrier(bar);
            if (u < NTOK / 128) final_norm_store(P, u, FR);
        }
    }
    if (PROBE_MASK || PROBE_SEAMS) { const unsigned long long t0_ = __builtin_amdgcn_s_memrealtime(); while (__builtin_amdgcn_s_memrealtime() - t0_ < (unsigned long long)PROBE_MULT * pacc) __builtin_amdgcn_s_sleep(8); }
#undef IN
#undef SEAM
#undef H
#undef ZIN
#undef GB
#undef MB
#undef MLAQ
#undef MLAKV
#undef KPER
#undef cosT
#undef sinT
#undef slot_tok
#undef slot_gate
}

extern "C" void kernel_launch(void* const* d_in, const int* in_sizes, int n_in, void* d_out, int out_size, void* d_ws, size_t ws_size, hipStream_t stream) {
    static int grid = 0;
    if (grid == 0) {
        if (n_in != 37 || out_size != NTOK * D || ws_size < WS_END) { fprintf(stderr, "kernel_launch: unexpected shapes: n_in %d out %d ws %zu\n", n_in, out_size, ws_size); grid = -1; return; }
        int dev = 0, cus = 0, per_cu = 0;
        if (hipGetDevice(&dev) != hipSuccess || hipDeviceGetAttribute(&cus, hipDeviceAttributeMultiprocessorCount, dev) != hipSuccess) { grid = -1; return; }
        if (hipFuncSetAttribute((const void*)mega_fwd, hipFuncAttributeMaxDynamicSharedMemorySize, LDS_BYTES) != hipSuccess) { fprintf(stderr, "kernel_launch: hipFuncSetAttribute failed\n"); grid = -1; return; }
        if (hipOccupancyMaxActiveBlocksPerMultiprocessor(&per_cu, (const void*)mega_fwd, NTHREADS, LDS_BYTES) != hipSuccess || per_cu < 1)
            fprintf(stderr, "kernel_launch: note: occupancy query reports %d workgroups per CU\n", per_cu);
        (void)hipGetLastError();
        grid = cus;
        if (grid != 256) fprintf(stderr, "kernel_launch: note: %d CUs (built for 256)\n", grid);
    }
    if (grid < 0) return;
    if (hipMemsetAsync((char*)d_ws + WS_CTL, 0, CTL_ZERO_BYTES, stream) != hipSuccess) return;
    Params p{};
    for (int i = 0; i < 37; ++i) p.in[i] = (const float*)d_in[i];
    p.out = (float*)d_out; p.ws = (unsigned char*)d_ws;
#if N_LAUNCH_MODE == 1
    p.ph_lo = 0; p.ph_hi = N_PHASES;
    hipLaunchKernelGGL(mega_fwd, dim3(grid), dim3(NTHREADS), LDS_BYTES, stream, p);
#else
    for (int ph = 0; ph < N_PHASES; ++ph) { p.ph_lo = ph; p.ph_hi = ph + 1; hipLaunchKernelGGL(mega_fwd, dim3(grid), dim3(NTHREADS), LDS_BYTES, stream, p); }
#endif
    const hipError_t le = hipPeekAtLastError();
    if (le != hipSuccess) fprintf(stderr, "kernel_launch: launch failed: %s\n", hipGetErrorName(le));
}
```

```cpp
#include <hip/hip_runtime.h>
#include <cstdio>
#include <cstdint>

#define GAS __attribute__((address_space(1)))
#define LAS __attribute__((address_space(3)))
typedef unsigned short bf16;
typedef short bf16x8 __attribute__((ext_vector_type(8)));
typedef short s16x4 __attribute__((ext_vector_type(4)));
typedef float f32x2 __attribute__((ext_vector_type(2)));
typedef float f32x4 __attribute__((ext_vector_type(4)));
typedef float f32x16 __attribute__((ext_vector_type(16)));
typedef unsigned u32x2 __attribute__((ext_vector_type(2)));
typedef unsigned u32x4 __attribute__((ext_vector_type(4)));
typedef __bf16 bf16x2_t __attribute__((ext_vector_type(2)));

constexpr int NB = 4, SEQ = 8192, NTOK = NB * SEQ, D = 1024;
constexpr int ZP = 2304;
constexpr int ZC_U = 0, ZC_FQ = 256, ZC_FK = 512, ZC_FV = 768, ZC_DQ = 1024, ZC_DK = 1280, ZC_DV = 1536, ZC_CQ = 1792, ZC_CKV = 2048, ZC_KPE = 2176;
constexpr int DIN = 2148, DFF = 2816, DFFE = 1408, NE = 8;
constexpr int MOE_ROWS = 2 * NTOK + NE * 256;
constexpr float RMS_EPS = 1e-6f;
constexpr int NWAVES = 8, NTHREADS = 512;

constexpr size_t MiB = 1u << 20;
constexpr size_t WS_CTL = 0, CTL_ZERO_BYTES = 1 * MiB;
constexpr size_t WS_COS = 1 * MiB, WS_SIN = 3 * MiB;
constexpr size_t WS_LOGF = 5 * MiB;
constexpr size_t WS_CDEC = 5 * MiB + 512 * 1024;
constexpr size_t WS_WSUM = 6 * MiB;
constexpr size_t WS_RSTDQ = 6 * MiB + 256 * 1024, WS_RSTDKV = 6 * MiB + 512 * 1024;
constexpr size_t WS_SC = 7 * MiB;
constexpr size_t WS_TOKINFO = 11 * MiB;
constexpr size_t WS_SLOTTOK = 12 * MiB, WS_SLOTGATE = 12 * MiB + 512 * 1024;
constexpr size_t WS_S5W = 13 * MiB;
constexpr size_t WS_PBF = 17 * MiB;
constexpr size_t WS_WMIX = 49 * MiB, WMIX_STRIDE = 20 * MiB;
constexpr size_t WM_IN = 0, WM_G = 4 * MiB + 512 * 1024, WM_B = 12 * MiB + 512 * 1024, WM_O = 14 * MiB + 512 * 1024, WM_PG = 16 * MiB + 512 * 1024,
                 WM_UP = 18 * MiB + 512 * 1024, WM_UQ = 19 * MiB, WM_UKV = 19 * MiB + 256 * 1024, WM_GLU = 19 * MiB + 384 * 1024;
constexpr size_t WS_W13 = 89 * MiB, WS_W2 = 100 * MiB;
constexpr size_t WS_H = 106 * MiB;
constexpr size_t WS_MLAQ = 170 * MiB, WS_MLAKV = 202 * MiB, WS_KPER = 234 * MiB;
constexpr size_t WS_M = 170 * MiB;
constexpr size_t WS_ZIN = 236 * MiB;
constexpr size_t WS_G = 380 * MiB;
constexpr size_t WS_HMID = 236 * MiB;
constexpr size_t WS_U = 236 * MiB;
constexpr size_t WS_WM13 = 418 * MiB, WS_WM2 = 462 * MiB;
constexpr size_t WS_MOEY = 89 * MiB;
constexpr size_t WS_H2 = 300 * MiB;
constexpr size_t WS_END = 484 * MiB;
constexpr int CW_BAR = 4096;
constexpr int CW_MOECNT = 16384;
constexpr int CW_QMAX = 20480;
constexpr int CW_KMAX = 22528;

#define LDS_WAIT() asm volatile("s_waitcnt lgkmcnt(0)" ::: "memory")
#define VM_WAIT() asm volatile("s_waitcnt vmcnt(0)" ::: "memory")
__device__ __forceinline__ unsigned f2bf(float f) { unsigned u = __builtin_bit_cast(unsigned, f); return (u + 0x7fffu + ((u >> 16) & 1u)) >> 16; }
__device__ __forceinline__ unsigned pk2(float lo, float hi) { f32x2 v = {lo, hi}; bf16x2_t b = __builtin_convertvector(v, bf16x2_t); return __builtin_bit_cast(unsigned, b); }
__device__ __forceinline__ float bf2f(unsigned short b) { return __uint_as_float((unsigned)b << 16); }
__device__ __forceinline__ float bflo(unsigned w) { return __uint_as_float(w << 16); }
__device__ __forceinline__ float bfhi(unsigned w) { return __uint_as_float(w & 0xffff0000u); }
constexpr int TID_TAB_OFF = 147456 - 512;
__device__ __forceinline__ unsigned hw_wave_key() { return (unsigned)__builtin_amdgcn_s_getreg((5 << 11) | 4) & 0x3Fu; }
__device__ __forceinline__ int my_tid() {
    unsigned addr = (unsigned)TID_TAB_OFF + 4u * hw_wave_key(); asm volatile("" : "+s"(addr));
    const int wave = __builtin_amdgcn_readfirstlane(*(const LAS int*)(uintptr_t)addr);
    int lane = (int)__builtin_amdgcn_mbcnt_hi(~0u, __builtin_amdgcn_mbcnt_lo(~0u, 0u)); asm volatile("" : "+v"(lane));
    return wave * 64 + lane;
}
__device__ __forceinline__ float shflx(float v, int o, int lane) { return __int_as_float(__builtin_amdgcn_ds_bpermute((lane ^ o) << 2, __float_as_int(v))); }
#define DPP_F(x_, ctrl_, rm_) __int_as_float(__builtin_amdgcn_update_dpp(0, __float_as_int(x_), (ctrl_), (rm_), 0xF, true))
__device__ __forceinline__ float wave_sum(float v) {
    v += DPP_F(v, 0xB1, 0xF); v += DPP_F(v, 0x4E, 0xF); v += DPP_F(v, 0x114, 0xF); v += DPP_F(v, 0x118, 0xF);
    v += DPP_F(v, 0x142, 0xA); v += DPP_F(v, 0x143, 0xC);
    return __int_as_float(__builtin_amdgcn_readlane(__float_as_int(v), 63));
}
__device__ __forceinline__ float sigmoidf_(float x) { return __builtin_amdgcn_rcpf(1.0f + __expf(-x)); }

struct XSrc { const float* f; const bf16* b; };
__device__ __forceinline__ f32x4 ldx4(const XSrc& x, size_t idx) {
    if (x.f) return *(const f32x4*)(x.f + idx);
    const u32x2 w = *(const u32x2*)(x.b + idx); return (f32x4){bflo(w.x), bfhi(w.x), bflo(w.y), bfhi(w.y)};
}
__device__ __forceinline__ bf16* xr_of(float* out) { return (bf16*)((unsigned char*)out + (size_t)NTOK * D * 2); }
#define BODY_IDS() int tid = my_tid(); asm volatile("" : "+v"(tid)); const int lane = tid & 63; const int wave = __builtin_amdgcn_readfirstlane(tid >> 6); \
    int grid_ = gridDim.x; asm volatile("" : "+s"(grid_)); \
    const int gw = blockIdx.x * NWAVES + wave, ngw = grid_ * NWAVES, gtid = blockIdx.x * NTHREADS + tid, gthreads = grid_ * NTHREADS; (void)lane; (void)wave; (void)gw; (void)ngw; (void)gtid; (void)gthreads
#define XB_TMO      128
#define XB_XCNT(j)  (256  + 64 * (j))
#define XB_XSUB(j)  (1280 + 64 * (j))
#define XB_XGEN(j)  (2304 + 64 * (j))
#define XB_TOP      3328
#define XB_TOPGEN   3392
#define XCD_BAR_WORDS 3456
#define XB_SPIN_CAP (1u << 22)

__device__ __forceinline__ unsigned xb_ld(unsigned* p)              { return __hip_atomic_load(p, __ATOMIC_RELAXED, __HIP_MEMORY_SCOPE_AGENT); }
__device__ __forceinline__ unsigned xb_add(unsigned* p, unsigned v) { return __hip_atomic_fetch_add(p, v, __ATOMIC_RELAXED, __HIP_MEMORY_SCOPE_AGENT); }
__device__ __forceinline__ unsigned xb_xcc_id() { return (unsigned)__builtin_amdgcn_s_getreg((3 << 11) | 20) & 0xFu; }
#define XB_SPIN(cond, bar) do { unsigned _sp = 0; while (cond) { __builtin_amdgcn_s_sleep(1); \
    if ((++_sp & 255u) == 0u) { if (xb_ld(&(bar)[XB_TMO])) break; if (_sp > XB_SPIN_CAP) { atomicAdd(&(bar)[XB_TMO], 1u); break; } } } } while (0)

struct XcdBarrier { unsigned* bar; unsigned x; volatile LAS unsigned* st; };

__device__ __forceinline__ XcdBarrier xcd_barrier_post(unsigned* bar, volatile LAS unsigned* st) {
    XcdBarrier b; b.bar = bar; b.x = xb_xcc_id(); b.st = st;
    if (my_tid() == 0) (void)xb_add(&bar[XB_XCNT(b.x)], 1u);
    return b;
}
__device__ __forceinline__ void xcd_barrier_complete(unsigned* bar, unsigned x, unsigned& nloc, unsigned& nx) {
    const unsigned G = gridDim.x * gridDim.y * gridDim.z;
    unsigned sum, cnt, mine, sp = 0u;
    for (;;) {
        sum = 0u; cnt = 0u; mine = 0u;
#pragma unroll
        for (unsigned j = 0; j < 16; ++j) { const unsigned c = xb_ld(&bar[XB_XCNT(j)]); sum += c; cnt += (c > 0u) ? 1u : 0u; mine = (j == x) ? c : mine; }
        if (sum == G) break;
        __builtin_amdgcn_s_sleep(1);
        if ((++sp & 255u) == 0u) { if (xb_ld(&bar[XB_TMO])) break; if (sp > XB_SPIN_CAP) { atomicAdd(&bar[XB_TMO], 1u); break; } }
    }
    nloc = mine > 0u ? mine : 1u; nx = cnt > 0u ? cnt : 1u;
}
__device__ __forceinline__ void xcd_barrier(const XcdBarrier& b) {
    asm volatile("s_waitcnt vmcnt(0)" ::: "memory");
    __syncthreads();
    if (my_tid() == 0) {
        unsigned* bar = b.bar;
        __builtin_amdgcn_s_waitcnt(0);
        unsigned nloc = b.st[0], nx = b.st[1];
        if (nloc == 0u) { xcd_barrier_complete(bar, b.x, nloc, nx); b.st[0] = nloc; b.st[1] = nx; }
        const unsigned old = xb_add(&bar[XB_XSUB(b.x)], 1u);
        const unsigned gen = old / nloc;
        if (old + 1u == (gen + 1u) * nloc) {
            __builtin_amdgcn_fence(__ATOMIC_RELEASE, "agent");
            asm volatile("s_waitcnt vmcnt(0)" ::: "memory");
            const unsigned og = xb_add(&bar[XB_TOP], 1u);
            const unsigned tg = og / nx;
            if (og + 1u == (tg + 1u) * nx) xb_add(&bar[XB_TOPGEN], 1u);
            else XB_SPIN(xb_ld(&bar[XB_TOPGEN]) == tg, bar);
            __builtin_amdgcn_fence(__ATOMIC_ACQUIRE, "agent");
            xb_add(&bar[XB_XGEN(b.x)], 1u);
            asm volatile("s_waitcnt vmcnt(0)" ::: "memory");
        } else {
            XB_SPIN(xb_ld(&bar[XB_XGEN(b.x)]) == gen, bar);
            __builtin_amdgcn_fence(__ATOMIC_ACQUIRE, "agent");
            asm volatile("s_waitcnt vmcnt(0)" ::: "memory");
        }
    }
    __syncthreads();
}
namespace pg8 {
constexpr int BM = 256, BK = 64, HALF = 128, HTB = HALF * BK * 2, STAGE_BYTES = 8 * HTB, NXCD = 8, WGM = 8;
__host__ __device__ __forceinline__ int lds_byte(int r, int c) { const int st = (r >> 4) * 2 + (c >> 5), rr = r & 15, cc = c & 31, ob = rr * 64 + cc * 2; return st * 1024 + (ob ^ (((ob >> 9) & 1) << 5)); }
__host__ __device__ __forceinline__ void stage_rc(int b, int& R, int& C) { const int st = b / 1024, sb = b % 1024, swz = sb ^ (((sb >> 9) & 1) << 5); R = (st >> 1) * 16 + swz / 64; C = (st & 1) * 32 + (swz % 64) / 2; }
__host__ __device__ __forceinline__ int perm32(int rho) { const int n = rho >> 4, i = rho & 15; return 8 * (i >> 2) + 4 * n + (i & 3); }

struct Unit { int pm, pn; };
struct Gemm { const bf16* A; const bf16* Bt; int lda, ldb, K; const int* gidx; };

struct StaticOrder {
    int nM, nN, nwg, G, c;
    __host__ __device__ void init(int M, int N, int G_, int c_) { nM = M / BM; nN = N / BM; nwg = nM * nN; G = G_; c = c_; }
    __host__ __device__ bool next(int i, Unit& u) const {
        const long L = (long)i * G + c; if (L >= nwg) return false;
        int wgid = (int)L; { const int q = nwg / NXCD, r = nwg % NXCD, xcd = wgid % NXCD, off = wgid / NXCD; wgid = (xcd < r ? xcd * (q + 1) : r * (q + 1) + (xcd - r) * q) + off; }
        const int nig = WGM * nN, gid = wgid / nig, fm = gid * WGM, gsz = (nM - fm) < WGM ? (nM - fm) : WGM;
        u.pm = fm + ((wgid % nig) % gsz); u.pn = (wgid % nig) / gsz; return true;
    }
};

template <class Epi, class Sched, bool ALIGN_EPI, bool GATHER>
__device__ __forceinline__ void gemm_phase(LAS unsigned char* lds, const Gemm g, const Sched& S, const Epi& E) {
    int tid = my_tid(); asm volatile("" : "+v"(tid));
    const int wid = __builtin_amdgcn_readfirstlane(tid >> 6), lane = tid & 63, wr = wid >> 2, wc = wid & 3, fr = lane & 15, fq = lane >> 4;
    int Kq = g.K; asm volatile("" : "+s"(Kq));
    const int K = Kq, nt = K / BK;
    int RA[2], CA[2];
    unsigned voffA[2], voffB[2];
#pragma unroll
    for (int i = 0; i < 2; ++i) { int R, C; stage_rc(tid * 16 + i * 8192, R, C); const int Rb = Epi::PERM ? ((R & ~31) + perm32(R & 31)) : R;
        RA[i] = R; CA[i] = C; voffA[i] = (unsigned)(R * g.lda + C) * 2u; voffB[i] = (unsigned)(Rb * g.ldb + C) * 2u; }
    const size_t kstep = (size_t)(BK * 2);
    const size_t hstepB = (size_t)HALF * g.ldb * 2, tstepB = 2 * hstepB;
    const size_t hstepA = (size_t)HALF * g.lda * 2, tstepA = 2 * hstepA;
    const unsigned ldsw = (unsigned)wid * 1024u;
    const int aoff = lds_byte(wr * 64 + fr, fq * 8), boff = lds_byte(wc * 32 + fr, fq * 8);
#define PG8_SA(b, h) (((b) * 2 + (h)) * HTB)
#define PG8_SB(b, h) ((4 + (b) * 2 + (h)) * HTB)
#define PG8_STAGEB(bufoff, gbase) do { _Pragma("unroll") for (int _i = 0; _i < 2; ++_i) \
        __builtin_amdgcn_global_load_lds((const unsigned*)((const char*)(gbase) + voffB[_i]), (LAS unsigned*)(lds + (bufoff) + ldsw + _i * 8192), 16, 0, 0); } while (0)
#define PG8_STAGEA(bufoff, kptr, isnext, h) do { _Pragma("unroll") for (int _i = 0; _i < 2; ++_i) { const char* _p; \
        if constexpr (GATHER) _p = (const char*)(kptr) + ((isnext) ? nvo[h][_i] : cvo[h][_i]); else _p = (const char*)(kptr) + (size_t)(h) * hstepA + voffA[_i]; \
        __builtin_amdgcn_global_load_lds((const unsigned*)_p, (LAS unsigned*)(lds + (bufoff) + ldsw + _i * 8192), 16, 0, 0); } } while (0)
#define PG8_LDA(dst, b, h) do { _Pragma("unroll") for (int m = 0; m < 4; ++m) _Pragma("unroll") for (int k = 0; k < 2; ++k) dst[m][k] = *(const LAS bf16x8*)(lds + PG8_SA(b, h) + aoff + m * 2048 + k * 1024); } while (0)
#define PG8_LDB(dst, b, h) do { _Pragma("unroll") for (int n = 0; n < 2; ++n) _Pragma("unroll") for (int k = 0; k < 2; ++k) dst[n][k] = *(const LAS bf16x8*)(lds + PG8_SB(b, h) + boff + n * 2048 + k * 1024); } while (0)
#define PG8_MMA(ai, bj, At, Bt) do { __builtin_amdgcn_s_setprio(1); _Pragma("unroll") for (int m = 0; m < 4; ++m) _Pragma("unroll") for (int n = 0; n < 2; ++n) _Pragma("unroll") for (int k = 0; k < 2; ++k) \
        acc[ai][bj][m][n] = __builtin_amdgcn_mfma_f32_16x16x32_bf16(Bt[n][k], At[m][k], acc[ai][bj][m][n], 0, 0, 0); __builtin_amdgcn_s_setprio(0); } while (0)
#define PG8_WAIT_V(n) asm volatile("s_waitcnt vmcnt(" #n ")" ::: "memory")
#define PG8_WAIT_L(n) asm volatile("s_waitcnt lgkmcnt(" #n ")" ::: "memory")
#define PG8_BAR __builtin_amdgcn_s_barrier()
#define PG8_SCHED __builtin_amdgcn_sched_barrier(0)
#define PG8_VOA(vo, u) do { _Pragma("unroll") for (int _h = 0; _h < 2; ++_h) _Pragma("unroll") for (int _i = 0; _i < 2; ++_i) { \
        int _row = (u).pm * BM + _h * HALF + RA[_i]; if (GATHER) { _row = g.gidx[_row]; _row = _row < 0 ? 0 : _row; } \
        (vo)[_h][_i] = (unsigned)_row * (unsigned)(g.lda * 2) + (unsigned)(CA[_i] * 2); } } while (0)
    Unit cur, nxt; int ui = 0;
    if (!S.next(0, cur)) return;
    f32x4 acc[2][2][4][2];
#pragma unroll
    for (int a = 0; a < 2; ++a)
#pragma unroll
        for (int b = 0; b < 2; ++b)
#pragma unroll
            for (int m = 0; m < 4; ++m)
#pragma unroll
                for (int n = 0; n < 2; ++n) acc[a][b][m][n] = (f32x4){0.f, 0.f, 0.f, 0.f};
    bf16x8 At[4][2], B0[2][2], B1[2][2];
    unsigned cvo[2][2], nvo[2][2];
    if constexpr (GATHER) { PG8_VOA(cvo, cur); PG8_VOA(nvo, cur); }
    const char* cA = (const char*)g.A + (GATHER ? (size_t)0 : (size_t)cur.pm * tstepA); const char* cB = (const char*)g.Bt + (size_t)cur.pn * tstepB;
    PG8_STAGEB(PG8_SB(0, 0), cB); PG8_STAGEB(PG8_SB(0, 1), cB + hstepB); PG8_STAGEA(PG8_SA(0, 0), cA, false, 0); PG8_STAGEA(PG8_SA(0, 1), cA, false, 1);
    if (wr == 1) PG8_BAR;
    PG8_WAIT_V(2); PG8_BAR;
    PG8_STAGEB(PG8_SB(1, 0), cB + kstep); PG8_STAGEA(PG8_SA(1, 0), cA + kstep, false, 0); PG8_STAGEB(PG8_SB(1, 1), cB + hstepB + kstep);
    PG8_WAIT_V(6); PG8_BAR;
    for (;;) {
        const bool has_next = S.next(ui + 1, nxt);
        if constexpr (GATHER) { if (has_next) { PG8_VOA(nvo, nxt); } }
        const char* nA = (GATHER || !has_next) ? cA : (const char*)g.A + (size_t)nxt.pm * tstepA;
        const char* nB = has_next ? (const char*)g.Bt + (size_t)nxt.pn * tstepB : cB;
#pragma nounroll
        for (int t = 0; t < nt; t += 2) {
            const bool last = (t == nt - 2);
            const char* a1 = cA + (size_t)(t + 1) * kstep;
            const char* a2 = last ? nA : cA + (size_t)(t + 2) * kstep; const char* b2 = last ? nB : cB + (size_t)(t + 2) * kstep;
            const char* a3 = a2 + kstep; const char* b3 = b2 + kstep;
            PG8_LDB(B0, 0, 0); PG8_LDB(B1, 0, 1); PG8_SCHED; PG8_LDA(At, 0, 0); PG8_STAGEA(PG8_SA(1, 1), a1, false, 1);
            PG8_WAIT_V(8); PG8_WAIT_L(0); PG8_BAR; PG8_MMA(0, 0, At, B0); PG8_MMA(0, 1, At, B1); PG8_BAR; PG8_SCHED;
            PG8_LDA(At, 0, 1); PG8_STAGEB(PG8_SB(0, 0), b2); PG8_STAGEB(PG8_SB(0, 1), b2 + hstepB); PG8_STAGEA(PG8_SA(0, 0), a2, last, 0);
            PG8_WAIT_V(8); PG8_WAIT_L(0); PG8_BAR; PG8_MMA(1, 0, At, B0); PG8_MMA(1, 1, At, B1); PG8_BAR; PG8_SCHED;
            PG8_LDB(B0, 1, 0); PG8_LDB(B1, 1, 1); PG8_SCHED; PG8_LDA(At, 1, 0); PG8_STAGEA(PG8_SA(0, 1), a2, last, 1);
            PG8_WAIT_V(8); PG8_WAIT_L(0); PG8_BAR; PG8_MMA(0, 0, At, B0); PG8_MMA(0, 1, At, B1); PG8_BAR; PG8_SCHED;
            PG8_LDA(At, 1, 1); PG8_STAGEB(PG8_SB(1, 0), b3); PG8_STAGEB(PG8_SB(1, 1), b3 + hstepB); PG8_STAGEA(PG8_SA(1, 0), a3, last, 0);
            PG8_WAIT_V(8); PG8_WAIT_L(0); PG8_BAR; PG8_MMA(1, 0, At, B0); PG8_MMA(1, 1, At, B1); PG8_BAR; PG8_SCHED;
        }
        if constexpr (ALIGN_EPI) { if (wr == 0) PG8_BAR; }
        E(acc, cur, wr, wc, fr, fq);
        if (!has_next) break;
#pragma unroll
        for (int a = 0; a < 2; ++a)
#pragma unroll
            for (int b = 0; b < 2; ++b)
#pragma unroll
                for (int m = 0; m < 4; ++m)
#pragma unroll
                    for (int n = 0; n < 2; ++n) acc[a][b][m][n] = (f32x4){0.f, 0.f, 0.f, 0.f};
        cur = nxt; cA = nA; cB = nB; ++ui;
        if constexpr (GATHER) {
#pragma unroll
            for (int _h = 0; _h < 2; ++_h)
#pragma unroll
                for (int _i = 0; _i < 2; ++_i) cvo[_h][_i] = nvo[_h][_i]; }
        if constexpr (ALIGN_EPI) { if (wr == 1) PG8_BAR; }
    }
    PG8_WAIT_V(0);
    if constexpr (!ALIGN_EPI) { if (wr == 0) PG8_BAR; }
    PG8_BAR;
#undef PG8_SA
#undef PG8_SB
#undef PG8_STAGEA
#undef PG8_STAGEB
#undef PG8_LDA
#undef PG8_LDB
#undef PG8_MMA
#undef PG8_WAIT_V
#undef PG8_WAIT_L
#undef PG8_BAR
#undef PG8_SCHED
#undef PG8_VOA
}

template <class Epi, class Sched, bool GATHER>
__device__ __forceinline__ void gemm_phase_naive(const Gemm g, const Sched& S, const Epi& E) {
    const int tid = threadIdx.x, wid = tid >> 6, lane = tid & 63, wr = wid >> 2, wc = wid & 3, fr = lane & 15, fq = lane >> 4;
    Unit u;
    for (int ui = 0; S.next(ui, u); ++ui) {
        f32x4 acc[2][2][4][2];
#pragma unroll
        for (int a = 0; a < 2; ++a)
#pragma unroll
            for (int b = 0; b < 2; ++b)
#pragma unroll
                for (int m = 0; m < 4; ++m)
#pragma unroll
                    for (int n = 0; n < 2; ++n) acc[a][b][m][n] = (f32x4){0.f, 0.f, 0.f, 0.f};
        const bf16* arow[2][4];
#pragma unroll
        for (int ai = 0; ai < 2; ++ai)
#pragma unroll
            for (int m = 0; m < 4; ++m) { int r = u.pm * BM + ai * HALF + wr * 64 + m * 16 + fr; if (GATHER) { r = g.gidx[r]; r = r < 0 ? 0 : r; } arow[ai][m] = g.A + (size_t)r * g.lda; }
        for (int k = 0; k < g.K; k += 4) {
            float av[2][4][4];
#pragma unroll
            for (int ai = 0; ai < 2; ++ai)
#pragma unroll
                for (int m = 0; m < 4; ++m) { const u32x2 w = *(const u32x2*)(arow[ai][m] + k); av[ai][m][0] = bflo(w.x); av[ai][m][1] = bfhi(w.x); av[ai][m][2] = bflo(w.y); av[ai][m][3] = bfhi(w.y); }
#pragma unroll
            for (int bj = 0; bj < 2; ++bj)
#pragma unroll
                for (int n = 0; n < 2; ++n)
#pragma unroll
                    for (int e = 0; e < 4; ++e) {
                        const int col = u.pn * BM + bj * HALF + wc * 32 + (Epi::PERM ? (8 * fq + 4 * n) : (16 * n + 4 * fq)) + e;
                        const u32x2 w = *(const u32x2*)(g.Bt + (size_t)col * g.ldb + k);
                        const float b0 = bflo(w.x), b1 = bfhi(w.x), b2 = bflo(w.y), b3 = bfhi(w.y);
#pragma unroll
                        for (int ai = 0; ai < 2; ++ai)
#pragma unroll
                            for (int m = 0; m < 4; ++m) acc[ai][bj][m][n][e] += av[ai][m][0] * b0 + av[ai][m][1] * b1 + av[ai][m][2] * b2 + av[ai][m][3] * b3;
                    }
        }
        E(acc, u, wr, wc, fr, fq);
    }
    VM_WAIT(); __syncthreads();
}
}
namespace g128 {
using pg8::lds_byte; using pg8::stage_rc; using pg8::HTB; using pg8::BK;
struct Seg { const bf16* A; const bf16* B; int lda, ldb, nt; };
typedef f32x4 acc_t[2][4][2];

template <class Prog>
__device__ __forceinline__ void stream(LAS unsigned char* lds, Prog& P, int nunits, int first, int stride) {
    int tid = my_tid(); asm volatile("" : "+v"(tid));
    const int wid = __builtin_amdgcn_readfirstlane(tid >> 6), lane = tid & 63, wr = wid >> 2, wc = wid & 3, fr = lane & 15, fq = lane >> 4;
    int RA[2], CA[2], RB[2];
#pragma unroll
    for (int i = 0; i < 2; ++i) { stage_rc(tid * 16 + i * 8192, RA[i], CA[i]); RB[i] = (RA[i] & ~31) + pg8::perm32(RA[i] & 31); }
    const unsigned ldsw = (unsigned)wid * 1024u;
    const int aoff = lds_byte(wr * 64 + fr, fq * 8), boff = lds_byte(wc * 32 + fr, fq * 8);
#define G_SA(b) ((b) * HTB)
#define G_SB(b, h) ((2 + (b) * 2 + (h)) * HTB)
#define G_STAGE(bufoff, base, ld, kbyte, RR) do { _Pragma("unroll") for (int _i = 0; _i < 2; ++_i) \
        __builtin_amdgcn_global_load_lds((const unsigned*)((const char*)(base) + (size_t)(kbyte) + (unsigned)(RR[_i] * (ld) + CA[_i]) * 2u), (LAS unsigned*)(lds + (bufoff) + ldsw + _i * 8192), 16, 0, 0); } while (0)
#define G_STAGE_A(b, S, j) G_STAGE(G_SA(b), (S).A, (S).lda, (j) * 128, RA)
#define G_STAGE_B(b, h, S, j) G_STAGE(G_SB(b, h), (const char*)(S).B + (size_t)(h) * 128 * (S).ldb * 2, (S).ldb, (j) * 128, RB)
#define G_LDA(dst, b) do { _Pragma("unroll") for (int m = 0; m < 4; ++m) _Pragma("unroll") for (int k = 0; k < 2; ++k) dst[m][k] = *(const LAS bf16x8*)(lds + G_SA(b) + aoff + m * 2048 + k * 1024); } while (0)
#define G_LDB(dst, b, h) do { _Pragma("unroll") for (int n = 0; n < 2; ++n) _Pragma("unroll") for (int k = 0; k < 2; ++k) dst[n][k] = *(const LAS bf16x8*)(lds + G_SB(b, h) + boff + n * 2048 + k * 1024); } while (0)
#define G_MMA(bj, At, Bt) do { __builtin_amdgcn_s_setprio(1); _Pragma("unroll") for (int m = 0; m < 4; ++m) _Pragma("unroll") for (int n = 0; n < 2; ++n) _Pragma("unroll") for (int k = 0; k < 2; ++k) \
        acc[bj][m][n] = __builtin_amdgcn_mfma_f32_16x16x32_bf16(Bt[n][k], At[m][k], acc[bj][m][n], 0, 0, 0); __builtin_amdgcn_s_setprio(0); } while (0)
#define G_WAIT_V(n) asm volatile("s_waitcnt vmcnt(" #n ")" ::: "memory")
#define G_WAIT_L(n) asm volatile("s_waitcnt lgkmcnt(" #n ")" ::: "memory")
#define G_BAR __builtin_amdgcn_s_barrier()
#define G_SCHED __builtin_amdgcn_sched_barrier(0)
    if (first >= nunits) return;
    P.reset();
    int ucur = first, scur = 0;
    Seg cur, nxt;
    P.seg(ucur, scur, cur);
    acc_t acc;
    P.init(ucur, scur, acc, wr, wc, fr, fq);
    bf16x8 At[4][2], B0[2][2], B1[2][2];
    G_STAGE_B(0, 0, cur, 0); G_STAGE_A(0, cur, 0); G_STAGE_B(0, 1, cur, 0);
    if (wr == 1) G_BAR;
    G_WAIT_V(2); G_BAR;
    G_STAGE_A(1, cur, 1); G_STAGE_B(1, 0, cur, 1);
    G_WAIT_V(4); G_BAR;
#define G_TILE(t_, b_) do { const bool n1_ = ((t_) + 1 >= nt), n2_ = ((t_) + 2 >= nt); const int j1_ = n1_ ? ((t_) + 1 - nt) : ((t_) + 1), j2_ = n2_ ? ((t_) + 2 - nt) : ((t_) + 2); \
        G_LDB(B0, b_, 0); G_SCHED; G_LDA(At, b_); \
        if (n1_) G_STAGE_B((b_) ^ 1, 1, nxt, j1_); else G_STAGE_B((b_) ^ 1, 1, cur, j1_); \
        G_WAIT_V(6); G_WAIT_L(0); G_BAR; G_MMA(0, At, B0); G_BAR; G_SCHED; \
        G_LDB(B1, b_, 1); \
        if (n2_) { G_STAGE_A(b_, nxt, j2_); G_STAGE_B(b_, 0, nxt, j2_); } else { G_STAGE_A(b_, cur, j2_); G_STAGE_B(b_, 0, cur, j2_); } \
        G_WAIT_V(6); G_WAIT_L(0); G_BAR; G_MMA(1, At, B1); G_BAR; G_SCHED; } while (0)
    for (;;) {
        int unxt = ucur, snxt = scur + 1; bool more = true;
        if (snxt == Prog::NSEG) { snxt = 0; unxt = ucur + stride; if (unxt >= nunits) { more = false; unxt = ucur; snxt = scur; } }
        P.seg(unxt, snxt, nxt);
        int ntq = cur.nt; asm volatile("" : "+s"(ntq)); const int nt = ntq;
#pragma nounroll
        for (int t = 0; t < nt; t += 2) { G_TILE(t, 0); G_TILE(t + 1, 1); }
        P.done(ucur, scur, acc, wr, wc, fr, fq);
        if (!more) break;
        P.init(unxt, snxt, acc, wr, wc, fr, fq);
        ucur = unxt; scur = snxt; cur = nxt;
    }
    G_WAIT_V(0);
    if (wr == 0) G_BAR;
    G_BAR;
#undef G_SA
#undef G_SB
#undef G_STAGE
#undef G_STAGE_A
#undef G_STAGE_B
#undef G_LDA
#undef G_LDB
#undef G_MMA
#undef G_WAIT_V
#undef G_WAIT_L
#undef G_BAR
#undef G_SCHED
#undef G_TILE
}

struct MergeProg {
    static constexpr int NSEG = 8;
    const bf16* Hn; const bf16* zin; const bf16* wg; const bf16* wb; const float* bg; bf16* M;
    __device__ __forceinline__ void reset() {
#pragma unroll
        for (int a = 0; a < 2; ++a)
#pragma unroll
            for (int b = 0; b < 4; ++b)
#pragma unroll
                for (int c = 0; c < 2; ++c) { g[a][b][c] = (u32x2){0u, 0u}; macc[a][b][c] = (u32x2){0u, 0u}; } }
    u32x2 g[2][4][2]; u32x2 macc[2][4][2];
    __device__ __forceinline__ void seg(int u, int s, Seg& S) const {
        const int pm = u >> 2, pn = u & 3, k = s >> 1;
        if ((s & 1) == 0) { S.A = Hn + (size_t)pm * 128 * D; S.lda = D; S.B = wg + ((size_t)k * D + pn * 256) * D; S.ldb = D; S.nt = D / 64; }
        else { const int ycol = (k == 0) ? ZC_U : (k == 1) ? ZC_FQ : (k == 2) ? ZC_CQ : ZC_DQ;
               S.A = zin + (size_t)pm * 128 * ZP + ycol; S.lda = ZP; S.B = wb + ((size_t)k * D + pn * 256) * 256; S.ldb = 256; S.nt = 4; }
    }
    __device__ __forceinline__ void init(int u, int s, acc_t& acc, int wr, int wc, int fr, int fq) {
        const int pn = u & 3, k = s >> 1;
        if ((s & 1) == 0) {
#pragma unroll
            for (int bj = 0; bj < 2; ++bj)
#pragma unroll
                for (int n = 0; n < 2; ++n) { const f32x4 bv = *(const f32x4*)(bg + (size_t)k * D + pn * 256 + bj * 128 + wc * 32 + 8 * fq + 4 * n);
#pragma unroll
                    for (int m = 0; m < 4; ++m) acc[bj][m][n] = bv; }
            if (s == 0) {
#pragma unroll
                for (int bj = 0; bj < 2; ++bj)
#pragma unroll
                    for (int m = 0; m < 4; ++m)
#pragma unroll
                        for (int n = 0; n < 2; ++n) macc[bj][m][n] = (u32x2){0u, 0u}; }
        } else {
#pragma unroll
            for (int bj = 0; bj < 2; ++bj)
#pragma unroll
                for (int m = 0; m < 4; ++m)
#pragma unroll
                    for (int n = 0; n < 2; ++n) acc[bj][m][n] = (f32x4){0.f, 0.f, 0.f, 0.f};
        }
    }
    __device__ __forceinline__ void done(int u, int s, const acc_t& acc, int wr, int wc, int fr, int fq) {
        if ((s & 1) == 0) {
#pragma unroll
            for (int bj = 0; bj < 2; ++bj)
#pragma unroll
                for (int m = 0; m < 4; ++m)
#pragma unroll
                    for (int n = 0; n < 2; ++n) { const f32x4 a = acc[bj][m][n]; u32x2 w; w.x = pk2(sigmoidf_(a[0]), sigmoidf_(a[1])); w.y = pk2(sigmoidf_(a[2]), sigmoidf_(a[3])); g[bj][m][n] = w; }
        } else {
#pragma unroll
            for (int bj = 0; bj < 2; ++bj)
#pragma unroll
                for (int m = 0; m < 4; ++m)
#pragma unroll
                    for (int n = 0; n < 2; ++n) { const u32x2 w = g[bj][m][n], q = macc[bj][m][n]; const f32x4 v = (f32x4){bflo(q.x), bfhi(q.x), bflo(q.y), bfhi(q.y)} + (f32x4){bflo(w.x), bfhi(w.x), bflo(w.y), bfhi(w.y)} * acc[bj][m][n];
                        u32x2 r; r.x = pk2(v[0], v[1]); r.y = pk2(v[2], v[3]); macc[bj][m][n] = r; }
            if (s == NSEG - 1) { const int pm = u >> 2, pn = u & 3;
#pragma unroll
                for (int m = 0; m < 4; ++m) { bf16* rp = M + (size_t)(pm * 128 + wr * 64 + m * 16 + fr) * D + pn * 256 + wc * 32 + 8 * fq;
#pragma unroll
                    for (int bj = 0; bj < 2; ++bj) *(u32x4*)(rp + bj * 128) = (u32x4){macc[bj][m][0].x, macc[bj][m][0].y, macc[bj][m][1].x, macc[bj][m][1].y}; } }
        }
    }
};

struct PleProg {
    static constexpr int NSEG = 8;
    const bf16* pbf; const bf16* hp; const bf16* wup; const bf16* wpg; bf16* x;
    u32x2 uu[2][4][2];
    __device__ __forceinline__ void reset() {
#pragma unroll
        for (int a = 0; a < 2; ++a)
#pragma unroll
            for (int b = 0; b < 4; ++b)
#pragma unroll
                for (int c = 0; c < 2; ++c) uu[a][b][c] = (u32x2){0u, 0u}; }
    __device__ __forceinline__ void seg(int u, int s, Seg& S) const {
        const int pn = s >> 1;
        if ((s & 1) == 0) { S.A = pbf + (size_t)u * 128 * 256; S.lda = 256; S.B = wup + (size_t)pn * 256 * 256; S.ldb = 256; S.nt = 4; }
        else { S.A = hp + (size_t)u * 128 * D; S.lda = D; S.B = wpg + (size_t)pn * 256 * D; S.ldb = D; S.nt = D / 64; }
    }
    __device__ __forceinline__ void init(int u, int s, acc_t& acc, int wr, int wc, int fr, int fq) {
#pragma unroll
        for (int bj = 0; bj < 2; ++bj)
#pragma unroll
            for (int m = 0; m < 4; ++m)
#pragma unroll
                for (int n = 0; n < 2; ++n) acc[bj][m][n] = (f32x4){0.f, 0.f, 0.f, 0.f};
    }
    __device__ __forceinline__ void done(int u, int s, const acc_t& acc, int wr, int wc, int fr, int fq) {
        if ((s & 1) == 0) {
#pragma unroll
            for (int bj = 0; bj < 2; ++bj)
#pragma unroll
                for (int m = 0; m < 4; ++m)
#pragma unroll
                    for (int n = 0; n < 2; ++n) { const f32x4 a = acc[bj][m][n]; u32x2 w; w.x = pk2(a[0], a[1]); w.y = pk2(a[2], a[3]); uu[bj][m][n] = w; }
        } else { const int pn = s >> 1;
#pragma unroll
            for (int m = 0; m < 4; ++m) { bf16* rp = x + (size_t)(u * 128 + wr * 64 + m * 16 + fr) * D + pn * 256 + wc * 32 + 8 * fq; u32x4 xv[2];
#pragma unroll
                for (int bj = 0; bj < 2; ++bj) xv[bj] = *(const u32x4*)(rp + bj * 128);
#pragma unroll
                for (int bj = 0; bj < 2; ++bj) { const u32x4 xw = xv[bj]; f32x4 r[2];
#pragma unroll
                    for (int n = 0; n < 2; ++n) { const u32x2 w = uu[bj][m][n]; f32x4 v = acc[bj][m][n];
                        v[0] = sigmoidf_(v[0]); v[1] = sigmoidf_(v[1]); v[2] = sigmoidf_(v[2]); v[3] = sigmoidf_(v[3]);
                        const f32x4 xo = n == 0 ? (f32x4){bflo(xw.x), bfhi(xw.x), bflo(xw.y), bfhi(xw.y)} : (f32x4){bflo(xw.z), bfhi(xw.z), bflo(xw.w), bfhi(xw.w)};
                        r[n] = xo + (f32x4){bflo(w.x), bfhi(w.x), bflo(w.y), bfhi(w.y)} * v; }
                    *(u32x4*)(rp + bj * 128) = (u32x4){pk2(r[0][0], r[0][1]), pk2(r[0][2], r[0][3]), pk2(r[1][0], r[1][1]), pk2(r[1][2], r[1][3])}; } } }
    }
};
}
namespace epi {
using pg8::Unit; using pg8::BM; using pg8::HALF;
__device__ __forceinline__ void epi_fence() { asm volatile("" ::: "memory"); }
#define EPI_FENCE epi_fence()
#define EPI_LOOP_ROWS for (int ai = 0; ai < 2; ++ai) _Pragma("unroll") for (int m = 0; m < 4; ++m)
#define EPI_LOOP_COLS for (int bj = 0; bj < 2; ++bj) _Pragma("unroll") for (int n = 0; n < 2; ++n)
#define EPI_ROW (u.pm * BM + ai * HALF + wr * 64 + m * 16 + fr)
#define EPI_COLT (bj * HALF + wc * 32 + n * 16 + 4 * fq)
typedef f32x4 acc_t[2][2][4][2];
#define EPI_C8(bj_) ((bj_) * HALF + wc * 32 + 8 * fq)
__device__ __forceinline__ u32x4 pack8(f32x4 a, f32x4 b) { return (u32x4){pk2(a[0], a[1]), pk2(a[2], a[3]), pk2(b[0], b[1]), pk2(b[2], b[3])}; }
__device__ __forceinline__ u32x2 pack4(f32x4 v) { u32x2 w; w.x = pk2(v[0], v[1]); w.y = pk2(v[2], v[3]); return w; }
__device__ __forceinline__ f32x4 unpack4(u32x2 w) { return (f32x4){bflo(w.x), bfhi(w.x), bflo(w.y), bfhi(w.y)}; }

struct EpiStore {
    static constexpr bool PERM = true;
    bf16* O; int ldc; int pn0;
    __device__ __forceinline__ void operator()(const acc_t& acc, const Unit& u, int wr, int wc, int fr, int fq) const {
#pragma unroll
        EPI_LOOP_ROWS { bf16* rp = O + (size_t)EPI_ROW * ldc + (u.pn - pn0) * BM + wc * 32 + 8 * fq;
#pragma unroll
            for (int bj = 0; bj < 2; ++bj) { const u32x2 lo = pack4(acc[ai][bj][m][0]), hi = pack4(acc[ai][bj][m][1]); *(u32x4*)(rp + bj * HALF) = (u32x4){lo.x, lo.y, hi.x, hi.y}; } }
    }
};
struct EpiRowScale {
    static constexpr bool PERM = true;
    bf16* O; int ldc; const float* rs;
    __device__ __forceinline__ void operator()(const acc_t& acc, const Unit& u, int wr, int wc, int fr, int fq) const {
        float sv[2][4];
#pragma unroll
        EPI_LOOP_ROWS sv[ai][m] = rs[EPI_ROW];
#pragma unroll
        EPI_LOOP_ROWS { const int row = EPI_ROW; const float s = sv[ai][m]; bf16* rp = O + (size_t)row * ldc + u.pn * BM;
#pragma unroll
            for (int bj = 0; bj < 2; ++bj) *(u32x4*)(rp + EPI_C8(bj)) = pack8(acc[ai][bj][m][0] * s, acc[ai][bj][m][1] * s); }
    }
};
struct EpiMlaQ {
    static constexpr bool PERM = false;
    bf16* O; const float* rs; const float* cosT; const float* sinT;
    __device__ __forceinline__ void operator()(const acc_t& acc, const Unit& u, int wr, int wc, int fr, int fq) const {
        float sv[2][4]; f32x4 csv[2], snv[2];
#pragma unroll
        EPI_LOOP_ROWS sv[ai][m] = rs[EPI_ROW];
        { const int row = u.pm * BM + wr * 64 + fr; csv[0] = *(const f32x4*)(cosT + (size_t)row * 16 + 4 * fq); snv[0] = *(const f32x4*)(sinT + (size_t)row * 16 + 4 * fq); }
#pragma unroll
        for (int it = 0; it < 8; ++it) { const int ai = it >> 2, m = it & 3;
            if (it + 1 < 8) { const int row = u.pm * BM + ((it + 1) >> 2) * HALF + wr * 64 + ((it + 1) & 3) * 16 + fr;
                csv[(it + 1) & 1] = *(const f32x4*)(cosT + (size_t)row * 16 + 4 * fq); snv[(it + 1) & 1] = *(const f32x4*)(sinT + (size_t)row * 16 + 4 * fq); }
            const int row = EPI_ROW; const float s = sv[ai][m]; bf16* rp = O + (size_t)row * 512 + u.pn * BM;
            const f32x4 cs = csv[it & 1], sn = snv[it & 1];
#pragma unroll
            for (int bj = 0; bj < 2; ++bj) { const int grp = u.pn * 8 + bj * 4 + wc;
                f32x4 t1 = acc[ai][bj][m][0] * s, t2 = acc[ai][bj][m][1] * s;
                if (grp % 3 == 2) { const f32x4 a = t1 * cs - t2 * sn, b = t2 * cs + t1 * sn; t1 = a; t2 = b; }
                *(u32x2*)(rp + bj * HALF + wc * 32 + 4 * fq) = pack4(t1); *(u32x2*)(rp + bj * HALF + wc * 32 + 16 + 4 * fq) = pack4(t2); } }
    }
};
struct EpiGate {
    static constexpr bool PERM = false;
    bf16* G; const float* bias;
    __device__ __forceinline__ void operator()(const acc_t& acc, const Unit& u, int wr, int wc, int fr, int fq) const {
        f32x4 bv[2][2];
#pragma unroll
        EPI_LOOP_COLS bv[bj][n] = *(const f32x4*)(bias + u.pn * BM + EPI_COLT);
#pragma unroll
        EPI_LOOP_ROWS { bf16* rp = G + (size_t)EPI_ROW * D + u.pn * BM;
#pragma unroll
            EPI_LOOP_COLS { f32x4 v = acc[ai][bj][m][n] + bv[bj][n];
                v[0] = sigmoidf_(v[0]); v[1] = sigmoidf_(v[1]); v[2] = sigmoidf_(v[2]); v[3] = sigmoidf_(v[3]);
                *(u32x2*)(rp + EPI_COLT) = pack4(v); } }
    }
};
#define EPI_IT_ROW(it_) (u.pm * BM + ((it_) >> 2) * HALF + wr * 64 + ((it_) & 3) * 16 + fr)
#define EPI_C4(c_) (((c_) >> 1) * HALF + wc * 32 + ((c_) & 1) * 16 + 4 * fq)
struct EpiMerge {
    static constexpr bool PERM = false;
    const bf16* G; bf16* M; int first;
    __device__ __forceinline__ void operator()(const acc_t& acc, const Unit& u, int wr, int wc, int fr, int fq) const {
        u32x2 gv[2][4], mv[2][4];
#define EPI_LD(it_) do { const size_t ro_ = (size_t)EPI_IT_ROW(it_) * D + u.pn * BM; _Pragma("unroll") for (int c = 0; c < 4; ++c) { gv[(it_) & 1][c] = *(const u32x2*)(G + ro_ + EPI_C4(c)); \
            mv[(it_) & 1][c] = first ? (u32x2){0u, 0u} : *(const u32x2*)(M + ro_ + EPI_C4(c)); } } while (0)
        EPI_LD(0);
#pragma unroll
        for (int it = 0; it < 8; ++it) { if (it + 1 < 8) EPI_LD(it + 1);
            const size_t ro = (size_t)EPI_IT_ROW(it) * D + u.pn * BM;
#pragma unroll
            for (int c = 0; c < 4; ++c) { const f32x4 v = unpack4(gv[it & 1][c]) * acc[it >> 2][c >> 1][it & 3][c & 1] + unpack4(mv[it & 1][c]); *(u32x2*)(M + ro + EPI_C4(c)) = pack4(v); } }
#undef EPI_LD
    }
};
struct EpiRes {
    static constexpr bool PERM = true;
    XSrc xin; bf16* xout;
    __device__ __forceinline__ void operator()(const acc_t& acc, const Unit& u, int wr, int wc, int fr, int fq) const {
        f32x4 xv[2][2][2];
#define EPI_LD(it_) do { const size_t ro_ = (size_t)EPI_IT_ROW(it_) * D + u.pn * BM; _Pragma("unroll") for (int bj = 0; bj < 2; ++bj) { \
            if (xin.f) { xv[(it_) & 1][bj][0] = *(const f32x4*)(xin.f + ro_ + EPI_C8(bj)); xv[(it_) & 1][bj][1] = *(const f32x4*)(xin.f + ro_ + EPI_C8(bj) + 4); } \
            else { const u32x4 w_ = *(const u32x4*)(xin.b + ro_ + EPI_C8(bj)); xv[(it_) & 1][bj][0] = (f32x4){bflo(w_.x), bfhi(w_.x), bflo(w_.y), bfhi(w_.y)}; xv[(it_) & 1][bj][1] = (f32x4){bflo(w_.z), bfhi(w_.z), bflo(w_.w), bfhi(w_.w)}; } } } while (0)
        EPI_LD(0);
#pragma unroll
        for (int it = 0; it < 8; ++it) { if (it + 1 < 8) EPI_LD(it + 1);
            const size_t ro = (size_t)EPI_IT_ROW(it) * D + u.pn * BM;
#pragma unroll
            for (int bj = 0; bj < 2; ++bj) *(u32x4*)(xout + ro + EPI_C8(bj)) = pack8(xv[it & 1][bj][0] + acc[it >> 2][bj][it & 3][0], xv[it & 1][bj][1] + acc[it >> 2][bj][it & 3][1]); }
#undef EPI_LD
    }
};
struct EpiPle {
    static constexpr bool PERM = false;
    const bf16* U; float* x;
    __device__ __forceinline__ void operator()(const acc_t& acc, const Unit& u, int wr, int wc, int fr, int fq) const {
        f32x4 xv[2][4]; u32x2 uv[2][4];
#define EPI_LD(it_) do { const size_t ro_ = (size_t)EPI_IT_ROW(it_) * D + u.pn * BM; _Pragma("unroll") for (int c = 0; c < 4; ++c) { xv[(it_) & 1][c] = *(const f32x4*)(x + ro_ + EPI_C4(c)); uv[(it_) & 1][c] = *(const u32x2*)(U + ro_ + EPI_C4(c)); } } while (0)
        EPI_LD(0);
#pragma unroll
        for (int it = 0; it < 8; ++it) { if (it + 1 < 8) EPI_LD(it + 1);
            const size_t ro = (size_t)EPI_IT_ROW(it) * D + u.pn * BM;
#pragma unroll
            for (int c = 0; c < 4; ++c) { f32x4 v = acc[it >> 2][c >> 1][it & 3][c & 1];
                v[0] = sigmoidf_(v[0]); v[1] = sigmoidf_(v[1]); v[2] = sigmoidf_(v[2]); v[3] = sigmoidf_(v[3]);
                *(f32x4*)(x + ro + EPI_C4(c)) = xv[it & 1][c] + unpack4(uv[it & 1][c]) * v; } }
#undef EPI_LD
    }
};
struct EpiSwiglu {
    static constexpr bool PERM = true;
    bf16* O; int ldc; int npt;
    __device__ __forceinline__ void operator()(const acc_t& acc, const Unit& u, int wr, int wc, int fr, int fq) const {
        const int ct = (u.pn % npt) * HALF;
#pragma unroll
        EPI_LOOP_ROWS { bf16* rp = O + (size_t)EPI_ROW * ldc + ct + wc * 32 + 8 * fq; u32x2 w[2];
#pragma unroll
            for (int n = 0; n < 2; ++n) { const f32x4 a = acc[ai][0][m][n], b = acc[ai][1][m][n]; f32x4 v;
#pragma unroll
                for (int e = 0; e < 4; ++e) v[e] = a[e] * sigmoidf_(a[e]) * b[e];
                w[n] = pack4(v); }
            *(u32x4*)rp = (u32x4){w[0].x, w[0].y, w[1].x, w[1].y}; }
    }
};
struct EpiGlu {
    static constexpr bool PERM = true;
    bf16* Y; int ldc;
    __device__ __forceinline__ void operator()(const acc_t& acc, const Unit& u, int wr, int wc, int fr, int fq) const {
        u32x4 yv[2][2];
#define EPI_LD(it_) do { const bf16* rp_ = Y + (size_t)EPI_IT_ROW(it_) * ldc + u.pn * BM; _Pragma("unroll") for (int bj = 0; bj < 2; ++bj) yv[(it_) & 1][bj] = *(const u32x4*)(rp_ + EPI_C8(bj)); } while (0)
        EPI_LD(0);
#pragma unroll
        for (int it = 0; it < 8; ++it) { if (it + 1 < 8) EPI_LD(it + 1);
            bf16* rp = Y + (size_t)EPI_IT_ROW(it) * ldc + u.pn * BM;
#pragma unroll
            for (int bj = 0; bj < 2; ++bj) { const u32x4 w = yv[it & 1][bj]; f32x4 a = acc[it >> 2][bj][it & 3][0], b = acc[it >> 2][bj][it & 3][1];
                a[0] = bflo(w.x) * sigmoidf_(a[0]); a[1] = bfhi(w.x) * sigmoidf_(a[1]); a[2] = bflo(w.y) * sigmoidf_(a[2]); a[3] = bfhi(w.y) * sigmoidf_(a[3]);
                b[0] = bflo(w.z) * sigmoidf_(b[0]); b[1] = bfhi(w.z) * sigmoidf_(b[1]); b[2] = bflo(w.w) * sigmoidf_(b[2]); b[3] = bfhi(w.w) * sigmoidf_(b[3]);
                *(u32x4*)(rp + EPI_C8(bj)) = pack8(a, b); } }
#undef EPI_LD
    }
};
struct EpiMoeDown {
    static constexpr bool PERM = true;
    bf16* Y; const float* slot_gate;
    __device__ __forceinline__ void operator()(const acc_t& acc, const Unit& u, int wr, int wc, int fr, int fq) const {
        const int ct = (u.pn & 3) * BM;
        float gv[2][4];
#pragma unroll
        EPI_LOOP_ROWS gv[ai][m] = slot_gate[EPI_ROW];
#pragma unroll
        EPI_LOOP_ROWS { const int row = EPI_ROW; const float gt = gv[ai][m]; bf16* rp = Y + (size_t)row * D + ct;
#pragma unroll
            for (int bj = 0; bj < 2; ++bj) *(u32x4*)(rp + EPI_C8(bj)) = pack8(acc[ai][bj][m][0] * gt, acc[ai][bj][m][1] * gt); }
    }
};
}
namespace att {
constexpr int MODE_FOX = 0, MODE_MLA = 1, MODE_BAND = 2;
constexpr float LOG2E = 1.4426950408889634f;
struct Tensors {
    const bf16* Q; int ldq;
    const bf16* K; int ldk;
    const bf16* K2;
    const bf16* V; int ldv;
    bf16* O; int ldo;
    const float* cdec;
    const float* relb;
    int qhs, khs, vhs, ohs;
    const unsigned* qmax; const unsigned* kmax;
};
template <int DQK> struct Lay { static constexpr int KS = DQK * 2 + 16, KB = 64 * KS, VB = 64 * 128, CB = 256, BUF = KB + VB + CB; };
constexpr int ATT_LDS_TAB = 2 * Lay<96>::BUF;
constexpr int ATT_LDS_BYTES = ATT_LDS_TAB + 520 * 4;
__device__ __forceinline__ int crow(int r, int hi) { return (r & 3) + 8 * (r >> 2) + 4 * hi; }
typedef short v4i16_t __attribute__((ext_vector_type(4)));
__device__ __forceinline__ s16x4 vtr(const LAS unsigned char* p) { return __builtin_bit_cast(s16x4, __builtin_amdgcn_ds_read_tr16_b64_v4i16((LAS v4i16_t*)p)); }

template <int MODE>
__device__ __forceinline__ void attn_unit(const Tensors& T, int b, int h, int qb, LAS unsigned char* lds) {
    constexpr int DQK = (MODE == MODE_MLA) ? 96 : 64, NKS = DQK / 16;
    typedef Lay<DQK> LY;
    int tid = my_tid(); asm volatile("" : "+v"(tid));
    const int lane = tid & 63, r32 = lane & 31, hi = lane >> 5; const int wid = __builtin_amdgcn_readfirstlane(tid >> 6);
    const int rowb = b * SEQ, q0 = qb * 256;
    const float sc2 = ((MODE == MODE_MLA) ? 0.10206207261596575f : 0.125f) * LOG2E;
    const int cw = 4 * qb + (wid >> 1);
    const int t_lo = (MODE == MODE_BAND) ? ((4 * qb - 8) > 0 ? (4 * qb - 8) : 0) : 0, t_hi = 4 * qb + 4;
    const int qrow = rowb + q0 + wid * 32 + r32;
    bf16x8 qf[NKS];
    { const bf16* qp = T.Q + (size_t)qrow * T.ldq + h * T.qhs + hi * 8;
#pragma unroll
      for (int ks = 0; ks < NKS; ++ks) qf[ks] = *(const bf16x8*)(qp + ks * 16); }
    float cq = 0.f; if (MODE == MODE_FOX) cq = T.cdec[(size_t)qrow * 4 + h];
    LAS float* tab = (LAS float*)(lds + ATT_LDS_TAB);
    if (MODE == MODE_BAND) { for (int i = tid; i < 513; i += NTHREADS) tab[i] = T.relb[h * 513 + i] * LOG2E; }
    u32x4 kreg0[2] = {}, kreg1[2] = {}, vreg[2] = {}; float creg[2] = {0.f, 0.f};
    const int srow = tid >> 3, sch = tid & 7;
#define ATT_KADDR(c_) (((c_) % 12 < 8) ? (const u32x4*)(T.K + (kr_ + (c_) / 12) * T.ldk + h * T.khs + ((c_) % 12) * 8) : (const u32x4*)(T.K2 + (kr_ + (c_) / 12) * 32 + ((c_) % 12 - 8) * 8))
#define ATT_LOAD_TILE(t_, r_) do { const size_t kr_ = (size_t)(rowb + (t_) * 64); \
        if (MODE == MODE_MLA) { kreg0[r_] = *ATT_KADDR(tid); if (tid < 256) kreg1[r_] = *ATT_KADDR(tid + 512); } \
        else { kreg0[r_] = *(const u32x4*)(T.K + (kr_ + srow) * T.ldk + h * T.khs + sch * 8); } \
        vreg[r_] = *(const u32x4*)(T.V + (kr_ + srow) * T.ldv + h * T.vhs + sch * 8); \
        if (MODE == MODE_FOX) { if (tid < 64) creg[r_] = T.cdec[(kr_ + tid) * 4 + h]; } } while (0)
#define ATT_STORE_TILE(buf_, r_) do { LAS unsigned char* base_ = lds + (buf_) * LY::BUF; \
        if (MODE == MODE_MLA) { *(LAS u32x4*)(base_ + (tid / 12) * LY::KS + (tid % 12) * 16) = kreg0[r_]; \
            if (tid < 256) *(LAS u32x4*)(base_ + ((tid + 512) / 12) * LY::KS + ((tid + 512) % 12) * 16) = kreg1[r_]; } \
        else { *(LAS u32x4*)(base_ + srow * LY::KS + sch * 16) = kreg0[r_]; } \
        *(LAS u32x4*)(base_ + LY::KB + srow * 128 + ((sch * 16) ^ (((srow >> 1) & 1) << 6))) = vreg[r_]; \
        if (MODE == MODE_FOX) { if (tid < 64) *(LAS float*)(base_ + LY::KB + LY::VB + tid * 4) = creg[r_]; } } while (0)
    float mrun = -INFINITY, lrun = 0.f;
    f32x16 o0 = {}, o1 = {};
    const int G = lane >> 4, qi = (lane & 15) >> 2, pi = lane & 3;
    const int vb0 = (4 * hi + qi) * 128 + 64 * (0 ^ (qi >> 1)) + 32 * (G & 1) + 8 * pi;
    const int vb1 = (4 * hi + qi) * 128 + 64 * (1 ^ (qi >> 1)) + 32 * (G & 1) + 8 * pi;
    int t_min = t_lo;
    if (MODE == MODE_FOX) {
        LAS int* tm = (LAS int*)(lds + ATT_LDS_TAB);
        if (tid == 0) tm[0] = t_hi - 1;
        __syncthreads();
        if (tid < t_hi) {
            const float q2 = __uint_as_float(T.qmax[(b * 4 + h) * 32 + qb]), k2 = __uint_as_float(T.kmax[b * 4 + h]);
            const float thr = 0.125f * sqrtf(q2) * 2.0f * sqrtf(k2) * 1.02f + 112.0f;
            const float cfirst = T.cdec[(size_t)(rowb + q0) * 4 + h], clast = T.cdec[(size_t)(rowb + tid * 64 + 63) * 4 + h];
            if (!(clast - cfirst > thr)) __hip_atomic_fetch_min(tm, tid, __ATOMIC_RELAXED, __HIP_MEMORY_SCOPE_WORKGROUP);
        }
        __syncthreads();
        t_min = tm[0];
    }
    const int n_t = t_hi - t_min;
#define ATT_TILE(i_) ((MODE == MODE_FOX) ? (t_hi - 1 - (i_)) : (t_min + (i_)))
    ATT_LOAD_TILE(ATT_TILE(0), 0); ATT_STORE_TILE(0, 0);
    if (n_t > 1) ATT_LOAD_TILE(ATT_TILE(1), 1);
    if (n_t > 2) ATT_LOAD_TILE(ATT_TILE(2), 0);
    __syncthreads();
    for (int it0 = 0; it0 < n_t; it0 += 2) {
#pragma unroll
      for (int half = 0; half < 2; ++half) { const int it = it0 + half; if (it < n_t) {
        const int t = ATT_TILE(it);
        const int buf = half;
        const bool active = (MODE == MODE_BAND) ? (t <= cw && t >= cw - 8) : (t <= cw);
        if (active) {
            const LAS unsigned char* kb = lds + buf * LY::BUF;
            const LAS unsigned char* vbuf = kb + LY::KB;
            f32x16 p0 = {}, p1 = {};
            bf16x8 ka[NKS], kc[NKS];
#pragma unroll
            for (int ks = 0; ks < NKS; ++ks) { ka[ks] = *(const LAS bf16x8*)(kb + r32 * LY::KS + (ks * 16 + hi * 8) * 2); kc[ks] = *(const LAS bf16x8*)(kb + (32 + r32) * LY::KS + (ks * 16 + hi * 8) * 2); }
            __builtin_amdgcn_sched_barrier(0);
#pragma unroll
            for (int ks = 0; ks < NKS; ++ks) { p0 = __builtin_amdgcn_mfma_f32_32x32x16_bf16(ka[ks], qf[ks], p0, 0, 0, 0); p1 = __builtin_amdgcn_mfma_f32_32x32x16_bf16(kc[ks], qf[ks], p1, 0, 0, 0); }
            s16x4 vl0[4], vh0[4], vl1[4], vh1[4];
#pragma unroll
            for (int s4 = 0; s4 < 4; ++s4) { vl0[s4] = vtr(vbuf + vb0 + s4 * 2048); vh0[s4] = vtr(vbuf + vb0 + s4 * 2048 + 1024); vl1[s4] = vtr(vbuf + vb1 + s4 * 2048); vh1[s4] = vtr(vbuf + vb1 + s4 * 2048 + 1024); }
            __builtin_amdgcn_sched_barrier(0);
            if (MODE == MODE_FOX) {
                const LAS float* cb = (const LAS float*)(vbuf + LY::VB);
                const float cq2 = cq * LOG2E;
#pragma unroll
                for (int a = 0; a < 4; ++a) {
                    const f32x4 c0 = *(const LAS f32x4*)(cb + 8 * a + 4 * hi), c1 = *(const LAS f32x4*)(cb + 32 + 8 * a + 4 * hi);
#pragma unroll
                    for (int e = 0; e < 4; ++e) { p0[4 * a + e] = p0[4 * a + e] * sc2 + (cq2 - c0[e] * LOG2E); p1[4 * a + e] = p1[4 * a + e] * sc2 + (cq2 - c1[e] * LOG2E); }
                }
                if (t == cw) { const int ql = 32 * (wid & 1) + r32;
#pragma unroll
                    for (int r = 0; r < 16; ++r) { const int kv = crow(r, hi); if (kv > ql) p0[r] = -INFINITY; if (kv + 32 > ql) p1[r] = -INFINITY; } }
            } else if (MODE == MODE_BAND) {
                const int dq = (q0 + wid * 32 + r32) - t * 64;
#pragma unroll
                for (int r = 0; r < 16; ++r) { const int kv = crow(r, hi);
                    int i0 = dq - kv, i1 = dq - kv - 32; i0 = i0 < -256 ? -256 : (i0 > 256 ? 256 : i0); i1 = i1 < -256 ? -256 : (i1 > 256 ? 256 : i1);
                    p0[r] = p0[r] * sc2 + tab[i0 + 256]; p1[r] = p1[r] * sc2 + tab[i1 + 256]; }
            }
            float mx = fmaxf(p0[0], p1[0]);
#pragma unroll
            for (int r = 1; r < 16; ++r) mx = fmaxf(mx, fmaxf(p0[r], p1[r]));
            { auto rr = __builtin_amdgcn_permlane32_swap(__float_as_uint(mx), __float_as_uint(mx), false, false); mx = fmaxf(__uint_as_float(rr[0]), __uint_as_float(rr[1])); }
            if (MODE == MODE_MLA) mx *= sc2;
            const float mnew = fmaxf(mrun, mx);
            if (__any(mnew > mrun)) {
                const float alpha = __builtin_amdgcn_exp2f(mrun - mnew);
                lrun *= alpha;
#pragma unroll
                for (int r = 0; r < 16; ++r) { o0[r] *= alpha; o1[r] *= alpha; }
                mrun = mnew;
            }
            float rs = 0.f;
#pragma unroll
            for (int r = 0; r < 16; ++r) {
                if (MODE == MODE_MLA) { p0[r] = __builtin_amdgcn_exp2f(__builtin_fmaf(p0[r], sc2, -mrun)); p1[r] = __builtin_amdgcn_exp2f(__builtin_fmaf(p1[r], sc2, -mrun)); }
                else { p0[r] = __builtin_amdgcn_exp2f(p0[r] - mrun); p1[r] = __builtin_amdgcn_exp2f(p1[r] - mrun); }
                rs += p0[r] + p1[r]; }
            lrun += rs;
#pragma unroll
            for (int s4 = 0; s4 < 4; ++s4) {
                u32x4 pw;
                if (s4 < 2) { const int o = 8 * (s4 & 1); pw.x = pk2(p0[o], p0[o + 1]); pw.y = pk2(p0[o + 2], p0[o + 3]); pw.z = pk2(p0[o + 4], p0[o + 5]); pw.w = pk2(p0[o + 6], p0[o + 7]); }
                else        { const int o = 8 * (s4 & 1); pw.x = pk2(p1[o], p1[o + 1]); pw.y = pk2(p1[o + 2], p1[o + 3]); pw.z = pk2(p1[o + 4], p1[o + 5]); pw.w = pk2(p1[o + 6], p1[o + 7]); }
                const bf16x8 pf = __builtin_bit_cast(bf16x8, pw);
                const s16x4 l0 = vl0[s4], h0 = vh0[s4], l1 = vl1[s4], h1 = vh1[s4];
                const bf16x8 vf0 = (bf16x8){l0[0], l0[1], l0[2], l0[3], h0[0], h0[1], h0[2], h0[3]};
                const bf16x8 vf1 = (bf16x8){l1[0], l1[1], l1[2], l1[3], h1[0], h1[1], h1[2], h1[3]};
                o0 = __builtin_amdgcn_mfma_f32_32x32x16_bf16(vf0, pf, o0, 0, 0, 0);
                o1 = __builtin_amdgcn_mfma_f32_32x32x16_bf16(vf1, pf, o1, 0, 0, 0);
            }
        }
        if (it + 1 < n_t) ATT_STORE_TILE(half ^ 1, half ^ 1);
        if (it + 3 < n_t) ATT_LOAD_TILE(ATT_TILE(it + 3), half ^ 1);
        __syncthreads();
      } }
    }
    { auto rr = __builtin_amdgcn_permlane32_swap(__float_as_uint(lrun), __float_as_uint(lrun), false, false); lrun = __uint_as_float(rr[0]) + __uint_as_float(rr[1]); }
    const float inv = 1.0f / lrun;
    bf16* op = T.O + (size_t)qrow * T.ldo + h * T.ohs;
#pragma unroll
    for (int a = 0; a < 4; ++a) {
        u32x2 w0, w1;
        w0.x = pk2(o0[4 * a] * inv, o0[4 * a + 1] * inv); w0.y = pk2(o0[4 * a + 2] * inv, o0[4 * a + 3] * inv);
        w1.x = pk2(o1[4 * a] * inv, o1[4 * a + 1] * inv); w1.y = pk2(o1[4 * a + 2] * inv, o1[4 * a + 3] * inv);
        *(u32x2*)(op + 8 * a + 4 * hi) = w0; *(u32x2*)(op + 32 + 8 * a + 4 * hi) = w1;
    }
}

template <int MODE>
__device__ __forceinline__ void attn_phase(const Tensors& T, LAS unsigned char* lds) {
    const int G = gridDim.x, bx = blockIdx.x, vcu = (G % 8 == 0) ? (bx % 8) * (G / 8) + bx / 8 : bx;
    for (int pr = vcu; pr < 256; pr += G) {
        const int bh = pr >> 4, s = pr & 15;
        attn_unit<MODE>(T, bh >> 2, bh & 3, s, lds);
        attn_unit<MODE>(T, bh >> 2, bh & 3, 31 - s, lds);
    }
}

template <int MODE>
__device__ __forceinline__ void attn_naive(const Tensors& T) {
    BODY_IDS();
    constexpr int DQK = (MODE == MODE_MLA) ? 96 : 64;
    const float sc = (MODE == MODE_MLA) ? 0.10206207261596575f : 0.125f;
    for (int idx = gtid; idx < NTOK * 4; idx += gthreads) {
        const int h = idx / NTOK, row = idx % NTOK, b = row / SEQ, tpos = row % SEQ, rowb = b * SEQ;
        float q[DQK], o[64];
#pragma unroll
        for (int d = 0; d < DQK; ++d) q[d] = bf2f(T.Q[(size_t)row * T.ldq + h * T.qhs + d]) * sc;
#pragma unroll
        for (int d = 0; d < 64; ++d) o[d] = 0.f;
        float m = -INFINITY, l = 0.f;
        const int ck = tpos / 64;
        const int k_lo = (MODE == MODE_BAND) ? ((ck - 8) > 0 ? (ck - 8) * 64 : 0) : 0;
        const int k_hi = (MODE == MODE_FOX) ? tpos : (ck * 64 + 63);
        const float cq = (MODE == MODE_FOX) ? T.cdec[(size_t)row * 4 + h] : 0.f;
        for (int kv = k_lo; kv <= k_hi; ++kv) {
            const size_t kr = (size_t)(rowb + kv);
            float s = 0.f;
#pragma unroll
            for (int d8 = 0; d8 < 8; ++d8) { const u32x4 w = *(const u32x4*)(T.K + kr * T.ldk + h * T.khs + d8 * 8);
                s += q[d8 * 8 + 0] * bflo(w.x) + q[d8 * 8 + 1] * bfhi(w.x) + q[d8 * 8 + 2] * bflo(w.y) + q[d8 * 8 + 3] * bfhi(w.y)
                   + q[d8 * 8 + 4] * bflo(w.z) + q[d8 * 8 + 5] * bfhi(w.z) + q[d8 * 8 + 6] * bflo(w.w) + q[d8 * 8 + 7] * bfhi(w.w); }
            if (MODE == MODE_MLA) {
#pragma unroll
                for (int d8 = 0; d8 < 4; ++d8) { const u32x4 w = *(const u32x4*)(T.K2 + kr * 32 + d8 * 8);
                    s += q[64 + d8 * 8 + 0] * bflo(w.x) + q[64 + d8 * 8 + 1] * bfhi(w.x) + q[64 + d8 * 8 + 2] * bflo(w.y) + q[64 + d8 * 8 + 3] * bfhi(w.y)
                       + q[64 + d8 * 8 + 4] * bflo(w.z) + q[64 + d8 * 8 + 5] * bfhi(w.z) + q[64 + d8 * 8 + 6] * bflo(w.w) + q[64 + d8 * 8 + 7] * bfhi(w.w); }
            }
            if (MODE == MODE_FOX) s += cq - T.cdec[kr * 4 + h];
            if (MODE == MODE_BAND) { int rel = tpos - kv; rel = rel < -256 ? -256 : (rel > 256 ? 256 : rel); s += T.relb[h * 513 + rel + 256]; }
            const float mn = fmaxf(m, s), al = __expf(m - mn), pp = __expf(s - mn);
            l = l * al + pp; m = mn;
#pragma unroll
            for (int d8 = 0; d8 < 8; ++d8) { const u32x4 w = *(const u32x4*)(T.V + kr * T.ldv + h * T.vhs + d8 * 8);
                o[d8 * 8 + 0] = o[d8 * 8 + 0] * al + pp * bflo(w.x); o[d8 * 8 + 1] = o[d8 * 8 + 1] * al + pp * bfhi(w.x);
                o[d8 * 8 + 2] = o[d8 * 8 + 2] * al + pp * bflo(w.y); o[d8 * 8 + 3] = o[d8 * 8 + 3] * al + pp * bfhi(w.y);
                o[d8 * 8 + 4] = o[d8 * 8 + 4] * al + pp * bflo(w.z); o[d8 * 8 + 5] = o[d8 * 8 + 5] * al + pp * bfhi(w.z);
                o[d8 * 8 + 6] = o[d8 * 8 + 6] * al + pp * bflo(w.w); o[d8 * 8 + 7] = o[d8 * 8 + 7] * al + pp * bfhi(w.w); }
        }
        const float inv = 1.0f / l;
#pragma unroll
        for (int d = 0; d < 64; d += 2) *(unsigned*)(T.O + (size_t)row * T.ldo + h * T.ohs + d) = pk2(o[d] * inv, o[d + 1] * inv);
    }
}
}
struct Params {
    const float* in[37];
    float* out;
    unsigned char* ws;
    int ph_lo, ph_hi;
};
enum { I_X = 0, I_P, I_POS, I_WIN, I_SAR, I_SAI, I_SLDT, I_SBR, I_SBI, I_SCR, I_SCI, I_SD, I_SGLU, I_FBF, I_GQ, I_WUQ, I_GKV, I_WUKV, I_RELB, I_WB, I_WG, I_BG, I_WO,
       I_GMIX, I_GFFN, I_FW1, I_FW3, I_FW2, I_MWR, I_MBR, I_MW1, I_MW3, I_MW2, I_GPLE, I_PWG, I_PWU, I_GFIN };

__device__ __forceinline__ void sincos_rad(double a, float& s, float& c) {
    double r = a * 0.15915494309189535; r = r - __builtin_rint(r); const float f = (float)r;
    s = __builtin_amdgcn_sinf(f); c = __builtin_amdgcn_cosf(f);
}
__device__ __forceinline__ float gelu_tanh(float x) {
    const float z = 0.7978845608028654f * (x + 0.044715f * x * x * x);
    const float e = __expf(2.0f * z); const float th = 1.0f - 2.0f / (1.0f + e);
    return 0.5f * x * (1.0f + th);
}
__device__ __forceinline__ float log_sigmoid(float z) { return fminf(z, 0.f) - log1pf(__expf(-fabsf(z))); }

struct CvtJob { const float* src; const float* ks; bf16* dst; int K, ldsrc, col0, ncols, row0, ldk, ilv; };
struct CvtRegs { f32x4 v[16]; };
__device__ __forceinline__ void cvt_load(const CvtJob& J, int item, int lane, CvtRegs& R) {
    const int nblk = (J.ncols + 63) >> 6, kb = item / nblk, nb = item % nblk, k0 = 64 * kb, n0 = 64 * nb;
    const int n4 = (lane & 15) * 4; const bool inb = (n0 + n4) < J.ncols;
#pragma unroll
    for (int i = 0; i < 16; ++i) { const int kk = 4 * i + (lane >> 4); f32x4 v = {0.f, 0.f, 0.f, 0.f};
        if (inb) v = *(const f32x4*)(J.src + (size_t)(k0 + kk) * J.ldsrc + J.col0 + n0 + n4);
        if (J.ks) v = v * J.ks[k0 + kk];
        R.v[i] = v; }
}
__device__ __forceinline__ void cvt_finish(const CvtJob& J, LAS float* scr, int item, int lane, const CvtRegs& R) {
    const int nblk = (J.ncols + 63) >> 6, kb = item / nblk, nb = item % nblk, k0 = 64 * kb, n0 = 64 * nb;
    const int n4 = (lane & 15) * 4;
#pragma unroll
    for (int i = 0; i < 16; ++i) { const int kk = 4 * i + (lane >> 4); *(LAS f32x4*)(scr + kk * 68 + n4) = R.v[i]; }
    LDS_WAIT(); asm volatile("" ::: "memory");
    const int c = lane & 7;
#pragma unroll
    for (int j = 0; j < 8; ++j) { const int n = (lane >> 3) + 8 * j; const LAS float* s = scr + (8 * c) * 68 + n;
        u32x4 o; o.x = pk2(s[0 * 68], s[1 * 68]); o.y = pk2(s[2 * 68], s[3 * 68]); o.z = pk2(s[4 * 68], s[5 * 68]); o.w = pk2(s[6 * 68], s[7 * 68]);
        const int nn = n0 + n; const int row = J.row0 + (J.ilv ? ((nn >> 7) * 256 + (nn & 127)) : nn);
        if (nn < J.ncols) *(u32x4*)(J.dst + (size_t)row * J.ldk + k0 + 8 * c) = o; }
    LDS_WAIT(); asm volatile("" ::: "memory");
}
__device__ __forceinline__ bf16* wmix(const Params& P, int L, size_t off) { return (bf16*)(P.ws + WS_WMIX + (size_t)L * WMIX_STRIDE + off); }
__device__ __forceinline__ CvtJob get_job(const Params& P, int j) {
    CvtJob J; J.ks = nullptr; J.ilv = 0; J.col0 = 0; J.row0 = 0;
    if (j < 40) {
        const int L = j / 20, q = j % 20;
        if (q < 5) {
            J.src = P.in[I_WIN] + (size_t)L * D * DIN; J.K = D; J.ldsrc = DIN; J.dst = wmix(P, L, WM_IN); J.ldk = D;
            J.col0 = q == 0 ? 0 : q == 1 ? 1380 : q == 2 ? 1028 : q == 3 ? 1220 : 1348;
            J.ncols = q == 0 ? 1024 : q == 1 ? 768 : q == 2 ? 192 : q == 3 ? 128 : 32;
            J.row0 = q == 0 ? 0 : q == 1 ? 1024 : q == 2 ? 1792 : q == 3 ? 2048 : 2176;
        } else if (q < 9) { const int k = q - 5; J.src = P.in[I_WG] + ((size_t)L * 4 + k) * D * D; J.K = D; J.ldsrc = D; J.ncols = D; J.row0 = k * D; J.dst = wmix(P, L, WM_G); J.ldk = D;
        } else if (q < 13) { const int k = q - 9; J.src = P.in[I_WB] + ((size_t)L * 4 + k) * 256 * D; J.K = 256; J.ldsrc = D; J.ncols = D; J.row0 = k * D; J.dst = wmix(P, L, WM_B); J.ldk = 256;
        } else if (q == 13) { J.src = P.in[I_WO] + (size_t)L * D * D; J.K = D; J.ldsrc = D; J.ncols = D; J.dst = wmix(P, L, WM_O); J.ldk = D;
        } else if (q == 14) { J.src = P.in[I_PWG] + (size_t)L * D * D; J.K = D; J.ldsrc = D; J.ncols = D; J.dst = wmix(P, L, WM_PG); J.ldk = D;
        } else if (q == 15) { J.src = P.in[I_PWU] + (size_t)L * 256 * D; J.K = 256; J.ldsrc = D; J.ncols = D; J.dst = wmix(P, L, WM_UP); J.ldk = 256;
        } else if (q == 16) { J.src = P.in[I_WUQ] + (size_t)L * 192 * 384; J.ks = P.in[I_GQ] + L * 192; J.K = 192; J.ldsrc = 384; J.ncols = 384; J.dst = wmix(P, L, WM_UQ); J.ldk = 256;
        } else if (q == 17) { J.src = P.in[I_WUKV] + (size_t)L * 128 * 512; J.ks = P.in[I_GKV] + L * 128; J.K = 128; J.ldsrc = 512; J.ncols = 512; J.dst = wmix(P, L, WM_UKV); J.ldk = 128;
        } else if (q == 18) { J.src = P.in[I_SGLU] + (size_t)L * 256 * 256; J.K = 256; J.ldsrc = 256; J.ncols = 256; J.dst = wmix(P, L, WM_GLU); J.ldk = 256;
        } else { J.src = nullptr; J.K = 0; J.ldsrc = 0; J.ncols = 32; J.dst = nullptr; J.ldk = 0; }
    } else if (j < 43) {
        const int q = j - 40;
        if (q == 0) { J.src = P.in[I_FW1]; J.K = D; J.ldsrc = DFF; J.ncols = DFF; J.dst = (bf16*)(P.ws + WS_W13); J.ldk = D; J.ilv = 1; }
        else if (q == 1) { J.src = P.in[I_FW3]; J.K = D; J.ldsrc = DFF; J.ncols = DFF; J.row0 = 128; J.dst = (bf16*)(P.ws + WS_W13); J.ldk = D; J.ilv = 1; }
        else { J.src = P.in[I_FW2]; J.K = DFF; J.ldsrc = D; J.ncols = D; J.dst = (bf16*)(P.ws + WS_W2); J.ldk = DFF; }
    } else {
        const int e = (j - 43) / 3, q = (j - 43) % 3;
        if (q == 0) { J.src = P.in[I_MW1] + (size_t)e * D * DFFE; J.K = D; J.ldsrc = DFFE; J.ncols = DFFE; J.row0 = e * 2816; J.dst = (bf16*)(P.ws + WS_WM13); J.ldk = D; J.ilv = 1; }
        else if (q == 1) { J.src = P.in[I_MW3] + (size_t)e * D * DFFE; J.K = D; J.ldsrc = DFFE; J.ncols = DFFE; J.row0 = e * 2816 + 128; J.dst = (bf16*)(P.ws + WS_WM13); J.ldk = D; J.ilv = 1; }
        else { J.src = P.in[I_MW2] + (size_t)e * DFFE * D; J.K = DFFE; J.ldsrc = D; J.ncols = D; J.row0 = e * D; J.dst = (bf16*)(P.ws + WS_WM2); J.ldk = DFFE; }
    }
    return J;
}
__device__ __forceinline__ void cvt_jobs(const Params& P, int j_lo, int j_hi, LAS unsigned char* lds) {
    BODY_IDS();
    LAS float* scr = (LAS float*)(lds + wave * 17408);
    int acc = 0; bool have = false; CvtJob Jp; int itp = 0; CvtRegs Rp;
    for (int j = j_lo; j < j_hi; ++j) {
        const CvtJob J = get_job(P, j);
        const int items = (J.K / 64) * ((J.ncols + 63) >> 6);
        const int first = (gw - (acc % ngw) + ngw) % ngw;
        for (int it = first; it < items; it += ngw) {
            CvtRegs Rn; cvt_load(J, it, lane, Rn);
            if (have) cvt_finish(Jp, scr, itp, lane, Rp);
            Jp = J; itp = it; have = true;
#pragma unroll
            for (int i = 0; i < 16; ++i) Rp.v[i] = Rn.v[i];
        }
        acc += items;
    }
    if (have) cvt_finish(Jp, scr, itp, lane, Rp);
}

__device__ __forceinline__ void p0_misc(const Params& P) {
    BODY_IDS();
    { const f32x4* src = (const f32x4*)P.in[I_P]; u32x2* dst = (u32x2*)(P.ws + WS_PBF);
      for (int i = gtid; i < 2 * NTOK * 256 / 4; i += gthreads) { const f32x4 v = src[i]; u32x2 w; w.x = pk2(v[0], v[1]); w.y = pk2(v[2], v[3]); dst[i] = w; } }
    { const int* pos = (const int*)P.in[I_POS]; float* ct = (float*)(P.ws + WS_COS); float* st = (float*)(P.ws + WS_SIN);
      const double invf[16] = {1.0, 0.5623413251903491, 0.31622776601683794, 0.1778279410038923, 0.1, 0.05623413251903491, 0.03162277660168379, 0.01778279410038923,
                               0.01, 0.005623413251903491, 0.0031622776601683794, 0.0017782794100389228, 0.001, 0.0005623413251903491, 0.00031622776601683794, 0.00017782794100389227};
      for (int i = gtid; i < NTOK * 16; i += gthreads) { const int row = i >> 4, f = i & 15; double iv = invf[0];
#pragma unroll
          for (int q = 1; q < 16; ++q) iv = (f == q) ? invf[q] : iv;
          const float ang = (float)pos[row] * (float)iv; float s, c; sincos_rad((double)ang, s, c); ct[i] = c; st[i] = s; } }
    for (int L = 0; L < 2; ++L) {
        bf16* win = wmix(P, L, WM_IN);
        for (int i = gtid; i < (64 + 96) * D / 8; i += gthreads) { const int e = i * 8, r = e / D, k = e % D; const int row = r < 64 ? 1984 + r : 2208 + (r - 64); *(u32x4*)(win + (size_t)row * D + k) = (u32x4){0u, 0u, 0u, 0u}; }
        bf16* wuq = wmix(P, L, WM_UQ);
        for (int i = gtid; i < 512 * 256 / 8; i += gthreads) { const int e = i * 8, r = e / 256, k = e % 256; if (r >= 384 || k >= 192) *(u32x4*)(wuq + e) = (u32x4){0u, 0u, 0u, 0u}; }
    }
}

__device__ __forceinline__ void rms_load(const XSrc& x, int row, int lane, f32x4 (&v)[4]) {
#pragma unroll
    for (int j = 0; j < 4; ++j) v[j] = ldx4(x, (size_t)row * D + 4 * lane + 256 * j);
}
struct GainRegs { f32x4 g[4]; };
__device__ __forceinline__ GainRegs load_gain(const float* gain, int lane) { GainRegs G; const f32x4* gr = (const f32x4*)gain + lane;
#pragma unroll
    for (int j = 0; j < 4; ++j) G.g[j] = gr[64 * j];
    return G; }
__device__ __forceinline__ void rms_finish(const GainRegs& G, bf16* orow, int lane, f32x4 (&v)[4]) {
    float s = 0.f;
#pragma unroll
    for (int j = 0; j < 4; ++j) s += (v[j][0] * v[j][0] + v[j][1] * v[j][1]) + (v[j][2] * v[j][2] + v[j][3] * v[j][3]);
    const float rstd = __builtin_amdgcn_rsqf(wave_sum(s) * (1.0f / D) + RMS_EPS);
    u32x2* o8 = (u32x2*)orow + lane;
#pragma unroll
    for (int j = 0; j < 4; ++j) { v[j] = v[j] * rstd * G.g[j]; if (orow) { u32x2 w; w.x = pk2(v[j][0], v[j][1]); w.y = pk2(v[j][2], v[j][3]); o8[64 * j] = w; } }
}
#define RMS_ROWS_BEGIN(x_, rowexpr_) f32x4 v[4], vn_[4]; { const int i = 0; rms_load(x_, (rowexpr_), lane, v); } for (int i = 0; i < 16; ++i) { if (i + 1 < 16) { const int i_ = i; { const int i = i_ + 1; rms_load(x_, (rowexpr_), lane, vn_); } }
#define RMS_ROWS_END() _Pragma("unroll") for (int j_ = 0; j_ < 4; ++j_) v[j_] = vn_[j_]; }
__device__ __forceinline__ void norm_plain(const XSrc x, const float* gain, bf16* H, int first, int stride) {
    BODY_IDS();
    const GainRegs GR = load_gain(gain, lane);
    for (int u = first; u < NTOK / 128; u += stride)
    { RMS_ROWS_BEGIN(x, u * 128 + wave * 16 + i) const int row = u * 128 + wave * 16 + i; rms_finish(GR, H + (size_t)row * D, lane, v); RMS_ROWS_END() }
}
__device__ __forceinline__ void norm1_phase(const Params& P, int L, const XSrc x, int first, int stride) {
    BODY_IDS();
    const float* win = P.in[I_WIN] + (size_t)L * D * DIN;
    f32x4 wff[4][4];
#pragma unroll
    for (int j = 0; j < 4; ++j)
#pragma unroll
        for (int e = 0; e < 4; ++e) wff[j][e] = *(const f32x4*)(win + (size_t)(4 * lane + 256 * j + e) * DIN + 1024);
    const float* gain = P.in[I_GMIX] + L * D; bf16* H = (bf16*)(P.ws + WS_H); const GainRegs GR = load_gain(gain, lane);
    float* logf = (float*)(P.ws + WS_LOGF); float* wsum = (float*)(P.ws + WS_WSUM);
    const f32x4 bf = *(const f32x4*)(P.in[I_FBF] + L * 4);
    for (int u = first; u < NTOK / 128; u += stride) { const int g0 = u * 8 + wave;
        f32x4 run = {0.f, 0.f, 0.f, 0.f};
        RMS_ROWS_BEGIN(x, g0 * 16 + i) const int row = g0 * 16 + i; rms_finish(GR, H + (size_t)row * D, lane, v);
            f32x4 d = {0.f, 0.f, 0.f, 0.f};
#pragma unroll
            for (int j = 0; j < 4; ++j)
#pragma unroll
                for (int e = 0; e < 4; ++e) d += wff[j][e] * v[j][e];
#pragma unroll
            for (int e = 0; e < 4; ++e) { d[e] = wave_sum(d[e]); run[e] += log_sigmoid(d[e] + bf[e]); }
            if (lane == 0) *(f32x4*)(logf + (size_t)row * 4) = run; RMS_ROWS_END()
        if (lane == 0) *(f32x4*)(wsum + (size_t)g0 * 4) = run;
    }
    __syncthreads();
}
__device__ __forceinline__ void prep_phase(const Params& P, int L) {
    BODY_IDS();
    unsigned* qmaxw = (unsigned*)(P.ws + WS_CTL) + CW_QMAX + L * 512; unsigned* kmaxw = (unsigned*)(P.ws + WS_CTL) + CW_KMAX + L * 16;
    const float* logf = (const float*)(P.ws + WS_LOGF); const float* wsum = (const float*)(P.ws + WS_WSUM); float* cdec = (float*)(P.ws + WS_CDEC);
    float* rq = (float*)(P.ws + WS_RSTDQ); float* rkv = (float*)(P.ws + WS_RSTDKV); const bf16* zin = (const bf16*)(P.ws + WS_ZIN); bf16* kper = (bf16*)(P.ws + WS_KPER);
    const float* ct = (const float*)(P.ws + WS_COS); const float* st = (const float*)(P.ws + WS_SIN);
    for (int g0 = gw; g0 < NTOK / 16; g0 += ngw) {
        const int first = (g0 / 512) * 512;
        f32x4 pre = {0.f, 0.f, 0.f, 0.f};
        for (int i = first + lane; i < g0; i += 64) pre += *(const f32x4*)(wsum + (size_t)i * 4);
#pragma unroll
        for (int e = 0; e < 4; ++e) pre[e] = wave_sum(pre[e]);
        if (lane < 16) { const int row = g0 * 16 + lane; *(f32x4*)(cdec + (size_t)row * 4) = *(const f32x4*)(logf + (size_t)row * 4) + pre; }
        float qk2m = 0.f;
        const int colA = (lane < 32 ? ZC_FQ : ZC_FK) + 8 * (lane & 31), colB = ZC_CQ + 8 * (lane < 52 ? lane : 51);
        u32x4 wa = *(const u32x4*)(zin + (size_t)(g0 * 16) * ZP + colA), wb = *(const u32x4*)(zin + (size_t)(g0 * 16) * ZP + colB);
        for (int i = 0; i < 16; ++i) { const int row = g0 * 16 + i;
            const u32x4 ca = wa, cb = wb;
            if (i + 1 < 16) { wa = *(const u32x4*)(zin + (size_t)(row + 1) * ZP + colA); wb = *(const u32x4*)(zin + (size_t)(row + 1) * ZP + colB); }
            const f32x4 cs = *(const f32x4*)(ct + (size_t)row * 16 + 8 * (lane & 1)), cs2 = *(const f32x4*)(ct + (size_t)row * 16 + 8 * (lane & 1) + 4);
            const f32x4 sn = *(const f32x4*)(st + (size_t)row * 16 + 8 * (lane & 1)), sn2 = *(const f32x4*)(st + (size_t)row * 16 + 8 * (lane & 1) + 4);
            { float sa = (bflo(ca.x) * bflo(ca.x) + bfhi(ca.x) * bfhi(ca.x)) + (bflo(ca.y) * bflo(ca.y) + bfhi(ca.y) * bfhi(ca.y)) + (bflo(ca.z) * bflo(ca.z) + bfhi(ca.z) * bfhi(ca.z)) + (bflo(ca.w) * bflo(ca.w) + bfhi(ca.w) * bfhi(ca.w));
              sa += DPP_F(sa, 0xB1, 0xF); sa += DPP_F(sa, 0x4E, 0xF); sa += DPP_F(sa, 0x141, 0xF);
              qk2m = fmaxf(qk2m, sa); }
            const float own[8] = {bflo(cb.x), bfhi(cb.x), bflo(cb.y), bfhi(cb.y), bflo(cb.z), bfhi(cb.z), bflo(cb.w), bfhi(cb.w)};
            float ssb = 0.f;
#pragma unroll
            for (int e = 0; e < 8; ++e) ssb += own[e] * own[e];
            const float sq = wave_sum(lane < 24 ? ssb : 0.f), skv = wave_sum((lane >= 32 && lane < 48) ? ssb : 0.f);
            if (lane == 0) { rq[row] = __builtin_amdgcn_rsqf(sq * (1.0f / 192.0f) + RMS_EPS); rkv[row] = __builtin_amdgcn_rsqf(skv * (1.0f / 128.0f) + RMS_EPS); }
            float oth[8];
#pragma unroll
            for (int e = 0; e < 8; ++e) oth[e] = DPP_F(own[e], 0x4E, 0xF);
            if (lane >= 48 && lane < 52) { const bool lo = lane < 50; float o8[8];
#pragma unroll
                for (int e = 0; e < 8; ++e) { const float c = e < 4 ? cs[e] : cs2[e - 4], sv = e < 4 ? sn[e] : sn2[e - 4];
                    o8[e] = lo ? (own[e] * c - oth[e] * sv) : (own[e] * c + oth[e] * sv); }
                *(u32x4*)(kper + (size_t)row * 32 + (lo ? 0 : 16) + 8 * (lane & 1)) = (u32x4){pk2(o8[0], o8[1]), pk2(o8[2], o8[3]), pk2(o8[4], o8[5]), pk2(o8[6], o8[7])}; } }
        if ((lane & 7) == 0) { const int row0 = g0 * 16, b = row0 / SEQ, qb = (row0 % SEQ) / 256, h = (lane & 31) >> 3;
            if (lane < 32) atomicMax(qmaxw + (b * 4 + h) * 32 + qb, __float_as_uint(qk2m)); else atomicMax(kmaxw + b * 4 + h, __float_as_uint(qk2m)); }
    }
}
struct FinalRows { u32x2 w[16][4]; };
__device__ __forceinline__ void final_norm_load(const Params& P, int u, FinalRows& R) {
    BODY_IDS();
    const bf16* xb = xr_of(P.out);
#pragma unroll
    for (int i = 0; i < 16; ++i) { const u32x2* xr = (const u32x2*)(xb + (size_t)(u * 128 + wave * 16 + i) * D) + lane;
#pragma unroll
        for (int j = 0; j < 4; ++j) R.w[i][j] = xr[64 * j]; }
}
__device__ __forceinline__ void final_norm_store(const Params& P, int u, const FinalRows& R) {
    BODY_IDS();
    const GainRegs GR = load_gain(P.in[I_GFIN], lane);
#pragma unroll
    for (int i = 0; i < 16; ++i) { f32x4 v[4]; float s = 0.f;
#pragma unroll
        for (int j = 0; j < 4; ++j) { const u32x2 w = R.w[i][j]; v[j] = (f32x4){bflo(w.x), bfhi(w.x), bflo(w.y), bfhi(w.y)}; s += (v[j][0] * v[j][0] + v[j][1] * v[j][1]) + (v[j][2] * v[j][2] + v[j][3] * v[j][3]); }
        const float rstd = __builtin_amdgcn_rsqf(wave_sum(s) * (1.0f / D) + RMS_EPS);
        f32x4* xo = (f32x4*)(P.out + (size_t)(u * 128 + wave * 16 + i) * D) + lane;
#pragma unroll
        for (int j = 0; j < 4; ++j) xo[64 * j] = v[j] * rstd * GR.g[j]; }
}
namespace s5 {
struct Coef { float abr, abi; f32x2 B2[16]; float a64r, a64i; };
__device__ __forceinline__ void coef(const Params& P, int L, int g, int p, Coef& C) {
    const float dt = __expf(P.in[I_SLDT][L * 16 + g]); const float ar = P.in[I_SAR][(L * 16 + g) * 64 + p], ai = P.in[I_SAI][(L * 16 + g) * 64 + p];
    const float mag = __expf(ar * dt); float sn, cs; sincos_rad((double)(ai * dt), sn, cs);
    C.abr = mag * cs; C.abi = mag * sn;
    const float den = ar * ar + ai * ai, nr = C.abr - 1.0f, ni = C.abi;
    const float cr = (nr * ar + ni * ai) / den, ci = (ni * ar - nr * ai) / den;
    const float* br = P.in[I_SBR] + ((size_t)(L * 16 + g) * 64 + p) * 16; const float* bi = P.in[I_SBI] + ((size_t)(L * 16 + g) * 64 + p) * 16;
#pragma unroll
    for (int h = 0; h < 16; ++h) { const float r = br[h], i = bi[h]; C.B2[h] = (f32x2){cr * r - ci * i, cr * i + ci * r}; }
    const float m64 = __expf(64.0f * ar * dt); float s64, c64; sincos_rad(64.0 * (double)(ai * dt), s64, c64);
    C.a64r = m64 * c64; C.a64i = m64 * s64;
}
constexpr int WAVE_LDS = 8448;
template <bool EMIT>
__device__ __forceinline__ void chunk(const Params& P, int L, int g, int row0, const Coef& C, float& xr, float& xi, LAS unsigned char* wl, int lane, const bf16x8 (&cf)[4], float dsk) {
    bf16* zin = (bf16*)(P.ws + WS_ZIN);
    LAS float* ut = (LAS float*)wl; LAS unsigned* xt = (LAS unsigned*)(wl + 4096);
    { const u32x4* up = (const u32x4*)(zin + (size_t)(row0 + lane) * ZP + ZC_U + g * 16); const u32x4 w0 = up[0], w1 = up[1];
      LAS f32x4* d = (LAS f32x4*)(ut + lane * 16);
      d[0] = (f32x4){bflo(w0.x), bfhi(w0.x), bflo(w0.y), bfhi(w0.y)}; d[1] = (f32x4){bflo(w0.z), bfhi(w0.z), bflo(w0.w), bfhi(w0.w)};
      d[2] = (f32x4){bflo(w1.x), bfhi(w1.x), bflo(w1.y), bfhi(w1.y)}; d[3] = (f32x4){bflo(w1.z), bfhi(w1.z), bflo(w1.w), bfhi(w1.w)}; }
    for (int tb = 0; tb < 4; ++tb) {
#pragma unroll 4
        for (int ti = 0; ti < 16; ++ti) {
            const LAS f32x4* up = (const LAS f32x4*)(ut + (tb * 16 + ti) * 16);
            f32x2 b2a = {0.f, 0.f}, b2b = {0.f, 0.f};
#pragma unroll
            for (int q = 0; q < 4; ++q) { const f32x4 u4 = up[q];
                b2a += C.B2[4 * q + 0] * (f32x2){u4[0], u4[0]}; b2b += C.B2[4 * q + 1] * (f32x2){u4[1], u4[1]};
                b2a += C.B2[4 * q + 2] * (f32x2){u4[2], u4[2]}; b2b += C.B2[4 * q + 3] * (f32x2){u4[3], u4[3]}; }
            const float br = b2a[0] + b2b[0], bi = b2a[1] + b2b[1];
            const float nr = C.abr * xr - C.abi * xi + br, ni = C.abr * xi + C.abi * xr + bi; xr = nr; xi = ni;
            if (EMIT) xt[ti * 68 + lane] = pk2(xr, xi);
        }
        if (EMIT) {
            f32x4 dacc = {0.f, 0.f, 0.f, 0.f};
#pragma unroll
            for (int ks = 0; ks < 4; ++ks) { const bf16x8 a = *(const LAS bf16x8*)((const LAS unsigned char*)xt + (lane & 15) * 272 + (ks * 32 + (lane >> 4) * 8) * 2);
                dacc = __builtin_amdgcn_mfma_f32_16x16x32_bf16(a, cf[ks], dacc, 0, 0, 0); }
            const int hp = lane & 15;
#pragma unroll
            for (int i = 0; i < 4; ++i) { const int tok = tb * 16 + 4 * (lane >> 4) + i; const float y = dacc[i] + dsk * ut[tok * 16 + hp];
                zin[(size_t)(row0 + tok) * ZP + ZC_U + g * 16 + hp] = (bf16)f2bf(gelu_tanh(y)); }
        }
    }
}
template <int PASS>
__device__ __forceinline__ void phase(const Params& P, int L, LAS unsigned char* lds) {
    BODY_IDS();
    LAS unsigned char* wl = lds + wave * WAVE_LDS;
    f32x2* SC = (f32x2*)(P.ws + WS_SC);
    for (int w = gw; w < 2048; w += ngw) {
        const int bg = w >> 5, cg = w & 31, b = bg >> 4, g = bg & 15;
        Coef C; coef(P, L, g, lane, C);
        bf16x8 cf[4]; float dsk = 0.f;
        if (PASS == 1) {
            const int hp = lane & 15, kg = lane >> 4;
            const float* cre = P.in[I_SCR] + ((size_t)(L * 16 + g) * 16 + hp) * 64; const float* cim = P.in[I_SCI] + ((size_t)(L * 16 + g) * 16 + hp) * 64;
#pragma unroll
            for (int ks = 0; ks < 4; ++ks) { const int p0 = 16 * ks + 4 * kg; u32x4 wv;
                wv.x = pk2(cre[p0], -cim[p0]); wv.y = pk2(cre[p0 + 1], -cim[p0 + 1]); wv.z = pk2(cre[p0 + 2], -cim[p0 + 2]); wv.w = pk2(cre[p0 + 3], -cim[p0 + 3]);
                cf[ks] = __builtin_bit_cast(bf16x8, wv); }
            dsk = P.in[I_SD][(L * 16 + g) * 16 + hp];
        } else {
#pragma unroll
            for (int ks = 0; ks < 4; ++ks) cf[ks] = (bf16x8){0, 0, 0, 0, 0, 0, 0, 0};
        }
        float xr = 0.f, xi = 0.f;
        if (PASS == 1) {
            const f32x2* sp = SC + ((size_t)bg * 128) * 64 + lane;
            for (int c = 0; c < 4 * cg; c += 4) { f32x2 sv[4];
#pragma unroll
                for (int q = 0; q < 4; ++q) sv[q] = sp[(size_t)(c + q) * 64];
#pragma unroll
                for (int q = 0; q < 4; ++q) { const float nr = C.a64r * xr - C.a64i * xi + sv[q][0], ni = C.a64r * xi + C.a64i * xr + sv[q][1]; xr = nr; xi = ni; } }
        }
        for (int cc = 0; cc < 4; ++cc) {
            const int c = 4 * cg + cc, row0 = b * SEQ + c * 64;
            if (PASS == 0) { xr = 0.f; xi = 0.f; }
            chunk<PASS == 1>(P, L, g, row0, C, xr, xi, wl, lane, cf, dsk);
            if (PASS == 0) SC[((size_t)bg * 128 + c) * 64 + lane] = (f32x2){xr, xi};
        }
    }
}
__device__ __forceinline__ void build_w(const Params& P, int L) {
    BODY_IDS();
    bf16* W = (bf16*)(P.ws + WS_S5W);
    for (int q = gtid; q < 16 * 64 * 64; q += gthreads) {
        const int g = q >> 12, p = (q >> 6) & 63, sidx = q & 63;
        const float dt = __expf(P.in[I_SLDT][L * 16 + g]); const float ar = P.in[I_SAR][(L * 16 + g) * 64 + p], ai = P.in[I_SAI][(L * 16 + g) * 64 + p];
        const float mag = __expf(ar * dt); float sn, cs; sincos_rad((double)(ai * dt), sn, cs);
        const float abr = mag * cs, abi = mag * sn, den = ar * ar + ai * ai, nr = abr - 1.0f, ni = abi;
        const float cr = (nr * ar + ni * ai) / den, ci = (ni * ar - nr * ai) / den;
        const float e = (float)(63 - sidx); const float me = __expf(e * ar * dt); float se, ce; sincos_rad((double)e * (double)(ai * dt), se, ce);
        const float Er = me * ce, Ei = me * se;
        const float* br = P.in[I_SBR] + ((size_t)(L * 16 + g) * 64 + p) * 16; const float* bi = P.in[I_SBI] + ((size_t)(L * 16 + g) * 64 + p) * 16;
        float vr[16], vi[16];
#pragma unroll
        for (int h = 0; h < 16; ++h) { const float bbr = cr * br[h] - ci * bi[h], bbi = cr * bi[h] + ci * br[h]; vr[h] = Er * bbr - Ei * bbi; vi[h] = Er * bbi + Ei * bbr; }
        bf16* w0 = W + ((size_t)g * 128 + 2 * p) * 1024 + sidx * 16;
        *(u32x4*)w0 = (u32x4){pk2(vr[0], vr[1]), pk2(vr[2], vr[3]), pk2(vr[4], vr[5]), pk2(vr[6], vr[7])}; *(u32x4*)(w0 + 8) = (u32x4){pk2(vr[8], vr[9]), pk2(vr[10], vr[11]), pk2(vr[12], vr[13]), pk2(vr[14], vr[15])};
        *(u32x4*)(w0 + 1024) = (u32x4){pk2(vi[0], vi[1]), pk2(vi[2], vi[3]), pk2(vi[4], vi[5]), pk2(vi[6], vi[7])}; *(u32x4*)(w0 + 1024 + 8) = (u32x4){pk2(vi[8], vi[9]), pk2(vi[10], vi[11]), pk2(vi[12], vi[13]), pk2(vi[14], vi[15])};
    }
}
__device__ __forceinline__ void pass0_mfma(const Params& P, LAS unsigned char* lds) {
    BODY_IDS();
    const bf16* zin = (const bf16*)(P.ws + WS_ZIN); const bf16* W = (const bf16*)(P.ws + WS_S5W); float* SC = (float*)(P.ws + WS_SC);
    for (int task = blockIdx.x; task < 256; task += gridDim.x) {
        const int g = task & 15, nq = (task >> 4) & 3, cgp = (task >> 6) * 8 + wave;
        __syncthreads();
#pragma unroll
        for (int i = 0; i < 8; ++i) { const int id = tid + 512 * i, row = id >> 7, c16 = id & 127;
            *(LAS u32x4*)(lds + row * 2064 + c16 * 16) = *(const u32x4*)(W + ((size_t)g * 128 + nq * 32 + row) * 1024 + c16 * 8); }
        __syncthreads();
        const int m = lane & 15, kq = lane >> 4, ci = 16 * cgp + m, b = ci >> 7, c = ci & 127;
        const bf16* ap = zin + (size_t)(b * SEQ + c * 64 + (kq >> 1)) * ZP + ZC_U + g * 16 + 8 * (kq & 1);
        const LAS unsigned char* bl = lds + m * 2064 + kq * 16;
        f32x4 d0 = {0.f, 0.f, 0.f, 0.f}, d1 = {0.f, 0.f, 0.f, 0.f};
#pragma unroll 8
        for (int ks = 0; ks < 32; ++ks) {
            const bf16x8 av = *(const bf16x8*)(ap + (size_t)(2 * ks) * ZP), b0 = *(const LAS bf16x8*)(bl + 64 * ks), b1 = *(const LAS bf16x8*)(bl + 16 * 2064 + 64 * ks);
            d0 = __builtin_amdgcn_mfma_f32_16x16x32_bf16(av, b0, d0, 0, 0, 0); d1 = __builtin_amdgcn_mfma_f32_16x16x32_bf16(av, b1, d1, 0, 0, 0);
        }
#pragma unroll
        for (int i = 0; i < 4; ++i) { const int cj = 16 * cgp + 4 * (lane >> 4) + i, bj = cj >> 7, cc = cj & 127; float* sp = SC + ((size_t)(bj * 16 + g) * 128 + cc) * 128 + nq * 32 + (lane & 15);
            sp[0] = d0[i]; sp[16] = d1[i]; }
    }
    __syncthreads();
}
__device__ __forceinline__ void naive(const Params& P, int L) {
    BODY_IDS();
    bf16* zin = (bf16*)(P.ws + WS_ZIN);
    for (int bg = gw; bg < 64; bg += ngw) {
        const int b = bg >> 4, g = bg & 15;
        Coef C; coef(P, L, g, lane, C);
        float cr[16], ci[16];
#pragma unroll
        for (int h = 0; h < 16; ++h) { cr[h] = P.in[I_SCR][((size_t)(L * 16 + g) * 16 + h) * 64 + lane]; ci[h] = P.in[I_SCI][((size_t)(L * 16 + g) * 16 + h) * 64 + lane]; }
        const float dsk = P.in[I_SD][(L * 16 + g) * 16 + (lane & 15)];
        float xr = 0.f, xi = 0.f;
        for (int t = 0; t < SEQ; ++t) {
            bf16* up = zin + (size_t)(b * SEQ + t) * ZP + ZC_U + g * 16;
            const u32x4 w0 = *(const u32x4*)up, w1 = *(const u32x4*)(up + 8);
            const float u[16] = {bflo(w0.x), bfhi(w0.x), bflo(w0.y), bfhi(w0.y), bflo(w0.z), bfhi(w0.z), bflo(w0.w), bfhi(w0.w),
                                 bflo(w1.x), bfhi(w1.x), bflo(w1.y), bfhi(w1.y), bflo(w1.z), bfhi(w1.z), bflo(w1.w), bfhi(w1.w)};
            float br = 0.f, bi = 0.f;
#pragma unroll
            for (int h = 0; h < 16; ++h) { br += C.B2[h][0] * u[h]; bi += C.B2[h][1] * u[h]; }
            const float nr = C.abr * xr - C.abi * xi + br, ni = C.abr * xi + C.abi * xr + bi; xr = nr; xi = ni;
            float ymine = 0.f, umine = 0.f;
#pragma unroll
            for (int h = 0; h < 16; ++h) { const float s = wave_sum(xr * cr[h] - xi * ci[h]); if ((lane & 15) == h) { ymine = s; umine = u[h]; } }
            __builtin_amdgcn_s_waitcnt(0);
            if (lane < 16) up[lane] = (bf16)f2bf(gelu_tanh(ymine + dsk * umine));
        }
    }
}
}

__device__ __forceinline__ void norm2_moe_phase(const Params& P, const XSrc x, LAS unsigned char* lds, int first, int stride) {
    BODY_IDS();
    LAS unsigned* lcnt = (LAS unsigned*)(lds + 32768); LAS unsigned* lbase = lcnt + 8;
    f32x4 wr0[4][4], wr1[4][4];
#pragma unroll
    for (int j = 0; j < 4; ++j)
#pragma unroll
        for (int q = 0; q < 4; ++q) { const float* wp = P.in[I_MWR] + (size_t)(4 * lane + 256 * j + q) * 8; wr0[j][q] = *(const f32x4*)wp; wr1[j][q] = *(const f32x4*)(wp + 4); }
    if (tid < 8) lcnt[tid] = 0u;
    __syncthreads();
    const float* gain = P.in[I_GFFN] + 1 * D; bf16* H = (bf16*)(P.ws + WS_H); const GainRegs GR = load_gain(gain, lane);
    unsigned* tokinfo = (unsigned*)(P.ws + WS_TOKINFO); unsigned* gcnt = (unsigned*)(P.ws + WS_CTL) + CW_MOECNT;
    const float* brt = P.in[I_MBR];
    for (int u = first; u < NTOK / 128; u += stride) { const int g0 = u * 8 + wave;
        RMS_ROWS_BEGIN(x, g0 * 16 + i) const int row = g0 * 16 + i; rms_finish(GR, H + (size_t)row * D, lane, v);
            float lg[8];
#pragma unroll
            for (int e = 0; e < 8; ++e) lg[e] = 0.f;
#pragma unroll
            for (int j = 0; j < 4; ++j)
#pragma unroll
                for (int q = 0; q < 4; ++q) { const f32x4 w0 = wr0[j][q], w1 = wr1[j][q]; const float hv = v[j][q];
                    lg[0] += hv * w0[0]; lg[1] += hv * w0[1]; lg[2] += hv * w0[2]; lg[3] += hv * w0[3]; lg[4] += hv * w1[0]; lg[5] += hv * w1[1]; lg[6] += hv * w1[2]; lg[7] += hv * w1[3]; }
#pragma unroll
            for (int e = 0; e < 8; ++e) lg[e] = wave_sum(lg[e]) + brt[e];
            int e0 = 0; float l0 = lg[0];
#pragma unroll
            for (int e = 1; e < 8; ++e) if (lg[e] > l0) { l0 = lg[e]; e0 = e; }
            int e1 = 0; float l1 = -INFINITY;
#pragma unroll
            for (int e = 0; e < 8; ++e) if (e != e0 && lg[e] > l1) { l1 = lg[e]; e1 = e; }
            const float ex = __expf(l1 - l0); const float ga = __builtin_amdgcn_rcpf(1.0f + ex), gb = ex * ga;
            if (lane == 0) { const unsigned r0 = __hip_atomic_fetch_add(&lcnt[e0], 1u, __ATOMIC_RELAXED, __HIP_MEMORY_SCOPE_WORKGROUP), r1 = __hip_atomic_fetch_add(&lcnt[e1], 1u, __ATOMIC_RELAXED, __HIP_MEMORY_SCOPE_WORKGROUP);
                u32x4 a; a.x = (unsigned)e0; a.y = (unsigned)e1; a.z = r0; a.w = r1; u32x4 bq; bq.x = __float_as_uint(ga); bq.y = __float_as_uint(gb); bq.z = 0u; bq.w = 0u;
                *(u32x4*)(tokinfo + (size_t)row * 8) = a; *(u32x4*)(tokinfo + (size_t)row * 8 + 4) = bq; } RMS_ROWS_END()
    }
    __syncthreads();
    if (tid < 8) lbase[tid] = __hip_atomic_fetch_add(gcnt + tid, lcnt[tid], __ATOMIC_RELAXED, __HIP_MEMORY_SCOPE_AGENT);
    __syncthreads();
    for (int u = first; u < NTOK / 128; u += stride) { const int g0 = u * 8 + wave;
        if (lane == 0) { for (int i = 0; i < 16; ++i) { const int row = g0 * 16 + i; u32x4 a = *(u32x4*)(tokinfo + (size_t)row * 8);
            unsigned b0 = 0, b1 = 0;
#pragma unroll
            for (int e = 0; e < 8; ++e) { const unsigned lb = lbase[e]; b0 = (a.x == (unsigned)e) ? lb : b0; b1 = (a.y == (unsigned)e) ? lb : b1; }
            a.z += b0; a.w += b1; *(u32x4*)(tokinfo + (size_t)row * 8) = a; } }
    }
    int* slot_tok = (int*)(P.ws + WS_SLOTTOK);
    for (int i = gtid; i < MOE_ROWS; i += gthreads) slot_tok[i] = -1;
    __syncthreads();
}
struct MoeLayout { int pstart[9]; };
__device__ __forceinline__ MoeLayout moe_layout(const Params& P) {
    const unsigned* gcnt = (const unsigned*)(P.ws + WS_CTL) + CW_MOECNT; MoeLayout Lo; int acc = 0;
#pragma unroll
    for (int e = 0; e < 8; ++e) { Lo.pstart[e] = acc; const int c = (int)__hip_atomic_load(gcnt + e, __ATOMIC_RELAXED, __HIP_MEMORY_SCOPE_AGENT); acc += (c + 255) / 256 * 256; }
    Lo.pstart[8] = acc; return Lo;
}
__device__ __forceinline__ void moe_assign_phase(const Params& P) {
    BODY_IDS();
    const MoeLayout Lo = moe_layout(P);
    const unsigned* tokinfo = (const unsigned*)(P.ws + WS_TOKINFO); int* slot_tok = (int*)(P.ws + WS_SLOTTOK); float* slot_gate = (float*)(P.ws + WS_SLOTGATE);
    for (int t = gtid; t < NTOK; t += gthreads) { const u32x4 a = *(const u32x4*)(tokinfo + (size_t)t * 8); const u32x2 g = *(const u32x2*)(tokinfo + (size_t)t * 8 + 4);
        int p0 = 0, p1 = 0;
#pragma unroll
        for (int e = 0; e < 8; ++e) { p0 = ((int)a.x == e) ? Lo.pstart[e] : p0; p1 = ((int)a.y == e) ? Lo.pstart[e] : p1; }
        const int s0 = p0 + (int)a.z, s1 = p1 + (int)a.w;
        slot_tok[s0] = t; slot_gate[s0] = __uint_as_float(g.x); slot_tok[s1] = t; slot_gate[s1] = __uint_as_float(g.y); }
}
struct MoeOrder {
    int pstart[9]; int ntile, ncol, G, c;
    __device__ __forceinline__ bool next(int i, pg8::Unit& u) const {
        const long Lf = (long)i * G + c; if (Lf >= (long)ntile * ncol) return false;
        const int rt = (int)(Lf / ncol), j = (int)(Lf % ncol); int e = 0;
#pragma unroll
        for (int q = 1; q < 8; ++q) e = (rt * 256 >= pstart[q]) ? q : e;
        u.pm = rt; u.pn = e * ncol + j; return true;
    }
};
__device__ __forceinline__ MoeOrder moe_order(const Params& P, int ncol, int G, int c) {
    const MoeLayout Lo = moe_layout(P); MoeOrder S;
#pragma unroll
    for (int e = 0; e < 9; ++e) S.pstart[e] = Lo.pstart[e];
    S.ntile = Lo.pstart[8] / 256; S.ncol = ncol; S.G = G; S.c = c; return S;
}

__device__ __forceinline__ void norm_moe_combine(const Params& P, const float* gain, int first, int stride) {
    BODY_IDS();
    const MoeLayout Lo = moe_layout(P); const GainRegs GR = load_gain(gain, lane);
    const unsigned* tokinfo = (const unsigned*)(P.ws + WS_TOKINFO); const bf16* Y = (const bf16*)(P.ws + WS_MOEY); bf16* H = (bf16*)(P.ws + WS_H2);
    for (int u = first; u < NTOK / 128; u += stride) for (int i = 0; i < 16; ++i) { const int row = u * 128 + wave * 16 + i;
        const u32x4 a = *(const u32x4*)(tokinfo + (size_t)row * 8);
        int p0 = 0, p1 = 0;
#pragma unroll
        for (int e = 0; e < 8; ++e) { p0 = ((int)a.x == e) ? Lo.pstart[e] : p0; p1 = ((int)a.y == e) ? Lo.pstart[e] : p1; }
        const u32x2* y0 = (const u32x2*)(Y + (size_t)(p0 + (int)a.z) * D) + lane; const u32x2* y1 = (const u32x2*)(Y + (size_t)(p1 + (int)a.w) * D) + lane;
        u32x2* xr = (u32x2*)(xr_of(P.out) + (size_t)row * D) + lane; f32x4 v[4]; float s = 0.f;
#pragma unroll
        for (int j = 0; j < 4; ++j) { const u32x2 w0 = y0[64 * j], w1 = y1[64 * j]; const u32x2 wx = xr[64 * j];
            v[j] = (f32x4){bflo(wx.x), bfhi(wx.x), bflo(wx.y), bfhi(wx.y)} + (f32x4){bflo(w0.x), bfhi(w0.x), bflo(w0.y), bfhi(w0.y)} + (f32x4){bflo(w1.x), bfhi(w1.x), bflo(w1.y), bfhi(w1.y)};
            { u32x2 wo; wo.x = pk2(v[j][0], v[j][1]); wo.y = pk2(v[j][2], v[j][3]); xr[64 * j] = wo; } s += (v[j][0] * v[j][0] + v[j][1] * v[j][1]) + (v[j][2] * v[j][2] + v[j][3] * v[j][3]); }
        const float rstd = __builtin_amdgcn_rsqf(wave_sum(s) * (1.0f / D) + RMS_EPS);
        u32x2* o8 = (u32x2*)(H + (size_t)row * D) + lane;
#pragma unroll
        for (int j = 0; j < 4; ++j) { const f32x4 h = v[j] * rstd * GR.g[j]; u32x2 w; w.x = pk2(h[0], h[1]); w.y = pk2(h[2], h[3]); o8[64 * j] = w; }
    }
}
#ifndef REF_MASK
#define REF_MASK 0
#endif
#ifndef N_LAUNCH_MODE
#define N_LAUNCH_MODE 1
#endif
constexpr int LDS_BYTES = 147456;
constexpr int MISC_OFF = LDS_BYTES - 64;
constexpr int N_PHASES = 27;
#ifndef PHASE_SEL
#define PHASE_SEL 0xFFFFFFFu
#endif
#define PH_ON(b) (((PHASE_SEL) >> (b)) & 1u)
#ifndef SUB_SEL
#define SUB_SEL 0xFFu
#endif
#define SUB_ON(b) (((SUB_SEL) >> (b)) & 1u)

#ifndef PROBE_MASK
#define PROBE_MASK 0u
#endif
#ifndef PROBE_MULT
#define PROBE_MULT 4
#endif
#define TIMED(bit, ...) do { unsigned long long t0_ = 0; if (((PROBE_MASK) >> (bit)) & 1u) t0_ = __builtin_amdgcn_s_memrealtime(); __VA_ARGS__; \
    if (((PROBE_MASK) >> (bit)) & 1u) pacc += __builtin_amdgcn_s_memrealtime() - t0_; } while (0)
#define RUN_GEMM(EPI_T, SCHED_T, GATH, gm, sc, ep) do { if (REF_MASK & 1) pg8::gemm_phase_naive<EPI_T, SCHED_T, GATH>(gm, sc, ep); \
    else pg8::gemm_phase<EPI_T, SCHED_T, true, GATH>(lds, gm, sc, ep); } while (0)

__device__ __forceinline__ int vcu_of() { int G = gridDim.x, bx = blockIdx.x; asm volatile("" : "+s"(G), "+s"(bx)); return (G % 8 == 0) ? (bx % 8) * (G / 8) + bx / 8 : bx; }
__device__ __forceinline__ bool in_range(int lo, int hi, int k) { asm volatile("" : "+s"(lo), "+s"(hi)); return lo <= k && k < hi; }
__global__ void __launch_bounds__(NTHREADS, 2) mega_fwd(Params P) {
    extern __shared__ __attribute__((aligned(16))) unsigned char lds_raw[];
    LAS unsigned char* lds = (LAS unsigned char*)lds_raw;
    const int tid = threadIdx.x;
    const int G = gridDim.x, bx = blockIdx.x;
    unsigned* ctl = (unsigned*)(P.ws + WS_CTL);
    volatile LAS unsigned* misc = (volatile LAS unsigned*)(lds + MISC_OFF);
    if (tid < 16) misc[tid] = 0u;
    if ((tid & 63) == 0) *(LAS int*)(uintptr_t)((unsigned)TID_TAB_OFF + 4u * hw_wave_key()) = tid >> 6;
    __syncthreads();
    const int lo = P.ph_lo, hi = P.ph_hi;
    XcdBarrier bar; bar.bar = ctl + CW_BAR; bar.x = 0; bar.st = misc;
    if (hi - lo > 1) bar = xcd_barrier_post(ctl + CW_BAR, misc);
#define IN(k) in_range(lo, hi, (k))
#ifndef PROBE_SEAMS
#define PROBE_SEAMS 0u
#endif
#define SEAM(k) do { if (IN(k) && IN((k) + 1)) { unsigned long long t0_ = 0; const bool tm_ = (((PROBE_MASK) >> 24) & 1u) || (((PROBE_SEAMS) >> (k)) & 1u); if (tm_) t0_ = __builtin_amdgcn_s_memrealtime(); \
    xcd_barrier(bar); if (tm_) pacc += __builtin_amdgcn_s_memrealtime() - t0_; } } while (0)
    unsigned long long pacc = 0;

#define H ((bf16*)(P.ws + WS_H))
#define ZIN ((bf16*)(P.ws + WS_ZIN))
#define GB ((bf16*)(P.ws + WS_G))
#define MB ((bf16*)(P.ws + WS_M))
#define MLAQ ((bf16*)(P.ws + WS_MLAQ))
#define MLAKV ((bf16*)(P.ws + WS_MLAKV))
#define KPER ((bf16*)(P.ws + WS_KPER))
#define cosT ((float*)(P.ws + WS_COS))
#define sinT ((float*)(P.ws + WS_SIN))
#define slot_tok ((int*)(P.ws + WS_SLOTTOK))
#define slot_gate ((float*)(P.ws + WS_SLOTGATE))

    if (PH_ON(0) && IN(0)) { TIMED(0, cvt_jobs(P, 0, 43, lds); p0_misc(P)); TIMED(1, norm1_phase(P, 0, XSrc{P.in[I_X], nullptr}, vcu_of(), gridDim.x)); }
    SEAM(0);

    for (int L = 0; L < 2; ++L) {
        const int pb = 1 + 12 * L;
        const int pc = (L == 0) ? 9 : 22;
        bf16* const XR = xr_of(P.out);
        const XSrc xsrc = (L == 0) ? XSrc{P.in[I_X], nullptr} : XSrc{nullptr, XR};
        if (PH_ON(2) && IN(pb + 1)) {
            TIMED(4, s5::build_w(P, L));
            pg8::Gemm g{H, wmix(P, L, WM_IN), D, D, D, nullptr}; pg8::StaticOrder S; S.init(NTOK, ZP, G, bx);
            epi::EpiStore E{ZIN, ZP, 0};
            TIMED(2, RUN_GEMM(epi::EpiStore, pg8::StaticOrder, false, g, S, E));
        }
        SEAM(pb + 1);
        if (PH_ON(3) && IN(pb + 2)) {
            TIMED(3, prep_phase(P, L));
            if (!(REF_MASK & 4)) TIMED(4, s5::pass0_mfma(P, lds));
            __syncthreads();
        }
        SEAM(pb + 2);
        if (PH_ON(4) && IN(pb + 3)) {
            if (SUB_ON(0)) { pg8::Gemm g{ZIN + ZC_CQ, wmix(P, L, WM_UQ), ZP, 256, 256, nullptr}; pg8::StaticOrder S; S.init(NTOK, 512, G, bx);
              epi::EpiMlaQ E{MLAQ, (const float*)(P.ws + WS_RSTDQ), cosT, sinT};
              TIMED(5, RUN_GEMM(epi::EpiMlaQ, pg8::StaticOrder, false, g, S, E)); }
            if (SUB_ON(1)) { pg8::Gemm g{ZIN + ZC_CKV, wmix(P, L, WM_UKV), ZP, 128, 128, nullptr}; pg8::StaticOrder S; S.init(NTOK, 512, G, bx);
              epi::EpiRowScale E{MLAKV, 512, (const float*)(P.ws + WS_RSTDKV)};
              TIMED(5, RUN_GEMM(epi::EpiRowScale, pg8::StaticOrder, false, g, S, E)); }
            if (SUB_ON(2)) { TIMED(6, if (REF_MASK & 4) s5::naive(P, L); else s5::phase<1>(P, L, lds)); }
            __syncthreads();
            if (SUB_ON(3)) { att::Tensors T; T.Q = ZIN + ZC_FQ; T.ldq = ZP; T.K = ZIN + ZC_FK; T.ldk = ZP; T.K2 = nullptr; T.V = ZIN + ZC_FV; T.ldv = ZP; T.O = ZIN + ZC_FQ; T.ldo = ZP;
              T.cdec = (const float*)(P.ws + WS_CDEC); T.relb = nullptr; T.qhs = 64; T.khs = 64; T.vhs = 64; T.ohs = 64;
              T.qmax = (const unsigned*)(P.ws + WS_CTL) + CW_QMAX + L * 512; T.kmax = (const unsigned*)(P.ws + WS_CTL) + CW_KMAX + L * 16;
              TIMED(7, if (REF_MASK & 2) att::attn_naive<att::MODE_FOX>(T); else att::attn_phase<att::MODE_FOX>(T, lds)); }
            __syncthreads();
            if (SUB_ON(4)) { att::Tensors T; T.Q = ZIN + ZC_DQ; T.ldq = ZP; T.K = ZIN + ZC_DK; T.ldk = ZP; T.K2 = nullptr; T.V = ZIN + ZC_DV; T.ldv = ZP; T.O = ZIN + ZC_DQ; T.ldo = ZP;
              T.cdec = nullptr; T.relb = P.in[I_RELB] + (size_t)L * 4 * 513; T.qhs = 64; T.khs = 64; T.vhs = 64; T.ohs = 64;
              TIMED(8, if (REF_MASK & 2) att::attn_naive<att::MODE_BAND>(T); else att::attn_phase<att::MODE_BAND>(T, lds)); }
            __syncthreads();
        }
        SEAM(pb + 3);
        if (PH_ON(5) && IN(pb + 4)) {
            if (SUB_ON(0)) { att::Tensors T; T.Q = MLAQ; T.ldq = 512; T.K = MLAKV; T.ldk = 512; T.K2 = KPER; T.V = MLAKV + 64; T.ldv = 512; T.O = ZIN + ZC_CQ; T.ldo = ZP;
              T.cdec = nullptr; T.relb = nullptr; T.qhs = 96; T.khs = 128; T.vhs = 128; T.ohs = 64;
              TIMED(9, if (REF_MASK & 2) att::attn_naive<att::MODE_MLA>(T); else att::attn_phase<att::MODE_MLA>(T, lds)); }
            __syncthreads();
            if (SUB_ON(1)) { pg8::Gemm g{ZIN + ZC_U, wmix(P, L, WM_GLU), ZP, 256, 256, nullptr}; pg8::StaticOrder S; S.init(NTOK, 256, G, bx);
              epi::EpiGlu E{ZIN + ZC_U, ZP};
              TIMED(10, RUN_GEMM(epi::EpiGlu, pg8::StaticOrder, false, g, S, E)); }
        }
        SEAM(pb + 4);
        if (PH_ON(6) && IN(pb + 5)) {
            g128::MergeProg MP; MP.Hn = H; MP.zin = ZIN; MP.wg = wmix(P, L, WM_G); MP.wb = wmix(P, L, WM_B); MP.bg = P.in[I_BG] + (size_t)L * 4 * D; MP.M = MB;
            const int vcu_ = vcu_of();
            TIMED(11, g128::stream<g128::MergeProg>(lds, MP, 1024, vcu_, G));
        }
        SEAM(pb + 5);
#define PANEL_FENCE() do { asm volatile("s_waitcnt vmcnt(0)" ::: "memory"); __builtin_amdgcn_fence(__ATOMIC_ACQUIRE, "agent"); asm volatile("s_waitcnt vmcnt(0)" ::: "memory"); __syncthreads(); } while (0)
        if (PH_ON(7) && IN(pb + 6)) {
            pg8::Gemm g{MB, wmix(P, L, WM_O), D, D, D, nullptr}; pg8::StaticOrder S; S.init(NTOK, D, G, bx);
            epi::EpiRes E{xsrc, XR};
            TIMED(13, RUN_GEMM(epi::EpiRes, pg8::StaticOrder, false, g, S, E));
        }
        SEAM(pb + 6);
        if (PH_ON(8) && IN(pb + 7)) {
            const int vcu_ = vcu_of();
            if (L == 0) TIMED(14, norm_plain(XSrc{nullptr, XR}, P.in[I_GFFN], H, vcu_, G));
            else { TIMED(14, norm2_moe_phase(P, XSrc{nullptr, XR}, lds, vcu_, G)); TIMED(25, cvt_jobs(P, 43, 67, lds)); __syncthreads(); }
        }
        SEAM(pb + 7);
        if (L == 0) {
            if (PH_ON(9) && IN(9)) {
                pg8::Gemm g{H, (const bf16*)(P.ws + WS_W13), D, D, D, nullptr}; pg8::StaticOrder S; S.init(NTOK, 2 * DFF, G, bx);
                epi::EpiSwiglu E{(bf16*)(P.ws + WS_HMID), DFF, 22};
                TIMED(15, RUN_GEMM(epi::EpiSwiglu, pg8::StaticOrder, false, g, S, E));
            }
            SEAM(9);
            if (PH_ON(10) && IN(10)) {
                pg8::Gemm g{(const bf16*)(P.ws + WS_HMID), (const bf16*)(P.ws + WS_W2), DFF, DFF, DFF, nullptr}; pg8::StaticOrder S; S.init(NTOK, D, G, bx);
                epi::EpiRes E{XSrc{nullptr, XR}, XR};
                TIMED(16, RUN_GEMM(epi::EpiRes, pg8::StaticOrder, false, g, S, E));
            }
            SEAM(10);
        } else {
            if (PH_ON(21) && IN(21)) TIMED(17, moe_assign_phase(P));
            SEAM(21);
            if (PH_ON(22) && IN(22)) {
                pg8::Gemm g{H, (const bf16*)(P.ws + WS_WM13), D, D, D, slot_tok}; const MoeOrder S = moe_order(P, 11, G, bx);
                epi::EpiSwiglu E{(bf16*)(P.ws + WS_HMID), DFFE, 11};
                TIMED(18, RUN_GEMM(epi::EpiSwiglu, MoeOrder, true, g, S, E));
            }
            SEAM(22);
            if (PH_ON(23) && IN(23)) {
                pg8::Gemm g{(const bf16*)(P.ws + WS_HMID), (const bf16*)(P.ws + WS_WM2), DFFE, DFFE, DFFE, nullptr}; const MoeOrder S = moe_order(P, 4, G, bx);
                epi::EpiMoeDown E{(bf16*)(P.ws + WS_MOEY), slot_gate};
                TIMED(19, RUN_GEMM(epi::EpiMoeDown, MoeOrder, false, g, S, E));
            }
            SEAM(23);
        }
        if (PH_ON(12) && IN(pc + 3)) {
            const int vcu_ = vcu_of();
            if (L == 0) TIMED(20, norm_plain(XSrc{nullptr, XR}, P.in[I_GPLE] + L * D, H, vcu_, G)); else TIMED(20, norm_moe_combine(P, P.in[I_GPLE] + L * D, vcu_, G));
            PANEL_FENCE();
            g128::PleProg PP; PP.pbf = (const bf16*)(P.ws + WS_PBF) + (size_t)L * NTOK * 256; PP.hp = (L == 0) ? H : (const bf16*)(P.ws + WS_H2); PP.wup = wmix(P, L, WM_UP); PP.wpg = wmix(P, L, WM_PG); PP.x = XR;
            TIMED(22, g128::stream<g128::PleProg>(lds, PP, NTOK / 128, vcu_, G));
            PANEL_FENCE();
            if (L == 0) TIMED(1, norm1_phase(P, 1, XSrc{nullptr, XR}, vcu_, G));
        }
        if (L == 0) SEAM(pc + 3);
    }
    if (PH_ON(26) && IN(25)) {
        const int vcu_ = vcu_of(); const int G_ = gridDim.x;
        for (int r = 0; r < (NTOK / 128 + G_ - 1) / G_; ++r) {
            const int u = vcu_ + r * G_; FinalRows FR;
            if (u < NTOK / 128) final_norm_load(P, u, FR);
            xcd_barrier(bar);
            if (u < NTOK / 128) final_norm_store(P, u, FR);
        }
    }
    if (PROBE_MASK || PROBE_SEAMS) { const unsigned long long t0_ = __builtin_amdgcn_s_memrealtime(); while (__builtin_amdgcn_s_memrealtime() - t0_ < (unsigned long long)PROBE_MULT * pacc) __builtin_amdgcn_s_sleep(8); }
#undef IN
#undef SEAM
#undef H
#undef ZIN
#undef GB
#undef MB
#undef MLAQ
#undef MLAKV
#undef KPER
#undef cosT
#undef sinT
#undef slot_tok
#undef slot_gate
}

extern "C" void kernel_launch(void* const* d_in, const int* in_sizes, int n_in, void* d_out, int out_size, void* d_ws, size_t ws_size, hipStream_t stream) {
    static int grid = 0;
    if (grid == 0) {
        if (n_in != 37 || out_size != NTOK * D || ws_size < WS_END) { fprintf(stderr, "kernel_launch: unexpected shapes: n_in %d out %d ws %zu\n", n_in, out_size, ws_size); grid = -1; return; }
        int dev = 0, cus = 0, per_cu = 0;
        if (hipGetDevice(&dev) != hipSuccess || hipDeviceGetAttribute(&cus, hipDeviceAttributeMultiprocessorCount, dev) != hipSuccess) { grid = -1; return; }
        if (hipFuncSetAttribute((const void*)mega_fwd, hipFuncAttributeMaxDynamicSharedMemorySize, LDS_BYTES) != hipSuccess) { fprintf(stderr, "kernel_launch: hipFuncSetAttribute failed\n"); grid = -1; return; }
        if (hipOccupancyMaxActiveBlocksPerMultiprocessor(&per_cu, (const void*)mega_fwd, NTHREADS, LDS_BYTES) != hipSuccess || per_cu < 1)
            fprintf(stderr, "kernel_launch: note: occupancy query reports %d workgroups per CU\n", per_cu);
        (void)hipGetLastError();
        grid = cus;
        if (grid != 256) fprintf(stderr, "kernel_launch: note: %d CUs (built for 256)\n", grid);
    }
    if (grid < 0) return;
    if (hipMemsetAsync((char*)d_ws + WS_CTL, 0, CTL_ZERO_BYTES, stream) != hipSuccess) return;
    Params p{};
    for (int i = 0; i < 37; ++i) p.in[i] = (const float*)d_in[i];
    p.out = (float*)d_out; p.ws = (unsigned char*)d_ws;
#if N_LAUNCH_MODE == 1
    p.ph_lo = 0; p.ph_hi = N_PHASES;
    hipLaunchKernelGGL(mega_fwd, dim3(grid), dim3(NTHREADS), LDS_BYTES, stream, p);
#else
    for (int ph = 0; ph < N_PHASES; ++ph) { p.ph_lo = ph; p.ph_hi = ph + 1; hipLaunchKernelGGL(mega_fwd, dim3(grid), dim3(NTHREADS), LDS_BYTES, stream, p); }
#endif
    const hipError_t le = hipPeekAtLastError();
    if (le != hipSuccess) fprintf(stderr, "kernel_launch: launch failed: %s\n", hipGetErrorName(le));
}
```

```cpp
#include <hip/hip_runtime.h>
#include <cstdio>
#include <cstdint>

#define GAS __attribute__((address_space(1)))
#define LAS __attribute__((address_space(3)))
typedef unsigned short bf16;
typedef short bf16x8 __attribute__((ext_vector_type(8)));
typedef short s16x4 __attribute__((ext_vector_type(4)));
typedef float f32x2 __attribute__((ext_vector_type(2)));
typedef float f32x4 __attribute__((ext_vector_type(4)));
typedef float f32x16 __attribute__((ext_vector_type(16)));
typedef unsigned u32x2 __attribute__((ext_vector_type(2)));
typedef unsigned u32x4 __attribute__((ext_vector_type(4)));
typedef __bf16 bf16x2_t __attribute__((ext_vector_type(2)));

constexpr int NB = 4, SEQ = 8192, NTOK = NB * SEQ, D = 1024;
constexpr int ZP = 2304;
constexpr int ZC_U = 0, ZC_FQ = 256, ZC_FK = 512, ZC_FV = 768, ZC_DQ = 1024, ZC_DK = 1280, ZC_DV = 1536, ZC_CQ = 1792, ZC_CKV = 2048, ZC_KPE = 2176;
constexpr int DIN = 2148, DFF = 2816, DFFE = 1408, NE = 8;
constexpr int MOE_ROWS = 2 * NTOK + NE * 256;
constexpr float RMS_EPS = 1e-6f;
constexpr int NWAVES = 8, NTHREADS = 512;

constexpr size_t MiB = 1u << 20;
constexpr size_t WS_CTL = 0, CTL_ZERO_BYTES = 1 * MiB;
constexpr size_t WS_COS = 1 * MiB, WS_SIN = 3 * MiB;
constexpr size_t WS_LOGF = 5 * MiB;
constexpr size_t WS_CDEC = 5 * MiB + 512 * 1024;
constexpr size_t WS_WSUM = 6 * MiB;
constexpr size_t WS_RSTDQ = 6 * MiB + 256 * 1024, WS_RSTDKV = 6 * MiB + 512 * 1024;
constexpr size_t WS_SC = 7 * MiB;
constexpr size_t WS_TOKINFO = 11 * MiB;
constexpr size_t WS_SLOTTOK = 12 * MiB, WS_SLOTGATE = 12 * MiB + 512 * 1024;
constexpr size_t WS_S5W = 13 * MiB;
constexpr size_t WS_PBF = 17 * MiB;
constexpr size_t WS_WMIX = 49 * MiB, WMIX_STRIDE = 20 * MiB;
constexpr size_t WM_IN = 0, WM_G = 4 * MiB + 512 * 1024, WM_B = 12 * MiB + 512 * 1024, WM_O = 14 * MiB + 512 * 1024, WM_PG = 16 * MiB + 512 * 1024,
                 WM_UP = 18 * MiB + 512 * 1024, WM_UQ = 19 * MiB, WM_UKV = 19 * MiB + 256 * 1024, WM_GLU = 19 * MiB + 384 * 1024;
constexpr size_t WS_W13 = 89 * MiB, WS_W2 = 100 * MiB;
constexpr size_t WS_H = 106 * MiB;
constexpr size_t WS_MLAQ = 170 * MiB, WS_MLAKV = 202 * MiB, WS_KPER = 234 * MiB;
constexpr size_t WS_M = 170 * MiB;
constexpr size_t WS_ZIN = 236 * MiB;
constexpr size_t WS_G = 380 * MiB;
constexpr size_t WS_HMID = 236 * MiB;
constexpr size_t WS_U = 236 * MiB;
constexpr size_t WS_WM13 = 418 * MiB, WS_WM2 = 462 * MiB;
constexpr size_t WS_MOEY = 89 * MiB;
constexpr size_t WS_H2 = 300 * MiB;
constexpr size_t WS_END = 484 * MiB;
constexpr int CW_BAR = 4096;
constexpr int CW_MOECNT = 16384;
constexpr int CW_QMAX = 20480;
constexpr int CW_KMAX = 22528;

#define LDS_WAIT() asm volatile("s_waitcnt lgkmcnt(0)" ::: "memory")
#define VM_WAIT() asm volatile("s_waitcnt vmcnt(0)" ::: "memory")
__device__ __forceinline__ unsigned f2bf(float f) { unsigned u = __builtin_bit_cast(unsigned, f); return (u + 0x7fffu + ((u >> 16) & 1u)) >> 16; }
__device__ __forceinline__ unsigned pk2(float lo, float hi) { f32x2 v = {lo, hi}; bf16x2_t b = __builtin_convertvector(v, bf16x2_t); return __builtin_bit_cast(unsigned, b); }
__device__ __forceinline__ float bf2f(unsigned short b) { return __uint_as_float((unsigned)b << 16); }
__device__ __forceinline__ float bflo(unsigned w) { return __uint_as_float(w << 16); }
__device__ __forceinline__ float bfhi(unsigned w) { return __uint_as_float(w & 0xffff0000u); }
constexpr int TID_TAB_OFF = 147456 - 512;
__device__ __forceinline__ unsigned hw_wave_key() { return (unsigned)__builtin_amdgcn_s_getreg((5 << 11) | 4) & 0x3Fu; }
__device__ __forceinline__ int my_tid() {
    unsigned addr = (unsigned)TID_TAB_OFF + 4u * hw_wave_key(); asm volatile("" : "+s"(addr));
    const int wave = __builtin_amdgcn_readfirstlane(*(const LAS int*)(uintptr_t)addr);
    int lane = (int)__builtin_amdgcn_mbcnt_hi(~0u, __builtin_amdgcn_mbcnt_lo(~0u, 0u)); asm volatile("" : "+v"(lane));
    return wave * 64 + lane;
}
__device__ __forceinline__ float shflx(float v, int o, int lane) { return __int_as_float(__builtin_amdgcn_ds_bpermute((lane ^ o) << 2, __float_as_int(v))); }
#define DPP_F(x_, ctrl_, rm_) __int_as_float(__builtin_amdgcn_update_dpp(0, __float_as_int(x_), (ctrl_), (rm_), 0xF, true))
__device__ __forceinline__ float wave_sum(float v) {
    v += DPP_F(v, 0xB1, 0xF); v += DPP_F(v, 0x4E, 0xF); v += DPP_F(v, 0x114, 0xF); v += DPP_F(v, 0x118, 0xF);
    v += DPP_F(v, 0x142, 0xA); v += DPP_F(v, 0x143, 0xC);
    return __int_as_float(__builtin_amdgcn_readlane(__float_as_int(v), 63));
}
__device__ __forceinline__ float sigmoidf_(float x) { return __builtin_amdgcn_rcpf(1.0f + __expf(-x)); }

struct XSrc { const float* f; const bf16* b; };
__device__ __forceinline__ f32x4 ldx4(const XSrc& x, size_t idx) {
    if (x.f) return *(const f32x4*)(x.f + idx);
    const u32x2 w = *(const u32x2*)(x.b + idx); return (f32x4){bflo(w.x), bfhi(w.x), bflo(w.y), bfhi(w.y)};
}
__device__ __forceinline__ bf16* xr_of(float* out) { return (bf16*)((unsigned char*)out + (size_t)NTOK * D * 2); }
#define BODY_IDS() int tid = my_tid(); asm volatile("" : "+v"(tid)); const int lane = tid & 63; const int wave = __builtin_amdgcn_readfirstlane(tid >> 6); \
    int grid_ = gridDim.x; asm volatile("" : "+s"(grid_)); \
    const int gw = blockIdx.x * NWAVES + wave, ngw = grid_ * NWAVES, gtid = blockIdx.x * NTHREADS + tid, gthreads = grid_ * NTHREADS; (void)lane; (void)wave; (void)gw; (void)ngw; (void)gtid; (void)gthreads
#define XB_TMO      128
#define XB_XCNT(j)  (256  + 64 * (j))
#define XB_XSUB(j)  (1280 + 64 * (j))
#define XB_XGEN(j)  (2304 + 64 * (j))
#define XB_TOP      3328
#define XB_TOPGEN   3392
#define XCD_BAR_WORDS 3456
#define XB_SPIN_CAP (1u << 22)

__device__ __forceinline__ unsigned xb_ld(unsigned* p)              { return __hip_atomic_load(p, __ATOMIC_RELAXED, __HIP_MEMORY_SCOPE_AGENT); }
__device__ __forceinline__ unsigned xb_add(unsigned* p, unsigned v) { return __hip_atomic_fetch_add(p, v, __ATOMIC_RELAXED, __HIP_MEMORY_SCOPE_AGENT); }
__device__ __forceinline__ unsigned xb_xcc_id() { return (unsigned)__builtin_amdgcn_s_getreg((3 << 11) | 20) & 0xFu; }
#define XB_SPIN(cond, bar) do { unsigned _sp = 0; while (cond) { __builtin_amdgcn_s_sleep(1); \
    if ((++_sp & 255u) == 0u) { if (xb_ld(&(bar)[XB_TMO])) break; if (_sp > XB_SPIN_CAP) { atomicAdd(&(bar)[XB_TMO], 1u); break; } } } } while (0)

struct XcdBarrier { unsigned* bar; unsigned x; volatile LAS unsigned* st; };

__device__ __forceinline__ XcdBarrier xcd_barrier_post(unsigned* bar, volatile LAS unsigned* st) {
    XcdBarrier b; b.bar = bar; b.x = xb_xcc_id(); b.st = st;
    if (my_tid() == 0) (void)xb_add(&bar[XB_XCNT(b.x)], 1u);
    return b;
}
__device__ __forceinline__ void xcd_barrier_complete(unsigned* bar, unsigned x, unsigned& nloc, unsigned& nx) {
    const unsigned G = gridDim.x * gridDim.y * gridDim.z;
    unsigned sum, cnt, mine, sp = 0u;
    for (;;) {
        sum = 0u; cnt = 0u; mine = 0u;
#pragma unroll
        for (unsigned j = 0; j < 16; ++j) { const unsigned c = xb_ld(&bar[XB_XCNT(j)]); sum += c; cnt += (c > 0u) ? 1u : 0u; mine = (j == x) ? c : mine; }
        if (sum == G) break;
        __builtin_amdgcn_s_sleep(1);
        if ((++sp & 255u) == 0u) { if (xb_ld(&bar[XB_TMO])) break; if (sp > XB_SPIN_CAP) { atomicAdd(&bar[XB_TMO], 1u); break; } }
    }
    nloc = mine > 0u ? mine : 1u; nx = cnt > 0u ? cnt : 1u;
}
__device__ __forceinline__ void xcd_barrier(const XcdBarrier& b) {
    asm volatile("s_waitcnt vmcnt(0)" ::: "memory");
    __syncthreads();
    if (my_tid() == 0) {
        unsigned* bar = b.bar;
        __builtin_amdgcn_s_waitcnt(0);
        unsigned nloc = b.st[0], nx = b.st[1];
        if (nloc == 0u) { xcd_barrier_complete(bar, b.x, nloc, nx); b.st[0] = nloc; b.st[1] = nx; }
        const unsigned old = xb_add(&bar[XB_XSUB(b.x)], 1u);
        const unsigned gen = old / nloc;
        if (old + 1u == (gen + 1u) * nloc) {
            __builtin_amdgcn_fence(__ATOMIC_RELEASE, "agent");
            asm volatile("s_waitcnt vmcnt(0)" ::: "memory");
            const unsigned og = xb_add(&bar[XB_TOP], 1u);
            const unsigned tg = og / nx;
            if (og + 1u == (tg + 1u) * nx) xb_add(&bar[XB_TOPGEN], 1u);
            else XB_SPIN(xb_ld(&bar[XB_TOPGEN]) == tg, bar);
            __builtin_amdgcn_fence(__ATOMIC_ACQUIRE, "agent");
            xb_add(&bar[XB_XGEN(b.x)], 1u);
            asm volatile("s_waitcnt vmcnt(0)" ::: "memory");
        } else {
            XB_SPIN(xb_ld(&bar[XB_XGEN(b.x)]) == gen, bar);
            __builtin_amdgcn_fence(__ATOMIC_ACQUIRE, "agent");
            asm volatile("s_waitcnt vmcnt(0)" ::: "memory");
        }
    }
    __syncthreads();
}
namespace pg8 {
constexpr int BM = 256, BK = 64, HALF = 128, HTB = HALF * BK * 2, STAGE_BYTES = 8 * HTB, NXCD = 8, WGM = 8;
__host__ __device__ __forceinline__ int lds_byte(int r, int c) { const int st = (r >> 4) * 2 + (c >> 5), rr = r & 15, cc = c & 31, ob = rr * 64 + cc * 2; return st * 1024 + (ob ^ (((ob >> 9) & 1) << 5)); }
__host__ __device__ __forceinline__ void stage_rc(int b, int& R, int& C) { const int st = b / 1024, sb = b % 1024, swz = sb ^ (((sb >> 9) & 1) << 5); R = (st >> 1) * 16 + swz / 64; C = (st & 1) * 32 + (swz % 64) / 2; }
__host__ __device__ __forceinline__ int perm32(int rho) { const int n = rho >> 4, i = rho & 15; return 8 * (i >> 2) + 4 * n + (i & 3); }

struct Unit { int pm, pn; };
struct Gemm { const bf16* A; const bf16* Bt; int lda, ldb, K; const int* gidx; };

struct StaticOrder {
    int nM, nN, nwg, G, c;
    __host__ __device__ void init(int M, int N, int G_, int c_) { nM = M / BM; nN = N / BM; nwg = nM * nN; G = G_; c = c_; }
    __host__ __device__ bool next(int i, Unit& u) const {
        const long L = (long)i * G + c; if (L >= nwg) return false;
        int wgid = (int)L; { const int q = nwg / NXCD, r = nwg % NXCD, xcd = wgid % NXCD, off = wgid / NXCD; wgid = (xcd < r ? xcd * (q + 1) : r * (q + 1) + (xcd - r) * q) + off; }
        const int nig = WGM * nN, gid = wgid / nig, fm = gid * WGM, gsz = (nM - fm) < WGM ? (nM - fm) : WGM;
        u.pm = fm + ((wgid % nig) % gsz); u.pn = (wgid % nig) / gsz; return true;
    }
};

template <class Epi, class Sched, bool ALIGN_EPI, bool GATHER>
__device__ __forceinline__ void gemm_phase(LAS unsigned char* lds, const Gemm g, const Sched& S, const Epi& E) {
    int tid = my_tid(); asm volatile("" : "+v"(tid));
    const int wid = __builtin_amdgcn_readfirstlane(tid >> 6), lane = tid & 63, wr = wid >> 2, wc = wid & 3, fr = lane & 15, fq = lane >> 4;
    int Kq = g.K; asm volatile("" : "+s"(Kq));
    const int K = Kq, nt = K / BK;
    int RA[2], CA[2];
    unsigned voffA[2], voffB[2];
#pragma unroll
    for (int i = 0; i < 2; ++i) { int R, C; stage_rc(tid * 16 + i * 8192, R, C); const int Rb = Epi::PERM ? ((R & ~31) + perm32(R & 31)) : R;
        RA[i] = R; CA[i] = C; voffA[i] = (unsigned)(R * g.lda + C) * 2u; voffB[i] = (unsigned)(Rb * g.ldb + C) * 2u; }
    const size_t kstep = (size_t)(BK * 2);
    const size_t hstepB = (size_t)HALF * g.ldb * 2, tstepB = 2 * hstepB;
    const size_t hstepA = (size_t)HALF * g.lda * 2, tstepA = 2 * hstepA;
    const unsigned ldsw = (unsigned)wid * 1024u;
    const int aoff = lds_byte(wr * 64 + fr, fq * 8), boff = lds_byte(wc * 32 + fr, fq * 8);
#define PG8_SA(b, h) (((b) * 2 + (h)) * HTB)
#define PG8_SB(b, h) ((4 + (b) * 2 + (h)) * HTB)
#define PG8_STAGEB(bufoff, gbase) do { _Pragma("unroll") for (int _i = 0; _i < 2; ++_i) \
        __builtin_amdgcn_global_load_lds((const unsigned*)((const char*)(gbase) + voffB[_i]), (LAS unsigned*)(lds + (bufoff) + ldsw + _i * 8192), 16, 0, 0); } while (0)
#define PG8_STAGEA(bufoff, kptr, isnext, h) do { _Pragma("unroll") for (int _i = 0; _i < 2; ++_i) { const char* _p; \
        if constexpr (GATHER) _p = (const char*)(kptr) + ((isnext) ? nvo[h][_i] : cvo[h][_i]); else _p = (const char*)(kptr) + (size_t)(h) * hstepA + voffA[_i]; \
        __builtin_amdgcn_global_load_lds((const unsigned*)_p, (LAS unsigned*)(lds + (bufoff) + ldsw + _i * 8192), 16, 0, 0); } } while (0)
#define PG8_LDA(dst, b, h) do { _Pragma("unroll") for (int m = 0; m < 4; ++m) _Pragma("unroll") for (int k = 0; k < 2; ++k) dst[m][k] = *(const LAS bf16x8*)(lds + PG8_SA(b, h) + aoff + m * 2048 + k * 1024); } while (0)
#define PG8_LDB(dst, b, h) do { _Pragma("unroll") for (int n = 0; n < 2; ++n) _Pragma("unroll") for (int k = 0; k < 2; ++k) dst[n][k] = *(const LAS bf16x8*)(lds + PG8_SB(b, h) + boff + n * 2048 + k * 1024); } while (0)
#define PG8_MMA(ai, bj, At, Bt) do { __builtin_amdgcn_s_setprio(1); _Pragma("unroll") for (int m = 0; m < 4; ++m) _Pragma("unroll") for (int n = 0; n < 2; ++n) _Pragma("unroll") for (int k = 0; k < 2; ++k) \
        acc[ai][bj][m][n] = __builtin_amdgcn_mfma_f32_16x16x32_bf16(Bt[n][k], At[m][k], acc[ai][bj][m][n], 0, 0, 0); __builtin_amdgcn_s_setprio(0); } while (0)
#define PG8_WAIT_V(n) asm volatile("s_waitcnt vmcnt(" #n ")" ::: "memory")
#define PG8_WAIT_L(n) asm volatile("s_waitcnt lgkmcnt(" #n ")" ::: "memory")
#define PG8_BAR __builtin_amdgcn_s_barrier()
#define PG8_SCHED __builtin_amdgcn_sched_barrier(0)
#define PG8_VOA(vo, u) do { _Pragma("unroll") for (int _h = 0; _h < 2; ++_h) _Pragma("unroll") for (int _i = 0; _i < 2; ++_i) { \
        int _row = (u).pm * BM + _h * HALF + RA[_i]; if (GATHER) { _row = g.gidx[_row]; _row = _row < 0 ? 0 : _row; } \
        (vo)[_h][_i] = (unsigned)_row * (unsigned)(g.lda * 2) + (unsigned)(CA[_i] * 2); } } while (0)
    Unit cur, nxt; int ui = 0;
    if (!S.next(0, cur)) return;
    f32x4 acc[2][2][4][2];
#pragma unroll
    for (int a = 0; a < 2; ++a)
#pragma unroll
        for (int b = 0; b < 2; ++b)
#pragma unroll
            for (int m = 0; m < 4; ++m)
#pragma unroll
                for (int n = 0; n < 2; ++n) acc[a][b][m][n] = (f32x4){0.f, 0.f, 0.f, 0.f};
    bf16x8 At[4][2], B0[2][2], B1[2][2];
    unsigned cvo[2][2], nvo[2][2];
    if constexpr (GATHER) { PG8_VOA(cvo, cur); PG8_VOA(nvo, cur); }
    const char* cA = (const char*)g.A + (GATHER ? (size_t)0 : (size_t)cur.pm * tstepA); const char* cB = (const char*)g.Bt + (size_t)cur.pn * tstepB;
    PG8_STAGEB(PG8_SB(0, 0), cB); PG8_STAGEB(PG8_SB(0, 1), cB + hstepB); PG8_STAGEA(PG8_SA(0, 0), cA, false, 0); PG8_STAGEA(PG8_SA(0, 1), cA, false, 1);
    if (wr == 1) PG8_BAR;
    PG8_WAIT_V(2); PG8_BAR;
    PG8_STAGEB(PG8_SB(1, 0), cB + kstep); PG8_STAGEA(PG8_SA(1, 0), cA + kstep, false, 0); PG8_STAGEB(PG8_SB(1, 1), cB + hstepB + kstep);
    PG8_WAIT_V(6); PG8_BAR;
    for (;;) {
        const bool has_next = S.next(ui + 1, nxt);
        if constexpr (GATHER) { if (has_next) { PG8_VOA(nvo, nxt); } }
        const char* nA = (GATHER || !has_next) ? cA : (const char*)g.A + (size_t)nxt.pm * tstepA;
        const char* nB = has_next ? (const char*)g.Bt + (size_t)nxt.pn * tstepB : cB;
#pragma nounroll
        for (int t = 0; t < nt; t += 2) {
            const bool last = (t == nt - 2);
            const char* a1 = cA + (size_t)(t + 1) * kstep;
            const char* a2 = last ? nA : cA + (size_t)(t + 2) * kstep; const char* b2 = last ? nB : cB + (size_t)(t + 2) * kstep;
            const char* a3 = a2 + kstep; const char* b3 = b2 + kstep;
            PG8_LDB(B0, 0, 0); PG8_LDB(B1, 0, 1); PG8_SCHED; PG8_LDA(At, 0, 0); PG8_STAGEA(PG8_SA(1, 1), a1, false, 1);
            PG8_WAIT_V(8); PG8_WAIT_L(0); PG8_BAR; PG8_MMA(0, 0, At, B0); PG8_MMA(0, 1, At, B1); PG8_BAR; PG8_SCHED;
            PG8_LDA(At, 0, 1); PG8_STAGEB(PG8_SB(0, 0), b2); PG8_STAGEB(PG8_SB(0, 1), b2 + hstepB); PG8_STAGEA(PG8_SA(0, 0), a2, last, 0);
            PG8_WAIT_V(8); PG8_WAIT_L(0); PG8_BAR; PG8_MMA(1, 0, At, B0); PG8_MMA(1, 1, At, B1); PG8_BAR; PG8_SCHED;
            PG8_LDB(B0, 1, 0); PG8_LDB(B1, 1, 1); PG8_SCHED; PG8_LDA(At, 1, 0); PG8_STAGEA(PG8_SA(0, 1), a2, last, 1);
            PG8_WAIT_V(8); PG8_WAIT_L(0); PG8_BAR; PG8_MMA(0, 0, At, B0); PG8_MMA(0, 1, At, B1); PG8_BAR; PG8_SCHED;
            PG8_LDA(At, 1, 1); PG8_STAGEB(PG8_SB(1, 0), b3); PG8_STAGEB(PG8_SB(1, 1), b3 + hstepB); PG8_STAGEA(PG8_SA(1, 0), a3, last, 0);
            PG8_WAIT_V(8); PG8_WAIT_L(0); PG8_BAR; PG8_MMA(1, 0, At, B0); PG8_MMA(1, 1, At, B1); PG8_BAR; PG8_SCHED;
        }
        if constexpr (ALIGN_EPI) { if (wr == 0) PG8_BAR; }
        E(acc, cur, wr, wc, fr, fq);
        if (!has_next) break;
#pragma unroll
        for (int a = 0; a < 2; ++a)
#pragma unroll
            for (int b = 0; b < 2; ++b)
#pragma unroll
                for (int m = 0; m < 4; ++m)
#pragma unroll
                    for (int n = 0; n < 2; ++n) acc[a][b][m][n] = (f32x4){0.f, 0.f, 0.f, 0.f};
        cur = nxt; cA = nA; cB = nB; ++ui;
        if constexpr (GATHER) {
#pragma unroll
            for (int _h = 0; _h < 2; ++_h)
#pragma unroll
                for (int _i = 0; _i < 2; ++_i) cvo[_h][_i] = nvo[_h][_i]; }
        if constexpr (ALIGN_EPI) { if (wr == 1) PG8_BAR; }
    }
    PG8_WAIT_V(0);
    if constexpr (!ALIGN_EPI) { if (wr == 0) PG8_BAR; }
    PG8_BAR;
#undef PG8_SA
#undef PG8_SB
#undef PG8_STAGEA
#undef PG8_STAGEB
#undef PG8_LDA
#undef PG8_LDB
#undef PG8_MMA
#undef PG8_WAIT_V
#undef PG8_WAIT_L
#undef PG8_BAR
#undef PG8_SCHED
#undef PG8_VOA
}

template <class Epi, class Sched, bool GATHER>
__device__ __forceinline__ void gemm_phase_naive(const Gemm g, const Sched& S, const Epi& E) {
    const int tid = threadIdx.x, wid = tid >> 6, lane = tid & 63, wr = wid >> 2, wc = wid & 3, fr = lane & 15, fq = lane >> 4;
    Unit u;
    for (int ui = 0; S.next(ui, u); ++ui) {
        f32x4 acc[2][2][4][2];
#pragma unroll
        for (int a = 0; a < 2; ++a)
#pragma unroll
            for (int b = 0; b < 2; ++b)
#pragma unroll
                for (int m = 0; m < 4; ++m)
#pragma unroll
                    for (int n = 0; n < 2; ++n) acc[a][b][m][n] = (f32x4){0.f, 0.f, 0.f, 0.f};
        const bf16* arow[2][4];
#pragma unroll
        for (int ai = 0; ai < 2; ++ai)
#pragma unroll
            for (int m = 0; m < 4; ++m) { int r = u.pm * BM + ai * HALF + wr * 64 + m * 16 + fr; if (GATHER) { r = g.gidx[r]; r = r < 0 ? 0 : r; } arow[ai][m] = g.A + (size_t)r * g.lda; }
        for (int k = 0; k < g.K; k += 4) {
            float av[2][4][4];
#pragma unroll
            for (int ai = 0; ai < 2; ++ai)
#pragma unroll
                for (int m = 0; m < 4; ++m) { const u32x2 w = *(const u32x2*)(arow[ai][m] + k); av[ai][m][0] = bflo(w.x); av[ai][m][1] = bfhi(w.x); av[ai][m][2] = bflo(w.y); av[ai][m][3] = bfhi(w.y); }
#pragma unroll
            for (int bj = 0; bj < 2; ++bj)
#pragma unroll
                for (int n = 0; n < 2; ++n)
#pragma unroll
                    for (int e = 0; e < 4; ++e) {
                        const int col = u.pn * BM + bj * HALF + wc * 32 + (Epi::PERM ? (8 * fq + 4 * n) : (16 * n + 4 * fq)) + e;
                        const u32x2 w = *(const u32x2*)(g.Bt + (size_t)col * g.ldb + k);
                        const float b0 = bflo(w.x), b1 = bfhi(w.x), b2 = bflo(w.y), b3 = bfhi(w.y);
#pragma unroll
                        for (int ai = 0; ai < 2; ++ai)
#pragma unroll
                            for (int m = 0; m < 4; ++m) acc[ai][bj][m][n][e] += av[ai][m][0] * b0 + av[ai][m][1] * b1 + av[ai][m][2] * b2 + av[ai][m][3] * b3;
                    }
        }
        E(acc, u, wr, wc, fr, fq);
    }
    VM_WAIT(); __syncthreads();
}
}
namespace g128 {
using pg8::lds_byte; using pg8::stage_rc; using pg8::HTB; using pg8::BK;
struct Seg { const bf16* A; const bf16* B; int lda, ldb, nt; };
typedef f32x4 acc_t[2][4][2];

template <class Prog>
__device__ __forceinline__ void stream(LAS unsigned char* lds, Prog& P, int nunits, int first, int stride) {
    int tid = my_tid(); asm volatile("" : "+v"(tid));
    const int wid = __builtin_amdgcn_readfirstlane(tid >> 6), lane = tid & 63, wr = wid >> 2, wc = wid & 3, fr = lane & 15, fq = lane >> 4;
    int RA[2], CA[2], RB[2];
#pragma unroll
    for (int i = 0; i < 2; ++i) { stage_rc(tid * 16 + i * 8192, RA[i], CA[i]); RB[i] = (RA[i] & ~31) + pg8::perm32(RA[i] & 31); }
    const unsigned ldsw = (unsigned)wid * 1024u;
    const int aoff = lds_byte(wr * 64 + fr, fq * 8), boff = lds_byte(wc * 32 + fr, fq * 8);
#define G_SA(b) ((b) * HTB)
#define G_SB(b, h) ((2 + (b) * 2 + (h)) * HTB)
#define G_STAGE(bufoff, base, ld, kbyte, RR) do { _Pragma("unroll") for (int _i = 0; _i < 2; ++_i) \
        __builtin_amdgcn_global_load_lds((const unsigned*)((const char*)(base) + (size_t)(kbyte) + (unsigned)(RR[_i] * (ld) + CA[_i]) * 2u), (LAS unsigned*)(lds + (bufoff) + ldsw + _i * 8192), 16, 0, 0); } while (0)
#define G_STAGE_A(b, S, j) G_STAGE(G_SA(b), (S).A, (S).lda, (j) * 128, RA)
#define G_STAGE_B(b, h, S, j) G_STAGE(G_SB(b, h), (const char*)(S).B + (size_t)(h) * 128 * (S).ldb * 2, (S).ldb, (j) * 128, RB)
#define G_LDA(dst, b) do { _Pragma("unroll") for (int m = 0; m < 4; ++m) _Pragma("unroll") for (int k = 0; k < 2; ++k) dst[m][k] = *(const LAS bf16x8*)(lds + G_SA(b) + aoff + m * 2048 + k * 1024); } while (0)
#define G_LDB(dst, b, h) do { _Pragma("unroll") for (int n = 0; n < 2; ++n) _Pragma("unroll") for (int k = 0; k < 2; ++k) dst[n][k] = *(const LAS bf16x8*)(lds + G_SB(b, h) + boff + n * 2048 + k * 1024); } while (0)
#define G_MMA(bj, At, Bt) do { __builtin_amdgcn_s_setprio(1); _Pragma("unroll") for (int m = 0; m < 4; ++m) _Pragma("unroll") for (int n = 0; n < 2; ++n) _Pragma("unroll") for (int k = 0; k < 2; ++k) \
        acc[bj][m][n] = __builtin_amdgcn_mfma_f32_16x16x32_bf16(Bt[n][k], At[m][k], acc[bj][m][n], 0, 0, 0); __builtin_amdgcn_s_setprio(0); } while (0)
#define G_WAIT_V(n) asm volatile("s_waitcnt vmcnt(" #n ")" ::: "memory")
#define G_WAIT_L(n) asm volatile("s_waitcnt lgkmcnt(" #n ")" ::: "memory")
#define G_BAR __builtin_amdgcn_s_barrier()
#define G_SCHED __builtin_amdgcn_sched_barrier(0)
    if (first >= nunits) return;
    P.reset();
    int ucur = first, scur = 0;
    Seg cur, nxt;
    P.seg(ucur, scur, cur);
    acc_t acc;
    P.init(ucur, scur, acc, wr, wc, fr, fq);
    bf16x8 At[4][2], B0[2][2], B1[2][2];
    G_STAGE_B(0, 0, cur, 0); G_STAGE_A(0, cur, 0); G_STAGE_B(0, 1, cur, 0);
    if (wr == 1) G_BAR;
    G_WAIT_V(2); G_BAR;
    G_STAGE_A(1, cur, 1); G_STAGE_B(1, 0, cur, 1);
    G_WAIT_V(4); G_BAR;
#define G_TILE(t_, b_) do { const bool n1_ = ((t_) + 1 >= nt), n2_ = ((t_) + 2 >= nt); const int j1_ = n1_ ? ((t_) + 1 - nt) : ((t_) + 1), j2_ = n2_ ? ((t_) + 2 - nt) : ((t_) + 2); \
        G_LDB(B0, b_, 0); G_SCHED; G_LDA(At, b_); \
        if (n1_) G_STAGE_B((b_) ^ 1, 1, nxt, j1_); else G_STAGE_B((b_) ^ 1, 1, cur, j1_); \
        G_WAIT_V(6); G_WAIT_L(0); G_BAR; G_MMA(0, At, B0); G_BAR; G_SCHED; \
        G_LDB(B1, b_, 1); \
        if (n2_) { G_STAGE_A(b_, nxt, j2_); G_STAGE_B(b_, 0, nxt, j2_); } else { G_STAGE_A(b_, cur, j2_); G_STAGE_B(b_, 0, cur, j2_); } \
        G_WAIT_V(6); G_WAIT_L(0); G_BAR; G_MMA(1, At, B1); G_BAR; G_SCHED; } while (0)
    for (;;) {
        int unxt = ucur, snxt = scur + 1; bool more = true;
        if (snxt == Prog::NSEG) { snxt = 0; unxt = ucur + stride; if (unxt >= nunits) { more = false; unxt = ucur; snxt = scur; } }
        P.seg(unxt, snxt, nxt);
        int ntq = cur.nt; asm volatile("" : "+s"(ntq)); const int nt = ntq;
#pragma nounroll
        for (int t = 0; t < nt; t += 2) { G_TILE(t, 0); G_TILE(t + 1, 1); }
        P.done(ucur, scur, acc, wr, wc, fr, fq);
        if (!more) break;
        P.init(unxt, snxt, acc, wr, wc, fr, fq);
        ucur = unxt; scur = snxt; cur = nxt;
    }
    G_WAIT_V(0);
    if (wr == 0) G_BAR;
    G_BAR;
#undef G_SA
#undef G_SB
#undef G_STAGE
#undef G_STAGE_A
#undef G_STAGE_B
#undef G_LDA
#undef G_LDB
#undef G_MMA
#undef G_WAIT_V
#undef G_WAIT_L
#undef G_BAR
#undef G_SCHED
#undef G_TILE
}

struct MergeProg {
    static constexpr int NSEG = 8;
    const bf16* Hn; const bf16* zin; const bf16* wg; const bf16* wb; const float* bg; bf16* M;
    __device__ __forceinline__ void reset() {
#pragma unroll
        for (int a = 0; a < 2; ++a)
#pragma unroll
            for (int b = 0; b < 4; ++b)
#pragma unroll
                for (int c = 0; c < 2; ++c) { g[a][b][c] = (u32x2){0u, 0u}; macc[a][b][c] = (u32x2){0u, 0u}; } }
    u32x2 g[2][4][2]; u32x2 macc[2][4][2];
    __device__ __forceinline__ void seg(int u, int s, Seg& S) const {
        const int pm = u >> 2, pn = u & 3, k = s >> 1;
        if ((s & 1) == 0) { S.A = Hn + (size_t)pm * 128 * D; S.lda = D; S.B = wg + ((size_t)k * D + pn * 256) * D; S.ldb = D; S.nt = D / 64; }
        else { const int ycol = (k == 0) ? ZC_U : (k == 1) ? ZC_FQ : (k == 2) ? ZC_CQ : ZC_DQ;
               S.A = zin + (size_t)pm * 128 * ZP + ycol; S.lda = ZP; S.B = wb + ((size_t)k * D + pn * 256) * 256; S.ldb = 256; S.nt = 4; }
    }
    __device__ __forceinline__ void init(int u, int s, acc_t& acc, int wr, int wc, int fr, int fq) {
        const int pn = u & 3, k = s >> 1;
        if ((s & 1) == 0) {
#pragma unroll
            for (int bj = 0; bj < 2; ++bj)
#pragma unroll
                for (int n = 0; n < 2; ++n) { const f32x4 bv = *(const f32x4*)(bg + (size_t)k * D + pn * 256 + bj * 128 + wc * 32 + 8 * fq + 4 * n);
#pragma unroll
                    for (int m = 0; m < 4; ++m) acc[bj][m][n] = bv; }
            if (s == 0) {
#pragma unroll
                for (int bj = 0; bj < 2; ++bj)
#pragma unroll
                    for (int m = 0; m < 4; ++m)
#pragma unroll
                        for (int n = 0; n < 2; ++n) macc[bj][m][n] = (u32x2){0u, 0u}; }
        } else {
#pragma unroll
            for (int bj = 0; bj < 2; ++bj)
#pragma unroll
                for (int m = 0; m < 4; ++m)
#pragma unroll
                    for (int n = 0; n < 2; ++n) acc[bj][m][n] = (f32x4){0.f, 0.f, 0.f, 0.f};
        }
    }
    __device__ __forceinline__ void done(int u, int s, const acc_t& acc, int wr, int wc, int fr, int fq) {
        if ((s & 1) == 0) {
#pragma unroll
            for (int bj = 0; bj < 2; ++bj)
#pragma unroll
                for (int m = 0; m < 4; ++m)
#pragma unroll
                    for (int n = 0; n < 2; ++n) { const f32x4 a = acc[bj][m][n]; u32x2 w; w.x = pk2(sigmoidf_(a[0]), sigmoidf_(a[1])); w.y = pk2(sigmoidf_(a[2]), sigmoidf_(a[3])); g[bj][m][n] = w; }
        } else {
#pragma unroll
            for (int bj = 0; bj < 2; ++bj)
#pragma unroll
                for (int m = 0; m < 4; ++m)
#pragma unroll
                    for (int n = 0; n < 2; ++n) { const u32x2 w = g[bj][m][n], q = macc[bj][m][n]; const f32x4 v = (f32x4){bflo(q.x), bfhi(q.x), bflo(q.y), bfhi(q.y)} + (f32x4){bflo(w.x), bfhi(w.x), bflo(w.y), bfhi(w.y)} * acc[bj][m][n];
                        u32x2 r; r.x = pk2(v[0], v[1]); r.y = pk2(v[2], v[3]); macc[bj][m][n] = r; }
            if (s == NSEG - 1) { const int pm = u >> 2, pn = u & 3;
#pragma unroll
                for (int m = 0; m < 4; ++m) { bf16* rp = M + (size_t)(pm * 128 + wr * 64 + m * 16 + fr) * D + pn * 256 + wc * 32 + 8 * fq;
#pragma unroll
                    for (int bj = 0; bj < 2; ++bj) *(u32x4*)(rp + bj * 128) = (u32x4){macc[bj][m][0].x, macc[bj][m][0].y, macc[bj][m][1].x, macc[bj][m][1].y}; } }
        }
    }
};

struct PleProg {
    static constexpr int NSEG = 8;
    const bf16* pbf; const bf16* hp; const bf16* wup; const bf16* wpg; bf16* x;
    u32x2 uu[2][4][2];
    __device__ __forceinline__ void reset() {
#pragma unroll
        for (int a = 0; a < 2; ++a)
#pragma unroll
            for (int b = 0; b < 4; ++b)
#pragma unroll
                for (int c = 0; c < 2; ++c) uu[a][b][c] = (u32x2){0u, 0u}; }
    __device__ __forceinline__ void seg(int u, int s, Seg& S) const {
        const int pn = s >> 1;
        if ((s & 1) == 0) { S.A = pbf + (size_t)u * 128 * 256; S.lda = 256; S.B = wup + (size_t)pn * 256 * 256; S.ldb = 256; S.nt = 4; }
        else { S.A = hp + (size_t)u * 128 * D; S.lda = D; S.B = wpg + (size_t)pn * 256 * D; S.ldb = D; S.nt = D / 64; }
    }
    __device__ __forceinline__ void init(int u, int s, acc_t& acc, int wr, int wc, int fr, int fq) {
#pragma unroll
        for (int bj = 0; bj < 2; ++bj)
#pragma unroll
            for (int m = 0; m < 4; ++m)
#pragma unroll
                for (int n = 0; n < 2; ++n) acc[bj][m][n] = (f32x4){0.f, 0.f, 0.f, 0.f};
    }
    __device__ __forceinline__ void done(int u, int s, const acc_t& acc, int wr, int wc, int fr, int fq) {
        if ((s & 1) == 0) {
#pragma unroll
            for (int bj = 0; bj < 2; ++bj)
#pragma unroll
                for (int m = 0; m < 4; ++m)
#pragma unroll
                    for (int n = 0; n < 2; ++n) { const f32x4 a = acc[bj][m][n]; u32x2 w; w.x = pk2(a[0], a[1]); w.y = pk2(a[2], a[3]); uu[bj][m][n] = w; }
        } else { const int pn = s >> 1;
#pragma unroll
            for (int m = 0; m < 4; ++m) { bf16* rp = x + (size_t)(u * 128 + wr * 64 + m * 16 + fr) * D + pn * 256 + wc * 32 + 8 * fq; u32x4 xv[2];
#pragma unroll
                for (int bj = 0; bj < 2; ++bj) xv[bj] = *(const u32x4*)(rp + bj * 128);
#pragma unroll
                for (int bj = 0; bj < 2; ++bj) { const u32x4 xw = xv[bj]; f32x4 r[2];
#pragma unroll
                    for (int n = 0; n < 2; ++n) { const u32x2 w = uu[bj][m][n]; f32x4 v = acc[bj][m][n];
                        v[0] = sigmoidf_(v[0]); v[1] = sigmoidf_(v[1]); v[2] = sigmoidf_(v[2]); v[3] = sigmoidf_(v[3]);
                        const f32x4 xo = n == 0 ? (f32x4){bflo(xw.x), bfhi(xw.x), bflo(xw.y), bfhi(xw.y)} : (f32x4){bflo(xw.z), bfhi(xw.z), bflo(xw.w), bfhi(xw.w)};
                        r[n] = xo + (f32x4){bflo(w.x), bfhi(w.x), bflo(w.y), bfhi(w.y)} * v; }
                    *(u32x4*)(rp + bj * 128) = (u32x4){pk2(r[0][0], r[0][1]), pk2(r[0][2], r[0][3]), pk2(r[1][0], r[1][1]), pk2(r[1][2], r[1][3])}; } } }
    }
};
}
namespace epi {
using pg8::Unit; using pg8::BM; using pg8::HALF;
__device__ __forceinline__ void epi_fence() { asm volatile("" ::: "memory"); }
#define EPI_FENCE epi_fence()
#define EPI_LOOP_ROWS for (int ai = 0; ai < 2; ++ai) _Pragma("unroll") for (int m = 0; m < 4; ++m)
#define EPI_LOOP_COLS for (int bj = 0; bj < 2; ++bj) _Pragma("unroll") for (int n = 0; n < 2; ++n)
#define EPI_ROW (u.pm * BM + ai * HALF + wr * 64 + m * 16 + fr)
#define EPI_COLT (bj * HALF + wc * 32 + n * 16 + 4 * fq)
typedef f32x4 acc_t[2][2][4][2];
#define EPI_C8(bj_) ((bj_) * HALF + wc * 32 + 8 * fq)
__device__ __forceinline__ u32x4 pack8(f32x4 a, f32x4 b) { return (u32x4){pk2(a[0], a[1]), pk2(a[2], a[3]), pk2(b[0], b[1]), pk2(b[2], b[3])}; }
__device__ __forceinline__ u32x2 pack4(f32x4 v) { u32x2 w; w.x = pk2(v[0], v[1]); w.y = pk2(v[2], v[3]); return w; }
__device__ __forceinline__ f32x4 unpack4(u32x2 w) { return (f32x4){bflo(w.x), bfhi(w.x), bflo(w.y), bfhi(w.y)}; }

struct EpiStore {
    static constexpr bool PERM = true;
    bf16* O; int ldc; int pn0;
    __device__ __forceinline__ void operator()(const acc_t& acc, const Unit& u, int wr, int wc, int fr, int fq) const {
#pragma unroll
        EPI_LOOP_ROWS { bf16* rp = O + (size_t)EPI_ROW * ldc + (u.pn - pn0) * BM + wc * 32 + 8 * fq;
#pragma unroll
            for (int bj = 0; bj < 2; ++bj) { const u32x2 lo = pack4(acc[ai][bj][m][0]), hi = pack4(acc[ai][bj][m][1]); *(u32x4*)(rp + bj * HALF) = (u32x4){lo.x, lo.y, hi.x, hi.y}; } }
    }
};
struct EpiRowScale {
    static constexpr bool PERM = true;
    bf16* O; int ldc; const float* rs;
    __device__ __forceinline__ void operator()(const acc_t& acc, const Unit& u, int wr, int wc, int fr, int fq) const {
        float sv[2][4];
#pragma unroll
        EPI_LOOP_ROWS sv[ai][m] = rs[EPI_ROW];
#pragma unroll
        EPI_LOOP_ROWS { const int row = EPI_ROW; const float s = sv[ai][m]; bf16* rp = O + (size_t)row * ldc + u.pn * BM;
#pragma unroll
            for (int bj = 0; bj < 2; ++bj) *(u32x4*)(rp + EPI_C8(bj)) = pack8(acc[ai][bj][m][0] * s, acc[ai][bj][m][1] * s); }
    }
};
struct EpiMlaQ {
    static constexpr bool PERM = false;
    bf16* O; const float* rs; const float* cosT; const float* sinT;
    __device__ __forceinline__ void operator()(const acc_t& acc, const Unit& u, int wr, int wc, int fr, int fq) const {
        float sv[2][4]; f32x4 csv[2], snv[2];
#pragma unroll
        EPI_LOOP_ROWS sv[ai][m] = rs[EPI_ROW];
        { const int row = u.pm * BM + wr * 64 + fr; csv[0] = *(const f32x4*)(cosT + (size_t)row * 16 + 4 * fq); snv[0] = *(const f32x4*)(sinT + (size_t)row * 16 + 4 * fq); }
#pragma unroll
        for (int it = 0; it < 8; ++it) { const int ai = it >> 2, m = it & 3;
            if (it + 1 < 8) { const int row = u.pm * BM + ((it + 1) >> 2) * HALF + wr * 64 + ((it + 1) & 3) * 16 + fr;
                csv[(it + 1) & 1] = *(const f32x4*)(cosT + (size_t)row * 16 + 4 * fq); snv[(it + 1) & 1] = *(const f32x4*)(sinT + (size_t)row * 16 + 4 * fq); }
            const int row = EPI_ROW; const float s = sv[ai][m]; bf16* rp = O + (size_t)row * 512 + u.pn * BM;
            const f32x4 cs = csv[it & 1], sn = snv[it & 1];
#pragma unroll
            for (int bj = 0; bj < 2; ++bj) { const int grp = u.pn * 8 + bj * 4 + wc;
                f32x4 t1 = acc[ai][bj][m][0] * s, t2 = acc[ai][bj][m][1] * s;
                if (grp % 3 == 2) { const f32x4 a = t1 * cs - t2 * sn, b = t2 * cs + t1 * sn; t1 = a; t2 = b; }
                *(u32x2*)(rp + bj * HALF + wc * 32 + 4 * fq) = pack4(t1); *(u32x2*)(rp + bj * HALF + wc * 32 + 16 + 4 * fq) = pack4(t2); } }
    }
};
struct EpiGate {
    static constexpr bool PERM = false;
    bf16* G; const float* bias;
    __device__ __forceinline__ void operator()(const acc_t& acc, const Unit& u, int wr, int wc, int fr, int fq) const {
        f32x4 bv[2][2];
#pragma unroll
        EPI_LOOP_COLS bv[bj][n] = *(const f32x4*)(bias + u.pn * BM + EPI_COLT);
#pragma unroll
        EPI_LOOP_ROWS { bf16* rp = G + (size_t)EPI_ROW * D + u.pn * BM;
#pragma unroll
            EPI_LOOP_COLS { f32x4 v = acc[ai][bj][m][n] + bv[bj][n];
                v[0] = sigmoidf_(v[0]); v[1] = sigmoidf_(v[1]); v[2] = sigmoidf_(v[2]); v[3] = sigmoidf_(v[3]);
                *(u32x2*)(rp + EPI_COLT) = pack4(v); } }
    }
};
#define EPI_IT_ROW(it_) (u.pm * BM + ((it_) >> 2) * HALF + wr * 64 + ((it_) & 3) * 16 + fr)
#define EPI_C4(c_) (((c_) >> 1) * HALF + wc * 32 + ((c_) & 1) * 16 + 4 * fq)
struct EpiMerge {
    static constexpr bool PERM = false;
    const bf16* G; bf16* M; int first;
    __device__ __forceinline__ void operator()(const acc_t& acc, const Unit& u, int wr, int wc, int fr, int fq) const {
        u32x2 gv[2][4], mv[2][4];
#define EPI_LD(it_) do { const size_t ro_ = (size_t)EPI_IT_ROW(it_) * D + u.pn * BM; _Pragma("unroll") for (int c = 0; c < 4; ++c) { gv[(it_) & 1][c] = *(const u32x2*)(G + ro_ + EPI_C4(c)); \
            mv[(it_) & 1][c] = first ? (u32x2){0u, 0u} : *(const u32x2*)(M + ro_ + EPI_C4(c)); } } while (0)
        EPI_LD(0);
#pragma unroll
        for (int it = 0; it < 8; ++it) { if (it + 1 < 8) EPI_LD(it + 1);
            const size_t ro = (size_t)EPI_IT_ROW(it) * D + u.pn * BM;
#pragma unroll
            for (int c = 0; c < 4; ++c) { const f32x4 v = unpack4(gv[it & 1][c]) * acc[it >> 2][c >> 1][it & 3][c & 1] + unpack4(mv[it & 1][c]); *(u32x2*)(M + ro + EPI_C4(c)) = pack4(v); } }
#undef EPI_LD
    }
};
struct EpiRes {
    static constexpr bool PERM = true;
    XSrc xin; bf16* xout;
    __device__ __forceinline__ void operator()(const acc_t& acc, const Unit& u, int wr, int wc, int fr, int fq) const {
        f32x4 xv[2][2][2];
#define EPI_LD(it_) do { const size_t ro_ = (size_t)EPI_IT_ROW(it_) * D + u.pn * BM; _Pragma("unroll") for (int bj = 0; bj < 2; ++bj) { \
            if (xin.f) { xv[(it_) & 1][bj][0] = *(const f32x4*)(xin.f + ro_ + EPI_C8(bj)); xv[(it_) & 1][bj][1] = *(const f32x4*)(xin.f + ro_ + EPI_C8(bj) + 4); } \
            else { const u32x4 w_ = *(const u32x4*)(xin.b + ro_ + EPI_C8(bj)); xv[(it_) & 1][bj][0] = (f32x4){bflo(w_.x), bfhi(w_.x), bflo(w_.y), bfhi(w_.y)}; xv[(it_) & 1][bj][1] = (f32x4){bflo(w_.z), bfhi(w_.z), bflo(w_.w), bfhi(w_.w)}; } } } while (0)
        EPI_LD(0);
#pragma unroll
        for (int it = 0; it < 8; ++it) { if (it + 1 < 8) EPI_LD(it + 1);
            const size_t ro = (size_t)EPI_IT_ROW(it) * D + u.pn * BM;
#pragma unroll
            for (int bj = 0; bj < 2; ++bj) *(u32x4*)(xout + ro + EPI_C8(bj)) = pack8(xv[it & 1][bj][0] + acc[it >> 2][bj][it & 3][0], xv[it & 1][bj][1] + acc[it >> 2][bj][it & 3][1]); }
#undef EPI_LD
    }
};
struct EpiPle {
    static constexpr bool PERM = false;
    const bf16* U; float* x;
    __device__ __forceinline__ void operator()(const acc_t& acc, const Unit& u, int wr, int wc, int fr, int fq) const {
        f32x4 xv[2][4]; u32x2 uv[2][4];
#define EPI_LD(it_) do { const size_t ro_ = (size_t)EPI_IT_ROW(it_) * D + u.pn * BM; _Pragma("unroll") for (int c = 0; c < 4; ++c) { xv[(it_) & 1][c] = *(const f32x4*)(x + ro_ + EPI_C4(c)); uv[(it_) & 1][c] = *(const u32x2*)(U + ro_ + EPI_C4(c)); } } while (0)
        EPI_LD(0);
#pragma unroll
        for (int it = 0; it < 8; ++it) { if (it + 1 < 8) EPI_LD(it + 1);
            const size_t ro = (size_t)EPI_IT_ROW(it) * D + u.pn * BM;
#pragma unroll
            for (int c = 0; c < 4; ++c) { f32x4 v = acc[it >> 2][c >> 1][it & 3][c & 1];
                v[0] = sigmoidf_(v[0]); v[1] = sigmoidf_(v[1]); v[2] = sigmoidf_(v[2]); v[3] = sigmoidf_(v[3]);
                *(f32x4*)(x + ro + EPI_C4(c)) = xv[it & 1][c] + unpack4(uv[it & 1][c]) * v; } }
#undef EPI_LD
    }
};
struct EpiSwiglu {
    static constexpr bool PERM = true;
    bf16* O; int ldc; int npt;
    __device__ __forceinline__ void operator()(const acc_t& acc, const Unit& u, int wr, int wc, int fr, int fq) const {
        const int ct = (u.pn % npt) * HALF;
#pragma unroll
        EPI_LOOP_ROWS { bf16* rp = O + (size_t)EPI_ROW * ldc + ct + wc * 32 + 8 * fq; u32x2 w[2];
#pragma unroll
            for (int n = 0; n < 2; ++n) { const f32x4 a = acc[ai][0][m][n], b = acc[ai][1][m][n]; f32x4 v;
#pragma unroll
                for (int e = 0; e < 4; ++e) v[e] = a[e] * sigmoidf_(a[e]) * b[e];
                w[n] = pack4(v); }
            *(u32x4*)rp = (u32x4){w[0].x, w[0].y, w[1].x, w[1].y}; }
    }
};
struct EpiGlu {
    static constexpr bool PERM = true;
    bf16* Y; int ldc;
    __device__ __forceinline__ void operator()(const acc_t& acc, const Unit& u, int wr, int wc, int fr, int fq) const {
        u32x4 yv[2][2];
#define EPI_LD(it_) do { const bf16* rp_ = Y + (size_t)EPI_IT_ROW(it_) * ldc + u.pn * BM; _Pragma("unroll") for (int bj = 0; bj < 2; ++bj) yv[(it_) & 1][bj] = *(const u32x4*)(rp_ + EPI_C8(bj)); } while (0)
        EPI_LD(0);
#pragma unroll
        for (int it = 0; it < 8; ++it) { if (it + 1 < 8) EPI_LD(it + 1);
            bf16* rp = Y + (size_t)EPI_IT_ROW(it) * ldc + u.pn * BM;
#pragma unroll
            for (int bj = 0; bj < 2; ++bj) { const u32x4 w = yv[it & 1][bj]; f32x4 a = acc[it >> 2][bj][it & 3][0], b = acc[it >> 2][bj][it & 3][1];
                a[0] = bflo(w.x) * sigmoidf_(a[0]); a[1] = bfhi(w.x) * sigmoidf_(a[1]); a[2] = bflo(w.y) * sigmoidf_(a[2]); a[3] = bfhi(w.y) * sigmoidf_(a[3]);
                b[0] = bflo(w.z) * sigmoidf_(b[0]); b[1] = bfhi(w.z) * sigmoidf_(b[1]); b[2] = bflo(w.w) * sigmoidf_(b[2]); b[3] = bfhi(w.w) * sigmoidf_(b[3]);
                *(u32x4*)(rp + EPI_C8(bj)) = pack8(a, b); } }
#undef EPI_LD
    }
};
struct EpiMoeDown {
    static constexpr bool PERM = true;
    bf16* Y; const float* slot_gate;
    __device__ __forceinline__ void operator()(const acc_t& acc, const Unit& u, int wr, int wc, int fr, int fq) const {
        const int ct = (u.pn & 3) * BM;
        float gv[2][4];
#pragma unroll
        EPI_LOOP_ROWS gv[ai][m] = slot_gate[EPI_ROW];
#pragma unroll
        EPI_LOOP_ROWS { const int row = EPI_ROW; const float gt = gv[ai][m]; bf16* rp = Y + (size_t)row * D + ct;
#pragma unroll
            for (int bj = 0; bj < 2; ++bj) *(u32x4*)(rp + EPI_C8(bj)) = pack8(acc[ai][bj][m][0] * gt, acc[ai][bj][m][1] * gt); }
    }
};
}
namespace att {
constexpr int MODE_FOX = 0, MODE_MLA = 1, MODE_BAND = 2;
constexpr float LOG2E = 1.4426950408889634f;
struct Tensors {
    const bf16* Q; int ldq;
    const bf16* K; int ldk;
    const bf16* K2;
    const bf16* V; int ldv;
    bf16* O; int ldo;
    const float* cdec;
    const float* relb;
    int qhs, khs, vhs, ohs;
    const unsigned* qmax; const unsigned* kmax;
};
template <int DQK> struct Lay { static constexpr int KS = DQK * 2 + 16, KB = 64 * KS, VB = 64 * 128, CB = 256, BUF = KB + VB + CB; };
constexpr int ATT_LDS_TAB = 2 * Lay<96>::BUF;
constexpr int ATT_LDS_BYTES = ATT_LDS_TAB + 520 * 4;
__device__ __forceinline__ int crow(int r, int hi) { return (r & 3) + 8 * (r >> 2) + 4 * hi; }
typedef short v4i16_t __attribute__((ext_vector_type(4)));
__device__ __forceinline__ s16x4 vtr(const LAS unsigned char* p) { return __builtin_bit_cast(s16x4, __builtin_amdgcn_ds_read_tr16_b64_v4i16((LAS v4i16_t*)p)); }

template <int MODE>
__device__ __forceinline__ void attn_unit(const Tensors& T, int b, int h, int qb, LAS unsigned char* lds) {
    constexpr int DQK = (MODE == MODE_MLA) ? 96 : 64, NKS = DQK / 16;
    typedef Lay<DQK> LY;
    int tid = my_tid(); asm volatile("" : "+v"(tid));
    const int lane = tid & 63, r32 = lane & 31, hi = lane >> 5; const int wid = __builtin_amdgcn_readfirstlane(tid >> 6);
    const int rowb = b * SEQ, q0 = qb * 256;
    const float sc2 = ((MODE == MODE_MLA) ? 0.10206207261596575f : 0.125f) * LOG2E;
    const int cw = 4 * qb + (wid >> 1);
    const int t_lo = (MODE == MODE_BAND) ? ((4 * qb - 8) > 0 ? (4 * qb - 8) : 0) : 0, t_hi = 4 * qb + 4;
    const int qrow = rowb + q0 + wid * 32 + r32;
    bf16x8 qf[NKS];
    { const bf16* qp = T.Q + (size_t)qrow * T.ldq + h * T.qhs + hi * 8;
#pragma unroll
      for (int ks = 0; ks < NKS; ++ks) qf[ks] = *(const bf16x8*)(qp + ks * 16); }
    float cq = 0.f; if (MODE == MODE_FOX) cq = T.cdec[(size_t)qrow * 4 + h];
    LAS float* tab = (LAS float*)(lds + ATT_LDS_TAB);
    if (MODE == MODE_BAND) { for (int i = tid; i < 513; i += NTHREADS) tab[i] = T.relb[h * 513 + i] * LOG2E; }
    u32x4 kreg0[2] = {}, kreg1[2] = {}, vreg[2] = {}; float creg[2] = {0.f, 0.f};
    const int srow = tid >> 3, sch = tid & 7;
#define ATT_KADDR(c_) (((c_) % 12 < 8) ? (const u32x4*)(T.K + (kr_ + (c_) / 12) * T.ldk + h * T.khs + ((c_) % 12) * 8) : (const u32x4*)(T.K2 + (kr_ + (c_) / 12) * 32 + ((c_) % 12 - 8) * 8))
#define ATT_LOAD_TILE(t_, r_) do { const size_t kr_ = (size_t)(rowb + (t_) * 64); \
        if (MODE == MODE_MLA) { kreg0[r_] = *ATT_KADDR(tid); if (tid < 256) kreg1[r_] = *ATT_KADDR(tid + 512); } \
        else { kreg0[r_] = *(const u32x4*)(T.K + (kr_ + srow) * T.ldk + h * T.khs + sch * 8); } \
        vreg[r_] = *(const u32x4*)(T.V + (kr_ + srow) * T.ldv + h * T.vhs + sch * 8); \
        if (MODE == MODE_FOX) { if (tid < 64) creg[r_] = T.cdec[(kr_ + tid) * 4 + h]; } } while (0)
#define ATT_STORE_TILE(buf_, r_) do { LAS unsigned char* base_ = lds + (buf_) * LY::BUF; \
        if (MODE == MODE_MLA) { *(LAS u32x4*)(base_ + (tid / 12) * LY::KS + (tid % 12) * 16) = kreg0[r_]; \
            if (tid < 256) *(LAS u32x4*)(base_ + ((tid + 512) / 12) * LY::KS + ((tid + 512) % 12) * 16) = kreg1[r_]; } \
        else { *(LAS u32x4*)(base_ + srow * LY::KS + sch * 16) = kreg0[r_]; } \
        *(LAS u32x4*)(base_ + LY::KB + srow * 128 + ((sch * 16) ^ (((srow >> 1) & 1) << 6))) = vreg[r_]; \
        if (MODE == MODE_FOX) { if (tid < 64) *(LAS float*)(base_ + LY::KB + LY::VB + tid * 4) = creg[r_]; } } while (0)
    float mrun = -INFINITY, lrun = 0.f;
    f32x16 o0 = {}, o1 = {};
    const int G = lane >> 4, qi = (lane & 15) >> 2, pi = lane & 3;
    const int vb0 = (4 * hi + qi) * 128 + 64 * (0 ^ (qi >> 1)) + 32 * (G & 1) + 8 * pi;
    const int vb1 = (4 * hi + qi) * 128 + 64 * (1 ^ (qi >> 1)) + 32 * (G & 1) + 8 * pi;
    int t_min = t_lo;
    if (MODE == MODE_FOX) {
        LAS int* tm = (LAS int*)(lds + ATT_LDS_TAB);
        if (tid == 0) tm[0] = t_hi - 1;
        __syncthreads();
        if (tid < t_hi) {
            const float q2 = __uint_as_float(T.qmax[(b * 4 + h) * 32 + qb]), k2 = __uint_as_float(T.kmax[b * 4 + h]);
            const float thr = 0.125f * sqrtf(q2) * 2.0f * sqrtf(k2) * 1.02f + 112.0f;
            const float cfirst = T.cdec[(size_t)(rowb + q0) * 4 + h], clast = T.cdec[(size_t)(rowb + tid * 64 + 63) * 4 + h];
            if (!(clast - cfirst > thr)) __hip_atomic_fetch_min(tm, tid, __ATOMIC_RELAXED, __HIP_MEMORY_SCOPE_WORKGROUP);
        }
        __syncthreads();
        t_min = tm[0];
    }
    const int n_t = t_hi - t_min;
#define ATT_TILE(i_) ((MODE == MODE_FOX) ? (t_hi - 1 - (i_)) : (t_min + (i_)))
    ATT_LOAD_TILE(ATT_TILE(0), 0); ATT_STORE_TILE(0, 0);
    if (n_t > 1) ATT_LOAD_TILE(ATT_TILE(1), 1);
    if (n_t > 2) ATT_LOAD_TILE(ATT_TILE(2), 0);
    __syncthreads();
    for (int it0 = 0; it0 < n_t; it0 += 2) {
#pragma unroll
      for (int half = 0; half < 2; ++half) { const int it = it0 + half; if (it < n_t) {
        const int t = ATT_TILE(it);
        const int buf = half;
        const bool active = (MODE == MODE_BAND) ? (t <= cw && t >= cw - 8) : (t <= cw);
        if (active) {
            const LAS unsigned char* kb = lds + buf * LY::BUF;
            const LAS unsigned char* vbuf = kb + LY::KB;
            f32x16 p0 = {}, p1 = {};
            bf16x8 ka[NKS], kc[NKS];
#pragma unroll
            for (int ks = 0; ks < NKS; ++ks) { ka[ks] = *(const LAS bf16x8*)(kb + r32 * LY::KS + (ks * 16 + hi * 8) * 2); kc[ks] = *(const LAS bf16x8*)(kb + (32 + r32) * LY::KS + (ks * 16 + hi * 8) * 2); }
            __builtin_amdgcn_sched_barrier(0);
#pragma unroll
            for (int ks = 0; ks < NKS; ++ks) { p0 = __builtin_amdgcn_mfma_f32_32x32x16_bf16(ka[ks], qf[ks], p0, 0, 0, 0); p1 = __builtin_amdgcn_mfma_f32_32x32x16_bf16(kc[ks], qf[ks], p1, 0, 0, 0); }
            s16x4 vl0[4], vh0[4], vl1[4], vh1[4];
#pragma unroll
            for (int s4 = 0; s4 < 4; ++s4) { vl0[s4] = vtr(vbuf + vb0 + s4 * 2048); vh0[s4] = vtr(vbuf + vb0 + s4 * 2048 + 1024); vl1[s4] = vtr(vbuf + vb1 + s4 * 2048); vh1[s4] = vtr(vbuf + vb1 + s4 * 2048 + 1024); }
            __builtin_amdgcn_sched_barrier(0);
            if (MODE == MODE_FOX) {
                const LAS float* cb = (const LAS float*)(vbuf + LY::VB);
                const float cq2 = cq * LOG2E;
#pragma unroll
                for (int a = 0; a < 4; ++a) {
                    const f32x4 c0 = *(const LAS f32x4*)(cb + 8 * a + 4 * hi), c1 = *(const LAS f32x4*)(cb + 32 + 8 * a + 4 * hi);
#pragma unroll
                    for (int e = 0; e < 4; ++e) { p0[4 * a + e] = p0[4 * a + e] * sc2 + (cq2 - c0[e] * LOG2E); p1[4 * a + e] = p1[4 * a + e] * sc2 + (cq2 - c1[e] * LOG2E); }
                }
                if (t == cw) { const int ql = 32 * (wid & 1) + r32;
#pragma unroll
                    for (int r = 0; r < 16; ++r) { const int kv = crow(r, hi); if (kv > ql) p0[r] = -INFINITY; if (kv + 32 > ql) p1[r] = -INFINITY; } }
            } else if (MODE == MODE_BAND) {
                const int dq = (q0 + wid * 32 + r32) - t * 64;
#pragma unroll
                for (int r = 0; r < 16; ++r) { const int kv = crow(r, hi);
                    int i0 = dq - kv, i1 = dq - kv - 32; i0 = i0 < -256 ? -256 : (i0 > 256 ? 256 : i0); i1 = i1 < -256 ? -256 : (i1 > 256 ? 256 : i1);
                    p0[r] = p0[r] * sc2 + tab[i0 + 256]; p1[r] = p1[r] * sc2 + tab[i1 + 256]; }
            }
            float mx = fmaxf(p0[0], p1[0]);
#pragma unroll
            for (int r = 1; r < 16; ++r) mx = fmaxf(mx, fmaxf(p0[r], p1[r]));
            { auto rr = __builtin_amdgcn_permlane32_swap(__float_as_uint(mx), __float_as_uint(mx), false, false); mx = fmaxf(__uint_as_float(rr[0]), __uint_as_float(rr[1])); }
            if (MODE == MODE_MLA) mx *= sc2;
            const float mnew = fmaxf(mrun, mx);
            if (__any(mnew > mrun)) {
                const float alpha = __builtin_amdgcn_exp2f(mrun - mnew);
                lrun *= alpha;
#pragma unroll
                for (int r = 0; r < 16; ++r) { o0[r] *= alpha; o1[r] *= alpha; }
                mrun = mnew;
            }
            float rs = 0.f;
#pragma unroll
            for (int r = 0; r < 16; ++r) {
                if (MODE == MODE_MLA) { p0[r] = __builtin_amdgcn_exp2f(__builtin_fmaf(p0[r], sc2, -mrun)); p1[r] = __builtin_amdgcn_exp2f(__builtin_fmaf(p1[r], sc2, -mrun)); }
                else { p0[r] = __builtin_amdgcn_exp2f(p0[r] - mrun); p1[r] = __builtin_amdgcn_exp2f(p1[r] - mrun); }
                rs += p0[r] + p1[r]; }
            lrun += rs;
#pragma unroll
            for (int s4 = 0; s4 < 4; ++s4) {
                u32x4 pw;
                if (s4 < 2) { const int o = 8 * (s4 & 1); pw.x = pk2(p0[o], p0[o + 1]); pw.y = pk2(p0[o + 2], p0[o + 3]); pw.z = pk2(p0[o + 4], p0[o + 5]); pw.w = pk2(p0[o + 6], p0[o + 7]); }
                else        { const int o = 8 * (s4 & 1); pw.x = pk2(p1[o], p1[o + 1]); pw.y = pk2(p1[o + 2], p1[o + 3]); pw.z = pk2(p1[o + 4], p1[o + 5]); pw.w = pk2(p1[o + 6], p1[o + 7]); }
                const bf16x8 pf = __builtin_bit_cast(bf16x8, pw);
                const s16x4 l0 = vl0[s4], h0 = vh0[s4], l1 = vl1[s4], h1 = vh1[s4];
                const bf16x8 vf0 = (bf16x8){l0[0], l0[1], l0[2], l0[3], h0[0], h0[1], h0[2], h0[3]};
                const bf16x8 vf1 = (bf16x8){l1[0], l1[1], l1[2], l1[3], h1[0], h1[1], h1[2], h1[3]};
                o0 = __builtin_amdgcn_mfma_f32_32x32x16_bf16(vf0, pf, o0, 0, 0, 0);
                o1 = __builtin_amdgcn_mfma_f32_32x32x16_bf16(vf1, pf, o1, 0, 0, 0);
            }
        }
        if (it + 1 < n_t) ATT_STORE_TILE(half ^ 1, half ^ 1);
        if (it + 3 < n_t) ATT_LOAD_TILE(ATT_TILE(it + 3), half ^ 1);
        __syncthreads();
      } }
    }
    { auto rr = __builtin_amdgcn_permlane32_swap(__float_as_uint(lrun), __float_as_uint(lrun), false, false); lrun = __uint_as_float(rr[0]) + __uint_as_float(rr[1]); }
    const float inv = 1.0f / lrun;
    bf16* op = T.O + (size_t)qrow * T.ldo + h * T.ohs;
#pragma unroll
    for (int a = 0; a < 4; ++a) {
        u32x2 w0, w1;
        w0.x = pk2(o0[4 * a] * inv, o0[4 * a + 1] * inv); w0.y = pk2(o0[4 * a + 2] * inv, o0[4 * a + 3] * inv);
        w1.x = pk2(o1[4 * a] * inv, o1[4 * a + 1] * inv); w1.y = pk2(o1[4 * a + 2] * inv, o1[4 * a + 3] * inv);
        *(u32x2*)(op + 8 * a + 4 * hi) = w0; *(u32x2*)(op + 32 + 8 * a + 4 * hi) = w1;
    }
}

template <int MODE>
__device__ __forceinline__ void attn_phase(const Tensors& T, LAS unsigned char* lds) {
    const int G = gridDim.x, bx = blockIdx.x, vcu = (G % 8 == 0) ? (bx % 8) * (G / 8) + bx / 8 : bx;
    for (int pr = vcu; pr < 256; pr += G) {
        const int bh = pr >> 4, s = pr & 15;
        attn_unit<MODE>(T, bh >> 2, bh & 3, s, lds);
        attn_unit<MODE>(T, bh >> 2, bh & 3, 31 - s, lds);
    }
}

template <int MODE>
__device__ __forceinline__ void attn_naive(const Tensors& T) {
    BODY_IDS();
    constexpr int DQK = (MODE == MODE_MLA) ? 96 : 64;
    const float sc = (MODE == MODE_MLA) ? 0.10206207261596575f : 0.125f;
    for (int idx = gtid; idx < NTOK * 4; idx += gthreads) {
        const int h = idx / NTOK, row = idx % NTOK, b = row / SEQ, tpos = row % SEQ, rowb = b * SEQ;
        float q[DQK], o[64];
#pragma unroll
        for (int d = 0; d < DQK; ++d) q[d] = bf2f(T.Q[(size_t)row * T.ldq + h * T.qhs + d]) * sc;
#pragma unroll
        for (int d = 0; d < 64; ++d) o[d] = 0.f;
        float m = -INFINITY, l = 0.f;
        const int ck = tpos / 64;
        const int k_lo = (MODE == MODE_BAND) ? ((ck - 8) > 0 ? (ck - 8) * 64 : 0) : 0;
        const int k_hi = (MODE == MODE_FOX) ? tpos : (ck * 64 + 63);
        const float cq = (MODE == MODE_FOX) ? T.cdec[(size_t)row * 4 + h] : 0.f;
        for (int kv = k_lo; kv <= k_hi; ++kv) {
            const size_t kr = (size_t)(rowb + kv);
            float s = 0.f;
#pragma unroll
            for (int d8 = 0; d8 < 8; ++d8) { const u32x4 w = *(const u32x4*)(T.K + kr * T.ldk + h * T.khs + d8 * 8);
                s += q[d8 * 8 + 0] * bflo(w.x) + q[d8 * 8 + 1] * bfhi(w.x) + q[d8 * 8 + 2] * bflo(w.y) + q[d8 * 8 + 3] * bfhi(w.y)
                   + q[d8 * 8 + 4] * bflo(w.z) + q[d8 * 8 + 5] * bfhi(w.z) + q[d8 * 8 + 6] * bflo(w.w) + q[d8 * 8 + 7] * bfhi(w.w); }
            if (MODE == MODE_MLA) {
#pragma unroll
                for (int d8 = 0; d8 < 4; ++d8) { const u32x4 w = *(const u32x4*)(T.K2 + kr * 32 + d8 * 8);
                    s += q[64 + d8 * 8 + 0] * bflo(w.x) + q[64 + d8 * 8 + 1] * bfhi(w.x) + q[64 + d8 * 8 + 2] * bflo(w.y) + q[64 + d8 * 8 + 3] * bfhi(w.y)
                       + q[64 + d8 * 8 + 4] * bflo(w.z) + q[64 + d8 * 8 + 5] * bfhi(w.z) + q[64 + d8 * 8 + 6] * bflo(w.w) + q[64 + d8 * 8 + 7] * bfhi(w.w); }
            }
            if (MODE == MODE_FOX) s += cq - T.cdec[kr * 4 + h];
            if (MODE == MODE_BAND) { int rel = tpos - kv; rel = rel < -256 ? -256 : (rel > 256 ? 256 : rel); s += T.relb[h * 513 + rel + 256]; }
            const float mn = fmaxf(m, s), al = __expf(m - mn), pp = __expf(s - mn);
            l = l * al + pp; m = mn;
#pragma unroll
            for (int d8 = 0; d8 < 8; ++d8) { const u32x4 w = *(const u32x4*)(T.V + kr * T.ldv + h * T.vhs + d8 * 8);
                o[d8 * 8 + 0] = o[d8 * 8 + 0] * al + pp * bflo(w.x); o[d8 * 8 + 1] = o[d8 * 8 + 1] * al + pp * bfhi(w.x);
                o[d8 * 8 + 2] = o[d8 * 8 + 2] * al + pp * bflo(w.y); o[d8 * 8 + 3] = o[d8 * 8 + 3] * al + pp * bfhi(w.y);
                o[d8 * 8 + 4] = o[d8 * 8 + 4] * al + pp * bflo(w.z); o[d8 * 8 + 5] = o[d8 * 8 + 5] * al + pp * bfhi(w.z);
                o[d8 * 8 + 6] = o[d8 * 8 + 6] * al + pp * bflo(w.w); o[d8 * 8 + 7] = o[d8 * 8 + 7] * al + pp * bfhi(w.w); }
        }
        const float inv = 1.0f / l;
#pragma unroll
        for (int d = 0; d < 64; d += 2) *(unsigned*)(T.O + (size_t)row * T.ldo + h * T.ohs + d) = pk2(o[d] * inv, o[d + 1] * inv);
    }
}
}
struct Params {
    const float* in[37];
    float* out;
    unsigned char* ws;
    int ph_lo, ph_hi;
};
enum { I_X = 0, I_P, I_POS, I_WIN, I_SAR, I_SAI, I_SLDT, I_SBR, I_SBI, I_SCR, I_SCI, I_SD, I_SGLU, I_FBF, I_GQ, I_WUQ, I_GKV, I_WUKV, I_RELB, I_WB, I_WG, I_BG, I_WO,
       I_GMIX, I_GFFN, I_FW1, I_FW3, I_FW2, I_MWR, I_MBR, I_MW1, I_MW3, I_MW2, I_GPLE, I_PWG, I_PWU, I_GFIN };

__device__ __forceinline__ void sincos_rad(double a, float& s, float& c) {
    double r = a * 0.15915494309189535; r = r - __builtin_rint(r); const float f = (float)r;
    s = __builtin_amdgcn_sinf(f); c = __builtin_amdgcn_cosf(f);
}
__device__ __forceinline__ float gelu_tanh(float x) {
    const float z = 0.7978845608028654f * (x + 0.044715f * x * x * x);
    const float e = __expf(2.0f * z); const float th = 1.0f - 2.0f / (1.0f + e);
    return 0.5f * x * (1.0f + th);
}
__device__ __forceinline__ float log_sigmoid(float z) { return fminf(z, 0.f) - log1pf(__expf(-fabsf(z))); }

struct CvtJob { const float* src; const float* ks; bf16* dst; int K, ldsrc, col0, ncols, row0, ldk, ilv; };
struct CvtRegs { f32x4 v[16]; };
__device__ __forceinline__ void cvt_load(const CvtJob& J, int item, int lane, CvtRegs& R) {
    const int nblk = (J.ncols + 63) >> 6, kb = item / nblk, nb = item % nblk, k0 = 64 * kb, n0 = 64 * nb;
    const int n4 = (lane & 15) * 4; const bool inb = (n0 + n4) < J.ncols;
#pragma unroll
    for (int i = 0; i < 16; ++i) { const int kk = 4 * i + (lane >> 4); f32x4 v = {0.f, 0.f, 0.f, 0.f};
        if (inb) v = *(const f32x4*)(J.src + (size_t)(k0 + kk) * J.ldsrc + J.col0 + n0 + n4);
        if (J.ks) v = v * J.ks[k0 + kk];
        R.v[i] = v; }
}
__device__ __forceinline__ void cvt_finish(const CvtJob& J, LAS float* scr, int item, int lane, const CvtRegs& R) {
    const int nblk = (J.ncols + 63) >> 6, kb = item / nblk, nb = item % nblk, k0 = 64 * kb, n0 = 64 * nb;
    const int n4 = (lane & 15) * 4;
#pragma unroll
    for (int i = 0; i < 16; ++i) { const int kk = 4 * i + (lane >> 4); *(LAS f32x4*)(scr + kk * 68 + n4) = R.v[i]; }
    LDS_WAIT(); asm volatile("" ::: "memory");
    const int c = lane & 7;
#pragma unroll
    for (int j = 0; j < 8; ++j) { const int n = (lane >> 3) + 8 * j; const LAS float* s = scr + (8 * c) * 68 + n;
        u32x4 o; o.x = pk2(s[0 * 68], s[1 * 68]); o.y = pk2(s[2 * 68], s[3 * 68]); o.z = pk2(s[4 * 68], s[5 * 68]); o.w = pk2(s[6 * 68], s[7 * 68]);
        const int nn = n0 + n; const int row = J.row0 + (J.ilv ? ((nn >> 7) * 256 + (nn & 127)) : nn);
        if (nn < J.ncols) *(u32x4*)(J.dst + (size_t)row * J.ldk + k0 + 8 * c) = o; }
    LDS_WAIT(); asm volatile("" ::: "memory");
}
__device__ __forceinline__ bf16* wmix(const Params& P, int L, size_t off) { return (bf16*)(P.ws + WS_WMIX + (size_t)L * WMIX_STRIDE + off); }
__device__ __forceinline__ CvtJob get_job(const Params& P, int j) {
    CvtJob J; J.ks = nullptr; J.ilv = 0; J.col0 = 0; J.row0 = 0;
    if (j < 40) {
        const int L = j / 20, q = j % 20;
        if (q < 5) {
            J.src = P.in[I_WIN] + (size_t)L * D * DIN; J.K = D; J.ldsrc = DIN; J.dst = wmix(P, L, WM_IN); J.ldk = D;
            J.col0 = q == 0 ? 0 : q == 1 ? 1380 : q == 2 ? 1028 : q == 3 ? 1220 : 1348;
            J.ncols = q == 0 ? 1024 : q == 1 ? 768 : q == 2 ? 192 : q == 3 ? 128 : 32;
            J.row0 = q == 0 ? 0 : q == 1 ? 1024 : q == 2 ? 1792 : q == 3 ? 2048 : 2176;
        } else if (q < 9) { const int k = q - 5; J.src = P.in[I_WG] + ((size_t)L * 4 + k) * D * D; J.K = D; J.ldsrc = D; J.ncols = D; J.row0 = k * D; J.dst = wmix(P, L, WM_G); J.ldk = D;
        } else if (q < 13) { const int k = q - 9; J.src = P.in[I_WB] + ((size_t)L * 4 + k) * 256 * D; J.K = 256; J.ldsrc = D; J.ncols = D; J.row0 = k * D; J.dst = wmix(P, L, WM_B); J.ldk = 256;
        } else if (q == 13) { J.src = P.in[I_WO] + (size_t)L * D * D; J.K = D; J.ldsrc = D; J.ncols = D; J.dst = wmix(P, L, WM_O); J.ldk = D;
        } else if (q == 14) { J.src = P.in[I_PWG] + (size_t)L * D * D; J.K = D; J.ldsrc = D; J.ncols = D; J.dst = wmix(P, L, WM_PG); J.ldk = D;
        } else if (q == 15) { J.src = P.in[I_PWU] + (size_t)L * 256 * D; J.K = 256; J.ldsrc = D; J.ncols = D; J.dst = wmix(P, L, WM_UP); J.ldk = 256;
        } else if (q == 16) { J.src = P.in[I_WUQ] + (size_t)L * 192 * 384; J.ks = P.in[I_GQ] + L * 192; J.K = 192; J.ldsrc = 384; J.ncols = 384; J.dst = wmix(P, L, WM_UQ); J.ldk = 256;
        } else if (q == 17) { J.src = P.in[I_WUKV] + (size_t)L * 128 * 512; J.ks = P.in[I_GKV] + L * 128; J.K = 128; J.ldsrc = 512; J.ncols = 512; J.dst = wmix(P, L, WM_UKV); J.ldk = 128;
        } else if (q == 18) { J.src = P.in[I_SGLU] + (size_t)L * 256 * 256; J.K = 256; J.ldsrc = 256; J.ncols = 256; J.dst = wmix(P, L, WM_GLU); J.ldk = 256;
        } else { J.src = nullptr; J.K = 0; J.ldsrc = 0; J.ncols = 32; J.dst = nullptr; J.ldk = 0; }
    } else if (j < 43) {
        const int q = j - 40;
        if (q == 0) { J.src = P.in[I_FW1]; J.K = D; J.ldsrc = DFF; J.ncols = DFF; J.dst = (bf16*)(P.ws + WS_W13); J.ldk = D; J.ilv = 1; }
        else if (q == 1) { J.src = P.in[I_FW3]; J.K = D; J.ldsrc = DFF; J.ncols = DFF; J.row0 = 128; J.dst = (bf16*)(P.ws + WS_W13); J.ldk = D; J.ilv = 1; }
        else { J.src = P.in[I_FW2]; J.K = DFF; J.ldsrc = D; J.ncols = D; J.dst = (bf16*)(P.ws + WS_W2); J.ldk = DFF; }
    } else {
        const int e = (j - 43) / 3, q = (j - 43) % 3;
        if (q == 0) { J.src = P.in[I_MW1] + (size_t)e * D * DFFE; J.K = D; J.ldsrc = DFFE; J.ncols = DFFE; J.row0 = e * 2816; J.dst = (bf16*)(P.ws + WS_WM13); J.ldk = D; J.ilv = 1; }
        else if (q == 1) { J.src = P.in[I_MW3] + (size_t)e * D * DFFE; J.K = D; J.ldsrc = DFFE; J.ncols = DFFE; J.row0 = e * 2816 + 128; J.dst = (bf16*)(P.ws + WS_WM13); J.ldk = D; J.ilv = 1; }
        else { J.src = P.in[I_MW2] + (size_t)e * DFFE * D; J.K = DFFE; J.ldsrc = D; J.ncols = D; J.row0 = e * D; J.dst = (bf16*)(P.ws + WS_WM2); J.ldk = DFFE; }
    }
    return J;
}
__device__ __forceinline__ void cvt_jobs(const Params& P, int j_lo, int j_hi, LAS unsigned char* lds) {
    BODY_IDS();
    LAS float* scr = (LAS float*)(lds + wave * 17408);
    int acc = 0; bool have = false; CvtJob Jp; int itp = 0; CvtRegs Rp;
    for (int j = j_lo; j < j_hi; ++j) {
        const CvtJob J = get_job(P, j);
        const int items = (J.K / 64) * ((J.ncols + 63) >> 6);
        const int first = (gw - (acc % ngw) + ngw) % ngw;
        for (int it = first; it < items; it += ngw) {
            CvtRegs Rn; cvt_load(J, it, lane, Rn);
            if (have) cvt_finish(Jp, scr, itp, lane, Rp);
            Jp = J; itp = it; have = true;
#pragma unroll
            for (int i = 0; i < 16; ++i) Rp.v[i] = Rn.v[i];
        }
        acc += items;
    }
    if (have) cvt_finish(Jp, scr, itp, lane, Rp);
}

__device__ __forceinline__ void p0_misc(const Params& P) {
    BODY_IDS();
    { const f32x4* src = (const f32x4*)P.in[I_P]; u32x2* dst = (u32x2*)(P.ws + WS_PBF);
      for (int i = gtid; i < 2 * NTOK * 256 / 4; i += gthreads) { const f32x4 v = src[i]; u32x2 w; w.x = pk2(v[0], v[1]); w.y = pk2(v[2], v[3]); dst[i] = w; } }
    { const int* pos = (const int*)P.in[I_POS]; float* ct = (float*)(P.ws + WS_COS); float* st = (float*)(P.ws + WS_SIN);
      const double invf[16] = {1.0, 0.5623413251903491, 0.31622776601683794, 0.1778279410038923, 0.1, 0.05623413251903491, 0.03162277660168379, 0.01778279410038923,
                               0.01, 0.005623413251903491, 0.0031622776601683794, 0.0017782794100389228, 0.001, 0.0005623413251903491, 0.00031622776601683794, 0.00017782794100389227};
      for (int i = gtid; i < NTOK * 16; i += gthreads) { const int row = i >> 4, f = i & 15; double iv = invf[0];
#pragma unroll
          for (int q = 1; q < 16; ++q) iv = (f == q) ? invf[q] : iv;
          const float ang = (float)pos[row] * (float)iv; float s, c; sincos_rad((double)ang, s, c); ct[i] = c; st[i] = s; } }
    for (int L = 0; L < 2; ++L) {
        bf16* win = wmix(P, L, WM_IN);
        for (int i = gtid; i < (64 + 96) * D / 8; i += gthreads) { const int e = i * 8, r = e / D, k = e % D; const int row = r < 64 ? 1984 + r : 2208 + (r - 64); *(u32x4*)(win + (size_t)row * D + k) = (u32x4){0u, 0u, 0u, 0u}; }
        bf16* wuq = wmix(P, L, WM_UQ);
        for (int i = gtid; i < 512 * 256 / 8; i += gthreads) { const int e = i * 8, r = e / 256, k = e % 256; if (r >= 384 || k >= 192) *(u32x4*)(wuq + e) = (u32x4){0u, 0u, 0u, 0u}; }
    }
}

__device__ __forceinline__ void rms_load(const XSrc& x, int row, int lane, f32x4 (&v)[4]) {
#pragma unroll
    for (int j = 0; j < 4; ++j) v[j] = ldx4(x, (size_t)row * D + 4 * lane + 256 * j);
}
struct GainRegs { f32x4 g[4]; };
__device__ __forceinline__ GainRegs load_gain(const float* gain, int lane) { GainRegs G; const f32x4* gr = (const f32x4*)gain + lane;
#pragma unroll
    for (int j = 0; j < 4; ++j) G.g[j] = gr[64 * j];
    return G; }
__device__ __forceinline__ void rms_finish(const GainRegs& G, bf16* orow, int lane, f32x4 (&v)[4]) {
    float s = 0.f;
#pragma unroll
    for (int j = 0; j < 4; ++j) s += (v[j][0] * v[j][0] + v[j][1] * v[j][1]) + (v[j][2] * v[j][2] + v[j][3] * v[j][3]);
    const float rstd = __builtin_amdgcn_rsqf(wave_sum(s) * (1.0f / D) + RMS_EPS);
    u32x2* o8 = (u32x2*)orow + lane;
#pragma unroll
    for (int j = 0; j < 4; ++j) { v[j] = v[j] * rstd * G.g[j]; if (orow) { u32x2 w; w.x = pk2(v[j][0], v[j][1]); w.y = pk2(v[j][2], v[j][3]); o8[64 * j] = w; } }
}
#define RMS_ROWS_BEGIN(x_, rowexpr_) f32x4 v[4], vn_[4]; { const int i = 0; rms_load(x_, (rowexpr_), lane, v); } for (int i = 0; i < 16; ++i) { if (i + 1 < 16) { const int i_ = i; { const int i = i_ + 1; rms_load(x_, (rowexpr_), lane, vn_); } }
#define RMS_ROWS_END() _Pragma("unroll") for (int j_ = 0; j_ < 4; ++j_) v[j_] = vn_[j_]; }
__device__ __forceinline__ void norm_plain(const XSrc x, const float* gain, bf16* H, int first, int stride) {
    BODY_IDS();
    const GainRegs GR = load_gain(gain, lane);
    for (int u = first; u < NTOK / 128; u += stride)
    { RMS_ROWS_BEGIN(x, u * 128 + wave * 16 + i) const int row = u * 128 + wave * 16 + i; rms_finish(GR, H + (size_t)row * D, lane, v); RMS_ROWS_END() }
}
__device__ __forceinline__ void norm1_phase(const Params& P, int L, const XSrc x, int first, int stride) {
    BODY_IDS();
    const float* win = P.in[I_WIN] + (size_t)L * D * DIN;
    f32x4 wff[4][4];
#pragma unroll
    for (int j = 0; j < 4; ++j)
#pragma unroll
        for (int e = 0; e < 4; ++e) wff[j][e] = *(const f32x4*)(win + (size_t)(4 * lane + 256 * j + e) * DIN + 1024);
    const float* gain = P.in[I_GMIX] + L * D; bf16* H = (bf16*)(P.ws + WS_H); const GainRegs GR = load_gain(gain, lane);
    float* logf = (float*)(P.ws + WS_LOGF); float* wsum = (float*)(P.ws + WS_WSUM);
    const f32x4 bf = *(const f32x4*)(P.in[I_FBF] + L * 4);
    for (int u = first; u < NTOK / 128; u += stride) { const int g0 = u * 8 + wave;
        f32x4 run = {0.f, 0.f, 0.f, 0.f};
        RMS_ROWS_BEGIN(x, g0 * 16 + i) const int row = g0 * 16 + i; rms_finish(GR, H + (size_t)row * D, lane, v);
            f32x4 d = {0.f, 0.f, 0.f, 0.f};
#pragma unroll
            for (int j = 0; j < 4; ++j)
#pragma unroll
                for (int e = 0; e < 4; ++e) d += wff[j][e] * v[j][e];
#pragma unroll
            for (int e = 0; e < 4; ++e) { d[e] = wave_sum(d[e]); run[e] += log_sigmoid(d[e] + bf[e]); }
            if (lane == 0) *(f32x4*)(logf + (size_t)row * 4) = run; RMS_ROWS_END()
        if (lane == 0) *(f32x4*)(wsum + (size_t)g0 * 4) = run;
    }
    __syncthreads();
}
__device__ __forceinline__ void prep_phase(const Params& P, int L) {
    BODY_IDS();
    unsigned* qmaxw = (unsigned*)(P.ws + WS_CTL) + CW_QMAX + L * 512; unsigned* kmaxw = (unsigned*)(P.ws + WS_CTL) + CW_KMAX + L * 16;
    const float* logf = (const float*)(P.ws + WS_LOGF); const float* wsum = (const float*)(P.ws + WS_WSUM); float* cdec = (float*)(P.ws + WS_CDEC);
    float* rq = (float*)(P.ws + WS_RSTDQ); float* rkv = (float*)(P.ws + WS_RSTDKV); const bf16* zin = (const bf16*)(P.ws + WS_ZIN); bf16* kper = (bf16*)(P.ws + WS_KPER);
    const float* ct = (const float*)(P.ws + WS_COS); const float* st = (const float*)(P.ws + WS_SIN);
    for (int g0 = gw; g0 < NTOK / 16; g0 += ngw) {
        const int first = (g0 / 512) * 512;
        f32x4 pre = {0.f, 0.f, 0.f, 0.f};
        for (int i = first + lane; i < g0; i += 64) pre += *(const f32x4*)(wsum + (size_t)i * 4);
#pragma unroll
        for (int e = 0; e < 4; ++e) pre[e] = wave_sum(pre[e]);
        if (lane < 16) { const int row = g0 * 16 + lane; *(f32x4*)(cdec + (size_t)row * 4) = *(const f32x4*)(logf + (size_t)row * 4) + pre; }
        float qk2m = 0.f;
        const int colA = (lane < 32 ? ZC_FQ : ZC_FK) + 8 * (lane & 31), colB = ZC_CQ + 8 * (lane < 52 ? lane : 51);
        u32x4 wa = *(const u32x4*)(zin + (size_t)(g0 * 16) * ZP + colA), wb = *(const u32x4*)(zin + (size_t)(g0 * 16) * ZP + colB);
        for (int i = 0; i < 16; ++i) { const int row = g0 * 16 + i;
            const u32x4 ca = wa, cb = wb;
            if (i + 1 < 16) { wa = *(const u32x4*)(zin + (size_t)(row + 1) * ZP + colA); wb = *(const u32x4*)(zin + (size_t)(row + 1) * ZP + colB); }
            const f32x4 cs = *(const f32x4*)(ct + (size_t)row * 16 + 8 * (lane & 1)), cs2 = *(const f32x4*)(ct + (size_t)row * 16 + 8 * (lane & 1) + 4);
            const f32x4 sn = *(const f32x4*)(st + (size_t)row * 16 + 8 * (lane & 1)), sn2 = *(const f32x4*)(st + (size_t)row * 16 + 8 * (lane & 1) + 4);
            { float sa = (bflo(ca.x) * bflo(ca.x) + bfhi(ca.x) * bfhi(ca.x)) + (bflo(ca.y) * bflo(ca.y) + bfhi(ca.y) * bfhi(ca.y)) + (bflo(ca.z) * bflo(ca.z) + bfhi(ca.z) * bfhi(ca.z)) + (bflo(ca.w) * bflo(ca.w) + bfhi(ca.w) * bfhi(ca.w));
              sa += DPP_F(sa, 0xB1, 0xF); sa += DPP_F(sa, 0x4E, 0xF); sa += DPP_F(sa, 0x141, 0xF);
              qk2m = fmaxf(qk2m, sa); }
            const float own[8] = {bflo(cb.x), bfhi(cb.x), bflo(cb.y), bfhi(cb.y), bflo(cb.z), bfhi(cb.z), bflo(cb.w), bfhi(cb.w)};
            float ssb = 0.f;
#pragma unroll
            for (int e = 0; e < 8; ++e) ssb += own[e] * own[e];
            const float sq = wave_sum(lane < 24 ? ssb : 0.f), skv = wave_sum((lane >= 32 && lane < 48) ? ssb : 0.f);
            if (lane == 0) { rq[row] = __builtin_amdgcn_rsqf(sq * (1.0f / 192.0f) + RMS_EPS); rkv[row] = __builtin_amdgcn_rsqf(skv * (1.0f / 128.0f) + RMS_EPS); }
            float oth[8];
#pragma unroll
            for (int e = 0; e < 8; ++e) oth[e] = DPP_F(own[e], 0x4E, 0xF);
            if (lane >= 48 && lane < 52) { const bool lo = lane < 50; float o8[8];
#pragma unroll
                for (int e = 0; e < 8; ++e) { const float c = e < 4 ? cs[e] : cs2[e - 4], sv = e < 4 ? sn[e] : sn2[e - 4];
                    o8[e] = lo ? (own[e] * c - oth[e] * sv) : (own[e] * c + oth[e] * sv); }
                *(u32x4*)(kper + (size_t)row * 32 + (lo ? 0 : 16) + 8 * (lane & 1)) = (u32x4){pk2(o8[0], o8[1]), pk2(o8[2], o8[3]), pk2(o8[4], o8[5]), pk2(o8[6], o8[7])}; } }
        if ((lane & 7) == 0) { const int row0 = g0 * 16, b = row0 / SEQ, qb = (row0 % SEQ) / 256, h = (lane & 31) >> 3;
            if (lane < 32) atomicMax(qmaxw + (b * 4 + h) * 32 + qb, __float_as_uint(qk2m)); else atomicMax(kmaxw + b * 4 + h, __float_as_uint(qk2m)); }
    }
}
struct FinalRows { u32x2 w[16][4]; };
__device__ __forceinline__ void final_norm_load(const Params& P, int u, FinalRows& R) {
    BODY_IDS();
    const bf16* xb = xr_of(P.out);
#pragma unroll
    for (int i = 0; i < 16; ++i) { const u32x2* xr = (const u32x2*)(xb + (size_t)(u * 128 + wave * 16 + i) * D) + lane;
#pragma unroll
        for (int j = 0; j < 4; ++j) R.w[i][j] = xr[64 * j]; }
}
__device__ __forceinline__ void final_norm_store(const Params& P, int u, const FinalRows& R) {
    BODY_IDS();
    const GainRegs GR = load_gain(P.in[I_GFIN], lane);
#pragma unroll
    for (int i = 0; i < 16; ++i) { f32x4 v[4]; float s = 0.f;
#pragma unroll
        for (int j = 0; j < 4; ++j) { const u32x2 w = R.w[i][j]; v[j] = (f32x4){bflo(w.x), bfhi(w.x), bflo(w.y), bfhi(w.y)}; s += (v[j][0] * v[j][0] + v[j][1] * v[j][1]) + (v[j][2] * v[j][2] + v[j][3] * v[j][3]); }
        const float rstd = __builtin_amdgcn_rsqf(wave_sum(s) * (1.0f / D) + RMS_EPS);
        f32x4* xo = (f32x4*)(P.out + (size_t)(u * 128 + wave * 16 + i) * D) + lane;
#pragma unroll
        for (int j = 0; j < 4; ++j) xo[64 * j] = v[j] * rstd * GR.g[j]; }
}
namespace s5 {
struct Coef { float abr, abi; f32x2 B2[16]; float a64r, a64i; };
__device__ __forceinline__ void coef(const Params& P, int L, int g, int p, Coef& C) {
    const float dt = __expf(P.in[I_SLDT][L * 16 + g]); const float ar = P.in[I_SAR][(L * 16 + g) * 64 + p], ai = P.in[I_SAI][(L * 16 + g) * 64 + p];
    const float mag = __expf(ar * dt); float sn, cs; sincos_rad((double)(ai * dt), sn, cs);
    C.abr = mag * cs; C.abi = mag * sn;
    const float den = ar * ar + ai * ai, nr = C.abr - 1.0f, ni = C.abi;
    const float cr = (nr * ar + ni * ai) / den, ci = (ni * ar - nr * ai) / den;
    const float* br = P.in[I_SBR] + ((size_t)(L * 16 + g) * 64 + p) * 16; const float* bi = P.in[I_SBI] + ((size_t)(L * 16 + g) * 64 + p) * 16;
#pragma unroll
    for (int h = 0; h < 16; ++h) { const float r = br[h], i = bi[h]; C.B2[h] = (f32x2){cr * r - ci * i, cr * i + ci * r}; }
    const float m64 = __expf(64.0f * ar * dt); float s64, c64; sincos_rad(64.0 * (double)(ai * dt), s64, c64);
    C.a64r = m64 * c64; C.a64i = m64 * s64;
}
constexpr int WAVE_LDS = 8448;
template <bool EMIT>
__device__ __forceinline__ void chunk(const Params& P, int L, int g, int row0, const Coef& C, float& xr, float& xi, LAS unsigned char* wl, int lane, const bf16x8 (&cf)[4], float dsk) {
    bf16* zin = (bf16*)(P.ws + WS_ZIN);
    LAS float* ut = (LAS float*)wl; LAS unsigned* xt = (LAS unsigned*)(wl + 4096);
    { const u32x4* up = (const u32x4*)(zin + (size_t)(row0 + lane) * ZP + ZC_U + g * 16); const u32x4 w0 = up[0], w1 = up[1];
      LAS f32x4* d = (LAS f32x4*)(ut + lane * 16);
      d[0] = (f32x4){bflo(w0.x), bfhi(w0.x), bflo(w0.y), bfhi(w0.y)}; d[1] = (f32x4){bflo(w0.z), bfhi(w0.z), bflo(w0.w), bfhi(w0.w)};
      d[2] = (f32x4){bflo(w1.x), bfhi(w1.x), bflo(w1.y), bfhi(w1.y)}; d[3] = (f32x4){bflo(w1.z), bfhi(w1.z), bflo(w1.w), bfhi(w1.w)}; }
    for (int tb = 0; tb < 4; ++tb) {
#pragma unroll 4
        for (int ti = 0; ti < 16; ++ti) {
            const LAS f32x4* up = (const LAS f32x4*)(ut + (tb * 16 + ti) * 16);
            f32x2 b2a = {0.f, 0.f}, b2b = {0.f, 0.f};
#pragma unroll
            for (int q = 0; q < 4; ++q) { const f32x4 u4 = up[q];
                b2a += C.B2[4 * q + 0] * (f32x2){u4[0], u4[0]}; b2b += C.B2[4 * q + 1] * (f32x2){u4[1], u4[1]};
                b2a += C.B2[4 * q + 2] * (f32x2){u4[2], u4[2]}; b2b += C.B2[4 * q + 3] * (f32x2){u4[3], u4[3]}; }
            const float br = b2a[0] + b2b[0], bi = b2a[1] + b2b[1];
            const float nr = C.abr * xr - C.abi * xi + br, ni = C.abr * xi + C.abi * xr + bi; xr = nr; xi = ni;
            if (EMIT) xt[ti * 68 + lane] = pk2(xr, xi);
        }
        if (EMIT) {
            f32x4 dacc = {0.f, 0.f, 0.f, 0.f};
#pragma unroll
            for (int ks = 0; ks < 4; ++ks) { const bf16x8 a = *(const LAS bf16x8*)((const LAS unsigned char*)xt + (lane & 15) * 272 + (ks * 32 + (lane >> 4) * 8) * 2);
                dacc = __builtin_amdgcn_mfma_f32_16x16x32_bf16(a, cf[ks], dacc, 0, 0, 0); }
            const int hp = lane & 15;
#pragma unroll
            for (int i = 0; i < 4; ++i) { const int tok = tb * 16 + 4 * (lane >> 4) + i; const float y = dacc[i] + dsk * ut[tok * 16 + hp];
                zin[(size_t)(row0 + tok) * ZP + ZC_U + g * 16 + hp] = (bf16)f2bf(gelu_tanh(y)); }
        }
    }
}
template <int PASS>
__device__ __forceinline__ void phase(const Params& P, int L, LAS unsigned char* lds) {
    BODY_IDS();
    LAS unsigned char* wl = lds + wave * WAVE_LDS;
    f32x2* SC = (f32x2*)(P.ws + WS_SC);
    for (int w = gw; w < 2048; w += ngw) {
        const int bg = w >> 5, cg = w & 31, b = bg >> 4, g = bg & 15;
        Coef C; coef(P, L, g, lane, C);
        bf16x8 cf[4]; float dsk = 0.f;
        if (PASS == 1) {
            const int hp = lane & 15, kg = lane >> 4;
            const float* cre = P.in[I_SCR] + ((size_t)(L * 16 + g) * 16 + hp) * 64; const float* cim = P.in[I_SCI] + ((size_t)(L * 16 + g) * 16 + hp) * 64;
#pragma unroll
            for (int ks = 0; ks < 4; ++ks) { const int p0 = 16 * ks + 4 * kg; u32x4 wv;
                wv.x = pk2(cre[p0], -cim[p0]); wv.y = pk2(cre[p0 + 1], -cim[p0 + 1]); wv.z = pk2(cre[p0 + 2], -cim[p0 + 2]); wv.w = pk2(cre[p0 + 3], -cim[p0 + 3]);
                cf[ks] = __builtin_bit_cast(bf16x8, wv); }
            dsk = P.in[I_SD][(L * 16 + g) * 16 + hp];
        } else {
#pragma unroll
            for (int ks = 0; ks < 4; ++ks) cf[ks] = (bf16x8){0, 0, 0, 0, 0, 0, 0, 0};
        }
        float xr = 0.f, xi = 0.f;
        if (PASS == 1) {
            const f32x2* sp = SC + ((size_t)bg * 128) * 64 + lane;
            for (int c = 0; c < 4 * cg; c += 4) { f32x2 sv[4];
#pragma unroll
                for (int q = 0; q < 4; ++q) sv[q] = sp[(size_t)(c + q) * 64];
#pragma unroll
                for (int q = 0; q < 4; ++q) { const float nr = C.a64r * xr - C.a64i * xi + sv[q][0], ni = C.a64r * xi + C.a64i * xr + sv[q][1]; xr = nr; xi = ni; } }
        }
        for (int cc = 0; cc < 4; ++cc) {
            const int c = 4 * cg + cc, row0 = b * SEQ + c * 64;
            if (PASS == 0) { xr = 0.f; xi = 0.f; }
            chunk<PASS == 1>(P, L, g, row0, C, xr, xi, wl, lane, cf, dsk);
            if (PASS == 0) SC[((size_t)bg * 128 + c) * 64 + lane] = (f32x2){xr, xi};
        }
    }
}
#define LDS_XLANE() asm volatile("" ::: "memory")
constexpr int WAVE_LDS1 = 4352;
__device__ __forceinline__ void phase1(const Params& P, int L, LAS unsigned char* lds) {
    BODY_IDS();
    LAS unsigned char* wl = lds + wave * WAVE_LDS1;
    LAS unsigned* bu = (LAS unsigned*)wl; LAS unsigned* xt = bu;
    bf16* zin = (bf16*)(P.ws + WS_ZIN);
    const f32x2* SC = (const f32x2*)(P.ws + WS_SC);
    const int m = lane & 15, kq = lane >> 4;
    for (int w = gw; w < 2048; w += ngw) {
        const int bg = w >> 5, cg = w & 31, b = bg >> 4, g = bg & 15;
        const bf16* ub = zin + (size_t)(b * SEQ + cg * 256 + m) * ZP + ZC_U + g * 16 + 8 * (kq & 1);
        u32x4 ua[4];
#pragma unroll
        for (int q = 0; q < 4; ++q) ua[q] = *(const u32x4*)(ub + (size_t)q * 16 * ZP);
        float abr, abi, a64r, a64i; bf16x8 bfr[8];
        { Coef C; coef(P, L, g, lane, C); abr = C.abr; abi = C.abi; a64r = C.a64r; a64i = C.a64i;
          LAS unsigned* tab = (LAS unsigned*)wl;
#pragma unroll
          for (int h2 = 0; h2 < 8; ++h2) { tab[lane * 8 + h2] = pk2(C.B2[2 * h2][0], C.B2[2 * h2 + 1][0]); tab[(64 + lane) * 8 + h2] = pk2(C.B2[2 * h2][1], C.B2[2 * h2 + 1][1]); }
          LDS_XLANE();
#pragma unroll
          for (int nt = 0; nt < 8; ++nt) { const u32x4 v = *(const LAS u32x4*)(wl + (16 * nt + m) * 32 + 16 * (kq & 1)); bfr[nt] = __builtin_bit_cast(bf16x8, kq < 2 ? v : (u32x4){0u, 0u, 0u, 0u}); }
          LDS_XLANE(); }
        bf16x8 cf[4]; float dskf;
        { const float* cre = P.in[I_SCR] + ((size_t)(L * 16 + g) * 16 + m) * 64; const float* cim = P.in[I_SCI] + ((size_t)(L * 16 + g) * 16 + m) * 64;
#pragma unroll
          for (int ks = 0; ks < 4; ++ks) { const int p0 = 16 * ks + 4 * kq; u32x4 wv;
              wv.x = pk2(cre[p0], -cim[p0]); wv.y = pk2(cre[p0 + 1], -cim[p0 + 1]); wv.z = pk2(cre[p0 + 2], -cim[p0 + 2]); wv.w = pk2(cre[p0 + 3], -cim[p0 + 3]);
              cf[ks] = __builtin_bit_cast(bf16x8, wv); }
          dskf = P.in[I_SD][(L * 16 + g) * 16 + m]; }
        float xr = 0.f, xi = 0.f;
        { const f32x2* sp = SC + ((size_t)bg * 128) * 64 + lane;
          for (int c = 0; c < 4 * cg; c += 4) { f32x2 sv[4];
#pragma unroll
              for (int q = 0; q < 4; ++q) sv[q] = sp[(size_t)(c + q) * 64];
#pragma unroll
              for (int q = 0; q < 4; ++q) { const float nr = a64r * xr - a64i * xi + sv[q][0], ni = a64r * xi + a64i * xr + sv[q][1]; xr = nr; xi = ni; } } }
#pragma nounroll
        for (int cc = 0; cc < 4; ++cc) {
            const int row0 = b * SEQ + (4 * cg + cc) * 64;
#ifdef S5_NOPREF
            if (cc > 0) {
#pragma unroll
                for (int q = 0; q < 4; ++q) ua[q] = *(const u32x4*)(ub + (size_t)(cc * 4 + q) * 16 * ZP);
            }
#else
            u32x4 un[4];
            if (cc < 3) {
#pragma unroll
                for (int q = 0; q < 4; ++q) un[q] = *(const u32x4*)(ub + (size_t)((cc + 1) * 4 + q) * 16 * ZP);
            } else {
#pragma unroll
                for (int q = 0; q < 4; ++q) un[q] = ua[q];
            }
#endif
#pragma unroll
            for (int tb = 0; tb < 4; ++tb) {
                const bf16x8 a = __builtin_bit_cast(bf16x8, ua[tb]);
                f32x4 dd[8];
#pragma unroll
                for (int nt = 0; nt < 8; ++nt) dd[nt] = __builtin_amdgcn_mfma_f32_16x16x32_bf16(a, bfr[nt], (f32x4){0.f, 0.f, 0.f, 0.f}, 0, 0, 0);
                unsigned short uraw[4];
#pragma unroll
                for (int i = 0; i < 4; ++i) uraw[i] = *(const unsigned short*)(zin + (size_t)(row0 + tb * 16 + 4 * kq + i) * ZP + ZC_U + g * 16 + m);
#pragma unroll
                for (int nt = 0; nt < 4; ++nt)
#pragma unroll
                    for (int i = 0; i < 4; ++i) bu[(4 * kq + i) * 68 + 16 * nt + m] = pk2(dd[nt][i], dd[nt + 4][i]);
                LDS_XLANE();
#pragma unroll
                for (int ti = 0; ti < 16; ++ti) {
#ifdef S5_V1
                    const unsigned bw = 0x3c003c00u + (unsigned)ti; const float br = bflo(bw), bi = bfhi(bw);
#else
                    const unsigned bw = bu[ti * 68 + lane]; const float br = bflo(bw), bi = bfhi(bw);
#endif
                    const float nr = abr * xr - abi * xi + br, ni = abr * xi + abi * xr + bi; xr = nr; xi = ni;
                    xt[ti * 68 + lane] = pk2(xr, xi);
                }
                LDS_XLANE();
                f32x4 dacc = {0.f, 0.f, 0.f, 0.f};
#pragma unroll
                for (int ks = 0; ks < 4; ++ks) { const bf16x8 a2 = *(const LAS bf16x8*)(wl + m * 272 + (ks * 32 + kq * 8) * 2);
                    dacc = __builtin_amdgcn_mfma_f32_16x16x32_bf16(a2, cf[ks], dacc, 0, 0, 0); }
                LDS_XLANE();
#pragma unroll
                for (int i = 0; i < 4; ++i) dacc[i] += dskf * __uint_as_float((unsigned)uraw[i] << 16);
#ifdef S5_NOPS
                asm volatile("s_nop 15\n\ts_nop 15" : "+v"(dacc));
#endif
#pragma unroll
                for (int i = 0; i < 4; ++i) { const int tok = tb * 16 + 4 * kq + i;
#ifdef S5_DUMMY
                    ((bf16*)(P.ws + WS_G))[(size_t)(row0 + tok) * 256 + g * 16 + m] = (bf16)f2bf(gelu_tanh(dacc[i])); }
#else
                    zin[(size_t)(row0 + tok) * ZP + ZC_U + g * 16 + m] = (bf16)f2bf(gelu_tanh(dacc[i])); }
#endif
            }
#ifndef S5_NOPREF
#pragma unroll
            for (int q = 0; q < 4; ++q) ua[q] = un[q];
#endif
        }
    }
}
__device__ __forceinline__ void build_w(const Params& P, int L) {
    BODY_IDS();
    bf16* W = (bf16*)(P.ws + WS_S5W);
    for (int q = gtid; q < 16 * 64 * 64; q += gthreads) {
        const int g = q >> 12, p = (q >> 6) & 63, sidx = q & 63;
        const float dt = __expf(P.in[I_SLDT][L * 16 + g]); const float ar = P.in[I_SAR][(L * 16 + g) * 64 + p], ai = P.in[I_SAI][(L * 16 + g) * 64 + p];
        const float mag = __expf(ar * dt); float sn, cs; sincos_rad((double)(ai * dt), sn, cs);
        const float abr = mag * cs, abi = mag * sn, den = ar * ar + ai * ai, nr = abr - 1.0f, ni = abi;
        const float cr = (nr * ar + ni * ai) / den, ci = (ni * ar - nr * ai) / den;
        const float e = (float)(63 - sidx); const float me = __expf(e * ar * dt); float se, ce; sincos_rad((double)e * (double)(ai * dt), se, ce);
        const float Er = me * ce, Ei = me * se;
        const float* br = P.in[I_SBR] + ((size_t)(L * 16 + g) * 64 + p) * 16; const float* bi = P.in[I_SBI] + ((size_t)(L * 16 + g) * 64 + p) * 16;
        float vr[16], vi[16];
#pragma unroll
        for (int h = 0; h < 16; ++h) { const float bbr = cr * br[h] - ci * bi[h], bbi = cr * bi[h] + ci * br[h]; vr[h] = Er * bbr - Ei * bbi; vi[h] = Er * bbi + Ei * bbr; }
        bf16* w0 = W + ((size_t)g * 128 + 2 * p) * 1024 + sidx * 16;
        *(u32x4*)w0 = (u32x4){pk2(vr[0], vr[1]), pk2(vr[2], vr[3]), pk2(vr[4], vr[5]), pk2(vr[6], vr[7])}; *(u32x4*)(w0 + 8) = (u32x4){pk2(vr[8], vr[9]), pk2(vr[10], vr[11]), pk2(vr[12], vr[13]), pk2(vr[14], vr[15])};
        *(u32x4*)(w0 + 1024) = (u32x4){pk2(vi[0], vi[1]), pk2(vi[2], vi[3]), pk2(vi[4], vi[5]), pk2(vi[6], vi[7])}; *(u32x4*)(w0 + 1024 + 8) = (u32x4){pk2(vi[8], vi[9]), pk2(vi[10], vi[11]), pk2(vi[12], vi[13]), pk2(vi[14], vi[15])};
    }
}
__device__ __forceinline__ void pass0_mfma(const Params& P, LAS unsigned char* lds) {
    BODY_IDS();
    const bf16* zin = (const bf16*)(P.ws + WS_ZIN); const bf16* W = (const bf16*)(P.ws + WS_S5W); float* SC = (float*)(P.ws + WS_SC);
    for (int task = blockIdx.x; task < 256; task += gridDim.x) {
        const int g = task & 15, nq = (task >> 4) & 3, cgp = (task >> 6) * 8 + wave;
        __syncthreads();
#pragma unroll
        for (int i = 0; i < 8; ++i) { const int id = tid + 512 * i, row = id >> 7, c16 = id & 127;
            *(LAS u32x4*)(lds + row * 2064 + c16 * 16) = *(const u32x4*)(W + ((size_t)g * 128 + nq * 32 + row) * 1024 + c16 * 8); }
        __syncthreads();
        const int m = lane & 15, kq = lane >> 4, ci = 16 * cgp + m, b = ci >> 7, c = ci & 127;
        const bf16* ap = zin + (size_t)(b * SEQ + c * 64 + (kq >> 1)) * ZP + ZC_U + g * 16 + 8 * (kq & 1);
        const LAS unsigned char* bl = lds + m * 2064 + kq * 16;
        f32x4 d0 = {0.f, 0.f, 0.f, 0.f}, d1 = {0.f, 0.f, 0.f, 0.f};
#pragma unroll 8
        for (int ks = 0; ks < 32; ++ks) {
            const bf16x8 av = *(const bf16x8*)(ap + (size_t)(2 * ks) * ZP), b0 = *(const LAS bf16x8*)(bl + 64 * ks), b1 = *(const LAS bf16x8*)(bl + 16 * 2064 + 64 * ks);
            d0 = __builtin_amdgcn_mfma_f32_16x16x32_bf16(av, b0, d0, 0, 0, 0); d1 = __builtin_amdgcn_mfma_f32_16x16x32_bf16(av, b1, d1, 0, 0, 0);
        }
#pragma unroll
        for (int i = 0; i < 4; ++i) { const int cj = 16 * cgp + 4 * (lane >> 4) + i, bj = cj >> 7, cc = cj & 127; float* sp = SC + ((size_t)(bj * 16 + g) * 128 + cc) * 128 + nq * 32 + (lane & 15);
            sp[0] = d0[i]; sp[16] = d1[i]; }
    }
    __syncthreads();
}
__device__ __forceinline__ void naive(const Params& P, int L) {
    BODY_IDS();
    bf16* zin = (bf16*)(P.ws + WS_ZIN);
    for (int bg = gw; bg < 64; bg += ngw) {
        const int b = bg >> 4, g = bg & 15;
        Coef C; coef(P, L, g, lane, C);
        float cr[16], ci[16];
#pragma unroll
        for (int h = 0; h < 16; ++h) { cr[h] = P.in[I_SCR][((size_t)(L * 16 + g) * 16 + h) * 64 + lane]; ci[h] = P.in[I_SCI][((size_t)(L * 16 + g) * 16 + h) * 64 + lane]; }
        const float dsk = P.in[I_SD][(L * 16 + g) * 16 + (lane & 15)];
        float xr = 0.f, xi = 0.f;
        for (int t = 0; t < SEQ; ++t) {
            bf16* up = zin + (size_t)(b * SEQ + t) * ZP + ZC_U + g * 16;
            const u32x4 w0 = *(const u32x4*)up, w1 = *(const u32x4*)(up + 8);
            const float u[16] = {bflo(w0.x), bfhi(w0.x), bflo(w0.y), bfhi(w0.y), bflo(w0.z), bfhi(w0.z), bflo(w0.w), bfhi(w0.w),
                                 bflo(w1.x), bfhi(w1.x), bflo(w1.y), bfhi(w1.y), bflo(w1.z), bfhi(w1.z), bflo(w1.w), bfhi(w1.w)};
            float br = 0.f, bi = 0.f;
#pragma unroll
            for (int h = 0; h < 16; ++h) { br += C.B2[h][0] * u[h]; bi += C.B2[h][1] * u[h]; }
            const float nr = C.abr * xr - C.abi * xi + br, ni = C.abr * xi + C.abi * xr + bi; xr = nr; xi = ni;
            float ymine = 0.f, umine = 0.f;
#pragma unroll
            for (int h = 0; h < 16; ++h) { const float s = wave_sum(xr * cr[h] - xi * ci[h]); if ((lane & 15) == h) { ymine = s; umine = u[h]; } }
            __builtin_amdgcn_s_waitcnt(0);
            if (lane < 16) up[lane] = (bf16)f2bf(gelu_tanh(ymine + dsk * umine));
        }
    }
}
}

__device__ __forceinline__ void norm2_moe_phase(const Params& P, const XSrc x, LAS unsigned char* lds, int first, int stride) {
    BODY_IDS();
    LAS unsigned* lcnt = (LAS unsigned*)(lds + 32768); LAS unsigned* lbase = lcnt + 8;
    f32x4 wr0[4][4], wr1[4][4];
#pragma unroll
    for (int j = 0; j < 4; ++j)
#pragma unroll
        for (int q = 0; q < 4; ++q) { const float* wp = P.in[I_MWR] + (size_t)(4 * lane + 256 * j + q) * 8; wr0[j][q] = *(const f32x4*)wp; wr1[j][q] = *(const f32x4*)(wp + 4); }
    if (tid < 8) lcnt[tid] = 0u;
    __syncthreads();
    const float* gain = P.in[I_GFFN] + 1 * D; bf16* H = (bf16*)(P.ws + WS_H); const GainRegs GR = load_gain(gain, lane);
    unsigned* tokinfo = (unsigned*)(P.ws + WS_TOKINFO); unsigned* gcnt = (unsigned*)(P.ws + WS_CTL) + CW_MOECNT;
    const float* brt = P.in[I_MBR];
    for (int u = first; u < NTOK / 128; u += stride) { const int g0 = u * 8 + wave;
        RMS_ROWS_BEGIN(x, g0 * 16 + i) const int row = g0 * 16 + i; rms_finish(GR, H + (size_t)row * D, lane, v);
            float lg[8];
#pragma unroll
            for (int e = 0; e < 8; ++e) lg[e] = 0.f;
#pragma unroll
            for (int j = 0; j < 4; ++j)
#pragma unroll
                for (int q = 0; q < 4; ++q) { const f32x4 w0 = wr0[j][q], w1 = wr1[j][q]; const float hv = v[j][q];
                    lg[0] += hv * w0[0]; lg[1] += hv * w0[1]; lg[2] += hv * w0[2]; lg[3] += hv * w0[3]; lg[4] += hv * w1[0]; lg[5] += hv * w1[1]; lg[6] += hv * w1[2]; lg[7] += hv * w1[3]; }
#pragma unroll
            for (int e = 0; e < 8; ++e) lg[e] = wave_sum(lg[e]) + brt[e];
            int e0 = 0; float l0 = lg[0];
#pragma unroll
            for (int e = 1; e < 8; ++e) if (lg[e] > l0) { l0 = lg[e]; e0 = e; }
            int e1 = 0; float l1 = -INFINITY;
#pragma unroll
            for (int e = 0; e < 8; ++e) if (e != e0 && lg[e] > l1) { l1 = lg[e]; e1 = e; }
            const float ex = __expf(l1 - l0); const float ga = __builtin_amdgcn_rcpf(1.0f + ex), gb = ex * ga;
            if (lane == 0) { const unsigned r0 = __hip_atomic_fetch_add(&lcnt[e0], 1u, __ATOMIC_RELAXED, __HIP_MEMORY_SCOPE_WORKGROUP), r1 = __hip_atomic_fetch_add(&lcnt[e1], 1u, __ATOMIC_RELAXED, __HIP_MEMORY_SCOPE_WORKGROUP);
                u32x4 a; a.x = (unsigned)e0; a.y = (unsigned)e1; a.z = r0; a.w = r1; u32x4 bq; bq.x = __float_as_uint(ga); bq.y = __float_as_uint(gb); bq.z = 0u; bq.w = 0u;
                *(u32x4*)(tokinfo + (size_t)row * 8) = a; *(u32x4*)(tokinfo + (size_t)row * 8 + 4) = bq; } RMS_ROWS_END()
    }
    __syncthreads();
    if (tid < 8) lbase[tid] = __hip_atomic_fetch_add(gcnt + tid, lcnt[tid], __ATOMIC_RELAXED, __HIP_MEMORY_SCOPE_AGENT);
    __syncthreads();
    for (int u = first; u < NTOK / 128; u += stride) { const int g0 = u * 8 + wave;
        if (lane == 0) { for (int i = 0; i < 16; ++i) { const int row = g0 * 16 + i; u32x4 a = *(u32x4*)(tokinfo + (size_t)row * 8);
            unsigned b0 = 0, b1 = 0;
#pragma unroll
            for (int e = 0; e < 8; ++e) { const unsigned lb = lbase[e]; b0 = (a.x == (unsigned)e) ? lb : b0; b1 = (a.y == (unsigned)e) ? lb : b1; }
            a.z += b0; a.w += b1; *(u32x4*)(tokinfo + (size_t)row * 8) = a; } }
    }
    int* slot_tok = (int*)(P.ws + WS_SLOTTOK);
    for (int i = gtid; i < MOE_ROWS; i += gthreads) slot_tok[i] = -1;
    __syncthreads();
}
struct MoeLayout { int pstart[9]; };
__device__ __forceinline__ MoeLayout moe_layout(const Params& P) {
    const unsigned* gcnt = (const unsigned*)(P.ws + WS_CTL) + CW_MOECNT; MoeLayout Lo; int acc = 0;
#pragma unroll
    for (int e = 0; e < 8; ++e) { Lo.pstart[e] = acc; const int c = (int)__hip_atomic_load(gcnt + e, __ATOMIC_RELAXED, __HIP_MEMORY_SCOPE_AGENT); acc += (c + 255) / 256 * 256; }
    Lo.pstart[8] = acc; return Lo;
}
__device__ __forceinline__ void moe_assign_phase(const Params& P) {
    BODY_IDS();
    const MoeLayout Lo = moe_layout(P);
    const unsigned* tokinfo = (const unsigned*)(P.ws + WS_TOKINFO); int* slot_tok = (int*)(P.ws + WS_SLOTTOK); float* slot_gate = (float*)(P.ws + WS_SLOTGATE);
    for (int t = gtid; t < NTOK; t += gthreads) { const u32x4 a = *(const u32x4*)(tokinfo + (size_t)t * 8); const u32x2 g = *(const u32x2*)(tokinfo + (size_t)t * 8 + 4);
        int p0 = 0, p1 = 0;
#pragma unroll
        for (int e = 0; e < 8; ++e) { p0 = ((int)a.x == e) ? Lo.pstart[e] : p0; p1 = ((int)a.y == e) ? Lo.pstart[e] : p1; }
        const int s0 = p0 + (int)a.z, s1 = p1 + (int)a.w;
        slot_tok[s0] = t; slot_gate[s0] = __uint_as_float(g.x); slot_tok[s1] = t; slot_gate[s1] = __uint_as_float(g.y); }
}
struct MoeOrder {
    int pstart[9]; int ntile, ncol, G, c;
    __device__ __forceinline__ bool next(int i, pg8::Unit& u) const {
        const long Lf = (long)i * G + c; if (Lf >= (long)ntile * ncol) return false;
        const int rt = (int)(Lf / ncol), j = (int)(Lf % ncol); int e = 0;
#pragma unroll
        for (int q = 1; q < 8; ++q) e = (rt * 256 >= pstart[q]) ? q : e;
        u.pm = rt; u.pn = e * ncol + j; return true;
    }
};
__device__ __forceinline__ MoeOrder moe_order(const Params& P, int ncol, int G, int c) {
    const MoeLayout Lo = moe_layout(P); MoeOrder S;
#pragma unroll
    for (int e = 0; e < 9; ++e) S.pstart[e] = Lo.pstart[e];
    S.ntile = Lo.pstart[8] / 256; S.ncol = ncol; S.G = G; S.c = c; return S;
}

__device__ __forceinline__ void norm_moe_combine(const Params& P, const float* gain, int first, int stride) {
    BODY_IDS();
    const MoeLayout Lo = moe_layout(P); const GainRegs GR = load_gain(gain, lane);
    const unsigned* tokinfo = (const unsigned*)(P.ws + WS_TOKINFO); const bf16* Y = (const bf16*)(P.ws + WS_MOEY); bf16* H = (bf16*)(P.ws + WS_H2);
    for (int u = first; u < NTOK / 128; u += stride) for (int i = 0; i < 16; ++i) { const int row = u * 128 + wave * 16 + i;
        const u32x4 a = *(const u32x4*)(tokinfo + (size_t)row * 8);
        int p0 = 0, p1 = 0;
#pragma unroll
        for (int e = 0; e < 8; ++e) { p0 = ((int)a.x == e) ? Lo.pstart[e] : p0; p1 = ((int)a.y == e) ? Lo.pstart[e] : p1; }
        const u32x2* y0 = (const u32x2*)(Y + (size_t)(p0 + (int)a.z) * D) + lane; const u32x2* y1 = (const u32x2*)(Y + (size_t)(p1 + (int)a.w) * D) + lane;
        u32x2* xr = (u32x2*)(xr_of(P.out) + (size_t)row * D) + lane; f32x4 v[4]; float s = 0.f;
#pragma unroll
        for (int j = 0; j < 4; ++j) { const u32x2 w0 = y0[64 * j], w1 = y1[64 * j]; const u32x2 wx = xr[64 * j];
            v[j] = (f32x4){bflo(wx.x), bfhi(wx.x), bflo(wx.y), bfhi(wx.y)} + (f32x4){bflo(w0.x), bfhi(w0.x), bflo(w0.y), bfhi(w0.y)} + (f32x4){bflo(w1.x), bfhi(w1.x), bflo(w1.y), bfhi(w1.y)};
            { u32x2 wo; wo.x = pk2(v[j][0], v[j][1]); wo.y = pk2(v[j][2], v[j][3]); xr[64 * j] = wo; } s += (v[j][0] * v[j][0] + v[j][1] * v[j][1]) + (v[j][2] * v[j][2] + v[j][3] * v[j][3]); }
        const float rstd = __builtin_amdgcn_rsqf(wave_sum(s) * (1.0f / D) + RMS_EPS);
        u32x2* o8 = (u32x2*)(H + (size_t)row * D) + lane;
#pragma unroll
        for (int j = 0; j < 4; ++j) { const f32x4 h = v[j] * rstd * GR.g[j]; u32x2 w; w.x = pk2(h[0], h[1]); w.y = pk2(h[2], h[3]); o8[64 * j] = w; }
    }
}
#ifndef REF_MASK
#define REF_MASK 0
#endif
#ifndef N_LAUNCH_MODE
#define N_LAUNCH_MODE 1
#endif
constexpr int LDS_BYTES = 147456;
constexpr int MISC_OFF = LDS_BYTES - 64;
constexpr int N_PHASES = 27;
#ifndef PHASE_SEL
#define PHASE_SEL 0xFFFFFFFu
#endif
#define PH_ON(b) (((PHASE_SEL) >> (b)) & 1u)
#ifndef SUB_SEL
#define SUB_SEL 0xFFu
#endif
#define SUB_ON(b) (((SUB_SEL) >> (b)) & 1u)

#ifndef PROBE_MASK
#define PROBE_MASK 0u
#endif
#ifndef PROBE_MULT
#define PROBE_MULT 4
#endif
#define TIMED(bit, ...) do { unsigned long long t0_ = 0; if (((PROBE_MASK) >> (bit)) & 1u) t0_ = __builtin_amdgcn_s_memrealtime(); __VA_ARGS__; \
    if (((PROBE_MASK) >> (bit)) & 1u) pacc += __builtin_amdgcn_s_memrealtime() - t0_; } while (0)
#define RUN_GEMM(EPI_T, SCHED_T, GATH, gm, sc, ep) do { if (REF_MASK & 1) pg8::gemm_phase_naive<EPI_T, SCHED_T, GATH>(gm, sc, ep); \
    else pg8::gemm_phase<EPI_T, SCHED_T, true, GATH>(lds, gm, sc, ep); } while (0)

__device__ __forceinline__ int hw_turn() { return my_tid() >> 6; }
__device__ __forceinline__ unsigned hw_simd_slot() { return hw_wave_key(); }
__device__ __forceinline__ int vcu_of() { int G = gridDim.x, bx = blockIdx.x; asm volatile("" : "+s"(G), "+s"(bx)); return (G % 8 == 0) ? (bx % 8) * (G / 8) + bx / 8 : bx; }
__device__ __forceinline__ bool in_range(int lo, int hi, int k) { asm volatile("" : "+s"(lo), "+s"(hi)); return lo <= k && k < hi; }
__global__ void __launch_bounds__(NTHREADS, 2) mega_fwd(Params P) {
    extern __shared__ __attribute__((aligned(16))) unsigned char lds_raw[];
    LAS unsigned char* lds = (LAS unsigned char*)lds_raw;
    const int tid = threadIdx.x;
    const int G = gridDim.x, bx = blockIdx.x;
    unsigned* ctl = (unsigned*)(P.ws + WS_CTL);
    volatile LAS unsigned* misc = (volatile LAS unsigned*)(lds + MISC_OFF);
    if (tid < 16) misc[tid] = 0u;
    if ((tid & 63) == 0) *(LAS int*)(uintptr_t)((unsigned)TID_TAB_OFF + 4u * hw_wave_key()) = tid >> 6;
    __syncthreads();
    const int lo = P.ph_lo, hi = P.ph_hi;
    XcdBarrier bar; bar.bar = ctl + CW_BAR; bar.x = 0; bar.st = misc;
    if (hi - lo > 1) bar = xcd_barrier_post(ctl + CW_BAR, misc);
#define IN(k) in_range(lo, hi, (k))
#ifndef PROBE_SEAMS
#define PROBE_SEAMS 0u
#endif
#define SEAM(k) do { if (IN(k) && IN((k) + 1)) { unsigned long long t0_ = 0; const bool tm_ = (((PROBE_MASK) >> 24) & 1u) || (((PROBE_SEAMS) >> (k)) & 1u); if (tm_) t0_ = __builtin_amdgcn_s_memrealtime(); \
    xcd_barrier(bar); if (tm_) pacc += __builtin_amdgcn_s_memrealtime() - t0_; } } while (0)
    unsigned long long pacc = 0;

#define H ((bf16*)(P.ws + WS_H))
#define ZIN ((bf16*)(P.ws + WS_ZIN))
#define GB ((bf16*)(P.ws + WS_G))
#define MB ((bf16*)(P.ws + WS_M))
#define MLAQ ((bf16*)(P.ws + WS_MLAQ))
#define MLAKV ((bf16*)(P.ws + WS_MLAKV))
#define KPER ((bf16*)(P.ws + WS_KPER))
#define cosT ((float*)(P.ws + WS_COS))
#define sinT ((float*)(P.ws + WS_SIN))
#define slot_tok ((int*)(P.ws + WS_SLOTTOK))
#define slot_gate ((float*)(P.ws + WS_SLOTGATE))

    if (PH_ON(0) && IN(0)) { TIMED(0, cvt_jobs(P, 0, 43, lds); p0_misc(P)); TIMED(1, norm1_phase(P, 0, XSrc{P.in[I_X], nullptr}, vcu_of(), gridDim.x)); }
    SEAM(0);

    for (int L = 0; L < 2; ++L) {
        const int pb = 1 + 12 * L;
        const int pc = (L == 0) ? 9 : 22;
        bf16* const XR = xr_of(P.out);
        const XSrc xsrc = (L == 0) ? XSrc{P.in[I_X], nullptr} : XSrc{nullptr, XR};
        if (PH_ON(2) && IN(pb + 1)) {
            TIMED(4, s5::build_w(P, L));
            pg8::Gemm g{H, wmix(P, L, WM_IN), D, D, D, nullptr}; pg8::StaticOrder S; S.init(NTOK, ZP, G, bx);
            epi::EpiStore E{ZIN, ZP, 0};
            TIMED(2, RUN_GEMM(epi::EpiStore, pg8::StaticOrder, false, g, S, E));
        }
        SEAM(pb + 1);
        if (PH_ON(3) && IN(pb + 2)) {
            TIMED(3, prep_phase(P, L));
            if (!(REF_MASK & 4)) TIMED(4, s5::pass0_mfma(P, lds));
            __syncthreads();
        }
        SEAM(pb + 2);
        if (PH_ON(4) && IN(pb + 3)) {
            if (SUB_ON(0)) { pg8::Gemm g{ZIN + ZC_CQ, wmix(P, L, WM_UQ), ZP, 256, 256, nullptr}; pg8::StaticOrder S; S.init(NTOK, 512, G, bx);
              epi::EpiMlaQ E{MLAQ, (const float*)(P.ws + WS_RSTDQ), cosT, sinT};
              TIMED(5, RUN_GEMM(epi::EpiMlaQ, pg8::StaticOrder, false, g, S, E)); }
            if (SUB_ON(1)) { pg8::Gemm g{ZIN + ZC_CKV, wmix(P, L, WM_UKV), ZP, 128, 128, nullptr}; pg8::StaticOrder S; S.init(NTOK, 512, G, bx);
              epi::EpiRowScale E{MLAKV, 512, (const float*)(P.ws + WS_RSTDKV)};
              TIMED(5, RUN_GEMM(epi::EpiRowScale, pg8::StaticOrder, false, g, S, E)); }
            if (SUB_ON(2)) { TIMED(6, if (REF_MASK & 4) s5::naive(P, L); else {
#ifdef S5_SERIAL
              for (int turn = 0; turn < S5_SERIAL; ++turn) { if (S5_SERIAL == 8 ? (int)hw_turn() == turn : S5_SERIAL == 2 ? (int)(hw_simd_slot() & 1) == turn : (int)(hw_simd_slot() >> 4) == turn) s5::phase1(P, L, lds); __syncthreads(); }
#else
              s5::phase1(P, L, lds);
#endif
              }); }
#ifdef S5_DUMMY
            __syncthreads();
#if S5_DUMMY == 2
            { BODY_IDS(); asm volatile("s_waitcnt vmcnt(0)" ::: "memory");
              const int bg = gw >> 5, cg = gw & 31, b = bg >> 4, g = bg & 15; const bf16* src = (const bf16*)(P.ws + WS_G); bf16* zin = (bf16*)(P.ws + WS_ZIN);
              for (int r = lane; r < 256; r += 64) { const size_t row = (size_t)b * SEQ + cg * 256 + r;
                  const u32x4 v0 = __builtin_nontemporal_load((const u32x4*)(src + row * 256 + g * 16)), v1 = __builtin_nontemporal_load((const u32x4*)(src + row * 256 + g * 16 + 8));
                  *(u32x4*)(zin + row * ZP + ZC_U + g * 16) = v0; *(u32x4*)(zin + row * ZP + ZC_U + g * 16 + 8) = v1; } }
#else
            if (SUB_ON(2)) s5::phase<1>(P, L, lds);
#endif
#endif
            __syncthreads();
            if (SUB_ON(3)) { att::Tensors T; T.Q = ZIN + ZC_FQ; T.ldq = ZP; T.K = ZIN + ZC_FK; T.ldk = ZP; T.K2 = nullptr; T.V = ZIN + ZC_FV; T.ldv = ZP; T.O = ZIN + ZC_FQ; T.ldo = ZP;
              T.cdec = (const float*)(P.ws + WS_CDEC); T.relb = nullptr; T.qhs = 64; T.khs = 64; T.vhs = 64; T.ohs = 64;
              T.qmax = (const unsigned*)(P.ws + WS_CTL) + CW_QMAX + L * 512; T.kmax = (const unsigned*)(P.ws + WS_CTL) + CW_KMAX + L * 16;
              TIMED(7, if (REF_MASK & 2) att::attn_naive<att::MODE_FOX>(T); else att::attn_phase<att::MODE_FOX>(T, lds)); }
            __syncthreads();
            if (SUB_ON(4)) { att::Tensors T; T.Q = ZIN + ZC_DQ; T.ldq = ZP; T.K = ZIN + ZC_DK; T.ldk = ZP; T.K2 = nullptr; T.V = ZIN + ZC_DV; T.ldv = ZP; T.O = ZIN + ZC_DQ; T.ldo = ZP;
              T.cdec = nullptr; T.relb = P.in[I_RELB] + (size_t)L * 4 * 513; T.qhs = 64; T.khs = 64; T.vhs = 64; T.ohs = 64;
              TIMED(8, if (REF_MASK & 2) att::attn_naive<att::MODE_BAND>(T); else att::attn_phase<att::MODE_BAND>(T, lds)); }
            __syncthreads();
        }
        SEAM(pb + 3);
        if (PH_ON(5) && IN(pb + 4)) {
            if (SUB_ON(0)) { att::Tensors T; T.Q = MLAQ; T.ldq = 512; T.K = MLAKV; T.ldk = 512; T.K2 = KPER; T.V = MLAKV + 64; T.ldv = 512; T.O = ZIN + ZC_CQ; T.ldo = ZP;
              T.cdec = nullptr; T.relb = nullptr; T.qhs = 96; T.khs = 128; T.vhs = 128; T.ohs = 64;
              TIMED(9, if (REF_MASK & 2) att::attn_naive<att::MODE_MLA>(T); else att::attn_phase<att::MODE_MLA>(T, lds)); }
            __syncthreads();
            if (SUB_ON(1)) { pg8::Gemm g{ZIN + ZC_U, wmix(P, L, WM_GLU), ZP, 256, 256, nullptr}; pg8::StaticOrder S; S.init(NTOK, 256, G, bx);
              epi::EpiGlu E{ZIN + ZC_U, ZP};
              TIMED(10, RUN_GEMM(epi::EpiGlu, pg8::StaticOrder, false, g, S, E)); }
        }
        SEAM(pb + 4);
        if (PH_ON(6) && IN(pb + 5)) {
            g128::MergeProg MP; MP.Hn = H; MP.zin = ZIN; MP.wg = wmix(P, L, WM_G); MP.wb = wmix(P, L, WM_B); MP.bg = P.in[I_BG] + (size_t)L * 4 * D; MP.M = MB;
            const int vcu_ = vcu_of();
            TIMED(11, g128::stream<g128::MergeProg>(lds, MP, 1024, vcu_, G));
        }
        SEAM(pb + 5);
#define PANEL_FENCE() do { asm volatile("s_waitcnt vmcnt(0)" ::: "memory"); __builtin_amdgcn_fence(__ATOMIC_ACQUIRE, "agent"); asm volatile("s_waitcnt vmcnt(0)" ::: "memory"); __syncthreads(); } while (0)
        if (PH_ON(7) && IN(pb + 6)) {
            pg8::Gemm g{MB, wmix(P, L, WM_O), D, D, D, nullptr}; pg8::StaticOrder S; S.init(NTOK, D, G, bx);
            epi::EpiRes E{xsrc, XR};
            TIMED(13, RUN_GEMM(epi::EpiRes, pg8::StaticOrder, false, g, S, E));
        }
        SEAM(pb + 6);
        if (PH_ON(8) && IN(pb + 7)) {
            const int vcu_ = vcu_of();
            if (L == 0) TIMED(14, norm_plain(XSrc{nullptr, XR}, P.in[I_GFFN], H, vcu_, G));
            else { TIMED(14, norm2_moe_phase(P, XSrc{nullptr, XR}, lds, vcu_, G)); TIMED(25, cvt_jobs(P, 43, 67, lds)); __syncthreads(); }
        }
        SEAM(pb + 7);
        if (L == 0) {
            if (PH_ON(9) && IN(9)) {
                pg8::Gemm g{H, (const bf16*)(P.ws + WS_W13), D, D, D, nullptr}; pg8::StaticOrder S; S.init(NTOK, 2 * DFF, G, bx);
                epi::EpiSwiglu E{(bf16*)(P.ws + WS_HMID), DFF, 22};
                TIMED(15, RUN_GEMM(epi::EpiSwiglu, pg8::StaticOrder, false, g, S, E));
            }
            SEAM(9);
            if (PH_ON(10) && IN(10)) {
                pg8::Gemm g{(const bf16*)(P.ws + WS_HMID), (const bf16*)(P.ws + WS_W2), DFF, DFF, DFF, nullptr}; pg8::StaticOrder S; S.init(NTOK, D, G, bx);
                epi::EpiRes E{XSrc{nullptr, XR}, XR};
                TIMED(16, RUN_GEMM(epi::EpiRes, pg8::StaticOrder, false, g, S, E));
            }
            SEAM(10);
        } else {
            if (PH_ON(21) && IN(21)) TIMED(17, moe_assign_phase(P));
            SEAM(21);
            if (PH_ON(22) && IN(22)) {
                pg8::Gemm g{H, (const bf16*)(P.ws + WS_WM13), D, D, D, slot_tok}; const MoeOrder S = moe_order(P, 11, G, bx);
                epi::EpiSwiglu E{(bf16*)(P.ws + WS_HMID), DFFE, 11};
                TIMED(18, RUN_GEMM(epi::EpiSwiglu, MoeOrder, true, g, S, E));
            }
            SEAM(22);
            if (PH_ON(23) && IN(23)) {
                pg8::Gemm g{(const bf16*)(P.ws + WS_HMID), (const bf16*)(P.ws + WS_WM2), DFFE, DFFE, DFFE, nullptr}; const MoeOrder S = moe_order(P, 4, G, bx);
                epi::EpiMoeDown E{(bf16*)(P.ws + WS_MOEY), slot_gate};
                TIMED(19, RUN_GEMM(epi::EpiMoeDown, MoeOrder, false, g, S, E));
            }
            SEAM(23);
        }
        if (PH_ON(12) && IN(pc + 3)) {
            const int vcu_ = vcu_of();
            if (L == 0) TIMED(20, norm_plain(XSrc{nullptr, XR}, P.in[I_GPLE] + L * D, H, vcu_, G)); else TIMED(20, norm_moe_combine(P, P.in[I_GPLE] + L * D, vcu_, G));
            PANEL_FENCE();
            g128::PleProg PP; PP.pbf = (const bf16*)(P.ws + WS_PBF) + (size_t)L * NTOK * 256; PP.hp = (L == 0) ? H : (const bf16*)(P.ws + WS_H2); PP.wup = wmix(P, L, WM_UP); PP.wpg = wmix(P, L, WM_PG); PP.x = XR;
            TIMED(22, g128::stream<g128::PleProg>(lds, PP, NTOK / 128, vcu_, G));
            PANEL_FENCE();
            if (L == 0) TIMED(1, norm1_phase(P, 1, XSrc{nullptr, XR}, vcu_, G));
        }
        if (L == 0) SEAM(pc + 3);
    }
    if (PH_ON(26) && IN(25)) {
        const int vcu_ = vcu_of(); const int G_ = gridDim.x;
        for (int r = 0; r < (NTOK / 128 + G_ - 1) / G_; ++r) {
            const int u = vcu_ + r * G_; FinalRows FR;
            if (u < NTOK / 128) final_norm_load(P, u, FR);
            xcd_barrier(bar);
            if (u < NTOK / 128) final_norm_store(P, u, FR);
        }
    }
    if (PROBE_MASK || PROBE_SEAMS) { const unsigned long long t0_ = __builtin_amdgcn_s_memrealtime(); while (__builtin_amdgcn_s_memrealtime() - t0_ < (unsigned long long)PROBE_MULT * pacc) __builtin_amdgcn_s_sleep(8); }
#undef IN
#undef SEAM
#undef H
#undef ZIN
#undef GB
#undef MB
#undef MLAQ
#undef MLAKV
#undef KPER
#undef cosT
#undef sinT
#undef slot_tok
#undef slot_gate
}

extern "C" void kernel_launch(void* const* d_in, const int* in_sizes, int n_in, void* d_out, int out_size, void* d_ws, size_t ws_size, hipStream_t stream) {
    static int grid = 0;
    if (grid == 0) {
        if (n_in != 37 || out_size != NTOK * D || ws_size < WS_END) { fprintf(stderr, "kernel_launch: unexpected shapes: n_in %d out %d ws %zu\n", n_in, out_size, ws_size); grid = -1; return; }
        int dev = 0, cus = 0, per_cu = 0;
        if (hipGetDevice(&dev) != hipSuccess || hipDeviceGetAttribute(&cus, hipDeviceAttributeMultiprocessorCount, dev) != hipSuccess) { grid = -1; return; }
        if (hipFuncSetAttribute((const void*)mega_fwd, hipFuncAttributeMaxDynamicSharedMemorySize, LDS_BYTES) != hipSuccess) { fprintf(stderr, "kernel_launch: hipFuncSetAttribute failed\n"); grid = -1; return; }
        if (hipOccupancyMaxActiveBlocksPerMultiprocessor(&per_cu, (const void*)mega_fwd, NTHREADS, LDS_BYTES) != hipSuccess || per_cu < 1)
            fprintf(stderr, "kernel_launch: note: occupancy query reports %d workgroups per CU\n", per_cu);
        (void)hipGetLastError();
        grid = cus;
        if (grid != 256) fprintf(stderr, "kernel_launch: note: %d CUs (built for 256)\n", grid);
    }
    if (grid < 0) return;
    if (hipMemsetAsync((char*)d_ws + WS_CTL, 0, CTL_ZERO_BYTES, stream) != hipSuccess) return;
    Params p{};
    for (int i = 0; i < 37; ++i) p.in[i] = (const float*)d_in[i];
    p.out = (float*)d_out; p.ws = (unsigned char*)d_ws;
#if N_LAUNCH_MODE == 1
    p.ph_lo = 0; p.ph_hi = N_PHASES;
    hipLaunchKernelGGL(mega_fwd, dim3(grid), dim3(NTHREADS), LDS_BYTES, stream, p);
#else
    for (int ph = 0; ph < N_PHASES; ++ph) { p.ph_lo = ph; p.ph_hi = ph + 1; hipLaunchKernelGGL(mega_fwd, dim3(grid), dim3(NTHREADS), LDS_BYTES, stream, p); }
#endif
    const hipError_t le = hipPeekAtLastError();
    if (le != hipSuccess) fprintf(stderr, "kernel_launch: launch failed: %s\n", hipGetErrorName(le));
}
```

```cpp
#include <hip/hip_runtime.h>
#include <cstdio>
#include <cstdint>

#define GAS __attribute__((address_space(1)))
#define LAS __attribute__((address_space(3)))
typedef unsigned short bf16;
typedef short bf16x8 __attribute__((ext_vector_type(8)));
typedef short s16x4 __attribute__((ext_vector_type(4)));
typedef float f32x2 __attribute__((ext_vector_type(2)));
typedef float f32x4 __attribute__((ext_vector_type(4)));
typedef float f32x16 __attribute__((ext_vector_type(16)));
typedef unsigned u32x2 __attribute__((ext_vector_type(2)));
typedef unsigned u32x4 __attribute__((ext_vector_type(4)));
typedef __bf16 bf16x2_t __attribute__((ext_vector_type(2)));

constexpr int NB = 4, SEQ = 8192, NTOK = NB * SEQ, D = 1024;
constexpr int ZP = 2304;
constexpr int ZC_U = 0, ZC_FQ = 256, ZC_FK = 512, ZC_FV = 768, ZC_DQ = 1024, ZC_DK = 1280, ZC_DV = 1536, ZC_CQ = 1792, ZC_CKV = 2048, ZC_KPE = 2176;
constexpr int DIN = 2148, DFF = 2816, DFFE = 1408, NE = 8;
constexpr int MOE_ROWS = 2 * NTOK + NE * 256;
constexpr float RMS_EPS = 1e-6f;
constexpr int NWAVES = 8, NTHREADS = 512;

constexpr size_t MiB = 1u << 20;
constexpr size_t WS_CTL = 0, CTL_ZERO_BYTES = 1 * MiB;
constexpr size_t WS_COS = 1 * MiB, WS_SIN = 3 * MiB;
constexpr size_t WS_LOGF = 5 * MiB;
constexpr size_t WS_CDEC = 5 * MiB + 512 * 1024;
constexpr size_t WS_WSUM = 6 * MiB;
constexpr size_t WS_RSTDQ = 6 * MiB + 256 * 1024, WS_RSTDKV = 6 * MiB + 512 * 1024;
constexpr size_t WS_SC = 7 * MiB;
constexpr size_t WS_TOKINFO = 11 * MiB;
constexpr size_t WS_SLOTTOK = 12 * MiB, WS_SLOTGATE = 12 * MiB + 512 * 1024;
constexpr size_t WS_S5W = 13 * MiB;
constexpr size_t WS_PBF = 17 * MiB;
constexpr size_t WS_WMIX = 49 * MiB, WMIX_STRIDE = 20 * MiB;
constexpr size_t WM_IN = 0, WM_G = 4 * MiB + 512 * 1024, WM_B = 12 * MiB + 512 * 1024, WM_O = 14 * MiB + 512 * 1024, WM_PG = 16 * MiB + 512 * 1024,
                 WM_UP = 18 * MiB + 512 * 1024, WM_UQ = 19 * MiB, WM_UKV = 19 * MiB + 256 * 1024, WM_GLU = 19 * MiB + 384 * 1024;
constexpr size_t WS_W13 = 89 * MiB, WS_W2 = 100 * MiB;
constexpr size_t WS_H = 106 * MiB;
constexpr size_t WS_MLAQ = 170 * MiB, WS_MLAKV = 202 * MiB, WS_KPER = 234 * MiB;
constexpr size_t WS_M = 170 * MiB;
constexpr size_t WS_ZIN = 236 * MiB;
constexpr size_t WS_G = 380 * MiB;
constexpr size_t WS_HMID = 236 * MiB;
constexpr size_t WS_U = 236 * MiB;
constexpr size_t WS_WM13 = 418 * MiB, WS_WM2 = 462 * MiB;
constexpr size_t WS_MOEY = 89 * MiB;
constexpr size_t WS_H2 = 300 * MiB;
constexpr size_t WS_END = 484 * MiB;
constexpr int CW_BAR = 4096;
constexpr int CW_MOECNT = 16384;
constexpr int CW_QMAX = 20480;
constexpr int CW_KMAX = 22528;

#define LDS_WAIT() asm volatile("s_waitcnt lgkmcnt(0)" ::: "memory")
#define VM_WAIT() asm volatile("s_waitcnt vmcnt(0)" ::: "memory")
__device__ __forceinline__ unsigned f2bf(float f) { unsigned u = __builtin_bit_cast(unsigned, f); return (u + 0x7fffu + ((u >> 16) & 1u)) >> 16; }
__device__ __forceinline__ unsigned pk2(float lo, float hi) { f32x2 v = {lo, hi}; bf16x2_t b = __builtin_convertvector(v, bf16x2_t); return __builtin_bit_cast(unsigned, b); }
__device__ __forceinline__ float bf2f(unsigned short b) { return __uint_as_float((unsigned)b << 16); }
__device__ __forceinline__ float bflo(unsigned w) { return __uint_as_float(w << 16); }
__device__ __forceinline__ float bfhi(unsigned w) { return __uint_as_float(w & 0xffff0000u); }
constexpr int TID_TAB_OFF = 147456 - 512;
__device__ __forceinline__ unsigned hw_wave_key() { return (unsigned)__builtin_amdgcn_s_getreg((5 << 11) | 4) & 0x3Fu; }
__device__ __forceinline__ int my_tid() {
    unsigned addr = (unsigned)TID_TAB_OFF + 4u * hw_wave_key(); asm volatile("" : "+s"(addr));
    const int wave = __builtin_amdgcn_readfirstlane(*(const LAS int*)(uintptr_t)addr);
    int lane = (int)__builtin_amdgcn_mbcnt_hi(~0u, __builtin_amdgcn_mbcnt_lo(~0u, 0u)); asm volatile("" : "+v"(lane));
    return wave * 64 + lane;
}
__device__ __forceinline__ float shflx(float v, int o, int lane) { return __int_as_float(__builtin_amdgcn_ds_bpermute((lane ^ o) << 2, __float_as_int(v))); }
#define DPP_F(x_, ctrl_, rm_) __int_as_float(__builtin_amdgcn_update_dpp(0, __float_as_int(x_), (ctrl_), (rm_), 0xF, true))
__device__ __forceinline__ float wave_sum(float v) {
    v += DPP_F(v, 0xB1, 0xF); v += DPP_F(v, 0x4E, 0xF); v += DPP_F(v, 0x114, 0xF); v += DPP_F(v, 0x118, 0xF);
    v += DPP_F(v, 0x142, 0xA); v += DPP_F(v, 0x143, 0xC);
    return __int_as_float(__builtin_amdgcn_readlane(__float_as_int(v), 63));
}
__device__ __forceinline__ float sigmoidf_(float x) { return __builtin_amdgcn_rcpf(1.0f + __expf(-x)); }

struct XSrc { const float* f; const bf16* b; };
__device__ __forceinline__ f32x4 ldx4(const XSrc& x, size_t idx) {
    if (x.f) return *(const f32x4*)(x.f + idx);
    const u32x2 w = *(const u32x2*)(x.b + idx); return (f32x4){bflo(w.x), bfhi(w.x), bflo(w.y), bfhi(w.y)};
}
__device__ __forceinline__ bf16* xr_of(float* out) { return (bf16*)((unsigned char*)out + (size_t)NTOK * D * 2); }
#define BODY_IDS() int tid = my_tid(); asm volatile("" : "+v"(tid)); const int lane = tid & 63; const int wave = __builtin_amdgcn_readfirstlane(tid >> 6); \
    int grid_ = gridDim.x; asm volatile("" : "+s"(grid_)); \
    const int gw = blockIdx.x * NWAVES + wave, ngw = grid_ * NWAVES, gtid = blockIdx.x * NTHREADS + tid, gthreads = grid_ * NTHREADS; (void)lane; (void)wave; (void)gw; (void)ngw; (void)gtid; (void)gthreads
#define XB_TMO      128
#define XB_XCNT(j)  (256  + 64 * (j))
#define XB_XSUB(j)  (1280 + 64 * (j))
#define XB_XGEN(j)  (2304 + 64 * (j))
#define XB_TOP      3328
#define XB_TOPGEN   3392
#define XCD_BAR_WORDS 3456
#define XB_SPIN_CAP (1u << 22)

__device__ __forceinline__ unsigned xb_ld(unsigned* p)              { return __hip_atomic_load(p, __ATOMIC_RELAXED, __HIP_MEMORY_SCOPE_AGENT); }
__device__ __forceinline__ unsigned xb_add(unsigned* p, unsigned v) { return __hip_atomic_fetch_add(p, v, __ATOMIC_RELAXED, __HIP_MEMORY_SCOPE_AGENT); }
__device__ __forceinline__ unsigned xb_xcc_id() { return (unsigned)__builtin_amdgcn_s_getreg((3 << 11) | 20) & 0xFu; }
#define XB_SPIN(cond, bar) do { unsigned _sp = 0; while (cond) { __builtin_amdgcn_s_sleep(1); \
    if ((++_sp & 255u) == 0u) { if (xb_ld(&(bar)[XB_TMO])) break; if (_sp > XB_SPIN_CAP) { atomicAdd(&(bar)[XB_TMO], 1u); break; } } } } while (0)

struct XcdBarrier { unsigned* bar; unsigned x; volatile LAS unsigned* st; };

__device__ __forceinline__ XcdBarrier xcd_barrier_post(unsigned* bar, volatile LAS unsigned* st) {
    XcdBarrier b; b.bar = bar; b.x = xb_xcc_id(); b.st = st;
    if (my_tid() == 0) (void)xb_add(&bar[XB_XCNT(b.x)], 1u);
    return b;
}
__device__ __forceinline__ void xcd_barrier_complete(unsigned* bar, unsigned x, unsigned& nloc, unsigned& nx) {
    const unsigned G = gridDim.x * gridDim.y * gridDim.z;
    unsigned sum, cnt, mine, sp = 0u;
    for (;;) {
        sum = 0u; cnt = 0u; mine = 0u;
#pragma unroll
        for (unsigned j = 0; j < 16; ++j) { const unsigned c = xb_ld(&bar[XB_XCNT(j)]); sum += c; cnt += (c > 0u) ? 1u : 0u; mine = (j == x) ? c : mine; }
        if (sum == G) break;
        __builtin_amdgcn_s_sleep(1);
        if ((++sp & 255u) == 0u) { if (xb_ld(&bar[XB_TMO])) break; if (sp > XB_SPIN_CAP) { atomicAdd(&bar[XB_TMO], 1u); break; } }
    }
    nloc = mine > 0u ? mine : 1u; nx = cnt > 0u ? cnt : 1u;
}
__device__ __forceinline__ void xcd_barrier(const XcdBarrier& b) {
    asm volatile("s_waitcnt vmcnt(0)" ::: "memory");
    __syncthreads();
    if (my_tid() == 0) {
        unsigned* bar = b.bar;
        __builtin_amdgcn_s_waitcnt(0);
        unsigned nloc = b.st[0], nx = b.st[1];
        if (nloc == 0u) { xcd_barrier_complete(bar, b.x, nloc, nx); b.st[0] = nloc; b.st[1] = nx; }
        const unsigned old = xb_add(&bar[XB_XSUB(b.x)], 1u);
        const unsigned gen = old / nloc;
        if (old + 1u == (gen + 1u) * nloc) {
            __builtin_amdgcn_fence(__ATOMIC_RELEASE, "agent");
            asm volatile("s_waitcnt vmcnt(0)" ::: "memory");
            const unsigned og = xb_add(&bar[XB_TOP], 1u);
            const unsigned tg = og / nx;
            if (og + 1u == (tg + 1u) * nx) xb_add(&bar[XB_TOPGEN], 1u);
            else XB_SPIN(xb_ld(&bar[XB_TOPGEN]) == tg, bar);
            __builtin_amdgcn_fence(__ATOMIC_ACQUIRE, "agent");
            xb_add(&bar[XB_XGEN(b.x)], 1u);
            asm volatile("s_waitcnt vmcnt(0)" ::: "memory");
        } else {
            XB_SPIN(xb_ld(&bar[XB_XGEN(b.x)]) == gen, bar);
            __builtin_amdgcn_fence(__ATOMIC_ACQUIRE, "agent");
            asm volatile("s_waitcnt vmcnt(0)" ::: "memory");
        }
    }
    __syncthreads();
}
namespace pg8 {
constexpr int BM = 256, BK = 64, HALF = 128, HTB = HALF * BK * 2, STAGE_BYTES = 8 * HTB, NXCD = 8, WGM = 8;
__host__ __device__ __forceinline__ int lds_byte(int r, int c) { const int st = (r >> 4) * 2 + (c >> 5), rr = r & 15, cc = c & 31, ob = rr * 64 + cc * 2; return st * 1024 + (ob ^ (((ob >> 9) & 1) << 5)); }
__host__ __device__ __forceinline__ void stage_rc(int b, int& R, int& C) { const int st = b / 1024, sb = b % 1024, swz = sb ^ (((sb >> 9) & 1) << 5); R = (st >> 1) * 16 + swz / 64; C = (st & 1) * 32 + (swz % 64) / 2; }
__host__ __device__ __forceinline__ int perm32(int rho) { const int n = rho >> 4, i = rho & 15; return 8 * (i >> 2) + 4 * n + (i & 3); }

struct Unit { int pm, pn; };
struct Gemm { const bf16* A; const bf16* Bt; int lda, ldb, K; const int* gidx; };

struct StaticOrder {
    int nM, nN, nwg, G, c;
    __host__ __device__ void init(int M, int N, int G_, int c_) { nM = M / BM; nN = N / BM; nwg = nM * nN; G = G_; c = c_; }
    __host__ __device__ bool next(int i, Unit& u) const {
        const long L = (long)i * G + c; if (L >= nwg) return false;
        int wgid = (int)L; { const int q = nwg / NXCD, r = nwg % NXCD, xcd = wgid % NXCD, off = wgid / NXCD; wgid = (xcd < r ? xcd * (q + 1) : r * (q + 1) + (xcd - r) * q) + off; }
        const int nig = WGM * nN, gid = wgid / nig, fm = gid * WGM, gsz = (nM - fm) < WGM ? (nM - fm) : WGM;
        u.pm = fm + ((wgid % nig) % gsz); u.pn = (wgid % nig) / gsz; return true;
    }
};

template <class Epi, class Sched, bool ALIGN_EPI, bool GATHER>
__device__ __forceinline__ void gemm_phase(LAS unsigned char* lds, const Gemm g, const Sched& S, const Epi& E) {
    int tid = my_tid(); asm volatile("" : "+v"(tid));
    const int wid = __builtin_amdgcn_readfirstlane(tid >> 6), lane = tid & 63, wr = wid >> 2, wc = wid & 3, fr = lane & 15, fq = lane >> 4;
    int Kq = g.K; asm volatile("" : "+s"(Kq));
    const int K = Kq, nt = K / BK;
    int RA[2], CA[2];
    unsigned voffA[2], voffB[2];
#pragma unroll
    for (int i = 0; i < 2; ++i) { int R, C; stage_rc(tid * 16 + i * 8192, R, C); const int Rb = Epi::PERM ? ((R & ~31) + perm32(R & 31)) : R;
        RA[i] = R; CA[i] = C; voffA[i] = (unsigned)(R * g.lda + C) * 2u; voffB[i] = (unsigned)(Rb * g.ldb + C) * 2u; }
    const size_t kstep = (size_t)(BK * 2);
    const size_t hstepB = (size_t)HALF * g.ldb * 2, tstepB = 2 * hstepB;
    const size_t hstepA = (size_t)HALF * g.lda * 2, tstepA = 2 * hstepA;
    const unsigned ldsw = (unsigned)wid * 1024u;
    const int aoff = lds_byte(wr * 64 + fr, fq * 8), boff = lds_byte(wc * 32 + fr, fq * 8);
#define PG8_SA(b, h) (((b) * 2 + (h)) * HTB)
#define PG8_SB(b, h) ((4 + (b) * 2 + (h)) * HTB)
#define PG8_STAGEB(bufoff, gbase) do { _Pragma("unroll") for (int _i = 0; _i < 2; ++_i) \
        __builtin_amdgcn_global_load_lds((const unsigned*)((const char*)(gbase) + voffB[_i]), (LAS unsigned*)(lds + (bufoff) + ldsw + _i * 8192), 16, 0, 0); } while (0)
#define PG8_STAGEA(bufoff, kptr, isnext, h) do { _Pragma("unroll") for (int _i = 0; _i < 2; ++_i) { const char* _p; \
        if constexpr (GATHER) _p = (const char*)(kptr) + ((isnext) ? nvo[h][_i] : cvo[h][_i]); else _p = (const char*)(kptr) + (size_t)(h) * hstepA + voffA[_i]; \
        __builtin_amdgcn_global_load_lds((const unsigned*)_p, (LAS unsigned*)(lds + (bufoff) + ldsw + _i * 8192), 16, 0, 0); } } while (0)
#define PG8_LDA(dst, b, h) do { _Pragma("unroll") for (int m = 0; m < 4; ++m) _Pragma("unroll") for (int k = 0; k < 2; ++k) dst[m][k] = *(const LAS bf16x8*)(lds + PG8_SA(b, h) + aoff + m * 2048 + k * 1024); } while (0)
#define PG8_LDB(dst, b, h) do { _Pragma("unroll") for (int n = 0; n < 2; ++n) _Pragma("unroll") for (int k = 0; k < 2; ++k) dst[n][k] = *(const LAS bf16x8*)(lds + PG8_SB(b, h) + boff + n * 2048 + k * 1024); } while (0)
#define PG8_MMA(ai, bj, At, Bt) do { __builtin_amdgcn_s_setprio(1); _Pragma("unroll") for (int m = 0; m < 4; ++m) _Pragma("unroll") for (int n = 0; n < 2; ++n) _Pragma("unroll") for (int k = 0; k < 2; ++k) \
        acc[ai][bj][m][n] = __builtin_amdgcn_mfma_f32_16x16x32_bf16(Bt[n][k], At[m][k], acc[ai][bj][m][n], 0, 0, 0); __builtin_amdgcn_s_setprio(0); } while (0)
#define PG8_WAIT_V(n) asm volatile("s_waitcnt vmcnt(" #n ")" ::: "memory")
#define PG8_WAIT_L(n) asm volatile("s_waitcnt lgkmcnt(" #n ")" ::: "memory")
#define PG8_BAR __builtin_amdgcn_s_barrier()
#define PG8_SCHED __builtin_amdgcn_sched_barrier(0)
#define PG8_VOA(vo, u) do { _Pragma("unroll") for (int _h = 0; _h < 2; ++_h) _Pragma("unroll") for (int _i = 0; _i < 2; ++_i) { \
        int _row = (u).pm * BM + _h * HALF + RA[_i]; if (GATHER) { _row = g.gidx[_row]; _row = _row < 0 ? 0 : _row; } \
        (vo)[_h][_i] = (unsigned)_row * (unsigned)(g.lda * 2) + (unsigned)(CA[_i] * 2); } } while (0)
    Unit cur, nxt; int ui = 0;
    if (!S.next(0, cur)) return;
    f32x4 acc[2][2][4][2];
#pragma unroll
    for (int a = 0; a < 2; ++a)
#pragma unroll
        for (int b = 0; b < 2; ++b)
#pragma unroll
            for (int m = 0; m < 4; ++m)
#pragma unroll
                for (int n = 0; n < 2; ++n) acc[a][b][m][n] = (f32x4){0.f, 0.f, 0.f, 0.f};
    bf16x8 At[4][2], B0[2][2], B1[2][2];
    unsigned cvo[2][2], nvo[2][2];
    if constexpr (GATHER) { PG8_VOA(cvo, cur); PG8_VOA(nvo, cur); }
    const char* cA = (const char*)g.A + (GATHER ? (size_t)0 : (size_t)cur.pm * tstepA); const char* cB = (const char*)g.Bt + (size_t)cur.pn * tstepB;
    PG8_STAGEB(PG8_SB(0, 0), cB); PG8_STAGEB(PG8_SB(0, 1), cB + hstepB); PG8_STAGEA(PG8_SA(0, 0), cA, false, 0); PG8_STAGEA(PG8_SA(0, 1), cA, false, 1);
    if (wr == 1) PG8_BAR;
    PG8_WAIT_V(2); PG8_BAR;
    PG8_STAGEB(PG8_SB(1, 0), cB + kstep); PG8_STAGEA(PG8_SA(1, 0), cA + kstep, false, 0); PG8_STAGEB(PG8_SB(1, 1), cB + hstepB + kstep);
    PG8_WAIT_V(6); PG8_BAR;
    for (;;) {
        const bool has_next = S.next(ui + 1, nxt);
        if constexpr (GATHER) { if (has_next) { PG8_VOA(nvo, nxt); } }
        const char* nA = (GATHER || !has_next) ? cA : (const char*)g.A + (size_t)nxt.pm * tstepA;
        const char* nB = has_next ? (const char*)g.Bt + (size_t)nxt.pn * tstepB : cB;
#pragma nounroll
        for (int t = 0; t < nt; t += 2) {
            const bool last = (t == nt - 2);
            const char* a1 = cA + (size_t)(t + 1) * kstep;
            const char* a2 = last ? nA : cA + (size_t)(t + 2) * kstep; const char* b2 = last ? nB : cB + (size_t)(t + 2) * kstep;
            const char* a3 = a2 + kstep; const char* b3 = b2 + kstep;
            PG8_LDB(B0, 0, 0); PG8_LDB(B1, 0, 1); PG8_SCHED; PG8_LDA(At, 0, 0); PG8_STAGEA(PG8_SA(1, 1), a1, false, 1);
            PG8_WAIT_V(8); PG8_WAIT_L(0); PG8_BAR; PG8_MMA(0, 0, At, B0); PG8_MMA(0, 1, At, B1); PG8_BAR; PG8_SCHED;
            PG8_LDA(At, 0, 1); PG8_STAGEB(PG8_SB(0, 0), b2); PG8_STAGEB(PG8_SB(0, 1), b2 + hstepB); PG8_STAGEA(PG8_SA(0, 0), a2, last, 0);
            PG8_WAIT_V(8); PG8_WAIT_L(0); PG8_BAR; PG8_MMA(1, 0, At, B0); PG8_MMA(1, 1, At, B1); PG8_BAR; PG8_SCHED;
            PG8_LDB(B0, 1, 0); PG8_LDB(B1, 1, 1); PG8_SCHED; PG8_LDA(At, 1, 0); PG8_STAGEA(PG8_SA(0, 1), a2, last, 1);
            PG8_WAIT_V(8); PG8_WAIT_L(0); PG8_BAR; PG8_MMA(0, 0, At, B0); PG8_MMA(0, 1, At, B1); PG8_BAR; PG8_SCHED;
            PG8_LDA(At, 1, 1); PG8_STAGEB(PG8_SB(1, 0), b3); PG8_STAGEB(PG8_SB(1, 1), b3 + hstepB); PG8_STAGEA(PG8_SA(1, 0), a3, last, 0);
            PG8_WAIT_V(8); PG8_WAIT_L(0); PG8_BAR; PG8_MMA(1, 0, At, B0); PG8_MMA(1, 1, At, B1); PG8_BAR; PG8_SCHED;
        }
        if constexpr (ALIGN_EPI) { if (wr == 0) PG8_BAR; }
        E(acc, cur, wr, wc, fr, fq);
        if (!has_next) break;
#pragma unroll
        for (int a = 0; a < 2; ++a)
#pragma unroll
            for (int b = 0; b < 2; ++b)
#pragma unroll
                for (int m = 0; m < 4; ++m)
#pragma unroll
                    for (int n = 0; n < 2; ++n) acc[a][b][m][n] = (f32x4){0.f, 0.f, 0.f, 0.f};
        cur = nxt; cA = nA; cB = nB; ++ui;
        if constexpr (GATHER) {
#pragma unroll
            for (int _h = 0; _h < 2; ++_h)
#pragma unroll
                for (int _i = 0; _i < 2; ++_i) cvo[_h][_i] = nvo[_h][_i]; }
        if constexpr (ALIGN_EPI) { if (wr == 1) PG8_BAR; }
    }
    PG8_WAIT_V(0);
    if constexpr (!ALIGN_EPI) { if (wr == 0) PG8_BAR; }
    PG8_BAR;
#undef PG8_SA
#undef PG8_SB
#undef PG8_STAGEA
#undef PG8_STAGEB
#undef PG8_LDA
#undef PG8_LDB
#undef PG8_MMA
#undef PG8_WAIT_V
#undef PG8_WAIT_L
#undef PG8_BAR
#undef PG8_SCHED
#undef PG8_VOA
}

template <class Epi, class Sched, bool GATHER>
__device__ __forceinline__ void gemm_phase_naive(const Gemm g, const Sched& S, const Epi& E) {
    const int tid = threadIdx.x, wid = tid >> 6, lane = tid & 63, wr = wid >> 2, wc = wid & 3, fr = lane & 15, fq = lane >> 4;
    Unit u;
    for (int ui = 0; S.next(ui, u); ++ui) {
        f32x4 acc[2][2][4][2];
#pragma unroll
        for (int a = 0; a < 2; ++a)
#pragma unroll
            for (int b = 0; b < 2; ++b)
#pragma unroll
                for (int m = 0; m < 4; ++m)
#pragma unroll
                    for (int n = 0; n < 2; ++n) acc[a][b][m][n] = (f32x4){0.f, 0.f, 0.f, 0.f};
        const bf16* arow[2][4];
#pragma unroll
        for (int ai = 0; ai < 2; ++ai)
#pragma unroll
            for (int m = 0; m < 4; ++m) { int r = u.pm * BM + ai * HALF + wr * 64 + m * 16 + fr; if (GATHER) { r = g.gidx[r]; r = r < 0 ? 0 : r; } arow[ai][m] = g.A + (size_t)r * g.lda; }
        for (int k = 0; k < g.K; k += 4) {
            float av[2][4][4];
#pragma unroll
            for (int ai = 0; ai < 2; ++ai)
#pragma unroll
                for (int m = 0; m < 4; ++m) { const u32x2 w = *(const u32x2*)(arow[ai][m] + k); av[ai][m][0] = bflo(w.x); av[ai][m][1] = bfhi(w.x); av[ai][m][2] = bflo(w.y); av[ai][m][3] = bfhi(w.y); }
#pragma unroll
            for (int bj = 0; bj < 2; ++bj)
#pragma unroll
                for (int n = 0; n < 2; ++n)
#pragma unroll
                    for (int e = 0; e < 4; ++e) {
                        const int col = u.pn * BM + bj * HALF + wc * 32 + (Epi::PERM ? (8 * fq + 4 * n) : (16 * n + 4 * fq)) + e;
                        const u32x2 w = *(const u32x2*)(g.Bt + (size_t)col * g.ldb + k);
                        const float b0 = bflo(w.x), b1 = bfhi(w.x), b2 = bflo(w.y), b3 = bfhi(w.y);
#pragma unroll
                        for (int ai = 0; ai < 2; ++ai)
#pragma unroll
                            for (int m = 0; m < 4; ++m) acc[ai][bj][m][n][e] += av[ai][m][0] * b0 + av[ai][m][1] * b1 + av[ai][m][2] * b2 + av[ai][m][3] * b3;
                    }
        }
        E(acc, u, wr, wc, fr, fq);
    }
    VM_WAIT(); __syncthreads();
}
}
namespace g128 {
using pg8::lds_byte; using pg8::stage_rc; using pg8::HTB; using pg8::BK;
struct Seg { const bf16* A; const bf16* B; int lda, ldb, nt; };
typedef f32x4 acc_t[2][4][2];

template <class Prog>
__device__ __forceinline__ void stream(LAS unsigned char* lds, Prog& P, int nunits, int first, int stride) {
    int tid = my_tid(); asm volatile("" : "+v"(tid));
    const int wid = __builtin_amdgcn_readfirstlane(tid >> 6), lane = tid & 63, wr = wid >> 2, wc = wid & 3, fr = lane & 15, fq = lane >> 4;
    int RA[2], CA[2], RB[2];
#pragma unroll
    for (int i = 0; i < 2; ++i) { stage_rc(tid * 16 + i * 8192, RA[i], CA[i]); RB[i] = (RA[i] & ~31) + pg8::perm32(RA[i] & 31); }
    const unsigned ldsw = (unsigned)wid * 1024u;
    const int aoff = lds_byte(wr * 64 + fr, fq * 8), boff = lds_byte(wc * 32 + fr, fq * 8);
#define G_SA(b) ((b) * HTB)
#define G_SB(b, h) ((2 + (b) * 2 + (h)) * HTB)
#define G_STAGE(bufoff, base, ld, kbyte, RR) do { _Pragma("unroll") for (int _i = 0; _i < 2; ++_i) \
        __builtin_amdgcn_global_load_lds((const unsigned*)((const char*)(base) + (size_t)(kbyte) + (unsigned)(RR[_i] * (ld) + CA[_i]) * 2u), (LAS unsigned*)(lds + (bufoff) + ldsw + _i * 8192), 16, 0, 0); } while (0)
#define G_STAGE_A(b, S, j) G_STAGE(G_SA(b), (S).A, (S).lda, (j) * 128, RA)
#define G_STAGE_B(b, h, S, j) G_STAGE(G_SB(b, h), (const char*)(S).B + (size_t)(h) * 128 * (S).ldb * 2, (S).ldb, (j) * 128, RB)
#define G_LDA(dst, b) do { _Pragma("unroll") for (int m = 0; m < 4; ++m) _Pragma("unroll") for (int k = 0; k < 2; ++k) dst[m][k] = *(const LAS bf16x8*)(lds + G_SA(b) + aoff + m * 2048 + k * 1024); } while (0)
#define G_LDB(dst, b, h) do { _Pragma("unroll") for (int n = 0; n < 2; ++n) _Pragma("unroll") for (int k = 0; k < 2; ++k) dst[n][k] = *(const LAS bf16x8*)(lds + G_SB(b, h) + boff + n * 2048 + k * 1024); } while (0)
#define G_MMA(bj, At, Bt) do { __builtin_amdgcn_s_setprio(1); _Pragma("unroll") for (int m = 0; m < 4; ++m) _Pragma("unroll") for (int n = 0; n < 2; ++n) _Pragma("unroll") for (int k = 0; k < 2; ++k) \
        acc[bj][m][n] = __builtin_amdgcn_mfma_f32_16x16x32_bf16(Bt[n][k], At[m][k], acc[bj][m][n], 0, 0, 0); __builtin_amdgcn_s_setprio(0); } while (0)
#define G_WAIT_V(n) asm volatile("s_waitcnt vmcnt(" #n ")" ::: "memory")
#define G_WAIT_L(n) asm volatile("s_waitcnt lgkmcnt(" #n ")" ::: "memory")
#define G_BAR __builtin_amdgcn_s_barrier()
#define G_SCHED __builtin_amdgcn_sched_barrier(0)
    if (first >= nunits) return;
    P.reset();
    int ucur = first, scur = 0;
    Seg cur, nxt;
    P.seg(ucur, scur, cur);
    acc_t acc;
    P.init(ucur, scur, acc, wr, wc, fr, fq);
    bf16x8 At[4][2], B0[2][2], B1[2][2];
    G_STAGE_B(0, 0, cur, 0); G_STAGE_A(0, cur, 0); G_STAGE_B(0, 1, cur, 0);
    if (wr == 1) G_BAR;
    G_WAIT_V(2); G_BAR;
    G_STAGE_A(1, cur, 1); G_STAGE_B(1, 0, cur, 1);
    G_WAIT_V(4); G_BAR;
#define G_TILE(t_, b_) do { const bool n1_ = ((t_) + 1 >= nt), n2_ = ((t_) + 2 >= nt); const int j1_ = n1_ ? ((t_) + 1 - nt) : ((t_) + 1), j2_ = n2_ ? ((t_) + 2 - nt) : ((t_) + 2); \
        G_LDB(B0, b_, 0); G_SCHED; G_LDA(At, b_); \
        if (n1_) G_STAGE_B((b_) ^ 1, 1, nxt, j1_); else G_STAGE_B((b_) ^ 1, 1, cur, j1_); \
        G_WAIT_V(6); G_WAIT_L(0); G_BAR; G_MMA(0, At, B0); G_BAR; G_SCHED; \
        G_LDB(B1, b_, 1); \
        if (n2_) { G_STAGE_A(b_, nxt, j2_); G_STAGE_B(b_, 0, nxt, j2_); } else { G_STAGE_A(b_, cur, j2_); G_STAGE_B(b_, 0, cur, j2_); } \
        G_WAIT_V(6); G_WAIT_L(0); G_BAR; G_MMA(1, At, B1); G_BAR; G_SCHED; } while (0)
    for (;;) {
        int unxt = ucur, snxt = scur + 1; bool more = true;
        if (snxt == Prog::NSEG) { snxt = 0; unxt = ucur + stride; if (unxt >= nunits) { more = false; unxt = ucur; snxt = scur; } }
        P.seg(unxt, snxt, nxt);
        int ntq = cur.nt; asm volatile("" : "+s"(ntq)); const int nt = ntq;
#pragma nounroll
        for (int t = 0; t < nt; t += 2) { G_TILE(t, 0); G_TILE(t + 1, 1); }
        P.done(ucur, scur, acc, wr, wc, fr, fq);
        if (!more) break;
        P.init(unxt, snxt, acc, wr, wc, fr, fq);
        ucur = unxt; scur = snxt; cur = nxt;
    }
    G_WAIT_V(0);
    if (wr == 0) G_BAR;
    G_BAR;
#undef G_SA
#undef G_SB
#undef G_STAGE
#undef G_STAGE_A
#undef G_STAGE_B
#undef G_LDA
#undef G_LDB
#undef G_MMA
#undef G_WAIT_V
#undef G_WAIT_L
#undef G_BAR
#undef G_SCHED
#undef G_TILE
}

struct MergeProg {
    static constexpr int NSEG = 8;
    const bf16* Hn; const bf16* zin; const bf16* wg; const bf16* wb; const float* bg; bf16* M;
    __device__ __forceinline__ void reset() {
#pragma unroll
        for (int a = 0; a < 2; ++a)
#pragma unroll
            for (int b = 0; b < 4; ++b)
#pragma unroll
                for (int c = 0; c < 2; ++c) { g[a][b][c] = (u32x2){0u, 0u}; macc[a][b][c] = (u32x2){0u, 0u}; } }
    u32x2 g[2][4][2]; u32x2 macc[2][4][2];
    __device__ __forceinline__ void seg(int u, int s, Seg& S) const {
        const int pm = u >> 2, pn = u & 3, k = s >> 1;
        if ((s & 1) == 0) { S.A = Hn + (size_t)pm * 128 * D; S.lda = D; S.B = wg + ((size_t)k * D + pn * 256) * D; S.ldb = D; S.nt = D / 64; }
        else { const int ycol = (k == 0) ? ZC_U : (k == 1) ? ZC_FQ : (k == 2) ? ZC_CQ : ZC_DQ;
               S.A = zin + (size_t)pm * 128 * ZP + ycol; S.lda = ZP; S.B = wb + ((size_t)k * D + pn * 256) * 256; S.ldb = 256; S.nt = 4; }
    }
    __device__ __forceinline__ void init(int u, int s, acc_t& acc, int wr, int wc, int fr, int fq) {
        const int pn = u & 3, k = s >> 1;
        if ((s & 1) == 0) {
#pragma unroll
            for (int bj = 0; bj < 2; ++bj)
#pragma unroll
                for (int n = 0; n < 2; ++n) { const f32x4 bv = *(const f32x4*)(bg + (size_t)k * D + pn * 256 + bj * 128 + wc * 32 + 8 * fq + 4 * n);
#pragma unroll
                    for (int m = 0; m < 4; ++m) acc[bj][m][n] = bv; }
            if (s == 0) {
#pragma unroll
                for (int bj = 0; bj < 2; ++bj)
#pragma unroll
                    for (int m = 0; m < 4; ++m)
#pragma unroll
                        for (int n = 0; n < 2; ++n) macc[bj][m][n] = (u32x2){0u, 0u}; }
        } else {
#pragma unroll
            for (int bj = 0; bj < 2; ++bj)
#pragma unroll
                for (int m = 0; m < 4; ++m)
#pragma unroll
                    for (int n = 0; n < 2; ++n) acc[bj][m][n] = (f32x4){0.f, 0.f, 0.f, 0.f};
        }
    }
    __device__ __forceinline__ void done(int u, int s, const acc_t& acc, int wr, int wc, int fr, int fq) {
        if ((s & 1) == 0) {
#pragma unroll
            for (int bj = 0; bj < 2; ++bj)
#pragma unroll
                for (int m = 0; m < 4; ++m)
#pragma unroll
                    for (int n = 0; n < 2; ++n) { const f32x4 a = acc[bj][m][n]; u32x2 w; w.x = pk2(sigmoidf_(a[0]), sigmoidf_(a[1])); w.y = pk2(sigmoidf_(a[2]), sigmoidf_(a[3])); g[bj][m][n] = w; }
        } else {
#pragma unroll
            for (int bj = 0; bj < 2; ++bj)
#pragma unroll
                for (int m = 0; m < 4; ++m)
#pragma unroll
                    for (int n = 0; n < 2; ++n) { const u32x2 w = g[bj][m][n], q = macc[bj][m][n]; const f32x4 v = (f32x4){bflo(q.x), bfhi(q.x), bflo(q.y), bfhi(q.y)} + (f32x4){bflo(w.x), bfhi(w.x), bflo(w.y), bfhi(w.y)} * acc[bj][m][n];
                        u32x2 r; r.x = pk2(v[0], v[1]); r.y = pk2(v[2], v[3]); macc[bj][m][n] = r; }
            if (s == NSEG - 1) { const int pm = u >> 2, pn = u & 3;
#pragma unroll
                for (int m = 0; m < 4; ++m) { bf16* rp = M + (size_t)(pm * 128 + wr * 64 + m * 16 + fr) * D + pn * 256 + wc * 32 + 8 * fq;
#pragma unroll
                    for (int bj = 0; bj < 2; ++bj) *(u32x4*)(rp + bj * 128) = (u32x4){macc[bj][m][0].x, macc[bj][m][0].y, macc[bj][m][1].x, macc[bj][m][1].y}; } }
        }
    }
};

struct PleProg {
    static constexpr int NSEG = 8;
    const bf16* pbf; const bf16* hp; const bf16* wup; const bf16* wpg; bf16* x;
    u32x2 uu[2][4][2];
    __device__ __forceinline__ void reset() {
#pragma unroll
        for (int a = 0; a < 2; ++a)
#pragma unroll
            for (int b = 0; b < 4; ++b)
#pragma unroll
                for (int c = 0; c < 2; ++c) uu[a][b][c] = (u32x2){0u, 0u}; }
    __device__ __forceinline__ void seg(int u, int s, Seg& S) const {
        const int pn = s >> 1;
        if ((s & 1) == 0) { S.A = pbf + (size_t)u * 128 * 256; S.lda = 256; S.B = wup + (size_t)pn * 256 * 256; S.ldb = 256; S.nt = 4; }
        else { S.A = hp + (size_t)u * 128 * D; S.lda = D; S.B = wpg + (size_t)pn * 256 * D; S.ldb = D; S.nt = D / 64; }
    }
    __device__ __forceinline__ void init(int u, int s, acc_t& acc, int wr, int wc, int fr, int fq) {
#pragma unroll
        for (int bj = 0; bj < 2; ++bj)
#pragma unroll
            for (int m = 0; m < 4; ++m)
#pragma unroll
                for (int n = 0; n < 2; ++n) acc[bj][m][n] = (f32x4){0.f, 0.f, 0.f, 0.f};
    }
    __device__ __forceinline__ void done(int u, int s, const acc_t& acc, int wr, int wc, int fr, int fq) {
        if ((s & 1) == 0) {
#pragma unroll
            for (int bj = 0; bj < 2; ++bj)
#pragma unroll
                for (int m = 0; m < 4; ++m)
#pragma unroll
                    for (int n = 0; n < 2; ++n) { const f32x4 a = acc[bj][m][n]; u32x2 w; w.x = pk2(a[0], a[1]); w.y = pk2(a[2], a[3]); uu[bj][m][n] = w; }
        } else { const int pn = s >> 1;
#pragma unroll
            for (int m = 0; m < 4; ++m) { bf16* rp = x + (size_t)(u * 128 + wr * 64 + m * 16 + fr) * D + pn * 256 + wc * 32 + 8 * fq; u32x4 xv[2];
#pragma unroll
                for (int bj = 0; bj < 2; ++bj) xv[bj] = *(const u32x4*)(rp + bj * 128);
#pragma unroll
                for (int bj = 0; bj < 2; ++bj) { const u32x4 xw = xv[bj]; f32x4 r[2];
#pragma unroll
                    for (int n = 0; n < 2; ++n) { const u32x2 w = uu[bj][m][n]; f32x4 v = acc[bj][m][n];
                        v[0] = sigmoidf_(v[0]); v[1] = sigmoidf_(v[1]); v[2] = sigmoidf_(v[2]); v[3] = sigmoidf_(v[3]);
                        const f32x4 xo = n == 0 ? (f32x4){bflo(xw.x), bfhi(xw.x), bflo(xw.y), bfhi(xw.y)} : (f32x4){bflo(xw.z), bfhi(xw.z), bflo(xw.w), bfhi(xw.w)};
                        r[n] = xo + (f32x4){bflo(w.x), bfhi(w.x), bflo(w.y), bfhi(w.y)} * v; }
                    *(u32x4*)(rp + bj * 128) = (u32x4){pk2(r[0][0], r[0][1]), pk2(r[0][2], r[0][3]), pk2(r[1][0], r[1][1]), pk2(r[1][2], r[1][3])}; } } }
    }
};
}
namespace epi {
using pg8::Unit; using pg8::BM; using pg8::HALF;
__device__ __forceinline__ void epi_fence() { asm volatile("" ::: "memory"); }
#define EPI_FENCE epi_fence()
#define EPI_LOOP_ROWS for (int ai = 0; ai < 2; ++ai) _Pragma("unroll") for (int m = 0; m < 4; ++m)
#define EPI_LOOP_COLS for (int bj = 0; bj < 2; ++bj) _Pragma("unroll") for (int n = 0; n < 2; ++n)
#define EPI_ROW (u.pm * BM + ai * HALF + wr * 64 + m * 16 + fr)
#define EPI_COLT (bj * HALF + wc * 32 + n * 16 + 4 * fq)
typedef f32x4 acc_t[2][2][4][2];
#define EPI_C8(bj_) ((bj_) * HALF + wc * 32 + 8 * fq)
__device__ __forceinline__ u32x4 pack8(f32x4 a, f32x4 b) { return (u32x4){pk2(a[0], a[1]), pk2(a[2], a[3]), pk2(b[0], b[1]), pk2(b[2], b[3])}; }
__device__ __forceinline__ u32x2 pack4(f32x4 v) { u32x2 w; w.x = pk2(v[0], v[1]); w.y = pk2(v[2], v[3]); return w; }
__device__ __forceinline__ f32x4 unpack4(u32x2 w) { return (f32x4){bflo(w.x), bfhi(w.x), bflo(w.y), bfhi(w.y)}; }

struct EpiStore {
    static constexpr bool PERM = true;
    bf16* O; int ldc; int pn0;
    __device__ __forceinline__ void operator()(const acc_t& acc, const Unit& u, int wr, int wc, int fr, int fq) const {
#pragma unroll
        EPI_LOOP_ROWS { bf16* rp = O + (size_t)EPI_ROW * ldc + (u.pn - pn0) * BM + wc * 32 + 8 * fq;
#pragma unroll
            for (int bj = 0; bj < 2; ++bj) { const u32x2 lo = pack4(acc[ai][bj][m][0]), hi = pack4(acc[ai][bj][m][1]); *(u32x4*)(rp + bj * HALF) = (u32x4){lo.x, lo.y, hi.x, hi.y}; } }
    }
};
struct EpiRowScale {
    static constexpr bool PERM = true;
    bf16* O; int ldc; const float* rs;
    __device__ __forceinline__ void operator()(const acc_t& acc, const Unit& u, int wr, int wc, int fr, int fq) const {
        float sv[2][4];
#pragma unroll
        EPI_LOOP_ROWS sv[ai][m] = rs[EPI_ROW];
#pragma unroll
        EPI_LOOP_ROWS { const int row = EPI_ROW; const float s = sv[ai][m]; bf16* rp = O + (size_t)row * ldc + u.pn * BM;
#pragma unroll
            for (int bj = 0; bj < 2; ++bj) *(u32x4*)(rp + EPI_C8(bj)) = pack8(acc[ai][bj][m][0] * s, acc[ai][bj][m][1] * s); }
    }
};
struct EpiMlaQ {
    static constexpr bool PERM = false;
    bf16* O; const float* rs; const float* cosT; const float* sinT;
    __device__ __forceinline__ void operator()(const acc_t& acc, const Unit& u, int wr, int wc, int fr, int fq) const {
        float sv[2][4]; f32x4 csv[2], snv[2];
#pragma unroll
        EPI_LOOP_ROWS sv[ai][m] = rs[EPI_ROW];
        { const int row = u.pm * BM + wr * 64 + fr; csv[0] = *(const f32x4*)(cosT + (size_t)row * 16 + 4 * fq); snv[0] = *(const f32x4*)(sinT + (size_t)row * 16 + 4 * fq); }
#pragma unroll
        for (int it = 0; it < 8; ++it) { const int ai = it >> 2, m = it & 3;
            if (it + 1 < 8) { const int row = u.pm * BM + ((it + 1) >> 2) * HALF + wr * 64 + ((it + 1) & 3) * 16 + fr;
                csv[(it + 1) & 1] = *(const f32x4*)(cosT + (size_t)row * 16 + 4 * fq); snv[(it + 1) & 1] = *(const f32x4*)(sinT + (size_t)row * 16 + 4 * fq); }
            const int row = EPI_ROW; const float s = sv[ai][m]; bf16* rp = O + (size_t)row * 512 + u.pn * BM;
            const f32x4 cs = csv[it & 1], sn = snv[it & 1];
#pragma unroll
            for (int bj = 0; bj < 2; ++bj) { const int grp = u.pn * 8 + bj * 4 + wc;
                f32x4 t1 = acc[ai][bj][m][0] * s, t2 = acc[ai][bj][m][1] * s;
                if (grp % 3 == 2) { const f32x4 a = t1 * cs - t2 * sn, b = t2 * cs + t1 * sn; t1 = a; t2 = b; }
                *(u32x2*)(rp + bj * HALF + wc * 32 + 4 * fq) = pack4(t1); *(u32x2*)(rp + bj * HALF + wc * 32 + 16 + 4 * fq) = pack4(t2); } }
    }
};
struct EpiGate {
    static constexpr bool PERM = false;
    bf16* G; const float* bias;
    __device__ __forceinline__ void operator()(const acc_t& acc, const Unit& u, int wr, int wc, int fr, int fq) const {
        f32x4 bv[2][2];
#pragma unroll
        EPI_LOOP_COLS bv[bj][n] = *(const f32x4*)(bias + u.pn * BM + EPI_COLT);
#pragma unroll
        EPI_LOOP_ROWS { bf16* rp = G + (size_t)EPI_ROW * D + u.pn * BM;
#pragma unroll
            EPI_LOOP_COLS { f32x4 v = acc[ai][bj][m][n] + bv[bj][n];
                v[0] = sigmoidf_(v[0]); v[1] = sigmoidf_(v[1]); v[2] = sigmoidf_(v[2]); v[3] = sigmoidf_(v[3]);
                *(u32x2*)(rp + EPI_COLT) = pack4(v); } }
    }
};
#define EPI_IT_ROW(it_) (u.pm * BM + ((it_) >> 2) * HALF + wr * 64 + ((it_) & 3) * 16 + fr)
#define EPI_C4(c_) (((c_) >> 1) * HALF + wc * 32 + ((c_) & 1) * 16 + 4 * fq)
struct EpiMerge {
    static constexpr bool PERM = false;
    const bf16* G; bf16* M; int first;
    __device__ __forceinline__ void operator()(const acc_t& acc, const Unit& u, int wr, int wc, int fr, int fq) const {
        u32x2 gv[2][4], mv[2][4];
#define EPI_LD(it_) do { const size_t ro_ = (size_t)EPI_IT_ROW(it_) * D + u.pn * BM; _Pragma("unroll") for (int c = 0; c < 4; ++c) { gv[(it_) & 1][c] = *(const u32x2*)(G + ro_ + EPI_C4(c)); \
            mv[(it_) & 1][c] = first ? (u32x2){0u, 0u} : *(const u32x2*)(M + ro_ + EPI_C4(c)); } } while (0)
        EPI_LD(0);
#pragma unroll
        for (int it = 0; it < 8; ++it) { if (it + 1 < 8) EPI_LD(it + 1);
            const size_t ro = (size_t)EPI_IT_ROW(it) * D + u.pn * BM;
#pragma unroll
            for (int c = 0; c < 4; ++c) { const f32x4 v = unpack4(gv[it & 1][c]) * acc[it >> 2][c >> 1][it & 3][c & 1] + unpack4(mv[it & 1][c]); *(u32x2*)(M + ro + EPI_C4(c)) = pack4(v); } }
#undef EPI_LD
    }
};
struct EpiRes {
    static constexpr bool PERM = true;
    XSrc xin; bf16* xout;
    __device__ __forceinline__ void operator()(const acc_t& acc, const Unit& u, int wr, int wc, int fr, int fq) const {
        f32x4 xv[2][2][2];
#define EPI_LD(it_) do { const size_t ro_ = (size_t)EPI_IT_ROW(it_) * D + u.pn * BM; _Pragma("unroll") for (int bj = 0; bj < 2; ++bj) { \
            if (xin.f) { xv[(it_) & 1][bj][0] = *(const f32x4*)(xin.f + ro_ + EPI_C8(bj)); xv[(it_) & 1][bj][1] = *(const f32x4*)(xin.f + ro_ + EPI_C8(bj) + 4); } \
            else { const u32x4 w_ = *(const u32x4*)(xin.b + ro_ + EPI_C8(bj)); xv[(it_) & 1][bj][0] = (f32x4){bflo(w_.x), bfhi(w_.x), bflo(w_.y), bfhi(w_.y)}; xv[(it_) & 1][bj][1] = (f32x4){bflo(w_.z), bfhi(w_.z), bflo(w_.w), bfhi(w_.w)}; } } } while (0)
        EPI_LD(0);
#pragma unroll
        for (int it = 0; it < 8; ++it) { if (it + 1 < 8) EPI_LD(it + 1);
            const size_t ro = (size_t)EPI_IT_ROW(it) * D + u.pn * BM;
#pragma unroll
            for (int bj = 0; bj < 2; ++bj) *(u32x4*)(xout + ro + EPI_C8(bj)) = pack8(xv[it & 1][bj][0] + acc[it >> 2][bj][it & 3][0], xv[it & 1][bj][1] + acc[it >> 2][bj][it & 3][1]); }
#undef EPI_LD
    }
};
struct EpiPle {
    static constexpr bool PERM = false;
    const bf16* U; float* x;
    __device__ __forceinline__ void operator()(const acc_t& acc, const Unit& u, int wr, int wc, int fr, int fq) const {
        f32x4 xv[2][4]; u32x2 uv[2][4];
#define EPI_LD(it_) do { const size_t ro_ = (size_t)EPI_IT_ROW(it_) * D + u.pn * BM; _Pragma("unroll") for (int c = 0; c < 4; ++c) { xv[(it_) & 1][c] = *(const f32x4*)(x + ro_ + EPI_C4(c)); uv[(it_) & 1][c] = *(const u32x2*)(U + ro_ + EPI_C4(c)); } } while (0)
        EPI_LD(0);
#pragma unroll
        for (int it = 0; it < 8; ++it) { if (it + 1 < 8) EPI_LD(it + 1);
            const size_t ro = (size_t)EPI_IT_ROW(it) * D + u.pn * BM;
#pragma unroll
            for (int c = 0; c < 4; ++c) { f32x4 v = acc[it >> 2][c >> 1][it & 3][c & 1];
                v[0] = sigmoidf_(v[0]); v[1] = sigmoidf_(v[1]); v[2] = sigmoidf_(v[2]); v[3] = sigmoidf_(v[3]);
                *(f32x4*)(x + ro + EPI_C4(c)) = xv[it & 1][c] + unpack4(uv[it & 1][c]) * v; } }
#undef EPI_LD
    }
};
struct EpiSwiglu {
    static constexpr bool PERM = true;
    bf16* O; int ldc; int npt;
    __device__ __forceinline__ void operator()(const acc_t& acc, const Unit& u, int wr, int wc, int fr, int fq) const {
        const int ct = (u.pn % npt) * HALF;
#pragma unroll
        EPI_LOOP_ROWS { bf16* rp = O + (size_t)EPI_ROW * ldc + ct + wc * 32 + 8 * fq; u32x2 w[2];
#pragma unroll
            for (int n = 0; n < 2; ++n) { const f32x4 a = acc[ai][0][m][n], b = acc[ai][1][m][n]; f32x4 v;
#pragma unroll
                for (int e = 0; e < 4; ++e) v[e] = a[e] * sigmoidf_(a[e]) * b[e];
                w[n] = pack4(v); }
            *(u32x4*)rp = (u32x4){w[0].x, w[0].y, w[1].x, w[1].y}; }
    }
};
struct EpiGlu {
    static constexpr bool PERM = true;
    bf16* Y; int ldc;
    __device__ __forceinline__ void operator()(const acc_t& acc, const Unit& u, int wr, int wc, int fr, int fq) const {
        u32x4 yv[2][2];
#define EPI_LD(it_) do { const bf16* rp_ = Y + (size_t)EPI_IT_ROW(it_) * ldc + u.pn * BM; _Pragma("unroll") for (int bj = 0; bj < 2; ++bj) yv[(it_) & 1][bj] = *(const u32x4*)(rp_ + EPI_C8(bj)); } while (0)
        EPI_LD(0);
#pragma unroll
        for (int it = 0; it < 8; ++it) { if (it + 1 < 8) EPI_LD(it + 1);
            bf16* rp = Y + (size_t)EPI_IT_ROW(it) * ldc + u.pn * BM;
#pragma unroll
            for (int bj = 0; bj < 2; ++bj) { const u32x4 w = yv[it & 1][bj]; f32x4 a = acc[it >> 2][bj][it & 3][0], b = acc[it >> 2][bj][it & 3][1];
                a[0] = bflo(w.x) * sigmoidf_(a[0]); a[1] = bfhi(w.x) * sigmoidf_(a[1]); a[2] = bflo(w.y) * sigmoidf_(a[2]); a[3] = bfhi(w.y) * sigmoidf_(a[3]);
                b[0] = bflo(w.z) * sigmoidf_(b[0]); b[1] = bfhi(w.z) * sigmoidf_(b[1]); b[2] = bflo(w.w) * sigmoidf_(b[2]); b[3] = bfhi(w.w) * sigmoidf_(b[3]);
                *(u32x4*)(rp + EPI_C8(bj)) = pack8(a, b); } }
#undef EPI_LD
    }
};
struct EpiMoeDown {
    static constexpr bool PERM = true;
    bf16* Y; const float* slot_gate;
    __device__ __forceinline__ void operator()(const acc_t& acc, const Unit& u, int wr, int wc, int fr, int fq) const {
        const int ct = (u.pn & 3) * BM;
        float gv[2][4];
#pragma unroll
        EPI_LOOP_ROWS gv[ai][m] = slot_gate[EPI_ROW];
#pragma unroll
        EPI_LOOP_ROWS { const int row = EPI_ROW; const float gt = gv[ai][m]; bf16* rp = Y + (size_t)row * D + ct;
#pragma unroll
            for (int bj = 0; bj < 2; ++bj) *(u32x4*)(rp + EPI_C8(bj)) = pack8(acc[ai][bj][m][0] * gt, acc[ai][bj][m][1] * gt); }
    }
};
}
namespace att {
constexpr int MODE_FOX = 0, MODE_MLA = 1, MODE_BAND = 2;
constexpr float LOG2E = 1.4426950408889634f;
struct Tensors {
    const bf16* Q; int ldq;
    const bf16* K; int ldk;
    const bf16* K2;
    const bf16* V; int ldv;
    bf16* O; int ldo;
    const float* cdec;
    const float* relb;
    int qhs, khs, vhs, ohs;
    const unsigned* qmax; const unsigned* kmax;
};
template <int DQK> struct Lay { static constexpr int KS = DQK * 2 + 16, KB = 64 * KS, VB = 64 * 128, CB = 256, BUF = KB + VB + CB; };
constexpr int ATT_LDS_TAB = 2 * Lay<96>::BUF;
constexpr int ATT_LDS_BYTES = ATT_LDS_TAB + 520 * 4;
__device__ __forceinline__ int crow(int r, int hi) { return (r & 3) + 8 * (r >> 2) + 4 * hi; }
typedef short v4i16_t __attribute__((ext_vector_type(4)));
__device__ __forceinline__ s16x4 vtr(const LAS unsigned char* p) { return __builtin_bit_cast(s16x4, __builtin_amdgcn_ds_read_tr16_b64_v4i16((LAS v4i16_t*)p)); }

template <int MODE>
__device__ __forceinline__ void attn_unit(const Tensors& T, int b, int h, int qb, LAS unsigned char* lds) {
    constexpr int DQK = (MODE == MODE_MLA) ? 96 : 64, NKS = DQK / 16;
    typedef Lay<DQK> LY;
    int tid = my_tid(); asm volatile("" : "+v"(tid));
    const int lane = tid & 63, r32 = lane & 31, hi = lane >> 5; const int wid = __builtin_amdgcn_readfirstlane(tid >> 6);
    const int rowb = b * SEQ, q0 = qb * 256;
    const float sc2 = ((MODE == MODE_MLA) ? 0.10206207261596575f : 0.125f) * LOG2E;
    const int cw = 4 * qb + (wid >> 1);
    const int t_lo = (MODE == MODE_BAND) ? ((4 * qb - 8) > 0 ? (4 * qb - 8) : 0) : 0, t_hi = 4 * qb + 4;
    const int qrow = rowb + q0 + wid * 32 + r32;
    bf16x8 qf[NKS];
    { const bf16* qp = T.Q + (size_t)qrow * T.ldq + h * T.qhs + hi * 8;
#pragma unroll
      for (int ks = 0; ks < NKS; ++ks) qf[ks] = *(const bf16x8*)(qp + ks * 16); }
    float cq = 0.f; if (MODE == MODE_FOX) cq = T.cdec[(size_t)qrow * 4 + h];
    LAS float* tab = (LAS float*)(lds + ATT_LDS_TAB);
    if (MODE == MODE_BAND) { for (int i = tid; i < 513; i += NTHREADS) tab[i] = T.relb[h * 513 + i] * LOG2E; }
    u32x4 kreg0[2] = {}, kreg1[2] = {}, vreg[2] = {}; float creg[2] = {0.f, 0.f};
    const int srow = tid >> 3, sch = tid & 7;
#define ATT_KADDR(c_) (((c_) % 12 < 8) ? (const u32x4*)(T.K + (kr_ + (c_) / 12) * T.ldk + h * T.khs + ((c_) % 12) * 8) : (const u32x4*)(T.K2 + (kr_ + (c_) / 12) * 32 + ((c_) % 12 - 8) * 8))
#define ATT_LOAD_TILE(t_, r_) do { const size_t kr_ = (size_t)(rowb + (t_) * 64); \
        if (MODE == MODE_MLA) { kreg0[r_] = *ATT_KADDR(tid); if (tid < 256) kreg1[r_] = *ATT_KADDR(tid + 512); } \
        else { kreg0[r_] = *(const u32x4*)(T.K + (kr_ + srow) * T.ldk + h * T.khs + sch * 8); } \
        vreg[r_] = *(const u32x4*)(T.V + (kr_ + srow) * T.ldv + h * T.vhs + sch * 8); \
        if (MODE == MODE_FOX) { if (tid < 64) creg[r_] = T.cdec[(kr_ + tid) * 4 + h]; } } while (0)
#define ATT_STORE_TILE(buf_, r_) do { LAS unsigned char* base_ = lds + (buf_) * LY::BUF; \
        if (MODE == MODE_MLA) { *(LAS u32x4*)(base_ + (tid / 12) * LY::KS + (tid % 12) * 16) = kreg0[r_]; \
            if (tid < 256) *(LAS u32x4*)(base_ + ((tid + 512) / 12) * LY::KS + ((tid + 512) % 12) * 16) = kreg1[r_]; } \
        else { *(LAS u32x4*)(base_ + srow * LY::KS + sch * 16) = kreg0[r_]; } \
        *(LAS u32x4*)(base_ + LY::KB + srow * 128 + ((sch * 16) ^ (((srow >> 1) & 1) << 6))) = vreg[r_]; \
        if (MODE == MODE_FOX) { if (tid < 64) *(LAS float*)(base_ + LY::KB + LY::VB + tid * 4) = creg[r_]; } } while (0)
    float mrun = -INFINITY, lrun = 0.f;
    f32x16 o0 = {}, o1 = {};
    const int G = lane >> 4, qi = (lane & 15) >> 2, pi = lane & 3;
    const int vb0 = (4 * hi + qi) * 128 + 64 * (0 ^ (qi >> 1)) + 32 * (G & 1) + 8 * pi;
    const int vb1 = (4 * hi + qi) * 128 + 64 * (1 ^ (qi >> 1)) + 32 * (G & 1) + 8 * pi;
    int t_min = t_lo;
    if (MODE == MODE_FOX) {
        LAS int* tm = (LAS int*)(lds + ATT_LDS_TAB);
        if (tid == 0) tm[0] = t_hi - 1;
        __syncthreads();
        if (tid < t_hi) {
            const float q2 = __uint_as_float(T.qmax[(b * 4 + h) * 32 + qb]), k2 = __uint_as_float(T.kmax[b * 4 + h]);
            const float thr = 0.125f * sqrtf(q2) * 2.0f * sqrtf(k2) * 1.02f + 112.0f;
            const float cfirst = T.cdec[(size_t)(rowb + q0) * 4 + h], clast = T.cdec[(size_t)(rowb + tid * 64 + 63) * 4 + h];
            if (!(clast - cfirst > thr)) __hip_atomic_fetch_min(tm, tid, __ATOMIC_RELAXED, __HIP_MEMORY_SCOPE_WORKGROUP);
        }
        __syncthreads();
        t_min = tm[0];
    }
    const int n_t = t_hi - t_min;
#define ATT_TILE(i_) ((MODE == MODE_FOX) ? (t_hi - 1 - (i_)) : (t_min + (i_)))
    ATT_LOAD_TILE(ATT_TILE(0), 0); ATT_STORE_TILE(0, 0);
    if (n_t > 1) ATT_LOAD_TILE(ATT_TILE(1), 1);
    if (n_t > 2) ATT_LOAD_TILE(ATT_TILE(2), 0);
    __syncthreads();
    for (int it0 = 0; it0 < n_t; it0 += 2) {
#pragma unroll
      for (int half = 0; half < 2; ++half) { const int it = it0 + half; if (it < n_t) {
        const int t = ATT_TILE(it);
        const int buf = half;
        const bool active = (MODE == MODE_BAND) ? (t <= cw && t >= cw - 8) : (t <= cw);
        if (active) {
            const LAS unsigned char* kb = lds + buf * LY::BUF;
            const LAS unsigned char* vbuf = kb + LY::KB;
            f32x16 p0 = {}, p1 = {};
            bf16x8 ka[NKS], kc[NKS];
#pragma unroll
            for (int ks = 0; ks < NKS; ++ks) { ka[ks] = *(const LAS bf16x8*)(kb + r32 * LY::KS + (ks * 16 + hi * 8) * 2); kc[ks] = *(const LAS bf16x8*)(kb + (32 + r32) * LY::KS + (ks * 16 + hi * 8) * 2); }
            __builtin_amdgcn_sched_barrier(0);
#pragma unroll
            for (int ks = 0; ks < NKS; ++ks) { p0 = __builtin_amdgcn_mfma_f32_32x32x16_bf16(ka[ks], qf[ks], p0, 0, 0, 0); p1 = __builtin_amdgcn_mfma_f32_32x32x16_bf16(kc[ks], qf[ks], p1, 0, 0, 0); }
            s16x4 vl0[4], vh0[4], vl1[4], vh1[4];
#pragma unroll
            for (int s4 = 0; s4 < 4; ++s4) { vl0[s4] = vtr(vbuf + vb0 + s4 * 2048); vh0[s4] = vtr(vbuf + vb0 + s4 * 2048 + 1024); vl1[s4] = vtr(vbuf + vb1 + s4 * 2048); vh1[s4] = vtr(vbuf + vb1 + s4 * 2048 + 1024); }
            __builtin_amdgcn_sched_barrier(0);
            if (MODE == MODE_FOX) {
                const LAS float* cb = (const LAS float*)(vbuf + LY::VB);
                const float cq2 = cq * LOG2E;
#pragma unroll
                for (int a = 0; a < 4; ++a) {
                    const f32x4 c0 = *(const LAS f32x4*)(cb + 8 * a + 4 * hi), c1 = *(const LAS f32x4*)(cb + 32 + 8 * a + 4 * hi);
#pragma unroll
                    for (int e = 0; e < 4; ++e) { p0[4 * a + e] = p0[4 * a + e] * sc2 + (cq2 - c0[e] * LOG2E); p1[4 * a + e] = p1[4 * a + e] * sc2 + (cq2 - c1[e] * LOG2E); }
                }
                if (t == cw) { const int ql = 32 * (wid & 1) + r32;
#pragma unroll
                    for (int r = 0; r < 16; ++r) { const int kv = crow(r, hi); if (kv > ql) p0[r] = -INFINITY; if (kv + 32 > ql) p1[r] = -INFINITY; } }
            } else if (MODE == MODE_BAND) {
                const int dq = (q0 + wid * 32 + r32) - t * 64;
#pragma unroll
                for (int r = 0; r < 16; ++r) { const int kv = crow(r, hi);
                    int i0 = dq - kv, i1 = dq - kv - 32; i0 = i0 < -256 ? -256 : (i0 > 256 ? 256 : i0); i1 = i1 < -256 ? -256 : (i1 > 256 ? 256 : i1);
                    p0[r] = p0[r] * sc2 + tab[i0 + 256]; p1[r] = p1[r] * sc2 + tab[i1 + 256]; }
            }
            float mx = fmaxf(p0[0], p1[0]);
#pragma unroll
            for (int r = 1; r < 16; ++r) mx = fmaxf(mx, fmaxf(p0[r], p1[r]));
            { auto rr = __builtin_amdgcn_permlane32_swap(__float_as_uint(mx), __float_as_uint(mx), false, false); mx = fmaxf(__uint_as_float(rr[0]), __uint_as_float(rr[1])); }
            if (MODE == MODE_MLA) mx *= sc2;
            const float mnew = fmaxf(mrun, mx);
            if (__any(mnew > mrun)) {
                const float alpha = __builtin_amdgcn_exp2f(mrun - mnew);
                lrun *= alpha;
#pragma unroll
                for (int r = 0; r < 16; ++r) { o0[r] *= alpha; o1[r] *= alpha; }
                mrun = mnew;
            }
            float rs = 0.f;
#pragma unroll
            for (int r = 0; r < 16; ++r) {
                if (MODE == MODE_MLA) { p0[r] = __builtin_amdgcn_exp2f(__builtin_fmaf(p0[r], sc2, -mrun)); p1[r] = __builtin_amdgcn_exp2f(__builtin_fmaf(p1[r], sc2, -mrun)); }
                else { p0[r] = __builtin_amdgcn_exp2f(p0[r] - mrun); p1[r] = __builtin_amdgcn_exp2f(p1[r] - mrun); }
                rs += p0[r] + p1[r]; }
            lrun += rs;
#pragma unroll
            for (int s4 = 0; s4 < 4; ++s4) {
                u32x4 pw;
                if (s4 < 2) { const int o = 8 * (s4 & 1); pw.x = pk2(p0[o], p0[o + 1]); pw.y = pk2(p0[o + 2], p0[o + 3]); pw.z = pk2(p0[o + 4], p0[o + 5]); pw.w = pk2(p0[o + 6], p0[o + 7]); }
                else        { const int o = 8 * (s4 & 1); pw.x = pk2(p1[o], p1[o + 1]); pw.y = pk2(p1[o + 2], p1[o + 3]); pw.z = pk2(p1[o + 4], p1[o + 5]); pw.w = pk2(p1[o + 6], p1[o + 7]); }
                const bf16x8 pf = __builtin_bit_cast(bf16x8, pw);
                const s16x4 l0 = vl0[s4], h0 = vh0[s4], l1 = vl1[s4], h1 = vh1[s4];
                const bf16x8 vf0 = (bf16x8){l0[0], l0[1], l0[2], l0[3], h0[0], h0[1], h0[2], h0[3]};
                const bf16x8 vf1 = (bf16x8){l1[0], l1[1], l1[2], l1[3], h1[0], h1[1], h1[2], h1[3]};
                o0 = __builtin_amdgcn_mfma_f32_32x32x16_bf16(vf0, pf, o0, 0, 0, 0);
                o1 = __builtin_amdgcn_mfma_f32_32x32x16_bf16(vf1, pf, o1, 0, 0, 0);
            }
        }
        if (it + 1 < n_t) ATT_STORE_TILE(half ^ 1, half ^ 1);
        if (it + 3 < n_t) ATT_LOAD_TILE(ATT_TILE(it + 3), half ^ 1);
        __syncthreads();
      } }
    }
    { auto rr = __builtin_amdgcn_permlane32_swap(__float_as_uint(lrun), __float_as_uint(lrun), false, false); lrun = __uint_as_float(rr[0]) + __uint_as_float(rr[1]); }
    const float inv = 1.0f / lrun;
    bf16* op = T.O + (size_t)qrow * T.ldo + h * T.ohs;
#pragma unroll
    for (int a = 0; a < 4; ++a) {
        u32x2 w0, w1;
        w0.x = pk2(o0[4 * a] * inv, o0[4 * a + 1] * inv); w0.y = pk2(o0[4 * a + 2] * inv, o0[4 * a + 3] * inv);
        w1.x = pk2(o1[4 * a] * inv, o1[4 * a + 1] * inv); w1.y = pk2(o1[4 * a + 2] * inv, o1[4 * a + 3] * inv);
        *(u32x2*)(op + 8 * a + 4 * hi) = w0; *(u32x2*)(op + 32 + 8 * a + 4 * hi) = w1;
    }
}

template <int MODE>
__device__ __forceinline__ void attn_phase(const Tensors& T, LAS unsigned char* lds) {
    const int G = gridDim.x, bx = blockIdx.x, vcu = (G % 8 == 0) ? (bx % 8) * (G / 8) + bx / 8 : bx;
    for (int pr = vcu; pr < 256; pr += G) {
        const int bh = pr >> 4, s = pr & 15;
        attn_unit<MODE>(T, bh >> 2, bh & 3, s, lds);
        attn_unit<MODE>(T, bh >> 2, bh & 3, 31 - s, lds);
    }
}

template <int MODE>
__device__ __forceinline__ void attn_naive(const Tensors& T) {
    BODY_IDS();
    constexpr int DQK = (MODE == MODE_MLA) ? 96 : 64;
    const float sc = (MODE == MODE_MLA) ? 0.10206207261596575f : 0.125f;
    for (int idx = gtid; idx < NTOK * 4; idx += gthreads) {
        const int h = idx / NTOK, row = idx % NTOK, b = row / SEQ, tpos = row % SEQ, rowb = b * SEQ;
        float q[DQK], o[64];
#pragma unroll
        for (int d = 0; d < DQK; ++d) q[d] = bf2f(T.Q[(size_t)row * T.ldq + h * T.qhs + d]) * sc;
#pragma unroll
        for (int d = 0; d < 64; ++d) o[d] = 0.f;
        float m = -INFINITY, l = 0.f;
        const int ck = tpos / 64;
        const int k_lo = (MODE == MODE_BAND) ? ((ck - 8) > 0 ? (ck - 8) * 64 : 0) : 0;
        const int k_hi = (MODE == MODE_FOX) ? tpos : (ck * 64 + 63);
        const float cq = (MODE == MODE_FOX) ? T.cdec[(size_t)row * 4 + h] : 0.f;
        for (int kv = k_lo; kv <= k_hi; ++kv) {
            const size_t kr = (size_t)(rowb + kv);
            float s = 0.f;
#pragma unroll
            for (int d8 = 0; d8 < 8; ++d8) { const u32x4 w = *(const u32x4*)(T.K + kr * T.ldk + h * T.khs + d8 * 8);
                s += q[d8 * 8 + 0] * bflo(w.x) + q[d8 * 8 + 1] * bfhi(w.x) + q[d8 * 8 + 2] * bflo(w.y) + q[d8 * 8 + 3] * bfhi(w.y)
                   + q[d8 * 8 + 4] * bflo(w.z) + q[d8 * 8 + 5] * bfhi(w.z) + q[d8 * 8 + 6] * bflo(w.w) + q[d8 * 8 + 7] * bfhi(w.w); }
            if (MODE == MODE_MLA) {
#pragma unroll
                for (int d8 = 0; d8 < 4; ++d8) { const u32x4 w = *(const u32x4*)(T.K2 + kr * 32 + d8 * 8);
                    s += q[64 + d8 * 8 + 0] * bflo(w.x) + q[64 + d8 * 8 + 1] * bfhi(w.x) + q[64 + d8 * 8 + 2] * bflo(w.y) + q[64 + d8 * 8 + 3] * bfhi(w.y)
                       + q[64 + d8 * 8 + 4] * bflo(w.z) + q[64 + d8 * 8 + 5] * bfhi(w.z) + q[64 + d8 * 8 + 6] * bflo(w.w) + q[64 + d8 * 8 + 7] * bfhi(w.w); }
            }
            if (MODE == MODE_FOX) s += cq - T.cdec[kr * 4 + h];
            if (MODE == MODE_BAND) { int rel = tpos - kv; rel = rel < -256 ? -256 : (rel > 256 ? 256 : rel); s += T.relb[h * 513 + rel + 256]; }
            const float mn = fmaxf(m, s), al = __expf(m - mn), pp = __expf(s - mn);
            l = l * al + pp; m = mn;
#pragma unroll
            for (int d8 = 0; d8 < 8; ++d8) { const u32x4 w = *(const u32x4*)(T.V + kr * T.ldv + h * T.vhs + d8 * 8);
                o[d8 * 8 + 0] = o[d8 * 8 + 0] * al + pp * bflo(w.x); o[d8 * 8 + 1] = o[d8 * 8 + 1] * al + pp * bfhi(w.x);
                o[d8 * 8 + 2] = o[d8 * 8 + 2] * al + pp * bflo(w.y); o[d8 * 8 + 3] = o[d8 * 8 + 3] * al + pp * bfhi(w.y);
                o[d8 * 8 + 4] = o[d8 * 8 + 4] * al + pp * bflo(w.z); o[d8 * 8 + 5] = o[d8 * 8 + 5] * al + pp * bfhi(w.z);
                o[d8 * 8 + 6] = o[d8 * 8 + 6] * al + pp * bflo(w.w); o[d8 * 8 + 7] = o[d8 * 8 + 7] * al + pp * bfhi(w.w); }
        }
        const float inv = 1.0f / l;
#pragma unroll
        for (int d = 0; d < 64; d += 2) *(unsigned*)(T.O + (size_t)row * T.ldo + h * T.ohs + d) = pk2(o[d] * inv, o[d + 1] * inv);
    }
}
}
struct Params {
    const float* in[37];
    float* out;
    unsigned char* ws;
    int ph_lo, ph_hi;
};
enum { I_X = 0, I_P, I_POS, I_WIN, I_SAR, I_SAI, I_SLDT, I_SBR, I_SBI, I_SCR, I_SCI, I_SD, I_SGLU, I_FBF, I_GQ, I_WUQ, I_GKV, I_WUKV, I_RELB, I_WB, I_WG, I_BG, I_WO,
       I_GMIX, I_GFFN, I_FW1, I_FW3, I_FW2, I_MWR, I_MBR, I_MW1, I_MW3, I_MW2, I_GPLE, I_PWG, I_PWU, I_GFIN };

__device__ __forceinline__ void sincos_rad(double a, float& s, float& c) {
    double r = a * 0.15915494309189535; r = r - __builtin_rint(r); const float f = (float)r;
    s = __builtin_amdgcn_sinf(f); c = __builtin_amdgcn_cosf(f);
}
__device__ __forceinline__ float gelu_tanh(float x) {
    const float z = 0.7978845608028654f * (x + 0.044715f * x * x * x);
    const float e = __expf(2.0f * z); const float th = 1.0f - 2.0f / (1.0f + e);
    return 0.5f * x * (1.0f + th);
}
__device__ __forceinline__ float log_sigmoid(float z) { return fminf(z, 0.f) - log1pf(__expf(-fabsf(z))); }

struct CvtJob { const float* src; const float* ks; bf16* dst; int K, ldsrc, col0, ncols, row0, ldk, ilv; };
struct CvtRegs { f32x4 v[16]; };
__device__ __forceinline__ void cvt_load(const CvtJob& J, int item, int lane, CvtRegs& R) {
    const int nblk = (J.ncols + 63) >> 6, kb = item / nblk, nb = item % nblk, k0 = 64 * kb, n0 = 64 * nb;
    const int n4 = (lane & 15) * 4; const bool inb = (n0 + n4) < J.ncols;
#pragma unroll
    for (int i = 0; i < 16; ++i) { const int kk = 4 * i + (lane >> 4); f32x4 v = {0.f, 0.f, 0.f, 0.f};
        if (inb) v = *(const f32x4*)(J.src + (size_t)(k0 + kk) * J.ldsrc + J.col0 + n0 + n4);
        if (J.ks) v = v * J.ks[k0 + kk];
        R.v[i] = v; }
}
__device__ __forceinline__ void cvt_finish(const CvtJob& J, LAS float* scr, int item, int lane, const CvtRegs& R) {
    const int nblk = (J.ncols + 63) >> 6, kb = item / nblk, nb = item % nblk, k0 = 64 * kb, n0 = 64 * nb;
    const int n4 = (lane & 15) * 4;
#pragma unroll
    for (int i = 0; i < 16; ++i) { const int kk = 4 * i + (lane >> 4); *(LAS f32x4*)(scr + kk * 68 + n4) = R.v[i]; }
    LDS_WAIT(); asm volatile("" ::: "memory");
    const int c = lane & 7;
#pragma unroll
    for (int j = 0; j < 8; ++j) { const int n = (lane >> 3) + 8 * j; const LAS float* s = scr + (8 * c) * 68 + n;
        u32x4 o; o.x = pk2(s[0 * 68], s[1 * 68]); o.y = pk2(s[2 * 68], s[3 * 68]); o.z = pk2(s[4 * 68], s[5 * 68]); o.w = pk2(s[6 * 68], s[7 * 68]);
        const int nn = n0 + n; const int row = J.row0 + (J.ilv ? ((nn >> 7) * 256 + (nn & 127)) : nn);
        if (nn < J.ncols) *(u32x4*)(J.dst + (size_t)row * J.ldk + k0 + 8 * c) = o; }
    LDS_WAIT(); asm volatile("" ::: "memory");
}
__device__ __forceinline__ bf16* wmix(const Params& P, int L, size_t off) { return (bf16*)(P.ws + WS_WMIX + (size_t)L * WMIX_STRIDE + off); }
__device__ __forceinline__ CvtJob get_job(const Params& P, int j) {
    CvtJob J; J.ks = nullptr; J.ilv = 0; J.col0 = 0; J.row0 = 0;
    if (j < 40) {
        const int L = j / 20, q = j % 20;
        if (q < 5) {
            J.src = P.in[I_WIN] + (size_t)L * D * DIN; J.K = D; J.ldsrc = DIN; J.dst = wmix(P, L, WM_IN); J.ldk = D;
            J.col0 = q == 0 ? 0 : q == 1 ? 1380 : q == 2 ? 1028 : q == 3 ? 1220 : 1348;
            J.ncols = q == 0 ? 1024 : q == 1 ? 768 : q == 2 ? 192 : q == 3 ? 128 : 32;
            J.row0 = q == 0 ? 0 : q == 1 ? 1024 : q == 2 ? 1792 : q == 3 ? 2048 : 2176;
        } else if (q < 9) { const int k = q - 5; J.src = P.in[I_WG] + ((size_t)L * 4 + k) * D * D; J.K = D; J.ldsrc = D; J.ncols = D; J.row0 = k * D; J.dst = wmix(P, L, WM_G); J.ldk = D;
        } else if (q < 13) { const int k = q - 9; J.src = P.in[I_WB] + ((size_t)L * 4 + k) * 256 * D; J.K = 256; J.ldsrc = D; J.ncols = D; J.row0 = k * D; J.dst = wmix(P, L, WM_B); J.ldk = 256;
        } else if (q == 13) { J.src = P.in[I_WO] + (size_t)L * D * D; J.K = D; J.ldsrc = D; J.ncols = D; J.dst = wmix(P, L, WM_O); J.ldk = D;
        } else if (q == 14) { J.src = P.in[I_PWG] + (size_t)L * D * D; J.K = D; J.ldsrc = D; J.ncols = D; J.dst = wmix(P, L, WM_PG); J.ldk = D;
        } else if (q == 15) { J.src = P.in[I_PWU] + (size_t)L * 256 * D; J.K = 256; J.ldsrc = D; J.ncols = D; J.dst = wmix(P, L, WM_UP); J.ldk = 256;
        } else if (q == 16) { J.src = P.in[I_WUQ] + (size_t)L * 192 * 384; J.ks = P.in[I_GQ] + L * 192; J.K = 192; J.ldsrc = 384; J.ncols = 384; J.dst = wmix(P, L, WM_UQ); J.ldk = 256;
        } else if (q == 17) { J.src = P.in[I_WUKV] + (size_t)L * 128 * 512; J.ks = P.in[I_GKV] + L * 128; J.K = 128; J.ldsrc = 512; J.ncols = 512; J.dst = wmix(P, L, WM_UKV); J.ldk = 128;
        } else if (q == 18) { J.src = P.in[I_SGLU] + (size_t)L * 256 * 256; J.K = 256; J.ldsrc = 256; J.ncols = 256; J.dst = wmix(P, L, WM_GLU); J.ldk = 256;
        } else { J.src = nullptr; J.K = 0; J.ldsrc = 0; J.ncols = 32; J.dst = nullptr; J.ldk = 0; }
    } else if (j < 43) {
        const int q = j - 40;
        if (q == 0) { J.src = P.in[I_FW1]; J.K = D; J.ldsrc = DFF; J.ncols = DFF; J.dst = (bf16*)(P.ws + WS_W13); J.ldk = D; J.ilv = 1; }
        else if (q == 1) { J.src = P.in[I_FW3]; J.K = D; J.ldsrc = DFF; J.ncols = DFF; J.row0 = 128; J.dst = (bf16*)(P.ws + WS_W13); J.ldk = D; J.ilv = 1; }
        else { J.src = P.in[I_FW2]; J.K = DFF; J.ldsrc = D; J.ncols = D; J.dst = (bf16*)(P.ws + WS_W2); J.ldk = DFF; }
    } else {
        const int e = (j - 43) / 3, q = (j - 43) % 3;
        if (q == 0) { J.src = P.in[I_MW1] + (size_t)e * D * DFFE; J.K = D; J.ldsrc = DFFE; J.ncols = DFFE; J.row0 = e * 2816; J.dst = (bf16*)(P.ws + WS_WM13); J.ldk = D; J.ilv = 1; }
        else if (q == 1) { J.src = P.in[I_MW3] + (size_t)e * D * DFFE; J.K = D; J.ldsrc = DFFE; J.ncols = DFFE; J.row0 = e * 2816 + 128; J.dst = (bf16*)(P.ws + WS_WM13); J.ldk = D; J.ilv = 1; }
        else { J.src = P.in[I_MW2] + (size_t)e * DFFE * D; J.K = DFFE; J.ldsrc = D; J.ncols = D; J.row0 = e * D; J.dst = (bf16*)(P.ws + WS_WM2); J.ldk = DFFE; }
    }
    return J;
}
__device__ __forceinline__ void cvt_jobs(const Params& P, int j_lo, int j_hi, LAS unsigned char* lds) {
    BODY_IDS();
    LAS float* scr = (LAS float*)(lds + wave * 17408);
    int acc = 0; bool have = false; CvtJob Jp; int itp = 0; CvtRegs Rp;
    for (int j = j_lo; j < j_hi; ++j) {
        const CvtJob J = get_job(P, j);
        const int items = (J.K / 64) * ((J.ncols + 63) >> 6);
        const int first = (gw - (acc % ngw) + ngw) % ngw;
        for (int it = first; it < items; it += ngw) {
            CvtRegs Rn; cvt_load(J, it, lane, Rn);
            if (have) cvt_finish(Jp, scr, itp, lane, Rp);
            Jp = J; itp = it; have = true;
#pragma unroll
            for (int i = 0; i < 16; ++i) Rp.v[i] = Rn.v[i];
        }
        acc += items;
    }
    if (have) cvt_finish(Jp, scr, itp, lane, Rp);
}

__device__ __forceinline__ void p0_misc(const Params& P) {
    BODY_IDS();
    { const f32x4* src = (const f32x4*)P.in[I_P]; u32x2* dst = (u32x2*)(P.ws + WS_PBF);
      for (int i = gtid; i < 2 * NTOK * 256 / 4; i += gthreads) { const f32x4 v = src[i]; u32x2 w; w.x = pk2(v[0], v[1]); w.y = pk2(v[2], v[3]); dst[i] = w; } }
    { const int* pos = (const int*)P.in[I_POS]; float* ct = (float*)(P.ws + WS_COS); float* st = (float*)(P.ws + WS_SIN);
      const double invf[16] = {1.0, 0.5623413251903491, 0.31622776601683794, 0.1778279410038923, 0.1, 0.05623413251903491, 0.03162277660168379, 0.01778279410038923,
                               0.01, 0.005623413251903491, 0.0031622776601683794, 0.0017782794100389228, 0.001, 0.0005623413251903491, 0.00031622776601683794, 0.00017782794100389227};
      for (int i = gtid; i < NTOK * 16; i += gthreads) { const int row = i >> 4, f = i & 15; double iv = invf[0];
#pragma unroll
          for (int q = 1; q < 16; ++q) iv = (f == q) ? invf[q] : iv;
          const float ang = (float)pos[row] * (float)iv; float s, c; sincos_rad((double)ang, s, c); ct[i] = c; st[i] = s; } }
    for (int L = 0; L < 2; ++L) {
        bf16* win = wmix(P, L, WM_IN);
        for (int i = gtid; i < (64 + 96) * D / 8; i += gthreads) { const int e = i * 8, r = e / D, k = e % D; const int row = r < 64 ? 1984 + r : 2208 + (r - 64); *(u32x4*)(win + (size_t)row * D + k) = (u32x4){0u, 0u, 0u, 0u}; }
        bf16* wuq = wmix(P, L, WM_UQ);
        for (int i = gtid; i < 512 * 256 / 8; i += gthreads) { const int e = i * 8, r = e / 256, k = e % 256; if (r >= 384 || k >= 192) *(u32x4*)(wuq + e) = (u32x4){0u, 0u, 0u, 0u}; }
    }
}

__device__ __forceinline__ void rms_load(const XSrc& x, int row, int lane, f32x4 (&v)[4]) {
#pragma unroll
    for (int j = 0; j < 4; ++j) v[j] = ldx4(x, (size_t)row * D + 4 * lane + 256 * j);
}
struct GainRegs { f32x4 g[4]; };
__device__ __forceinline__ GainRegs load_gain(const float* gain, int lane) { GainRegs G; const f32x4* gr = (const f32x4*)gain + lane;
#pragma unroll
    for (int j = 0; j < 4; ++j) G.g[j] = gr[64 * j];
    return G; }
__device__ __forceinline__ void rms_finish(const GainRegs& G, bf16* orow, int lane, f32x4 (&v)[4]) {
    float s = 0.f;
#pragma unroll
    for (int j = 0; j < 4; ++j) s += (v[j][0] * v[j][0] + v[j][1] * v[j][1]) + (v[j][2] * v[j][2] + v[j][3] * v[j][3]);
    const float rstd = __builtin_amdgcn_rsqf(wave_sum(s) * (1.0f / D) + RMS_EPS);
    u32x2* o8 = (u32x2*)orow + lane;
#pragma unroll
    for (int j = 0; j < 4; ++j) { v[j] = v[j] * rstd * G.g[j]; if (orow) { u32x2 w; w.x = pk2(v[j][0], v[j][1]); w.y = pk2(v[j][2], v[j][3]); o8[64 * j] = w; } }
}
#define RMS_ROWS_BEGIN(x_, rowexpr_) f32x4 v[4], vn_[4]; { const int i = 0; rms_load(x_, (rowexpr_), lane, v); } for (int i = 0; i < 16; ++i) { if (i + 1 < 16) { const int i_ = i; { const int i = i_ + 1; rms_load(x_, (rowexpr_), lane, vn_); } }
#define RMS_ROWS_END() _Pragma("unroll") for (int j_ = 0; j_ < 4; ++j_) v[j_] = vn_[j_]; }
__device__ __forceinline__ void norm_plain(const XSrc x, const float* gain, bf16* H, int first, int stride) {
    BODY_IDS();
    const GainRegs GR = load_gain(gain, lane);
    for (int u = first; u < NTOK / 128; u += stride)
    { RMS_ROWS_BEGIN(x, u * 128 + wave * 16 + i) const int row = u * 128 + wave * 16 + i; rms_finish(GR, H + (size_t)row * D, lane, v); RMS_ROWS_END() }
}
__device__ __forceinline__ void norm1_phase(const Params& P, int L, const XSrc x, int first, int stride) {
    BODY_IDS();
    const float* win = P.in[I_WIN] + (size_t)L * D * DIN;
    f32x4 wff[4][4];
#pragma unroll
    for (int j = 0; j < 4; ++j)
#pragma unroll
        for (int e = 0; e < 4; ++e) wff[j][e] = *(const f32x4*)(win + (size_t)(4 * lane + 256 * j + e) * DIN + 1024);
    const float* gain = P.in[I_GMIX] + L * D; bf16* H = (bf16*)(P.ws + WS_H); const GainRegs GR = load_gain(gain, lane);
    float* logf = (float*)(P.ws + WS_LOGF); float* wsum = (float*)(P.ws + WS_WSUM);
    const f32x4 bf = *(const f32x4*)(P.in[I_FBF] + L * 4);
    for (int u = first; u < NTOK / 128; u += stride) { const int g0 = u * 8 + wave;
        f32x4 run = {0.f, 0.f, 0.f, 0.f};
        RMS_ROWS_BEGIN(x, g0 * 16 + i) const int row = g0 * 16 + i; rms_finish(GR, H + (size_t)row * D, lane, v);
            f32x4 d = {0.f, 0.f, 0.f, 0.f};
#pragma unroll
            for (int j = 0; j < 4; ++j)
#pragma unroll
                for (int e = 0; e < 4; ++e) d += wff[j][e] * v[j][e];
#pragma unroll
            for (int e = 0; e < 4; ++e) { d[e] = wave_sum(d[e]); run[e] += log_sigmoid(d[e] + bf[e]); }
            if (lane == 0) *(f32x4*)(logf + (size_t)row * 4) = run; RMS_ROWS_END()
        if (lane == 0) *(f32x4*)(wsum + (size_t)g0 * 4) = run;
    }
    __syncthreads();
}
__device__ __forceinline__ void prep_phase(const Params& P, int L) {
    BODY_IDS();
    unsigned* qmaxw = (unsigned*)(P.ws + WS_CTL) + CW_QMAX + L * 512; unsigned* kmaxw = (unsigned*)(P.ws + WS_CTL) + CW_KMAX + L * 16;
    const float* logf = (const float*)(P.ws + WS_LOGF); const float* wsum = (const float*)(P.ws + WS_WSUM); float* cdec = (float*)(P.ws + WS_CDEC);
    float* rq = (float*)(P.ws + WS_RSTDQ); float* rkv = (float*)(P.ws + WS_RSTDKV); const bf16* zin = (const bf16*)(P.ws + WS_ZIN); bf16* kper = (bf16*)(P.ws + WS_KPER);
    const float* ct = (const float*)(P.ws + WS_COS); const float* st = (const float*)(P.ws + WS_SIN);
    for (int g0 = gw; g0 < NTOK / 16; g0 += ngw) {
        const int first = (g0 / 512) * 512;
        f32x4 pre = {0.f, 0.f, 0.f, 0.f};
        for (int i = first + lane; i < g0; i += 64) pre += *(const f32x4*)(wsum + (size_t)i * 4);
#pragma unroll
        for (int e = 0; e < 4; ++e) pre[e] = wave_sum(pre[e]);
        if (lane < 16) { const int row = g0 * 16 + lane; *(f32x4*)(cdec + (size_t)row * 4) = *(const f32x4*)(logf + (size_t)row * 4) + pre; }
        float qk2m = 0.f;
        const int colA = (lane < 32 ? ZC_FQ : ZC_FK) + 8 * (lane & 31), colB = ZC_CQ + 8 * (lane < 52 ? lane : 51);
        u32x4 wa = *(const u32x4*)(zin + (size_t)(g0 * 16) * ZP + colA), wb = *(const u32x4*)(zin + (size_t)(g0 * 16) * ZP + colB);
        for (int i = 0; i < 16; ++i) { const int row = g0 * 16 + i;
            const u32x4 ca = wa, cb = wb;
            if (i + 1 < 16) { wa = *(const u32x4*)(zin + (size_t)(row + 1) * ZP + colA); wb = *(const u32x4*)(zin + (size_t)(row + 1) * ZP + colB); }
            const f32x4 cs = *(const f32x4*)(ct + (size_t)row * 16 + 8 * (lane & 1)), cs2 = *(const f32x4*)(ct + (size_t)row * 16 + 8 * (lane & 1) + 4);
            const f32x4 sn = *(const f32x4*)(st + (size_t)row * 16 + 8 * (lane & 1)), sn2 = *(const f32x4*)(st + (size_t)row * 16 + 8 * (lane & 1) + 4);
            { float sa = (bflo(ca.x) * bflo(ca.x) + bfhi(ca.x) * bfhi(ca.x)) + (bflo(ca.y) * bflo(ca.y) + bfhi(ca.y) * bfhi(ca.y)) + (bflo(ca.z) * bflo(ca.z) + bfhi(ca.z) * bfhi(ca.z)) + (bflo(ca.w) * bflo(ca.w) + bfhi(ca.w) * bfhi(ca.w));
              sa += DPP_F(sa, 0xB1, 0xF); sa += DPP_F(sa, 0x4E, 0xF); sa += DPP_F(sa, 0x141, 0xF);
              qk2m = fmaxf(qk2m, sa); }
            const float own[8] = {bflo(cb.x), bfhi(cb.x), bflo(cb.y), bfhi(cb.y), bflo(cb.z), bfhi(cb.z), bflo(cb.w), bfhi(cb.w)};
            float ssb = 0.f;
#pragma unroll
            for (int e = 0; e < 8; ++e) ssb += own[e] * own[e];
            const float sq = wave_sum(lane < 24 ? ssb : 0.f), skv = wave_sum((lane >= 32 && lane < 48) ? ssb : 0.f);
            if (lane == 0) { rq[row] = __builtin_amdgcn_rsqf(sq * (1.0f / 192.0f) + RMS_EPS); rkv[row] = __builtin_amdgcn_rsqf(skv * (1.0f / 128.0f) + RMS_EPS); }
            float oth[8];
#pragma unroll
            for (int e = 0; e < 8; ++e) oth[e] = DPP_F(own[e], 0x4E, 0xF);
            if (lane >= 48 && lane < 52) { const bool lo = lane < 50; float o8[8];
#pragma unroll
                for (int e = 0; e < 8; ++e) { const float c = e < 4 ? cs[e] : cs2[e - 4], sv = e < 4 ? sn[e] : sn2[e - 4];
                    o8[e] = lo ? (own[e] * c - oth[e] * sv) : (own[e] * c + oth[e] * sv); }
                *(u32x4*)(kper + (size_t)row * 32 + (lo ? 0 : 16) + 8 * (lane & 1)) = (u32x4){pk2(o8[0], o8[1]), pk2(o8[2], o8[3]), pk2(o8[4], o8[5]), pk2(o8[6], o8[7])}; } }
        if ((lane & 7) == 0) { const int row0 = g0 * 16, b = row0 / SEQ, qb = (row0 % SEQ) / 256, h = (lane & 31) >> 3;
            if (lane < 32) atomicMax(qmaxw + (b * 4 + h) * 32 + qb, __float_as_uint(qk2m)); else atomicMax(kmaxw + b * 4 + h, __float_as_uint(qk2m)); }
    }
}
struct FinalRows { u32x2 w[16][4]; };
__device__ __forceinline__ void final_norm_load(const Params& P, int u, FinalRows& R) {
    BODY_IDS();
    const bf16* xb = xr_of(P.out);
#pragma unroll
    for (int i = 0; i < 16; ++i) { const u32x2* xr = (const u32x2*)(xb + (size_t)(u * 128 + wave * 16 + i) * D) + lane;
#pragma unroll
        for (int j = 0; j < 4; ++j) R.w[i][j] = xr[64 * j]; }
}
__device__ __forceinline__ void final_norm_store(const Params& P, int u, const FinalRows& R) {
    BODY_IDS();
    const GainRegs GR = load_gain(P.in[I_GFIN], lane);
#pragma unroll
    for (int i = 0; i < 16; ++i) { f32x4 v[4]; float s = 0.f;
#pragma unroll
        for (int j = 0; j < 4; ++j) { const u32x2 w = R.w[i][j]; v[j] = (f32x4){bflo(w.x), bfhi(w.x), bflo(w.y), bfhi(w.y)}; s += (v[j][0] * v[j][0] + v[j][1] * v[j][1]) + (v[j][2] * v[j][2] + v[j][3] * v[j][3]); }
        const float rstd = __builtin_amdgcn_rsqf(wave_sum(s) * (1.0f / D) + RMS_EPS);
        f32x4* xo = (f32x4*)(P.out + (size_t)(u * 128 + wave * 16 + i) * D) + lane;
#pragma unroll
        for (int j = 0; j < 4; ++j) xo[64 * j] = v[j] * rstd * GR.g[j]; }
}
namespace s5 {
struct Coef { float abr, abi; f32x2 B2[16]; float a64r, a64i; };
__device__ __forceinline__ void coef(const Params& P, int L, int g, int p, Coef& C) {
    const float dt = __expf(P.in[I_SLDT][L * 16 + g]); const float ar = P.in[I_SAR][(L * 16 + g) * 64 + p], ai = P.in[I_SAI][(L * 16 + g) * 64 + p];
    const float mag = __expf(ar * dt); float sn, cs; sincos_rad((double)(ai * dt), sn, cs);
    C.abr = mag * cs; C.abi = mag * sn;
    const float den = ar * ar + ai * ai, nr = C.abr - 1.0f, ni = C.abi;
    const float cr = (nr * ar + ni * ai) / den, ci = (ni * ar - nr * ai) / den;
    const float* br = P.in[I_SBR] + ((size_t)(L * 16 + g) * 64 + p) * 16; const float* bi = P.in[I_SBI] + ((size_t)(L * 16 + g) * 64 + p) * 16;
#pragma unroll
    for (int h = 0; h < 16; ++h) { const float r = br[h], i = bi[h]; C.B2[h] = (f32x2){cr * r - ci * i, cr * i + ci * r}; }
    const float m64 = __expf(64.0f * ar * dt); float s64, c64; sincos_rad(64.0 * (double)(ai * dt), s64, c64);
    C.a64r = m64 * c64; C.a64i = m64 * s64;
}
constexpr int WAVE_LDS = 8448;
template <bool EMIT>
__device__ __forceinline__ void chunk(const Params& P, int L, int g, int row0, const Coef& C, float& xr, float& xi, LAS unsigned char* wl, int lane, const bf16x8 (&cf)[4], float dsk) {
    bf16* zin = (bf16*)(P.ws + WS_ZIN);
    LAS float* ut = (LAS float*)wl; LAS unsigned* xt = (LAS unsigned*)(wl + 4096);
    { const u32x4* up = (const u32x4*)(zin + (size_t)(row0 + lane) * ZP + ZC_U + g * 16); const u32x4 w0 = up[0], w1 = up[1];
      LAS f32x4* d = (LAS f32x4*)(ut + lane * 16);
      d[0] = (f32x4){bflo(w0.x), bfhi(w0.x), bflo(w0.y), bfhi(w0.y)}; d[1] = (f32x4){bflo(w0.z), bfhi(w0.z), bflo(w0.w), bfhi(w0.w)};
      d[2] = (f32x4){bflo(w1.x), bfhi(w1.x), bflo(w1.y), bfhi(w1.y)}; d[3] = (f32x4){bflo(w1.z), bfhi(w1.z), bflo(w1.w), bfhi(w1.w)}; }
    for (int tb = 0; tb < 4; ++tb) {
#pragma unroll 4
        for (int ti = 0; ti < 16; ++ti) {
            const LAS f32x4* up = (const LAS f32x4*)(ut + (tb * 16 + ti) * 16);
            f32x2 b2a = {0.f, 0.f}, b2b = {0.f, 0.f};
#pragma unroll
            for (int q = 0; q < 4; ++q) { const f32x4 u4 = up[q];
                b2a += C.B2[4 * q + 0] * (f32x2){u4[0], u4[0]}; b2b += C.B2[4 * q + 1] * (f32x2){u4[1], u4[1]};
                b2a += C.B2[4 * q + 2] * (f32x2){u4[2], u4[2]}; b2b += C.B2[4 * q + 3] * (f32x2){u4[3], u4[3]}; }
            const float br = b2a[0] + b2b[0], bi = b2a[1] + b2b[1];
            const float nr = C.abr * xr - C.abi * xi + br, ni = C.abr * xi + C.abi * xr + bi; xr = nr; xi = ni;
            if (EMIT) xt[ti * 68 + lane] = pk2(xr, xi);
        }
        if (EMIT) {
            f32x4 dacc = {0.f, 0.f, 0.f, 0.f};
#pragma unroll
            for (int ks = 0; ks < 4; ++ks) { const bf16x8 a = *(const LAS bf16x8*)((const LAS unsigned char*)xt + (lane & 15) * 272 + (ks * 32 + (lane >> 4) * 8) * 2);
                dacc = __builtin_amdgcn_mfma_f32_16x16x32_bf16(a, cf[ks], dacc, 0, 0, 0); }
            const int hp = lane & 15;
#pragma unroll
            for (int i = 0; i < 4; ++i) { const int tok = tb * 16 + 4 * (lane >> 4) + i; const float y = dacc[i] + dsk * ut[tok * 16 + hp];
                zin[(size_t)(row0 + tok) * ZP + ZC_U + g * 16 + hp] = (bf16)f2bf(gelu_tanh(y)); }
        }
    }
}
template <int PASS>
__device__ __forceinline__ void phase(const Params& P, int L, LAS unsigned char* lds) {
    BODY_IDS();
    LAS unsigned char* wl = lds + wave * WAVE_LDS;
    f32x2* SC = (f32x2*)(P.ws + WS_SC);
    for (int w = gw; w < 2048; w += ngw) {
        const int bg = w >> 5, cg = w & 31, b = bg >> 4, g = bg & 15;
        Coef C; coef(P, L, g, lane, C);
        bf16x8 cf[4]; float dsk = 0.f;
        if (PASS == 1) {
            const int hp = lane & 15, kg = lane >> 4;
            const float* cre = P.in[I_SCR] + ((size_t)(L * 16 + g) * 16 + hp) * 64; const float* cim = P.in[I_SCI] + ((size_t)(L * 16 + g) * 16 + hp) * 64;
#pragma unroll
            for (int ks = 0; ks < 4; ++ks) { const int p0 = 16 * ks + 4 * kg; u32x4 wv;
                wv.x = pk2(cre[p0], -cim[p0]); wv.y = pk2(cre[p0 + 1], -cim[p0 + 1]); wv.z = pk2(cre[p0 + 2], -cim[p0 + 2]); wv.w = pk2(cre[p0 + 3], -cim[p0 + 3]);
                cf[ks] = __builtin_bit_cast(bf16x8, wv); }
            dsk = P.in[I_SD][(L * 16 + g) * 16 + hp];
        } else {
#pragma unroll
            for (int ks = 0; ks < 4; ++ks) cf[ks] = (bf16x8){0, 0, 0, 0, 0, 0, 0, 0};
        }
        float xr = 0.f, xi = 0.f;
        if (PASS == 1) {
            const f32x2* sp = SC + ((size_t)bg * 128) * 64 + lane;
            for (int c = 0; c < 4 * cg; c += 4) { f32x2 sv[4];
#pragma unroll
                for (int q = 0; q < 4; ++q) sv[q] = sp[(size_t)(c + q) * 64];
#pragma unroll
                for (int q = 0; q < 4; ++q) { const float nr = C.a64r * xr - C.a64i * xi + sv[q][0], ni = C.a64r * xi + C.a64i * xr + sv[q][1]; xr = nr; xi = ni; } }
        }
        for (int cc = 0; cc < 4; ++cc) {
            const int c = 4 * cg + cc, row0 = b * SEQ + c * 64;
            if (PASS == 0) { xr = 0.f; xi = 0.f; }
            chunk<PASS == 1>(P, L, g, row0, C, xr, xi, wl, lane, cf, dsk);
            if (PASS == 0) SC[((size_t)bg * 128 + c) * 64 + lane] = (f32x2){xr, xi};
        }
    }
}
#define LDS_XLANE() asm volatile("" ::: "memory")
constexpr int WAVE_LDS1 = 4352;
__device__ __forceinline__ void phase1(const Params& P, int L, LAS unsigned char* lds) {
    BODY_IDS();
    LAS unsigned char* wl = lds + wave * WAVE_LDS1;
    LAS unsigned* bu = (LAS unsigned*)wl; LAS unsigned* xt = bu;
    bf16* zin = (bf16*)(P.ws + WS_ZIN);
    const f32x2* SC = (const f32x2*)(P.ws + WS_SC);
    const int m = lane & 15, kq = lane >> 4;
    for (int w = gw; w < 2048; w += ngw) {
        const int bg = w >> 5, cg = w & 31, b = bg >> 4, g = bg & 15;
        const bf16* ub = zin + (size_t)(b * SEQ + cg * 256 + m) * ZP + ZC_U + g * 16 + 8 * (kq & 1);
        u32x4 ua[4];
#pragma unroll
        for (int q = 0; q < 4; ++q) ua[q] = *(const u32x4*)(ub + (size_t)q * 16 * ZP);
        const f32x2* sp = SC + ((size_t)bg * 128) * 64 + lane;
        f32x2 pq[4][4];
        if (cg > 0) {
#pragma unroll
            for (int j = 0; j < 4; ++j) { const int bc = j < cg ? j : cg - 1;
#pragma unroll
                for (int t = 0; t < 4; ++t) pq[j][t] = sp[(size_t)(4 * bc + t) * 64]; }
        }
        float abr, abi, a64r, a64i; bf16x8 bfr[8];
        { Coef C; coef(P, L, g, lane, C); abr = C.abr; abi = C.abi; a64r = C.a64r; a64i = C.a64i;
          LAS unsigned* tab = (LAS unsigned*)wl;
#pragma unroll
          for (int h2 = 0; h2 < 8; ++h2) { tab[lane * 8 + h2] = pk2(C.B2[2 * h2][0], C.B2[2 * h2 + 1][0]); tab[(64 + lane) * 8 + h2] = pk2(C.B2[2 * h2][1], C.B2[2 * h2 + 1][1]); }
          LDS_XLANE();
#pragma unroll
          for (int nt = 0; nt < 8; ++nt) { const u32x4 v = *(const LAS u32x4*)(wl + (16 * nt + m) * 32 + 16 * (kq & 1)); bfr[nt] = __builtin_bit_cast(bf16x8, kq < 2 ? v : (u32x4){0u, 0u, 0u, 0u}); }
          LDS_XLANE(); }
        bf16x8 cf[4]; float dskf;
        { const float* cre = P.in[I_SCR] + ((size_t)(L * 16 + g) * 16 + m) * 64; const float* cim = P.in[I_SCI] + ((size_t)(L * 16 + g) * 16 + m) * 64;
#pragma unroll
          for (int ks = 0; ks < 4; ++ks) { const int p0 = 16 * ks + 4 * kq; u32x4 wv;
              wv.x = pk2(cre[p0], -cim[p0]); wv.y = pk2(cre[p0 + 1], -cim[p0 + 1]); wv.z = pk2(cre[p0 + 2], -cim[p0 + 2]); wv.w = pk2(cre[p0 + 3], -cim[p0 + 3]);
              cf[ks] = __builtin_bit_cast(bf16x8, wv); }
          dskf = P.in[I_SD][(L * 16 + g) * 16 + m]; }
        float xr = 0.f, xi = 0.f;
        for (int k = 0; k < cg; k += 4) {
#pragma unroll
            for (int j = 0; j < 4; ++j) {
                if (k + j < cg) {
#pragma unroll
                    for (int t = 0; t < 4; ++t) { const float nr = a64r * xr - a64i * xi + pq[j][t][0], ni = a64r * xi + a64i * xr + pq[j][t][1]; xr = nr; xi = ni; } }
                const int bn = k + j + 4, bc = bn < cg ? bn : cg - 1;
#pragma unroll
                for (int t = 0; t < 4; ++t) pq[j][t] = sp[(size_t)(4 * bc + t) * 64];
            }
        }
#pragma nounroll
        for (int cc = 0; cc < 4; ++cc) {
            const int row0 = b * SEQ + (4 * cg + cc) * 64;
            u32x4 un[4];
            if (cc < 3) {
#pragma unroll
                for (int q = 0; q < 4; ++q) un[q] = *(const u32x4*)(ub + (size_t)((cc + 1) * 4 + q) * 16 * ZP);
            } else {
#pragma unroll
                for (int q = 0; q < 4; ++q) un[q] = ua[q];
            }
#pragma unroll
            for (int tb = 0; tb < 4; ++tb) {
                const bf16x8 a = __builtin_bit_cast(bf16x8, ua[tb]);
                f32x4 dd[8];
#pragma unroll
                for (int nt = 0; nt < 8; ++nt) dd[nt] = __builtin_amdgcn_mfma_f32_16x16x32_bf16(a, bfr[nt], (f32x4){0.f, 0.f, 0.f, 0.f}, 0, 0, 0);
                unsigned short uraw[4];
#pragma unroll
                for (int i = 0; i < 4; ++i) uraw[i] = *(const unsigned short*)(zin + (size_t)(row0 + tb * 16 + 4 * kq + i) * ZP + ZC_U + g * 16 + m);
#pragma unroll
                for (int nt = 0; nt < 4; ++nt)
#pragma unroll
                    for (int i = 0; i < 4; ++i) bu[(4 * kq + i) * 68 + 16 * nt + m] = pk2(dd[nt][i], dd[nt + 4][i]);
                LDS_XLANE();
#pragma unroll
                for (int ti = 0; ti < 16; ++ti) {
                    const unsigned bw = bu[ti * 68 + lane]; const float br = bflo(bw), bi = bfhi(bw);
                    const float nr = abr * xr - abi * xi + br, ni = abr * xi + abi * xr + bi; xr = nr; xi = ni;
                    xt[ti * 68 + lane] = pk2(xr, xi);
                }
                LDS_XLANE();
                f32x4 dacc = {0.f, 0.f, 0.f, 0.f};
#pragma unroll
                for (int ks = 0; ks < 4; ++ks) { const bf16x8 a2 = *(const LAS bf16x8*)(wl + m * 272 + (ks * 32 + kq * 8) * 2);
                    dacc = __builtin_amdgcn_mfma_f32_16x16x32_bf16(a2, cf[ks], dacc, 0, 0, 0); }
                LDS_XLANE();
#pragma unroll
                for (int i = 0; i < 4; ++i) { const int tok = tb * 16 + 4 * kq + i; const float y = dacc[i] + dskf * __uint_as_float((unsigned)uraw[i] << 16);
                    zin[(size_t)(row0 + tok) * ZP + ZC_U + g * 16 + m] = (bf16)f2bf(gelu_tanh(y)); }
            }
#pragma unroll
            for (int q = 0; q < 4; ++q) ua[q] = un[q];
        }
    }
}
__device__ __forceinline__ void build_w(const Params& P, int L) {
    BODY_IDS();
    bf16* W = (bf16*)(P.ws + WS_S5W);
    for (int q = gtid; q < 16 * 64 * 64; q += gthreads) {
        const int g = q >> 12, p = (q >> 6) & 63, sidx = q & 63;
        const float dt = __expf(P.in[I_SLDT][L * 16 + g]); const float ar = P.in[I_SAR][(L * 16 + g) * 64 + p], ai = P.in[I_SAI][(L * 16 + g) * 64 + p];
        const float mag = __expf(ar * dt); float sn, cs; sincos_rad((double)(ai * dt), sn, cs);
        const float abr = mag * cs, abi = mag * sn, den = ar * ar + ai * ai, nr = abr - 1.0f, ni = abi;
        const float cr = (nr * ar + ni * ai) / den, ci = (ni * ar - nr * ai) / den;
        const float e = (float)(63 - sidx); const float me = __expf(e * ar * dt); float se, ce; sincos_rad((double)e * (double)(ai * dt), se, ce);
        const float Er = me * ce, Ei = me * se;
        const float* br = P.in[I_SBR] + ((size_t)(L * 16 + g) * 64 + p) * 16; const float* bi = P.in[I_SBI] + ((size_t)(L * 16 + g) * 64 + p) * 16;
        float vr[16], vi[16];
#pragma unroll
        for (int h = 0; h < 16; ++h) { const float bbr = cr * br[h] - ci * bi[h], bbi = cr * bi[h] + ci * br[h]; vr[h] = Er * bbr - Ei * bbi; vi[h] = Er * bbi + Ei * bbr; }
        bf16* w0 = W + ((size_t)g * 128 + 2 * p) * 1024 + sidx * 16;
        *(u32x4*)w0 = (u32x4){pk2(vr[0], vr[1]), pk2(vr[2], vr[3]), pk2(vr[4], vr[5]), pk2(vr[6], vr[7])}; *(u32x4*)(w0 + 8) = (u32x4){pk2(vr[8], vr[9]), pk2(vr[10], vr[11]), pk2(vr[12], vr[13]), pk2(vr[14], vr[15])};
        *(u32x4*)(w0 + 1024) = (u32x4){pk2(vi[0], vi[1]), pk2(vi[2], vi[3]), pk2(vi[4], vi[5]), pk2(vi[6], vi[7])}; *(u32x4*)(w0 + 1024 + 8) = (u32x4){pk2(vi[8], vi[9]), pk2(vi[10], vi[11]), pk2(vi[12], vi[13]), pk2(vi[14], vi[15])};
    }
}
__device__ __forceinline__ void pass0_mfma(const Params& P, LAS unsigned char* lds) {
    BODY_IDS();
    const bf16* zin = (const bf16*)(P.ws + WS_ZIN); const bf16* W = (const bf16*)(P.ws + WS_S5W); float* SC = (float*)(P.ws + WS_SC);
    for (int task = blockIdx.x; task < 256; task += gridDim.x) {
        const int g = task & 15, nq = (task >> 4) & 3, cgp = (task >> 6) * 8 + wave;
        __syncthreads();
#pragma unroll
        for (int i = 0; i < 8; ++i) { const int id = tid + 512 * i, row = id >> 7, c16 = id & 127;
            *(LAS u32x4*)(lds + row * 2064 + c16 * 16) = *(const u32x4*)(W + ((size_t)g * 128 + nq * 32 + row) * 1024 + c16 * 8); }
        __syncthreads();
        const int m = lane & 15, kq = lane >> 4, ci = 16 * cgp + m, b = ci >> 7, c = ci & 127;
        const bf16* ap = zin + (size_t)(b * SEQ + c * 64 + (kq >> 1)) * ZP + ZC_U + g * 16 + 8 * (kq & 1);
        const LAS unsigned char* bl = lds + m * 2064 + kq * 16;
        f32x4 d0 = {0.f, 0.f, 0.f, 0.f}, d1 = {0.f, 0.f, 0.f, 0.f};
#pragma unroll 8
        for (int ks = 0; ks < 32; ++ks) {
            const bf16x8 av = *(const bf16x8*)(ap + (size_t)(2 * ks) * ZP), b0 = *(const LAS bf16x8*)(bl + 64 * ks), b1 = *(const LAS bf16x8*)(bl + 16 * 2064 + 64 * ks);
            d0 = __builtin_amdgcn_mfma_f32_16x16x32_bf16(av, b0, d0, 0, 0, 0); d1 = __builtin_amdgcn_mfma_f32_16x16x32_bf16(av, b1, d1, 0, 0, 0);
        }
#pragma unroll
        for (int i = 0; i < 4; ++i) { const int cj = 16 * cgp + 4 * (lane >> 4) + i, bj = cj >> 7, cc = cj & 127; float* sp = SC + ((size_t)(bj * 16 + g) * 128 + cc) * 128 + nq * 32 + (lane & 15);
            sp[0] = d0[i]; sp[16] = d1[i]; }
    }
    __syncthreads();
}
__device__ __forceinline__ void naive(const Params& P, int L) {
    BODY_IDS();
    bf16* zin = (bf16*)(P.ws + WS_ZIN);
    for (int bg = gw; bg < 64; bg += ngw) {
        const int b = bg >> 4, g = bg & 15;
        Coef C; coef(P, L, g, lane, C);
        float cr[16], ci[16];
#pragma unroll
        for (int h = 0; h < 16; ++h) { cr[h] = P.in[I_SCR][((size_t)(L * 16 + g) * 16 + h) * 64 + lane]; ci[h] = P.in[I_SCI][((size_t)(L * 16 + g) * 16 + h) * 64 + lane]; }
        const float dsk = P.in[I_SD][(L * 16 + g) * 16 + (lane & 15)];
        float xr = 0.f, xi = 0.f;
        for (int t = 0; t < SEQ; ++t) {
            bf16* up = zin + (size_t)(b * SEQ + t) * ZP + ZC_U + g * 16;
            const u32x4 w0 = *(const u32x4*)up, w1 = *(const u32x4*)(up + 8);
            const float u[16] = {bflo(w0.x), bfhi(w0.x), bflo(w0.y), bfhi(w0.y), bflo(w0.z), bfhi(w0.z), bflo(w0.w), bfhi(w0.w),
                                 bflo(w1.x), bfhi(w1.x), bflo(w1.y), bfhi(w1.y), bflo(w1.z), bfhi(w1.z), bflo(w1.w), bfhi(w1.w)};
            float br = 0.f, bi = 0.f;
#pragma unroll
            for (int h = 0; h < 16; ++h) { br += C.B2[h][0] * u[h]; bi += C.B2[h][1] * u[h]; }
            const float nr = C.abr * xr - C.abi * xi + br, ni = C.abr * xi + C.abi * xr + bi; xr = nr; xi = ni;
            float ymine = 0.f, umine = 0.f;
#pragma unroll
            for (int h = 0; h < 16; ++h) { const float s = wave_sum(xr * cr[h] - xi * ci[h]); if ((lane & 15) == h) { ymine = s; umine = u[h]; } }
            __builtin_amdgcn_s_waitcnt(0);
            if (lane < 16) up[lane] = (bf16)f2bf(gelu_tanh(ymine + dsk * umine));
        }
    }
}
}

__device__ __forceinline__ void norm2_moe_phase(const Params& P, const XSrc x, LAS unsigned char* lds, int first, int stride) {
    BODY_IDS();
    LAS unsigned* lcnt = (LAS unsigned*)(lds + 32768); LAS unsigned* lbase = lcnt + 8;
    f32x4 wr0[4][4], wr1[4][4];
#pragma unroll
    for (int j = 0; j < 4; ++j)
#pragma unroll
        for (int q = 0; q < 4; ++q) { const float* wp = P.in[I_MWR] + (size_t)(4 * lane + 256 * j + q) * 8; wr0[j][q] = *(const f32x4*)wp; wr1[j][q] = *(const f32x4*)(wp + 4); }
    if (tid < 8) lcnt[tid] = 0u;
    __syncthreads();
    const float* gain = P.in[I_GFFN] + 1 * D; bf16* H = (bf16*)(P.ws + WS_H); const GainRegs GR = load_gain(gain, lane);
    unsigned* tokinfo = (unsigned*)(P.ws + WS_TOKINFO); unsigned* gcnt = (unsigned*)(P.ws + WS_CTL) + CW_MOECNT;
    const float* brt = P.in[I_MBR];
    for (int u = first; u < NTOK / 128; u += stride) { const int g0 = u * 8 + wave;
        RMS_ROWS_BEGIN(x, g0 * 16 + i) const int row = g0 * 16 + i; rms_finish(GR, H + (size_t)row * D, lane, v);
            float lg[8];
#pragma unroll
            for (int e = 0; e < 8; ++e) lg[e] = 0.f;
#pragma unroll
            for (int j = 0; j < 4; ++j)
#pragma unroll
                for (int q = 0; q < 4; ++q) { const f32x4 w0 = wr0[j][q], w1 = wr1[j][q]; const float hv = v[j][q];
                    lg[0] += hv * w0[0]; lg[1] += hv * w0[1]; lg[2] += hv * w0[2]; lg[3] += hv * w0[3]; lg[4] += hv * w1[0]; lg[5] += hv * w1[1]; lg[6] += hv * w1[2]; lg[7] += hv * w1[3]; }
#pragma unroll
            for (int e = 0; e < 8; ++e) lg[e] = wave_sum(lg[e]) + brt[e];
            int e0 = 0; float l0 = lg[0];
#pragma unroll
            for (int e = 1; e < 8; ++e) if (lg[e] > l0) { l0 = lg[e]; e0 = e; }
            int e1 = 0; float l1 = -INFINITY;
#pragma unroll
            for (int e = 0; e < 8; ++e) if (e != e0 && lg[e] > l1) { l1 = lg[e]; e1 = e; }
            const float ex = __expf(l1 - l0); const float ga = __builtin_amdgcn_rcpf(1.0f + ex), gb = ex * ga;
            if (lane == 0) { const unsigned r0 = __hip_atomic_fetch_add(&lcnt[e0], 1u, __ATOMIC_RELAXED, __HIP_MEMORY_SCOPE_WORKGROUP), r1 = __hip_atomic_fetch_add(&lcnt[e1], 1u, __ATOMIC_RELAXED, __HIP_MEMORY_SCOPE_WORKGROUP);
                u32x4 a; a.x = (unsigned)e0; a.y = (unsigned)e1; a.z = r0; a.w = r1; u32x4 bq; bq.x = __float_as_uint(ga); bq.y = __float_as_uint(gb); bq.z = 0u; bq.w = 0u;
                *(u32x4*)(tokinfo + (size_t)row * 8) = a; *(u32x4*)(tokinfo + (size_t)row * 8 + 4) = bq; } RMS_ROWS_END()
    }
    __syncthreads();
    if (tid < 8) lbase[tid] = __hip_atomic_fetch_add(gcnt + tid, lcnt[tid], __ATOMIC_RELAXED, __HIP_MEMORY_SCOPE_AGENT);
    __syncthreads();
    for (int u = first; u < NTOK / 128; u += stride) { const int g0 = u * 8 + wave;
        if (lane == 0) { for (int i = 0; i < 16; ++i) { const int row = g0 * 16 + i; u32x4 a = *(u32x4*)(tokinfo + (size_t)row * 8);
            unsigned b0 = 0, b1 = 0;
#pragma unroll
            for (int e = 0; e < 8; ++e) { const unsigned lb = lbase[e]; b0 = (a.x == (unsigned)e) ? lb : b0; b1 = (a.y == (unsigned)e) ? lb : b1; }
            a.z += b0; a.w += b1; *(u32x4*)(tokinfo + (size_t)row * 8) = a; } }
    }
    int* slot_tok = (int*)(P.ws + WS_SLOTTOK);
    for (int i = gtid; i < MOE_ROWS; i += gthreads) slot_tok[i] = -1;
    __syncthreads();
}
struct MoeLayout { int pstart[9]; };
__device__ __forceinline__ MoeLayout moe_layout(const Params& P) {
    const unsigned* gcnt = (const unsigned*)(P.ws + WS_CTL) + CW_MOECNT; MoeLayout Lo; int acc = 0;
#pragma unroll
    for (int e = 0; e < 8; ++e) { Lo.pstart[e] = acc; const int c = (int)__hip_atomic_load(gcnt + e, __ATOMIC_RELAXED, __HIP_MEMORY_SCOPE_AGENT); acc += (c + 255) / 256 * 256; }
    Lo.pstart[8] = acc; return Lo;
}
__device__ __forceinline__ void moe_assign_phase(const Params& P) {
    BODY_IDS();
    const MoeLayout Lo = moe_layout(P);
    const unsigned* tokinfo = (const unsigned*)(P.ws + WS_TOKINFO); int* slot_tok = (int*)(P.ws + WS_SLOTTOK); float* slot_gate = (float*)(P.ws + WS_SLOTGATE);
    for (int t = gtid; t < NTOK; t += gthreads) { const u32x4 a = *(const u32x4*)(tokinfo + (size_t)t * 8); const u32x2 g = *(const u32x2*)(tokinfo + (size_t)t * 8 + 4);
        int p0 = 0, p1 = 0;
#pragma unroll
        for (int e = 0; e < 8; ++e) { p0 = ((int)a.x == e) ? Lo.pstart[e] : p0; p1 = ((int)a.y == e) ? Lo.pstart[e] : p1; }
        const int s0 = p0 + (int)a.z, s1 = p1 + (int)a.w;
        slot_tok[s0] = t; slot_gate[s0] = __uint_as_float(g.x); slot_tok[s1] = t; slot_gate[s1] = __uint_as_float(g.y); }
}
struct MoeOrder {
    int pstart[9]; int ntile, ncol, G, c;
    __device__ __forceinline__ bool next(int i, pg8::Unit& u) const {
        const long Lf = (long)i * G + c; if (Lf >= (long)ntile * ncol) return false;
        const int rt = (int)(Lf / ncol), j = (int)(Lf % ncol); int e = 0;
#pragma unroll
        for (int q = 1; q < 8; ++q) e = (rt * 256 >= pstart[q]) ? q : e;
        u.pm = rt; u.pn = e * ncol + j; return true;
    }
};
__device__ __forceinline__ MoeOrder moe_order(const Params& P, int ncol, int G, int c) {
    const MoeLayout Lo = moe_layout(P); MoeOrder S;
#pragma unroll
    for (int e = 0; e < 9; ++e) S.pstart[e] = Lo.pstart[e];
    S.ntile = Lo.pstart[8] / 256; S.ncol = ncol; S.G = G; S.c = c; return S;
}

__device__ __forceinline__ void norm_moe_combine(const Params& P, const float* gain, int first, int stride) {
    BODY_IDS();
    const MoeLayout Lo = moe_layout(P); const GainRegs GR = load_gain(gain, lane);
    const unsigned* tokinfo = (const unsigned*)(P.ws + WS_TOKINFO); const bf16* Y = (const bf16*)(P.ws + WS_MOEY); bf16* H = (bf16*)(P.ws + WS_H2);
    for (int u = first; u < NTOK / 128; u += stride) for (int i = 0; i < 16; ++i) { const int row = u * 128 + wave * 16 + i;
        const u32x4 a = *(const u32x4*)(tokinfo + (size_t)row * 8);
        int p0 = 0, p1 = 0;
#pragma unroll
        for (int e = 0; e < 8; ++e) { p0 = ((int)a.x == e) ? Lo.pstart[e] : p0; p1 = ((int)a.y == e) ? Lo.pstart[e] : p1; }
        const u32x2* y0 = (const u32x2*)(Y + (size_t)(p0 + (int)a.z) * D) + lane; const u32x2* y1 = (const u32x2*)(Y + (size_t)(p1 + (int)a.w) * D) + lane;
        u32x2* xr = (u32x2*)(xr_of(P.out) + (size_t)row * D) + lane; f32x4 v[4]; float s = 0.f;
#pragma unroll
        for (int j = 0; j < 4; ++j) { const u32x2 w0 = y0[64 * j], w1 = y1[64 * j]; const u32x2 wx = xr[64 * j];
            v[j] = (f32x4){bflo(wx.x), bfhi(wx.x), bflo(wx.y), bfhi(wx.y)} + (f32x4){bflo(w0.x), bfhi(w0.x), bflo(w0.y), bfhi(w0.y)} + (f32x4){bflo(w1.x), bfhi(w1.x), bflo(w1.y), bfhi(w1.y)};
            { u32x2 wo; wo.x = pk2(v[j][0], v[j][1]); wo.y = pk2(v[j][2], v[j][3]); xr[64 * j] = wo; } s += (v[j][0] * v[j][0] + v[j][1] * v[j][1]) + (v[j][2] * v[j][2] + v[j][3] * v[j][3]); }
        const float rstd = __builtin_amdgcn_rsqf(wave_sum(s) * (1.0f / D) + RMS_EPS);
        u32x2* o8 = (u32x2*)(H + (size_t)row * D) + lane;
#pragma unroll
        for (int j = 0; j < 4; ++j) { const f32x4 h = v[j] * rstd * GR.g[j]; u32x2 w; w.x = pk2(h[0], h[1]); w.y = pk2(h[2], h[3]); o8[64 * j] = w; }
    }
}
#ifndef REF_MASK
#define REF_MASK 0
#endif
#ifndef N_LAUNCH_MODE
#define N_LAUNCH_MODE 1
#endif
constexpr int LDS_BYTES = 147456;
constexpr int MISC_OFF = LDS_BYTES - 64;
constexpr int N_PHASES = 27;
#ifndef PHASE_SEL
#define PHASE_SEL 0xFFFFFFFu
#endif
#define PH_ON(b) (((PHASE_SEL) >> (b)) & 1u)
#ifndef SUB_SEL
#define SUB_SEL 0xFFu
#endif
#define SUB_ON(b) (((SUB_SEL) >> (b)) & 1u)

#ifndef PROBE_MASK
#define PROBE_MASK 0u
#endif
#ifndef PROBE_MULT
#define PROBE_MULT 4
#endif
#define TIMED(bit, ...) do { unsigned long long t0_ = 0; if (((PROBE_MASK) >> (bit)) & 1u) t0_ = __builtin_amdgcn_s_memrealtime(); __VA_ARGS__; \
    if (((PROBE_MASK) >> (bit)) & 1u) pacc += __builtin_amdgcn_s_memrealtime() - t0_; } while (0)
#define RUN_GEMM(EPI_T, SCHED_T, GATH, gm, sc, ep) do { if (REF_MASK & 1) pg8::gemm_phase_naive<EPI_T, SCHED_T, GATH>(gm, sc, ep); \
    else pg8::gemm_phase<EPI_T, SCHED_T, true, GATH>(lds, gm, sc, ep); } while (0)

__device__ __forceinline__ int vcu_of() { int G = gridDim.x, bx = blockIdx.x; asm volatile("" : "+s"(G), "+s"(bx)); return (G % 8 == 0) ? (bx % 8) * (G / 8) + bx / 8 : bx; }
__device__ __forceinline__ bool in_range(int lo, int hi, int k) { asm volatile("" : "+s"(lo), "+s"(hi)); return lo <= k && k < hi; }
__global__ void __launch_bounds__(NTHREADS, 2) mega_fwd(Params P) {
    extern __shared__ __attribute__((aligned(16))) unsigned char lds_raw[];
    LAS unsigned char* lds = (LAS unsigned char*)lds_raw;
    const int tid = threadIdx.x;
    const int G = gridDim.x, bx = blockIdx.x;
    unsigned* ctl = (unsigned*)(P.ws + WS_CTL);
    volatile LAS unsigned* misc = (volatile LAS unsigned*)(lds + MISC_OFF);
    if (tid < 16) misc[tid] = 0u;
    if ((tid & 63) == 0) *(LAS int*)(uintptr_t)((unsigned)TID_TAB_OFF + 4u * hw_wave_key()) = tid >> 6;
    __syncthreads();
    const int lo = P.ph_lo, hi = P.ph_hi;
    XcdBarrier bar; bar.bar = ctl + CW_BAR; bar.x = 0; bar.st = misc;
    if (hi - lo > 1) bar = xcd_barrier_post(ctl + CW_BAR, misc);
#define IN(k) in_range(lo, hi, (k))
#ifndef PROBE_SEAMS
#define PROBE_SEAMS 0u
#endif
#define SEAM(k) do { if (IN(k) && IN((k) + 1)) { unsigned long long t0_ = 0; const bool tm_ = (((PROBE_MASK) >> 24) & 1u) || (((PROBE_SEAMS) >> (k)) & 1u); if (tm_) t0_ = __builtin_amdgcn_s_memrealtime(); \
    xcd_barrier(bar); if (tm_) pacc += __builtin_amdgcn_s_memrealtime() - t0_; } } while (0)
    unsigned long long pacc = 0;

#define H ((bf16*)(P.ws + WS_H))
#define ZIN ((bf16*)(P.ws + WS_ZIN))
#define GB ((bf16*)(P.ws + WS_G))
#define MB ((bf16*)(P.ws + WS_M))
#define MLAQ ((bf16*)(P.ws + WS_MLAQ))
#define MLAKV ((bf16*)(P.ws + WS_MLAKV))
#define KPER ((bf16*)(P.ws + WS_KPER))
#define cosT ((float*)(P.ws + WS_COS))
#define sinT ((float*)(P.ws + WS_SIN))
#define slot_tok ((int*)(P.ws + WS_SLOTTOK))
#define slot_gate ((float*)(P.ws + WS_SLOTGATE))

    if (PH_ON(0) && IN(0)) { TIMED(0, cvt_jobs(P, 0, 43, lds); p0_misc(P)); TIMED(1, norm1_phase(P, 0, XSrc{P.in[I_X], nullptr}, vcu_of(), gridDim.x)); }
    SEAM(0);

    for (int L = 0; L < 2; ++L) {
        const int pb = 1 + 12 * L;
        const int pc = (L == 0) ? 9 : 22;
        bf16* const XR = xr_of(P.out);
        const XSrc xsrc = (L == 0) ? XSrc{P.in[I_X], nullptr} : XSrc{nullptr, XR};
        if (PH_ON(2) && IN(pb + 1)) {
            TIMED(4, s5::build_w(P, L));
            pg8::Gemm g{H, wmix(P, L, WM_IN), D, D, D, nullptr}; pg8::StaticOrder S; S.init(NTOK, ZP, G, bx);
            epi::EpiStore E{ZIN, ZP, 0};
            TIMED(2, RUN_GEMM(epi::EpiStore, pg8::StaticOrder, false, g, S, E));
        }
        SEAM(pb + 1);
        if (PH_ON(3) && IN(pb + 2)) {
            TIMED(3, prep_phase(P, L));
            if (!(REF_MASK & 4)) TIMED(4, s5::pass0_mfma(P, lds));
            __syncthreads();
        }
        SEAM(pb + 2);
        if (PH_ON(4) && IN(pb + 3)) {
            if (SUB_ON(0)) { pg8::Gemm g{ZIN + ZC_CQ, wmix(P, L, WM_UQ), ZP, 256, 256, nullptr}; pg8::StaticOrder S; S.init(NTOK, 512, G, bx);
              epi::EpiMlaQ E{MLAQ, (const float*)(P.ws + WS_RSTDQ), cosT, sinT};
              TIMED(5, RUN_GEMM(epi::EpiMlaQ, pg8::StaticOrder, false, g, S, E)); }
            if (SUB_ON(1)) { pg8::Gemm g{ZIN + ZC_CKV, wmix(P, L, WM_UKV), ZP, 128, 128, nullptr}; pg8::StaticOrder S; S.init(NTOK, 512, G, bx);
              epi::EpiRowScale E{MLAKV, 512, (const float*)(P.ws + WS_RSTDKV)};
              TIMED(5, RUN_GEMM(epi::EpiRowScale, pg8::StaticOrder, false, g, S, E)); }
            if (SUB_ON(2)) { TIMED(6, if (REF_MASK & 4) s5::naive(P, L); else s5::phase1(P, L, lds)); }
            __syncthreads();
            if (SUB_ON(3)) { att::Tensors T; T.Q = ZIN + ZC_FQ; T.ldq = ZP; T.K = ZIN + ZC_FK; T.ldk = ZP; T.K2 = nullptr; T.V = ZIN + ZC_FV; T.ldv = ZP; T.O = ZIN + ZC_FQ; T.ldo = ZP;
              T.cdec = (const float*)(P.ws + WS_CDEC); T.relb = nullptr; T.qhs = 64; T.khs = 64; T.vhs = 64; T.ohs = 64;
              T.qmax = (const unsigned*)(P.ws + WS_CTL) + CW_QMAX + L * 512; T.kmax = (const unsigned*)(P.ws + WS_CTL) + CW_KMAX + L * 16;
              TIMED(7, if (REF_MASK & 2) att::attn_naive<att::MODE_FOX>(T); else att::attn_phase<att::MODE_FOX>(T, lds)); }
            __syncthreads();
            if (SUB_ON(4)) { att::Tensors T; T.Q = ZIN + ZC_DQ; T.ldq = ZP; T.K = ZIN + ZC_DK; T.ldk = ZP; T.K2 = nullptr; T.V = ZIN + ZC_DV; T.ldv = ZP; T.O = ZIN + ZC_DQ; T.ldo = ZP;
              T.cdec = nullptr; T.relb = P.in[I_RELB] + (size_t)L * 4 * 513; T.qhs = 64; T.khs = 64; T.vhs = 64; T.ohs = 64;
              TIMED(8, if (REF_MASK & 2) att::attn_naive<att::MODE_BAND>(T); else att::attn_phase<att::MODE_BAND>(T, lds)); }
            __syncthreads();
        }
        SEAM(pb + 3);
        if (PH_ON(5) && IN(pb + 4)) {
            if (SUB_ON(0)) { att::Tensors T; T.Q = MLAQ; T.ldq = 512; T.K = MLAKV; T.ldk = 512; T.K2 = KPER; T.V = MLAKV + 64; T.ldv = 512; T.O = ZIN + ZC_CQ; T.ldo = ZP;
              T.cdec = nullptr; T.relb = nullptr; T.qhs = 96; T.khs = 128; T.vhs = 128; T.ohs = 64;
              TIMED(9, if (REF_MASK & 2) att::attn_naive<att::MODE_MLA>(T); else att::attn_phase<att::MODE_MLA>(T, lds)); }
            __syncthreads();
            if (SUB_ON(1)) { pg8::Gemm g{ZIN + ZC_U, wmix(P, L, WM_GLU), ZP, 256, 256, nullptr}; pg8::StaticOrder S; S.init(NTOK, 256, G, bx);
              epi::EpiGlu E{ZIN + ZC_U, ZP};
              TIMED(10, RUN_GEMM(epi::EpiGlu, pg8::StaticOrder, false, g, S, E)); }
        }
        SEAM(pb + 4);
        if (PH_ON(6) && IN(pb + 5)) {
            g128::MergeProg MP; MP.Hn = H; MP.zin = ZIN; MP.wg = wmix(P, L, WM_G); MP.wb = wmix(P, L, WM_B); MP.bg = P.in[I_BG] + (size_t)L * 4 * D; MP.M = MB;
            const int vcu_ = vcu_of();
            TIMED(11, g128::stream<g128::MergeProg>(lds, MP, 1024, vcu_, G));
        }
        SEAM(pb + 5);
#define PANEL_FENCE() do { asm volatile("s_waitcnt vmcnt(0)" ::: "memory"); __builtin_amdgcn_fence(__ATOMIC_ACQUIRE, "agent"); asm volatile("s_waitcnt vmcnt(0)" ::: "memory"); __syncthreads(); } while (0)
        if (PH_ON(7) && IN(pb + 6)) {
            pg8::Gemm g{MB, wmix(P, L, WM_O), D, D, D, nullptr}; pg8::StaticOrder S; S.init(NTOK, D, G, bx);
            epi::EpiRes E{xsrc, XR};
            TIMED(13, RUN_GEMM(epi::EpiRes, pg8::StaticOrder, false, g, S, E));
        }
        SEAM(pb + 6);
        if (PH_ON(8) && IN(pb + 7)) {
            const int vcu_ = vcu_of();
            if (L == 0) TIMED(14, norm_plain(XSrc{nullptr, XR}, P.in[I_GFFN], H, vcu_, G));
            else { TIMED(14, norm2_moe_phase(P, XSrc{nullptr, XR}, lds, vcu_, G)); TIMED(25, cvt_jobs(P, 43, 67, lds)); __syncthreads(); }
        }
        SEAM(pb + 7);
        if (L == 0) {
            if (PH_ON(9) && IN(9)) {
                pg8::Gemm g{H, (const bf16*)(P.ws + WS_W13), D, D, D, nullptr}; pg8::StaticOrder S; S.init(NTOK, 2 * DFF, G, bx);
                epi::EpiSwiglu E{(bf16*)(P.ws + WS_HMID), DFF, 22};
                TIMED(15, RUN_GEMM(epi::EpiSwiglu, pg8::StaticOrder, false, g, S, E));
            }
            SEAM(9);
            if (PH_ON(10) && IN(10)) {
                pg8::Gemm g{(const bf16*)(P.ws + WS_HMID), (const bf16*)(P.ws + WS_W2), DFF, DFF, DFF, nullptr}; pg8::StaticOrder S; S.init(NTOK, D, G, bx);
                epi::EpiRes E{XSrc{nullptr, XR}, XR};
                TIMED(16, RUN_GEMM(epi::EpiRes, pg8::StaticOrder, false, g, S, E));
            }
            SEAM(10);
        } else {
            if (PH_ON(21) && IN(21)) TIMED(17, moe_assign_phase(P));
            SEAM(21);
            if (PH_ON(22) && IN(22)) {
                pg8::Gemm g{H, (const bf16*)(P.ws + WS_WM13), D, D, D, slot_tok}; const MoeOrder S = moe_order(P, 11, G, bx);
                epi::EpiSwiglu E{(bf16*)(P.ws + WS_HMID), DFFE, 11};
                TIMED(18, RUN_GEMM(epi::EpiSwiglu, MoeOrder, true, g, S, E));
            }
            SEAM(22);
            if (PH_ON(23) && IN(23)) {
                pg8::Gemm g{(const bf16*)(P.ws + WS_HMID), (const bf16*)(P.ws + WS_WM2), DFFE, DFFE, DFFE, nullptr}; const MoeOrder S = moe_order(P, 4, G, bx);
                epi::EpiMoeDown E{(bf16*)(P.ws + WS_MOEY), slot_gate};
                TIMED(19, RUN_GEMM(epi::EpiMoeDown, MoeOrder, false, g, S, E));
            }
            SEAM(23);
        }
        if (PH_ON(12) && IN(pc + 3)) {
            const int vcu_ = vcu_of();
            if (L == 0) TIMED(20, norm_plain(XSrc{nullptr, XR}, P.in[I_GPLE] + L * D, H, vcu_, G)); else TIMED(20, norm_moe_combine(P, P.in[I_GPLE] + L * D, vcu_, G));
            PANEL_FENCE();
            g128::PleProg PP; PP.pbf = (const bf16*)(P.ws + WS_PBF) + (size_t)L * NTOK * 256; PP.hp = (L == 0) ? H : (const bf16*)(P.ws + WS_H2); PP.wup = wmix(P, L, WM_UP); PP.wpg = wmix(P, L, WM_PG); PP.x = XR;
            TIMED(22, g128::stream<g128::PleProg>(lds, PP, NTOK / 128, vcu_, G));
            PANEL_FENCE();
            if (L == 0) TIMED(1, norm1_phase(P, 1, XSrc{nullptr, XR}, vcu_, G));
        }
        if (L == 0) SEAM(pc + 3);
    }
    if (PH_ON(26) && IN(25)) {
        const int vcu_ = vcu_of(); const int G_ = gridDim.x;
        for (int r = 0; r < (NTOK / 128 + G_ - 1) / G_; ++r) {
            const int u = vcu_ + r * G_; FinalRows FR;
            if (u < NTOK / 128) final_norm_load(P, u, FR);
            xcd_barrier(bar);
            if (u < NTOK / 128) final_norm_store(P, u, FR);
        }
    }
    if (PROBE_MASK || PROBE_SEAMS) { const unsigned long long t0_ = __builtin_amdgcn_s_memrealtime(); while (__builtin_amdgcn_s_memrealtime() - t0_ < (unsigned long long)PROBE_MULT * pacc) __builtin_amdgcn_s_sleep(8); }
#undef IN
#undef SEAM
#undef H
#undef ZIN
#undef GB
#undef MB
#undef MLAQ
#undef MLAKV
#undef KPER
#undef cosT
#undef sinT
#undef slot_tok
#undef slot_gate
}

extern "C" void kernel_launch(void* const* d_in, const int* in_sizes, int n_in, void* d_out, int out_size, void* d_ws, size_t ws_size, hipStream_t stream) {
    static int grid = 0;
    if (grid == 0) {
        if (n_in != 37 || out_size != NTOK * D || ws_size < WS_END) { fprintf(stderr, "kernel_launch: unexpected shapes: n_in %d out %d ws %zu\n", n_in, out_size, ws_size); grid = -1; return; }
        int dev = 0, cus = 0, per_cu = 0;
        if (hipGetDevice(&dev) != hipSuccess || hipDeviceGetAttribute(&cus, hipDeviceAttributeMultiprocessorCount, dev) != hipSuccess) { grid = -1; return; }
        if (hipFuncSetAttribute((const void*)mega_fwd, hipFuncAttributeMaxDynamicSharedMemorySize, LDS_BYTES) != hipSuccess) { fprintf(stderr, "kernel_launch: hipFuncSetAttribute failed\n"); grid = -1; return; }
        if (hipOccupancyMaxActiveBlocksPerMultiprocessor(&per_cu, (const void*)mega_fwd, NTHREADS, LDS_BYTES) != hipSuccess || per_cu < 1)
            fprintf(stderr, "kernel_launch: note: occupancy query reports %d workgroups per CU\n", per_cu);
        (void)hipGetLastError();
        grid = cus;
        if (grid != 256) fprintf(stderr, "kernel_launch: note: %d CUs (built for 256)\n", grid);
    }
    if (grid < 0) return;
    if (hipMemsetAsync((char*)d_ws + WS_CTL, 0, CTL_ZERO_BYTES, stream) != hipSuccess) return;
    Params p{};
    for (int i = 0; i < 37; ++i) p.in[i] = (const float*)d_in[i];
    p.out = (float*)d_out; p.ws = (unsigned char*)d_ws;
#if N_LAUNCH_MODE == 1
    p.ph_lo = 0; p.ph_hi = N_PHASES;
    hipLaunchKernelGGL(mega_fwd, dim3(grid), dim3(NTHREADS), LDS_BYTES, stream, p);
#else
    for (int ph = 0; ph < N_PHASES; ++ph) { p.ph_lo = ph; p.ph_hi = ph + 1; hipLaunchKernelGGL(mega_fwd, dim3(grid), dim3(NTHREADS), LDS_BYTES, stream, p); }
#endif
    const hipError_t le = hipPeekAtLastError();
    if (le != hipSuccess) fprintf(stderr, "kernel_launch: launch failed: %s\n", hipGetErrorName(le));
}
```

```cpp
#include <hip/hip_runtime.h>
#include <cstdio>
#include <cstdint>

#define GAS __attribute__((address_space(1)))
#define LAS __attribute__((address_space(3)))
typedef unsigned short bf16;
typedef short bf16x8 __attribute__((ext_vector_type(8)));
typedef short s16x4 __attribute__((ext_vector_type(4)));
typedef float f32x2 __attribute__((ext_vector_type(2)));
typedef float f32x4 __attribute__((ext_vector_type(4)));
typedef float f32x16 __attribute__((ext_vector_type(16)));
typedef unsigned u32x2 __attribute__((ext_vector_type(2)));
typedef unsigned u32x4 __attribute__((ext_vector_type(4)));
typedef __bf16 bf16x2_t __attribute__((ext_vector_type(2)));

constexpr int NB = 4, SEQ = 8192, NTOK = NB * SEQ, D = 1024;
constexpr int ZP = 2304;
constexpr int ZC_U = 0, ZC_FQ = 256, ZC_FK = 512, ZC_FV = 768, ZC_DQ = 1024, ZC_DK = 1280, ZC_DV = 1536, ZC_CQ = 1792, ZC_CKV = 2048, ZC_KPE = 2176;
constexpr int DIN = 2148, DFF = 2816, DFFE = 1408, NE = 8;
constexpr int MOE_ROWS = 2 * NTOK + NE * 256;
constexpr float RMS_EPS = 1e-6f;
constexpr int NWAVES = 8, NTHREADS = 512;

constexpr size_t MiB = 1u << 20;
constexpr size_t WS_CTL = 0, CTL_ZERO_BYTES = 1 * MiB;
constexpr size_t WS_COS = 1 * MiB, WS_SIN = 3 * MiB;
constexpr size_t WS_LOGF = 5 * MiB;
constexpr size_t WS_CDEC = 5 * MiB + 512 * 1024;
constexpr size_t WS_WSUM = 6 * MiB;
constexpr size_t WS_RSTDQ = 6 * MiB + 256 * 1024, WS_RSTDKV = 6 * MiB + 512 * 1024;
constexpr size_t WS_SC = 7 * MiB;
constexpr size_t WS_TOKINFO = 11 * MiB;
constexpr size_t WS_SLOTTOK = 12 * MiB, WS_SLOTGATE = 12 * MiB + 512 * 1024;
constexpr size_t WS_S5W = 13 * MiB;
constexpr size_t WS_PBF = 17 * MiB;
constexpr size_t WS_WMIX = 49 * MiB, WMIX_STRIDE = 20 * MiB;
constexpr size_t WM_IN = 0, WM_G = 4 * MiB + 512 * 1024, WM_B = 12 * MiB + 512 * 1024, WM_O = 14 * MiB + 512 * 1024, WM_PG = 16 * MiB + 512 * 1024,
                 WM_UP = 18 * MiB + 512 * 1024, WM_UQ = 19 * MiB, WM_UKV = 19 * MiB + 256 * 1024, WM_GLU = 19 * MiB + 384 * 1024;
constexpr size_t WS_W13 = 89 * MiB, WS_W2 = 100 * MiB;
constexpr size_t WS_H = 106 * MiB;
constexpr size_t WS_MLAQ = 170 * MiB, WS_MLAKV = 202 * MiB, WS_KPER = 234 * MiB;
constexpr size_t WS_M = 170 * MiB;
constexpr size_t WS_ZIN = 236 * MiB;
constexpr size_t WS_G = 380 * MiB;
constexpr size_t WS_HMID = 236 * MiB;
constexpr size_t WS_U = 236 * MiB;
constexpr size_t WS_WM13 = 418 * MiB, WS_WM2 = 462 * MiB;
constexpr size_t WS_MOEY = 89 * MiB;
constexpr size_t WS_H2 = 300 * MiB;
constexpr size_t WS_END = 484 * MiB;
constexpr int CW_BAR = 4096;
constexpr int CW_MOECNT = 16384;
constexpr int CW_QMAX = 20480;
constexpr int CW_KMAX = 22528;

#define LDS_WAIT() asm volatile("s_waitcnt lgkmcnt(0)" ::: "memory")
#define VM_WAIT() asm volatile("s_waitcnt vmcnt(0)" ::: "memory")
__device__ __forceinline__ unsigned f2bf(float f) { unsigned u = __builtin_bit_cast(unsigned, f); return (u + 0x7fffu + ((u >> 16) & 1u)) >> 16; }
__device__ __forceinline__ unsigned pk2(float lo, float hi) { f32x2 v = {lo, hi}; bf16x2_t b = __builtin_convertvector(v, bf16x2_t); return __builtin_bit_cast(unsigned, b); }
__device__ __forceinline__ float bf2f(unsigned short b) { return __uint_as_float((unsigned)b << 16); }
__device__ __forceinline__ float bflo(unsigned w) { return __uint_as_float(w << 16); }
__device__ __forceinline__ float bfhi(unsigned w) { return __uint_as_float(w & 0xffff0000u); }
constexpr int TID_TAB_OFF = 147456 - 512;
__device__ __forceinline__ unsigned hw_wave_key() { return (unsigned)__builtin_amdgcn_s_getreg((5 << 11) | 4) & 0x3Fu; }
__device__ __forceinline__ int my_tid() {
    unsigned addr = (unsigned)TID_TAB_OFF + 4u * hw_wave_key(); asm volatile("" : "+s"(addr));
    const int wave = __builtin_amdgcn_readfirstlane(*(const LAS int*)(uintptr_t)addr);
    int lane = (int)__builtin_amdgcn_mbcnt_hi(~0u, __builtin_amdgcn_mbcnt_lo(~0u, 0u)); asm volatile("" : "+v"(lane));
    return wave * 64 + lane;
}
__device__ __forceinline__ float shflx(float v, int o, int lane) { return __int_as_float(__builtin_amdgcn_ds_bpermute((lane ^ o) << 2, __float_as_int(v))); }
#define DPP_F(x_, ctrl_, rm_) __int_as_float(__builtin_amdgcn_update_dpp(0, __float_as_int(x_), (ctrl_), (rm_), 0xF, true))
__device__ __forceinline__ float wave_sum(float v) {
    v += DPP_F(v, 0xB1, 0xF); v += DPP_F(v, 0x4E, 0xF); v += DPP_F(v, 0x114, 0xF); v += DPP_F(v, 0x118, 0xF);
    v += DPP_F(v, 0x142, 0xA); v += DPP_F(v, 0x143, 0xC);
    return __int_as_float(__builtin_amdgcn_readlane(__float_as_int(v), 63));
}
__device__ __forceinline__ float sigmoidf_(float x) { return __builtin_amdgcn_rcpf(1.0f + __expf(-x)); }

struct XSrc { const float* f; const bf16* b; };
__device__ __forceinline__ f32x4 ldx4(const XSrc& x, size_t idx) {
    if (x.f) return *(const f32x4*)(x.f + idx);
    const u32x2 w = *(const u32x2*)(x.b + idx); return (f32x4){bflo(w.x), bfhi(w.x), bflo(w.y), bfhi(w.y)};
}
__device__ __forceinline__ bf16* xr_of(float* out) { return (bf16*)((unsigned char*)out + (size_t)NTOK * D * 2); }
#define BODY_IDS() int tid = my_tid(); asm volatile("" : "+v"(tid)); const int lane = tid & 63; const int wave = __builtin_amdgcn_readfirstlane(tid >> 6); \
    int grid_ = gridDim.x; asm volatile("" : "+s"(grid_)); \
    const int gw = blockIdx.x * NWAVES + wave, ngw = grid_ * NWAVES, gtid = blockIdx.x * NTHREADS + tid, gthreads = grid_ * NTHREADS; (void)lane; (void)wave; (void)gw; (void)ngw; (void)gtid; (void)gthreads
#define XB_TMO      128
#define XB_XCNT(j)  (256  + 64 * (j))
#define XB_XSUB(j)  (1280 + 64 * (j))
#define XB_XGEN(j)  (2304 + 64 * (j))
#define XB_TOP      3328
#define XB_TOPGEN   3392
#define XCD_BAR_WORDS 3456
#define XB_SPIN_CAP (1u << 22)

__device__ __forceinline__ unsigned xb_ld(unsigned* p)              { return __hip_atomic_load(p, __ATOMIC_RELAXED, __HIP_MEMORY_SCOPE_AGENT); }
__device__ __forceinline__ unsigned xb_add(unsigned* p, unsigned v) { return __hip_atomic_fetch_add(p, v, __ATOMIC_RELAXED, __HIP_MEMORY_SCOPE_AGENT); }
__device__ __forceinline__ unsigned xb_xcc_id() { return (unsigned)__builtin_amdgcn_s_getreg((3 << 11) | 20) & 0xFu; }
#define XB_SPIN(cond, bar) do { unsigned _sp = 0; while (cond) { __builtin_amdgcn_s_sleep(1); \
    if ((++_sp & 255u) == 0u) { if (xb_ld(&(bar)[XB_TMO])) break; if (_sp > XB_SPIN_CAP) { atomicAdd(&(bar)[XB_TMO], 1u); break; } } } } while (0)

struct XcdBarrier { unsigned* bar; unsigned x; volatile LAS unsigned* st; };

__device__ __forceinline__ XcdBarrier xcd_barrier_post(unsigned* bar, volatile LAS unsigned* st) {
    XcdBarrier b; b.bar = bar; b.x = xb_xcc_id(); b.st = st;
    if (my_tid() == 0) (void)xb_add(&bar[XB_XCNT(b.x)], 1u);
    return b;
}
__device__ __forceinline__ void xcd_barrier_complete(unsigned* bar, unsigned x, unsigned& nloc, unsigned& nx) {
    const unsigned G = gridDim.x * gridDim.y * gridDim.z;
    unsigned sum, cnt, mine, sp = 0u;
    for (;;) {
        sum = 0u; cnt = 0u; mine = 0u;
#pragma unroll
        for (unsigned j = 0; j < 16; ++j) { const unsigned c = xb_ld(&bar[XB_XCNT(j)]); sum += c; cnt += (c > 0u) ? 1u : 0u; mine = (j == x) ? c : mine; }
        if (sum == G) break;
        __builtin_amdgcn_s_sleep(1);
        if ((++sp & 255u) == 0u) { if (xb_ld(&bar[XB_TMO])) break; if (sp > XB_SPIN_CAP) { atomicAdd(&bar[XB_TMO], 1u); break; } }
    }
    nloc = mine > 0u ? mine : 1u; nx = cnt > 0u ? cnt : 1u;
}
__device__ __forceinline__ void xcd_barrier(const XcdBarrier& b) {
    asm volatile("s_waitcnt vmcnt(0)" ::: "memory");
    __syncthreads();
    if (my_tid() == 0) {
        unsigned* bar = b.bar;
        __builtin_amdgcn_s_waitcnt(0);
        unsigned nloc = b.st[0], nx = b.st[1];
        if (nloc == 0u) { xcd_barrier_complete(bar, b.x, nloc, nx); b.st[0] = nloc; b.st[1] = nx; }
        const unsigned old = xb_add(&bar[XB_XSUB(b.x)], 1u);
        const unsigned gen = old / nloc;
        if (old + 1u == (gen + 1u) * nloc) {
            __builtin_amdgcn_fence(__ATOMIC_RELEASE, "agent");
            asm volatile("s_waitcnt vmcnt(0)" ::: "memory");
            const unsigned og = xb_add(&bar[XB_TOP], 1u);
            const unsigned tg = og / nx;
            if (og + 1u == (tg + 1u) * nx) xb_add(&bar[XB_TOPGEN], 1u);
            else XB_SPIN(xb_ld(&bar[XB_TOPGEN]) == tg, bar);
            __builtin_amdgcn_fence(__ATOMIC_ACQUIRE, "agent");
            xb_add(&bar[XB_XGEN(b.x)], 1u);
            asm volatile("s_waitcnt vmcnt(0)" ::: "memory");
        } else {
            XB_SPIN(xb_ld(&bar[XB_XGEN(b.x)]) == gen, bar);
            __builtin_amdgcn_fence(__ATOMIC_ACQUIRE, "agent");
            asm volatile("s_waitcnt vmcnt(0)" ::: "memory");
        }
    }
    __syncthreads();
}
namespace pg8 {
constexpr int BM = 256, BK = 64, HALF = 128, HTB = HALF * BK * 2, STAGE_BYTES = 8 * HTB, NXCD = 8, WGM = 8;
__host__ __device__ __forceinline__ int lds_byte(int r, int c) { const int st = (r >> 4) * 2 + (c >> 5), rr = r & 15, cc = c & 31, ob = rr * 64 + cc * 2; return st * 1024 + (ob ^ (((ob >> 9) & 1) << 5)); }
__host__ __device__ __forceinline__ void stage_rc(int b, int& R, int& C) { const int st = b / 1024, sb = b % 1024, swz = sb ^ (((sb >> 9) & 1) << 5); R = (st >> 1) * 16 + swz / 64; C = (st & 1) * 32 + (swz % 64) / 2; }
__host__ __device__ __forceinline__ int perm32(int rho) { const int n = rho >> 4, i = rho & 15; return 8 * (i >> 2) + 4 * n + (i & 3); }

struct Unit { int pm, pn; };
struct Gemm { const bf16* A; const bf16* Bt; int lda, ldb, K; const int* gidx; };

struct StaticOrder {
    int nM, nN, nwg, G, c;
    __host__ __device__ void init(int M, int N, int G_, int c_) { nM = M / BM; nN = N / BM; nwg = nM * nN; G = G_; c = c_; }
    __host__ __device__ bool next(int i, Unit& u) const {
        const long L = (long)i * G + c; if (L >= nwg) return false;
        int wgid = (int)L; { const int q = nwg / NXCD, r = nwg % NXCD, xcd = wgid % NXCD, off = wgid / NXCD; wgid = (xcd < r ? xcd * (q + 1) : r * (q + 1) + (xcd - r) * q) + off; }
        const int nig = WGM * nN, gid = wgid / nig, fm = gid * WGM, gsz = (nM - fm) < WGM ? (nM - fm) : WGM;
        u.pm = fm + ((wgid % nig) % gsz); u.pn = (wgid % nig) / gsz; return true;
    }
};

template <class Epi, class Sched, bool ALIGN_EPI, bool GATHER>
__device__ __forceinline__ void gemm_phase(LAS unsigned char* lds, const Gemm g, const Sched& S, const Epi& E) {
    int tid = my_tid(); asm volatile("" : "+v"(tid));
    const int wid = __builtin_amdgcn_readfirstlane(tid >> 6), lane = tid & 63, wr = wid >> 2, wc = wid & 3, fr = lane & 15, fq = lane >> 4;
    int Kq = g.K; asm volatile("" : "+s"(Kq));
    const int K = Kq, nt = K / BK;
    int RA[2], CA[2];
    unsigned voffA[2], voffB[2];
#pragma unroll
    for (int i = 0; i < 2; ++i) { int R, C; stage_rc(tid * 16 + i * 8192, R, C); const int Rb = Epi::PERM ? ((R & ~31) + perm32(R & 31)) : R;
        RA[i] = R; CA[i] = C; voffA[i] = (unsigned)(R * g.lda + C) * 2u; voffB[i] = (unsigned)(Rb * g.ldb + C) * 2u; }
    const size_t kstep = (size_t)(BK * 2);
    const size_t hstepB = (size_t)HALF * g.ldb * 2, tstepB = 2 * hstepB;
    const size_t hstepA = (size_t)HALF * g.lda * 2, tstepA = 2 * hstepA;
    const unsigned ldsw = (unsigned)wid * 1024u;
    const int aoff = lds_byte(wr * 64 + fr, fq * 8), boff = lds_byte(wc * 32 + fr, fq * 8);
#define PG8_SA(b, h) (((b) * 2 + (h)) * HTB)
#define PG8_SB(b, h) ((4 + (b) * 2 + (h)) * HTB)
#define PG8_STAGEB(bufoff, gbase) do { _Pragma("unroll") for (int _i = 0; _i < 2; ++_i) \
        __builtin_amdgcn_global_load_lds((const unsigned*)((const char*)(gbase) + voffB[_i]), (LAS unsigned*)(lds + (bufoff) + ldsw + _i * 8192), 16, 0, 0); } while (0)
#define PG8_STAGEA(bufoff, kptr, isnext, h) do { _Pragma("unroll") for (int _i = 0; _i < 2; ++_i) { const char* _p; \
        if constexpr (GATHER) _p = (const char*)(kptr) + ((isnext) ? nvo[h][_i] : cvo[h][_i]); else _p = (const char*)(kptr) + (size_t)(h) * hstepA + voffA[_i]; \
        __builtin_amdgcn_global_load_lds((const unsigned*)_p, (LAS unsigned*)(lds + (bufoff) + ldsw + _i * 8192), 16, 0, 0); } } while (0)
#define PG8_LDA(dst, b, h) do { _Pragma("unroll") for (int m = 0; m < 4; ++m) _Pragma("unroll") for (int k = 0; k < 2; ++k) dst[m][k] = *(const LAS bf16x8*)(lds + PG8_SA(b, h) + aoff + m * 2048 + k * 1024); } while (0)
#define PG8_LDB(dst, b, h) do { _Pragma("unroll") for (int n = 0; n < 2; ++n) _Pragma("unroll") for (int k = 0; k < 2; ++k) dst[n][k] = *(const LAS bf16x8*)(lds + PG8_SB(b, h) + boff + n * 2048 + k * 1024); } while (0)
#define PG8_MMA(ai, bj, At, Bt) do { __builtin_amdgcn_s_setprio(1); _Pragma("unroll") for (int m = 0; m < 4; ++m) _Pragma("unroll") for (int n = 0; n < 2; ++n) _Pragma("unroll") for (int k = 0; k < 2; ++k) \
        acc[ai][bj][m][n] = __builtin_amdgcn_mfma_f32_16x16x32_bf16(Bt[n][k], At[m][k], acc[ai][bj][m][n], 0, 0, 0); __builtin_amdgcn_s_setprio(0); } while (0)
#define PG8_WAIT_V(n) asm volatile("s_waitcnt vmcnt(" #n ")" ::: "memory")
#define PG8_WAIT_L(n) asm volatile("s_waitcnt lgkmcnt(" #n ")" ::: "memory")
#define PG8_BAR __builtin_amdgcn_s_barrier()
#define PG8_SCHED __builtin_amdgcn_sched_barrier(0)
#define PG8_VOA(vo, u) do { _Pragma("unroll") for (int _h = 0; _h < 2; ++_h) _Pragma("unroll") for (int _i = 0; _i < 2; ++_i) { \
        int _row = (u).pm * BM + _h * HALF + RA[_i]; if (GATHER) { _row = g.gidx[_row]; _row = _row < 0 ? 0 : _row; } \
        (vo)[_h][_i] = (unsigned)_row * (unsigned)(g.lda * 2) + (unsigned)(CA[_i] * 2); } } while (0)
    Unit cur, nxt; int ui = 0;
    if (!S.next(0, cur)) return;
    f32x4 acc[2][2][4][2];
#pragma unroll
    for (int a = 0; a < 2; ++a)
#pragma unroll
        for (int b = 0; b < 2; ++b)
#pragma unroll
            for (int m = 0; m < 4; ++m)
#pragma unroll
                for (int n = 0; n < 2; ++n) acc[a][b][m][n] = (f32x4){0.f, 0.f, 0.f, 0.f};
    bf16x8 At[4][2], B0[2][2], B1[2][2];
    unsigned cvo[2][2], nvo[2][2];
    if constexpr (GATHER) { PG8_VOA(cvo, cur); PG8_VOA(nvo, cur); }
    const char* cA = (const char*)g.A + (GATHER ? (size_t)0 : (size_t)cur.pm * tstepA); const char* cB = (const char*)g.Bt + (size_t)cur.pn * tstepB;
    PG8_STAGEB(PG8_SB(0, 0), cB); PG8_STAGEB(PG8_SB(0, 1), cB + hstepB); PG8_STAGEA(PG8_SA(0, 0), cA, false, 0); PG8_STAGEA(PG8_SA(0, 1), cA, false, 1);
    if (wr == 1) PG8_BAR;
    PG8_WAIT_V(2); PG8_BAR;
    PG8_STAGEB(PG8_SB(1, 0), cB + kstep); PG8_STAGEA(PG8_SA(1, 0), cA + kstep, false, 0); PG8_STAGEB(PG8_SB(1, 1), cB + hstepB + kstep);
    PG8_WAIT_V(6); PG8_BAR;
    for (;;) {
        const bool has_next = S.next(ui + 1, nxt);
        if constexpr (GATHER) { if (has_next) { PG8_VOA(nvo, nxt); } }
        const char* nA = (GATHER || !has_next) ? cA : (const char*)g.A + (size_t)nxt.pm * tstepA;
        const char* nB = has_next ? (const char*)g.Bt + (size_t)nxt.pn * tstepB : cB;
#pragma nounroll
        for (int t = 0; t < nt; t += 2) {
            const bool last = (t == nt - 2);
            const char* a1 = cA + (size_t)(t + 1) * kstep;
            const char* a2 = last ? nA : cA + (size_t)(t + 2) * kstep; const char* b2 = last ? nB : cB + (size_t)(t + 2) * kstep;
            const char* a3 = a2 + kstep; const char* b3 = b2 + kstep;
            PG8_LDB(B0, 0, 0); PG8_LDB(B1, 0, 1); PG8_SCHED; PG8_LDA(At, 0, 0); PG8_STAGEA(PG8_SA(1, 1), a1, false, 1);
            PG8_WAIT_V(8); PG8_WAIT_L(0); PG8_BAR; PG8_MMA(0, 0, At, B0); PG8_MMA(0, 1, At, B1); PG8_BAR; PG8_SCHED;
            PG8_LDA(At, 0, 1); PG8_STAGEB(PG8_SB(0, 0), b2); PG8_STAGEB(PG8_SB(0, 1), b2 + hstepB); PG8_STAGEA(PG8_SA(0, 0), a2, last, 0);
            PG8_WAIT_V(8); PG8_WAIT_L(0); PG8_BAR; PG8_MMA(1, 0, At, B0); PG8_MMA(1, 1, At, B1); PG8_BAR; PG8_SCHED;
            PG8_LDB(B0, 1, 0); PG8_LDB(B1, 1, 1); PG8_SCHED; PG8_LDA(At, 1, 0); PG8_STAGEA(PG8_SA(0, 1), a2, last, 1);
            PG8_WAIT_V(8); PG8_WAIT_L(0); PG8_BAR; PG8_MMA(0, 0, At, B0); PG8_MMA(0, 1, At, B1); PG8_BAR; PG8_SCHED;
            PG8_LDA(At, 1, 1); PG8_STAGEB(PG8_SB(1, 0), b3); PG8_STAGEB(PG8_SB(1, 1), b3 + hstepB); PG8_STAGEA(PG8_SA(1, 0), a3, last, 0);
            PG8_WAIT_V(8); PG8_WAIT_L(0); PG8_BAR; PG8_MMA(1, 0, At, B0); PG8_MMA(1, 1, At, B1); PG8_BAR; PG8_SCHED;
        }
        if constexpr (ALIGN_EPI) { if (wr == 0) PG8_BAR; }
        E(acc, cur, wr, wc, fr, fq);
        if (!has_next) break;
#pragma unroll
        for (int a = 0; a < 2; ++a)
#pragma unroll
            for (int b = 0; b < 2; ++b)
#pragma unroll
                for (int m = 0; m < 4; ++m)
#pragma unroll
                    for (int n = 0; n < 2; ++n) acc[a][b][m][n] = (f32x4){0.f, 0.f, 0.f, 0.f};
        cur = nxt; cA = nA; cB = nB; ++ui;
        if constexpr (GATHER) {
#pragma unroll
            for (int _h = 0; _h < 2; ++_h)
#pragma unroll
                for (int _i = 0; _i < 2; ++_i) cvo[_h][_i] = nvo[_h][_i]; }
        if constexpr (ALIGN_EPI) { if (wr == 1) PG8_BAR; }
    }
    PG8_WAIT_V(0);
    if constexpr (!ALIGN_EPI) { if (wr == 0) PG8_BAR; }
    PG8_BAR;
#undef PG8_SA
#undef PG8_SB
#undef PG8_STAGEA
#undef PG8_STAGEB
#undef PG8_LDA
#undef PG8_LDB
#undef PG8_MMA
#undef PG8_WAIT_V
#undef PG8_WAIT_L
#undef PG8_BAR
#undef PG8_SCHED
#undef PG8_VOA
}

template <class Epi, class Sched, bool GATHER>
__device__ __forceinline__ void gemm_phase_naive(const Gemm g, const Sched& S, const Epi& E) {
    const int tid = threadIdx.x, wid = tid >> 6, lane = tid & 63, wr = wid >> 2, wc = wid & 3, fr = lane & 15, fq = lane >> 4;
    Unit u;
    for (int ui = 0; S.next(ui, u); ++ui) {
        f32x4 acc[2][2][4][2];
#pragma unroll
        for (int a = 0; a < 2; ++a)
#pragma unroll
            for (int b = 0; b < 2; ++b)
#pragma unroll
                for (int m = 0; m < 4; ++m)
#pragma unroll
                    for (int n = 0; n < 2; ++n) acc[a][b][m][n] = (f32x4){0.f, 0.f, 0.f, 0.f};
        const bf16* arow[2][4];
#pragma unroll
        for (int ai = 0; ai < 2; ++ai)
#pragma unroll
            for (int m = 0; m < 4; ++m) { int r = u.pm * BM + ai * HALF + wr * 64 + m * 16 + fr; if (GATHER) { r = g.gidx[r]; r = r < 0 ? 0 : r; } arow[ai][m] = g.A + (size_t)r * g.lda; }
        for (int k = 0; k < g.K; k += 4) {
            float av[2][4][4];
#pragma unroll
            for (int ai = 0; ai < 2; ++ai)
#pragma unroll
                for (int m = 0; m < 4; ++m) { const u32x2 w = *(const u32x2*)(arow[ai][m] + k); av[ai][m][0] = bflo(w.x); av[ai][m][1] = bfhi(w.x); av[ai][m][2] = bflo(w.y); av[ai][m][3] = bfhi(w.y); }
#pragma unroll
            for (int bj = 0; bj < 2; ++bj)
#pragma unroll
                for (int n = 0; n < 2; ++n)
#pragma unroll
                    for (int e = 0; e < 4; ++e) {
                        const int col = u.pn * BM + bj * HALF + wc * 32 + (Epi::PERM ? (8 * fq + 4 * n) : (16 * n + 4 * fq)) + e;
                        const u32x2 w = *(const u32x2*)(g.Bt + (size_t)col * g.ldb + k);
                        const float b0 = bflo(w.x), b1 = bfhi(w.x), b2 = bflo(w.y), b3 = bfhi(w.y);
#pragma unroll
                        for (int ai = 0; ai < 2; ++ai)
#pragma unroll
                            for (int m = 0; m < 4; ++m) acc[ai][bj][m][n][e] += av[ai][m][0] * b0 + av[ai][m][1] * b1 + av[ai][m][2] * b2 + av[ai][m][3] * b3;
                    }
        }
        E(acc, u, wr, wc, fr, fq);
    }
    VM_WAIT(); __syncthreads();
}
}
namespace g128 {
using pg8::lds_byte; using pg8::stage_rc; using pg8::HTB; using pg8::BK;
struct Seg { const bf16* A; const bf16* B; int lda, ldb, nt; };
typedef f32x4 acc_t[2][4][2];

template <class Prog>
__device__ __forceinline__ void stream(LAS unsigned char* lds, Prog& P, int nunits, int first, int stride) {
    int tid = my_tid(); asm volatile("" : "+v"(tid));
    const int wid = __builtin_amdgcn_readfirstlane(tid >> 6), lane = tid & 63, wr = wid >> 2, wc = wid & 3, fr = lane & 15, fq = lane >> 4;
    int RA[2], CA[2], RB[2];
#pragma unroll
    for (int i = 0; i < 2; ++i) { stage_rc(tid * 16 + i * 8192, RA[i], CA[i]); RB[i] = (RA[i] & ~31) + pg8::perm32(RA[i] & 31); }
    const unsigned ldsw = (unsigned)wid * 1024u;
    const int aoff = lds_byte(wr * 64 + fr, fq * 8), boff = lds_byte(wc * 32 + fr, fq * 8);
#define G_SA(b) ((b) * HTB)
#define G_SB(b, h) ((2 + (b) * 2 + (h)) * HTB)
#define G_STAGE(bufoff, base, ld, kbyte, RR) do { _Pragma("unroll") for (int _i = 0; _i < 2; ++_i) \
        __builtin_amdgcn_global_load_lds((const unsigned*)((const char*)(base) + (size_t)(kbyte) + (unsigned)(RR[_i] * (ld) + CA[_i]) * 2u), (LAS unsigned*)(lds + (bufoff) + ldsw + _i * 8192), 16, 0, 0); } while (0)
#define G_STAGE_A(b, S, j) G_STAGE(G_SA(b), (S).A, (S).lda, (j) * 128, RA)
#define G_STAGE_B(b, h, S, j) G_STAGE(G_SB(b, h), (const char*)(S).B + (size_t)(h) * 128 * (S).ldb * 2, (S).ldb, (j) * 128, RB)
#define G_LDA(dst, b) do { _Pragma("unroll") for (int m = 0; m < 4; ++m) _Pragma("unroll") for (int k = 0; k < 2; ++k) dst[m][k] = *(const LAS bf16x8*)(lds + G_SA(b) + aoff + m * 2048 + k * 1024); } while (0)
#define G_LDB(dst, b, h) do { _Pragma("unroll") for (int n = 0; n < 2; ++n) _Pragma("unroll") for (int k = 0; k < 2; ++k) dst[n][k] = *(const LAS bf16x8*)(lds + G_SB(b, h) + boff + n * 2048 + k * 1024); } while (0)
#define G_MMA(bj, At, Bt) do { __builtin_amdgcn_s_setprio(1); _Pragma("unroll") for (int m = 0; m < 4; ++m) _Pragma("unroll") for (int n = 0; n < 2; ++n) _Pragma("unroll") for (int k = 0; k < 2; ++k) \
        acc[bj][m][n] = __builtin_amdgcn_mfma_f32_16x16x32_bf16(Bt[n][k], At[m][k], acc[bj][m][n], 0, 0, 0); __builtin_amdgcn_s_setprio(0); } while (0)
#define G_WAIT_V(n) asm volatile("s_waitcnt vmcnt(" #n ")" ::: "memory")
#define G_WAIT_L(n) asm volatile("s_waitcnt lgkmcnt(" #n ")" ::: "memory")
#define G_BAR __builtin_amdgcn_s_barrier()
#define G_SCHED __builtin_amdgcn_sched_barrier(0)
    if (first >= nunits) return;
    P.reset();
    int ucur = first, scur = 0;
    Seg cur, nxt;
    P.seg(ucur, scur, cur);
    acc_t acc;
    P.init(ucur, scur, acc, wr, wc, fr, fq);
    bf16x8 At[4][2], B0[2][2], B1[2][2];
    G_STAGE_B(0, 0, cur, 0); G_STAGE_A(0, cur, 0); G_STAGE_B(0, 1, cur, 0);
    if (wr == 1) G_BAR;
    G_WAIT_V(2); G_BAR;
    G_STAGE_A(1, cur, 1); G_STAGE_B(1, 0, cur, 1);
    G_WAIT_V(4); G_BAR;
#define G_TILE(t_, b_) do { const bool n1_ = ((t_) + 1 >= nt), n2_ = ((t_) + 2 >= nt); const int j1_ = n1_ ? ((t_) + 1 - nt) : ((t_) + 1), j2_ = n2_ ? ((t_) + 2 - nt) : ((t_) + 2); \
        G_LDB(B0, b_, 0); G_SCHED; G_LDA(At, b_); \
        if (n1_) G_STAGE_B((b_) ^ 1, 1, nxt, j1_); else G_STAGE_B((b_) ^ 1, 1, cur, j1_); \
        G_WAIT_V(6); G_WAIT_L(0); G_BAR; G_MMA(0, At, B0); G_BAR; G_SCHED; \
        G_LDB(B1, b_, 1); \
        if (n2_) { G_STAGE_A(b_, nxt, j2_); G_STAGE_B(b_, 0, nxt, j2_); } else { G_STAGE_A(b_, cur, j2_); G_STAGE_B(b_, 0, cur, j2_); } \
        G_WAIT_V(6); G_WAIT_L(0); G_BAR; G_MMA(1, At, B1); G_BAR; G_SCHED; } while (0)
    for (;;) {
        int unxt = ucur, snxt = scur + 1; bool more = true;
        if (snxt == Prog::NSEG) { snxt = 0; unxt = ucur + stride; if (unxt >= nunits) { more = false; unxt = ucur; snxt = scur; } }
        P.seg(unxt, snxt, nxt);
        int ntq = cur.nt; asm volatile("" : "+s"(ntq)); const int nt = ntq;
#pragma nounroll
        for (int t = 0; t < nt; t += 2) { G_TILE(t, 0); G_TILE(t + 1, 1); }
        P.done(ucur, scur, acc, wr, wc, fr, fq);
        if (!more) break;
        P.init(unxt, snxt, acc, wr, wc, fr, fq);
        ucur = unxt; scur = snxt; cur = nxt;
    }
    G_WAIT_V(0);
    if (wr == 0) G_BAR;
    G_BAR;
#undef G_SA
#undef G_SB
#undef G_STAGE
#undef G_STAGE_A
#undef G_STAGE_B
#undef G_LDA
#undef G_LDB
#undef G_MMA
#undef G_WAIT_V
#undef G_WAIT_L
#undef G_BAR
#undef G_SCHED
#undef G_TILE
}

struct MergeProg {
    static constexpr int NSEG = 8;
    const bf16* Hn; const bf16* zin; const bf16* wg; const bf16* wb; const float* bg; bf16* M;
    __device__ __forceinline__ void reset() {
#pragma unroll
        for (int a = 0; a < 2; ++a)
#pragma unroll
            for (int b = 0; b < 4; ++b)
#pragma unroll
                for (int c = 0; c < 2; ++c) { g[a][b][c] = (u32x2){0u, 0u}; macc[a][b][c] = (u32x2){0u, 0u}; } }
    u32x2 g[2][4][2]; u32x2 macc[2][4][2];
    __device__ __forceinline__ void seg(int u, int s, Seg& S) const {
        const int pm = u >> 2, pn = u & 3, k = s >> 1;
        if ((s & 1) == 0) { S.A = Hn + (size_t)pm * 128 * D; S.lda = D; S.B = wg + ((size_t)k * D + pn * 256) * D; S.ldb = D; S.nt = D / 64; }
        else { const int ycol = (k == 0) ? ZC_U : (k == 1) ? ZC_FQ : (k == 2) ? ZC_CQ : ZC_DQ;
               S.A = zin + (size_t)pm * 128 * ZP + ycol; S.lda = ZP; S.B = wb + ((size_t)k * D + pn * 256) * 256; S.ldb = 256; S.nt = 4; }
    }
    __device__ __forceinline__ void init(int u, int s, acc_t& acc, int wr, int wc, int fr, int fq) {
        const int pn = u & 3, k = s >> 1;
        if ((s & 1) == 0) {
#pragma unroll
            for (int bj = 0; bj < 2; ++bj)
#pragma unroll
                for (int n = 0; n < 2; ++n) { const f32x4 bv = *(const f32x4*)(bg + (size_t)k * D + pn * 256 + bj * 128 + wc * 32 + 8 * fq + 4 * n);
#pragma unroll
                    for (int m = 0; m < 4; ++m) acc[bj][m][n] = bv; }
            if (s == 0) {
#pragma unroll
                for (int bj = 0; bj < 2; ++bj)
#pragma unroll
                    for (int m = 0; m < 4; ++m)
#pragma unroll
                        for (int n = 0; n < 2; ++n) macc[bj][m][n] = (u32x2){0u, 0u}; }
        } else {
#pragma unroll
            for (int bj = 0; bj < 2; ++bj)
#pragma unroll
                for (int m = 0; m < 4; ++m)
#pragma unroll
                    for (int n = 0; n < 2; ++n) acc[bj][m][n] = (f32x4){0.f, 0.f, 0.f, 0.f};
        }
    }
    __device__ __forceinline__ void done(int u, int s, const acc_t& acc, int wr, int wc, int fr, int fq) {
        if ((s & 1) == 0) {
#pragma unroll
            for (int bj = 0; bj < 2; ++bj)
#pragma unroll
                for (int m = 0; m < 4; ++m)
#pragma unroll
                    for (int n = 0; n < 2; ++n) { const f32x4 a = acc[bj][m][n]; u32x2 w; w.x = pk2(sigmoidf_(a[0]), sigmoidf_(a[1])); w.y = pk2(sigmoidf_(a[2]), sigmoidf_(a[3])); g[bj][m][n] = w; }
        } else {
#pragma unroll
            for (int bj = 0; bj < 2; ++bj)
#pragma unroll
                for (int m = 0; m < 4; ++m)
#pragma unroll
                    for (int n = 0; n < 2; ++n) { const u32x2 w = g[bj][m][n], q = macc[bj][m][n]; const f32x4 v = (f32x4){bflo(q.x), bfhi(q.x), bflo(q.y), bfhi(q.y)} + (f32x4){bflo(w.x), bfhi(w.x), bflo(w.y), bfhi(w.y)} * acc[bj][m][n];
                        u32x2 r; r.x = pk2(v[0], v[1]); r.y = pk2(v[2], v[3]); macc[bj][m][n] = r; }
            if (s == NSEG - 1) { const int pm = u >> 2, pn = u & 3;
#pragma unroll
                for (int m = 0; m < 4; ++m) { bf16* rp = M + (size_t)(pm * 128 + wr * 64 + m * 16 + fr) * D + pn * 256 + wc * 32 + 8 * fq;
#pragma unroll
                    for (int bj = 0; bj < 2; ++bj) *(u32x4*)(rp + bj * 128) = (u32x4){macc[bj][m][0].x, macc[bj][m][0].y, macc[bj][m][1].x, macc[bj][m][1].y}; } }
        }
    }
};

struct PleProg {
    static constexpr int NSEG = 8;
    const bf16* pbf; const bf16* hp; const bf16* wup; const bf16* wpg; bf16* x;
    u32x2 uu[2][4][2];
    __device__ __forceinline__ void reset() {
#pragma unroll
        for (int a = 0; a < 2; ++a)
#pragma unroll
            for (int b = 0; b < 4; ++b)
#pragma unroll
                for (int c = 0; c < 2; ++c) uu[a][b][c] = (u32x2){0u, 0u}; }
    __device__ __forceinline__ void seg(int u, int s, Seg& S) const {
        const int pn = s >> 1;
        if ((s & 1) == 0) { S.A = pbf + (size_t)u * 128 * 256; S.lda = 256; S.B = wup + (size_t)pn * 256 * 256; S.ldb = 256; S.nt = 4; }
        else { S.A = hp + (size_t)u * 128 * D; S.lda = D; S.B = wpg + (size_t)pn * 256 * D; S.ldb = D; S.nt = D / 64; }
    }
    __device__ __forceinline__ void init(int u, int s, acc_t& acc, int wr, int wc, int fr, int fq) {
#pragma unroll
        for (int bj = 0; bj < 2; ++bj)
#pragma unroll
            for (int m = 0; m < 4; ++m)
#pragma unroll
                for (int n = 0; n < 2; ++n) acc[bj][m][n] = (f32x4){0.f, 0.f, 0.f, 0.f};
    }
    __device__ __forceinline__ void done(int u, int s, const acc_t& acc, int wr, int wc, int fr, int fq) {
        if ((s & 1) == 0) {
#pragma unroll
            for (int bj = 0; bj < 2; ++bj)
#pragma unroll
                for (int m = 0; m < 4; ++m)
#pragma unroll
                    for (int n = 0; n < 2; ++n) { const f32x4 a = acc[bj][m][n]; u32x2 w; w.x = pk2(a[0], a[1]); w.y = pk2(a[2], a[3]); uu[bj][m][n] = w; }
        } else { const int pn = s >> 1;
#pragma unroll
            for (int m = 0; m < 4; ++m) { bf16* rp = x + (size_t)(u * 128 + wr * 64 + m * 16 + fr) * D + pn * 256 + wc * 32 + 8 * fq; u32x4 xv[2];
#pragma unroll
                for (int bj = 0; bj < 2; ++bj) xv[bj] = *(const u32x4*)(rp + bj * 128);
#pragma unroll
                for (int bj = 0; bj < 2; ++bj) { const u32x4 xw = xv[bj]; f32x4 r[2];
#pragma unroll
                    for (int n = 0; n < 2; ++n) { const u32x2 w = uu[bj][m][n]; f32x4 v = acc[bj][m][n];
                        v[0] = sigmoidf_(v[0]); v[1] = sigmoidf_(v[1]); v[2] = sigmoidf_(v[2]); v[3] = sigmoidf_(v[3]);
                        const f32x4 xo = n == 0 ? (f32x4){bflo(xw.x), bfhi(xw.x), bflo(xw.y), bfhi(xw.y)} : (f32x4){bflo(xw.z), bfhi(xw.z), bflo(xw.w), bfhi(xw.w)};
                        r[n] = xo + (f32x4){bflo(w.x), bfhi(w.x), bflo(w.y), bfhi(w.y)} * v; }
                    *(u32x4*)(rp + bj * 128) = (u32x4){pk2(r[0][0], r[0][1]), pk2(r[0][2], r[0][3]), pk2(r[1][0], r[1][1]), pk2(r[1][2], r[1][3])}; } } }
    }
};
}
namespace epi {
using pg8::Unit; using pg8::BM; using pg8::HALF;
__device__ __forceinline__ void epi_fence() { asm volatile("" ::: "memory"); }
#define EPI_FENCE epi_fence()
#define EPI_LOOP_ROWS for (int ai = 0; ai < 2; ++ai) _Pragma("unroll") for (int m = 0; m < 4; ++m)
#define EPI_LOOP_COLS for (int bj = 0; bj < 2; ++bj) _Pragma("unroll") for (int n = 0; n < 2; ++n)
#define EPI_ROW (u.pm * BM + ai * HALF + wr * 64 + m * 16 + fr)
#define EPI_COLT (bj * HALF + wc * 32 + n * 16 + 4 * fq)
typedef f32x4 acc_t[2][2][4][2];
#define EPI_C8(bj_) ((bj_) * HALF + wc * 32 + 8 * fq)
__device__ __forceinline__ u32x4 pack8(f32x4 a, f32x4 b) { return (u32x4){pk2(a[0], a[1]), pk2(a[2], a[3]), pk2(b[0], b[1]), pk2(b[2], b[3])}; }
__device__ __forceinline__ u32x2 pack4(f32x4 v) { u32x2 w; w.x = pk2(v[0], v[1]); w.y = pk2(v[2], v[3]); return w; }
__device__ __forceinline__ f32x4 unpack4(u32x2 w) { return (f32x4){bflo(w.x), bfhi(w.x), bflo(w.y), bfhi(w.y)}; }

struct EpiStore {
    static constexpr bool PERM = true;
    bf16* O; int ldc; int pn0;
    __device__ __forceinline__ void operator()(const acc_t& acc, const Unit& u, int wr, int wc, int fr, int fq) const {
#pragma unroll
        EPI_LOOP_ROWS { bf16* rp = O + (size_t)EPI_ROW * ldc + (u.pn - pn0) * BM + wc * 32 + 8 * fq;
#pragma unroll
            for (int bj = 0; bj < 2; ++bj) { const u32x2 lo = pack4(acc[ai][bj][m][0]), hi = pack4(acc[ai][bj][m][1]); *(u32x4*)(rp + bj * HALF) = (u32x4){lo.x, lo.y, hi.x, hi.y}; } }
    }
};
struct EpiRowScale {
    static constexpr bool PERM = true;
    bf16* O; int ldc; const float* rs;
    __device__ __forceinline__ void operator()(const acc_t& acc, const Unit& u, int wr, int wc, int fr, int fq) const {
        float sv[2][4];
#pragma unroll
        EPI_LOOP_ROWS sv[ai][m] = rs[EPI_ROW];
#pragma unroll
        EPI_LOOP_ROWS { const int row = EPI_ROW; const float s = sv[ai][m]; bf16* rp = O + (size_t)row * ldc + u.pn * BM;
#pragma unroll
            for (int bj = 0; bj < 2; ++bj) *(u32x4*)(rp + EPI_C8(bj)) = pack8(acc[ai][bj][m][0] * s, acc[ai][bj][m][1] * s); }
    }
};
struct EpiMlaQ {
    static constexpr bool PERM = false;
    bf16* O; const float* rs; const float* cosT; const float* sinT;
    __device__ __forceinline__ void operator()(const acc_t& acc, const Unit& u, int wr, int wc, int fr, int fq) const {
        float sv[2][4]; f32x4 csv[2], snv[2];
#pragma unroll
        EPI_LOOP_ROWS sv[ai][m] = rs[EPI_ROW];
        { const int row = u.pm * BM + wr * 64 + fr; csv[0] = *(const f32x4*)(cosT + (size_t)row * 16 + 4 * fq); snv[0] = *(const f32x4*)(sinT + (size_t)row * 16 + 4 * fq); }
#pragma unroll
        for (int it = 0; it < 8; ++it) { const int ai = it >> 2, m = it & 3;
            if (it + 1 < 8) { const int row = u.pm * BM + ((it + 1) >> 2) * HALF + wr * 64 + ((it + 1) & 3) * 16 + fr;
                csv[(it + 1) & 1] = *(const f32x4*)(cosT + (size_t)row * 16 + 4 * fq); snv[(it + 1) & 1] = *(const f32x4*)(sinT + (size_t)row * 16 + 4 * fq); }
            const int row = EPI_ROW; const float s = sv[ai][m]; bf16* rp = O + (size_t)row * 512 + u.pn * BM;
            const f32x4 cs = csv[it & 1], sn = snv[it & 1];
#pragma unroll
            for (int bj = 0; bj < 2; ++bj) { const int grp = u.pn * 8 + bj * 4 + wc;
                f32x4 t1 = acc[ai][bj][m][0] * s, t2 = acc[ai][bj][m][1] * s;
                if (grp % 3 == 2) { const f32x4 a = t1 * cs - t2 * sn, b = t2 * cs + t1 * sn; t1 = a; t2 = b; }
                *(u32x2*)(rp + bj * HALF + wc * 32 + 4 * fq) = pack4(t1); *(u32x2*)(rp + bj * HALF + wc * 32 + 16 + 4 * fq) = pack4(t2); } }
    }
};
struct EpiGate {
    static constexpr bool PERM = false;
    bf16* G; const float* bias;
    __device__ __forceinline__ void operator()(const acc_t& acc, const Unit& u, int wr, int wc, int fr, int fq) const {
        f32x4 bv[2][2];
#pragma unroll
        EPI_LOOP_COLS bv[bj][n] = *(const f32x4*)(bias + u.pn * BM + EPI_COLT);
#pragma unroll
        EPI_LOOP_ROWS { bf16* rp = G + (size_t)EPI_ROW * D + u.pn * BM;
#pragma unroll
            EPI_LOOP_COLS { f32x4 v = acc[ai][bj][m][n] + bv[bj][n];
                v[0] = sigmoidf_(v[0]); v[1] = sigmoidf_(v[1]); v[2] = sigmoidf_(v[2]); v[3] = sigmoidf_(v[3]);
                *(u32x2*)(rp + EPI_COLT) = pack4(v); } }
    }
};
#define EPI_IT_ROW(it_) (u.pm * BM + ((it_) >> 2) * HALF + wr * 64 + ((it_) & 3) * 16 + fr)
#define EPI_C4(c_) (((c_) >> 1) * HALF + wc * 32 + ((c_) & 1) * 16 + 4 * fq)
struct EpiMerge {
    static constexpr bool PERM = false;
    const bf16* G; bf16* M; int first;
    __device__ __forceinline__ void operator()(const acc_t& acc, const Unit& u, int wr, int wc, int fr, int fq) const {
        u32x2 gv[2][4], mv[2][4];
#define EPI_LD(it_) do { const size_t ro_ = (size_t)EPI_IT_ROW(it_) * D + u.pn * BM; _Pragma("unroll") for (int c = 0; c < 4; ++c) { gv[(it_) & 1][c] = *(const u32x2*)(G + ro_ + EPI_C4(c)); \
            mv[(it_) & 1][c] = first ? (u32x2){0u, 0u} : *(const u32x2*)(M + ro_ + EPI_C4(c)); } } while (0)
        EPI_LD(0);
#pragma unroll
        for (int it = 0; it < 8; ++it) { if (it + 1 < 8) EPI_LD(it + 1);
            const size_t ro = (size_t)EPI_IT_ROW(it) * D + u.pn * BM;
#pragma unroll
            for (int c = 0; c < 4; ++c) { const f32x4 v = unpack4(gv[it & 1][c]) * acc[it >> 2][c >> 1][it & 3][c & 1] + unpack4(mv[it & 1][c]); *(u32x2*)(M + ro + EPI_C4(c)) = pack4(v); } }
#undef EPI_LD
    }
};
struct EpiRes {
    static constexpr bool PERM = true;
    XSrc xin; bf16* xout;
    __device__ __forceinline__ void operator()(const acc_t& acc, const Unit& u, int wr, int wc, int fr, int fq) const {
        f32x4 xv[2][2][2];
#define EPI_LD(it_) do { const size_t ro_ = (size_t)EPI_IT_ROW(it_) * D + u.pn * BM; _Pragma("unroll") for (int bj = 0; bj < 2; ++bj) { \
            if (xin.f) { xv[(it_) & 1][bj][0] = *(const f32x4*)(xin.f + ro_ + EPI_C8(bj)); xv[(it_) & 1][bj][1] = *(const f32x4*)(xin.f + ro_ + EPI_C8(bj) + 4); } \
            else { const u32x4 w_ = *(const u32x4*)(xin.b + ro_ + EPI_C8(bj)); xv[(it_) & 1][bj][0] = (f32x4){bflo(w_.x), bfhi(w_.x), bflo(w_.y), bfhi(w_.y)}; xv[(it_) & 1][bj][1] = (f32x4){bflo(w_.z), bfhi(w_.z), bflo(w_.w), bfhi(w_.w)}; } } } while (0)
        EPI_LD(0);
#pragma unroll
        for (int it = 0; it < 8; ++it) { if (it + 1 < 8) EPI_LD(it + 1);
            const size_t ro = (size_t)EPI_IT_ROW(it) * D + u.pn * BM;
#pragma unroll
            for (int bj = 0; bj < 2; ++bj) *(u32x4*)(xout + ro + EPI_C8(bj)) = pack8(xv[it & 1][bj][0] + acc[it >> 2][bj][it & 3][0], xv[it & 1][bj][1] + acc[it >> 2][bj][it & 3][1]); }
#undef EPI_LD
    }
};
struct EpiPle {
    static constexpr bool PERM = false;
    const bf16* U; float* x;
    __device__ __forceinline__ void operator()(const acc_t& acc, const Unit& u, int wr, int wc, int fr, int fq) const {
        f32x4 xv[2][4]; u32x2 uv[2][4];
#define EPI_LD(it_) do { const size_t ro_ = (size_t)EPI_IT_ROW(it_) * D + u.pn * BM; _Pragma("unroll") for (int c = 0; c < 4; ++c) { xv[(it_) & 1][c] = *(const f32x4*)(x + ro_ + EPI_C4(c)); uv[(it_) & 1][c] = *(const u32x2*)(U + ro_ + EPI_C4(c)); } } while (0)
        EPI_LD(0);
#pragma unroll
        for (int it = 0; it < 8; ++it) { if (it + 1 < 8) EPI_LD(it + 1);
            const size_t ro = (size_t)EPI_IT_ROW(it) * D + u.pn * BM;
#pragma unroll
            for (int c = 0; c < 4; ++c) { f32x4 v = acc[it >> 2][c >> 1][it & 3][c & 1];
                v[0] = sigmoidf_(v[0]); v[1] = sigmoidf_(v[1]); v[2] = sigmoidf_(v[2]); v[3] = sigmoidf_(v[3]);
                *(f32x4*)(x + ro + EPI_C4(c)) = xv[it & 1][c] + unpack4(uv[it & 1][c]) * v; } }
#undef EPI_LD
    }
};
struct EpiSwiglu {
    static constexpr bool PERM = true;
    bf16* O; int ldc; int npt;
    __device__ __forceinline__ void operator()(const acc_t& acc, const Unit& u, int wr, int wc, int fr, int fq) const {
        const int ct = (u.pn % npt) * HALF;
#pragma unroll
        EPI_LOOP_ROWS { bf16* rp = O + (size_t)EPI_ROW * ldc + ct + wc * 32 + 8 * fq; u32x2 w[2];
#pragma unroll
            for (int n = 0; n < 2; ++n) { const f32x4 a = acc[ai][0][m][n], b = acc[ai][1][m][n]; f32x4 v;
#pragma unroll
                for (int e = 0; e < 4; ++e) v[e] = a[e] * sigmoidf_(a[e]) * b[e];
                w[n] = pack4(v); }
            *(u32x4*)rp = (u32x4){w[0].x, w[0].y, w[1].x, w[1].y}; }
    }
};
struct EpiGlu {
    static constexpr bool PERM = true;
    bf16* Y; int ldc;
    __device__ __forceinline__ void operator()(const acc_t& acc, const Unit& u, int wr, int wc, int fr, int fq) const {
        u32x4 yv[2][2];
#define EPI_LD(it_) do { const bf16* rp_ = Y + (size_t)EPI_IT_ROW(it_) * ldc + u.pn * BM; _Pragma("unroll") for (int bj = 0; bj < 2; ++bj) yv[(it_) & 1][bj] = *(const u32x4*)(rp_ + EPI_C8(bj)); } while (0)
        EPI_LD(0);
#pragma unroll
        for (int it = 0; it < 8; ++it) { if (it + 1 < 8) EPI_LD(it + 1);
            bf16* rp = Y + (size_t)EPI_IT_ROW(it) * ldc + u.pn * BM;
#pragma unroll
            for (int bj = 0; bj < 2; ++bj) { const u32x4 w = yv[it & 1][bj]; f32x4 a = acc[it >> 2][bj][it & 3][0], b = acc[it >> 2][bj][it & 3][1];
                a[0] = bflo(w.x) * sigmoidf_(a[0]); a[1] = bfhi(w.x) * sigmoidf_(a[1]); a[2] = bflo(w.y) * sigmoidf_(a[2]); a[3] = bfhi(w.y) * sigmoidf_(a[3]);
                b[0] = bflo(w.z) * sigmoidf_(b[0]); b[1] = bfhi(w.z) * sigmoidf_(b[1]); b[2] = bflo(w.w) * sigmoidf_(b[2]); b[3] = bfhi(w.w) * sigmoidf_(b[3]);
                *(u32x4*)(rp + EPI_C8(bj)) = pack8(a, b); } }
#undef EPI_LD
    }
};
struct EpiMoeDown {
    static constexpr bool PERM = true;
    bf16* Y; const float* slot_gate;
    __device__ __forceinline__ void operator()(const acc_t& acc, const Unit& u, int wr, int wc, int fr, int fq) const {
        const int ct = (u.pn & 3) * BM;
        float gv[2][4];
#pragma unroll
        EPI_LOOP_ROWS gv[ai][m] = slot_gate[EPI_ROW];
#pragma unroll
        EPI_LOOP_ROWS { const int row = EPI_ROW; const float gt = gv[ai][m]; bf16* rp = Y + (size_t)row * D + ct;
#pragma unroll
            for (int bj = 0; bj < 2; ++bj) *(u32x4*)(rp + EPI_C8(bj)) = pack8(acc[ai][bj][m][0] * gt, acc[ai][bj][m][1] * gt); }
    }
};
}
namespace att {
constexpr int MODE_FOX = 0, MODE_MLA = 1, MODE_BAND = 2;
constexpr float LOG2E = 1.4426950408889634f;
struct Tensors {
    const bf16* Q; int ldq;
    const bf16* K; int ldk;
    const bf16* K2;
    const bf16* V; int ldv;
    bf16* O; int ldo;
    const float* cdec;
    const float* relb;
    int qhs, khs, vhs, ohs;
    const unsigned* qmax; const unsigned* kmax;
};
template <int DQK> struct Lay { static constexpr int KS = DQK * 2 + 16, KB = 64 * KS, VB = 64 * 128, CB = 256, BUF = KB + VB + CB; };
constexpr int ATT_LDS_TAB = 2 * Lay<96>::BUF;
constexpr int ATT_LDS_BYTES = ATT_LDS_TAB + 832 * 4;
__device__ __forceinline__ int crow(int r, int hi) { return (r & 3) + 8 * (r >> 2) + 4 * hi; }
typedef short v4i16_t __attribute__((ext_vector_type(4)));
__device__ __forceinline__ s16x4 vtr(const LAS unsigned char* p) { return __builtin_bit_cast(s16x4, __builtin_amdgcn_ds_read_tr16_b64_v4i16((LAS v4i16_t*)p)); }

template <int MODE>
__device__ __forceinline__ void attn_unit(const Tensors& T, int b, int h, int qb, LAS unsigned char* lds) {
    constexpr int DQK = (MODE == MODE_MLA) ? 96 : 64, NKS = DQK / 16;
    typedef Lay<DQK> LY;
    int tid = my_tid(); asm volatile("" : "+v"(tid));
    const int lane = tid & 63, r32 = lane & 31, hi = lane >> 5; const int wid = __builtin_amdgcn_readfirstlane(tid >> 6);
    const int rowb = b * SEQ, q0 = qb * 256;
    const float sc2 = ((MODE == MODE_MLA) ? 0.10206207261596575f : 0.125f) * LOG2E;
    const int cw = 4 * qb + (wid >> 1);
    const int t_lo = (MODE == MODE_BAND) ? ((4 * qb - 8) > 0 ? (4 * qb - 8) : 0) : 0, t_hi = 4 * qb + 4;
    const int qrow = rowb + q0 + wid * 32 + r32;
    bf16x8 qf[NKS];
    { const bf16* qp = T.Q + (size_t)qrow * T.ldq + h * T.qhs + hi * 8;
#pragma unroll
      for (int ks = 0; ks < NKS; ++ks) qf[ks] = *(const bf16x8*)(qp + ks * 16); }
    float cq = 0.f; if (MODE == MODE_FOX) cq = T.cdec[(size_t)qrow * 4 + h];
    LAS float* tab = (LAS float*)(lds + ATT_LDS_TAB);
    if (MODE == MODE_BAND) { for (int i = tid; i < 832; i += NTHREADS) tab[i] = T.relb[h * 513 + (i < 512 ? i : 512)] * LOG2E; }
    u32x4 kreg0[2] = {}, kreg1[2] = {}, vreg[2] = {}; float creg[2] = {0.f, 0.f};
    const int srow = tid >> 3, sch = tid & 7;
#define ATT_KADDR(c_) (((c_) % 12 < 8) ? (const u32x4*)(T.K + (kr_ + (c_) / 12) * T.ldk + h * T.khs + ((c_) % 12) * 8) : (const u32x4*)(T.K2 + (kr_ + (c_) / 12) * 32 + ((c_) % 12 - 8) * 8))
#define ATT_LOAD_TILE(t_, r_) do { const size_t kr_ = (size_t)(rowb + (t_) * 64); \
        if (MODE == MODE_MLA) { kreg0[r_] = *ATT_KADDR(tid); if (tid < 256) kreg1[r_] = *ATT_KADDR(tid + 512); } \
        else { kreg0[r_] = *(const u32x4*)(T.K + (kr_ + srow) * T.ldk + h * T.khs + sch * 8); } \
        vreg[r_] = *(const u32x4*)(T.V + (kr_ + srow) * T.ldv + h * T.vhs + sch * 8); \
        if (MODE == MODE_FOX) { if (tid < 64) creg[r_] = T.cdec[(kr_ + tid) * 4 + h]; } } while (0)
#define ATT_STORE_TILE(buf_, r_) do { LAS unsigned char* base_ = lds + (buf_) * LY::BUF; \
        if (MODE == MODE_MLA) { *(LAS u32x4*)(base_ + (tid / 12) * LY::KS + (tid % 12) * 16) = kreg0[r_]; \
            if (tid < 256) *(LAS u32x4*)(base_ + ((tid + 512) / 12) * LY::KS + ((tid + 512) % 12) * 16) = kreg1[r_]; } \
        else { *(LAS u32x4*)(base_ + srow * LY::KS + sch * 16) = kreg0[r_]; } \
        *(LAS u32x4*)(base_ + LY::KB + srow * 128 + ((sch * 16) ^ (((srow >> 1) & 1) << 6))) = vreg[r_]; \
        if (MODE == MODE_FOX) { if (tid < 64) *(LAS float*)(base_ + LY::KB + LY::VB + tid * 4) = creg[r_]; } } while (0)
    float mrun = -INFINITY, lrun = 0.f;
    f32x16 o0 = {}, o1 = {};
    const int G = lane >> 4, qi = (lane & 15) >> 2, pi = lane & 3;
    const int vb0 = (4 * hi + qi) * 128 + 64 * (0 ^ (qi >> 1)) + 32 * (G & 1) + 8 * pi;
    const int vb1 = (4 * hi + qi) * 128 + 64 * (1 ^ (qi >> 1)) + 32 * (G & 1) + 8 * pi;
    int t_min = t_lo;
    if (MODE == MODE_FOX) {
        LAS int* tm = (LAS int*)(lds + ATT_LDS_TAB);
        if (tid == 0) tm[0] = t_hi - 1;
        __syncthreads();
        if (tid < t_hi) {
            const float q2 = __uint_as_float(T.qmax[(b * 4 + h) * 32 + qb]), k2 = __uint_as_float(T.kmax[b * 4 + h]);
            const float thr = 0.125f * sqrtf(q2) * 2.0f * sqrtf(k2) * 1.02f + 112.0f;
            const float cfirst = T.cdec[(size_t)(rowb + q0) * 4 + h], clast = T.cdec[(size_t)(rowb + tid * 64 + 63) * 4 + h];
            if (!(clast - cfirst > thr)) __hip_atomic_fetch_min(tm, tid, __ATOMIC_RELAXED, __HIP_MEMORY_SCOPE_WORKGROUP);
        }
        __syncthreads();
        t_min = tm[0];
    }
    const int n_t = t_hi - t_min;
#define ATT_TILE(i_) ((MODE == MODE_FOX) ? (t_hi - 1 - (i_)) : (t_min + (i_)))
    ATT_LOAD_TILE(ATT_TILE(0), 0); ATT_STORE_TILE(0, 0);
    if (n_t > 1) ATT_LOAD_TILE(ATT_TILE(1), 1);
    if (n_t > 2) ATT_LOAD_TILE(ATT_TILE(2), 0);
    __syncthreads();
    for (int it0 = 0; it0 < n_t; it0 += 2) {
#pragma unroll
      for (int half = 0; half < 2; ++half) { const int it = it0 + half; if (it < n_t) {
        const int t = ATT_TILE(it);
        const int buf = half;
        const bool active = (MODE == MODE_BAND) ? (t <= cw && t >= cw - 8) : (t <= cw);
        if (active) {
            const LAS unsigned char* kb = lds + buf * LY::BUF;
            const LAS unsigned char* vbuf = kb + LY::KB;
            f32x16 p0 = {}, p1 = {};
            bf16x8 ka[NKS], kc[NKS];
#pragma unroll
            for (int ks = 0; ks < NKS; ++ks) { ka[ks] = *(const LAS bf16x8*)(kb + r32 * LY::KS + (ks * 16 + hi * 8) * 2); kc[ks] = *(const LAS bf16x8*)(kb + (32 + r32) * LY::KS + (ks * 16 + hi * 8) * 2); }
            __builtin_amdgcn_sched_barrier(0);
#pragma unroll
            for (int ks = 0; ks < NKS; ++ks) { p0 = __builtin_amdgcn_mfma_f32_32x32x16_bf16(ka[ks], qf[ks], p0, 0, 0, 0); p1 = __builtin_amdgcn_mfma_f32_32x32x16_bf16(kc[ks], qf[ks], p1, 0, 0, 0); }
            s16x4 vl0[4], vh0[4], vl1[4], vh1[4];
#pragma unroll
            for (int s4 = 0; s4 < 4; ++s4) { vl0[s4] = vtr(vbuf + vb0 + s4 * 2048); vh0[s4] = vtr(vbuf + vb0 + s4 * 2048 + 1024); vl1[s4] = vtr(vbuf + vb1 + s4 * 2048); vh1[s4] = vtr(vbuf + vb1 + s4 * 2048 + 1024); }
            __builtin_amdgcn_sched_barrier(0);
            if (MODE == MODE_FOX) {
                const LAS float* cb = (const LAS float*)(vbuf + LY::VB);
                const float cq2 = cq * LOG2E;
#pragma unroll
                for (int a = 0; a < 4; ++a) {
                    const f32x4 c0 = *(const LAS f32x4*)(cb + 8 * a + 4 * hi), c1 = *(const LAS f32x4*)(cb + 32 + 8 * a + 4 * hi);
#pragma unroll
                    for (int e = 0; e < 4; ++e) { p0[4 * a + e] = p0[4 * a + e] * sc2 + (cq2 - c0[e] * LOG2E); p1[4 * a + e] = p1[4 * a + e] * sc2 + (cq2 - c1[e] * LOG2E); }
                }
                if (t == cw) { const int ql = 32 * (wid & 1) + r32;
#pragma unroll
                    for (int r = 0; r < 16; ++r) { const int kv = crow(r, hi); if (kv > ql) p0[r] = -INFINITY; if (kv + 32 > ql) p1[r] = -INFINITY; } }
            } else if (MODE == MODE_BAND) {
                const LAS float* bp = tab + ((q0 + wid * 32 + r32) - t * 64) + 256 - 4 * hi - 95;
#pragma unroll
                for (int r = 0; r < 16; ++r) { const int kvb = (r & 3) + 8 * (r >> 2);
                    p0[r] = p0[r] * sc2 + bp[95 - kvb]; p1[r] = p1[r] * sc2 + bp[63 - kvb]; }
            }
            float mx = fmaxf(p0[0], p1[0]);
#pragma unroll
            for (int r = 1; r < 16; ++r) mx = fmaxf(mx, fmaxf(p0[r], p1[r]));
            { auto rr = __builtin_amdgcn_permlane32_swap(__float_as_uint(mx), __float_as_uint(mx), false, false); mx = fmaxf(__uint_as_float(rr[0]), __uint_as_float(rr[1])); }
            if (MODE == MODE_MLA) mx *= sc2;
            const float mnew = fmaxf(mrun, mx);
            if (__any(mnew > mrun)) {
                const float alpha = __builtin_amdgcn_exp2f(mrun - mnew);
                lrun *= alpha;
#pragma unroll
                for (int r = 0; r < 16; ++r) { o0[r] *= alpha; o1[r] *= alpha; }
                mrun = mnew;
            }
            float rs = 0.f;
#pragma unroll
            for (int r = 0; r < 16; ++r) {
                if (MODE == MODE_MLA) { p0[r] = __builtin_amdgcn_exp2f(__builtin_fmaf(p0[r], sc2, -mrun)); p1[r] = __builtin_amdgcn_exp2f(__builtin_fmaf(p1[r], sc2, -mrun)); }
                else { p0[r] = __builtin_amdgcn_exp2f(p0[r] - mrun); p1[r] = __builtin_amdgcn_exp2f(p1[r] - mrun); }
                rs += p0[r] + p1[r]; }
            lrun += rs;
#pragma unroll
            for (int s4 = 0; s4 < 4; ++s4) {
                u32x4 pw;
                if (s4 < 2) { const int o = 8 * (s4 & 1); pw.x = pk2(p0[o], p0[o + 1]); pw.y = pk2(p0[o + 2], p0[o + 3]); pw.z = pk2(p0[o + 4], p0[o + 5]); pw.w = pk2(p0[o + 6], p0[o + 7]); }
                else        { const int o = 8 * (s4 & 1); pw.x = pk2(p1[o], p1[o + 1]); pw.y = pk2(p1[o + 2], p1[o + 3]); pw.z = pk2(p1[o + 4], p1[o + 5]); pw.w = pk2(p1[o + 6], p1[o + 7]); }
                const bf16x8 pf = __builtin_bit_cast(bf16x8, pw);
                const s16x4 l0 = vl0[s4], h0 = vh0[s4], l1 = vl1[s4], h1 = vh1[s4];
                const bf16x8 vf0 = (bf16x8){l0[0], l0[1], l0[2], l0[3], h0[0], h0[1], h0[2], h0[3]};
                const bf16x8 vf1 = (bf16x8){l1[0], l1[1], l1[2], l1[3], h1[0], h1[1], h1[2], h1[3]};
                o0 = __builtin_amdgcn_mfma_f32_32x32x16_bf16(vf0, pf, o0, 0, 0, 0);
                o1 = __builtin_amdgcn_mfma_f32_32x32x16_bf16(vf1, pf, o1, 0, 0, 0);
            }
        }
        if (it + 1 < n_t) ATT_STORE_TILE(half ^ 1, half ^ 1);
        if (it + 3 < n_t) ATT_LOAD_TILE(ATT_TILE(it + 3), half ^ 1);
        __syncthreads();
      } }
    }
    { auto rr = __builtin_amdgcn_permlane32_swap(__float_as_uint(lrun), __float_as_uint(lrun), false, false); lrun = __uint_as_float(rr[0]) + __uint_as_float(rr[1]); }
    const float inv = 1.0f / lrun;
    bf16* op = T.O + (size_t)qrow * T.ldo + h * T.ohs;
#pragma unroll
    for (int a = 0; a < 4; ++a) {
        u32x2 w0, w1;
        w0.x = pk2(o0[4 * a] * inv, o0[4 * a + 1] * inv); w0.y = pk2(o0[4 * a + 2] * inv, o0[4 * a + 3] * inv);
        w1.x = pk2(o1[4 * a] * inv, o1[4 * a + 1] * inv); w1.y = pk2(o1[4 * a + 2] * inv, o1[4 * a + 3] * inv);
        *(u32x2*)(op + 8 * a + 4 * hi) = w0; *(u32x2*)(op + 32 + 8 * a + 4 * hi) = w1;
    }
}

template <int MODE>
__device__ __forceinline__ void attn_phase(const Tensors& T, LAS unsigned char* lds) {
    const int G = gridDim.x, bx = blockIdx.x, vcu = (G % 8 == 0) ? (bx % 8) * (G / 8) + bx / 8 : bx;
    for (int pr = vcu; pr < 256; pr += G) {
        const int bh = pr >> 4, s = pr & 15;
        attn_unit<MODE>(T, bh >> 2, bh & 3, s, lds);
        attn_unit<MODE>(T, bh >> 2, bh & 3, 31 - s, lds);
    }
}

template <int MODE>
__device__ __forceinline__ void attn_naive(const Tensors& T) {
    BODY_IDS();
    constexpr int DQK = (MODE == MODE_MLA) ? 96 : 64;
    const float sc = (MODE == MODE_MLA) ? 0.10206207261596575f : 0.125f;
    for (int idx = gtid; idx < NTOK * 4; idx += gthreads) {
        const int h = idx / NTOK, row = idx % NTOK, b = row / SEQ, tpos = row % SEQ, rowb = b * SEQ;
        float q[DQK], o[64];
#pragma unroll
        for (int d = 0; d < DQK; ++d) q[d] = bf2f(T.Q[(size_t)row * T.ldq + h * T.qhs + d]) * sc;
#pragma unroll
        for (int d = 0; d < 64; ++d) o[d] = 0.f;
        float m = -INFINITY, l = 0.f;
        const int ck = tpos / 64;
        const int k_lo = (MODE == MODE_BAND) ? ((ck - 8) > 0 ? (ck - 8) * 64 : 0) : 0;
        const int k_hi = (MODE == MODE_FOX) ? tpos : (ck * 64 + 63);
        const float cq = (MODE == MODE_FOX) ? T.cdec[(size_t)row * 4 + h] : 0.f;
        for (int kv = k_lo; kv <= k_hi; ++kv) {
            const size_t kr = (size_t)(rowb + kv);
            float s = 0.f;
#pragma unroll
            for (int d8 = 0; d8 < 8; ++d8) { const u32x4 w = *(const u32x4*)(T.K + kr * T.ldk + h * T.khs + d8 * 8);
                s += q[d8 * 8 + 0] * bflo(w.x) + q[d8 * 8 + 1] * bfhi(w.x) + q[d8 * 8 + 2] * bflo(w.y) + q[d8 * 8 + 3] * bfhi(w.y)
                   + q[d8 * 8 + 4] * bflo(w.z) + q[d8 * 8 + 5] * bfhi(w.z) + q[d8 * 8 + 6] * bflo(w.w) + q[d8 * 8 + 7] * bfhi(w.w); }
            if (MODE == MODE_MLA) {
#pragma unroll
                for (int d8 = 0; d8 < 4; ++d8) { const u32x4 w = *(const u32x4*)(T.K2 + kr * 32 + d8 * 8);
                    s += q[64 + d8 * 8 + 0] * bflo(w.x) + q[64 + d8 * 8 + 1] * bfhi(w.x) + q[64 + d8 * 8 + 2] * bflo(w.y) + q[64 + d8 * 8 + 3] * bfhi(w.y)
                       + q[64 + d8 * 8 + 4] * bflo(w.z) + q[64 + d8 * 8 + 5] * bfhi(w.z) + q[64 + d8 * 8 + 6] * bflo(w.w) + q[64 + d8 * 8 + 7] * bfhi(w.w); }
            }
            if (MODE == MODE_FOX) s += cq - T.cdec[kr * 4 + h];
            if (MODE == MODE_BAND) { int rel = tpos - kv; rel = rel < -256 ? -256 : (rel > 256 ? 256 : rel); s += T.relb[h * 513 + rel + 256]; }
            const float mn = fmaxf(m, s), al = __expf(m - mn), pp = __expf(s - mn);
            l = l * al + pp; m = mn;
#pragma unroll
            for (int d8 = 0; d8 < 8; ++d8) { const u32x4 w = *(const u32x4*)(T.V + kr * T.ldv + h * T.vhs + d8 * 8);
                o[d8 * 8 + 0] = o[d8 * 8 + 0] * al + pp * bflo(w.x); o[d8 * 8 + 1] = o[d8 * 8 + 1] * al + pp * bfhi(w.x);
                o[d8 * 8 + 2] = o[d8 * 8 + 2] * al + pp * bflo(w.y); o[d8 * 8 + 3] = o[d8 * 8 + 3] * al + pp * bfhi(w.y);
                o[d8 * 8 + 4] = o[d8 * 8 + 4] * al + pp * bflo(w.z); o[d8 * 8 + 5] = o[d8 * 8 + 5] * al + pp * bfhi(w.z);
                o[d8 * 8 + 6] = o[d8 * 8 + 6] * al + pp * bflo(w.w); o[d8 * 8 + 7] = o[d8 * 8 + 7] * al + pp * bfhi(w.w); }
        }
        const float inv = 1.0f / l;
#pragma unroll
        for (int d = 0; d < 64; d += 2) *(unsigned*)(T.O + (size_t)row * T.ldo + h * T.ohs + d) = pk2(o[d] * inv, o[d + 1] * inv);
    }
}
}
struct Params {
    const float* in[37];
    float* out;
    unsigned char* ws;
    int ph_lo, ph_hi;
};
enum { I_X = 0, I_P, I_POS, I_WIN, I_SAR, I_SAI, I_SLDT, I_SBR, I_SBI, I_SCR, I_SCI, I_SD, I_SGLU, I_FBF, I_GQ, I_WUQ, I_GKV, I_WUKV, I_RELB, I_WB, I_WG, I_BG, I_WO,
       I_GMIX, I_GFFN, I_FW1, I_FW3, I_FW2, I_MWR, I_MBR, I_MW1, I_MW3, I_MW2, I_GPLE, I_PWG, I_PWU, I_GFIN };

__device__ __forceinline__ void sincos_rad(double a, float& s, float& c) {
    double r = a * 0.15915494309189535; r = r - __builtin_rint(r); const float f = (float)r;
    s = __builtin_amdgcn_sinf(f); c = __builtin_amdgcn_cosf(f);
}
__device__ __forceinline__ float gelu_tanh(float x) {
    const float z = 0.7978845608028654f * (x + 0.044715f * x * x * x);
    return x * __builtin_amdgcn_rcpf(1.0f + __expf(-2.0f * z));
}
__device__ __forceinline__ float log_sigmoid(float z) { return fminf(z, 0.f) - log1pf(__expf(-fabsf(z))); }

struct CvtJob { const float* src; const float* ks; bf16* dst; int K, ldsrc, col0, ncols, row0, ldk, ilv; };
struct CvtRegs { f32x4 v[16]; };
__device__ __forceinline__ void cvt_load(const CvtJob& J, int item, int lane, CvtRegs& R) {
    const int nblk = (J.ncols + 63) >> 6, kb = item / nblk, nb = item % nblk, k0 = 64 * kb, n0 = 64 * nb;
    const int n4 = (lane & 15) * 4; const bool inb = (n0 + n4) < J.ncols;
#pragma unroll
    for (int i = 0; i < 16; ++i) { const int kk = 4 * i + (lane >> 4); f32x4 v = {0.f, 0.f, 0.f, 0.f};
        if (inb) v = *(const f32x4*)(J.src + (size_t)(k0 + kk) * J.ldsrc + J.col0 + n0 + n4);
        if (J.ks) v = v * J.ks[k0 + kk];
        R.v[i] = v; }
}
__device__ __forceinline__ void cvt_finish(const CvtJob& J, LAS float* scr, int item, int lane, const CvtRegs& R) {
    const int nblk = (J.ncols + 63) >> 6, kb = item / nblk, nb = item % nblk, k0 = 64 * kb, n0 = 64 * nb;
    const int n4 = (lane & 15) * 4;
#pragma unroll
    for (int i = 0; i < 16; ++i) { const int kk = 4 * i + (lane >> 4); *(LAS f32x4*)(scr + kk * 68 + n4) = R.v[i]; }
    LDS_WAIT(); asm volatile("" ::: "memory");
    const int c = lane & 7;
#pragma unroll
    for (int j = 0; j < 8; ++j) { const int n = (lane >> 3) + 8 * j; const LAS float* s = scr + (8 * c) * 68 + n;
        u32x4 o; o.x = pk2(s[0 * 68], s[1 * 68]); o.y = pk2(s[2 * 68], s[3 * 68]); o.z = pk2(s[4 * 68], s[5 * 68]); o.w = pk2(s[6 * 68], s[7 * 68]);
        const int nn = n0 + n; const int row = J.row0 + (J.ilv ? ((nn >> 7) * 256 + (nn & 127)) : nn);
        if (nn < J.ncols) *(u32x4*)(J.dst + (size_t)row * J.ldk + k0 + 8 * c) = o; }
    LDS_WAIT(); asm volatile("" ::: "memory");
}
__device__ __forceinline__ bf16* wmix(const Params& P, int L, size_t off) { return (bf16*)(P.ws + WS_WMIX + (size_t)L * WMIX_STRIDE + off); }
__device__ __forceinline__ CvtJob get_job(const Params& P, int j) {
    CvtJob J; J.ks = nullptr; J.ilv = 0; J.col0 = 0; J.row0 = 0;
    if (j < 40) {
        const int L = j / 20, q = j % 20;
        if (q < 5) {
            J.src = P.in[I_WIN] + (size_t)L * D * DIN; J.K = D; J.ldsrc = DIN; J.dst = wmix(P, L, WM_IN); J.ldk = D;
            J.col0 = q == 0 ? 0 : q == 1 ? 1380 : q == 2 ? 1028 : q == 3 ? 1220 : 1348;
            J.ncols = q == 0 ? 1024 : q == 1 ? 768 : q == 2 ? 192 : q == 3 ? 128 : 32;
            J.row0 = q == 0 ? 0 : q == 1 ? 1024 : q == 2 ? 1792 : q == 3 ? 2048 : 2176;
        } else if (q < 9) { const int k = q - 5; J.src = P.in[I_WG] + ((size_t)L * 4 + k) * D * D; J.K = D; J.ldsrc = D; J.ncols = D; J.row0 = k * D; J.dst = wmix(P, L, WM_G); J.ldk = D;
        } else if (q < 13) { const int k = q - 9; J.src = P.in[I_WB] + ((size_t)L * 4 + k) * 256 * D; J.K = 256; J.ldsrc = D; J.ncols = D; J.row0 = k * D; J.dst = wmix(P, L, WM_B); J.ldk = 256;
        } else if (q == 13) { J.src = P.in[I_WO] + (size_t)L * D * D; J.K = D; J.ldsrc = D; J.ncols = D; J.dst = wmix(P, L, WM_O); J.ldk = D;
        } else if (q == 14) { J.src = P.in[I_PWG] + (size_t)L * D * D; J.K = D; J.ldsrc = D; J.ncols = D; J.dst = wmix(P, L, WM_PG); J.ldk = D;
        } else if (q == 15) { J.src = P.in[I_PWU] + (size_t)L * 256 * D; J.K = 256; J.ldsrc = D; J.ncols = D; J.dst = wmix(P, L, WM_UP); J.ldk = 256;
        } else if (q == 16) { J.src = P.in[I_WUQ] + (size_t)L * 192 * 384; J.ks = P.in[I_GQ] + L * 192; J.K = 192; J.ldsrc = 384; J.ncols = 384; J.dst = wmix(P, L, WM_UQ); J.ldk = 256;
        } else if (q == 17) { J.src = P.in[I_WUKV] + (size_t)L * 128 * 512; J.ks = P.in[I_GKV] + L * 128; J.K = 128; J.ldsrc = 512; J.ncols = 512; J.dst = wmix(P, L, WM_UKV); J.ldk = 128;
        } else if (q == 18) { J.src = P.in[I_SGLU] + (size_t)L * 256 * 256; J.K = 256; J.ldsrc = 256; J.ncols = 256; J.dst = wmix(P, L, WM_GLU); J.ldk = 256;
        } else { J.src = nullptr; J.K = 0; J.ldsrc = 0; J.ncols = 32; J.dst = nullptr; J.ldk = 0; }
    } else if (j < 43) {
        const int q = j - 40;
        if (q == 0) { J.src = P.in[I_FW1]; J.K = D; J.ldsrc = DFF; J.ncols = DFF; J.dst = (bf16*)(P.ws + WS_W13); J.ldk = D; J.ilv = 1; }
        else if (q == 1) { J.src = P.in[I_FW3]; J.K = D; J.ldsrc = DFF; J.ncols = DFF; J.row0 = 128; J.dst = (bf16*)(P.ws + WS_W13); J.ldk = D; J.ilv = 1; }
        else { J.src = P.in[I_FW2]; J.K = DFF; J.ldsrc = D; J.ncols = D; J.dst = (bf16*)(P.ws + WS_W2); J.ldk = DFF; }
    } else {
        const int e = (j - 43) / 3, q = (j - 43) % 3;
        if (q == 0) { J.src = P.in[I_MW1] + (size_t)e * D * DFFE; J.K = D; J.ldsrc = DFFE; J.ncols = DFFE; J.row0 = e * 2816; J.dst = (bf16*)(P.ws + WS_WM13); J.ldk = D; J.ilv = 1; }
        else if (q == 1) { J.src = P.in[I_MW3] + (size_t)e * D * DFFE; J.K = D; J.ldsrc = DFFE; J.ncols = DFFE; J.row0 = e * 2816 + 128; J.dst = (bf16*)(P.ws + WS_WM13); J.ldk = D; J.ilv = 1; }
        else { J.src = P.in[I_MW2] + (size_t)e * DFFE * D; J.K = DFFE; J.ldsrc = D; J.ncols = D; J.row0 = e * D; J.dst = (bf16*)(P.ws + WS_WM2); J.ldk = DFFE; }
    }
    return J;
}
__device__ __forceinline__ void cvt_jobs(const Params& P, int j_lo, int j_hi, LAS unsigned char* lds) {
    BODY_IDS();
    LAS float* scr = (LAS float*)(lds + wave * 17408);
    int acc = 0; bool have = false; CvtJob Jp; int itp = 0; CvtRegs Rp;
    for (int j = j_lo; j < j_hi; ++j) {
        const CvtJob J = get_job(P, j);
        const int items = (J.K / 64) * ((J.ncols + 63) >> 6);
        const int first = (gw - (acc % ngw) + ngw) % ngw;
        for (int it = first; it < items; it += ngw) {
            CvtRegs Rn; cvt_load(J, it, lane, Rn);
            if (have) cvt_finish(Jp, scr, itp, lane, Rp);
            Jp = J; itp = it; have = true;
#pragma unroll
            for (int i = 0; i < 16; ++i) Rp.v[i] = Rn.v[i];
        }
        acc += items;
    }
    if (have) cvt_finish(Jp, scr, itp, lane, Rp);
}

__device__ __forceinline__ void p0_misc(const Params& P) {
    BODY_IDS();
    { const f32x4* src = (const f32x4*)P.in[I_P]; u32x2* dst = (u32x2*)(P.ws + WS_PBF);
      for (int i = gtid; i < 2 * NTOK * 256 / 4; i += gthreads) { const f32x4 v = src[i]; u32x2 w; w.x = pk2(v[0], v[1]); w.y = pk2(v[2], v[3]); dst[i] = w; } }
    { const int* pos = (const int*)P.in[I_POS]; float* ct = (float*)(P.ws + WS_COS); float* st = (float*)(P.ws + WS_SIN);
      const double invf[16] = {1.0, 0.5623413251903491, 0.31622776601683794, 0.1778279410038923, 0.1, 0.05623413251903491, 0.03162277660168379, 0.01778279410038923,
                               0.01, 0.005623413251903491, 0.0031622776601683794, 0.0017782794100389228, 0.001, 0.0005623413251903491, 0.00031622776601683794, 0.00017782794100389227};
      for (int i = gtid; i < NTOK * 16; i += gthreads) { const int row = i >> 4, f = i & 15; double iv = invf[0];
#pragma unroll
          for (int q = 1; q < 16; ++q) iv = (f == q) ? invf[q] : iv;
          const float ang = (float)pos[row] * (float)iv; float s, c; sincos_rad((double)ang, s, c); ct[i] = c; st[i] = s; } }
    for (int L = 0; L < 2; ++L) {
        bf16* win = wmix(P, L, WM_IN);
        for (int i = gtid; i < (64 + 96) * D / 8; i += gthreads) { const int e = i * 8, r = e / D, k = e % D; const int row = r < 64 ? 1984 + r : 2208 + (r - 64); *(u32x4*)(win + (size_t)row * D + k) = (u32x4){0u, 0u, 0u, 0u}; }
        bf16* wuq = wmix(P, L, WM_UQ);
        for (int i = gtid; i < 512 * 256 / 8; i += gthreads) { const int e = i * 8, r = e / 256, k = e % 256; if (r >= 384 || k >= 192) *(u32x4*)(wuq + e) = (u32x4){0u, 0u, 0u, 0u}; }
    }
}

__device__ __forceinline__ void rms_load(const XSrc& x, int row, int lane, f32x4 (&v)[4]) {
#pragma unroll
    for (int j = 0; j < 4; ++j) v[j] = ldx4(x, (size_t)row * D + 4 * lane + 256 * j);
}
struct GainRegs { f32x4 g[4]; };
__device__ __forceinline__ GainRegs load_gain(const float* gain, int lane) { GainRegs G; const f32x4* gr = (const f32x4*)gain + lane;
#pragma unroll
    for (int j = 0; j < 4; ++j) G.g[j] = gr[64 * j];
    return G; }
__device__ __forceinline__ void rms_finish(const GainRegs& G, bf16* orow, int lane, f32x4 (&v)[4]) {
    float s = 0.f;
#pragma unroll
    for (int j = 0; j < 4; ++j) s += (v[j][0] * v[j][0] + v[j][1] * v[j][1]) + (v[j][2] * v[j][2] + v[j][3] * v[j][3]);
    const float rstd = __builtin_amdgcn_rsqf(wave_sum(s) * (1.0f / D) + RMS_EPS);
    u32x2* o8 = (u32x2*)orow + lane;
#pragma unroll
    for (int j = 0; j < 4; ++j) { v[j] = v[j] * rstd * G.g[j]; if (orow) { u32x2 w; w.x = pk2(v[j][0], v[j][1]); w.y = pk2(v[j][2], v[j][3]); o8[64 * j] = w; } }
}
#define RMS_ROWS_BEGIN(x_, rowexpr_) f32x4 v[4], vn_[4]; { const int i = 0; rms_load(x_, (rowexpr_), lane, v); } for (int i = 0; i < 16; ++i) { if (i + 1 < 16) { const int i_ = i; { const int i = i_ + 1; rms_load(x_, (rowexpr_), lane, vn_); } }
#define RMS_ROWS_END() _Pragma("unroll") for (int j_ = 0; j_ < 4; ++j_) v[j_] = vn_[j_]; }
__device__ __forceinline__ void norm_plain(const XSrc x, const float* gain, bf16* H, int first, int stride) {
    BODY_IDS();
    const GainRegs GR = load_gain(gain, lane);
    for (int u = first; u < NTOK / 128; u += stride)
    { RMS_ROWS_BEGIN(x, u * 128 + wave * 16 + i) const int row = u * 128 + wave * 16 + i; rms_finish(GR, H + (size_t)row * D, lane, v); RMS_ROWS_END() }
}
__device__ __forceinline__ void norm1_phase(const Params& P, int L, const XSrc x, int first, int stride) {
    BODY_IDS();
    const float* win = P.in[I_WIN] + (size_t)L * D * DIN;
    f32x4 wff[4][4];
#pragma unroll
    for (int j = 0; j < 4; ++j)
#pragma unroll
        for (int e = 0; e < 4; ++e) wff[j][e] = *(const f32x4*)(win + (size_t)(4 * lane + 256 * j + e) * DIN + 1024);
    const float* gain = P.in[I_GMIX] + L * D; bf16* H = (bf16*)(P.ws + WS_H); const GainRegs GR = load_gain(gain, lane);
    float* logf = (float*)(P.ws + WS_LOGF); float* wsum = (float*)(P.ws + WS_WSUM);
    const f32x4 bf = *(const f32x4*)(P.in[I_FBF] + L * 4);
    for (int u = first; u < NTOK / 128; u += stride) { const int g0 = u * 8 + wave;
        f32x4 run = {0.f, 0.f, 0.f, 0.f};
        RMS_ROWS_BEGIN(x, g0 * 16 + i) const int row = g0 * 16 + i; rms_finish(GR, H + (size_t)row * D, lane, v);
            f32x4 d = {0.f, 0.f, 0.f, 0.f};
#pragma unroll
            for (int j = 0; j < 4; ++j)
#pragma unroll
                for (int e = 0; e < 4; ++e) d += wff[j][e] * v[j][e];
#pragma unroll
            for (int e = 0; e < 4; ++e) { d[e] = wave_sum(d[e]); run[e] += log_sigmoid(d[e] + bf[e]); }
            if (lane == 0) *(f32x4*)(logf + (size_t)row * 4) = run; RMS_ROWS_END()
        if (lane == 0) *(f32x4*)(wsum + (size_t)g0 * 4) = run;
    }
    __syncthreads();
}
__device__ __forceinline__ void prep_phase(const Params& P, int L) {
    BODY_IDS();
    unsigned* qmaxw = (unsigned*)(P.ws + WS_CTL) + CW_QMAX + L * 512; unsigned* kmaxw = (unsigned*)(P.ws + WS_CTL) + CW_KMAX + L * 16;
    const float* logf = (const float*)(P.ws + WS_LOGF); const float* wsum = (const float*)(P.ws + WS_WSUM); float* cdec = (float*)(P.ws + WS_CDEC);
    float* rq = (float*)(P.ws + WS_RSTDQ); float* rkv = (float*)(P.ws + WS_RSTDKV); const bf16* zin = (const bf16*)(P.ws + WS_ZIN); bf16* kper = (bf16*)(P.ws + WS_KPER);
    const float* ct = (const float*)(P.ws + WS_COS); const float* st = (const float*)(P.ws + WS_SIN);
    for (int g0 = gw; g0 < NTOK / 16; g0 += ngw) {
        const int first = (g0 / 512) * 512;
        f32x4 pre = {0.f, 0.f, 0.f, 0.f};
        for (int i = first + lane; i < g0; i += 64) pre += *(const f32x4*)(wsum + (size_t)i * 4);
#pragma unroll
        for (int e = 0; e < 4; ++e) pre[e] = wave_sum(pre[e]);
        if (lane < 16) { const int row = g0 * 16 + lane; *(f32x4*)(cdec + (size_t)row * 4) = *(const f32x4*)(logf + (size_t)row * 4) + pre; }
        float qk2m = 0.f;
        const int colA = (lane < 32 ? ZC_FQ : ZC_FK) + 8 * (lane & 31), colB = ZC_CQ + 8 * (lane < 52 ? lane : 51);
        u32x4 wa = *(const u32x4*)(zin + (size_t)(g0 * 16) * ZP + colA), wb = *(const u32x4*)(zin + (size_t)(g0 * 16) * ZP + colB);
        for (int i = 0; i < 16; ++i) { const int row = g0 * 16 + i;
            const u32x4 ca = wa, cb = wb;
            if (i + 1 < 16) { wa = *(const u32x4*)(zin + (size_t)(row + 1) * ZP + colA); wb = *(const u32x4*)(zin + (size_t)(row + 1) * ZP + colB); }
            const f32x4 cs = *(const f32x4*)(ct + (size_t)row * 16 + 8 * (lane & 1)), cs2 = *(const f32x4*)(ct + (size_t)row * 16 + 8 * (lane & 1) + 4);
            const f32x4 sn = *(const f32x4*)(st + (size_t)row * 16 + 8 * (lane & 1)), sn2 = *(const f32x4*)(st + (size_t)row * 16 + 8 * (lane & 1) + 4);
            { float sa = (bflo(ca.x) * bflo(ca.x) + bfhi(ca.x) * bfhi(ca.x)) + (bflo(ca.y) * bflo(ca.y) + bfhi(ca.y) * bfhi(ca.y)) + (bflo(ca.z) * bflo(ca.z) + bfhi(ca.z) * bfhi(ca.z)) + (bflo(ca.w) * bflo(ca.w) + bfhi(ca.w) * bfhi(ca.w));
              sa += DPP_F(sa, 0xB1, 0xF); sa += DPP_F(sa, 0x4E, 0xF); sa += DPP_F(sa, 0x141, 0xF);
              qk2m = fmaxf(qk2m, sa); }
            const float own[8] = {bflo(cb.x), bfhi(cb.x), bflo(cb.y), bfhi(cb.y), bflo(cb.z), bfhi(cb.z), bflo(cb.w), bfhi(cb.w)};
            float ssb = 0.f;
#pragma unroll
            for (int e = 0; e < 8; ++e) ssb += own[e] * own[e];
            const float sq = wave_sum(lane < 24 ? ssb : 0.f), skv = wave_sum((lane >= 32 && lane < 48) ? ssb : 0.f);
            if (lane == 0) { rq[row] = __builtin_amdgcn_rsqf(sq * (1.0f / 192.0f) + RMS_EPS); rkv[row] = __builtin_amdgcn_rsqf(skv * (1.0f / 128.0f) + RMS_EPS); }
            float oth[8];
#pragma unroll
            for (int e = 0; e < 8; ++e) oth[e] = DPP_F(own[e], 0x4E, 0xF);
            if (lane >= 48 && lane < 52) { const bool lo = lane < 50; float o8[8];
#pragma unroll
                for (int e = 0; e < 8; ++e) { const float c = e < 4 ? cs[e] : cs2[e - 4], sv = e < 4 ? sn[e] : sn2[e - 4];
                    o8[e] = lo ? (own[e] * c - oth[e] * sv) : (own[e] * c + oth[e] * sv); }
                *(u32x4*)(kper + (size_t)row * 32 + (lo ? 0 : 16) + 8 * (lane & 1)) = (u32x4){pk2(o8[0], o8[1]), pk2(o8[2], o8[3]), pk2(o8[4], o8[5]), pk2(o8[6], o8[7])}; } }
        if ((lane & 7) == 0) { const int row0 = g0 * 16, b = row0 / SEQ, qb = (row0 % SEQ) / 256, h = (lane & 31) >> 3;
            if (lane < 32) atomicMax(qmaxw + (b * 4 + h) * 32 + qb, __float_as_uint(qk2m)); else atomicMax(kmaxw + b * 4 + h, __float_as_uint(qk2m)); }
    }
}
struct FinalRows { u32x2 w[16][4]; };
__device__ __forceinline__ void final_norm_load(const Params& P, int u, FinalRows& R) {
    BODY_IDS();
    const bf16* xb = xr_of(P.out);
#pragma unroll
    for (int i = 0; i < 16; ++i) { const u32x2* xr = (const u32x2*)(xb + (size_t)(u * 128 + wave * 16 + i) * D) + lane;
#pragma unroll
        for (int j = 0; j < 4; ++j) R.w[i][j] = xr[64 * j]; }
}
__device__ __forceinline__ void final_norm_store(const Params& P, int u, const FinalRows& R) {
    BODY_IDS();
    const GainRegs GR = load_gain(P.in[I_GFIN], lane);
#pragma unroll
    for (int i = 0; i < 16; ++i) { f32x4 v[4]; float s = 0.f;
#pragma unroll
        for (int j = 0; j < 4; ++j) { const u32x2 w = R.w[i][j]; v[j] = (f32x4){bflo(w.x), bfhi(w.x), bflo(w.y), bfhi(w.y)}; s += (v[j][0] * v[j][0] + v[j][1] * v[j][1]) + (v[j][2] * v[j][2] + v[j][3] * v[j][3]); }
        const float rstd = __builtin_amdgcn_rsqf(wave_sum(s) * (1.0f / D) + RMS_EPS);
        f32x4* xo = (f32x4*)(P.out + (size_t)(u * 128 + wave * 16 + i) * D) + lane;
#pragma unroll
        for (int j = 0; j < 4; ++j) xo[64 * j] = v[j] * rstd * GR.g[j]; }
}
namespace s5 {
struct Coef { float abr, abi; f32x2 B2[16]; float a64r, a64i; };
__device__ __forceinline__ void coef(const Params& P, int L, int g, int p, Coef& C) {
    const float dt = __expf(P.in[I_SLDT][L * 16 + g]); const float ar = P.in[I_SAR][(L * 16 + g) * 64 + p], ai = P.in[I_SAI][(L * 16 + g) * 64 + p];
    const float mag = __expf(ar * dt); float sn, cs; sincos_rad((double)(ai * dt), sn, cs);
    C.abr = mag * cs; C.abi = mag * sn;
    const float den = ar * ar + ai * ai, nr = C.abr - 1.0f, ni = C.abi;
    const float cr = (nr * ar + ni * ai) / den, ci = (ni * ar - nr * ai) / den;
    const float* br = P.in[I_SBR] + ((size_t)(L * 16 + g) * 64 + p) * 16; const float* bi = P.in[I_SBI] + ((size_t)(L * 16 + g) * 64 + p) * 16;
#pragma unroll
    for (int h = 0; h < 16; ++h) { const float r = br[h], i = bi[h]; C.B2[h] = (f32x2){cr * r - ci * i, cr * i + ci * r}; }
    const float m64 = __expf(64.0f * ar * dt); float s64, c64; sincos_rad(64.0 * (double)(ai * dt), s64, c64);
    C.a64r = m64 * c64; C.a64i = m64 * s64;
}
constexpr int WAVE_LDS = 8448;
template <bool EMIT>
__device__ __forceinline__ void chunk(const Params& P, int L, int g, int row0, const Coef& C, float& xr, float& xi, LAS unsigned char* wl, int lane, const bf16x8 (&cf)[4], float dsk) {
    bf16* zin = (bf16*)(P.ws + WS_ZIN);
    LAS float* ut = (LAS float*)wl; LAS unsigned* xt = (LAS unsigned*)(wl + 4096);
    { const u32x4* up = (const u32x4*)(zin + (size_t)(row0 + lane) * ZP + ZC_U + g * 16); const u32x4 w0 = up[0], w1 = up[1];
      LAS f32x4* d = (LAS f32x4*)(ut + lane * 16);
      d[0] = (f32x4){bflo(w0.x), bfhi(w0.x), bflo(w0.y), bfhi(w0.y)}; d[1] = (f32x4){bflo(w0.z), bfhi(w0.z), bflo(w0.w), bfhi(w0.w)};
      d[2] = (f32x4){bflo(w1.x), bfhi(w1.x), bflo(w1.y), bfhi(w1.y)}; d[3] = (f32x4){bflo(w1.z), bfhi(w1.z), bflo(w1.w), bfhi(w1.w)}; }
    for (int tb = 0; tb < 4; ++tb) {
#pragma unroll 4
        for (int ti = 0; ti < 16; ++ti) {
            const LAS f32x4* up = (const LAS f32x4*)(ut + (tb * 16 + ti) * 16);
            f32x2 b2a = {0.f, 0.f}, b2b = {0.f, 0.f};
#pragma unroll
            for (int q = 0; q < 4; ++q) { const f32x4 u4 = up[q];
                b2a += C.B2[4 * q + 0] * (f32x2){u4[0], u4[0]}; b2b += C.B2[4 * q + 1] * (f32x2){u4[1], u4[1]};
                b2a += C.B2[4 * q + 2] * (f32x2){u4[2], u4[2]}; b2b += C.B2[4 * q + 3] * (f32x2){u4[3], u4[3]}; }
            const float br = b2a[0] + b2b[0], bi = b2a[1] + b2b[1];
            const float nr = C.abr * xr - C.abi * xi + br, ni = C.abr * xi + C.abi * xr + bi; xr = nr; xi = ni;
            if (EMIT) xt[ti * 68 + lane] = pk2(xr, xi);
        }
        if (EMIT) {
            f32x4 dacc = {0.f, 0.f, 0.f, 0.f};
#pragma unroll
            for (int ks = 0; ks < 4; ++ks) { const bf16x8 a = *(const LAS bf16x8*)((const LAS unsigned char*)xt + (lane & 15) * 272 + (ks * 32 + (lane >> 4) * 8) * 2);
                dacc = __builtin_amdgcn_mfma_f32_16x16x32_bf16(a, cf[ks], dacc, 0, 0, 0); }
            const int hp = lane & 15;
#pragma unroll
            for (int i = 0; i < 4; ++i) { const int tok = tb * 16 + 4 * (lane >> 4) + i; const float y = dacc[i] + dsk * ut[tok * 16 + hp];
                zin[(size_t)(row0 + tok) * ZP + ZC_U + g * 16 + hp] = (bf16)f2bf(gelu_tanh(y)); }
        }
    }
}
template <int PASS>
__device__ __forceinline__ void phase(const Params& P, int L, LAS unsigned char* lds) {
    BODY_IDS();
    LAS unsigned char* wl = lds + wave * WAVE_LDS;
    f32x2* SC = (f32x2*)(P.ws + WS_SC);
    for (int w = gw; w < 2048; w += ngw) {
        const int bg = w >> 5, cg = w & 31, b = bg >> 4, g = bg & 15;
        Coef C; coef(P, L, g, lane, C);
        bf16x8 cf[4]; float dsk = 0.f;
        if (PASS == 1) {
            const int hp = lane & 15, kg = lane >> 4;
            const float* cre = P.in[I_SCR] + ((size_t)(L * 16 + g) * 16 + hp) * 64; const float* cim = P.in[I_SCI] + ((size_t)(L * 16 + g) * 16 + hp) * 64;
#pragma unroll
            for (int ks = 0; ks < 4; ++ks) { const int p0 = 16 * ks + 4 * kg; u32x4 wv;
                wv.x = pk2(cre[p0], -cim[p0]); wv.y = pk2(cre[p0 + 1], -cim[p0 + 1]); wv.z = pk2(cre[p0 + 2], -cim[p0 + 2]); wv.w = pk2(cre[p0 + 3], -cim[p0 + 3]);
                cf[ks] = __builtin_bit_cast(bf16x8, wv); }
            dsk = P.in[I_SD][(L * 16 + g) * 16 + hp];
        } else {
#pragma unroll
            for (int ks = 0; ks < 4; ++ks) cf[ks] = (bf16x8){0, 0, 0, 0, 0, 0, 0, 0};
        }
        float xr = 0.f, xi = 0.f;
        if (PASS == 1) {
            const f32x2* sp = SC + ((size_t)bg * 128) * 64 + lane;
            for (int c = 0; c < 4 * cg; c += 4) { f32x2 sv[4];
#pragma unroll
                for (int q = 0; q < 4; ++q) sv[q] = sp[(size_t)(c + q) * 64];
#pragma unroll
                for (int q = 0; q < 4; ++q) { const float nr = C.a64r * xr - C.a64i * xi + sv[q][0], ni = C.a64r * xi + C.a64i * xr + sv[q][1]; xr = nr; xi = ni; } }
        }
        for (int cc = 0; cc < 4; ++cc) {
            const int c = 4 * cg + cc, row0 = b * SEQ + c * 64;
            if (PASS == 0) { xr = 0.f; xi = 0.f; }
            chunk<PASS == 1>(P, L, g, row0, C, xr, xi, wl, lane, cf, dsk);
            if (PASS == 0) SC[((size_t)bg * 128 + c) * 64 + lane] = (f32x2){xr, xi};
        }
    }
}
#define LDS_XLANE() asm volatile("" ::: "memory")
constexpr int WAVE_LDS1 = 4352;
__device__ __forceinline__ void phase1(const Params& P, int L, LAS unsigned char* lds) {
    BODY_IDS();
    LAS unsigned char* wl = lds + wave * WAVE_LDS1;
    LAS unsigned* bu = (LAS unsigned*)wl; LAS unsigned* xt = bu;
    bf16* zin = (bf16*)(P.ws + WS_ZIN);
    const f32x2* SC = (const f32x2*)(P.ws + WS_SC);
    const int m = lane & 15, kq = lane >> 4;
    for (int w = gw; w < 2048; w += ngw) {
        const int bg = w >> 5, cg = w & 31, b = bg >> 4, g = bg & 15;
        const bf16* ub = zin + (size_t)(b * SEQ + cg * 256 + m) * ZP + ZC_U + g * 16 + 8 * (kq & 1);
        u32x4 ua[4];
#pragma unroll
        for (int q = 0; q < 4; ++q) ua[q] = *(const u32x4*)(ub + (size_t)q * 16 * ZP);
        const f32x2* sp = SC + ((size_t)bg * 128) * 64 + lane;
        f32x2 pq[4][4];
        if (cg > 0) {
#pragma unroll
            for (int j = 0; j < 4; ++j) { const int bc = j < cg ? j : cg - 1;
#pragma unroll
                for (int t = 0; t < 4; ++t) pq[j][t] = sp[(size_t)(4 * bc + t) * 64]; }
        }
        float abr, abi, a64r, a64i; bf16x8 bfr[8];
        { Coef C; coef(P, L, g, lane, C); abr = C.abr; abi = C.abi; a64r = C.a64r; a64i = C.a64i;
          LAS unsigned* tab = (LAS unsigned*)wl;
#pragma unroll
          for (int h2 = 0; h2 < 8; ++h2) { tab[lane * 8 + h2] = pk2(C.B2[2 * h2][0], C.B2[2 * h2 + 1][0]); tab[(64 + lane) * 8 + h2] = pk2(C.B2[2 * h2][1], C.B2[2 * h2 + 1][1]); }
          LDS_XLANE();
#pragma unroll
          for (int nt = 0; nt < 8; ++nt) { const u32x4 v = *(const LAS u32x4*)(wl + (16 * nt + m) * 32 + 16 * (kq & 1)); bfr[nt] = __builtin_bit_cast(bf16x8, kq < 2 ? v : (u32x4){0u, 0u, 0u, 0u}); }
          LDS_XLANE(); }
        bf16x8 cf[4]; float dskf;
        { const float* cre = P.in[I_SCR] + ((size_t)(L * 16 + g) * 16 + m) * 64; const float* cim = P.in[I_SCI] + ((size_t)(L * 16 + g) * 16 + m) * 64;
#pragma unroll
          for (int ks = 0; ks < 4; ++ks) { const int p0 = 16 * ks + 4 * kq; u32x4 wv;
              wv.x = pk2(cre[p0], -cim[p0]); wv.y = pk2(cre[p0 + 1], -cim[p0 + 1]); wv.z = pk2(cre[p0 + 2], -cim[p0 + 2]); wv.w = pk2(cre[p0 + 3], -cim[p0 + 3]);
              cf[ks] = __builtin_bit_cast(bf16x8, wv); }
          dskf = P.in[I_SD][(L * 16 + g) * 16 + m]; }
        float xr = 0.f, xi = 0.f;
        for (int k = 0; k < cg; k += 4) {
#pragma unroll
            for (int j = 0; j < 4; ++j) {
                if (k + j < cg) {
#pragma unroll
                    for (int t = 0; t < 4; ++t) { const float nr = a64r * xr - a64i * xi + pq[j][t][0], ni = a64r * xi + a64i * xr + pq[j][t][1]; xr = nr; xi = ni; } }
                const int bn = k + j + 4, bc = bn < cg ? bn : cg - 1;
#pragma unroll
                for (int t = 0; t < 4; ++t) pq[j][t] = sp[(size_t)(4 * bc + t) * 64];
            }
        }
#pragma nounroll
        for (int cc = 0; cc < 4; ++cc) {
            const int row0 = b * SEQ + (4 * cg + cc) * 64;
            u32x4 un[4];
            if (cc < 3) {
#pragma unroll
                for (int q = 0; q < 4; ++q) un[q] = *(const u32x4*)(ub + (size_t)((cc + 1) * 4 + q) * 16 * ZP);
            } else {
#pragma unroll
                for (int q = 0; q < 4; ++q) un[q] = ua[q];
            }
#pragma unroll
            for (int tb = 0; tb < 4; ++tb) {
                const bf16x8 a = __builtin_bit_cast(bf16x8, ua[tb]);
                f32x4 dd[8];
#pragma unroll
                for (int nt = 0; nt < 8; ++nt) dd[nt] = __builtin_amdgcn_mfma_f32_16x16x32_bf16(a, bfr[nt], (f32x4){0.f, 0.f, 0.f, 0.f}, 0, 0, 0);
                unsigned short uraw[4];
#pragma unroll
                for (int i = 0; i < 4; ++i) uraw[i] = *(const unsigned short*)(zin + (size_t)(row0 + tb * 16 + 4 * kq + i) * ZP + ZC_U + g * 16 + m);
#pragma unroll
                for (int nt = 0; nt < 4; ++nt)
#pragma unroll
                    for (int i = 0; i < 4; ++i) bu[(4 * kq + i) * 68 + 16 * nt + m] = pk2(dd[nt][i], dd[nt + 4][i]);
                LDS_XLANE();
#pragma unroll
                for (int ti = 0; ti < 16; ++ti) {
                    const unsigned bw = bu[ti * 68 + lane]; const float br = bflo(bw), bi = bfhi(bw);
                    const float nr = abr * xr - abi * xi + br, ni = abr * xi + abi * xr + bi; xr = nr; xi = ni;
                    xt[ti * 68 + lane] = pk2(xr, xi);
                }
                LDS_XLANE();
                f32x4 dacc = {0.f, 0.f, 0.f, 0.f};
#pragma unroll
                for (int ks = 0; ks < 4; ++ks) { const bf16x8 a2 = *(const LAS bf16x8*)(wl + m * 272 + (ks * 32 + kq * 8) * 2);
                    dacc = __builtin_amdgcn_mfma_f32_16x16x32_bf16(a2, cf[ks], dacc, 0, 0, 0); }
                LDS_XLANE();
#pragma unroll
                for (int i = 0; i < 4; ++i) { const int tok = tb * 16 + 4 * kq + i; const float y = dacc[i] + dskf * __uint_as_float((unsigned)uraw[i] << 16);
                    const float gy = gelu_tanh(y); *(unsigned short*)(zin + (size_t)(row0 + tok) * ZP + ZC_U + g * 16 + m) = (unsigned short)pk2(gy, gy); }
            }
#pragma unroll
            for (int q = 0; q < 4; ++q) ua[q] = un[q];
        }
    }
}
__device__ __forceinline__ void build_w(const Params& P, int L) {
    BODY_IDS();
    bf16* W = (bf16*)(P.ws + WS_S5W);
    for (int q = gtid; q < 16 * 64 * 64; q += gthreads) {
        const int g = q >> 12, p = (q >> 6) & 63, sidx = q & 63;
        const float dt = __expf(P.in[I_SLDT][L * 16 + g]); const float ar = P.in[I_SAR][(L * 16 + g) * 64 + p], ai = P.in[I_SAI][(L * 16 + g) * 64 + p];
        const float mag = __expf(ar * dt); float sn, cs; sincos_rad((double)(ai * dt), sn, cs);
        const float abr = mag * cs, abi = mag * sn, den = ar * ar + ai * ai, nr = abr - 1.0f, ni = abi;
        const float cr = (nr * ar + ni * ai) / den, ci = (ni * ar - nr * ai) / den;
        const float e = (float)(63 - sidx); const float me = __expf(e * ar * dt); float se, ce; sincos_rad((double)e * (double)(ai * dt), se, ce);
        const float Er = me * ce, Ei = me * se;
        const float* br = P.in[I_SBR] + ((size_t)(L * 16 + g) * 64 + p) * 16; const float* bi = P.in[I_SBI] + ((size_t)(L * 16 + g) * 64 + p) * 16;
        float vr[16], vi[16];
#pragma unroll
        for (int h = 0; h < 16; ++h) { const float bbr = cr * br[h] - ci * bi[h], bbi = cr * bi[h] + ci * br[h]; vr[h] = Er * bbr - Ei * bbi; vi[h] = Er * bbi + Ei * bbr; }
        bf16* w0 = W + ((size_t)g * 128 + 2 * p) * 1024 + sidx * 16;
        *(u32x4*)w0 = (u32x4){pk2(vr[0], vr[1]), pk2(vr[2], vr[3]), pk2(vr[4], vr[5]), pk2(vr[6], vr[7])}; *(u32x4*)(w0 + 8) = (u32x4){pk2(vr[8], vr[9]), pk2(vr[10], vr[11]), pk2(vr[12], vr[13]), pk2(vr[14], vr[15])};
        *(u32x4*)(w0 + 1024) = (u32x4){pk2(vi[0], vi[1]), pk2(vi[2], vi[3]), pk2(vi[4], vi[5]), pk2(vi[6], vi[7])}; *(u32x4*)(w0 + 1024 + 8) = (u32x4){pk2(vi[8], vi[9]), pk2(vi[10], vi[11]), pk2(vi[12], vi[13]), pk2(vi[14], vi[15])};
    }
}
__device__ __forceinline__ void pass0_mfma(const Params& P, LAS unsigned char* lds) {
    BODY_IDS();
    const bf16* zin = (const bf16*)(P.ws + WS_ZIN); const bf16* W = (const bf16*)(P.ws + WS_S5W); float* SC = (float*)(P.ws + WS_SC);
    for (int task = blockIdx.x; task < 256; task += gridDim.x) {
        const int g = task & 15, nq = (task >> 4) & 3, cgp = (task >> 6) * 8 + wave;
        __syncthreads();
#pragma unroll
        for (int i = 0; i < 8; ++i) { const int id = tid + 512 * i, row = id >> 7, c16 = id & 127;
            *(LAS u32x4*)(lds + row * 2064 + c16 * 16) = *(const u32x4*)(W + ((size_t)g * 128 + nq * 32 + row) * 1024 + c16 * 8); }
        __syncthreads();
        const int m = lane & 15, kq = lane >> 4, ci = 16 * cgp + m, b = ci >> 7, c = ci & 127;
        const bf16* ap = zin + (size_t)(b * SEQ + c * 64 + (kq >> 1)) * ZP + ZC_U + g * 16 + 8 * (kq & 1);
        const LAS unsigned char* bl = lds + m * 2064 + kq * 16;
        f32x4 d0 = {0.f, 0.f, 0.f, 0.f}, d1 = {0.f, 0.f, 0.f, 0.f};
#pragma unroll 8
        for (int ks = 0; ks < 32; ++ks) {
            const bf16x8 av = *(const bf16x8*)(ap + (size_t)(2 * ks) * ZP), b0 = *(const LAS bf16x8*)(bl + 64 * ks), b1 = *(const LAS bf16x8*)(bl + 16 * 2064 + 64 * ks);
            d0 = __builtin_amdgcn_mfma_f32_16x16x32_bf16(av, b0, d0, 0, 0, 0); d1 = __builtin_amdgcn_mfma_f32_16x16x32_bf16(av, b1, d1, 0, 0, 0);
        }
#pragma unroll
        for (int i = 0; i < 4; ++i) { const int cj = 16 * cgp + 4 * (lane >> 4) + i, bj = cj >> 7, cc = cj & 127; float* sp = SC + ((size_t)(bj * 16 + g) * 128 + cc) * 128 + nq * 32 + (lane & 15);
            sp[0] = d0[i]; sp[16] = d1[i]; }
    }
    __syncthreads();
}
__device__ __forceinline__ void naive(const Params& P, int L) {
    BODY_IDS();
    bf16* zin = (bf16*)(P.ws + WS_ZIN);
    for (int bg = gw; bg < 64; bg += ngw) {
        const int b = bg >> 4, g = bg & 15;
        Coef C; coef(P, L, g, lane, C);
        float cr[16], ci[16];
#pragma unroll
        for (int h = 0; h < 16; ++h) { cr[h] = P.in[I_SCR][((size_t)(L * 16 + g) * 16 + h) * 64 + lane]; ci[h] = P.in[I_SCI][((size_t)(L * 16 + g) * 16 + h) * 64 + lane]; }
        const float dsk = P.in[I_SD][(L * 16 + g) * 16 + (lane & 15)];
        float xr = 0.f, xi = 0.f;
        for (int t = 0; t < SEQ; ++t) {
            bf16* up = zin + (size_t)(b * SEQ + t) * ZP + ZC_U + g * 16;
            const u32x4 w0 = *(const u32x4*)up, w1 = *(const u32x4*)(up + 8);
            const float u[16] = {bflo(w0.x), bfhi(w0.x), bflo(w0.y), bfhi(w0.y), bflo(w0.z), bfhi(w0.z), bflo(w0.w), bfhi(w0.w),
                                 bflo(w1.x), bfhi(w1.x), bflo(w1.y), bfhi(w1.y), bflo(w1.z), bfhi(w1.z), bflo(w1.w), bfhi(w1.w)};
            float br = 0.f, bi = 0.f;
#pragma unroll
            for (int h = 0; h < 16; ++h) { br += C.B2[h][0] * u[h]; bi += C.B2[h][1] * u[h]; }
            const float nr = C.abr * xr - C.abi * xi + br, ni = C.abr * xi + C.abi * xr + bi; xr = nr; xi = ni;
            float ymine = 0.f, umine = 0.f;
#pragma unroll
            for (int h = 0; h < 16; ++h) { const float s = wave_sum(xr * cr[h] - xi * ci[h]); if ((lane & 15) == h) { ymine = s; umine = u[h]; } }
            __builtin_amdgcn_s_waitcnt(0);
            if (lane < 16) up[lane] = (bf16)f2bf(gelu_tanh(ymine + dsk * umine));
        }
    }
}
}

__device__ __forceinline__ void norm2_moe_phase(const Params& P, const XSrc x, LAS unsigned char* lds, int first, int stride) {
    BODY_IDS();
    LAS unsigned* lcnt = (LAS unsigned*)(lds + 32768); LAS unsigned* lbase = lcnt + 8;
    f32x4 wr0[4][4], wr1[4][4];
#pragma unroll
    for (int j = 0; j < 4; ++j)
#pragma unroll
        for (int q = 0; q < 4; ++q) { const float* wp = P.in[I_MWR] + (size_t)(4 * lane + 256 * j + q) * 8; wr0[j][q] = *(const f32x4*)wp; wr1[j][q] = *(const f32x4*)(wp + 4); }
    if (tid < 8) lcnt[tid] = 0u;
    __syncthreads();
    const float* gain = P.in[I_GFFN] + 1 * D; bf16* H = (bf16*)(P.ws + WS_H); const GainRegs GR = load_gain(gain, lane);
    unsigned* tokinfo = (unsigned*)(P.ws + WS_TOKINFO); unsigned* gcnt = (unsigned*)(P.ws + WS_CTL) + CW_MOECNT;
    const float* brt = P.in[I_MBR];
    for (int u = first; u < NTOK / 128; u += stride) { const int g0 = u * 8 + wave;
        RMS_ROWS_BEGIN(x, g0 * 16 + i) const int row = g0 * 16 + i; rms_finish(GR, H + (size_t)row * D, lane, v);
            float lg[8];
#pragma unroll
            for (int e = 0; e < 8; ++e) lg[e] = 0.f;
#pragma unroll
            for (int j = 0; j < 4; ++j)
#pragma unroll
                for (int q = 0; q < 4; ++q) { const f32x4 w0 = wr0[j][q], w1 = wr1[j][q]; const float hv = v[j][q];
                    lg[0] += hv * w0[0]; lg[1] += hv * w0[1]; lg[2] += hv * w0[2]; lg[3] += hv * w0[3]; lg[4] += hv * w1[0]; lg[5] += hv * w1[1]; lg[6] += hv * w1[2]; lg[7] += hv * w1[3]; }
#pragma unroll
            for (int e = 0; e < 8; ++e) lg[e] = wave_sum(lg[e]) + brt[e];
            int e0 = 0; float l0 = lg[0];
#pragma unroll
            for (int e = 1; e < 8; ++e) if (lg[e] > l0) { l0 = lg[e]; e0 = e; }
            int e1 = 0; float l1 = -INFINITY;
#pragma unroll
            for (int e = 0; e < 8; ++e) if (e != e0 && lg[e] > l1) { l1 = lg[e]; e1 = e; }
            const float ex = __expf(l1 - l0); const float ga = __builtin_amdgcn_rcpf(1.0f + ex), gb = ex * ga;
            if (lane == 0) { const unsigned r0 = __hip_atomic_fetch_add(&lcnt[e0], 1u, __ATOMIC_RELAXED, __HIP_MEMORY_SCOPE_WORKGROUP), r1 = __hip_atomic_fetch_add(&lcnt[e1], 1u, __ATOMIC_RELAXED, __HIP_MEMORY_SCOPE_WORKGROUP);
                u32x4 a; a.x = (unsigned)e0; a.y = (unsigned)e1; a.z = r0; a.w = r1; u32x4 bq; bq.x = __float_as_uint(ga); bq.y = __float_as_uint(gb); bq.z = 0u; bq.w = 0u;
                *(u32x4*)(tokinfo + (size_t)row * 8) = a; *(u32x4*)(tokinfo + (size_t)row * 8 + 4) = bq; } RMS_ROWS_END()
    }
    __syncthreads();
    if (tid < 8) lbase[tid] = __hip_atomic_fetch_add(gcnt + tid, lcnt[tid], __ATOMIC_RELAXED, __HIP_MEMORY_SCOPE_AGENT);
    __syncthreads();
    for (int u = first; u < NTOK / 128; u += stride) { const int g0 = u * 8 + wave;
        if (lane == 0) { for (int i = 0; i < 16; ++i) { const int row = g0 * 16 + i; u32x4 a = *(u32x4*)(tokinfo + (size_t)row * 8);
            unsigned b0 = 0, b1 = 0;
#pragma unroll
            for (int e = 0; e < 8; ++e) { const unsigned lb = lbase[e]; b0 = (a.x == (unsigned)e) ? lb : b0; b1 = (a.y == (unsigned)e) ? lb : b1; }
            a.z += b0; a.w += b1; *(u32x4*)(tokinfo + (size_t)row * 8) = a; } }
    }
    int* slot_tok = (int*)(P.ws + WS_SLOTTOK);
    for (int i = gtid; i < MOE_ROWS; i += gthreads) slot_tok[i] = -1;
    __syncthreads();
}
struct MoeLayout { int pstart[9]; };
__device__ __forceinline__ MoeLayout moe_layout(const Params& P) {
    const unsigned* gcnt = (const unsigned*)(P.ws + WS_CTL) + CW_MOECNT; MoeLayout Lo; int acc = 0;
#pragma unroll
    for (int e = 0; e < 8; ++e) { Lo.pstart[e] = acc; const int c = (int)__hip_atomic_load(gcnt + e, __ATOMIC_RELAXED, __HIP_MEMORY_SCOPE_AGENT); acc += (c + 255) / 256 * 256; }
    Lo.pstart[8] = acc; return Lo;
}
__device__ __forceinline__ void moe_assign_phase(const Params& P) {
    BODY_IDS();
    const MoeLayout Lo = moe_layout(P);
    const unsigned* tokinfo = (const unsigned*)(P.ws + WS_TOKINFO); int* slot_tok = (int*)(P.ws + WS_SLOTTOK); float* slot_gate = (float*)(P.ws + WS_SLOTGATE);
    for (int t = gtid; t < NTOK; t += gthreads) { const u32x4 a = *(const u32x4*)(tokinfo + (size_t)t * 8); const u32x2 g = *(const u32x2*)(tokinfo + (size_t)t * 8 + 4);
        int p0 = 0, p1 = 0;
#pragma unroll
        for (int e = 0; e < 8; ++e) { p0 = ((int)a.x == e) ? Lo.pstart[e] : p0; p1 = ((int)a.y == e) ? Lo.pstart[e] : p1; }
        const int s0 = p0 + (int)a.z, s1 = p1 + (int)a.w;
        slot_tok[s0] = t; slot_gate[s0] = __uint_as_float(g.x); slot_tok[s1] = t; slot_gate[s1] = __uint_as_float(g.y); }
}
struct MoeOrder {
    int pstart[9]; int ntile, ncol, G, c;
    __device__ __forceinline__ bool next(int i, pg8::Unit& u) const {
        const long Lf = (long)i * G + c; if (Lf >= (long)ntile * ncol) return false;
        const int rt = (int)(Lf / ncol), j = (int)(Lf % ncol); int e = 0;
#pragma unroll
        for (int q = 1; q < 8; ++q) e = (rt * 256 >= pstart[q]) ? q : e;
        u.pm = rt; u.pn = e * ncol + j; return true;
    }
};
__device__ __forceinline__ MoeOrder moe_order(const Params& P, int ncol, int G, int c) {
    const MoeLayout Lo = moe_layout(P); MoeOrder S;
#pragma unroll
    for (int e = 0; e < 9; ++e) S.pstart[e] = Lo.pstart[e];
    S.ntile = Lo.pstart[8] / 256; S.ncol = ncol; S.G = G; S.c = c; return S;
}

__device__ __forceinline__ void norm_moe_combine(const Params& P, const float* gain, int first, int stride) {
    BODY_IDS();
    const MoeLayout Lo = moe_layout(P); const GainRegs GR = load_gain(gain, lane);
    const unsigned* tokinfo = (const unsigned*)(P.ws + WS_TOKINFO); const bf16* Y = (const bf16*)(P.ws + WS_MOEY); bf16* H = (bf16*)(P.ws + WS_H2);
    for (int u = first; u < NTOK / 128; u += stride) for (int i = 0; i < 16; ++i) { const int row = u * 128 + wave * 16 + i;
        const u32x4 a = *(const u32x4*)(tokinfo + (size_t)row * 8);
        int p0 = 0, p1 = 0;
#pragma unroll
        for (int e = 0; e < 8; ++e) { p0 = ((int)a.x == e) ? Lo.pstart[e] : p0; p1 = ((int)a.y == e) ? Lo.pstart[e] : p1; }
        const u32x2* y0 = (const u32x2*)(Y + (size_t)(p0 + (int)a.z) * D) + lane; const u32x2* y1 = (const u32x2*)(Y + (size_t)(p1 + (int)a.w) * D) + lane;
        u32x2* xr = (u32x2*)(xr_of(P.out) + (size_t)row * D) + lane; f32x4 v[4]; float s = 0.f;
#pragma unroll
        for (int j = 0; j < 4; ++j) { const u32x2 w0 = y0[64 * j], w1 = y1[64 * j]; const u32x2 wx = xr[64 * j];
            v[j] = (f32x4){bflo(wx.x), bfhi(wx.x), bflo(wx.y), bfhi(wx.y)} + (f32x4){bflo(w0.x), bfhi(w0.x), bflo(w0.y), bfhi(w0.y)} + (f32x4){bflo(w1.x), bfhi(w1.x), bflo(w1.y), bfhi(w1.y)};
            { u32x2 wo; wo.x = pk2(v[j][0], v[j][1]); wo.y = pk2(v[j][2], v[j][3]); xr[64 * j] = wo; } s += (v[j][0] * v[j][0] + v[j][1] * v[j][1]) + (v[j][2] * v[j][2] + v[j][3] * v[j][3]); }
        const float rstd = __builtin_amdgcn_rsqf(wave_sum(s) * (1.0f / D) + RMS_EPS);
        u32x2* o8 = (u32x2*)(H + (size_t)row * D) + lane;
#pragma unroll
        for (int j = 0; j < 4; ++j) { const f32x4 h = v[j] * rstd * GR.g[j]; u32x2 w; w.x = pk2(h[0], h[1]); w.y = pk2(h[2], h[3]); o8[64 * j] = w; }
    }
}
#ifndef REF_MASK
#define REF_MASK 0
#endif
#ifndef N_LAUNCH_MODE
#define N_LAUNCH_MODE 1
#endif
constexpr int LDS_BYTES = 147456;
constexpr int MISC_OFF = LDS_BYTES - 64;
constexpr int N_PHASES = 27;
#ifndef PHASE_SEL
#define PHASE_SEL 0xFFFFFFFu
#endif
#define PH_ON(b) (((PHASE_SEL) >> (b)) & 1u)
#ifndef SUB_SEL
#define SUB_SEL 0xFFu
#endif
#define SUB_ON(b) (((SUB_SEL) >> (b)) & 1u)

#ifndef PROBE_MASK
#define PROBE_MASK 0u
#endif
#ifndef PROBE_MULT
#define PROBE_MULT 4
#endif
#define TIMED(bit, ...) do { unsigned long long t0_ = 0; if (((PROBE_MASK) >> (bit)) & 1u) t0_ = __builtin_amdgcn_s_memrealtime(); __VA_ARGS__; \
    if (((PROBE_MASK) >> (bit)) & 1u) pacc += __builtin_amdgcn_s_memrealtime() - t0_; } while (0)
#define RUN_GEMM(EPI_T, SCHED_T, GATH, gm, sc, ep) do { if (REF_MASK & 1) pg8::gemm_phase_naive<EPI_T, SCHED_T, GATH>(gm, sc, ep); \
    else pg8::gemm_phase<EPI_T, SCHED_T, true, GATH>(lds, gm, sc, ep); } while (0)

__device__ __forceinline__ int vcu_of() { int G = gridDim.x, bx = blockIdx.x; asm volatile("" : "+s"(G), "+s"(bx)); return (G % 8 == 0) ? (bx % 8) * (G / 8) + bx / 8 : bx; }
__device__ __forceinline__ bool in_range(int lo, int hi, int k) { asm volatile("" : "+s"(lo), "+s"(hi)); return lo <= k && k < hi; }
__global__ void __launch_bounds__(NTHREADS, 2) mega_fwd(Params P) {
    extern __shared__ __attribute__((aligned(16))) unsigned char lds_raw[];
    LAS unsigned char* lds = (LAS unsigned char*)lds_raw;
    const int tid = threadIdx.x;
    const int G = gridDim.x, bx = blockIdx.x;
    unsigned* ctl = (unsigned*)(P.ws + WS_CTL);
    volatile LAS unsigned* misc = (volatile LAS unsigned*)(lds + MISC_OFF);
    if (tid < 16) misc[tid] = 0u;
    if ((tid & 63) == 0) *(LAS int*)(uintptr_t)((unsigned)TID_TAB_OFF + 4u * hw_wave_key()) = tid >> 6;
    __syncthreads();
    const int lo = P.ph_lo, hi = P.ph_hi;
    XcdBarrier bar; bar.bar = ctl + CW_BAR; bar.x = 0; bar.st = misc;
    if (hi - lo > 1) bar = xcd_barrier_post(ctl + CW_BAR, misc);
#define IN(k) in_range(lo, hi, (k))
#ifndef PROBE_SEAMS
#define PROBE_SEAMS 0u
#endif
#define SEAM(k) do { if (IN(k) && IN((k) + 1)) { unsigned long long t0_ = 0; const bool tm_ = (((PROBE_MASK) >> 24) & 1u) || (((PROBE_SEAMS) >> (k)) & 1u); if (tm_) t0_ = __builtin_amdgcn_s_memrealtime(); \
    xcd_barrier(bar); if (tm_) pacc += __builtin_amdgcn_s_memrealtime() - t0_; } } while (0)
    unsigned long long pacc = 0;

#define H ((bf16*)(P.ws + WS_H))
#define ZIN ((bf16*)(P.ws + WS_ZIN))
#define GB ((bf16*)(P.ws + WS_G))
#define MB ((bf16*)(P.ws + WS_M))
#define MLAQ ((bf16*)(P.ws + WS_MLAQ))
#define MLAKV ((bf16*)(P.ws + WS_MLAKV))
#define KPER ((bf16*)(P.ws + WS_KPER))
#define cosT ((float*)(P.ws + WS_COS))
#define sinT ((float*)(P.ws + WS_SIN))
#define slot_tok ((int*)(P.ws + WS_SLOTTOK))
#define slot_gate ((float*)(P.ws + WS_SLOTGATE))

    if (PH_ON(0) && IN(0)) { TIMED(0, cvt_jobs(P, 0, 43, lds); p0_misc(P)); TIMED(1, norm1_phase(P, 0, XSrc{P.in[I_X], nullptr}, vcu_of(), gridDim.x)); }
    SEAM(0);

    for (int L = 0; L < 2; ++L) {
        const int pb = 1 + 12 * L;
        const int pc = (L == 0) ? 9 : 22;
        bf16* const XR = xr_of(P.out);
        const XSrc xsrc = (L == 0) ? XSrc{P.in[I_X], nullptr} : XSrc{nullptr, XR};
        if (PH_ON(2) && IN(pb + 1)) {
            TIMED(4, s5::build_w(P, L));
            pg8::Gemm g{H, wmix(P, L, WM_IN), D, D, D, nullptr}; pg8::StaticOrder S; S.init(NTOK, ZP, G, bx);
            epi::EpiStore E{ZIN, ZP, 0};
            TIMED(2, RUN_GEMM(epi::EpiStore, pg8::StaticOrder, false, g, S, E));
        }
        SEAM(pb + 1);
        if (PH_ON(3) && IN(pb + 2)) {
            TIMED(3, prep_phase(P, L));
            if (!(REF_MASK & 4)) TIMED(4, s5::pass0_mfma(P, lds));
            __syncthreads();
        }
        SEAM(pb + 2);
        if (PH_ON(4) && IN(pb + 3)) {
            if (SUB_ON(0)) { pg8::Gemm g{ZIN + ZC_CQ, wmix(P, L, WM_UQ), ZP, 256, 256, nullptr}; pg8::StaticOrder S; S.init(NTOK, 512, G, bx);
              epi::EpiMlaQ E{MLAQ, (const float*)(P.ws + WS_RSTDQ), cosT, sinT};
              TIMED(5, RUN_GEMM(epi::EpiMlaQ, pg8::StaticOrder, false, g, S, E)); }
            if (SUB_ON(1)) { pg8::Gemm g{ZIN + ZC_CKV, wmix(P, L, WM_UKV), ZP, 128, 128, nullptr}; pg8::StaticOrder S; S.init(NTOK, 512, G, bx);
              epi::EpiRowScale E{MLAKV, 512, (const float*)(P.ws + WS_RSTDKV)};
              TIMED(5, RUN_GEMM(epi::EpiRowScale, pg8::StaticOrder, false, g, S, E)); }
            if (SUB_ON(2)) { TIMED(6, if (REF_MASK & 4) s5::naive(P, L); else s5::phase1(P, L, lds)); }
            __syncthreads();
            if (SUB_ON(3)) { att::Tensors T; T.Q = ZIN + ZC_FQ; T.ldq = ZP; T.K = ZIN + ZC_FK; T.ldk = ZP; T.K2 = nullptr; T.V = ZIN + ZC_FV; T.ldv = ZP; T.O = ZIN + ZC_FQ; T.ldo = ZP;
              T.cdec = (const float*)(P.ws + WS_CDEC); T.relb = nullptr; T.qhs = 64; T.khs = 64; T.vhs = 64; T.ohs = 64;
              T.qmax = (const unsigned*)(P.ws + WS_CTL) + CW_QMAX + L * 512; T.kmax = (const unsigned*)(P.ws + WS_CTL) + CW_KMAX + L * 16;
              TIMED(7, if (REF_MASK & 2) att::attn_naive<att::MODE_FOX>(T); else att::attn_phase<att::MODE_FOX>(T, lds)); }
            __syncthreads();
            if (SUB_ON(4)) { att::Tensors T; T.Q = ZIN + ZC_DQ; T.ldq = ZP; T.K = ZIN + ZC_DK; T.ldk = ZP; T.K2 = nullptr; T.V = ZIN + ZC_DV; T.ldv = ZP; T.O = ZIN + ZC_DQ; T.ldo = ZP;
              T.cdec = nullptr; T.relb = P.in[I_RELB] + (size_t)L * 4 * 513; T.qhs = 64; T.khs = 64; T.vhs = 64; T.ohs = 64;
              TIMED(8, if (REF_MASK & 2) att::attn_naive<att::MODE_BAND>(T); else att::attn_phase<att::MODE_BAND>(T, lds)); }
            __syncthreads();
        }
        SEAM(pb + 3);
        if (PH_ON(5) && IN(pb + 4)) {
            if (SUB_ON(0)) { att::Tensors T; T.Q = MLAQ; T.ldq = 512; T.K = MLAKV; T.ldk = 512; T.K2 = KPER; T.V = MLAKV + 64; T.ldv = 512; T.O = ZIN + ZC_CQ; T.ldo = ZP;
              T.cdec = nullptr; T.relb = nullptr; T.qhs = 96; T.khs = 128; T.vhs = 128; T.ohs = 64;
              TIMED(9, if (REF_MASK & 2) att::attn_naive<att::MODE_MLA>(T); else att::attn_phase<att::MODE_MLA>(T, lds)); }
            __syncthreads();
            if (SUB_ON(1)) { pg8::Gemm g{ZIN + ZC_U, wmix(P, L, WM_GLU), ZP, 256, 256, nullptr}; pg8::StaticOrder S; S.init(NTOK, 256, G, bx);
              epi::EpiGlu E{ZIN + ZC_U, ZP};
              TIMED(10, RUN_GEMM(epi::EpiGlu, pg8::StaticOrder, false, g, S, E)); }
        }
        SEAM(pb + 4);
        if (PH_ON(6) && IN(pb + 5)) {
            g128::MergeProg MP; MP.Hn = H; MP.zin = ZIN; MP.wg = wmix(P, L, WM_G); MP.wb = wmix(P, L, WM_B); MP.bg = P.in[I_BG] + (size_t)L * 4 * D; MP.M = MB;
            const int vcu_ = vcu_of();
            TIMED(11, g128::stream<g128::MergeProg>(lds, MP, 1024, vcu_, G));
        }
        SEAM(pb + 5);
#define PANEL_FENCE() do { asm volatile("s_waitcnt vmcnt(0)" ::: "memory"); __builtin_amdgcn_fence(__ATOMIC_ACQUIRE, "agent"); asm volatile("s_waitcnt vmcnt(0)" ::: "memory"); __syncthreads(); } while (0)
        if (PH_ON(7) && IN(pb + 6)) {
            pg8::Gemm g{MB, wmix(P, L, WM_O), D, D, D, nullptr}; pg8::StaticOrder S; S.init(NTOK, D, G, bx);
            epi::EpiRes E{xsrc, XR};
            TIMED(13, RUN_GEMM(epi::EpiRes, pg8::StaticOrder, false, g, S, E));
        }
        SEAM(pb + 6);
        if (PH_ON(8) && IN(pb + 7)) {
            const int vcu_ = vcu_of();
            if (L == 0) TIMED(14, norm_plain(XSrc{nullptr, XR}, P.in[I_GFFN], H, vcu_, G));
            else { TIMED(14, norm2_moe_phase(P, XSrc{nullptr, XR}, lds, vcu_, G)); TIMED(25, cvt_jobs(P, 43, 67, lds)); __syncthreads(); }
        }
        SEAM(pb + 7);
        if (L == 0) {
            if (PH_ON(9) && IN(9)) {
                pg8::Gemm g{H, (const bf16*)(P.ws + WS_W13), D, D, D, nullptr}; pg8::StaticOrder S; S.init(NTOK, 2 * DFF, G, bx);
                epi::EpiSwiglu E{(bf16*)(P.ws + WS_HMID), DFF, 22};
                TIMED(15, RUN_GEMM(epi::EpiSwiglu, pg8::StaticOrder, false, g, S, E));
            }
            SEAM(9);
            if (PH_ON(10) && IN(10)) {
                pg8::Gemm g{(const bf16*)(P.ws + WS_HMID), (const bf16*)(P.ws + WS_W2), DFF, DFF, DFF, nullptr}; pg8::StaticOrder S; S.init(NTOK, D, G, bx);
                epi::EpiRes E{XSrc{nullptr, XR}, XR};
                TIMED(16, RUN_GEMM(epi::EpiRes, pg8::StaticOrder, false, g, S, E));
            }
            SEAM(10);
        } else {
            if (PH_ON(21) && IN(21)) TIMED(17, moe_assign_phase(P));
            SEAM(21);
            if (PH_ON(22) && IN(22)) {
                pg8::Gemm g{H, (const bf16*)(P.ws + WS_WM13), D, D, D, slot_tok}; const MoeOrder S = moe_order(P, 11, G, bx);
                epi::EpiSwiglu E{(bf16*)(P.ws + WS_HMID), DFFE, 11};
                TIMED(18, RUN_GEMM(epi::EpiSwiglu, MoeOrder, true, g, S, E));
            }
            SEAM(22);
            if (PH_ON(23) && IN(23)) {
                pg8::Gemm g{(const bf16*)(P.ws + WS_HMID), (const bf16*)(P.ws + WS_WM2), DFFE, DFFE, DFFE, nullptr}; const MoeOrder S = moe_order(P, 4, G, bx);
                epi::EpiMoeDown E{(bf16*)(P.ws + WS_MOEY), slot_gate};
                TIMED(19, RUN_GEMM(epi::EpiMoeDown, MoeOrder, false, g, S, E));
            }
            SEAM(23);
        }
        if (PH_ON(12) && IN(pc + 3)) {
            const int vcu_ = vcu_of();
            if (L == 0) TIMED(20, norm_plain(XSrc{nullptr, XR}, P.in[I_GPLE] + L * D, H, vcu_, G)); else TIMED(20, norm_moe_combine(P, P.in[I_GPLE] + L * D, vcu_, G));
            PANEL_FENCE();
            g128::PleProg PP; PP.pbf = (const bf16*)(P.ws + WS_PBF) + (size_t)L * NTOK * 256; PP.hp = (L == 0) ? H : (const bf16*)(P.ws + WS_H2); PP.wup = wmix(P, L, WM_UP); PP.wpg = wmix(P, L, WM_PG); PP.x = XR;
            TIMED(22, g128::stream<g128::PleProg>(lds, PP, NTOK / 128, vcu_, G));
            PANEL_FENCE();
            if (L == 0) TIMED(1, norm1_phase(P, 1, XSrc{nullptr, XR}, vcu_, G));
        }
        if (L == 0) SEAM(pc + 3);
    }
    if (PH_ON(26) && IN(25)) {
        const int vcu_ = vcu_of(); const int G_ = gridDim.x;
        for (int r = 0; r < (NTOK / 128 + G_ - 1) / G_; ++r) {
            const int u = vcu_ + r * G_; FinalRows FR;
            if (u < NTOK / 128) final_norm_load(P, u, FR);
            xcd_barrier(bar);
            if (u < NTOK / 128) final_norm_store(P, u, FR);
        }
    }
    if (PROBE_MASK || PROBE_SEAMS) { const unsigned long long t0_ = __builtin_amdgcn_s_memrealtime(); while (__builtin_amdgcn_s_memrealtime() - t0_ < (unsigned long long)PROBE_MULT * pacc) __builtin_amdgcn_s_sleep(8); }
#undef IN
#undef SEAM
#undef H
#undef ZIN
#undef GB
#undef MB
#undef MLAQ
#undef MLAKV
#undef KPER
#undef cosT
#undef sinT
#undef slot_tok
#undef slot_gate
}

extern "C" void kernel_launch(void* const* d_in, const int* in_sizes, int n_in, void* d_out, int out_size, void* d_ws, size_t ws_size, hipStream_t stream) {
    static int grid = 0;
    if (grid == 0) {
        if (n_in != 37 || out_size != NTOK * D || ws_size < WS_END) { fprintf(stderr, "kernel_launch: unexpected shapes: n_in %d out %d ws %zu\n", n_in, out_size, ws_size); grid = -1; return; }
        int dev = 0, cus = 0, per_cu = 0;
        if (hipGetDevice(&dev) != hipSuccess || hipDeviceGetAttribute(&cus, hipDeviceAttributeMultiprocessorCount, dev) != hipSuccess) { grid = -1; return; }
        if (hipFuncSetAttribute((const void*)mega_fwd, hipFuncAttributeMaxDynamicSharedMemorySize, LDS_BYTES) != hipSuccess) { fprintf(stderr, "kernel_launch: hipFuncSetAttribute failed\n"); grid = -1; return; }
        if (hipOccupancyMaxActiveBlocksPerMultiprocessor(&per_cu, (const void*)mega_fwd, NTHREADS, LDS_BYTES) != hipSuccess || per_cu < 1)
            fprintf(stderr, "kernel_launch: note: occupancy query reports %d workgroups per CU\n", per_cu);
        (void)hipGetLastError();
        grid = cus;
        if (grid != 256) fprintf(stderr, "kernel_launch: note: %d CUs (built for 256)\n", grid);
    }
    if (grid < 0) return;
    if (hipMemsetAsync((char*)d_ws + WS_CTL, 0, CTL_ZERO_BYTES, stream) != hipSuccess) return;
    Params p{};
    for (int i = 0; i < 37; ++i) p.in[i] = (const float*)d_in[i];
    p.out = (float*)d_out; p.ws = (unsigned char*)d_ws;
#if N_LAUNCH_MODE == 1
    p.ph_lo = 0; p.ph_hi = N_PHASES;
    hipLaunchKernelGGL(mega_fwd, dim3(grid), dim3(NTHREADS), LDS_BYTES, stream, p);
#else
    for (int ph = 0; ph < N_PHASES; ++ph) { p.ph_lo = ph; p.ph_hi = ph + 1; hipLaunchKernelGGL(mega_fwd, dim3(grid), dim3(NTHREADS), LDS_BYTES, stream, p); }
#endif
    const hipError_t le = hipPeekAtLastError();
    if (le != hipSuccess) fprintf(stderr, "kernel_launch: launch failed: %s\n", hipGetErrorName(le));
}
```

```cpp
#include <hip/hip_runtime.h>
#include <cstdio>
#include <cstdint>

#define GAS __attribute__((address_space(1)))
#define LAS __attribute__((address_space(3)))
typedef unsigned short bf16;
typedef short bf16x8 __attribute__((ext_vector_type(8)));
typedef short s16x4 __attribute__((ext_vector_type(4)));
typedef float f32x2 __attribute__((ext_vector_type(2)));
typedef float f32x4 __attribute__((ext_vector_type(4)));
typedef float f32x16 __attribute__((ext_vector_type(16)));
typedef unsigned u32x2 __attribute__((ext_vector_type(2)));
typedef unsigned u32x4 __attribute__((ext_vector_type(4)));
typedef __bf16 bf16x2_t __attribute__((ext_vector_type(2)));

constexpr int NB = 4, SEQ = 8192, NTOK = NB * SEQ, D = 1024;
constexpr int ZP = 2304;
constexpr int ZC_U = 0, ZC_FQ = 256, ZC_FK = 512, ZC_FV = 768, ZC_DQ = 1024, ZC_DK = 1280, ZC_DV = 1536, ZC_CQ = 1792, ZC_CKV = 2048, ZC_KPE = 2176;
constexpr int DIN = 2148, DFF = 2816, DFFE = 1408, NE = 8;
constexpr int MOE_ROWS = 2 * NTOK + NE * 256;
constexpr float RMS_EPS = 1e-6f;
constexpr int NWAVES = 8, NTHREADS = 512;

constexpr size_t MiB = 1u << 20;
constexpr size_t WS_CTL = 0, CTL_ZERO_BYTES = 1 * MiB;
constexpr size_t WS_COS = 1 * MiB, WS_SIN = 3 * MiB;
constexpr size_t WS_LOGF = 5 * MiB;
constexpr size_t WS_CDEC = 5 * MiB + 512 * 1024;
constexpr size_t WS_WSUM = 6 * MiB;
constexpr size_t WS_RSTDQ = 6 * MiB + 256 * 1024, WS_RSTDKV = 6 * MiB + 512 * 1024;
constexpr size_t WS_SC = 7 * MiB;
constexpr size_t WS_TOKINFO = 11 * MiB;
constexpr size_t WS_SLOTTOK = 12 * MiB, WS_SLOTGATE = 12 * MiB + 512 * 1024;
constexpr size_t WS_S5W = 13 * MiB;
constexpr size_t WS_PBF = 17 * MiB;
constexpr size_t WS_WMIX = 49 * MiB, WMIX_STRIDE = 20 * MiB;
constexpr size_t WM_IN = 0, WM_G = 4 * MiB + 512 * 1024, WM_B = 12 * MiB + 512 * 1024, WM_O = 14 * MiB + 512 * 1024, WM_PG = 16 * MiB + 512 * 1024,
                 WM_UP = 18 * MiB + 512 * 1024, WM_UQ = 19 * MiB, WM_UKV = 19 * MiB + 256 * 1024, WM_GLU = 19 * MiB + 384 * 1024;
constexpr size_t WS_W13 = 89 * MiB, WS_W2 = 100 * MiB;
constexpr size_t WS_H = 106 * MiB;
constexpr size_t WS_MLAQ = 170 * MiB, WS_MLAKV = 202 * MiB, WS_KPER = 234 * MiB;
constexpr size_t WS_M = 170 * MiB;
constexpr size_t WS_ZIN = 236 * MiB;
constexpr size_t WS_G = 380 * MiB;
constexpr size_t WS_HMID = 236 * MiB;
constexpr size_t WS_U = 236 * MiB;
constexpr size_t WS_WM13 = 418 * MiB, WS_WM2 = 462 * MiB;
constexpr size_t WS_MOEY = 89 * MiB;
constexpr size_t WS_H2 = 300 * MiB;
constexpr size_t WS_END = 484 * MiB;
constexpr int CW_BAR = 4096;
constexpr int CW_MOECNT = 16384;
constexpr int CW_QMAX = 20480;
constexpr int CW_KMAX = 22528;

#define LDS_WAIT() asm volatile("s_waitcnt lgkmcnt(0)" ::: "memory")
#define VM_WAIT() asm volatile("s_waitcnt vmcnt(0)" ::: "memory")
__device__ __forceinline__ unsigned f2bf(float f) { unsigned u = __builtin_bit_cast(unsigned, f); return (u + 0x7fffu + ((u >> 16) & 1u)) >> 16; }
__device__ __forceinline__ unsigned pk2(float lo, float hi) { f32x2 v = {lo, hi}; bf16x2_t b = __builtin_convertvector(v, bf16x2_t); return __builtin_bit_cast(unsigned, b); }
__device__ __forceinline__ float bf2f(unsigned short b) { return __uint_as_float((unsigned)b << 16); }
__device__ __forceinline__ float bflo(unsigned w) { return __uint_as_float(w << 16); }
__device__ __forceinline__ float bfhi(unsigned w) { return __uint_as_float(w & 0xffff0000u); }
constexpr int TID_TAB_OFF = 147456 - 512;
__device__ __forceinline__ unsigned hw_wave_key() { return (unsigned)__builtin_amdgcn_s_getreg((5 << 11) | 4) & 0x3Fu; }
__device__ __forceinline__ int my_tid() {
    unsigned addr = (unsigned)TID_TAB_OFF + 4u * hw_wave_key(); asm volatile("" : "+s"(addr));
    const int wave = __builtin_amdgcn_readfirstlane(*(const LAS int*)(uintptr_t)addr);
    int lane = (int)__builtin_amdgcn_mbcnt_hi(~0u, __builtin_amdgcn_mbcnt_lo(~0u, 0u)); asm volatile("" : "+v"(lane));
    return wave * 64 + lane;
}
__device__ __forceinline__ float shflx(float v, int o, int lane) { return __int_as_float(__builtin_amdgcn_ds_bpermute((lane ^ o) << 2, __float_as_int(v))); }
#define DPP_F(x_, ctrl_, rm_) __int_as_float(__builtin_amdgcn_update_dpp(0, __float_as_int(x_), (ctrl_), (rm_), 0xF, true))
__device__ __forceinline__ float wave_sum(float v) {
    v += DPP_F(v, 0xB1, 0xF); v += DPP_F(v, 0x4E, 0xF); v += DPP_F(v, 0x114, 0xF); v += DPP_F(v, 0x118, 0xF);
    v += DPP_F(v, 0x142, 0xA); v += DPP_F(v, 0x143, 0xC);
    return __int_as_float(__builtin_amdgcn_readlane(__float_as_int(v), 63));
}
__device__ __forceinline__ float sigmoidf_(float x) { return __builtin_amdgcn_rcpf(1.0f + __expf(-x)); }

struct XSrc { const float* f; const bf16* b; };
__device__ __forceinline__ f32x4 ldx4(const XSrc& x, size_t idx) {
    if (x.f) return *(const f32x4*)(x.f + idx);
    const u32x2 w = *(const u32x2*)(x.b + idx); return (f32x4){bflo(w.x), bfhi(w.x), bflo(w.y), bfhi(w.y)};
}
__device__ __forceinline__ bf16* xr_of(float* out) { return (bf16*)((unsigned char*)out + (size_t)NTOK * D * 2); }
#define BODY_IDS() int tid = my_tid(); asm volatile("" : "+v"(tid)); const int lane = tid & 63; const int wave = __builtin_amdgcn_readfirstlane(tid >> 6); \
    int grid_ = gridDim.x; asm volatile("" : "+s"(grid_)); \
    const int gw = blockIdx.x * NWAVES + wave, ngw = grid_ * NWAVES, gtid = blockIdx.x * NTHREADS + tid, gthreads = grid_ * NTHREADS; (void)lane; (void)wave; (void)gw; (void)ngw; (void)gtid; (void)gthreads
#define XB_TMO      128
#define XB_XCNT(j)  (256  + 64 * (j))
#define XB_XSUB(j)  (1280 + 64 * (j))
#define XB_XGEN(j)  (2304 + 64 * (j))
#define XB_TOP      3328
#define XB_TOPGEN   3392
#define XCD_BAR_WORDS 3456
#define XB_SPIN_CAP (1u << 22)

__device__ __forceinline__ unsigned xb_ld(unsigned* p)              { return __hip_atomic_load(p, __ATOMIC_RELAXED, __HIP_MEMORY_SCOPE_AGENT); }
__device__ __forceinline__ unsigned xb_add(unsigned* p, unsigned v) { return __hip_atomic_fetch_add(p, v, __ATOMIC_RELAXED, __HIP_MEMORY_SCOPE_AGENT); }
__device__ __forceinline__ unsigned xb_xcc_id() { return (unsigned)__builtin_amdgcn_s_getreg((3 << 11) | 20) & 0xFu; }
#define XB_SPIN(cond, bar) do { unsigned _sp = 0; while (cond) { __builtin_amdgcn_s_sleep(1); \
    if ((++_sp & 255u) == 0u) { if (xb_ld(&(bar)[XB_TMO])) break; if (_sp > XB_SPIN_CAP) { atomicAdd(&(bar)[XB_TMO], 1u); break; } } } } while (0)

struct XcdBarrier { unsigned* bar; unsigned x; volatile LAS unsigned* st; };

__device__ __forceinline__ XcdBarrier xcd_barrier_post(unsigned* bar, volatile LAS unsigned* st) {
    XcdBarrier b; b.bar = bar; b.x = xb_xcc_id(); b.st = st;
    if (my_tid() == 0) (void)xb_add(&bar[XB_XCNT(b.x)], 1u);
    return b;
}
__device__ __forceinline__ void xcd_barrier_complete(unsigned* bar, unsigned x, unsigned& nloc, unsigned& nx) {
    const unsigned G = gridDim.x * gridDim.y * gridDim.z;
    unsigned sum, cnt, mine, sp = 0u;
    for (;;) {
        sum = 0u; cnt = 0u; mine = 0u;
#pragma unroll
        for (unsigned j = 0; j < 16; ++j) { const unsigned c = xb_ld(&bar[XB_XCNT(j)]); sum += c; cnt += (c > 0u) ? 1u : 0u; mine = (j == x) ? c : mine; }
        if (sum == G) break;
        __builtin_amdgcn_s_sleep(1);
        if ((++sp & 255u) == 0u) { if (xb_ld(&bar[XB_TMO])) break; if (sp > XB_SPIN_CAP) { atomicAdd(&bar[XB_TMO], 1u); break; } }
    }
    nloc = mine > 0u ? mine : 1u; nx = cnt > 0u ? cnt : 1u;
}
__device__ __forceinline__ void xcd_barrier(const XcdBarrier& b) {
    asm volatile("s_waitcnt vmcnt(0)" ::: "memory");
    __syncthreads();
    if (my_tid() == 0) {
        unsigned* bar = b.bar;
        __builtin_amdgcn_s_waitcnt(0);
        unsigned nloc = b.st[0], nx = b.st[1];
        if (nloc == 0u) { xcd_barrier_complete(bar, b.x, nloc, nx); b.st[0] = nloc; b.st[1] = nx; }
        const unsigned old = xb_add(&bar[XB_XSUB(b.x)], 1u);
        const unsigned gen = old / nloc;
        if (old + 1u == (gen + 1u) * nloc) {
            __builtin_amdgcn_fence(__ATOMIC_RELEASE, "agent");
            asm volatile("s_waitcnt vmcnt(0)" ::: "memory");
            const unsigned og = xb_add(&bar[XB_TOP], 1u);
            const unsigned tg = og / nx;
            if (og + 1u == (tg + 1u) * nx) xb_add(&bar[XB_TOPGEN], 1u);
            else XB_SPIN(xb_ld(&bar[XB_TOPGEN]) == tg, bar);
            __builtin_amdgcn_fence(__ATOMIC_ACQUIRE, "agent");
            xb_add(&bar[XB_XGEN(b.x)], 1u);
            asm volatile("s_waitcnt vmcnt(0)" ::: "memory");
        } else {
            XB_SPIN(xb_ld(&bar[XB_XGEN(b.x)]) == gen, bar);
            __builtin_amdgcn_fence(__ATOMIC_ACQUIRE, "agent");
            asm volatile("s_waitcnt vmcnt(0)" ::: "memory");
        }
    }
    __syncthreads();
}
namespace pg8 {
constexpr int BM = 256, BK = 64, HALF = 128, HTB = HALF * BK * 2, STAGE_BYTES = 8 * HTB, NXCD = 8, WGM = 8;
__host__ __device__ __forceinline__ int lds_byte(int r, int c) { const int st = (r >> 4) * 2 + (c >> 5), rr = r & 15, cc = c & 31, ob = rr * 64 + cc * 2; return st * 1024 + (ob ^ (((ob >> 9) & 1) << 5)); }
__host__ __device__ __forceinline__ void stage_rc(int b, int& R, int& C) { const int st = b / 1024, sb = b % 1024, swz = sb ^ (((sb >> 9) & 1) << 5); R = (st >> 1) * 16 + swz / 64; C = (st & 1) * 32 + (swz % 64) / 2; }
__host__ __device__ __forceinline__ int perm32(int rho) { const int n = rho >> 4, i = rho & 15; return 8 * (i >> 2) + 4 * n + (i & 3); }

struct Unit { int pm, pn; };
struct Gemm { const bf16* A; const bf16* Bt; int lda, ldb, K; const int* gidx; };

struct StaticOrder {
    int nM, nN, nwg, G, c;
    __host__ __device__ void init(int M, int N, int G_, int c_) { nM = M / BM; nN = N / BM; nwg = nM * nN; G = G_; c = c_; }
    __host__ __device__ __forceinline__ bool next(int i, Unit& u) const {
        const long L = (long)i * G + c; if (L >= nwg) return false;
        int wgid = (int)L; { const int q = nwg / NXCD, r = nwg % NXCD, xcd = wgid % NXCD, off = wgid / NXCD; wgid = (xcd < r ? xcd * (q + 1) : r * (q + 1) + (xcd - r) * q) + off; }
        const int nig = WGM * nN, gid = wgid / nig, fm = gid * WGM, gsz = (nM - fm) < WGM ? (nM - fm) : WGM;
        u.pm = fm + ((wgid % nig) % gsz); u.pn = (wgid % nig) / gsz; return true;
    }
};

template <class Epi, class Sched, bool ALIGN_EPI, bool GATHER>
__device__ __forceinline__ void gemm_phase(LAS unsigned char* lds, const Gemm g, const Sched& S, const Epi& E) {
    int tid = my_tid(); asm volatile("" : "+v"(tid));
    const int wid = __builtin_amdgcn_readfirstlane(tid >> 6), lane = tid & 63, wr = wid >> 2, wc = wid & 3, fr = lane & 15, fq = lane >> 4;
    int Kq = g.K; asm volatile("" : "+s"(Kq));
    const int K = Kq, nt = K / BK;
    int RA[2], CA[2];
    unsigned voffA[2], voffB[2];
#pragma unroll
    for (int i = 0; i < 2; ++i) { int R, C; stage_rc(tid * 16 + i * 8192, R, C); const int Rb = Epi::PERM ? ((R & ~31) + perm32(R & 31)) : R;
        RA[i] = R; CA[i] = C; voffA[i] = (unsigned)(R * g.lda + C) * 2u; voffB[i] = (unsigned)(Rb * g.ldb + C) * 2u; }
    const size_t kstep = (size_t)(BK * 2);
    const size_t hstepB = (size_t)HALF * g.ldb * 2, tstepB = 2 * hstepB;
    const size_t hstepA = (size_t)HALF * g.lda * 2, tstepA = 2 * hstepA;
    const unsigned ldsw = (unsigned)wid * 1024u;
    const int aoff = lds_byte(wr * 64 + fr, fq * 8), boff = lds_byte(wc * 32 + fr, fq * 8);
#define PG8_SA(b, h) (((b) * 2 + (h)) * HTB)
#define PG8_SB(b, h) ((4 + (b) * 2 + (h)) * HTB)
#define PG8_STAGEB(bufoff, gbase) do { _Pragma("unroll") for (int _i = 0; _i < 2; ++_i) \
        __builtin_amdgcn_global_load_lds((const unsigned*)((const char*)(gbase) + voffB[_i]), (LAS unsigned*)(lds + (bufoff) + ldsw + _i * 8192), 16, 0, 0); } while (0)
#define PG8_STAGEA(bufoff, kptr, isnext, h) do { _Pragma("unroll") for (int _i = 0; _i < 2; ++_i) { const char* _p; \
        if constexpr (GATHER) _p = (const char*)(kptr) + ((isnext) ? nvo[h][_i] : cvo[h][_i]); else _p = (const char*)(kptr) + (size_t)(h) * hstepA + voffA[_i]; \
        __builtin_amdgcn_global_load_lds((const unsigned*)_p, (LAS unsigned*)(lds + (bufoff) + ldsw + _i * 8192), 16, 0, 0); } } while (0)
#define PG8_LDA(dst, b, h) do { _Pragma("unroll") for (int m = 0; m < 4; ++m) _Pragma("unroll") for (int k = 0; k < 2; ++k) dst[m][k] = *(const LAS bf16x8*)(lds + PG8_SA(b, h) + aoff + m * 2048 + k * 1024); } while (0)
#define PG8_LDB(dst, b, h) do { _Pragma("unroll") for (int n = 0; n < 2; ++n) _Pragma("unroll") for (int k = 0; k < 2; ++k) dst[n][k] = *(const LAS bf16x8*)(lds + PG8_SB(b, h) + boff + n * 2048 + k * 1024); } while (0)
#define PG8_MMA(ai, bj, At, Bt) do { __builtin_amdgcn_s_setprio(1); _Pragma("unroll") for (int m = 0; m < 4; ++m) _Pragma("unroll") for (int n = 0; n < 2; ++n) _Pragma("unroll") for (int k = 0; k < 2; ++k) \
        acc[ai][bj][m][n] = __builtin_amdgcn_mfma_f32_16x16x32_bf16(Bt[n][k], At[m][k], acc[ai][bj][m][n], 0, 0, 0); __builtin_amdgcn_s_setprio(0); } while (0)
#define PG8_WAIT_V(n) asm volatile("s_waitcnt vmcnt(" #n ")" ::: "memory")
#define PG8_WAIT_L(n) asm volatile("s_waitcnt lgkmcnt(" #n ")" ::: "memory")
#define PG8_BAR __builtin_amdgcn_s_barrier()
#define PG8_SCHED __builtin_amdgcn_sched_barrier(0)
#define PG8_VOA(vo, u) do { _Pragma("unroll") for (int _h = 0; _h < 2; ++_h) _Pragma("unroll") for (int _i = 0; _i < 2; ++_i) { \
        int _row = (u).pm * BM + _h * HALF + RA[_i]; if (GATHER) { _row = g.gidx[_row]; _row = _row < 0 ? 0 : _row; } \
        (vo)[_h][_i] = (unsigned)_row * (unsigned)(g.lda * 2) + (unsigned)(CA[_i] * 2); } } while (0)
    Unit cur, nxt; int ui = 0;
    if (!S.next(0, cur)) return;
    f32x4 acc[2][2][4][2];
#pragma unroll
    for (int a = 0; a < 2; ++a)
#pragma unroll
        for (int b = 0; b < 2; ++b)
#pragma unroll
            for (int m = 0; m < 4; ++m)
#pragma unroll
                for (int n = 0; n < 2; ++n) acc[a][b][m][n] = (f32x4){0.f, 0.f, 0.f, 0.f};
    bf16x8 At[4][2], B0[2][2], B1[2][2];
    unsigned cvo[2][2], nvo[2][2];
    if constexpr (GATHER) { PG8_VOA(cvo, cur); PG8_VOA(nvo, cur); }
    const char* cA = (const char*)g.A + (GATHER ? (size_t)0 : (size_t)cur.pm * tstepA); const char* cB = (const char*)g.Bt + (size_t)cur.pn * tstepB;
    PG8_STAGEB(PG8_SB(0, 0), cB); PG8_STAGEB(PG8_SB(0, 1), cB + hstepB); PG8_STAGEA(PG8_SA(0, 0), cA, false, 0); PG8_STAGEA(PG8_SA(0, 1), cA, false, 1);
    if (wr == 1) PG8_BAR;
    PG8_WAIT_V(2); PG8_BAR;
    PG8_STAGEB(PG8_SB(1, 0), cB + kstep); PG8_STAGEA(PG8_SA(1, 0), cA + kstep, false, 0); PG8_STAGEB(PG8_SB(1, 1), cB + hstepB + kstep);
    PG8_WAIT_V(6); PG8_BAR;
    for (;;) {
        const bool has_next = S.next(ui + 1, nxt);
        if constexpr (GATHER) { if (has_next) { PG8_VOA(nvo, nxt); } }
        const char* nA = (GATHER || !has_next) ? cA : (const char*)g.A + (size_t)nxt.pm * tstepA;
        const char* nB = has_next ? (const char*)g.Bt + (size_t)nxt.pn * tstepB : cB;
#pragma nounroll
        for (int t = 0; t < nt; t += 2) {
            const bool last = (t == nt - 2);
            const char* a1 = cA + (size_t)(t + 1) * kstep;
            const char* a2 = last ? nA : cA + (size_t)(t + 2) * kstep; const char* b2 = last ? nB : cB + (size_t)(t + 2) * kstep;
            const char* a3 = a2 + kstep; const char* b3 = b2 + kstep;
            PG8_LDB(B0, 0, 0); PG8_LDB(B1, 0, 1); PG8_SCHED; PG8_LDA(At, 0, 0); PG8_STAGEA(PG8_SA(1, 1), a1, false, 1);
            PG8_WAIT_V(8); PG8_WAIT_L(0); PG8_BAR; PG8_MMA(0, 0, At, B0); PG8_MMA(0, 1, At, B1); PG8_BAR; PG8_SCHED;
            PG8_LDA(At, 0, 1); PG8_STAGEB(PG8_SB(0, 0), b2); PG8_STAGEB(PG8_SB(0, 1), b2 + hstepB); PG8_STAGEA(PG8_SA(0, 0), a2, last, 0);
            PG8_WAIT_V(8); PG8_WAIT_L(0); PG8_BAR; PG8_MMA(1, 0, At, B0); PG8_MMA(1, 1, At, B1); PG8_BAR; PG8_SCHED;
            PG8_LDB(B0, 1, 0); PG8_LDB(B1, 1, 1); PG8_SCHED; PG8_LDA(At, 1, 0); PG8_STAGEA(PG8_SA(0, 1), a2, last, 1);
            PG8_WAIT_V(8); PG8_WAIT_L(0); PG8_BAR; PG8_MMA(0, 0, At, B0); PG8_MMA(0, 1, At, B1); PG8_BAR; PG8_SCHED;
            PG8_LDA(At, 1, 1); PG8_STAGEB(PG8_SB(1, 0), b3); PG8_STAGEB(PG8_SB(1, 1), b3 + hstepB); PG8_STAGEA(PG8_SA(1, 0), a3, last, 0);
            PG8_WAIT_V(8); PG8_WAIT_L(0); PG8_BAR; PG8_MMA(1, 0, At, B0); PG8_MMA(1, 1, At, B1); PG8_BAR; PG8_SCHED;
        }
        if constexpr (ALIGN_EPI) { if (wr == 0) PG8_BAR; }
        E(acc, cur, wr, wc, fr, fq);
        if (!has_next) break;
#pragma unroll
        for (int a = 0; a < 2; ++a)
#pragma unroll
            for (int b = 0; b < 2; ++b)
#pragma unroll
                for (int m = 0; m < 4; ++m)
#pragma unroll
                    for (int n = 0; n < 2; ++n) acc[a][b][m][n] = (f32x4){0.f, 0.f, 0.f, 0.f};
        cur = nxt; cA = nA; cB = nB; ++ui;
        if constexpr (GATHER) {
#pragma unroll
            for (int _h = 0; _h < 2; ++_h)
#pragma unroll
                for (int _i = 0; _i < 2; ++_i) cvo[_h][_i] = nvo[_h][_i]; }
        if constexpr (ALIGN_EPI) { if (wr == 1) PG8_BAR; }
    }
    PG8_WAIT_V(0);
    if constexpr (!ALIGN_EPI) { if (wr == 0) PG8_BAR; }
    PG8_BAR;
#undef PG8_SA
#undef PG8_SB
#undef PG8_STAGEA
#undef PG8_STAGEB
#undef PG8_LDA
#undef PG8_LDB
#undef PG8_MMA
#undef PG8_WAIT_V
#undef PG8_WAIT_L
#undef PG8_BAR
#undef PG8_SCHED
#undef PG8_VOA
}

template <class Epi, class Sched, bool GATHER>
__device__ __forceinline__ void gemm_phase_naive(const Gemm g, const Sched& S, const Epi& E) {
    const int tid = threadIdx.x, wid = tid >> 6, lane = tid & 63, wr = wid >> 2, wc = wid & 3, fr = lane & 15, fq = lane >> 4;
    Unit u;
    for (int ui = 0; S.next(ui, u); ++ui) {
        f32x4 acc[2][2][4][2];
#pragma unroll
        for (int a = 0; a < 2; ++a)
#pragma unroll
            for (int b = 0; b < 2; ++b)
#pragma unroll
                for (int m = 0; m < 4; ++m)
#pragma unroll
                    for (int n = 0; n < 2; ++n) acc[a][b][m][n] = (f32x4){0.f, 0.f, 0.f, 0.f};
        const bf16* arow[2][4];
#pragma unroll
        for (int ai = 0; ai < 2; ++ai)
#pragma unroll
            for (int m = 0; m < 4; ++m) { int r = u.pm * BM + ai * HALF + wr * 64 + m * 16 + fr; if (GATHER) { r = g.gidx[r]; r = r < 0 ? 0 : r; } arow[ai][m] = g.A + (size_t)r * g.lda; }
        for (int k = 0; k < g.K; k += 4) {
            float av[2][4][4];
#pragma unroll
            for (int ai = 0; ai < 2; ++ai)
#pragma unroll
                for (int m = 0; m < 4; ++m) { const u32x2 w = *(const u32x2*)(arow[ai][m] + k); av[ai][m][0] = bflo(w.x); av[ai][m][1] = bfhi(w.x); av[ai][m][2] = bflo(w.y); av[ai][m][3] = bfhi(w.y); }
#pragma unroll
            for (int bj = 0; bj < 2; ++bj)
#pragma unroll
                for (int n = 0; n < 2; ++n)
#pragma unroll
                    for (int e = 0; e < 4; ++e) {
                        const int col = u.pn * BM + bj * HALF + wc * 32 + (Epi::PERM ? (8 * fq + 4 * n) : (16 * n + 4 * fq)) + e;
                        const u32x2 w = *(const u32x2*)(g.Bt + (size_t)col * g.ldb + k);
                        const float b0 = bflo(w.x), b1 = bfhi(w.x), b2 = bflo(w.y), b3 = bfhi(w.y);
#pragma unroll
                        for (int ai = 0; ai < 2; ++ai)
#pragma unroll
                            for (int m = 0; m < 4; ++m) acc[ai][bj][m][n][e] += av[ai][m][0] * b0 + av[ai][m][1] * b1 + av[ai][m][2] * b2 + av[ai][m][3] * b3;
                    }
        }
        E(acc, u, wr, wc, fr, fq);
    }
    VM_WAIT(); __syncthreads();
}
}
namespace g128 {
using pg8::lds_byte; using pg8::stage_rc; using pg8::HTB; using pg8::BK;
struct Seg { const bf16* A; const bf16* B; int lda, ldb, nt; };
typedef f32x4 acc_t[2][4][2];

template <class Prog>
__device__ __forceinline__ void stream(LAS unsigned char* lds, Prog& P, int nunits, int first, int stride) {
    int tid = my_tid(); asm volatile("" : "+v"(tid));
    const int wid = __builtin_amdgcn_readfirstlane(tid >> 6), lane = tid & 63, wr = wid >> 2, wc = wid & 3, fr = lane & 15, fq = lane >> 4;
    int RA[2], CA[2], RB[2];
#pragma unroll
    for (int i = 0; i < 2; ++i) { stage_rc(tid * 16 + i * 8192, RA[i], CA[i]); RB[i] = (RA[i] & ~31) + pg8::perm32(RA[i] & 31); }
    const unsigned ldsw = (unsigned)wid * 1024u;
    const int aoff = lds_byte(wr * 64 + fr, fq * 8), boff = lds_byte(wc * 32 + fr, fq * 8);
#define G_SA(b) ((b) * HTB)
#define G_SB(b, h) ((2 + (b) * 2 + (h)) * HTB)
#define G_STAGE(bufoff, base, ld, kbyte, RR) do { _Pragma("unroll") for (int _i = 0; _i < 2; ++_i) \
        __builtin_amdgcn_global_load_lds((const unsigned*)((const char*)(base) + (size_t)(kbyte) + (unsigned)(RR[_i] * (ld) + CA[_i]) * 2u), (LAS unsigned*)(lds + (bufoff) + ldsw + _i * 8192), 16, 0, 0); } while (0)
#define G_STAGE_A(b, S, j) G_STAGE(G_SA(b), (S).A, (S).lda, (j) * 128, RA)
#define G_STAGE_B(b, h, S, j) G_STAGE(G_SB(b, h), (const char*)(S).B + (size_t)(h) * 128 * (S).ldb * 2, (S).ldb, (j) * 128, RB)
#define G_LDA(dst, b) do { _Pragma("unroll") for (int m = 0; m < 4; ++m) _Pragma("unroll") for (int k = 0; k < 2; ++k) dst[m][k] = *(const LAS bf16x8*)(lds + G_SA(b) + aoff + m * 2048 + k * 1024); } while (0)
#define G_LDB(dst, b, h) do { _Pragma("unroll") for (int n = 0; n < 2; ++n) _Pragma("unroll") for (int k = 0; k < 2; ++k) dst[n][k] = *(const LAS bf16x8*)(lds + G_SB(b, h) + boff + n * 2048 + k * 1024); } while (0)
#define G_MMA(bj, At, Bt) do { __builtin_amdgcn_s_setprio(1); _Pragma("unroll") for (int m = 0; m < 4; ++m) _Pragma("unroll") for (int n = 0; n < 2; ++n) _Pragma("unroll") for (int k = 0; k < 2; ++k) \
        acc[bj][m][n] = __builtin_amdgcn_mfma_f32_16x16x32_bf16(Bt[n][k], At[m][k], acc[bj][m][n], 0, 0, 0); __builtin_amdgcn_s_setprio(0); } while (0)
#define G_WAIT_V(n) asm volatile("s_waitcnt vmcnt(" #n ")" ::: "memory")
#define G_WAIT_L(n) asm volatile("s_waitcnt lgkmcnt(" #n ")" ::: "memory")
#define G_BAR __builtin_amdgcn_s_barrier()
#define G_SCHED __builtin_amdgcn_sched_barrier(0)
    if (first >= nunits) return;
    P.reset();
    int ucur = first, scur = 0;
    Seg cur, nxt;
    P.seg(ucur, scur, cur);
    acc_t acc;
    P.init(ucur, scur, acc, wr, wc, fr, fq);
    bf16x8 At[4][2], B0[2][2], B1[2][2];
    G_STAGE_B(0, 0, cur, 0); G_STAGE_A(0, cur, 0); G_STAGE_B(0, 1, cur, 0);
    if (wr == 1) G_BAR;
    G_WAIT_V(2); G_BAR;
    G_STAGE_A(1, cur, 1); G_STAGE_B(1, 0, cur, 1);
    G_WAIT_V(4); G_BAR;
#define G_TILE(t_, b_) do { const bool n1_ = ((t_) + 1 >= nt), n2_ = ((t_) + 2 >= nt); const int j1_ = n1_ ? ((t_) + 1 - nt) : ((t_) + 1), j2_ = n2_ ? ((t_) + 2 - nt) : ((t_) + 2); \
        G_LDB(B0, b_, 0); G_SCHED; G_LDA(At, b_); \
        if (n1_) G_STAGE_B((b_) ^ 1, 1, nxt, j1_); else G_STAGE_B((b_) ^ 1, 1, cur, j1_); \
        G_WAIT_V(6); G_WAIT_L(0); G_BAR; G_MMA(0, At, B0); G_BAR; G_SCHED; \
        G_LDB(B1, b_, 1); \
        if (n2_) { G_STAGE_A(b_, nxt, j2_); G_STAGE_B(b_, 0, nxt, j2_); } else { G_STAGE_A(b_, cur, j2_); G_STAGE_B(b_, 0, cur, j2_); } \
        G_WAIT_V(6); G_WAIT_L(0); G_BAR; G_MMA(1, At, B1); G_BAR; G_SCHED; } while (0)
    for (;;) {
        int unxt = ucur, snxt = scur + 1; bool more = true;
        if (snxt == Prog::NSEG) { snxt = 0; unxt = ucur + stride; if (unxt >= nunits) { more = false; unxt = ucur; snxt = scur; } }
        P.seg(unxt, snxt, nxt);
        int ntq = cur.nt; asm volatile("" : "+s"(ntq)); const int nt = ntq;
#pragma nounroll
        for (int t = 0; t < nt; t += 2) { G_TILE(t, 0); G_TILE(t + 1, 1); }
        P.done(ucur, scur, acc, wr, wc, fr, fq);
        if (!more) break;
        P.init(unxt, snxt, acc, wr, wc, fr, fq);
        ucur = unxt; scur = snxt; cur = nxt;
    }
    G_WAIT_V(0);
    if (wr == 0) G_BAR;
    G_BAR;
#undef G_SA
#undef G_SB
#undef G_STAGE
#undef G_STAGE_A
#undef G_STAGE_B
#undef G_LDA
#undef G_LDB
#undef G_MMA
#undef G_WAIT_V
#undef G_WAIT_L
#undef G_BAR
#undef G_SCHED
#undef G_TILE
}

struct MergeProg {
    static constexpr int NSEG = 8;
    const bf16* Hn; const bf16* zin; const bf16* wg; const bf16* wb; const float* bg; bf16* M;
    __device__ __forceinline__ void reset() {
#pragma unroll
        for (int a = 0; a < 2; ++a)
#pragma unroll
            for (int b = 0; b < 4; ++b)
#pragma unroll
                for (int c = 0; c < 2; ++c) { g[a][b][c] = (u32x2){0u, 0u}; macc[a][b][c] = (u32x2){0u, 0u}; } }
    u32x2 g[2][4][2]; u32x2 macc[2][4][2];
    __device__ __forceinline__ void seg(int u, int s, Seg& S) const {
        const int pm = u >> 2, pn = u & 3, k = s >> 1;
        if ((s & 1) == 0) { S.A = Hn + (size_t)pm * 128 * D; S.lda = D; S.B = wg + ((size_t)k * D + pn * 256) * D; S.ldb = D; S.nt = D / 64; }
        else { const int ycol = (k == 0) ? ZC_U : (k == 1) ? ZC_FQ : (k == 2) ? ZC_CQ : ZC_DQ;
               S.A = zin + (size_t)pm * 128 * ZP + ycol; S.lda = ZP; S.B = wb + ((size_t)k * D + pn * 256) * 256; S.ldb = 256; S.nt = 4; }
    }
    __device__ __forceinline__ void init(int u, int s, acc_t& acc, int wr, int wc, int fr, int fq) {
        const int pn = u & 3, k = s >> 1;
        if ((s & 1) == 0) {
#pragma unroll
            for (int bj = 0; bj < 2; ++bj)
#pragma unroll
                for (int n = 0; n < 2; ++n) { const f32x4 bv = *(const f32x4*)(bg + (size_t)k * D + pn * 256 + bj * 128 + wc * 32 + 8 * fq + 4 * n);
#pragma unroll
                    for (int m = 0; m < 4; ++m) acc[bj][m][n] = bv; }
            if (s == 0) {
#pragma unroll
                for (int bj = 0; bj < 2; ++bj)
#pragma unroll
                    for (int m = 0; m < 4; ++m)
#pragma unroll
                        for (int n = 0; n < 2; ++n) macc[bj][m][n] = (u32x2){0u, 0u}; }
        } else {
#pragma unroll
            for (int bj = 0; bj < 2; ++bj)
#pragma unroll
                for (int m = 0; m < 4; ++m)
#pragma unroll
                    for (int n = 0; n < 2; ++n) acc[bj][m][n] = (f32x4){0.f, 0.f, 0.f, 0.f};
        }
    }
    __device__ __forceinline__ void done(int u, int s, const acc_t& acc, int wr, int wc, int fr, int fq) {
        if ((s & 1) == 0) {
#pragma unroll
            for (int bj = 0; bj < 2; ++bj)
#pragma unroll
                for (int m = 0; m < 4; ++m)
#pragma unroll
                    for (int n = 0; n < 2; ++n) { const f32x4 a = acc[bj][m][n]; u32x2 w; w.x = pk2(sigmoidf_(a[0]), sigmoidf_(a[1])); w.y = pk2(sigmoidf_(a[2]), sigmoidf_(a[3])); g[bj][m][n] = w; }
        } else {
#pragma unroll
            for (int bj = 0; bj < 2; ++bj)
#pragma unroll
                for (int m = 0; m < 4; ++m)
#pragma unroll
                    for (int n = 0; n < 2; ++n) { const u32x2 w = g[bj][m][n], q = macc[bj][m][n]; const f32x4 v = (f32x4){bflo(q.x), bfhi(q.x), bflo(q.y), bfhi(q.y)} + (f32x4){bflo(w.x), bfhi(w.x), bflo(w.y), bfhi(w.y)} * acc[bj][m][n];
                        u32x2 r; r.x = pk2(v[0], v[1]); r.y = pk2(v[2], v[3]); macc[bj][m][n] = r; }
            if (s == NSEG - 1) { const int pm = u >> 2, pn = u & 3;
#pragma unroll
                for (int m = 0; m < 4; ++m) { bf16* rp = M + (size_t)(pm * 128 + wr * 64 + m * 16 + fr) * D + pn * 256 + wc * 32 + 8 * fq;
#pragma unroll
                    for (int bj = 0; bj < 2; ++bj) *(u32x4*)(rp + bj * 128) = (u32x4){macc[bj][m][0].x, macc[bj][m][0].y, macc[bj][m][1].x, macc[bj][m][1].y}; } }
        }
    }
};

struct PleProg {
    static constexpr int NSEG = 8;
    const bf16* pbf; const bf16* hp; const bf16* wup; const bf16* wpg; bf16* x;
    u32x2 uu[2][4][2];
    __device__ __forceinline__ void reset() {
#pragma unroll
        for (int a = 0; a < 2; ++a)
#pragma unroll
            for (int b = 0; b < 4; ++b)
#pragma unroll
                for (int c = 0; c < 2; ++c) uu[a][b][c] = (u32x2){0u, 0u}; }
    __device__ __forceinline__ void seg(int u, int s, Seg& S) const {
        const int pn = s >> 1;
        if ((s & 1) == 0) { S.A = pbf + (size_t)u * 128 * 256; S.lda = 256; S.B = wup + (size_t)pn * 256 * 256; S.ldb = 256; S.nt = 4; }
        else { S.A = hp + (size_t)u * 128 * D; S.lda = D; S.B = wpg + (size_t)pn * 256 * D; S.ldb = D; S.nt = D / 64; }
    }
    __device__ __forceinline__ void init(int u, int s, acc_t& acc, int wr, int wc, int fr, int fq) {
#pragma unroll
        for (int bj = 0; bj < 2; ++bj)
#pragma unroll
            for (int m = 0; m < 4; ++m)
#pragma unroll
                for (int n = 0; n < 2; ++n) acc[bj][m][n] = (f32x4){0.f, 0.f, 0.f, 0.f};
    }
    __device__ __forceinline__ void done(int u, int s, const acc_t& acc, int wr, int wc, int fr, int fq) {
        if ((s & 1) == 0) {
#pragma unroll
            for (int bj = 0; bj < 2; ++bj)
#pragma unroll
                for (int m = 0; m < 4; ++m)
#pragma unroll
                    for (int n = 0; n < 2; ++n) { const f32x4 a = acc[bj][m][n]; u32x2 w; w.x = pk2(a[0], a[1]); w.y = pk2(a[2], a[3]); uu[bj][m][n] = w; }
        } else { const int pn = s >> 1;
#pragma unroll
            for (int m = 0; m < 4; ++m) { bf16* rp = x + (size_t)(u * 128 + wr * 64 + m * 16 + fr) * D + pn * 256 + wc * 32 + 8 * fq; u32x4 xv[2];
#pragma unroll
                for (int bj = 0; bj < 2; ++bj) xv[bj] = *(const u32x4*)(rp + bj * 128);
#pragma unroll
                for (int bj = 0; bj < 2; ++bj) { const u32x4 xw = xv[bj]; f32x4 r[2];
#pragma unroll
                    for (int n = 0; n < 2; ++n) { const u32x2 w = uu[bj][m][n]; f32x4 v = acc[bj][m][n];
                        v[0] = sigmoidf_(v[0]); v[1] = sigmoidf_(v[1]); v[2] = sigmoidf_(v[2]); v[3] = sigmoidf_(v[3]);
                        const f32x4 xo = n == 0 ? (f32x4){bflo(xw.x), bfhi(xw.x), bflo(xw.y), bfhi(xw.y)} : (f32x4){bflo(xw.z), bfhi(xw.z), bflo(xw.w), bfhi(xw.w)};
                        r[n] = xo + (f32x4){bflo(w.x), bfhi(w.x), bflo(w.y), bfhi(w.y)} * v; }
                    *(u32x4*)(rp + bj * 128) = (u32x4){pk2(r[0][0], r[0][1]), pk2(r[0][2], r[0][3]), pk2(r[1][0], r[1][1]), pk2(r[1][2], r[1][3])}; } } }
    }
};
}
namespace epi {
using pg8::Unit; using pg8::BM; using pg8::HALF;
__device__ __forceinline__ void epi_fence() { asm volatile("" ::: "memory"); }
#define EPI_FENCE epi_fence()
#define EPI_LOOP_ROWS for (int ai = 0; ai < 2; ++ai) _Pragma("unroll") for (int m = 0; m < 4; ++m)
#define EPI_LOOP_COLS for (int bj = 0; bj < 2; ++bj) _Pragma("unroll") for (int n = 0; n < 2; ++n)
#define EPI_ROW (u.pm * BM + ai * HALF + wr * 64 + m * 16 + fr)
#define EPI_COLT (bj * HALF + wc * 32 + n * 16 + 4 * fq)
typedef f32x4 acc_t[2][2][4][2];
#define EPI_C8(bj_) ((bj_) * HALF + wc * 32 + 8 * fq)
__device__ __forceinline__ u32x4 pack8(f32x4 a, f32x4 b) { return (u32x4){pk2(a[0], a[1]), pk2(a[2], a[3]), pk2(b[0], b[1]), pk2(b[2], b[3])}; }
__device__ __forceinline__ u32x2 pack4(f32x4 v) { u32x2 w; w.x = pk2(v[0], v[1]); w.y = pk2(v[2], v[3]); return w; }
__device__ __forceinline__ f32x4 unpack4(u32x2 w) { return (f32x4){bflo(w.x), bfhi(w.x), bflo(w.y), bfhi(w.y)}; }

struct EpiStore {
    static constexpr bool PERM = true;
    bf16* O; int ldc; int pn0;
    __device__ __forceinline__ void operator()(const acc_t& acc, const Unit& u, int wr, int wc, int fr, int fq) const {
#pragma unroll
        EPI_LOOP_ROWS { bf16* rp = O + (size_t)EPI_ROW * ldc + (u.pn - pn0) * BM + wc * 32 + 8 * fq;
#pragma unroll
            for (int bj = 0; bj < 2; ++bj) { const u32x2 lo = pack4(acc[ai][bj][m][0]), hi = pack4(acc[ai][bj][m][1]); *(u32x4*)(rp + bj * HALF) = (u32x4){lo.x, lo.y, hi.x, hi.y}; } }
    }
};
struct EpiRowScale {
    static constexpr bool PERM = true;
    bf16* O; int ldc; const float* rs;
    __device__ __forceinline__ void operator()(const acc_t& acc, const Unit& u, int wr, int wc, int fr, int fq) const {
        float sv[2][4];
#pragma unroll
        EPI_LOOP_ROWS sv[ai][m] = rs[EPI_ROW];
#pragma unroll
        EPI_LOOP_ROWS { const int row = EPI_ROW; const float s = sv[ai][m]; bf16* rp = O + (size_t)row * ldc + u.pn * BM;
#pragma unroll
            for (int bj = 0; bj < 2; ++bj) *(u32x4*)(rp + EPI_C8(bj)) = pack8(acc[ai][bj][m][0] * s, acc[ai][bj][m][1] * s); }
    }
};
struct EpiMlaQ {
    static constexpr bool PERM = false;
    bf16* O; const float* rs; const float* cosT; const float* sinT;
    __device__ __forceinline__ void operator()(const acc_t& acc, const Unit& u, int wr, int wc, int fr, int fq) const {
        float sv[2][4]; f32x4 csv[2], snv[2];
#pragma unroll
        EPI_LOOP_ROWS sv[ai][m] = rs[EPI_ROW];
        { const int row = u.pm * BM + wr * 64 + fr; csv[0] = *(const f32x4*)(cosT + (size_t)row * 16 + 4 * fq); snv[0] = *(const f32x4*)(sinT + (size_t)row * 16 + 4 * fq); }
#pragma unroll
        for (int it = 0; it < 8; ++it) { const int ai = it >> 2, m = it & 3;
            if (it + 1 < 8) { const int row = u.pm * BM + ((it + 1) >> 2) * HALF + wr * 64 + ((it + 1) & 3) * 16 + fr;
                csv[(it + 1) & 1] = *(const f32x4*)(cosT + (size_t)row * 16 + 4 * fq); snv[(it + 1) & 1] = *(const f32x4*)(sinT + (size_t)row * 16 + 4 * fq); }
            const int row = EPI_ROW; const float s = sv[ai][m]; bf16* rp = O + (size_t)row * 512 + u.pn * BM;
            const f32x4 cs = csv[it & 1], sn = snv[it & 1];
#pragma unroll
            for (int bj = 0; bj < 2; ++bj) { const int grp = u.pn * 8 + bj * 4 + wc;
                f32x4 t1 = acc[ai][bj][m][0] * s, t2 = acc[ai][bj][m][1] * s;
                if (grp % 3 == 2) { const f32x4 a = t1 * cs - t2 * sn, b = t2 * cs + t1 * sn; t1 = a; t2 = b; }
                *(u32x2*)(rp + bj * HALF + wc * 32 + 4 * fq) = pack4(t1); *(u32x2*)(rp + bj * HALF + wc * 32 + 16 + 4 * fq) = pack4(t2); } }
    }
};
struct EpiGate {
    static constexpr bool PERM = false;
    bf16* G; const float* bias;
    __device__ __forceinline__ void operator()(const acc_t& acc, const Unit& u, int wr, int wc, int fr, int fq) const {
        f32x4 bv[2][2];
#pragma unroll
        EPI_LOOP_COLS bv[bj][n] = *(const f32x4*)(bias + u.pn * BM + EPI_COLT);
#pragma unroll
        EPI_LOOP_ROWS { bf16* rp = G + (size_t)EPI_ROW * D + u.pn * BM;
#pragma unroll
            EPI_LOOP_COLS { f32x4 v = acc[ai][bj][m][n] + bv[bj][n];
                v[0] = sigmoidf_(v[0]); v[1] = sigmoidf_(v[1]); v[2] = sigmoidf_(v[2]); v[3] = sigmoidf_(v[3]);
                *(u32x2*)(rp + EPI_COLT) = pack4(v); } }
    }
};
#define EPI_IT_ROW(it_) (u.pm * BM + ((it_) >> 2) * HALF + wr * 64 + ((it_) & 3) * 16 + fr)
#define EPI_C4(c_) (((c_) >> 1) * HALF + wc * 32 + ((c_) & 1) * 16 + 4 * fq)
struct EpiMerge {
    static constexpr bool PERM = false;
    const bf16* G; bf16* M; int first;
    __device__ __forceinline__ void operator()(const acc_t& acc, const Unit& u, int wr, int wc, int fr, int fq) const {
        u32x2 gv[2][4], mv[2][4];
#define EPI_LD(it_) do { const size_t ro_ = (size_t)EPI_IT_ROW(it_) * D + u.pn * BM; _Pragma("unroll") for (int c = 0; c < 4; ++c) { gv[(it_) & 1][c] = *(const u32x2*)(G + ro_ + EPI_C4(c)); \
            mv[(it_) & 1][c] = first ? (u32x2){0u, 0u} : *(const u32x2*)(M + ro_ + EPI_C4(c)); } } while (0)
        EPI_LD(0);
#pragma unroll
        for (int it = 0; it < 8; ++it) { if (it + 1 < 8) EPI_LD(it + 1);
            const size_t ro = (size_t)EPI_IT_ROW(it) * D + u.pn * BM;
#pragma unroll
            for (int c = 0; c < 4; ++c) { const f32x4 v = unpack4(gv[it & 1][c]) * acc[it >> 2][c >> 1][it & 3][c & 1] + unpack4(mv[it & 1][c]); *(u32x2*)(M + ro + EPI_C4(c)) = pack4(v); } }
#undef EPI_LD
    }
};
struct EpiRes {
    static constexpr bool PERM = true;
    XSrc xin; bf16* xout;
    float* ssq;
    __device__ __forceinline__ void operator()(const acc_t& acc, const Unit& u, int wr, int wc, int fr, int fq) const {
        f32x4 xv[2][2][2];
#define EPI_LD(it_) do { const size_t ro_ = (size_t)EPI_IT_ROW(it_) * D + u.pn * BM; _Pragma("unroll") for (int bj = 0; bj < 2; ++bj) { \
            if (xin.f) { xv[(it_) & 1][bj][0] = *(const f32x4*)(xin.f + ro_ + EPI_C8(bj)); xv[(it_) & 1][bj][1] = *(const f32x4*)(xin.f + ro_ + EPI_C8(bj) + 4); } \
            else { const u32x4 w_ = *(const u32x4*)(xin.b + ro_ + EPI_C8(bj)); xv[(it_) & 1][bj][0] = (f32x4){bflo(w_.x), bfhi(w_.x), bflo(w_.y), bfhi(w_.y)}; xv[(it_) & 1][bj][1] = (f32x4){bflo(w_.z), bfhi(w_.z), bflo(w_.w), bfhi(w_.w)}; } } } while (0)
        EPI_LD(0);
#pragma unroll
        for (int it = 0; it < 8; ++it) { if (it + 1 < 8) EPI_LD(it + 1);
            const size_t ro = (size_t)EPI_IT_ROW(it) * D + u.pn * BM;
            float sq = 0.f;
#pragma unroll
            for (int bj = 0; bj < 2; ++bj) { const f32x4 v0 = xv[it & 1][bj][0] + acc[it >> 2][bj][it & 3][0], v1 = xv[it & 1][bj][1] + acc[it >> 2][bj][it & 3][1];
                sq += (v0[0] * v0[0] + v0[1] * v0[1]) + (v0[2] * v0[2] + v0[3] * v0[3]) + (v1[0] * v1[0] + v1[1] * v1[1]) + (v1[2] * v1[2] + v1[3] * v1[3]);
                *(u32x4*)(xout + ro + EPI_C8(bj)) = pack8(v0, v1); }
            if (ssq) {
                sq += shflx(sq, 16, fr + 16 * fq);
                { auto rr = __builtin_amdgcn_permlane32_swap(__float_as_uint(sq), __float_as_uint(sq), false, false); sq = __uint_as_float(rr[0]) + __uint_as_float(rr[1]); }
                if (fq == 0) ssq[(size_t)EPI_IT_ROW(it) * 16 + u.pn * 4 + wc] = sq; } }
#undef EPI_LD
    }
};
struct EpiPle {
    static constexpr bool PERM = false;
    const bf16* U; float* x;
    __device__ __forceinline__ void operator()(const acc_t& acc, const Unit& u, int wr, int wc, int fr, int fq) const {
        f32x4 xv[2][4]; u32x2 uv[2][4];
#define EPI_LD(it_) do { const size_t ro_ = (size_t)EPI_IT_ROW(it_) * D + u.pn * BM; _Pragma("unroll") for (int c = 0; c < 4; ++c) { xv[(it_) & 1][c] = *(const f32x4*)(x + ro_ + EPI_C4(c)); uv[(it_) & 1][c] = *(const u32x2*)(U + ro_ + EPI_C4(c)); } } while (0)
        EPI_LD(0);
#pragma unroll
        for (int it = 0; it < 8; ++it) { if (it + 1 < 8) EPI_LD(it + 1);
            const size_t ro = (size_t)EPI_IT_ROW(it) * D + u.pn * BM;
#pragma unroll
            for (int c = 0; c < 4; ++c) { f32x4 v = acc[it >> 2][c >> 1][it & 3][c & 1];
                v[0] = sigmoidf_(v[0]); v[1] = sigmoidf_(v[1]); v[2] = sigmoidf_(v[2]); v[3] = sigmoidf_(v[3]);
                *(f32x4*)(x + ro + EPI_C4(c)) = xv[it & 1][c] + unpack4(uv[it & 1][c]) * v; } }
#undef EPI_LD
    }
};
struct EpiSwiglu {
    static constexpr bool PERM = true;
    bf16* O; int ldc; int npt;
    const LAS float* rl;
    mutable int ord;
    __device__ __forceinline__ void operator()(const acc_t& acc, const Unit& u, int wr, int wc, int fr, int fq) const {
        const int ct = (u.pn % npt) * HALF;
#pragma unroll
        EPI_LOOP_ROWS { bf16* rp = O + (size_t)EPI_ROW * ldc + ct + wc * 32 + 8 * fq; u32x2 w[2];
            const float r = rl ? rl[ord * 256 + ai * HALF + wr * 64 + m * 16 + fr] : 1.0f;
#pragma unroll
            for (int n = 0; n < 2; ++n) { const f32x4 a = acc[ai][0][m][n] * r, b = acc[ai][1][m][n] * r; f32x4 v;
#pragma unroll
                for (int e = 0; e < 4; ++e) v[e] = a[e] * sigmoidf_(a[e]) * b[e];
                w[n] = pack4(v); }
            *(u32x4*)rp = (u32x4){w[0].x, w[0].y, w[1].x, w[1].y}; }
        ++ord;
    }
};
struct EpiGlu {
    static constexpr bool PERM = true;
    bf16* Y; int ldc;
    __device__ __forceinline__ void operator()(const acc_t& acc, const Unit& u, int wr, int wc, int fr, int fq) const {
        u32x4 yv[2][2];
#define EPI_LD(it_) do { const bf16* rp_ = Y + (size_t)EPI_IT_ROW(it_) * ldc + u.pn * BM; _Pragma("unroll") for (int bj = 0; bj < 2; ++bj) yv[(it_) & 1][bj] = *(const u32x4*)(rp_ + EPI_C8(bj)); } while (0)
        EPI_LD(0);
#pragma unroll
        for (int it = 0; it < 8; ++it) { if (it + 1 < 8) EPI_LD(it + 1);
            bf16* rp = Y + (size_t)EPI_IT_ROW(it) * ldc + u.pn * BM;
#pragma unroll
            for (int bj = 0; bj < 2; ++bj) { const u32x4 w = yv[it & 1][bj]; f32x4 a = acc[it >> 2][bj][it & 3][0], b = acc[it >> 2][bj][it & 3][1];
                a[0] = bflo(w.x) * sigmoidf_(a[0]); a[1] = bfhi(w.x) * sigmoidf_(a[1]); a[2] = bflo(w.y) * sigmoidf_(a[2]); a[3] = bfhi(w.y) * sigmoidf_(a[3]);
                b[0] = bflo(w.z) * sigmoidf_(b[0]); b[1] = bfhi(w.z) * sigmoidf_(b[1]); b[2] = bflo(w.w) * sigmoidf_(b[2]); b[3] = bfhi(w.w) * sigmoidf_(b[3]);
                *(u32x4*)(rp + EPI_C8(bj)) = pack8(a, b); } }
#undef EPI_LD
    }
};
struct EpiMoeDown {
    static constexpr bool PERM = true;
    bf16* Y; const float* slot_gate;
    __device__ __forceinline__ void operator()(const acc_t& acc, const Unit& u, int wr, int wc, int fr, int fq) const {
        const int ct = (u.pn & 3) * BM;
        float gv[2][4];
#pragma unroll
        EPI_LOOP_ROWS gv[ai][m] = slot_gate[EPI_ROW];
#pragma unroll
        EPI_LOOP_ROWS { const int row = EPI_ROW; const float gt = gv[ai][m]; bf16* rp = Y + (size_t)row * D + ct;
#pragma unroll
            for (int bj = 0; bj < 2; ++bj) *(u32x4*)(rp + EPI_C8(bj)) = pack8(acc[ai][bj][m][0] * gt, acc[ai][bj][m][1] * gt); }
    }
};
}
namespace att {
constexpr int MODE_FOX = 0, MODE_MLA = 1, MODE_BAND = 2;
constexpr float LOG2E = 1.4426950408889634f;
struct Tensors {
    const bf16* Q; int ldq;
    const bf16* K; int ldk;
    const bf16* K2;
    const bf16* V; int ldv;
    bf16* O; int ldo;
    const float* cdec;
    const float* relb;
    int qhs, khs, vhs, ohs;
    const unsigned* qmax; const unsigned* kmax;
};
template <int DQK> struct Lay { static constexpr int KS = DQK * 2 + 16, KB = 64 * KS, VB = 64 * 128, CB = 256, BUF = KB + VB + CB; };
constexpr int ATT_LDS_TAB = 2 * Lay<96>::BUF;
constexpr int ATT_LDS_BYTES = ATT_LDS_TAB + 832 * 4;
__device__ __forceinline__ int crow(int r, int hi) { return (r & 3) + 8 * (r >> 2) + 4 * hi; }
typedef short v4i16_t __attribute__((ext_vector_type(4)));
__device__ __forceinline__ s16x4 vtr(const LAS unsigned char* p) { return __builtin_bit_cast(s16x4, __builtin_amdgcn_ds_read_tr16_b64_v4i16((LAS v4i16_t*)p)); }

template <int MODE>
__device__ __forceinline__ void attn_unit(const Tensors& T, int b, int h, int qb, LAS unsigned char* lds) {
    constexpr int DQK = (MODE == MODE_MLA) ? 96 : 64, NKS = DQK / 16;
    typedef Lay<DQK> LY;
    int tid = my_tid(); asm volatile("" : "+v"(tid));
    const int lane = tid & 63, r32 = lane & 31, hi = lane >> 5; const int wid = __builtin_amdgcn_readfirstlane(tid >> 6);
    const int rowb = b * SEQ, q0 = qb * 256;
    const float sc2 = ((MODE == MODE_MLA) ? 0.10206207261596575f : 0.125f) * LOG2E;
    const int cw = 4 * qb + (wid >> 1);
    const int t_lo = (MODE == MODE_BAND) ? ((4 * qb - 8) > 0 ? (4 * qb - 8) : 0) : 0, t_hi = 4 * qb + 4;
    const int qrow = rowb + q0 + wid * 32 + r32;
    bf16x8 qf[NKS];
    { const bf16* qp = T.Q + (size_t)qrow * T.ldq + h * T.qhs + hi * 8;
#pragma unroll
      for (int ks = 0; ks < NKS; ++ks) qf[ks] = *(const bf16x8*)(qp + ks * 16); }
    float cq = 0.f; if (MODE == MODE_FOX) cq = T.cdec[(size_t)qrow * 4 + h];
    LAS float* tab = (LAS float*)(lds + ATT_LDS_TAB);
    if (MODE == MODE_BAND) { for (int i = tid; i < 832; i += NTHREADS) tab[i] = T.relb[h * 513 + (i < 512 ? i : 512)] * LOG2E; }
    u32x4 kreg0[2] = {}, kreg1[2] = {}, vreg[2] = {}; float creg[2] = {0.f, 0.f};
    const int srow = tid >> 3, sch = tid & 7;
#define ATT_KADDR(c_) (((c_) % 12 < 8) ? (const u32x4*)(T.K + (kr_ + (c_) / 12) * T.ldk + h * T.khs + ((c_) % 12) * 8) : (const u32x4*)(T.K2 + (kr_ + (c_) / 12) * 32 + ((c_) % 12 - 8) * 8))
#define ATT_LOAD_TILE(t_, r_) do { const size_t kr_ = (size_t)(rowb + (t_) * 64); \
        if (MODE == MODE_MLA) { kreg0[r_] = *ATT_KADDR(tid); if (tid < 256) kreg1[r_] = *ATT_KADDR(tid + 512); } \
        else { kreg0[r_] = *(const u32x4*)(T.K + (kr_ + srow) * T.ldk + h * T.khs + sch * 8); } \
        vreg[r_] = *(const u32x4*)(T.V + (kr_ + srow) * T.ldv + h * T.vhs + sch * 8); \
        if (MODE == MODE_FOX) { if (tid < 64) creg[r_] = T.cdec[(kr_ + tid) * 4 + h]; } } while (0)
#define ATT_STORE_TILE(buf_, r_) do { LAS unsigned char* base_ = lds + (buf_) * LY::BUF; \
        if (MODE == MODE_MLA) { *(LAS u32x4*)(base_ + (tid / 12) * LY::KS + (tid % 12) * 16) = kreg0[r_]; \
            if (tid < 256) *(LAS u32x4*)(base_ + ((tid + 512) / 12) * LY::KS + ((tid + 512) % 12) * 16) = kreg1[r_]; } \
        else { *(LAS u32x4*)(base_ + srow * LY::KS + sch * 16) = kreg0[r_]; } \
        *(LAS u32x4*)(base_ + LY::KB + srow * 128 + ((sch * 16) ^ (((srow >> 1) & 1) << 6))) = vreg[r_]; \
        if (MODE == MODE_FOX) { if (tid < 64) *(LAS float*)(base_ + LY::KB + LY::VB + tid * 4) = creg[r_]; } } while (0)
    float mrun = -INFINITY, lrun = 0.f;
    f32x16 o0 = {}, o1 = {};
    const int G = lane >> 4, qi = (lane & 15) >> 2, pi = lane & 3;
    const int vb0 = (4 * hi + qi) * 128 + 64 * (0 ^ (qi >> 1)) + 32 * (G & 1) + 8 * pi;
    const int vb1 = (4 * hi + qi) * 128 + 64 * (1 ^ (qi >> 1)) + 32 * (G & 1) + 8 * pi;
    int t_min = t_lo;
    if (MODE == MODE_FOX) {
        LAS int* tm = (LAS int*)(lds + ATT_LDS_TAB);
        if (tid == 0) tm[0] = t_hi - 1;
        __syncthreads();
        if (tid < t_hi) {
            const float q2 = __uint_as_float(T.qmax[(b * 4 + h) * 32 + qb]), k2 = __uint_as_float(T.kmax[b * 4 + h]);
            const float thr = 0.125f * sqrtf(q2) * 2.0f * sqrtf(k2) * 1.02f + 112.0f;
            const float cfirst = T.cdec[(size_t)(rowb + q0) * 4 + h], clast = T.cdec[(size_t)(rowb + tid * 64 + 63) * 4 + h];
            if (!(clast - cfirst > thr)) __hip_atomic_fetch_min(tm, tid, __ATOMIC_RELAXED, __HIP_MEMORY_SCOPE_WORKGROUP);
        }
        __syncthreads();
        t_min = tm[0];
    }
    const int n_t = t_hi - t_min;
#define ATT_TILE(i_) ((MODE == MODE_FOX) ? (t_hi - 1 - (i_)) : (t_min + (i_)))
    ATT_LOAD_TILE(ATT_TILE(0), 0); ATT_STORE_TILE(0, 0);
    if (n_t > 1) ATT_LOAD_TILE(ATT_TILE(1), 1);
    if (n_t > 2) ATT_LOAD_TILE(ATT_TILE(2), 0);
    __syncthreads();
    for (int it0 = 0; it0 < n_t; it0 += 2) {
#pragma unroll
      for (int half = 0; half < 2; ++half) { const int it = it0 + half; if (it < n_t) {
        const int t = ATT_TILE(it);
        const int buf = half;
        const bool active = (MODE == MODE_BAND) ? (t <= cw && t >= cw - 8) : (t <= cw);
        if (active) {
            const LAS unsigned char* kb = lds + buf * LY::BUF;
            const LAS unsigned char* vbuf = kb + LY::KB;
            f32x16 p0 = {}, p1 = {};
            bf16x8 ka[NKS], kc[NKS];
#pragma unroll
            for (int ks = 0; ks < NKS; ++ks) { ka[ks] = *(const LAS bf16x8*)(kb + r32 * LY::KS + (ks * 16 + hi * 8) * 2); kc[ks] = *(const LAS bf16x8*)(kb + (32 + r32) * LY::KS + (ks * 16 + hi * 8) * 2); }
            __builtin_amdgcn_sched_barrier(0);
#pragma unroll
            for (int ks = 0; ks < NKS; ++ks) { p0 = __builtin_amdgcn_mfma_f32_32x32x16_bf16(ka[ks], qf[ks], p0, 0, 0, 0); p1 = __builtin_amdgcn_mfma_f32_32x32x16_bf16(kc[ks], qf[ks], p1, 0, 0, 0); }
            s16x4 vl0[4], vh0[4], vl1[4], vh1[4];
#pragma unroll
            for (int s4 = 0; s4 < 4; ++s4) { vl0[s4] = vtr(vbuf + vb0 + s4 * 2048); vh0[s4] = vtr(vbuf + vb0 + s4 * 2048 + 1024); vl1[s4] = vtr(vbuf + vb1 + s4 * 2048); vh1[s4] = vtr(vbuf + vb1 + s4 * 2048 + 1024); }
            __builtin_amdgcn_sched_barrier(0);
            if (MODE == MODE_FOX) {
                const LAS float* cb = (const LAS float*)(vbuf + LY::VB);
                const float cq2 = cq * LOG2E;
#pragma unroll
                for (int a = 0; a < 4; ++a) {
                    const f32x4 c0 = *(const LAS f32x4*)(cb + 8 * a + 4 * hi), c1 = *(const LAS f32x4*)(cb + 32 + 8 * a + 4 * hi);
#pragma unroll
                    for (int e = 0; e < 4; ++e) { p0[4 * a + e] = p0[4 * a + e] * sc2 + (cq2 - c0[e] * LOG2E); p1[4 * a + e] = p1[4 * a + e] * sc2 + (cq2 - c1[e] * LOG2E); }
                }
                if (t == cw) { const int ql = 32 * (wid & 1) + r32;
#pragma unroll
                    for (int r = 0; r < 16; ++r) { const int kv = crow(r, hi); if (kv > ql) p0[r] = -INFINITY; if (kv + 32 > ql) p1[r] = -INFINITY; } }
            } else if (MODE == MODE_BAND) {
                const LAS float* bp = tab + ((q0 + wid * 32 + r32) - t * 64) + 256 - 4 * hi - 95;
#pragma unroll
                for (int r = 0; r < 16; ++r) { const int kvb = (r & 3) + 8 * (r >> 2);
                    p0[r] = p0[r] * sc2 + bp[95 - kvb]; p1[r] = p1[r] * sc2 + bp[63 - kvb]; }
            }
            float mx = fmaxf(p0[0], p1[0]);
#pragma unroll
            for (int r = 1; r < 16; ++r) mx = fmaxf(mx, fmaxf(p0[r], p1[r]));
            { auto rr = __builtin_amdgcn_permlane32_swap(__float_as_uint(mx), __float_as_uint(mx), false, false); mx = fmaxf(__uint_as_float(rr[0]), __uint_as_float(rr[1])); }
            if (MODE == MODE_MLA) mx *= sc2;
            const float mnew = fmaxf(mrun, mx);
            if (__any(mnew > mrun)) {
                const float alpha = __builtin_amdgcn_exp2f(mrun - mnew);
                lrun *= alpha;
#pragma unroll
                for (int r = 0; r < 16; ++r) { o0[r] *= alpha; o1[r] *= alpha; }
                mrun = mnew;
            }
            float rs = 0.f;
#pragma unroll
            for (int r = 0; r < 16; ++r) {
                if (MODE == MODE_MLA) { p0[r] = __builtin_amdgcn_exp2f(__builtin_fmaf(p0[r], sc2, -mrun)); p1[r] = __builtin_amdgcn_exp2f(__builtin_fmaf(p1[r], sc2, -mrun)); }
                else { p0[r] = __builtin_amdgcn_exp2f(p0[r] - mrun); p1[r] = __builtin_amdgcn_exp2f(p1[r] - mrun); }
                rs += p0[r] + p1[r]; }
            lrun += rs;
#pragma unroll
            for (int s4 = 0; s4 < 4; ++s4) {
                u32x4 pw;
                if (s4 < 2) { const int o = 8 * (s4 & 1); pw.x = pk2(p0[o], p0[o + 1]); pw.y = pk2(p0[o + 2], p0[o + 3]); pw.z = pk2(p0[o + 4], p0[o + 5]); pw.w = pk2(p0[o + 6], p0[o + 7]); }
                else        { const int o = 8 * (s4 & 1); pw.x = pk2(p1[o], p1[o + 1]); pw.y = pk2(p1[o + 2], p1[o + 3]); pw.z = pk2(p1[o + 4], p1[o + 5]); pw.w = pk2(p1[o + 6], p1[o + 7]); }
                const bf16x8 pf = __builtin_bit_cast(bf16x8, pw);
                const s16x4 l0 = vl0[s4], h0 = vh0[s4], l1 = vl1[s4], h1 = vh1[s4];
                const bf16x8 vf0 = (bf16x8){l0[0], l0[1], l0[2], l0[3], h0[0], h0[1], h0[2], h0[3]};
                const bf16x8 vf1 = (bf16x8){l1[0], l1[1], l1[2], l1[3], h1[0], h1[1], h1[2], h1[3]};
                o0 = __builtin_amdgcn_mfma_f32_32x32x16_bf16(vf0, pf, o0, 0, 0, 0);
                o1 = __builtin_amdgcn_mfma_f32_32x32x16_bf16(vf1, pf, o1, 0, 0, 0);
            }
        }
        if (it + 1 < n_t) ATT_STORE_TILE(half ^ 1, half ^ 1);
        if (it + 3 < n_t) ATT_LOAD_TILE(ATT_TILE(it + 3), half ^ 1);
        __syncthreads();
      } }
    }
    { auto rr = __builtin_amdgcn_permlane32_swap(__float_as_uint(lrun), __float_as_uint(lrun), false, false); lrun = __uint_as_float(rr[0]) + __uint_as_float(rr[1]); }
    const float inv = 1.0f / lrun;
    bf16* op = T.O + (size_t)qrow * T.ldo + h * T.ohs;
#pragma unroll
    for (int a = 0; a < 4; ++a) {
        u32x2 w0, w1;
        w0.x = pk2(o0[4 * a] * inv, o0[4 * a + 1] * inv); w0.y = pk2(o0[4 * a + 2] * inv, o0[4 * a + 3] * inv);
        w1.x = pk2(o1[4 * a] * inv, o1[4 * a + 1] * inv); w1.y = pk2(o1[4 * a + 2] * inv, o1[4 * a + 3] * inv);
        *(u32x2*)(op + 8 * a + 4 * hi) = w0; *(u32x2*)(op + 32 + 8 * a + 4 * hi) = w1;
    }
}

template <int MODE>
__device__ __forceinline__ void attn_phase(const Tensors& T, LAS unsigned char* lds) {
    const int G = gridDim.x, bx = blockIdx.x, vcu = (G % 8 == 0) ? (bx % 8) * (G / 8) + bx / 8 : bx;
    for (int pr = vcu; pr < 256; pr += G) {
        const int bh = pr >> 4, s = pr & 15;
        attn_unit<MODE>(T, bh >> 2, bh & 3, s, lds);
        attn_unit<MODE>(T, bh >> 2, bh & 3, 31 - s, lds);
    }
}

template <int MODE>
__device__ __forceinline__ void attn_naive(const Tensors& T) {
    BODY_IDS();
    constexpr int DQK = (MODE == MODE_MLA) ? 96 : 64;
    const float sc = (MODE == MODE_MLA) ? 0.10206207261596575f : 0.125f;
    for (int idx = gtid; idx < NTOK * 4; idx += gthreads) {
        const int h = idx / NTOK, row = idx % NTOK, b = row / SEQ, tpos = row % SEQ, rowb = b * SEQ;
        float q[DQK], o[64];
#pragma unroll
        for (int d = 0; d < DQK; ++d) q[d] = bf2f(T.Q[(size_t)row * T.ldq + h * T.qhs + d]) * sc;
#pragma unroll
        for (int d = 0; d < 64; ++d) o[d] = 0.f;
        float m = -INFINITY, l = 0.f;
        const int ck = tpos / 64;
        const int k_lo = (MODE == MODE_BAND) ? ((ck - 8) > 0 ? (ck - 8) * 64 : 0) : 0;
        const int k_hi = (MODE == MODE_FOX) ? tpos : (ck * 64 + 63);
        const float cq = (MODE == MODE_FOX) ? T.cdec[(size_t)row * 4 + h] : 0.f;
        for (int kv = k_lo; kv <= k_hi; ++kv) {
            const size_t kr = (size_t)(rowb + kv);
            float s = 0.f;
#pragma unroll
            for (int d8 = 0; d8 < 8; ++d8) { const u32x4 w = *(const u32x4*)(T.K + kr * T.ldk + h * T.khs + d8 * 8);
                s += q[d8 * 8 + 0] * bflo(w.x) + q[d8 * 8 + 1] * bfhi(w.x) + q[d8 * 8 + 2] * bflo(w.y) + q[d8 * 8 + 3] * bfhi(w.y)
                   + q[d8 * 8 + 4] * bflo(w.z) + q[d8 * 8 + 5] * bfhi(w.z) + q[d8 * 8 + 6] * bflo(w.w) + q[d8 * 8 + 7] * bfhi(w.w); }
            if (MODE == MODE_MLA) {
#pragma unroll
                for (int d8 = 0; d8 < 4; ++d8) { const u32x4 w = *(const u32x4*)(T.K2 + kr * 32 + d8 * 8);
                    s += q[64 + d8 * 8 + 0] * bflo(w.x) + q[64 + d8 * 8 + 1] * bfhi(w.x) + q[64 + d8 * 8 + 2] * bflo(w.y) + q[64 + d8 * 8 + 3] * bfhi(w.y)
                       + q[64 + d8 * 8 + 4] * bflo(w.z) + q[64 + d8 * 8 + 5] * bfhi(w.z) + q[64 + d8 * 8 + 6] * bflo(w.w) + q[64 + d8 * 8 + 7] * bfhi(w.w); }
            }
            if (MODE == MODE_FOX) s += cq - T.cdec[kr * 4 + h];
            if (MODE == MODE_BAND) { int rel = tpos - kv; rel = rel < -256 ? -256 : (rel > 256 ? 256 : rel); s += T.relb[h * 513 + rel + 256]; }
            const float mn = fmaxf(m, s), al = __expf(m - mn), pp = __expf(s - mn);
            l = l * al + pp; m = mn;
#pragma unroll
            for (int d8 = 0; d8 < 8; ++d8) { const u32x4 w = *(const u32x4*)(T.V + kr * T.ldv + h * T.vhs + d8 * 8);
                o[d8 * 8 + 0] = o[d8 * 8 + 0] * al + pp * bflo(w.x); o[d8 * 8 + 1] = o[d8 * 8 + 1] * al + pp * bfhi(w.x);
                o[d8 * 8 + 2] = o[d8 * 8 + 2] * al + pp * bflo(w.y); o[d8 * 8 + 3] = o[d8 * 8 + 3] * al + pp * bfhi(w.y);
                o[d8 * 8 + 4] = o[d8 * 8 + 4] * al + pp * bflo(w.z); o[d8 * 8 + 5] = o[d8 * 8 + 5] * al + pp * bfhi(w.z);
                o[d8 * 8 + 6] = o[d8 * 8 + 6] * al + pp * bflo(w.w); o[d8 * 8 + 7] = o[d8 * 8 + 7] * al + pp * bfhi(w.w); }
        }
        const float inv = 1.0f / l;
#pragma unroll
        for (int d = 0; d < 64; d += 2) *(unsigned*)(T.O + (size_t)row * T.ldo + h * T.ohs + d) = pk2(o[d] * inv, o[d + 1] * inv);
    }
}
}
struct Params {
    const float* in[37];
    float* out;
    unsigned char* ws;
    int ph_lo, ph_hi;
};
enum { I_X = 0, I_P, I_POS, I_WIN, I_SAR, I_SAI, I_SLDT, I_SBR, I_SBI, I_SCR, I_SCI, I_SD, I_SGLU, I_FBF, I_GQ, I_WUQ, I_GKV, I_WUKV, I_RELB, I_WB, I_WG, I_BG, I_WO,
       I_GMIX, I_GFFN, I_FW1, I_FW3, I_FW2, I_MWR, I_MBR, I_MW1, I_MW3, I_MW2, I_GPLE, I_PWG, I_PWU, I_GFIN };

__device__ __forceinline__ void sincos_rad(double a, float& s, float& c) {
    double r = a * 0.15915494309189535; r = r - __builtin_rint(r); const float f = (float)r;
    s = __builtin_amdgcn_sinf(f); c = __builtin_amdgcn_cosf(f);
}
__device__ __forceinline__ float gelu_tanh(float x) {
    const float z = 0.7978845608028654f * (x + 0.044715f * x * x * x);
    return x * __builtin_amdgcn_rcpf(1.0f + __expf(-2.0f * z));
}
__device__ __forceinline__ float log_sigmoid(float z) { return fminf(z, 0.f) - log1pf(__expf(-fabsf(z))); }

struct CvtJob { const float* src; const float* ks; bf16* dst; int K, ldsrc, col0, ncols, row0, ldk, ilv; };
struct CvtRegs { f32x4 v[16]; };
__device__ __forceinline__ void cvt_load(const CvtJob& J, int item, int lane, CvtRegs& R) {
    const int nblk = (J.ncols + 63) >> 6, kb = item / nblk, nb = item % nblk, k0 = 64 * kb, n0 = 64 * nb;
    const int n4 = (lane & 15) * 4; const bool inb = (n0 + n4) < J.ncols;
#pragma unroll
    for (int i = 0; i < 16; ++i) { const int kk = 4 * i + (lane >> 4); f32x4 v = {0.f, 0.f, 0.f, 0.f};
        if (inb) v = *(const f32x4*)(J.src + (size_t)(k0 + kk) * J.ldsrc + J.col0 + n0 + n4);
        if (J.ks) v = v * J.ks[k0 + kk];
        R.v[i] = v; }
}
__device__ __forceinline__ void cvt_finish(const CvtJob& J, LAS float* scr, int item, int lane, const CvtRegs& R) {
    const int nblk = (J.ncols + 63) >> 6, kb = item / nblk, nb = item % nblk, k0 = 64 * kb, n0 = 64 * nb;
    const int n4 = (lane & 15) * 4;
#pragma unroll
    for (int i = 0; i < 16; ++i) { const int kk = 4 * i + (lane >> 4); *(LAS f32x4*)(scr + kk * 68 + n4) = R.v[i]; }
    LDS_WAIT(); asm volatile("" ::: "memory");
    const int c = lane & 7;
#pragma unroll
    for (int j = 0; j < 8; ++j) { const int n = (lane >> 3) + 8 * j; const LAS float* s = scr + (8 * c) * 68 + n;
        u32x4 o; o.x = pk2(s[0 * 68], s[1 * 68]); o.y = pk2(s[2 * 68], s[3 * 68]); o.z = pk2(s[4 * 68], s[5 * 68]); o.w = pk2(s[6 * 68], s[7 * 68]);
        const int nn = n0 + n; const int row = J.row0 + (J.ilv ? ((nn >> 7) * 256 + (nn & 127)) : nn);
        if (nn < J.ncols) *(u32x4*)(J.dst + (size_t)row * J.ldk + k0 + 8 * c) = o; }
    LDS_WAIT(); asm volatile("" ::: "memory");
}
__device__ __forceinline__ bf16* wmix(const Params& P, int L, size_t off) { return (bf16*)(P.ws + WS_WMIX + (size_t)L * WMIX_STRIDE + off); }
__device__ __forceinline__ CvtJob get_job(const Params& P, int j) {
    CvtJob J; J.ks = nullptr; J.ilv = 0; J.col0 = 0; J.row0 = 0;
    if (j < 40) {
        const int L = j / 20, q = j % 20;
        if (q < 5) {
            J.src = P.in[I_WIN] + (size_t)L * D * DIN; J.K = D; J.ldsrc = DIN; J.dst = wmix(P, L, WM_IN); J.ldk = D;
            J.col0 = q == 0 ? 0 : q == 1 ? 1380 : q == 2 ? 1028 : q == 3 ? 1220 : 1348;
            J.ncols = q == 0 ? 1024 : q == 1 ? 768 : q == 2 ? 192 : q == 3 ? 128 : 32;
            J.row0 = q == 0 ? 0 : q == 1 ? 1024 : q == 2 ? 1792 : q == 3 ? 2048 : 2176;
        } else if (q < 9) { const int k = q - 5; J.src = P.in[I_WG] + ((size_t)L * 4 + k) * D * D; J.K = D; J.ldsrc = D; J.ncols = D; J.row0 = k * D; J.dst = wmix(P, L, WM_G); J.ldk = D;
        } else if (q < 13) { const int k = q - 9; J.src = P.in[I_WB] + ((size_t)L * 4 + k) * 256 * D; J.K = 256; J.ldsrc = D; J.ncols = D; J.row0 = k * D; J.dst = wmix(P, L, WM_B); J.ldk = 256;
        } else if (q == 13) { J.src = P.in[I_WO] + (size_t)L * D * D; J.K = D; J.ldsrc = D; J.ncols = D; J.dst = wmix(P, L, WM_O); J.ldk = D;
        } else if (q == 14) { J.src = P.in[I_PWG] + (size_t)L * D * D; J.K = D; J.ldsrc = D; J.ncols = D; J.dst = wmix(P, L, WM_PG); J.ldk = D;
        } else if (q == 15) { J.src = P.in[I_PWU] + (size_t)L * 256 * D; J.K = 256; J.ldsrc = D; J.ncols = D; J.dst = wmix(P, L, WM_UP); J.ldk = 256;
        } else if (q == 16) { J.src = P.in[I_WUQ] + (size_t)L * 192 * 384; J.ks = P.in[I_GQ] + L * 192; J.K = 192; J.ldsrc = 384; J.ncols = 384; J.dst = wmix(P, L, WM_UQ); J.ldk = 256;
        } else if (q == 17) { J.src = P.in[I_WUKV] + (size_t)L * 128 * 512; J.ks = P.in[I_GKV] + L * 128; J.K = 128; J.ldsrc = 512; J.ncols = 512; J.dst = wmix(P, L, WM_UKV); J.ldk = 128;
        } else if (q == 18) { J.src = P.in[I_SGLU] + (size_t)L * 256 * 256; J.K = 256; J.ldsrc = 256; J.ncols = 256; J.dst = wmix(P, L, WM_GLU); J.ldk = 256;
        } else { J.src = nullptr; J.K = 0; J.ldsrc = 0; J.ncols = 32; J.dst = nullptr; J.ldk = 0; }
    } else if (j < 43) {
        const int q = j - 40;
        if (q == 0) { J.src = P.in[I_FW1]; J.ks = P.in[I_GFFN]; J.K = D; J.ldsrc = DFF; J.ncols = DFF; J.dst = (bf16*)(P.ws + WS_W13); J.ldk = D; J.ilv = 1; }
        else if (q == 1) { J.src = P.in[I_FW3]; J.ks = P.in[I_GFFN]; J.K = D; J.ldsrc = DFF; J.ncols = DFF; J.row0 = 128; J.dst = (bf16*)(P.ws + WS_W13); J.ldk = D; J.ilv = 1; }
        else { J.src = P.in[I_FW2]; J.K = DFF; J.ldsrc = D; J.ncols = D; J.dst = (bf16*)(P.ws + WS_W2); J.ldk = DFF; }
    } else {
        const int e = (j - 43) / 3, q = (j - 43) % 3;
        if (q == 0) { J.src = P.in[I_MW1] + (size_t)e * D * DFFE; J.K = D; J.ldsrc = DFFE; J.ncols = DFFE; J.row0 = e * 2816; J.dst = (bf16*)(P.ws + WS_WM13); J.ldk = D; J.ilv = 1; }
        else if (q == 1) { J.src = P.in[I_MW3] + (size_t)e * D * DFFE; J.K = D; J.ldsrc = DFFE; J.ncols = DFFE; J.row0 = e * 2816 + 128; J.dst = (bf16*)(P.ws + WS_WM13); J.ldk = D; J.ilv = 1; }
        else { J.src = P.in[I_MW2] + (size_t)e * DFFE * D; J.K = DFFE; J.ldsrc = D; J.ncols = D; J.row0 = e * D; J.dst = (bf16*)(P.ws + WS_WM2); J.ldk = DFFE; }
    }
    return J;
}
__device__ __forceinline__ void cvt_jobs(const Params& P, int j_lo, int j_hi, LAS unsigned char* lds) {
    BODY_IDS();
    LAS float* scr = (LAS float*)(lds + wave * 17408);
    int acc = 0; bool have = false; CvtJob Jp; int itp = 0; CvtRegs Rp;
    for (int j = j_lo; j < j_hi; ++j) {
        const CvtJob J = get_job(P, j);
        const int items = (J.K / 64) * ((J.ncols + 63) >> 6);
        const int first = (gw - (acc % ngw) + ngw) % ngw;
        for (int it = first; it < items; it += ngw) {
            CvtRegs Rn; cvt_load(J, it, lane, Rn);
            if (have) cvt_finish(Jp, scr, itp, lane, Rp);
            Jp = J; itp = it; have = true;
#pragma unroll
            for (int i = 0; i < 16; ++i) Rp.v[i] = Rn.v[i];
        }
        acc += items;
    }
    if (have) cvt_finish(Jp, scr, itp, lane, Rp);
}

__device__ __forceinline__ void p0_misc(const Params& P) {
    BODY_IDS();
    { const f32x4* src = (const f32x4*)P.in[I_P]; u32x2* dst = (u32x2*)(P.ws + WS_PBF);
      for (int i = gtid; i < 2 * NTOK * 256 / 4; i += gthreads) { const f32x4 v = src[i]; u32x2 w; w.x = pk2(v[0], v[1]); w.y = pk2(v[2], v[3]); dst[i] = w; } }
    { const int* pos = (const int*)P.in[I_POS]; float* ct = (float*)(P.ws + WS_COS); float* st = (float*)(P.ws + WS_SIN);
      const double invf[16] = {1.0, 0.5623413251903491, 0.31622776601683794, 0.1778279410038923, 0.1, 0.05623413251903491, 0.03162277660168379, 0.01778279410038923,
                               0.01, 0.005623413251903491, 0.0031622776601683794, 0.0017782794100389228, 0.001, 0.0005623413251903491, 0.00031622776601683794, 0.00017782794100389227};
      for (int i = gtid; i < NTOK * 16; i += gthreads) { const int row = i >> 4, f = i & 15; double iv = invf[0];
#pragma unroll
          for (int q = 1; q < 16; ++q) iv = (f == q) ? invf[q] : iv;
          const float ang = (float)pos[row] * (float)iv; float s, c; sincos_rad((double)ang, s, c); ct[i] = c; st[i] = s; } }
    for (int L = 0; L < 2; ++L) {
        bf16* win = wmix(P, L, WM_IN);
        for (int i = gtid; i < (64 + 96) * D / 8; i += gthreads) { const int e = i * 8, r = e / D, k = e % D; const int row = r < 64 ? 1984 + r : 2208 + (r - 64); *(u32x4*)(win + (size_t)row * D + k) = (u32x4){0u, 0u, 0u, 0u}; }
        bf16* wuq = wmix(P, L, WM_UQ);
        for (int i = gtid; i < 512 * 256 / 8; i += gthreads) { const int e = i * 8, r = e / 256, k = e % 256; if (r >= 384 || k >= 192) *(u32x4*)(wuq + e) = (u32x4){0u, 0u, 0u, 0u}; }
    }
}

__device__ __forceinline__ void rms_load(const XSrc& x, int row, int lane, f32x4 (&v)[4]) {
#pragma unroll
    for (int j = 0; j < 4; ++j) v[j] = ldx4(x, (size_t)row * D + 4 * lane + 256 * j);
}
struct GainRegs { f32x4 g[4]; };
__device__ __forceinline__ GainRegs load_gain(const float* gain, int lane) { GainRegs G; const f32x4* gr = (const f32x4*)gain + lane;
#pragma unroll
    for (int j = 0; j < 4; ++j) G.g[j] = gr[64 * j];
    return G; }
__device__ __forceinline__ void rms_finish(const GainRegs& G, bf16* orow, int lane, f32x4 (&v)[4]) {
    float s = 0.f;
#pragma unroll
    for (int j = 0; j < 4; ++j) s += (v[j][0] * v[j][0] + v[j][1] * v[j][1]) + (v[j][2] * v[j][2] + v[j][3] * v[j][3]);
    const float rstd = __builtin_amdgcn_rsqf(wave_sum(s) * (1.0f / D) + RMS_EPS);
    u32x2* o8 = (u32x2*)orow + lane;
#pragma unroll
    for (int j = 0; j < 4; ++j) { v[j] = v[j] * rstd * G.g[j]; if (orow) { u32x2 w; w.x = pk2(v[j][0], v[j][1]); w.y = pk2(v[j][2], v[j][3]); o8[64 * j] = w; } }
}
#define RMS_ROWS_BEGIN(x_, rowexpr_) f32x4 v[4], vn_[4]; { const int i = 0; rms_load(x_, (rowexpr_), lane, v); } for (int i = 0; i < 16; ++i) { if (i + 1 < 16) { const int i_ = i; { const int i = i_ + 1; rms_load(x_, (rowexpr_), lane, vn_); } }
#define RMS_ROWS_END() _Pragma("unroll") for (int j_ = 0; j_ < 4; ++j_) v[j_] = vn_[j_]; }
__device__ __forceinline__ void norm_plain(const XSrc x, const float* gain, bf16* H, int first, int stride) {
    BODY_IDS();
    const GainRegs GR = load_gain(gain, lane);
    for (int u = first; u < NTOK / 128; u += stride)
    { RMS_ROWS_BEGIN(x, u * 128 + wave * 16 + i) const int row = u * 128 + wave * 16 + i; rms_finish(GR, H + (size_t)row * D, lane, v); RMS_ROWS_END() }
}
__device__ __forceinline__ void norm1_phase(const Params& P, int L, const XSrc x, int first, int stride) {
    BODY_IDS();
    const float* win = P.in[I_WIN] + (size_t)L * D * DIN;
    f32x4 wff[4][4];
#pragma unroll
    for (int j = 0; j < 4; ++j)
#pragma unroll
        for (int e = 0; e < 4; ++e) wff[j][e] = *(const f32x4*)(win + (size_t)(4 * lane + 256 * j + e) * DIN + 1024);
    const float* gain = P.in[I_GMIX] + L * D; bf16* H = (bf16*)(P.ws + WS_H); const GainRegs GR = load_gain(gain, lane);
    float* logf = (float*)(P.ws + WS_LOGF); float* wsum = (float*)(P.ws + WS_WSUM);
    const f32x4 bf = *(const f32x4*)(P.in[I_FBF] + L * 4);
    for (int u = first; u < NTOK / 128; u += stride) { const int g0 = u * 8 + wave;
        f32x4 run = {0.f, 0.f, 0.f, 0.f};
        RMS_ROWS_BEGIN(x, g0 * 16 + i) const int row = g0 * 16 + i; rms_finish(GR, H + (size_t)row * D, lane, v);
            f32x4 d = {0.f, 0.f, 0.f, 0.f};
#pragma unroll
            for (int j = 0; j < 4; ++j)
#pragma unroll
                for (int e = 0; e < 4; ++e) d += wff[j][e] * v[j][e];
#pragma unroll
            for (int e = 0; e < 4; ++e) { d[e] = wave_sum(d[e]); run[e] += log_sigmoid(d[e] + bf[e]); }
            if (lane == 0) *(f32x4*)(logf + (size_t)row * 4) = run; RMS_ROWS_END()
        if (lane == 0) *(f32x4*)(wsum + (size_t)g0 * 4) = run;
    }
    __syncthreads();
}
__device__ __forceinline__ void prep_phase(const Params& P, int L) {
    BODY_IDS();
    unsigned* qmaxw = (unsigned*)(P.ws + WS_CTL) + CW_QMAX + L * 512; unsigned* kmaxw = (unsigned*)(P.ws + WS_CTL) + CW_KMAX + L * 16;
    const float* logf = (const float*)(P.ws + WS_LOGF); const float* wsum = (const float*)(P.ws + WS_WSUM); float* cdec = (float*)(P.ws + WS_CDEC);
    float* rq = (float*)(P.ws + WS_RSTDQ); float* rkv = (float*)(P.ws + WS_RSTDKV); const bf16* zin = (const bf16*)(P.ws + WS_ZIN); bf16* kper = (bf16*)(P.ws + WS_KPER);
    const float* ct = (const float*)(P.ws + WS_COS); const float* st = (const float*)(P.ws + WS_SIN);
    for (int g0 = gw; g0 < NTOK / 16; g0 += ngw) {
        const int first = (g0 / 512) * 512;
        f32x4 pre = {0.f, 0.f, 0.f, 0.f};
        for (int i = first + lane; i < g0; i += 64) pre += *(const f32x4*)(wsum + (size_t)i * 4);
#pragma unroll
        for (int e = 0; e < 4; ++e) pre[e] = wave_sum(pre[e]);
        if (lane < 16) { const int row = g0 * 16 + lane; *(f32x4*)(cdec + (size_t)row * 4) = *(const f32x4*)(logf + (size_t)row * 4) + pre; }
        float qk2m = 0.f;
        const int colA = (lane < 32 ? ZC_FQ : ZC_FK) + 8 * (lane & 31), colB = ZC_CQ + 8 * (lane < 52 ? lane : 51);
        u32x4 wa = *(const u32x4*)(zin + (size_t)(g0 * 16) * ZP + colA), wb = *(const u32x4*)(zin + (size_t)(g0 * 16) * ZP + colB);
        for (int i = 0; i < 16; ++i) { const int row = g0 * 16 + i;
            const u32x4 ca = wa, cb = wb;
            if (i + 1 < 16) { wa = *(const u32x4*)(zin + (size_t)(row + 1) * ZP + colA); wb = *(const u32x4*)(zin + (size_t)(row + 1) * ZP + colB); }
            const f32x4 cs = *(const f32x4*)(ct + (size_t)row * 16 + 8 * (lane & 1)), cs2 = *(const f32x4*)(ct + (size_t)row * 16 + 8 * (lane & 1) + 4);
            const f32x4 sn = *(const f32x4*)(st + (size_t)row * 16 + 8 * (lane & 1)), sn2 = *(const f32x4*)(st + (size_t)row * 16 + 8 * (lane & 1) + 4);
            { float sa = (bflo(ca.x) * bflo(ca.x) + bfhi(ca.x) * bfhi(ca.x)) + (bflo(ca.y) * bflo(ca.y) + bfhi(ca.y) * bfhi(ca.y)) + (bflo(ca.z) * bflo(ca.z) + bfhi(ca.z) * bfhi(ca.z)) + (bflo(ca.w) * bflo(ca.w) + bfhi(ca.w) * bfhi(ca.w));
              sa += DPP_F(sa, 0xB1, 0xF); sa += DPP_F(sa, 0x4E, 0xF); sa += DPP_F(sa, 0x141, 0xF);
              qk2m = fmaxf(qk2m, sa); }
            const float own[8] = {bflo(cb.x), bfhi(cb.x), bflo(cb.y), bfhi(cb.y), bflo(cb.z), bfhi(cb.z), bflo(cb.w), bfhi(cb.w)};
            float ssb = 0.f;
#pragma unroll
            for (int e = 0; e < 8; ++e) ssb += own[e] * own[e];
            const float sq = wave_sum(lane < 24 ? ssb : 0.f), skv = wave_sum((lane >= 32 && lane < 48) ? ssb : 0.f);
            if (lane == 0) { rq[row] = __builtin_amdgcn_rsqf(sq * (1.0f / 192.0f) + RMS_EPS); rkv[row] = __builtin_amdgcn_rsqf(skv * (1.0f / 128.0f) + RMS_EPS); }
            float oth[8];
#pragma unroll
            for (int e = 0; e < 8; ++e) oth[e] = DPP_F(own[e], 0x4E, 0xF);
            if (lane >= 48 && lane < 52) { const bool lo = lane < 50; float o8[8];
#pragma unroll
                for (int e = 0; e < 8; ++e) { const float c = e < 4 ? cs[e] : cs2[e - 4], sv = e < 4 ? sn[e] : sn2[e - 4];
                    o8[e] = lo ? (own[e] * c - oth[e] * sv) : (own[e] * c + oth[e] * sv); }
                *(u32x4*)(kper + (size_t)row * 32 + (lo ? 0 : 16) + 8 * (lane & 1)) = (u32x4){pk2(o8[0], o8[1]), pk2(o8[2], o8[3]), pk2(o8[4], o8[5]), pk2(o8[6], o8[7])}; } }
        if ((lane & 7) == 0) { const int row0 = g0 * 16, b = row0 / SEQ, qb = (row0 % SEQ) / 256, h = (lane & 31) >> 3;
            if (lane < 32) atomicMax(qmaxw + (b * 4 + h) * 32 + qb, __float_as_uint(qk2m)); else atomicMax(kmaxw + b * 4 + h, __float_as_uint(qk2m)); }
    }
}
struct FinalRows { u32x2 w[16][4]; };
__device__ __forceinline__ void final_norm_load(const Params& P, int u, FinalRows& R) {
    BODY_IDS();
    const bf16* xb = xr_of(P.out);
#pragma unroll
    for (int i = 0; i < 16; ++i) { const u32x2* xr = (const u32x2*)(xb + (size_t)(u * 128 + wave * 16 + i) * D) + lane;
#pragma unroll
        for (int j = 0; j < 4; ++j) R.w[i][j] = xr[64 * j]; }
}
__device__ __forceinline__ void final_norm_store(const Params& P, int u, const FinalRows& R) {
    BODY_IDS();
    const GainRegs GR = load_gain(P.in[I_GFIN], lane);
#pragma unroll
    for (int i = 0; i < 16; ++i) { f32x4 v[4]; float s = 0.f;
#pragma unroll
        for (int j = 0; j < 4; ++j) { const u32x2 w = R.w[i][j]; v[j] = (f32x4){bflo(w.x), bfhi(w.x), bflo(w.y), bfhi(w.y)}; s += (v[j][0] * v[j][0] + v[j][1] * v[j][1]) + (v[j][2] * v[j][2] + v[j][3] * v[j][3]); }
        const float rstd = __builtin_amdgcn_rsqf(wave_sum(s) * (1.0f / D) + RMS_EPS);
        f32x4* xo = (f32x4*)(P.out + (size_t)(u * 128 + wave * 16 + i) * D) + lane;
#pragma unroll
        for (int j = 0; j < 4; ++j) xo[64 * j] = v[j] * rstd * GR.g[j]; }
}
namespace s5 {
struct Coef { float abr, abi; f32x2 B2[16]; float a64r, a64i; };
__device__ __forceinline__ void coef(const Params& P, int L, int g, int p, Coef& C) {
    const float dt = __expf(P.in[I_SLDT][L * 16 + g]); const float ar = P.in[I_SAR][(L * 16 + g) * 64 + p], ai = P.in[I_SAI][(L * 16 + g) * 64 + p];
    const float mag = __expf(ar * dt); float sn, cs; sincos_rad((double)(ai * dt), sn, cs);
    C.abr = mag * cs; C.abi = mag * sn;
    const float den = ar * ar + ai * ai, nr = C.abr - 1.0f, ni = C.abi;
    const float cr = (nr * ar + ni * ai) / den, ci = (ni * ar - nr * ai) / den;
    const float* br = P.in[I_SBR] + ((size_t)(L * 16 + g) * 64 + p) * 16; const float* bi = P.in[I_SBI] + ((size_t)(L * 16 + g) * 64 + p) * 16;
#pragma unroll
    for (int h = 0; h < 16; ++h) { const float r = br[h], i = bi[h]; C.B2[h] = (f32x2){cr * r - ci * i, cr * i + ci * r}; }
    const float m64 = __expf(64.0f * ar * dt); float s64, c64; sincos_rad(64.0 * (double)(ai * dt), s64, c64);
    C.a64r = m64 * c64; C.a64i = m64 * s64;
}
constexpr int WAVE_LDS = 8448;
template <bool EMIT>
__device__ __forceinline__ void chunk(const Params& P, int L, int g, int row0, const Coef& C, float& xr, float& xi, LAS unsigned char* wl, int lane, const bf16x8 (&cf)[4], float dsk) {
    bf16* zin = (bf16*)(P.ws + WS_ZIN);
    LAS float* ut = (LAS float*)wl; LAS unsigned* xt = (LAS unsigned*)(wl + 4096);
    { const u32x4* up = (const u32x4*)(zin + (size_t)(row0 + lane) * ZP + ZC_U + g * 16); const u32x4 w0 = up[0], w1 = up[1];
      LAS f32x4* d = (LAS f32x4*)(ut + lane * 16);
      d[0] = (f32x4){bflo(w0.x), bfhi(w0.x), bflo(w0.y), bfhi(w0.y)}; d[1] = (f32x4){bflo(w0.z), bfhi(w0.z), bflo(w0.w), bfhi(w0.w)};
      d[2] = (f32x4){bflo(w1.x), bfhi(w1.x), bflo(w1.y), bfhi(w1.y)}; d[3] = (f32x4){bflo(w1.z), bfhi(w1.z), bflo(w1.w), bfhi(w1.w)}; }
    for (int tb = 0; tb < 4; ++tb) {
#pragma unroll 4
        for (int ti = 0; ti < 16; ++ti) {
            const LAS f32x4* up = (const LAS f32x4*)(ut + (tb * 16 + ti) * 16);
            f32x2 b2a = {0.f, 0.f}, b2b = {0.f, 0.f};
#pragma unroll
            for (int q = 0; q < 4; ++q) { const f32x4 u4 = up[q];
                b2a += C.B2[4 * q + 0] * (f32x2){u4[0], u4[0]}; b2b += C.B2[4 * q + 1] * (f32x2){u4[1], u4[1]};
                b2a += C.B2[4 * q + 2] * (f32x2){u4[2], u4[2]}; b2b += C.B2[4 * q + 3] * (f32x2){u4[3], u4[3]}; }
            const float br = b2a[0] + b2b[0], bi = b2a[1] + b2b[1];
            const float nr = C.abr * xr - C.abi * xi + br, ni = C.abr * xi + C.abi * xr + bi; xr = nr; xi = ni;
            if (EMIT) xt[ti * 68 + lane] = pk2(xr, xi);
        }
        if (EMIT) {
            f32x4 dacc = {0.f, 0.f, 0.f, 0.f};
#pragma unroll
            for (int ks = 0; ks < 4; ++ks) { const bf16x8 a = *(const LAS bf16x8*)((const LAS unsigned char*)xt + (lane & 15) * 272 + (ks * 32 + (lane >> 4) * 8) * 2);
                dacc = __builtin_amdgcn_mfma_f32_16x16x32_bf16(a, cf[ks], dacc, 0, 0, 0); }
            const int hp = lane & 15;
#pragma unroll
            for (int i = 0; i < 4; ++i) { const int tok = tb * 16 + 4 * (lane >> 4) + i; const float y = dacc[i] + dsk * ut[tok * 16 + hp];
                zin[(size_t)(row0 + tok) * ZP + ZC_U + g * 16 + hp] = (bf16)f2bf(gelu_tanh(y)); }
        }
    }
}
template <int PASS>
__device__ __forceinline__ void phase(const Params& P, int L, LAS unsigned char* lds) {
    BODY_IDS();
    LAS unsigned char* wl = lds + wave * WAVE_LDS;
    f32x2* SC = (f32x2*)(P.ws + WS_SC);
    for (int w = gw; w < 2048; w += ngw) {
        const int bg = w >> 5, cg = w & 31, b = bg >> 4, g = bg & 15;
        Coef C; coef(P, L, g, lane, C);
        bf16x8 cf[4]; float dsk = 0.f;
        if (PASS == 1) {
            const int hp = lane & 15, kg = lane >> 4;
            const float* cre = P.in[I_SCR] + ((size_t)(L * 16 + g) * 16 + hp) * 64; const float* cim = P.in[I_SCI] + ((size_t)(L * 16 + g) * 16 + hp) * 64;
#pragma unroll
            for (int ks = 0; ks < 4; ++ks) { const int p0 = 16 * ks + 4 * kg; u32x4 wv;
                wv.x = pk2(cre[p0], -cim[p0]); wv.y = pk2(cre[p0 + 1], -cim[p0 + 1]); wv.z = pk2(cre[p0 + 2], -cim[p0 + 2]); wv.w = pk2(cre[p0 + 3], -cim[p0 + 3]);
                cf[ks] = __builtin_bit_cast(bf16x8, wv); }
            dsk = P.in[I_SD][(L * 16 + g) * 16 + hp];
        } else {
#pragma unroll
            for (int ks = 0; ks < 4; ++ks) cf[ks] = (bf16x8){0, 0, 0, 0, 0, 0, 0, 0};
        }
        float xr = 0.f, xi = 0.f;
        if (PASS == 1) {
            const f32x2* sp = SC + ((size_t)bg * 128) * 64 + lane;
            for (int c = 0; c < 4 * cg; c += 4) { f32x2 sv[4];
#pragma unroll
                for (int q = 0; q < 4; ++q) sv[q] = sp[(size_t)(c + q) * 64];
#pragma unroll
                for (int q = 0; q < 4; ++q) { const float nr = C.a64r * xr - C.a64i * xi + sv[q][0], ni = C.a64r * xi + C.a64i * xr + sv[q][1]; xr = nr; xi = ni; } }
        }
        for (int cc = 0; cc < 4; ++cc) {
            const int c = 4 * cg + cc, row0 = b * SEQ + c * 64;
            if (PASS == 0) { xr = 0.f; xi = 0.f; }
            chunk<PASS == 1>(P, L, g, row0, C, xr, xi, wl, lane, cf, dsk);
            if (PASS == 0) SC[((size_t)bg * 128 + c) * 64 + lane] = (f32x2){xr, xi};
        }
    }
}
#define LDS_XLANE() asm volatile("" ::: "memory")
constexpr int WAVE_LDS1 = 4352;
__device__ __forceinline__ void phase1(const Params& P, int L, LAS unsigned char* lds) {
    BODY_IDS();
    LAS unsigned char* wl = lds + wave * WAVE_LDS1;
    LAS unsigned* bu = (LAS unsigned*)wl; LAS unsigned* xt = bu;
    bf16* zin = (bf16*)(P.ws + WS_ZIN);
    const f32x2* SC = (const f32x2*)(P.ws + WS_SC);
    const int m = lane & 15, kq = lane >> 4;
    for (int w = gw; w < 2048; w += ngw) {
        const int bg = w >> 5, cg = w & 31, b = bg >> 4, g = bg & 15;
        const bf16* ub = zin + (size_t)(b * SEQ + cg * 256 + m) * ZP + ZC_U + g * 16 + 8 * (kq & 1);
        u32x4 ua[4];
#pragma unroll
        for (int q = 0; q < 4; ++q) ua[q] = *(const u32x4*)(ub + (size_t)q * 16 * ZP);
        const f32x2* sp = SC + ((size_t)bg * 128) * 64 + lane;
        f32x2 pq[4][4];
        if (cg > 0) {
#pragma unroll
            for (int j = 0; j < 4; ++j) { const int bc = j < cg ? j : cg - 1;
#pragma unroll
                for (int t = 0; t < 4; ++t) pq[j][t] = sp[(size_t)(4 * bc + t) * 64]; }
        }
        float abr, abi, a64r, a64i; bf16x8 bfr[8];
        { Coef C; coef(P, L, g, lane, C); abr = C.abr; abi = C.abi; a64r = C.a64r; a64i = C.a64i;
          LAS unsigned* tab = (LAS unsigned*)wl;
#pragma unroll
          for (int h2 = 0; h2 < 8; ++h2) { tab[lane * 8 + h2] = pk2(C.B2[2 * h2][0], C.B2[2 * h2 + 1][0]); tab[(64 + lane) * 8 + h2] = pk2(C.B2[2 * h2][1], C.B2[2 * h2 + 1][1]); }
          LDS_XLANE();
#pragma unroll
          for (int nt = 0; nt < 8; ++nt) { const u32x4 v = *(const LAS u32x4*)(wl + (16 * nt + m) * 32 + 16 * (kq & 1)); bfr[nt] = __builtin_bit_cast(bf16x8, kq < 2 ? v : (u32x4){0u, 0u, 0u, 0u}); }
          LDS_XLANE(); }
        bf16x8 cf[4]; float dskf;
        { const float* cre = P.in[I_SCR] + ((size_t)(L * 16 + g) * 16 + m) * 64; const float* cim = P.in[I_SCI] + ((size_t)(L * 16 + g) * 16 + m) * 64;
#pragma unroll
          for (int ks = 0; ks < 4; ++ks) { const int p0 = 16 * ks + 4 * kq; u32x4 wv;
              wv.x = pk2(cre[p0], -cim[p0]); wv.y = pk2(cre[p0 + 1], -cim[p0 + 1]); wv.z = pk2(cre[p0 + 2], -cim[p0 + 2]); wv.w = pk2(cre[p0 + 3], -cim[p0 + 3]);
              cf[ks] = __builtin_bit_cast(bf16x8, wv); }
          dskf = P.in[I_SD][(L * 16 + g) * 16 + m]; }
        float xr = 0.f, xi = 0.f;
        for (int k = 0; k < cg; k += 4) {
#pragma unroll
            for (int j = 0; j < 4; ++j) {
                if (k + j < cg) {
#pragma unroll
                    for (int t = 0; t < 4; ++t) { const float nr = a64r * xr - a64i * xi + pq[j][t][0], ni = a64r * xi + a64i * xr + pq[j][t][1]; xr = nr; xi = ni; } }
                const int bn = k + j + 4, bc = bn < cg ? bn : cg - 1;
#pragma unroll
                for (int t = 0; t < 4; ++t) pq[j][t] = sp[(size_t)(4 * bc + t) * 64];
            }
        }
#pragma nounroll
        for (int cc = 0; cc < 4; ++cc) {
            const int row0 = b * SEQ + (4 * cg + cc) * 64;
            u32x4 un[4];
            if (cc < 3) {
#pragma unroll
                for (int q = 0; q < 4; ++q) un[q] = *(const u32x4*)(ub + (size_t)((cc + 1) * 4 + q) * 16 * ZP);
            } else {
#pragma unroll
                for (int q = 0; q < 4; ++q) un[q] = ua[q];
            }
#pragma unroll
            for (int tb = 0; tb < 4; ++tb) {
                const bf16x8 a = __builtin_bit_cast(bf16x8, ua[tb]);
                f32x4 dd[8];
#pragma unroll
                for (int nt = 0; nt < 8; ++nt) dd[nt] = __builtin_amdgcn_mfma_f32_16x16x32_bf16(a, bfr[nt], (f32x4){0.f, 0.f, 0.f, 0.f}, 0, 0, 0);
                unsigned short uraw[4];
#pragma unroll
                for (int i = 0; i < 4; ++i) uraw[i] = *(const unsigned short*)(zin + (size_t)(row0 + tb * 16 + 4 * kq + i) * ZP + ZC_U + g * 16 + m);
#pragma unroll
                for (int nt = 0; nt < 4; ++nt)
#pragma unroll
                    for (int i = 0; i < 4; ++i) bu[(4 * kq + i) * 68 + 16 * nt + m] = pk2(dd[nt][i], dd[nt + 4][i]);
                LDS_XLANE();
#pragma unroll
                for (int ti = 0; ti < 16; ++ti) {
                    const unsigned bw = bu[ti * 68 + lane]; const float br = bflo(bw), bi = bfhi(bw);
                    const float nr = abr * xr - abi * xi + br, ni = abr * xi + abi * xr + bi; xr = nr; xi = ni;
                    xt[ti * 68 + lane] = pk2(xr, xi);
                }
                LDS_XLANE();
                f32x4 dacc = {0.f, 0.f, 0.f, 0.f};
#pragma unroll
                for (int ks = 0; ks < 4; ++ks) { const bf16x8 a2 = *(const LAS bf16x8*)(wl + m * 272 + (ks * 32 + kq * 8) * 2);
                    dacc = __builtin_amdgcn_mfma_f32_16x16x32_bf16(a2, cf[ks], dacc, 0, 0, 0); }
                LDS_XLANE();
#pragma unroll
                for (int i = 0; i < 4; ++i) { const int tok = tb * 16 + 4 * kq + i; const float y = dacc[i] + dskf * __uint_as_float((unsigned)uraw[i] << 16);
                    const float gy = gelu_tanh(y); *(unsigned short*)(zin + (size_t)(row0 + tok) * ZP + ZC_U + g * 16 + m) = (unsigned short)pk2(gy, gy); }
            }
#pragma unroll
            for (int q = 0; q < 4; ++q) ua[q] = un[q];
        }
    }
}
__device__ __forceinline__ void build_w(const Params& P, int L) {
    BODY_IDS();
    bf16* W = (bf16*)(P.ws + WS_S5W);
    for (int q = gtid; q < 16 * 64 * 64; q += gthreads) {
        const int g = q >> 12, p = (q >> 6) & 63, sidx = q & 63;
        const float dt = __expf(P.in[I_SLDT][L * 16 + g]); const float ar = P.in[I_SAR][(L * 16 + g) * 64 + p], ai = P.in[I_SAI][(L * 16 + g) * 64 + p];
        const float mag = __expf(ar * dt); float sn, cs; sincos_rad((double)(ai * dt), sn, cs);
        const float abr = mag * cs, abi = mag * sn, den = ar * ar + ai * ai, nr = abr - 1.0f, ni = abi;
        const float cr = (nr * ar + ni * ai) / den, ci = (ni * ar - nr * ai) / den;
        const float e = (float)(63 - sidx); const float me = __expf(e * ar * dt); float se, ce; sincos_rad((double)e * (double)(ai * dt), se, ce);
        const float Er = me * ce, Ei = me * se;
        const float* br = P.in[I_SBR] + ((size_t)(L * 16 + g) * 64 + p) * 16; const float* bi = P.in[I_SBI] + ((size_t)(L * 16 + g) * 64 + p) * 16;
        float vr[16], vi[16];
#pragma unroll
        for (int h = 0; h < 16; ++h) { const float bbr = cr * br[h] - ci * bi[h], bbi = cr * bi[h] + ci * br[h]; vr[h] = Er * bbr - Ei * bbi; vi[h] = Er * bbi + Ei * bbr; }
        bf16* w0 = W + ((size_t)g * 128 + 2 * p) * 1024 + sidx * 16;
        *(u32x4*)w0 = (u32x4){pk2(vr[0], vr[1]), pk2(vr[2], vr[3]), pk2(vr[4], vr[5]), pk2(vr[6], vr[7])}; *(u32x4*)(w0 + 8) = (u32x4){pk2(vr[8], vr[9]), pk2(vr[10], vr[11]), pk2(vr[12], vr[13]), pk2(vr[14], vr[15])};
        *(u32x4*)(w0 + 1024) = (u32x4){pk2(vi[0], vi[1]), pk2(vi[2], vi[3]), pk2(vi[4], vi[5]), pk2(vi[6], vi[7])}; *(u32x4*)(w0 + 1024 + 8) = (u32x4){pk2(vi[8], vi[9]), pk2(vi[10], vi[11]), pk2(vi[12], vi[13]), pk2(vi[14], vi[15])};
    }
}
__device__ __forceinline__ void pass0_mfma(const Params& P, LAS unsigned char* lds) {
    BODY_IDS();
    const bf16* zin = (const bf16*)(P.ws + WS_ZIN); const bf16* W = (const bf16*)(P.ws + WS_S5W); float* SC = (float*)(P.ws + WS_SC);
    for (int task = blockIdx.x; task < 256; task += gridDim.x) {
        const int g = task & 15, nq = (task >> 4) & 3, cgp = (task >> 6) * 8 + wave;
        __syncthreads();
#pragma unroll
        for (int i = 0; i < 8; ++i) { const int id = tid + 512 * i, row = id >> 7, c16 = id & 127;
            *(LAS u32x4*)(lds + row * 2064 + c16 * 16) = *(const u32x4*)(W + ((size_t)g * 128 + nq * 32 + row) * 1024 + c16 * 8); }
        __syncthreads();
        const int m = lane & 15, kq = lane >> 4, ci = 16 * cgp + m, b = ci >> 7, c = ci & 127;
        const bf16* ap = zin + (size_t)(b * SEQ + c * 64 + (kq >> 1)) * ZP + ZC_U + g * 16 + 8 * (kq & 1);
        const LAS unsigned char* bl = lds + m * 2064 + kq * 16;
        f32x4 d0 = {0.f, 0.f, 0.f, 0.f}, d1 = {0.f, 0.f, 0.f, 0.f};
#pragma unroll 8
        for (int ks = 0; ks < 32; ++ks) {
            const bf16x8 av = *(const bf16x8*)(ap + (size_t)(2 * ks) * ZP), b0 = *(const LAS bf16x8*)(bl + 64 * ks), b1 = *(const LAS bf16x8*)(bl + 16 * 2064 + 64 * ks);
            d0 = __builtin_amdgcn_mfma_f32_16x16x32_bf16(av, b0, d0, 0, 0, 0); d1 = __builtin_amdgcn_mfma_f32_16x16x32_bf16(av, b1, d1, 0, 0, 0);
        }
#pragma unroll
        for (int i = 0; i < 4; ++i) { const int cj = 16 * cgp + 4 * (lane >> 4) + i, bj = cj >> 7, cc = cj & 127; float* sp = SC + ((size_t)(bj * 16 + g) * 128 + cc) * 128 + nq * 32 + (lane & 15);
            sp[0] = d0[i]; sp[16] = d1[i]; }
    }
    __syncthreads();
}
__device__ __forceinline__ void naive(const Params& P, int L) {
    BODY_IDS();
    bf16* zin = (bf16*)(P.ws + WS_ZIN);
    for (int bg = gw; bg < 64; bg += ngw) {
        const int b = bg >> 4, g = bg & 15;
        Coef C; coef(P, L, g, lane, C);
        float cr[16], ci[16];
#pragma unroll
        for (int h = 0; h < 16; ++h) { cr[h] = P.in[I_SCR][((size_t)(L * 16 + g) * 16 + h) * 64 + lane]; ci[h] = P.in[I_SCI][((size_t)(L * 16 + g) * 16 + h) * 64 + lane]; }
        const float dsk = P.in[I_SD][(L * 16 + g) * 16 + (lane & 15)];
        float xr = 0.f, xi = 0.f;
        for (int t = 0; t < SEQ; ++t) {
            bf16* up = zin + (size_t)(b * SEQ + t) * ZP + ZC_U + g * 16;
            const u32x4 w0 = *(const u32x4*)up, w1 = *(const u32x4*)(up + 8);
            const float u[16] = {bflo(w0.x), bfhi(w0.x), bflo(w0.y), bfhi(w0.y), bflo(w0.z), bfhi(w0.z), bflo(w0.w), bfhi(w0.w),
                                 bflo(w1.x), bfhi(w1.x), bflo(w1.y), bfhi(w1.y), bflo(w1.z), bfhi(w1.z), bflo(w1.w), bfhi(w1.w)};
            float br = 0.f, bi = 0.f;
#pragma unroll
            for (int h = 0; h < 16; ++h) { br += C.B2[h][0] * u[h]; bi += C.B2[h][1] * u[h]; }
            const float nr = C.abr * xr - C.abi * xi + br, ni = C.abr * xi + C.abi * xr + bi; xr = nr; xi = ni;
            float ymine = 0.f, umine = 0.f;
#pragma unroll
            for (int h = 0; h < 16; ++h) { const float s = wave_sum(xr * cr[h] - xi * ci[h]); if ((lane & 15) == h) { ymine = s; umine = u[h]; } }
            __builtin_amdgcn_s_waitcnt(0);
            if (lane < 16) up[lane] = (bf16)f2bf(gelu_tanh(ymine + dsk * umine));
        }
    }
}
}

__device__ __forceinline__ void norm2_moe_phase(const Params& P, const XSrc x, LAS unsigned char* lds, int first, int stride) {
    BODY_IDS();
    LAS unsigned* lcnt = (LAS unsigned*)(lds + 32768); LAS unsigned* lbase = lcnt + 8;
    f32x4 wr0[4][4], wr1[4][4];
#pragma unroll
    for (int j = 0; j < 4; ++j)
#pragma unroll
        for (int q = 0; q < 4; ++q) { const float* wp = P.in[I_MWR] + (size_t)(4 * lane + 256 * j + q) * 8; wr0[j][q] = *(const f32x4*)wp; wr1[j][q] = *(const f32x4*)(wp + 4); }
    if (tid < 8) lcnt[tid] = 0u;
    __syncthreads();
    const float* gain = P.in[I_GFFN] + 1 * D; bf16* H = (bf16*)(P.ws + WS_H); const GainRegs GR = load_gain(gain, lane);
    unsigned* tokinfo = (unsigned*)(P.ws + WS_TOKINFO); unsigned* gcnt = (unsigned*)(P.ws + WS_CTL) + CW_MOECNT;
    const float* brt = P.in[I_MBR];
    for (int u = first; u < NTOK / 128; u += stride) { const int g0 = u * 8 + wave;
        RMS_ROWS_BEGIN(x, g0 * 16 + i) const int row = g0 * 16 + i; rms_finish(GR, H + (size_t)row * D, lane, v);
            float lg[8];
#pragma unroll
            for (int e = 0; e < 8; ++e) lg[e] = 0.f;
#pragma unroll
            for (int j = 0; j < 4; ++j)
#pragma unroll
                for (int q = 0; q < 4; ++q) { const f32x4 w0 = wr0[j][q], w1 = wr1[j][q]; const float hv = v[j][q];
                    lg[0] += hv * w0[0]; lg[1] += hv * w0[1]; lg[2] += hv * w0[2]; lg[3] += hv * w0[3]; lg[4] += hv * w1[0]; lg[5] += hv * w1[1]; lg[6] += hv * w1[2]; lg[7] += hv * w1[3]; }
#pragma unroll
            for (int e = 0; e < 8; ++e) lg[e] = wave_sum(lg[e]) + brt[e];
            int e0 = 0; float l0 = lg[0];
#pragma unroll
            for (int e = 1; e < 8; ++e) if (lg[e] > l0) { l0 = lg[e]; e0 = e; }
            int e1 = 0; float l1 = -INFINITY;
#pragma unroll
            for (int e = 0; e < 8; ++e) if (e != e0 && lg[e] > l1) { l1 = lg[e]; e1 = e; }
            const float ex = __expf(l1 - l0); const float ga = __builtin_amdgcn_rcpf(1.0f + ex), gb = ex * ga;
            if (lane == 0) { const unsigned r0 = __hip_atomic_fetch_add(&lcnt[e0], 1u, __ATOMIC_RELAXED, __HIP_MEMORY_SCOPE_WORKGROUP), r1 = __hip_atomic_fetch_add(&lcnt[e1], 1u, __ATOMIC_RELAXED, __HIP_MEMORY_SCOPE_WORKGROUP);
                u32x4 a; a.x = (unsigned)e0; a.y = (unsigned)e1; a.z = r0; a.w = r1; u32x4 bq; bq.x = __float_as_uint(ga); bq.y = __float_as_uint(gb); bq.z = 0u; bq.w = 0u;
                *(u32x4*)(tokinfo + (size_t)row * 8) = a; *(u32x4*)(tokinfo + (size_t)row * 8 + 4) = bq; } RMS_ROWS_END()
    }
    __syncthreads();
    if (tid < 8) lbase[tid] = __hip_atomic_fetch_add(gcnt + tid, lcnt[tid], __ATOMIC_RELAXED, __HIP_MEMORY_SCOPE_AGENT);
    __syncthreads();
    for (int u = first; u < NTOK / 128; u += stride) { const int g0 = u * 8 + wave;
        if (lane == 0) { for (int i = 0; i < 16; ++i) { const int row = g0 * 16 + i; u32x4 a = *(u32x4*)(tokinfo + (size_t)row * 8);
            unsigned b0 = 0, b1 = 0;
#pragma unroll
            for (int e = 0; e < 8; ++e) { const unsigned lb = lbase[e]; b0 = (a.x == (unsigned)e) ? lb : b0; b1 = (a.y == (unsigned)e) ? lb : b1; }
            a.z += b0; a.w += b1; *(u32x4*)(tokinfo + (size_t)row * 8) = a; } }
    }
    int* slot_tok = (int*)(P.ws + WS_SLOTTOK);
    for (int i = gtid; i < MOE_ROWS; i += gthreads) slot_tok[i] = -1;
    __syncthreads();
}
struct MoeLayout { int pstart[9]; };
__device__ __forceinline__ MoeLayout moe_layout(const Params& P) {
    const unsigned* gcnt = (const unsigned*)(P.ws + WS_CTL) + CW_MOECNT; MoeLayout Lo; int acc = 0;
#pragma unroll
    for (int e = 0; e < 8; ++e) { Lo.pstart[e] = acc; const int c = (int)__hip_atomic_load(gcnt + e, __ATOMIC_RELAXED, __HIP_MEMORY_SCOPE_AGENT); acc += (c + 255) / 256 * 256; }
    Lo.pstart[8] = acc; return Lo;
}
__device__ __forceinline__ void moe_assign_phase(const Params& P) {
    BODY_IDS();
    const MoeLayout Lo = moe_layout(P);
    const unsigned* tokinfo = (const unsigned*)(P.ws + WS_TOKINFO); int* slot_tok = (int*)(P.ws + WS_SLOTTOK); float* slot_gate = (float*)(P.ws + WS_SLOTGATE);
    for (int t = gtid; t < NTOK; t += gthreads) { const u32x4 a = *(const u32x4*)(tokinfo + (size_t)t * 8); const u32x2 g = *(const u32x2*)(tokinfo + (size_t)t * 8 + 4);
        int p0 = 0, p1 = 0;
#pragma unroll
        for (int e = 0; e < 8; ++e) { p0 = ((int)a.x == e) ? Lo.pstart[e] : p0; p1 = ((int)a.y == e) ? Lo.pstart[e] : p1; }
        const int s0 = p0 + (int)a.z, s1 = p1 + (int)a.w;
        slot_tok[s0] = t; slot_gate[s0] = __uint_as_float(g.x); slot_tok[s1] = t; slot_gate[s1] = __uint_as_float(g.y); }
}
struct MoeOrder {
    int pstart[9]; int ntile, ncol, G, c;
    __device__ __forceinline__ bool next(int i, pg8::Unit& u) const {
        const long Lf = (long)i * G + c; if (Lf >= (long)ntile * ncol) return false;
        const int rt = (int)(Lf / ncol), j = (int)(Lf % ncol); int e = 0;
#pragma unroll
        for (int q = 1; q < 8; ++q) e = (rt * 256 >= pstart[q]) ? q : e;
        u.pm = rt; u.pn = e * ncol + j; return true;
    }
};
__device__ __forceinline__ MoeOrder moe_order(const Params& P, int ncol, int G, int c) {
    const MoeLayout Lo = moe_layout(P); MoeOrder S;
#pragma unroll
    for (int e = 0; e < 9; ++e) S.pstart[e] = Lo.pstart[e];
    S.ntile = Lo.pstart[8] / 256; S.ncol = ncol; S.G = G; S.c = c; return S;
}

__device__ __forceinline__ void norm_moe_combine(const Params& P, const float* gain, int first, int stride) {
    BODY_IDS();
    const MoeLayout Lo = moe_layout(P); const GainRegs GR = load_gain(gain, lane);
    const unsigned* tokinfo = (const unsigned*)(P.ws + WS_TOKINFO); const bf16* Y = (const bf16*)(P.ws + WS_MOEY); bf16* H = (bf16*)(P.ws + WS_H2);
    for (int u = first; u < NTOK / 128; u += stride) for (int i = 0; i < 16; ++i) { const int row = u * 128 + wave * 16 + i;
        const u32x4 a = *(const u32x4*)(tokinfo + (size_t)row * 8);
        int p0 = 0, p1 = 0;
#pragma unroll
        for (int e = 0; e < 8; ++e) { p0 = ((int)a.x == e) ? Lo.pstart[e] : p0; p1 = ((int)a.y == e) ? Lo.pstart[e] : p1; }
        const u32x2* y0 = (const u32x2*)(Y + (size_t)(p0 + (int)a.z) * D) + lane; const u32x2* y1 = (const u32x2*)(Y + (size_t)(p1 + (int)a.w) * D) + lane;
        u32x2* xr = (u32x2*)(xr_of(P.out) + (size_t)row * D) + lane; f32x4 v[4]; float s = 0.f;
#pragma unroll
        for (int j = 0; j < 4; ++j) { const u32x2 w0 = y0[64 * j], w1 = y1[64 * j]; const u32x2 wx = xr[64 * j];
            v[j] = (f32x4){bflo(wx.x), bfhi(wx.x), bflo(wx.y), bfhi(wx.y)} + (f32x4){bflo(w0.x), bfhi(w0.x), bflo(w0.y), bfhi(w0.y)} + (f32x4){bflo(w1.x), bfhi(w1.x), bflo(w1.y), bfhi(w1.y)};
            { u32x2 wo; wo.x = pk2(v[j][0], v[j][1]); wo.y = pk2(v[j][2], v[j][3]); xr[64 * j] = wo; } s += (v[j][0] * v[j][0] + v[j][1] * v[j][1]) + (v[j][2] * v[j][2] + v[j][3] * v[j][3]); }
        const float rstd = __builtin_amdgcn_rsqf(wave_sum(s) * (1.0f / D) + RMS_EPS);
        u32x2* o8 = (u32x2*)(H + (size_t)row * D) + lane;
#pragma unroll
        for (int j = 0; j < 4; ++j) { const f32x4 h = v[j] * rstd * GR.g[j]; u32x2 w; w.x = pk2(h[0], h[1]); w.y = pk2(h[2], h[3]); o8[64 * j] = w; }
    }
}
#ifndef REF_MASK
#define REF_MASK 0
#endif
#ifndef N_LAUNCH_MODE
#define N_LAUNCH_MODE 1
#endif
constexpr int LDS_BYTES = 147456;
constexpr int RL_OFF = 131072, RL_UNITS = 15;
constexpr int MISC_OFF = LDS_BYTES - 64;
constexpr int N_PHASES = 27;
#ifndef PHASE_SEL
#define PHASE_SEL 0xFFFFFFFu
#endif
#define PH_ON(b) (((PHASE_SEL) >> (b)) & 1u)
#ifndef SUB_SEL
#define SUB_SEL 0xFFu
#endif
#define SUB_ON(b) (((SUB_SEL) >> (b)) & 1u)

#ifndef PROBE_MASK
#define PROBE_MASK 0u
#endif
#ifndef PROBE_MULT
#define PROBE_MULT 4
#endif
#define TIMED(bit, ...) do { unsigned long long t0_ = 0; if (((PROBE_MASK) >> (bit)) & 1u) t0_ = __builtin_amdgcn_s_memrealtime(); __VA_ARGS__; \
    if (((PROBE_MASK) >> (bit)) & 1u) pacc += __builtin_amdgcn_s_memrealtime() - t0_; } while (0)
#define RUN_GEMM(EPI_T, SCHED_T, GATH, gm, sc, ep) do { if (REF_MASK & 1) pg8::gemm_phase_naive<EPI_T, SCHED_T, GATH>(gm, sc, ep); \
    else pg8::gemm_phase<EPI_T, SCHED_T, true, GATH>(lds, gm, sc, ep); } while (0)

__device__ __forceinline__ int vcu_of() { int G = gridDim.x, bx = blockIdx.x; asm volatile("" : "+s"(G), "+s"(bx)); return (G % 8 == 0) ? (bx % 8) * (G / 8) + bx / 8 : bx; }
__device__ __forceinline__ bool in_range(int lo, int hi, int k) { asm volatile("" : "+s"(lo), "+s"(hi)); return lo <= k && k < hi; }
__global__ void __launch_bounds__(NTHREADS, 2) mega_fwd(Params P) {
    extern __shared__ __attribute__((aligned(16))) unsigned char lds_raw[];
    LAS unsigned char* lds = (LAS unsigned char*)lds_raw;
    const int tid = threadIdx.x;
    const int G = gridDim.x, bx = blockIdx.x;
    unsigned* ctl = (unsigned*)(P.ws + WS_CTL);
    volatile LAS unsigned* misc = (volatile LAS unsigned*)(lds + MISC_OFF);
    if (tid < 16) misc[tid] = 0u;
    if ((tid & 63) == 0) *(LAS int*)(uintptr_t)((unsigned)TID_TAB_OFF + 4u * hw_wave_key()) = tid >> 6;
    __syncthreads();
    const int lo = P.ph_lo, hi = P.ph_hi;
    XcdBarrier bar; bar.bar = ctl + CW_BAR; bar.x = 0; bar.st = misc;
    if (hi - lo > 1) bar = xcd_barrier_post(ctl + CW_BAR, misc);
#define IN(k) in_range(lo, hi, (k))
#ifndef PROBE_SEAMS
#define PROBE_SEAMS 0u
#endif
#define SEAM(k) do { if (IN(k) && IN((k) + 1)) { unsigned long long t0_ = 0; const bool tm_ = (((PROBE_MASK) >> 24) & 1u) || (((PROBE_SEAMS) >> (k)) & 1u); if (tm_) t0_ = __builtin_amdgcn_s_memrealtime(); \
    xcd_barrier(bar); if (tm_) pacc += __builtin_amdgcn_s_memrealtime() - t0_; } } while (0)
    unsigned long long pacc = 0;

#define H ((bf16*)(P.ws + WS_H))
#define ZIN ((bf16*)(P.ws + WS_ZIN))
#define GB ((bf16*)(P.ws + WS_G))
#define MB ((bf16*)(P.ws + WS_M))
#define MLAQ ((bf16*)(P.ws + WS_MLAQ))
#define MLAKV ((bf16*)(P.ws + WS_MLAKV))
#define KPER ((bf16*)(P.ws + WS_KPER))
#define cosT ((float*)(P.ws + WS_COS))
#define sinT ((float*)(P.ws + WS_SIN))
#define slot_tok ((int*)(P.ws + WS_SLOTTOK))
#define slot_gate ((float*)(P.ws + WS_SLOTGATE))

    if (PH_ON(0) && IN(0)) { TIMED(0, cvt_jobs(P, 0, 43, lds); p0_misc(P)); TIMED(1, norm1_phase(P, 0, XSrc{P.in[I_X], nullptr}, vcu_of(), gridDim.x)); }
    SEAM(0);

    for (int L = 0; L < 2; ++L) {
        const int pb = 1 + 12 * L;
        const int pc = (L == 0) ? 9 : 22;
        bf16* const XR = xr_of(P.out);
        const XSrc xsrc = (L == 0) ? XSrc{P.in[I_X], nullptr} : XSrc{nullptr, XR};
        if (PH_ON(2) && IN(pb + 1)) {
            TIMED(4, s5::build_w(P, L));
            pg8::Gemm g{H, wmix(P, L, WM_IN), D, D, D, nullptr}; pg8::StaticOrder S; S.init(NTOK, ZP, G, bx);
            epi::EpiStore E{ZIN, ZP, 0};
            TIMED(2, RUN_GEMM(epi::EpiStore, pg8::StaticOrder, false, g, S, E));
        }
        SEAM(pb + 1);
        if (PH_ON(3) && IN(pb + 2)) {
            TIMED(3, prep_phase(P, L));
            if (!(REF_MASK & 4)) TIMED(4, s5::pass0_mfma(P, lds));
            __syncthreads();
        }
        SEAM(pb + 2);
        if (PH_ON(4) && IN(pb + 3)) {
            if (SUB_ON(0)) { pg8::Gemm g{ZIN + ZC_CQ, wmix(P, L, WM_UQ), ZP, 256, 256, nullptr}; pg8::StaticOrder S; S.init(NTOK, 512, G, bx);
              epi::EpiMlaQ E{MLAQ, (const float*)(P.ws + WS_RSTDQ), cosT, sinT};
              TIMED(5, RUN_GEMM(epi::EpiMlaQ, pg8::StaticOrder, false, g, S, E)); }
            if (SUB_ON(1)) { pg8::Gemm g{ZIN + ZC_CKV, wmix(P, L, WM_UKV), ZP, 128, 128, nullptr}; pg8::StaticOrder S; S.init(NTOK, 512, G, bx);
              epi::EpiRowScale E{MLAKV, 512, (const float*)(P.ws + WS_RSTDKV)};
              TIMED(5, RUN_GEMM(epi::EpiRowScale, pg8::StaticOrder, false, g, S, E)); }
            if (SUB_ON(2)) { TIMED(6, if (REF_MASK & 4) s5::naive(P, L); else s5::phase1(P, L, lds)); }
            __syncthreads();
            if (SUB_ON(3)) { att::Tensors T; T.Q = ZIN + ZC_FQ; T.ldq = ZP; T.K = ZIN + ZC_FK; T.ldk = ZP; T.K2 = nullptr; T.V = ZIN + ZC_FV; T.ldv = ZP; T.O = ZIN + ZC_FQ; T.ldo = ZP;
              T.cdec = (const float*)(P.ws + WS_CDEC); T.relb = nullptr; T.qhs = 64; T.khs = 64; T.vhs = 64; T.ohs = 64;
              T.qmax = (const unsigned*)(P.ws + WS_CTL) + CW_QMAX + L * 512; T.kmax = (const unsigned*)(P.ws + WS_CTL) + CW_KMAX + L * 16;
              TIMED(7, if (REF_MASK & 2) att::attn_naive<att::MODE_FOX>(T); else att::attn_phase<att::MODE_FOX>(T, lds)); }
            __syncthreads();
            if (SUB_ON(4)) { att::Tensors T; T.Q = ZIN + ZC_DQ; T.ldq = ZP; T.K = ZIN + ZC_DK; T.ldk = ZP; T.K2 = nullptr; T.V = ZIN + ZC_DV; T.ldv = ZP; T.O = ZIN + ZC_DQ; T.ldo = ZP;
              T.cdec = nullptr; T.relb = P.in[I_RELB] + (size_t)L * 4 * 513; T.qhs = 64; T.khs = 64; T.vhs = 64; T.ohs = 64;
              TIMED(8, if (REF_MASK & 2) att::attn_naive<att::MODE_BAND>(T); else att::attn_phase<att::MODE_BAND>(T, lds)); }
            __syncthreads();
        }
        SEAM(pb + 3);
        if (PH_ON(5) && IN(pb + 4)) {
            if (SUB_ON(0)) { att::Tensors T; T.Q = MLAQ; T.ldq = 512; T.K = MLAKV; T.ldk = 512; T.K2 = KPER; T.V = MLAKV + 64; T.ldv = 512; T.O = ZIN + ZC_CQ; T.ldo = ZP;
              T.cdec = nullptr; T.relb = nullptr; T.qhs = 96; T.khs = 128; T.vhs = 128; T.ohs = 64;
              TIMED(9, if (REF_MASK & 2) att::attn_naive<att::MODE_MLA>(T); else att::attn_phase<att::MODE_MLA>(T, lds)); }
            __syncthreads();
            if (SUB_ON(1)) { pg8::Gemm g{ZIN + ZC_U, wmix(P, L, WM_GLU), ZP, 256, 256, nullptr}; pg8::StaticOrder S; S.init(NTOK, 256, G, bx);
              epi::EpiGlu E{ZIN + ZC_U, ZP};
              TIMED(10, RUN_GEMM(epi::EpiGlu, pg8::StaticOrder, false, g, S, E)); }
        }
        SEAM(pb + 4);
        if (PH_ON(6) && IN(pb + 5)) {
            g128::MergeProg MP; MP.Hn = H; MP.zin = ZIN; MP.wg = wmix(P, L, WM_G); MP.wb = wmix(P, L, WM_B); MP.bg = P.in[I_BG] + (size_t)L * 4 * D; MP.M = MB;
            const int vcu_ = vcu_of();
            TIMED(11, g128::stream<g128::MergeProg>(lds, MP, 1024, vcu_, G));
        }
        SEAM(pb + 5);
#define PANEL_FENCE() do { asm volatile("s_waitcnt vmcnt(0)" ::: "memory"); __builtin_amdgcn_fence(__ATOMIC_ACQUIRE, "agent"); asm volatile("s_waitcnt vmcnt(0)" ::: "memory"); __syncthreads(); } while (0)
        if (PH_ON(7) && IN(pb + 6)) {
            pg8::Gemm g{MB, wmix(P, L, WM_O), D, D, D, nullptr}; pg8::StaticOrder S; S.init(NTOK, D, G, bx);
            epi::EpiRes E{xsrc, XR, (L == 0) ? (float*)(P.ws + WS_G) : nullptr};
            TIMED(13, RUN_GEMM(epi::EpiRes, pg8::StaticOrder, false, g, S, E));
        }
        SEAM(pb + 6);
        if (PH_ON(8) && IN(pb + 7)) {
            const int vcu_ = vcu_of();
            if (L != 0) { TIMED(14, norm2_moe_phase(P, XSrc{nullptr, XR}, lds, vcu_, G)); TIMED(25, cvt_jobs(P, 43, 67, lds)); __syncthreads(); }
        }
        if (L != 0) SEAM(pb + 7);
        if (L == 0) {
            if (PH_ON(9) && IN(9)) {
                pg8::Gemm g{XR, (const bf16*)(P.ws + WS_W13), D, D, D, nullptr}; pg8::StaticOrder S; S.init(NTOK, 2 * DFF, G, bx);
                LAS float* rl = (LAS float*)(lds + RL_OFF);
                { const int t_ = my_tid(); const int half = __builtin_amdgcn_readfirstlane(t_ >> 8); const f32x4* sl = (const f32x4*)(P.ws + WS_G);
                  int nu = 0; { pg8::Unit uu; while (nu < RL_UNITS && S.next(nu, uu)) ++nu; }
#pragma unroll 3
                  for (int i = half; i < nu; i += 2) { pg8::Unit uu; S.next(i, uu);
                      const f32x4* rp = sl + (size_t)(uu.pm * 256 + (t_ & 255)) * 4; const f32x4 s0 = rp[0], s1 = rp[1], s2 = rp[2], s3 = rp[3];
                      const float tot = (((s0[0] + s0[1]) + (s0[2] + s0[3])) + ((s1[0] + s1[1]) + (s1[2] + s1[3]))) + (((s2[0] + s2[1]) + (s2[2] + s2[3])) + ((s3[0] + s3[1]) + (s3[2] + s3[3])));
                      rl[i * 256 + (t_ & 255)] = __builtin_amdgcn_rsqf(tot * (1.0f / D) + RMS_EPS); }
                  __syncthreads(); }
                epi::EpiSwiglu E{(bf16*)(P.ws + WS_HMID), DFF, 22, rl, 0};
                TIMED(15, RUN_GEMM(epi::EpiSwiglu, pg8::StaticOrder, false, g, S, E));
            }
            SEAM(9);
            if (PH_ON(10) && IN(10)) {
                pg8::Gemm g{(const bf16*)(P.ws + WS_HMID), (const bf16*)(P.ws + WS_W2), DFF, DFF, DFF, nullptr}; pg8::StaticOrder S; S.init(NTOK, D, G, bx);
                epi::EpiRes E{XSrc{nullptr, XR}, XR, nullptr};
                TIMED(16, RUN_GEMM(epi::EpiRes, pg8::StaticOrder, false, g, S, E));
            }
            SEAM(10);
        } else {
            if (PH_ON(21) && IN(21)) TIMED(17, moe_assign_phase(P));
            SEAM(21);
            if (PH_ON(22) && IN(22)) {
                pg8::Gemm g{H, (const bf16*)(P.ws + WS_WM13), D, D, D, slot_tok}; const MoeOrder S = moe_order(P, 11, G, bx);
                epi::EpiSwiglu E{(bf16*)(P.ws + WS_HMID), DFFE, 11, nullptr, 0};
                TIMED(18, RUN_GEMM(epi::EpiSwiglu, MoeOrder, true, g, S, E));
            }
            SEAM(22);
            if (PH_ON(23) && IN(23)) {
                pg8::Gemm g{(const bf16*)(P.ws + WS_HMID), (const bf16*)(P.ws + WS_WM2), DFFE, DFFE, DFFE, nullptr}; const MoeOrder S = moe_order(P, 4, G, bx);
                epi::EpiMoeDown E{(bf16*)(P.ws + WS_MOEY), slot_gate};
                TIMED(19, RUN_GEMM(epi::EpiMoeDown, MoeOrder, false, g, S, E));
            }
            SEAM(23);
        }
        if (PH_ON(12) && IN(pc + 3)) {
            const int vcu_ = vcu_of();
            if (L == 0) TIMED(20, norm_plain(XSrc{nullptr, XR}, P.in[I_GPLE] + L * D, H, vcu_, G)); else TIMED(20, norm_moe_combine(P, P.in[I_GPLE] + L * D, vcu_, G));
            PANEL_FENCE();
            g128::PleProg PP; PP.pbf = (const bf16*)(P.ws + WS_PBF) + (size_t)L * NTOK * 256; PP.hp = (L == 0) ? H : (const bf16*)(P.ws + WS_H2); PP.wup = wmix(P, L, WM_UP); PP.wpg = wmix(P, L, WM_PG); PP.x = XR;
            TIMED(22, g128::stream<g128::PleProg>(lds, PP, NTOK / 128, vcu_, G));
            PANEL_FENCE();
            if (L == 0) TIMED(1, norm1_phase(P, 1, XSrc{nullptr, XR}, vcu_, G));
        }
        if (L == 0) SEAM(pc + 3);
    }
    if (PH_ON(26) && IN(25)) {
        const int vcu_ = vcu_of(); const int G_ = gridDim.x;
        for (int r = 0; r < (NTOK / 128 + G_ - 1) / G_; ++r) {
            const int u = vcu_ + r * G_; FinalRows FR;
            if (u < NTOK / 128) final_norm_load(P, u, FR);
            xcd_barrier(bar);
            if (u < NTOK / 128) final_norm_store(P, u, FR);
        }
    }
    if (PROBE_MASK || PROBE_SEAMS) { const unsigned long long t0_ = __builtin_amdgcn_s_memrealtime(); while (__builtin_amdgcn_s_memrealtime() - t0_ < (unsigned long long)PROBE_MULT * pacc) __builtin_amdgcn_s_sleep(8); }
#undef IN
#undef SEAM
#undef H
#undef ZIN
#undef GB
#undef MB
#undef MLAQ
#undef MLAKV
#undef KPER
#undef cosT
#undef sinT
#undef slot_tok
#undef slot_gate
}

extern "C" void kernel_launch(void* const* d_in, const int* in_sizes, int n_in, void* d_out, int out_size, void* d_ws, size_t ws_size, hipStream_t stream) {
    static int grid = 0;
    if (grid == 0) {
        if (n_in != 37 || out_size != NTOK * D || ws_size < WS_END) { fprintf(stderr, "kernel_launch: unexpected shapes: n_in %d out %d ws %zu\n", n_in, out_size, ws_size); grid = -1; return; }
        int dev = 0, cus = 0, per_cu = 0;
        if (hipGetDevice(&dev) != hipSuccess || hipDeviceGetAttribute(&cus, hipDeviceAttributeMultiprocessorCount, dev) != hipSuccess) { grid = -1; return; }
        if (hipFuncSetAttribute((const void*)mega_fwd, hipFuncAttributeMaxDynamicSharedMemorySize, LDS_BYTES) != hipSuccess) { fprintf(stderr, "kernel_launch: hipFuncSetAttribute failed\n"); grid = -1; return; }
        if (hipOccupancyMaxActiveBlocksPerMultiprocessor(&per_cu, (const void*)mega_fwd, NTHREADS, LDS_BYTES) != hipSuccess || per_cu < 1)
            fprintf(stderr, "kernel_launch: note: occupancy query reports %d workgroups per CU\n", per_cu);
        (void)hipGetLastError();
        grid = cus;
        if (grid != 256) fprintf(stderr, "kernel_launch: note: %d CUs (built for 256)\n", grid);
    }
    if (grid < 0) return;
    if (hipMemsetAsync((char*)d_ws + WS_CTL, 0, CTL_ZERO_BYTES, stream) != hipSuccess) return;
    Params p{};
    for (int i = 0; i < 37; ++i) p.in[i] = (const float*)d_in[i];
    p.out = (float*)d_out; p.ws = (unsigned char*)d_ws;
#if N_LAUNCH_MODE == 1
    p.ph_lo = 0; p.ph_hi = N_PHASES;
    hipLaunchKernelGGL(mega_fwd, dim3(grid), dim3(NTHREADS), LDS_BYTES, stream, p);
#else
    for (int ph = 0; ph < N_PHASES; ++ph) { p.ph_lo = ph; p.ph_hi = ph + 1; hipLaunchKernelGGL(mega_fwd, dim3(grid), dim3(NTHREADS), LDS_BYTES, stream, p); }
#endif
    const hipError_t le = hipPeekAtLastError();
    if (le != hipSuccess) fprintf(stderr, "kernel_launch: launch failed: %s\n", hipGetErrorName(le));
}
```

```cpp
#include <hip/hip_runtime.h>
#include <cstdio>
#include <cstdint>

#define GAS __attribute__((address_space(1)))
#define LAS __attribute__((address_space(3)))
typedef unsigned short bf16;
typedef short bf16x8 __attribute__((ext_vector_type(8)));
typedef short s16x4 __attribute__((ext_vector_type(4)));
typedef float f32x2 __attribute__((ext_vector_type(2)));
typedef float f32x4 __attribute__((ext_vector_type(4)));
typedef float f32x16 __attribute__((ext_vector_type(16)));
typedef unsigned u32x2 __attribute__((ext_vector_type(2)));
typedef unsigned u32x4 __attribute__((ext_vector_type(4)));
typedef __bf16 bf16x2_t __attribute__((ext_vector_type(2)));

constexpr int NB = 4, SEQ = 8192, NTOK = NB * SEQ, D = 1024;
constexpr int ZP = 2304;
constexpr int ZC_U = 0, ZC_FQ = 256, ZC_FK = 512, ZC_FV = 768, ZC_DQ = 1024, ZC_DK = 1280, ZC_DV = 1536, ZC_CQ = 1792, ZC_CKV = 2048, ZC_KPE = 2176;
constexpr int DIN = 2148, DFF = 2816, DFFE = 1408, NE = 8;
constexpr int MOE_ROWS = 2 * NTOK + NE * 256;
constexpr float RMS_EPS = 1e-6f;
constexpr int NWAVES = 8, NTHREADS = 512;

constexpr size_t MiB = 1u << 20;
constexpr size_t WS_CTL = 0, CTL_ZERO_BYTES = 1 * MiB;
constexpr size_t WS_COS = 1 * MiB, WS_SIN = 3 * MiB;
constexpr size_t WS_LOGF = 5 * MiB;
constexpr size_t WS_CDEC = 5 * MiB + 512 * 1024;
constexpr size_t WS_WSUM = 6 * MiB;
constexpr size_t WS_RSTDQ = 6 * MiB + 256 * 1024, WS_RSTDKV = 6 * MiB + 512 * 1024;
constexpr size_t WS_SC = 7 * MiB;
constexpr size_t WS_TOKINFO = 11 * MiB;
constexpr size_t WS_SLOTTOK = 12 * MiB, WS_SLOTGATE = 12 * MiB + 512 * 1024;
constexpr size_t WS_S5W = 13 * MiB;
constexpr size_t WS_PBF = 17 * MiB;
constexpr size_t WS_WMIX = 49 * MiB, WMIX_STRIDE = 20 * MiB;
constexpr size_t WM_IN = 0, WM_G = 4 * MiB + 512 * 1024, WM_B = 12 * MiB + 512 * 1024, WM_O = 14 * MiB + 512 * 1024, WM_PG = 16 * MiB + 512 * 1024,
                 WM_UP = 18 * MiB + 512 * 1024, WM_UQ = 19 * MiB, WM_UKV = 19 * MiB + 256 * 1024, WM_GLU = 19 * MiB + 384 * 1024;
constexpr size_t WS_W13 = 89 * MiB, WS_W2 = 100 * MiB;
constexpr size_t WS_H = 106 * MiB;
constexpr size_t WS_MLAQ = 170 * MiB, WS_MLAKV = 202 * MiB, WS_KPER = 234 * MiB;
constexpr size_t WS_M = 170 * MiB;
constexpr size_t WS_ZIN = 236 * MiB;
constexpr size_t WS_G = 380 * MiB;
constexpr size_t WS_HMID = 236 * MiB;
constexpr size_t WS_U = 236 * MiB;
constexpr size_t WS_WM13 = 418 * MiB, WS_WM2 = 462 * MiB;
constexpr size_t WS_MOEY = 89 * MiB;
constexpr size_t WS_SSQ = 7 * MiB;
constexpr size_t WS_H2 = 300 * MiB;
constexpr size_t WS_END = 484 * MiB;
constexpr int CW_BAR = 4096;
constexpr int CW_MOECNT = 16384;
constexpr int CW_QMAX = 20480;
constexpr int CW_KMAX = 22528;

#define LDS_WAIT() asm volatile("s_waitcnt lgkmcnt(0)" ::: "memory")
#define VM_WAIT() asm volatile("s_waitcnt vmcnt(0)" ::: "memory")
__device__ __forceinline__ unsigned f2bf(float f) { unsigned u = __builtin_bit_cast(unsigned, f); return (u + 0x7fffu + ((u >> 16) & 1u)) >> 16; }
__device__ __forceinline__ unsigned pk2(float lo, float hi) { f32x2 v = {lo, hi}; bf16x2_t b = __builtin_convertvector(v, bf16x2_t); return __builtin_bit_cast(unsigned, b); }
__device__ __forceinline__ float bf2f(unsigned short b) { return __uint_as_float((unsigned)b << 16); }
__device__ __forceinline__ float bflo(unsigned w) { return __uint_as_float(w << 16); }
__device__ __forceinline__ float bfhi(unsigned w) { return __uint_as_float(w & 0xffff0000u); }
constexpr int TID_TAB_OFF = 147456 - 512;
__device__ __forceinline__ unsigned hw_wave_key() { return (unsigned)__builtin_amdgcn_s_getreg((5 << 11) | 4) & 0x3Fu; }
__device__ __forceinline__ int my_tid() {
    unsigned addr = (unsigned)TID_TAB_OFF + 4u * hw_wave_key(); asm volatile("" : "+s"(addr));
    const int wave = __builtin_amdgcn_readfirstlane(*(const LAS int*)(uintptr_t)addr);
    int lane = (int)__builtin_amdgcn_mbcnt_hi(~0u, __builtin_amdgcn_mbcnt_lo(~0u, 0u)); asm volatile("" : "+v"(lane));
    return wave * 64 + lane;
}
__device__ __forceinline__ float shflx(float v, int o, int lane) { return __int_as_float(__builtin_amdgcn_ds_bpermute((lane ^ o) << 2, __float_as_int(v))); }
#define DPP_F(x_, ctrl_, rm_) __int_as_float(__builtin_amdgcn_update_dpp(0, __float_as_int(x_), (ctrl_), (rm_), 0xF, true))
__device__ __forceinline__ float wave_sum(float v) {
    v += DPP_F(v, 0xB1, 0xF); v += DPP_F(v, 0x4E, 0xF); v += DPP_F(v, 0x114, 0xF); v += DPP_F(v, 0x118, 0xF);
    v += DPP_F(v, 0x142, 0xA); v += DPP_F(v, 0x143, 0xC);
    return __int_as_float(__builtin_amdgcn_readlane(__float_as_int(v), 63));
}
__device__ __forceinline__ float sigmoidf_(float x) { return __builtin_amdgcn_rcpf(1.0f + __expf(-x)); }

struct XSrc { const float* f; const bf16* b; };
__device__ __forceinline__ f32x4 ldx4(const XSrc& x, size_t idx) {
    if (x.f) return *(const f32x4*)(x.f + idx);
    const u32x2 w = *(const u32x2*)(x.b + idx); return (f32x4){bflo(w.x), bfhi(w.x), bflo(w.y), bfhi(w.y)};
}
__device__ __forceinline__ bf16* xr_of(float* out) { return (bf16*)((unsigned char*)out + (size_t)NTOK * D * 2); }
#define BODY_IDS() int tid = my_tid(); asm volatile("" : "+v"(tid)); const int lane = tid & 63; const int wave = __builtin_amdgcn_readfirstlane(tid >> 6); \
    int grid_ = gridDim.x; asm volatile("" : "+s"(grid_)); \
    const int gw = blockIdx.x * NWAVES + wave, ngw = grid_ * NWAVES, gtid = blockIdx.x * NTHREADS + tid, gthreads = grid_ * NTHREADS; (void)lane; (void)wave; (void)gw; (void)ngw; (void)gtid; (void)gthreads
#define XB_TMO      128
#define XB_XCNT(j)  (256  + 64 * (j))
#define XB_XSUB(j)  (1280 + 64 * (j))
#define XB_XGEN(j)  (2304 + 64 * (j))
#define XB_TOP      3328
#define XB_TOPGEN   3392
#define XCD_BAR_WORDS 3456
#define XB_SPIN_CAP (1u << 22)

__device__ __forceinline__ unsigned xb_ld(unsigned* p)              { return __hip_atomic_load(p, __ATOMIC_RELAXED, __HIP_MEMORY_SCOPE_AGENT); }
__device__ __forceinline__ unsigned xb_add(unsigned* p, unsigned v) { return __hip_atomic_fetch_add(p, v, __ATOMIC_RELAXED, __HIP_MEMORY_SCOPE_AGENT); }
__device__ __forceinline__ unsigned xb_xcc_id() { return (unsigned)__builtin_amdgcn_s_getreg((3 << 11) | 20) & 0xFu; }
#define XB_SPIN(cond, bar) do { unsigned _sp = 0; while (cond) { __builtin_amdgcn_s_sleep(1); \
    if ((++_sp & 255u) == 0u) { if (xb_ld(&(bar)[XB_TMO])) break; if (_sp > XB_SPIN_CAP) { atomicAdd(&(bar)[XB_TMO], 1u); break; } } } } while (0)

struct XcdBarrier { unsigned* bar; unsigned x; volatile LAS unsigned* st; };

__device__ __forceinline__ XcdBarrier xcd_barrier_post(unsigned* bar, volatile LAS unsigned* st) {
    XcdBarrier b; b.bar = bar; b.x = xb_xcc_id(); b.st = st;
    if (my_tid() == 0) (void)xb_add(&bar[XB_XCNT(b.x)], 1u);
    return b;
}
__device__ __forceinline__ void xcd_barrier_complete(unsigned* bar, unsigned x, unsigned& nloc, unsigned& nx) {
    const unsigned G = gridDim.x * gridDim.y * gridDim.z;
    unsigned sum, cnt, mine, sp = 0u;
    for (;;) {
        sum = 0u; cnt = 0u; mine = 0u;
#pragma unroll
        for (unsigned j = 0; j < 16; ++j) { const unsigned c = xb_ld(&bar[XB_XCNT(j)]); sum += c; cnt += (c > 0u) ? 1u : 0u; mine = (j == x) ? c : mine; }
        if (sum == G) break;
        __builtin_amdgcn_s_sleep(1);
        if ((++sp & 255u) == 0u) { if (xb_ld(&bar[XB_TMO])) break; if (sp > XB_SPIN_CAP) { atomicAdd(&bar[XB_TMO], 1u); break; } }
    }
    nloc = mine > 0u ? mine : 1u; nx = cnt > 0u ? cnt : 1u;
}
__device__ __forceinline__ void xcd_barrier(const XcdBarrier& b) {
    asm volatile("s_waitcnt vmcnt(0)" ::: "memory");
    __syncthreads();
    if (my_tid() == 0) {
        unsigned* bar = b.bar;
        __builtin_amdgcn_s_waitcnt(0);
        unsigned nloc = b.st[0], nx = b.st[1];
        if (nloc == 0u) { xcd_barrier_complete(bar, b.x, nloc, nx); b.st[0] = nloc; b.st[1] = nx; }
        const unsigned old = xb_add(&bar[XB_XSUB(b.x)], 1u);
        const unsigned gen = old / nloc;
        if (old + 1u == (gen + 1u) * nloc) {
            __builtin_amdgcn_fence(__ATOMIC_RELEASE, "agent");
            asm volatile("s_waitcnt vmcnt(0)" ::: "memory");
            const unsigned og = xb_add(&bar[XB_TOP], 1u);
            const unsigned tg = og / nx;
            if (og + 1u == (tg + 1u) * nx) xb_add(&bar[XB_TOPGEN], 1u);
            else XB_SPIN(xb_ld(&bar[XB_TOPGEN]) == tg, bar);
            __builtin_amdgcn_fence(__ATOMIC_ACQUIRE, "agent");
            xb_add(&bar[XB_XGEN(b.x)], 1u);
            asm volatile("s_waitcnt vmcnt(0)" ::: "memory");
        } else {
            XB_SPIN(xb_ld(&bar[XB_XGEN(b.x)]) == gen, bar);
            __builtin_amdgcn_fence(__ATOMIC_ACQUIRE, "agent");
            asm volatile("s_waitcnt vmcnt(0)" ::: "memory");
        }
    }
    __syncthreads();
}
namespace pg8 {
constexpr int BM = 256, BK = 64, HALF = 128, HTB = HALF * BK * 2, STAGE_BYTES = 8 * HTB, NXCD = 8, WGM = 8;
__host__ __device__ __forceinline__ int lds_byte(int r, int c) { const int st = (r >> 4) * 2 + (c >> 5), rr = r & 15, cc = c & 31, ob = rr * 64 + cc * 2; return st * 1024 + (ob ^ (((ob >> 9) & 1) << 5)); }
__host__ __device__ __forceinline__ void stage_rc(int b, int& R, int& C) { const int st = b / 1024, sb = b % 1024, swz = sb ^ (((sb >> 9) & 1) << 5); R = (st >> 1) * 16 + swz / 64; C = (st & 1) * 32 + (swz % 64) / 2; }
__host__ __device__ __forceinline__ int perm32(int rho) { const int n = rho >> 4, i = rho & 15; return 8 * (i >> 2) + 4 * n + (i & 3); }

struct Unit { int pm, pn; };
struct Gemm { const bf16* A; const bf16* Bt; int lda, ldb, K; const int* gidx; };

struct StaticOrder {
    int nM, nN, nwg, G, c;
    __host__ __device__ void init(int M, int N, int G_, int c_) { nM = M / BM; nN = N / BM; nwg = nM * nN; G = G_; c = c_; }
    __host__ __device__ __forceinline__ bool next(int i, Unit& u) const {
        const long L = (long)i * G + c; if (L >= nwg) return false;
        int wgid = (int)L; { const int q = nwg / NXCD, r = nwg % NXCD, xcd = wgid % NXCD, off = wgid / NXCD; wgid = (xcd < r ? xcd * (q + 1) : r * (q + 1) + (xcd - r) * q) + off; }
        const int nig = WGM * nN, gid = wgid / nig, fm = gid * WGM, gsz = (nM - fm) < WGM ? (nM - fm) : WGM;
        u.pm = fm + ((wgid % nig) % gsz); u.pn = (wgid % nig) / gsz; return true;
    }
};

template <class Epi, class Sched, bool ALIGN_EPI, bool GATHER>
__device__ __forceinline__ void gemm_phase(LAS unsigned char* lds, const Gemm g, const Sched& S, const Epi& E) {
    int tid = my_tid(); asm volatile("" : "+v"(tid));
    const int wid = __builtin_amdgcn_readfirstlane(tid >> 6), lane = tid & 63, wr = wid >> 2, wc = wid & 3, fr = lane & 15, fq = lane >> 4;
    int Kq = g.K; asm volatile("" : "+s"(Kq));
    const int K = Kq, nt = K / BK;
    int RA[2], CA[2];
    unsigned voffA[2], voffB[2];
#pragma unroll
    for (int i = 0; i < 2; ++i) { int R, C; stage_rc(tid * 16 + i * 8192, R, C); const int Rb = Epi::PERM ? ((R & ~31) + perm32(R & 31)) : R;
        RA[i] = R; CA[i] = C; voffA[i] = (unsigned)(R * g.lda + C) * 2u; voffB[i] = (unsigned)(Rb * g.ldb + C) * 2u; }
    const size_t kstep = (size_t)(BK * 2);
    const size_t hstepB = (size_t)HALF * g.ldb * 2, tstepB = 2 * hstepB;
    const size_t hstepA = (size_t)HALF * g.lda * 2, tstepA = 2 * hstepA;
    const unsigned ldsw = (unsigned)wid * 1024u;
    const int aoff = lds_byte(wr * 64 + fr, fq * 8), boff = lds_byte(wc * 32 + fr, fq * 8);
#define PG8_SA(b, h) (((b) * 2 + (h)) * HTB)
#define PG8_SB(b, h) ((4 + (b) * 2 + (h)) * HTB)
#define PG8_STAGEB(bufoff, gbase) do { _Pragma("unroll") for (int _i = 0; _i < 2; ++_i) \
        __builtin_amdgcn_global_load_lds((const unsigned*)((const char*)(gbase) + voffB[_i]), (LAS unsigned*)(lds + (bufoff) + ldsw + _i * 8192), 16, 0, 0); } while (0)
#define PG8_STAGEA(bufoff, kptr, isnext, h) do { _Pragma("unroll") for (int _i = 0; _i < 2; ++_i) { const char* _p; \
        if constexpr (GATHER) _p = (const char*)(kptr) + ((isnext) ? nvo[h][_i] : cvo[h][_i]); else _p = (const char*)(kptr) + (size_t)(h) * hstepA + voffA[_i]; \
        __builtin_amdgcn_global_load_lds((const unsigned*)_p, (LAS unsigned*)(lds + (bufoff) + ldsw + _i * 8192), 16, 0, 0); } } while (0)
#define PG8_LDA(dst, b, h) do { _Pragma("unroll") for (int m = 0; m < 4; ++m) _Pragma("unroll") for (int k = 0; k < 2; ++k) dst[m][k] = *(const LAS bf16x8*)(lds + PG8_SA(b, h) + aoff + m * 2048 + k * 1024); } while (0)
#define PG8_LDB(dst, b, h) do { _Pragma("unroll") for (int n = 0; n < 2; ++n) _Pragma("unroll") for (int k = 0; k < 2; ++k) dst[n][k] = *(const LAS bf16x8*)(lds + PG8_SB(b, h) + boff + n * 2048 + k * 1024); } while (0)
#define PG8_MMA(ai, bj, At, Bt) do { __builtin_amdgcn_s_setprio(1); _Pragma("unroll") for (int m = 0; m < 4; ++m) _Pragma("unroll") for (int n = 0; n < 2; ++n) _Pragma("unroll") for (int k = 0; k < 2; ++k) \
        acc[ai][bj][m][n] = __builtin_amdgcn_mfma_f32_16x16x32_bf16(Bt[n][k], At[m][k], acc[ai][bj][m][n], 0, 0, 0); __builtin_amdgcn_s_setprio(0); } while (0)
#define PG8_WAIT_V(n) asm volatile("s_waitcnt vmcnt(" #n ")" ::: "memory")
#define PG8_WAIT_L(n) asm volatile("s_waitcnt lgkmcnt(" #n ")" ::: "memory")
#define PG8_BAR __builtin_amdgcn_s_barrier()
#define PG8_SCHED __builtin_amdgcn_sched_barrier(0)
#define PG8_VOA(vo, u) do { _Pragma("unroll") for (int _h = 0; _h < 2; ++_h) _Pragma("unroll") for (int _i = 0; _i < 2; ++_i) { \
        int _row = (u).pm * BM + _h * HALF + RA[_i]; if (GATHER) { _row = g.gidx[_row]; _row = _row < 0 ? 0 : _row; } \
        (vo)[_h][_i] = (unsigned)_row * (unsigned)(g.lda * 2) + (unsigned)(CA[_i] * 2); } } while (0)
    Unit cur, nxt; int ui = 0;
    if (!S.next(0, cur)) return;
    f32x4 acc[2][2][4][2];
#pragma unroll
    for (int a = 0; a < 2; ++a)
#pragma unroll
        for (int b = 0; b < 2; ++b)
#pragma unroll
            for (int m = 0; m < 4; ++m)
#pragma unroll
                for (int n = 0; n < 2; ++n) acc[a][b][m][n] = (f32x4){0.f, 0.f, 0.f, 0.f};
    bf16x8 At[4][2], B0[2][2], B1[2][2];
    unsigned cvo[2][2], nvo[2][2];
    if constexpr (GATHER) { PG8_VOA(cvo, cur); PG8_VOA(nvo, cur); }
    const char* cA = (const char*)g.A + (GATHER ? (size_t)0 : (size_t)cur.pm * tstepA); const char* cB = (const char*)g.Bt + (size_t)cur.pn * tstepB;
    PG8_STAGEB(PG8_SB(0, 0), cB); PG8_STAGEB(PG8_SB(0, 1), cB + hstepB); PG8_STAGEA(PG8_SA(0, 0), cA, false, 0); PG8_STAGEA(PG8_SA(0, 1), cA, false, 1);
    if (wr == 1) PG8_BAR;
    PG8_WAIT_V(2); PG8_BAR;
    PG8_STAGEB(PG8_SB(1, 0), cB + kstep); PG8_STAGEA(PG8_SA(1, 0), cA + kstep, false, 0); PG8_STAGEB(PG8_SB(1, 1), cB + hstepB + kstep);
    PG8_WAIT_V(6); PG8_BAR;
    for (;;) {
        const bool has_next = S.next(ui + 1, nxt);
        if constexpr (GATHER) { if (has_next) { PG8_VOA(nvo, nxt); } }
        const char* nA = (GATHER || !has_next) ? cA : (const char*)g.A + (size_t)nxt.pm * tstepA;
        const char* nB = has_next ? (const char*)g.Bt + (size_t)nxt.pn * tstepB : cB;
#pragma nounroll
        for (int t = 0; t < nt; t += 2) {
            const bool last = (t == nt - 2);
            const char* a1 = cA + (size_t)(t + 1) * kstep;
            const char* a2 = last ? nA : cA + (size_t)(t + 2) * kstep; const char* b2 = last ? nB : cB + (size_t)(t + 2) * kstep;
            const char* a3 = a2 + kstep; const char* b3 = b2 + kstep;
            PG8_LDB(B0, 0, 0); PG8_LDB(B1, 0, 1); PG8_SCHED; PG8_LDA(At, 0, 0); PG8_STAGEA(PG8_SA(1, 1), a1, false, 1);
            PG8_WAIT_V(8); PG8_WAIT_L(0); PG8_BAR; PG8_MMA(0, 0, At, B0); PG8_MMA(0, 1, At, B1); PG8_BAR; PG8_SCHED;
            PG8_LDA(At, 0, 1); PG8_STAGEB(PG8_SB(0, 0), b2); PG8_STAGEB(PG8_SB(0, 1), b2 + hstepB); PG8_STAGEA(PG8_SA(0, 0), a2, last, 0);
            PG8_WAIT_V(8); PG8_WAIT_L(0); PG8_BAR; PG8_MMA(1, 0, At, B0); PG8_MMA(1, 1, At, B1); PG8_BAR; PG8_SCHED;
            PG8_LDB(B0, 1, 0); PG8_LDB(B1, 1, 1); PG8_SCHED; PG8_LDA(At, 1, 0); PG8_STAGEA(PG8_SA(0, 1), a2, last, 1);
            PG8_WAIT_V(8); PG8_WAIT_L(0); PG8_BAR; PG8_MMA(0, 0, At, B0); PG8_MMA(0, 1, At, B1); PG8_BAR; PG8_SCHED;
            PG8_LDA(At, 1, 1); PG8_STAGEB(PG8_SB(1, 0), b3); PG8_STAGEB(PG8_SB(1, 1), b3 + hstepB); PG8_STAGEA(PG8_SA(1, 0), a3, last, 0);
            PG8_WAIT_V(8); PG8_WAIT_L(0); PG8_BAR; PG8_MMA(1, 0, At, B0); PG8_MMA(1, 1, At, B1); PG8_BAR; PG8_SCHED;
        }
        if constexpr (ALIGN_EPI) { if (wr == 0) PG8_BAR; }
        E(acc, cur, wr, wc, fr, fq);
        if (!has_next) break;
#pragma unroll
        for (int a = 0; a < 2; ++a)
#pragma unroll
            for (int b = 0; b < 2; ++b)
#pragma unroll
                for (int m = 0; m < 4; ++m)
#pragma unroll
                    for (int n = 0; n < 2; ++n) acc[a][b][m][n] = (f32x4){0.f, 0.f, 0.f, 0.f};
        cur = nxt; cA = nA; cB = nB; ++ui;
        if constexpr (GATHER) {
#pragma unroll
            for (int _h = 0; _h < 2; ++_h)
#pragma unroll
                for (int _i = 0; _i < 2; ++_i) cvo[_h][_i] = nvo[_h][_i]; }
        if constexpr (ALIGN_EPI) { if (wr == 1) PG8_BAR; }
    }
    PG8_WAIT_V(0);
    if constexpr (!ALIGN_EPI) { if (wr == 0) PG8_BAR; }
    PG8_BAR;
#undef PG8_SA
#undef PG8_SB
#undef PG8_STAGEA
#undef PG8_STAGEB
#undef PG8_LDA
#undef PG8_LDB
#undef PG8_MMA
#undef PG8_WAIT_V
#undef PG8_WAIT_L
#undef PG8_BAR
#undef PG8_SCHED
#undef PG8_VOA
}

template <class Epi, class Sched, bool GATHER>
__device__ __forceinline__ void gemm_phase_naive(const Gemm g, const Sched& S, const Epi& E) {
    const int tid = threadIdx.x, wid = tid >> 6, lane = tid & 63, wr = wid >> 2, wc = wid & 3, fr = lane & 15, fq = lane >> 4;
    Unit u;
    for (int ui = 0; S.next(ui, u); ++ui) {
        f32x4 acc[2][2][4][2];
#pragma unroll
        for (int a = 0; a < 2; ++a)
#pragma unroll
            for (int b = 0; b < 2; ++b)
#pragma unroll
                for (int m = 0; m < 4; ++m)
#pragma unroll
                    for (int n = 0; n < 2; ++n) acc[a][b][m][n] = (f32x4){0.f, 0.f, 0.f, 0.f};
        const bf16* arow[2][4];
#pragma unroll
        for (int ai = 0; ai < 2; ++ai)
#pragma unroll
            for (int m = 0; m < 4; ++m) { int r = u.pm * BM + ai * HALF + wr * 64 + m * 16 + fr; if (GATHER) { r = g.gidx[r]; r = r < 0 ? 0 : r; } arow[ai][m] = g.A + (size_t)r * g.lda; }
        for (int k = 0; k < g.K; k += 4) {
            float av[2][4][4];
#pragma unroll
            for (int ai = 0; ai < 2; ++ai)
#pragma unroll
                for (int m = 0; m < 4; ++m) { const u32x2 w = *(const u32x2*)(arow[ai][m] + k); av[ai][m][0] = bflo(w.x); av[ai][m][1] = bfhi(w.x); av[ai][m][2] = bflo(w.y); av[ai][m][3] = bfhi(w.y); }
#pragma unroll
            for (int bj = 0; bj < 2; ++bj)
#pragma unroll
                for (int n = 0; n < 2; ++n)
#pragma unroll
                    for (int e = 0; e < 4; ++e) {
                        const int col = u.pn * BM + bj * HALF + wc * 32 + (Epi::PERM ? (8 * fq + 4 * n) : (16 * n + 4 * fq)) + e;
                        const u32x2 w = *(const u32x2*)(g.Bt + (size_t)col * g.ldb + k);
                        const float b0 = bflo(w.x), b1 = bfhi(w.x), b2 = bflo(w.y), b3 = bfhi(w.y);
#pragma unroll
                        for (int ai = 0; ai < 2; ++ai)
#pragma unroll
                            for (int m = 0; m < 4; ++m) acc[ai][bj][m][n][e] += av[ai][m][0] * b0 + av[ai][m][1] * b1 + av[ai][m][2] * b2 + av[ai][m][3] * b3;
                    }
        }
        E(acc, u, wr, wc, fr, fq);
    }
    VM_WAIT(); __syncthreads();
}
}
namespace g128 {
using pg8::lds_byte; using pg8::stage_rc; using pg8::HTB; using pg8::BK;
struct Seg { const bf16* A; const bf16* B; int lda, ldb, nt; };
typedef f32x4 acc_t[2][4][2];

template <class Prog>
__device__ __forceinline__ void stream(LAS unsigned char* lds, Prog& P, int nunits, int first, int stride) {
    int tid = my_tid(); asm volatile("" : "+v"(tid));
    const int wid = __builtin_amdgcn_readfirstlane(tid >> 6), lane = tid & 63, wr = wid >> 2, wc = wid & 3, fr = lane & 15, fq = lane >> 4;
    int RA[2], CA[2], RB[2];
#pragma unroll
    for (int i = 0; i < 2; ++i) { stage_rc(tid * 16 + i * 8192, RA[i], CA[i]); RB[i] = (RA[i] & ~31) + pg8::perm32(RA[i] & 31); }
    const unsigned ldsw = (unsigned)wid * 1024u;
    const int aoff = lds_byte(wr * 64 + fr, fq * 8), boff = lds_byte(wc * 32 + fr, fq * 8);
#define G_SA(b) ((b) * HTB)
#define G_SB(b, h) ((2 + (b) * 2 + (h)) * HTB)
#define G_STAGE(bufoff, base, ld, kbyte, RR) do { _Pragma("unroll") for (int _i = 0; _i < 2; ++_i) \
        __builtin_amdgcn_global_load_lds((const unsigned*)((const char*)(base) + (size_t)(kbyte) + (unsigned)(RR[_i] * (ld) + CA[_i]) * 2u), (LAS unsigned*)(lds + (bufoff) + ldsw + _i * 8192), 16, 0, 0); } while (0)
#define G_STAGE_A(b, S, j) G_STAGE(G_SA(b), (S).A, (S).lda, (j) * 128, RA)
#define G_STAGE_B(b, h, S, j) G_STAGE(G_SB(b, h), (const char*)(S).B + (size_t)(h) * 128 * (S).ldb * 2, (S).ldb, (j) * 128, RB)
#define G_LDA(dst, b) do { _Pragma("unroll") for (int m = 0; m < 4; ++m) _Pragma("unroll") for (int k = 0; k < 2; ++k) dst[m][k] = *(const LAS bf16x8*)(lds + G_SA(b) + aoff + m * 2048 + k * 1024); } while (0)
#define G_LDB(dst, b, h) do { _Pragma("unroll") for (int n = 0; n < 2; ++n) _Pragma("unroll") for (int k = 0; k < 2; ++k) dst[n][k] = *(const LAS bf16x8*)(lds + G_SB(b, h) + boff + n * 2048 + k * 1024); } while (0)
#define G_MMA(bj, At, Bt) do { __builtin_amdgcn_s_setprio(1); _Pragma("unroll") for (int m = 0; m < 4; ++m) _Pragma("unroll") for (int n = 0; n < 2; ++n) _Pragma("unroll") for (int k = 0; k < 2; ++k) \
        acc[bj][m][n] = __builtin_amdgcn_mfma_f32_16x16x32_bf16(Bt[n][k], At[m][k], acc[bj][m][n], 0, 0, 0); __builtin_amdgcn_s_setprio(0); } while (0)
#define G_WAIT_V(n) asm volatile("s_waitcnt vmcnt(" #n ")" ::: "memory")
#define G_WAIT_L(n) asm volatile("s_waitcnt lgkmcnt(" #n ")" ::: "memory")
#define G_BAR __builtin_amdgcn_s_barrier()
#define G_SCHED __builtin_amdgcn_sched_barrier(0)
    if (first >= nunits) return;
    P.reset();
    int ucur = first, scur = 0;
    Seg cur, nxt;
    P.seg(ucur, scur, cur);
    acc_t acc;
    P.init(ucur, scur, acc, wr, wc, fr, fq);
    bf16x8 At[4][2], B0[2][2], B1[2][2];
    G_STAGE_B(0, 0, cur, 0); G_STAGE_A(0, cur, 0); G_STAGE_B(0, 1, cur, 0);
    if (wr == 1) G_BAR;
    G_WAIT_V(2); G_BAR;
    G_STAGE_A(1, cur, 1); G_STAGE_B(1, 0, cur, 1);
    G_WAIT_V(4); G_BAR;
#define G_TILE(t_, b_) do { const bool n1_ = ((t_) + 1 >= nt), n2_ = ((t_) + 2 >= nt); const int j1_ = n1_ ? ((t_) + 1 - nt) : ((t_) + 1), j2_ = n2_ ? ((t_) + 2 - nt) : ((t_) + 2); \
        G_LDB(B0, b_, 0); G_SCHED; G_LDA(At, b_); \
        if (n1_) G_STAGE_B((b_) ^ 1, 1, nxt, j1_); else G_STAGE_B((b_) ^ 1, 1, cur, j1_); \
        G_WAIT_V(6); G_WAIT_L(0); G_BAR; G_MMA(0, At, B0); G_BAR; G_SCHED; \
        G_LDB(B1, b_, 1); \
        if (n2_) { G_STAGE_A(b_, nxt, j2_); G_STAGE_B(b_, 0, nxt, j2_); } else { G_STAGE_A(b_, cur, j2_); G_STAGE_B(b_, 0, cur, j2_); } \
        G_WAIT_V(6); G_WAIT_L(0); G_BAR; G_MMA(1, At, B1); G_BAR; G_SCHED; } while (0)
    for (;;) {
        int unxt = ucur, snxt = scur + 1; bool more = true;
        if (snxt == Prog::NSEG) { snxt = 0; unxt = ucur + stride; if (unxt >= nunits) { more = false; unxt = ucur; snxt = scur; } }
        P.seg(unxt, snxt, nxt);
        int ntq = cur.nt; asm volatile("" : "+s"(ntq)); const int nt = ntq;
#pragma nounroll
        for (int t = 0; t < nt; t += 2) { G_TILE(t, 0); G_TILE(t + 1, 1); }
        P.done(ucur, scur, acc, wr, wc, fr, fq);
        if (!more) break;
        P.init(unxt, snxt, acc, wr, wc, fr, fq);
        ucur = unxt; scur = snxt; cur = nxt;
    }
    G_WAIT_V(0);
    if (wr == 0) G_BAR;
    G_BAR;
#undef G_SA
#undef G_SB
#undef G_STAGE
#undef G_STAGE_A
#undef G_STAGE_B
#undef G_LDA
#undef G_LDB
#undef G_MMA
#undef G_WAIT_V
#undef G_WAIT_L
#undef G_BAR
#undef G_SCHED
#undef G_TILE
}

struct MergeProg {
    static constexpr int NSEG = 8;
    const bf16* Hn; const bf16* zin; const bf16* wg; const bf16* wb; const float* bg; bf16* M;
    __device__ __forceinline__ void reset() {
#pragma unroll
        for (int a = 0; a < 2; ++a)
#pragma unroll
            for (int b = 0; b < 4; ++b)
#pragma unroll
                for (int c = 0; c < 2; ++c) { g[a][b][c] = (u32x2){0u, 0u}; macc[a][b][c] = (u32x2){0u, 0u}; } }
    u32x2 g[2][4][2]; u32x2 macc[2][4][2];
    __device__ __forceinline__ void seg(int u, int s, Seg& S) const {
        const int pm = u >> 2, pn = u & 3, k = s >> 1;
        if ((s & 1) == 0) { S.A = Hn + (size_t)pm * 128 * D; S.lda = D; S.B = wg + ((size_t)k * D + pn * 256) * D; S.ldb = D; S.nt = D / 64; }
        else { const int ycol = (k == 0) ? ZC_U : (k == 1) ? ZC_FQ : (k == 2) ? ZC_CQ : ZC_DQ;
               S.A = zin + (size_t)pm * 128 * ZP + ycol; S.lda = ZP; S.B = wb + ((size_t)k * D + pn * 256) * 256; S.ldb = 256; S.nt = 4; }
    }
    __device__ __forceinline__ void init(int u, int s, acc_t& acc, int wr, int wc, int fr, int fq) {
        const int pn = u & 3, k = s >> 1;
        if ((s & 1) == 0) {
#pragma unroll
            for (int bj = 0; bj < 2; ++bj)
#pragma unroll
                for (int n = 0; n < 2; ++n) { const f32x4 bv = *(const f32x4*)(bg + (size_t)k * D + pn * 256 + bj * 128 + wc * 32 + 8 * fq + 4 * n);
#pragma unroll
                    for (int m = 0; m < 4; ++m) acc[bj][m][n] = bv; }
            if (s == 0) {
#pragma unroll
                for (int bj = 0; bj < 2; ++bj)
#pragma unroll
                    for (int m = 0; m < 4; ++m)
#pragma unroll
                        for (int n = 0; n < 2; ++n) macc[bj][m][n] = (u32x2){0u, 0u}; }
        } else {
#pragma unroll
            for (int bj = 0; bj < 2; ++bj)
#pragma unroll
                for (int m = 0; m < 4; ++m)
#pragma unroll
                    for (int n = 0; n < 2; ++n) acc[bj][m][n] = (f32x4){0.f, 0.f, 0.f, 0.f};
        }
    }
    __device__ __forceinline__ void done(int u, int s, const acc_t& acc, int wr, int wc, int fr, int fq) {
        if ((s & 1) == 0) {
#pragma unroll
            for (int bj = 0; bj < 2; ++bj)
#pragma unroll
                for (int m = 0; m < 4; ++m)
#pragma unroll
                    for (int n = 0; n < 2; ++n) { const f32x4 a = acc[bj][m][n]; u32x2 w; w.x = pk2(sigmoidf_(a[0]), sigmoidf_(a[1])); w.y = pk2(sigmoidf_(a[2]), sigmoidf_(a[3])); g[bj][m][n] = w; }
        } else {
#pragma unroll
            for (int bj = 0; bj < 2; ++bj)
#pragma unroll
                for (int m = 0; m < 4; ++m)
#pragma unroll
                    for (int n = 0; n < 2; ++n) { const u32x2 w = g[bj][m][n], q = macc[bj][m][n]; const f32x4 v = (f32x4){bflo(q.x), bfhi(q.x), bflo(q.y), bfhi(q.y)} + (f32x4){bflo(w.x), bfhi(w.x), bflo(w.y), bfhi(w.y)} * acc[bj][m][n];
                        u32x2 r; r.x = pk2(v[0], v[1]); r.y = pk2(v[2], v[3]); macc[bj][m][n] = r; }
            if (s == NSEG - 1) { const int pm = u >> 2, pn = u & 3;
#pragma unroll
                for (int m = 0; m < 4; ++m) { bf16* rp = M + (size_t)(pm * 128 + wr * 64 + m * 16 + fr) * D + pn * 256 + wc * 32 + 8 * fq;
#pragma unroll
                    for (int bj = 0; bj < 2; ++bj) *(u32x4*)(rp + bj * 128) = (u32x4){macc[bj][m][0].x, macc[bj][m][0].y, macc[bj][m][1].x, macc[bj][m][1].y}; } }
        }
    }
};

struct PleProg {
    static constexpr int NSEG = 8;
    const bf16* pbf; const bf16* hp; const bf16* wup; const bf16* wpg; const bf16* xin; bf16* xout;
    const float* ssq;
    u32x2 uu[2][4][2]; float rs[4];
    __device__ __forceinline__ void reset() {
#pragma unroll
        for (int m = 0; m < 4; ++m) rs[m] = 1.0f;
#pragma unroll
        for (int a = 0; a < 2; ++a)
#pragma unroll
            for (int b = 0; b < 4; ++b)
#pragma unroll
                for (int c = 0; c < 2; ++c) uu[a][b][c] = (u32x2){0u, 0u}; }
    __device__ __forceinline__ void seg(int u, int s, Seg& S) const {
        const int pn = s >> 1;
        if ((s & 1) == 0) { S.A = pbf + (size_t)u * 128 * 256; S.lda = 256; S.B = wup + (size_t)pn * 256 * 256; S.ldb = 256; S.nt = 4; }
        else { S.A = hp + (size_t)u * 128 * D; S.lda = D; S.B = wpg + (size_t)pn * 256 * D; S.ldb = D; S.nt = D / 64; }
    }
    __device__ __forceinline__ void init(int u, int s, acc_t& acc, int wr, int wc, int fr, int fq) {
#pragma unroll
        for (int bj = 0; bj < 2; ++bj)
#pragma unroll
            for (int m = 0; m < 4; ++m)
#pragma unroll
                for (int n = 0; n < 2; ++n) acc[bj][m][n] = (f32x4){0.f, 0.f, 0.f, 0.f};
        if (s == 0 && ssq) {
#pragma unroll
            for (int m = 0; m < 4; ++m) { const f32x4* rp = (const f32x4*)ssq + (size_t)(u * 128 + wr * 64 + m * 16 + fr) * 4; const f32x4 s0 = rp[0], s1 = rp[1], s2 = rp[2], s3 = rp[3];
                const float tot = (((s0[0] + s0[1]) + (s0[2] + s0[3])) + ((s1[0] + s1[1]) + (s1[2] + s1[3]))) + (((s2[0] + s2[1]) + (s2[2] + s2[3])) + ((s3[0] + s3[1]) + (s3[2] + s3[3])));
                rs[m] = __builtin_amdgcn_rsqf(tot * (1.0f / D) + RMS_EPS); } }
    }
    __device__ __forceinline__ void done(int u, int s, const acc_t& acc, int wr, int wc, int fr, int fq) {
        if ((s & 1) == 0) {
#pragma unroll
            for (int bj = 0; bj < 2; ++bj)
#pragma unroll
                for (int m = 0; m < 4; ++m)
#pragma unroll
                    for (int n = 0; n < 2; ++n) { const f32x4 a = acc[bj][m][n]; u32x2 w; w.x = pk2(a[0], a[1]); w.y = pk2(a[2], a[3]); uu[bj][m][n] = w; }
        } else { const int pn = s >> 1;
#pragma unroll
            for (int m = 0; m < 4; ++m) { const size_t ro = (size_t)(u * 128 + wr * 64 + m * 16 + fr) * D + pn * 256 + wc * 32 + 8 * fq; const bf16* rpi = xin + ro; bf16* rp = xout + ro; u32x4 xv[2]; const float rsm = rs[m];
#pragma unroll
                for (int bj = 0; bj < 2; ++bj) xv[bj] = *(const u32x4*)(rpi + bj * 128);
#pragma unroll
                for (int bj = 0; bj < 2; ++bj) { const u32x4 xw = xv[bj]; f32x4 r[2];
#pragma unroll
                    for (int n = 0; n < 2; ++n) { const u32x2 w = uu[bj][m][n]; f32x4 v = acc[bj][m][n] * rsm;
                        v[0] = sigmoidf_(v[0]); v[1] = sigmoidf_(v[1]); v[2] = sigmoidf_(v[2]); v[3] = sigmoidf_(v[3]);
                        const f32x4 xo = n == 0 ? (f32x4){bflo(xw.x), bfhi(xw.x), bflo(xw.y), bfhi(xw.y)} : (f32x4){bflo(xw.z), bfhi(xw.z), bflo(xw.w), bfhi(xw.w)};
                        r[n] = xo + (f32x4){bflo(w.x), bfhi(w.x), bflo(w.y), bfhi(w.y)} * v; }
                    *(u32x4*)(rp + bj * 128) = (u32x4){pk2(r[0][0], r[0][1]), pk2(r[0][2], r[0][3]), pk2(r[1][0], r[1][1]), pk2(r[1][2], r[1][3])}; } } }
    }
};
}
namespace epi {
using pg8::Unit; using pg8::BM; using pg8::HALF;
__device__ __forceinline__ void epi_fence() { asm volatile("" ::: "memory"); }
#define EPI_FENCE epi_fence()
#define EPI_LOOP_ROWS for (int ai = 0; ai < 2; ++ai) _Pragma("unroll") for (int m = 0; m < 4; ++m)
#define EPI_LOOP_COLS for (int bj = 0; bj < 2; ++bj) _Pragma("unroll") for (int n = 0; n < 2; ++n)
#define EPI_ROW (u.pm * BM + ai * HALF + wr * 64 + m * 16 + fr)
#define EPI_COLT (bj * HALF + wc * 32 + n * 16 + 4 * fq)
typedef f32x4 acc_t[2][2][4][2];
#define EPI_C8(bj_) ((bj_) * HALF + wc * 32 + 8 * fq)
__device__ __forceinline__ u32x4 pack8(f32x4 a, f32x4 b) { return (u32x4){pk2(a[0], a[1]), pk2(a[2], a[3]), pk2(b[0], b[1]), pk2(b[2], b[3])}; }
__device__ __forceinline__ u32x2 pack4(f32x4 v) { u32x2 w; w.x = pk2(v[0], v[1]); w.y = pk2(v[2], v[3]); return w; }
__device__ __forceinline__ f32x4 unpack4(u32x2 w) { return (f32x4){bflo(w.x), bfhi(w.x), bflo(w.y), bfhi(w.y)}; }

struct EpiStore {
    static constexpr bool PERM = true;
    bf16* O; int ldc; int pn0;
    __device__ __forceinline__ void operator()(const acc_t& acc, const Unit& u, int wr, int wc, int fr, int fq) const {
#pragma unroll
        EPI_LOOP_ROWS { bf16* rp = O + (size_t)EPI_ROW * ldc + (u.pn - pn0) * BM + wc * 32 + 8 * fq;
#pragma unroll
            for (int bj = 0; bj < 2; ++bj) { const u32x2 lo = pack4(acc[ai][bj][m][0]), hi = pack4(acc[ai][bj][m][1]); *(u32x4*)(rp + bj * HALF) = (u32x4){lo.x, lo.y, hi.x, hi.y}; } }
    }
};
struct EpiRowScale {
    static constexpr bool PERM = true;
    bf16* O; int ldc; const float* rs;
    __device__ __forceinline__ void operator()(const acc_t& acc, const Unit& u, int wr, int wc, int fr, int fq) const {
        float sv[2][4];
#pragma unroll
        EPI_LOOP_ROWS sv[ai][m] = rs[EPI_ROW];
#pragma unroll
        EPI_LOOP_ROWS { const int row = EPI_ROW; const float s = sv[ai][m]; bf16* rp = O + (size_t)row * ldc + u.pn * BM;
#pragma unroll
            for (int bj = 0; bj < 2; ++bj) *(u32x4*)(rp + EPI_C8(bj)) = pack8(acc[ai][bj][m][0] * s, acc[ai][bj][m][1] * s); }
    }
};
struct EpiMlaQ {
    static constexpr bool PERM = false;
    bf16* O; const float* rs; const float* cosT; const float* sinT;
    __device__ __forceinline__ void operator()(const acc_t& acc, const Unit& u, int wr, int wc, int fr, int fq) const {
        float sv[2][4]; f32x4 csv[2], snv[2];
#pragma unroll
        EPI_LOOP_ROWS sv[ai][m] = rs[EPI_ROW];
        { const int row = u.pm * BM + wr * 64 + fr; csv[0] = *(const f32x4*)(cosT + (size_t)row * 16 + 4 * fq); snv[0] = *(const f32x4*)(sinT + (size_t)row * 16 + 4 * fq); }
#pragma unroll
        for (int it = 0; it < 8; ++it) { const int ai = it >> 2, m = it & 3;
            if (it + 1 < 8) { const int row = u.pm * BM + ((it + 1) >> 2) * HALF + wr * 64 + ((it + 1) & 3) * 16 + fr;
                csv[(it + 1) & 1] = *(const f32x4*)(cosT + (size_t)row * 16 + 4 * fq); snv[(it + 1) & 1] = *(const f32x4*)(sinT + (size_t)row * 16 + 4 * fq); }
            const int row = EPI_ROW; const float s = sv[ai][m]; bf16* rp = O + (size_t)row * 512 + u.pn * BM;
            const f32x4 cs = csv[it & 1], sn = snv[it & 1];
#pragma unroll
            for (int bj = 0; bj < 2; ++bj) { const int grp = u.pn * 8 + bj * 4 + wc;
                f32x4 t1 = acc[ai][bj][m][0] * s, t2 = acc[ai][bj][m][1] * s;
                if (grp % 3 == 2) { const f32x4 a = t1 * cs - t2 * sn, b = t2 * cs + t1 * sn; t1 = a; t2 = b; }
                *(u32x2*)(rp + bj * HALF + wc * 32 + 4 * fq) = pack4(t1); *(u32x2*)(rp + bj * HALF + wc * 32 + 16 + 4 * fq) = pack4(t2); } }
    }
};
struct EpiGate {
    static constexpr bool PERM = false;
    bf16* G; const float* bias;
    __device__ __forceinline__ void operator()(const acc_t& acc, const Unit& u, int wr, int wc, int fr, int fq) const {
        f32x4 bv[2][2];
#pragma unroll
        EPI_LOOP_COLS bv[bj][n] = *(const f32x4*)(bias + u.pn * BM + EPI_COLT);
#pragma unroll
        EPI_LOOP_ROWS { bf16* rp = G + (size_t)EPI_ROW * D + u.pn * BM;
#pragma unroll
            EPI_LOOP_COLS { f32x4 v = acc[ai][bj][m][n] + bv[bj][n];
                v[0] = sigmoidf_(v[0]); v[1] = sigmoidf_(v[1]); v[2] = sigmoidf_(v[2]); v[3] = sigmoidf_(v[3]);
                *(u32x2*)(rp + EPI_COLT) = pack4(v); } }
    }
};
#define EPI_IT_ROW(it_) (u.pm * BM + ((it_) >> 2) * HALF + wr * 64 + ((it_) & 3) * 16 + fr)
#define EPI_C4(c_) (((c_) >> 1) * HALF + wc * 32 + ((c_) & 1) * 16 + 4 * fq)
struct EpiMerge {
    static constexpr bool PERM = false;
    const bf16* G; bf16* M; int first;
    __device__ __forceinline__ void operator()(const acc_t& acc, const Unit& u, int wr, int wc, int fr, int fq) const {
        u32x2 gv[2][4], mv[2][4];
#define EPI_LD(it_) do { const size_t ro_ = (size_t)EPI_IT_ROW(it_) * D + u.pn * BM; _Pragma("unroll") for (int c = 0; c < 4; ++c) { gv[(it_) & 1][c] = *(const u32x2*)(G + ro_ + EPI_C4(c)); \
            mv[(it_) & 1][c] = first ? (u32x2){0u, 0u} : *(const u32x2*)(M + ro_ + EPI_C4(c)); } } while (0)
        EPI_LD(0);
#pragma unroll
        for (int it = 0; it < 8; ++it) { if (it + 1 < 8) EPI_LD(it + 1);
            const size_t ro = (size_t)EPI_IT_ROW(it) * D + u.pn * BM;
#pragma unroll
            for (int c = 0; c < 4; ++c) { const f32x4 v = unpack4(gv[it & 1][c]) * acc[it >> 2][c >> 1][it & 3][c & 1] + unpack4(mv[it & 1][c]); *(u32x2*)(M + ro + EPI_C4(c)) = pack4(v); } }
#undef EPI_LD
    }
};
struct EpiRes {
    static constexpr bool PERM = true;
    XSrc xin; bf16* xout;
    float* ssq;
    __device__ __forceinline__ void operator()(const acc_t& acc, const Unit& u, int wr, int wc, int fr, int fq) const {
        f32x4 xv[2][2][2];
#define EPI_LD(it_) do { const size_t ro_ = (size_t)EPI_IT_ROW(it_) * D + u.pn * BM; _Pragma("unroll") for (int bj = 0; bj < 2; ++bj) { \
            if (xin.f) { xv[(it_) & 1][bj][0] = *(const f32x4*)(xin.f + ro_ + EPI_C8(bj)); xv[(it_) & 1][bj][1] = *(const f32x4*)(xin.f + ro_ + EPI_C8(bj) + 4); } \
            else { const u32x4 w_ = *(const u32x4*)(xin.b + ro_ + EPI_C8(bj)); xv[(it_) & 1][bj][0] = (f32x4){bflo(w_.x), bfhi(w_.x), bflo(w_.y), bfhi(w_.y)}; xv[(it_) & 1][bj][1] = (f32x4){bflo(w_.z), bfhi(w_.z), bflo(w_.w), bfhi(w_.w)}; } } } while (0)
        EPI_LD(0);
#pragma unroll
        for (int it = 0; it < 8; ++it) { if (it + 1 < 8) EPI_LD(it + 1);
            const size_t ro = (size_t)EPI_IT_ROW(it) * D + u.pn * BM;
            float sq = 0.f;
#pragma unroll
            for (int bj = 0; bj < 2; ++bj) { const f32x4 v0 = xv[it & 1][bj][0] + acc[it >> 2][bj][it & 3][0], v1 = xv[it & 1][bj][1] + acc[it >> 2][bj][it & 3][1];
                sq += (v0[0] * v0[0] + v0[1] * v0[1]) + (v0[2] * v0[2] + v0[3] * v0[3]) + (v1[0] * v1[0] + v1[1] * v1[1]) + (v1[2] * v1[2] + v1[3] * v1[3]);
                *(u32x4*)(xout + ro + EPI_C8(bj)) = pack8(v0, v1); }
            if (ssq) {
                sq += shflx(sq, 16, fr + 16 * fq);
                { auto rr = __builtin_amdgcn_permlane32_swap(__float_as_uint(sq), __float_as_uint(sq), false, false); sq = __uint_as_float(rr[0]) + __uint_as_float(rr[1]); }
                if (fq == 0) ssq[(size_t)EPI_IT_ROW(it) * 16 + u.pn * 4 + wc] = sq; } }
#undef EPI_LD
    }
};
struct EpiPle {
    static constexpr bool PERM = false;
    const bf16* U; float* x;
    __device__ __forceinline__ void operator()(const acc_t& acc, const Unit& u, int wr, int wc, int fr, int fq) const {
        f32x4 xv[2][4]; u32x2 uv[2][4];
#define EPI_LD(it_) do { const size_t ro_ = (size_t)EPI_IT_ROW(it_) * D + u.pn * BM; _Pragma("unroll") for (int c = 0; c < 4; ++c) { xv[(it_) & 1][c] = *(const f32x4*)(x + ro_ + EPI_C4(c)); uv[(it_) & 1][c] = *(const u32x2*)(U + ro_ + EPI_C4(c)); } } while (0)
        EPI_LD(0);
#pragma unroll
        for (int it = 0; it < 8; ++it) { if (it + 1 < 8) EPI_LD(it + 1);
            const size_t ro = (size_t)EPI_IT_ROW(it) * D + u.pn * BM;
#pragma unroll
            for (int c = 0; c < 4; ++c) { f32x4 v = acc[it >> 2][c >> 1][it & 3][c & 1];
                v[0] = sigmoidf_(v[0]); v[1] = sigmoidf_(v[1]); v[2] = sigmoidf_(v[2]); v[3] = sigmoidf_(v[3]);
                *(f32x4*)(x + ro + EPI_C4(c)) = xv[it & 1][c] + unpack4(uv[it & 1][c]) * v; } }
#undef EPI_LD
    }
};
struct EpiSwiglu {
    static constexpr bool PERM = true;
    bf16* O; int ldc; int npt;
    const LAS float* rl;
    mutable int ord;
    __device__ __forceinline__ void operator()(const acc_t& acc, const Unit& u, int wr, int wc, int fr, int fq) const {
        const int ct = (u.pn % npt) * HALF;
#pragma unroll
        EPI_LOOP_ROWS { bf16* rp = O + (size_t)EPI_ROW * ldc + ct + wc * 32 + 8 * fq; u32x2 w[2];
            const float r = rl ? rl[ord * 256 + ai * HALF + wr * 64 + m * 16 + fr] : 1.0f;
#pragma unroll
            for (int n = 0; n < 2; ++n) { const f32x4 a = acc[ai][0][m][n] * r, b = acc[ai][1][m][n] * r; f32x4 v;
#pragma unroll
                for (int e = 0; e < 4; ++e) v[e] = a[e] * sigmoidf_(a[e]) * b[e];
                w[n] = pack4(v); }
            *(u32x4*)rp = (u32x4){w[0].x, w[0].y, w[1].x, w[1].y}; }
        ++ord;
    }
};
struct EpiGlu {
    static constexpr bool PERM = true;
    bf16* Y; int ldc;
    __device__ __forceinline__ void operator()(const acc_t& acc, const Unit& u, int wr, int wc, int fr, int fq) const {
        u32x4 yv[2][2];
#define EPI_LD(it_) do { const bf16* rp_ = Y + (size_t)EPI_IT_ROW(it_) * ldc + u.pn * BM; _Pragma("unroll") for (int bj = 0; bj < 2; ++bj) yv[(it_) & 1][bj] = *(const u32x4*)(rp_ + EPI_C8(bj)); } while (0)
        EPI_LD(0);
#pragma unroll
        for (int it = 0; it < 8; ++it) { if (it + 1 < 8) EPI_LD(it + 1);
            bf16* rp = Y + (size_t)EPI_IT_ROW(it) * ldc + u.pn * BM;
#pragma unroll
            for (int bj = 0; bj < 2; ++bj) { const u32x4 w = yv[it & 1][bj]; f32x4 a = acc[it >> 2][bj][it & 3][0], b = acc[it >> 2][bj][it & 3][1];
                a[0] = bflo(w.x) * sigmoidf_(a[0]); a[1] = bfhi(w.x) * sigmoidf_(a[1]); a[2] = bflo(w.y) * sigmoidf_(a[2]); a[3] = bfhi(w.y) * sigmoidf_(a[3]);
                b[0] = bflo(w.z) * sigmoidf_(b[0]); b[1] = bfhi(w.z) * sigmoidf_(b[1]); b[2] = bflo(w.w) * sigmoidf_(b[2]); b[3] = bfhi(w.w) * sigmoidf_(b[3]);
                *(u32x4*)(rp + EPI_C8(bj)) = pack8(a, b); } }
#undef EPI_LD
    }
};
struct EpiMoeDown {
    static constexpr bool PERM = true;
    bf16* Y; const float* slot_gate;
    __device__ __forceinline__ void operator()(const acc_t& acc, const Unit& u, int wr, int wc, int fr, int fq) const {
        const int ct = (u.pn & 3) * BM;
        float gv[2][4];
#pragma unroll
        EPI_LOOP_ROWS gv[ai][m] = slot_gate[EPI_ROW];
#pragma unroll
        EPI_LOOP_ROWS { const int row = EPI_ROW; const float gt = gv[ai][m]; bf16* rp = Y + (size_t)row * D + ct;
#pragma unroll
            for (int bj = 0; bj < 2; ++bj) *(u32x4*)(rp + EPI_C8(bj)) = pack8(acc[ai][bj][m][0] * gt, acc[ai][bj][m][1] * gt); }
    }
};
}
namespace att {
constexpr int MODE_FOX = 0, MODE_MLA = 1, MODE_BAND = 2;
constexpr float LOG2E = 1.4426950408889634f;
struct Tensors {
    const bf16* Q; int ldq;
    const bf16* K; int ldk;
    const bf16* K2;
    const bf16* V; int ldv;
    bf16* O; int ldo;
    const float* cdec;
    const float* relb;
    int qhs, khs, vhs, ohs;
    const unsigned* qmax; const unsigned* kmax;
};
template <int DQK> struct Lay { static constexpr int KS = DQK * 2 + 16, KB = 64 * KS, VB = 64 * 128, CB = 256, BUF = KB + VB + CB; };
constexpr int ATT_LDS_TAB = 2 * Lay<96>::BUF;
constexpr int ATT_LDS_BYTES = ATT_LDS_TAB + 832 * 4;
__device__ __forceinline__ int crow(int r, int hi) { return (r & 3) + 8 * (r >> 2) + 4 * hi; }
typedef short v4i16_t __attribute__((ext_vector_type(4)));
__device__ __forceinline__ s16x4 vtr(const LAS unsigned char* p) { return __builtin_bit_cast(s16x4, __builtin_amdgcn_ds_read_tr16_b64_v4i16((LAS v4i16_t*)p)); }

template <int MODE>
__device__ __forceinline__ void attn_unit(const Tensors& T, int b, int h, int qb, LAS unsigned char* lds) {
    constexpr int DQK = (MODE == MODE_MLA) ? 96 : 64, NKS = DQK / 16;
    typedef Lay<DQK> LY;
    int tid = my_tid(); asm volatile("" : "+v"(tid));
    const int lane = tid & 63, r32 = lane & 31, hi = lane >> 5; const int wid = __builtin_amdgcn_readfirstlane(tid >> 6);
    const int rowb = b * SEQ, q0 = qb * 256;
    const float sc2 = ((MODE == MODE_MLA) ? 0.10206207261596575f : 0.125f) * LOG2E;
    const int cw = 4 * qb + (wid >> 1);
    const int t_lo = (MODE == MODE_BAND) ? ((4 * qb - 8) > 0 ? (4 * qb - 8) : 0) : 0, t_hi = 4 * qb + 4;
    const int qrow = rowb + q0 + wid * 32 + r32;
    bf16x8 qf[NKS];
    { const bf16* qp = T.Q + (size_t)qrow * T.ldq + h * T.qhs + hi * 8;
#pragma unroll
      for (int ks = 0; ks < NKS; ++ks) qf[ks] = *(const bf16x8*)(qp + ks * 16); }
    float cq = 0.f; if (MODE == MODE_FOX) cq = T.cdec[(size_t)qrow * 4 + h];
    LAS float* tab = (LAS float*)(lds + ATT_LDS_TAB);
    if (MODE == MODE_BAND) { for (int i = tid; i < 832; i += NTHREADS) tab[i] = T.relb[h * 513 + (i < 512 ? i : 512)] * LOG2E; }
    u32x4 kreg0[2] = {}, kreg1[2] = {}, vreg[2] = {}; float creg[2] = {0.f, 0.f};
    const int srow = tid >> 3, sch = tid & 7;
#define ATT_KADDR(c_) (((c_) % 12 < 8) ? (const u32x4*)(T.K + (kr_ + (c_) / 12) * T.ldk + h * T.khs + ((c_) % 12) * 8) : (const u32x4*)(T.K2 + (kr_ + (c_) / 12) * 32 + ((c_) % 12 - 8) * 8))
#define ATT_LOAD_TILE(t_, r_) do { const size_t kr_ = (size_t)(rowb + (t_) * 64); \
        if (MODE == MODE_MLA) { kreg0[r_] = *ATT_KADDR(tid); if (tid < 256) kreg1[r_] = *ATT_KADDR(tid + 512); } \
        else { kreg0[r_] = *(const u32x4*)(T.K + (kr_ + srow) * T.ldk + h * T.khs + sch * 8); } \
        vreg[r_] = *(const u32x4*)(T.V + (kr_ + srow) * T.ldv + h * T.vhs + sch * 8); \
        if (MODE == MODE_FOX) { if (tid < 64) creg[r_] = T.cdec[(kr_ + tid) * 4 + h]; } } while (0)
#define ATT_STORE_TILE(buf_, r_) do { LAS unsigned char* base_ = lds + (buf_) * LY::BUF; \
        if (MODE == MODE_MLA) { *(LAS u32x4*)(base_ + (tid / 12) * LY::KS + (tid % 12) * 16) = kreg0[r_]; \
            if (tid < 256) *(LAS u32x4*)(base_ + ((tid + 512) / 12) * LY::KS + ((tid + 512) % 12) * 16) = kreg1[r_]; } \
        else { *(LAS u32x4*)(base_ + srow * LY::KS + sch * 16) = kreg0[r_]; } \
        *(LAS u32x4*)(base_ + LY::KB + srow * 128 + ((sch * 16) ^ (((srow >> 1) & 1) << 6))) = vreg[r_]; \
        if (MODE == MODE_FOX) { if (tid < 64) *(LAS float*)(base_ + LY::KB + LY::VB + tid * 4) = creg[r_]; } } while (0)
    float mrun = -INFINITY, lrun = 0.f;
    f32x16 o0 = {}, o1 = {};
    const int G = lane >> 4, qi = (lane & 15) >> 2, pi = lane & 3;
    const int vb0 = (4 * hi + qi) * 128 + 64 * (0 ^ (qi >> 1)) + 32 * (G & 1) + 8 * pi;
    const int vb1 = (4 * hi + qi) * 128 + 64 * (1 ^ (qi >> 1)) + 32 * (G & 1) + 8 * pi;
    int t_min = t_lo;
    if (MODE == MODE_FOX) {
        LAS int* tm = (LAS int*)(lds + ATT_LDS_TAB);
        if (tid == 0) tm[0] = t_hi - 1;
        __syncthreads();
        if (tid < t_hi) {
            const float q2 = __uint_as_float(T.qmax[(b * 4 + h) * 32 + qb]), k2 = __uint_as_float(T.kmax[b * 4 + h]);
            const float thr = 0.125f * sqrtf(q2) * 2.0f * sqrtf(k2) * 1.02f + 112.0f;
            const float cfirst = T.cdec[(size_t)(rowb + q0) * 4 + h], clast = T.cdec[(size_t)(rowb + tid * 64 + 63) * 4 + h];
            if (!(clast - cfirst > thr)) __hip_atomic_fetch_min(tm, tid, __ATOMIC_RELAXED, __HIP_MEMORY_SCOPE_WORKGROUP);
        }
        __syncthreads();
        t_min = tm[0];
    }
    const int n_t = t_hi - t_min;
#define ATT_TILE(i_) ((MODE == MODE_FOX) ? (t_hi - 1 - (i_)) : (t_min + (i_)))
    ATT_LOAD_TILE(ATT_TILE(0), 0); ATT_STORE_TILE(0, 0);
    if (n_t > 1) ATT_LOAD_TILE(ATT_TILE(1), 1);
    if (n_t > 2) ATT_LOAD_TILE(ATT_TILE(2), 0);
    __syncthreads();
    for (int it0 = 0; it0 < n_t; it0 += 2) {
#pragma unroll
      for (int half = 0; half < 2; ++half) { const int it = it0 + half; if (it < n_t) {
        const int t = ATT_TILE(it);
        const int buf = half;
        const bool active = (MODE == MODE_BAND) ? (t <= cw && t >= cw - 8) : (t <= cw);
        if (active) {
            const LAS unsigned char* kb = lds + buf * LY::BUF;
            const LAS unsigned char* vbuf = kb + LY::KB;
            f32x16 p0 = {}, p1 = {};
            bf16x8 ka[NKS], kc[NKS];
#pragma unroll
            for (int ks = 0; ks < NKS; ++ks) { ka[ks] = *(const LAS bf16x8*)(kb + r32 * LY::KS + (ks * 16 + hi * 8) * 2); kc[ks] = *(const LAS bf16x8*)(kb + (32 + r32) * LY::KS + (ks * 16 + hi * 8) * 2); }
            __builtin_amdgcn_sched_barrier(0);
#pragma unroll
            for (int ks = 0; ks < NKS; ++ks) { p0 = __builtin_amdgcn_mfma_f32_32x32x16_bf16(ka[ks], qf[ks], p0, 0, 0, 0); p1 = __builtin_amdgcn_mfma_f32_32x32x16_bf16(kc[ks], qf[ks], p1, 0, 0, 0); }
            s16x4 vl0[4], vh0[4], vl1[4], vh1[4];
#pragma unroll
            for (int s4 = 0; s4 < 4; ++s4) { vl0[s4] = vtr(vbuf + vb0 + s4 * 2048); vh0[s4] = vtr(vbuf + vb0 + s4 * 2048 + 1024); vl1[s4] = vtr(vbuf + vb1 + s4 * 2048); vh1[s4] = vtr(vbuf + vb1 + s4 * 2048 + 1024); }
            __builtin_amdgcn_sched_barrier(0);
            if (MODE == MODE_FOX) {
                const LAS float* cb = (const LAS float*)(vbuf + LY::VB);
                const float cq2 = cq * LOG2E;
#pragma unroll
                for (int a = 0; a < 4; ++a) {
                    const f32x4 c0 = *(const LAS f32x4*)(cb + 8 * a + 4 * hi), c1 = *(const LAS f32x4*)(cb + 32 + 8 * a + 4 * hi);
#pragma unroll
                    for (int e = 0; e < 4; ++e) { p0[4 * a + e] = p0[4 * a + e] * sc2 + (cq2 - c0[e] * LOG2E); p1[4 * a + e] = p1[4 * a + e] * sc2 + (cq2 - c1[e] * LOG2E); }
                }
                if (t == cw) { const int ql = 32 * (wid & 1) + r32;
#pragma unroll
                    for (int r = 0; r < 16; ++r) { const int kv = crow(r, hi); if (kv > ql) p0[r] = -INFINITY; if (kv + 32 > ql) p1[r] = -INFINITY; } }
            } else if (MODE == MODE_BAND) {
                const LAS float* bp = tab + ((q0 + wid * 32 + r32) - t * 64) + 256 - 4 * hi - 95;
#pragma unroll
                for (int r = 0; r < 16; ++r) { const int kvb = (r & 3) + 8 * (r >> 2);
                    p0[r] = p0[r] * sc2 + bp[95 - kvb]; p1[r] = p1[r] * sc2 + bp[63 - kvb]; }
            }
            float mx = fmaxf(p0[0], p1[0]);
#pragma unroll
            for (int r = 1; r < 16; ++r) mx = fmaxf(mx, fmaxf(p0[r], p1[r]));
            { auto rr = __builtin_amdgcn_permlane32_swap(__float_as_uint(mx), __float_as_uint(mx), false, false); mx = fmaxf(__uint_as_float(rr[0]), __uint_as_float(rr[1])); }
            if (MODE == MODE_MLA) mx *= sc2;
            const float mnew = fmaxf(mrun, mx);
            if (__any(mnew > mrun)) {
                const float alpha = __builtin_amdgcn_exp2f(mrun - mnew);
                lrun *= alpha;
#pragma unroll
                for (int r = 0; r < 16; ++r) { o0[r] *= alpha; o1[r] *= alpha; }
                mrun = mnew;
            }
            float rs = 0.f;
#pragma unroll
            for (int r = 0; r < 16; ++r) {
                if (MODE == MODE_MLA) { p0[r] = __builtin_amdgcn_exp2f(__builtin_fmaf(p0[r], sc2, -mrun)); p1[r] = __builtin_amdgcn_exp2f(__builtin_fmaf(p1[r], sc2, -mrun)); }
                else { p0[r] = __builtin_amdgcn_exp2f(p0[r] - mrun); p1[r] = __builtin_amdgcn_exp2f(p1[r] - mrun); }
                rs += p0[r] + p1[r]; }
            lrun += rs;
#pragma unroll
            for (int s4 = 0; s4 < 4; ++s4) {
                u32x4 pw;
                if (s4 < 2) { const int o = 8 * (s4 & 1); pw.x = pk2(p0[o], p0[o + 1]); pw.y = pk2(p0[o + 2], p0[o + 3]); pw.z = pk2(p0[o + 4], p0[o + 5]); pw.w = pk2(p0[o + 6], p0[o + 7]); }
                else        { const int o = 8 * (s4 & 1); pw.x = pk2(p1[o], p1[o + 1]); pw.y = pk2(p1[o + 2], p1[o + 3]); pw.z = pk2(p1[o + 4], p1[o + 5]); pw.w = pk2(p1[o + 6], p1[o + 7]); }
                const bf16x8 pf = __builtin_bit_cast(bf16x8, pw);
                const s16x4 l0 = vl0[s4], h0 = vh0[s4], l1 = vl1[s4], h1 = vh1[s4];
                const bf16x8 vf0 = (bf16x8){l0[0], l0[1], l0[2], l0[3], h0[0], h0[1], h0[2], h0[3]};
                const bf16x8 vf1 = (bf16x8){l1[0], l1[1], l1[2], l1[3], h1[0], h1[1], h1[2], h1[3]};
                o0 = __builtin_amdgcn_mfma_f32_32x32x16_bf16(vf0, pf, o0, 0, 0, 0);
                o1 = __builtin_amdgcn_mfma_f32_32x32x16_bf16(vf1, pf, o1, 0, 0, 0);
            }
        }
        if (it + 1 < n_t) ATT_STORE_TILE(half ^ 1, half ^ 1);
        if (it + 3 < n_t) ATT_LOAD_TILE(ATT_TILE(it + 3), half ^ 1);
        __syncthreads();
      } }
    }
    { auto rr = __builtin_amdgcn_permlane32_swap(__float_as_uint(lrun), __float_as_uint(lrun), false, false); lrun = __uint_as_float(rr[0]) + __uint_as_float(rr[1]); }
    const float inv = 1.0f / lrun;
    bf16* op = T.O + (size_t)qrow * T.ldo + h * T.ohs;
#pragma unroll
    for (int a = 0; a < 4; ++a) {
        u32x2 w0, w1;
        w0.x = pk2(o0[4 * a] * inv, o0[4 * a + 1] * inv); w0.y = pk2(o0[4 * a + 2] * inv, o0[4 * a + 3] * inv);
        w1.x = pk2(o1[4 * a] * inv, o1[4 * a + 1] * inv); w1.y = pk2(o1[4 * a + 2] * inv, o1[4 * a + 3] * inv);
        *(u32x2*)(op + 8 * a + 4 * hi) = w0; *(u32x2*)(op + 32 + 8 * a + 4 * hi) = w1;
    }
}

template <int MODE>
__device__ __forceinline__ void attn_phase(const Tensors& T, LAS unsigned char* lds) {
    const int G = gridDim.x, bx = blockIdx.x, vcu = (G % 8 == 0) ? (bx % 8) * (G / 8) + bx / 8 : bx;
    for (int pr = vcu; pr < 256; pr += G) {
        const int bh = pr >> 4, s = pr & 15;
        attn_unit<MODE>(T, bh >> 2, bh & 3, s, lds);
        attn_unit<MODE>(T, bh >> 2, bh & 3, 31 - s, lds);
    }
}

template <int MODE>
__device__ __forceinline__ void attn_naive(const Tensors& T) {
    BODY_IDS();
    constexpr int DQK = (MODE == MODE_MLA) ? 96 : 64;
    const float sc = (MODE == MODE_MLA) ? 0.10206207261596575f : 0.125f;
    for (int idx = gtid; idx < NTOK * 4; idx += gthreads) {
        const int h = idx / NTOK, row = idx % NTOK, b = row / SEQ, tpos = row % SEQ, rowb = b * SEQ;
        float q[DQK], o[64];
#pragma unroll
        for (int d = 0; d < DQK; ++d) q[d] = bf2f(T.Q[(size_t)row * T.ldq + h * T.qhs + d]) * sc;
#pragma unroll
        for (int d = 0; d < 64; ++d) o[d] = 0.f;
        float m = -INFINITY, l = 0.f;
        const int ck = tpos / 64;
        const int k_lo = (MODE == MODE_BAND) ? ((ck - 8) > 0 ? (ck - 8) * 64 : 0) : 0;
        const int k_hi = (MODE == MODE_FOX) ? tpos : (ck * 64 + 63);
        const float cq = (MODE == MODE_FOX) ? T.cdec[(size_t)row * 4 + h] : 0.f;
        for (int kv = k_lo; kv <= k_hi; ++kv) {
            const size_t kr = (size_t)(rowb + kv);
            float s = 0.f;
#pragma unroll
            for (int d8 = 0; d8 < 8; ++d8) { const u32x4 w = *(const u32x4*)(T.K + kr * T.ldk + h * T.khs + d8 * 8);
                s += q[d8 * 8 + 0] * bflo(w.x) + q[d8 * 8 + 1] * bfhi(w.x) + q[d8 * 8 + 2] * bflo(w.y) + q[d8 * 8 + 3] * bfhi(w.y)
                   + q[d8 * 8 + 4] * bflo(w.z) + q[d8 * 8 + 5] * bfhi(w.z) + q[d8 * 8 + 6] * bflo(w.w) + q[d8 * 8 + 7] * bfhi(w.w); }
            if (MODE == MODE_MLA) {
#pragma unroll
                for (int d8 = 0; d8 < 4; ++d8) { const u32x4 w = *(const u32x4*)(T.K2 + kr * 32 + d8 * 8);
                    s += q[64 + d8 * 8 + 0] * bflo(w.x) + q[64 + d8 * 8 + 1] * bfhi(w.x) + q[64 + d8 * 8 + 2] * bflo(w.y) + q[64 + d8 * 8 + 3] * bfhi(w.y)
                       + q[64 + d8 * 8 + 4] * bflo(w.z) + q[64 + d8 * 8 + 5] * bfhi(w.z) + q[64 + d8 * 8 + 6] * bflo(w.w) + q[64 + d8 * 8 + 7] * bfhi(w.w); }
            }
            if (MODE == MODE_FOX) s += cq - T.cdec[kr * 4 + h];
            if (MODE == MODE_BAND) { int rel = tpos - kv; rel = rel < -256 ? -256 : (rel > 256 ? 256 : rel); s += T.relb[h * 513 + rel + 256]; }
            const float mn = fmaxf(m, s), al = __expf(m - mn), pp = __expf(s - mn);
            l = l * al + pp; m = mn;
#pragma unroll
            for (int d8 = 0; d8 < 8; ++d8) { const u32x4 w = *(const u32x4*)(T.V + kr * T.ldv + h * T.vhs + d8 * 8);
                o[d8 * 8 + 0] = o[d8 * 8 + 0] * al + pp * bflo(w.x); o[d8 * 8 + 1] = o[d8 * 8 + 1] * al + pp * bfhi(w.x);
                o[d8 * 8 + 2] = o[d8 * 8 + 2] * al + pp * bflo(w.y); o[d8 * 8 + 3] = o[d8 * 8 + 3] * al + pp * bfhi(w.y);
                o[d8 * 8 + 4] = o[d8 * 8 + 4] * al + pp * bflo(w.z); o[d8 * 8 + 5] = o[d8 * 8 + 5] * al + pp * bfhi(w.z);
                o[d8 * 8 + 6] = o[d8 * 8 + 6] * al + pp * bflo(w.w); o[d8 * 8 + 7] = o[d8 * 8 + 7] * al + pp * bfhi(w.w); }
        }
        const float inv = 1.0f / l;
#pragma unroll
        for (int d = 0; d < 64; d += 2) *(unsigned*)(T.O + (size_t)row * T.ldo + h * T.ohs + d) = pk2(o[d] * inv, o[d + 1] * inv);
    }
}
}
struct Params {
    const float* in[37];
    float* out;
    unsigned char* ws;
    int ph_lo, ph_hi;
};
enum { I_X = 0, I_P, I_POS, I_WIN, I_SAR, I_SAI, I_SLDT, I_SBR, I_SBI, I_SCR, I_SCI, I_SD, I_SGLU, I_FBF, I_GQ, I_WUQ, I_GKV, I_WUKV, I_RELB, I_WB, I_WG, I_BG, I_WO,
       I_GMIX, I_GFFN, I_FW1, I_FW3, I_FW2, I_MWR, I_MBR, I_MW1, I_MW3, I_MW2, I_GPLE, I_PWG, I_PWU, I_GFIN };

__device__ __forceinline__ void sincos_rad(double a, float& s, float& c) {
    double r = a * 0.15915494309189535; r = r - __builtin_rint(r); const float f = (float)r;
    s = __builtin_amdgcn_sinf(f); c = __builtin_amdgcn_cosf(f);
}
__device__ __forceinline__ float gelu_tanh(float x) {
    const float z = 0.7978845608028654f * (x + 0.044715f * x * x * x);
    return x * __builtin_amdgcn_rcpf(1.0f + __expf(-2.0f * z));
}
__device__ __forceinline__ float log_sigmoid(float z) { return fminf(z, 0.f) - log1pf(__expf(-fabsf(z))); }

struct CvtJob { const float* src; const float* ks; bf16* dst; int K, ldsrc, col0, ncols, row0, ldk, ilv; };
struct CvtRegs { f32x4 v[16]; };
__device__ __forceinline__ void cvt_load(const CvtJob& J, int item, int lane, CvtRegs& R) {
    const int nblk = (J.ncols + 63) >> 6, kb = item / nblk, nb = item % nblk, k0 = 64 * kb, n0 = 64 * nb;
    const int n4 = (lane & 15) * 4; const bool inb = (n0 + n4) < J.ncols;
#pragma unroll
    for (int i = 0; i < 16; ++i) { const int kk = 4 * i + (lane >> 4); f32x4 v = {0.f, 0.f, 0.f, 0.f};
        if (inb) v = *(const f32x4*)(J.src + (size_t)(k0 + kk) * J.ldsrc + J.col0 + n0 + n4);
        if (J.ks) v = v * J.ks[k0 + kk];
        R.v[i] = v; }
}
__device__ __forceinline__ void cvt_finish(const CvtJob& J, LAS float* scr, int item, int lane, const CvtRegs& R) {
    const int nblk = (J.ncols + 63) >> 6, kb = item / nblk, nb = item % nblk, k0 = 64 * kb, n0 = 64 * nb;
    const int n4 = (lane & 15) * 4;
#pragma unroll
    for (int i = 0; i < 16; ++i) { const int kk = 4 * i + (lane >> 4); *(LAS f32x4*)(scr + kk * 68 + n4) = R.v[i]; }
    LDS_WAIT(); asm volatile("" ::: "memory");
    const int c = lane & 7;
#pragma unroll
    for (int j = 0; j < 8; ++j) { const int n = (lane >> 3) + 8 * j; const LAS float* s = scr + (8 * c) * 68 + n;
        u32x4 o; o.x = pk2(s[0 * 68], s[1 * 68]); o.y = pk2(s[2 * 68], s[3 * 68]); o.z = pk2(s[4 * 68], s[5 * 68]); o.w = pk2(s[6 * 68], s[7 * 68]);
        const int nn = n0 + n; const int row = J.row0 + (J.ilv ? ((nn >> 7) * 256 + (nn & 127)) : nn);
        if (nn < J.ncols) *(u32x4*)(J.dst + (size_t)row * J.ldk + k0 + 8 * c) = o; }
    LDS_WAIT(); asm volatile("" ::: "memory");
}
__device__ __forceinline__ bf16* wmix(const Params& P, int L, size_t off) { return (bf16*)(P.ws + WS_WMIX + (size_t)L * WMIX_STRIDE + off); }
__device__ __forceinline__ CvtJob get_job(const Params& P, int j) {
    CvtJob J; J.ks = nullptr; J.ilv = 0; J.col0 = 0; J.row0 = 0;
    if (j < 40) {
        const int L = j / 20, q = j % 20;
        if (q < 5) {
            J.src = P.in[I_WIN] + (size_t)L * D * DIN; J.K = D; J.ldsrc = DIN; J.dst = wmix(P, L, WM_IN); J.ldk = D;
            J.col0 = q == 0 ? 0 : q == 1 ? 1380 : q == 2 ? 1028 : q == 3 ? 1220 : 1348;
            J.ncols = q == 0 ? 1024 : q == 1 ? 768 : q == 2 ? 192 : q == 3 ? 128 : 32;
            J.row0 = q == 0 ? 0 : q == 1 ? 1024 : q == 2 ? 1792 : q == 3 ? 2048 : 2176;
        } else if (q < 9) { const int k = q - 5; J.src = P.in[I_WG] + ((size_t)L * 4 + k) * D * D; J.K = D; J.ldsrc = D; J.ncols = D; J.row0 = k * D; J.dst = wmix(P, L, WM_G); J.ldk = D;
        } else if (q < 13) { const int k = q - 9; J.src = P.in[I_WB] + ((size_t)L * 4 + k) * 256 * D; J.K = 256; J.ldsrc = D; J.ncols = D; J.row0 = k * D; J.dst = wmix(P, L, WM_B); J.ldk = 256;
        } else if (q == 13) { J.src = P.in[I_WO] + (size_t)L * D * D; J.K = D; J.ldsrc = D; J.ncols = D; J.dst = wmix(P, L, WM_O); J.ldk = D;
        } else if (q == 14) { J.src = P.in[I_PWG] + (size_t)L * D * D;
#ifndef BIS_A
            if (L == 0) J.ks = P.in[I_GPLE];
#endif
            J.K = D; J.ldsrc = D; J.ncols = D; J.dst = wmix(P, L, WM_PG); J.ldk = D;
        } else if (q == 15) { J.src = P.in[I_PWU] + (size_t)L * 256 * D; J.K = 256; J.ldsrc = D; J.ncols = D; J.dst = wmix(P, L, WM_UP); J.ldk = 256;
        } else if (q == 16) { J.src = P.in[I_WUQ] + (size_t)L * 192 * 384; J.ks = P.in[I_GQ] + L * 192; J.K = 192; J.ldsrc = 384; J.ncols = 384; J.dst = wmix(P, L, WM_UQ); J.ldk = 256;
        } else if (q == 17) { J.src = P.in[I_WUKV] + (size_t)L * 128 * 512; J.ks = P.in[I_GKV] + L * 128; J.K = 128; J.ldsrc = 512; J.ncols = 512; J.dst = wmix(P, L, WM_UKV); J.ldk = 128;
        } else if (q == 18) { J.src = P.in[I_SGLU] + (size_t)L * 256 * 256; J.K = 256; J.ldsrc = 256; J.ncols = 256; J.dst = wmix(P, L, WM_GLU); J.ldk = 256;
        } else { J.src = nullptr; J.K = 0; J.ldsrc = 0; J.ncols = 32; J.dst = nullptr; J.ldk = 0; }
    } else if (j < 43) {
        const int q = j - 40;
        if (q == 0) { J.src = P.in[I_FW1]; J.ks = P.in[I_GFFN]; J.K = D; J.ldsrc = DFF; J.ncols = DFF; J.dst = (bf16*)(P.ws + WS_W13); J.ldk = D; J.ilv = 1; }
        else if (q == 1) { J.src = P.in[I_FW3]; J.ks = P.in[I_GFFN]; J.K = D; J.ldsrc = DFF; J.ncols = DFF; J.row0 = 128; J.dst = (bf16*)(P.ws + WS_W13); J.ldk = D; J.ilv = 1; }
        else { J.src = P.in[I_FW2]; J.K = DFF; J.ldsrc = D; J.ncols = D; J.dst = (bf16*)(P.ws + WS_W2); J.ldk = DFF; }
    } else {
        const int e = (j - 43) / 3, q = (j - 43) % 3;
        if (q == 0) { J.src = P.in[I_MW1] + (size_t)e * D * DFFE; J.K = D; J.ldsrc = DFFE; J.ncols = DFFE; J.row0 = e * 2816; J.dst = (bf16*)(P.ws + WS_WM13); J.ldk = D; J.ilv = 1; }
        else if (q == 1) { J.src = P.in[I_MW3] + (size_t)e * D * DFFE; J.K = D; J.ldsrc = DFFE; J.ncols = DFFE; J.row0 = e * 2816 + 128; J.dst = (bf16*)(P.ws + WS_WM13); J.ldk = D; J.ilv = 1; }
        else { J.src = P.in[I_MW2] + (size_t)e * DFFE * D; J.K = DFFE; J.ldsrc = D; J.ncols = D; J.row0 = e * D; J.dst = (bf16*)(P.ws + WS_WM2); J.ldk = DFFE; }
    }
    return J;
}
__device__ __forceinline__ void cvt_jobs(const Params& P, int j_lo, int j_hi, LAS unsigned char* lds) {
    BODY_IDS();
    LAS float* scr = (LAS float*)(lds + wave * 17408);
    int acc = 0; bool have = false; CvtJob Jp; int itp = 0; CvtRegs Rp;
    for (int j = j_lo; j < j_hi; ++j) {
        const CvtJob J = get_job(P, j);
        const int items = (J.K / 64) * ((J.ncols + 63) >> 6);
        const int first = (gw - (acc % ngw) + ngw) % ngw;
        for (int it = first; it < items; it += ngw) {
            CvtRegs Rn; cvt_load(J, it, lane, Rn);
            if (have) cvt_finish(Jp, scr, itp, lane, Rp);
            Jp = J; itp = it; have = true;
#pragma unroll
            for (int i = 0; i < 16; ++i) Rp.v[i] = Rn.v[i];
        }
        acc += items;
    }
    if (have) cvt_finish(Jp, scr, itp, lane, Rp);
}

__device__ __forceinline__ void p0_misc(const Params& P) {
    BODY_IDS();
    { const f32x4* src = (const f32x4*)P.in[I_P]; u32x2* dst = (u32x2*)(P.ws + WS_PBF);
      for (int i = gtid; i < 2 * NTOK * 256 / 4; i += gthreads) { const f32x4 v = src[i]; u32x2 w; w.x = pk2(v[0], v[1]); w.y = pk2(v[2], v[3]); dst[i] = w; } }
    { const int* pos = (const int*)P.in[I_POS]; float* ct = (float*)(P.ws + WS_COS); float* st = (float*)(P.ws + WS_SIN);
      const double invf[16] = {1.0, 0.5623413251903491, 0.31622776601683794, 0.1778279410038923, 0.1, 0.05623413251903491, 0.03162277660168379, 0.01778279410038923,
                               0.01, 0.005623413251903491, 0.0031622776601683794, 0.0017782794100389228, 0.001, 0.0005623413251903491, 0.00031622776601683794, 0.00017782794100389227};
      for (int i = gtid; i < NTOK * 16; i += gthreads) { const int row = i >> 4, f = i & 15; double iv = invf[0];
#pragma unroll
          for (int q = 1; q < 16; ++q) iv = (f == q) ? invf[q] : iv;
          const float ang = (float)pos[row] * (float)iv; float s, c; sincos_rad((double)ang, s, c); ct[i] = c; st[i] = s; } }
    for (int L = 0; L < 2; ++L) {
        bf16* win = wmix(P, L, WM_IN);
        for (int i = gtid; i < (64 + 96) * D / 8; i += gthreads) { const int e = i * 8, r = e / D, k = e % D; const int row = r < 64 ? 1984 + r : 2208 + (r - 64); *(u32x4*)(win + (size_t)row * D + k) = (u32x4){0u, 0u, 0u, 0u}; }
        bf16* wuq = wmix(P, L, WM_UQ);
        for (int i = gtid; i < 512 * 256 / 8; i += gthreads) { const int e = i * 8, r = e / 256, k = e % 256; if (r >= 384 || k >= 192) *(u32x4*)(wuq + e) = (u32x4){0u, 0u, 0u, 0u}; }
    }
}

__device__ __forceinline__ void rms_load(const XSrc& x, int row, int lane, f32x4 (&v)[4]) {
#pragma unroll
    for (int j = 0; j < 4; ++j) v[j] = ldx4(x, (size_t)row * D + 4 * lane + 256 * j);
}
struct GainRegs { f32x4 g[4]; };
__device__ __forceinline__ GainRegs load_gain(const float* gain, int lane) { GainRegs G; const f32x4* gr = (const f32x4*)gain + lane;
#pragma unroll
    for (int j = 0; j < 4; ++j) G.g[j] = gr[64 * j];
    return G; }
__device__ __forceinline__ void rms_finish(const GainRegs& G, bf16* orow, int lane, f32x4 (&v)[4]) {
    float s = 0.f;
#pragma unroll
    for (int j = 0; j < 4; ++j) s += (v[j][0] * v[j][0] + v[j][1] * v[j][1]) + (v[j][2] * v[j][2] + v[j][3] * v[j][3]);
    const float rstd = __builtin_amdgcn_rsqf(wave_sum(s) * (1.0f / D) + RMS_EPS);
    u32x2* o8 = (u32x2*)orow + lane;
#pragma unroll
    for (int j = 0; j < 4; ++j) { v[j] = v[j] * rstd * G.g[j]; if (orow) { u32x2 w; w.x = pk2(v[j][0], v[j][1]); w.y = pk2(v[j][2], v[j][3]); o8[64 * j] = w; } }
}
#define RMS_ROWS_BEGIN(x_, rowexpr_) f32x4 v[4], vn_[4]; { const int i = 0; rms_load(x_, (rowexpr_), lane, v); } for (int i = 0; i < 16; ++i) { if (i + 1 < 16) { const int i_ = i; { const int i = i_ + 1; rms_load(x_, (rowexpr_), lane, vn_); } }
#define RMS_ROWS_END() _Pragma("unroll") for (int j_ = 0; j_ < 4; ++j_) v[j_] = vn_[j_]; }
__device__ __forceinline__ void norm_plain(const XSrc x, const float* gain, bf16* H, int first, int stride) {
    BODY_IDS();
    const GainRegs GR = load_gain(gain, lane);
    for (int u = first; u < NTOK / 128; u += stride)
    { RMS_ROWS_BEGIN(x, u * 128 + wave * 16 + i) const int row = u * 128 + wave * 16 + i; rms_finish(GR, H + (size_t)row * D, lane, v); RMS_ROWS_END() }
}
__device__ __forceinline__ void norm1_phase(const Params& P, int L, const XSrc x, int first, int stride) {
    BODY_IDS();
    const float* win = P.in[I_WIN] + (size_t)L * D * DIN;
    f32x4 wff[4][4];
#pragma unroll
    for (int j = 0; j < 4; ++j)
#pragma unroll
        for (int e = 0; e < 4; ++e) wff[j][e] = *(const f32x4*)(win + (size_t)(4 * lane + 256 * j + e) * DIN + 1024);
    const float* gain = P.in[I_GMIX] + L * D; bf16* H = (bf16*)(P.ws + WS_H); const GainRegs GR = load_gain(gain, lane);
    float* logf = (float*)(P.ws + WS_LOGF); float* wsum = (float*)(P.ws + WS_WSUM);
    const f32x4 bf = *(const f32x4*)(P.in[I_FBF] + L * 4);
    for (int u = first; u < NTOK / 128; u += stride) { const int g0 = u * 8 + wave;
        f32x4 run = {0.f, 0.f, 0.f, 0.f};
        RMS_ROWS_BEGIN(x, g0 * 16 + i) const int row = g0 * 16 + i; rms_finish(GR, H + (size_t)row * D, lane, v);
            f32x4 d = {0.f, 0.f, 0.f, 0.f};
#pragma unroll
            for (int j = 0; j < 4; ++j)
#pragma unroll
                for (int e = 0; e < 4; ++e) d += wff[j][e] * v[j][e];
#pragma unroll
            for (int e = 0; e < 4; ++e) { d[e] = wave_sum(d[e]); run[e] += log_sigmoid(d[e] + bf[e]); }
            if (lane == 0) *(f32x4*)(logf + (size_t)row * 4) = run; RMS_ROWS_END()
        if (lane == 0) *(f32x4*)(wsum + (size_t)g0 * 4) = run;
    }
    __syncthreads();
}
__device__ __forceinline__ void prep_phase(const Params& P, int L) {
    BODY_IDS();
    unsigned* qmaxw = (unsigned*)(P.ws + WS_CTL) + CW_QMAX + L * 512; unsigned* kmaxw = (unsigned*)(P.ws + WS_CTL) + CW_KMAX + L * 16;
    const float* logf = (const float*)(P.ws + WS_LOGF); const float* wsum = (const float*)(P.ws + WS_WSUM); float* cdec = (float*)(P.ws + WS_CDEC);
    float* rq = (float*)(P.ws + WS_RSTDQ); float* rkv = (float*)(P.ws + WS_RSTDKV); const bf16* zin = (const bf16*)(P.ws + WS_ZIN); bf16* kper = (bf16*)(P.ws + WS_KPER);
    const float* ct = (const float*)(P.ws + WS_COS); const float* st = (const float*)(P.ws + WS_SIN);
    for (int g0 = gw; g0 < NTOK / 16; g0 += ngw) {
        const int first = (g0 / 512) * 512;
        f32x4 pre = {0.f, 0.f, 0.f, 0.f};
        for (int i = first + lane; i < g0; i += 64) pre += *(const f32x4*)(wsum + (size_t)i * 4);
#pragma unroll
        for (int e = 0; e < 4; ++e) pre[e] = wave_sum(pre[e]);
        if (lane < 16) { const int row = g0 * 16 + lane; *(f32x4*)(cdec + (size_t)row * 4) = *(const f32x4*)(logf + (size_t)row * 4) + pre; }
        float qk2m = 0.f;
        const int colA = (lane < 32 ? ZC_FQ : ZC_FK) + 8 * (lane & 31), colB = ZC_CQ + 8 * (lane < 52 ? lane : 51);
        u32x4 wa = *(const u32x4*)(zin + (size_t)(g0 * 16) * ZP + colA), wb = *(const u32x4*)(zin + (size_t)(g0 * 16) * ZP + colB);
        for (int i = 0; i < 16; ++i) { const int row = g0 * 16 + i;
            const u32x4 ca = wa, cb = wb;
            if (i + 1 < 16) { wa = *(const u32x4*)(zin + (size_t)(row + 1) * ZP + colA); wb = *(const u32x4*)(zin + (size_t)(row + 1) * ZP + colB); }
            const f32x4 cs = *(const f32x4*)(ct + (size_t)row * 16 + 8 * (lane & 1)), cs2 = *(const f32x4*)(ct + (size_t)row * 16 + 8 * (lane & 1) + 4);
            const f32x4 sn = *(const f32x4*)(st + (size_t)row * 16 + 8 * (lane & 1)), sn2 = *(const f32x4*)(st + (size_t)row * 16 + 8 * (lane & 1) + 4);
            { float sa = (bflo(ca.x) * bflo(ca.x) + bfhi(ca.x) * bfhi(ca.x)) + (bflo(ca.y) * bflo(ca.y) + bfhi(ca.y) * bfhi(ca.y)) + (bflo(ca.z) * bflo(ca.z) + bfhi(ca.z) * bfhi(ca.z)) + (bflo(ca.w) * bflo(ca.w) + bfhi(ca.w) * bfhi(ca.w));
              sa += DPP_F(sa, 0xB1, 0xF); sa += DPP_F(sa, 0x4E, 0xF); sa += DPP_F(sa, 0x141, 0xF);
              qk2m = fmaxf(qk2m, sa); }
            const float own[8] = {bflo(cb.x), bfhi(cb.x), bflo(cb.y), bfhi(cb.y), bflo(cb.z), bfhi(cb.z), bflo(cb.w), bfhi(cb.w)};
            float ssb = 0.f;
#pragma unroll
            for (int e = 0; e < 8; ++e) ssb += own[e] * own[e];
            const float sq = wave_sum(lane < 24 ? ssb : 0.f), skv = wave_sum((lane >= 32 && lane < 48) ? ssb : 0.f);
            if (lane == 0) { rq[row] = __builtin_amdgcn_rsqf(sq * (1.0f / 192.0f) + RMS_EPS); rkv[row] = __builtin_amdgcn_rsqf(skv * (1.0f / 128.0f) + RMS_EPS); }
            float oth[8];
#pragma unroll
            for (int e = 0; e < 8; ++e) oth[e] = DPP_F(own[e], 0x4E, 0xF);
            if (lane >= 48 && lane < 52) { const bool lo = lane < 50; float o8[8];
#pragma unroll
                for (int e = 0; e < 8; ++e) { const float c = e < 4 ? cs[e] : cs2[e - 4], sv = e < 4 ? sn[e] : sn2[e - 4];
                    o8[e] = lo ? (own[e] * c - oth[e] * sv) : (own[e] * c + oth[e] * sv); }
                *(u32x4*)(kper + (size_t)row * 32 + (lo ? 0 : 16) + 8 * (lane & 1)) = (u32x4){pk2(o8[0], o8[1]), pk2(o8[2], o8[3]), pk2(o8[4], o8[5]), pk2(o8[6], o8[7])}; } }
        if ((lane & 7) == 0) { const int row0 = g0 * 16, b = row0 / SEQ, qb = (row0 % SEQ) / 256, h = (lane & 31) >> 3;
            if (lane < 32) atomicMax(qmaxw + (b * 4 + h) * 32 + qb, __float_as_uint(qk2m)); else atomicMax(kmaxw + b * 4 + h, __float_as_uint(qk2m)); }
    }
}
struct FinalRows { u32x2 w[16][4]; };
__device__ __forceinline__ void final_norm_load(const Params& P, int u, FinalRows& R) {
    BODY_IDS();
    const bf16* xb = xr_of(P.out);
#pragma unroll
    for (int i = 0; i < 16; ++i) { const u32x2* xr = (const u32x2*)(xb + (size_t)(u * 128 + wave * 16 + i) * D) + lane;
#pragma unroll
        for (int j = 0; j < 4; ++j) R.w[i][j] = xr[64 * j]; }
}
__device__ __forceinline__ void final_norm_store(const Params& P, int u, const FinalRows& R) {
    BODY_IDS();
    const GainRegs GR = load_gain(P.in[I_GFIN], lane);
#pragma unroll
    for (int i = 0; i < 16; ++i) { f32x4 v[4]; float s = 0.f;
#pragma unroll
        for (int j = 0; j < 4; ++j) { const u32x2 w = R.w[i][j]; v[j] = (f32x4){bflo(w.x), bfhi(w.x), bflo(w.y), bfhi(w.y)}; s += (v[j][0] * v[j][0] + v[j][1] * v[j][1]) + (v[j][2] * v[j][2] + v[j][3] * v[j][3]); }
        const float rstd = __builtin_amdgcn_rsqf(wave_sum(s) * (1.0f / D) + RMS_EPS);
        f32x4* xo = (f32x4*)(P.out + (size_t)(u * 128 + wave * 16 + i) * D) + lane;
#pragma unroll
        for (int j = 0; j < 4; ++j) xo[64 * j] = v[j] * rstd * GR.g[j]; }
}
namespace s5 {
struct Coef { float abr, abi; f32x2 B2[16]; float a64r, a64i; };
__device__ __forceinline__ void coef(const Params& P, int L, int g, int p, Coef& C) {
    const float dt = __expf(P.in[I_SLDT][L * 16 + g]); const float ar = P.in[I_SAR][(L * 16 + g) * 64 + p], ai = P.in[I_SAI][(L * 16 + g) * 64 + p];
    const float mag = __expf(ar * dt); float sn, cs; sincos_rad((double)(ai * dt), sn, cs);
    C.abr = mag * cs; C.abi = mag * sn;
    const float den = ar * ar + ai * ai, nr = C.abr - 1.0f, ni = C.abi;
    const float cr = (nr * ar + ni * ai) / den, ci = (ni * ar - nr * ai) / den;
    const float* br = P.in[I_SBR] + ((size_t)(L * 16 + g) * 64 + p) * 16; const float* bi = P.in[I_SBI] + ((size_t)(L * 16 + g) * 64 + p) * 16;
#pragma unroll
    for (int h = 0; h < 16; ++h) { const float r = br[h], i = bi[h]; C.B2[h] = (f32x2){cr * r - ci * i, cr * i + ci * r}; }
    const float m64 = __expf(64.0f * ar * dt); float s64, c64; sincos_rad(64.0 * (double)(ai * dt), s64, c64);
    C.a64r = m64 * c64; C.a64i = m64 * s64;
}
constexpr int WAVE_LDS = 8448;
template <bool EMIT>
__device__ __forceinline__ void chunk(const Params& P, int L, int g, int row0, const Coef& C, float& xr, float& xi, LAS unsigned char* wl, int lane, const bf16x8 (&cf)[4], float dsk) {
    bf16* zin = (bf16*)(P.ws + WS_ZIN);
    LAS float* ut = (LAS float*)wl; LAS unsigned* xt = (LAS unsigned*)(wl + 4096);
    { const u32x4* up = (const u32x4*)(zin + (size_t)(row0 + lane) * ZP + ZC_U + g * 16); const u32x4 w0 = up[0], w1 = up[1];
      LAS f32x4* d = (LAS f32x4*)(ut + lane * 16);
      d[0] = (f32x4){bflo(w0.x), bfhi(w0.x), bflo(w0.y), bfhi(w0.y)}; d[1] = (f32x4){bflo(w0.z), bfhi(w0.z), bflo(w0.w), bfhi(w0.w)};
      d[2] = (f32x4){bflo(w1.x), bfhi(w1.x), bflo(w1.y), bfhi(w1.y)}; d[3] = (f32x4){bflo(w1.z), bfhi(w1.z), bflo(w1.w), bfhi(w1.w)}; }
    for (int tb = 0; tb < 4; ++tb) {
#pragma unroll 4
        for (int ti = 0; ti < 16; ++ti) {
            const LAS f32x4* up = (const LAS f32x4*)(ut + (tb * 16 + ti) * 16);
            f32x2 b2a = {0.f, 0.f}, b2b = {0.f, 0.f};
#pragma unroll
            for (int q = 0; q < 4; ++q) { const f32x4 u4 = up[q];
                b2a += C.B2[4 * q + 0] * (f32x2){u4[0], u4[0]}; b2b += C.B2[4 * q + 1] * (f32x2){u4[1], u4[1]};
                b2a += C.B2[4 * q + 2] * (f32x2){u4[2], u4[2]}; b2b += C.B2[4 * q + 3] * (f32x2){u4[3], u4[3]}; }
            const float br = b2a[0] + b2b[0], bi = b2a[1] + b2b[1];
            const float nr = C.abr * xr - C.abi * xi + br, ni = C.abr * xi + C.abi * xr + bi; xr = nr; xi = ni;
            if (EMIT) xt[ti * 68 + lane] = pk2(xr, xi);
        }
        if (EMIT) {
            f32x4 dacc = {0.f, 0.f, 0.f, 0.f};
#pragma unroll
            for (int ks = 0; ks < 4; ++ks) { const bf16x8 a = *(const LAS bf16x8*)((const LAS unsigned char*)xt + (lane & 15) * 272 + (ks * 32 + (lane >> 4) * 8) * 2);
                dacc = __builtin_amdgcn_mfma_f32_16x16x32_bf16(a, cf[ks], dacc, 0, 0, 0); }
            const int hp = lane & 15;
#pragma unroll
            for (int i = 0; i < 4; ++i) { const int tok = tb * 16 + 4 * (lane >> 4) + i; const float y = dacc[i] + dsk * ut[tok * 16 + hp];
                zin[(size_t)(row0 + tok) * ZP + ZC_U + g * 16 + hp] = (bf16)f2bf(gelu_tanh(y)); }
        }
    }
}
template <int PASS>
__device__ __forceinline__ void phase(const Params& P, int L, LAS unsigned char* lds) {
    BODY_IDS();
    LAS unsigned char* wl = lds + wave * WAVE_LDS;
    f32x2* SC = (f32x2*)(P.ws + WS_SC);
    for (int w = gw; w < 2048; w += ngw) {
        const int bg = w >> 5, cg = w & 31, b = bg >> 4, g = bg & 15;
        Coef C; coef(P, L, g, lane, C);
        bf16x8 cf[4]; float dsk = 0.f;
        if (PASS == 1) {
            const int hp = lane & 15, kg = lane >> 4;
            const float* cre = P.in[I_SCR] + ((size_t)(L * 16 + g) * 16 + hp) * 64; const float* cim = P.in[I_SCI] + ((size_t)(L * 16 + g) * 16 + hp) * 64;
#pragma unroll
            for (int ks = 0; ks < 4; ++ks) { const int p0 = 16 * ks + 4 * kg; u32x4 wv;
                wv.x = pk2(cre[p0], -cim[p0]); wv.y = pk2(cre[p0 + 1], -cim[p0 + 1]); wv.z = pk2(cre[p0 + 2], -cim[p0 + 2]); wv.w = pk2(cre[p0 + 3], -cim[p0 + 3]);
                cf[ks] = __builtin_bit_cast(bf16x8, wv); }
            dsk = P.in[I_SD][(L * 16 + g) * 16 + hp];
        } else {
#pragma unroll
            for (int ks = 0; ks < 4; ++ks) cf[ks] = (bf16x8){0, 0, 0, 0, 0, 0, 0, 0};
        }
        float xr = 0.f, xi = 0.f;
        if (PASS == 1) {
            const f32x2* sp = SC + ((size_t)bg * 128) * 64 + lane;
            for (int c = 0; c < 4 * cg; c += 4) { f32x2 sv[4];
#pragma unroll
                for (int q = 0; q < 4; ++q) sv[q] = sp[(size_t)(c + q) * 64];
#pragma unroll
                for (int q = 0; q < 4; ++q) { const float nr = C.a64r * xr - C.a64i * xi + sv[q][0], ni = C.a64r * xi + C.a64i * xr + sv[q][1]; xr = nr; xi = ni; } }
        }
        for (int cc = 0; cc < 4; ++cc) {
            const int c = 4 * cg + cc, row0 = b * SEQ + c * 64;
            if (PASS == 0) { xr = 0.f; xi = 0.f; }
            chunk<PASS == 1>(P, L, g, row0, C, xr, xi, wl, lane, cf, dsk);
            if (PASS == 0) SC[((size_t)bg * 128 + c) * 64 + lane] = (f32x2){xr, xi};
        }
    }
}
#define LDS_XLANE() asm volatile("" ::: "memory")
constexpr int WAVE_LDS1 = 4352;
__device__ __forceinline__ void phase1(const Params& P, int L, LAS unsigned char* lds) {
    BODY_IDS();
    LAS unsigned char* wl = lds + wave * WAVE_LDS1;
    LAS unsigned* bu = (LAS unsigned*)wl; LAS unsigned* xt = bu;
    bf16* zin = (bf16*)(P.ws + WS_ZIN);
    const f32x2* SC = (const f32x2*)(P.ws + WS_SC);
    const int m = lane & 15, kq = lane >> 4;
    for (int w = gw; w < 2048; w += ngw) {
        const int bg = w >> 5, cg = w & 31, b = bg >> 4, g = bg & 15;
        const bf16* ub = zin + (size_t)(b * SEQ + cg * 256 + m) * ZP + ZC_U + g * 16 + 8 * (kq & 1);
        u32x4 ua[4];
#pragma unroll
        for (int q = 0; q < 4; ++q) ua[q] = *(const u32x4*)(ub + (size_t)q * 16 * ZP);
        const f32x2* sp = SC + ((size_t)bg * 128) * 64 + lane;
        f32x2 pq[4][4];
        if (cg > 0) {
#pragma unroll
            for (int j = 0; j < 4; ++j) { const int bc = j < cg ? j : cg - 1;
#pragma unroll
                for (int t = 0; t < 4; ++t) pq[j][t] = sp[(size_t)(4 * bc + t) * 64]; }
        }
        float abr, abi, a64r, a64i; bf16x8 bfr[8];
        { Coef C; coef(P, L, g, lane, C); abr = C.abr; abi = C.abi; a64r = C.a64r; a64i = C.a64i;
          LAS unsigned* tab = (LAS unsigned*)wl;
#pragma unroll
          for (int h2 = 0; h2 < 8; ++h2) { tab[lane * 8 + h2] = pk2(C.B2[2 * h2][0], C.B2[2 * h2 + 1][0]); tab[(64 + lane) * 8 + h2] = pk2(C.B2[2 * h2][1], C.B2[2 * h2 + 1][1]); }
          LDS_XLANE();
#pragma unroll
          for (int nt = 0; nt < 8; ++nt) { const u32x4 v = *(const LAS u32x4*)(wl + (16 * nt + m) * 32 + 16 * (kq & 1)); bfr[nt] = __builtin_bit_cast(bf16x8, kq < 2 ? v : (u32x4){0u, 0u, 0u, 0u}); }
          LDS_XLANE(); }
        bf16x8 cf[4]; float dskf;
        { const float* cre = P.in[I_SCR] + ((size_t)(L * 16 + g) * 16 + m) * 64; const float* cim = P.in[I_SCI] + ((size_t)(L * 16 + g) * 16 + m) * 64;
#pragma unroll
          for (int ks = 0; ks < 4; ++ks) { const int p0 = 16 * ks + 4 * kq; u32x4 wv;
              wv.x = pk2(cre[p0], -cim[p0]); wv.y = pk2(cre[p0 + 1], -cim[p0 + 1]); wv.z = pk2(cre[p0 + 2], -cim[p0 + 2]); wv.w = pk2(cre[p0 + 3], -cim[p0 + 3]);
              cf[ks] = __builtin_bit_cast(bf16x8, wv); }
          dskf = P.in[I_SD][(L * 16 + g) * 16 + m]; }
        float xr = 0.f, xi = 0.f;
        for (int k = 0; k < cg; k += 4) {
#pragma unroll
            for (int j = 0; j < 4; ++j) {
                if (k + j < cg) {
#pragma unroll
                    for (int t = 0; t < 4; ++t) { const float nr = a64r * xr - a64i * xi + pq[j][t][0], ni = a64r * xi + a64i * xr + pq[j][t][1]; xr = nr; xi = ni; } }
                const int bn = k + j + 4, bc = bn < cg ? bn : cg - 1;
#pragma unroll
                for (int t = 0; t < 4; ++t) pq[j][t] = sp[(size_t)(4 * bc + t) * 64];
            }
        }
#pragma nounroll
        for (int cc = 0; cc < 4; ++cc) {
            const int row0 = b * SEQ + (4 * cg + cc) * 64;
            u32x4 un[4];
            if (cc < 3) {
#pragma unroll
                for (int q = 0; q < 4; ++q) un[q] = *(const u32x4*)(ub + (size_t)((cc + 1) * 4 + q) * 16 * ZP);
            } else {
#pragma unroll
                for (int q = 0; q < 4; ++q) un[q] = ua[q];
            }
#pragma unroll
            for (int tb = 0; tb < 4; ++tb) {
                const bf16x8 a = __builtin_bit_cast(bf16x8, ua[tb]);
                f32x4 dd[8];
#pragma unroll
                for (int nt = 0; nt < 8; ++nt) dd[nt] = __builtin_amdgcn_mfma_f32_16x16x32_bf16(a, bfr[nt], (f32x4){0.f, 0.f, 0.f, 0.f}, 0, 0, 0);
                unsigned short uraw[4];
#pragma unroll
                for (int i = 0; i < 4; ++i) uraw[i] = *(const unsigned short*)(zin + (size_t)(row0 + tb * 16 + 4 * kq + i) * ZP + ZC_U + g * 16 + m);
#pragma unroll
                for (int nt = 0; nt < 4; ++nt)
#pragma unroll
                    for (int i = 0; i < 4; ++i) bu[(4 * kq + i) * 68 + 16 * nt + m] = pk2(dd[nt][i], dd[nt + 4][i]);
                LDS_XLANE();
#pragma unroll
                for (int ti = 0; ti < 16; ++ti) {
                    const unsigned bw = bu[ti * 68 + lane]; const float br = bflo(bw), bi = bfhi(bw);
                    const float nr = abr * xr - abi * xi + br, ni = abr * xi + abi * xr + bi; xr = nr; xi = ni;
                    xt[ti * 68 + lane] = pk2(xr, xi);
                }
                LDS_XLANE();
                f32x4 dacc = {0.f, 0.f, 0.f, 0.f};
#pragma unroll
                for (int ks = 0; ks < 4; ++ks) { const bf16x8 a2 = *(const LAS bf16x8*)(wl + m * 272 + (ks * 32 + kq * 8) * 2);
                    dacc = __builtin_amdgcn_mfma_f32_16x16x32_bf16(a2, cf[ks], dacc, 0, 0, 0); }
                LDS_XLANE();
#pragma unroll
                for (int i = 0; i < 4; ++i) { const int tok = tb * 16 + 4 * kq + i; const float y = dacc[i] + dskf * __uint_as_float((unsigned)uraw[i] << 16);
                    const float gy = gelu_tanh(y); *(unsigned short*)(zin + (size_t)(row0 + tok) * ZP + ZC_U + g * 16 + m) = (unsigned short)pk2(gy, gy); }
            }
#pragma unroll
            for (int q = 0; q < 4; ++q) ua[q] = un[q];
        }
    }
}
__device__ __forceinline__ void build_w(const Params& P, int L) {
    BODY_IDS();
    bf16* W = (bf16*)(P.ws + WS_S5W);
    for (int q = gtid; q < 16 * 64 * 64; q += gthreads) {
        const int g = q >> 12, p = (q >> 6) & 63, sidx = q & 63;
        const float dt = __expf(P.in[I_SLDT][L * 16 + g]); const float ar = P.in[I_SAR][(L * 16 + g) * 64 + p], ai = P.in[I_SAI][(L * 16 + g) * 64 + p];
        const float mag = __expf(ar * dt); float sn, cs; sincos_rad((double)(ai * dt), sn, cs);
        const float abr = mag * cs, abi = mag * sn, den = ar * ar + ai * ai, nr = abr - 1.0f, ni = abi;
        const float cr = (nr * ar + ni * ai) / den, ci = (ni * ar - nr * ai) / den;
        const float e = (float)(63 - sidx); const float me = __expf(e * ar * dt); float se, ce; sincos_rad((double)e * (double)(ai * dt), se, ce);
        const float Er = me * ce, Ei = me * se;
        const float* br = P.in[I_SBR] + ((size_t)(L * 16 + g) * 64 + p) * 16; const float* bi = P.in[I_SBI] + ((size_t)(L * 16 + g) * 64 + p) * 16;
        float vr[16], vi[16];
#pragma unroll
        for (int h = 0; h < 16; ++h) { const float bbr = cr * br[h] - ci * bi[h], bbi = cr * bi[h] + ci * br[h]; vr[h] = Er * bbr - Ei * bbi; vi[h] = Er * bbi + Ei * bbr; }
        bf16* w0 = W + ((size_t)g * 128 + 2 * p) * 1024 + sidx * 16;
        *(u32x4*)w0 = (u32x4){pk2(vr[0], vr[1]), pk2(vr[2], vr[3]), pk2(vr[4], vr[5]), pk2(vr[6], vr[7])}; *(u32x4*)(w0 + 8) = (u32x4){pk2(vr[8], vr[9]), pk2(vr[10], vr[11]), pk2(vr[12], vr[13]), pk2(vr[14], vr[15])};
        *(u32x4*)(w0 + 1024) = (u32x4){pk2(vi[0], vi[1]), pk2(vi[2], vi[3]), pk2(vi[4], vi[5]), pk2(vi[6], vi[7])}; *(u32x4*)(w0 + 1024 + 8) = (u32x4){pk2(vi[8], vi[9]), pk2(vi[10], vi[11]), pk2(vi[12], vi[13]), pk2(vi[14], vi[15])};
    }
}
__device__ __forceinline__ void pass0_mfma(const Params& P, LAS unsigned char* lds) {
    BODY_IDS();
    const bf16* zin = (const bf16*)(P.ws + WS_ZIN); const bf16* W = (const bf16*)(P.ws + WS_S5W); float* SC = (float*)(P.ws + WS_SC);
    for (int task = blockIdx.x; task < 256; task += gridDim.x) {
        const int g = task & 15, nq = (task >> 4) & 3, cgp = (task >> 6) * 8 + wave;
        __syncthreads();
#pragma unroll
        for (int i = 0; i < 8; ++i) { const int id = tid + 512 * i, row = id >> 7, c16 = id & 127;
            *(LAS u32x4*)(lds + row * 2064 + c16 * 16) = *(const u32x4*)(W + ((size_t)g * 128 + nq * 32 + row) * 1024 + c16 * 8); }
        __syncthreads();
        const int m = lane & 15, kq = lane >> 4, ci = 16 * cgp + m, b = ci >> 7, c = ci & 127;
        const bf16* ap = zin + (size_t)(b * SEQ + c * 64 + (kq >> 1)) * ZP + ZC_U + g * 16 + 8 * (kq & 1);
        const LAS unsigned char* bl = lds + m * 2064 + kq * 16;
        f32x4 d0 = {0.f, 0.f, 0.f, 0.f}, d1 = {0.f, 0.f, 0.f, 0.f};
#pragma unroll 8
        for (int ks = 0; ks < 32; ++ks) {
            const bf16x8 av = *(const bf16x8*)(ap + (size_t)(2 * ks) * ZP), b0 = *(const LAS bf16x8*)(bl + 64 * ks), b1 = *(const LAS bf16x8*)(bl + 16 * 2064 + 64 * ks);
            d0 = __builtin_amdgcn_mfma_f32_16x16x32_bf16(av, b0, d0, 0, 0, 0); d1 = __builtin_amdgcn_mfma_f32_16x16x32_bf16(av, b1, d1, 0, 0, 0);
        }
#pragma unroll
        for (int i = 0; i < 4; ++i) { const int cj = 16 * cgp + 4 * (lane >> 4) + i, bj = cj >> 7, cc = cj & 127; float* sp = SC + ((size_t)(bj * 16 + g) * 128 + cc) * 128 + nq * 32 + (lane & 15);
            sp[0] = d0[i]; sp[16] = d1[i]; }
    }
    __syncthreads();
}
__device__ __forceinline__ void naive(const Params& P, int L) {
    BODY_IDS();
    bf16* zin = (bf16*)(P.ws + WS_ZIN);
    for (int bg = gw; bg < 64; bg += ngw) {
        const int b = bg >> 4, g = bg & 15;
        Coef C; coef(P, L, g, lane, C);
        float cr[16], ci[16];
#pragma unroll
        for (int h = 0; h < 16; ++h) { cr[h] = P.in[I_SCR][((size_t)(L * 16 + g) * 16 + h) * 64 + lane]; ci[h] = P.in[I_SCI][((size_t)(L * 16 + g) * 16 + h) * 64 + lane]; }
        const float dsk = P.in[I_SD][(L * 16 + g) * 16 + (lane & 15)];
        float xr = 0.f, xi = 0.f;
        for (int t = 0; t < SEQ; ++t) {
            bf16* up = zin + (size_t)(b * SEQ + t) * ZP + ZC_U + g * 16;
            const u32x4 w0 = *(const u32x4*)up, w1 = *(const u32x4*)(up + 8);
            const float u[16] = {bflo(w0.x), bfhi(w0.x), bflo(w0.y), bfhi(w0.y), bflo(w0.z), bfhi(w0.z), bflo(w0.w), bfhi(w0.w),
                                 bflo(w1.x), bfhi(w1.x), bflo(w1.y), bfhi(w1.y), bflo(w1.z), bfhi(w1.z), bflo(w1.w), bfhi(w1.w)};
            float br = 0.f, bi = 0.f;
#pragma unroll
            for (int h = 0; h < 16; ++h) { br += C.B2[h][0] * u[h]; bi += C.B2[h][1] * u[h]; }
            const float nr = C.abr * xr - C.abi * xi + br, ni = C.abr * xi + C.abi * xr + bi; xr = nr; xi = ni;
            float ymine = 0.f, umine = 0.f;
#pragma unroll
            for (int h = 0; h < 16; ++h) { const float s = wave_sum(xr * cr[h] - xi * ci[h]); if ((lane & 15) == h) { ymine = s; umine = u[h]; } }
            __builtin_amdgcn_s_waitcnt(0);
            if (lane < 16) up[lane] = (bf16)f2bf(gelu_tanh(ymine + dsk * umine));
        }
    }
}
}

__device__ __forceinline__ void norm2_moe_phase(const Params& P, const XSrc x, LAS unsigned char* lds, int first, int stride) {
    BODY_IDS();
    LAS unsigned* lcnt = (LAS unsigned*)(lds + 32768); LAS unsigned* lbase = lcnt + 8;
    f32x4 wr0[4][4], wr1[4][4];
#pragma unroll
    for (int j = 0; j < 4; ++j)
#pragma unroll
        for (int q = 0; q < 4; ++q) { const float* wp = P.in[I_MWR] + (size_t)(4 * lane + 256 * j + q) * 8; wr0[j][q] = *(const f32x4*)wp; wr1[j][q] = *(const f32x4*)(wp + 4); }
    if (tid < 8) lcnt[tid] = 0u;
    __syncthreads();
    const float* gain = P.in[I_GFFN] + 1 * D; bf16* H = (bf16*)(P.ws + WS_H); const GainRegs GR = load_gain(gain, lane);
    unsigned* tokinfo = (unsigned*)(P.ws + WS_TOKINFO); unsigned* gcnt = (unsigned*)(P.ws + WS_CTL) + CW_MOECNT;
    const float* brt = P.in[I_MBR];
    for (int u = first; u < NTOK / 128; u += stride) { const int g0 = u * 8 + wave;
        RMS_ROWS_BEGIN(x, g0 * 16 + i) const int row = g0 * 16 + i; rms_finish(GR, H + (size_t)row * D, lane, v);
            float lg[8];
#pragma unroll
            for (int e = 0; e < 8; ++e) lg[e] = 0.f;
#pragma unroll
            for (int j = 0; j < 4; ++j)
#pragma unroll
                for (int q = 0; q < 4; ++q) { const f32x4 w0 = wr0[j][q], w1 = wr1[j][q]; const float hv = v[j][q];
                    lg[0] += hv * w0[0]; lg[1] += hv * w0[1]; lg[2] += hv * w0[2]; lg[3] += hv * w0[3]; lg[4] += hv * w1[0]; lg[5] += hv * w1[1]; lg[6] += hv * w1[2]; lg[7] += hv * w1[3]; }
#pragma unroll
            for (int e = 0; e < 8; ++e) lg[e] = wave_sum(lg[e]) + brt[e];
            int e0 = 0; float l0 = lg[0];
#pragma unroll
            for (int e = 1; e < 8; ++e) if (lg[e] > l0) { l0 = lg[e]; e0 = e; }
            int e1 = 0; float l1 = -INFINITY;
#pragma unroll
            for (int e = 0; e < 8; ++e) if (e != e0 && lg[e] > l1) { l1 = lg[e]; e1 = e; }
            const float ex = __expf(l1 - l0); const float ga = __builtin_amdgcn_rcpf(1.0f + ex), gb = ex * ga;
            if (lane == 0) { const unsigned r0 = __hip_atomic_fetch_add(&lcnt[e0], 1u, __ATOMIC_RELAXED, __HIP_MEMORY_SCOPE_WORKGROUP), r1 = __hip_atomic_fetch_add(&lcnt[e1], 1u, __ATOMIC_RELAXED, __HIP_MEMORY_SCOPE_WORKGROUP);
                u32x4 a; a.x = (unsigned)e0; a.y = (unsigned)e1; a.z = r0; a.w = r1; u32x4 bq; bq.x = __float_as_uint(ga); bq.y = __float_as_uint(gb); bq.z = 0u; bq.w = 0u;
                *(u32x4*)(tokinfo + (size_t)row * 8) = a; *(u32x4*)(tokinfo + (size_t)row * 8 + 4) = bq; } RMS_ROWS_END()
    }
    __syncthreads();
    if (tid < 8) lbase[tid] = __hip_atomic_fetch_add(gcnt + tid, lcnt[tid], __ATOMIC_RELAXED, __HIP_MEMORY_SCOPE_AGENT);
    __syncthreads();
    for (int u = first; u < NTOK / 128; u += stride) { const int g0 = u * 8 + wave;
        if (lane == 0) { for (int i = 0; i < 16; ++i) { const int row = g0 * 16 + i; u32x4 a = *(u32x4*)(tokinfo + (size_t)row * 8);
            unsigned b0 = 0, b1 = 0;
#pragma unroll
            for (int e = 0; e < 8; ++e) { const unsigned lb = lbase[e]; b0 = (a.x == (unsigned)e) ? lb : b0; b1 = (a.y == (unsigned)e) ? lb : b1; }
            a.z += b0; a.w += b1; *(u32x4*)(tokinfo + (size_t)row * 8) = a; } }
    }
    int* slot_tok = (int*)(P.ws + WS_SLOTTOK);
    for (int i = gtid; i < MOE_ROWS; i += gthreads) slot_tok[i] = -1;
    __syncthreads();
}
struct MoeLayout { int pstart[9]; };
__device__ __forceinline__ MoeLayout moe_layout(const Params& P) {
    const unsigned* gcnt = (const unsigned*)(P.ws + WS_CTL) + CW_MOECNT; MoeLayout Lo; int acc = 0;
#pragma unroll
    for (int e = 0; e < 8; ++e) { Lo.pstart[e] = acc; const int c = (int)__hip_atomic_load(gcnt + e, __ATOMIC_RELAXED, __HIP_MEMORY_SCOPE_AGENT); acc += (c + 255) / 256 * 256; }
    Lo.pstart[8] = acc; return Lo;
}
__device__ __forceinline__ void moe_assign_phase(const Params& P) {
    BODY_IDS();
    const MoeLayout Lo = moe_layout(P);
    const unsigned* tokinfo = (const unsigned*)(P.ws + WS_TOKINFO); int* slot_tok = (int*)(P.ws + WS_SLOTTOK); float* slot_gate = (float*)(P.ws + WS_SLOTGATE);
    for (int t = gtid; t < NTOK; t += gthreads) { const u32x4 a = *(const u32x4*)(tokinfo + (size_t)t * 8); const u32x2 g = *(const u32x2*)(tokinfo + (size_t)t * 8 + 4);
        int p0 = 0, p1 = 0;
#pragma unroll
        for (int e = 0; e < 8; ++e) { p0 = ((int)a.x == e) ? Lo.pstart[e] : p0; p1 = ((int)a.y == e) ? Lo.pstart[e] : p1; }
        const int s0 = p0 + (int)a.z, s1 = p1 + (int)a.w;
        slot_tok[s0] = t; slot_gate[s0] = __uint_as_float(g.x); slot_tok[s1] = t; slot_gate[s1] = __uint_as_float(g.y); }
}
struct MoeOrder {
    int pstart[9]; int ntile, ncol, G, c;
    __device__ __forceinline__ bool next(int i, pg8::Unit& u) const {
        const long Lf = (long)i * G + c; if (Lf >= (long)ntile * ncol) return false;
        const int rt = (int)(Lf / ncol), j = (int)(Lf % ncol); int e = 0;
#pragma unroll
        for (int q = 1; q < 8; ++q) e = (rt * 256 >= pstart[q]) ? q : e;
        u.pm = rt; u.pn = e * ncol + j; return true;
    }
};
__device__ __forceinline__ MoeOrder moe_order(const Params& P, int ncol, int G, int c) {
    const MoeLayout Lo = moe_layout(P); MoeOrder S;
#pragma unroll
    for (int e = 0; e < 9; ++e) S.pstart[e] = Lo.pstart[e];
    S.ntile = Lo.pstart[8] / 256; S.ncol = ncol; S.G = G; S.c = c; return S;
}

__device__ __forceinline__ void norm_moe_combine(const Params& P, const float* gain, int first, int stride) {
    BODY_IDS();
    const MoeLayout Lo = moe_layout(P); const GainRegs GR = load_gain(gain, lane);
    const unsigned* tokinfo = (const unsigned*)(P.ws + WS_TOKINFO); const bf16* Y = (const bf16*)(P.ws + WS_MOEY); bf16* H = (bf16*)(P.ws + WS_H2);
    for (int u = first; u < NTOK / 128; u += stride) for (int i = 0; i < 16; ++i) { const int row = u * 128 + wave * 16 + i;
        const u32x4 a = *(const u32x4*)(tokinfo + (size_t)row * 8);
        int p0 = 0, p1 = 0;
#pragma unroll
        for (int e = 0; e < 8; ++e) { p0 = ((int)a.x == e) ? Lo.pstart[e] : p0; p1 = ((int)a.y == e) ? Lo.pstart[e] : p1; }
        const u32x2* y0 = (const u32x2*)(Y + (size_t)(p0 + (int)a.z) * D) + lane; const u32x2* y1 = (const u32x2*)(Y + (size_t)(p1 + (int)a.w) * D) + lane;
        u32x2* xr = (u32x2*)(xr_of(P.out) + (size_t)row * D) + lane; f32x4 v[4]; float s = 0.f;
#pragma unroll
        for (int j = 0; j < 4; ++j) { const u32x2 w0 = y0[64 * j], w1 = y1[64 * j]; const u32x2 wx = xr[64 * j];
            v[j] = (f32x4){bflo(wx.x), bfhi(wx.x), bflo(wx.y), bfhi(wx.y)} + (f32x4){bflo(w0.x), bfhi(w0.x), bflo(w0.y), bfhi(w0.y)} + (f32x4){bflo(w1.x), bfhi(w1.x), bflo(w1.y), bfhi(w1.y)};
            { u32x2 wo; wo.x = pk2(v[j][0], v[j][1]); wo.y = pk2(v[j][2], v[j][3]); xr[64 * j] = wo; } s += (v[j][0] * v[j][0] + v[j][1] * v[j][1]) + (v[j][2] * v[j][2] + v[j][3] * v[j][3]); }
        const float rstd = __builtin_amdgcn_rsqf(wave_sum(s) * (1.0f / D) + RMS_EPS);
        u32x2* o8 = (u32x2*)(H + (size_t)row * D) + lane;
#pragma unroll
        for (int j = 0; j < 4; ++j) { const f32x4 h = v[j] * rstd * GR.g[j]; u32x2 w; w.x = pk2(h[0], h[1]); w.y = pk2(h[2], h[3]); o8[64 * j] = w; }
    }
}
#ifndef REF_MASK
#define REF_MASK 0
#endif
#ifndef N_LAUNCH_MODE
#define N_LAUNCH_MODE 1
#endif
constexpr int LDS_BYTES = 147456;
#ifdef BIS_A
#define BIS_HP H
#define BIS_SSQ ((const float*)nullptr)
#else
#define BIS_HP XR
#define BIS_SSQ ((const float*)(P.ws + WS_SSQ))
#endif
constexpr int RL_OFF = 131072, RL_UNITS = 15;
constexpr int MISC_OFF = LDS_BYTES - 64;
constexpr int N_PHASES = 27;
#ifndef PHASE_SEL
#define PHASE_SEL 0xFFFFFFFu
#endif
#define PH_ON(b) (((PHASE_SEL) >> (b)) & 1u)
#ifndef SUB_SEL
#define SUB_SEL 0xFFu
#endif
#define SUB_ON(b) (((SUB_SEL) >> (b)) & 1u)

#ifndef PROBE_MASK
#define PROBE_MASK 0u
#endif
#ifndef PROBE_MULT
#define PROBE_MULT 4
#endif
#define TIMED(bit, ...) do { unsigned long long t0_ = 0; if (((PROBE_MASK) >> (bit)) & 1u) t0_ = __builtin_amdgcn_s_memrealtime(); __VA_ARGS__; \
    if (((PROBE_MASK) >> (bit)) & 1u) pacc += __builtin_amdgcn_s_memrealtime() - t0_; } while (0)
#define RUN_GEMM(EPI_T, SCHED_T, GATH, gm, sc, ep) do { if (REF_MASK & 1) pg8::gemm_phase_naive<EPI_T, SCHED_T, GATH>(gm, sc, ep); \
    else pg8::gemm_phase<EPI_T, SCHED_T, true, GATH>(lds, gm, sc, ep); } while (0)

__device__ __forceinline__ int vcu_of() { int G = gridDim.x, bx = blockIdx.x; asm volatile("" : "+s"(G), "+s"(bx)); return (G % 8 == 0) ? (bx % 8) * (G / 8) + bx / 8 : bx; }
__device__ __forceinline__ bool in_range(int lo, int hi, int k) { asm volatile("" : "+s"(lo), "+s"(hi)); return lo <= k && k < hi; }
__global__ void __launch_bounds__(NTHREADS, 2) mega_fwd(Params P) {
    extern __shared__ __attribute__((aligned(16))) unsigned char lds_raw[];
    LAS unsigned char* lds = (LAS unsigned char*)lds_raw;
    const int tid = threadIdx.x;
    const int G = gridDim.x, bx = blockIdx.x;
    unsigned* ctl = (unsigned*)(P.ws + WS_CTL);
    volatile LAS unsigned* misc = (volatile LAS unsigned*)(lds + MISC_OFF);
    if (tid < 16) misc[tid] = 0u;
    if ((tid & 63) == 0) *(LAS int*)(uintptr_t)((unsigned)TID_TAB_OFF + 4u * hw_wave_key()) = tid >> 6;
    __syncthreads();
    const int lo = P.ph_lo, hi = P.ph_hi;
    XcdBarrier bar; bar.bar = ctl + CW_BAR; bar.x = 0; bar.st = misc;
    if (hi - lo > 1) bar = xcd_barrier_post(ctl + CW_BAR, misc);
#define IN(k) in_range(lo, hi, (k))
#ifndef PROBE_SEAMS
#define PROBE_SEAMS 0u
#endif
#define SEAM(k) do { if (IN(k) && IN((k) + 1)) { unsigned long long t0_ = 0; const bool tm_ = (((PROBE_MASK) >> 24) & 1u) || (((PROBE_SEAMS) >> (k)) & 1u); if (tm_) t0_ = __builtin_amdgcn_s_memrealtime(); \
    xcd_barrier(bar); if (tm_) pacc += __builtin_amdgcn_s_memrealtime() - t0_; } } while (0)
    unsigned long long pacc = 0;

#define H ((bf16*)(P.ws + WS_H))
#define ZIN ((bf16*)(P.ws + WS_ZIN))
#define GB ((bf16*)(P.ws + WS_G))
#define MB ((bf16*)(P.ws + WS_M))
#define MLAQ ((bf16*)(P.ws + WS_MLAQ))
#define MLAKV ((bf16*)(P.ws + WS_MLAKV))
#define KPER ((bf16*)(P.ws + WS_KPER))
#define cosT ((float*)(P.ws + WS_COS))
#define sinT ((float*)(P.ws + WS_SIN))
#define slot_tok ((int*)(P.ws + WS_SLOTTOK))
#define slot_gate ((float*)(P.ws + WS_SLOTGATE))

    if (PH_ON(0) && IN(0)) { TIMED(0, cvt_jobs(P, 0, 43, lds); p0_misc(P)); TIMED(1, norm1_phase(P, 0, XSrc{P.in[I_X], nullptr}, vcu_of(), gridDim.x)); }
    SEAM(0);

    for (int L = 0; L < 2; ++L) {
        const int pb = 1 + 12 * L;
        const int pc = (L == 0) ? 9 : 22;
        bf16* const XR = xr_of(P.out);
#ifdef BIS_B
        bf16* const X2 = XR;
#else
        bf16* const X2 = (bf16*)(P.ws + WS_WM13);
#endif
        const XSrc xsrc = (L == 0) ? XSrc{P.in[I_X], nullptr} : XSrc{nullptr, X2};
        if (PH_ON(2) && IN(pb + 1)) {
            TIMED(4, s5::build_w(P, L));
            pg8::Gemm g{H, wmix(P, L, WM_IN), D, D, D, nullptr}; pg8::StaticOrder S; S.init(NTOK, ZP, G, bx);
            epi::EpiStore E{ZIN, ZP, 0};
            TIMED(2, RUN_GEMM(epi::EpiStore, pg8::StaticOrder, false, g, S, E));
        }
        SEAM(pb + 1);
        if (PH_ON(3) && IN(pb + 2)) {
            TIMED(3, prep_phase(P, L));
            if (!(REF_MASK & 4)) TIMED(4, s5::pass0_mfma(P, lds));
            __syncthreads();
        }
        SEAM(pb + 2);
        if (PH_ON(4) && IN(pb + 3)) {
            if (SUB_ON(0)) { pg8::Gemm g{ZIN + ZC_CQ, wmix(P, L, WM_UQ), ZP, 256, 256, nullptr}; pg8::StaticOrder S; S.init(NTOK, 512, G, bx);
              epi::EpiMlaQ E{MLAQ, (const float*)(P.ws + WS_RSTDQ), cosT, sinT};
              TIMED(5, RUN_GEMM(epi::EpiMlaQ, pg8::StaticOrder, false, g, S, E)); }
            if (SUB_ON(1)) { pg8::Gemm g{ZIN + ZC_CKV, wmix(P, L, WM_UKV), ZP, 128, 128, nullptr}; pg8::StaticOrder S; S.init(NTOK, 512, G, bx);
              epi::EpiRowScale E{MLAKV, 512, (const float*)(P.ws + WS_RSTDKV)};
              TIMED(5, RUN_GEMM(epi::EpiRowScale, pg8::StaticOrder, false, g, S, E)); }
            if (SUB_ON(2)) { TIMED(6, if (REF_MASK & 4) s5::naive(P, L); else s5::phase1(P, L, lds)); }
            __syncthreads();
            if (SUB_ON(3)) { att::Tensors T; T.Q = ZIN + ZC_FQ; T.ldq = ZP; T.K = ZIN + ZC_FK; T.ldk = ZP; T.K2 = nullptr; T.V = ZIN + ZC_FV; T.ldv = ZP; T.O = ZIN + ZC_FQ; T.ldo = ZP;
              T.cdec = (const float*)(P.ws + WS_CDEC); T.relb = nullptr; T.qhs = 64; T.khs = 64; T.vhs = 64; T.ohs = 64;
              T.qmax = (const unsigned*)(P.ws + WS_CTL) + CW_QMAX + L * 512; T.kmax = (const unsigned*)(P.ws + WS_CTL) + CW_KMAX + L * 16;
              TIMED(7, if (REF_MASK & 2) att::attn_naive<att::MODE_FOX>(T); else att::attn_phase<att::MODE_FOX>(T, lds)); }
            __syncthreads();
            if (SUB_ON(4)) { att::Tensors T; T.Q = ZIN + ZC_DQ; T.ldq = ZP; T.K = ZIN + ZC_DK; T.ldk = ZP; T.K2 = nullptr; T.V = ZIN + ZC_DV; T.ldv = ZP; T.O = ZIN + ZC_DQ; T.ldo = ZP;
              T.cdec = nullptr; T.relb = P.in[I_RELB] + (size_t)L * 4 * 513; T.qhs = 64; T.khs = 64; T.vhs = 64; T.ohs = 64;
              TIMED(8, if (REF_MASK & 2) att::attn_naive<att::MODE_BAND>(T); else att::attn_phase<att::MODE_BAND>(T, lds)); }
            __syncthreads();
        }
        SEAM(pb + 3);
        if (PH_ON(5) && IN(pb + 4)) {
            if (SUB_ON(0)) { att::Tensors T; T.Q = MLAQ; T.ldq = 512; T.K = MLAKV; T.ldk = 512; T.K2 = KPER; T.V = MLAKV + 64; T.ldv = 512; T.O = ZIN + ZC_CQ; T.ldo = ZP;
              T.cdec = nullptr; T.relb = nullptr; T.qhs = 96; T.khs = 128; T.vhs = 128; T.ohs = 64;
              TIMED(9, if (REF_MASK & 2) att::attn_naive<att::MODE_MLA>(T); else att::attn_phase<att::MODE_MLA>(T, lds)); }
            __syncthreads();
            if (SUB_ON(1)) { pg8::Gemm g{ZIN + ZC_U, wmix(P, L, WM_GLU), ZP, 256, 256, nullptr}; pg8::StaticOrder S; S.init(NTOK, 256, G, bx);
              epi::EpiGlu E{ZIN + ZC_U, ZP};
              TIMED(10, RUN_GEMM(epi::EpiGlu, pg8::StaticOrder, false, g, S, E)); }
        }
        SEAM(pb + 4);
        if (PH_ON(6) && IN(pb + 5)) {
            g128::MergeProg MP; MP.Hn = H; MP.zin = ZIN; MP.wg = wmix(P, L, WM_G); MP.wb = wmix(P, L, WM_B); MP.bg = P.in[I_BG] + (size_t)L * 4 * D; MP.M = MB;
            const int vcu_ = vcu_of();
            TIMED(11, g128::stream<g128::MergeProg>(lds, MP, 1024, vcu_, G));
        }
        SEAM(pb + 5);
#define PANEL_FENCE() do { asm volatile("s_waitcnt vmcnt(0)" ::: "memory"); __builtin_amdgcn_fence(__ATOMIC_ACQUIRE, "agent"); asm volatile("s_waitcnt vmcnt(0)" ::: "memory"); __syncthreads(); } while (0)
        if (PH_ON(7) && IN(pb + 6)) {
            pg8::Gemm g{MB, wmix(P, L, WM_O), D, D, D, nullptr}; pg8::StaticOrder S; S.init(NTOK, D, G, bx);
            epi::EpiRes E{xsrc, XR, (L == 0) ? (float*)(P.ws + WS_SSQ) : nullptr};
            TIMED(13, RUN_GEMM(epi::EpiRes, pg8::StaticOrder, false, g, S, E));
        }
        SEAM(pb + 6);
        if (PH_ON(8) && IN(pb + 7)) {
            const int vcu_ = vcu_of();
            if (L != 0) { TIMED(14, norm2_moe_phase(P, XSrc{nullptr, XR}, lds, vcu_, G)); TIMED(25, cvt_jobs(P, 43, 67, lds)); __syncthreads(); }
        }
        if (L != 0) SEAM(pb + 7);
        if (L == 0) {
            if (PH_ON(9) && IN(9)) {
                pg8::Gemm g{XR, (const bf16*)(P.ws + WS_W13), D, D, D, nullptr}; pg8::StaticOrder S; S.init(NTOK, 2 * DFF, G, bx);
                LAS float* rl = (LAS float*)(lds + RL_OFF);
                { const int t_ = my_tid(); const int half = __builtin_amdgcn_readfirstlane(t_ >> 8); const f32x4* sl = (const f32x4*)(P.ws + WS_SSQ);
                  int nu = 0; { pg8::Unit uu; while (nu < RL_UNITS && S.next(nu, uu)) ++nu; }
#pragma unroll 3
                  for (int i = half; i < nu; i += 2) { pg8::Unit uu; S.next(i, uu);
                      const f32x4* rp = sl + (size_t)(uu.pm * 256 + (t_ & 255)) * 4; const f32x4 s0 = rp[0], s1 = rp[1], s2 = rp[2], s3 = rp[3];
                      const float tot = (((s0[0] + s0[1]) + (s0[2] + s0[3])) + ((s1[0] + s1[1]) + (s1[2] + s1[3]))) + (((s2[0] + s2[1]) + (s2[2] + s2[3])) + ((s3[0] + s3[1]) + (s3[2] + s3[3])));
                      rl[i * 256 + (t_ & 255)] = __builtin_amdgcn_rsqf(tot * (1.0f / D) + RMS_EPS); }
                  __syncthreads(); }
                epi::EpiSwiglu E{(bf16*)(P.ws + WS_HMID), DFF, 22, rl, 0};
                TIMED(15, RUN_GEMM(epi::EpiSwiglu, pg8::StaticOrder, false, g, S, E));
            }
            SEAM(9);
            if (PH_ON(10) && IN(10)) {
                pg8::Gemm g{(const bf16*)(P.ws + WS_HMID), (const bf16*)(P.ws + WS_W2), DFF, DFF, DFF, nullptr}; pg8::StaticOrder S; S.init(NTOK, D, G, bx);
                epi::EpiRes E{XSrc{nullptr, XR}, XR, (float*)(P.ws + WS_SSQ)};
                TIMED(16, RUN_GEMM(epi::EpiRes, pg8::StaticOrder, false, g, S, E));
            }
            SEAM(10);
        } else {
            if (PH_ON(21) && IN(21)) TIMED(17, moe_assign_phase(P));
            SEAM(21);
            if (PH_ON(22) && IN(22)) {
                pg8::Gemm g{H, (const bf16*)(P.ws + WS_WM13), D, D, D, slot_tok}; const MoeOrder S = moe_order(P, 11, G, bx);
                epi::EpiSwiglu E{(bf16*)(P.ws + WS_HMID), DFFE, 11, nullptr, 0};
                TIMED(18, RUN_GEMM(epi::EpiSwiglu, MoeOrder, true, g, S, E));
            }
            SEAM(22);
            if (PH_ON(23) && IN(23)) {
                pg8::Gemm g{(const bf16*)(P.ws + WS_HMID), (const bf16*)(P.ws + WS_WM2), DFFE, DFFE, DFFE, nullptr}; const MoeOrder S = moe_order(P, 4, G, bx);
                epi::EpiMoeDown E{(bf16*)(P.ws + WS_MOEY), slot_gate};
                TIMED(19, RUN_GEMM(epi::EpiMoeDown, MoeOrder, false, g, S, E));
            }
            SEAM(23);
        }
        if (PH_ON(12) && IN(pc + 3)) {
            const int vcu_ = vcu_of();
#ifdef BIS_A
            if (L == 0) TIMED(20, norm_plain(XSrc{nullptr, XR}, P.in[I_GPLE] + L * D, H, vcu_, G)); else TIMED(20, norm_moe_combine(P, P.in[I_GPLE] + L * D, vcu_, G));
            PANEL_FENCE();
#else
            if (L != 0) { TIMED(20, norm_moe_combine(P, P.in[I_GPLE] + L * D, vcu_, G)); PANEL_FENCE(); }
#endif
            g128::PleProg PP; PP.pbf = (const bf16*)(P.ws + WS_PBF) + (size_t)L * NTOK * 256; PP.hp = (L == 0) ? BIS_HP : (const bf16*)(P.ws + WS_H2); PP.wup = wmix(P, L, WM_UP); PP.wpg = wmix(P, L, WM_PG);
            PP.xin = XR; PP.xout = (L == 0) ? X2 : XR; PP.ssq = (L == 0) ? BIS_SSQ : nullptr;
            TIMED(22, g128::stream<g128::PleProg>(lds, PP, NTOK / 128, vcu_, G));
            PANEL_FENCE();
            if (L == 0) TIMED(1, norm1_phase(P, 1, XSrc{nullptr, X2}, vcu_, G));
        }
        if (L == 0) SEAM(pc + 3);
    }
    if (PH_ON(26) && IN(25)) {
        const int vcu_ = vcu_of(); const int G_ = gridDim.x;
        for (int r = 0; r < (NTOK / 128 + G_ - 1) / G_; ++r) {
            const int u = vcu_ + r * G_; FinalRows FR;
            if (u < NTOK / 128) final_norm_load(P, u, FR);
            xcd_barrier(bar);
            if (u < NTOK / 128) final_norm_store(P, u, FR);
        }
    }
    if (PROBE_MASK || PROBE_SEAMS) { const unsigned long long t0_ = __builtin_amdgcn_s_memrealtime(); while (__builtin_amdgcn_s_memrealtime() - t0_ < (unsigned long long)PROBE_MULT * pacc) __builtin_amdgcn_s_sleep(8); }
#undef IN
#undef SEAM
#undef H
#undef ZIN
#undef GB
#undef MB
#undef MLAQ
#undef MLAKV
#undef KPER
#undef cosT
#undef sinT
#undef slot_tok
#undef slot_gate
}

extern "C" void kernel_launch(void* const* d_in, const int* in_sizes, int n_in, void* d_out, int out_size, void* d_ws, size_t ws_size, hipStream_t stream) {
    static int grid = 0;
    if (grid == 0) {
        if (n_in != 37 || out_size != NTOK * D || ws_size < WS_END) { fprintf(stderr, "kernel_launch: unexpected shapes: n_in %d out %d ws %zu\n", n_in, out_size, ws_size); grid = -1; return; }
        int dev = 0, cus = 0, per_cu = 0;
        if (hipGetDevice(&dev) != hipSuccess || hipDeviceGetAttribute(&cus, hipDeviceAttributeMultiprocessorCount, dev) != hipSuccess) { grid = -1; return; }
        if (hipFuncSetAttribute((const void*)mega_fwd, hipFuncAttributeMaxDynamicSharedMemorySize, LDS_BYTES) != hipSuccess) { fprintf(stderr, "kernel_launch: hipFuncSetAttribute failed\n"); grid = -1; return; }
        if (hipOccupancyMaxActiveBlocksPerMultiprocessor(&per_cu, (const void*)mega_fwd, NTHREADS, LDS_BYTES) != hipSuccess || per_cu < 1)
            fprintf(stderr, "kernel_launch: note: occupancy query reports %d workgroups per CU\n", per_cu);
        (void)hipGetLastError();
        grid = cus;
        if (grid != 256) fprintf(stderr, "kernel_launch: note: %d CUs (built for 256)\n", grid);
    }
    if (grid < 0) return;
    if (hipMemsetAsync((char*)d_ws + WS_CTL, 0, CTL_ZERO_BYTES, stream) != hipSuccess) return;
    Params p{};
    for (int i = 0; i < 37; ++i) p.in[i] = (const float*)d_in[i];
    p.out = (float*)d_out; p.ws = (unsigned char*)d_ws;
#if N_LAUNCH_MODE == 1
    p.ph_lo = 0; p.ph_hi = N_PHASES;
    hipLaunchKernelGGL(mega_fwd, dim3(grid), dim3(NTHREADS), LDS_BYTES, stream, p);
#else
    for (int ph = 0; ph < N_PHASES; ++ph) { p.ph_lo = ph; p.ph_hi = ph + 1; hipLaunchKernelGGL(mega_fwd, dim3(grid), dim3(NTHREADS), LDS_BYTES, stream, p); }
#endif
    const hipError_t le = hipPeekAtLastError();
    if (le != hipSuccess) fprintf(stderr, "kernel_launch: launch failed: %s\n", hipGetErrorName(le));
}
```

```cpp
#include <hip/hip_runtime.h>
#include <cstdio>
#include <cstdint>

#define GAS __attribute__((address_space(1)))
#define LAS __attribute__((address_space(3)))
typedef unsigned short bf16;
typedef short bf16x8 __attribute__((ext_vector_type(8)));
typedef short s16x4 __attribute__((ext_vector_type(4)));
typedef float f32x2 __attribute__((ext_vector_type(2)));
typedef float f32x4 __attribute__((ext_vector_type(4)));
typedef float f32x16 __attribute__((ext_vector_type(16)));
typedef unsigned u32x2 __attribute__((ext_vector_type(2)));
typedef unsigned u32x4 __attribute__((ext_vector_type(4)));
typedef __bf16 bf16x2_t __attribute__((ext_vector_type(2)));

constexpr int NB = 4, SEQ = 8192, NTOK = NB * SEQ, D = 1024;
constexpr int ZP = 2304;
constexpr int ZC_U = 0, ZC_FQ = 256, ZC_FK = 512, ZC_FV = 768, ZC_DQ = 1024, ZC_DK = 1280, ZC_DV = 1536, ZC_CQ = 1792, ZC_CKV = 2048, ZC_KPE = 2176;
constexpr int DIN = 2148, DFF = 2816, DFFE = 1408, NE = 8;
constexpr int MOE_ROWS = 2 * NTOK + NE * 256;
constexpr float RMS_EPS = 1e-6f;
constexpr int NWAVES = 8, NTHREADS = 512;

constexpr size_t MiB = 1u << 20;
constexpr size_t WS_CTL = 0, CTL_ZERO_BYTES = 1 * MiB;
constexpr size_t WS_COS = 1 * MiB, WS_SIN = 3 * MiB;
constexpr size_t WS_LOGF = 5 * MiB;
constexpr size_t WS_CDEC = 5 * MiB + 512 * 1024;
constexpr size_t WS_WSUM = 6 * MiB;
constexpr size_t WS_RSTDQ = 6 * MiB + 256 * 1024, WS_RSTDKV = 6 * MiB + 512 * 1024;
constexpr size_t WS_SC = 7 * MiB;
constexpr size_t WS_TOKINFO = 11 * MiB;
constexpr size_t WS_SLOTTOK = 12 * MiB, WS_SLOTGATE = 12 * MiB + 512 * 1024;
constexpr size_t WS_S5W = 13 * MiB;
constexpr size_t WS_PBF = 17 * MiB;
constexpr size_t WS_WMIX = 49 * MiB, WMIX_STRIDE = 20 * MiB;
constexpr size_t WM_IN = 0, WM_G = 4 * MiB + 512 * 1024, WM_B = 12 * MiB + 512 * 1024, WM_O = 14 * MiB + 512 * 1024, WM_PG = 16 * MiB + 512 * 1024,
                 WM_UP = 18 * MiB + 512 * 1024, WM_UQ = 19 * MiB, WM_UKV = 19 * MiB + 256 * 1024, WM_GLU = 19 * MiB + 384 * 1024;
constexpr size_t WS_W13 = 89 * MiB, WS_W2 = 100 * MiB;
constexpr size_t WS_H = 106 * MiB;
constexpr size_t WS_MLAQ = 170 * MiB, WS_MLAKV = 202 * MiB, WS_KPER = 234 * MiB;
constexpr size_t WS_M = 170 * MiB;
constexpr size_t WS_ZIN = 236 * MiB;
constexpr size_t WS_G = 380 * MiB;
constexpr size_t WS_HMID = 236 * MiB;
constexpr size_t WS_U = 236 * MiB;
constexpr size_t WS_WM13 = 418 * MiB, WS_WM2 = 462 * MiB;
constexpr size_t WS_MOEY = 89 * MiB;
constexpr size_t WS_SSQ = 7 * MiB;
constexpr size_t WS_H2 = 300 * MiB;
constexpr size_t WS_END = 484 * MiB;
constexpr int CW_BAR = 4096;
constexpr int CW_MOECNT = 16384;
constexpr int CW_QMAX = 20480;
constexpr int CW_KMAX = 22528;

#define LDS_WAIT() asm volatile("s_waitcnt lgkmcnt(0)" ::: "memory")
#define VM_WAIT() asm volatile("s_waitcnt vmcnt(0)" ::: "memory")
__device__ __forceinline__ unsigned f2bf(float f) { unsigned u = __builtin_bit_cast(unsigned, f); return (u + 0x7fffu + ((u >> 16) & 1u)) >> 16; }
__device__ __forceinline__ unsigned pk2(float lo, float hi) { f32x2 v = {lo, hi}; bf16x2_t b = __builtin_convertvector(v, bf16x2_t); return __builtin_bit_cast(unsigned, b); }
__device__ __forceinline__ float bf2f(unsigned short b) { return __uint_as_float((unsigned)b << 16); }
__device__ __forceinline__ float bflo(unsigned w) { return __uint_as_float(w << 16); }
__device__ __forceinline__ float bfhi(unsigned w) { return __uint_as_float(w & 0xffff0000u); }
constexpr int TID_TAB_OFF = 147456 - 512;
__device__ __forceinline__ unsigned hw_wave_key() { return (unsigned)__builtin_amdgcn_s_getreg((5 << 11) | 4) & 0x3Fu; }
__device__ __forceinline__ int my_tid() {
    unsigned addr = (unsigned)TID_TAB_OFF + 4u * hw_wave_key(); asm volatile("" : "+s"(addr));
    const int wave = __builtin_amdgcn_readfirstlane(*(const LAS int*)(uintptr_t)addr);
    int lane = (int)__builtin_amdgcn_mbcnt_hi(~0u, __builtin_amdgcn_mbcnt_lo(~0u, 0u)); asm volatile("" : "+v"(lane));
    return wave * 64 + lane;
}
__device__ __forceinline__ float shflx(float v, int o, int lane) { return __int_as_float(__builtin_amdgcn_ds_bpermute((lane ^ o) << 2, __float_as_int(v))); }
#define DPP_F(x_, ctrl_, rm_) __int_as_float(__builtin_amdgcn_update_dpp(0, __float_as_int(x_), (ctrl_), (rm_), 0xF, true))
__device__ __forceinline__ float wave_sum(float v) {
    v += DPP_F(v, 0xB1, 0xF); v += DPP_F(v, 0x4E, 0xF); v += DPP_F(v, 0x114, 0xF); v += DPP_F(v, 0x118, 0xF);
    v += DPP_F(v, 0x142, 0xA); v += DPP_F(v, 0x143, 0xC);
    return __int_as_float(__builtin_amdgcn_readlane(__float_as_int(v), 63));
}
__device__ __forceinline__ float sigmoidf_(float x) { return __builtin_amdgcn_rcpf(1.0f + __expf(-x)); }

struct XSrc { const float* f; const bf16* b; };
__device__ __forceinline__ f32x4 ldx4(const XSrc& x, size_t idx) {
    if (x.f) return *(const f32x4*)(x.f + idx);
    const u32x2 w = *(const u32x2*)(x.b + idx); return (f32x4){bflo(w.x), bfhi(w.x), bflo(w.y), bfhi(w.y)};
}
__device__ __forceinline__ bf16* xr_of(float* out) { return (bf16*)((unsigned char*)out + (size_t)NTOK * D * 2); }
#define BODY_IDS() int tid = my_tid(); asm volatile("" : "+v"(tid)); const int lane = tid & 63; const int wave = __builtin_amdgcn_readfirstlane(tid >> 6); \
    int grid_ = gridDim.x; asm volatile("" : "+s"(grid_)); \
    const int gw = blockIdx.x * NWAVES + wave, ngw = grid_ * NWAVES, gtid = blockIdx.x * NTHREADS + tid, gthreads = grid_ * NTHREADS; (void)lane; (void)wave; (void)gw; (void)ngw; (void)gtid; (void)gthreads
#define XB_TMO      128
#define XB_XCNT(j)  (256  + 64 * (j))
#define XB_XSUB(j)  (1280 + 64 * (j))
#define XB_XGEN(j)  (2304 + 64 * (j))
#define XB_TOP      3328
#define XB_TOPGEN   3392
#define XCD_BAR_WORDS 3456
#define XB_SPIN_CAP (1u << 22)

__device__ __forceinline__ unsigned xb_ld(unsigned* p)              { return __hip_atomic_load(p, __ATOMIC_RELAXED, __HIP_MEMORY_SCOPE_AGENT); }
__device__ __forceinline__ unsigned xb_add(unsigned* p, unsigned v) { return __hip_atomic_fetch_add(p, v, __ATOMIC_RELAXED, __HIP_MEMORY_SCOPE_AGENT); }
__device__ __forceinline__ unsigned xb_xcc_id() { return (unsigned)__builtin_amdgcn_s_getreg((3 << 11) | 20) & 0xFu; }
#define XB_SPIN(cond, bar) do { unsigned _sp = 0; while (cond) { __builtin_amdgcn_s_sleep(1); \
    if ((++_sp & 255u) == 0u) { if (xb_ld(&(bar)[XB_TMO])) break; if (_sp > XB_SPIN_CAP) { atomicAdd(&(bar)[XB_TMO], 1u); break; } } } } while (0)

struct XcdBarrier { unsigned* bar; unsigned x; volatile LAS unsigned* st; };

__device__ __forceinline__ XcdBarrier xcd_barrier_post(unsigned* bar, volatile LAS unsigned* st) {
    XcdBarrier b; b.bar = bar; b.x = xb_xcc_id(); b.st = st;
    if (my_tid() == 0) (void)xb_add(&bar[XB_XCNT(b.x)], 1u);
    return b;
}
__device__ __forceinline__ void xcd_barrier_complete(unsigned* bar, unsigned x, unsigned& nloc, unsigned& nx) {
    const unsigned G = gridDim.x * gridDim.y * gridDim.z;
    unsigned sum, cnt, mine, sp = 0u;
    for (;;) {
        sum = 0u; cnt = 0u; mine = 0u;
#pragma unroll
        for (unsigned j = 0; j < 16; ++j) { const unsigned c = xb_ld(&bar[XB_XCNT(j)]); sum += c; cnt += (c > 0u) ? 1u : 0u; mine = (j == x) ? c : mine; }
        if (sum == G) break;
        __builtin_amdgcn_s_sleep(1);
        if ((++sp & 255u) == 0u) { if (xb_ld(&bar[XB_TMO])) break; if (sp > XB_SPIN_CAP) { atomicAdd(&bar[XB_TMO], 1u); break; } }
    }
    nloc = mine > 0u ? mine : 1u; nx = cnt > 0u ? cnt : 1u;
}
__device__ __forceinline__ void xcd_barrier(const XcdBarrier& b) {
    asm volatile("s_waitcnt vmcnt(0)" ::: "memory");
    __syncthreads();
    if (my_tid() == 0) {
        unsigned* bar = b.bar;
        __builtin_amdgcn_s_waitcnt(0);
        unsigned nloc = b.st[0], nx = b.st[1];
        if (nloc == 0u) { xcd_barrier_complete(bar, b.x, nloc, nx); b.st[0] = nloc; b.st[1] = nx; }
        const unsigned old = xb_add(&bar[XB_XSUB(b.x)], 1u);
        const unsigned gen = old / nloc;
        if (old + 1u == (gen + 1u) * nloc) {
            __builtin_amdgcn_fence(__ATOMIC_RELEASE, "agent");
            asm volatile("s_waitcnt vmcnt(0)" ::: "memory");
            const unsigned og = xb_add(&bar[XB_TOP], 1u);
            const unsigned tg = og / nx;
            if (og + 1u == (tg + 1u) * nx) xb_add(&bar[XB_TOPGEN], 1u);
            else XB_SPIN(xb_ld(&bar[XB_TOPGEN]) == tg, bar);
            __builtin_amdgcn_fence(__ATOMIC_ACQUIRE, "agent");
            xb_add(&bar[XB_XGEN(b.x)], 1u);
            asm volatile("s_waitcnt vmcnt(0)" ::: "memory");
        } else {
            XB_SPIN(xb_ld(&bar[XB_XGEN(b.x)]) == gen, bar);
            __builtin_amdgcn_fence(__ATOMIC_ACQUIRE, "agent");
            asm volatile("s_waitcnt vmcnt(0)" ::: "memory");
        }
    }
    __syncthreads();
}
namespace pg8 {
constexpr int BM = 256, BK = 64, HALF = 128, HTB = HALF * BK * 2, STAGE_BYTES = 8 * HTB, NXCD = 8, WGM = 8;
__host__ __device__ __forceinline__ int lds_byte(int r, int c) { const int st = (r >> 4) * 2 + (c >> 5), rr = r & 15, cc = c & 31, ob = rr * 64 + cc * 2; return st * 1024 + (ob ^ (((ob >> 9) & 1) << 5)); }
__host__ __device__ __forceinline__ void stage_rc(int b, int& R, int& C) { const int st = b / 1024, sb = b % 1024, swz = sb ^ (((sb >> 9) & 1) << 5); R = (st >> 1) * 16 + swz / 64; C = (st & 1) * 32 + (swz % 64) / 2; }
__host__ __device__ __forceinline__ int perm32(int rho) { const int n = rho >> 4, i = rho & 15; return 8 * (i >> 2) + 4 * n + (i & 3); }

struct Unit { int pm, pn; };
struct Gemm { const bf16* A; const bf16* Bt; int lda, ldb, K; const int* gidx; };

struct StaticOrder {
    int nM, nN, nwg, G, c;
    __host__ __device__ void init(int M, int N, int G_, int c_) { nM = M / BM; nN = N / BM; nwg = nM * nN; G = G_; c = c_; }
    __host__ __device__ __forceinline__ bool next(int i, Unit& u) const {
        const long L = (long)i * G + c; if (L >= nwg) return false;
        int wgid = (int)L; { const int q = nwg / NXCD, r = nwg % NXCD, xcd = wgid % NXCD, off = wgid / NXCD; wgid = (xcd < r ? xcd * (q + 1) : r * (q + 1) + (xcd - r) * q) + off; }
        const int nig = WGM * nN, gid = wgid / nig, fm = gid * WGM, gsz = (nM - fm) < WGM ? (nM - fm) : WGM;
        u.pm = fm + ((wgid % nig) % gsz); u.pn = (wgid % nig) / gsz; return true;
    }
};

template <class Epi, class Sched, bool ALIGN_EPI, bool GATHER>
__device__ __forceinline__ void gemm_phase(LAS unsigned char* lds, const Gemm g, const Sched& S, const Epi& E) {
    int tid = my_tid(); asm volatile("" : "+v"(tid));
    const int wid = __builtin_amdgcn_readfirstlane(tid >> 6), lane = tid & 63, wr = wid >> 2, wc = wid & 3, fr = lane & 15, fq = lane >> 4;
    int Kq = g.K; asm volatile("" : "+s"(Kq));
    const int K = Kq, nt = K / BK;
    int RA[2], CA[2];
    unsigned voffA[2], voffB[2];
#pragma unroll
    for (int i = 0; i < 2; ++i) { int R, C; stage_rc(tid * 16 + i * 8192, R, C); const int Rb = Epi::PERM ? ((R & ~31) + perm32(R & 31)) : R;
        RA[i] = R; CA[i] = C; voffA[i] = (unsigned)(R * g.lda + C) * 2u; voffB[i] = (unsigned)(Rb * g.ldb + C) * 2u; }
    const size_t kstep = (size_t)(BK * 2);
    const size_t hstepB = (size_t)HALF * g.ldb * 2, tstepB = 2 * hstepB;
    const size_t hstepA = (size_t)HALF * g.lda * 2, tstepA = 2 * hstepA;
    const unsigned ldsw = (unsigned)wid * 1024u;
    const int aoff = lds_byte(wr * 64 + fr, fq * 8), boff = lds_byte(wc * 32 + fr, fq * 8);
#define PG8_SA(b, h) (((b) * 2 + (h)) * HTB)
#define PG8_SB(b, h) ((4 + (b) * 2 + (h)) * HTB)
#define PG8_STAGEB(bufoff, gbase) do { _Pragma("unroll") for (int _i = 0; _i < 2; ++_i) \
        __builtin_amdgcn_global_load_lds((const unsigned*)((const char*)(gbase) + voffB[_i]), (LAS unsigned*)(lds + (bufoff) + ldsw + _i * 8192), 16, 0, 0); } while (0)
#define PG8_STAGEA(bufoff, kptr, isnext, h) do { _Pragma("unroll") for (int _i = 0; _i < 2; ++_i) { const char* _p; \
        if constexpr (GATHER) _p = (const char*)(kptr) + ((isnext) ? nvo[h][_i] : cvo[h][_i]); else _p = (const char*)(kptr) + (size_t)(h) * hstepA + voffA[_i]; \
        __builtin_amdgcn_global_load_lds((const unsigned*)_p, (LAS unsigned*)(lds + (bufoff) + ldsw + _i * 8192), 16, 0, 0); } } while (0)
#define PG8_LDA(dst, b, h) do { _Pragma("unroll") for (int m = 0; m < 4; ++m) _Pragma("unroll") for (int k = 0; k < 2; ++k) dst[m][k] = *(const LAS bf16x8*)(lds + PG8_SA(b, h) + aoff + m * 2048 + k * 1024); } while (0)
#define PG8_LDB(dst, b, h) do { _Pragma("unroll") for (int n = 0; n < 2; ++n) _Pragma("unroll") for (int k = 0; k < 2; ++k) dst[n][k] = *(const LAS bf16x8*)(lds + PG8_SB(b, h) + boff + n * 2048 + k * 1024); } while (0)
#define PG8_MMA(ai, bj, At, Bt) do { __builtin_amdgcn_s_setprio(1); _Pragma("unroll") for (int m = 0; m < 4; ++m) _Pragma("unroll") for (int n = 0; n < 2; ++n) _Pragma("unroll") for (int k = 0; k < 2; ++k) \
        acc[ai][bj][m][n] = __builtin_amdgcn_mfma_f32_16x16x32_bf16(Bt[n][k], At[m][k], acc[ai][bj][m][n], 0, 0, 0); __builtin_amdgcn_s_setprio(0); } while (0)
#define PG8_WAIT_V(n) asm volatile("s_waitcnt vmcnt(" #n ")" ::: "memory")
#define PG8_WAIT_L(n) asm volatile("s_waitcnt lgkmcnt(" #n ")" ::: "memory")
#define PG8_BAR __builtin_amdgcn_s_barrier()
#define PG8_SCHED __builtin_amdgcn_sched_barrier(0)
#define PG8_VOA(vo, u) do { _Pragma("unroll") for (int _h = 0; _h < 2; ++_h) _Pragma("unroll") for (int _i = 0; _i < 2; ++_i) { \
        int _row = (u).pm * BM + _h * HALF + RA[_i]; if (GATHER) { _row = g.gidx[_row]; _row = _row < 0 ? 0 : _row; } \
        (vo)[_h][_i] = (unsigned)_row * (unsigned)(g.lda * 2) + (unsigned)(CA[_i] * 2); } } while (0)
    Unit cur, nxt; int ui = 0;
    if (!S.next(0, cur)) return;
    f32x4 acc[2][2][4][2];
#pragma unroll
    for (int a = 0; a < 2; ++a)
#pragma unroll
        for (int b = 0; b < 2; ++b)
#pragma unroll
            for (int m = 0; m < 4; ++m)
#pragma unroll
                for (int n = 0; n < 2; ++n) acc[a][b][m][n] = (f32x4){0.f, 0.f, 0.f, 0.f};
    bf16x8 At[4][2], B0[2][2], B1[2][2];
    unsigned cvo[2][2], nvo[2][2];
    if constexpr (GATHER) { PG8_VOA(cvo, cur); PG8_VOA(nvo, cur); }
    const char* cA = (const char*)g.A + (GATHER ? (size_t)0 : (size_t)cur.pm * tstepA); const char* cB = (const char*)g.Bt + (size_t)cur.pn * tstepB;
    PG8_STAGEB(PG8_SB(0, 0), cB); PG8_STAGEB(PG8_SB(0, 1), cB + hstepB); PG8_STAGEA(PG8_SA(0, 0), cA, false, 0); PG8_STAGEA(PG8_SA(0, 1), cA, false, 1);
    if (wr == 1) PG8_BAR;
    PG8_WAIT_V(2); PG8_BAR;
    PG8_STAGEB(PG8_SB(1, 0), cB + kstep); PG8_STAGEA(PG8_SA(1, 0), cA + kstep, false, 0); PG8_STAGEB(PG8_SB(1, 1), cB + hstepB + kstep);
    PG8_WAIT_V(6); PG8_BAR;
    for (;;) {
        const bool has_next = S.next(ui + 1, nxt);
        if constexpr (GATHER) { if (has_next) { PG8_VOA(nvo, nxt); } }
        const char* nA = (GATHER || !has_next) ? cA : (const char*)g.A + (size_t)nxt.pm * tstepA;
        const char* nB = has_next ? (const char*)g.Bt + (size_t)nxt.pn * tstepB : cB;
#pragma nounroll
        for (int t = 0; t < nt; t += 2) {
            const bool last = (t == nt - 2);
            const char* a1 = cA + (size_t)(t + 1) * kstep;
            const char* a2 = last ? nA : cA + (size_t)(t + 2) * kstep; const char* b2 = last ? nB : cB + (size_t)(t + 2) * kstep;
            const char* a3 = a2 + kstep; const char* b3 = b2 + kstep;
            PG8_LDB(B0, 0, 0); PG8_LDB(B1, 0, 1); PG8_SCHED; PG8_LDA(At, 0, 0); PG8_STAGEA(PG8_SA(1, 1), a1, false, 1);
            PG8_WAIT_V(8); PG8_WAIT_L(0); PG8_BAR; PG8_MMA(0, 0, At, B0); PG8_MMA(0, 1, At, B1); PG8_BAR; PG8_SCHED;
            PG8_LDA(At, 0, 1); PG8_STAGEB(PG8_SB(0, 0), b2); PG8_STAGEB(PG8_SB(0, 1), b2 + hstepB); PG8_STAGEA(PG8_SA(0, 0), a2, last, 0);
            PG8_WAIT_V(8); PG8_WAIT_L(0); PG8_BAR; PG8_MMA(1, 0, At, B0); PG8_MMA(1, 1, At, B1); PG8_BAR; PG8_SCHED;
            PG8_LDB(B0, 1, 0); PG8_LDB(B1, 1, 1); PG8_SCHED; PG8_LDA(At, 1, 0); PG8_STAGEA(PG8_SA(0, 1), a2, last, 1);
            PG8_WAIT_V(8); PG8_WAIT_L(0); PG8_BAR; PG8_MMA(0, 0, At, B0); PG8_MMA(0, 1, At, B1); PG8_BAR; PG8_SCHED;
            PG8_LDA(At, 1, 1); PG8_STAGEB(PG8_SB(1, 0), b3); PG8_STAGEB(PG8_SB(1, 1), b3 + hstepB); PG8_STAGEA(PG8_SA(1, 0), a3, last, 0);
            PG8_WAIT_V(8); PG8_WAIT_L(0); PG8_BAR; PG8_MMA(1, 0, At, B0); PG8_MMA(1, 1, At, B1); PG8_BAR; PG8_SCHED;
        }
        if constexpr (ALIGN_EPI) { if (wr == 0) PG8_BAR; }
        E(acc, cur, wr, wc, fr, fq);
        if (!has_next) break;
#pragma unroll
        for (int a = 0; a < 2; ++a)
#pragma unroll
            for (int b = 0; b < 2; ++b)
#pragma unroll
                for (int m = 0; m < 4; ++m)
#pragma unroll
                    for (int n = 0; n < 2; ++n) acc[a][b][m][n] = (f32x4){0.f, 0.f, 0.f, 0.f};
        cur = nxt; cA = nA; cB = nB; ++ui;
        if constexpr (GATHER) {
#pragma unroll
            for (int _h = 0; _h < 2; ++_h)
#pragma unroll
                for (int _i = 0; _i < 2; ++_i) cvo[_h][_i] = nvo[_h][_i]; }
        if constexpr (ALIGN_EPI) { if (wr == 1) PG8_BAR; }
    }
    PG8_WAIT_V(0);
    if constexpr (!ALIGN_EPI) { if (wr == 0) PG8_BAR; }
    PG8_BAR;
#undef PG8_SA
#undef PG8_SB
#undef PG8_STAGEA
#undef PG8_STAGEB
#undef PG8_LDA
#undef PG8_LDB
#undef PG8_MMA
#undef PG8_WAIT_V
#undef PG8_WAIT_L
#undef PG8_BAR
#undef PG8_SCHED
#undef PG8_VOA
}

template <class Epi, class Sched, bool GATHER>
__device__ __forceinline__ void gemm_phase_naive(const Gemm g, const Sched& S, const Epi& E) {
    const int tid = threadIdx.x, wid = tid >> 6, lane = tid & 63, wr = wid >> 2, wc = wid & 3, fr = lane & 15, fq = lane >> 4;
    Unit u;
    for (int ui = 0; S.next(ui, u); ++ui) {
        f32x4 acc[2][2][4][2];
#pragma unroll
        for (int a = 0; a < 2; ++a)
#pragma unroll
            for (int b = 0; b < 2; ++b)
#pragma unroll
                for (int m = 0; m < 4; ++m)
#pragma unroll
                    for (int n = 0; n < 2; ++n) acc[a][b][m][n] = (f32x4){0.f, 0.f, 0.f, 0.f};
        const bf16* arow[2][4];
#pragma unroll
        for (int ai = 0; ai < 2; ++ai)
#pragma unroll
            for (int m = 0; m < 4; ++m) { int r = u.pm * BM + ai * HALF + wr * 64 + m * 16 + fr; if (GATHER) { r = g.gidx[r]; r = r < 0 ? 0 : r; } arow[ai][m] = g.A + (size_t)r * g.lda; }
        for (int k = 0; k < g.K; k += 4) {
            float av[2][4][4];
#pragma unroll
            for (int ai = 0; ai < 2; ++ai)
#pragma unroll
                for (int m = 0; m < 4; ++m) { const u32x2 w = *(const u32x2*)(arow[ai][m] + k); av[ai][m][0] = bflo(w.x); av[ai][m][1] = bfhi(w.x); av[ai][m][2] = bflo(w.y); av[ai][m][3] = bfhi(w.y); }
#pragma unroll
            for (int bj = 0; bj < 2; ++bj)
#pragma unroll
                for (int n = 0; n < 2; ++n)
#pragma unroll
                    for (int e = 0; e < 4; ++e) {
                        const int col = u.pn * BM + bj * HALF + wc * 32 + (Epi::PERM ? (8 * fq + 4 * n) : (16 * n + 4 * fq)) + e;
                        const u32x2 w = *(const u32x2*)(g.Bt + (size_t)col * g.ldb + k);
                        const float b0 = bflo(w.x), b1 = bfhi(w.x), b2 = bflo(w.y), b3 = bfhi(w.y);
#pragma unroll
                        for (int ai = 0; ai < 2; ++ai)
#pragma unroll
                            for (int m = 0; m < 4; ++m) acc[ai][bj][m][n][e] += av[ai][m][0] * b0 + av[ai][m][1] * b1 + av[ai][m][2] * b2 + av[ai][m][3] * b3;
                    }
        }
        E(acc, u, wr, wc, fr, fq);
    }
    VM_WAIT(); __syncthreads();
}
}
namespace g128 {
using pg8::lds_byte; using pg8::stage_rc; using pg8::HTB; using pg8::BK;
struct Seg { const bf16* A; const bf16* B; int lda, ldb, nt; };
typedef f32x4 acc_t[2][4][2];

template <class Prog>
__device__ __forceinline__ void stream(LAS unsigned char* lds, Prog& P, int nunits, int first, int stride) {
    int tid = my_tid(); asm volatile("" : "+v"(tid));
    const int wid = __builtin_amdgcn_readfirstlane(tid >> 6), lane = tid & 63, wr = wid >> 2, wc = wid & 3, fr = lane & 15, fq = lane >> 4;
    int RA[2], CA[2], RB[2];
#pragma unroll
    for (int i = 0; i < 2; ++i) { stage_rc(tid * 16 + i * 8192, RA[i], CA[i]); RB[i] = (RA[i] & ~31) + pg8::perm32(RA[i] & 31); }
    const unsigned ldsw = (unsigned)wid * 1024u;
    const int aoff = lds_byte(wr * 64 + fr, fq * 8), boff = lds_byte(wc * 32 + fr, fq * 8);
#define G_SA(b) ((b) * HTB)
#define G_SB(b, h) ((2 + (b) * 2 + (h)) * HTB)
#define G_STAGE(bufoff, base, ld, kbyte, RR) do { _Pragma("unroll") for (int _i = 0; _i < 2; ++_i) \
        __builtin_amdgcn_global_load_lds((const unsigned*)((const char*)(base) + (size_t)(kbyte) + (unsigned)(RR[_i] * (ld) + CA[_i]) * 2u), (LAS unsigned*)(lds + (bufoff) + ldsw + _i * 8192), 16, 0, 0); } while (0)
#define G_STAGE_A(b, S, j) G_STAGE(G_SA(b), (S).A, (S).lda, (j) * 128, RA)
#define G_STAGE_B(b, h, S, j) G_STAGE(G_SB(b, h), (const char*)(S).B + (size_t)(h) * 128 * (S).ldb * 2, (S).ldb, (j) * 128, RB)
#define G_LDA(dst, b) do { _Pragma("unroll") for (int m = 0; m < 4; ++m) _Pragma("unroll") for (int k = 0; k < 2; ++k) dst[m][k] = *(const LAS bf16x8*)(lds + G_SA(b) + aoff + m * 2048 + k * 1024); } while (0)
#define G_LDB(dst, b, h) do { _Pragma("unroll") for (int n = 0; n < 2; ++n) _Pragma("unroll") for (int k = 0; k < 2; ++k) dst[n][k] = *(const LAS bf16x8*)(lds + G_SB(b, h) + boff + n * 2048 + k * 1024); } while (0)
#define G_MMA(bj, At, Bt) do { __builtin_amdgcn_s_setprio(1); _Pragma("unroll") for (int m = 0; m < 4; ++m) _Pragma("unroll") for (int n = 0; n < 2; ++n) _Pragma("unroll") for (int k = 0; k < 2; ++k) \
        acc[bj][m][n] = __builtin_amdgcn_mfma_f32_16x16x32_bf16(Bt[n][k], At[m][k], acc[bj][m][n], 0, 0, 0); __builtin_amdgcn_s_setprio(0); } while (0)
#define G_WAIT_V(n) asm volatile("s_waitcnt vmcnt(" #n ")" ::: "memory")
#define G_WAIT_L(n) asm volatile("s_waitcnt lgkmcnt(" #n ")" ::: "memory")
#define G_BAR __builtin_amdgcn_s_barrier()
#define G_SCHED __builtin_amdgcn_sched_barrier(0)
    if (first >= nunits) return;
    P.reset();
    int ucur = first, scur = 0;
    Seg cur, nxt;
    P.seg(ucur, scur, cur);
    acc_t acc;
    P.init(ucur, scur, acc, wr, wc, fr, fq);
    bf16x8 At[4][2], B0[2][2], B1[2][2];
    G_STAGE_B(0, 0, cur, 0); G_STAGE_A(0, cur, 0); G_STAGE_B(0, 1, cur, 0);
    if (wr == 1) G_BAR;
    G_WAIT_V(2); G_BAR;
    G_STAGE_A(1, cur, 1); G_STAGE_B(1, 0, cur, 1);
    G_WAIT_V(4); G_BAR;
#define G_TILE(t_, b_) do { const bool n1_ = ((t_) + 1 >= nt), n2_ = ((t_) + 2 >= nt); const int j1_ = n1_ ? ((t_) + 1 - nt) : ((t_) + 1), j2_ = n2_ ? ((t_) + 2 - nt) : ((t_) + 2); \
        G_LDB(B0, b_, 0); G_SCHED; G_LDA(At, b_); \
        if (n1_) G_STAGE_B((b_) ^ 1, 1, nxt, j1_); else G_STAGE_B((b_) ^ 1, 1, cur, j1_); \
        G_WAIT_V(6); G_WAIT_L(0); G_BAR; G_MMA(0, At, B0); G_BAR; G_SCHED; \
        G_LDB(B1, b_, 1); \
        if (n2_) { G_STAGE_A(b_, nxt, j2_); G_STAGE_B(b_, 0, nxt, j2_); } else { G_STAGE_A(b_, cur, j2_); G_STAGE_B(b_, 0, cur, j2_); } \
        G_WAIT_V(6); G_WAIT_L(0); G_BAR; G_MMA(1, At, B1); G_BAR; G_SCHED; } while (0)
    for (;;) {
        int unxt = ucur, snxt = scur + 1; bool more = true;
        if (snxt == Prog::NSEG) { snxt = 0; unxt = ucur + stride; if (unxt >= nunits) { more = false; unxt = ucur; snxt = scur; } }
        P.seg(unxt, snxt, nxt);
        int ntq = cur.nt; asm volatile("" : "+s"(ntq)); const int nt = ntq;
#pragma nounroll
        for (int t = 0; t < nt; t += 2) { G_TILE(t, 0); G_TILE(t + 1, 1); }
        P.done(ucur, scur, acc, wr, wc, fr, fq);
        if (!more) break;
        P.init(unxt, snxt, acc, wr, wc, fr, fq);
        ucur = unxt; scur = snxt; cur = nxt;
    }
    G_WAIT_V(0);
    if (wr == 0) G_BAR;
    G_BAR;
#undef G_SA
#undef G_SB
#undef G_STAGE
#undef G_STAGE_A
#undef G_STAGE_B
#undef G_LDA
#undef G_LDB
#undef G_MMA
#undef G_WAIT_V
#undef G_WAIT_L
#undef G_BAR
#undef G_SCHED
#undef G_TILE
}

struct MergeProg {
    static constexpr int NSEG = 8;
    const bf16* Hn; const bf16* zin; const bf16* wg; const bf16* wb; const float* bg; bf16* M;
    __device__ __forceinline__ void reset() {
#pragma unroll
        for (int a = 0; a < 2; ++a)
#pragma unroll
            for (int b = 0; b < 4; ++b)
#pragma unroll
                for (int c = 0; c < 2; ++c) { g[a][b][c] = (u32x2){0u, 0u}; macc[a][b][c] = (u32x2){0u, 0u}; } }
    u32x2 g[2][4][2]; u32x2 macc[2][4][2];
    __device__ __forceinline__ void seg(int u, int s, Seg& S) const {
        const int pm = u >> 2, pn = u & 3, k = s >> 1;
        if ((s & 1) == 0) { S.A = Hn + (size_t)pm * 128 * D; S.lda = D; S.B = wg + ((size_t)k * D + pn * 256) * D; S.ldb = D; S.nt = D / 64; }
        else { const int ycol = (k == 0) ? ZC_U : (k == 1) ? ZC_FQ : (k == 2) ? ZC_CQ : ZC_DQ;
               S.A = zin + (size_t)pm * 128 * ZP + ycol; S.lda = ZP; S.B = wb + ((size_t)k * D + pn * 256) * 256; S.ldb = 256; S.nt = 4; }
    }
    __device__ __forceinline__ void init(int u, int s, acc_t& acc, int wr, int wc, int fr, int fq) {
        const int pn = u & 3, k = s >> 1;
        if ((s & 1) == 0) {
#pragma unroll
            for (int bj = 0; bj < 2; ++bj)
#pragma unroll
                for (int n = 0; n < 2; ++n) { const f32x4 bv = *(const f32x4*)(bg + (size_t)k * D + pn * 256 + bj * 128 + wc * 32 + 8 * fq + 4 * n);
#pragma unroll
                    for (int m = 0; m < 4; ++m) acc[bj][m][n] = bv; }
            if (s == 0) {
#pragma unroll
                for (int bj = 0; bj < 2; ++bj)
#pragma unroll
                    for (int m = 0; m < 4; ++m)
#pragma unroll
                        for (int n = 0; n < 2; ++n) macc[bj][m][n] = (u32x2){0u, 0u}; }
        } else {
#pragma unroll
            for (int bj = 0; bj < 2; ++bj)
#pragma unroll
                for (int m = 0; m < 4; ++m)
#pragma unroll
                    for (int n = 0; n < 2; ++n) acc[bj][m][n] = (f32x4){0.f, 0.f, 0.f, 0.f};
        }
    }
    __device__ __forceinline__ void done(int u, int s, const acc_t& acc, int wr, int wc, int fr, int fq) {
        if ((s & 1) == 0) {
#pragma unroll
            for (int bj = 0; bj < 2; ++bj)
#pragma unroll
                for (int m = 0; m < 4; ++m)
#pragma unroll
                    for (int n = 0; n < 2; ++n) { const f32x4 a = acc[bj][m][n]; u32x2 w; w.x = pk2(sigmoidf_(a[0]), sigmoidf_(a[1])); w.y = pk2(sigmoidf_(a[2]), sigmoidf_(a[3])); g[bj][m][n] = w; }
        } else {
#pragma unroll
            for (int bj = 0; bj < 2; ++bj)
#pragma unroll
                for (int m = 0; m < 4; ++m)
#pragma unroll
                    for (int n = 0; n < 2; ++n) { const u32x2 w = g[bj][m][n], q = macc[bj][m][n]; const f32x4 v = (f32x4){bflo(q.x), bfhi(q.x), bflo(q.y), bfhi(q.y)} + (f32x4){bflo(w.x), bfhi(w.x), bflo(w.y), bfhi(w.y)} * acc[bj][m][n];
                        u32x2 r; r.x = pk2(v[0], v[1]); r.y = pk2(v[2], v[3]); macc[bj][m][n] = r; }
            if (s == NSEG - 1) { const int pm = u >> 2, pn = u & 3;
#pragma unroll
                for (int m = 0; m < 4; ++m) { bf16* rp = M + (size_t)(pm * 128 + wr * 64 + m * 16 + fr) * D + pn * 256 + wc * 32 + 8 * fq;
#pragma unroll
                    for (int bj = 0; bj < 2; ++bj) *(u32x4*)(rp + bj * 128) = (u32x4){macc[bj][m][0].x, macc[bj][m][0].y, macc[bj][m][1].x, macc[bj][m][1].y}; } }
        }
    }
};

struct PleProg {
    static constexpr int NSEG = 8;
    const bf16* pbf; const bf16* hp; const bf16* wup; const bf16* wpg; const bf16* xin; bf16* xout;
    const float* rsv;
    const float* ssq;
    u32x2 uu[2][4][2]; float rs[4];
    __device__ __forceinline__ void reset() {
#pragma unroll
        for (int m = 0; m < 4; ++m) rs[m] = 1.0f;
#pragma unroll
        for (int a = 0; a < 2; ++a)
#pragma unroll
            for (int b = 0; b < 4; ++b)
#pragma unroll
                for (int c = 0; c < 2; ++c) uu[a][b][c] = (u32x2){0u, 0u}; }
    __device__ __forceinline__ void seg(int u, int s, Seg& S) const {
        const int pn = s >> 1;
        if ((s & 1) == 0) { S.A = pbf + (size_t)u * 128 * 256; S.lda = 256; S.B = wup + (size_t)pn * 256 * 256; S.ldb = 256; S.nt = 4; }
        else { S.A = hp + (size_t)u * 128 * D; S.lda = D; S.B = wpg + (size_t)pn * 256 * D; S.ldb = D; S.nt = D / 64; }
    }
    __device__ __forceinline__ void init(int u, int s, acc_t& acc, int wr, int wc, int fr, int fq) {
#pragma unroll
        for (int bj = 0; bj < 2; ++bj)
#pragma unroll
            for (int m = 0; m < 4; ++m)
#pragma unroll
                for (int n = 0; n < 2; ++n) acc[bj][m][n] = (f32x4){0.f, 0.f, 0.f, 0.f};
        if (s == 0 && rsv) {
#pragma unroll
            for (int m = 0; m < 4; ++m) rs[m] = rsv[u * 128 + wr * 64 + m * 16 + fr]; }
        if (s == 0 && ssq) {
#pragma unroll
            for (int m = 0; m < 4; ++m) { const f32x4* rp = (const f32x4*)ssq + (size_t)(u * 128 + wr * 64 + m * 16 + fr) * 4; const f32x4 s0 = rp[0], s1 = rp[1], s2 = rp[2], s3 = rp[3];
                const float tot = (((s0[0] + s0[1]) + (s0[2] + s0[3])) + ((s1[0] + s1[1]) + (s1[2] + s1[3]))) + (((s2[0] + s2[1]) + (s2[2] + s2[3])) + ((s3[0] + s3[1]) + (s3[2] + s3[3])));
                rs[m] = __builtin_amdgcn_rsqf(tot * (1.0f / D) + RMS_EPS); } }
    }
    __device__ __forceinline__ void done(int u, int s, const acc_t& acc, int wr, int wc, int fr, int fq) {
        if ((s & 1) == 0) {
#pragma unroll
            for (int bj = 0; bj < 2; ++bj)
#pragma unroll
                for (int m = 0; m < 4; ++m)
#pragma unroll
                    for (int n = 0; n < 2; ++n) { const f32x4 a = acc[bj][m][n]; u32x2 w; w.x = pk2(a[0], a[1]); w.y = pk2(a[2], a[3]); uu[bj][m][n] = w; }
        } else { const int pn = s >> 1;
#pragma unroll
            for (int m = 0; m < 4; ++m) { const size_t ro = (size_t)(u * 128 + wr * 64 + m * 16 + fr) * D + pn * 256 + wc * 32 + 8 * fq; const bf16* rpi = xin + ro; bf16* rp = xout + ro; u32x4 xv[2]; const float rsm = rs[m];
#pragma unroll
                for (int bj = 0; bj < 2; ++bj) xv[bj] = *(const u32x4*)(rpi + bj * 128);
#pragma unroll
                for (int bj = 0; bj < 2; ++bj) { const u32x4 xw = xv[bj]; f32x4 r[2];
#pragma unroll
                    for (int n = 0; n < 2; ++n) { const u32x2 w = uu[bj][m][n]; f32x4 v = acc[bj][m][n] * rsm;
                        v[0] = sigmoidf_(v[0]); v[1] = sigmoidf_(v[1]); v[2] = sigmoidf_(v[2]); v[3] = sigmoidf_(v[3]);
                        const f32x4 xo = n == 0 ? (f32x4){bflo(xw.x), bfhi(xw.x), bflo(xw.y), bfhi(xw.y)} : (f32x4){bflo(xw.z), bfhi(xw.z), bflo(xw.w), bfhi(xw.w)};
                        r[n] = xo + (f32x4){bflo(w.x), bfhi(w.x), bflo(w.y), bfhi(w.y)} * v; }
                    *(u32x4*)(rp + bj * 128) = (u32x4){pk2(r[0][0], r[0][1]), pk2(r[0][2], r[0][3]), pk2(r[1][0], r[1][1]), pk2(r[1][2], r[1][3])}; } } }
    }
};
}
namespace epi {
using pg8::Unit; using pg8::BM; using pg8::HALF;
__device__ __forceinline__ void epi_fence() { asm volatile("" ::: "memory"); }
#define EPI_FENCE epi_fence()
#define EPI_LOOP_ROWS for (int ai = 0; ai < 2; ++ai) _Pragma("unroll") for (int m = 0; m < 4; ++m)
#define EPI_LOOP_COLS for (int bj = 0; bj < 2; ++bj) _Pragma("unroll") for (int n = 0; n < 2; ++n)
#define EPI_ROW (u.pm * BM + ai * HALF + wr * 64 + m * 16 + fr)
#define EPI_COLT (bj * HALF + wc * 32 + n * 16 + 4 * fq)
typedef f32x4 acc_t[2][2][4][2];
#define EPI_C8(bj_) ((bj_) * HALF + wc * 32 + 8 * fq)
__device__ __forceinline__ u32x4 pack8(f32x4 a, f32x4 b) { return (u32x4){pk2(a[0], a[1]), pk2(a[2], a[3]), pk2(b[0], b[1]), pk2(b[2], b[3])}; }
__device__ __forceinline__ u32x2 pack4(f32x4 v) { u32x2 w; w.x = pk2(v[0], v[1]); w.y = pk2(v[2], v[3]); return w; }
__device__ __forceinline__ f32x4 unpack4(u32x2 w) { return (f32x4){bflo(w.x), bfhi(w.x), bflo(w.y), bfhi(w.y)}; }

struct EpiStore {
    static constexpr bool PERM = true;
    bf16* O; int ldc; int pn0;
    __device__ __forceinline__ void operator()(const acc_t& acc, const Unit& u, int wr, int wc, int fr, int fq) const {
#pragma unroll
        EPI_LOOP_ROWS { bf16* rp = O + (size_t)EPI_ROW * ldc + (u.pn - pn0) * BM + wc * 32 + 8 * fq;
#pragma unroll
            for (int bj = 0; bj < 2; ++bj) { const u32x2 lo = pack4(acc[ai][bj][m][0]), hi = pack4(acc[ai][bj][m][1]); *(u32x4*)(rp + bj * HALF) = (u32x4){lo.x, lo.y, hi.x, hi.y}; } }
    }
};
struct EpiRowScale {
    static constexpr bool PERM = true;
    bf16* O; int ldc; const float* rs;
    __device__ __forceinline__ void operator()(const acc_t& acc, const Unit& u, int wr, int wc, int fr, int fq) const {
        float sv[2][4];
#pragma unroll
        EPI_LOOP_ROWS sv[ai][m] = rs[EPI_ROW];
#pragma unroll
        EPI_LOOP_ROWS { const int row = EPI_ROW; const float s = sv[ai][m]; bf16* rp = O + (size_t)row * ldc + u.pn * BM;
#pragma unroll
            for (int bj = 0; bj < 2; ++bj) *(u32x4*)(rp + EPI_C8(bj)) = pack8(acc[ai][bj][m][0] * s, acc[ai][bj][m][1] * s); }
    }
};
struct EpiMlaQ {
    static constexpr bool PERM = false;
    bf16* O; const float* rs; const float* cosT; const float* sinT;
    __device__ __forceinline__ void operator()(const acc_t& acc, const Unit& u, int wr, int wc, int fr, int fq) const {
        float sv[2][4]; f32x4 csv[2], snv[2];
#pragma unroll
        EPI_LOOP_ROWS sv[ai][m] = rs[EPI_ROW];
        { const int row = u.pm * BM + wr * 64 + fr; csv[0] = *(const f32x4*)(cosT + (size_t)row * 16 + 4 * fq); snv[0] = *(const f32x4*)(sinT + (size_t)row * 16 + 4 * fq); }
#pragma unroll
        for (int it = 0; it < 8; ++it) { const int ai = it >> 2, m = it & 3;
            if (it + 1 < 8) { const int row = u.pm * BM + ((it + 1) >> 2) * HALF + wr * 64 + ((it + 1) & 3) * 16 + fr;
                csv[(it + 1) & 1] = *(const f32x4*)(cosT + (size_t)row * 16 + 4 * fq); snv[(it + 1) & 1] = *(const f32x4*)(sinT + (size_t)row * 16 + 4 * fq); }
            const int row = EPI_ROW; const float s = sv[ai][m]; bf16* rp = O + (size_t)row * 512 + u.pn * BM;
            const f32x4 cs = csv[it & 1], sn = snv[it & 1];
#pragma unroll
            for (int bj = 0; bj < 2; ++bj) { const int grp = u.pn * 8 + bj * 4 + wc;
                f32x4 t1 = acc[ai][bj][m][0] * s, t2 = acc[ai][bj][m][1] * s;
                if (grp % 3 == 2) { const f32x4 a = t1 * cs - t2 * sn, b = t2 * cs + t1 * sn; t1 = a; t2 = b; }
                *(u32x2*)(rp + bj * HALF + wc * 32 + 4 * fq) = pack4(t1); *(u32x2*)(rp + bj * HALF + wc * 32 + 16 + 4 * fq) = pack4(t2); } }
    }
};
struct EpiGate {
    static constexpr bool PERM = false;
    bf16* G; const float* bias;
    __device__ __forceinline__ void operator()(const acc_t& acc, const Unit& u, int wr, int wc, int fr, int fq) const {
        f32x4 bv[2][2];
#pragma unroll
        EPI_LOOP_COLS bv[bj][n] = *(const f32x4*)(bias + u.pn * BM + EPI_COLT);
#pragma unroll
        EPI_LOOP_ROWS { bf16* rp = G + (size_t)EPI_ROW * D + u.pn * BM;
#pragma unroll
            EPI_LOOP_COLS { f32x4 v = acc[ai][bj][m][n] + bv[bj][n];
                v[0] = sigmoidf_(v[0]); v[1] = sigmoidf_(v[1]); v[2] = sigmoidf_(v[2]); v[3] = sigmoidf_(v[3]);
                *(u32x2*)(rp + EPI_COLT) = pack4(v); } }
    }
};
#define EPI_IT_ROW(it_) (u.pm * BM + ((it_) >> 2) * HALF + wr * 64 + ((it_) & 3) * 16 + fr)
#define EPI_C4(c_) (((c_) >> 1) * HALF + wc * 32 + ((c_) & 1) * 16 + 4 * fq)
struct EpiMerge {
    static constexpr bool PERM = false;
    const bf16* G; bf16* M; int first;
    __device__ __forceinline__ void operator()(const acc_t& acc, const Unit& u, int wr, int wc, int fr, int fq) const {
        u32x2 gv[2][4], mv[2][4];
#define EPI_LD(it_) do { const size_t ro_ = (size_t)EPI_IT_ROW(it_) * D + u.pn * BM; _Pragma("unroll") for (int c = 0; c < 4; ++c) { gv[(it_) & 1][c] = *(const u32x2*)(G + ro_ + EPI_C4(c)); \
            mv[(it_) & 1][c] = first ? (u32x2){0u, 0u} : *(const u32x2*)(M + ro_ + EPI_C4(c)); } } while (0)
        EPI_LD(0);
#pragma unroll
        for (int it = 0; it < 8; ++it) { if (it + 1 < 8) EPI_LD(it + 1);
            const size_t ro = (size_t)EPI_IT_ROW(it) * D + u.pn * BM;
#pragma unroll
            for (int c = 0; c < 4; ++c) { const f32x4 v = unpack4(gv[it & 1][c]) * acc[it >> 2][c >> 1][it & 3][c & 1] + unpack4(mv[it & 1][c]); *(u32x2*)(M + ro + EPI_C4(c)) = pack4(v); } }
#undef EPI_LD
    }
};
struct EpiRes {
    static constexpr bool PERM = true;
    XSrc xin; bf16* xout;
    float* ssq;
    __device__ __forceinline__ void operator()(const acc_t& acc, const Unit& u, int wr, int wc, int fr, int fq) const {
        f32x4 xv[2][2][2];
#define EPI_LD(it_) do { const size_t ro_ = (size_t)EPI_IT_ROW(it_) * D + u.pn * BM; _Pragma("unroll") for (int bj = 0; bj < 2; ++bj) { \
            if (xin.f) { xv[(it_) & 1][bj][0] = *(const f32x4*)(xin.f + ro_ + EPI_C8(bj)); xv[(it_) & 1][bj][1] = *(const f32x4*)(xin.f + ro_ + EPI_C8(bj) + 4); } \
            else { const u32x4 w_ = *(const u32x4*)(xin.b + ro_ + EPI_C8(bj)); xv[(it_) & 1][bj][0] = (f32x4){bflo(w_.x), bfhi(w_.x), bflo(w_.y), bfhi(w_.y)}; xv[(it_) & 1][bj][1] = (f32x4){bflo(w_.z), bfhi(w_.z), bflo(w_.w), bfhi(w_.w)}; } } } while (0)
        EPI_LD(0);
#pragma unroll
        for (int it = 0; it < 8; ++it) { if (it + 1 < 8) EPI_LD(it + 1);
            const size_t ro = (size_t)EPI_IT_ROW(it) * D + u.pn * BM;
            float sq = 0.f;
#pragma unroll
            for (int bj = 0; bj < 2; ++bj) { const f32x4 v0 = xv[it & 1][bj][0] + acc[it >> 2][bj][it & 3][0], v1 = xv[it & 1][bj][1] + acc[it >> 2][bj][it & 3][1];
                sq += (v0[0] * v0[0] + v0[1] * v0[1]) + (v0[2] * v0[2] + v0[3] * v0[3]) + (v1[0] * v1[0] + v1[1] * v1[1]) + (v1[2] * v1[2] + v1[3] * v1[3]);
                *(u32x4*)(xout + ro + EPI_C8(bj)) = pack8(v0, v1); }
            if (ssq) {
                sq += shflx(sq, 16, fr + 16 * fq);
                { auto rr = __builtin_amdgcn_permlane32_swap(__float_as_uint(sq), __float_as_uint(sq), false, false); sq = __uint_as_float(rr[0]) + __uint_as_float(rr[1]); }
                if (fq == 0) ssq[(size_t)EPI_IT_ROW(it) * 16 + u.pn * 4 + wc] = sq; } }
#undef EPI_LD
    }
};
struct EpiPle {
    static constexpr bool PERM = false;
    const bf16* U; float* x;
    __device__ __forceinline__ void operator()(const acc_t& acc, const Unit& u, int wr, int wc, int fr, int fq) const {
        f32x4 xv[2][4]; u32x2 uv[2][4];
#define EPI_LD(it_) do { const size_t ro_ = (size_t)EPI_IT_ROW(it_) * D + u.pn * BM; _Pragma("unroll") for (int c = 0; c < 4; ++c) { xv[(it_) & 1][c] = *(const f32x4*)(x + ro_ + EPI_C4(c)); uv[(it_) & 1][c] = *(const u32x2*)(U + ro_ + EPI_C4(c)); } } while (0)
        EPI_LD(0);
#pragma unroll
        for (int it = 0; it < 8; ++it) { if (it + 1 < 8) EPI_LD(it + 1);
            const size_t ro = (size_t)EPI_IT_ROW(it) * D + u.pn * BM;
#pragma unroll
            for (int c = 0; c < 4; ++c) { f32x4 v = acc[it >> 2][c >> 1][it & 3][c & 1];
                v[0] = sigmoidf_(v[0]); v[1] = sigmoidf_(v[1]); v[2] = sigmoidf_(v[2]); v[3] = sigmoidf_(v[3]);
                *(f32x4*)(x + ro + EPI_C4(c)) = xv[it & 1][c] + unpack4(uv[it & 1][c]) * v; } }
#undef EPI_LD
    }
};
struct EpiSwiglu {
    static constexpr bool PERM = true;
    bf16* O; int ldc; int npt;
    const LAS float* rl;
    mutable int ord;
    __device__ __forceinline__ void operator()(const acc_t& acc, const Unit& u, int wr, int wc, int fr, int fq) const {
        const int ct = (u.pn % npt) * HALF;
#pragma unroll
        EPI_LOOP_ROWS { bf16* rp = O + (size_t)EPI_ROW * ldc + ct + wc * 32 + 8 * fq; u32x2 w[2];
            const float r = rl ? rl[ord * 256 + ai * HALF + wr * 64 + m * 16 + fr] : 1.0f;
#pragma unroll
            for (int n = 0; n < 2; ++n) { const f32x4 a = acc[ai][0][m][n] * r, b = acc[ai][1][m][n] * r; f32x4 v;
#pragma unroll
                for (int e = 0; e < 4; ++e) v[e] = a[e] * sigmoidf_(a[e]) * b[e];
                w[n] = pack4(v); }
            *(u32x4*)rp = (u32x4){w[0].x, w[0].y, w[1].x, w[1].y}; }
        ++ord;
    }
};
struct EpiGlu {
    static constexpr bool PERM = true;
    bf16* Y; int ldc;
    __device__ __forceinline__ void operator()(const acc_t& acc, const Unit& u, int wr, int wc, int fr, int fq) const {
        u32x4 yv[2][2];
#define EPI_LD(it_) do { const bf16* rp_ = Y + (size_t)EPI_IT_ROW(it_) * ldc + u.pn * BM; _Pragma("unroll") for (int bj = 0; bj < 2; ++bj) yv[(it_) & 1][bj] = *(const u32x4*)(rp_ + EPI_C8(bj)); } while (0)
        EPI_LD(0);
#pragma unroll
        for (int it = 0; it < 8; ++it) { if (it + 1 < 8) EPI_LD(it + 1);
            bf16* rp = Y + (size_t)EPI_IT_ROW(it) * ldc + u.pn * BM;
#pragma unroll
            for (int bj = 0; bj < 2; ++bj) { const u32x4 w = yv[it & 1][bj]; f32x4 a = acc[it >> 2][bj][it & 3][0], b = acc[it >> 2][bj][it & 3][1];
                a[0] = bflo(w.x) * sigmoidf_(a[0]); a[1] = bfhi(w.x) * sigmoidf_(a[1]); a[2] = bflo(w.y) * sigmoidf_(a[2]); a[3] = bfhi(w.y) * sigmoidf_(a[3]);
                b[0] = bflo(w.z) * sigmoidf_(b[0]); b[1] = bfhi(w.z) * sigmoidf_(b[1]); b[2] = bflo(w.w) * sigmoidf_(b[2]); b[3] = bfhi(w.w) * sigmoidf_(b[3]);
                *(u32x4*)(rp + EPI_C8(bj)) = pack8(a, b); } }
#undef EPI_LD
    }
};
struct EpiMoeDown {
    static constexpr bool PERM = true;
    bf16* Y; const float* slot_gate;
    __device__ __forceinline__ void operator()(const acc_t& acc, const Unit& u, int wr, int wc, int fr, int fq) const {
        const int ct = (u.pn & 3) * BM;
        float gv[2][4];
#pragma unroll
        EPI_LOOP_ROWS gv[ai][m] = slot_gate[EPI_ROW];
#pragma unroll
        EPI_LOOP_ROWS { const int row = EPI_ROW; const float gt = gv[ai][m]; bf16* rp = Y + (size_t)row * D + ct;
#pragma unroll
            for (int bj = 0; bj < 2; ++bj) *(u32x4*)(rp + EPI_C8(bj)) = pack8(acc[ai][bj][m][0] * gt, acc[ai][bj][m][1] * gt); }
    }
};
}
namespace att {
constexpr int MODE_FOX = 0, MODE_MLA = 1, MODE_BAND = 2;
constexpr float LOG2E = 1.4426950408889634f;
struct Tensors {
    const bf16* Q; int ldq;
    const bf16* K; int ldk;
    const bf16* K2;
    const bf16* V; int ldv;
    bf16* O; int ldo;
    const float* cdec;
    const float* relb;
    int qhs, khs, vhs, ohs;
    const unsigned* qmax; const unsigned* kmax;
};
template <int DQK> struct Lay { static constexpr int KS = DQK * 2 + 16, KB = 64 * KS, VB = 64 * 128, CB = 256, BUF = KB + VB + CB; };
constexpr int ATT_LDS_TAB = 2 * Lay<96>::BUF;
constexpr int ATT_LDS_BYTES = ATT_LDS_TAB + 832 * 4;
__device__ __forceinline__ int crow(int r, int hi) { return (r & 3) + 8 * (r >> 2) + 4 * hi; }
typedef short v4i16_t __attribute__((ext_vector_type(4)));
__device__ __forceinline__ s16x4 vtr(const LAS unsigned char* p) { return __builtin_bit_cast(s16x4, __builtin_amdgcn_ds_read_tr16_b64_v4i16((LAS v4i16_t*)p)); }

template <int MODE>
__device__ __forceinline__ void attn_unit(const Tensors& T, int b, int h, int qb, LAS unsigned char* lds) {
    constexpr int DQK = (MODE == MODE_MLA) ? 96 : 64, NKS = DQK / 16;
    typedef Lay<DQK> LY;
    int tid = my_tid(); asm volatile("" : "+v"(tid));
    const int lane = tid & 63, r32 = lane & 31, hi = lane >> 5; const int wid = __builtin_amdgcn_readfirstlane(tid >> 6);
    const int rowb = b * SEQ, q0 = qb * 256;
    const float sc2 = ((MODE == MODE_MLA) ? 0.10206207261596575f : 0.125f) * LOG2E;
    const int cw = 4 * qb + (wid >> 1);
    const int t_lo = (MODE == MODE_BAND) ? ((4 * qb - 8) > 0 ? (4 * qb - 8) : 0) : 0, t_hi = 4 * qb + 4;
    const int qrow = rowb + q0 + wid * 32 + r32;
    bf16x8 qf[NKS];
    { const bf16* qp = T.Q + (size_t)qrow * T.ldq + h * T.qhs + hi * 8;
#pragma unroll
      for (int ks = 0; ks < NKS; ++ks) qf[ks] = *(const bf16x8*)(qp + ks * 16); }
    float cq = 0.f; if (MODE == MODE_FOX) cq = T.cdec[(size_t)qrow * 4 + h];
    LAS float* tab = (LAS float*)(lds + ATT_LDS_TAB);
    if (MODE == MODE_BAND) { for (int i = tid; i < 832; i += NTHREADS) tab[i] = T.relb[h * 513 + (i < 512 ? i : 512)] * LOG2E; }
    u32x4 kreg0[2] = {}, kreg1[2] = {}, vreg[2] = {}; float creg[2] = {0.f, 0.f};
    const int srow = tid >> 3, sch = tid & 7;
#define ATT_KADDR(c_) (((c_) % 12 < 8) ? (const u32x4*)(T.K + (kr_ + (c_) / 12) * T.ldk + h * T.khs + ((c_) % 12) * 8) : (const u32x4*)(T.K2 + (kr_ + (c_) / 12) * 32 + ((c_) % 12 - 8) * 8))
#define ATT_LOAD_TILE(t_, r_) do { const size_t kr_ = (size_t)(rowb + (t_) * 64); \
        if (MODE == MODE_MLA) { kreg0[r_] = *ATT_KADDR(tid); if (tid < 256) kreg1[r_] = *ATT_KADDR(tid + 512); } \
        else { kreg0[r_] = *(const u32x4*)(T.K + (kr_ + srow) * T.ldk + h * T.khs + sch * 8); } \
        vreg[r_] = *(const u32x4*)(T.V + (kr_ + srow) * T.ldv + h * T.vhs + sch * 8); \
        if (MODE == MODE_FOX) { if (tid < 64) creg[r_] = T.cdec[(kr_ + tid) * 4 + h]; } } while (0)
#define ATT_STORE_TILE(buf_, r_) do { LAS unsigned char* base_ = lds + (buf_) * LY::BUF; \
        if (MODE == MODE_MLA) { *(LAS u32x4*)(base_ + (tid / 12) * LY::KS + (tid % 12) * 16) = kreg0[r_]; \
            if (tid < 256) *(LAS u32x4*)(base_ + ((tid + 512) / 12) * LY::KS + ((tid + 512) % 12) * 16) = kreg1[r_]; } \
        else { *(LAS u32x4*)(base_ + srow * LY::KS + sch * 16) = kreg0[r_]; } \
        *(LAS u32x4*)(base_ + LY::KB + srow * 128 + ((sch * 16) ^ (((srow >> 1) & 1) << 6))) = vreg[r_]; \
        if (MODE == MODE_FOX) { if (tid < 64) *(LAS float*)(base_ + LY::KB + LY::VB + tid * 4) = creg[r_]; } } while (0)
    float mrun = -INFINITY, lrun = 0.f;
    f32x16 o0 = {}, o1 = {};
    const int G = lane >> 4, qi = (lane & 15) >> 2, pi = lane & 3;
    const int vb0 = (4 * hi + qi) * 128 + 64 * (0 ^ (qi >> 1)) + 32 * (G & 1) + 8 * pi;
    const int vb1 = (4 * hi + qi) * 128 + 64 * (1 ^ (qi >> 1)) + 32 * (G & 1) + 8 * pi;
    int t_min = t_lo;
    if (MODE == MODE_FOX) {
        LAS int* tm = (LAS int*)(lds + ATT_LDS_TAB);
        if (tid == 0) tm[0] = t_hi - 1;
        __syncthreads();
        if (tid < t_hi) {
            const float q2 = __uint_as_float(T.qmax[(b * 4 + h) * 32 + qb]), k2 = __uint_as_float(T.kmax[b * 4 + h]);
            const float thr = 0.125f * sqrtf(q2) * 2.0f * sqrtf(k2) * 1.02f + 112.0f;
            const float cfirst = T.cdec[(size_t)(rowb + q0) * 4 + h], clast = T.cdec[(size_t)(rowb + tid * 64 + 63) * 4 + h];
            if (!(clast - cfirst > thr)) __hip_atomic_fetch_min(tm, tid, __ATOMIC_RELAXED, __HIP_MEMORY_SCOPE_WORKGROUP);
        }
        __syncthreads();
        t_min = tm[0];
    }
    const int n_t = t_hi - t_min;
#define ATT_TILE(i_) ((MODE == MODE_FOX) ? (t_hi - 1 - (i_)) : (t_min + (i_)))
    ATT_LOAD_TILE(ATT_TILE(0), 0); ATT_STORE_TILE(0, 0);
    if (n_t > 1) ATT_LOAD_TILE(ATT_TILE(1), 1);
    if (n_t > 2) ATT_LOAD_TILE(ATT_TILE(2), 0);
    __syncthreads();
    for (int it0 = 0; it0 < n_t; it0 += 2) {
#pragma unroll
      for (int half = 0; half < 2; ++half) { const int it = it0 + half; if (it < n_t) {
        const int t = ATT_TILE(it);
        const int buf = half;
        const bool active = (MODE == MODE_BAND) ? (t <= cw && t >= cw - 8) : (t <= cw);
        if (active) {
            const LAS unsigned char* kb = lds + buf * LY::BUF;
            const LAS unsigned char* vbuf = kb + LY::KB;
            f32x16 p0 = {}, p1 = {};
            bf16x8 ka[NKS], kc[NKS];
#pragma unroll
            for (int ks = 0; ks < NKS; ++ks) { ka[ks] = *(const LAS bf16x8*)(kb + r32 * LY::KS + (ks * 16 + hi * 8) * 2); kc[ks] = *(const LAS bf16x8*)(kb + (32 + r32) * LY::KS + (ks * 16 + hi * 8) * 2); }
            __builtin_amdgcn_sched_barrier(0);
#pragma unroll
            for (int ks = 0; ks < NKS; ++ks) { p0 = __builtin_amdgcn_mfma_f32_32x32x16_bf16(ka[ks], qf[ks], p0, 0, 0, 0); p1 = __builtin_amdgcn_mfma_f32_32x32x16_bf16(kc[ks], qf[ks], p1, 0, 0, 0); }
            s16x4 vl0[4], vh0[4], vl1[4], vh1[4];
#pragma unroll
            for (int s4 = 0; s4 < 4; ++s4) { vl0[s4] = vtr(vbuf + vb0 + s4 * 2048); vh0[s4] = vtr(vbuf + vb0 + s4 * 2048 + 1024); vl1[s4] = vtr(vbuf + vb1 + s4 * 2048); vh1[s4] = vtr(vbuf + vb1 + s4 * 2048 + 1024); }
            __builtin_amdgcn_sched_barrier(0);
            if (MODE == MODE_FOX) {
                const LAS float* cb = (const LAS float*)(vbuf + LY::VB);
                const float cq2 = cq * LOG2E;
#pragma unroll
                for (int a = 0; a < 4; ++a) {
                    const f32x4 c0 = *(const LAS f32x4*)(cb + 8 * a + 4 * hi), c1 = *(const LAS f32x4*)(cb + 32 + 8 * a + 4 * hi);
#pragma unroll
                    for (int e = 0; e < 4; ++e) { p0[4 * a + e] = p0[4 * a + e] * sc2 + (cq2 - c0[e] * LOG2E); p1[4 * a + e] = p1[4 * a + e] * sc2 + (cq2 - c1[e] * LOG2E); }
                }
                if (t == cw) { const int ql = 32 * (wid & 1) + r32;
#pragma unroll
                    for (int r = 0; r < 16; ++r) { const int kv = crow(r, hi); if (kv > ql) p0[r] = -INFINITY; if (kv + 32 > ql) p1[r] = -INFINITY; } }
            } else if (MODE == MODE_BAND) {
                const LAS float* bp = tab + ((q0 + wid * 32 + r32) - t * 64) + 256 - 4 * hi - 95;
#pragma unroll
                for (int r = 0; r < 16; ++r) { const int kvb = (r & 3) + 8 * (r >> 2);
                    p0[r] = p0[r] * sc2 + bp[95 - kvb]; p1[r] = p1[r] * sc2 + bp[63 - kvb]; }
            }
            float mx = fmaxf(p0[0], p1[0]);
#pragma unroll
            for (int r = 1; r < 16; ++r) mx = fmaxf(mx, fmaxf(p0[r], p1[r]));
            { auto rr = __builtin_amdgcn_permlane32_swap(__float_as_uint(mx), __float_as_uint(mx), false, false); mx = fmaxf(__uint_as_float(rr[0]), __uint_as_float(rr[1])); }
            if (MODE == MODE_MLA) mx *= sc2;
            const float mnew = fmaxf(mrun, mx);
            if (__any(mnew > mrun)) {
                const float alpha = __builtin_amdgcn_exp2f(mrun - mnew);
                lrun *= alpha;
#pragma unroll
                for (int r = 0; r < 16; ++r) { o0[r] *= alpha; o1[r] *= alpha; }
                mrun = mnew;
            }
            float rs = 0.f;
#pragma unroll
            for (int r = 0; r < 16; ++r) {
                if (MODE == MODE_MLA) { p0[r] = __builtin_amdgcn_exp2f(__builtin_fmaf(p0[r], sc2, -mrun)); p1[r] = __builtin_amdgcn_exp2f(__builtin_fmaf(p1[r], sc2, -mrun)); }
                else { p0[r] = __builtin_amdgcn_exp2f(p0[r] - mrun); p1[r] = __builtin_amdgcn_exp2f(p1[r] - mrun); }
                rs += p0[r] + p1[r]; }
            lrun += rs;
#pragma unroll
            for (int s4 = 0; s4 < 4; ++s4) {
                u32x4 pw;
                if (s4 < 2) { const int o = 8 * (s4 & 1); pw.x = pk2(p0[o], p0[o + 1]); pw.y = pk2(p0[o + 2], p0[o + 3]); pw.z = pk2(p0[o + 4], p0[o + 5]); pw.w = pk2(p0[o + 6], p0[o + 7]); }
                else        { const int o = 8 * (s4 & 1); pw.x = pk2(p1[o], p1[o + 1]); pw.y = pk2(p1[o + 2], p1[o + 3]); pw.z = pk2(p1[o + 4], p1[o + 5]); pw.w = pk2(p1[o + 6], p1[o + 7]); }
                const bf16x8 pf = __builtin_bit_cast(bf16x8, pw);
                const s16x4 l0 = vl0[s4], h0 = vh0[s4], l1 = vl1[s4], h1 = vh1[s4];
                const bf16x8 vf0 = (bf16x8){l0[0], l0[1], l0[2], l0[3], h0[0], h0[1], h0[2], h0[3]};
                const bf16x8 vf1 = (bf16x8){l1[0], l1[1], l1[2], l1[3], h1[0], h1[1], h1[2], h1[3]};
                o0 = __builtin_amdgcn_mfma_f32_32x32x16_bf16(vf0, pf, o0, 0, 0, 0);
                o1 = __builtin_amdgcn_mfma_f32_32x32x16_bf16(vf1, pf, o1, 0, 0, 0);
            }
        }
        if (it + 1 < n_t) ATT_STORE_TILE(half ^ 1, half ^ 1);
        if (it + 3 < n_t) ATT_LOAD_TILE(ATT_TILE(it + 3), half ^ 1);
        __syncthreads();
      } }
    }
    { auto rr = __builtin_amdgcn_permlane32_swap(__float_as_uint(lrun), __float_as_uint(lrun), false, false); lrun = __uint_as_float(rr[0]) + __uint_as_float(rr[1]); }
    const float inv = 1.0f / lrun;
    bf16* op = T.O + (size_t)qrow * T.ldo + h * T.ohs;
#pragma unroll
    for (int a = 0; a < 4; ++a) {
        u32x2 w0, w1;
        w0.x = pk2(o0[4 * a] * inv, o0[4 * a + 1] * inv); w0.y = pk2(o0[4 * a + 2] * inv, o0[4 * a + 3] * inv);
        w1.x = pk2(o1[4 * a] * inv, o1[4 * a + 1] * inv); w1.y = pk2(o1[4 * a + 2] * inv, o1[4 * a + 3] * inv);
        *(u32x2*)(op + 8 * a + 4 * hi) = w0; *(u32x2*)(op + 32 + 8 * a + 4 * hi) = w1;
    }
}

template <int MODE>
__device__ __forceinline__ void attn_phase(const Tensors& T, LAS unsigned char* lds) {
    const int G = gridDim.x, bx = blockIdx.x, vcu = (G % 8 == 0) ? (bx % 8) * (G / 8) + bx / 8 : bx;
    for (int pr = vcu; pr < 256; pr += G) {
        const int bh = pr >> 4, s = pr & 15;
        attn_unit<MODE>(T, bh >> 2, bh & 3, s, lds);
        attn_unit<MODE>(T, bh >> 2, bh & 3, 31 - s, lds);
    }
}

template <int MODE>
__device__ __forceinline__ void attn_naive(const Tensors& T) {
    BODY_IDS();
    constexpr int DQK = (MODE == MODE_MLA) ? 96 : 64;
    const float sc = (MODE == MODE_MLA) ? 0.10206207261596575f : 0.125f;
    for (int idx = gtid; idx < NTOK * 4; idx += gthreads) {
        const int h = idx / NTOK, row = idx % NTOK, b = row / SEQ, tpos = row % SEQ, rowb = b * SEQ;
        float q[DQK], o[64];
#pragma unroll
        for (int d = 0; d < DQK; ++d) q[d] = bf2f(T.Q[(size_t)row * T.ldq + h * T.qhs + d]) * sc;
#pragma unroll
        for (int d = 0; d < 64; ++d) o[d] = 0.f;
        float m = -INFINITY, l = 0.f;
        const int ck = tpos / 64;
        const int k_lo = (MODE == MODE_BAND) ? ((ck - 8) > 0 ? (ck - 8) * 64 : 0) : 0;
        const int k_hi = (MODE == MODE_FOX) ? tpos : (ck * 64 + 63);
        const float cq = (MODE == MODE_FOX) ? T.cdec[(size_t)row * 4 + h] : 0.f;
        for (int kv = k_lo; kv <= k_hi; ++kv) {
            const size_t kr = (size_t)(rowb + kv);
            float s = 0.f;
#pragma unroll
            for (int d8 = 0; d8 < 8; ++d8) { const u32x4 w = *(const u32x4*)(T.K + kr * T.ldk + h * T.khs + d8 * 8);
                s += q[d8 * 8 + 0] * bflo(w.x) + q[d8 * 8 + 1] * bfhi(w.x) + q[d8 * 8 + 2] * bflo(w.y) + q[d8 * 8 + 3] * bfhi(w.y)
                   + q[d8 * 8 + 4] * bflo(w.z) + q[d8 * 8 + 5] * bfhi(w.z) + q[d8 * 8 + 6] * bflo(w.w) + q[d8 * 8 + 7] * bfhi(w.w); }
            if (MODE == MODE_MLA) {
#pragma unroll
                for (int d8 = 0; d8 < 4; ++d8) { const u32x4 w = *(const u32x4*)(T.K2 + kr * 32 + d8 * 8);
                    s += q[64 + d8 * 8 + 0] * bflo(w.x) + q[64 + d8 * 8 + 1] * bfhi(w.x) + q[64 + d8 * 8 + 2] * bflo(w.y) + q[64 + d8 * 8 + 3] * bfhi(w.y)
                       + q[64 + d8 * 8 + 4] * bflo(w.z) + q[64 + d8 * 8 + 5] * bfhi(w.z) + q[64 + d8 * 8 + 6] * bflo(w.w) + q[64 + d8 * 8 + 7] * bfhi(w.w); }
            }
            if (MODE == MODE_FOX) s += cq - T.cdec[kr * 4 + h];
            if (MODE == MODE_BAND) { int rel = tpos - kv; rel = rel < -256 ? -256 : (rel > 256 ? 256 : rel); s += T.relb[h * 513 + rel + 256]; }
            const float mn = fmaxf(m, s), al = __expf(m - mn), pp = __expf(s - mn);
            l = l * al + pp; m = mn;
#pragma unroll
            for (int d8 = 0; d8 < 8; ++d8) { const u32x4 w = *(const u32x4*)(T.V + kr * T.ldv + h * T.vhs + d8 * 8);
                o[d8 * 8 + 0] = o[d8 * 8 + 0] * al + pp * bflo(w.x); o[d8 * 8 + 1] = o[d8 * 8 + 1] * al + pp * bfhi(w.x);
                o[d8 * 8 + 2] = o[d8 * 8 + 2] * al + pp * bflo(w.y); o[d8 * 8 + 3] = o[d8 * 8 + 3] * al + pp * bfhi(w.y);
                o[d8 * 8 + 4] = o[d8 * 8 + 4] * al + pp * bflo(w.z); o[d8 * 8 + 5] = o[d8 * 8 + 5] * al + pp * bfhi(w.z);
                o[d8 * 8 + 6] = o[d8 * 8 + 6] * al + pp * bflo(w.w); o[d8 * 8 + 7] = o[d8 * 8 + 7] * al + pp * bfhi(w.w); }
        }
        const float inv = 1.0f / l;
#pragma unroll
        for (int d = 0; d < 64; d += 2) *(unsigned*)(T.O + (size_t)row * T.ldo + h * T.ohs + d) = pk2(o[d] * inv, o[d + 1] * inv);
    }
}
}
struct Params {
    const float* in[37];
    float* out;
    unsigned char* ws;
    int ph_lo, ph_hi;
};
enum { I_X = 0, I_P, I_POS, I_WIN, I_SAR, I_SAI, I_SLDT, I_SBR, I_SBI, I_SCR, I_SCI, I_SD, I_SGLU, I_FBF, I_GQ, I_WUQ, I_GKV, I_WUKV, I_RELB, I_WB, I_WG, I_BG, I_WO,
       I_GMIX, I_GFFN, I_FW1, I_FW3, I_FW2, I_MWR, I_MBR, I_MW1, I_MW3, I_MW2, I_GPLE, I_PWG, I_PWU, I_GFIN };

__device__ __forceinline__ void sincos_rad(double a, float& s, float& c) {
    double r = a * 0.15915494309189535; r = r - __builtin_rint(r); const float f = (float)r;
    s = __builtin_amdgcn_sinf(f); c = __builtin_amdgcn_cosf(f);
}
__device__ __forceinline__ float gelu_tanh(float x) {
    const float z = 0.7978845608028654f * (x + 0.044715f * x * x * x);
    return x * __builtin_amdgcn_rcpf(1.0f + __expf(-2.0f * z));
}
__device__ __forceinline__ float log_sigmoid(float z) { return fminf(z, 0.f) - log1pf(__expf(-fabsf(z))); }

struct CvtJob { const float* src; const float* ks; bf16* dst; int K, ldsrc, col0, ncols, row0, ldk, ilv; };
struct CvtRegs { f32x4 v[16]; };
__device__ __forceinline__ void cvt_load(const CvtJob& J, int item, int lane, CvtRegs& R) {
    const int nblk = (J.ncols + 63) >> 6, kb = item / nblk, nb = item % nblk, k0 = 64 * kb, n0 = 64 * nb;
    const int n4 = (lane & 15) * 4; const bool inb = (n0 + n4) < J.ncols;
#pragma unroll
    for (int i = 0; i < 16; ++i) { const int kk = 4 * i + (lane >> 4); f32x4 v = {0.f, 0.f, 0.f, 0.f};
        if (inb) v = *(const f32x4*)(J.src + (size_t)(k0 + kk) * J.ldsrc + J.col0 + n0 + n4);
        if (J.ks) v = v * J.ks[k0 + kk];
        R.v[i] = v; }
}
__device__ __forceinline__ void cvt_finish(const CvtJob& J, LAS float* scr, int item, int lane, const CvtRegs& R) {
    const int nblk = (J.ncols + 63) >> 6, kb = item / nblk, nb = item % nblk, k0 = 64 * kb, n0 = 64 * nb;
    const int n4 = (lane & 15) * 4;
#pragma unroll
    for (int i = 0; i < 16; ++i) { const int kk = 4 * i + (lane >> 4); *(LAS f32x4*)(scr + kk * 68 + n4) = R.v[i]; }
    LDS_WAIT(); asm volatile("" ::: "memory");
    const int c = lane & 7;
#pragma unroll
    for (int j = 0; j < 8; ++j) { const int n = (lane >> 3) + 8 * j; const LAS float* s = scr + (8 * c) * 68 + n;
        u32x4 o; o.x = pk2(s[0 * 68], s[1 * 68]); o.y = pk2(s[2 * 68], s[3 * 68]); o.z = pk2(s[4 * 68], s[5 * 68]); o.w = pk2(s[6 * 68], s[7 * 68]);
        const int nn = n0 + n; const int row = J.row0 + (J.ilv ? ((nn >> 7) * 256 + (nn & 127)) : nn);
        if (nn < J.ncols) *(u32x4*)(J.dst + (size_t)row * J.ldk + k0 + 8 * c) = o; }
    LDS_WAIT(); asm volatile("" ::: "memory");
}
__device__ __forceinline__ bf16* wmix(const Params& P, int L, size_t off) { return (bf16*)(P.ws + WS_WMIX + (size_t)L * WMIX_STRIDE + off); }
__device__ __forceinline__ CvtJob get_job(const Params& P, int j) {
    CvtJob J; J.ks = nullptr; J.ilv = 0; J.col0 = 0; J.row0 = 0;
    if (j < 40) {
        const int L = j / 20, q = j % 20;
        if (q < 5) {
            J.src = P.in[I_WIN] + (size_t)L * D * DIN; J.K = D; J.ldsrc = DIN; J.dst = wmix(P, L, WM_IN); J.ldk = D;
            J.col0 = q == 0 ? 0 : q == 1 ? 1380 : q == 2 ? 1028 : q == 3 ? 1220 : 1348;
            J.ncols = q == 0 ? 1024 : q == 1 ? 768 : q == 2 ? 192 : q == 3 ? 128 : 32;
            J.row0 = q == 0 ? 0 : q == 1 ? 1024 : q == 2 ? 1792 : q == 3 ? 2048 : 2176;
        } else if (q < 9) { const int k = q - 5; J.src = P.in[I_WG] + ((size_t)L * 4 + k) * D * D; J.K = D; J.ldsrc = D; J.ncols = D; J.row0 = k * D; J.dst = wmix(P, L, WM_G); J.ldk = D;
        } else if (q < 13) { const int k = q - 9; J.src = P.in[I_WB] + ((size_t)L * 4 + k) * 256 * D; J.K = 256; J.ldsrc = D; J.ncols = D; J.row0 = k * D; J.dst = wmix(P, L, WM_B); J.ldk = 256;
        } else if (q == 13) { J.src = P.in[I_WO] + (size_t)L * D * D; J.K = D; J.ldsrc = D; J.ncols = D; J.dst = wmix(P, L, WM_O); J.ldk = D;
        } else if (q == 14) { J.src = P.in[I_PWG] + (size_t)L * D * D;  J.ks = P.in[I_GPLE] + L * D; J.K = D; J.ldsrc = D; J.ncols = D; J.dst = wmix(P, L, WM_PG); J.ldk = D;
        } else if (q == 15) { J.src = P.in[I_PWU] + (size_t)L * 256 * D; J.K = 256; J.ldsrc = D; J.ncols = D; J.dst = wmix(P, L, WM_UP); J.ldk = 256;
        } else if (q == 16) { J.src = P.in[I_WUQ] + (size_t)L * 192 * 384; J.ks = P.in[I_GQ] + L * 192; J.K = 192; J.ldsrc = 384; J.ncols = 384; J.dst = wmix(P, L, WM_UQ); J.ldk = 256;
        } else if (q == 17) { J.src = P.in[I_WUKV] + (size_t)L * 128 * 512; J.ks = P.in[I_GKV] + L * 128; J.K = 128; J.ldsrc = 512; J.ncols = 512; J.dst = wmix(P, L, WM_UKV); J.ldk = 128;
        } else if (q == 18) { J.src = P.in[I_SGLU] + (size_t)L * 256 * 256; J.K = 256; J.ldsrc = 256; J.ncols = 256; J.dst = wmix(P, L, WM_GLU); J.ldk = 256;
        } else { J.src = nullptr; J.K = 0; J.ldsrc = 0; J.ncols = 32; J.dst = nullptr; J.ldk = 0; }
    } else if (j < 43) {
        const int q = j - 40;
        if (q == 0) { J.src = P.in[I_FW1]; J.ks = P.in[I_GFFN]; J.K = D; J.ldsrc = DFF; J.ncols = DFF; J.dst = (bf16*)(P.ws + WS_W13); J.ldk = D; J.ilv = 1; }
        else if (q == 1) { J.src = P.in[I_FW3]; J.ks = P.in[I_GFFN]; J.K = D; J.ldsrc = DFF; J.ncols = DFF; J.row0 = 128; J.dst = (bf16*)(P.ws + WS_W13); J.ldk = D; J.ilv = 1; }
        else { J.src = P.in[I_FW2]; J.K = DFF; J.ldsrc = D; J.ncols = D; J.dst = (bf16*)(P.ws + WS_W2); J.ldk = DFF; }
    } else {
        const int e = (j - 43) / 3, q = (j - 43) % 3;
        if (q == 0) { J.src = P.in[I_MW1] + (size_t)e * D * DFFE; J.K = D; J.ldsrc = DFFE; J.ncols = DFFE; J.row0 = e * 2816; J.dst = (bf16*)(P.ws + WS_WM13); J.ldk = D; J.ilv = 1; }
        else if (q == 1) { J.src = P.in[I_MW3] + (size_t)e * D * DFFE; J.K = D; J.ldsrc = DFFE; J.ncols = DFFE; J.row0 = e * 2816 + 128; J.dst = (bf16*)(P.ws + WS_WM13); J.ldk = D; J.ilv = 1; }
        else { J.src = P.in[I_MW2] + (size_t)e * DFFE * D; J.K = DFFE; J.ldsrc = D; J.ncols = D; J.row0 = e * D; J.dst = (bf16*)(P.ws + WS_WM2); J.ldk = DFFE; }
    }
    return J;
}
__device__ __forceinline__ void cvt_jobs(const Params& P, int j_lo, int j_hi, LAS unsigned char* lds) {
    BODY_IDS();
    LAS float* scr = (LAS float*)(lds + wave * 17408);
    int acc = 0; bool have = false; CvtJob Jp; int itp = 0; CvtRegs Rp;
    for (int j = j_lo; j < j_hi; ++j) {
        const CvtJob J = get_job(P, j);
        const int items = (J.K / 64) * ((J.ncols + 63) >> 6);
        const int first = (gw - (acc % ngw) + ngw) % ngw;
        for (int it = first; it < items; it += ngw) {
            CvtRegs Rn; cvt_load(J, it, lane, Rn);
            if (have) cvt_finish(Jp, scr, itp, lane, Rp);
            Jp = J; itp = it; have = true;
#pragma unroll
            for (int i = 0; i < 16; ++i) Rp.v[i] = Rn.v[i];
        }
        acc += items;
    }
    if (have) cvt_finish(Jp, scr, itp, lane, Rp);
}

__device__ __forceinline__ void p0_misc(const Params& P) {
    BODY_IDS();
    { const f32x4* src = (const f32x4*)P.in[I_P]; u32x2* dst = (u32x2*)(P.ws + WS_PBF);
      for (int i = gtid; i < 2 * NTOK * 256 / 4; i += gthreads) { const f32x4 v = src[i]; u32x2 w; w.x = pk2(v[0], v[1]); w.y = pk2(v[2], v[3]); dst[i] = w; } }
    { const int* pos = (const int*)P.in[I_POS]; float* ct = (float*)(P.ws + WS_COS); float* st = (float*)(P.ws + WS_SIN);
      const double invf[16] = {1.0, 0.5623413251903491, 0.31622776601683794, 0.1778279410038923, 0.1, 0.05623413251903491, 0.03162277660168379, 0.01778279410038923,
                               0.01, 0.005623413251903491, 0.0031622776601683794, 0.0017782794100389228, 0.001, 0.0005623413251903491, 0.00031622776601683794, 0.00017782794100389227};
      for (int i = gtid; i < NTOK * 16; i += gthreads) { const int row = i >> 4, f = i & 15; double iv = invf[0];
#pragma unroll
          for (int q = 1; q < 16; ++q) iv = (f == q) ? invf[q] : iv;
          const float ang = (float)pos[row] * (float)iv; float s, c; sincos_rad((double)ang, s, c); ct[i] = c; st[i] = s; } }
    for (int L = 0; L < 2; ++L) {
        bf16* win = wmix(P, L, WM_IN);
        for (int i = gtid; i < (64 + 96) * D / 8; i += gthreads) { const int e = i * 8, r = e / D, k = e % D; const int row = r < 64 ? 1984 + r : 2208 + (r - 64); *(u32x4*)(win + (size_t)row * D + k) = (u32x4){0u, 0u, 0u, 0u}; }
        bf16* wuq = wmix(P, L, WM_UQ);
        for (int i = gtid; i < 512 * 256 / 8; i += gthreads) { const int e = i * 8, r = e / 256, k = e % 256; if (r >= 384 || k >= 192) *(u32x4*)(wuq + e) = (u32x4){0u, 0u, 0u, 0u}; }
    }
}

__device__ __forceinline__ void rms_load(const XSrc& x, int row, int lane, f32x4 (&v)[4]) {
#pragma unroll
    for (int j = 0; j < 4; ++j) v[j] = ldx4(x, (size_t)row * D + 4 * lane + 256 * j);
}
struct GainRegs { f32x4 g[4]; };
__device__ __forceinline__ GainRegs load_gain(const float* gain, int lane) { GainRegs G; const f32x4* gr = (const f32x4*)gain + lane;
#pragma unroll
    for (int j = 0; j < 4; ++j) G.g[j] = gr[64 * j];
    return G; }
__device__ __forceinline__ void rms_finish(const GainRegs& G, bf16* orow, int lane, f32x4 (&v)[4]) {
    float s = 0.f;
#pragma unroll
    for (int j = 0; j < 4; ++j) s += (v[j][0] * v[j][0] + v[j][1] * v[j][1]) + (v[j][2] * v[j][2] + v[j][3] * v[j][3]);
    const float rstd = __builtin_amdgcn_rsqf(wave_sum(s) * (1.0f / D) + RMS_EPS);
    u32x2* o8 = (u32x2*)orow + lane;
#pragma unroll
    for (int j = 0; j < 4; ++j) { v[j] = v[j] * rstd * G.g[j]; if (orow) { u32x2 w; w.x = pk2(v[j][0], v[j][1]); w.y = pk2(v[j][2], v[j][3]); o8[64 * j] = w; } }
}
#define RMS_ROWS_BEGIN(x_, rowexpr_) f32x4 v[4], vn_[4]; { const int i = 0; rms_load(x_, (rowexpr_), lane, v); } for (int i = 0; i < 16; ++i) { if (i + 1 < 16) { const int i_ = i; { const int i = i_ + 1; rms_load(x_, (rowexpr_), lane, vn_); } }
#define RMS_ROWS_END() _Pragma("unroll") for (int j_ = 0; j_ < 4; ++j_) v[j_] = vn_[j_]; }
__device__ __forceinline__ void norm_plain(const XSrc x, const float* gain, bf16* H, int first, int stride) {
    BODY_IDS();
    const GainRegs GR = load_gain(gain, lane);
    for (int u = first; u < NTOK / 128; u += stride)
    { RMS_ROWS_BEGIN(x, u * 128 + wave * 16 + i) const int row = u * 128 + wave * 16 + i; rms_finish(GR, H + (size_t)row * D, lane, v); RMS_ROWS_END() }
}
__device__ __forceinline__ void norm1_phase(const Params& P, int L, const XSrc x, int first, int stride) {
    BODY_IDS();
    const float* win = P.in[I_WIN] + (size_t)L * D * DIN;
    f32x4 wff[4][4];
#pragma unroll
    for (int j = 0; j < 4; ++j)
#pragma unroll
        for (int e = 0; e < 4; ++e) wff[j][e] = *(const f32x4*)(win + (size_t)(4 * lane + 256 * j + e) * DIN + 1024);
    const float* gain = P.in[I_GMIX] + L * D; bf16* H = (bf16*)(P.ws + WS_H); const GainRegs GR = load_gain(gain, lane);
    float* logf = (float*)(P.ws + WS_LOGF); float* wsum = (float*)(P.ws + WS_WSUM);
    const f32x4 bf = *(const f32x4*)(P.in[I_FBF] + L * 4);
    for (int u = first; u < NTOK / 128; u += stride) { const int g0 = u * 8 + wave;
        f32x4 run = {0.f, 0.f, 0.f, 0.f};
        RMS_ROWS_BEGIN(x, g0 * 16 + i) const int row = g0 * 16 + i; rms_finish(GR, H + (size_t)row * D, lane, v);
            f32x4 d = {0.f, 0.f, 0.f, 0.f};
#pragma unroll
            for (int j = 0; j < 4; ++j)
#pragma unroll
                for (int e = 0; e < 4; ++e) d += wff[j][e] * v[j][e];
#pragma unroll
            for (int e = 0; e < 4; ++e) { d[e] = wave_sum(d[e]); run[e] += log_sigmoid(d[e] + bf[e]); }
            if (lane == 0) *(f32x4*)(logf + (size_t)row * 4) = run; RMS_ROWS_END()
        if (lane == 0) *(f32x4*)(wsum + (size_t)g0 * 4) = run;
    }
    __syncthreads();
}
__device__ __forceinline__ void prep_phase(const Params& P, int L) {
    BODY_IDS();
    unsigned* qmaxw = (unsigned*)(P.ws + WS_CTL) + CW_QMAX + L * 512; unsigned* kmaxw = (unsigned*)(P.ws + WS_CTL) + CW_KMAX + L * 16;
    const float* logf = (const float*)(P.ws + WS_LOGF); const float* wsum = (const float*)(P.ws + WS_WSUM); float* cdec = (float*)(P.ws + WS_CDEC);
    float* rq = (float*)(P.ws + WS_RSTDQ); float* rkv = (float*)(P.ws + WS_RSTDKV); const bf16* zin = (const bf16*)(P.ws + WS_ZIN); bf16* kper = (bf16*)(P.ws + WS_KPER);
    const float* ct = (const float*)(P.ws + WS_COS); const float* st = (const float*)(P.ws + WS_SIN);
    for (int g0 = gw; g0 < NTOK / 16; g0 += ngw) {
        const int first = (g0 / 512) * 512;
        f32x4 pre = {0.f, 0.f, 0.f, 0.f};
        for (int i = first + lane; i < g0; i += 64) pre += *(const f32x4*)(wsum + (size_t)i * 4);
#pragma unroll
        for (int e = 0; e < 4; ++e) pre[e] = wave_sum(pre[e]);
        if (lane < 16) { const int row = g0 * 16 + lane; *(f32x4*)(cdec + (size_t)row * 4) = *(const f32x4*)(logf + (size_t)row * 4) + pre; }
        float qk2m = 0.f;
        const int colA = (lane < 32 ? ZC_FQ : ZC_FK) + 8 * (lane & 31), colB = ZC_CQ + 8 * (lane < 52 ? lane : 51);
        u32x4 wa = *(const u32x4*)(zin + (size_t)(g0 * 16) * ZP + colA), wb = *(const u32x4*)(zin + (size_t)(g0 * 16) * ZP + colB);
        for (int i = 0; i < 16; ++i) { const int row = g0 * 16 + i;
            const u32x4 ca = wa, cb = wb;
            if (i + 1 < 16) { wa = *(const u32x4*)(zin + (size_t)(row + 1) * ZP + colA); wb = *(const u32x4*)(zin + (size_t)(row + 1) * ZP + colB); }
            const f32x4 cs = *(const f32x4*)(ct + (size_t)row * 16 + 8 * (lane & 1)), cs2 = *(const f32x4*)(ct + (size_t)row * 16 + 8 * (lane & 1) + 4);
            const f32x4 sn = *(const f32x4*)(st + (size_t)row * 16 + 8 * (lane & 1)), sn2 = *(const f32x4*)(st + (size_t)row * 16 + 8 * (lane & 1) + 4);
            { float sa = (bflo(ca.x) * bflo(ca.x) + bfhi(ca.x) * bfhi(ca.x)) + (bflo(ca.y) * bflo(ca.y) + bfhi(ca.y) * bfhi(ca.y)) + (bflo(ca.z) * bflo(ca.z) + bfhi(ca.z) * bfhi(ca.z)) + (bflo(ca.w) * bflo(ca.w) + bfhi(ca.w) * bfhi(ca.w));
              sa += DPP_F(sa, 0xB1, 0xF); sa += DPP_F(sa, 0x4E, 0xF); sa += DPP_F(sa, 0x141, 0xF);
              qk2m = fmaxf(qk2m, sa); }
            const float own[8] = {bflo(cb.x), bfhi(cb.x), bflo(cb.y), bfhi(cb.y), bflo(cb.z), bfhi(cb.z), bflo(cb.w), bfhi(cb.w)};
            float ssb = 0.f;
#pragma unroll
            for (int e = 0; e < 8; ++e) ssb += own[e] * own[e];
            const float sq = wave_sum(lane < 24 ? ssb : 0.f), skv = wave_sum((lane >= 32 && lane < 48) ? ssb : 0.f);
            if (lane == 0) { rq[row] = __builtin_amdgcn_rsqf(sq * (1.0f / 192.0f) + RMS_EPS); rkv[row] = __builtin_amdgcn_rsqf(skv * (1.0f / 128.0f) + RMS_EPS); }
            float oth[8];
#pragma unroll
            for (int e = 0; e < 8; ++e) oth[e] = DPP_F(own[e], 0x4E, 0xF);
            if (lane >= 48 && lane < 52) { const bool lo = lane < 50; float o8[8];
#pragma unroll
                for (int e = 0; e < 8; ++e) { const float c = e < 4 ? cs[e] : cs2[e - 4], sv = e < 4 ? sn[e] : sn2[e - 4];
                    o8[e] = lo ? (own[e] * c - oth[e] * sv) : (own[e] * c + oth[e] * sv); }
                *(u32x4*)(kper + (size_t)row * 32 + (lo ? 0 : 16) + 8 * (lane & 1)) = (u32x4){pk2(o8[0], o8[1]), pk2(o8[2], o8[3]), pk2(o8[4], o8[5]), pk2(o8[6], o8[7])}; } }
        if ((lane & 7) == 0) { const int row0 = g0 * 16, b = row0 / SEQ, qb = (row0 % SEQ) / 256, h = (lane & 31) >> 3;
            if (lane < 32) atomicMax(qmaxw + (b * 4 + h) * 32 + qb, __float_as_uint(qk2m)); else atomicMax(kmaxw + b * 4 + h, __float_as_uint(qk2m)); }
    }
}
struct FinalRows { u32x2 w[16][4]; };
__device__ __forceinline__ void final_norm_load(const Params& P, int u, FinalRows& R) {
    BODY_IDS();
    const bf16* xb = (const bf16*)(P.ws + WS_WM13);
#pragma unroll
    for (int i = 0; i < 16; ++i) { const u32x2* xr = (const u32x2*)(xb + (size_t)(u * 128 + wave * 16 + i) * D) + lane;
#pragma unroll
        for (int j = 0; j < 4; ++j) R.w[i][j] = xr[64 * j]; }
}
__device__ __forceinline__ void final_norm_store(const Params& P, int u, const FinalRows& R) {
    BODY_IDS();
    const GainRegs GR = load_gain(P.in[I_GFIN], lane);
#pragma unroll
    for (int i = 0; i < 16; ++i) { f32x4 v[4]; float s = 0.f;
#pragma unroll
        for (int j = 0; j < 4; ++j) { const u32x2 w = R.w[i][j]; v[j] = (f32x4){bflo(w.x), bfhi(w.x), bflo(w.y), bfhi(w.y)}; s += (v[j][0] * v[j][0] + v[j][1] * v[j][1]) + (v[j][2] * v[j][2] + v[j][3] * v[j][3]); }
        const float rstd = __builtin_amdgcn_rsqf(wave_sum(s) * (1.0f / D) + RMS_EPS);
        f32x4* xo = (f32x4*)(P.out + (size_t)(u * 128 + wave * 16 + i) * D) + lane;
#pragma unroll
        for (int j = 0; j < 4; ++j) xo[64 * j] = v[j] * rstd * GR.g[j]; }
}
namespace s5 {
struct Coef { float abr, abi; f32x2 B2[16]; float a64r, a64i; };
__device__ __forceinline__ void coef(const Params& P, int L, int g, int p, Coef& C) {
    const float dt = __expf(P.in[I_SLDT][L * 16 + g]); const float ar = P.in[I_SAR][(L * 16 + g) * 64 + p], ai = P.in[I_SAI][(L * 16 + g) * 64 + p];
    const float mag = __expf(ar * dt); float sn, cs; sincos_rad((double)(ai * dt), sn, cs);
    C.abr = mag * cs; C.abi = mag * sn;
    const float den = ar * ar + ai * ai, nr = C.abr - 1.0f, ni = C.abi;
    const float cr = (nr * ar + ni * ai) / den, ci = (ni * ar - nr * ai) / den;
    const float* br = P.in[I_SBR] + ((size_t)(L * 16 + g) * 64 + p) * 16; const float* bi = P.in[I_SBI] + ((size_t)(L * 16 + g) * 64 + p) * 16;
#pragma unroll
    for (int h = 0; h < 16; ++h) { const float r = br[h], i = bi[h]; C.B2[h] = (f32x2){cr * r - ci * i, cr * i + ci * r}; }
    const float m64 = __expf(64.0f * ar * dt); float s64, c64; sincos_rad(64.0 * (double)(ai * dt), s64, c64);
    C.a64r = m64 * c64; C.a64i = m64 * s64;
}
constexpr int WAVE_LDS = 8448;
template <bool EMIT>
__device__ __forceinline__ void chunk(const Params& P, int L, int g, int row0, const Coef& C, float& xr, float& xi, LAS unsigned char* wl, int lane, const bf16x8 (&cf)[4], float dsk) {
    bf16* zin = (bf16*)(P.ws + WS_ZIN);
    LAS float* ut = (LAS float*)wl; LAS unsigned* xt = (LAS unsigned*)(wl + 4096);
    { const u32x4* up = (const u32x4*)(zin + (size_t)(row0 + lane) * ZP + ZC_U + g * 16); const u32x4 w0 = up[0], w1 = up[1];
      LAS f32x4* d = (LAS f32x4*)(ut + lane * 16);
      d[0] = (f32x4){bflo(w0.x), bfhi(w0.x), bflo(w0.y), bfhi(w0.y)}; d[1] = (f32x4){bflo(w0.z), bfhi(w0.z), bflo(w0.w), bfhi(w0.w)};
      d[2] = (f32x4){bflo(w1.x), bfhi(w1.x), bflo(w1.y), bfhi(w1.y)}; d[3] = (f32x4){bflo(w1.z), bfhi(w1.z), bflo(w1.w), bfhi(w1.w)}; }
    for (int tb = 0; tb < 4; ++tb) {
#pragma unroll 4
        for (int ti = 0; ti < 16; ++ti) {
            const LAS f32x4* up = (const LAS f32x4*)(ut + (tb * 16 + ti) * 16);
            f32x2 b2a = {0.f, 0.f}, b2b = {0.f, 0.f};
#pragma unroll
            for (int q = 0; q < 4; ++q) { const f32x4 u4 = up[q];
                b2a += C.B2[4 * q + 0] * (f32x2){u4[0], u4[0]}; b2b += C.B2[4 * q + 1] * (f32x2){u4[1], u4[1]};
                b2a += C.B2[4 * q + 2] * (f32x2){u4[2], u4[2]}; b2b += C.B2[4 * q + 3] * (f32x2){u4[3], u4[3]}; }
            const float br = b2a[0] + b2b[0], bi = b2a[1] + b2b[1];
            const float nr = C.abr * xr - C.abi * xi + br, ni = C.abr * xi + C.abi * xr + bi; xr = nr; xi = ni;
            if (EMIT) xt[ti * 68 + lane] = pk2(xr, xi);
        }
        if (EMIT) {
            f32x4 dacc = {0.f, 0.f, 0.f, 0.f};
#pragma unroll
            for (int ks = 0; ks < 4; ++ks) { const bf16x8 a = *(const LAS bf16x8*)((const LAS unsigned char*)xt + (lane & 15) * 272 + (ks * 32 + (lane >> 4) * 8) * 2);
                dacc = __builtin_amdgcn_mfma_f32_16x16x32_bf16(a, cf[ks], dacc, 0, 0, 0); }
            const int hp = lane & 15;
#pragma unroll
            for (int i = 0; i < 4; ++i) { const int tok = tb * 16 + 4 * (lane >> 4) + i; const float y = dacc[i] + dsk * ut[tok * 16 + hp];
                zin[(size_t)(row0 + tok) * ZP + ZC_U + g * 16 + hp] = (bf16)f2bf(gelu_tanh(y)); }
        }
    }
}
template <int PASS>
__device__ __forceinline__ void phase(const Params& P, int L, LAS unsigned char* lds) {
    BODY_IDS();
    LAS unsigned char* wl = lds + wave * WAVE_LDS;
    f32x2* SC = (f32x2*)(P.ws + WS_SC);
    for (int w = gw; w < 2048; w += ngw) {
        const int bg = w >> 5, cg = w & 31, b = bg >> 4, g = bg & 15;
        Coef C; coef(P, L, g, lane, C);
        bf16x8 cf[4]; float dsk = 0.f;
        if (PASS == 1) {
            const int hp = lane & 15, kg = lane >> 4;
            const float* cre = P.in[I_SCR] + ((size_t)(L * 16 + g) * 16 + hp) * 64; const float* cim = P.in[I_SCI] + ((size_t)(L * 16 + g) * 16 + hp) * 64;
#pragma unroll
            for (int ks = 0; ks < 4; ++ks) { const int p0 = 16 * ks + 4 * kg; u32x4 wv;
                wv.x = pk2(cre[p0], -cim[p0]); wv.y = pk2(cre[p0 + 1], -cim[p0 + 1]); wv.z = pk2(cre[p0 + 2], -cim[p0 + 2]); wv.w = pk2(cre[p0 + 3], -cim[p0 + 3]);
                cf[ks] = __builtin_bit_cast(bf16x8, wv); }
            dsk = P.in[I_SD][(L * 16 + g) * 16 + hp];
        } else {
#pragma unroll
            for (int ks = 0; ks < 4; ++ks) cf[ks] = (bf16x8){0, 0, 0, 0, 0, 0, 0, 0};
        }
        float xr = 0.f, xi = 0.f;
        if (PASS == 1) {
            const f32x2* sp = SC + ((size_t)bg * 128) * 64 + lane;
            for (int c = 0; c < 4 * cg; c += 4) { f32x2 sv[4];
#pragma unroll
                for (int q = 0; q < 4; ++q) sv[q] = sp[(size_t)(c + q) * 64];
#pragma unroll
                for (int q = 0; q < 4; ++q) { const float nr = C.a64r * xr - C.a64i * xi + sv[q][0], ni = C.a64r * xi + C.a64i * xr + sv[q][1]; xr = nr; xi = ni; } }
        }
        for (int cc = 0; cc < 4; ++cc) {
            const int c = 4 * cg + cc, row0 = b * SEQ + c * 64;
            if (PASS == 0) { xr = 0.f; xi = 0.f; }
            chunk<PASS == 1>(P, L, g, row0, C, xr, xi, wl, lane, cf, dsk);
            if (PASS == 0) SC[((size_t)bg * 128 + c) * 64 + lane] = (f32x2){xr, xi};
        }
    }
}
#define LDS_XLANE() asm volatile("" ::: "memory")
constexpr int WAVE_LDS1 = 4352;
__device__ __forceinline__ void phase1(const Params& P, int L, LAS unsigned char* lds) {
    BODY_IDS();
    LAS unsigned char* wl = lds + wave * WAVE_LDS1;
    LAS unsigned* bu = (LAS unsigned*)wl; LAS unsigned* xt = bu;
    bf16* zin = (bf16*)(P.ws + WS_ZIN);
    const f32x2* SC = (const f32x2*)(P.ws + WS_SC);
    const int m = lane & 15, kq = lane >> 4;
    for (int w = gw; w < 2048; w += ngw) {
        const int bg = w >> 5, cg = w & 31, b = bg >> 4, g = bg & 15;
        const bf16* ub = zin + (size_t)(b * SEQ + cg * 256 + m) * ZP + ZC_U + g * 16 + 8 * (kq & 1);
        u32x4 ua[4];
#pragma unroll
        for (int q = 0; q < 4; ++q) ua[q] = *(const u32x4*)(ub + (size_t)q * 16 * ZP);
        const f32x2* sp = SC + ((size_t)bg * 128) * 64 + lane;
        f32x2 pq[4][4];
        if (cg > 0) {
#pragma unroll
            for (int j = 0; j < 4; ++j) { const int bc = j < cg ? j : cg - 1;
#pragma unroll
                for (int t = 0; t < 4; ++t) pq[j][t] = sp[(size_t)(4 * bc + t) * 64]; }
        }
        float abr, abi, a64r, a64i; bf16x8 bfr[8];
        { Coef C; coef(P, L, g, lane, C); abr = C.abr; abi = C.abi; a64r = C.a64r; a64i = C.a64i;
          LAS unsigned* tab = (LAS unsigned*)wl;
#pragma unroll
          for (int h2 = 0; h2 < 8; ++h2) { tab[lane * 8 + h2] = pk2(C.B2[2 * h2][0], C.B2[2 * h2 + 1][0]); tab[(64 + lane) * 8 + h2] = pk2(C.B2[2 * h2][1], C.B2[2 * h2 + 1][1]); }
          LDS_XLANE();
#pragma unroll
          for (int nt = 0; nt < 8; ++nt) { const u32x4 v = *(const LAS u32x4*)(wl + (16 * nt + m) * 32 + 16 * (kq & 1)); bfr[nt] = __builtin_bit_cast(bf16x8, kq < 2 ? v : (u32x4){0u, 0u, 0u, 0u}); }
          LDS_XLANE(); }
        bf16x8 cf[4]; float dskf;
        { const float* cre = P.in[I_SCR] + ((size_t)(L * 16 + g) * 16 + m) * 64; const float* cim = P.in[I_SCI] + ((size_t)(L * 16 + g) * 16 + m) * 64;
#pragma unroll
          for (int ks = 0; ks < 4; ++ks) { const int p0 = 16 * ks + 4 * kq; u32x4 wv;
              wv.x = pk2(cre[p0], -cim[p0]); wv.y = pk2(cre[p0 + 1], -cim[p0 + 1]); wv.z = pk2(cre[p0 + 2], -cim[p0 + 2]); wv.w = pk2(cre[p0 + 3], -cim[p0 + 3]);
              cf[ks] = __builtin_bit_cast(bf16x8, wv); }
          dskf = P.in[I_SD][(L * 16 + g) * 16 + m]; }
        float xr = 0.f, xi = 0.f;
        for (int k = 0; k < cg; k += 4) {
#pragma unroll
            for (int j = 0; j < 4; ++j) {
                if (k + j < cg) {
#pragma unroll
                    for (int t = 0; t < 4; ++t) { const float nr = a64r * xr - a64i * xi + pq[j][t][0], ni = a64r * xi + a64i * xr + pq[j][t][1]; xr = nr; xi = ni; } }
                const int bn = k + j + 4, bc = bn < cg ? bn : cg - 1;
#pragma unroll
                for (int t = 0; t < 4; ++t) pq[j][t] = sp[(size_t)(4 * bc + t) * 64];
            }
        }
#pragma nounroll
        for (int cc = 0; cc < 4; ++cc) {
            const int row0 = b * SEQ + (4 * cg + cc) * 64;
            u32x4 un[4];
            if (cc < 3) {
#pragma unroll
                for (int q = 0; q < 4; ++q) un[q] = *(const u32x4*)(ub + (size_t)((cc + 1) * 4 + q) * 16 * ZP);
            } else {
#pragma unroll
                for (int q = 0; q < 4; ++q) un[q] = ua[q];
            }
#pragma unroll
            for (int tb = 0; tb < 4; ++tb) {
                const bf16x8 a = __builtin_bit_cast(bf16x8, ua[tb]);
                f32x4 dd[8];
#pragma unroll
                for (int nt = 0; nt < 8; ++nt) dd[nt] = __builtin_amdgcn_mfma_f32_16x16x32_bf16(a, bfr[nt], (f32x4){0.f, 0.f, 0.f, 0.f}, 0, 0, 0);
                unsigned short uraw[4];
#pragma unroll
                for (int i = 0; i < 4; ++i) uraw[i] = *(const unsigned short*)(zin + (size_t)(row0 + tb * 16 + 4 * kq + i) * ZP + ZC_U + g * 16 + m);
#pragma unroll
                for (int nt = 0; nt < 4; ++nt)
#pragma unroll
                    for (int i = 0; i < 4; ++i) bu[(4 * kq + i) * 68 + 16 * nt + m] = pk2(dd[nt][i], dd[nt + 4][i]);
                LDS_XLANE();
#pragma unroll
                for (int ti = 0; ti < 16; ++ti) {
                    const unsigned bw = bu[ti * 68 + lane]; const float br = bflo(bw), bi = bfhi(bw);
                    const float nr = abr * xr - abi * xi + br, ni = abr * xi + abi * xr + bi; xr = nr; xi = ni;
                    xt[ti * 68 + lane] = pk2(xr, xi);
                }
                LDS_XLANE();
                f32x4 dacc = {0.f, 0.f, 0.f, 0.f};
#pragma unroll
                for (int ks = 0; ks < 4; ++ks) { const bf16x8 a2 = *(const LAS bf16x8*)(wl + m * 272 + (ks * 32 + kq * 8) * 2);
                    dacc = __builtin_amdgcn_mfma_f32_16x16x32_bf16(a2, cf[ks], dacc, 0, 0, 0); }
                LDS_XLANE();
#pragma unroll
                for (int i = 0; i < 4; ++i) { const int tok = tb * 16 + 4 * kq + i; const float y = dacc[i] + dskf * __uint_as_float((unsigned)uraw[i] << 16);
                    const float gy = gelu_tanh(y); *(unsigned short*)(zin + (size_t)(row0 + tok) * ZP + ZC_U + g * 16 + m) = (unsigned short)pk2(gy, gy); }
            }
#pragma unroll
            for (int q = 0; q < 4; ++q) ua[q] = un[q];
        }
    }
}
__device__ __forceinline__ void build_w(const Params& P, int L) {
    BODY_IDS();
    bf16* W = (bf16*)(P.ws + WS_S5W);
    for (int q = gtid; q < 16 * 64 * 64; q += gthreads) {
        const int g = q >> 12, p = (q >> 6) & 63, sidx = q & 63;
        const float dt = __expf(P.in[I_SLDT][L * 16 + g]); const float ar = P.in[I_SAR][(L * 16 + g) * 64 + p], ai = P.in[I_SAI][(L * 16 + g) * 64 + p];
        const float mag = __expf(ar * dt); float sn, cs; sincos_rad((double)(ai * dt), sn, cs);
        const float abr = mag * cs, abi = mag * sn, den = ar * ar + ai * ai, nr = abr - 1.0f, ni = abi;
        const float cr = (nr * ar + ni * ai) / den, ci = (ni * ar - nr * ai) / den;
        const float e = (float)(63 - sidx); const float me = __expf(e * ar * dt); float se, ce; sincos_rad((double)e * (double)(ai * dt), se, ce);
        const float Er = me * ce, Ei = me * se;
        const float* br = P.in[I_SBR] + ((size_t)(L * 16 + g) * 64 + p) * 16; const float* bi = P.in[I_SBI] + ((size_t)(L * 16 + g) * 64 + p) * 16;
        float vr[16], vi[16];
#pragma unroll
        for (int h = 0; h < 16; ++h) { const float bbr = cr * br[h] - ci * bi[h], bbi = cr * bi[h] + ci * br[h]; vr[h] = Er * bbr - Ei * bbi; vi[h] = Er * bbi + Ei * bbr; }
        bf16* w0 = W + ((size_t)g * 128 + 2 * p) * 1024 + sidx * 16;
        *(u32x4*)w0 = (u32x4){pk2(vr[0], vr[1]), pk2(vr[2], vr[3]), pk2(vr[4], vr[5]), pk2(vr[6], vr[7])}; *(u32x4*)(w0 + 8) = (u32x4){pk2(vr[8], vr[9]), pk2(vr[10], vr[11]), pk2(vr[12], vr[13]), pk2(vr[14], vr[15])};
        *(u32x4*)(w0 + 1024) = (u32x4){pk2(vi[0], vi[1]), pk2(vi[2], vi[3]), pk2(vi[4], vi[5]), pk2(vi[6], vi[7])}; *(u32x4*)(w0 + 1024 + 8) = (u32x4){pk2(vi[8], vi[9]), pk2(vi[10], vi[11]), pk2(vi[12], vi[13]), pk2(vi[14], vi[15])};
    }
}
__device__ __forceinline__ void pass0_mfma(const Params& P, LAS unsigned char* lds) {
    BODY_IDS();
    const bf16* zin = (const bf16*)(P.ws + WS_ZIN); const bf16* W = (const bf16*)(P.ws + WS_S5W); float* SC = (float*)(P.ws + WS_SC);
    for (int task = blockIdx.x; task < 256; task += gridDim.x) {
        const int g = task & 15, nq = (task >> 4) & 3, cgp = (task >> 6) * 8 + wave;
        __syncthreads();
#pragma unroll
        for (int i = 0; i < 8; ++i) { const int id = tid + 512 * i, row = id >> 7, c16 = id & 127;
            *(LAS u32x4*)(lds + row * 2064 + c16 * 16) = *(const u32x4*)(W + ((size_t)g * 128 + nq * 32 + row) * 1024 + c16 * 8); }
        __syncthreads();
        const int m = lane & 15, kq = lane >> 4, ci = 16 * cgp + m, b = ci >> 7, c = ci & 127;
        const bf16* ap = zin + (size_t)(b * SEQ + c * 64 + (kq >> 1)) * ZP + ZC_U + g * 16 + 8 * (kq & 1);
        const LAS unsigned char* bl = lds + m * 2064 + kq * 16;
        f32x4 d0 = {0.f, 0.f, 0.f, 0.f}, d1 = {0.f, 0.f, 0.f, 0.f};
#pragma unroll 8
        for (int ks = 0; ks < 32; ++ks) {
            const bf16x8 av = *(const bf16x8*)(ap + (size_t)(2 * ks) * ZP), b0 = *(const LAS bf16x8*)(bl + 64 * ks), b1 = *(const LAS bf16x8*)(bl + 16 * 2064 + 64 * ks);
            d0 = __builtin_amdgcn_mfma_f32_16x16x32_bf16(av, b0, d0, 0, 0, 0); d1 = __builtin_amdgcn_mfma_f32_16x16x32_bf16(av, b1, d1, 0, 0, 0);
        }
#pragma unroll
        for (int i = 0; i < 4; ++i) { const int cj = 16 * cgp + 4 * (lane >> 4) + i, bj = cj >> 7, cc = cj & 127; float* sp = SC + ((size_t)(bj * 16 + g) * 128 + cc) * 128 + nq * 32 + (lane & 15);
            sp[0] = d0[i]; sp[16] = d1[i]; }
    }
    __syncthreads();
}
__device__ __forceinline__ void naive(const Params& P, int L) {
    BODY_IDS();
    bf16* zin = (bf16*)(P.ws + WS_ZIN);
    for (int bg = gw; bg < 64; bg += ngw) {
        const int b = bg >> 4, g = bg & 15;
        Coef C; coef(P, L, g, lane, C);
        float cr[16], ci[16];
#pragma unroll
        for (int h = 0; h < 16; ++h) { cr[h] = P.in[I_SCR][((size_t)(L * 16 + g) * 16 + h) * 64 + lane]; ci[h] = P.in[I_SCI][((size_t)(L * 16 + g) * 16 + h) * 64 + lane]; }
        const float dsk = P.in[I_SD][(L * 16 + g) * 16 + (lane & 15)];
        float xr = 0.f, xi = 0.f;
        for (int t = 0; t < SEQ; ++t) {
            bf16* up = zin + (size_t)(b * SEQ + t) * ZP + ZC_U + g * 16;
            const u32x4 w0 = *(const u32x4*)up, w1 = *(const u32x4*)(up + 8);
            const float u[16] = {bflo(w0.x), bfhi(w0.x), bflo(w0.y), bfhi(w0.y), bflo(w0.z), bfhi(w0.z), bflo(w0.w), bfhi(w0.w),
                                 bflo(w1.x), bfhi(w1.x), bflo(w1.y), bfhi(w1.y), bflo(w1.z), bfhi(w1.z), bflo(w1.w), bfhi(w1.w)};
            float br = 0.f, bi = 0.f;
#pragma unroll
            for (int h = 0; h < 16; ++h) { br += C.B2[h][0] * u[h]; bi += C.B2[h][1] * u[h]; }
            const float nr = C.abr * xr - C.abi * xi + br, ni = C.abr * xi + C.abi * xr + bi; xr = nr; xi = ni;
            float ymine = 0.f, umine = 0.f;
#pragma unroll
            for (int h = 0; h < 16; ++h) { const float s = wave_sum(xr * cr[h] - xi * ci[h]); if ((lane & 15) == h) { ymine = s; umine = u[h]; } }
            __builtin_amdgcn_s_waitcnt(0);
            if (lane < 16) up[lane] = (bf16)f2bf(gelu_tanh(ymine + dsk * umine));
        }
    }
}
}

__device__ __forceinline__ void norm2_moe_phase(const Params& P, const XSrc x, LAS unsigned char* lds, int first, int stride) {
    BODY_IDS();
    LAS unsigned* lcnt = (LAS unsigned*)(lds + 32768); LAS unsigned* lbase = lcnt + 8;
    f32x4 wr0[4][4], wr1[4][4];
#pragma unroll
    for (int j = 0; j < 4; ++j)
#pragma unroll
        for (int q = 0; q < 4; ++q) { const float* wp = P.in[I_MWR] + (size_t)(4 * lane + 256 * j + q) * 8; wr0[j][q] = *(const f32x4*)wp; wr1[j][q] = *(const f32x4*)(wp + 4); }
    if (tid < 8) lcnt[tid] = 0u;
    __syncthreads();
    const float* gain = P.in[I_GFFN] + 1 * D; bf16* H = (bf16*)(P.ws + WS_H); const GainRegs GR = load_gain(gain, lane);
    unsigned* tokinfo = (unsigned*)(P.ws + WS_TOKINFO); unsigned* gcnt = (unsigned*)(P.ws + WS_CTL) + CW_MOECNT;
    const float* brt = P.in[I_MBR];
    for (int u = first; u < NTOK / 128; u += stride) { const int g0 = u * 8 + wave;
        RMS_ROWS_BEGIN(x, g0 * 16 + i) const int row = g0 * 16 + i; rms_finish(GR, H + (size_t)row * D, lane, v);
            float lg[8];
#pragma unroll
            for (int e = 0; e < 8; ++e) lg[e] = 0.f;
#pragma unroll
            for (int j = 0; j < 4; ++j)
#pragma unroll
                for (int q = 0; q < 4; ++q) { const f32x4 w0 = wr0[j][q], w1 = wr1[j][q]; const float hv = v[j][q];
                    lg[0] += hv * w0[0]; lg[1] += hv * w0[1]; lg[2] += hv * w0[2]; lg[3] += hv * w0[3]; lg[4] += hv * w1[0]; lg[5] += hv * w1[1]; lg[6] += hv * w1[2]; lg[7] += hv * w1[3]; }
#pragma unroll
            for (int e = 0; e < 8; ++e) lg[e] = wave_sum(lg[e]) + brt[e];
            int e0 = 0; float l0 = lg[0];
#pragma unroll
            for (int e = 1; e < 8; ++e) if (lg[e] > l0) { l0 = lg[e]; e0 = e; }
            int e1 = 0; float l1 = -INFINITY;
#pragma unroll
            for (int e = 0; e < 8; ++e) if (e != e0 && lg[e] > l1) { l1 = lg[e]; e1 = e; }
            const float ex = __expf(l1 - l0); const float ga = __builtin_amdgcn_rcpf(1.0f + ex), gb = ex * ga;
            if (lane == 0) { const unsigned r0 = __hip_atomic_fetch_add(&lcnt[e0], 1u, __ATOMIC_RELAXED, __HIP_MEMORY_SCOPE_WORKGROUP), r1 = __hip_atomic_fetch_add(&lcnt[e1], 1u, __ATOMIC_RELAXED, __HIP_MEMORY_SCOPE_WORKGROUP);
                u32x4 a; a.x = (unsigned)e0; a.y = (unsigned)e1; a.z = r0; a.w = r1; u32x4 bq; bq.x = __float_as_uint(ga); bq.y = __float_as_uint(gb); bq.z = 0u; bq.w = 0u;
                *(u32x4*)(tokinfo + (size_t)row * 8) = a; *(u32x4*)(tokinfo + (size_t)row * 8 + 4) = bq; } RMS_ROWS_END()
    }
    __syncthreads();
    if (tid < 8) lbase[tid] = __hip_atomic_fetch_add(gcnt + tid, lcnt[tid], __ATOMIC_RELAXED, __HIP_MEMORY_SCOPE_AGENT);
    __syncthreads();
    for (int u = first; u < NTOK / 128; u += stride) { const int g0 = u * 8 + wave;
        if (lane == 0) { for (int i = 0; i < 16; ++i) { const int row = g0 * 16 + i; u32x4 a = *(u32x4*)(tokinfo + (size_t)row * 8);
            unsigned b0 = 0, b1 = 0;
#pragma unroll
            for (int e = 0; e < 8; ++e) { const unsigned lb = lbase[e]; b0 = (a.x == (unsigned)e) ? lb : b0; b1 = (a.y == (unsigned)e) ? lb : b1; }
            a.z += b0; a.w += b1; *(u32x4*)(tokinfo + (size_t)row * 8) = a; } }
    }
    int* slot_tok = (int*)(P.ws + WS_SLOTTOK);
    for (int i = gtid; i < MOE_ROWS; i += gthreads) slot_tok[i] = -1;
    __syncthreads();
}
struct MoeLayout { int pstart[9]; };
__device__ __forceinline__ MoeLayout moe_layout(const Params& P) {
    const unsigned* gcnt = (const unsigned*)(P.ws + WS_CTL) + CW_MOECNT; MoeLayout Lo; int acc = 0;
#pragma unroll
    for (int e = 0; e < 8; ++e) { Lo.pstart[e] = acc; const int c = (int)__hip_atomic_load(gcnt + e, __ATOMIC_RELAXED, __HIP_MEMORY_SCOPE_AGENT); acc += (c + 255) / 256 * 256; }
    Lo.pstart[8] = acc; return Lo;
}
__device__ __forceinline__ void moe_assign_phase(const Params& P) {
    BODY_IDS();
    const MoeLayout Lo = moe_layout(P);
    const unsigned* tokinfo = (const unsigned*)(P.ws + WS_TOKINFO); int* slot_tok = (int*)(P.ws + WS_SLOTTOK); float* slot_gate = (float*)(P.ws + WS_SLOTGATE);
    for (int t = gtid; t < NTOK; t += gthreads) { const u32x4 a = *(const u32x4*)(tokinfo + (size_t)t * 8); const u32x2 g = *(const u32x2*)(tokinfo + (size_t)t * 8 + 4);
        int p0 = 0, p1 = 0;
#pragma unroll
        for (int e = 0; e < 8; ++e) { p0 = ((int)a.x == e) ? Lo.pstart[e] : p0; p1 = ((int)a.y == e) ? Lo.pstart[e] : p1; }
        const int s0 = p0 + (int)a.z, s1 = p1 + (int)a.w;
        slot_tok[s0] = t; slot_gate[s0] = __uint_as_float(g.x); slot_tok[s1] = t; slot_gate[s1] = __uint_as_float(g.y); }
}
struct MoeOrder {
    int pstart[9]; int ntile, ncol, G, c;
    __device__ __forceinline__ bool next(int i, pg8::Unit& u) const {
        const long Lf = (long)i * G + c; if (Lf >= (long)ntile * ncol) return false;
        const int rt = (int)(Lf / ncol), j = (int)(Lf % ncol); int e = 0;
#pragma unroll
        for (int q = 1; q < 8; ++q) e = (rt * 256 >= pstart[q]) ? q : e;
        u.pm = rt; u.pn = e * ncol + j; return true;
    }
};
__device__ __forceinline__ MoeOrder moe_order(const Params& P, int ncol, int G, int c) {
    const MoeLayout Lo = moe_layout(P); MoeOrder S;
#pragma unroll
    for (int e = 0; e < 9; ++e) S.pstart[e] = Lo.pstart[e];
    S.ntile = Lo.pstart[8] / 256; S.ncol = ncol; S.G = G; S.c = c; return S;
}

__device__ __forceinline__ void norm_moe_combine(const Params& P, const float* gain, int first, int stride) {
    BODY_IDS();
    const MoeLayout Lo = moe_layout(P); (void)gain;
    const unsigned* tokinfo = (const unsigned*)(P.ws + WS_TOKINFO); const bf16* Y = (const bf16*)(P.ws + WS_MOEY); float* rsv = (float*)(P.ws + WS_SSQ);
    for (int u = first; u < NTOK / 128; u += stride) for (int i = 0; i < 16; ++i) { const int row = u * 128 + wave * 16 + i;
        const u32x4 a = *(const u32x4*)(tokinfo + (size_t)row * 8);
        int p0 = 0, p1 = 0;
#pragma unroll
        for (int e = 0; e < 8; ++e) { p0 = ((int)a.x == e) ? Lo.pstart[e] : p0; p1 = ((int)a.y == e) ? Lo.pstart[e] : p1; }
        const u32x2* y0 = (const u32x2*)(Y + (size_t)(p0 + (int)a.z) * D) + lane; const u32x2* y1 = (const u32x2*)(Y + (size_t)(p1 + (int)a.w) * D) + lane;
        u32x2* xr = (u32x2*)(xr_of(P.out) + (size_t)row * D) + lane; f32x4 v[4]; float s = 0.f;
#pragma unroll
        for (int j = 0; j < 4; ++j) { const u32x2 w0 = y0[64 * j], w1 = y1[64 * j]; const u32x2 wx = xr[64 * j];
            v[j] = (f32x4){bflo(wx.x), bfhi(wx.x), bflo(wx.y), bfhi(wx.y)} + (f32x4){bflo(w0.x), bfhi(w0.x), bflo(w0.y), bfhi(w0.y)} + (f32x4){bflo(w1.x), bfhi(w1.x), bflo(w1.y), bfhi(w1.y)};
            { u32x2 wo; wo.x = pk2(v[j][0], v[j][1]); wo.y = pk2(v[j][2], v[j][3]); xr[64 * j] = wo; } s += (v[j][0] * v[j][0] + v[j][1] * v[j][1]) + (v[j][2] * v[j][2] + v[j][3] * v[j][3]); }
        const float rstd = __builtin_amdgcn_rsqf(wave_sum(s) * (1.0f / D) + RMS_EPS);
        if (lane == 0) rsv[row] = rstd;
    }
}
#ifndef REF_MASK
#define REF_MASK 0
#endif
#ifndef N_LAUNCH_MODE
#define N_LAUNCH_MODE 1
#endif
constexpr int LDS_BYTES = 147456;
constexpr int RL_OFF = 131072, RL_UNITS = 15;
constexpr int MISC_OFF = LDS_BYTES - 64;
constexpr int N_PHASES = 27;
#ifndef PHASE_SEL
#define PHASE_SEL 0xFFFFFFFu
#endif
#define PH_ON(b) (((PHASE_SEL) >> (b)) & 1u)
#ifndef SUB_SEL
#define SUB_SEL 0xFFu
#endif
#define SUB_ON(b) (((SUB_SEL) >> (b)) & 1u)

#ifndef PROBE_MASK
#define PROBE_MASK 0u
#endif
#ifndef PROBE_MULT
#define PROBE_MULT 4
#endif
#define TIMED(bit, ...) do { unsigned long long t0_ = 0; if (((PROBE_MASK) >> (bit)) & 1u) t0_ = __builtin_amdgcn_s_memrealtime(); __VA_ARGS__; \
    if (((PROBE_MASK) >> (bit)) & 1u) pacc += __builtin_amdgcn_s_memrealtime() - t0_; } while (0)
#define RUN_GEMM(EPI_T, SCHED_T, GATH, gm, sc, ep) do { if (REF_MASK & 1) pg8::gemm_phase_naive<EPI_T, SCHED_T, GATH>(gm, sc, ep); \
    else pg8::gemm_phase<EPI_T, SCHED_T, true, GATH>(lds, gm, sc, ep); } while (0)

__device__ __forceinline__ int vcu_of() { int G = gridDim.x, bx = blockIdx.x; asm volatile("" : "+s"(G), "+s"(bx)); return (G % 8 == 0) ? (bx % 8) * (G / 8) + bx / 8 : bx; }
__device__ __forceinline__ bool in_range(int lo, int hi, int k) { asm volatile("" : "+s"(lo), "+s"(hi)); return lo <= k && k < hi; }
__global__ void __launch_bounds__(NTHREADS, 2) mega_fwd(Params P) {
    extern __shared__ __attribute__((aligned(16))) unsigned char lds_raw[];
    LAS unsigned char* lds = (LAS unsigned char*)lds_raw;
    const int tid = threadIdx.x;
    const int G = gridDim.x, bx = blockIdx.x;
    unsigned* ctl = (unsigned*)(P.ws + WS_CTL);
    volatile LAS unsigned* misc = (volatile LAS unsigned*)(lds + MISC_OFF);
    if (tid < 16) misc[tid] = 0u;
    if ((tid & 63) == 0) *(LAS int*)(uintptr_t)((unsigned)TID_TAB_OFF + 4u * hw_wave_key()) = tid >> 6;
    __syncthreads();
    const int lo = P.ph_lo, hi = P.ph_hi;
    XcdBarrier bar; bar.bar = ctl + CW_BAR; bar.x = 0; bar.st = misc;
    if (hi - lo > 1) bar = xcd_barrier_post(ctl + CW_BAR, misc);
#define IN(k) in_range(lo, hi, (k))
#ifndef PROBE_SEAMS
#define PROBE_SEAMS 0u
#endif
#define SEAM(k) do { if (IN(k) && IN((k) + 1)) { unsigned long long t0_ = 0; const bool tm_ = (((PROBE_MASK) >> 24) & 1u) || (((PROBE_SEAMS) >> (k)) & 1u); if (tm_) t0_ = __builtin_amdgcn_s_memrealtime(); \
    xcd_barrier(bar); if (tm_) pacc += __builtin_amdgcn_s_memrealtime() - t0_; } } while (0)
    unsigned long long pacc = 0;

#define H ((bf16*)(P.ws + WS_H))
#define ZIN ((bf16*)(P.ws + WS_ZIN))
#define GB ((bf16*)(P.ws + WS_G))
#define MB ((bf16*)(P.ws + WS_M))
#define MLAQ ((bf16*)(P.ws + WS_MLAQ))
#define MLAKV ((bf16*)(P.ws + WS_MLAKV))
#define KPER ((bf16*)(P.ws + WS_KPER))
#define cosT ((float*)(P.ws + WS_COS))
#define sinT ((float*)(P.ws + WS_SIN))
#define slot_tok ((int*)(P.ws + WS_SLOTTOK))
#define slot_gate ((float*)(P.ws + WS_SLOTGATE))

    if (PH_ON(0) && IN(0)) { TIMED(0, cvt_jobs(P, 0, 43, lds); p0_misc(P)); TIMED(1, norm1_phase(P, 0, XSrc{P.in[I_X], nullptr}, vcu_of(), gridDim.x)); }
    SEAM(0);

    for (int L = 0; L < 2; ++L) {
        const int pb = 1 + 12 * L;
        const int pc = (L == 0) ? 9 : 22;
        bf16* const XR = xr_of(P.out);
        bf16* const X2 = (bf16*)(P.ws + WS_WM13);
        const XSrc xsrc = (L == 0) ? XSrc{P.in[I_X], nullptr} : XSrc{nullptr, X2};
        if (PH_ON(2) && IN(pb + 1)) {
            TIMED(4, s5::build_w(P, L));
            pg8::Gemm g{H, wmix(P, L, WM_IN), D, D, D, nullptr}; pg8::StaticOrder S; S.init(NTOK, ZP, G, bx);
            epi::EpiStore E{ZIN, ZP, 0};
            TIMED(2, RUN_GEMM(epi::EpiStore, pg8::StaticOrder, false, g, S, E));
        }
        SEAM(pb + 1);
        if (PH_ON(3) && IN(pb + 2)) {
            TIMED(3, prep_phase(P, L));
            if (!(REF_MASK & 4)) TIMED(4, s5::pass0_mfma(P, lds));
            __syncthreads();
        }
        SEAM(pb + 2);
        if (PH_ON(4) && IN(pb + 3)) {
            if (SUB_ON(0)) { pg8::Gemm g{ZIN + ZC_CQ, wmix(P, L, WM_UQ), ZP, 256, 256, nullptr}; pg8::StaticOrder S; S.init(NTOK, 512, G, bx);
              epi::EpiMlaQ E{MLAQ, (const float*)(P.ws + WS_RSTDQ), cosT, sinT};
              TIMED(5, RUN_GEMM(epi::EpiMlaQ, pg8::StaticOrder, false, g, S, E)); }
            if (SUB_ON(1)) { pg8::Gemm g{ZIN + ZC_CKV, wmix(P, L, WM_UKV), ZP, 128, 128, nullptr}; pg8::StaticOrder S; S.init(NTOK, 512, G, bx);
              epi::EpiRowScale E{MLAKV, 512, (const float*)(P.ws + WS_RSTDKV)};
              TIMED(5, RUN_GEMM(epi::EpiRowScale, pg8::StaticOrder, false, g, S, E)); }
            if (SUB_ON(2)) { TIMED(6, if (REF_MASK & 4) s5::naive(P, L); else s5::phase1(P, L, lds)); }
            __syncthreads();
            if (SUB_ON(3)) { att::Tensors T; T.Q = ZIN + ZC_FQ; T.ldq = ZP; T.K = ZIN + ZC_FK; T.ldk = ZP; T.K2 = nullptr; T.V = ZIN + ZC_FV; T.ldv = ZP; T.O = ZIN + ZC_FQ; T.ldo = ZP;
              T.cdec = (const float*)(P.ws + WS_CDEC); T.relb = nullptr; T.qhs = 64; T.khs = 64; T.vhs = 64; T.ohs = 64;
              T.qmax = (const unsigned*)(P.ws + WS_CTL) + CW_QMAX + L * 512; T.kmax = (const unsigned*)(P.ws + WS_CTL) + CW_KMAX + L * 16;
              TIMED(7, if (REF_MASK & 2) att::attn_naive<att::MODE_FOX>(T); else att::attn_phase<att::MODE_FOX>(T, lds)); }
            __syncthreads();
            if (SUB_ON(4)) { att::Tensors T; T.Q = ZIN + ZC_DQ; T.ldq = ZP; T.K = ZIN + ZC_DK; T.ldk = ZP; T.K2 = nullptr; T.V = ZIN + ZC_DV; T.ldv = ZP; T.O = ZIN + ZC_DQ; T.ldo = ZP;
              T.cdec = nullptr; T.relb = P.in[I_RELB] + (size_t)L * 4 * 513; T.qhs = 64; T.khs = 64; T.vhs = 64; T.ohs = 64;
              TIMED(8, if (REF_MASK & 2) att::attn_naive<att::MODE_BAND>(T); else att::attn_phase<att::MODE_BAND>(T, lds)); }
            __syncthreads();
        }
        SEAM(pb + 3);
        if (PH_ON(5) && IN(pb + 4)) {
            if (SUB_ON(0)) { att::Tensors T; T.Q = MLAQ; T.ldq = 512; T.K = MLAKV; T.ldk = 512; T.K2 = KPER; T.V = MLAKV + 64; T.ldv = 512; T.O = ZIN + ZC_CQ; T.ldo = ZP;
              T.cdec = nullptr; T.relb = nullptr; T.qhs = 96; T.khs = 128; T.vhs = 128; T.ohs = 64;
              TIMED(9, if (REF_MASK & 2) att::attn_naive<att::MODE_MLA>(T); else att::attn_phase<att::MODE_MLA>(T, lds)); }
            __syncthreads();
            if (SUB_ON(1)) { pg8::Gemm g{ZIN + ZC_U, wmix(P, L, WM_GLU), ZP, 256, 256, nullptr}; pg8::StaticOrder S; S.init(NTOK, 256, G, bx);
              epi::EpiGlu E{ZIN + ZC_U, ZP};
              TIMED(10, RUN_GEMM(epi::EpiGlu, pg8::StaticOrder, false, g, S, E)); }
        }
        SEAM(pb + 4);
        if (PH_ON(6) && IN(pb + 5)) {
            g128::MergeProg MP; MP.Hn = H; MP.zin = ZIN; MP.wg = wmix(P, L, WM_G); MP.wb = wmix(P, L, WM_B); MP.bg = P.in[I_BG] + (size_t)L * 4 * D; MP.M = MB;
            const int vcu_ = vcu_of();
            TIMED(11, g128::stream<g128::MergeProg>(lds, MP, 1024, vcu_, G));
        }
        SEAM(pb + 5);
#define PANEL_FENCE() do { asm volatile("s_waitcnt vmcnt(0)" ::: "memory"); __builtin_amdgcn_fence(__ATOMIC_ACQUIRE, "agent"); asm volatile("s_waitcnt vmcnt(0)" ::: "memory"); __syncthreads(); } while (0)
        if (PH_ON(7) && IN(pb + 6)) {
            pg8::Gemm g{MB, wmix(P, L, WM_O), D, D, D, nullptr}; pg8::StaticOrder S; S.init(NTOK, D, G, bx);
            epi::EpiRes E{xsrc, XR, (L == 0) ? (float*)(P.ws + WS_SSQ) : nullptr};
            TIMED(13, RUN_GEMM(epi::EpiRes, pg8::StaticOrder, false, g, S, E));
        }
        SEAM(pb + 6);
        if (PH_ON(8) && IN(pb + 7)) {
            const int vcu_ = vcu_of();
            if (L != 0) { TIMED(14, norm2_moe_phase(P, XSrc{nullptr, XR}, lds, vcu_, G)); TIMED(25, cvt_jobs(P, 43, 67, lds)); __syncthreads(); }
        }
        if (L != 0) SEAM(pb + 7);
        if (L == 0) {
            if (PH_ON(9) && IN(9)) {
                pg8::Gemm g{XR, (const bf16*)(P.ws + WS_W13), D, D, D, nullptr}; pg8::StaticOrder S; S.init(NTOK, 2 * DFF, G, bx);
                LAS float* rl = (LAS float*)(lds + RL_OFF);
                { const int t_ = my_tid(); const int half = __builtin_amdgcn_readfirstlane(t_ >> 8); const f32x4* sl = (const f32x4*)(P.ws + WS_SSQ);
                  int nu = 0; { pg8::Unit uu; while (nu < RL_UNITS && S.next(nu, uu)) ++nu; }
#pragma unroll 3
                  for (int i = half; i < nu; i += 2) { pg8::Unit uu; S.next(i, uu);
                      const f32x4* rp = sl + (size_t)(uu.pm * 256 + (t_ & 255)) * 4; const f32x4 s0 = rp[0], s1 = rp[1], s2 = rp[2], s3 = rp[3];
                      const float tot = (((s0[0] + s0[1]) + (s0[2] + s0[3])) + ((s1[0] + s1[1]) + (s1[2] + s1[3]))) + (((s2[0] + s2[1]) + (s2[2] + s2[3])) + ((s3[0] + s3[1]) + (s3[2] + s3[3])));
                      rl[i * 256 + (t_ & 255)] = __builtin_amdgcn_rsqf(tot * (1.0f / D) + RMS_EPS); }
                  __syncthreads(); }
                epi::EpiSwiglu E{(bf16*)(P.ws + WS_HMID), DFF, 22, rl, 0};
                TIMED(15, RUN_GEMM(epi::EpiSwiglu, pg8::StaticOrder, false, g, S, E));
            }
            SEAM(9);
            if (PH_ON(10) && IN(10)) {
                pg8::Gemm g{(const bf16*)(P.ws + WS_HMID), (const bf16*)(P.ws + WS_W2), DFF, DFF, DFF, nullptr}; pg8::StaticOrder S; S.init(NTOK, D, G, bx);
                epi::EpiRes E{XSrc{nullptr, XR}, XR, (float*)(P.ws + WS_SSQ)};
                TIMED(16, RUN_GEMM(epi::EpiRes, pg8::StaticOrder, false, g, S, E));
            }
            SEAM(10);
        } else {
            if (PH_ON(21) && IN(21)) TIMED(17, moe_assign_phase(P));
            SEAM(21);
            if (PH_ON(22) && IN(22)) {
                pg8::Gemm g{H, (const bf16*)(P.ws + WS_WM13), D, D, D, slot_tok}; const MoeOrder S = moe_order(P, 11, G, bx);
                epi::EpiSwiglu E{(bf16*)(P.ws + WS_HMID), DFFE, 11, nullptr, 0};
                TIMED(18, RUN_GEMM(epi::EpiSwiglu, MoeOrder, true, g, S, E));
            }
            SEAM(22);
            if (PH_ON(23) && IN(23)) {
                pg8::Gemm g{(const bf16*)(P.ws + WS_HMID), (const bf16*)(P.ws + WS_WM2), DFFE, DFFE, DFFE, nullptr}; const MoeOrder S = moe_order(P, 4, G, bx);
                epi::EpiMoeDown E{(bf16*)(P.ws + WS_MOEY), slot_gate};
                TIMED(19, RUN_GEMM(epi::EpiMoeDown, MoeOrder, false, g, S, E));
            }
            SEAM(23);
        }
        if (PH_ON(12) && IN(pc + 3)) {
            const int vcu_ = vcu_of();
            if (L != 0) { TIMED(20, norm_moe_combine(P, P.in[I_GPLE] + L * D, vcu_, G)); PANEL_FENCE(); }
            g128::PleProg PP; PP.pbf = (const bf16*)(P.ws + WS_PBF) + (size_t)L * NTOK * 256; PP.hp = XR; PP.wup = wmix(P, L, WM_UP); PP.wpg = wmix(P, L, WM_PG);
            PP.xin = XR; PP.xout = X2; PP.ssq = (L == 0) ? (const float*)(P.ws + WS_SSQ) : nullptr; PP.rsv = (L == 0) ? nullptr : (const float*)(P.ws + WS_SSQ);
            TIMED(22, g128::stream<g128::PleProg>(lds, PP, NTOK / 128, vcu_, G));
            PANEL_FENCE();
            if (L == 0) TIMED(1, norm1_phase(P, 1, XSrc{nullptr, X2}, vcu_, G));
        }
        if (L == 0) SEAM(pc + 3);
    }
    if (PH_ON(26) && IN(25)) {
        const int vcu_ = vcu_of(); const int G_ = gridDim.x;
        for (int r = 0; r < (NTOK / 128 + G_ - 1) / G_; ++r) {
            const int u = vcu_ + r * G_; FinalRows FR;
            if (u < NTOK / 128) final_norm_load(P, u, FR);
            xcd_barrier(bar);
            if (u < NTOK / 128) final_norm_store(P, u, FR);
        }
    }
    if (PROBE_MASK || PROBE_SEAMS) { const unsigned long long t0_ = __builtin_amdgcn_s_memrealtime(); while (__builtin_amdgcn_s_memrealtime() - t0_ < (unsigned long long)PROBE_MULT * pacc) __builtin_amdgcn_s_sleep(8); }
#undef IN
#undef SEAM
#undef H
#undef ZIN
#undef GB
#undef MB
#undef MLAQ
#undef MLAKV
#undef KPER
#undef cosT
#undef sinT
#undef slot_tok
#undef slot_gate
}

extern "C" void kernel_launch(void* const* d_in, const int* in_sizes, int n_in, void* d_out, int out_size, void* d_ws, size_t ws_size, hipStream_t stream) {
    static int grid = 0;
    if (grid == 0) {
        if (n_in != 37 || out_size != NTOK * D || ws_size < WS_END) { fprintf(stderr, "kernel_launch: unexpected shapes: n_in %d out %d ws %zu\n", n_in, out_size, ws_size); grid = -1; return; }
        int dev = 0, cus = 0, per_cu = 0;
        if (hipGetDevice(&dev) != hipSuccess || hipDeviceGetAttribute(&cus, hipDeviceAttributeMultiprocessorCount, dev) != hipSuccess) { grid = -1; return; }
        if (hipFuncSetAttribute((const void*)mega_fwd, hipFuncAttributeMaxDynamicSharedMemorySize, LDS_BYTES) != hipSuccess) { fprintf(stderr, "kernel_launch: hipFuncSetAttribute failed\n"); grid = -1; return; }
        if (hipOccupancyMaxActiveBlocksPerMultiprocessor(&per_cu, (const void*)mega_fwd, NTHREADS, LDS_BYTES) != hipSuccess || per_cu < 1)
            fprintf(stderr, "kernel_launch: note: occupancy query reports %d workgroups per CU\n", per_cu);
        (void)hipGetLastError();
        grid = cus;
        if (grid != 256) fprintf(stderr, "kernel_launch: note: %d CUs (built for 256)\n", grid);
    }
    if (grid < 0) return;
    if (hipMemsetAsync((char*)d_ws + WS_CTL, 0, CTL_ZERO_BYTES, stream) != hipSuccess) return;
    Params p{};
    for (int i = 0; i < 37; ++i) p.in[i] = (const float*)d_in[i];
    p.out = (float*)d_out; p.ws = (unsigned char*)d_ws;
#if N_LAUNCH_MODE == 1
    p.ph_lo = 0; p.ph_hi = N_PHASES;
    hipLaunchKernelGGL(mega_fwd, dim3(grid), dim3(NTHREADS), LDS_BYTES, stream, p);
#else
    for (int ph = 0; ph < N_PHASES; ++ph) { p.ph_lo = ph; p.ph_hi = ph + 1; hipLaunchKernelGGL(mega_fwd, dim3(grid), dim3(NTHREADS), LDS_BYTES, stream, p); }
#endif
    const hipError_t le = hipPeekAtLastError();
    if (le != hipSuccess) fprintf(stderr, "kernel_launch: launch failed: %s\n", hipGetErrorName(le));
}
```

```cpp
#include <hip/hip_runtime.h>
#include <cstdio>
#include <cstdint>

#define GAS __attribute__((address_space(1)))
#define LAS __attribute__((address_space(3)))
typedef unsigned short bf16;
typedef short bf16x8 __attribute__((ext_vector_type(8)));
typedef short s16x4 __attribute__((ext_vector_type(4)));
typedef float f32x2 __attribute__((ext_vector_type(2)));
typedef float f32x4 __attribute__((ext_vector_type(4)));
typedef float f32x16 __attribute__((ext_vector_type(16)));
typedef unsigned u32x2 __attribute__((ext_vector_type(2)));
typedef unsigned u32x4 __attribute__((ext_vector_type(4)));
typedef __bf16 bf16x2_t __attribute__((ext_vector_type(2)));

constexpr int NB = 4, SEQ = 8192, NTOK = NB * SEQ, D = 1024;
constexpr int ZP = 2304;
constexpr int ZC_U = 0, ZC_FQ = 256, ZC_FK = 512, ZC_FV = 768, ZC_DQ = 1024, ZC_DK = 1280, ZC_DV = 1536, ZC_CQ = 1792, ZC_CKV = 2048, ZC_KPE = 2176;
constexpr int DIN = 2148, DFF = 2816, DFFE = 1408, NE = 8;
constexpr int MOE_ROWS = 2 * NTOK + NE * 256;
constexpr float RMS_EPS = 1e-6f;
constexpr int NWAVES = 8, NTHREADS = 512;

constexpr size_t MiB = 1u << 20;
constexpr size_t WS_CTL = 0, CTL_ZERO_BYTES = 1 * MiB;
constexpr size_t WS_COS = 1 * MiB, WS_SIN = 3 * MiB;
constexpr size_t WS_LOGF = 5 * MiB;
constexpr size_t WS_CDEC = 5 * MiB + 512 * 1024;
constexpr size_t WS_WSUM = 6 * MiB;
constexpr size_t WS_RSTDQ = 6 * MiB + 256 * 1024, WS_RSTDKV = 6 * MiB + 512 * 1024;
constexpr size_t WS_SC = 7 * MiB;
constexpr size_t WS_TOKINFO = 11 * MiB;
constexpr size_t WS_SLOTTOK = 12 * MiB, WS_SLOTGATE = 12 * MiB + 512 * 1024;
constexpr size_t WS_S5W = 13 * MiB;
constexpr size_t WS_PBF = 17 * MiB;
constexpr size_t WS_WMIX = 49 * MiB, WMIX_STRIDE = 20 * MiB;
constexpr size_t WM_IN = 0, WM_G = 4 * MiB + 512 * 1024, WM_B = 12 * MiB + 512 * 1024, WM_O = 14 * MiB + 512 * 1024, WM_PG = 16 * MiB + 512 * 1024,
                 WM_UP = 18 * MiB + 512 * 1024, WM_UQ = 19 * MiB, WM_UKV = 19 * MiB + 256 * 1024, WM_GLU = 19 * MiB + 384 * 1024;
constexpr size_t WS_W13 = 89 * MiB, WS_W2 = 100 * MiB;
constexpr size_t WS_H = 106 * MiB;
constexpr size_t WS_MLAQ = 170 * MiB, WS_MLAKV = 202 * MiB, WS_KPER = 234 * MiB;
constexpr size_t WS_M = 170 * MiB;
constexpr size_t WS_ZIN = 236 * MiB;
constexpr size_t WS_G = 380 * MiB;
constexpr size_t WS_HMID = 236 * MiB;
constexpr size_t WS_U = 236 * MiB;
constexpr size_t WS_WM13 = 418 * MiB, WS_WM2 = 462 * MiB;
constexpr size_t WS_MOEY = 89 * MiB;
constexpr size_t WS_SSQ = 7 * MiB;
constexpr size_t WS_H2 = 300 * MiB;
constexpr size_t WS_END = 484 * MiB;
constexpr int CW_BAR = 4096;
constexpr int CW_MOECNT = 16384;
constexpr int CW_QMAX = 20480;
constexpr int CW_KMAX = 22528;

#define LDS_WAIT() asm volatile("s_waitcnt lgkmcnt(0)" ::: "memory")
#define VM_WAIT() asm volatile("s_waitcnt vmcnt(0)" ::: "memory")
__device__ __forceinline__ unsigned f2bf(float f) { unsigned u = __builtin_bit_cast(unsigned, f); return (u + 0x7fffu + ((u >> 16) & 1u)) >> 16; }
__device__ __forceinline__ unsigned pk2(float lo, float hi) { f32x2 v = {lo, hi}; bf16x2_t b = __builtin_convertvector(v, bf16x2_t); return __builtin_bit_cast(unsigned, b); }
__device__ __forceinline__ float bf2f(unsigned short b) { return __uint_as_float((unsigned)b << 16); }
__device__ __forceinline__ float bflo(unsigned w) { return __uint_as_float(w << 16); }
__device__ __forceinline__ float bfhi(unsigned w) { return __uint_as_float(w & 0xffff0000u); }
constexpr int TID_TAB_OFF = 147456 - 512;
__device__ __forceinline__ unsigned hw_wave_key() { return (unsigned)__builtin_amdgcn_s_getreg((5 << 11) | 4) & 0x3Fu; }
__device__ __forceinline__ int my_tid() {
    unsigned addr = (unsigned)TID_TAB_OFF + 4u * hw_wave_key(); asm volatile("" : "+s"(addr));
    const int wave = __builtin_amdgcn_readfirstlane(*(const LAS int*)(uintptr_t)addr);
    int lane = (int)__builtin_amdgcn_mbcnt_hi(~0u, __builtin_amdgcn_mbcnt_lo(~0u, 0u)); asm volatile("" : "+v"(lane));
    return wave * 64 + lane;
}
__device__ __forceinline__ float shflx(float v, int o, int lane) { return __int_as_float(__builtin_amdgcn_ds_bpermute((lane ^ o) << 2, __float_as_int(v))); }
#define DPP_F(x_, ctrl_, rm_) __int_as_float(__builtin_amdgcn_update_dpp(0, __float_as_int(x_), (ctrl_), (rm_), 0xF, true))
__device__ __forceinline__ float wave_sum(float v) {
    v += DPP_F(v, 0xB1, 0xF); v += DPP_F(v, 0x4E, 0xF); v += DPP_F(v, 0x114, 0xF); v += DPP_F(v, 0x118, 0xF);
    v += DPP_F(v, 0x142, 0xA); v += DPP_F(v, 0x143, 0xC);
    return __int_as_float(__builtin_amdgcn_readlane(__float_as_int(v), 63));
}
__device__ __forceinline__ float sigmoidf_(float x) { return __builtin_amdgcn_rcpf(1.0f + __expf(-x)); }

struct XSrc { const float* f; const bf16* b; };
__device__ __forceinline__ f32x4 ldx4(const XSrc& x, size_t idx) {
    if (x.f) return *(const f32x4*)(x.f + idx);
    const u32x2 w = *(const u32x2*)(x.b + idx); return (f32x4){bflo(w.x), bfhi(w.x), bflo(w.y), bfhi(w.y)};
}
__device__ __forceinline__ bf16* xr_of(float* out) { return (bf16*)((unsigned char*)out + (size_t)NTOK * D * 2); }
#define BODY_IDS() int tid = my_tid(); asm volatile("" : "+v"(tid)); const int lane = tid & 63; const int wave = __builtin_amdgcn_readfirstlane(tid >> 6); \
    int grid_ = gridDim.x; asm volatile("" : "+s"(grid_)); \
    const int gw = blockIdx.x * NWAVES + wave, ngw = grid_ * NWAVES, gtid = blockIdx.x * NTHREADS + tid, gthreads = grid_ * NTHREADS; (void)lane; (void)wave; (void)gw; (void)ngw; (void)gtid; (void)gthreads
#define XB_TMO      128
#define XB_XCNT(j)  (256  + 64 * (j))
#define XB_XSUB(j)  (1280 + 64 * (j))
#define XB_XGEN(j)  (2304 + 64 * (j))
#define XB_TOP      3328
#define XB_TOPGEN   3392
#define XCD_BAR_WORDS 3456
#define XB_SPIN_CAP (1u << 22)

__device__ __forceinline__ unsigned xb_ld(unsigned* p)              { return __hip_atomic_load(p, __ATOMIC_RELAXED, __HIP_MEMORY_SCOPE_AGENT); }
__device__ __forceinline__ unsigned xb_add(unsigned* p, unsigned v) { return __hip_atomic_fetch_add(p, v, __ATOMIC_RELAXED, __HIP_MEMORY_SCOPE_AGENT); }
__device__ __forceinline__ unsigned xb_xcc_id() { return (unsigned)__builtin_amdgcn_s_getreg((3 << 11) | 20) & 0xFu; }
#define XB_SPIN(cond, bar) do { unsigned _sp = 0; while (cond) { __builtin_amdgcn_s_sleep(1); \
    if ((++_sp & 255u) == 0u) { if (xb_ld(&(bar)[XB_TMO])) break; if (_sp > XB_SPIN_CAP) { atomicAdd(&(bar)[XB_TMO], 1u); break; } } } } while (0)

struct XcdBarrier { unsigned* bar; unsigned x; volatile LAS unsigned* st; };

__device__ __forceinline__ XcdBarrier xcd_barrier_post(unsigned* bar, volatile LAS unsigned* st) {
    XcdBarrier b; b.bar = bar; b.x = xb_xcc_id(); b.st = st;
    if (my_tid() == 0) (void)xb_add(&bar[XB_XCNT(b.x)], 1u);
    return b;
}
__device__ __forceinline__ void xcd_barrier_complete(unsigned* bar, unsigned x, unsigned& nloc, unsigned& nx) {
    const unsigned G = gridDim.x * gridDim.y * gridDim.z;
    unsigned sum, cnt, mine, sp = 0u;
    for (;;) {
        sum = 0u; cnt = 0u; mine = 0u;
#pragma unroll
        for (unsigned j = 0; j < 16; ++j) { const unsigned c = xb_ld(&bar[XB_XCNT(j)]); sum += c; cnt += (c > 0u) ? 1u : 0u; mine = (j == x) ? c : mine; }
        if (sum == G) break;
        __builtin_amdgcn_s_sleep(1);
        if ((++sp & 255u) == 0u) { if (xb_ld(&bar[XB_TMO])) break; if (sp > XB_SPIN_CAP) { atomicAdd(&bar[XB_TMO], 1u); break; } }
    }
    nloc = mine > 0u ? mine : 1u; nx = cnt > 0u ? cnt : 1u;
}
__device__ __forceinline__ void xcd_barrier(const XcdBarrier& b) {
    asm volatile("s_waitcnt vmcnt(0)" ::: "memory");
    __syncthreads();
    if (my_tid() == 0) {
        unsigned* bar = b.bar;
        __builtin_amdgcn_s_waitcnt(0);
        unsigned nloc = b.st[0], nx = b.st[1];
        if (nloc == 0u) { xcd_barrier_complete(bar, b.x, nloc, nx); b.st[0] = nloc; b.st[1] = nx; }
        const unsigned old = xb_add(&bar[XB_XSUB(b.x)], 1u);
        const unsigned gen = old / nloc;
        if (old + 1u == (gen + 1u) * nloc) {
            __builtin_amdgcn_fence(__ATOMIC_RELEASE, "agent");
            asm volatile("s_waitcnt vmcnt(0)" ::: "memory");
            const unsigned og = xb_add(&bar[XB_TOP], 1u);
            const unsigned tg = og / nx;
            if (og + 1u == (tg + 1u) * nx) xb_add(&bar[XB_TOPGEN], 1u);
            else XB_SPIN(xb_ld(&bar[XB_TOPGEN]) == tg, bar);
            __builtin_amdgcn_fence(__ATOMIC_ACQUIRE, "agent");
            xb_add(&bar[XB_XGEN(b.x)], 1u);
            asm volatile("s_waitcnt vmcnt(0)" ::: "memory");
        } else {
            XB_SPIN(xb_ld(&bar[XB_XGEN(b.x)]) == gen, bar);
            __builtin_amdgcn_fence(__ATOMIC_ACQUIRE, "agent");
            asm volatile("s_waitcnt vmcnt(0)" ::: "memory");
        }
    }
    __syncthreads();
}
namespace pg8 {
constexpr int BM = 256, BK = 64, HALF = 128, HTB = HALF * BK * 2, STAGE_BYTES = 8 * HTB, NXCD = 8, WGM = 8;
__host__ __device__ __forceinline__ int lds_byte(int r, int c) { const int st = (r >> 4) * 2 + (c >> 5), rr = r & 15, cc = c & 31, ob = rr * 64 + cc * 2; return st * 1024 + (ob ^ (((ob >> 9) & 1) << 5)); }
__host__ __device__ __forceinline__ void stage_rc(int b, int& R, int& C) { const int st = b / 1024, sb = b % 1024, swz = sb ^ (((sb >> 9) & 1) << 5); R = (st >> 1) * 16 + swz / 64; C = (st & 1) * 32 + (swz % 64) / 2; }
__host__ __device__ __forceinline__ int perm32(int rho) { const int n = rho >> 4, i = rho & 15; return 8 * (i >> 2) + 4 * n + (i & 3); }

struct Unit { int pm, pn; };
struct Gemm { const bf16* A; const bf16* Bt; int lda, ldb, K; const int* gidx; };

struct StaticOrder {
    int nM, nN, nwg, G, c;
    __host__ __device__ void init(int M, int N, int G_, int c_) { nM = M / BM; nN = N / BM; nwg = nM * nN; G = G_; c = c_; }
    __host__ __device__ __forceinline__ bool next(int i, Unit& u) const {
        const long L = (long)i * G + c; if (L >= nwg) return false;
        int wgid = (int)L; { const int q = nwg / NXCD, r = nwg % NXCD, xcd = wgid % NXCD, off = wgid / NXCD; wgid = (xcd < r ? xcd * (q + 1) : r * (q + 1) + (xcd - r) * q) + off; }
        const int nig = WGM * nN, gid = wgid / nig, fm = gid * WGM, gsz = (nM - fm) < WGM ? (nM - fm) : WGM;
        u.pm = fm + ((wgid % nig) % gsz); u.pn = (wgid % nig) / gsz; return true;
    }
};

template <class Epi, class Sched, bool ALIGN_EPI, bool GATHER>
__device__ __forceinline__ void gemm_phase(LAS unsigned char* lds, const Gemm g, const Sched& S, const Epi& E) {
    int tid = my_tid(); asm volatile("" : "+v"(tid));
    const int wid = __builtin_amdgcn_readfirstlane(tid >> 6), lane = tid & 63, wr = wid >> 2, wc = wid & 3, fr = lane & 15, fq = lane >> 4;
    int Kq = g.K; asm volatile("" : "+s"(Kq));
    const int K = Kq, nt = K / BK;
    int RA[2], CA[2];
    unsigned voffA[2], voffB[2];
#pragma unroll
    for (int i = 0; i < 2; ++i) { int R, C; stage_rc(tid * 16 + i * 8192, R, C); const int Rb = Epi::PERM ? ((R & ~31) + perm32(R & 31)) : R;
        RA[i] = R; CA[i] = C; voffA[i] = (unsigned)(R * g.lda + C) * 2u; voffB[i] = (unsigned)(Rb * g.ldb + C) * 2u; }
    const size_t kstep = (size_t)(BK * 2);
    const size_t hstepB = (size_t)HALF * g.ldb * 2, tstepB = 2 * hstepB;
    const size_t hstepA = (size_t)HALF * g.lda * 2, tstepA = 2 * hstepA;
    const unsigned ldsw = (unsigned)wid * 1024u;
    const int aoff = lds_byte(wr * 64 + fr, fq * 8), boff = lds_byte(wc * 32 + fr, fq * 8);
#define PG8_SA(b, h) (((b) * 2 + (h)) * HTB)
#define PG8_SB(b, h) ((4 + (b) * 2 + (h)) * HTB)
#define PG8_STAGEB(bufoff, gbase) do { _Pragma("unroll") for (int _i = 0; _i < 2; ++_i) \
        __builtin_amdgcn_global_load_lds((const unsigned*)((const char*)(gbase) + voffB[_i]), (LAS unsigned*)(lds + (bufoff) + ldsw + _i * 8192), 16, 0, 0); } while (0)
#define PG8_STAGEA(bufoff, kptr, isnext, h) do { _Pragma("unroll") for (int _i = 0; _i < 2; ++_i) { const char* _p; \
        if constexpr (GATHER) _p = (const char*)(kptr) + ((isnext) ? nvo[h][_i] : cvo[h][_i]); else _p = (const char*)(kptr) + (size_t)(h) * hstepA + voffA[_i]; \
        __builtin_amdgcn_global_load_lds((const unsigned*)_p, (LAS unsigned*)(lds + (bufoff) + ldsw + _i * 8192), 16, 0, 0); } } while (0)
#define PG8_LDA(dst, b, h) do { _Pragma("unroll") for (int m = 0; m < 4; ++m) _Pragma("unroll") for (int k = 0; k < 2; ++k) dst[m][k] = *(const LAS bf16x8*)(lds + PG8_SA(b, h) + aoff + m * 2048 + k * 1024); } while (0)
#define PG8_LDB(dst, b, h) do { _Pragma("unroll") for (int n = 0; n < 2; ++n) _Pragma("unroll") for (int k = 0; k < 2; ++k) dst[n][k] = *(const LAS bf16x8*)(lds + PG8_SB(b, h) + boff + n * 2048 + k * 1024); } while (0)
#define PG8_MMA(ai, bj, At, Bt) do { __builtin_amdgcn_s_setprio(1); _Pragma("unroll") for (int m = 0; m < 4; ++m) _Pragma("unroll") for (int n = 0; n < 2; ++n) _Pragma("unroll") for (int k = 0; k < 2; ++k) \
        acc[ai][bj][m][n] = __builtin_amdgcn_mfma_f32_16x16x32_bf16(Bt[n][k], At[m][k], acc[ai][bj][m][n], 0, 0, 0); __builtin_amdgcn_s_setprio(0); } while (0)
#define PG8_WAIT_V(n) asm volatile("s_waitcnt vmcnt(" #n ")" ::: "memory")
#define PG8_WAIT_L(n) asm volatile("s_waitcnt lgkmcnt(" #n ")" ::: "memory")
#define PG8_BAR __builtin_amdgcn_s_barrier()
#define PG8_SCHED __builtin_amdgcn_sched_barrier(0)
#define PG8_VOA(vo, u) do { _Pragma("unroll") for (int _h = 0; _h < 2; ++_h) _Pragma("unroll") for (int _i = 0; _i < 2; ++_i) { \
        int _row = (u).pm * BM + _h * HALF + RA[_i]; if (GATHER) { _row = g.gidx[_row]; _row = _row < 0 ? 0 : _row; } \
        (vo)[_h][_i] = (unsigned)_row * (unsigned)(g.lda * 2) + (unsigned)(CA[_i] * 2); } } while (0)
    Unit cur, nxt; int ui = 0;
    if (!S.next(0, cur)) return;
    f32x4 acc[2][2][4][2];
#pragma unroll
    for (int a = 0; a < 2; ++a)
#pragma unroll
        for (int b = 0; b < 2; ++b)
#pragma unroll
            for (int m = 0; m < 4; ++m)
#pragma unroll
                for (int n = 0; n < 2; ++n) acc[a][b][m][n] = (f32x4){0.f, 0.f, 0.f, 0.f};
    bf16x8 At[4][2], B0[2][2], B1[2][2];
    unsigned cvo[2][2], nvo[2][2];
    if constexpr (GATHER) { PG8_VOA(cvo, cur); PG8_VOA(nvo, cur); }
    const char* cA = (const char*)g.A + (GATHER ? (size_t)0 : (size_t)cur.pm * tstepA); const char* cB = (const char*)g.Bt + (size_t)cur.pn * tstepB;
    PG8_STAGEB(PG8_SB(0, 0), cB); PG8_STAGEB(PG8_SB(0, 1), cB + hstepB); PG8_STAGEA(PG8_SA(0, 0), cA, false, 0); PG8_STAGEA(PG8_SA(0, 1), cA, false, 1);
    if (wr == 1) PG8_BAR;
    PG8_WAIT_V(2); PG8_BAR;
    PG8_STAGEB(PG8_SB(1, 0), cB + kstep); PG8_STAGEA(PG8_SA(1, 0), cA + kstep, false, 0); PG8_STAGEB(PG8_SB(1, 1), cB + hstepB + kstep);
    PG8_WAIT_V(6); PG8_BAR;
    for (;;) {
        const bool has_next = S.next(ui + 1, nxt);
        if constexpr (GATHER) { if (has_next) { PG8_VOA(nvo, nxt); } }
        const char* nA = (GATHER || !has_next) ? cA : (const char*)g.A + (size_t)nxt.pm * tstepA;
        const char* nB = has_next ? (const char*)g.Bt + (size_t)nxt.pn * tstepB : cB;
#pragma nounroll
        for (int t = 0; t < nt; t += 2) {
            const bool last = (t == nt - 2);
            const char* a1 = cA + (size_t)(t + 1) * kstep;
            const char* a2 = last ? nA : cA + (size_t)(t + 2) * kstep; const char* b2 = last ? nB : cB + (size_t)(t + 2) * kstep;
            const char* a3 = a2 + kstep; const char* b3 = b2 + kstep;
            PG8_LDB(B0, 0, 0); PG8_LDB(B1, 0, 1); PG8_SCHED; PG8_LDA(At, 0, 0); PG8_STAGEA(PG8_SA(1, 1), a1, false, 1);
            PG8_WAIT_V(8); PG8_WAIT_L(0); PG8_BAR; PG8_MMA(0, 0, At, B0); PG8_MMA(0, 1, At, B1); PG8_BAR; PG8_SCHED;
            PG8_LDA(At, 0, 1); PG8_STAGEB(PG8_SB(0, 0), b2); PG8_STAGEB(PG8_SB(0, 1), b2 + hstepB); PG8_STAGEA(PG8_SA(0, 0), a2, last, 0);
            PG8_WAIT_V(8); PG8_WAIT_L(0); PG8_BAR; PG8_MMA(1, 0, At, B0); PG8_MMA(1, 1, At, B1); PG8_BAR; PG8_SCHED;
            PG8_LDB(B0, 1, 0); PG8_LDB(B1, 1, 1); PG8_SCHED; PG8_LDA(At, 1, 0); PG8_STAGEA(PG8_SA(0, 1), a2, last, 1);
            PG8_WAIT_V(8); PG8_WAIT_L(0); PG8_BAR; PG8_MMA(0, 0, At, B0); PG8_MMA(0, 1, At, B1); PG8_BAR; PG8_SCHED;
            PG8_LDA(At, 1, 1); PG8_STAGEB(PG8_SB(1, 0), b3); PG8_STAGEB(PG8_SB(1, 1), b3 + hstepB); PG8_STAGEA(PG8_SA(1, 0), a3, last, 0);
            PG8_WAIT_V(8); PG8_WAIT_L(0); PG8_BAR; PG8_MMA(1, 0, At, B0); PG8_MMA(1, 1, At, B1); PG8_BAR; PG8_SCHED;
        }
        if constexpr (ALIGN_EPI) { if (wr == 0) PG8_BAR; }
        E(acc, cur, wr, wc, fr, fq);
        if (!has_next) break;
#pragma unroll
        for (int a = 0; a < 2; ++a)
#pragma unroll
            for (int b = 0; b < 2; ++b)
#pragma unroll
                for (int m = 0; m < 4; ++m)
#pragma unroll
                    for (int n = 0; n < 2; ++n) acc[a][b][m][n] = (f32x4){0.f, 0.f, 0.f, 0.f};
        cur = nxt; cA = nA; cB = nB; ++ui;
        if constexpr (GATHER) {
#pragma unroll
            for (int _h = 0; _h < 2; ++_h)
#pragma unroll
                for (int _i = 0; _i < 2; ++_i) cvo[_h][_i] = nvo[_h][_i]; }
        if constexpr (ALIGN_EPI) { if (wr == 1) PG8_BAR; }
    }
    PG8_WAIT_V(0);
    if constexpr (!ALIGN_EPI) { if (wr == 0) PG8_BAR; }
    PG8_BAR;
#undef PG8_SA
#undef PG8_SB
#undef PG8_STAGEA
#undef PG8_STAGEB
#undef PG8_LDA
#undef PG8_LDB
#undef PG8_MMA
#undef PG8_WAIT_V
#undef PG8_WAIT_L
#undef PG8_BAR
#undef PG8_SCHED
#undef PG8_VOA
}

template <class Epi, class Sched, bool GATHER>
__device__ __forceinline__ void gemm_phase_naive(const Gemm g, const Sched& S, const Epi& E) {
    const int tid = threadIdx.x, wid = tid >> 6, lane = tid & 63, wr = wid >> 2, wc = wid & 3, fr = lane & 15, fq = lane >> 4;
    Unit u;
    for (int ui = 0; S.next(ui, u); ++ui) {
        f32x4 acc[2][2][4][2];
#pragma unroll
        for (int a = 0; a < 2; ++a)
#pragma unroll
            for (int b = 0; b < 2; ++b)
#pragma unroll
                for (int m = 0; m < 4; ++m)
#pragma unroll
                    for (int n = 0; n < 2; ++n) acc[a][b][m][n] = (f32x4){0.f, 0.f, 0.f, 0.f};
        const bf16* arow[2][4];
#pragma unroll
        for (int ai = 0; ai < 2; ++ai)
#pragma unroll
            for (int m = 0; m < 4; ++m) { int r = u.pm * BM + ai * HALF + wr * 64 + m * 16 + fr; if (GATHER) { r = g.gidx[r]; r = r < 0 ? 0 : r; } arow[ai][m] = g.A + (size_t)r * g.lda; }
        for (int k = 0; k < g.K; k += 4) {
            float av[2][4][4];
#pragma unroll
            for (int ai = 0; ai < 2; ++ai)
#pragma unroll
                for (int m = 0; m < 4; ++m) { const u32x2 w = *(const u32x2*)(arow[ai][m] + k); av[ai][m][0] = bflo(w.x); av[ai][m][1] = bfhi(w.x); av[ai][m][2] = bflo(w.y); av[ai][m][3] = bfhi(w.y); }
#pragma unroll
            for (int bj = 0; bj < 2; ++bj)
#pragma unroll
                for (int n = 0; n < 2; ++n)
#pragma unroll
                    for (int e = 0; e < 4; ++e) {
                        const int col = u.pn * BM + bj * HALF + wc * 32 + (Epi::PERM ? (8 * fq + 4 * n) : (16 * n + 4 * fq)) + e;
                        const u32x2 w = *(const u32x2*)(g.Bt + (size_t)col * g.ldb + k);
                        const float b0 = bflo(w.x), b1 = bfhi(w.x), b2 = bflo(w.y), b3 = bfhi(w.y);
#pragma unroll
                        for (int ai = 0; ai < 2; ++ai)
#pragma unroll
                            for (int m = 0; m < 4; ++m) acc[ai][bj][m][n][e] += av[ai][m][0] * b0 + av[ai][m][1] * b1 + av[ai][m][2] * b2 + av[ai][m][3] * b3;
                    }
        }
        E(acc, u, wr, wc, fr, fq);
    }
    VM_WAIT(); __syncthreads();
}
}
namespace g128 {
using pg8::lds_byte; using pg8::stage_rc; using pg8::HTB; using pg8::BK;
struct Seg { const bf16* A; const bf16* B; int lda, ldb, nt; };
typedef f32x4 acc_t[2][4][2];

template <class Prog>
__device__ __forceinline__ void stream(LAS unsigned char* lds, Prog& P, int nunits, int first, int stride) {
    int tid = my_tid(); asm volatile("" : "+v"(tid));
    const int wid = __builtin_amdgcn_readfirstlane(tid >> 6), lane = tid & 63, wr = wid >> 2, wc = wid & 3, fr = lane & 15, fq = lane >> 4;
    int RA[2], CA[2], RB[2];
#pragma unroll
    for (int i = 0; i < 2; ++i) { stage_rc(tid * 16 + i * 8192, RA[i], CA[i]); RB[i] = (RA[i] & ~31) + pg8::perm32(RA[i] & 31); }
    const unsigned ldsw = (unsigned)wid * 1024u;
    const int aoff = lds_byte(wr * 64 + fr, fq * 8), boff = lds_byte(wc * 32 + fr, fq * 8);
#define G_SA(b) ((b) * HTB)
#define G_SB(b, h) ((2 + (b) * 2 + (h)) * HTB)
#define G_STAGE(bufoff, base, ld, kbyte, RR) do { _Pragma("unroll") for (int _i = 0; _i < 2; ++_i) \
        __builtin_amdgcn_global_load_lds((const unsigned*)((const char*)(base) + (size_t)(kbyte) + (unsigned)(RR[_i] * (ld) + CA[_i]) * 2u), (LAS unsigned*)(lds + (bufoff) + ldsw + _i * 8192), 16, 0, 0); } while (0)
#define G_STAGE_A(b, S, j) G_STAGE(G_SA(b), (S).A, (S).lda, (j) * 128, RA)
#define G_STAGE_B(b, h, S, j) G_STAGE(G_SB(b, h), (const char*)(S).B + (size_t)(h) * 128 * (S).ldb * 2, (S).ldb, (j) * 128, RB)
#define G_LDA(dst, b) do { _Pragma("unroll") for (int m = 0; m < 4; ++m) _Pragma("unroll") for (int k = 0; k < 2; ++k) dst[m][k] = *(const LAS bf16x8*)(lds + G_SA(b) + aoff + m * 2048 + k * 1024); } while (0)
#define G_LDB(dst, b, h) do { _Pragma("unroll") for (int n = 0; n < 2; ++n) _Pragma("unroll") for (int k = 0; k < 2; ++k) dst[n][k] = *(const LAS bf16x8*)(lds + G_SB(b, h) + boff + n * 2048 + k * 1024); } while (0)
#define G_MMA(bj, At, Bt) do { __builtin_amdgcn_s_setprio(1); _Pragma("unroll") for (int m = 0; m < 4; ++m) _Pragma("unroll") for (int n = 0; n < 2; ++n) _Pragma("unroll") for (int k = 0; k < 2; ++k) \
        acc[bj][m][n] = __builtin_amdgcn_mfma_f32_16x16x32_bf16(Bt[n][k], At[m][k], acc[bj][m][n], 0, 0, 0); __builtin_amdgcn_s_setprio(0); } while (0)
#define G_WAIT_V(n) asm volatile("s_waitcnt vmcnt(" #n ")" ::: "memory")
#define G_WAIT_L(n) asm volatile("s_waitcnt lgkmcnt(" #n ")" ::: "memory")
#define G_BAR __builtin_amdgcn_s_barrier()
#define G_SCHED __builtin_amdgcn_sched_barrier(0)
    if (first >= nunits) return;
    P.reset();
    int ucur = first, scur = 0;
    Seg cur, nxt;
    P.seg(ucur, scur, cur);
    acc_t acc;
    P.init(ucur, scur, acc, wr, wc, fr, fq);
    bf16x8 At[4][2], B0[2][2], B1[2][2];
    G_STAGE_B(0, 0, cur, 0); G_STAGE_A(0, cur, 0); G_STAGE_B(0, 1, cur, 0);
    if (wr == 1) G_BAR;
    G_WAIT_V(2); G_BAR;
    G_STAGE_A(1, cur, 1); G_STAGE_B(1, 0, cur, 1);
    G_WAIT_V(4); G_BAR;
#define G_TILE(t_, b_) do { const bool n1_ = ((t_) + 1 >= nt), n2_ = ((t_) + 2 >= nt); const int j1_ = n1_ ? ((t_) + 1 - nt) : ((t_) + 1), j2_ = n2_ ? ((t_) + 2 - nt) : ((t_) + 2); \
        G_LDB(B0, b_, 0); G_SCHED; G_LDA(At, b_); \
        if (n1_) G_STAGE_B((b_) ^ 1, 1, nxt, j1_); else G_STAGE_B((b_) ^ 1, 1, cur, j1_); \
        G_WAIT_V(6); G_WAIT_L(0); G_BAR; G_MMA(0, At, B0); G_BAR; G_SCHED; \
        G_LDB(B1, b_, 1); \
        if (n2_) { G_STAGE_A(b_, nxt, j2_); G_STAGE_B(b_, 0, nxt, j2_); } else { G_STAGE_A(b_, cur, j2_); G_STAGE_B(b_, 0, cur, j2_); } \
        G_WAIT_V(6); G_WAIT_L(0); G_BAR; G_MMA(1, At, B1); G_BAR; G_SCHED; } while (0)
    for (;;) {
        int unxt = ucur, snxt = scur + 1; bool more = true;
        if (snxt == Prog::NSEG) { snxt = 0; unxt = ucur + stride; if (unxt >= nunits) { more = false; unxt = ucur; snxt = scur; } }
        P.seg(unxt, snxt, nxt);
        int ntq = cur.nt; asm volatile("" : "+s"(ntq)); const int nt = ntq;
#pragma nounroll
        for (int t = 0; t < nt; t += 2) { G_TILE(t, 0); G_TILE(t + 1, 1); }
        P.done(ucur, scur, acc, wr, wc, fr, fq);
        if (!more) break;
        P.init(unxt, snxt, acc, wr, wc, fr, fq);
        ucur = unxt; scur = snxt; cur = nxt;
    }
    G_WAIT_V(0);
    if (wr == 0) G_BAR;
    G_BAR;
#undef G_SA
#undef G_SB
#undef G_STAGE
#undef G_STAGE_A
#undef G_STAGE_B
#undef G_LDA
#undef G_LDB
#undef G_MMA
#undef G_WAIT_V
#undef G_WAIT_L
#undef G_BAR
#undef G_SCHED
#undef G_TILE
}

struct MergeProg {
    static constexpr int NSEG = 8;
    const bf16* Hn; const bf16* zin; const bf16* wg; const bf16* wb; const float* bg; bf16* M;
    __device__ __forceinline__ void reset() {
#pragma unroll
        for (int a = 0; a < 2; ++a)
#pragma unroll
            for (int b = 0; b < 4; ++b)
#pragma unroll
                for (int c = 0; c < 2; ++c) { g[a][b][c] = (u32x2){0u, 0u}; macc[a][b][c] = (u32x2){0u, 0u}; } }
    u32x2 g[2][4][2]; u32x2 macc[2][4][2];
    __device__ __forceinline__ void seg(int u, int s, Seg& S) const {
        const int pm = u >> 2, pn = u & 3, k = s >> 1;
        if ((s & 1) == 0) { S.A = Hn + (size_t)pm * 128 * D; S.lda = D; S.B = wg + ((size_t)k * D + pn * 256) * D; S.ldb = D; S.nt = D / 64; }
        else { const int ycol = (k == 0) ? ZC_U : (k == 1) ? ZC_FQ : (k == 2) ? ZC_CQ : ZC_DQ;
               S.A = zin + (size_t)pm * 128 * ZP + ycol; S.lda = ZP; S.B = wb + ((size_t)k * D + pn * 256) * 256; S.ldb = 256; S.nt = 4; }
    }
    __device__ __forceinline__ void init(int u, int s, acc_t& acc, int wr, int wc, int fr, int fq) {
        const int pn = u & 3, k = s >> 1;
        if ((s & 1) == 0) {
#pragma unroll
            for (int bj = 0; bj < 2; ++bj)
#pragma unroll
                for (int n = 0; n < 2; ++n) { const f32x4 bv = *(const f32x4*)(bg + (size_t)k * D + pn * 256 + bj * 128 + wc * 32 + 8 * fq + 4 * n);
#pragma unroll
                    for (int m = 0; m < 4; ++m) acc[bj][m][n] = bv; }
            if (s == 0) {
#pragma unroll
                for (int bj = 0; bj < 2; ++bj)
#pragma unroll
                    for (int m = 0; m < 4; ++m)
#pragma unroll
                        for (int n = 0; n < 2; ++n) macc[bj][m][n] = (u32x2){0u, 0u}; }
        } else {
#pragma unroll
            for (int bj = 0; bj < 2; ++bj)
#pragma unroll
                for (int m = 0; m < 4; ++m)
#pragma unroll
                    for (int n = 0; n < 2; ++n) acc[bj][m][n] = (f32x4){0.f, 0.f, 0.f, 0.f};
        }
    }
    __device__ __forceinline__ void done(int u, int s, const acc_t& acc, int wr, int wc, int fr, int fq) {
        if ((s & 1) == 0) {
#pragma unroll
            for (int bj = 0; bj < 2; ++bj)
#pragma unroll
                for (int m = 0; m < 4; ++m)
#pragma unroll
                    for (int n = 0; n < 2; ++n) { const f32x4 a = acc[bj][m][n]; u32x2 w; w.x = pk2(sigmoidf_(a[0]), sigmoidf_(a[1])); w.y = pk2(sigmoidf_(a[2]), sigmoidf_(a[3])); g[bj][m][n] = w; }
        } else {
#pragma unroll
            for (int bj = 0; bj < 2; ++bj)
#pragma unroll
                for (int m = 0; m < 4; ++m)
#pragma unroll
                    for (int n = 0; n < 2; ++n) { const u32x2 w = g[bj][m][n], q = macc[bj][m][n]; const f32x4 v = (f32x4){bflo(q.x), bfhi(q.x), bflo(q.y), bfhi(q.y)} + (f32x4){bflo(w.x), bfhi(w.x), bflo(w.y), bfhi(w.y)} * acc[bj][m][n];
                        u32x2 r; r.x = pk2(v[0], v[1]); r.y = pk2(v[2], v[3]); macc[bj][m][n] = r; }
            if (s == NSEG - 1) { const int pm = u >> 2, pn = u & 3;
#pragma unroll
                for (int m = 0; m < 4; ++m) { bf16* rp = M + (size_t)(pm * 128 + wr * 64 + m * 16 + fr) * D + pn * 256 + wc * 32 + 8 * fq;
#pragma unroll
                    for (int bj = 0; bj < 2; ++bj) *(u32x4*)(rp + bj * 128) = (u32x4){macc[bj][m][0].x, macc[bj][m][0].y, macc[bj][m][1].x, macc[bj][m][1].y}; } }
        }
    }
};

struct PleProg {
    static constexpr int NSEG = 8;
    const bf16* pbf; const bf16* hp; const bf16* wup; const bf16* wpg; const bf16* xin; bf16* xout;
    const float* rsv;
    const float* ssq;
    u32x2 uu[2][4][2]; float rs[4];
    __device__ __forceinline__ void reset() {
#pragma unroll
        for (int m = 0; m < 4; ++m) rs[m] = 1.0f;
#pragma unroll
        for (int a = 0; a < 2; ++a)
#pragma unroll
            for (int b = 0; b < 4; ++b)
#pragma unroll
                for (int c = 0; c < 2; ++c) uu[a][b][c] = (u32x2){0u, 0u}; }
    __device__ __forceinline__ void seg(int u, int s, Seg& S) const {
        const int pn = s >> 1;
        if ((s & 1) == 0) { S.A = pbf + (size_t)u * 128 * 256; S.lda = 256; S.B = wup + (size_t)pn * 256 * 256; S.ldb = 256; S.nt = 4; }
        else { S.A = hp + (size_t)u * 128 * D; S.lda = D; S.B = wpg + (size_t)pn * 256 * D; S.ldb = D; S.nt = D / 64; }
    }
    __device__ __forceinline__ void init(int u, int s, acc_t& acc, int wr, int wc, int fr, int fq) {
#pragma unroll
        for (int bj = 0; bj < 2; ++bj)
#pragma unroll
            for (int m = 0; m < 4; ++m)
#pragma unroll
                for (int n = 0; n < 2; ++n) acc[bj][m][n] = (f32x4){0.f, 0.f, 0.f, 0.f};
        if (s == 0 && rsv) {
#pragma unroll
            for (int m = 0; m < 4; ++m) rs[m] = rsv[u * 128 + wr * 64 + m * 16 + fr]; }
        if (s == 0 && ssq) {
#pragma unroll
            for (int m = 0; m < 4; ++m) { const f32x4* rp = (const f32x4*)ssq + (size_t)(u * 128 + wr * 64 + m * 16 + fr) * 4; const f32x4 s0 = rp[0], s1 = rp[1], s2 = rp[2], s3 = rp[3];
                const float tot = (((s0[0] + s0[1]) + (s0[2] + s0[3])) + ((s1[0] + s1[1]) + (s1[2] + s1[3]))) + (((s2[0] + s2[1]) + (s2[2] + s2[3])) + ((s3[0] + s3[1]) + (s3[2] + s3[3])));
                rs[m] = __builtin_amdgcn_rsqf(tot * (1.0f / D) + RMS_EPS); } }
    }
    __device__ __forceinline__ void done(int u, int s, const acc_t& acc, int wr, int wc, int fr, int fq) {
        if ((s & 1) == 0) {
#pragma unroll
            for (int bj = 0; bj < 2; ++bj)
#pragma unroll
                for (int m = 0; m < 4; ++m)
#pragma unroll
                    for (int n = 0; n < 2; ++n) { const f32x4 a = acc[bj][m][n]; u32x2 w; w.x = pk2(a[0], a[1]); w.y = pk2(a[2], a[3]); uu[bj][m][n] = w; }
        } else { const int pn = s >> 1;
#pragma unroll
            for (int m = 0; m < 4; ++m) { const size_t ro = (size_t)(u * 128 + wr * 64 + m * 16 + fr) * D + pn * 256 + wc * 32 + 8 * fq; const bf16* rpi = xin + ro; bf16* rp = xout + ro; u32x4 xv[2]; const float rsm = rs[m];
#pragma unroll
                for (int bj = 0; bj < 2; ++bj) xv[bj] = *(const u32x4*)(rpi + bj * 128);
#pragma unroll
                for (int bj = 0; bj < 2; ++bj) { const u32x4 xw = xv[bj]; f32x4 r[2];
#pragma unroll
                    for (int n = 0; n < 2; ++n) { const u32x2 w = uu[bj][m][n]; f32x4 v = acc[bj][m][n] * rsm;
                        v[0] = sigmoidf_(v[0]); v[1] = sigmoidf_(v[1]); v[2] = sigmoidf_(v[2]); v[3] = sigmoidf_(v[3]);
                        const f32x4 xo = n == 0 ? (f32x4){bflo(xw.x), bfhi(xw.x), bflo(xw.y), bfhi(xw.y)} : (f32x4){bflo(xw.z), bfhi(xw.z), bflo(xw.w), bfhi(xw.w)};
                        r[n] = xo + (f32x4){bflo(w.x), bfhi(w.x), bflo(w.y), bfhi(w.y)} * v; }
                    *(u32x4*)(rp + bj * 128) = (u32x4){pk2(r[0][0], r[0][1]), pk2(r[0][2], r[0][3]), pk2(r[1][0], r[1][1]), pk2(r[1][2], r[1][3])}; } } }
    }
};
}
namespace epi {
using pg8::Unit; using pg8::BM; using pg8::HALF;
__device__ __forceinline__ void epi_fence() { asm volatile("" ::: "memory"); }
#define EPI_FENCE epi_fence()
#define EPI_LOOP_ROWS for (int ai = 0; ai < 2; ++ai) _Pragma("unroll") for (int m = 0; m < 4; ++m)
#define EPI_LOOP_COLS for (int bj = 0; bj < 2; ++bj) _Pragma("unroll") for (int n = 0; n < 2; ++n)
#define EPI_ROW (u.pm * BM + ai * HALF + wr * 64 + m * 16 + fr)
#define EPI_COLT (bj * HALF + wc * 32 + n * 16 + 4 * fq)
typedef f32x4 acc_t[2][2][4][2];
#define EPI_C8(bj_) ((bj_) * HALF + wc * 32 + 8 * fq)
__device__ __forceinline__ u32x4 pack8(f32x4 a, f32x4 b) { return (u32x4){pk2(a[0], a[1]), pk2(a[2], a[3]), pk2(b[0], b[1]), pk2(b[2], b[3])}; }
__device__ __forceinline__ u32x2 pack4(f32x4 v) { u32x2 w; w.x = pk2(v[0], v[1]); w.y = pk2(v[2], v[3]); return w; }
__device__ __forceinline__ f32x4 unpack4(u32x2 w) { return (f32x4){bflo(w.x), bfhi(w.x), bflo(w.y), bfhi(w.y)}; }

struct EpiStore {
    static constexpr bool PERM = true;
    bf16* O; int ldc; int pn0;
    __device__ __forceinline__ void operator()(const acc_t& acc, const Unit& u, int wr, int wc, int fr, int fq) const {
#pragma unroll
        EPI_LOOP_ROWS { bf16* rp = O + (size_t)EPI_ROW * ldc + (u.pn - pn0) * BM + wc * 32 + 8 * fq;
#pragma unroll
            for (int bj = 0; bj < 2; ++bj) { const u32x2 lo = pack4(acc[ai][bj][m][0]), hi = pack4(acc[ai][bj][m][1]); *(u32x4*)(rp + bj * HALF) = (u32x4){lo.x, lo.y, hi.x, hi.y}; } }
    }
};
struct EpiRowScale {
    static constexpr bool PERM = true;
    bf16* O; int ldc; const float* rs;
    __device__ __forceinline__ void operator()(const acc_t& acc, const Unit& u, int wr, int wc, int fr, int fq) const {
        float sv[2][4];
#pragma unroll
        EPI_LOOP_ROWS sv[ai][m] = rs[EPI_ROW];
#pragma unroll
        EPI_LOOP_ROWS { const int row = EPI_ROW; const float s = sv[ai][m]; bf16* rp = O + (size_t)row * ldc + u.pn * BM;
#pragma unroll
            for (int bj = 0; bj < 2; ++bj) *(u32x4*)(rp + EPI_C8(bj)) = pack8(acc[ai][bj][m][0] * s, acc[ai][bj][m][1] * s); }
    }
};
struct EpiMlaQ {
    static constexpr bool PERM = false;
    bf16* O; const float* rs; const float* cosT; const float* sinT;
    __device__ __forceinline__ void operator()(const acc_t& acc, const Unit& u, int wr, int wc, int fr, int fq) const {
        float sv[2][4]; f32x4 csv[2], snv[2];
#pragma unroll
        EPI_LOOP_ROWS sv[ai][m] = rs[EPI_ROW];
        { const int row = u.pm * BM + wr * 64 + fr; csv[0] = *(const f32x4*)(cosT + (size_t)row * 16 + 4 * fq); snv[0] = *(const f32x4*)(sinT + (size_t)row * 16 + 4 * fq); }
#pragma unroll
        for (int it = 0; it < 8; ++it) { const int ai = it >> 2, m = it & 3;
            if (it + 1 < 8) { const int row = u.pm * BM + ((it + 1) >> 2) * HALF + wr * 64 + ((it + 1) & 3) * 16 + fr;
                csv[(it + 1) & 1] = *(const f32x4*)(cosT + (size_t)row * 16 + 4 * fq); snv[(it + 1) & 1] = *(const f32x4*)(sinT + (size_t)row * 16 + 4 * fq); }
            const int row = EPI_ROW; const float s = sv[ai][m]; bf16* rp = O + (size_t)row * 512 + u.pn * BM;
            const f32x4 cs = csv[it & 1], sn = snv[it & 1];
#pragma unroll
            for (int bj = 0; bj < 2; ++bj) { const int grp = u.pn * 8 + bj * 4 + wc;
                f32x4 t1 = acc[ai][bj][m][0] * s, t2 = acc[ai][bj][m][1] * s;
                if (grp % 3 == 2) { const f32x4 a = t1 * cs - t2 * sn, b = t2 * cs + t1 * sn; t1 = a; t2 = b; }
                *(u32x2*)(rp + bj * HALF + wc * 32 + 4 * fq) = pack4(t1); *(u32x2*)(rp + bj * HALF + wc * 32 + 16 + 4 * fq) = pack4(t2); } }
    }
};
struct EpiGate {
    static constexpr bool PERM = false;
    bf16* G; const float* bias;
    __device__ __forceinline__ void operator()(const acc_t& acc, const Unit& u, int wr, int wc, int fr, int fq) const {
        f32x4 bv[2][2];
#pragma unroll
        EPI_LOOP_COLS bv[bj][n] = *(const f32x4*)(bias + u.pn * BM + EPI_COLT);
#pragma unroll
        EPI_LOOP_ROWS { bf16* rp = G + (size_t)EPI_ROW * D + u.pn * BM;
#pragma unroll
            EPI_LOOP_COLS { f32x4 v = acc[ai][bj][m][n] + bv[bj][n];
                v[0] = sigmoidf_(v[0]); v[1] = sigmoidf_(v[1]); v[2] = sigmoidf_(v[2]); v[3] = sigmoidf_(v[3]);
                *(u32x2*)(rp + EPI_COLT) = pack4(v); } }
    }
};
#define EPI_IT_ROW(it_) (u.pm * BM + ((it_) >> 2) * HALF + wr * 64 + ((it_) & 3) * 16 + fr)
#define EPI_C4(c_) (((c_) >> 1) * HALF + wc * 32 + ((c_) & 1) * 16 + 4 * fq)
struct EpiMerge {
    static constexpr bool PERM = false;
    const bf16* G; bf16* M; int first;
    __device__ __forceinline__ void operator()(const acc_t& acc, const Unit& u, int wr, int wc, int fr, int fq) const {
        u32x2 gv[2][4], mv[2][4];
#define EPI_LD(it_) do { const size_t ro_ = (size_t)EPI_IT_ROW(it_) * D + u.pn * BM; _Pragma("unroll") for (int c = 0; c < 4; ++c) { gv[(it_) & 1][c] = *(const u32x2*)(G + ro_ + EPI_C4(c)); \
            mv[(it_) & 1][c] = first ? (u32x2){0u, 0u} : *(const u32x2*)(M + ro_ + EPI_C4(c)); } } while (0)
        EPI_LD(0);
#pragma unroll
        for (int it = 0; it < 8; ++it) { if (it + 1 < 8) EPI_LD(it + 1);
            const size_t ro = (size_t)EPI_IT_ROW(it) * D + u.pn * BM;
#pragma unroll
            for (int c = 0; c < 4; ++c) { const f32x4 v = unpack4(gv[it & 1][c]) * acc[it >> 2][c >> 1][it & 3][c & 1] + unpack4(mv[it & 1][c]); *(u32x2*)(M + ro + EPI_C4(c)) = pack4(v); } }
#undef EPI_LD
    }
};
struct EpiRes {
    static constexpr bool PERM = true;
    XSrc xin; bf16* xout;
    float* ssq;
    __device__ __forceinline__ void operator()(const acc_t& acc, const Unit& u, int wr, int wc, int fr, int fq) const {
        f32x4 xv[2][2][2];
#define EPI_LD(it_) do { const size_t ro_ = (size_t)EPI_IT_ROW(it_) * D + u.pn * BM; _Pragma("unroll") for (int bj = 0; bj < 2; ++bj) { \
            if (xin.f) { xv[(it_) & 1][bj][0] = *(const f32x4*)(xin.f + ro_ + EPI_C8(bj)); xv[(it_) & 1][bj][1] = *(const f32x4*)(xin.f + ro_ + EPI_C8(bj) + 4); } \
            else { const u32x4 w_ = *(const u32x4*)(xin.b + ro_ + EPI_C8(bj)); xv[(it_) & 1][bj][0] = (f32x4){bflo(w_.x), bfhi(w_.x), bflo(w_.y), bfhi(w_.y)}; xv[(it_) & 1][bj][1] = (f32x4){bflo(w_.z), bfhi(w_.z), bflo(w_.w), bfhi(w_.w)}; } } } while (0)
        EPI_LD(0);
#pragma unroll
        for (int it = 0; it < 8; ++it) { if (it + 1 < 8) EPI_LD(it + 1);
            const size_t ro = (size_t)EPI_IT_ROW(it) * D + u.pn * BM;
            float sq = 0.f;
#pragma unroll
            for (int bj = 0; bj < 2; ++bj) { const f32x4 v0 = xv[it & 1][bj][0] + acc[it >> 2][bj][it & 3][0], v1 = xv[it & 1][bj][1] + acc[it >> 2][bj][it & 3][1];
                sq += (v0[0] * v0[0] + v0[1] * v0[1]) + (v0[2] * v0[2] + v0[3] * v0[3]) + (v1[0] * v1[0] + v1[1] * v1[1]) + (v1[2] * v1[2] + v1[3] * v1[3]);
                *(u32x4*)(xout + ro + EPI_C8(bj)) = pack8(v0, v1); }
            if (ssq) {
                sq += shflx(sq, 16, fr + 16 * fq);
                { auto rr = __builtin_amdgcn_permlane32_swap(__float_as_uint(sq), __float_as_uint(sq), false, false); sq = __uint_as_float(rr[0]) + __uint_as_float(rr[1]); }
                if (fq == 0) ssq[(size_t)EPI_IT_ROW(it) * 16 + u.pn * 4 + wc] = sq; } }
#undef EPI_LD
    }
};
struct EpiPle {
    static constexpr bool PERM = false;
    const bf16* U; float* x;
    __device__ __forceinline__ void operator()(const acc_t& acc, const Unit& u, int wr, int wc, int fr, int fq) const {
        f32x4 xv[2][4]; u32x2 uv[2][4];
#define EPI_LD(it_) do { const size_t ro_ = (size_t)EPI_IT_ROW(it_) * D + u.pn * BM; _Pragma("unroll") for (int c = 0; c < 4; ++c) { xv[(it_) & 1][c] = *(const f32x4*)(x + ro_ + EPI_C4(c)); uv[(it_) & 1][c] = *(const u32x2*)(U + ro_ + EPI_C4(c)); } } while (0)
        EPI_LD(0);
#pragma unroll
        for (int it = 0; it < 8; ++it) { if (it + 1 < 8) EPI_LD(it + 1);
            const size_t ro = (size_t)EPI_IT_ROW(it) * D + u.pn * BM;
#pragma unroll
            for (int c = 0; c < 4; ++c) { f32x4 v = acc[it >> 2][c >> 1][it & 3][c & 1];
                v[0] = sigmoidf_(v[0]); v[1] = sigmoidf_(v[1]); v[2] = sigmoidf_(v[2]); v[3] = sigmoidf_(v[3]);
                *(f32x4*)(x + ro + EPI_C4(c)) = xv[it & 1][c] + unpack4(uv[it & 1][c]) * v; } }
#undef EPI_LD
    }
};
struct EpiSwiglu {
    static constexpr bool PERM = true;
    bf16* O; int ldc; int npt;
    const LAS float* rl;
    mutable int ord;
    __device__ __forceinline__ void operator()(const acc_t& acc, const Unit& u, int wr, int wc, int fr, int fq) const {
        const int ct = (u.pn % npt) * HALF;
#pragma unroll
        EPI_LOOP_ROWS { bf16* rp = O + (size_t)EPI_ROW * ldc + ct + wc * 32 + 8 * fq; u32x2 w[2];
            const float r = rl ? rl[ord * 256 + ai * HALF + wr * 64 + m * 16 + fr] : 1.0f;
#pragma unroll
            for (int n = 0; n < 2; ++n) { const f32x4 a = acc[ai][0][m][n] * r, b = acc[ai][1][m][n] * r; f32x4 v;
#pragma unroll
                for (int e = 0; e < 4; ++e) v[e] = a[e] * sigmoidf_(a[e]) * b[e];
                w[n] = pack4(v); }
            *(u32x4*)rp = (u32x4){w[0].x, w[0].y, w[1].x, w[1].y}; }
        ++ord;
    }
};
struct EpiGlu {
    static constexpr bool PERM = true;
    bf16* Y; int ldc;
    __device__ __forceinline__ void operator()(const acc_t& acc, const Unit& u, int wr, int wc, int fr, int fq) const {
        u32x4 yv[2][2];
#define EPI_LD(it_) do { const bf16* rp_ = Y + (size_t)EPI_IT_ROW(it_) * ldc + u.pn * BM; _Pragma("unroll") for (int bj = 0; bj < 2; ++bj) yv[(it_) & 1][bj] = *(const u32x4*)(rp_ + EPI_C8(bj)); } while (0)
        EPI_LD(0);
#pragma unroll
        for (int it = 0; it < 8; ++it) { if (it + 1 < 8) EPI_LD(it + 1);
            bf16* rp = Y + (size_t)EPI_IT_ROW(it) * ldc + u.pn * BM;
#pragma unroll
            for (int bj = 0; bj < 2; ++bj) { const u32x4 w = yv[it & 1][bj]; f32x4 a = acc[it >> 2][bj][it & 3][0], b = acc[it >> 2][bj][it & 3][1];
                a[0] = bflo(w.x) * sigmoidf_(a[0]); a[1] = bfhi(w.x) * sigmoidf_(a[1]); a[2] = bflo(w.y) * sigmoidf_(a[2]); a[3] = bfhi(w.y) * sigmoidf_(a[3]);
                b[0] = bflo(w.z) * sigmoidf_(b[0]); b[1] = bfhi(w.z) * sigmoidf_(b[1]); b[2] = bflo(w.w) * sigmoidf_(b[2]); b[3] = bfhi(w.w) * sigmoidf_(b[3]);
                *(u32x4*)(rp + EPI_C8(bj)) = pack8(a, b); } }
#undef EPI_LD
    }
};
struct EpiMoeDown {
    static constexpr bool PERM = true;
    bf16* Y; const float* slot_gate;
    __device__ __forceinline__ void operator()(const acc_t& acc, const Unit& u, int wr, int wc, int fr, int fq) const {
        const int ct = (u.pn & 3) * BM;
        float gv[2][4];
#pragma unroll
        EPI_LOOP_ROWS gv[ai][m] = slot_gate[EPI_ROW];
#pragma unroll
        EPI_LOOP_ROWS { const int row = EPI_ROW; const float gt = gv[ai][m]; bf16* rp = Y + (size_t)row * D + ct;
#pragma unroll
            for (int bj = 0; bj < 2; ++bj) *(u32x4*)(rp + EPI_C8(bj)) = pack8(acc[ai][bj][m][0] * gt, acc[ai][bj][m][1] * gt); }
    }
};
}
namespace att {
constexpr int MODE_FOX = 0, MODE_MLA = 1, MODE_BAND = 2;
constexpr float LOG2E = 1.4426950408889634f;
struct Tensors {
    const bf16* Q; int ldq;
    const bf16* K; int ldk;
    const bf16* K2;
    const bf16* V; int ldv;
    bf16* O; int ldo;
    const float* cdec;
    const float* relb;
    int qhs, khs, vhs, ohs;
    const unsigned* qmax; const unsigned* kmax;
};
template <int DQK> struct Lay { static constexpr int KS = DQK * 2 + 16, KB = 64 * KS, VB = 64 * 128, CB = 256, BUF = KB + VB + CB; };
constexpr int ATT_LDS_TAB = 2 * Lay<96>::BUF;
constexpr int ATT_LDS_BYTES = ATT_LDS_TAB + 832 * 4;
__device__ __forceinline__ int crow(int r, int hi) { return (r & 3) + 8 * (r >> 2) + 4 * hi; }
typedef short v4i16_t __attribute__((ext_vector_type(4)));
__device__ __forceinline__ s16x4 vtr(const LAS unsigned char* p) { return __builtin_bit_cast(s16x4, __builtin_amdgcn_ds_read_tr16_b64_v4i16((LAS v4i16_t*)p)); }

template <int MODE>
__device__ __forceinline__ void attn_unit(const Tensors& T, int b, int h, int qb, LAS unsigned char* lds) {
    constexpr int DQK = (MODE == MODE_MLA) ? 96 : 64, NKS = DQK / 16;
    typedef Lay<DQK> LY;
    int tid = my_tid(); asm volatile("" : "+v"(tid));
    const int lane = tid & 63, r32 = lane & 31, hi = lane >> 5; const int wid = __builtin_amdgcn_readfirstlane(tid >> 6);
    const int rowb = b * SEQ, q0 = qb * 256;
    const float sc2 = ((MODE == MODE_MLA) ? 0.10206207261596575f : 0.125f) * LOG2E;
    const int cw = 4 * qb + (wid >> 1);
    const int t_lo = (MODE == MODE_BAND) ? ((4 * qb - 8) > 0 ? (4 * qb - 8) : 0) : 0, t_hi = 4 * qb + 4;
    const int qrow = rowb + q0 + wid * 32 + r32;
    bf16x8 qf[NKS];
    { const bf16* qp = T.Q + (size_t)qrow * T.ldq + h * T.qhs + hi * 8;
#pragma unroll
      for (int ks = 0; ks < NKS; ++ks) qf[ks] = *(const bf16x8*)(qp + ks * 16); }
    float cq = 0.f; if (MODE == MODE_FOX) cq = T.cdec[(size_t)qrow * 4 + h];
    LAS float* tab = (LAS float*)(lds + ATT_LDS_TAB);
    if (MODE == MODE_BAND) { for (int i = tid; i < 832; i += NTHREADS) tab[i] = T.relb[h * 513 + (i < 512 ? i : 512)] * LOG2E; }
    u32x4 kreg0[2] = {}, kreg1[2] = {}, vreg[2] = {}; float creg[2] = {0.f, 0.f};
    const int srow = tid >> 3, sch = tid & 7;
#define ATT_KADDR(c_) (((c_) % 12 < 8) ? (const u32x4*)(T.K + (kr_ + (c_) / 12) * T.ldk + h * T.khs + ((c_) % 12) * 8) : (const u32x4*)(T.K2 + (kr_ + (c_) / 12) * 32 + ((c_) % 12 - 8) * 8))
#define ATT_LOAD_TILE(t_, r_) do { const size_t kr_ = (size_t)(rowb + (t_) * 64); \
        if (MODE == MODE_MLA) { kreg0[r_] = *ATT_KADDR(tid); if (tid < 256) kreg1[r_] = *ATT_KADDR(tid + 512); } \
        else { kreg0[r_] = *(const u32x4*)(T.K + (kr_ + srow) * T.ldk + h * T.khs + sch * 8); } \
        vreg[r_] = *(const u32x4*)(T.V + (kr_ + srow) * T.ldv + h * T.vhs + sch * 8); \
        if (MODE == MODE_FOX) { if (tid < 64) creg[r_] = T.cdec[(kr_ + tid) * 4 + h]; } } while (0)
#define ATT_STORE_TILE(buf_, r_) do { LAS unsigned char* base_ = lds + (buf_) * LY::BUF; \
        if (MODE == MODE_MLA) { *(LAS u32x4*)(base_ + (tid / 12) * LY::KS + (tid % 12) * 16) = kreg0[r_]; \
            if (tid < 256) *(LAS u32x4*)(base_ + ((tid + 512) / 12) * LY::KS + ((tid + 512) % 12) * 16) = kreg1[r_]; } \
        else { *(LAS u32x4*)(base_ + srow * LY::KS + sch * 16) = kreg0[r_]; } \
        *(LAS u32x4*)(base_ + LY::KB + srow * 128 + ((sch * 16) ^ (((srow >> 1) & 1) << 6))) = vreg[r_]; \
        if (MODE == MODE_FOX) { if (tid < 64) *(LAS float*)(base_ + LY::KB + LY::VB + tid * 4) = creg[r_]; } } while (0)
    float mrun = -INFINITY, lrun = 0.f;
    f32x16 o0 = {}, o1 = {};
    const int G = lane >> 4, qi = (lane & 15) >> 2, pi = lane & 3;
    const int vb0 = (4 * hi + qi) * 128 + 64 * (0 ^ (qi >> 1)) + 32 * (G & 1) + 8 * pi;
    const int vb1 = (4 * hi + qi) * 128 + 64 * (1 ^ (qi >> 1)) + 32 * (G & 1) + 8 * pi;
    int t_min = t_lo;
    if (MODE == MODE_FOX) {
        LAS int* tm = (LAS int*)(lds + ATT_LDS_TAB);
        if (tid == 0) tm[0] = t_hi - 1;
        __syncthreads();
        if (tid < t_hi) {
            const float q2 = __uint_as_float(T.qmax[(b * 4 + h) * 32 + qb]), k2 = __uint_as_float(T.kmax[b * 4 + h]);
            const float thr = 0.125f * sqrtf(q2) * 2.0f * sqrtf(k2) * 1.02f + 112.0f;
            const float cfirst = T.cdec[(size_t)(rowb + q0) * 4 + h], clast = T.cdec[(size_t)(rowb + tid * 64 + 63) * 4 + h];
            if (!(clast - cfirst > thr)) __hip_atomic_fetch_min(tm, tid, __ATOMIC_RELAXED, __HIP_MEMORY_SCOPE_WORKGROUP);
        }
        __syncthreads();
        t_min = tm[0];
    }
    const int n_t = t_hi - t_min;
#define ATT_TILE(i_) ((MODE == MODE_FOX) ? (t_hi - 1 - (i_)) : (t_min + (i_)))
    ATT_LOAD_TILE(ATT_TILE(0), 0); ATT_STORE_TILE(0, 0);
    if (n_t > 1) ATT_LOAD_TILE(ATT_TILE(1), 1);
    if (n_t > 2) ATT_LOAD_TILE(ATT_TILE(2), 0);
    __syncthreads();
    for (int it0 = 0; it0 < n_t; it0 += 2) {
#pragma unroll
      for (int half = 0; half < 2; ++half) { const int it = it0 + half; if (it < n_t) {
        const int t = ATT_TILE(it);
        const int buf = half;
        const bool active = (MODE == MODE_BAND) ? (t <= cw && t >= cw - 8) : (t <= cw);
        if (active) {
            const LAS unsigned char* kb = lds + buf * LY::BUF;
            const LAS unsigned char* vbuf = kb + LY::KB;
            f32x16 p0 = {}, p1 = {};
            bf16x8 ka[NKS], kc[NKS];
#pragma unroll
            for (int ks = 0; ks < NKS; ++ks) { ka[ks] = *(const LAS bf16x8*)(kb + r32 * LY::KS + (ks * 16 + hi * 8) * 2); kc[ks] = *(const LAS bf16x8*)(kb + (32 + r32) * LY::KS + (ks * 16 + hi * 8) * 2); }
            __builtin_amdgcn_sched_barrier(0);
#pragma unroll
            for (int ks = 0; ks < NKS; ++ks) { p0 = __builtin_amdgcn_mfma_f32_32x32x16_bf16(ka[ks], qf[ks], p0, 0, 0, 0); p1 = __builtin_amdgcn_mfma_f32_32x32x16_bf16(kc[ks], qf[ks], p1, 0, 0, 0); }
            s16x4 vl0[4], vh0[4], vl1[4], vh1[4];
#pragma unroll
            for (int s4 = 0; s4 < 4; ++s4) { vl0[s4] = vtr(vbuf + vb0 + s4 * 2048); vh0[s4] = vtr(vbuf + vb0 + s4 * 2048 + 1024); vl1[s4] = vtr(vbuf + vb1 + s4 * 2048); vh1[s4] = vtr(vbuf + vb1 + s4 * 2048 + 1024); }
            __builtin_amdgcn_sched_barrier(0);
            if (MODE == MODE_FOX) {
                const LAS float* cb = (const LAS float*)(vbuf + LY::VB);
                const float cq2 = cq * LOG2E;
#pragma unroll
                for (int a = 0; a < 4; ++a) {
                    const f32x4 c0 = *(const LAS f32x4*)(cb + 8 * a + 4 * hi), c1 = *(const LAS f32x4*)(cb + 32 + 8 * a + 4 * hi);
#pragma unroll
                    for (int e = 0; e < 4; ++e) { p0[4 * a + e] = p0[4 * a + e] * sc2 + (cq2 - c0[e] * LOG2E); p1[4 * a + e] = p1[4 * a + e] * sc2 + (cq2 - c1[e] * LOG2E); }
                }
                if (t == cw) { const int ql = 32 * (wid & 1) + r32;
#pragma unroll
                    for (int r = 0; r < 16; ++r) { const int kv = crow(r, hi); if (kv > ql) p0[r] = -INFINITY; if (kv + 32 > ql) p1[r] = -INFINITY; } }
            } else if (MODE == MODE_BAND) {
                const LAS float* bp = tab + ((q0 + wid * 32 + r32) - t * 64) + 256 - 4 * hi - 95;
#pragma unroll
                for (int r = 0; r < 16; ++r) { const int kvb = (r & 3) + 8 * (r >> 2);
                    p0[r] = p0[r] * sc2 + bp[95 - kvb]; p1[r] = p1[r] * sc2 + bp[63 - kvb]; }
            }
            float mx = fmaxf(p0[0], p1[0]);
#pragma unroll
            for (int r = 1; r < 16; ++r) mx = fmaxf(mx, fmaxf(p0[r], p1[r]));
            { auto rr = __builtin_amdgcn_permlane32_swap(__float_as_uint(mx), __float_as_uint(mx), false, false); mx = fmaxf(__uint_as_float(rr[0]), __uint_as_float(rr[1])); }
            if (MODE == MODE_MLA) mx *= sc2;
            const float mnew = fmaxf(mrun, mx);
            if (__any(mnew > mrun)) {
                const float alpha = __builtin_amdgcn_exp2f(mrun - mnew);
                lrun *= alpha;
#pragma unroll
                for (int r = 0; r < 16; ++r) { o0[r] *= alpha; o1[r] *= alpha; }
                mrun = mnew;
            }
            float rs = 0.f;
#pragma unroll
            for (int r = 0; r < 16; ++r) {
                if (MODE == MODE_MLA) { p0[r] = __builtin_amdgcn_exp2f(__builtin_fmaf(p0[r], sc2, -mrun)); p1[r] = __builtin_amdgcn_exp2f(__builtin_fmaf(p1[r], sc2, -mrun)); }
                else { p0[r] = __builtin_amdgcn_exp2f(p0[r] - mrun); p1[r] = __builtin_amdgcn_exp2f(p1[r] - mrun); }
                rs += p0[r] + p1[r]; }
            lrun += rs;
#pragma unroll
            for (int s4 = 0; s4 < 4; ++s4) {
                u32x4 pw;
                if (s4 < 2) { const int o = 8 * (s4 & 1); pw.x = pk2(p0[o], p0[o + 1]); pw.y = pk2(p0[o + 2], p0[o + 3]); pw.z = pk2(p0[o + 4], p0[o + 5]); pw.w = pk2(p0[o + 6], p0[o + 7]); }
                else        { const int o = 8 * (s4 & 1); pw.x = pk2(p1[o], p1[o + 1]); pw.y = pk2(p1[o + 2], p1[o + 3]); pw.z = pk2(p1[o + 4], p1[o + 5]); pw.w = pk2(p1[o + 6], p1[o + 7]); }
                const bf16x8 pf = __builtin_bit_cast(bf16x8, pw);
                const s16x4 l0 = vl0[s4], h0 = vh0[s4], l1 = vl1[s4], h1 = vh1[s4];
                const bf16x8 vf0 = (bf16x8){l0[0], l0[1], l0[2], l0[3], h0[0], h0[1], h0[2], h0[3]};
                const bf16x8 vf1 = (bf16x8){l1[0], l1[1], l1[2], l1[3], h1[0], h1[1], h1[2], h1[3]};
                o0 = __builtin_amdgcn_mfma_f32_32x32x16_bf16(vf0, pf, o0, 0, 0, 0);
                o1 = __builtin_amdgcn_mfma_f32_32x32x16_bf16(vf1, pf, o1, 0, 0, 0);
            }
        }
        if (it + 1 < n_t) ATT_STORE_TILE(half ^ 1, half ^ 1);
        if (it + 3 < n_t) ATT_LOAD_TILE(ATT_TILE(it + 3), half ^ 1);
        __syncthreads();
      } }
    }
    { auto rr = __builtin_amdgcn_permlane32_swap(__float_as_uint(lrun), __float_as_uint(lrun), false, false); lrun = __uint_as_float(rr[0]) + __uint_as_float(rr[1]); }
    const float inv = 1.0f / lrun;
    bf16* op = T.O + (size_t)qrow * T.ldo + h * T.ohs;
#pragma unroll
    for (int a = 0; a < 4; ++a) {
        u32x2 w0, w1;
        w0.x = pk2(o0[4 * a] * inv, o0[4 * a + 1] * inv); w0.y = pk2(o0[4 * a + 2] * inv, o0[4 * a + 3] * inv);
        w1.x = pk2(o1[4 * a] * inv, o1[4 * a + 1] * inv); w1.y = pk2(o1[4 * a + 2] * inv, o1[4 * a + 3] * inv);
        *(u32x2*)(op + 8 * a + 4 * hi) = w0; *(u32x2*)(op + 32 + 8 * a + 4 * hi) = w1;
    }
}

template <int MODE>
__device__ __forceinline__ void attn_phase(const Tensors& T, LAS unsigned char* lds) {
    const int G = gridDim.x, bx = blockIdx.x, vcu = (G % 8 == 0) ? (bx % 8) * (G / 8) + bx / 8 : bx;
    for (int pr = vcu; pr < 256; pr += G) {
        const int bh = pr >> 4, s = pr & 15;
        attn_unit<MODE>(T, bh >> 2, bh & 3, s, lds);
        attn_unit<MODE>(T, bh >> 2, bh & 3, 31 - s, lds);
    }
}

template <int MODE>
__device__ __forceinline__ void attn_naive(const Tensors& T) {
    BODY_IDS();
    constexpr int DQK = (MODE == MODE_MLA) ? 96 : 64;
    const float sc = (MODE == MODE_MLA) ? 0.10206207261596575f : 0.125f;
    for (int idx = gtid; idx < NTOK * 4; idx += gthreads) {
        const int h = idx / NTOK, row = idx % NTOK, b = row / SEQ, tpos = row % SEQ, rowb = b * SEQ;
        float q[DQK], o[64];
#pragma unroll
        for (int d = 0; d < DQK; ++d) q[d] = bf2f(T.Q[(size_t)row * T.ldq + h * T.qhs + d]) * sc;
#pragma unroll
        for (int d = 0; d < 64; ++d) o[d] = 0.f;
        float m = -INFINITY, l = 0.f;
        const int ck = tpos / 64;
        const int k_lo = (MODE == MODE_BAND) ? ((ck - 8) > 0 ? (ck - 8) * 64 : 0) : 0;
        const int k_hi = (MODE == MODE_FOX) ? tpos : (ck * 64 + 63);
        const float cq = (MODE == MODE_FOX) ? T.cdec[(size_t)row * 4 + h] : 0.f;
        for (int kv = k_lo; kv <= k_hi; ++kv) {
            const size_t kr = (size_t)(rowb + kv);
            float s = 0.f;
#pragma unroll
            for (int d8 = 0; d8 < 8; ++d8) { const u32x4 w = *(const u32x4*)(T.K + kr * T.ldk + h * T.khs + d8 * 8);
                s += q[d8 * 8 + 0] * bflo(w.x) + q[d8 * 8 + 1] * bfhi(w.x) + q[d8 * 8 + 2] * bflo(w.y) + q[d8 * 8 + 3] * bfhi(w.y)
                   + q[d8 * 8 + 4] * bflo(w.z) + q[d8 * 8 + 5] * bfhi(w.z) + q[d8 * 8 + 6] * bflo(w.w) + q[d8 * 8 + 7] * bfhi(w.w); }
            if (MODE == MODE_MLA) {
#pragma unroll
                for (int d8 = 0; d8 < 4; ++d8) { const u32x4 w = *(const u32x4*)(T.K2 + kr * 32 + d8 * 8);
                    s += q[64 + d8 * 8 + 0] * bflo(w.x) + q[64 + d8 * 8 + 1] * bfhi(w.x) + q[64 + d8 * 8 + 2] * bflo(w.y) + q[64 + d8 * 8 + 3] * bfhi(w.y)
                       + q[64 + d8 * 8 + 4] * bflo(w.z) + q[64 + d8 * 8 + 5] * bfhi(w.z) + q[64 + d8 * 8 + 6] * bflo(w.w) + q[64 + d8 * 8 + 7] * bfhi(w.w); }
            }
            if (MODE == MODE_FOX) s += cq - T.cdec[kr * 4 + h];
            if (MODE == MODE_BAND) { int rel = tpos - kv; rel = rel < -256 ? -256 : (rel > 256 ? 256 : rel); s += T.relb[h * 513 + rel + 256]; }
            const float mn = fmaxf(m, s), al = __expf(m - mn), pp = __expf(s - mn);
            l = l * al + pp; m = mn;
#pragma unroll
            for (int d8 = 0; d8 < 8; ++d8) { const u32x4 w = *(const u32x4*)(T.V + kr * T.ldv + h * T.vhs + d8 * 8);
                o[d8 * 8 + 0] = o[d8 * 8 + 0] * al + pp * bflo(w.x); o[d8 * 8 + 1] = o[d8 * 8 + 1] * al + pp * bfhi(w.x);
                o[d8 * 8 + 2] = o[d8 * 8 + 2] * al + pp * bflo(w.y); o[d8 * 8 + 3] = o[d8 * 8 + 3] * al + pp * bfhi(w.y);
                o[d8 * 8 + 4] = o[d8 * 8 + 4] * al + pp * bflo(w.z); o[d8 * 8 + 5] = o[d8 * 8 + 5] * al + pp * bfhi(w.z);
                o[d8 * 8 + 6] = o[d8 * 8 + 6] * al + pp * bflo(w.w); o[d8 * 8 + 7] = o[d8 * 8 + 7] * al + pp * bfhi(w.w); }
        }
        const float inv = 1.0f / l;
#pragma unroll
        for (int d = 0; d < 64; d += 2) *(unsigned*)(T.O + (size_t)row * T.ldo + h * T.ohs + d) = pk2(o[d] * inv, o[d + 1] * inv);
    }
}
}
struct Params {
    const float* in[37];
    float* out;
    unsigned char* ws;
    int ph_lo, ph_hi;
};
enum { I_X = 0, I_P, I_POS, I_WIN, I_SAR, I_SAI, I_SLDT, I_SBR, I_SBI, I_SCR, I_SCI, I_SD, I_SGLU, I_FBF, I_GQ, I_WUQ, I_GKV, I_WUKV, I_RELB, I_WB, I_WG, I_BG, I_WO,
       I_GMIX, I_GFFN, I_FW1, I_FW3, I_FW2, I_MWR, I_MBR, I_MW1, I_MW3, I_MW2, I_GPLE, I_PWG, I_PWU, I_GFIN };

__device__ __forceinline__ void sincos_rad(double a, float& s, float& c) {
    double r = a * 0.15915494309189535; r = r - __builtin_rint(r); const float f = (float)r;
    s = __builtin_amdgcn_sinf(f); c = __builtin_amdgcn_cosf(f);
}
__device__ __forceinline__ float gelu_tanh(float x) {
    const float z = 0.7978845608028654f * (x + 0.044715f * x * x * x);
    return x * __builtin_amdgcn_rcpf(1.0f + __expf(-2.0f * z));
}
__device__ __forceinline__ float log_sigmoid(float z) { return fminf(z, 0.f) - log1pf(__expf(-fabsf(z))); }

struct CvtJob { const float* src; const float* ks; bf16* dst; int K, ldsrc, col0, ncols, row0, ldk, ilv; };
struct CvtRegs { f32x4 v[16]; };
__device__ __forceinline__ void cvt_load(const CvtJob& J, int item, int lane, CvtRegs& R) {
    const int nblk = (J.ncols + 63) >> 6, kb = item / nblk, nb = item % nblk, k0 = 64 * kb, n0 = 64 * nb;
    const int n4 = (lane & 15) * 4; const bool inb = (n0 + n4) < J.ncols;
#pragma unroll
    for (int i = 0; i < 16; ++i) { const int kk = 4 * i + (lane >> 4); f32x4 v = {0.f, 0.f, 0.f, 0.f};
        if (inb) v = *(const f32x4*)(J.src + (size_t)(k0 + kk) * J.ldsrc + J.col0 + n0 + n4);
        if (J.ks) v = v * J.ks[k0 + kk];
        R.v[i] = v; }
}
__device__ __forceinline__ void cvt_finish(const CvtJob& J, LAS float* scr, int item, int lane, const CvtRegs& R) {
    const int nblk = (J.ncols + 63) >> 6, kb = item / nblk, nb = item % nblk, k0 = 64 * kb, n0 = 64 * nb;
    const int n4 = (lane & 15) * 4;
#pragma unroll
    for (int i = 0; i < 16; ++i) { const int kk = 4 * i + (lane >> 4); *(LAS f32x4*)(scr + kk * 68 + n4) = R.v[i]; }
    LDS_WAIT(); asm volatile("" ::: "memory");
    const int c = lane & 7;
#pragma unroll
    for (int j = 0; j < 8; ++j) { const int n = (lane >> 3) + 8 * j; const LAS float* s = scr + (8 * c) * 68 + n;
        u32x4 o; o.x = pk2(s[0 * 68], s[1 * 68]); o.y = pk2(s[2 * 68], s[3 * 68]); o.z = pk2(s[4 * 68], s[5 * 68]); o.w = pk2(s[6 * 68], s[7 * 68]);
        const int nn = n0 + n; const int row = J.row0 + (J.ilv ? ((nn >> 7) * 256 + (nn & 127)) : nn);
        if (nn < J.ncols) *(u32x4*)(J.dst + (size_t)row * J.ldk + k0 + 8 * c) = o; }
    LDS_WAIT(); asm volatile("" ::: "memory");
}
__device__ __forceinline__ bf16* wmix(const Params& P, int L, size_t off) { return (bf16*)(P.ws + WS_WMIX + (size_t)L * WMIX_STRIDE + off); }
__device__ __forceinline__ CvtJob get_job(const Params& P, int j) {
    CvtJob J; J.ks = nullptr; J.ilv = 0; J.col0 = 0; J.row0 = 0;
    if (j < 40) {
        const int L = j / 20, q = j % 20;
        if (q < 5) {
            J.src = P.in[I_WIN] + (size_t)L * D * DIN; J.K = D; J.ldsrc = DIN; J.dst = wmix(P, L, WM_IN); J.ldk = D;
            J.col0 = q == 0 ? 0 : q == 1 ? 1380 : q == 2 ? 1028 : q == 3 ? 1220 : 1348;
            J.ncols = q == 0 ? 1024 : q == 1 ? 768 : q == 2 ? 192 : q == 3 ? 128 : 32;
            J.row0 = q == 0 ? 0 : q == 1 ? 1024 : q == 2 ? 1792 : q == 3 ? 2048 : 2176;
        } else if (q < 9) { const int k = q - 5; J.src = P.in[I_WG] + ((size_t)L * 4 + k) * D * D; J.K = D; J.ldsrc = D; J.ncols = D; J.row0 = k * D; J.dst = wmix(P, L, WM_G); J.ldk = D;
        } else if (q < 13) { const int k = q - 9; J.src = P.in[I_WB] + ((size_t)L * 4 + k) * 256 * D; J.K = 256; J.ldsrc = D; J.ncols = D; J.row0 = k * D; J.dst = wmix(P, L, WM_B); J.ldk = 256;
        } else if (q == 13) { J.src = P.in[I_WO] + (size_t)L * D * D; J.K = D; J.ldsrc = D; J.ncols = D; J.dst = wmix(P, L, WM_O); J.ldk = D;
        } else if (q == 14) { J.src = P.in[I_PWG] + (size_t)L * D * D;  J.ks = P.in[I_GPLE] + L * D; J.K = D; J.ldsrc = D; J.ncols = D; J.dst = wmix(P, L, WM_PG); J.ldk = D;
        } else if (q == 15) { J.src = P.in[I_PWU] + (size_t)L * 256 * D; J.K = 256; J.ldsrc = D; J.ncols = D; J.dst = wmix(P, L, WM_UP); J.ldk = 256;
        } else if (q == 16) { J.src = P.in[I_WUQ] + (size_t)L * 192 * 384; J.ks = P.in[I_GQ] + L * 192; J.K = 192; J.ldsrc = 384; J.ncols = 384; J.dst = wmix(P, L, WM_UQ); J.ldk = 256;
        } else if (q == 17) { J.src = P.in[I_WUKV] + (size_t)L * 128 * 512; J.ks = P.in[I_GKV] + L * 128; J.K = 128; J.ldsrc = 512; J.ncols = 512; J.dst = wmix(P, L, WM_UKV); J.ldk = 128;
        } else if (q == 18) { J.src = P.in[I_SGLU] + (size_t)L * 256 * 256; J.K = 256; J.ldsrc = 256; J.ncols = 256; J.dst = wmix(P, L, WM_GLU); J.ldk = 256;
        } else { J.src = nullptr; J.K = 0; J.ldsrc = 0; J.ncols = 32; J.dst = nullptr; J.ldk = 0; }
    } else if (j < 43) {
        const int q = j - 40;
        if (q == 0) { J.src = P.in[I_FW1]; J.ks = P.in[I_GFFN]; J.K = D; J.ldsrc = DFF; J.ncols = DFF; J.dst = (bf16*)(P.ws + WS_W13); J.ldk = D; J.ilv = 1; }
        else if (q == 1) { J.src = P.in[I_FW3]; J.ks = P.in[I_GFFN]; J.K = D; J.ldsrc = DFF; J.ncols = DFF; J.row0 = 128; J.dst = (bf16*)(P.ws + WS_W13); J.ldk = D; J.ilv = 1; }
        else { J.src = P.in[I_FW2]; J.K = DFF; J.ldsrc = D; J.ncols = D; J.dst = (bf16*)(P.ws + WS_W2); J.ldk = DFF; }
    } else {
        const int e = (j - 43) / 3, q = (j - 43) % 3;
        if (q == 0) { J.src = P.in[I_MW1] + (size_t)e * D * DFFE; J.K = D; J.ldsrc = DFFE; J.ncols = DFFE; J.row0 = e * 2816; J.dst = (bf16*)(P.ws + WS_WM13); J.ldk = D; J.ilv = 1; }
        else if (q == 1) { J.src = P.in[I_MW3] + (size_t)e * D * DFFE; J.K = D; J.ldsrc = DFFE; J.ncols = DFFE; J.row0 = e * 2816 + 128; J.dst = (bf16*)(P.ws + WS_WM13); J.ldk = D; J.ilv = 1; }
        else { J.src = P.in[I_MW2] + (size_t)e * DFFE * D; J.K = DFFE; J.ldsrc = D; J.ncols = D; J.row0 = e * D; J.dst = (bf16*)(P.ws + WS_WM2); J.ldk = DFFE; }
    }
    return J;
}
__device__ __forceinline__ void cvt_jobs(const Params& P, int j_lo, int j_hi, LAS unsigned char* lds, int blk0 = 0, int nblk = 0) {
    BODY_IDS();
    const int gw_ = nblk ? ((int)blockIdx.x - blk0) * NWAVES + wave : gw, ngw_ = nblk ? nblk * NWAVES : ngw;
    LAS float* scr = (LAS float*)(lds + wave * 17408);
    int acc = 0; bool have = false; CvtJob Jp; int itp = 0; CvtRegs Rp;
    for (int j = j_lo; j < j_hi; ++j) {
        const CvtJob J = get_job(P, j);
        const int items = (J.K / 64) * ((J.ncols + 63) >> 6);
        const int first = (gw_ - (acc % ngw_) + ngw_) % ngw_;
        for (int it = first; it < items; it += ngw_) {
            CvtRegs Rn; cvt_load(J, it, lane, Rn);
            if (have) cvt_finish(Jp, scr, itp, lane, Rp);
            Jp = J; itp = it; have = true;
#pragma unroll
            for (int i = 0; i < 16; ++i) Rp.v[i] = Rn.v[i];
        }
        acc += items;
    }
    if (have) cvt_finish(Jp, scr, itp, lane, Rp);
}

__device__ __forceinline__ void p0_misc(const Params& P) {
    BODY_IDS();
    { const f32x4* src = (const f32x4*)P.in[I_P]; u32x2* dst = (u32x2*)(P.ws + WS_PBF);
      for (int i = gtid; i < 2 * NTOK * 256 / 4; i += gthreads) { const f32x4 v = src[i]; u32x2 w; w.x = pk2(v[0], v[1]); w.y = pk2(v[2], v[3]); dst[i] = w; } }
    { const int* pos = (const int*)P.in[I_POS]; float* ct = (float*)(P.ws + WS_COS); float* st = (float*)(P.ws + WS_SIN);
      const double invf[16] = {1.0, 0.5623413251903491, 0.31622776601683794, 0.1778279410038923, 0.1, 0.05623413251903491, 0.03162277660168379, 0.01778279410038923,
                               0.01, 0.005623413251903491, 0.0031622776601683794, 0.0017782794100389228, 0.001, 0.0005623413251903491, 0.00031622776601683794, 0.00017782794100389227};
      for (int i = gtid; i < NTOK * 16; i += gthreads) { const int row = i >> 4, f = i & 15; double iv = invf[0];
#pragma unroll
          for (int q = 1; q < 16; ++q) iv = (f == q) ? invf[q] : iv;
          const float ang = (float)pos[row] * (float)iv; float s, c; sincos_rad((double)ang, s, c); ct[i] = c; st[i] = s; } }
    for (int L = 0; L < 2; ++L) {
        bf16* win = wmix(P, L, WM_IN);
        for (int i = gtid; i < (64 + 96) * D / 8; i += gthreads) { const int e = i * 8, r = e / D, k = e % D; const int row = r < 64 ? 1984 + r : 2208 + (r - 64); *(u32x4*)(win + (size_t)row * D + k) = (u32x4){0u, 0u, 0u, 0u}; }
        bf16* wuq = wmix(P, L, WM_UQ);
        for (int i = gtid; i < 512 * 256 / 8; i += gthreads) { const int e = i * 8, r = e / 256, k = e % 256; if (r >= 384 || k >= 192) *(u32x4*)(wuq + e) = (u32x4){0u, 0u, 0u, 0u}; }
    }
}

__device__ __forceinline__ void rms_load(const XSrc& x, int row, int lane, f32x4 (&v)[4]) {
#pragma unroll
    for (int j = 0; j < 4; ++j) v[j] = ldx4(x, (size_t)row * D + 4 * lane + 256 * j);
}
struct GainRegs { f32x4 g[4]; };
__device__ __forceinline__ GainRegs load_gain(const float* gain, int lane) { GainRegs G; const f32x4* gr = (const f32x4*)gain + lane;
#pragma unroll
    for (int j = 0; j < 4; ++j) G.g[j] = gr[64 * j];
    return G; }
__device__ __forceinline__ void rms_finish(const GainRegs& G, bf16* orow, int lane, f32x4 (&v)[4]) {
    float s = 0.f;
#pragma unroll
    for (int j = 0; j < 4; ++j) s += (v[j][0] * v[j][0] + v[j][1] * v[j][1]) + (v[j][2] * v[j][2] + v[j][3] * v[j][3]);
    const float rstd = __builtin_amdgcn_rsqf(wave_sum(s) * (1.0f / D) + RMS_EPS);
    u32x2* o8 = (u32x2*)orow + lane;
#pragma unroll
    for (int j = 0; j < 4; ++j) { v[j] = v[j] * rstd * G.g[j]; if (orow) { u32x2 w; w.x = pk2(v[j][0], v[j][1]); w.y = pk2(v[j][2], v[j][3]); o8[64 * j] = w; } }
}
#define RMS_ROWS_BEGIN(x_, rowexpr_) f32x4 v[4], vn_[4]; { const int i = 0; rms_load(x_, (rowexpr_), lane, v); } for (int i = 0; i < 16; ++i) { if (i + 1 < 16) { const int i_ = i; { const int i = i_ + 1; rms_load(x_, (rowexpr_), lane, vn_); } }
#define RMS_ROWS_END() _Pragma("unroll") for (int j_ = 0; j_ < 4; ++j_) v[j_] = vn_[j_]; }
__device__ __forceinline__ void norm_plain(const XSrc x, const float* gain, bf16* H, int first, int stride) {
    BODY_IDS();
    const GainRegs GR = load_gain(gain, lane);
    for (int u = first; u < NTOK / 128; u += stride)
    { RMS_ROWS_BEGIN(x, u * 128 + wave * 16 + i) const int row = u * 128 + wave * 16 + i; rms_finish(GR, H + (size_t)row * D, lane, v); RMS_ROWS_END() }
}
__device__ __forceinline__ void norm1_phase(const Params& P, int L, const XSrc x, int first, int stride) {
    BODY_IDS();
    const float* win = P.in[I_WIN] + (size_t)L * D * DIN;
    f32x4 wff[4][4];
#pragma unroll
    for (int j = 0; j < 4; ++j)
#pragma unroll
        for (int e = 0; e < 4; ++e) wff[j][e] = *(const f32x4*)(win + (size_t)(4 * lane + 256 * j + e) * DIN + 1024);
    const float* gain = P.in[I_GMIX] + L * D; bf16* H = (bf16*)(P.ws + WS_H); const GainRegs GR = load_gain(gain, lane);
    float* logf = (float*)(P.ws + WS_LOGF); float* wsum = (float*)(P.ws + WS_WSUM);
    const f32x4 bf = *(const f32x4*)(P.in[I_FBF] + L * 4);
    for (int u = first; u < NTOK / 128; u += stride) { const int g0 = u * 8 + wave;
        f32x4 run = {0.f, 0.f, 0.f, 0.f};
        RMS_ROWS_BEGIN(x, g0 * 16 + i) const int row = g0 * 16 + i; rms_finish(GR, H + (size_t)row * D, lane, v);
            f32x4 d = {0.f, 0.f, 0.f, 0.f};
#pragma unroll
            for (int j = 0; j < 4; ++j)
#pragma unroll
                for (int e = 0; e < 4; ++e) d += wff[j][e] * v[j][e];
#pragma unroll
            for (int e = 0; e < 4; ++e) { d[e] = wave_sum(d[e]); run[e] += log_sigmoid(d[e] + bf[e]); }
            if (lane == 0) *(f32x4*)(logf + (size_t)row * 4) = run; RMS_ROWS_END()
        if (lane == 0) *(f32x4*)(wsum + (size_t)g0 * 4) = run;
    }
    __syncthreads();
}
__device__ __forceinline__ void prep_phase(const Params& P, int L) {
    BODY_IDS();
    unsigned* qmaxw = (unsigned*)(P.ws + WS_CTL) + CW_QMAX + L * 512; unsigned* kmaxw = (unsigned*)(P.ws + WS_CTL) + CW_KMAX + L * 16;
    const float* logf = (const float*)(P.ws + WS_LOGF); const float* wsum = (const float*)(P.ws + WS_WSUM); float* cdec = (float*)(P.ws + WS_CDEC);
    float* rq = (float*)(P.ws + WS_RSTDQ); float* rkv = (float*)(P.ws + WS_RSTDKV); const bf16* zin = (const bf16*)(P.ws + WS_ZIN); bf16* kper = (bf16*)(P.ws + WS_KPER);
    const float* ct = (const float*)(P.ws + WS_COS); const float* st = (const float*)(P.ws + WS_SIN);
    for (int g0 = gw; g0 < NTOK / 16; g0 += ngw) {
        const int first = (g0 / 512) * 512;
        f32x4 pre = {0.f, 0.f, 0.f, 0.f};
        for (int i = first + lane; i < g0; i += 64) pre += *(const f32x4*)(wsum + (size_t)i * 4);
#pragma unroll
        for (int e = 0; e < 4; ++e) pre[e] = wave_sum(pre[e]);
        if (lane < 16) { const int row = g0 * 16 + lane; *(f32x4*)(cdec + (size_t)row * 4) = *(const f32x4*)(logf + (size_t)row * 4) + pre; }
        float qk2m = 0.f;
        const int colA = (lane < 32 ? ZC_FQ : ZC_FK) + 8 * (lane & 31), colB = ZC_CQ + 8 * (lane < 52 ? lane : 51);
        u32x4 wa = *(const u32x4*)(zin + (size_t)(g0 * 16) * ZP + colA), wb = *(const u32x4*)(zin + (size_t)(g0 * 16) * ZP + colB);
        for (int i = 0; i < 16; ++i) { const int row = g0 * 16 + i;
            const u32x4 ca = wa, cb = wb;
            if (i + 1 < 16) { wa = *(const u32x4*)(zin + (size_t)(row + 1) * ZP + colA); wb = *(const u32x4*)(zin + (size_t)(row + 1) * ZP + colB); }
            const f32x4 cs = *(const f32x4*)(ct + (size_t)row * 16 + 8 * (lane & 1)), cs2 = *(const f32x4*)(ct + (size_t)row * 16 + 8 * (lane & 1) + 4);
            const f32x4 sn = *(const f32x4*)(st + (size_t)row * 16 + 8 * (lane & 1)), sn2 = *(const f32x4*)(st + (size_t)row * 16 + 8 * (lane & 1) + 4);
            { float sa = (bflo(ca.x) * bflo(ca.x) + bfhi(ca.x) * bfhi(ca.x)) + (bflo(ca.y) * bflo(ca.y) + bfhi(ca.y) * bfhi(ca.y)) + (bflo(ca.z) * bflo(ca.z) + bfhi(ca.z) * bfhi(ca.z)) + (bflo(ca.w) * bflo(ca.w) + bfhi(ca.w) * bfhi(ca.w));
              sa += DPP_F(sa, 0xB1, 0xF); sa += DPP_F(sa, 0x4E, 0xF); sa += DPP_F(sa, 0x141, 0xF);
              qk2m = fmaxf(qk2m, sa); }
            const float own[8] = {bflo(cb.x), bfhi(cb.x), bflo(cb.y), bfhi(cb.y), bflo(cb.z), bfhi(cb.z), bflo(cb.w), bfhi(cb.w)};
            float ssb = 0.f;
#pragma unroll
            for (int e = 0; e < 8; ++e) ssb += own[e] * own[e];
            const float sq = wave_sum(lane < 24 ? ssb : 0.f), skv = wave_sum((lane >= 32 && lane < 48) ? ssb : 0.f);
            if (lane == 0) { rq[row] = __builtin_amdgcn_rsqf(sq * (1.0f / 192.0f) + RMS_EPS); rkv[row] = __builtin_amdgcn_rsqf(skv * (1.0f / 128.0f) + RMS_EPS); }
            float oth[8];
#pragma unroll
            for (int e = 0; e < 8; ++e) oth[e] = DPP_F(own[e], 0x4E, 0xF);
            if (lane >= 48 && lane < 52) { const bool lo = lane < 50; float o8[8];
#pragma unroll
                for (int e = 0; e < 8; ++e) { const float c = e < 4 ? cs[e] : cs2[e - 4], sv = e < 4 ? sn[e] : sn2[e - 4];
                    o8[e] = lo ? (own[e] * c - oth[e] * sv) : (own[e] * c + oth[e] * sv); }
                *(u32x4*)(kper + (size_t)row * 32 + (lo ? 0 : 16) + 8 * (lane & 1)) = (u32x4){pk2(o8[0], o8[1]), pk2(o8[2], o8[3]), pk2(o8[4], o8[5]), pk2(o8[6], o8[7])}; } }
        if ((lane & 7) == 0) { const int row0 = g0 * 16, b = row0 / SEQ, qb = (row0 % SEQ) / 256, h = (lane & 31) >> 3;
            if (lane < 32) atomicMax(qmaxw + (b * 4 + h) * 32 + qb, __float_as_uint(qk2m)); else atomicMax(kmaxw + b * 4 + h, __float_as_uint(qk2m)); }
    }
}
struct FinalRows { u32x2 w[16][4]; };
__device__ __forceinline__ void final_norm_load(const Params& P, int u, FinalRows& R) {
    BODY_IDS();
    const bf16* xb = (const bf16*)(P.ws + WS_WM13);
#pragma unroll
    for (int i = 0; i < 16; ++i) { const u32x2* xr = (const u32x2*)(xb + (size_t)(u * 128 + wave * 16 + i) * D) + lane;
#pragma unroll
        for (int j = 0; j < 4; ++j) R.w[i][j] = xr[64 * j]; }
}
__device__ __forceinline__ void final_norm_store(const Params& P, int u, const FinalRows& R) {
    BODY_IDS();
    const GainRegs GR = load_gain(P.in[I_GFIN], lane);
#pragma unroll
    for (int i = 0; i < 16; ++i) { f32x4 v[4]; float s = 0.f;
#pragma unroll
        for (int j = 0; j < 4; ++j) { const u32x2 w = R.w[i][j]; v[j] = (f32x4){bflo(w.x), bfhi(w.x), bflo(w.y), bfhi(w.y)}; s += (v[j][0] * v[j][0] + v[j][1] * v[j][1]) + (v[j][2] * v[j][2] + v[j][3] * v[j][3]); }
        const float rstd = __builtin_amdgcn_rsqf(wave_sum(s) * (1.0f / D) + RMS_EPS);
        f32x4* xo = (f32x4*)(P.out + (size_t)(u * 128 + wave * 16 + i) * D) + lane;
#pragma unroll
        for (int j = 0; j < 4; ++j) xo[64 * j] = v[j] * rstd * GR.g[j]; }
}
namespace s5 {
struct Coef { float abr, abi; f32x2 B2[16]; float a64r, a64i; };
__device__ __forceinline__ void coef(const Params& P, int L, int g, int p, Coef& C) {
    const float dt = __expf(P.in[I_SLDT][L * 16 + g]); const float ar = P.in[I_SAR][(L * 16 + g) * 64 + p], ai = P.in[I_SAI][(L * 16 + g) * 64 + p];
    const float mag = __expf(ar * dt); float sn, cs; sincos_rad((double)(ai * dt), sn, cs);
    C.abr = mag * cs; C.abi = mag * sn;
    const float den = ar * ar + ai * ai, nr = C.abr - 1.0f, ni = C.abi;
    const float cr = (nr * ar + ni * ai) / den, ci = (ni * ar - nr * ai) / den;
    const float* br = P.in[I_SBR] + ((size_t)(L * 16 + g) * 64 + p) * 16; const float* bi = P.in[I_SBI] + ((size_t)(L * 16 + g) * 64 + p) * 16;
#pragma unroll
    for (int h = 0; h < 16; ++h) { const float r = br[h], i = bi[h]; C.B2[h] = (f32x2){cr * r - ci * i, cr * i + ci * r}; }
    const float m64 = __expf(64.0f * ar * dt); float s64, c64; sincos_rad(64.0 * (double)(ai * dt), s64, c64);
    C.a64r = m64 * c64; C.a64i = m64 * s64;
}
constexpr int WAVE_LDS = 8448;
template <bool EMIT>
__device__ __forceinline__ void chunk(const Params& P, int L, int g, int row0, const Coef& C, float& xr, float& xi, LAS unsigned char* wl, int lane, const bf16x8 (&cf)[4], float dsk) {
    bf16* zin = (bf16*)(P.ws + WS_ZIN);
    LAS float* ut = (LAS float*)wl; LAS unsigned* xt = (LAS unsigned*)(wl + 4096);
    { const u32x4* up = (const u32x4*)(zin + (size_t)(row0 + lane) * ZP + ZC_U + g * 16); const u32x4 w0 = up[0], w1 = up[1];
      LAS f32x4* d = (LAS f32x4*)(ut + lane * 16);
      d[0] = (f32x4){bflo(w0.x), bfhi(w0.x), bflo(w0.y), bfhi(w0.y)}; d[1] = (f32x4){bflo(w0.z), bfhi(w0.z), bflo(w0.w), bfhi(w0.w)};
      d[2] = (f32x4){bflo(w1.x), bfhi(w1.x), bflo(w1.y), bfhi(w1.y)}; d[3] = (f32x4){bflo(w1.z), bfhi(w1.z), bflo(w1.w), bfhi(w1.w)}; }
    for (int tb = 0; tb < 4; ++tb) {
#pragma unroll 4
        for (int ti = 0; ti < 16; ++ti) {
            const LAS f32x4* up = (const LAS f32x4*)(ut + (tb * 16 + ti) * 16);
            f32x2 b2a = {0.f, 0.f}, b2b = {0.f, 0.f};
#pragma unroll
            for (int q = 0; q < 4; ++q) { const f32x4 u4 = up[q];
                b2a += C.B2[4 * q + 0] * (f32x2){u4[0], u4[0]}; b2b += C.B2[4 * q + 1] * (f32x2){u4[1], u4[1]};
                b2a += C.B2[4 * q + 2] * (f32x2){u4[2], u4[2]}; b2b += C.B2[4 * q + 3] * (f32x2){u4[3], u4[3]}; }
            const float br = b2a[0] + b2b[0], bi = b2a[1] + b2b[1];
            const float nr = C.abr * xr - C.abi * xi + br, ni = C.abr * xi + C.abi * xr + bi; xr = nr; xi = ni;
            if (EMIT) xt[ti * 68 + lane] = pk2(xr, xi);
        }
        if (EMIT) {
            f32x4 dacc = {0.f, 0.f, 0.f, 0.f};
#pragma unroll
            for (int ks = 0; ks < 4; ++ks) { const bf16x8 a = *(const LAS bf16x8*)((const LAS unsigned char*)xt + (lane & 15) * 272 + (ks * 32 + (lane >> 4) * 8) * 2);
                dacc = __builtin_amdgcn_mfma_f32_16x16x32_bf16(a, cf[ks], dacc, 0, 0, 0); }
            const int hp = lane & 15;
#pragma unroll
            for (int i = 0; i < 4; ++i) { const int tok = tb * 16 + 4 * (lane >> 4) + i; const float y = dacc[i] + dsk * ut[tok * 16 + hp];
                zin[(size_t)(row0 + tok) * ZP + ZC_U + g * 16 + hp] = (bf16)f2bf(gelu_tanh(y)); }
        }
    }
}
template <int PASS>
__device__ __forceinline__ void phase(const Params& P, int L, LAS unsigned char* lds) {
    BODY_IDS();
    LAS unsigned char* wl = lds + wave * WAVE_LDS;
    f32x2* SC = (f32x2*)(P.ws + WS_SC);
    for (int w = gw; w < 2048; w += ngw) {
        const int bg = w >> 5, cg = w & 31, b = bg >> 4, g = bg & 15;
        Coef C; coef(P, L, g, lane, C);
        bf16x8 cf[4]; float dsk = 0.f;
        if (PASS == 1) {
            const int hp = lane & 15, kg = lane >> 4;
            const float* cre = P.in[I_SCR] + ((size_t)(L * 16 + g) * 16 + hp) * 64; const float* cim = P.in[I_SCI] + ((size_t)(L * 16 + g) * 16 + hp) * 64;
#pragma unroll
            for (int ks = 0; ks < 4; ++ks) { const int p0 = 16 * ks + 4 * kg; u32x4 wv;
                wv.x = pk2(cre[p0], -cim[p0]); wv.y = pk2(cre[p0 + 1], -cim[p0 + 1]); wv.z = pk2(cre[p0 + 2], -cim[p0 + 2]); wv.w = pk2(cre[p0 + 3], -cim[p0 + 3]);
                cf[ks] = __builtin_bit_cast(bf16x8, wv); }
            dsk = P.in[I_SD][(L * 16 + g) * 16 + hp];
        } else {
#pragma unroll
            for (int ks = 0; ks < 4; ++ks) cf[ks] = (bf16x8){0, 0, 0, 0, 0, 0, 0, 0};
        }
        float xr = 0.f, xi = 0.f;
        if (PASS == 1) {
            const f32x2* sp = SC + ((size_t)bg * 128) * 64 + lane;
            for (int c = 0; c < 4 * cg; c += 4) { f32x2 sv[4];
#pragma unroll
                for (int q = 0; q < 4; ++q) sv[q] = sp[(size_t)(c + q) * 64];
#pragma unroll
                for (int q = 0; q < 4; ++q) { const float nr = C.a64r * xr - C.a64i * xi + sv[q][0], ni = C.a64r * xi + C.a64i * xr + sv[q][1]; xr = nr; xi = ni; } }
        }
        for (int cc = 0; cc < 4; ++cc) {
            const int c = 4 * cg + cc, row0 = b * SEQ + c * 64;
            if (PASS == 0) { xr = 0.f; xi = 0.f; }
            chunk<PASS == 1>(P, L, g, row0, C, xr, xi, wl, lane, cf, dsk);
            if (PASS == 0) SC[((size_t)bg * 128 + c) * 64 + lane] = (f32x2){xr, xi};
        }
    }
}
#define LDS_XLANE() asm volatile("" ::: "memory")
constexpr int WAVE_LDS1 = 4352;
__device__ __forceinline__ void phase1(const Params& P, int L, LAS unsigned char* lds) {
    BODY_IDS();
    LAS unsigned char* wl = lds + wave * WAVE_LDS1;
    LAS unsigned* bu = (LAS unsigned*)wl; LAS unsigned* xt = bu;
    bf16* zin = (bf16*)(P.ws + WS_ZIN);
    const f32x2* SC = (const f32x2*)(P.ws + WS_SC);
    const int m = lane & 15, kq = lane >> 4;
    for (int w = gw; w < 2048; w += ngw) {
        const int bg = w >> 5, cg = w & 31, b = bg >> 4, g = bg & 15;
        const bf16* ub = zin + (size_t)(b * SEQ + cg * 256 + m) * ZP + ZC_U + g * 16 + 8 * (kq & 1);
        u32x4 ua[4];
#pragma unroll
        for (int q = 0; q < 4; ++q) ua[q] = *(const u32x4*)(ub + (size_t)q * 16 * ZP);
        const f32x2* sp = SC + ((size_t)bg * 128) * 64 + lane;
        f32x2 pq[4][4];
        if (cg > 0) {
#pragma unroll
            for (int j = 0; j < 4; ++j) { const int bc = j < cg ? j : cg - 1;
#pragma unroll
                for (int t = 0; t < 4; ++t) pq[j][t] = sp[(size_t)(4 * bc + t) * 64]; }
        }
        float abr, abi, a64r, a64i; bf16x8 bfr[8];
        { Coef C; coef(P, L, g, lane, C); abr = C.abr; abi = C.abi; a64r = C.a64r; a64i = C.a64i;
          LAS unsigned* tab = (LAS unsigned*)wl;
#pragma unroll
          for (int h2 = 0; h2 < 8; ++h2) { tab[lane * 8 + h2] = pk2(C.B2[2 * h2][0], C.B2[2 * h2 + 1][0]); tab[(64 + lane) * 8 + h2] = pk2(C.B2[2 * h2][1], C.B2[2 * h2 + 1][1]); }
          LDS_XLANE();
#pragma unroll
          for (int nt = 0; nt < 8; ++nt) { const u32x4 v = *(const LAS u32x4*)(wl + (16 * nt + m) * 32 + 16 * (kq & 1)); bfr[nt] = __builtin_bit_cast(bf16x8, kq < 2 ? v : (u32x4){0u, 0u, 0u, 0u}); }
          LDS_XLANE(); }
        bf16x8 cf[4]; float dskf;
        { const float* cre = P.in[I_SCR] + ((size_t)(L * 16 + g) * 16 + m) * 64; const float* cim = P.in[I_SCI] + ((size_t)(L * 16 + g) * 16 + m) * 64;
#pragma unroll
          for (int ks = 0; ks < 4; ++ks) { const int p0 = 16 * ks + 4 * kq; u32x4 wv;
              wv.x = pk2(cre[p0], -cim[p0]); wv.y = pk2(cre[p0 + 1], -cim[p0 + 1]); wv.z = pk2(cre[p0 + 2], -cim[p0 + 2]); wv.w = pk2(cre[p0 + 3], -cim[p0 + 3]);
              cf[ks] = __builtin_bit_cast(bf16x8, wv); }
          dskf = P.in[I_SD][(L * 16 + g) * 16 + m]; }
        float xr = 0.f, xi = 0.f;
        for (int k = 0; k < cg; k += 4) {
#pragma unroll
            for (int j = 0; j < 4; ++j) {
                if (k + j < cg) {
#pragma unroll
                    for (int t = 0; t < 4; ++t) { const float nr = a64r * xr - a64i * xi + pq[j][t][0], ni = a64r * xi + a64i * xr + pq[j][t][1]; xr = nr; xi = ni; } }
                const int bn = k + j + 4, bc = bn < cg ? bn : cg - 1;
#pragma unroll
                for (int t = 0; t < 4; ++t) pq[j][t] = sp[(size_t)(4 * bc + t) * 64];
            }
        }
#pragma nounroll
        for (int cc = 0; cc < 4; ++cc) {
            const int row0 = b * SEQ + (4 * cg + cc) * 64;
            u32x4 un[4];
            if (cc < 3) {
#pragma unroll
                for (int q = 0; q < 4; ++q) un[q] = *(const u32x4*)(ub + (size_t)((cc + 1) * 4 + q) * 16 * ZP);
            } else {
#pragma unroll
                for (int q = 0; q < 4; ++q) un[q] = ua[q];
            }
#pragma unroll
            for (int tb = 0; tb < 4; ++tb) {
                const bf16x8 a = __builtin_bit_cast(bf16x8, ua[tb]);
                f32x4 dd[8];
#pragma unroll
                for (int nt = 0; nt < 8; ++nt) dd[nt] = __builtin_amdgcn_mfma_f32_16x16x32_bf16(a, bfr[nt], (f32x4){0.f, 0.f, 0.f, 0.f}, 0, 0, 0);
                unsigned short uraw[4];
#pragma unroll
                for (int i = 0; i < 4; ++i) uraw[i] = *(const unsigned short*)(zin + (size_t)(row0 + tb * 16 + 4 * kq + i) * ZP + ZC_U + g * 16 + m);
#pragma unroll
                for (int nt = 0; nt < 4; ++nt)
#pragma unroll
                    for (int i = 0; i < 4; ++i) bu[(4 * kq + i) * 68 + 16 * nt + m] = pk2(dd[nt][i], dd[nt + 4][i]);
                LDS_XLANE();
#pragma unroll
                for (int ti = 0; ti < 16; ++ti) {
                    const unsigned bw = bu[ti * 68 + lane]; const float br = bflo(bw), bi = bfhi(bw);
                    const float nr = abr * xr - abi * xi + br, ni = abr * xi + abi * xr + bi; xr = nr; xi = ni;
                    xt[ti * 68 + lane] = pk2(xr, xi);
                }
                LDS_XLANE();
                f32x4 dacc = {0.f, 0.f, 0.f, 0.f};
#pragma unroll
                for (int ks = 0; ks < 4; ++ks) { const bf16x8 a2 = *(const LAS bf16x8*)(wl + m * 272 + (ks * 32 + kq * 8) * 2);
                    dacc = __builtin_amdgcn_mfma_f32_16x16x32_bf16(a2, cf[ks], dacc, 0, 0, 0); }
                LDS_XLANE();
#pragma unroll
                for (int i = 0; i < 4; ++i) { const int tok = tb * 16 + 4 * kq + i; const float y = dacc[i] + dskf * __uint_as_float((unsigned)uraw[i] << 16);
                    const float gy = gelu_tanh(y); *(unsigned short*)(zin + (size_t)(row0 + tok) * ZP + ZC_U + g * 16 + m) = (unsigned short)pk2(gy, gy); }
            }
#pragma unroll
            for (int q = 0; q < 4; ++q) ua[q] = un[q];
        }
    }
}
__device__ __forceinline__ void build_w(const Params& P, int L) {
    BODY_IDS();
    bf16* W = (bf16*)(P.ws + WS_S5W);
    for (int q = gtid; q < 16 * 64 * 64; q += gthreads) {
        const int g = q >> 12, p = (q >> 6) & 63, sidx = q & 63;
        const float dt = __expf(P.in[I_SLDT][L * 16 + g]); const float ar = P.in[I_SAR][(L * 16 + g) * 64 + p], ai = P.in[I_SAI][(L * 16 + g) * 64 + p];
        const float mag = __expf(ar * dt); float sn, cs; sincos_rad((double)(ai * dt), sn, cs);
        const float abr = mag * cs, abi = mag * sn, den = ar * ar + ai * ai, nr = abr - 1.0f, ni = abi;
        const float cr = (nr * ar + ni * ai) / den, ci = (ni * ar - nr * ai) / den;
        const float e = (float)(63 - sidx); const float me = __expf(e * ar * dt); float se, ce; sincos_rad((double)e * (double)(ai * dt), se, ce);
        const float Er = me * ce, Ei = me * se;
        const float* br = P.in[I_SBR] + ((size_t)(L * 16 + g) * 64 + p) * 16; const float* bi = P.in[I_SBI] + ((size_t)(L * 16 + g) * 64 + p) * 16;
        float vr[16], vi[16];
#pragma unroll
        for (int h = 0; h < 16; ++h) { const float bbr = cr * br[h] - ci * bi[h], bbi = cr * bi[h] + ci * br[h]; vr[h] = Er * bbr - Ei * bbi; vi[h] = Er * bbi + Ei * bbr; }
        bf16* w0 = W + ((size_t)g * 128 + 2 * p) * 1024 + sidx * 16;
        *(u32x4*)w0 = (u32x4){pk2(vr[0], vr[1]), pk2(vr[2], vr[3]), pk2(vr[4], vr[5]), pk2(vr[6], vr[7])}; *(u32x4*)(w0 + 8) = (u32x4){pk2(vr[8], vr[9]), pk2(vr[10], vr[11]), pk2(vr[12], vr[13]), pk2(vr[14], vr[15])};
        *(u32x4*)(w0 + 1024) = (u32x4){pk2(vi[0], vi[1]), pk2(vi[2], vi[3]), pk2(vi[4], vi[5]), pk2(vi[6], vi[7])}; *(u32x4*)(w0 + 1024 + 8) = (u32x4){pk2(vi[8], vi[9]), pk2(vi[10], vi[11]), pk2(vi[12], vi[13]), pk2(vi[14], vi[15])};
    }
}
__device__ __forceinline__ void pass0_mfma(const Params& P, LAS unsigned char* lds) {
    BODY_IDS();
    const bf16* zin = (const bf16*)(P.ws + WS_ZIN); const bf16* W = (const bf16*)(P.ws + WS_S5W); float* SC = (float*)(P.ws + WS_SC);
    for (int task = blockIdx.x; task < 256; task += gridDim.x) {
        const int g = task & 15, nq = (task >> 4) & 3, cgp = (task >> 6) * 8 + wave;
        __syncthreads();
#pragma unroll
        for (int i = 0; i < 8; ++i) { const int id = tid + 512 * i, row = id >> 7, c16 = id & 127;
            *(LAS u32x4*)(lds + row * 2064 + c16 * 16) = *(const u32x4*)(W + ((size_t)g * 128 + nq * 32 + row) * 1024 + c16 * 8); }
        __syncthreads();
        const int m = lane & 15, kq = lane >> 4, ci = 16 * cgp + m, b = ci >> 7, c = ci & 127;
        const bf16* ap = zin + (size_t)(b * SEQ + c * 64 + (kq >> 1)) * ZP + ZC_U + g * 16 + 8 * (kq & 1);
        const LAS unsigned char* bl = lds + m * 2064 + kq * 16;
        f32x4 d0 = {0.f, 0.f, 0.f, 0.f}, d1 = {0.f, 0.f, 0.f, 0.f};
#pragma unroll 8
        for (int ks = 0; ks < 32; ++ks) {
            const bf16x8 av = *(const bf16x8*)(ap + (size_t)(2 * ks) * ZP), b0 = *(const LAS bf16x8*)(bl + 64 * ks), b1 = *(const LAS bf16x8*)(bl + 16 * 2064 + 64 * ks);
            d0 = __builtin_amdgcn_mfma_f32_16x16x32_bf16(av, b0, d0, 0, 0, 0); d1 = __builtin_amdgcn_mfma_f32_16x16x32_bf16(av, b1, d1, 0, 0, 0);
        }
#pragma unroll
        for (int i = 0; i < 4; ++i) { const int cj = 16 * cgp + 4 * (lane >> 4) + i, bj = cj >> 7, cc = cj & 127; float* sp = SC + ((size_t)(bj * 16 + g) * 128 + cc) * 128 + nq * 32 + (lane & 15);
            sp[0] = d0[i]; sp[16] = d1[i]; }
    }
    __syncthreads();
}
__device__ __forceinline__ void naive(const Params& P, int L) {
    BODY_IDS();
    bf16* zin = (bf16*)(P.ws + WS_ZIN);
    for (int bg = gw; bg < 64; bg += ngw) {
        const int b = bg >> 4, g = bg & 15;
        Coef C; coef(P, L, g, lane, C);
        float cr[16], ci[16];
#pragma unroll
        for (int h = 0; h < 16; ++h) { cr[h] = P.in[I_SCR][((size_t)(L * 16 + g) * 16 + h) * 64 + lane]; ci[h] = P.in[I_SCI][((size_t)(L * 16 + g) * 16 + h) * 64 + lane]; }
        const float dsk = P.in[I_SD][(L * 16 + g) * 16 + (lane & 15)];
        float xr = 0.f, xi = 0.f;
        for (int t = 0; t < SEQ; ++t) {
            bf16* up = zin + (size_t)(b * SEQ + t) * ZP + ZC_U + g * 16;
            const u32x4 w0 = *(const u32x4*)up, w1 = *(const u32x4*)(up + 8);
            const float u[16] = {bflo(w0.x), bfhi(w0.x), bflo(w0.y), bfhi(w0.y), bflo(w0.z), bfhi(w0.z), bflo(w0.w), bfhi(w0.w),
                                 bflo(w1.x), bfhi(w1.x), bflo(w1.y), bfhi(w1.y), bflo(w1.z), bfhi(w1.z), bflo(w1.w), bfhi(w1.w)};
            float br = 0.f, bi = 0.f;
#pragma unroll
            for (int h = 0; h < 16; ++h) { br += C.B2[h][0] * u[h]; bi += C.B2[h][1] * u[h]; }
            const float nr = C.abr * xr - C.abi * xi + br, ni = C.abr * xi + C.abi * xr + bi; xr = nr; xi = ni;
            float ymine = 0.f, umine = 0.f;
#pragma unroll
            for (int h = 0; h < 16; ++h) { const float s = wave_sum(xr * cr[h] - xi * ci[h]); if ((lane & 15) == h) { ymine = s; umine = u[h]; } }
            __builtin_amdgcn_s_waitcnt(0);
            if (lane < 16) up[lane] = (bf16)f2bf(gelu_tanh(ymine + dsk * umine));
        }
    }
}
}

__device__ __forceinline__ void norm2_moe_phase(const Params& P, const XSrc x, LAS unsigned char* lds, int first, int stride) {
    BODY_IDS();
    LAS unsigned* lcnt = (LAS unsigned*)(lds + 32768); LAS unsigned* lbase = lcnt + 8;
    f32x4 wr0[4][4], wr1[4][4];
#pragma unroll
    for (int j = 0; j < 4; ++j)
#pragma unroll
        for (int q = 0; q < 4; ++q) { const float* wp = P.in[I_MWR] + (size_t)(4 * lane + 256 * j + q) * 8; wr0[j][q] = *(const f32x4*)wp; wr1[j][q] = *(const f32x4*)(wp + 4); }
    if (tid < 8) lcnt[tid] = 0u;
    __syncthreads();
    const float* gain = P.in[I_GFFN] + 1 * D; bf16* H = (bf16*)(P.ws + WS_H); const GainRegs GR = load_gain(gain, lane);
    unsigned* tokinfo = (unsigned*)(P.ws + WS_TOKINFO); unsigned* gcnt = (unsigned*)(P.ws + WS_CTL) + CW_MOECNT;
    const float* brt = P.in[I_MBR];
    for (int u = first; u < NTOK / 128; u += stride) { const int g0 = u * 8 + wave;
        RMS_ROWS_BEGIN(x, g0 * 16 + i) const int row = g0 * 16 + i; rms_finish(GR, H + (size_t)row * D, lane, v);
            float lg[8];
#pragma unroll
            for (int e = 0; e < 8; ++e) lg[e] = 0.f;
#pragma unroll
            for (int j = 0; j < 4; ++j)
#pragma unroll
                for (int q = 0; q < 4; ++q) { const f32x4 w0 = wr0[j][q], w1 = wr1[j][q]; const float hv = v[j][q];
                    lg[0] += hv * w0[0]; lg[1] += hv * w0[1]; lg[2] += hv * w0[2]; lg[3] += hv * w0[3]; lg[4] += hv * w1[0]; lg[5] += hv * w1[1]; lg[6] += hv * w1[2]; lg[7] += hv * w1[3]; }
#pragma unroll
            for (int e = 0; e < 8; ++e) lg[e] = wave_sum(lg[e]) + brt[e];
            int e0 = 0; float l0 = lg[0];
#pragma unroll
            for (int e = 1; e < 8; ++e) if (lg[e] > l0) { l0 = lg[e]; e0 = e; }
            int e1 = 0; float l1 = -INFINITY;
#pragma unroll
            for (int e = 0; e < 8; ++e) if (e != e0 && lg[e] > l1) { l1 = lg[e]; e1 = e; }
            const float ex = __expf(l1 - l0); const float ga = __builtin_amdgcn_rcpf(1.0f + ex), gb = ex * ga;
            if (lane == 0) { const unsigned r0 = __hip_atomic_fetch_add(&lcnt[e0], 1u, __ATOMIC_RELAXED, __HIP_MEMORY_SCOPE_WORKGROUP), r1 = __hip_atomic_fetch_add(&lcnt[e1], 1u, __ATOMIC_RELAXED, __HIP_MEMORY_SCOPE_WORKGROUP);
                u32x4 a; a.x = (unsigned)e0; a.y = (unsigned)e1; a.z = r0; a.w = r1; u32x4 bq; bq.x = __float_as_uint(ga); bq.y = __float_as_uint(gb); bq.z = 0u; bq.w = 0u;
                *(u32x4*)(tokinfo + (size_t)row * 8) = a; *(u32x4*)(tokinfo + (size_t)row * 8 + 4) = bq; } RMS_ROWS_END()
    }
    __syncthreads();
    if (tid < 8) lbase[tid] = __hip_atomic_fetch_add(gcnt + tid, lcnt[tid], __ATOMIC_RELAXED, __HIP_MEMORY_SCOPE_AGENT);
    __syncthreads();
    for (int u = first; u < NTOK / 128; u += stride) { const int g0 = u * 8 + wave;
        if (lane == 0) { for (int i = 0; i < 16; ++i) { const int row = g0 * 16 + i; u32x4 a = *(u32x4*)(tokinfo + (size_t)row * 8);
            unsigned b0 = 0, b1 = 0;
#pragma unroll
            for (int e = 0; e < 8; ++e) { const unsigned lb = lbase[e]; b0 = (a.x == (unsigned)e) ? lb : b0; b1 = (a.y == (unsigned)e) ? lb : b1; }
            a.z += b0; a.w += b1; *(u32x4*)(tokinfo + (size_t)row * 8) = a; } }
    }
    int* slot_tok = (int*)(P.ws + WS_SLOTTOK);
    for (int i = gtid; i < MOE_ROWS; i += gthreads) slot_tok[i] = -1;
    __syncthreads();
}
struct MoeLayout { int pstart[9]; };
__device__ __forceinline__ MoeLayout moe_layout(const Params& P) {
    const unsigned* gcnt = (const unsigned*)(P.ws + WS_CTL) + CW_MOECNT; MoeLayout Lo; int acc = 0;
#pragma unroll
    for (int e = 0; e < 8; ++e) { Lo.pstart[e] = acc; const int c = (int)__hip_atomic_load(gcnt + e, __ATOMIC_RELAXED, __HIP_MEMORY_SCOPE_AGENT); acc += (c + 255) / 256 * 256; }
    Lo.pstart[8] = acc; return Lo;
}
__device__ __forceinline__ void moe_assign_phase(const Params& P) {
    BODY_IDS();
    const MoeLayout Lo = moe_layout(P);
    const unsigned* tokinfo = (const unsigned*)(P.ws + WS_TOKINFO); int* slot_tok = (int*)(P.ws + WS_SLOTTOK); float* slot_gate = (float*)(P.ws + WS_SLOTGATE);
    for (int t = gtid; t < NTOK; t += gthreads) { const u32x4 a = *(const u32x4*)(tokinfo + (size_t)t * 8); const u32x2 g = *(const u32x2*)(tokinfo + (size_t)t * 8 + 4);
        int p0 = 0, p1 = 0;
#pragma unroll
        for (int e = 0; e < 8; ++e) { p0 = ((int)a.x == e) ? Lo.pstart[e] : p0; p1 = ((int)a.y == e) ? Lo.pstart[e] : p1; }
        const int s0 = p0 + (int)a.z, s1 = p1 + (int)a.w;
        slot_tok[s0] = t; slot_gate[s0] = __uint_as_float(g.x); slot_tok[s1] = t; slot_gate[s1] = __uint_as_float(g.y); }
}
struct MoeOrder {
    int pstart[9]; int ntile, ncol, G, c;
    __device__ __forceinline__ bool next(int i, pg8::Unit& u) const {
        const long Lf = (long)i * G + c; if (Lf >= (long)ntile * ncol) return false;
        const int rt = (int)(Lf / ncol), j = (int)(Lf % ncol); int e = 0;
#pragma unroll
        for (int q = 1; q < 8; ++q) e = (rt * 256 >= pstart[q]) ? q : e;
        u.pm = rt; u.pn = e * ncol + j; return true;
    }
};
__device__ __forceinline__ MoeOrder moe_order(const Params& P, int ncol, int G, int c) {
    const MoeLayout Lo = moe_layout(P); MoeOrder S;
#pragma unroll
    for (int e = 0; e < 9; ++e) S.pstart[e] = Lo.pstart[e];
    S.ntile = Lo.pstart[8] / 256; S.ncol = ncol; S.G = G; S.c = c; return S;
}

__device__ __forceinline__ void norm_moe_combine(const Params& P, const float* gain, int first, int stride) {
    BODY_IDS();
    const MoeLayout Lo = moe_layout(P); (void)gain;
    const unsigned* tokinfo = (const unsigned*)(P.ws + WS_TOKINFO); const bf16* Y = (const bf16*)(P.ws + WS_MOEY); float* rsv = (float*)(P.ws + WS_SSQ);
    for (int u = first; u < NTOK / 128; u += stride) for (int i = 0; i < 16; ++i) { const int row = u * 128 + wave * 16 + i;
        const u32x4 a = *(const u32x4*)(tokinfo + (size_t)row * 8);
        int p0 = 0, p1 = 0;
#pragma unroll
        for (int e = 0; e < 8; ++e) { p0 = ((int)a.x == e) ? Lo.pstart[e] : p0; p1 = ((int)a.y == e) ? Lo.pstart[e] : p1; }
        const u32x2* y0 = (const u32x2*)(Y + (size_t)(p0 + (int)a.z) * D) + lane; const u32x2* y1 = (const u32x2*)(Y + (size_t)(p1 + (int)a.w) * D) + lane;
        u32x2* xr = (u32x2*)(xr_of(P.out) + (size_t)row * D) + lane; f32x4 v[4]; float s = 0.f;
#pragma unroll
        for (int j = 0; j < 4; ++j) { const u32x2 w0 = y0[64 * j], w1 = y1[64 * j]; const u32x2 wx = xr[64 * j];
            v[j] = (f32x4){bflo(wx.x), bfhi(wx.x), bflo(wx.y), bfhi(wx.y)} + (f32x4){bflo(w0.x), bfhi(w0.x), bflo(w0.y), bfhi(w0.y)} + (f32x4){bflo(w1.x), bfhi(w1.x), bflo(w1.y), bfhi(w1.y)};
            { u32x2 wo; wo.x = pk2(v[j][0], v[j][1]); wo.y = pk2(v[j][2], v[j][3]); xr[64 * j] = wo; } s += (v[j][0] * v[j][0] + v[j][1] * v[j][1]) + (v[j][2] * v[j][2] + v[j][3] * v[j][3]); }
        const float rstd = __builtin_amdgcn_rsqf(wave_sum(s) * (1.0f / D) + RMS_EPS);
        if (lane == 0) rsv[row] = rstd;
    }
}
#ifndef REF_MASK
#define REF_MASK 0
#endif
#ifndef N_LAUNCH_MODE
#define N_LAUNCH_MODE 1
#endif
constexpr int LDS_BYTES = 147456;
constexpr int RL_OFF = 131072, RL_UNITS = 15;
constexpr int MISC_OFF = LDS_BYTES - 64;
constexpr int N_PHASES = 27;
#ifndef PHASE_SEL
#define PHASE_SEL 0xFFFFFFFu
#endif
#define PH_ON(b) (((PHASE_SEL) >> (b)) & 1u)
#ifndef SUB_SEL
#define SUB_SEL 0xFFu
#endif
#define SUB_ON(b) (((SUB_SEL) >> (b)) & 1u)

#ifndef PROBE_MASK
#define PROBE_MASK 0u
#endif
#ifndef PROBE_MULT
#define PROBE_MULT 4
#endif
#define TIMED(bit, ...) do { unsigned long long t0_ = 0; if (((PROBE_MASK) >> (bit)) & 1u) t0_ = __builtin_amdgcn_s_memrealtime(); __VA_ARGS__; \
    if (((PROBE_MASK) >> (bit)) & 1u) pacc += __builtin_amdgcn_s_memrealtime() - t0_; } while (0)
#define RUN_GEMM(EPI_T, SCHED_T, GATH, gm, sc, ep) do { if (REF_MASK & 1) pg8::gemm_phase_naive<EPI_T, SCHED_T, GATH>(gm, sc, ep); \
    else pg8::gemm_phase<EPI_T, SCHED_T, true, GATH>(lds, gm, sc, ep); } while (0)

__device__ __forceinline__ int vcu_of() { int G = gridDim.x, bx = blockIdx.x; asm volatile("" : "+s"(G), "+s"(bx)); return (G % 8 == 0) ? (bx % 8) * (G / 8) + bx / 8 : bx; }
__device__ __forceinline__ bool in_range(int lo, int hi, int k) { asm volatile("" : "+s"(lo), "+s"(hi)); return lo <= k && k < hi; }
__global__ void __launch_bounds__(NTHREADS, 2) mega_fwd(Params P) {
    extern __shared__ __attribute__((aligned(16))) unsigned char lds_raw[];
    LAS unsigned char* lds = (LAS unsigned char*)lds_raw;
    const int tid = threadIdx.x;
    const int G = gridDim.x, bx = blockIdx.x;
    unsigned* ctl = (unsigned*)(P.ws + WS_CTL);
    volatile LAS unsigned* misc = (volatile LAS unsigned*)(lds + MISC_OFF);
    if (tid < 16) misc[tid] = 0u;
    if ((tid & 63) == 0) *(LAS int*)(uintptr_t)((unsigned)TID_TAB_OFF + 4u * hw_wave_key()) = tid >> 6;
    __syncthreads();
    const int lo = P.ph_lo, hi = P.ph_hi;
    XcdBarrier bar; bar.bar = ctl + CW_BAR; bar.x = 0; bar.st = misc;
    if (hi - lo > 1) bar = xcd_barrier_post(ctl + CW_BAR, misc);
#define IN(k) in_range(lo, hi, (k))
#ifndef PROBE_SEAMS
#define PROBE_SEAMS 0u
#endif
#define SEAM(k) do { if (IN(k) && IN((k) + 1)) { unsigned long long t0_ = 0; const bool tm_ = (((PROBE_MASK) >> 24) & 1u) || (((PROBE_SEAMS) >> (k)) & 1u); if (tm_) t0_ = __builtin_amdgcn_s_memrealtime(); \
    xcd_barrier(bar); if (tm_) pacc += __builtin_amdgcn_s_memrealtime() - t0_; } } while (0)
    unsigned long long pacc = 0;

#define H ((bf16*)(P.ws + WS_H))
#define ZIN ((bf16*)(P.ws + WS_ZIN))
#define GB ((bf16*)(P.ws + WS_G))
#define MB ((bf16*)(P.ws + WS_M))
#define MLAQ ((bf16*)(P.ws + WS_MLAQ))
#define MLAKV ((bf16*)(P.ws + WS_MLAKV))
#define KPER ((bf16*)(P.ws + WS_KPER))
#define cosT ((float*)(P.ws + WS_COS))
#define sinT ((float*)(P.ws + WS_SIN))
#define slot_tok ((int*)(P.ws + WS_SLOTTOK))
#define slot_gate ((float*)(P.ws + WS_SLOTGATE))

    if (PH_ON(0) && IN(0)) { TIMED(0, cvt_jobs(P, 0, 20, lds); p0_misc(P)); TIMED(1, norm1_phase(P, 0, XSrc{P.in[I_X], nullptr}, vcu_of(), gridDim.x)); }
    SEAM(0);

    for (int L = 0; L < 2; ++L) {
        const int pb = 1 + 12 * L;
        const int pc = (L == 0) ? 9 : 22;
        bf16* const XR = xr_of(P.out);
        bf16* const X2 = (bf16*)(P.ws + WS_WM13);
        const XSrc xsrc = (L == 0) ? XSrc{P.in[I_X], nullptr} : XSrc{nullptr, X2};
        if (PH_ON(2) && IN(pb + 1)) {
            TIMED(4, s5::build_w(P, L));
            pg8::Gemm g{H, wmix(P, L, WM_IN), D, D, D, nullptr}; pg8::StaticOrder S; S.init(NTOK, ZP, G, bx);
            epi::EpiStore E{ZIN, ZP, 0};
            TIMED(2, RUN_GEMM(epi::EpiStore, pg8::StaticOrder, false, g, S, E));
            if (L == 0) { const int rem_ = ((NTOK / 256) * (ZP / 256)) % G;
                if (rem_ == 0) TIMED(0, cvt_jobs(P, 20, 43, lds)); else if (bx >= rem_) TIMED(0, cvt_jobs(P, 20, 43, lds, rem_, G - rem_));
                __syncthreads(); }
        }
        SEAM(pb + 1);
        if (PH_ON(3) && IN(pb + 2)) {
            TIMED(3, prep_phase(P, L));
            if (!(REF_MASK & 4)) TIMED(4, s5::pass0_mfma(P, lds));
            __syncthreads();
        }
        SEAM(pb + 2);
        if (PH_ON(4) && IN(pb + 3)) {
            if (SUB_ON(0)) { pg8::Gemm g{ZIN + ZC_CQ, wmix(P, L, WM_UQ), ZP, 256, 256, nullptr}; pg8::StaticOrder S; S.init(NTOK, 512, G, bx);
              epi::EpiMlaQ E{MLAQ, (const float*)(P.ws + WS_RSTDQ), cosT, sinT};
              TIMED(5, RUN_GEMM(epi::EpiMlaQ, pg8::StaticOrder, false, g, S, E)); }
            if (SUB_ON(1)) { pg8::Gemm g{ZIN + ZC_CKV, wmix(P, L, WM_UKV), ZP, 128, 128, nullptr}; pg8::StaticOrder S; S.init(NTOK, 512, G, bx);
              epi::EpiRowScale E{MLAKV, 512, (const float*)(P.ws + WS_RSTDKV)};
              TIMED(5, RUN_GEMM(epi::EpiRowScale, pg8::StaticOrder, false, g, S, E)); }
            if (SUB_ON(2)) { TIMED(6, if (REF_MASK & 4) s5::naive(P, L); else s5::phase1(P, L, lds)); }
            __syncthreads();
            if (SUB_ON(3)) { att::Tensors T; T.Q = ZIN + ZC_FQ; T.ldq = ZP; T.K = ZIN + ZC_FK; T.ldk = ZP; T.K2 = nullptr; T.V = ZIN + ZC_FV; T.ldv = ZP; T.O = ZIN + ZC_FQ; T.ldo = ZP;
              T.cdec = (const float*)(P.ws + WS_CDEC); T.relb = nullptr; T.qhs = 64; T.khs = 64; T.vhs = 64; T.ohs = 64;
              T.qmax = (const unsigned*)(P.ws + WS_CTL) + CW_QMAX + L * 512; T.kmax = (const unsigned*)(P.ws + WS_CTL) + CW_KMAX + L * 16;
              TIMED(7, if (REF_MASK & 2) att::attn_naive<att::MODE_FOX>(T); else att::attn_phase<att::MODE_FOX>(T, lds)); }
            __syncthreads();
            if (SUB_ON(4)) { att::Tensors T; T.Q = ZIN + ZC_DQ; T.ldq = ZP; T.K = ZIN + ZC_DK; T.ldk = ZP; T.K2 = nullptr; T.V = ZIN + ZC_DV; T.ldv = ZP; T.O = ZIN + ZC_DQ; T.ldo = ZP;
              T.cdec = nullptr; T.relb = P.in[I_RELB] + (size_t)L * 4 * 513; T.qhs = 64; T.khs = 64; T.vhs = 64; T.ohs = 64;
              TIMED(8, if (REF_MASK & 2) att::attn_naive<att::MODE_BAND>(T); else att::attn_phase<att::MODE_BAND>(T, lds)); }
            __syncthreads();
        }
        SEAM(pb + 3);
        if (PH_ON(5) && IN(pb + 4)) {
            if (SUB_ON(0)) { att::Tensors T; T.Q = MLAQ; T.ldq = 512; T.K = MLAKV; T.ldk = 512; T.K2 = KPER; T.V = MLAKV + 64; T.ldv = 512; T.O = ZIN + ZC_CQ; T.ldo = ZP;
              T.cdec = nullptr; T.relb = nullptr; T.qhs = 96; T.khs = 128; T.vhs = 128; T.ohs = 64;
              TIMED(9, if (REF_MASK & 2) att::attn_naive<att::MODE_MLA>(T); else att::attn_phase<att::MODE_MLA>(T, lds)); }
            __syncthreads();
            if (SUB_ON(1)) { pg8::Gemm g{ZIN + ZC_U, wmix(P, L, WM_GLU), ZP, 256, 256, nullptr}; pg8::StaticOrder S; S.init(NTOK, 256, G, bx);
              epi::EpiGlu E{ZIN + ZC_U, ZP};
              TIMED(10, RUN_GEMM(epi::EpiGlu, pg8::StaticOrder, false, g, S, E)); }
        }
        SEAM(pb + 4);
        if (PH_ON(6) && IN(pb + 5)) {
            g128::MergeProg MP; MP.Hn = H; MP.zin = ZIN; MP.wg = wmix(P, L, WM_G); MP.wb = wmix(P, L, WM_B); MP.bg = P.in[I_BG] + (size_t)L * 4 * D; MP.M = MB;
            const int vcu_ = vcu_of();
            TIMED(11, g128::stream<g128::MergeProg>(lds, MP, 1024, vcu_, G));
        }
        SEAM(pb + 5);
#define PANEL_FENCE() do { asm volatile("s_waitcnt vmcnt(0)" ::: "memory"); __builtin_amdgcn_fence(__ATOMIC_ACQUIRE, "agent"); asm volatile("s_waitcnt vmcnt(0)" ::: "memory"); __syncthreads(); } while (0)
        if (PH_ON(7) && IN(pb + 6)) {
            pg8::Gemm g{MB, wmix(P, L, WM_O), D, D, D, nullptr}; pg8::StaticOrder S; S.init(NTOK, D, G, bx);
            epi::EpiRes E{xsrc, XR, (L == 0) ? (float*)(P.ws + WS_SSQ) : nullptr};
            TIMED(13, RUN_GEMM(epi::EpiRes, pg8::StaticOrder, false, g, S, E));
        }
        SEAM(pb + 6);
        if (PH_ON(8) && IN(pb + 7)) {
            const int vcu_ = vcu_of();
            if (L != 0) { TIMED(14, norm2_moe_phase(P, XSrc{nullptr, XR}, lds, vcu_, G)); TIMED(25, cvt_jobs(P, 43, 67, lds)); __syncthreads(); }
        }
        if (L != 0) SEAM(pb + 7);
        if (L == 0) {
            if (PH_ON(9) && IN(9)) {
                pg8::Gemm g{XR, (const bf16*)(P.ws + WS_W13), D, D, D, nullptr}; pg8::StaticOrder S; S.init(NTOK, 2 * DFF, G, bx);
                LAS float* rl = (LAS float*)(lds + RL_OFF);
                { const int t_ = my_tid(); const int half = __builtin_amdgcn_readfirstlane(t_ >> 8); const f32x4* sl = (const f32x4*)(P.ws + WS_SSQ);
                  int nu = 0; { pg8::Unit uu; while (nu < RL_UNITS && S.next(nu, uu)) ++nu; }
#pragma unroll 3
                  for (int i = half; i < nu; i += 2) { pg8::Unit uu; S.next(i, uu);
                      const f32x4* rp = sl + (size_t)(uu.pm * 256 + (t_ & 255)) * 4; const f32x4 s0 = rp[0], s1 = rp[1], s2 = rp[2], s3 = rp[3];
                      const float tot = (((s0[0] + s0[1]) + (s0[2] + s0[3])) + ((s1[0] + s1[1]) + (s1[2] + s1[3]))) + (((s2[0] + s2[1]) + (s2[2] + s2[3])) + ((s3[0] + s3[1]) + (s3[2] + s3[3])));
                      rl[i * 256 + (t_ & 255)] = __builtin_amdgcn_rsqf(tot * (1.0f / D) + RMS_EPS); }
                  __syncthreads(); }
                epi::EpiSwiglu E{(bf16*)(P.ws + WS_HMID), DFF, 22, rl, 0};
                TIMED(15, RUN_GEMM(epi::EpiSwiglu, pg8::StaticOrder, false, g, S, E));
            }
            SEAM(9);
            if (PH_ON(10) && IN(10)) {
                pg8::Gemm g{(const bf16*)(P.ws + WS_HMID), (const bf16*)(P.ws + WS_W2), DFF, DFF, DFF, nullptr}; pg8::StaticOrder S; S.init(NTOK, D, G, bx);
                epi::EpiRes E{XSrc{nullptr, XR}, XR, (float*)(P.ws + WS_SSQ)};
                TIMED(16, RUN_GEMM(epi::EpiRes, pg8::StaticOrder, false, g, S, E));
            }
            SEAM(10);
        } else {
            if (PH_ON(21) && IN(21)) TIMED(17, moe_assign_phase(P));
            SEAM(21);
            if (PH_ON(22) && IN(22)) {
                pg8::Gemm g{H, (const bf16*)(P.ws + WS_WM13), D, D, D, slot_tok}; const MoeOrder S = moe_order(P, 11, G, bx);
                epi::EpiSwiglu E{(bf16*)(P.ws + WS_HMID), DFFE, 11, nullptr, 0};
                TIMED(18, RUN_GEMM(epi::EpiSwiglu, MoeOrder, true, g, S, E));
            }
            SEAM(22);
            if (PH_ON(23) && IN(23)) {
                pg8::Gemm g{(const bf16*)(P.ws + WS_HMID), (const bf16*)(P.ws + WS_WM2), DFFE, DFFE, DFFE, nullptr}; const MoeOrder S = moe_order(P, 4, G, bx);
                epi::EpiMoeDown E{(bf16*)(P.ws + WS_MOEY), slot_gate};
                TIMED(19, RUN_GEMM(epi::EpiMoeDown, MoeOrder, false, g, S, E));
            }
            SEAM(23);
        }
        if (PH_ON(12) && IN(pc + 3)) {
            const int vcu_ = vcu_of();
            if (L != 0) { TIMED(20, norm_moe_combine(P, P.in[I_GPLE] + L * D, vcu_, G)); PANEL_FENCE(); }
            g128::PleProg PP; PP.pbf = (const bf16*)(P.ws + WS_PBF) + (size_t)L * NTOK * 256; PP.hp = XR; PP.wup = wmix(P, L, WM_UP); PP.wpg = wmix(P, L, WM_PG);
            PP.xin = XR; PP.xout = X2; PP.ssq = (L == 0) ? (const float*)(P.ws + WS_SSQ) : nullptr; PP.rsv = (L == 0) ? nullptr : (const float*)(P.ws + WS_SSQ);
            TIMED(22, g128::stream<g128::PleProg>(lds, PP, NTOK / 128, vcu_, G));
            PANEL_FENCE();
            if (L == 0) TIMED(1, norm1_phase(P, 1, XSrc{nullptr, X2}, vcu_, G));
        }
        if (L == 0) SEAM(pc + 3);
    }
    if (PH_ON(26) && IN(25)) {
        const int vcu_ = vcu_of(); const int G_ = gridDim.x;
        for (int r = 0; r < (NTOK / 128 + G_ - 1) / G_; ++r) {
            const int u = vcu_ + r * G_; FinalRows FR;
            if (u < NTOK / 128) final_norm_load(P, u, FR);
            xcd_barrier(bar);
            if (u < NTOK / 128) final_norm_store(P, u, FR);
        }
    }
    if (PROBE_MASK || PROBE_SEAMS) { const unsigned long long t0_ = __builtin_amdgcn_s_memrealtime(); while (__builtin_amdgcn_s_memrealtime() - t0_ < (unsigned long long)PROBE_MULT * pacc) __builtin_amdgcn_s_sleep(8); }
#undef IN
#undef SEAM
#undef H
#undef ZIN
#undef GB
#undef MB
#undef MLAQ
#undef MLAKV
#undef KPER
#undef cosT
#undef sinT
#undef slot_tok
#undef slot_gate
}

extern "C" void kernel_launch(void* const* d_in, const int* in_sizes, int n_in, void* d_out, int out_size, void* d_ws, size_t ws_size, hipStream_t stream) {
    static int grid = 0;
    if (grid == 0) {
        if (n_in != 37 || out_size != NTOK * D || ws_size < WS_END) { fprintf(stderr, "kernel_launch: unexpected shapes: n_in %d out %d ws %zu\n", n_in, out_size, ws_size); grid = -1; return; }
        int dev = 0, cus = 0, per_cu = 0;
        if (hipGetDevice(&dev) != hipSuccess || hipDeviceGetAttribute(&cus, hipDeviceAttributeMultiprocessorCount, dev) != hipSuccess) { grid = -1; return; }
        if (hipFuncSetAttribute((const void*)mega_fwd, hipFuncAttributeMaxDynamicSharedMemorySize, LDS_BYTES) != hipSuccess) { fprintf(stderr, "kernel_launch: hipFuncSetAttribute failed\n"); grid = -1; return; }
        if (hipOccupancyMaxActiveBlocksPerMultiprocessor(&per_cu, (const void*)mega_fwd, NTHREADS, LDS_BYTES) != hipSuccess || per_cu < 1)
            fprintf(stderr, "kernel_launch: note: occupancy query reports %d workgroups per CU\n", per_cu);
        (void)hipGetLastError();
        grid = cus;
        if (grid != 256) fprintf(stderr, "kernel_launch: note: %d CUs (built for 256)\n", grid);
    }
    if (grid < 0) return;
    if (hipMemsetAsync((char*)d_ws + WS_CTL, 0, CTL_ZERO_BYTES, stream) != hipSuccess) return;
    Params p{};
    for (int i = 0; i < 37; ++i) p.in[i] = (const float*)d_in[i];
    p.out = (float*)d_out; p.ws = (unsigned char*)d_ws;
#if N_LAUNCH_MODE == 1
    p.ph_lo = 0; p.ph_hi = N_PHASES;
    hipLaunchKernelGGL(mega_fwd, dim3(grid), dim3(NTHREADS), LDS_BYTES, stream, p);
#else
    for (int ph = 0; ph < N_PHASES; ++ph) { p.ph_lo = ph; p.ph_hi = ph + 1; hipLaunchKernelGGL(mega_fwd, dim3(grid), dim3(NTHREADS), LDS_BYTES, stream, p); }
#endif
    const hipError_t le = hipPeekAtLastError();
    if (le != hipSuccess) fprintf(stderr, "kernel_launch: launch failed: %s\n", hipGetErrorName(le));
}
```
